# Optimizing an MI355X kernel written in HIP

```python
import jax, jax.numpy as jnp
from jax import lax
import numpy as np

D_MODEL = 1024
BATCH = 16
SEQ = 2048
DEPTH = 1

N_ATT_HEADS = 8
ATT_HEAD_DIM = 128
KV_LORA = 256
IDX_HEADS = 8
IDX_DIM = 64
TOPK_MAX = 256
Q_BLOCK = 128
N_RET_HEADS = 4
RET_QK_DIM = 128
RET_V_DIM = 256
RET_CHUNK = 128
N_GROUPS = 4
EXPERTS_PER_GROUP = 4
N_EXPERTS = N_GROUPS * EXPERTS_PER_GROUP
EXPERT_FF = 256
TOP_K_EXPERTS = 2
EPS = 1e-6

ATT_Q_W = N_ATT_HEADS * ATT_HEAD_DIM
RET_QK_W = N_RET_HEADS * RET_QK_DIM
RET_V_W = N_RET_HEADS * RET_V_DIM
SPLITS = (ATT_Q_W, KV_LORA, IDX_HEADS * IDX_DIM, IDX_DIM, IDX_HEADS,
          RET_QK_W, RET_QK_W, RET_V_W, RET_V_W, D_MODEL, D_MODEL)
IN_WIDTH = sum(SPLITS)

kernel_name = "hybrid_dsa_retention_hmoe_block"


def rms_norm(x, g):
    xf = x.astype(jnp.float32)
    y = xf * lax.rsqrt(jnp.mean(xf * xf, axis=-1, keepdims=True) + EPS)
    return (y * g.astype(jnp.float32)).astype(x.dtype)


def group_norm_heads(x, g):
    xf = x.astype(jnp.float32)
    mu = jnp.mean(xf, axis=-1, keepdims=True)
    var = jnp.mean(jnp.square(xf - mu), axis=-1, keepdims=True)
    return ((xf - mu) * lax.rsqrt(var + EPS) * g.astype(jnp.float32)).astype(x.dtype)


def alibi_slopes(n_heads):
    return 2.0 ** (-8.0 * jnp.arange(1, n_heads + 1, dtype=jnp.float32) / n_heads)


def retention_decays(n_heads):
    return 1.0 - 2.0 ** (-5.0 - jnp.arange(n_heads, dtype=jnp.float32))


def sparse_indexed_attention(q, k, v, q_idx, k_idx, w_idx, slopes):
    B, S, H, Dh = q.shape
    n_sel = min(TOPK_MAX, S // 4)
    nb = S // Q_BLOCK
    key_pos = jnp.arange(S)
    k_idx32 = k_idx.astype(jnp.float32)

    def to_blocks(a):
        return a.reshape((B, nb, Q_BLOCK) + a.shape[2:]).swapaxes(0, 1)

    def one_block(args):
        qb, qib, wb, blk = args
        q_pos = blk * Q_BLOCK + jnp.arange(Q_BLOCK)
        causal = key_pos[None, :] <= q_pos[:, None]
        dots = jnp.einsum('bqhd,bsd->bqhs', qib.astype(jnp.float32), k_idx32) * (IDX_DIM ** -0.5)
        score = jnp.einsum('bqhs,bqh->bqs', jax.nn.relu(dots), wb.astype(jnp.float32))
        score = jnp.where(causal[None], score, -jnp.inf)
        _, sel = lax.top_k(score, n_sel)
        k_sel = jax.vmap(lambda kk, ii: kk[ii])(k, sel)
        v_sel = jax.vmap(lambda vv, ii: vv[ii])(v, sel)
        logits = jnp.einsum('bqhd,bqkd->bhqk', qb, k_sel).astype(jnp.float32) * (Dh ** -0.5)
        dist = (q_pos[None, :, None] - sel).astype(jnp.float32)
        logits = logits - slopes[None, :, None, None] * dist[:, None]
        valid = sel <= q_pos[None, :, None]
        logits = jnp.where(valid[:, None], logits, -jnp.inf)
        p = jax.nn.softmax(logits, axis=-1).astype(v.dtype)
        return jnp.einsum('bhqk,bqkd->bqhd', p, v_sel)

    out = lax.map(one_block, (to_blocks(q), to_blocks(q_idx), to_blocks(w_idx), jnp.arange(nb)))
    return out.swapaxes(0, 1).reshape(B, S, H, Dh)


def retention_chunkwise(q, k, v, gammas):
    B, S, H, Dk = q.shape
    Dv = v.shape[-1]
    C = RET_CHUNK
    n = S // C
    log_g = jnp.log(gammas)
    i = jnp.arange(C, dtype=jnp.float32)
    rel = i[:, None] - i[None, :]
    decay_intra = jnp.where(rel[None] >= 0, jnp.exp(rel[None] * log_g[:, None, None]), 0.0)
    q_decay = jnp.exp((i + 1.0)[None] * log_g[:, None])
    k_decay = jnp.exp((C - 1.0 - i)[None] * log_g[:, None])
    chunk_decay = jnp.exp(C * log_g)

    def chunks(a):
        return a.astype(jnp.float32).reshape(B, n, C, H, a.shape[-1]).transpose(1, 0, 3, 2, 4)

    qc = chunks(q)
    kc = chunks(k) * (Dk ** -0.5)
    vc = chunks(v)

    def step(state, xs):
        qi, ki, vi = xs
        intra = jnp.einsum('bhqd,bhkd->bhqk', qi, ki) * decay_intra[None]
        o = (jnp.einsum('bhqk,bhkv->bhqv', intra, vi)
             + jnp.einsum('bhqd,bhdv->bhqv', qi * q_decay[None, :, :, None], state))
        state = (chunk_decay[None, :, None, None] * state
                 + jnp.einsum('bhkd,bhkv->bhdv', ki * k_decay[None, :, :, None], vi))
        return state, o

    init = jnp.zeros((B, H, Dk, Dv), jnp.float32)
    _, o = lax.scan(step, init, (qc, kc, vc))
    return o.transpose(1, 0, 3, 2, 4).reshape(B, S, H, Dv)


def hierarchical_moe(h, w_group, b_group, w_er, b_er, w_gate, w_up, w_down):
    B, S, D = h.shape
    t = h.reshape(B * S, D)
    g_logits = (t @ w_group).astype(jnp.float32) + b_group.astype(jnp.float32)
    g_prob = jax.nn.softmax(g_logits, axis=-1)
    g_sel = jnp.argmax(g_logits, axis=-1)
    g_w = jnp.take_along_axis(g_prob, g_sel[:, None], axis=1)
    e_logits = ((t @ w_er).astype(jnp.float32) + b_er.astype(jnp.float32)).reshape(-1, N_GROUPS, EXPERTS_PER_GROUP)
    e_in = jnp.take_along_axis(e_logits, g_sel[:, None, None], axis=1)[:, 0]
    top_v, top_i = lax.top_k(e_in, TOP_K_EXPERTS)
    top_p = jax.nn.softmax(top_v, axis=-1) * g_w
    expert_id = g_sel[:, None] * EXPERTS_PER_GROUP + top_i
    comb = jnp.sum(jax.nn.one_hot(expert_id, N_EXPERTS, dtype=jnp.float32) * top_p[..., None], axis=1)
    hg = jnp.einsum('td,edf->tef', t, w_gate)
    hu = jnp.einsum('td,edf->tef', t, w_up)
    act = jax.nn.silu(hg) * hu * comb[..., None].astype(hg.dtype)
    out = jnp.einsum('tef,efd->td', act, w_down)
    return out.reshape(B, S, D).astype(h.dtype)


def setup_inputs(seed: int = 0) -> dict:
    key = jax.random.key(seed)
    ks = jax.random.split(key, 24)
    L = DEPTH
    f32 = jnp.float32

    def nrm(k, shape, fan_in):
        return jax.random.normal(k, shape, f32) * (fan_in ** -0.5)

    def gain(k, shape):
        return 1.0 + 0.02 * jax.random.normal(k, shape, f32)

    return {
        "x": jax.random.normal(ks[0], (BATCH, SEQ, D_MODEL), f32),
        "norm1_g": gain(ks[1], (L, D_MODEL)),
        "w_in": nrm(ks[2], (L, D_MODEL, IN_WIDTH), D_MODEL),
        "kv_norm_g": gain(ks[3], (L, KV_LORA)),
        "w_kv_up": nrm(ks[4], (L, KV_LORA, 2 * ATT_HEAD_DIM), KV_LORA),
        "q_norm_g": gain(ks[5], (L, ATT_HEAD_DIM)),
        "k_norm_g": gain(ks[6], (L, ATT_HEAD_DIM)),
        "idx_k_norm_g": gain(ks[7], (L, IDX_DIM)),
        "ret_norm_g": gain(ks[8], (L, N_RET_HEADS, RET_V_DIM)),
        "w_att_branch": nrm(ks[9], (L, ATT_Q_W, D_MODEL), ATT_Q_W),
        "w_ret_branch": nrm(ks[10], (L, RET_V_W, D_MODEL), RET_V_W),
        "w_out": nrm(ks[11], (L, D_MODEL, D_MODEL), D_MODEL),
        "norm2_g": gain(ks[12], (L, D_MODEL)),
        "w_group_router": nrm(ks[13], (L, D_MODEL, N_GROUPS), D_MODEL),
        "b_group_router": 0.01 * jax.random.normal(ks[14], (L, N_GROUPS), f32),
        "w_expert_router": nrm(ks[15], (L, D_MODEL, N_EXPERTS), D_MODEL),
        "b_expert_router": 0.01 * jax.random.normal(ks[16], (L, N_EXPERTS), f32),
        "w_exp_gate": nrm(ks[17], (L, N_EXPERTS, D_MODEL, EXPERT_FF), D_MODEL),
        "w_exp_up": nrm(ks[18], (L, N_EXPERTS, D_MODEL, EXPERT_FF), D_MODEL),
        "w_exp_down": nrm(ks[19], (L, N_EXPERTS, EXPERT_FF, D_MODEL), EXPERT_FF),
    }


def reference(x, norm1_g, w_in, kv_norm_g, w_kv_up, q_norm_g, k_norm_g, idx_k_norm_g,
              ret_norm_g, w_att_branch, w_ret_branch, w_out, norm2_g, w_group_router,
              b_group_router, w_expert_router, b_expert_router, w_exp_gate, w_exp_up,
              w_exp_down):
    B, S, D = x.shape
    slopes = alibi_slopes(N_ATT_HEADS)
    gammas = retention_decays(N_RET_HEADS)
    points = np.cumsum(np.array(SPLITS))[:-1].tolist()
    h = x
    for l in range(DEPTH):
        n = rms_norm(h, norm1_g[l])
        proj = n @ w_in[l]
        (q_att, c_kv, q_idx, k_idx, w_idx, r_q, r_k, r_v, r_gate,
         g_att, g_ret) = jnp.split(proj, points, axis=-1)

        q = rms_norm(q_att.reshape(B, S, N_ATT_HEADS, ATT_HEAD_DIM), q_norm_g[l])
        kv = rms_norm(c_kv, kv_norm_g[l]) @ w_kv_up[l]
        k_sh, v_sh = jnp.split(kv, 2, axis=-1)
        k_sh = rms_norm(k_sh, k_norm_g[l])
        k_idx = rms_norm(k_idx, idx_k_norm_g[l])
        w_idx = w_idx * (IDX_HEADS ** -0.5)
        att = sparse_indexed_attention(q, k_sh, v_sh,
                                       q_idx.reshape(B, S, IDX_HEADS, IDX_DIM),
                                       k_idx, w_idx, slopes)
        y_att = att.reshape(B, S, ATT_Q_W) @ w_att_branch[l]

        ret = retention_chunkwise(r_q.reshape(B, S, N_RET_HEADS, RET_QK_DIM),
                                  r_k.reshape(B, S, N_RET_HEADS, RET_QK_DIM),
                                  r_v.reshape(B, S, N_RET_HEADS, RET_V_DIM), gammas)
        ret = group_norm_heads(ret, ret_norm_g[l]).astype(h.dtype)
        y_ret = (jax.nn.silu(r_gate) * ret.reshape(B, S, RET_V_W)) @ w_ret_branch[l]

        mixed = jax.nn.sigmoid(g_att) * y_att + jax.nn.sigmoid(g_ret) * y_ret
        h = h + mixed @ w_out[l]

        n2 = rms_norm(h, norm2_g[l])
        h = h + hierarchical_moe(n2, w_group_router[l], b_group_router[l],
                                 w_expert_router[l], b_expert_router[l],
                                 w_exp_gate[l], w_exp_up[l], w_exp_down[l])
    return h
```

```cpp
#include <hip/hip_runtime.h>
#include <hip/hip_cooperative_groups.h>
#include <cstdio>
#include <cstdint>

namespace pg8 {
#define PG8_LAS __attribute__((address_space(3)))
typedef unsigned short bf16_t;
typedef short bf16x8 __attribute__((ext_vector_type(8)));
typedef float f32x4 __attribute__((ext_vector_type(4)));
typedef unsigned u32x4 __attribute__((ext_vector_type(4)));
typedef unsigned u32x2 __attribute__((ext_vector_type(2)));
constexpr int BM = 256, BK = 64, HALF = 128, HTB = HALF * BK * 2  , STAGE_BYTES = 8 * HTB, NXCD = 8, WGM = 8;

__host__ __device__ __forceinline__ int lds_byte(int r, int c) { const int st = (r >> 4) * 2 + (c >> 5), rr = r & 15, cc = c & 31, ob = rr * 64 + cc * 2; return st * 1024 + (ob ^ (((ob >> 9) & 1) << 5)); }
__host__ __device__ __forceinline__ void stage_rc(int b, int& R, int& C) { const int st = b / 1024, sb = b % 1024, swz = sb ^ (((sb >> 9) & 1) << 5); R = (st >> 1) * 16 + swz / 64; C = (st & 1) * 32 + (swz % 64) / 2; }
__host__ __device__ __forceinline__ int perm32(int rho) { const int n = rho >> 4, i = rho & 15; return 8 * (i >> 2) + 4 * n + (i & 3); }

struct Unit { int pm, pn; const char* a; const char* b; long bjump; int aux; };
struct Gemm { int K, lda, ldb, ksplit; };

struct StaticOrder {
    int nM, nN, nwg, G, c; const char* A; const char* Bt; size_t tA, tB;
    __device__ void init(int M, int N, int G_, int c_, const void* A_, int lda, const void* Bt_, int ldb) { nM = M / BM; nN = N / BM; nwg = nM * nN; G = G_; c = c_; A = (const char*)A_; Bt = (const char*)Bt_; tA = (size_t)BM * lda * 2; tB = (size_t)BM * ldb * 2; }
    __device__ bool next(int i, Unit& u) const {
        const long L = (long)i * G + c; if (L >= nwg) return false;
        int wgid = (int)L; { const int q = nwg / NXCD, r = nwg % NXCD, xcd = wgid % NXCD, off = wgid / NXCD; wgid = (xcd < r ? xcd * (q + 1) : r * (q + 1) + (xcd - r) * q) + off; }
        const int nig = WGM * nN, gid = wgid / nig, fm = gid * WGM, gsz = (nM - fm) < WGM ? (nM - fm) : WGM;
        u.pm = fm + ((wgid % nig) % gsz); u.pn = (wgid % nig) / gsz; u.a = A + (size_t)u.pm * tA; u.b = Bt + (size_t)u.pn * tB; u.bjump = 0; u.aux = 0; return true;
    }
    __device__ __forceinline__ void a_ready(const Unit&) const {}
    __device__ __forceinline__ void done(const Unit&) const {}
};

typedef float f32x2c __attribute__((ext_vector_type(2))); typedef __bf16 bf16x2c __attribute__((ext_vector_type(2)));
__device__ __forceinline__ unsigned cvt_pk_bf16(float lo, float hi) { const f32x2c v = {lo, hi}; const bf16x2c b = __builtin_convertvector(v, bf16x2c); return __builtin_bit_cast(unsigned, b); }
__device__ __forceinline__ float bf_lo(unsigned w) { return __uint_as_float(w << 16); }
__device__ __forceinline__ float bf_hi(unsigned w) { return __uint_as_float(w & 0xffff0000u); }


template <class Epi, class Sched, bool ALIGN_EPI = false, bool SP2 = false>
__device__ __forceinline__ void gemm_phase(PG8_LAS unsigned char* lds, const Gemm g, const Sched& S, const Epi& E) {
    const int tid = threadIdx.x, wid = __builtin_amdgcn_readfirstlane(tid >> 6), lane = tid & 63, wr = wid >> 2, wc = wid & 3, fr = lane & 15, fq = lane >> 4;
    const int K = g.K, nt = K / BK;
    unsigned voffA[2], voffB[2];
#pragma unroll
    for (int i = 0; i < 2; ++i) { int R, C; stage_rc(tid * 16 + i * 8192, R, C); const int Rb = Epi::PERM ? ((R & ~31) + perm32(R & 31)) : R;
        voffA[i] = (unsigned)(R * g.lda + C) * 2u; voffB[i] = (unsigned)(Rb * g.ldb + C) * 2u; }
    const size_t kstep = (size_t)(BK * 2);
    const size_t hstepA = (size_t)HALF * g.lda * 2, hstepB = (size_t)HALF * g.ldb * 2;
    const unsigned ldsw = (unsigned)wid * 1024u;
    const int aoff = lds_byte(wr * 64 + fr, fq * 8), boff = lds_byte(wc * 32 + fr, fq * 8);
#define PG8_SA(b, h) (((b) * 2 + (h)) * HTB)
#define PG8_SB(b, h) ((4 + (b) * 2 + (h)) * HTB)
#define PG8_STAGE(bufoff, gbase, voff) do { _Pragma("unroll") for (int _i = 0; _i < 2; ++_i) \
        __builtin_amdgcn_global_load_lds((const unsigned*)((const char*)(gbase) + (voff)[_i]), (PG8_LAS unsigned*)(lds + (bufoff) + ldsw + _i * 8192), 16, 0, 0); } while (0)
#define PG8_LDA(dst, b, h) do { _Pragma("unroll") for (int m = 0; m < 4; ++m) _Pragma("unroll") for (int k = 0; k < 2; ++k) dst[m][k] = *(const PG8_LAS bf16x8*)(lds + PG8_SA(b, h) + aoff + m * 2048 + k * 1024); } while (0)
#define PG8_LDB(dst, b, h) do { _Pragma("unroll") for (int n = 0; n < 2; ++n) _Pragma("unroll") for (int k = 0; k < 2; ++k) dst[n][k] = *(const PG8_LAS bf16x8*)(lds + PG8_SB(b, h) + boff + n * 2048 + k * 1024); } while (0)
#define PG8_MMA(ai, bj, At, Bt) do { __builtin_amdgcn_s_setprio(1); _Pragma("unroll") for (int m = 0; m < 4; ++m) _Pragma("unroll") for (int n = 0; n < 2; ++n) _Pragma("unroll") for (int k = 0; k < 2; ++k) \
        acc[ai][bj][m][n] = __builtin_amdgcn_mfma_f32_16x16x32_bf16(Bt[n][k], At[m][k], acc[ai][bj][m][n], 0, 0, 0); __builtin_amdgcn_s_setprio(0); } while (0)
#define PG8_WAIT_V(n) asm volatile("s_waitcnt vmcnt(" #n ")" ::: "memory")
#define PG8_WAIT_L(n) asm volatile("s_waitcnt lgkmcnt(" #n ")" ::: "memory")
#define PG8_BAR __builtin_amdgcn_s_barrier()
#define PG8_SCHED __builtin_amdgcn_sched_barrier(0)
    Unit cur, nxt; int ui = 0;
    if (!S.next(0, cur)) return;
    f32x4 acc[2][2][4][2];
#pragma unroll
    for (int a = 0; a < 2; ++a)
#pragma unroll
        for (int b = 0; b < 2; ++b)
#pragma unroll
            for (int m = 0; m < 4; ++m)
#pragma unroll
                for (int n = 0; n < 2; ++n) acc[a][b][m][n] = (f32x4){0.f, 0.f, 0.f, 0.f};
    bf16x8 At[4][2], B0[2][2], B1[2][2];
    const char* cA = cur.a; const char* cB = cur.b; long cJ = cur.bjump;
    S.a_ready(cur);
    if constexpr (SP2) {
        PG8_STAGE(PG8_SB(0, 0), cB, voffB); PG8_STAGE(PG8_SB(0, 1), cB + hstepB, voffB); PG8_STAGE(PG8_SA(0, 0), cA, voffA); PG8_STAGE(PG8_SA(0, 1), cA + hstepA, voffA);
        if (wr == 1) PG8_BAR;
        PG8_WAIT_V(2); PG8_BAR;
        PG8_STAGE(PG8_SB(1, 0), cB + kstep, voffB); PG8_STAGE(PG8_SA(1, 0), cA + kstep, voffA); PG8_STAGE(PG8_SB(1, 1), cB + hstepB + kstep, voffB);
        PG8_WAIT_V(6); PG8_BAR;
    } else {
        PG8_STAGE(PG8_SB(0, 0), cB, voffB); PG8_STAGE(PG8_SA(0, 0), cA, voffA); PG8_STAGE(PG8_SB(0, 1), cB + hstepB, voffB); PG8_STAGE(PG8_SA(0, 1), cA + hstepA, voffA);
        if (wr == 1) PG8_BAR;
        PG8_WAIT_V(4); PG8_BAR;
        PG8_STAGE(PG8_SB(1, 0), cB + kstep, voffB); PG8_STAGE(PG8_SA(1, 0), cA + kstep, voffA); PG8_STAGE(PG8_SB(1, 1), cB + hstepB + kstep, voffB);
        PG8_WAIT_V(6); PG8_BAR;
    }
    for (;;) {
        const bool has_next = S.next(ui + 1, nxt);
        const char* nA = has_next ? nxt.a : cA; const char* nB = has_next ? nxt.b : cB;
#pragma unroll 1
        for (int t = 0; t < nt; t += 2) {
            const bool last = (t == nt - 2);
            const char* a1 = cA + (size_t)(t + 1) * kstep;
            const char* a2 = last ? nA : cA + (size_t)(t + 2) * kstep; const char* b2 = last ? nB : cB + (size_t)(t + 2) * kstep + ((t + 2) >= g.ksplit ? cJ : 0L);
            const char* a3 = a2 + kstep; const char* b3 = b2 + kstep;
            if (last && has_next) S.a_ready(nxt);
            if constexpr (SP2) {
            PG8_LDB(B0, 0, 0); PG8_LDB(B1, 0, 1); PG8_SCHED; PG8_LDA(At, 0, 0); PG8_STAGE(PG8_SA(1, 1), a1 + hstepA, voffA);
            PG8_WAIT_V(8); PG8_WAIT_L(0); PG8_BAR; PG8_MMA(0, 0, At, B0); PG8_MMA(0, 1, At, B1); PG8_BAR; PG8_SCHED;
            PG8_LDA(At, 0, 1); PG8_STAGE(PG8_SB(0, 0), b2, voffB); PG8_STAGE(PG8_SB(0, 1), b2 + hstepB, voffB); PG8_STAGE(PG8_SA(0, 0), a2, voffA);
            PG8_WAIT_V(8); PG8_WAIT_L(0); PG8_BAR; PG8_MMA(1, 0, At, B0); PG8_MMA(1, 1, At, B1); PG8_BAR; PG8_SCHED;
            PG8_LDB(B0, 1, 0); PG8_LDB(B1, 1, 1); PG8_SCHED; PG8_LDA(At, 1, 0); PG8_STAGE(PG8_SA(0, 1), a2 + hstepA, voffA);
            PG8_WAIT_V(8); PG8_WAIT_L(0); PG8_BAR; PG8_MMA(0, 0, At, B0); PG8_MMA(0, 1, At, B1); PG8_BAR; PG8_SCHED;
            PG8_LDA(At, 1, 1); PG8_STAGE(PG8_SB(1, 0), b3, voffB); PG8_STAGE(PG8_SB(1, 1), b3 + hstepB, voffB); PG8_STAGE(PG8_SA(1, 0), a3, voffA);
            PG8_WAIT_V(8); PG8_WAIT_L(0); PG8_BAR; PG8_MMA(1, 0, At, B0); PG8_MMA(1, 1, At, B1); PG8_BAR; PG8_SCHED;
            } else {
            PG8_LDB(B0, 0, 0); PG8_SCHED; PG8_LDA(At, 0, 0); PG8_STAGE(PG8_SA(1, 1), a1 + hstepA, voffA);
            PG8_WAIT_L(8); PG8_BAR; PG8_WAIT_L(0); PG8_MMA(0, 0, At, B0); PG8_BAR; PG8_SCHED;
            PG8_LDB(B1, 0, 1); PG8_STAGE(PG8_SB(0, 0), b2, voffB);
            PG8_BAR; PG8_WAIT_L(0); PG8_MMA(0, 1, At, B1); PG8_BAR;
            PG8_LDA(At, 0, 1); PG8_STAGE(PG8_SA(0, 0), a2, voffA);
            PG8_BAR; PG8_WAIT_L(0); PG8_MMA(1, 0, At, B0); PG8_BAR; PG8_SCHED;
            PG8_STAGE(PG8_SB(0, 1), b2 + hstepB, voffB);
            PG8_WAIT_V(6); PG8_BAR; PG8_MMA(1, 1, At, B1); PG8_BAR;
            PG8_LDB(B0, 1, 0); PG8_SCHED; PG8_LDA(At, 1, 0); PG8_STAGE(PG8_SA(0, 1), a2 + hstepA, voffA);
            PG8_WAIT_L(8); PG8_BAR; PG8_WAIT_L(0); PG8_MMA(0, 0, At, B0); PG8_BAR; PG8_SCHED;
            PG8_LDB(B1, 1, 1); PG8_STAGE(PG8_SB(1, 0), b3, voffB);
            PG8_BAR; PG8_WAIT_L(0); PG8_MMA(0, 1, At, B1); PG8_BAR;
            PG8_LDA(At, 1, 1); PG8_STAGE(PG8_SA(1, 0), a3, voffA);
            PG8_BAR; PG8_WAIT_L(0); PG8_MMA(1, 0, At, B0); PG8_BAR; PG8_SCHED;
            PG8_STAGE(PG8_SB(1, 1), b3 + hstepB, voffB);
            PG8_WAIT_V(6); PG8_BAR; PG8_MMA(1, 1, At, B1); PG8_BAR;
            }
        }
        if constexpr (ALIGN_EPI) { if (wr == 0) PG8_BAR; }
        if constexpr (!Epi::AFTER_DRAIN) { E(acc, cur, wr, wc, fr, fq); S.done(cur); }
        if (!has_next) break;
#pragma unroll
        for (int a = 0; a < 2; ++a)
#pragma unroll
            for (int b = 0; b < 2; ++b)
#pragma unroll
                for (int m = 0; m < 4; ++m)
#pragma unroll
                    for (int n = 0; n < 2; ++n) acc[a][b][m][n] = (f32x4){0.f, 0.f, 0.f, 0.f};
        cur = nxt; cA = nA; cB = nB; cJ = cur.bjump; ++ui;
        if constexpr (ALIGN_EPI) { if (wr == 1) PG8_BAR; }
    }
    PG8_WAIT_V(0);
    if constexpr (!ALIGN_EPI) { if (wr == 0) PG8_BAR; }
    PG8_BAR;
    if constexpr (Epi::AFTER_DRAIN) { E.fused(acc, cur, wr, wc, fr, fq, lds, wid, lane); S.done(cur); }
#undef PG8_SA
#undef PG8_SB
#undef PG8_STAGE
#undef PG8_LDA
#undef PG8_LDB
#undef PG8_MMA
#undef PG8_WAIT_V
#undef PG8_WAIT_L
#undef PG8_BAR
#undef PG8_SCHED
}
}

constexpr int D = 1024, BATCH = 16, SEQ = 2048, T = BATCH * SEQ;
constexpr int INW = 6984, INWP = 7168;
constexpr int C_QA = 0, C_CKV = 1024, C_QI = 1280, C_KI = 1792, C_WI = 1856, C_RQ = 1864, C_RK = 2376, C_RV = 2888, C_RG = 3912, C_GA = 4936, C_GR = 5960;
constexpr float EPS = 1e-6f;
constexpr int NWAVES = 8;

constexpr size_t MiB = 1u << 20;
constexpr size_t WS_CTL = 0, CTL_ZERO_BYTES = 1 * MiB;
constexpr size_t WS_WIN = 1 * MiB, WS_WKV = 15 * MiB, WS_WATT = 16 * MiB, WS_WRET = 18 * MiB, WS_WOUT = 20 * MiB, WS_W1 = 22 * MiB, WS_WD = 38 * MiB, WS_ACT = 46 * MiB;
constexpr size_t O_QA = 0, O_CKV = 2048, O_QI = 2560, O_KW = 3584, O_RQ = 3840, O_RK = 4864, O_RV = 5888, O_RG = 7936, O_GA = 9984, O_GR = 12032, O_END = 14080;

constexpr int MP_ROWS = 38912;
constexpr size_t MO_APERM = 0, MO_ACT = 80 * MiB, MO_N2 = 120 * MiB, MO_META = 184 * MiB;
constexpr size_t MM_B = 0, MM_P = 131072, MM_CL = 262144, MM_CH = 393216, MM_RS = 524288, MM_PTOK = 655360, MM_PRS = 819200, MM_PCL = 983040, MM_PCH = 1146880, MM_END = 1310720;
constexpr size_t WS_WR = 15 * MiB + 512 * 1024;
constexpr int CW_MOE = 256;
constexpr int RING_OFF = 0, RING_BYTES = 131072, P3_HIST_OFF = 131072, P3_TOT_OFF = 147456, P3_T_OFF = 149504, LDSCTL_OFF = 151552, MISC_OFF = LDSCTL_OFF + 320, LDS_BYTES = 152576;
constexpr int CW_Q3 = 64, CW_Q4 = 128;

#define GAS __attribute__((address_space(1)))
#define LAS __attribute__((address_space(3)))
typedef unsigned short bf16;
typedef unsigned v4u __attribute__((ext_vector_type(4)));
typedef float f32x4 __attribute__((ext_vector_type(4)));
#define LDS_WAIT() asm volatile("s_waitcnt lgkmcnt(0)" ::: "memory")
#define VM_WAIT() asm volatile("s_waitcnt vmcnt(0)" ::: "memory")
__device__ __forceinline__ unsigned f2bf(float f) { unsigned u = __builtin_bit_cast(unsigned, f); return (u + 0x7fffu + ((u >> 16) & 1u)) >> 16; }
__device__ __forceinline__ unsigned pk2(float lo, float hi) { return f2bf(lo) | (f2bf(hi) << 16); }
__device__ __forceinline__ float bf2f(bf16 b) { return __uint_as_float((unsigned)b << 16); }

struct Args { const float* in[20]; float* out; unsigned char* ws; unsigned char* xb; int ph_lo, ph_hi, ntok, tok0; };

struct Frame {
    LAS unsigned char* lds;
    int tid, lane, wave, vcu, G;
    int ntok;
    unsigned char* ws; unsigned char* act;
};

struct EpiProj {
    static constexpr bool PERM = true, AFTER_DRAIN = false;
    unsigned char* act; size_t ntok;
    __device__ __forceinline__ void operator()(const pg8::f32x4 (&acc)[2][2][4][2], const pg8::Unit& u, int wr, int wc, int fr, int fq) const {
        const int pn = u.pn; size_t O; int ld, cb, nbj = 2;
        if (pn < 4) { O = O_QA; ld = 1024; cb = pn * 256; }
        else if (pn == 4) { O = O_CKV; ld = 256; cb = 0; }
        else if (pn < 7) { O = O_QI; ld = 512; cb = (pn - 5) * 256; }
        else if (pn == 7) { O = O_KW; ld = 128; cb = 0; nbj = 1; }
        else if (pn < 10) { O = O_RQ; ld = 512; cb = (pn - 8) * 256; }
        else if (pn < 12) { O = O_RK; ld = 512; cb = (pn - 10) * 256; }
        else { O = O_RV + (size_t)((pn - 12) >> 2) * 2048; ld = 1024; cb = ((pn - 12) & 3) * 256; }
        pg8::bf16_t* base = (pg8::bf16_t*)(act + ntok * O);
        const int row0 = u.pm * pg8::BM + wr * 64 + fr, col0 = cb + wc * 32 + 8 * fq;
#pragma unroll
        for (int ai = 0; ai < 2; ++ai)
#pragma unroll
            for (int m = 0; m < 4; ++m) { pg8::bf16_t* rowp = base + (size_t)(row0 + ai * pg8::HALF + m * 16) * ld + col0;
#pragma unroll
                for (int bj = 0; bj < 2; ++bj) if (bj < nbj) { const pg8::f32x4 v0 = acc[ai][bj][m][0], v1 = acc[ai][bj][m][1];
                    pg8::u32x4 w; w.x = pg8::cvt_pk_bf16(v0[0], v0[1]); w.y = pg8::cvt_pk_bf16(v0[2], v0[3]); w.z = pg8::cvt_pk_bf16(v1[0], v1[1]); w.w = pg8::cvt_pk_bf16(v1[2], v1[3]);
                    *(pg8::u32x4*)(rowp + bj * pg8::HALF) = w; } }
    }
};


__device__ __forceinline__ float sigm(float x) { return 1.f / (1.f + __expf(-x)); }
struct EpiGateA {
    static constexpr bool PERM = true, AFTER_DRAIN = false;
    pg8::bf16_t* GA;
    __device__ __forceinline__ void operator()(const pg8::f32x4 (&acc)[2][2][4][2], const pg8::Unit& u, int wr, int wc, int fr, int fq) const {
        const int row0 = u.pm * pg8::BM + wr * 64 + fr, col0 = u.pn * pg8::BM + wc * 32 + 8 * fq;
#pragma unroll
        for (int ai = 0; ai < 2; ++ai)
#pragma unroll
            for (int m = 0; m < 4; ++m) { pg8::bf16_t* rowp = GA + (size_t)(row0 + ai * pg8::HALF + m * 16) * 1024 + col0;
#pragma unroll
                for (int bj = 0; bj < 2; ++bj) { const pg8::u32x4 g = *(const pg8::u32x4*)(rowp + bj * pg8::HALF); const pg8::f32x4 v0 = acc[ai][bj][m][0], v1 = acc[ai][bj][m][1];
                    pg8::u32x4 w; w.x = pg8::cvt_pk_bf16(sigm(pg8::bf_lo(g.x)) * v0[0], sigm(pg8::bf_hi(g.x)) * v0[1]); w.y = pg8::cvt_pk_bf16(sigm(pg8::bf_lo(g.y)) * v0[2], sigm(pg8::bf_hi(g.y)) * v0[3]);
                    w.z = pg8::cvt_pk_bf16(sigm(pg8::bf_lo(g.z)) * v1[0], sigm(pg8::bf_hi(g.z)) * v1[1]); w.w = pg8::cvt_pk_bf16(sigm(pg8::bf_lo(g.w)) * v1[2], sigm(pg8::bf_hi(g.w)) * v1[3]);
                    *(pg8::u32x4*)(rowp + bj * pg8::HALF) = w; } }
    }
};
struct EpiGateB {
    static constexpr bool PERM = true, AFTER_DRAIN = false;
    pg8::bf16_t* GA; const pg8::bf16_t* GR;
    __device__ __forceinline__ void operator()(const pg8::f32x4 (&acc)[2][2][4][2], const pg8::Unit& u, int wr, int wc, int fr, int fq) const {
        const int row0 = u.pm * pg8::BM + wr * 64 + fr, col0 = u.pn * pg8::BM + wc * 32 + 8 * fq;
#pragma unroll
        for (int ai = 0; ai < 2; ++ai)
#pragma unroll
            for (int m = 0; m < 4; ++m) { const size_t ro = (size_t)(row0 + ai * pg8::HALF + m * 16) * 1024 + col0;
#pragma unroll
                for (int bj = 0; bj < 2; ++bj) { const pg8::u32x4 t = *(const pg8::u32x4*)(GA + ro + bj * pg8::HALF), g = *(const pg8::u32x4*)(GR + ro + bj * pg8::HALF); const pg8::f32x4 v0 = acc[ai][bj][m][0], v1 = acc[ai][bj][m][1];
                    pg8::u32x4 w; w.x = pg8::cvt_pk_bf16(pg8::bf_lo(t.x) + sigm(pg8::bf_lo(g.x)) * v0[0], pg8::bf_hi(t.x) + sigm(pg8::bf_hi(g.x)) * v0[1]); w.y = pg8::cvt_pk_bf16(pg8::bf_lo(t.y) + sigm(pg8::bf_lo(g.y)) * v0[2], pg8::bf_hi(t.y) + sigm(pg8::bf_hi(g.y)) * v0[3]);
                    w.z = pg8::cvt_pk_bf16(pg8::bf_lo(t.z) + sigm(pg8::bf_lo(g.z)) * v1[0], pg8::bf_hi(t.z) + sigm(pg8::bf_hi(g.z)) * v1[1]); w.w = pg8::cvt_pk_bf16(pg8::bf_lo(t.w) + sigm(pg8::bf_lo(g.w)) * v1[2], pg8::bf_hi(t.w) + sigm(pg8::bf_hi(g.w)) * v1[3]);
                    *(pg8::u32x4*)(GA + ro + bj * pg8::HALF) = w; } }
    }
};
struct EpiResid {
    static constexpr bool PERM = false, AFTER_DRAIN = false;
    const float* x; float* out;
    __device__ __forceinline__ void operator()(const pg8::f32x4 (&acc)[2][2][4][2], const pg8::Unit& u, int wr, int wc, int fr, int fq) const {
        const int row0 = u.pm * pg8::BM + wr * 64 + fr, col0 = u.pn * pg8::BM + wc * 32 + 4 * fq;
#pragma unroll
        for (int ai = 0; ai < 2; ++ai)
#pragma unroll
            for (int m = 0; m < 4; ++m) { const size_t ro = (size_t)(row0 + ai * pg8::HALF + m * 16) * 1024 + col0;
#pragma unroll
                for (int bj = 0; bj < 2; ++bj)
#pragma unroll
                    for (int n = 0; n < 2; ++n) { const size_t o = ro + bj * pg8::HALF + n * 16; *(pg8::f32x4*)(out + o) = *(const pg8::f32x4*)(x + o) + acc[ai][bj][m][n]; } }
    }
};

__device__ __forceinline__ float wave_sum(float v) {
#pragma unroll
    for (int o = 1; o < 64; o <<= 1) v += __shfl_xor(v, o);
    return v;
}
__device__ __forceinline__ void p0_transpose_item(const float* W, int K, int N, bf16* WT, int map, int row_off, int par, const float* gk, LAS float* scr, int item, int lane) {
    const int nblk = (N + 31) / 32, kb = item / nblk, nb = item % nblk, k0 = 64 * kb, n0 = 32 * nb;
    const int nn = n0 + (lane & 31);
#pragma unroll 8
    for (int i = 0; i < 32; ++i) { const int kk = 2 * i + (lane >> 5); float v = (nn < N) ? W[(size_t)(k0 + kk) * N + nn] : 0.f; if (gk) v *= gk[k0 + kk]; scr[kk * 33 + (lane & 31)] = v; }
    LDS_WAIT(); asm volatile("" ::: "memory");
    const int c = lane & 7;
#pragma unroll
    for (int j = 0; j < 4; ++j) { const int nl = (lane >> 3) + 8 * j, n = n0 + nl; const LAS float* s = scr + (8 * c) * 33 + nl;
        v4u o; o.x = pk2(s[0 * 33], s[1 * 33]); o.y = pk2(s[2 * 33], s[3 * 33]); o.z = pk2(s[4 * 33], s[5 * 33]); o.w = pk2(s[6 * 33], s[7 * 33]);
        if (n < N) { const int row = (map == 0) ? row_off + n : (map == 1) ? (n < 1864 ? n : n + 184) : row_off + 2 * n + par;
            *(GAS v4u*)(WT + (size_t)row * K + k0 + 8 * c) = o; } }
    LDS_WAIT(); asm volatile("" ::: "memory");
}
__device__ __forceinline__ void p0_prologue(Frame& F, const Args& a) {
    LAS float* scr = (LAS float*)(F.lds + RING_OFF + F.wave * 16384);
    const int gw = F.vcu * NWAVES + F.wave, NGW = F.G * NWAVES;
    bf16* Win_t = (bf16*)(F.ws + WS_WIN); bf16* Wkv_t = (bf16*)(F.ws + WS_WKV); bf16* Watt_t = (bf16*)(F.ws + WS_WATT); bf16* Wret_t = (bf16*)(F.ws + WS_WRET);
    bf16* Wout_t = (bf16*)(F.ws + WS_WOUT); bf16* W1_t = (bf16*)(F.ws + WS_W1); bf16* Wd_t = (bf16*)(F.ws + WS_WD);
    constexpr int I_IN = 16 * 219, I_KV = 4 * 8, I_SQ = 16 * 32, I_GU = 16 * 8  , I_DN = 4 * 32  ;
    constexpr int NITEMS = I_IN + I_KV + 3 * I_SQ + 16 * (2 * I_GU + I_DN);
    for (int it = gw; it < NITEMS; it += NGW) {
        int r = it;
        if (r < I_IN) { p0_transpose_item(a.in[2], 1024, INW, Win_t, 1, 0, 0, a.in[1], scr, r, F.lane); continue; } r -= I_IN;
        if (r < I_KV) { p0_transpose_item(a.in[4], 256, 256, Wkv_t, 0, 0, 0, a.in[3], scr, r, F.lane); continue; } r -= I_KV;
        if (r < I_SQ) { p0_transpose_item(a.in[9], 1024, 1024, Watt_t, 0, 0, 0, nullptr, scr, r, F.lane); continue; } r -= I_SQ;
        if (r < I_SQ) { p0_transpose_item(a.in[10], 1024, 1024, Wret_t, 0, 0, 0, nullptr, scr, r, F.lane); continue; } r -= I_SQ;
        if (r < I_SQ) { p0_transpose_item(a.in[11], 1024, 1024, Wout_t, 0, 0, 0, nullptr, scr, r, F.lane); continue; } r -= I_SQ;
        const int e = r / (2 * I_GU + I_DN), q = r % (2 * I_GU + I_DN);
        if (q < I_GU) p0_transpose_item(a.in[17] + (size_t)e * 1024 * 256, 1024, 256, W1_t, 2, e * 512, 0, nullptr, scr, q, F.lane);
        else if (q < 2 * I_GU) p0_transpose_item(a.in[18] + (size_t)e * 1024 * 256, 1024, 256, W1_t, 2, e * 512, 1, nullptr, scr, q - I_GU, F.lane);
        else p0_transpose_item(a.in[19] + (size_t)e * 256 * 1024, 256, 1024, Wd_t + (size_t)e * 1024 * 256, 0, 0, 0, nullptr, scr, q - 2 * I_GU, F.lane);
    }
    { const int gt = (F.vcu * NWAVES + F.wave) * 64 + F.lane, NGT = F.G * NWAVES * 64; GAS v4u* z = (GAS v4u*)(Win_t + (size_t)1864 * 1024);
      for (int i = gt; i < 184 * 1024 * 2 / 16; i += NGT) z[i] = (v4u){0u, 0u, 0u, 0u}; }
    { const int gt = (F.vcu * NWAVES + F.wave) * 64 + F.lane, NGT = F.G * NWAVES * 64; bf16* Wh = (bf16*)(F.ws + WS_WR); bf16* Wl = Wh + 32 * 1024;
      for (int i = gt; i < 32 * 1024; i += NGT) { const int n = i >> 10, k = i & 1023; const float wv = n < 4 ? a.in[13][k * 4 + n] : (n < 20 ? a.in[15][k * 16 + (n - 4)] : 0.f);
        const unsigned hb = f2bf(wv); const float hf = __uint_as_float(hb << 16); Wh[i] = (bf16)hb; Wl[i] = (bf16)f2bf(wv - hf); } }
    const float* x = a.in[0] + (size_t)a.tok0 * D;
    for (int m = gw; m < F.ntok; m += NGW) {
        const GAS f32x4* xr = (const GAS f32x4*)(x + (size_t)m * D) + F.lane;
        f32x4 v[4]; float s = 0.f;
#pragma unroll
        for (int j = 0; j < 4; ++j) { v[j] = xr[64 * j]; s += (v[j].x * v[j].x + v[j].y * v[j].y) + (v[j].z * v[j].z + v[j].w * v[j].w); }
        const float rstd = 1.f / sqrtf(wave_sum(s) * (1.f / D) + EPS);
        GAS unsigned long long* o8 = (GAS unsigned long long*)(a.xb + (size_t)m * D * 2) + F.lane;
#pragma unroll
        for (int j = 0; j < 4; ++j) o8[64 * j] = (unsigned long long)pk2(v[j].x * rstd, v[j].y * rstd) | ((unsigned long long)pk2(v[j].z * rstd, v[j].w * rstd) << 32);
    }
}


constexpr size_t AUX_KP = 0, AUX_VV = 256, AUX_KIN = 512, AUX_MASK = 640, AUX_END = 896;
typedef short bf16x8_t __attribute__((ext_vector_type(8)));
typedef float f32x16 __attribute__((ext_vector_type(16)));
__device__ __forceinline__ int crow(int r, int hi) { return (r & 3) + 8 * (r >> 2) + 4 * hi; }
__device__ __forceinline__ float xhalf_sum(float v) { auto rr = __builtin_amdgcn_permlane32_swap(__float_as_uint(v), __float_as_uint(v), false, false); return __uint_as_float(rr[0]) + __uint_as_float(rr[1]); }
__device__ __forceinline__ float sumsq8(bf16x8_t v) { float s = 0.f;
#pragma unroll
    for (int j = 0; j < 8; ++j) { const float f = __uint_as_float((unsigned)(unsigned short)v[j] << 16); s += f * f; } return s; }
__device__ __forceinline__ void p2_post(Frame& F, const Args& a) {
    const int gw = F.vcu * NWAVES + F.wave, NGW = F.G * NWAVES, lane = F.lane, r32 = lane & 31, hi = lane >> 5;
    const size_t nt_ = (size_t)F.ntok;
    const bf16* CKV = (const bf16*)(F.act + nt_ * O_CKV); const bf16* KW = (const bf16*)(F.act + nt_ * O_KW);
    const bf16* Wkv_t = (const bf16*)(F.ws + WS_WKV);
    unsigned char* aux = a.xb + nt_ * 2048;
    bf16* KP = (bf16*)(aux + nt_ * AUX_KP); bf16* VV = (bf16*)(aux + nt_ * AUX_VV); bf16* KIN = (bf16*)(aux + nt_ * AUX_KIN);
    const float* g_q = a.in[5]; const float* g_k = a.in[6]; const float* g_ki = a.in[7];
    const int ntask = 2 * (F.ntok / 32);
    for (int task = gw; task < ntask; task += NGW) {
        const int kind = task & 1, t0 = (task >> 1) * 32;
        const bf16* crowp = CKV + (size_t)(t0 + r32) * 256 + hi * 8;
        bf16x8_t bfr[16]; float ss = 0.f;
#pragma unroll
        for (int kk = 0; kk < 16; ++kk) { bfr[kk] = *(const bf16x8_t*)(crowp + kk * 16); ss += sumsq8(bfr[kk]); }
        ss = xhalf_sum(ss);
        const float rstd = rsqrtf(ss * (1.f / 256.f) + EPS);
        f32x16 acc[4];
#pragma unroll
        for (int nt = 0; nt < 4; ++nt) { acc[nt] = f32x16{};
            const bf16* wrow = Wkv_t + (size_t)(kind * 128 + nt * 32 + r32) * 256 + hi * 8;
#pragma unroll
            for (int kk = 0; kk < 16; ++kk) { const bf16x8_t af = *(const bf16x8_t*)(wrow + kk * 16); acc[nt] = __builtin_amdgcn_mfma_f32_32x32x16_bf16(af, bfr[kk], acc[nt], 0, 0, 0); } }
        float sc = rstd;
        if (kind == 0) { float sk = 0.f;
#pragma unroll
            for (int nt = 0; nt < 4; ++nt)
#pragma unroll
                for (int r = 0; r < 16; ++r) { const float v = acc[nt][r] * rstd; sk += v * v; }
            sk = xhalf_sum(sk);
            sc = rstd * rsqrtf(sk * (1.f / 128.f) + EPS) * (0.08838834764831845f * 1.4426950408889634f); }
        bf16* orow = (kind == 0 ? KP : VV) + (size_t)(t0 + r32) * 128;
#pragma unroll
        for (int nt = 0; nt < 4; ++nt)
#pragma unroll
            for (int g = 0; g < 4; ++g) { const int ch = nt * 32 + 8 * g + 4 * hi; float v[4];
#pragma unroll
                for (int j = 0; j < 4; ++j) { v[j] = acc[nt][4 * g + j] * sc; if (kind == 0) v[j] *= g_k[ch + j] * g_q[ch + j]; }
                *(unsigned long long*)(orow + ch) = (unsigned long long)pk2(v[0], v[1]) | ((unsigned long long)pk2(v[2], v[3]) << 32); }
        if (kind == 0) {
            const bf16* kr = KW + (size_t)(t0 + r32) * 128 + hi * 32; bf16x8_t kv4[4]; float s2 = 0.f;
#pragma unroll
            for (int j = 0; j < 4; ++j) { kv4[j] = *(const bf16x8_t*)(kr + 8 * j); s2 += sumsq8(kv4[j]); }
            s2 = xhalf_sum(s2);
            const float rk = rsqrtf(s2 * (1.f / 64.f) + EPS);
            bf16* ko = KIN + (size_t)(t0 + r32) * 64 + hi * 32;
#pragma unroll
            for (int j = 0; j < 4; ++j) { float f[8];
#pragma unroll
                for (int e = 0; e < 8; ++e) f[e] = __uint_as_float((unsigned)(unsigned short)kv4[j][e] << 16) * rk * g_ki[hi * 32 + 8 * j + e];
                v4u o; o.x = pk2(f[0], f[1]); o.y = pk2(f[2], f[3]); o.z = pk2(f[4], f[5]); o.w = pk2(f[6], f[7]);
                *(v4u*)(ko + 8 * j) = o; }
        }
    }
}


typedef float f32x4_t __attribute__((ext_vector_type(4)));
__device__ __forceinline__ unsigned key15_of(float s) { const unsigned short hb = __builtin_bit_cast(unsigned short, (_Float16)s); const unsigned u = (hb & 0x8000u) ? (~(unsigned)hb & 0xffffu) : ((unsigned)hb | 0x8000u); return u >> 1; }
__device__ __forceinline__ unsigned sad4(unsigned x) { return __builtin_amdgcn_sad_u8(x, 0u, 0u); }
__device__ __forceinline__ void p3_merge(LAS unsigned* hist, LAS unsigned short* tot, int w, int g, int q, int& need, int& bsel) {
    __syncthreads();
    const int o = 4 * w + g; unsigned c = 0;
#pragma unroll
    for (int p = 0; p < 32; ++p) { const int tidp = (p >> 2) * 64 + (p & 3) * 16 + q; c += (hist[(o >> 2) * 512 + tidp] >> (8 * (o & 3))) & 0xffu; }
    tot[q * 32 + o] = (unsigned short)c;
    __syncthreads();
    v4u tv[4];
#pragma unroll
    for (int j = 0; j < 4; ++j) tv[j] = *(const LAS v4u*)((const LAS unsigned char*)tot + q * 64 + j * 16);
    int cum = 0, bs = 0, ab = 0; bool found = false;
#pragma unroll
    for (int bin = 31; bin >= 0; --bin) { const unsigned wd = tv[bin >> 3][(bin >> 1) & 3]; const int cc = (int)((bin & 1) ? (wd >> 16) : (wd & 0xffffu));
        if (!found && cum + cc >= need) { bs = bin; ab = cum; found = true; } cum += cc; }
    bsel = bs; need -= ab;
}
__device__ __forceinline__ void p3_index(Frame& F, const Args& a) {
    const int tid = F.tid, lane = F.lane, w = F.wave, q = lane & 15, g = lane >> 4;
    LAS unsigned* keys = (LAS unsigned*)(F.lds + RING_OFF);
    LAS unsigned* hist = (LAS unsigned*)(F.lds + P3_HIST_OFF);
    LAS unsigned short* tot = (LAS unsigned short*)(F.lds + P3_TOT_OFF);
    LAS unsigned char* Tt = (LAS unsigned char*)(F.lds + P3_T_OFF);
    volatile LAS unsigned* MISC = (volatile LAS unsigned*)(F.lds + MISC_OFF);
    const size_t nt_ = (size_t)F.ntok;
    const bf16* QI = (const bf16*)(F.act + nt_ * O_QI); const bf16* KW = (const bf16*)(F.act + nt_ * O_KW);
    unsigned char* aux = a.xb + nt_ * 2048;
    const bf16* KIN = (const bf16*)(aux + nt_ * AUX_KIN); unsigned* MASK = (unsigned*)(aux + nt_ * AUX_MASK);
    unsigned* qctr = (unsigned*)(F.ws + WS_CTL) + CW_Q3;
    const int nb = F.ntok / SEQ, nitems = nb * 128;
    for (;;) {
        __syncthreads(); if (tid == 0) MISC[0] = atomicAdd(qctr, 1u); __syncthreads();
        const int it = (int)MISC[0]; if (it >= nitems) break;
        const int qg = 127 - it / nb, b = it % nb, q0 = qg * 16, qme = q0 + q; const size_t tokq = (size_t)b * SEQ + qme;
        unsigned* Mb = MASK + (size_t)b * 64 * 2048;
        const int kb_hi = ((qg >> 3) + 1) << 2, nkb = (qg >> 1) + 1;
        if (qg < 16) {
            if (tid < kb_hi * 16) { const int kb = tid >> 4, qq = q0 + (tid & 15), nbits = qq - kb * 32 + 1; Mb[kb * 2048 + qq] = nbits >= 32 ? 0xffffffffu : (nbits <= 0 ? 0u : ((1u << nbits) - 1u)); }
            continue;
        }
        float wq[8];
        { const v4u wv = *(const v4u*)(KW + tokq * 128 + 64); const float c = 0.35355339059327373f * 0.125f;
          wq[0] = pg8::bf_lo(wv.x) * c; wq[1] = pg8::bf_hi(wv.x) * c; wq[2] = pg8::bf_lo(wv.y) * c; wq[3] = pg8::bf_hi(wv.y) * c; wq[4] = pg8::bf_lo(wv.z) * c; wq[5] = pg8::bf_hi(wv.z) * c; wq[6] = pg8::bf_lo(wv.w) * c; wq[7] = pg8::bf_hi(wv.w) * c; }
        bf16x8_t qfr[8][2], qlin[2];
#pragma unroll
        for (int h = 0; h < 8; ++h)
#pragma unroll
            for (int ks = 0; ks < 2; ++ks) qfr[h][ks] = *(const bf16x8_t*)(QI + tokq * 512 + h * 64 + ks * 32 + g * 8);
#pragma unroll
        for (int ks = 0; ks < 2; ++ks) { float f[8];
#pragma unroll
            for (int j = 0; j < 8; ++j) { float s = 0.f;
#pragma unroll
                for (int h = 0; h < 8; ++h) s += wq[h] * __uint_as_float((unsigned)(unsigned short)qfr[h][ks][j] << 16);
                f[j] = s; }
            v4u o; o.x = pk2(f[0], f[1]); o.y = pk2(f[2], f[3]); o.z = pk2(f[4], f[5]); o.w = pk2(f[6], f[7]); qlin[ks] = __builtin_bit_cast(bf16x8_t, o); }
#pragma unroll
        for (int i = 0; i < 8; ++i) hist[i * 512 + tid] = 0u;
        for (int s = 0, kb = w; kb < nkb; ++s, kb += 8) {
#pragma unroll
            for (int t = 0; t < 2; ++t) {
                bf16x8_t afr[2];
#pragma unroll
                for (int ks = 0; ks < 2; ++ks) afr[ks] = *(const bf16x8_t*)(KIN + ((size_t)b * SEQ + kb * 32 + t * 16 + q) * 64 + ks * 32 + g * 8);
                f32x4_t sacc = f32x4_t{};
#pragma unroll
                for (int ks = 0; ks < 2; ++ks) sacc = __builtin_amdgcn_mfma_f32_16x16x32_bf16(afr[ks], qlin[ks], sacc, 0, 0, 0);
#pragma unroll
                for (int h = 0; h < 8; ++h) { f32x4_t d = f32x4_t{};
#pragma unroll
                    for (int ks = 0; ks < 2; ++ks) d = __builtin_amdgcn_mfma_f32_16x16x32_bf16(afr[ks], qfr[h][ks], d, 0, 0, 0);
#pragma unroll
                    for (int r = 0; r < 4; ++r) sacc[r] = fmaf(fabsf(d[r]), wq[h], sacc[r]); }
#pragma unroll
                for (int i = 0; i < 2; ++i) { unsigned k2[2];
#pragma unroll
                    for (int e = 0; e < 2; ++e) { const int r = 2 * i + e; unsigned k = key15_of(sacc[r]); if (kb * 32 + t * 16 + 4 * g + r > qme) k = 0u; k2[e] = k;
                        const unsigned dg = k >> 10; (void)__hip_atomic_fetch_add((LAS unsigned*)&hist[(dg >> 2) * 512 + tid], 1u << ((dg & 3u) * 8u), __ATOMIC_RELAXED, __HIP_MEMORY_SCOPE_WORKGROUP); }
                    keys[(s * 4 + t * 2 + i) * 512 + tid] = k2[0] | (k2[1] << 16); }
            }
        }
        int need = 256, bsel;
        p3_merge(hist, tot, w, g, q, need, bsel);
        unsigned prefix = (unsigned)bsel;
#pragma unroll
        for (int pass = 0; pass < 2; ++pass) {
            const int sh_hi = pass == 0 ? 10 : 5, sh = pass == 0 ? 5 : 0;
#pragma unroll
            for (int i = 0; i < 8; ++i) hist[i * 512 + tid] = 0u;
            for (int s = 0, kb = w; kb < nkb; ++s, kb += 8)
#pragma unroll
                for (int i = 0; i < 4; ++i) { const unsigned d2 = keys[(s * 4 + i) * 512 + tid];
#pragma unroll
                    for (int e = 0; e < 2; ++e) { const unsigned k = e ? (d2 >> 16) : (d2 & 0xffffu);
                        if ((k >> sh_hi) == prefix) { const unsigned dg = (k >> sh) & 31u; (void)__hip_atomic_fetch_add((LAS unsigned*)&hist[(dg >> 2) * 512 + tid], 1u << ((dg & 3u) * 8u), __ATOMIC_RELAXED, __HIP_MEMORY_SCOPE_WORKGROUP); } } }
            p3_merge(hist, tot, w, g, q, need, bsel);
            prefix = (prefix << 5) | (unsigned)bsel;
        }
        const unsigned tau = prefix; const int need_eq = need;
        unsigned gtw[8], eqw[8];
#pragma unroll
        for (int s = 0; s < 8; ++s) { const int kb = w + 8 * s; gtw[s] = 0u; eqw[s] = 0u;
            if (kb < nkb) { unsigned gg = 0u, qq = 0u;
#pragma unroll
                for (int i = 0; i < 4; ++i) { const unsigned d2 = keys[(s * 4 + i) * 512 + tid];
#pragma unroll
                    for (int e = 0; e < 2; ++e) { const unsigned k = e ? (d2 >> 16) : (d2 & 0xffffu); const int bit = (i >> 1) * 16 + 4 * g + (i & 1) * 2 + e;
                        gg |= (k > tau ? 1u : 0u) << bit; qq |= (k == tau ? 1u : 0u) << bit; } }
                gg |= (unsigned)__shfl_xor((int)gg, 16); gg |= (unsigned)__shfl_xor((int)gg, 32); qq |= (unsigned)__shfl_xor((int)qq, 16); qq |= (unsigned)__shfl_xor((int)qq, 32);
                gtw[s] = gg; eqw[s] = qq;
                if (g == 0) Tt[q * 64 + kb] = (unsigned char)__builtin_popcount(qq); } }
        __syncthreads();
        { unsigned run = 0u;
#pragma unroll
          for (int s = 0; s < 8; ++s) { const int kb = w + 8 * s;
            if (kb < nkb) { const unsigned g0 = *(const LAS unsigned*)(Tt + q * 64 + 8 * s), g1 = *(const LAS unsigned*)(Tt + q * 64 + 8 * s + 4);
                const unsigned m0 = w >= 4 ? g0 : (w == 0 ? 0u : (g0 & ((1u << (8 * w)) - 1u))), m1 = w > 4 ? (g1 & ((1u << (8 * (w - 4))) - 1u)) : 0u;
                const int pre = (int)(run + sad4(m0) + sad4(m1)), m = need_eq - pre, pc = __builtin_popcount(eqw[s]);
                unsigned se = eqw[s];
                if (m < pc) { se = 0u; unsigned x = eqw[s]; for (int i = 0; i < m; ++i) { const unsigned bb = x & (0u - x); se |= bb; x ^= bb; } }
                if (g == 0) Mb[kb * 2048 + qme] = gtw[s] | se;
                run += sad4(g0) + sad4(g1); } } }
        if (tid < (kb_hi - nkb) * 16) Mb[(nkb + (tid >> 4)) * 2048 + q0 + (tid & 15)] = 0u;
    }
}


namespace att {
using bf16x8 = __attribute__((ext_vector_type(8))) short;
using s16x4  = __attribute__((ext_vector_type(4))) short;
using u32x4  = __attribute__((ext_vector_type(4))) unsigned;
constexpr int KVBLK = 64;
constexpr size_t SHM_V = KVBLK * 128 * 2, SHM_K = KVBLK * 128 * 2;
constexpr int OFF_WS = 65536, OFF_MK = 65536 + 2048, OFF_Q = 65536 + 2048 + 8192, QPITCH = 272;
constexpr float THR2 = 11.5f;
#define KSWZ(row, colB) ((row) * 256 + ((colB) ^ (((row) & 7) << 4)))
#define SBAR() __builtin_amdgcn_sched_barrier(0)
__device__ __forceinline__ unsigned cvtpk(float lo, float hi) { unsigned r; asm volatile("v_cvt_pk_bf16_f32 %0, %1, %2" : "=v"(r) : "v"(lo), "v"(hi)); return r; }
__device__ __forceinline__ float msk(float p, unsigned w, int bit) { const int m = __builtin_amdgcn_sbfe((int)w, bit, 1); return __uint_as_float((__float_as_uint(p) & (unsigned)m) | (0xff800000u & ~(unsigned)m)); }
__device__ __forceinline__ void partialSM(f32x16& p0, f32x16& p1, unsigned w0, unsigned w1, float& m_reg, float& mn, float& alpha) {
#pragma unroll
  for (int r = 0; r < 16; ++r) { const int bit = (r & 3) + 8 * (r >> 2); p0[r] = msk(p0[r], w0, bit); p1[r] = msk(p1[r], w1, bit); }
  float pmax = p0[0];
#pragma unroll
  for (int r = 1; r < 16; ++r) pmax = fmaxf(pmax, p0[r]);
#pragma unroll
  for (int r = 0; r < 16; ++r) pmax = fmaxf(pmax, p1[r]);
  { auto rr = __builtin_amdgcn_permlane32_swap(__float_as_uint(pmax), __float_as_uint(pmax), false, false); pmax = fmaxf(__uint_as_float(rr[0]), __uint_as_float(rr[1])); }
  if (__builtin_expect(__all(pmax - m_reg <= THR2), 1)) { mn = m_reg; alpha = 1.f; }
  else { mn = fmaxf(m_reg, pmax); alpha = __builtin_amdgcn_exp2f(m_reg - mn); m_reg = mn; }
#pragma unroll
  for (int r = 0; r < 16; ++r) { p0[r] -= mn; p1[r] -= mn; }
#pragma unroll
  for (int r = 0; r < 16; ++r) p0[r] = __builtin_amdgcn_exp2f(p0[r]);
}
__device__ __forceinline__ void finishSM(f32x16& p0, f32x16& p1, float alpha, float& l_reg, bf16x8& pa0, bf16x8& pa1, bf16x8& pa2, bf16x8& pa3) {
#pragma unroll
  for (int r = 0; r < 16; ++r) p1[r] = __builtin_amdgcn_exp2f(p1[r]);
  float ps = 0;
#pragma unroll
  for (int r = 0; r < 16; ++r) ps += p0[r];
#pragma unroll
  for (int r = 0; r < 16; ++r) ps += p1[r];
  { auto rr = __builtin_amdgcn_permlane32_swap(__float_as_uint(ps), __float_as_uint(ps), false, false); ps = __uint_as_float(rr[0]) + __uint_as_float(rr[1]); }
  l_reg = l_reg * alpha + ps;
#define PK4(P, BASE, OUT) do { unsigned a0 = cvtpk(P[BASE + 0], P[BASE + 1]), a1 = cvtpk(P[BASE + 2], P[BASE + 3]);   \
    unsigned b0 = cvtpk(P[BASE + 4], P[BASE + 5]), b1 = cvtpk(P[BASE + 6], P[BASE + 7]);                              \
    auto r0 = __builtin_amdgcn_permlane32_swap(a0, b0, false, false); auto r1 = __builtin_amdgcn_permlane32_swap(a1, b1, false, false); \
    u32x4 w = {r0[0], r1[0], r0[1], r1[1]}; OUT = *reinterpret_cast<bf16x8*>(&w); } while (0)
  PK4(p0, 0, pa0); PK4(p0, 8, pa1); PK4(p1, 0, pa2); PK4(p1, 8, pa3);
#undef PK4
}
__device__ __forceinline__ void qkt(f32x16& p0, f32x16& p1, const char* Ks, const char* qrow, const float (&bo)[16], float kb0, float kb1, int r32, int hi) {
#pragma unroll
  for (int r = 0; r < 16; ++r) { p0[r] = bo[r] + kb0; p1[r] = bo[r] + kb1; }
#pragma unroll
  for (int d0 = 0; d0 < 8; ++d0) { const int cb = (d0 * 16 + hi * 8) * 2;
    const bf16x8 b0 = *reinterpret_cast<const bf16x8*>(Ks + KSWZ(r32, cb));
    const bf16x8 b1 = *reinterpret_cast<const bf16x8*>(Ks + KSWZ(32 + r32, cb));
    const bf16x8 qf = *reinterpret_cast<const bf16x8*>(qrow + d0 * 32);
    p0 = __builtin_amdgcn_mfma_f32_32x32x16_bf16(b0, qf, p0, 0, 0, 0);
    p1 = __builtin_amdgcn_mfma_f32_32x32x16_bf16(b1, qf, p1, 0, 0, 0); }
}
__device__ __forceinline__ int v_st(int k, int c) { const int kk = (k & ~0xC) | ((k & 4) << 1) | ((k & 8) >> 1); return ((kk >> 3) * 4 + (c >> 5)) * 512 + ((kk & 7) * 32 + (c & 31)) * 2; }
__device__ __forceinline__ int v_rd_base(int lane) { return ((lane & 3) << 3) | (((lane >> 2) & 3) << 6) | (((lane >> 4) & 1) << 5) | (((lane >> 5) & 1) << 8); }
constexpr int v_rd_off(int d0, int ks, int half) { return d0 * 512 + ks * 4096 + half * 2048; }
template <int OFF> __device__ __forceinline__ s16x4 tr_read(int vb) { s16x4 r; asm volatile("ds_read_b64_tr_b16 %0, %1 offset:%2" : "=&v"(r) : "v"(vb), "i"(OFF) : "memory"); return r; }
template <int D0> __device__ __forceinline__ void pv_one(f32x16& od, int vb, bf16x8 pa0, bf16x8 pa1, bf16x8 pa2, bf16x8 pa3) {
  const s16x4 l0 = tr_read<v_rd_off(D0, 0, 0)>(vb), h0 = tr_read<v_rd_off(D0, 0, 1)>(vb), l1 = tr_read<v_rd_off(D0, 1, 0)>(vb), h1 = tr_read<v_rd_off(D0, 1, 1)>(vb);
  const s16x4 l2 = tr_read<v_rd_off(D0, 2, 0)>(vb), h2 = tr_read<v_rd_off(D0, 2, 1)>(vb), l3 = tr_read<v_rd_off(D0, 3, 0)>(vb), h3 = tr_read<v_rd_off(D0, 3, 1)>(vb);
  asm volatile("s_waitcnt lgkmcnt(0)" ::: "memory"); SBAR();
#define PK(L, H) (bf16x8){L[0], L[1], L[2], L[3], H[0], H[1], H[2], H[3]}
  od = __builtin_amdgcn_mfma_f32_32x32x16_bf16(pa0, PK(l0, h0), od, 0, 0, 0);
  od = __builtin_amdgcn_mfma_f32_32x32x16_bf16(pa1, PK(l1, h1), od, 0, 0, 0);
  od = __builtin_amdgcn_mfma_f32_32x32x16_bf16(pa2, PK(l2, h2), od, 0, 0, 0);
  od = __builtin_amdgcn_mfma_f32_32x32x16_bf16(pa3, PK(l3, h3), od, 0, 0, 0);
#undef PK
}
__device__ __forceinline__ void pv_d0(f32x16* o, int vb, bf16x8 pa0, bf16x8 pa1, bf16x8 pa2, bf16x8 pa3) {
  pv_one<0>(o[0], vb, pa0, pa1, pa2, pa3); pv_one<1>(o[1], vb, pa0, pa1, pa2, pa3); pv_one<2>(o[2], vb, pa0, pa1, pa2, pa3); pv_one<3>(o[3], vb, pa0, pa1, pa2, pa3);
}
__device__ __forceinline__ void attn_item(const bf16* __restrict__ Qb, const bf16* __restrict__ Kh, const bf16* __restrict__ Vh, const unsigned* __restrict__ Mq, bf16* __restrict__ Ob, int NT, char* lds) {
  const int tid = threadIdx.x, wid = __builtin_amdgcn_readfirstlane(tid >> 6), lane = tid & 63, r32 = lane & 31, hi = lane >> 5;
  char* V_lds = lds; char* K_lds = lds + 2 * SHM_V;
  float* ws = (float*)(lds + OFF_WS) + wid * 64; float* li_l = ws; float* al_l = ws + 32;
  unsigned* mk = (unsigned*)(lds + OFF_MK);
  for (int i = tid; i < NT * 64; i += 512) mk[i] = Mq[(size_t)(i >> 5) * 2048 + (i & 31)];
  float m_reg = -1e30f, l_reg = 0; f32x16 o[4] = {};
  char* const qrow = lds + OFF_Q + wid * (32 * QPITCH) + r32 * QPITCH + hi * 16;
  { bf16x8 qr[8]; const bf16* Qw = Qb + (size_t)r32 * 1024 + wid * 128 + hi * 8; float ss = 0.f;
#pragma unroll
    for (int d0 = 0; d0 < 8; ++d0) { qr[d0] = *reinterpret_cast<const bf16x8*>(Qw + d0 * 16); ss += sumsq8(qr[d0]); }
    ss = xhalf_sum(ss); const float rq = rsqrtf(ss * (1.f / 128.f) + EPS);
#pragma unroll
    for (int d0 = 0; d0 < 8; ++d0) { float f[8];
#pragma unroll
      for (int j = 0; j < 8; ++j) f[j] = __uint_as_float((unsigned)(unsigned short)qr[d0][j] << 16) * rq;
      u32x4 w = {cvtpk(f[0], f[1]), cvtpk(f[2], f[3]), cvtpk(f[4], f[5]), cvtpk(f[6], f[7])}; *reinterpret_cast<u32x4*>(qrow + d0 * 32) = w; } }
  const float slope2 = __builtin_amdgcn_exp2f(-(float)(wid + 1)) * 1.4426950408889634f;
  float bo[16];
#pragma unroll
  for (int r = 0; r < 16; ++r) bo[r] = __uint_as_float(__builtin_amdgcn_readfirstlane(__float_as_uint(slope2 * (float)((r & 3) + 8 * (r >> 2)))));
  const float hoff = slope2 * (float)(4 * hi);
  const int sr = tid >> 4, sc = (tid & 15) * 8, vst0 = v_st(sr, sc), vst1 = v_st(32 + sr, sc);
  const int vb0 = (int)(uintptr_t)V_lds + v_rd_base(lane);
  constexpr int SDEPTH = 1;
  struct { bf16x8 vs0, vs1, ks0, ks1; } sr_[SDEPTH];
#define SLOAD(i, k0) do { sr_[i].vs0 = *reinterpret_cast<const bf16x8*>(&Vh[(size_t)((k0) + sr) * 128 + sc]); sr_[i].vs1 = *reinterpret_cast<const bf16x8*>(&Vh[(size_t)((k0) + 32 + sr) * 128 + sc]); \
    sr_[i].ks0 = *reinterpret_cast<const bf16x8*>(&Kh[(size_t)((k0) + sr) * 128 + sc]); sr_[i].ks1 = *reinterpret_cast<const bf16x8*>(&Kh[(size_t)((k0) + 32 + sr) * 128 + sc]); } while (0)
#define SWRITE(b, i) do { *(bf16x8*)(V_lds + (b) * SHM_V + vst0) = sr_[i].vs0; *(bf16x8*)(V_lds + (b) * SHM_V + vst1) = sr_[i].vs1; const int kc = sc * 2; \
    *(bf16x8*)(K_lds + (b) * SHM_K + KSWZ(sr, kc)) = sr_[i].ks0; *(bf16x8*)(K_lds + (b) * SHM_K + KSWZ(32 + sr, kc)) = sr_[i].ks1; } while (0)
#define SWAIT() do { if constexpr (SDEPTH == 2) asm volatile("s_waitcnt vmcnt(4)" ::: "memory"); else asm volatile("s_waitcnt vmcnt(0)" ::: "memory"); } while (0)
#define RESC(a) do { if (__any((a) < 1.f)) { if (hi == 0) al_l[r32] = (a); asm volatile("s_waitcnt lgkmcnt(0)" ::: "memory"); \
    _Pragma("unroll") for (int d = 0; d < 4; ++d) _Pragma("unroll") for (int r = 0; r < 16; ++r) o[d][r] *= al_l[crow(r, hi)]; } } while (0)
#define MW(j, e) (mk[(2 * (j) + (e)) * 32 + r32] >> (4 * hi))
#define KB0(j) (slope2 * (float)((j) * 64) + hoff)
#define KB1(j) (slope2 * (float)((j) * 64 + 32) + hoff)
  f32x16 pA0, pA1, pB0, pB1; float mnA, mnB, alA, alB; bf16x8 pa0, pa1, pa2, pa3;
  constexpr int SE = 0, SO = SDEPTH - 1;
  SLOAD(SE, 0); asm volatile("s_waitcnt vmcnt(0)" ::: "memory"); SWRITE(0, SE); __syncthreads();
  qkt(pA0, pA1, K_lds, qrow, bo, KB0(0), KB1(0), r32, hi); partialSM(pA0, pA1, MW(0, 0), MW(0, 1), m_reg, mnA, alA);
  SLOAD(SO, KVBLK); if constexpr (SDEPTH == 2) { if (2 < NT) SLOAD(SE, 2 * KVBLK); }
  SWAIT(); SWRITE(1, SO); __syncthreads();
  for (int j = 1; j + 1 < NT; j += 2) {
    SBAR(); qkt(pB0, pB1, K_lds + SHM_K, qrow, bo, KB0(j), KB1(j), r32, hi);
    finishSM(pA0, pA1, alA, l_reg, pa0, pa1, pa2, pa3); SBAR();
    SLOAD(SO, (j + SDEPTH) * KVBLK); SBAR();
    pv_d0(o, vb0, pa0, pa1, pa2, pa3); partialSM(pB0, pB1, MW(j, 0), MW(j, 1), m_reg, mnB, alB);
    __syncthreads(); SWAIT(); SWRITE(0, SE);
    RESC(alB); __syncthreads();
    SBAR(); qkt(pA0, pA1, K_lds, qrow, bo, KB0(j + 1), KB1(j + 1), r32, hi);
    finishSM(pB0, pB1, alB, l_reg, pa0, pa1, pa2, pa3); SBAR();
    if (SDEPTH == 1 || j + 3 < NT) SLOAD(SE, (j + 1 + SDEPTH) * KVBLK); SBAR();
    pv_d0(o, vb0 + (int)SHM_V, pa0, pa1, pa2, pa3); partialSM(pA0, pA1, MW(j + 1, 0), MW(j + 1, 1), m_reg, mnA, alA);
    __syncthreads(); SWAIT(); SWRITE(1, SO);
    RESC(alA); __syncthreads();
  }
  SBAR(); qkt(pB0, pB1, K_lds + SHM_K, qrow, bo, KB0(NT - 1), KB1(NT - 1), r32, hi);
  finishSM(pA0, pA1, alA, l_reg, pa0, pa1, pa2, pa3); SBAR();
  pv_d0(o, vb0, pa0, pa1, pa2, pa3); partialSM(pB0, pB1, MW(NT - 1, 0), MW(NT - 1, 1), m_reg, mnB, alB);
  __syncthreads(); RESC(alB);
  finishSM(pB0, pB1, alB, l_reg, pa0, pa1, pa2, pa3); SBAR();
  pv_d0(o, vb0 + (int)SHM_V, pa0, pa1, pa2, pa3);
  if (hi == 0) li_l[r32] = l_reg; asm volatile("s_waitcnt lgkmcnt(0)" ::: "memory");
  float rli[16];
#pragma unroll
  for (int r = 0; r < 16; ++r) rli[r] = __builtin_amdgcn_rcpf(li_l[crow(r, hi)]);
  __syncthreads();
  unsigned short* stg = (unsigned short*)(lds + wid * 8192);
#pragma unroll
  for (int r = 0; r < 16; ++r) { const int orow = crow(r, hi);
#pragma unroll
    for (int d0 = 0; d0 < 4; ++d0) stg[orow * 128 + d0 * 32 + r32] = (unsigned short)f2bf(o[d0][r] * rli[r]); }
  asm volatile("s_waitcnt lgkmcnt(0)" ::: "memory");
#pragma unroll
  for (int i = 0; i < 8; ++i) { const int row = i * 4 + (lane >> 4), ch = lane & 15; const u32x4 v = *(const u32x4*)(stg + row * 128 + ch * 8);
    *(u32x4*)(Ob + (size_t)row * 1024 + wid * 128 + ch * 8) = v; }
#undef SLOAD
#undef SWRITE
#undef SWAIT
#undef RESC
#undef MW
#undef KB0
#undef KB1
}
#undef KSWZ
#undef SBAR
}


namespace ret {
using bf16x8 = __attribute__((ext_vector_type(8))) short;
using s16x4  = __attribute__((ext_vector_type(4))) short;
using u32x4  = __attribute__((ext_vector_type(4))) unsigned;
using u32x2  = __attribute__((ext_vector_type(2))) unsigned;
constexpr int C = 64, QP = 272, KPI = 272, VP = 576;
constexpr int OFF_Q = 0, OFF_K = 17408, OFF_V = 34816, OFF_ST = 71680;
typedef float f32x2_t __attribute__((ext_vector_type(2))); typedef __bf16 bf16x2_t __attribute__((ext_vector_type(2)));
__device__ __forceinline__ unsigned cvtpk(float lo, float hi) { const f32x2_t v = {lo, hi}; const bf16x2_t b = __builtin_convertvector(v, bf16x2_t); return __builtin_bit_cast(unsigned, b); }
__device__ __forceinline__ s16x4 trr(const char* p) { s16x4 r; asm volatile("ds_read_b64_tr_b16 %0, %1" : "=&v"(r) : "v"((int)(uintptr_t)p) : "memory"); return r; }
__device__ __forceinline__ bf16x8 pk8(const f32x16& x, int s) { u32x4 w = {cvtpk(x[8 * s + 0], x[8 * s + 1]), cvtpk(x[8 * s + 2], x[8 * s + 3]), cvtpk(x[8 * s + 4], x[8 * s + 5]), cvtpk(x[8 * s + 6], x[8 * s + 7])}; return *reinterpret_cast<bf16x8*>(&w); }
__device__ __forceinline__ float silu_(float x) { return x / (1.f + __expf(-x)); }
__device__ __forceinline__ void ret_item(int b, int h, const bf16* __restrict__ RQ, const bf16* __restrict__ RK, bf16* RV, const bf16* __restrict__ RG, const float* __restrict__ gnorm, char* lds) {
  const int tid = threadIdx.x, w = __builtin_amdgcn_readfirstlane(tid >> 6), lane = tid & 63, r32 = lane & 31, hi = lane >> 5;
  const float lg = __log2f(1.f - exp2f(-5.f - (float)h)), gC = exp2f(64.f * lg);
  char* Qs = lds + OFF_Q; char* Ks = lds + OFF_K; char* Vs = lds + OFF_V; float* st = (float*)(lds + OFF_ST);
  f32x16 S[4] = {};
  const unsigned voffQ = (unsigned)(((tid >> 4) * 512 + (tid & 15) * 8) * 2), voffV = (unsigned)(((tid >> 5) * 1024 + (tid & 31) * 8) * 2);
  const int trq = (lane & 15) >> 2, trp = lane & 3, trg = (lane >> 4) & 1;
  for (int c = 0; c < SEQ / C; ++c) {
    const size_t tok0 = (size_t)b * SEQ + (size_t)c * C;
    __syncthreads();
    { const char* qb_ = (const char*)(RQ + tok0 * 512 + h * 128); const char* kb_ = (const char*)(RK + tok0 * 512 + h * 128); const char* vb_ = (const char*)(RV + tok0 * 1024 + h * 256);
#pragma unroll
      for (int i = 0; i < 2; ++i) { const int row = (tid >> 4) + 32 * i, ch = tid & 15;
        const u32x4 qv = *(const u32x4*)(qb_ + voffQ + i * 32768); *(u32x4*)(Qs + row * QP + ch * 16) = qv;
        const u32x4 kv = *(const u32x4*)(kb_ + voffQ + i * 32768); const float f = exp2f(lg * (float)(C - 1 - row)) * 0.08838834764831845f;
        u32x4 ko; ko.x = cvtpk(pg8::bf_lo(kv.x) * f, pg8::bf_hi(kv.x) * f); ko.y = cvtpk(pg8::bf_lo(kv.y) * f, pg8::bf_hi(kv.y) * f); ko.z = cvtpk(pg8::bf_lo(kv.z) * f, pg8::bf_hi(kv.z) * f); ko.w = cvtpk(pg8::bf_lo(kv.w) * f, pg8::bf_hi(kv.w) * f);
        *(u32x4*)(Ks + row * KPI + ch * 16) = ko; }
#pragma unroll
      for (int i = 0; i < 4; ++i) { const int row = (tid >> 5) + 16 * i, ch = tid & 31;
        *(u32x4*)(Vs + row * VP + ch * 16) = *(const u32x4*)(vb_ + voffV + i * 32768); } }
    __syncthreads();
    f32x16 ot[2] = {};
#pragma unroll
    for (int dt = 0; dt < 4; ++dt)
#pragma unroll
      for (int s = 0; s < 2; ++s) { const bf16x8 af = pk8(S[dt], s);
#pragma unroll
        for (int nt = 0; nt < 2; ++nt) { const char* qp = Qs + (32 * nt + r32) * QP + (32 * dt + 16 * s + 4 * hi) * 2;
          const u32x2 lo = *(const u32x2*)qp, hi8 = *(const u32x2*)(qp + 16); const u32x4 bw = {lo.x, lo.y, hi8.x, hi8.y};
          ot[nt] = __builtin_amdgcn_mfma_f32_32x32x16_bf16(af, *reinterpret_cast<const bf16x8*>(&bw), ot[nt], 0, 0, 0); }
        __builtin_amdgcn_sched_barrier(0); }
#pragma unroll
    for (int nt = 0; nt < 2; ++nt)
#pragma unroll
      for (int r = 0; r < 16; ++r) ot[nt][r] *= gC;
    __builtin_amdgcn_sched_barrier(0);
    bf16x8 vfr[4];
    { s16x4 vlo[4], vhi[4];
#pragma unroll
      for (int ks = 0; ks < 4; ++ks) { const char* vp = Vs + (16 * ks + 4 * hi + trq) * VP + (32 * w + 16 * trg + 4 * trp) * 2; vlo[ks] = trr(vp); vhi[ks] = trr(vp + 8 * VP); }
      asm volatile("s_waitcnt lgkmcnt(0)" : "+v"(vlo[0]), "+v"(vlo[1]), "+v"(vlo[2]), "+v"(vlo[3]), "+v"(vhi[0]), "+v"(vhi[1]), "+v"(vhi[2]), "+v"(vhi[3]) :: "memory"); __builtin_amdgcn_sched_barrier(0);
#pragma unroll
      for (int ks = 0; ks < 4; ++ks) vfr[ks] = (bf16x8){vlo[ks][0], vlo[ks][1], vlo[ks][2], vlo[ks][3], vhi[ks][0], vhi[ks][1], vhi[ks][2], vhi[ks][3]}; }
#pragma unroll
    for (int nt = 0; nt < 2; ++nt)
#pragma unroll
      for (int jt = 0; jt <= nt; ++jt) { f32x16 pt = {};
#pragma unroll
        for (int kk = 0; kk < 8; ++kk) { const bf16x8 ka = *(const bf16x8*)(Ks + (32 * jt + r32) * KPI + (16 * kk + 8 * hi) * 2), qb = *(const bf16x8*)(Qs + (32 * nt + r32) * QP + (16 * kk + 8 * hi) * 2);
          pt = __builtin_amdgcn_mfma_f32_32x32x16_bf16(ka, qb, pt, 0, 0, 0); }
        if (jt == nt) {
#pragma unroll
          for (int r = 0; r < 16; ++r) if (crow(r, hi) > r32) pt[r] = 0.f; }
#pragma unroll
        for (int s = 0; s < 2; ++s) ot[nt] = __builtin_amdgcn_mfma_f32_32x32x16_bf16(vfr[2 * jt + s], pk8(pt, s), ot[nt], 0, 0, 0);
        __builtin_amdgcn_sched_barrier(0); }
    __builtin_amdgcn_sched_barrier(0);
#pragma unroll
    for (int dt = 0; dt < 4; ++dt) {
#pragma unroll
      for (int r = 0; r < 16; ++r) S[dt][r] *= gC;
#pragma unroll
      for (int ks = 0; ks < 4; ++ks) { const char* kp = Ks + (16 * ks + 4 * hi + trq) * KPI + (32 * dt + 16 * trg + 4 * trp) * 2;
        s16x4 lo = trr(kp), hi8 = trr(kp + 8 * KPI); asm volatile("s_waitcnt lgkmcnt(0)" : "+v"(lo), "+v"(hi8) :: "memory"); __builtin_amdgcn_sched_barrier(0);
        S[dt] = __builtin_amdgcn_mfma_f32_32x32x16_bf16((bf16x8){lo[0], lo[1], lo[2], lo[3], hi8[0], hi8[1], hi8[2], hi8[3]}, vfr[ks], S[dt], 0, 0, 0); } }
    __builtin_amdgcn_sched_barrier(0);
#pragma unroll
    for (int nt = 0; nt < 2; ++nt) { const float rs = exp2f(lg * (float)(32 * nt + r32 + 1 - C)); float s1 = 0.f, s2 = 0.f;
#pragma unroll
      for (int r = 0; r < 16; ++r) { ot[nt][r] *= rs; s1 += ot[nt][r]; s2 += ot[nt][r] * ot[nt][r]; }
      s1 = xhalf_sum(s1); s2 = xhalf_sum(s2);
      if (hi == 0) { st[(w * 64 + 32 * nt + r32) * 2] = s1; st[(w * 64 + 32 * nt + r32) * 2 + 1] = s2; } }
    __syncthreads();
#pragma unroll
    for (int nt = 0; nt < 2; ++nt) { float s1 = 0.f, s2 = 0.f;
#pragma unroll
      for (int ww = 0; ww < 8; ++ww) { s1 += st[(ww * 64 + 32 * nt + r32) * 2]; s2 += st[(ww * 64 + 32 * nt + r32) * 2 + 1]; }
      const float mu = s1 * (1.f / 256.f), var = fmaxf(s2 * (1.f / 256.f) - mu * mu, 0.f), rstd = rsqrtf(var + EPS);
#pragma unroll
      for (int g = 0; g < 4; ++g) { float y[4];
#pragma unroll
        for (int j = 0; j < 4; ++j) y[j] = (ot[nt][4 * g + j] - mu) * rstd * gnorm[h * 256 + 32 * w + 8 * g + 4 * hi + j];
        const u32x2 o2 = {cvtpk(y[0], y[1]), cvtpk(y[2], y[3])};
        *(u32x2*)(Vs + (32 * nt + r32) * VP + (32 * w + 8 * g + 4 * hi) * 2) = o2; } }
    __syncthreads();
    { const char* gb_ = (const char*)(RG + tok0 * 1024 + h * 256); char* ob_ = (char*)(RV + tok0 * 1024 + h * 256);
#pragma unroll
      for (int i = 0; i < 4; ++i) { const int row = (tid >> 5) + 16 * i, ch = tid & 31;
        const u32x4 yv = *(const u32x4*)(Vs + row * VP + ch * 16); const u32x4 gt = *(const u32x4*)(gb_ + voffV + i * 32768);
        u32x4 o; o.x = cvtpk(pg8::bf_lo(yv.x) * silu_(pg8::bf_lo(gt.x)), pg8::bf_hi(yv.x) * silu_(pg8::bf_hi(gt.x))); o.y = cvtpk(pg8::bf_lo(yv.y) * silu_(pg8::bf_lo(gt.y)), pg8::bf_hi(yv.y) * silu_(pg8::bf_hi(gt.y)));
        o.z = cvtpk(pg8::bf_lo(yv.z) * silu_(pg8::bf_lo(gt.z)), pg8::bf_hi(yv.z) * silu_(pg8::bf_hi(gt.z))); o.w = cvtpk(pg8::bf_lo(yv.w) * silu_(pg8::bf_lo(gt.w)), pg8::bf_hi(yv.w) * silu_(pg8::bf_hi(gt.w)));
        *(u32x4*)(ob_ + voffV + i * 32768) = o; } }
  }
}
}

__device__ __forceinline__ void p4_attn(Frame& F, const Args& a, unsigned char* lds_generic) {
    const size_t nt_ = (size_t)F.ntok;
    const bf16* QA = (const bf16*)(F.act + nt_ * O_QA); bf16* ATT = (bf16*)(F.act + nt_ * O_QA);
    unsigned char* aux = a.xb + nt_ * 2048;
    const bf16* KP = (const bf16*)(aux + nt_ * AUX_KP); const bf16* VV = (const bf16*)(aux + nt_ * AUX_VV); const unsigned* MASK = (const unsigned*)(aux + nt_ * AUX_MASK);
    volatile LAS unsigned* MISC = (volatile LAS unsigned*)(F.lds + MISC_OFF);
    unsigned* qctr = (unsigned*)(F.ws + WS_CTL) + CW_Q4;
    const bf16* RQ = (const bf16*)(F.act + nt_ * O_RQ); const bf16* RK = (const bf16*)(F.act + nt_ * O_RK); bf16* RV = (bf16*)(F.act + nt_ * O_RV); const bf16* RG = (const bf16*)(F.act + nt_ * O_RG);
    const int nb = F.ntok / SEQ, nret = nb * 4, nitems = nb * 64;
    for (;;) {
        __syncthreads(); if (F.tid == 0) MISC[0] = atomicAdd(qctr + 16, 1u); __syncthreads();
        const int it = (int)MISC[0]; if (it >= nret) break;
        ret::ret_item(it >> 2, it & 3, RQ, RK, RV, RG, a.in[8], (char*)lds_generic);
    }
    for (;;) {
        __syncthreads(); if (F.tid == 0) MISC[0] = atomicAdd(qctr, 1u); __syncthreads();
        const int it = (int)MISC[0]; if (it >= nitems) break;
        const int qb = 63 - it / nb, b = it % nb, NT = 2 * ((qb >> 2) + 1);
        const size_t row0 = (size_t)b * SEQ + qb * 32;
        att::attn_item(QA + row0 * 1024, KP + (size_t)b * SEQ * 128, VV + (size_t)b * SEQ * 128, MASK + (size_t)b * 64 * 2048 + qb * 32, ATT + row0 * 1024, NT, (char*)lds_generic);
    }
}


__device__ __forceinline__ void p7_router(Frame& F, const Args& a) {
    const int lane = F.lane, r32 = lane & 31, hi = lane >> 5, tid = F.tid;
    unsigned char* mo = F.act; bf16* N2 = (bf16*)(mo + MO_N2); unsigned char* meta = mo + MO_META;
    int* MB = (int*)(meta + MM_B); int* MPp = (int*)(meta + MM_P); float* MCL = (float*)(meta + MM_CL); float* MCH = (float*)(meta + MM_CH); float* MRS = (float*)(meta + MM_RS);
    const bf16* Wh = (const bf16*)(F.ws + WS_WR); const bf16* Wl = Wh + 32 * 1024;
    const float* g2 = a.in[12]; const float* b_gr = a.in[14]; const float* b_er = a.in[16];
    const float* hbase = a.out + (size_t)a.tok0 * D;
    unsigned* gcnt = (unsigned*)(F.ws + WS_CTL) + CW_MOE;
    LAS unsigned* lcnt = (LAS unsigned*)(F.lds + RING_OFF);
    if (tid < 64) lcnt[tid] = 0u;
    __syncthreads();
    const int ntasks = F.ntok / 32, tpw = ntasks / F.G;
    const bool have = F.wave < tpw; const int t = (F.vcu * tpw + F.wave) * 32 + r32;
    int bucket = 0, posl = 0; float clo = 0.f, chi = 0.f, rstd = 0.f;
    if (have) {
        const float* hrow = hbase + (size_t)t * D + hi * 8; bf16* nrow = N2 + (size_t)t * D + hi * 8;
        f32x16 acc = f32x16{}; float ss = 0.f;
#pragma unroll 4
        for (int kk = 0; kk < 64; ++kk) {
            const f32x4 a0 = *(const f32x4*)(hrow + kk * 16), a1 = *(const f32x4*)(hrow + kk * 16 + 4);
            const f32x4 q0 = *(const f32x4*)(g2 + kk * 16 + hi * 8), q1 = *(const f32x4*)(g2 + kk * 16 + hi * 8 + 4);
            ss += (a0.x * a0.x + a0.y * a0.y) + (a0.z * a0.z + a0.w * a0.w) + (a1.x * a1.x + a1.y * a1.y) + (a1.z * a1.z + a1.w * a1.w);
            const float x[8] = {a0.x * q0.x, a0.y * q0.y, a0.z * q0.z, a0.w * q0.w, a1.x * q1.x, a1.y * q1.y, a1.z * q1.z, a1.w * q1.w};
            unsigned hb[8]; float lo[8];
#pragma unroll
            for (int j = 0; j < 8; ++j) { hb[j] = f2bf(x[j]); lo[j] = x[j] - __uint_as_float(hb[j] << 16); }
            v4u xh; xh.x = hb[0] | (hb[1] << 16); xh.y = hb[2] | (hb[3] << 16); xh.z = hb[4] | (hb[5] << 16); xh.w = hb[6] | (hb[7] << 16);
            v4u xl; xl.x = pk2(lo[0], lo[1]); xl.y = pk2(lo[2], lo[3]); xl.z = pk2(lo[4], lo[5]); xl.w = pk2(lo[6], lo[7]);
            *(v4u*)(nrow + kk * 16) = xh;
            const bf16x8_t wh = *(const bf16x8_t*)(Wh + (size_t)r32 * 1024 + kk * 16 + hi * 8), wl = *(const bf16x8_t*)(Wl + (size_t)r32 * 1024 + kk * 16 + hi * 8);
            const bf16x8_t bh = __builtin_bit_cast(bf16x8_t, xh), bl = __builtin_bit_cast(bf16x8_t, xl);
            acc = __builtin_amdgcn_mfma_f32_32x32x16_bf16(wh, bh, acc, 0, 0, 0);
            acc = __builtin_amdgcn_mfma_f32_32x32x16_bf16(wh, bl, acc, 0, 0, 0);
            acc = __builtin_amdgcn_mfma_f32_32x32x16_bf16(wl, bh, acc, 0, 0, 0);
        }
        ss = xhalf_sum(ss); rstd = rsqrtf(ss * (1.f / D) + EPS);
        float L[24];
#pragma unroll
        for (int r = 0; r < 12; ++r) { const float v = acc[r]; auto rr = __builtin_amdgcn_permlane32_swap(__float_as_uint(v), __float_as_uint(v), false, false);
            L[(r & 3) + 8 * (r >> 2)] = __uint_as_float(rr[0]); L[(r & 3) + 8 * (r >> 2) + 4] = __uint_as_float(rr[1]); }
        float gl[4];
#pragma unroll
        for (int i = 0; i < 4; ++i) gl[i] = L[i] * rstd + b_gr[i];
        int g = 0; float gm = gl[0];
#pragma unroll
        for (int i = 1; i < 4; ++i) if (gl[i] > gm) { gm = gl[i]; g = i; }
        float se = 0.f;
#pragma unroll
        for (int i = 0; i < 4; ++i) se += __expf(gl[i] - gm);
        const float gw = 1.f / se;
        float el[4];
#pragma unroll
        for (int i = 0; i < 4; ++i) { const float l0 = L[4 + i], l1 = L[8 + i], l2 = L[12 + i], l3 = L[16 + i]; const float lv = g == 0 ? l0 : (g == 1 ? l1 : (g == 2 ? l2 : l3));
            const float b0 = b_er[i], b1 = b_er[4 + i], b2 = b_er[8 + i], b3 = b_er[12 + i]; el[i] = lv * rstd + (g == 0 ? b0 : (g == 1 ? b1 : (g == 2 ? b2 : b3))); }
        int i1 = 0; float v1 = el[0];
#pragma unroll
        for (int i = 1; i < 4; ++i) if (el[i] > v1) { v1 = el[i]; i1 = i; }
        int i2 = -1; float v2 = 0.f;
#pragma unroll
        for (int i = 0; i < 4; ++i) if (i != i1 && (i2 < 0 || el[i] > v2)) { v2 = el[i]; i2 = i; }
        const float e2 = __expf(v2 - v1), p1 = gw / (1.f + e2), p2 = gw * e2 / (1.f + e2);
        const int lo_ = i1 < i2 ? i1 : i2, hi_ = i1 < i2 ? i2 : i1;
        const int pair = lo_ == 0 ? (hi_ - 1) : (lo_ == 1 ? (hi_ + 1) : 5);
        bucket = g * 6 + pair; clo = i1 < i2 ? p1 : p2; chi = i1 < i2 ? p2 : p1;
        if (hi == 0) posl = (int)__hip_atomic_fetch_add(&lcnt[bucket], 1u, __ATOMIC_RELAXED, __HIP_MEMORY_SCOPE_WORKGROUP);
    }
    __syncthreads();
    if (tid < 24) lcnt[32 + tid] = atomicAdd(gcnt + tid, lcnt[tid]);
    __syncthreads();
    if (have && hi == 0) { MB[t] = bucket; MPp[t] = (int)lcnt[32 + bucket] + posl; MCL[t] = clo; MCH[t] = chi; MRS[t] = rstd; }
}
__device__ __forceinline__ int moe_tiles(const unsigned* gcnt, int* rowstart  ) { int rs = 0;
    for (int b = 0; b < 24; ++b) { rowstart[b] = rs; rs += (int)((gcnt[b] + 255u) & ~255u); } rowstart[24] = rs; return rs >> 8; }
__device__ __forceinline__ void p8_permute(Frame& F, const Args& a) {
    unsigned char* mo = F.act; const bf16* N2 = (const bf16*)(mo + MO_N2); bf16* AP = (bf16*)(mo + MO_APERM); unsigned char* meta = mo + MO_META;
    const int* MB = (const int*)(meta + MM_B); const int* MPp = (const int*)(meta + MM_P); const float* MCL = (const float*)(meta + MM_CL); const float* MCH = (const float*)(meta + MM_CH); const float* MRS = (const float*)(meta + MM_RS);
    int* PTOK = (int*)(meta + MM_PTOK); float* PRS = (float*)(meta + MM_PRS); float* PCL = (float*)(meta + MM_PCL); float* PCH = (float*)(meta + MM_PCH);
    const unsigned* gcnt = (const unsigned*)(F.ws + WS_CTL) + CW_MOE;
    LAS int* rsL = (LAS int*)(F.lds + RING_OFF);
    if (F.tid == 0) { int rs = 0; for (int b = 0; b < 24; ++b) { rsL[b] = rs; rs += (int)((gcnt[b] + 255u) & ~255u); } rsL[24] = rs; }
    __syncthreads();
    const int gw = F.vcu * NWAVES + F.wave, NGW = F.G * NWAVES;
    for (int t = gw; t < F.ntok; t += NGW) {
        const int b = MB[t], prow = rsL[b] + MPp[t];
        const GAS v4u* s = (const GAS v4u*)(N2 + (size_t)t * D) + F.lane; GAS v4u* d = (GAS v4u*)(AP + (size_t)prow * D) + F.lane;
        d[0] = s[0]; d[64] = s[64];
        if (F.lane == 0) { PTOK[prow] = t; PRS[prow] = MRS[t]; PCL[prow] = MCL[t]; PCH[prow] = MCH[t]; }
    }
    const int gt = gw * 64 + F.lane, NGT = NGW * 64;
    for (int b = 0; b < 24; ++b) { const int c = (int)gcnt[b], p0 = rsL[b] + c, p1 = rsL[b + 1];
        for (int r = p0 + gt; r < p1; r += NGT) { PTOK[r] = -1; PRS[r] = 0.f; PCL[r] = 0.f; PCH[r] = 0.f; } }
}
struct MoeOrder {
    int ntile, G, c; const char* A; size_t tA; const char* W; int mode; const LAS unsigned char* tb;
    __device__ bool next(int i, pg8::Unit& u) const {
        const long L = (long)i * G + c; if (L >= (long)ntile * 4) return false;
        u.pm = (int)(L >> 2); u.pn = (int)(L & 3); u.a = A + (size_t)u.pm * tA;
        const int bk = tb[u.pm], g = bk / 6, pr = bk % 6; const int lo = pr < 3 ? 0 : (pr < 5 ? 1 : 2), hi = pr < 3 ? pr + 1 : (pr < 5 ? pr - 1 : 3);
        const int elo = g * 4 + lo, ehi = g * 4 + hi; u.aux = 0;
        if (mode == 1) { const int e = u.pn < 2 ? elo : ehi; u.b = W + ((size_t)e * 512 + (size_t)(u.pn & 1) * 256) * 1024 * 2; u.bjump = 0; }
        else { u.b = W + ((size_t)elo * 1024 + (size_t)u.pn * 256) * 256 * 2; u.bjump = (long)(ehi - elo) * 1024 * 256 * 2 - 4 * 128; }
        return true;
    }
    __device__ __forceinline__ void a_ready(const pg8::Unit&) const {}
    __device__ __forceinline__ void done(const pg8::Unit&) const {}
};
__device__ __forceinline__ float silu_f(float x) { return x / (1.f + __expf(-x)); }
struct EpiMoe1 {
    static constexpr bool PERM = true, AFTER_DRAIN = false;
    pg8::bf16_t* ACT; const float* PRS; const float* PCL; const float* PCH;
    __device__ __forceinline__ void operator()(const pg8::f32x4 (&acc)[2][2][4][2], const pg8::Unit& u, int wr, int wc, int fr, int fq) const {
        const int row0 = u.pm * pg8::BM + wr * 64 + fr, slot = u.pn >> 1, fcol0 = slot * 256 + (u.pn & 1) * 128 + wc * 16 + 4 * fq; const float* PC = slot ? PCH : PCL;
#pragma unroll
        for (int ai = 0; ai < 2; ++ai)
#pragma unroll
            for (int m = 0; m < 4; ++m) { const int row = row0 + ai * pg8::HALF + m * 16; const float rs = PRS[row], cw = PC[row]; pg8::bf16_t* rowp = ACT + (size_t)row * 512 + fcol0;
#pragma unroll
                for (int bj = 0; bj < 2; ++bj) { const pg8::f32x4 v0 = acc[ai][bj][m][0], v1 = acc[ai][bj][m][1];
                    const float a0 = silu_f(v0[0] * rs) * (v0[1] * rs) * cw, a1 = silu_f(v0[2] * rs) * (v0[3] * rs) * cw, a2 = silu_f(v1[0] * rs) * (v1[1] * rs) * cw, a3 = silu_f(v1[2] * rs) * (v1[3] * rs) * cw;
                    pg8::u32x2 w; w.x = pg8::cvt_pk_bf16(a0, a1); w.y = pg8::cvt_pk_bf16(a2, a3); *(pg8::u32x2*)(rowp + bj * 64) = w; } }
    }
};
struct EpiMoe2 {
    static constexpr bool PERM = false, AFTER_DRAIN = false;
    float* out; const int* PTOK;
    __device__ __forceinline__ void operator()(const pg8::f32x4 (&acc)[2][2][4][2], const pg8::Unit& u, int wr, int wc, int fr, int fq) const {
        const int row0 = u.pm * pg8::BM + wr * 64 + fr, col0 = u.pn * pg8::BM + wc * 32 + 4 * fq;
#pragma unroll
        for (int ai = 0; ai < 2; ++ai)
#pragma unroll
            for (int m = 0; m < 4; ++m) { const int tok = PTOK[row0 + ai * pg8::HALF + m * 16];
                if (tok >= 0) { float* rowp = out + (size_t)tok * 1024 + col0;
#pragma unroll
                    for (int bj = 0; bj < 2; ++bj)
#pragma unroll
                        for (int n = 0; n < 2; ++n) { pg8::f32x4* p = (pg8::f32x4*)(rowp + bj * pg8::HALF + n * 16); *p = *p + acc[ai][bj][m][n]; } } }
    }
};
__device__ __forceinline__ int moe_setup(Frame& F, LAS unsigned char* tb) {
    const unsigned* gcnt = (const unsigned*)(F.ws + WS_CTL) + CW_MOE;
    LAS int* nt_ = (LAS int*)(tb + 256);
    __syncthreads();
    if (F.tid == 0) { int tl = 0; for (int b = 0; b < 24; ++b) { const int n = (int)((gcnt[b] + 255u) >> 8); for (int i = 0; i < n; ++i) tb[tl + i] = (unsigned char)b; tl += n; } nt_[0] = tl; }
    __syncthreads();
    return nt_[0];
}

__global__ void __launch_bounds__(NWAVES * 64, 2) mk_fwd(Args args) {
    extern __shared__ __attribute__((aligned(16))) unsigned char lds[];
    Frame F;
    F.lds = (LAS unsigned char*)lds;
    F.tid = threadIdx.x; F.lane = F.tid & 63; F.wave = __builtin_amdgcn_readfirstlane(F.tid >> 6);
    F.G = gridDim.x; { const int bx = blockIdx.x; F.vcu = (F.G % 8 == 0) ? (bx % 8) * (F.G / 8) + bx / 8 : bx; }
    F.ntok = args.ntok; F.ws = args.ws; F.act = args.ws + WS_ACT;
    const int lo = args.ph_lo, hi = args.ph_hi;
    cooperative_groups::grid_group grid = cooperative_groups::this_grid();
#define IN(k) (lo <= (k) && (k) < hi)
#define SEAM(k) do { if (IN(k) && IN((k) + 1)) { grid.sync(); } } while (0)
    if (IN(0)) { p0_prologue(F, args); }
    SEAM(0);
    if (IN(1)) {
        pg8::Gemm g{1024, 1024, 1024, 16};
        pg8::StaticOrder S; S.init(F.ntok, INWP, F.G, (int)blockIdx.x, args.xb, 1024, F.ws + WS_WIN, 1024);
        EpiProj E{F.act, (size_t)F.ntok};
        pg8::gemm_phase<EpiProj, pg8::StaticOrder, true, true>(F.lds + RING_OFF, g, S, E);
    }
    SEAM(1);
    if (IN(2)) { p2_post(F, args); }
    SEAM(2);
    if (IN(3)) { p3_index(F, args); }
    SEAM(3);
    if (IN(4)) { p4_attn(F, args, lds); }
    SEAM(4);
    if (IN(5)) {
        pg8::Gemm g{1024, 1024, 1024, 16}; const size_t nt_ = (size_t)F.ntok;
        pg8::bf16_t* GA = (pg8::bf16_t*)(F.act + nt_ * O_GA); const pg8::bf16_t* GR = (const pg8::bf16_t*)(F.act + nt_ * O_GR);
        { pg8::StaticOrder S; S.init(F.ntok, 1024, F.G, (int)blockIdx.x, F.act + nt_ * O_QA, 1024, F.ws + WS_WATT, 1024); EpiGateA E{GA};
          pg8::gemm_phase<EpiGateA, pg8::StaticOrder, true, true>(F.lds + RING_OFF, g, S, E); }
        { pg8::StaticOrder S; S.init(F.ntok, 1024, F.G, (int)blockIdx.x, F.act + nt_ * O_RV, 1024, F.ws + WS_WRET, 1024); EpiGateB E{GA, GR};
          pg8::gemm_phase<EpiGateB, pg8::StaticOrder, true, true>(F.lds + RING_OFF, g, S, E); }
    }
    SEAM(5);
    if (IN(6)) {
        pg8::Gemm g{1024, 1024, 1024, 16}; const size_t nt_ = (size_t)F.ntok;
        pg8::StaticOrder S; S.init(F.ntok, 1024, F.G, (int)blockIdx.x, F.act + nt_ * O_GA, 1024, F.ws + WS_WOUT, 1024);
        EpiResid E{args.in[0] + (size_t)args.tok0 * D, args.out + (size_t)args.tok0 * D};
        pg8::gemm_phase<EpiResid, pg8::StaticOrder, true, true>(F.lds + RING_OFF, g, S, E);
    }
    SEAM(6);
    if (IN(7)) { p7_router(F, args); }
    SEAM(7);
    if (IN(8)) { p8_permute(F, args); }
    SEAM(8);
    if (IN(9)) {
        LAS unsigned char* tb = F.lds + LDSCTL_OFF - 1024; const int ntile = moe_setup(F, tb);
        unsigned char* meta = F.act + MO_META;
        pg8::Gemm g{1024, 1024, 1024, 16};
        MoeOrder S{ntile, F.G, (int)blockIdx.x, (const char*)(F.act + MO_APERM), (size_t)256 * 1024 * 2, (const char*)(F.ws + WS_W1), 1, tb};
        EpiMoe1 E{(pg8::bf16_t*)(F.act + MO_ACT), (const float*)(meta + MM_PRS), (const float*)(meta + MM_PCL), (const float*)(meta + MM_PCH)};
        pg8::gemm_phase<EpiMoe1, MoeOrder, true, true>(F.lds + RING_OFF, g, S, E);
    }
    SEAM(9);
    if (IN(10)) {
        LAS unsigned char* tb = F.lds + LDSCTL_OFF - 1024; const int ntile = moe_setup(F, tb);
        unsigned char* meta = F.act + MO_META;
        pg8::Gemm g{512, 512, 256, 4};
        MoeOrder S{ntile, F.G, (int)blockIdx.x, (const char*)(F.act + MO_ACT), (size_t)256 * 512 * 2, (const char*)(F.ws + WS_WD), 2, tb};
        EpiMoe2 E{args.out + (size_t)args.tok0 * D, (const int*)(meta + MM_PTOK)};
        pg8::gemm_phase<EpiMoe2, MoeOrder, true, true>(F.lds + RING_OFF, g, S, E);
    }
#undef IN
#undef SEAM
}

__device__ __forceinline__ float block_sum256(float v, float* red) {
#pragma unroll
    for (int o = 32; o > 0; o >>= 1) v += __shfl_xor(v, o);
    __syncthreads();
    if ((threadIdx.x & 63) == 0) red[threadIdx.x >> 6] = v;
    __syncthreads();
    return red[0] + red[1] + red[2] + red[3];
}
__device__ __forceinline__ float block_max256(float v, float* red) {
#pragma unroll
    for (int o = 32; o > 0; o >>= 1) v = fmaxf(v, __shfl_xor(v, o));
    __syncthreads();
    if ((threadIdx.x & 63) == 0) red[threadIdx.x >> 6] = v;
    __syncthreads();
    return fmaxf(fmaxf(red[0], red[1]), fmaxf(red[2], red[3]));
}
__device__ __forceinline__ float sigmoidf_(float x) { return 1.f / (1.f + expf(-x)); }
__device__ __forceinline__ float siluf_(float x) { return x / (1.f + expf(-x)); }

__global__ void __launch_bounds__(256) nv_rmsnorm(const float* inb, long in_ld, float* outb, long out_ld, int ninner, int width, const float* gain, int gstride) {
    __shared__ float red[8];
    const int r = blockIdx.x, t = r / ninner, i = r % ninner;
    const float* in = inb + (long)t * in_ld + (long)i * width;
    float* out = outb + (long)t * out_ld + (long)i * width;
    float s = 0.f;
    for (int c = threadIdx.x; c < width; c += 256) { const float v = in[c]; s += v * v; }
    s = block_sum256(s, red);
    const float rs = rsqrtf(s / (float)width + EPS);
    for (int c = threadIdx.x; c < width; c += 256) out[c] = in[c] * rs * gain[i * gstride + c];
}
__global__ void __launch_bounds__(256) nv_gemm(const float* A, long lda, const float* B, long ldb, float* C, long ldc, int M, int N, int K) {
    __shared__ float As[8][128 + 4];
    __shared__ float Bs[8][128 + 4];
    const int tid = threadIdx.x, tx = tid & 15, ty = tid >> 4;
    const int m0 = blockIdx.y * 128, n0 = blockIdx.x * 128;
    float acc[8][8];
#pragma unroll
    for (int i = 0; i < 8; ++i)
#pragma unroll
        for (int j = 0; j < 8; ++j) acc[i][j] = 0.f;
    for (int k0 = 0; k0 < K; k0 += 8) {
        { const int r = tid >> 1, kk = (tid & 1) * 4;
          const float4 v = *(const float4*)(A + (long)(m0 + r) * lda + k0 + kk);
          As[kk + 0][r] = v.x; As[kk + 1][r] = v.y; As[kk + 2][r] = v.z; As[kk + 3][r] = v.w; }
        { const int kk = tid >> 5, c = (tid & 31) * 4;
#pragma unroll
          for (int j = 0; j < 4; ++j) { const int n = n0 + c + j; Bs[kk][c + j] = (n < N) ? B[(long)(k0 + kk) * ldb + n] : 0.f; } }
        __syncthreads();
#pragma unroll
        for (int kk = 0; kk < 8; ++kk) {
            float a[8], b[8];
#pragma unroll
            for (int i = 0; i < 8; ++i) a[i] = As[kk][ty * 8 + i];
#pragma unroll
            for (int j = 0; j < 8; ++j) b[j] = Bs[kk][tx * 8 + j];
#pragma unroll
            for (int i = 0; i < 8; ++i)
#pragma unroll
                for (int j = 0; j < 8; ++j) acc[i][j] += a[i] * b[j];
        }
        __syncthreads();
    }
#pragma unroll
    for (int i = 0; i < 8; ++i)
#pragma unroll
        for (int j = 0; j < 8; ++j) { const int n = n0 + tx * 8 + j; if (n < N) C[(long)(m0 + ty * 8 + i) * ldc + n] = acc[i][j]; }
}
__global__ void __launch_bounds__(256) nv_attn(const float* proj, const float* kv, float* att, float wscale, float dscale, float lscale, const unsigned* maskb) {
    __shared__ float s_qi[512], s_w[8], s_score[2048], s_q[1024], s_p[8][256], red[8];
    __shared__ int s_sel[256 + 64]; __shared__ int s_pref[65]; __shared__ unsigned s_mw[64];
    const int tq = blockIdx.x, b = tq / SEQ, t = tq % SEQ, tid = threadIdx.x;
    const float* prow = proj + (long)tq * INW;
    const float* pb = proj + (long)b * SEQ * INW;
    const float* kvb = kv + (long)b * SEQ * 256;
    for (int i = tid; i < 512; i += 256) s_qi[i] = prow[C_QI + i];
    for (int i = tid; i < 1024; i += 256) s_q[i] = prow[C_QA + i];
    if (tid < 8) s_w[tid] = prow[C_WI + tid] * wscale;
    __syncthreads();
    const int n = t + 1;
    int cnt;
    if (maskb) {
        if (tid < 64) s_mw[tid] = (tid * 32 <= t) ? maskb[tid * 2048 + t] : 0u;
        __syncthreads();
        if (tid == 0) { int c = 0; for (int i = 0; i < 64; ++i) { s_pref[i] = c; c += __builtin_popcount(s_mw[i]); } s_pref[64] = c; }
        __syncthreads();
        if (tid < 64) { unsigned x = s_mw[tid]; int p = s_pref[tid]; while (x) { const int bpos = __builtin_ctz(x); x &= x - 1; if (p < 256) s_sel[p] = tid * 32 + bpos; ++p; } }
        cnt = s_pref[64] < 256 ? s_pref[64] : 256;
        __syncthreads();
    } else {
    for (int s = tid; s < n; s += 256) {
        const float* kr = pb + (long)s * INW + C_KI;
        float kk[64];
#pragma unroll
        for (int d = 0; d < 64; ++d) kk[d] = kr[d];
        float sc = 0.f;
#pragma unroll
        for (int h = 0; h < 8; ++h) {
            float dt = 0.f;
#pragma unroll
            for (int d = 0; d < 64; ++d) dt += s_qi[h * 64 + d] * kk[d];
            dt *= dscale;
            sc += fmaxf(dt, 0.f) * s_w[h];
        }
        s_score[s] = sc;
    }
    __syncthreads();
    if (n <= 256) { if (tid < n) s_sel[tid] = tid; cnt = n; }
    else {
        for (int s = tid; s < n; s += 256) {
            const float v = s_score[s]; int rank = 0;
            for (int j = 0; j < n; ++j) { const float u = s_score[j]; rank += (u > v || (u == v && j < s)) ? 1 : 0; }
            if (rank < 256) s_sel[rank] = s;
        }
        cnt = 256;
    }
    __syncthreads();
    }
    float lg[8];
    const bool act = tid < cnt;
    const int sj = act ? s_sel[tid] : 0;
    {
        const float* kr = kvb + (long)sj * 256;
#pragma unroll
        for (int h = 0; h < 8; ++h) lg[h] = 0.f;
        for (int d = 0; d < 128; ++d) { const float kd = kr[d];
#pragma unroll
            for (int h = 0; h < 8; ++h) lg[h] += s_q[h * 128 + d] * kd; }
    }
#pragma unroll
    for (int h = 0; h < 8; ++h) {
        const float slope = exp2f(-(float)(h + 1));
        float x = act ? (lg[h] * lscale - slope * (float)(t - sj)) : -INFINITY;
        const float m = block_max256(x, red);
        const float e = act ? expf(x - m) : 0.f;
        const float su = block_sum256(e, red);
        s_p[h][tid] = e / su;
    }
    __syncthreads();
    float o4[4] = {0.f, 0.f, 0.f, 0.f};
    for (int j = 0; j < cnt; ++j) {
        const float* vr = kvb + (long)s_sel[j] * 256 + 128;
#pragma unroll
        for (int i = 0; i < 4; ++i) { const int o = tid + 256 * i; o4[i] += s_p[o >> 7][j] * vr[o & 127]; }
    }
#pragma unroll
    for (int i = 0; i < 4; ++i) att[(long)tq * 1024 + tid + 256 * i] = o4[i];
}
__global__ void __launch_bounds__(256) nv_ret(const float* proj, float* reto) {
    __shared__ float sq[128], sk[128];
    const int b = blockIdx.x >> 2, h = blockIdx.x & 3, v = threadIdx.x;
    const float gamma = 1.f - exp2f(-5.f - (float)h);
    float S[128];
#pragma unroll
    for (int d = 0; d < 128; ++d) S[d] = 0.f;
    for (int t = 0; t < SEQ; ++t) {
        const float* row = proj + (long)(b * SEQ + t) * INW;
        if (v < 128) { sq[v] = row[C_RQ + h * 128 + v]; sk[v] = row[C_RK + h * 128 + v] * 0.08838834764831845f; }
        __syncthreads();
        const float vv = row[C_RV + h * 256 + v];
        float o = 0.f;
#pragma unroll
        for (int d = 0; d < 128; ++d) { S[d] = gamma * S[d] + sk[d] * vv; o += sq[d] * S[d]; }
        reto[(long)(b * SEQ + t) * 1024 + h * 256 + v] = o;
        __syncthreads();
    }
}
__global__ void __launch_bounds__(256) nv_retpost(const float* proj, const float* reto, const float* g, float* a2) {
    __shared__ float red[8];
    const int t = blockIdx.x >> 2, h = blockIdx.x & 3, c = threadIdx.x;
    const float x = reto[(long)t * 1024 + h * 256 + c];
    const float mu = block_sum256(x, red) * (1.f / 256.f);
    const float dv = x - mu;
    const float var = block_sum256(dv * dv, red) * (1.f / 256.f);
    const float y = dv * rsqrtf(var + EPS) * g[h * 256 + c];
    a2[(long)t * 1024 + h * 256 + c] = siluf_(proj[(long)t * INW + C_RG + h * 256 + c]) * y;
}
__global__ void __launch_bounds__(256) nv_mix(const float* proj, const float* ya, const float* yr, float* mix) {
    const long i = (long)blockIdx.x * 256 + threadIdx.x; const long t = i >> 10; const int c = (int)(i & 1023);
    mix[i] = sigmoidf_(proj[t * INW + C_GA + c]) * ya[i] + sigmoidf_(proj[t * INW + C_GR + c]) * yr[i];
}
__global__ void __launch_bounds__(256) nv_add(const float* a, const float* b, float* o) {
    const long i = (long)blockIdx.x * 256 + threadIdx.x; o[i] = a[i] + b[i];
}
__global__ void __launch_bounds__(256) nv_moe(const float* n2, float* hio, const float* wgr, const float* bgr, const float* wer, const float* ber,
                                              const float* wg, const float* wu, const float* wd) {
    __shared__ float s_n[1024], s_lg[20], s_act[256], s_p[2];
    __shared__ int s_e[2];
    const int t = blockIdx.x, tid = threadIdx.x;
    for (int i = tid; i < 1024; i += 256) s_n[i] = n2[(long)t * 1024 + i];
    __syncthreads();
    if (tid < 20) {
        float a = 0.f;
        if (tid < 4) { for (int d = 0; d < 1024; ++d) a += s_n[d] * wgr[d * 4 + tid]; a += bgr[tid]; }
        else { const int e = tid - 4; for (int d = 0; d < 1024; ++d) a += s_n[d] * wer[d * 16 + e]; a += ber[e]; }
        s_lg[tid] = a;
    }
    __syncthreads();
    if (tid == 0) {
        int g = 0; float m = s_lg[0];
        for (int i = 1; i < 4; ++i) if (s_lg[i] > m) { m = s_lg[i]; g = i; }
        float se = 0.f; for (int i = 0; i < 4; ++i) se += expf(s_lg[i] - m);
        const float gw = 1.f / se;
        const float* el = s_lg + 4 + g * 4;
        int i1 = 0; for (int i = 1; i < 4; ++i) if (el[i] > el[i1]) i1 = i;
        int i2 = -1; for (int i = 0; i < 4; ++i) if (i != i1 && (i2 < 0 || el[i] > el[i2])) i2 = i;
        const float e2 = expf(el[i2] - el[i1]);
        s_p[0] = gw / (1.f + e2); s_p[1] = gw * e2 / (1.f + e2);
        s_e[0] = g * 4 + i1; s_e[1] = g * 4 + i2;
    }
    __syncthreads();
    float acc[4] = {0.f, 0.f, 0.f, 0.f};
    for (int sl = 0; sl < 2; ++sl) {
        const int e = s_e[sl]; const float p = s_p[sl];
        const float* g_ = wg + (long)e * 1024 * 256 + tid; const float* u_ = wu + (long)e * 1024 * 256 + tid;
        float hg = 0.f, hu = 0.f;
        for (int d = 0; d < 1024; ++d) { hg += s_n[d] * g_[(long)d * 256]; hu += s_n[d] * u_[(long)d * 256]; }
        __syncthreads();
        s_act[tid] = siluf_(hg) * hu * p;
        __syncthreads();
        const float* d_ = wd + (long)e * 256 * 1024;
        for (int f = 0; f < 256; ++f) { const float a = s_act[f];
#pragma unroll
            for (int i = 0; i < 4; ++i) acc[i] += a * d_[(long)f * 1024 + tid + 256 * i]; }
    }
#pragma unroll
    for (int i = 0; i < 4; ++i) hio[(long)t * 1024 + tid + 256 * i] += acc[i];
}
__global__ void __launch_bounds__(256) ad_proj(const unsigned char* act, int ntok, int tok_lo, float* PROJ) {
    const int t = blockIdx.x; const size_t tg = (size_t)(tok_lo + t); const size_t nt = (size_t)ntok;
    const bf16* QA = (const bf16*)(act + nt * O_QA) + tg * 1024; const bf16* CKV = (const bf16*)(act + nt * O_CKV) + tg * 256; const bf16* QI = (const bf16*)(act + nt * O_QI) + tg * 512;
    const bf16* KW = (const bf16*)(act + nt * O_KW) + tg * 128; const bf16* RQ = (const bf16*)(act + nt * O_RQ) + tg * 512; const bf16* RK = (const bf16*)(act + nt * O_RK) + tg * 512;
    const bf16* R4 = (const bf16*)(act + nt * O_RV);
    float* o = PROJ + (size_t)t * INW;
    for (int c = threadIdx.x; c < INW; c += 256) {
        bf16 v;
        if (c < C_CKV) v = QA[c]; else if (c < C_QI) v = CKV[c - C_CKV]; else if (c < C_KI) v = QI[c - C_QI]; else if (c < C_RQ) v = KW[c - C_KI];
        else if (c < C_RK) v = RQ[c - C_RQ]; else if (c < C_RV) v = RK[c - C_RK];
        else { const int cc = c - C_RV; v = R4[(size_t)(cc >> 10) * nt * 1024 + tg * 1024 + (cc & 1023)]; }
        o[c] = bf2f(v);
    }
}


__global__ void __launch_bounds__(256) ad_kv(const unsigned char* aux, int ntok, int tok_lo, float* KV, float* PROJ) {
    const int t = blockIdx.x; const size_t tg = (size_t)(tok_lo + t); const size_t nt = (size_t)ntok; const int c = threadIdx.x;
    const bf16* KP = (const bf16*)(aux + nt * AUX_KP) + tg * 128; const bf16* VV = (const bf16*)(aux + nt * AUX_VV) + tg * 128; const bf16* KIN = (const bf16*)(aux + nt * AUX_KIN) + tg * 64;
    KV[(size_t)t * 256 + c] = bf2f(c < 128 ? KP[c] : VV[c - 128]);
    if (c < 64) PROJ[(size_t)t * INW + C_KI + c] = bf2f(KIN[c]);
}
__global__ void __launch_bounds__(256) nv_fill(float* p, float v, int n) { const int i = blockIdx.x * 256 + threadIdx.x; if (i < n) p[i] = v; }


__global__ void __launch_bounds__(256) ad_att(const unsigned char* act, int ntok, int tok_lo, float* ATT) {
    const int t = blockIdx.x; const bf16* A = (const bf16*)(act + (size_t)ntok * O_QA) + (size_t)(tok_lo + t) * 1024;
    for (int c = threadIdx.x; c < 1024; c += 256) ATT[(size_t)t * 1024 + c] = bf2f(A[c]);
}


__global__ void __launch_bounds__(256) ad_a2(const unsigned char* act, int ntok, int tok_lo, float* A2) {
    const int t = blockIdx.x; const bf16* A = (const bf16*)(act + (size_t)ntok * O_RV) + (size_t)(tok_lo + t) * 1024;
    for (int c = threadIdx.x; c < 1024; c += 256) A2[(size_t)t * 1024 + c] = bf2f(A[c]);
}

static void gemm(hipStream_t st, const float* A, long lda, const float* B, long ldb, float* C, long ldc, int M, int N, int K) {
    hipLaunchKernelGGL(nv_gemm, dim3((N + 127) / 128, M / 128), dim3(256), 0, st, A, lda, B, ldb, C, ldc, M, N, K);
}

extern "C" void kernel_launch(void* const* d_in, const int* in_sizes, int n_in, void* d_out, int out_size, void* d_ws, size_t ws_size, hipStream_t stream) {
    static int grid = 0;
    if (grid == 0) {
        int dev = 0, cus = 0, per_cu = 0;
        (void)hipGetDevice(&dev); (void)hipDeviceGetAttribute(&cus, hipDeviceAttributeMultiprocessorCount, dev);
        if (hipFuncSetAttribute((const void*)mk_fwd, hipFuncAttributeMaxDynamicSharedMemorySize, LDS_BYTES) != hipSuccess) { fprintf(stderr, "kernel_launch: hipFuncSetAttribute failed\n"); grid = -1; return; }
        (void)hipOccupancyMaxActiveBlocksPerMultiprocessor(&per_cu, (const void*)mk_fwd, NWAVES * 64, LDS_BYTES);
        (void)hipGetLastError();
        if (per_cu < 1) { fprintf(stderr, "kernel_launch: occupancy query says %d blocks per CU\n", per_cu); per_cu = 1; }
        grid = cus * per_cu;
        if (n_in != 20 || ws_size < (size_t)512 * MiB) { fprintf(stderr, "kernel_launch: unexpected n_in %d / ws_size %zu\n", n_in, ws_size); grid = -1; return; }
    }
    if (grid < 0) return;
    const float* x = (const float*)d_in[0];
    const float* kv_norm_g = (const float*)d_in[3]; const float* w_kv_up = (const float*)d_in[4]; const float* q_norm_g = (const float*)d_in[5];
    const float* k_norm_g = (const float*)d_in[6]; const float* idx_k_norm_g = (const float*)d_in[7]; const float* ret_norm_g = (const float*)d_in[8];
    const float* w_att = (const float*)d_in[9]; const float* w_ret = (const float*)d_in[10]; const float* w_out = (const float*)d_in[11];
    const float* norm2_g = (const float*)d_in[12]; const float* w_gr = (const float*)d_in[13]; const float* b_gr = (const float*)d_in[14];
    const float* w_er = (const float*)d_in[15]; const float* b_er = (const float*)d_in[16]; const float* w_eg = (const float*)d_in[17];
    const float* w_eu = (const float*)d_in[18]; const float* w_ed = (const float*)d_in[19];
    float* out = (float*)d_out;
    unsigned char* ws = (unsigned char*)d_ws;
    if (ws_size < WS_ACT + (size_t)T * O_END) { fprintf(stderr, "kernel_launch: workspace too small\n"); return; }
    (void)x; (void)kv_norm_g; (void)w_kv_up; (void)q_norm_g; (void)k_norm_g; (void)idx_k_norm_g; (void)ret_norm_g; (void)w_att; (void)w_ret; (void)w_out; (void)norm2_g; (void)w_gr; (void)b_gr; (void)w_er; (void)b_er; (void)w_eg; (void)w_eu; (void)w_ed;
    (void)hipMemsetAsync(ws + WS_CTL, 0, CTL_ZERO_BYTES, stream);
    Args a{};
    for (int i = 0; i < 20; ++i) a.in[i] = (const float*)d_in[i];
    a.out = out; a.ws = ws; a.xb = (unsigned char*)d_out; a.ntok = T; a.tok0 = 0;
    a.ph_lo = 0; a.ph_hi = 11;
    void* kargs[] = {(void*)&a};
    const hipError_t le = hipLaunchCooperativeKernel((const void*)mk_fwd, dim3(grid), dim3(NWAVES * 64), kargs, (unsigned)LDS_BYTES, stream);
    if (le != hipSuccess) fprintf(stderr, "kernel_launch: cooperative launch failed: %s (grid %d)\n", hipGetErrorString(le), grid);
}
```

```cpp
#include <hip/hip_runtime.h>
#include <hip/hip_cooperative_groups.h>
#include <cstdio>
#include <cstdint>

namespace pg8 {
#define PG8_LAS __attribute__((address_space(3)))
typedef unsigned short bf16_t;
typedef short bf16x8 __attribute__((ext_vector_type(8)));
typedef float f32x4 __attribute__((ext_vector_type(4)));
typedef unsigned u32x4 __attribute__((ext_vector_type(4)));
typedef unsigned u32x2 __attribute__((ext_vector_type(2)));
constexpr int BM = 256, BK = 64, HALF = 128, HTB = HALF * BK * 2  , STAGE_BYTES = 8 * HTB, NXCD = 8, WGM = 8;

__host__ __device__ __forceinline__ int lds_byte(int r, int c) { const int st = (r >> 4) * 2 + (c >> 5), rr = r & 15, cc = c & 31, ob = rr * 64 + cc * 2; return st * 1024 + (ob ^ (((ob >> 9) & 1) << 5)); }
__host__ __device__ __forceinline__ void stage_rc(int b, int& R, int& C) { const int st = b / 1024, sb = b % 1024, swz = sb ^ (((sb >> 9) & 1) << 5); R = (st >> 1) * 16 + swz / 64; C = (st & 1) * 32 + (swz % 64) / 2; }
__host__ __device__ __forceinline__ int perm32(int rho) { const int n = rho >> 4, i = rho & 15; return 8 * (i >> 2) + 4 * n + (i & 3); }

struct Unit { int pm, pn; const char* a; const char* b; long bjump; int aux; };
struct Gemm { int K, lda, ldb, ksplit; };

struct StaticOrder {
    int nM, nN, nwg, G, c; const char* A; const char* Bt; size_t tA, tB;
    __device__ void init(int M, int N, int G_, int c_, const void* A_, int lda, const void* Bt_, int ldb) { nM = M / BM; nN = N / BM; nwg = nM * nN; G = G_; c = c_; A = (const char*)A_; Bt = (const char*)Bt_; tA = (size_t)BM * lda * 2; tB = (size_t)BM * ldb * 2; }
    __device__ bool next(int i, Unit& u) const {
        const long L = (long)i * G + c; if (L >= nwg) return false;
        int wgid = (int)L; { const int q = nwg / NXCD, r = nwg % NXCD, xcd = wgid % NXCD, off = wgid / NXCD; wgid = (xcd < r ? xcd * (q + 1) : r * (q + 1) + (xcd - r) * q) + off; }
        const int nig = WGM * nN, gid = wgid / nig, fm = gid * WGM, gsz = (nM - fm) < WGM ? (nM - fm) : WGM;
        u.pm = fm + ((wgid % nig) % gsz); u.pn = (wgid % nig) / gsz; u.a = A + (size_t)u.pm * tA; u.b = Bt + (size_t)u.pn * tB; u.bjump = 0; u.aux = 0; return true;
    }
    __device__ __forceinline__ void a_ready(const Unit&) const {}
    __device__ __forceinline__ void done(const Unit&) const {}
};

typedef float f32x2c __attribute__((ext_vector_type(2))); typedef __bf16 bf16x2c __attribute__((ext_vector_type(2)));
__device__ __forceinline__ unsigned cvt_pk_bf16(float lo, float hi) { const f32x2c v = {lo, hi}; const bf16x2c b = __builtin_convertvector(v, bf16x2c); return __builtin_bit_cast(unsigned, b); }
__device__ __forceinline__ float bf_lo(unsigned w) { return __uint_as_float(w << 16); }
__device__ __forceinline__ float bf_hi(unsigned w) { return __uint_as_float(w & 0xffff0000u); }


template <class Epi, class Sched, bool ALIGN_EPI = false, bool SP2 = false>
__device__ __forceinline__ void gemm_phase(PG8_LAS unsigned char* lds, const Gemm g, const Sched& S, const Epi& E) {
    const int tid = threadIdx.x, wid = __builtin_amdgcn_readfirstlane(tid >> 6), lane = tid & 63, wr = wid >> 2, wc = wid & 3, fr = lane & 15, fq = lane >> 4;
    const int K = g.K, nt = K / BK;
    unsigned voffA[2], voffB[2];
#pragma unroll
    for (int i = 0; i < 2; ++i) { int R, C; stage_rc(tid * 16 + i * 8192, R, C); const int Rb = Epi::PERM ? ((R & ~31) + perm32(R & 31)) : R;
        voffA[i] = (unsigned)(R * g.lda + C) * 2u; voffB[i] = (unsigned)(Rb * g.ldb + C) * 2u; }
    const size_t kstep = (size_t)(BK * 2);
    const size_t hstepA = (size_t)HALF * g.lda * 2, hstepB = (size_t)HALF * g.ldb * 2;
    const unsigned ldsw = (unsigned)wid * 1024u;
    const int aoff = lds_byte(wr * 64 + fr, fq * 8), boff = lds_byte(wc * 32 + fr, fq * 8);
#define PG8_SA(b, h) (((b) * 2 + (h)) * HTB)
#define PG8_SB(b, h) ((4 + (b) * 2 + (h)) * HTB)
#define PG8_STAGE(bufoff, gbase, voff) do { _Pragma("unroll") for (int _i = 0; _i < 2; ++_i) \
        __builtin_amdgcn_global_load_lds((const unsigned*)((const char*)(gbase) + (voff)[_i]), (PG8_LAS unsigned*)(lds + (bufoff) + ldsw + _i * 8192), 16, 0, 0); } while (0)
#define PG8_LDA(dst, b, h) do { _Pragma("unroll") for (int m = 0; m < 4; ++m) _Pragma("unroll") for (int k = 0; k < 2; ++k) dst[m][k] = *(const PG8_LAS bf16x8*)(lds + PG8_SA(b, h) + aoff + m * 2048 + k * 1024); } while (0)
#define PG8_LDB(dst, b, h) do { _Pragma("unroll") for (int n = 0; n < 2; ++n) _Pragma("unroll") for (int k = 0; k < 2; ++k) dst[n][k] = *(const PG8_LAS bf16x8*)(lds + PG8_SB(b, h) + boff + n * 2048 + k * 1024); } while (0)
#define PG8_MMA(ai, bj, At, Bt) do { __builtin_amdgcn_s_setprio(1); _Pragma("unroll") for (int m = 0; m < 4; ++m) _Pragma("unroll") for (int n = 0; n < 2; ++n) _Pragma("unroll") for (int k = 0; k < 2; ++k) \
        acc[ai][bj][m][n] = __builtin_amdgcn_mfma_f32_16x16x32_bf16(Bt[n][k], At[m][k], acc[ai][bj][m][n], 0, 0, 0); __builtin_amdgcn_s_setprio(0); } while (0)
#define PG8_WAIT_V(n) asm volatile("s_waitcnt vmcnt(" #n ")" ::: "memory")
#define PG8_WAIT_L(n) asm volatile("s_waitcnt lgkmcnt(" #n ")" ::: "memory")
#define PG8_BAR __builtin_amdgcn_s_barrier()
#define PG8_SCHED __builtin_amdgcn_sched_barrier(0)
    Unit cur, nxt; int ui = 0;
    if (!S.next(0, cur)) return;
    f32x4 acc[2][2][4][2];
#pragma unroll
    for (int a = 0; a < 2; ++a)
#pragma unroll
        for (int b = 0; b < 2; ++b)
#pragma unroll
            for (int m = 0; m < 4; ++m)
#pragma unroll
                for (int n = 0; n < 2; ++n) acc[a][b][m][n] = (f32x4){0.f, 0.f, 0.f, 0.f};
    bf16x8 At[4][2], B0[2][2], B1[2][2];
    const char* cA = cur.a; const char* cB = cur.b; long cJ = cur.bjump;
    S.a_ready(cur);
    if constexpr (SP2) {
        PG8_STAGE(PG8_SB(0, 0), cB, voffB); PG8_STAGE(PG8_SB(0, 1), cB + hstepB, voffB); PG8_STAGE(PG8_SA(0, 0), cA, voffA); PG8_STAGE(PG8_SA(0, 1), cA + hstepA, voffA);
        if (wr == 1) PG8_BAR;
        PG8_WAIT_V(2); PG8_BAR;
        PG8_STAGE(PG8_SB(1, 0), cB + kstep, voffB); PG8_STAGE(PG8_SA(1, 0), cA + kstep, voffA); PG8_STAGE(PG8_SB(1, 1), cB + hstepB + kstep, voffB);
        PG8_WAIT_V(6); PG8_BAR;
    } else {
        PG8_STAGE(PG8_SB(0, 0), cB, voffB); PG8_STAGE(PG8_SA(0, 0), cA, voffA); PG8_STAGE(PG8_SB(0, 1), cB + hstepB, voffB); PG8_STAGE(PG8_SA(0, 1), cA + hstepA, voffA);
        if (wr == 1) PG8_BAR;
        PG8_WAIT_V(4); PG8_BAR;
        PG8_STAGE(PG8_SB(1, 0), cB + kstep, voffB); PG8_STAGE(PG8_SA(1, 0), cA + kstep, voffA); PG8_STAGE(PG8_SB(1, 1), cB + hstepB + kstep, voffB);
        PG8_WAIT_V(6); PG8_BAR;
    }
    for (;;) {
        const bool has_next = S.next(ui + 1, nxt);
        const char* nA = has_next ? nxt.a : cA; const char* nB = has_next ? nxt.b : cB;
#pragma unroll 1
        for (int t = 0; t < nt; t += 2) {
            const bool last = (t == nt - 2);
            const char* a1 = cA + (size_t)(t + 1) * kstep;
            const char* a2 = last ? nA : cA + (size_t)(t + 2) * kstep; const char* b2 = last ? nB : cB + (size_t)(t + 2) * kstep + ((t + 2) >= g.ksplit ? cJ : 0L);
            const char* a3 = a2 + kstep; const char* b3 = b2 + kstep;
            if (last && has_next) S.a_ready(nxt);
            if constexpr (SP2) {
            PG8_LDB(B0, 0, 0); PG8_LDB(B1, 0, 1); PG8_SCHED; PG8_LDA(At, 0, 0); PG8_STAGE(PG8_SA(1, 1), a1 + hstepA, voffA);
            PG8_WAIT_V(8); PG8_WAIT_L(0); PG8_BAR; PG8_MMA(0, 0, At, B0); PG8_MMA(0, 1, At, B1); PG8_BAR; PG8_SCHED;
            PG8_LDA(At, 0, 1); PG8_STAGE(PG8_SB(0, 0), b2, voffB); PG8_STAGE(PG8_SB(0, 1), b2 + hstepB, voffB); PG8_STAGE(PG8_SA(0, 0), a2, voffA);
            PG8_WAIT_V(8); PG8_WAIT_L(0); PG8_BAR; PG8_MMA(1, 0, At, B0); PG8_MMA(1, 1, At, B1); PG8_BAR; PG8_SCHED;
            PG8_LDB(B0, 1, 0); PG8_LDB(B1, 1, 1); PG8_SCHED; PG8_LDA(At, 1, 0); PG8_STAGE(PG8_SA(0, 1), a2 + hstepA, voffA);
            PG8_WAIT_V(8); PG8_WAIT_L(0); PG8_BAR; PG8_MMA(0, 0, At, B0); PG8_MMA(0, 1, At, B1); PG8_BAR; PG8_SCHED;
            PG8_LDA(At, 1, 1); PG8_STAGE(PG8_SB(1, 0), b3, voffB); PG8_STAGE(PG8_SB(1, 1), b3 + hstepB, voffB); PG8_STAGE(PG8_SA(1, 0), a3, voffA);
            PG8_WAIT_V(8); PG8_WAIT_L(0); PG8_BAR; PG8_MMA(1, 0, At, B0); PG8_MMA(1, 1, At, B1); PG8_BAR; PG8_SCHED;
            } else {
            PG8_LDB(B0, 0, 0); PG8_SCHED; PG8_LDA(At, 0, 0); PG8_STAGE(PG8_SA(1, 1), a1 + hstepA, voffA);
            PG8_WAIT_L(8); PG8_BAR; PG8_WAIT_L(0); PG8_MMA(0, 0, At, B0); PG8_BAR; PG8_SCHED;
            PG8_LDB(B1, 0, 1); PG8_STAGE(PG8_SB(0, 0), b2, voffB);
            PG8_BAR; PG8_WAIT_L(0); PG8_MMA(0, 1, At, B1); PG8_BAR;
            PG8_LDA(At, 0, 1); PG8_STAGE(PG8_SA(0, 0), a2, voffA);
            PG8_BAR; PG8_WAIT_L(0); PG8_MMA(1, 0, At, B0); PG8_BAR; PG8_SCHED;
            PG8_STAGE(PG8_SB(0, 1), b2 + hstepB, voffB);
            PG8_WAIT_V(6); PG8_BAR; PG8_MMA(1, 1, At, B1); PG8_BAR;
            PG8_LDB(B0, 1, 0); PG8_SCHED; PG8_LDA(At, 1, 0); PG8_STAGE(PG8_SA(0, 1), a2 + hstepA, voffA);
            PG8_WAIT_L(8); PG8_BAR; PG8_WAIT_L(0); PG8_MMA(0, 0, At, B0); PG8_BAR; PG8_SCHED;
            PG8_LDB(B1, 1, 1); PG8_STAGE(PG8_SB(1, 0), b3, voffB);
            PG8_BAR; PG8_WAIT_L(0); PG8_MMA(0, 1, At, B1); PG8_BAR;
            PG8_LDA(At, 1, 1); PG8_STAGE(PG8_SA(1, 0), a3, voffA);
            PG8_BAR; PG8_WAIT_L(0); PG8_MMA(1, 0, At, B0); PG8_BAR; PG8_SCHED;
            PG8_STAGE(PG8_SB(1, 1), b3 + hstepB, voffB);
            PG8_WAIT_V(6); PG8_BAR; PG8_MMA(1, 1, At, B1); PG8_BAR;
            }
        }
        if constexpr (ALIGN_EPI) { if (wr == 0) PG8_BAR; }
        if constexpr (!Epi::AFTER_DRAIN) { E(acc, cur, wr, wc, fr, fq); S.done(cur); }
        if (!has_next) break;
#pragma unroll
        for (int a = 0; a < 2; ++a)
#pragma unroll
            for (int b = 0; b < 2; ++b)
#pragma unroll
                for (int m = 0; m < 4; ++m)
#pragma unroll
                    for (int n = 0; n < 2; ++n) acc[a][b][m][n] = (f32x4){0.f, 0.f, 0.f, 0.f};
        cur = nxt; cA = nA; cB = nB; cJ = cur.bjump; ++ui;
        if constexpr (ALIGN_EPI) { if (wr == 1) PG8_BAR; }
    }
    PG8_WAIT_V(0);
    if constexpr (!ALIGN_EPI) { if (wr == 0) PG8_BAR; }
    PG8_BAR;
    if constexpr (Epi::AFTER_DRAIN) { E.fused(acc, cur, wr, wc, fr, fq, lds, wid, lane); S.done(cur); }
#undef PG8_SA
#undef PG8_SB
#undef PG8_STAGE
#undef PG8_LDA
#undef PG8_LDB
#undef PG8_MMA
#undef PG8_WAIT_V
#undef PG8_WAIT_L
#undef PG8_BAR
#undef PG8_SCHED
}
}

constexpr int D = 1024, BATCH = 16, SEQ = 2048, T = BATCH * SEQ;
constexpr int INW = 6984, INWP = 7168;
constexpr int C_QA = 0, C_CKV = 1024, C_QI = 1280, C_KI = 1792, C_WI = 1856, C_RQ = 1864, C_RK = 2376, C_RV = 2888, C_RG = 3912, C_GA = 4936, C_GR = 5960;
constexpr float EPS = 1e-6f;
constexpr int NWAVES = 8;

constexpr size_t MiB = 1u << 20;
constexpr size_t WS_CTL = 0, CTL_ZERO_BYTES = 1 * MiB;
constexpr size_t WS_WIN = 1 * MiB, WS_WKV = 15 * MiB, WS_WATT = 16 * MiB, WS_WRET = 18 * MiB, WS_WOUT = 20 * MiB, WS_W1 = 22 * MiB, WS_WD = 38 * MiB, WS_ACT = 46 * MiB;
constexpr size_t O_QA = 0, O_CKV = 2048, O_QI = 2560, O_KW = 3584, O_RQ = 3840, O_RK = 4864, O_RV = 5888, O_RG = 7936, O_GA = 9984, O_GR = 12032, O_END = 14080;

constexpr int MP_ROWS = 38912;
constexpr size_t MO_APERM = 0, MO_ACT = 80 * MiB, MO_N2 = 120 * MiB, MO_META = 184 * MiB;
constexpr size_t MM_B = 0, MM_P = 131072, MM_CL = 262144, MM_CH = 393216, MM_RS = 524288, MM_PTOK = 655360, MM_PRS = 819200, MM_PCL = 983040, MM_PCH = 1146880, MM_END = 1310720;
constexpr size_t WS_WR = 15 * MiB + 512 * 1024;
constexpr int CW_MOE = 256;
constexpr int RING_OFF = 0, RING_BYTES = 131072, P3_HIST_OFF = 131072, P3_TOT_OFF = 147456, P3_T_OFF = 149504, LDSCTL_OFF = 151552, MISC_OFF = LDSCTL_OFF + 320, LDS_BYTES = 152576;
constexpr int CW_Q3 = 64, CW_Q4 = 128;

#define GAS __attribute__((address_space(1)))
#define LAS __attribute__((address_space(3)))
typedef unsigned short bf16;
typedef unsigned v4u __attribute__((ext_vector_type(4)));
typedef float f32x4 __attribute__((ext_vector_type(4)));
#define LDS_WAIT() asm volatile("s_waitcnt lgkmcnt(0)" ::: "memory")
#define VM_WAIT() asm volatile("s_waitcnt vmcnt(0)" ::: "memory")
__device__ __forceinline__ unsigned f2bf(float f) { unsigned u = __builtin_bit_cast(unsigned, f); return (u + 0x7fffu + ((u >> 16) & 1u)) >> 16; }
__device__ __forceinline__ unsigned pk2(float lo, float hi) { return f2bf(lo) | (f2bf(hi) << 16); }
__device__ __forceinline__ float bf2f(bf16 b) { return __uint_as_float((unsigned)b << 16); }


typedef GAS unsigned gu32;
constexpr int CW_BAR = 4096;
#define XB_TMO      128
#define XB_XCNT(j)  (256  + 64 * (j))
#define XB_XSUB(j)  (1280 + 64 * (j))
#define XB_XGEN(j)  (2304 + 64 * (j))
#define XB_TOP      3328
#define XB_TOPGEN   3392
#define XCD_BAR_WORDS 3456
#define XB_SPIN_CAP (1u << 18)

__device__ __forceinline__ unsigned xb_ld(unsigned* p)              { return __hip_atomic_load(p, __ATOMIC_RELAXED, __HIP_MEMORY_SCOPE_AGENT); }
__device__ __forceinline__ unsigned xb_add(unsigned* p, unsigned v) { return __hip_atomic_fetch_add(p, v, __ATOMIC_RELAXED, __HIP_MEMORY_SCOPE_AGENT); }
__device__ __forceinline__ unsigned xb_xcc_id() { return (unsigned)__builtin_amdgcn_s_getreg((3 << 11) | 20) & 0xFu; }
#define XB_SPIN(cond, bar) do { unsigned _sp = 0; while (cond) { __builtin_amdgcn_s_sleep(1); \
    if ((++_sp & 255u) == 0u) { if (xb_ld(&(bar)[XB_TMO])) break; if (_sp > XB_SPIN_CAP) { atomicAdd(&(bar)[XB_TMO], 1u); break; } } } } while (0)

struct XcdBarrier {
    unsigned* bar; unsigned x;
    volatile LAS unsigned* st;
};

__device__ __forceinline__ XcdBarrier xcd_barrier_post(unsigned* bar, volatile LAS unsigned* st) {
    XcdBarrier b; b.bar = bar; b.x = xb_xcc_id(); b.st = st;
    if (threadIdx.x == 0) (void)xb_add(&bar[XB_XCNT(b.x)], 1u);
    return b;
}
__device__ __forceinline__ void xcd_barrier_complete(unsigned* bar, unsigned x, unsigned& nloc, unsigned& nx) {
    const unsigned G = gridDim.x * gridDim.y * gridDim.z;
    unsigned sum, cnt, mine, sp = 0u;
    for (;;) {
        sum = 0u; cnt = 0u; mine = 0u;
#pragma unroll
        for (unsigned j = 0; j < 16; ++j) { const unsigned c = xb_ld(&bar[XB_XCNT(j)]); sum += c; cnt += (c > 0u) ? 1u : 0u; mine = (j == x) ? c : mine; }
        if (sum == G) break;
        __builtin_amdgcn_s_sleep(1);
        if ((++sp & 255u) == 0u) { if (xb_ld(&bar[XB_TMO])) break; if (sp > XB_SPIN_CAP) { atomicAdd(&bar[XB_TMO], 1u); break; } }
    }
    nloc = mine > 0u ? mine : 1u; nx = cnt > 0u ? cnt : 1u;
}

__device__ __forceinline__ void xcd_barrier(const XcdBarrier& b) {
    asm volatile("s_waitcnt vmcnt(0)" ::: "memory");
    __syncthreads();
    if (threadIdx.x == 0) {
        unsigned* bar = b.bar;
        __builtin_amdgcn_s_waitcnt(0);
        unsigned nloc = b.st[0], nx = b.st[1];
        if (nloc == 0u) { xcd_barrier_complete(bar, b.x, nloc, nx); b.st[0] = nloc; b.st[1] = nx; }
        const unsigned old = xb_add(&bar[XB_XSUB(b.x)], 1u);
        const unsigned gen = old / nloc;
        if (old + 1u == (gen + 1u) * nloc) {
            __builtin_amdgcn_fence(__ATOMIC_RELEASE, "agent");
            asm volatile("s_waitcnt vmcnt(0)" ::: "memory");
            const unsigned og = xb_add(&bar[XB_TOP], 1u);
            const unsigned tg = og / nx;
            if (og + 1u == (tg + 1u) * nx) xb_add(&bar[XB_TOPGEN], 1u);
            else XB_SPIN(xb_ld(&bar[XB_TOPGEN]) == tg, bar);
            __builtin_amdgcn_fence(__ATOMIC_ACQUIRE, "agent");
            xb_add(&bar[XB_XGEN(b.x)], 1u);
            asm volatile("s_waitcnt vmcnt(0)" ::: "memory");
        } else {
            XB_SPIN(xb_ld(&bar[XB_XGEN(b.x)]) == gen, bar);
            __builtin_amdgcn_fence(__ATOMIC_ACQUIRE, "agent");
            asm volatile("s_waitcnt vmcnt(0)" ::: "memory");
        }
    }
    __syncthreads();
}

struct Args { const float* in[20]; float* out; unsigned char* ws; unsigned char* xb; int ph_lo, ph_hi, ntok, tok0; };

struct Frame {
    LAS unsigned char* lds;
    int tid, lane, wave, vcu, G;
    int ntok;
    unsigned char* ws; unsigned char* act;
};

struct EpiProj {
    static constexpr bool PERM = true, AFTER_DRAIN = false;
    unsigned char* act; size_t ntok;
    __device__ __forceinline__ void operator()(const pg8::f32x4 (&acc)[2][2][4][2], const pg8::Unit& u, int wr, int wc, int fr, int fq) const {
        const int pn = u.pn; size_t O; int ld, cb, nbj = 2;
        if (pn < 4) { O = O_QA; ld = 1024; cb = pn * 256; }
        else if (pn == 4) { O = O_CKV; ld = 256; cb = 0; }
        else if (pn < 7) { O = O_QI; ld = 512; cb = (pn - 5) * 256; }
        else if (pn == 7) { O = O_KW; ld = 128; cb = 0; nbj = 1; }
        else if (pn < 10) { O = O_RQ; ld = 512; cb = (pn - 8) * 256; }
        else if (pn < 12) { O = O_RK; ld = 512; cb = (pn - 10) * 256; }
        else { O = O_RV + (size_t)((pn - 12) >> 2) * 2048; ld = 1024; cb = ((pn - 12) & 3) * 256; }
        pg8::bf16_t* base = (pg8::bf16_t*)(act + ntok * O);
        const int row0 = u.pm * pg8::BM + wr * 64 + fr, col0 = cb + wc * 32 + 8 * fq;
#pragma unroll
        for (int ai = 0; ai < 2; ++ai)
#pragma unroll
            for (int m = 0; m < 4; ++m) { pg8::bf16_t* rowp = base + (size_t)(row0 + ai * pg8::HALF + m * 16) * ld + col0;
#pragma unroll
                for (int bj = 0; bj < 2; ++bj) if (bj < nbj) { const pg8::f32x4 v0 = acc[ai][bj][m][0], v1 = acc[ai][bj][m][1];
                    pg8::u32x4 w; w.x = pg8::cvt_pk_bf16(v0[0], v0[1]); w.y = pg8::cvt_pk_bf16(v0[2], v0[3]); w.z = pg8::cvt_pk_bf16(v1[0], v1[1]); w.w = pg8::cvt_pk_bf16(v1[2], v1[3]);
                    *(pg8::u32x4*)(rowp + bj * pg8::HALF) = w; } }
    }
};


__device__ __forceinline__ float sigm(float x) { return 1.f / (1.f + __expf(-x)); }
struct EpiGateA {
    static constexpr bool PERM = true, AFTER_DRAIN = false;
    pg8::bf16_t* GA;
    __device__ __forceinline__ void operator()(const pg8::f32x4 (&acc)[2][2][4][2], const pg8::Unit& u, int wr, int wc, int fr, int fq) const {
        const int row0 = u.pm * pg8::BM + wr * 64 + fr, col0 = u.pn * pg8::BM + wc * 32 + 8 * fq;
#pragma unroll
        for (int ai = 0; ai < 2; ++ai)
#pragma unroll
            for (int m = 0; m < 4; ++m) { pg8::bf16_t* rowp = GA + (size_t)(row0 + ai * pg8::HALF + m * 16) * 1024 + col0;
#pragma unroll
                for (int bj = 0; bj < 2; ++bj) { const pg8::u32x4 g = *(const pg8::u32x4*)(rowp + bj * pg8::HALF); const pg8::f32x4 v0 = acc[ai][bj][m][0], v1 = acc[ai][bj][m][1];
                    pg8::u32x4 w; w.x = pg8::cvt_pk_bf16(sigm(pg8::bf_lo(g.x)) * v0[0], sigm(pg8::bf_hi(g.x)) * v0[1]); w.y = pg8::cvt_pk_bf16(sigm(pg8::bf_lo(g.y)) * v0[2], sigm(pg8::bf_hi(g.y)) * v0[3]);
                    w.z = pg8::cvt_pk_bf16(sigm(pg8::bf_lo(g.z)) * v1[0], sigm(pg8::bf_hi(g.z)) * v1[1]); w.w = pg8::cvt_pk_bf16(sigm(pg8::bf_lo(g.w)) * v1[2], sigm(pg8::bf_hi(g.w)) * v1[3]);
                    *(pg8::u32x4*)(rowp + bj * pg8::HALF) = w; } }
    }
};
struct EpiGateB {
    static constexpr bool PERM = true, AFTER_DRAIN = false;
    pg8::bf16_t* GA; const pg8::bf16_t* GR;
    __device__ __forceinline__ void operator()(const pg8::f32x4 (&acc)[2][2][4][2], const pg8::Unit& u, int wr, int wc, int fr, int fq) const {
        const int row0 = u.pm * pg8::BM + wr * 64 + fr, col0 = u.pn * pg8::BM + wc * 32 + 8 * fq;
#pragma unroll
        for (int ai = 0; ai < 2; ++ai)
#pragma unroll
            for (int m = 0; m < 4; ++m) { const size_t ro = (size_t)(row0 + ai * pg8::HALF + m * 16) * 1024 + col0;
#pragma unroll
                for (int bj = 0; bj < 2; ++bj) { const pg8::u32x4 t = *(const pg8::u32x4*)(GA + ro + bj * pg8::HALF), g = *(const pg8::u32x4*)(GR + ro + bj * pg8::HALF); const pg8::f32x4 v0 = acc[ai][bj][m][0], v1 = acc[ai][bj][m][1];
                    pg8::u32x4 w; w.x = pg8::cvt_pk_bf16(pg8::bf_lo(t.x) + sigm(pg8::bf_lo(g.x)) * v0[0], pg8::bf_hi(t.x) + sigm(pg8::bf_hi(g.x)) * v0[1]); w.y = pg8::cvt_pk_bf16(pg8::bf_lo(t.y) + sigm(pg8::bf_lo(g.y)) * v0[2], pg8::bf_hi(t.y) + sigm(pg8::bf_hi(g.y)) * v0[3]);
                    w.z = pg8::cvt_pk_bf16(pg8::bf_lo(t.z) + sigm(pg8::bf_lo(g.z)) * v1[0], pg8::bf_hi(t.z) + sigm(pg8::bf_hi(g.z)) * v1[1]); w.w = pg8::cvt_pk_bf16(pg8::bf_lo(t.w) + sigm(pg8::bf_lo(g.w)) * v1[2], pg8::bf_hi(t.w) + sigm(pg8::bf_hi(g.w)) * v1[3]);
                    *(pg8::u32x4*)(GA + ro + bj * pg8::HALF) = w; } }
    }
};
struct EpiResid {
    static constexpr bool PERM = false, AFTER_DRAIN = false;
    const float* x; float* out;
    __device__ __forceinline__ void operator()(const pg8::f32x4 (&acc)[2][2][4][2], const pg8::Unit& u, int wr, int wc, int fr, int fq) const {
        const int row0 = u.pm * pg8::BM + wr * 64 + fr, col0 = u.pn * pg8::BM + wc * 32 + 4 * fq;
#pragma unroll
        for (int ai = 0; ai < 2; ++ai)
#pragma unroll
            for (int m = 0; m < 4; ++m) { const size_t ro = (size_t)(row0 + ai * pg8::HALF + m * 16) * 1024 + col0;
#pragma unroll
                for (int bj = 0; bj < 2; ++bj)
#pragma unroll
                    for (int n = 0; n < 2; ++n) { const size_t o = ro + bj * pg8::HALF + n * 16; *(pg8::f32x4*)(out + o) = *(const pg8::f32x4*)(x + o) + acc[ai][bj][m][n]; } }
    }
};

__device__ __forceinline__ float wave_sum(float v) {
#pragma unroll
    for (int o = 1; o < 64; o <<= 1) v += __shfl_xor(v, o);
    return v;
}
__device__ __forceinline__ void p0_transpose_item(const float* W, int K, int N, bf16* WT, int map, int row_off, int par, const float* gk, LAS float* scr, int item, int lane) {
    const int nblk = (N + 31) / 32, kb = item / nblk, nb = item % nblk, k0 = 64 * kb, n0 = 32 * nb;
    const int nn = n0 + (lane & 31);
#pragma unroll 8
    for (int i = 0; i < 32; ++i) { const int kk = 2 * i + (lane >> 5); float v = (nn < N) ? W[(size_t)(k0 + kk) * N + nn] : 0.f; if (gk) v *= gk[k0 + kk]; scr[kk * 33 + (lane & 31)] = v; }
    LDS_WAIT(); asm volatile("" ::: "memory");
    const int c = lane & 7;
#pragma unroll
    for (int j = 0; j < 4; ++j) { const int nl = (lane >> 3) + 8 * j, n = n0 + nl; const LAS float* s = scr + (8 * c) * 33 + nl;
        v4u o; o.x = pk2(s[0 * 33], s[1 * 33]); o.y = pk2(s[2 * 33], s[3 * 33]); o.z = pk2(s[4 * 33], s[5 * 33]); o.w = pk2(s[6 * 33], s[7 * 33]);
        if (n < N) { const int row = (map == 0) ? row_off + n : (map == 1) ? (n < 1864 ? n : n + 184) : row_off + 2 * n + par;
            *(GAS v4u*)(WT + (size_t)row * K + k0 + 8 * c) = o; } }
    LDS_WAIT(); asm volatile("" ::: "memory");
}
__device__ __forceinline__ void p0_prologue(Frame& F, const Args& a) {
    LAS float* scr = (LAS float*)(F.lds + RING_OFF + F.wave * 16384);
    const int gw = F.vcu * NWAVES + F.wave, NGW = F.G * NWAVES;
    bf16* Win_t = (bf16*)(F.ws + WS_WIN); bf16* Wkv_t = (bf16*)(F.ws + WS_WKV); bf16* Watt_t = (bf16*)(F.ws + WS_WATT); bf16* Wret_t = (bf16*)(F.ws + WS_WRET);
    bf16* Wout_t = (bf16*)(F.ws + WS_WOUT); bf16* W1_t = (bf16*)(F.ws + WS_W1); bf16* Wd_t = (bf16*)(F.ws + WS_WD);
    constexpr int I_IN = 16 * 219, I_KV = 4 * 8, I_SQ = 16 * 32, I_GU = 16 * 8  , I_DN = 4 * 32  ;
    constexpr int NITEMS = I_IN + I_KV + 3 * I_SQ + 16 * (2 * I_GU + I_DN);
    for (int it = gw; it < NITEMS; it += NGW) {
        int r = it;
        if (r < I_IN) { p0_transpose_item(a.in[2], 1024, INW, Win_t, 1, 0, 0, a.in[1], scr, r, F.lane); continue; } r -= I_IN;
        if (r < I_KV) { p0_transpose_item(a.in[4], 256, 256, Wkv_t, 0, 0, 0, a.in[3], scr, r, F.lane); continue; } r -= I_KV;
        if (r < I_SQ) { p0_transpose_item(a.in[9], 1024, 1024, Watt_t, 0, 0, 0, nullptr, scr, r, F.lane); continue; } r -= I_SQ;
        if (r < I_SQ) { p0_transpose_item(a.in[10], 1024, 1024, Wret_t, 0, 0, 0, nullptr, scr, r, F.lane); continue; } r -= I_SQ;
        if (r < I_SQ) { p0_transpose_item(a.in[11], 1024, 1024, Wout_t, 0, 0, 0, nullptr, scr, r, F.lane); continue; } r -= I_SQ;
        const int e = r / (2 * I_GU + I_DN), q = r % (2 * I_GU + I_DN);
        if (q < I_GU) p0_transpose_item(a.in[17] + (size_t)e * 1024 * 256, 1024, 256, W1_t, 2, e * 512, 0, nullptr, scr, q, F.lane);
        else if (q < 2 * I_GU) p0_transpose_item(a.in[18] + (size_t)e * 1024 * 256, 1024, 256, W1_t, 2, e * 512, 1, nullptr, scr, q - I_GU, F.lane);
        else p0_transpose_item(a.in[19] + (size_t)e * 256 * 1024, 256, 1024, Wd_t + (size_t)e * 1024 * 256, 0, 0, 0, nullptr, scr, q - 2 * I_GU, F.lane);
    }
    { const int gt = (F.vcu * NWAVES + F.wave) * 64 + F.lane, NGT = F.G * NWAVES * 64; GAS v4u* z = (GAS v4u*)(Win_t + (size_t)1864 * 1024);
      for (int i = gt; i < 184 * 1024 * 2 / 16; i += NGT) z[i] = (v4u){0u, 0u, 0u, 0u}; }
    { const int gt = (F.vcu * NWAVES + F.wave) * 64 + F.lane, NGT = F.G * NWAVES * 64; bf16* Wh = (bf16*)(F.ws + WS_WR); bf16* Wl = Wh + 32 * 1024;
      for (int i = gt; i < 32 * 1024; i += NGT) { const int n = i >> 10, k = i & 1023; const float wv = n < 4 ? a.in[13][k * 4 + n] : (n < 20 ? a.in[15][k * 16 + (n - 4)] : 0.f);
        const unsigned hb = f2bf(wv); const float hf = __uint_as_float(hb << 16); Wh[i] = (bf16)hb; Wl[i] = (bf16)f2bf(wv - hf); } }
    const float* x = a.in[0] + (size_t)a.tok0 * D;
    for (int m = gw; m < F.ntok; m += NGW) {
        const GAS f32x4* xr = (const GAS f32x4*)(x + (size_t)m * D) + F.lane;
        f32x4 v[4]; float s = 0.f;
#pragma unroll
        for (int j = 0; j < 4; ++j) { v[j] = xr[64 * j]; s += (v[j].x * v[j].x + v[j].y * v[j].y) + (v[j].z * v[j].z + v[j].w * v[j].w); }
        const float rstd = 1.f / sqrtf(wave_sum(s) * (1.f / D) + EPS);
        GAS unsigned long long* o8 = (GAS unsigned long long*)(a.xb + (size_t)m * D * 2) + F.lane;
#pragma unroll
        for (int j = 0; j < 4; ++j) o8[64 * j] = (unsigned long long)pk2(v[j].x * rstd, v[j].y * rstd) | ((unsigned long long)pk2(v[j].z * rstd, v[j].w * rstd) << 32);
    }
}


constexpr size_t AUX_KP = 0, AUX_VV = 256, AUX_KIN = 512, AUX_MASK = 640, AUX_END = 896;
typedef short bf16x8_t __attribute__((ext_vector_type(8)));
typedef float f32x16 __attribute__((ext_vector_type(16)));
__device__ __forceinline__ int crow(int r, int hi) { return (r & 3) + 8 * (r >> 2) + 4 * hi; }
__device__ __forceinline__ float xhalf_sum(float v) { auto rr = __builtin_amdgcn_permlane32_swap(__float_as_uint(v), __float_as_uint(v), false, false); return __uint_as_float(rr[0]) + __uint_as_float(rr[1]); }
__device__ __forceinline__ float sumsq8(bf16x8_t v) { float s = 0.f;
#pragma unroll
    for (int j = 0; j < 8; ++j) { const float f = __uint_as_float((unsigned)(unsigned short)v[j] << 16); s += f * f; } return s; }
__device__ __forceinline__ void p2_post(Frame& F, const Args& a) {
    const int gw = F.vcu * NWAVES + F.wave, NGW = F.G * NWAVES, lane = F.lane, r32 = lane & 31, hi = lane >> 5;
    const size_t nt_ = (size_t)F.ntok;
    const bf16* CKV = (const bf16*)(F.act + nt_ * O_CKV); const bf16* KW = (const bf16*)(F.act + nt_ * O_KW);
    const bf16* Wkv_t = (const bf16*)(F.ws + WS_WKV);
    unsigned char* aux = a.xb + nt_ * 2048;
    bf16* KP = (bf16*)(aux + nt_ * AUX_KP); bf16* VV = (bf16*)(aux + nt_ * AUX_VV); bf16* KIN = (bf16*)(aux + nt_ * AUX_KIN);
    const float* g_q = a.in[5]; const float* g_k = a.in[6]; const float* g_ki = a.in[7];
    const int ntask = 2 * (F.ntok / 32);
    for (int task = gw; task < ntask; task += NGW) {
        const int kind = task & 1, t0 = (task >> 1) * 32;
        const bf16* crowp = CKV + (size_t)(t0 + r32) * 256 + hi * 8;
        bf16x8_t bfr[16]; float ss = 0.f;
#pragma unroll
        for (int kk = 0; kk < 16; ++kk) { bfr[kk] = *(const bf16x8_t*)(crowp + kk * 16); ss += sumsq8(bfr[kk]); }
        ss = xhalf_sum(ss);
        const float rstd = rsqrtf(ss * (1.f / 256.f) + EPS);
        f32x16 acc[4];
#pragma unroll
        for (int nt = 0; nt < 4; ++nt) { acc[nt] = f32x16{};
            const bf16* wrow = Wkv_t + (size_t)(kind * 128 + nt * 32 + r32) * 256 + hi * 8;
#pragma unroll
            for (int kk = 0; kk < 16; ++kk) { const bf16x8_t af = *(const bf16x8_t*)(wrow + kk * 16); acc[nt] = __builtin_amdgcn_mfma_f32_32x32x16_bf16(af, bfr[kk], acc[nt], 0, 0, 0); } }
        float sc = rstd;
        if (kind == 0) { float sk = 0.f;
#pragma unroll
            for (int nt = 0; nt < 4; ++nt)
#pragma unroll
                for (int r = 0; r < 16; ++r) { const float v = acc[nt][r] * rstd; sk += v * v; }
            sk = xhalf_sum(sk);
            sc = rstd * rsqrtf(sk * (1.f / 128.f) + EPS) * (0.08838834764831845f * 1.4426950408889634f); }
        bf16* orow = (kind == 0 ? KP : VV) + (size_t)(t0 + r32) * 128;
#pragma unroll
        for (int nt = 0; nt < 4; ++nt)
#pragma unroll
            for (int g = 0; g < 4; ++g) { const int ch = nt * 32 + 8 * g + 4 * hi; float v[4];
#pragma unroll
                for (int j = 0; j < 4; ++j) { v[j] = acc[nt][4 * g + j] * sc; if (kind == 0) v[j] *= g_k[ch + j] * g_q[ch + j]; }
                *(unsigned long long*)(orow + ch) = (unsigned long long)pk2(v[0], v[1]) | ((unsigned long long)pk2(v[2], v[3]) << 32); }
        if (kind == 0) {
            const bf16* kr = KW + (size_t)(t0 + r32) * 128 + hi * 32; bf16x8_t kv4[4]; float s2 = 0.f;
#pragma unroll
            for (int j = 0; j < 4; ++j) { kv4[j] = *(const bf16x8_t*)(kr + 8 * j); s2 += sumsq8(kv4[j]); }
            s2 = xhalf_sum(s2);
            const float rk = rsqrtf(s2 * (1.f / 64.f) + EPS);
            bf16* ko = KIN + (size_t)(t0 + r32) * 64 + hi * 32;
#pragma unroll
            for (int j = 0; j < 4; ++j) { float f[8];
#pragma unroll
                for (int e = 0; e < 8; ++e) f[e] = __uint_as_float((unsigned)(unsigned short)kv4[j][e] << 16) * rk * g_ki[hi * 32 + 8 * j + e];
                v4u o; o.x = pk2(f[0], f[1]); o.y = pk2(f[2], f[3]); o.z = pk2(f[4], f[5]); o.w = pk2(f[6], f[7]);
                *(v4u*)(ko + 8 * j) = o; }
        }
    }
}


typedef float f32x4_t __attribute__((ext_vector_type(4)));
__device__ __forceinline__ unsigned key15_of(float s) { const unsigned short hb = __builtin_bit_cast(unsigned short, (_Float16)s); const unsigned u = (hb & 0x8000u) ? (~(unsigned)hb & 0xffffu) : ((unsigned)hb | 0x8000u); return u >> 1; }
__device__ __forceinline__ unsigned sad4(unsigned x) { return __builtin_amdgcn_sad_u8(x, 0u, 0u); }
__device__ __forceinline__ void p3_merge(LAS unsigned* hist, LAS unsigned short* tot, int w, int g, int q, int& need, int& bsel) {
    __syncthreads();
    const int o = 4 * w + g; unsigned c = 0;
#pragma unroll
    for (int p = 0; p < 32; ++p) { const int tidp = (p >> 2) * 64 + (p & 3) * 16 + q; c += (hist[(o >> 2) * 512 + tidp] >> (8 * (o & 3))) & 0xffu; }
    tot[q * 32 + o] = (unsigned short)c;
    __syncthreads();
    v4u tv[4];
#pragma unroll
    for (int j = 0; j < 4; ++j) tv[j] = *(const LAS v4u*)((const LAS unsigned char*)tot + q * 64 + j * 16);
    int cum = 0, bs = 0, ab = 0; bool found = false;
#pragma unroll
    for (int bin = 31; bin >= 0; --bin) { const unsigned wd = tv[bin >> 3][(bin >> 1) & 3]; const int cc = (int)((bin & 1) ? (wd >> 16) : (wd & 0xffffu));
        if (!found && cum + cc >= need) { bs = bin; ab = cum; found = true; } cum += cc; }
    bsel = bs; need -= ab;
}
__device__ __forceinline__ void p3_index(Frame& F, const Args& a) {
    const int tid = F.tid, lane = F.lane, w = F.wave, q = lane & 15, g = lane >> 4;
    LAS unsigned* keys = (LAS unsigned*)(F.lds + RING_OFF);
    LAS unsigned* hist = (LAS unsigned*)(F.lds + P3_HIST_OFF);
    LAS unsigned short* tot = (LAS unsigned short*)(F.lds + P3_TOT_OFF);
    LAS unsigned char* Tt = (LAS unsigned char*)(F.lds + P3_T_OFF);
    volatile LAS unsigned* MISC = (volatile LAS unsigned*)(F.lds + MISC_OFF);
    const size_t nt_ = (size_t)F.ntok;
    const bf16* QI = (const bf16*)(F.act + nt_ * O_QI); const bf16* KW = (const bf16*)(F.act + nt_ * O_KW);
    unsigned char* aux = a.xb + nt_ * 2048;
    const bf16* KIN = (const bf16*)(aux + nt_ * AUX_KIN); unsigned* MASK = (unsigned*)(aux + nt_ * AUX_MASK);
    unsigned* qctr = (unsigned*)(F.ws + WS_CTL) + CW_Q3;
    const int nb = F.ntok / SEQ, nitems = nb * 128;
    for (;;) {
        __syncthreads(); if (tid == 0) MISC[0] = atomicAdd(qctr, 1u); __syncthreads();
        const int it = (int)MISC[0]; if (it >= nitems) break;
        const int qg = 127 - it / nb, b = it % nb, q0 = qg * 16, qme = q0 + q; const size_t tokq = (size_t)b * SEQ + qme;
        unsigned* Mb = MASK + (size_t)b * 64 * 2048;
        const int kb_hi = ((qg >> 3) + 1) << 2, nkb = (qg >> 1) + 1;
        if (qg < 16) {
            if (tid < kb_hi * 16) { const int kb = tid >> 4, qq = q0 + (tid & 15), nbits = qq - kb * 32 + 1; Mb[kb * 2048 + qq] = nbits >= 32 ? 0xffffffffu : (nbits <= 0 ? 0u : ((1u << nbits) - 1u)); }
            continue;
        }
        float wq[8];
        { const v4u wv = *(const v4u*)(KW + tokq * 128 + 64); const float c = 0.35355339059327373f * 0.125f;
          wq[0] = pg8::bf_lo(wv.x) * c; wq[1] = pg8::bf_hi(wv.x) * c; wq[2] = pg8::bf_lo(wv.y) * c; wq[3] = pg8::bf_hi(wv.y) * c; wq[4] = pg8::bf_lo(wv.z) * c; wq[5] = pg8::bf_hi(wv.z) * c; wq[6] = pg8::bf_lo(wv.w) * c; wq[7] = pg8::bf_hi(wv.w) * c; }
        bf16x8_t qfr[8][2], qlin[2];
#pragma unroll
        for (int h = 0; h < 8; ++h)
#pragma unroll
            for (int ks = 0; ks < 2; ++ks) qfr[h][ks] = *(const bf16x8_t*)(QI + tokq * 512 + h * 64 + ks * 32 + g * 8);
#pragma unroll
        for (int ks = 0; ks < 2; ++ks) { float f[8];
#pragma unroll
            for (int j = 0; j < 8; ++j) { float s = 0.f;
#pragma unroll
                for (int h = 0; h < 8; ++h) s += wq[h] * __uint_as_float((unsigned)(unsigned short)qfr[h][ks][j] << 16);
                f[j] = s; }
            v4u o; o.x = pk2(f[0], f[1]); o.y = pk2(f[2], f[3]); o.z = pk2(f[4], f[5]); o.w = pk2(f[6], f[7]); qlin[ks] = __builtin_bit_cast(bf16x8_t, o); }
#pragma unroll
        for (int i = 0; i < 8; ++i) hist[i * 512 + tid] = 0u;
        for (int s = 0, kb = w; kb < nkb; ++s, kb += 8) {
#pragma unroll
            for (int t = 0; t < 2; ++t) {
                bf16x8_t afr[2];
#pragma unroll
                for (int ks = 0; ks < 2; ++ks) afr[ks] = *(const bf16x8_t*)(KIN + ((size_t)b * SEQ + kb * 32 + t * 16 + q) * 64 + ks * 32 + g * 8);
                f32x4_t sacc = f32x4_t{};
#pragma unroll
                for (int ks = 0; ks < 2; ++ks) sacc = __builtin_amdgcn_mfma_f32_16x16x32_bf16(afr[ks], qlin[ks], sacc, 0, 0, 0);
#pragma unroll
                for (int h = 0; h < 8; ++h) { f32x4_t d = f32x4_t{};
#pragma unroll
                    for (int ks = 0; ks < 2; ++ks) d = __builtin_amdgcn_mfma_f32_16x16x32_bf16(afr[ks], qfr[h][ks], d, 0, 0, 0);
#pragma unroll
                    for (int r = 0; r < 4; ++r) sacc[r] = fmaf(fabsf(d[r]), wq[h], sacc[r]); }
#pragma unroll
                for (int i = 0; i < 2; ++i) { unsigned k2[2];
#pragma unroll
                    for (int e = 0; e < 2; ++e) { const int r = 2 * i + e; unsigned k = key15_of(sacc[r]); if (kb * 32 + t * 16 + 4 * g + r > qme) k = 0u; k2[e] = k;
                        const unsigned dg = k >> 10; (void)__hip_atomic_fetch_add((LAS unsigned*)&hist[(dg >> 2) * 512 + tid], 1u << ((dg & 3u) * 8u), __ATOMIC_RELAXED, __HIP_MEMORY_SCOPE_WORKGROUP); }
                    keys[(s * 4 + t * 2 + i) * 512 + tid] = k2[0] | (k2[1] << 16); }
            }
        }
        int need = 256, bsel;
        p3_merge(hist, tot, w, g, q, need, bsel);
        unsigned prefix = (unsigned)bsel;
#pragma unroll
        for (int pass = 0; pass < 2; ++pass) {
            const int sh_hi = pass == 0 ? 10 : 5, sh = pass == 0 ? 5 : 0;
#pragma unroll
            for (int i = 0; i < 8; ++i) hist[i * 512 + tid] = 0u;
            for (int s = 0, kb = w; kb < nkb; ++s, kb += 8)
#pragma unroll
                for (int i = 0; i < 4; ++i) { const unsigned d2 = keys[(s * 4 + i) * 512 + tid];
#pragma unroll
                    for (int e = 0; e < 2; ++e) { const unsigned k = e ? (d2 >> 16) : (d2 & 0xffffu);
                        if ((k >> sh_hi) == prefix) { const unsigned dg = (k >> sh) & 31u; (void)__hip_atomic_fetch_add((LAS unsigned*)&hist[(dg >> 2) * 512 + tid], 1u << ((dg & 3u) * 8u), __ATOMIC_RELAXED, __HIP_MEMORY_SCOPE_WORKGROUP); } } }
            p3_merge(hist, tot, w, g, q, need, bsel);
            prefix = (prefix << 5) | (unsigned)bsel;
        }
        const unsigned tau = prefix; const int need_eq = need;
        unsigned gtw[8], eqw[8];
#pragma unroll
        for (int s = 0; s < 8; ++s) { const int kb = w + 8 * s; gtw[s] = 0u; eqw[s] = 0u;
            if (kb < nkb) { unsigned gg = 0u, qq = 0u;
#pragma unroll
                for (int i = 0; i < 4; ++i) { const unsigned d2 = keys[(s * 4 + i) * 512 + tid];
#pragma unroll
                    for (int e = 0; e < 2; ++e) { const unsigned k = e ? (d2 >> 16) : (d2 & 0xffffu); const int bit = (i >> 1) * 16 + 4 * g + (i & 1) * 2 + e;
                        gg |= (k > tau ? 1u : 0u) << bit; qq |= (k == tau ? 1u : 0u) << bit; } }
                gg |= (unsigned)__shfl_xor((int)gg, 16); gg |= (unsigned)__shfl_xor((int)gg, 32); qq |= (unsigned)__shfl_xor((int)qq, 16); qq |= (unsigned)__shfl_xor((int)qq, 32);
                gtw[s] = gg; eqw[s] = qq;
                if (g == 0) Tt[q * 64 + kb] = (unsigned char)__builtin_popcount(qq); } }
        __syncthreads();
        { unsigned run = 0u;
#pragma unroll
          for (int s = 0; s < 8; ++s) { const int kb = w + 8 * s;
            if (kb < nkb) { const unsigned g0 = *(const LAS unsigned*)(Tt + q * 64 + 8 * s), g1 = *(const LAS unsigned*)(Tt + q * 64 + 8 * s + 4);
                const unsigned m0 = w >= 4 ? g0 : (w == 0 ? 0u : (g0 & ((1u << (8 * w)) - 1u))), m1 = w > 4 ? (g1 & ((1u << (8 * (w - 4))) - 1u)) : 0u;
                const int pre = (int)(run + sad4(m0) + sad4(m1)), m = need_eq - pre, pc = __builtin_popcount(eqw[s]);
                unsigned se = eqw[s];
                if (m < pc) { se = 0u; unsigned x = eqw[s]; for (int i = 0; i < m; ++i) { const unsigned bb = x & (0u - x); se |= bb; x ^= bb; } }
                if (g == 0) Mb[kb * 2048 + qme] = gtw[s] | se;
                run += sad4(g0) + sad4(g1); } } }
        if (tid < (kb_hi - nkb) * 16) Mb[(nkb + (tid >> 4)) * 2048 + q0 + (tid & 15)] = 0u;
    }
}


namespace att {
using bf16x8 = __attribute__((ext_vector_type(8))) short;
using s16x4  = __attribute__((ext_vector_type(4))) short;
using u32x4  = __attribute__((ext_vector_type(4))) unsigned;
constexpr int KVBLK = 64;
constexpr size_t SHM_V = KVBLK * 128 * 2, SHM_K = KVBLK * 128 * 2;
constexpr int OFF_WS = 65536, OFF_MK = 65536 + 2048, OFF_Q = 65536 + 2048 + 8192, QPITCH = 272;
constexpr float THR2 = 11.5f;
#define KSWZ(row, colB) ((row) * 256 + ((colB) ^ (((row) & 7) << 4)))
#define SBAR() __builtin_amdgcn_sched_barrier(0)
__device__ __forceinline__ unsigned cvtpk(float lo, float hi) { unsigned r; asm volatile("v_cvt_pk_bf16_f32 %0, %1, %2" : "=v"(r) : "v"(lo), "v"(hi)); return r; }
__device__ __forceinline__ float msk(float p, unsigned w, int bit) { const int m = __builtin_amdgcn_sbfe((int)w, bit, 1); return __uint_as_float((__float_as_uint(p) & (unsigned)m) | (0xff800000u & ~(unsigned)m)); }
__device__ __forceinline__ void partialSM(f32x16& p0, f32x16& p1, unsigned w0, unsigned w1, float& m_reg, float& mn, float& alpha) {
#pragma unroll
  for (int r = 0; r < 16; ++r) { const int bit = (r & 3) + 8 * (r >> 2); p0[r] = msk(p0[r], w0, bit); p1[r] = msk(p1[r], w1, bit); }
  float pmax = p0[0];
#pragma unroll
  for (int r = 1; r < 16; ++r) pmax = fmaxf(pmax, p0[r]);
#pragma unroll
  for (int r = 0; r < 16; ++r) pmax = fmaxf(pmax, p1[r]);
  { auto rr = __builtin_amdgcn_permlane32_swap(__float_as_uint(pmax), __float_as_uint(pmax), false, false); pmax = fmaxf(__uint_as_float(rr[0]), __uint_as_float(rr[1])); }
  if (__builtin_expect(__all(pmax - m_reg <= THR2), 1)) { mn = m_reg; alpha = 1.f; }
  else { mn = fmaxf(m_reg, pmax); alpha = __builtin_amdgcn_exp2f(m_reg - mn); m_reg = mn; }
#pragma unroll
  for (int r = 0; r < 16; ++r) { p0[r] -= mn; p1[r] -= mn; }
#pragma unroll
  for (int r = 0; r < 16; ++r) p0[r] = __builtin_amdgcn_exp2f(p0[r]);
}
__device__ __forceinline__ void finishSM(f32x16& p0, f32x16& p1, float alpha, float& l_reg, bf16x8& pa0, bf16x8& pa1, bf16x8& pa2, bf16x8& pa3) {
#pragma unroll
  for (int r = 0; r < 16; ++r) p1[r] = __builtin_amdgcn_exp2f(p1[r]);
  float ps = 0;
#pragma unroll
  for (int r = 0; r < 16; ++r) ps += p0[r];
#pragma unroll
  for (int r = 0; r < 16; ++r) ps += p1[r];
  { auto rr = __builtin_amdgcn_permlane32_swap(__float_as_uint(ps), __float_as_uint(ps), false, false); ps = __uint_as_float(rr[0]) + __uint_as_float(rr[1]); }
  l_reg = l_reg * alpha + ps;
#define PK4(P, BASE, OUT) do { unsigned a0 = cvtpk(P[BASE + 0], P[BASE + 1]), a1 = cvtpk(P[BASE + 2], P[BASE + 3]);   \
    unsigned b0 = cvtpk(P[BASE + 4], P[BASE + 5]), b1 = cvtpk(P[BASE + 6], P[BASE + 7]);                              \
    auto r0 = __builtin_amdgcn_permlane32_swap(a0, b0, false, false); auto r1 = __builtin_amdgcn_permlane32_swap(a1, b1, false, false); \
    u32x4 w = {r0[0], r1[0], r0[1], r1[1]}; OUT = *reinterpret_cast<bf16x8*>(&w); } while (0)
  PK4(p0, 0, pa0); PK4(p0, 8, pa1); PK4(p1, 0, pa2); PK4(p1, 8, pa3);
#undef PK4
}
__device__ __forceinline__ void qkt(f32x16& p0, f32x16& p1, const char* Ks, const char* qrow, const float (&bo)[16], float kb0, float kb1, int r32, int hi) {
#pragma unroll
  for (int r = 0; r < 16; ++r) { p0[r] = bo[r] + kb0; p1[r] = bo[r] + kb1; }
#pragma unroll
  for (int d0 = 0; d0 < 8; ++d0) { const int cb = (d0 * 16 + hi * 8) * 2;
    const bf16x8 b0 = *reinterpret_cast<const bf16x8*>(Ks + KSWZ(r32, cb));
    const bf16x8 b1 = *reinterpret_cast<const bf16x8*>(Ks + KSWZ(32 + r32, cb));
    const bf16x8 qf = *reinterpret_cast<const bf16x8*>(qrow + d0 * 32);
    p0 = __builtin_amdgcn_mfma_f32_32x32x16_bf16(b0, qf, p0, 0, 0, 0);
    p1 = __builtin_amdgcn_mfma_f32_32x32x16_bf16(b1, qf, p1, 0, 0, 0); }
}
__device__ __forceinline__ int v_st(int k, int c) { const int kk = (k & ~0xC) | ((k & 4) << 1) | ((k & 8) >> 1); return ((kk >> 3) * 4 + (c >> 5)) * 512 + ((kk & 7) * 32 + (c & 31)) * 2; }
__device__ __forceinline__ int v_rd_base(int lane) { return ((lane & 3) << 3) | (((lane >> 2) & 3) << 6) | (((lane >> 4) & 1) << 5) | (((lane >> 5) & 1) << 8); }
constexpr int v_rd_off(int d0, int ks, int half) { return d0 * 512 + ks * 4096 + half * 2048; }
template <int OFF> __device__ __forceinline__ s16x4 tr_read(int vb) { s16x4 r; asm volatile("ds_read_b64_tr_b16 %0, %1 offset:%2" : "=&v"(r) : "v"(vb), "i"(OFF) : "memory"); return r; }
template <int D0> __device__ __forceinline__ void pv_one(f32x16& od, int vb, bf16x8 pa0, bf16x8 pa1, bf16x8 pa2, bf16x8 pa3) {
  const s16x4 l0 = tr_read<v_rd_off(D0, 0, 0)>(vb), h0 = tr_read<v_rd_off(D0, 0, 1)>(vb), l1 = tr_read<v_rd_off(D0, 1, 0)>(vb), h1 = tr_read<v_rd_off(D0, 1, 1)>(vb);
  const s16x4 l2 = tr_read<v_rd_off(D0, 2, 0)>(vb), h2 = tr_read<v_rd_off(D0, 2, 1)>(vb), l3 = tr_read<v_rd_off(D0, 3, 0)>(vb), h3 = tr_read<v_rd_off(D0, 3, 1)>(vb);
  asm volatile("s_waitcnt lgkmcnt(0)" ::: "memory"); SBAR();
#define PK(L, H) (bf16x8){L[0], L[1], L[2], L[3], H[0], H[1], H[2], H[3]}
  od = __builtin_amdgcn_mfma_f32_32x32x16_bf16(pa0, PK(l0, h0), od, 0, 0, 0);
  od = __builtin_amdgcn_mfma_f32_32x32x16_bf16(pa1, PK(l1, h1), od, 0, 0, 0);
  od = __builtin_amdgcn_mfma_f32_32x32x16_bf16(pa2, PK(l2, h2), od, 0, 0, 0);
  od = __builtin_amdgcn_mfma_f32_32x32x16_bf16(pa3, PK(l3, h3), od, 0, 0, 0);
#undef PK
}
__device__ __forceinline__ void pv_d0(f32x16* o, int vb, bf16x8 pa0, bf16x8 pa1, bf16x8 pa2, bf16x8 pa3) {
  pv_one<0>(o[0], vb, pa0, pa1, pa2, pa3); pv_one<1>(o[1], vb, pa0, pa1, pa2, pa3); pv_one<2>(o[2], vb, pa0, pa1, pa2, pa3); pv_one<3>(o[3], vb, pa0, pa1, pa2, pa3);
}
__device__ __forceinline__ void attn_item(const bf16* __restrict__ Qb, const bf16* __restrict__ Kh, const bf16* __restrict__ Vh, const unsigned* __restrict__ Mq, bf16* __restrict__ Ob, int NT, char* lds) {
  const int tid = threadIdx.x, wid = __builtin_amdgcn_readfirstlane(tid >> 6), lane = tid & 63, r32 = lane & 31, hi = lane >> 5;
  char* V_lds = lds; char* K_lds = lds + 2 * SHM_V;
  float* ws = (float*)(lds + OFF_WS) + wid * 64; float* li_l = ws; float* al_l = ws + 32;
  unsigned* mk = (unsigned*)(lds + OFF_MK);
  for (int i = tid; i < NT * 64; i += 512) mk[i] = Mq[(size_t)(i >> 5) * 2048 + (i & 31)];
  float m_reg = -1e30f, l_reg = 0; f32x16 o[4] = {};
  char* const qrow = lds + OFF_Q + wid * (32 * QPITCH) + r32 * QPITCH + hi * 16;
  { bf16x8 qr[8]; const bf16* Qw = Qb + (size_t)r32 * 1024 + wid * 128 + hi * 8; float ss = 0.f;
#pragma unroll
    for (int d0 = 0; d0 < 8; ++d0) { qr[d0] = *reinterpret_cast<const bf16x8*>(Qw + d0 * 16); ss += sumsq8(qr[d0]); }
    ss = xhalf_sum(ss); const float rq = rsqrtf(ss * (1.f / 128.f) + EPS);
#pragma unroll
    for (int d0 = 0; d0 < 8; ++d0) { float f[8];
#pragma unroll
      for (int j = 0; j < 8; ++j) f[j] = __uint_as_float((unsigned)(unsigned short)qr[d0][j] << 16) * rq;
      u32x4 w = {cvtpk(f[0], f[1]), cvtpk(f[2], f[3]), cvtpk(f[4], f[5]), cvtpk(f[6], f[7])}; *reinterpret_cast<u32x4*>(qrow + d0 * 32) = w; } }
  const float slope2 = __builtin_amdgcn_exp2f(-(float)(wid + 1)) * 1.4426950408889634f;
  float bo[16];
#pragma unroll
  for (int r = 0; r < 16; ++r) bo[r] = __uint_as_float(__builtin_amdgcn_readfirstlane(__float_as_uint(slope2 * (float)((r & 3) + 8 * (r >> 2)))));
  const float hoff = slope2 * (float)(4 * hi);
  const int sr = tid >> 4, sc = (tid & 15) * 8, vst0 = v_st(sr, sc), vst1 = v_st(32 + sr, sc);
  const int vb0 = (int)(uintptr_t)V_lds + v_rd_base(lane);
  constexpr int SDEPTH = 1;
  struct { bf16x8 vs0, vs1, ks0, ks1; } sr_[SDEPTH];
#define SLOAD(i, k0) do { sr_[i].vs0 = *reinterpret_cast<const bf16x8*>(&Vh[(size_t)((k0) + sr) * 128 + sc]); sr_[i].vs1 = *reinterpret_cast<const bf16x8*>(&Vh[(size_t)((k0) + 32 + sr) * 128 + sc]); \
    sr_[i].ks0 = *reinterpret_cast<const bf16x8*>(&Kh[(size_t)((k0) + sr) * 128 + sc]); sr_[i].ks1 = *reinterpret_cast<const bf16x8*>(&Kh[(size_t)((k0) + 32 + sr) * 128 + sc]); } while (0)
#define SWRITE(b, i) do { *(bf16x8*)(V_lds + (b) * SHM_V + vst0) = sr_[i].vs0; *(bf16x8*)(V_lds + (b) * SHM_V + vst1) = sr_[i].vs1; const int kc = sc * 2; \
    *(bf16x8*)(K_lds + (b) * SHM_K + KSWZ(sr, kc)) = sr_[i].ks0; *(bf16x8*)(K_lds + (b) * SHM_K + KSWZ(32 + sr, kc)) = sr_[i].ks1; } while (0)
#define SWAIT() do { if constexpr (SDEPTH == 2) asm volatile("s_waitcnt vmcnt(4)" ::: "memory"); else asm volatile("s_waitcnt vmcnt(0)" ::: "memory"); } while (0)
#define RESC(a) do { if (__any((a) < 1.f)) { if (hi == 0) al_l[r32] = (a); asm volatile("s_waitcnt lgkmcnt(0)" ::: "memory"); \
    _Pragma("unroll") for (int d = 0; d < 4; ++d) _Pragma("unroll") for (int r = 0; r < 16; ++r) o[d][r] *= al_l[crow(r, hi)]; } } while (0)
#define MW(j, e) (mk[(2 * (j) + (e)) * 32 + r32] >> (4 * hi))
#define KB0(j) (slope2 * (float)((j) * 64) + hoff)
#define KB1(j) (slope2 * (float)((j) * 64 + 32) + hoff)
  f32x16 pA0, pA1, pB0, pB1; float mnA, mnB, alA, alB; bf16x8 pa0, pa1, pa2, pa3;
  constexpr int SE = 0, SO = SDEPTH - 1;
  SLOAD(SE, 0); asm volatile("s_waitcnt vmcnt(0)" ::: "memory"); SWRITE(0, SE); __syncthreads();
  qkt(pA0, pA1, K_lds, qrow, bo, KB0(0), KB1(0), r32, hi); partialSM(pA0, pA1, MW(0, 0), MW(0, 1), m_reg, mnA, alA);
  SLOAD(SO, KVBLK); if constexpr (SDEPTH == 2) { if (2 < NT) SLOAD(SE, 2 * KVBLK); }
  SWAIT(); SWRITE(1, SO); __syncthreads();
  for (int j = 1; j + 1 < NT; j += 2) {
    SBAR(); qkt(pB0, pB1, K_lds + SHM_K, qrow, bo, KB0(j), KB1(j), r32, hi);
    finishSM(pA0, pA1, alA, l_reg, pa0, pa1, pa2, pa3); SBAR();
    SLOAD(SO, (j + SDEPTH) * KVBLK); SBAR();
    pv_d0(o, vb0, pa0, pa1, pa2, pa3); partialSM(pB0, pB1, MW(j, 0), MW(j, 1), m_reg, mnB, alB);
    __syncthreads(); SWAIT(); SWRITE(0, SE);
    RESC(alB); __syncthreads();
    SBAR(); qkt(pA0, pA1, K_lds, qrow, bo, KB0(j + 1), KB1(j + 1), r32, hi);
    finishSM(pB0, pB1, alB, l_reg, pa0, pa1, pa2, pa3); SBAR();
    if (SDEPTH == 1 || j + 3 < NT) SLOAD(SE, (j + 1 + SDEPTH) * KVBLK); SBAR();
    pv_d0(o, vb0 + (int)SHM_V, pa0, pa1, pa2, pa3); partialSM(pA0, pA1, MW(j + 1, 0), MW(j + 1, 1), m_reg, mnA, alA);
    __syncthreads(); SWAIT(); SWRITE(1, SO);
    RESC(alA); __syncthreads();
  }
  SBAR(); qkt(pB0, pB1, K_lds + SHM_K, qrow, bo, KB0(NT - 1), KB1(NT - 1), r32, hi);
  finishSM(pA0, pA1, alA, l_reg, pa0, pa1, pa2, pa3); SBAR();
  pv_d0(o, vb0, pa0, pa1, pa2, pa3); partialSM(pB0, pB1, MW(NT - 1, 0), MW(NT - 1, 1), m_reg, mnB, alB);
  __syncthreads(); RESC(alB);
  finishSM(pB0, pB1, alB, l_reg, pa0, pa1, pa2, pa3); SBAR();
  pv_d0(o, vb0 + (int)SHM_V, pa0, pa1, pa2, pa3);
  if (hi == 0) li_l[r32] = l_reg; asm volatile("s_waitcnt lgkmcnt(0)" ::: "memory");
  float rli[16];
#pragma unroll
  for (int r = 0; r < 16; ++r) rli[r] = __builtin_amdgcn_rcpf(li_l[crow(r, hi)]);
  __syncthreads();
  unsigned short* stg = (unsigned short*)(lds + wid * 8192);
#pragma unroll
  for (int r = 0; r < 16; ++r) { const int orow = crow(r, hi);
#pragma unroll
    for (int d0 = 0; d0 < 4; ++d0) stg[orow * 128 + d0 * 32 + r32] = (unsigned short)f2bf(o[d0][r] * rli[r]); }
  asm volatile("s_waitcnt lgkmcnt(0)" ::: "memory");
#pragma unroll
  for (int i = 0; i < 8; ++i) { const int row = i * 4 + (lane >> 4), ch = lane & 15; const u32x4 v = *(const u32x4*)(stg + row * 128 + ch * 8);
    *(u32x4*)(Ob + (size_t)row * 1024 + wid * 128 + ch * 8) = v; }
#undef SLOAD
#undef SWRITE
#undef SWAIT
#undef RESC
#undef MW
#undef KB0
#undef KB1
}
#undef KSWZ
#undef SBAR
}


namespace ret {
using bf16x8 = __attribute__((ext_vector_type(8))) short;
using s16x4  = __attribute__((ext_vector_type(4))) short;
using u32x4  = __attribute__((ext_vector_type(4))) unsigned;
using u32x2  = __attribute__((ext_vector_type(2))) unsigned;
constexpr int C = 64, QP = 272, KPI = 272, VP = 576;
constexpr int OFF_Q = 0, OFF_K = 17408, OFF_V = 34816, OFF_ST = 71680;
typedef float f32x2_t __attribute__((ext_vector_type(2))); typedef __bf16 bf16x2_t __attribute__((ext_vector_type(2)));
__device__ __forceinline__ unsigned cvtpk(float lo, float hi) { const f32x2_t v = {lo, hi}; const bf16x2_t b = __builtin_convertvector(v, bf16x2_t); return __builtin_bit_cast(unsigned, b); }
__device__ __forceinline__ s16x4 trr(const char* p) { s16x4 r; asm volatile("ds_read_b64_tr_b16 %0, %1" : "=&v"(r) : "v"((int)(uintptr_t)p) : "memory"); return r; }
__device__ __forceinline__ bf16x8 pk8(const f32x16& x, int s) { u32x4 w = {cvtpk(x[8 * s + 0], x[8 * s + 1]), cvtpk(x[8 * s + 2], x[8 * s + 3]), cvtpk(x[8 * s + 4], x[8 * s + 5]), cvtpk(x[8 * s + 6], x[8 * s + 7])}; return *reinterpret_cast<bf16x8*>(&w); }
__device__ __forceinline__ float silu_(float x) { return x / (1.f + __expf(-x)); }
__device__ __forceinline__ void ret_item(int b, int h, const bf16* __restrict__ RQ, const bf16* __restrict__ RK, bf16* RV, const bf16* __restrict__ RG, const float* __restrict__ gnorm, char* lds) {
  const int tid = threadIdx.x, w = __builtin_amdgcn_readfirstlane(tid >> 6), lane = tid & 63, r32 = lane & 31, hi = lane >> 5;
  const float lg = __log2f(1.f - exp2f(-5.f - (float)h)), gC = exp2f(64.f * lg);
  char* Qs = lds + OFF_Q; char* Ks = lds + OFF_K; char* Vs = lds + OFF_V; float* st = (float*)(lds + OFF_ST);
  f32x16 S[4] = {};
  const unsigned voffQ = (unsigned)(((tid >> 4) * 512 + (tid & 15) * 8) * 2), voffV = (unsigned)(((tid >> 5) * 1024 + (tid & 31) * 8) * 2);
  const int trq = (lane & 15) >> 2, trp = lane & 3, trg = (lane >> 4) & 1;
  for (int c = 0; c < SEQ / C; ++c) {
    const size_t tok0 = (size_t)b * SEQ + (size_t)c * C;
    __syncthreads();
    { const char* qb_ = (const char*)(RQ + tok0 * 512 + h * 128); const char* kb_ = (const char*)(RK + tok0 * 512 + h * 128); const char* vb_ = (const char*)(RV + tok0 * 1024 + h * 256);
#pragma unroll
      for (int i = 0; i < 2; ++i) { const int row = (tid >> 4) + 32 * i, ch = tid & 15;
        const u32x4 qv = *(const u32x4*)(qb_ + voffQ + i * 32768); *(u32x4*)(Qs + row * QP + ch * 16) = qv;
        const u32x4 kv = *(const u32x4*)(kb_ + voffQ + i * 32768); const float f = exp2f(lg * (float)(C - 1 - row)) * 0.08838834764831845f;
        u32x4 ko; ko.x = cvtpk(pg8::bf_lo(kv.x) * f, pg8::bf_hi(kv.x) * f); ko.y = cvtpk(pg8::bf_lo(kv.y) * f, pg8::bf_hi(kv.y) * f); ko.z = cvtpk(pg8::bf_lo(kv.z) * f, pg8::bf_hi(kv.z) * f); ko.w = cvtpk(pg8::bf_lo(kv.w) * f, pg8::bf_hi(kv.w) * f);
        *(u32x4*)(Ks + row * KPI + ch * 16) = ko; }
#pragma unroll
      for (int i = 0; i < 4; ++i) { const int row = (tid >> 5) + 16 * i, ch = tid & 31;
        *(u32x4*)(Vs + row * VP + ch * 16) = *(const u32x4*)(vb_ + voffV + i * 32768); } }
    __syncthreads();
    f32x16 ot[2] = {};
#pragma unroll
    for (int dt = 0; dt < 4; ++dt)
#pragma unroll
      for (int s = 0; s < 2; ++s) { const bf16x8 af = pk8(S[dt], s);
#pragma unroll
        for (int nt = 0; nt < 2; ++nt) { const char* qp = Qs + (32 * nt + r32) * QP + (32 * dt + 16 * s + 4 * hi) * 2;
          const u32x2 lo = *(const u32x2*)qp, hi8 = *(const u32x2*)(qp + 16); const u32x4 bw = {lo.x, lo.y, hi8.x, hi8.y};
          ot[nt] = __builtin_amdgcn_mfma_f32_32x32x16_bf16(af, *reinterpret_cast<const bf16x8*>(&bw), ot[nt], 0, 0, 0); }
        __builtin_amdgcn_sched_barrier(0); }
#pragma unroll
    for (int nt = 0; nt < 2; ++nt)
#pragma unroll
      for (int r = 0; r < 16; ++r) ot[nt][r] *= gC;
    __builtin_amdgcn_sched_barrier(0);
    bf16x8 vfr[4];
    { s16x4 vlo[4], vhi[4];
#pragma unroll
      for (int ks = 0; ks < 4; ++ks) { const char* vp = Vs + (16 * ks + 4 * hi + trq) * VP + (32 * w + 16 * trg + 4 * trp) * 2; vlo[ks] = trr(vp); vhi[ks] = trr(vp + 8 * VP); }
      asm volatile("s_waitcnt lgkmcnt(0)" : "+v"(vlo[0]), "+v"(vlo[1]), "+v"(vlo[2]), "+v"(vlo[3]), "+v"(vhi[0]), "+v"(vhi[1]), "+v"(vhi[2]), "+v"(vhi[3]) :: "memory"); __builtin_amdgcn_sched_barrier(0);
#pragma unroll
      for (int ks = 0; ks < 4; ++ks) vfr[ks] = (bf16x8){vlo[ks][0], vlo[ks][1], vlo[ks][2], vlo[ks][3], vhi[ks][0], vhi[ks][1], vhi[ks][2], vhi[ks][3]}; }
#pragma unroll
    for (int nt = 0; nt < 2; ++nt)
#pragma unroll
      for (int jt = 0; jt <= nt; ++jt) { f32x16 pt = {};
#pragma unroll
        for (int kk = 0; kk < 8; ++kk) { const bf16x8 ka = *(const bf16x8*)(Ks + (32 * jt + r32) * KPI + (16 * kk + 8 * hi) * 2), qb = *(const bf16x8*)(Qs + (32 * nt + r32) * QP + (16 * kk + 8 * hi) * 2);
          pt = __builtin_amdgcn_mfma_f32_32x32x16_bf16(ka, qb, pt, 0, 0, 0); }
        if (jt == nt) {
#pragma unroll
          for (int r = 0; r < 16; ++r) if (crow(r, hi) > r32) pt[r] = 0.f; }
#pragma unroll
        for (int s = 0; s < 2; ++s) ot[nt] = __builtin_amdgcn_mfma_f32_32x32x16_bf16(vfr[2 * jt + s], pk8(pt, s), ot[nt], 0, 0, 0);
        __builtin_amdgcn_sched_barrier(0); }
    __builtin_amdgcn_sched_barrier(0);
#pragma unroll
    for (int dt = 0; dt < 4; ++dt) {
#pragma unroll
      for (int r = 0; r < 16; ++r) S[dt][r] *= gC;
#pragma unroll
      for (int ks = 0; ks < 4; ++ks) { const char* kp = Ks + (16 * ks + 4 * hi + trq) * KPI + (32 * dt + 16 * trg + 4 * trp) * 2;
        s16x4 lo = trr(kp), hi8 = trr(kp + 8 * KPI); asm volatile("s_waitcnt lgkmcnt(0)" : "+v"(lo), "+v"(hi8) :: "memory"); __builtin_amdgcn_sched_barrier(0);
        S[dt] = __builtin_amdgcn_mfma_f32_32x32x16_bf16((bf16x8){lo[0], lo[1], lo[2], lo[3], hi8[0], hi8[1], hi8[2], hi8[3]}, vfr[ks], S[dt], 0, 0, 0); } }
    __builtin_amdgcn_sched_barrier(0);
#pragma unroll
    for (int nt = 0; nt < 2; ++nt) { const float rs = exp2f(lg * (float)(32 * nt + r32 + 1 - C)); float s1 = 0.f, s2 = 0.f;
#pragma unroll
      for (int r = 0; r < 16; ++r) { ot[nt][r] *= rs; s1 += ot[nt][r]; s2 += ot[nt][r] * ot[nt][r]; }
      s1 = xhalf_sum(s1); s2 = xhalf_sum(s2);
      if (hi == 0) { st[(w * 64 + 32 * nt + r32) * 2] = s1; st[(w * 64 + 32 * nt + r32) * 2 + 1] = s2; } }
    __syncthreads();
#pragma unroll
    for (int nt = 0; nt < 2; ++nt) { float s1 = 0.f, s2 = 0.f;
#pragma unroll
      for (int ww = 0; ww < 8; ++ww) { s1 += st[(ww * 64 + 32 * nt + r32) * 2]; s2 += st[(ww * 64 + 32 * nt + r32) * 2 + 1]; }
      const float mu = s1 * (1.f / 256.f), var = fmaxf(s2 * (1.f / 256.f) - mu * mu, 0.f), rstd = rsqrtf(var + EPS);
#pragma unroll
      for (int g = 0; g < 4; ++g) { float y[4];
#pragma unroll
        for (int j = 0; j < 4; ++j) y[j] = (ot[nt][4 * g + j] - mu) * rstd * gnorm[h * 256 + 32 * w + 8 * g + 4 * hi + j];
        const u32x2 o2 = {cvtpk(y[0], y[1]), cvtpk(y[2], y[3])};
        *(u32x2*)(Vs + (32 * nt + r32) * VP + (32 * w + 8 * g + 4 * hi) * 2) = o2; } }
    __syncthreads();
    { const char* gb_ = (const char*)(RG + tok0 * 1024 + h * 256); char* ob_ = (char*)(RV + tok0 * 1024 + h * 256);
#pragma unroll
      for (int i = 0; i < 4; ++i) { const int row = (tid >> 5) + 16 * i, ch = tid & 31;
        const u32x4 yv = *(const u32x4*)(Vs + row * VP + ch * 16); const u32x4 gt = *(const u32x4*)(gb_ + voffV + i * 32768);
        u32x4 o; o.x = cvtpk(pg8::bf_lo(yv.x) * silu_(pg8::bf_lo(gt.x)), pg8::bf_hi(yv.x) * silu_(pg8::bf_hi(gt.x))); o.y = cvtpk(pg8::bf_lo(yv.y) * silu_(pg8::bf_lo(gt.y)), pg8::bf_hi(yv.y) * silu_(pg8::bf_hi(gt.y)));
        o.z = cvtpk(pg8::bf_lo(yv.z) * silu_(pg8::bf_lo(gt.z)), pg8::bf_hi(yv.z) * silu_(pg8::bf_hi(gt.z))); o.w = cvtpk(pg8::bf_lo(yv.w) * silu_(pg8::bf_lo(gt.w)), pg8::bf_hi(yv.w) * silu_(pg8::bf_hi(gt.w)));
        *(u32x4*)(ob_ + voffV + i * 32768) = o; } }
  }
}
}

__device__ __forceinline__ void p4_attn(Frame& F, const Args& a, unsigned char* lds_generic) {
    const size_t nt_ = (size_t)F.ntok;
    const bf16* QA = (const bf16*)(F.act + nt_ * O_QA); bf16* ATT = (bf16*)(F.act + nt_ * O_QA);
    unsigned char* aux = a.xb + nt_ * 2048;
    const bf16* KP = (const bf16*)(aux + nt_ * AUX_KP); const bf16* VV = (const bf16*)(aux + nt_ * AUX_VV); const unsigned* MASK = (const unsigned*)(aux + nt_ * AUX_MASK);
    volatile LAS unsigned* MISC = (volatile LAS unsigned*)(F.lds + MISC_OFF);
    unsigned* qctr = (unsigned*)(F.ws + WS_CTL) + CW_Q4;
    const bf16* RQ = (const bf16*)(F.act + nt_ * O_RQ); const bf16* RK = (const bf16*)(F.act + nt_ * O_RK); bf16* RV = (bf16*)(F.act + nt_ * O_RV); const bf16* RG = (const bf16*)(F.act + nt_ * O_RG);
    const int nb = F.ntok / SEQ, nret = nb * 4, nitems = nb * 64;
    for (;;) {
        __syncthreads(); if (F.tid == 0) MISC[0] = atomicAdd(qctr + 16, 1u); __syncthreads();
        const int it = (int)MISC[0]; if (it >= nret) break;
        ret::ret_item(it >> 2, it & 3, RQ, RK, RV, RG, a.in[8], (char*)lds_generic);
    }
    for (;;) {
        __syncthreads(); if (F.tid == 0) MISC[0] = atomicAdd(qctr, 1u); __syncthreads();
        const int it = (int)MISC[0]; if (it >= nitems) break;
        const int qb = 63 - it / nb, b = it % nb, NT = 2 * ((qb >> 2) + 1);
        const size_t row0 = (size_t)b * SEQ + qb * 32;
        att::attn_item(QA + row0 * 1024, KP + (size_t)b * SEQ * 128, VV + (size_t)b * SEQ * 128, MASK + (size_t)b * 64 * 2048 + qb * 32, ATT + row0 * 1024, NT, (char*)lds_generic);
    }
}


__device__ __forceinline__ void p7_router(Frame& F, const Args& a) {
    const int lane = F.lane, r32 = lane & 31, hi = lane >> 5, tid = F.tid;
    unsigned char* mo = F.act; bf16* N2 = (bf16*)(mo + MO_N2); unsigned char* meta = mo + MO_META;
    int* MB = (int*)(meta + MM_B); int* MPp = (int*)(meta + MM_P); float* MCL = (float*)(meta + MM_CL); float* MCH = (float*)(meta + MM_CH); float* MRS = (float*)(meta + MM_RS);
    const bf16* Wh = (const bf16*)(F.ws + WS_WR); const bf16* Wl = Wh + 32 * 1024;
    const float* g2 = a.in[12]; const float* b_gr = a.in[14]; const float* b_er = a.in[16];
    const float* hbase = a.out + (size_t)a.tok0 * D;
    unsigned* gcnt = (unsigned*)(F.ws + WS_CTL) + CW_MOE;
    LAS unsigned* lcnt = (LAS unsigned*)(F.lds + RING_OFF);
    if (tid < 64) lcnt[tid] = 0u;
    __syncthreads();
    const int ntasks = F.ntok / 32, tpw = ntasks / F.G;
    const bool have = F.wave < tpw; const int t = (F.vcu * tpw + F.wave) * 32 + r32;
    int bucket = 0, posl = 0; float clo = 0.f, chi = 0.f, rstd = 0.f;
    if (have) {
        const float* hrow = hbase + (size_t)t * D + hi * 8; bf16* nrow = N2 + (size_t)t * D + hi * 8;
        f32x16 acc = f32x16{}; float ss = 0.f;
#pragma unroll 4
        for (int kk = 0; kk < 64; ++kk) {
            const f32x4 a0 = *(const f32x4*)(hrow + kk * 16), a1 = *(const f32x4*)(hrow + kk * 16 + 4);
            const f32x4 q0 = *(const f32x4*)(g2 + kk * 16 + hi * 8), q1 = *(const f32x4*)(g2 + kk * 16 + hi * 8 + 4);
            ss += (a0.x * a0.x + a0.y * a0.y) + (a0.z * a0.z + a0.w * a0.w) + (a1.x * a1.x + a1.y * a1.y) + (a1.z * a1.z + a1.w * a1.w);
            const float x[8] = {a0.x * q0.x, a0.y * q0.y, a0.z * q0.z, a0.w * q0.w, a1.x * q1.x, a1.y * q1.y, a1.z * q1.z, a1.w * q1.w};
            unsigned hb[8]; float lo[8];
#pragma unroll
            for (int j = 0; j < 8; ++j) { hb[j] = f2bf(x[j]); lo[j] = x[j] - __uint_as_float(hb[j] << 16); }
            v4u xh; xh.x = hb[0] | (hb[1] << 16); xh.y = hb[2] | (hb[3] << 16); xh.z = hb[4] | (hb[5] << 16); xh.w = hb[6] | (hb[7] << 16);
            v4u xl; xl.x = pk2(lo[0], lo[1]); xl.y = pk2(lo[2], lo[3]); xl.z = pk2(lo[4], lo[5]); xl.w = pk2(lo[6], lo[7]);
            *(v4u*)(nrow + kk * 16) = xh;
            const bf16x8_t wh = *(const bf16x8_t*)(Wh + (size_t)r32 * 1024 + kk * 16 + hi * 8), wl = *(const bf16x8_t*)(Wl + (size_t)r32 * 1024 + kk * 16 + hi * 8);
            const bf16x8_t bh = __builtin_bit_cast(bf16x8_t, xh), bl = __builtin_bit_cast(bf16x8_t, xl);
            acc = __builtin_amdgcn_mfma_f32_32x32x16_bf16(wh, bh, acc, 0, 0, 0);
            acc = __builtin_amdgcn_mfma_f32_32x32x16_bf16(wh, bl, acc, 0, 0, 0);
            acc = __builtin_amdgcn_mfma_f32_32x32x16_bf16(wl, bh, acc, 0, 0, 0);
        }
        ss = xhalf_sum(ss); rstd = rsqrtf(ss * (1.f / D) + EPS);
        float L[24];
#pragma unroll
        for (int r = 0; r < 12; ++r) { const float v = acc[r]; auto rr = __builtin_amdgcn_permlane32_swap(__float_as_uint(v), __float_as_uint(v), false, false);
            L[(r & 3) + 8 * (r >> 2)] = __uint_as_float(rr[0]); L[(r & 3) + 8 * (r >> 2) + 4] = __uint_as_float(rr[1]); }
        float gl[4];
#pragma unroll
        for (int i = 0; i < 4; ++i) gl[i] = L[i] * rstd + b_gr[i];
        int g = 0; float gm = gl[0];
#pragma unroll
        for (int i = 1; i < 4; ++i) if (gl[i] > gm) { gm = gl[i]; g = i; }
        float se = 0.f;
#pragma unroll
        for (int i = 0; i < 4; ++i) se += __expf(gl[i] - gm);
        const float gw = 1.f / se;
        float el[4];
#pragma unroll
        for (int i = 0; i < 4; ++i) { const float l0 = L[4 + i], l1 = L[8 + i], l2 = L[12 + i], l3 = L[16 + i]; const float lv = g == 0 ? l0 : (g == 1 ? l1 : (g == 2 ? l2 : l3));
            const float b0 = b_er[i], b1 = b_er[4 + i], b2 = b_er[8 + i], b3 = b_er[12 + i]; el[i] = lv * rstd + (g == 0 ? b0 : (g == 1 ? b1 : (g == 2 ? b2 : b3))); }
        int i1 = 0; float v1 = el[0];
#pragma unroll
        for (int i = 1; i < 4; ++i) if (el[i] > v1) { v1 = el[i]; i1 = i; }
        int i2 = -1; float v2 = 0.f;
#pragma unroll
        for (int i = 0; i < 4; ++i) if (i != i1 && (i2 < 0 || el[i] > v2)) { v2 = el[i]; i2 = i; }
        const float e2 = __expf(v2 - v1), p1 = gw / (1.f + e2), p2 = gw * e2 / (1.f + e2);
        const int lo_ = i1 < i2 ? i1 : i2, hi_ = i1 < i2 ? i2 : i1;
        const int pair = lo_ == 0 ? (hi_ - 1) : (lo_ == 1 ? (hi_ + 1) : 5);
        bucket = g * 6 + pair; clo = i1 < i2 ? p1 : p2; chi = i1 < i2 ? p2 : p1;
        if (hi == 0) posl = (int)__hip_atomic_fetch_add(&lcnt[bucket], 1u, __ATOMIC_RELAXED, __HIP_MEMORY_SCOPE_WORKGROUP);
    }
    __syncthreads();
    if (tid < 24) lcnt[32 + tid] = atomicAdd(gcnt + tid, lcnt[tid]);
    __syncthreads();
    if (have && hi == 0) { MB[t] = bucket; MPp[t] = (int)lcnt[32 + bucket] + posl; MCL[t] = clo; MCH[t] = chi; MRS[t] = rstd; }
}
__device__ __forceinline__ int moe_tiles(const unsigned* gcnt, int* rowstart  ) { int rs = 0;
    for (int b = 0; b < 24; ++b) { rowstart[b] = rs; rs += (int)((gcnt[b] + 255u) & ~255u); } rowstart[24] = rs; return rs >> 8; }
__device__ __forceinline__ void p8_permute(Frame& F, const Args& a) {
    unsigned char* mo = F.act; const bf16* N2 = (const bf16*)(mo + MO_N2); bf16* AP = (bf16*)(mo + MO_APERM); unsigned char* meta = mo + MO_META;
    const int* MB = (const int*)(meta + MM_B); const int* MPp = (const int*)(meta + MM_P); const float* MCL = (const float*)(meta + MM_CL); const float* MCH = (const float*)(meta + MM_CH); const float* MRS = (const float*)(meta + MM_RS);
    int* PTOK = (int*)(meta + MM_PTOK); float* PRS = (float*)(meta + MM_PRS); float* PCL = (float*)(meta + MM_PCL); float* PCH = (float*)(meta + MM_PCH);
    const unsigned* gcnt = (const unsigned*)(F.ws + WS_CTL) + CW_MOE;
    LAS int* rsL = (LAS int*)(F.lds + RING_OFF);
    if (F.tid == 0) { int rs = 0; for (int b = 0; b < 24; ++b) { rsL[b] = rs; rs += (int)((gcnt[b] + 255u) & ~255u); } rsL[24] = rs; }
    __syncthreads();
    const int gw = F.vcu * NWAVES + F.wave, NGW = F.G * NWAVES;
    for (int t = gw; t < F.ntok; t += NGW) {
        const int b = MB[t], prow = rsL[b] + MPp[t];
        const GAS v4u* s = (const GAS v4u*)(N2 + (size_t)t * D) + F.lane; GAS v4u* d = (GAS v4u*)(AP + (size_t)prow * D) + F.lane;
        d[0] = s[0]; d[64] = s[64];
        if (F.lane == 0) { PTOK[prow] = t; PRS[prow] = MRS[t]; PCL[prow] = MCL[t]; PCH[prow] = MCH[t]; }
    }
    const int gt = gw * 64 + F.lane, NGT = NGW * 64;
    for (int b = 0; b < 24; ++b) { const int c = (int)gcnt[b], p0 = rsL[b] + c, p1 = rsL[b + 1];
        for (int r = p0 + gt; r < p1; r += NGT) { PTOK[r] = -1; PRS[r] = 0.f; PCL[r] = 0.f; PCH[r] = 0.f; } }
}
struct MoeOrder {
    int ntile, G, c; const char* A; size_t tA; const char* W; int mode; const LAS unsigned char* tb;
    __device__ bool next(int i, pg8::Unit& u) const {
        const long L = (long)i * G + c; if (L >= (long)ntile * 4) return false;
        u.pm = (int)(L >> 2); u.pn = (int)(L & 3); u.a = A + (size_t)u.pm * tA;
        const int bk = tb[u.pm], g = bk / 6, pr = bk % 6; const int lo = pr < 3 ? 0 : (pr < 5 ? 1 : 2), hi = pr < 3 ? pr + 1 : (pr < 5 ? pr - 1 : 3);
        const int elo = g * 4 + lo, ehi = g * 4 + hi; u.aux = 0;
        if (mode == 1) { const int e = u.pn < 2 ? elo : ehi; u.b = W + ((size_t)e * 512 + (size_t)(u.pn & 1) * 256) * 1024 * 2; u.bjump = 0; }
        else { u.b = W + ((size_t)elo * 1024 + (size_t)u.pn * 256) * 256 * 2; u.bjump = (long)(ehi - elo) * 1024 * 256 * 2 - 4 * 128; }
        return true;
    }
    __device__ __forceinline__ void a_ready(const pg8::Unit&) const {}
    __device__ __forceinline__ void done(const pg8::Unit&) const {}
};
__device__ __forceinline__ float silu_f(float x) { return x / (1.f + __expf(-x)); }
struct EpiMoe1 {
    static constexpr bool PERM = true, AFTER_DRAIN = false;
    pg8::bf16_t* ACT; const float* PRS; const float* PCL; const float* PCH;
    __device__ __forceinline__ void operator()(const pg8::f32x4 (&acc)[2][2][4][2], const pg8::Unit& u, int wr, int wc, int fr, int fq) const {
        const int row0 = u.pm * pg8::BM + wr * 64 + fr, slot = u.pn >> 1, fcol0 = slot * 256 + (u.pn & 1) * 128 + wc * 16 + 4 * fq; const float* PC = slot ? PCH : PCL;
#pragma unroll
        for (int ai = 0; ai < 2; ++ai)
#pragma unroll
            for (int m = 0; m < 4; ++m) { const int row = row0 + ai * pg8::HALF + m * 16; const float rs = PRS[row], cw = PC[row]; pg8::bf16_t* rowp = ACT + (size_t)row * 512 + fcol0;
#pragma unroll
                for (int bj = 0; bj < 2; ++bj) { const pg8::f32x4 v0 = acc[ai][bj][m][0], v1 = acc[ai][bj][m][1];
                    const float a0 = silu_f(v0[0] * rs) * (v0[1] * rs) * cw, a1 = silu_f(v0[2] * rs) * (v0[3] * rs) * cw, a2 = silu_f(v1[0] * rs) * (v1[1] * rs) * cw, a3 = silu_f(v1[2] * rs) * (v1[3] * rs) * cw;
                    pg8::u32x2 w; w.x = pg8::cvt_pk_bf16(a0, a1); w.y = pg8::cvt_pk_bf16(a2, a3); *(pg8::u32x2*)(rowp + bj * 64) = w; } }
    }
};
struct EpiMoe2 {
    static constexpr bool PERM = false, AFTER_DRAIN = false;
    float* out; const int* PTOK;
    __device__ __forceinline__ void operator()(const pg8::f32x4 (&acc)[2][2][4][2], const pg8::Unit& u, int wr, int wc, int fr, int fq) const {
        const int row0 = u.pm * pg8::BM + wr * 64 + fr, col0 = u.pn * pg8::BM + wc * 32 + 4 * fq;
#pragma unroll
        for (int ai = 0; ai < 2; ++ai)
#pragma unroll
            for (int m = 0; m < 4; ++m) { const int tok = PTOK[row0 + ai * pg8::HALF + m * 16];
                if (tok >= 0) { float* rowp = out + (size_t)tok * 1024 + col0;
#pragma unroll
                    for (int bj = 0; bj < 2; ++bj)
#pragma unroll
                        for (int n = 0; n < 2; ++n) { pg8::f32x4* p = (pg8::f32x4*)(rowp + bj * pg8::HALF + n * 16); *p = *p + acc[ai][bj][m][n]; } } }
    }
};
__device__ __forceinline__ int moe_setup(Frame& F, LAS unsigned char* tb) {
    const unsigned* gcnt = (const unsigned*)(F.ws + WS_CTL) + CW_MOE;
    LAS int* nt_ = (LAS int*)(tb + 256);
    __syncthreads();
    if (F.tid == 0) { int tl = 0; for (int b = 0; b < 24; ++b) { const int n = (int)((gcnt[b] + 255u) >> 8); for (int i = 0; i < n; ++i) tb[tl + i] = (unsigned char)b; tl += n; } nt_[0] = tl; }
    __syncthreads();
    return nt_[0];
}

__global__ void __launch_bounds__(NWAVES * 64, 2) mk_fwd(Args args) {
    extern __shared__ __attribute__((aligned(16))) unsigned char lds[];
    Frame F;
    F.lds = (LAS unsigned char*)lds;
    F.tid = threadIdx.x; F.lane = F.tid & 63; F.wave = __builtin_amdgcn_readfirstlane(F.tid >> 6);
    F.G = gridDim.x; { const int bx = blockIdx.x; F.vcu = (F.G % 8 == 0) ? (bx % 8) * (F.G / 8) + bx / 8 : bx; }
    F.ntok = args.ntok; F.ws = args.ws; F.act = args.ws + WS_ACT;
    const int lo = args.ph_lo, hi = args.ph_hi;
    cooperative_groups::grid_group grid = cooperative_groups::this_grid();
    volatile LAS unsigned* MISCW = (volatile LAS unsigned*)(F.lds + MISC_OFF);
    for (int u = F.tid; u < (LDS_BYTES - LDSCTL_OFF) / 4; u += NWAVES * 64) ((LAS unsigned*)(F.lds + LDSCTL_OFF))[u] = 0u;
    __syncthreads();
    XcdBarrier bar = xcd_barrier_post((unsigned*)(F.ws + WS_CTL) + CW_BAR, MISCW + 8);
#define IN(k) (lo <= (k) && (k) < hi)
#define SEAM(k) do { if (IN(k) && IN((k) + 1)) { xcd_barrier(bar); } } while (0)
    if (IN(0)) { p0_prologue(F, args); }
    SEAM(0);
    if (IN(1)) {
        pg8::Gemm g{1024, 1024, 1024, 16};
        pg8::StaticOrder S; S.init(F.ntok, INWP, F.G, (int)blockIdx.x, args.xb, 1024, F.ws + WS_WIN, 1024);
        EpiProj E{F.act, (size_t)F.ntok};
        pg8::gemm_phase<EpiProj, pg8::StaticOrder, true, true>(F.lds + RING_OFF, g, S, E);
    }
    SEAM(1);
    if (IN(2)) { p2_post(F, args); }
    SEAM(2);
    if (IN(3)) { p3_index(F, args); }
    SEAM(3);
    if (IN(4)) { p4_attn(F, args, lds); }
    SEAM(4);
    if (IN(5)) {
        pg8::Gemm g{1024, 1024, 1024, 16}; const size_t nt_ = (size_t)F.ntok;
        pg8::bf16_t* GA = (pg8::bf16_t*)(F.act + nt_ * O_GA); const pg8::bf16_t* GR = (const pg8::bf16_t*)(F.act + nt_ * O_GR);
        { pg8::StaticOrder S; S.init(F.ntok, 1024, F.G, (int)blockIdx.x, F.act + nt_ * O_QA, 1024, F.ws + WS_WATT, 1024); EpiGateA E{GA};
          pg8::gemm_phase<EpiGateA, pg8::StaticOrder, true, true>(F.lds + RING_OFF, g, S, E); }
        { pg8::StaticOrder S; S.init(F.ntok, 1024, F.G, (int)blockIdx.x, F.act + nt_ * O_RV, 1024, F.ws + WS_WRET, 1024); EpiGateB E{GA, GR};
          pg8::gemm_phase<EpiGateB, pg8::StaticOrder, true, true>(F.lds + RING_OFF, g, S, E); }
    }
    SEAM(5);
    if (IN(6)) {
        pg8::Gemm g{1024, 1024, 1024, 16}; const size_t nt_ = (size_t)F.ntok;
        pg8::StaticOrder S; S.init(F.ntok, 1024, F.G, (int)blockIdx.x, F.act + nt_ * O_GA, 1024, F.ws + WS_WOUT, 1024);
        EpiResid E{args.in[0] + (size_t)args.tok0 * D, args.out + (size_t)args.tok0 * D};
        pg8::gemm_phase<EpiResid, pg8::StaticOrder, true, true>(F.lds + RING_OFF, g, S, E);
    }
    SEAM(6);
    if (IN(7)) { p7_router(F, args); }
    SEAM(7);
    if (IN(8)) { p8_permute(F, args); }
    SEAM(8);
    if (IN(9)) {
        LAS unsigned char* tb = F.lds + LDSCTL_OFF - 1024; const int ntile = moe_setup(F, tb);
        unsigned char* meta = F.act + MO_META;
        pg8::Gemm g{1024, 1024, 1024, 16};
        MoeOrder S{ntile, F.G, (int)blockIdx.x, (const char*)(F.act + MO_APERM), (size_t)256 * 1024 * 2, (const char*)(F.ws + WS_W1), 1, tb};
        EpiMoe1 E{(pg8::bf16_t*)(F.act + MO_ACT), (const float*)(meta + MM_PRS), (const float*)(meta + MM_PCL), (const float*)(meta + MM_PCH)};
        pg8::gemm_phase<EpiMoe1, MoeOrder, true, true>(F.lds + RING_OFF, g, S, E);
    }
    SEAM(9);
    if (IN(10)) {
        LAS unsigned char* tb = F.lds + LDSCTL_OFF - 1024; const int ntile = moe_setup(F, tb);
        unsigned char* meta = F.act + MO_META;
        pg8::Gemm g{512, 512, 256, 4};
        MoeOrder S{ntile, F.G, (int)blockIdx.x, (const char*)(F.act + MO_ACT), (size_t)256 * 512 * 2, (const char*)(F.ws + WS_WD), 2, tb};
        EpiMoe2 E{args.out + (size_t)args.tok0 * D, (const int*)(meta + MM_PTOK)};
        pg8::gemm_phase<EpiMoe2, MoeOrder, true, true>(F.lds + RING_OFF, g, S, E);
    }
    if (hi - lo > 1) grid.sync();
#undef IN
#undef SEAM
}

__device__ __forceinline__ float block_sum256(float v, float* red) {
#pragma unroll
    for (int o = 32; o > 0; o >>= 1) v += __shfl_xor(v, o);
    __syncthreads();
    if ((threadIdx.x & 63) == 0) red[threadIdx.x >> 6] = v;
    __syncthreads();
    return red[0] + red[1] + red[2] + red[3];
}
__device__ __forceinline__ float block_max256(float v, float* red) {
#pragma unroll
    for (int o = 32; o > 0; o >>= 1) v = fmaxf(v, __shfl_xor(v, o));
    __syncthreads();
    if ((threadIdx.x & 63) == 0) red[threadIdx.x >> 6] = v;
    __syncthreads();
    return fmaxf(fmaxf(red[0], red[1]), fmaxf(red[2], red[3]));
}
__device__ __forceinline__ float sigmoidf_(float x) { return 1.f / (1.f + expf(-x)); }
__device__ __forceinline__ float siluf_(float x) { return x / (1.f + expf(-x)); }

__global__ void __launch_bounds__(256) nv_rmsnorm(const float* inb, long in_ld, float* outb, long out_ld, int ninner, int width, const float* gain, int gstride) {
    __shared__ float red[8];
    const int r = blockIdx.x, t = r / ninner, i = r % ninner;
    const float* in = inb + (long)t * in_ld + (long)i * width;
    float* out = outb + (long)t * out_ld + (long)i * width;
    float s = 0.f;
    for (int c = threadIdx.x; c < width; c += 256) { const float v = in[c]; s += v * v; }
    s = block_sum256(s, red);
    const float rs = rsqrtf(s / (float)width + EPS);
    for (int c = threadIdx.x; c < width; c += 256) out[c] = in[c] * rs * gain[i * gstride + c];
}
__global__ void __launch_bounds__(256) nv_gemm(const float* A, long lda, const float* B, long ldb, float* C, long ldc, int M, int N, int K) {
    __shared__ float As[8][128 + 4];
    __shared__ float Bs[8][128 + 4];
    const int tid = threadIdx.x, tx = tid & 15, ty = tid >> 4;
    const int m0 = blockIdx.y * 128, n0 = blockIdx.x * 128;
    float acc[8][8];
#pragma unroll
    for (int i = 0; i < 8; ++i)
#pragma unroll
        for (int j = 0; j < 8; ++j) acc[i][j] = 0.f;
    for (int k0 = 0; k0 < K; k0 += 8) {
        { const int r = tid >> 1, kk = (tid & 1) * 4;
          const float4 v = *(const float4*)(A + (long)(m0 + r) * lda + k0 + kk);
          As[kk + 0][r] = v.x; As[kk + 1][r] = v.y; As[kk + 2][r] = v.z; As[kk + 3][r] = v.w; }
        { const int kk = tid >> 5, c = (tid & 31) * 4;
#pragma unroll
          for (int j = 0; j < 4; ++j) { const int n = n0 + c + j; Bs[kk][c + j] = (n < N) ? B[(long)(k0 + kk) * ldb + n] : 0.f; } }
        __syncthreads();
#pragma unroll
        for (int kk = 0; kk < 8; ++kk) {
            float a[8], b[8];
#pragma unroll
            for (int i = 0; i < 8; ++i) a[i] = As[kk][ty * 8 + i];
#pragma unroll
            for (int j = 0; j < 8; ++j) b[j] = Bs[kk][tx * 8 + j];
#pragma unroll
            for (int i = 0; i < 8; ++i)
#pragma unroll
                for (int j = 0; j < 8; ++j) acc[i][j] += a[i] * b[j];
        }
        __syncthreads();
    }
#pragma unroll
    for (int i = 0; i < 8; ++i)
#pragma unroll
        for (int j = 0; j < 8; ++j) { const int n = n0 + tx * 8 + j; if (n < N) C[(long)(m0 + ty * 8 + i) * ldc + n] = acc[i][j]; }
}
__global__ void __launch_bounds__(256) nv_attn(const float* proj, const float* kv, float* att, float wscale, float dscale, float lscale, const unsigned* maskb) {
    __shared__ float s_qi[512], s_w[8], s_score[2048], s_q[1024], s_p[8][256], red[8];
    __shared__ int s_sel[256 + 64]; __shared__ int s_pref[65]; __shared__ unsigned s_mw[64];
    const int tq = blockIdx.x, b = tq / SEQ, t = tq % SEQ, tid = threadIdx.x;
    const float* prow = proj + (long)tq * INW;
    const float* pb = proj + (long)b * SEQ * INW;
    const float* kvb = kv + (long)b * SEQ * 256;
    for (int i = tid; i < 512; i += 256) s_qi[i] = prow[C_QI + i];
    for (int i = tid; i < 1024; i += 256) s_q[i] = prow[C_QA + i];
    if (tid < 8) s_w[tid] = prow[C_WI + tid] * wscale;
    __syncthreads();
    const int n = t + 1;
    int cnt;
    if (maskb) {
        if (tid < 64) s_mw[tid] = (tid * 32 <= t) ? maskb[tid * 2048 + t] : 0u;
        __syncthreads();
        if (tid == 0) { int c = 0; for (int i = 0; i < 64; ++i) { s_pref[i] = c; c += __builtin_popcount(s_mw[i]); } s_pref[64] = c; }
        __syncthreads();
        if (tid < 64) { unsigned x = s_mw[tid]; int p = s_pref[tid]; while (x) { const int bpos = __builtin_ctz(x); x &= x - 1; if (p < 256) s_sel[p] = tid * 32 + bpos; ++p; } }
        cnt = s_pref[64] < 256 ? s_pref[64] : 256;
        __syncthreads();
    } else {
    for (int s = tid; s < n; s += 256) {
        const float* kr = pb + (long)s * INW + C_KI;
        float kk[64];
#pragma unroll
        for (int d = 0; d < 64; ++d) kk[d] = kr[d];
        float sc = 0.f;
#pragma unroll
        for (int h = 0; h < 8; ++h) {
            float dt = 0.f;
#pragma unroll
            for (int d = 0; d < 64; ++d) dt += s_qi[h * 64 + d] * kk[d];
            dt *= dscale;
            sc += fmaxf(dt, 0.f) * s_w[h];
        }
        s_score[s] = sc;
    }
    __syncthreads();
    if (n <= 256) { if (tid < n) s_sel[tid] = tid; cnt = n; }
    else {
        for (int s = tid; s < n; s += 256) {
            const float v = s_score[s]; int rank = 0;
            for (int j = 0; j < n; ++j) { const float u = s_score[j]; rank += (u > v || (u == v && j < s)) ? 1 : 0; }
            if (rank < 256) s_sel[rank] = s;
        }
        cnt = 256;
    }
    __syncthreads();
    }
    float lg[8];
    const bool act = tid < cnt;
    const int sj = act ? s_sel[tid] : 0;
    {
        const float* kr = kvb + (long)sj * 256;
#pragma unroll
        for (int h = 0; h < 8; ++h) lg[h] = 0.f;
        for (int d = 0; d < 128; ++d) { const float kd = kr[d];
#pragma unroll
            for (int h = 0; h < 8; ++h) lg[h] += s_q[h * 128 + d] * kd; }
    }
#pragma unroll
    for (int h = 0; h < 8; ++h) {
        const float slope = exp2f(-(float)(h + 1));
        float x = act ? (lg[h] * lscale - slope * (float)(t - sj)) : -INFINITY;
        const float m = block_max256(x, red);
        const float e = act ? expf(x - m) : 0.f;
        const float su = block_sum256(e, red);
        s_p[h][tid] = e / su;
    }
    __syncthreads();
    float o4[4] = {0.f, 0.f, 0.f, 0.f};
    for (int j = 0; j < cnt; ++j) {
        const float* vr = kvb + (long)s_sel[j] * 256 + 128;
#pragma unroll
        for (int i = 0; i < 4; ++i) { const int o = tid + 256 * i; o4[i] += s_p[o >> 7][j] * vr[o & 127]; }
    }
#pragma unroll
    for (int i = 0; i < 4; ++i) att[(long)tq * 1024 + tid + 256 * i] = o4[i];
}
__global__ void __launch_bounds__(256) nv_ret(const float* proj, float* reto) {
    __shared__ float sq[128], sk[128];
    const int b = blockIdx.x >> 2, h = blockIdx.x & 3, v = threadIdx.x;
    const float gamma = 1.f - exp2f(-5.f - (float)h);
    float S[128];
#pragma unroll
    for (int d = 0; d < 128; ++d) S[d] = 0.f;
    for (int t = 0; t < SEQ; ++t) {
        const float* row = proj + (long)(b * SEQ + t) * INW;
        if (v < 128) { sq[v] = row[C_RQ + h * 128 + v]; sk[v] = row[C_RK + h * 128 + v] * 0.08838834764831845f; }
        __syncthreads();
        const float vv = row[C_RV + h * 256 + v];
        float o = 0.f;
#pragma unroll
        for (int d = 0; d < 128; ++d) { S[d] = gamma * S[d] + sk[d] * vv; o += sq[d] * S[d]; }
        reto[(long)(b * SEQ + t) * 1024 + h * 256 + v] = o;
        __syncthreads();
    }
}
__global__ void __launch_bounds__(256) nv_retpost(const float* proj, const float* reto, const float* g, float* a2) {
    __shared__ float red[8];
    const int t = blockIdx.x >> 2, h = blockIdx.x & 3, c = threadIdx.x;
    const float x = reto[(long)t * 1024 + h * 256 + c];
    const float mu = block_sum256(x, red) * (1.f / 256.f);
    const float dv = x - mu;
    const float var = block_sum256(dv * dv, red) * (1.f / 256.f);
    const float y = dv * rsqrtf(var + EPS) * g[h * 256 + c];
    a2[(long)t * 1024 + h * 256 + c] = siluf_(proj[(long)t * INW + C_RG + h * 256 + c]) * y;
}
__global__ void __launch_bounds__(256) nv_mix(const float* proj, const float* ya, const float* yr, float* mix) {
    const long i = (long)blockIdx.x * 256 + threadIdx.x; const long t = i >> 10; const int c = (int)(i & 1023);
    mix[i] = sigmoidf_(proj[t * INW + C_GA + c]) * ya[i] + sigmoidf_(proj[t * INW + C_GR + c]) * yr[i];
}
__global__ void __launch_bounds__(256) nv_add(const float* a, const float* b, float* o) {
    const long i = (long)blockIdx.x * 256 + threadIdx.x; o[i] = a[i] + b[i];
}
__global__ void __launch_bounds__(256) nv_moe(const float* n2, float* hio, const float* wgr, const float* bgr, const float* wer, const float* ber,
                                              const float* wg, const float* wu, const float* wd) {
    __shared__ float s_n[1024], s_lg[20], s_act[256], s_p[2];
    __shared__ int s_e[2];
    const int t = blockIdx.x, tid = threadIdx.x;
    for (int i = tid; i < 1024; i += 256) s_n[i] = n2[(long)t * 1024 + i];
    __syncthreads();
    if (tid < 20) {
        float a = 0.f;
        if (tid < 4) { for (int d = 0; d < 1024; ++d) a += s_n[d] * wgr[d * 4 + tid]; a += bgr[tid]; }
        else { const int e = tid - 4; for (int d = 0; d < 1024; ++d) a += s_n[d] * wer[d * 16 + e]; a += ber[e]; }
        s_lg[tid] = a;
    }
    __syncthreads();
    if (tid == 0) {
        int g = 0; float m = s_lg[0];
        for (int i = 1; i < 4; ++i) if (s_lg[i] > m) { m = s_lg[i]; g = i; }
        float se = 0.f; for (int i = 0; i < 4; ++i) se += expf(s_lg[i] - m);
        const float gw = 1.f / se;
        const float* el = s_lg + 4 + g * 4;
        int i1 = 0; for (int i = 1; i < 4; ++i) if (el[i] > el[i1]) i1 = i;
        int i2 = -1; for (int i = 0; i < 4; ++i) if (i != i1 && (i2 < 0 || el[i] > el[i2])) i2 = i;
        const float e2 = expf(el[i2] - el[i1]);
        s_p[0] = gw / (1.f + e2); s_p[1] = gw * e2 / (1.f + e2);
        s_e[0] = g * 4 + i1; s_e[1] = g * 4 + i2;
    }
    __syncthreads();
    float acc[4] = {0.f, 0.f, 0.f, 0.f};
    for (int sl = 0; sl < 2; ++sl) {
        const int e = s_e[sl]; const float p = s_p[sl];
        const float* g_ = wg + (long)e * 1024 * 256 + tid; const float* u_ = wu + (long)e * 1024 * 256 + tid;
        float hg = 0.f, hu = 0.f;
        for (int d = 0; d < 1024; ++d) { hg += s_n[d] * g_[(long)d * 256]; hu += s_n[d] * u_[(long)d * 256]; }
        __syncthreads();
        s_act[tid] = siluf_(hg) * hu * p;
        __syncthreads();
        const float* d_ = wd + (long)e * 256 * 1024;
        for (int f = 0; f < 256; ++f) { const float a = s_act[f];
#pragma unroll
            for (int i = 0; i < 4; ++i) acc[i] += a * d_[(long)f * 1024 + tid + 256 * i]; }
    }
#pragma unroll
    for (int i = 0; i < 4; ++i) hio[(long)t * 1024 + tid + 256 * i] += acc[i];
}
__global__ void __launch_bounds__(256) ad_proj(const unsigned char* act, int ntok, int tok_lo, float* PROJ) {
    const int t = blockIdx.x; const size_t tg = (size_t)(tok_lo + t); const size_t nt = (size_t)ntok;
    const bf16* QA = (const bf16*)(act + nt * O_QA) + tg * 1024; const bf16* CKV = (const bf16*)(act + nt * O_CKV) + tg * 256; const bf16* QI = (const bf16*)(act + nt * O_QI) + tg * 512;
    const bf16* KW = (const bf16*)(act + nt * O_KW) + tg * 128; const bf16* RQ = (const bf16*)(act + nt * O_RQ) + tg * 512; const bf16* RK = (const bf16*)(act + nt * O_RK) + tg * 512;
    const bf16* R4 = (const bf16*)(act + nt * O_RV);
    float* o = PROJ + (size_t)t * INW;
    for (int c = threadIdx.x; c < INW; c += 256) {
        bf16 v;
        if (c < C_CKV) v = QA[c]; else if (c < C_QI) v = CKV[c - C_CKV]; else if (c < C_KI) v = QI[c - C_QI]; else if (c < C_RQ) v = KW[c - C_KI];
        else if (c < C_RK) v = RQ[c - C_RQ]; else if (c < C_RV) v = RK[c - C_RK];
        else { const int cc = c - C_RV; v = R4[(size_t)(cc >> 10) * nt * 1024 + tg * 1024 + (cc & 1023)]; }
        o[c] = bf2f(v);
    }
}


__global__ void __launch_bounds__(256) ad_kv(const unsigned char* aux, int ntok, int tok_lo, float* KV, float* PROJ) {
    const int t = blockIdx.x; const size_t tg = (size_t)(tok_lo + t); const size_t nt = (size_t)ntok; const int c = threadIdx.x;
    const bf16* KP = (const bf16*)(aux + nt * AUX_KP) + tg * 128; const bf16* VV = (const bf16*)(aux + nt * AUX_VV) + tg * 128; const bf16* KIN = (const bf16*)(aux + nt * AUX_KIN) + tg * 64;
    KV[(size_t)t * 256 + c] = bf2f(c < 128 ? KP[c] : VV[c - 128]);
    if (c < 64) PROJ[(size_t)t * INW + C_KI + c] = bf2f(KIN[c]);
}
__global__ void __launch_bounds__(256) nv_fill(float* p, float v, int n) { const int i = blockIdx.x * 256 + threadIdx.x; if (i < n) p[i] = v; }


__global__ void __launch_bounds__(256) ad_att(const unsigned char* act, int ntok, int tok_lo, float* ATT) {
    const int t = blockIdx.x; const bf16* A = (const bf16*)(act + (size_t)ntok * O_QA) + (size_t)(tok_lo + t) * 1024;
    for (int c = threadIdx.x; c < 1024; c += 256) ATT[(size_t)t * 1024 + c] = bf2f(A[c]);
}


__global__ void __launch_bounds__(256) ad_a2(const unsigned char* act, int ntok, int tok_lo, float* A2) {
    const int t = blockIdx.x; const bf16* A = (const bf16*)(act + (size_t)ntok * O_RV) + (size_t)(tok_lo + t) * 1024;
    for (int c = threadIdx.x; c < 1024; c += 256) A2[(size_t)t * 1024 + c] = bf2f(A[c]);
}

static void gemm(hipStream_t st, const float* A, long lda, const float* B, long ldb, float* C, long ldc, int M, int N, int K) {
    hipLaunchKernelGGL(nv_gemm, dim3((N + 127) / 128, M / 128), dim3(256), 0, st, A, lda, B, ldb, C, ldc, M, N, K);
}

extern "C" void kernel_launch(void* const* d_in, const int* in_sizes, int n_in, void* d_out, int out_size, void* d_ws, size_t ws_size, hipStream_t stream) {
    static int grid = 0;
    if (grid == 0) {
        int dev = 0, cus = 0, per_cu = 0;
        (void)hipGetDevice(&dev); (void)hipDeviceGetAttribute(&cus, hipDeviceAttributeMultiprocessorCount, dev);
        if (hipFuncSetAttribute((const void*)mk_fwd, hipFuncAttributeMaxDynamicSharedMemorySize, LDS_BYTES) != hipSuccess) { fprintf(stderr, "kernel_launch: hipFuncSetAttribute failed\n"); grid = -1; return; }
        (void)hipOccupancyMaxActiveBlocksPerMultiprocessor(&per_cu, (const void*)mk_fwd, NWAVES * 64, LDS_BYTES);
        (void)hipGetLastError();
        if (per_cu < 1) { fprintf(stderr, "kernel_launch: occupancy query says %d blocks per CU\n", per_cu); per_cu = 1; }
        grid = cus * per_cu;
        if (n_in != 20 || ws_size < (size_t)512 * MiB) { fprintf(stderr, "kernel_launch: unexpected n_in %d / ws_size %zu\n", n_in, ws_size); grid = -1; return; }
    }
    if (grid < 0) return;
    const float* x = (const float*)d_in[0];
    const float* kv_norm_g = (const float*)d_in[3]; const float* w_kv_up = (const float*)d_in[4]; const float* q_norm_g = (const float*)d_in[5];
    const float* k_norm_g = (const float*)d_in[6]; const float* idx_k_norm_g = (const float*)d_in[7]; const float* ret_norm_g = (const float*)d_in[8];
    const float* w_att = (const float*)d_in[9]; const float* w_ret = (const float*)d_in[10]; const float* w_out = (const float*)d_in[11];
    const float* norm2_g = (const float*)d_in[12]; const float* w_gr = (const float*)d_in[13]; const float* b_gr = (const float*)d_in[14];
    const float* w_er = (const float*)d_in[15]; const float* b_er = (const float*)d_in[16]; const float* w_eg = (const float*)d_in[17];
    const float* w_eu = (const float*)d_in[18]; const float* w_ed = (const float*)d_in[19];
    float* out = (float*)d_out;
    unsigned char* ws = (unsigned char*)d_ws;
    if (ws_size < WS_ACT + (size_t)T * O_END) { fprintf(stderr, "kernel_launch: workspace too small\n"); return; }
    (void)x; (void)kv_norm_g; (void)w_kv_up; (void)q_norm_g; (void)k_norm_g; (void)idx_k_norm_g; (void)ret_norm_g; (void)w_att; (void)w_ret; (void)w_out; (void)norm2_g; (void)w_gr; (void)b_gr; (void)w_er; (void)b_er; (void)w_eg; (void)w_eu; (void)w_ed;
    (void)hipMemsetAsync(ws + WS_CTL, 0, CTL_ZERO_BYTES, stream);
    Args a{};
    for (int i = 0; i < 20; ++i) a.in[i] = (const float*)d_in[i];
    a.out = out; a.ws = ws; a.xb = (unsigned char*)d_out; a.ntok = T; a.tok0 = 0;
    a.ph_lo = 0; a.ph_hi = 11;
    void* kargs[] = {(void*)&a};
    const hipError_t le = hipLaunchCooperativeKernel((const void*)mk_fwd, dim3(grid), dim3(NWAVES * 64), kargs, (unsigned)LDS_BYTES, stream);
    if (le != hipSuccess) fprintf(stderr, "kernel_launch: cooperative launch failed: %s (grid %d)\n", hipGetErrorString(le), grid);
}
```

```cpp
#include <hip/hip_runtime.h>
#include <hip/hip_cooperative_groups.h>
#include <cstdio>
#include <cstdint>

namespace pg8 {
#define PG8_LAS __attribute__((address_space(3)))
typedef unsigned short bf16_t;
typedef short bf16x8 __attribute__((ext_vector_type(8)));
typedef float f32x4 __attribute__((ext_vector_type(4)));
typedef unsigned u32x4 __attribute__((ext_vector_type(4)));
typedef unsigned u32x2 __attribute__((ext_vector_type(2)));
constexpr int BM = 256, BK = 64, HALF = 128, HTB = HALF * BK * 2  , STAGE_BYTES = 8 * HTB, NXCD = 8, WGM = 8;

__host__ __device__ __forceinline__ int lds_byte(int r, int c) { const int st = (r >> 4) * 2 + (c >> 5), rr = r & 15, cc = c & 31, ob = rr * 64 + cc * 2; return st * 1024 + (ob ^ (((ob >> 9) & 1) << 5)); }
__host__ __device__ __forceinline__ void stage_rc(int b, int& R, int& C) { const int st = b / 1024, sb = b % 1024, swz = sb ^ (((sb >> 9) & 1) << 5); R = (st >> 1) * 16 + swz / 64; C = (st & 1) * 32 + (swz % 64) / 2; }
__host__ __device__ __forceinline__ int perm32(int rho) { const int n = rho >> 4, i = rho & 15; return 8 * (i >> 2) + 4 * n + (i & 3); }

struct Unit { int pm, pn; const char* a; const char* b; long bjump; int aux; };
struct Gemm { int K, lda, ldb, ksplit; };

struct StaticOrder {
    int nM, nN, nwg, G, c; const char* A; const char* Bt; size_t tA, tB;
    __device__ void init(int M, int N, int G_, int c_, const void* A_, int lda, const void* Bt_, int ldb) { nM = M / BM; nN = N / BM; nwg = nM * nN; G = G_; c = c_; A = (const char*)A_; Bt = (const char*)Bt_; tA = (size_t)BM * lda * 2; tB = (size_t)BM * ldb * 2; }
    __device__ bool next(int i, Unit& u) const {
        const long L = (long)i * G + c; if (L >= nwg) return false;
        int wgid = (int)L; { const int q = nwg / NXCD, r = nwg % NXCD, xcd = wgid % NXCD, off = wgid / NXCD; wgid = (xcd < r ? xcd * (q + 1) : r * (q + 1) + (xcd - r) * q) + off; }
        const int nig = WGM * nN, gid = wgid / nig, fm = gid * WGM, gsz = (nM - fm) < WGM ? (nM - fm) : WGM;
        u.pm = fm + ((wgid % nig) % gsz); u.pn = (wgid % nig) / gsz; u.a = A + (size_t)u.pm * tA; u.b = Bt + (size_t)u.pn * tB; u.bjump = 0; u.aux = 0; return true;
    }
    __device__ __forceinline__ void a_ready(const Unit&) const {}
    __device__ __forceinline__ void done(const Unit&) const {}
};

typedef float f32x2c __attribute__((ext_vector_type(2))); typedef __bf16 bf16x2c __attribute__((ext_vector_type(2)));
__device__ __forceinline__ unsigned cvt_pk_bf16(float lo, float hi) { const f32x2c v = {lo, hi}; const bf16x2c b = __builtin_convertvector(v, bf16x2c); return __builtin_bit_cast(unsigned, b); }
__device__ __forceinline__ float bf_lo(unsigned w) { return __uint_as_float(w << 16); }
__device__ __forceinline__ float bf_hi(unsigned w) { return __uint_as_float(w & 0xffff0000u); }


template <class Epi, class Sched, bool ALIGN_EPI = false, bool SP2 = false>
__device__ __forceinline__ void gemm_phase(PG8_LAS unsigned char* lds, const Gemm g, const Sched& S, const Epi& E) {
    const int tid = threadIdx.x, wid = __builtin_amdgcn_readfirstlane(tid >> 6), lane = tid & 63, wr = wid >> 2, wc = wid & 3, fr = lane & 15, fq = lane >> 4;
    const int K = g.K, nt = K / BK;
    unsigned voffA[2], voffB[2];
#pragma unroll
    for (int i = 0; i < 2; ++i) { int R, C; stage_rc(tid * 16 + i * 8192, R, C); const int Rb = Epi::PERM ? ((R & ~31) + perm32(R & 31)) : R;
        voffA[i] = (unsigned)(R * g.lda + C) * 2u; voffB[i] = (unsigned)(Rb * g.ldb + C) * 2u; }
    const size_t kstep = (size_t)(BK * 2);
    const size_t hstepA = (size_t)HALF * g.lda * 2, hstepB = (size_t)HALF * g.ldb * 2;
    const unsigned ldsw = (unsigned)wid * 1024u;
    const int aoff = lds_byte(wr * 64 + fr, fq * 8), boff = lds_byte(wc * 32 + fr, fq * 8);
#define PG8_SA(b, h) (((b) * 2 + (h)) * HTB)
#define PG8_SB(b, h) ((4 + (b) * 2 + (h)) * HTB)
#define PG8_STAGE(bufoff, gbase, voff) do { _Pragma("unroll") for (int _i = 0; _i < 2; ++_i) \
        __builtin_amdgcn_global_load_lds((const unsigned*)((const char*)(gbase) + (voff)[_i]), (PG8_LAS unsigned*)(lds + (bufoff) + ldsw + _i * 8192), 16, 0, 0); } while (0)
#define PG8_LDA(dst, b, h) do { _Pragma("unroll") for (int m = 0; m < 4; ++m) _Pragma("unroll") for (int k = 0; k < 2; ++k) dst[m][k] = *(const PG8_LAS bf16x8*)(lds + PG8_SA(b, h) + aoff + m * 2048 + k * 1024); } while (0)
#define PG8_LDB(dst, b, h) do { _Pragma("unroll") for (int n = 0; n < 2; ++n) _Pragma("unroll") for (int k = 0; k < 2; ++k) dst[n][k] = *(const PG8_LAS bf16x8*)(lds + PG8_SB(b, h) + boff + n * 2048 + k * 1024); } while (0)
#define PG8_MMA(ai, bj, At, Bt) do { __builtin_amdgcn_s_setprio(1); _Pragma("unroll") for (int m = 0; m < 4; ++m) _Pragma("unroll") for (int n = 0; n < 2; ++n) _Pragma("unroll") for (int k = 0; k < 2; ++k) \
        acc[ai][bj][m][n] = __builtin_amdgcn_mfma_f32_16x16x32_bf16(Bt[n][k], At[m][k], acc[ai][bj][m][n], 0, 0, 0); __builtin_amdgcn_s_setprio(0); } while (0)
#define PG8_WAIT_V(n) asm volatile("s_waitcnt vmcnt(" #n ")" ::: "memory")
#define PG8_WAIT_L(n) asm volatile("s_waitcnt lgkmcnt(" #n ")" ::: "memory")
#define PG8_BAR __builtin_amdgcn_s_barrier()
#define PG8_SCHED __builtin_amdgcn_sched_barrier(0)
    Unit cur, nxt; int ui = 0;
    if (!S.next(0, cur)) return;
    f32x4 acc[2][2][4][2];
#pragma unroll
    for (int a = 0; a < 2; ++a)
#pragma unroll
        for (int b = 0; b < 2; ++b)
#pragma unroll
            for (int m = 0; m < 4; ++m)
#pragma unroll
                for (int n = 0; n < 2; ++n) acc[a][b][m][n] = (f32x4){0.f, 0.f, 0.f, 0.f};
    bf16x8 At[4][2], B0[2][2], B1[2][2];
    const char* cA = cur.a; const char* cB = cur.b; long cJ = cur.bjump;
    S.a_ready(cur);
    if constexpr (SP2) {
        PG8_STAGE(PG8_SB(0, 0), cB, voffB); PG8_STAGE(PG8_SB(0, 1), cB + hstepB, voffB); PG8_STAGE(PG8_SA(0, 0), cA, voffA); PG8_STAGE(PG8_SA(0, 1), cA + hstepA, voffA);
        if (wr == 1) PG8_BAR;
        PG8_WAIT_V(2); PG8_BAR;
        PG8_STAGE(PG8_SB(1, 0), cB + kstep, voffB); PG8_STAGE(PG8_SA(1, 0), cA + kstep, voffA); PG8_STAGE(PG8_SB(1, 1), cB + hstepB + kstep, voffB);
        PG8_WAIT_V(6); PG8_BAR;
    } else {
        PG8_STAGE(PG8_SB(0, 0), cB, voffB); PG8_STAGE(PG8_SA(0, 0), cA, voffA); PG8_STAGE(PG8_SB(0, 1), cB + hstepB, voffB); PG8_STAGE(PG8_SA(0, 1), cA + hstepA, voffA);
        if (wr == 1) PG8_BAR;
        PG8_WAIT_V(4); PG8_BAR;
        PG8_STAGE(PG8_SB(1, 0), cB + kstep, voffB); PG8_STAGE(PG8_SA(1, 0), cA + kstep, voffA); PG8_STAGE(PG8_SB(1, 1), cB + hstepB + kstep, voffB);
        PG8_WAIT_V(6); PG8_BAR;
    }
    for (;;) {
        const bool has_next = S.next(ui + 1, nxt);
        const char* nA = has_next ? nxt.a : cA; const char* nB = has_next ? nxt.b : cB;
#pragma unroll 1
        for (int t = 0; t < nt; t += 2) {
            const bool last = (t == nt - 2);
            const char* a1 = cA + (size_t)(t + 1) * kstep;
            const char* a2 = last ? nA : cA + (size_t)(t + 2) * kstep; const char* b2 = last ? nB : cB + (size_t)(t + 2) * kstep + ((t + 2) >= g.ksplit ? cJ : 0L);
            const char* a3 = a2 + kstep; const char* b3 = b2 + kstep;
            if (last && has_next) S.a_ready(nxt);
            if constexpr (SP2) {
            PG8_LDB(B0, 0, 0); PG8_LDB(B1, 0, 1); PG8_SCHED; PG8_LDA(At, 0, 0); PG8_STAGE(PG8_SA(1, 1), a1 + hstepA, voffA);
            PG8_WAIT_V(8); PG8_WAIT_L(0); PG8_BAR; PG8_MMA(0, 0, At, B0); PG8_MMA(0, 1, At, B1); PG8_BAR; PG8_SCHED;
            PG8_LDA(At, 0, 1); PG8_STAGE(PG8_SB(0, 0), b2, voffB); PG8_STAGE(PG8_SB(0, 1), b2 + hstepB, voffB); PG8_STAGE(PG8_SA(0, 0), a2, voffA);
            PG8_WAIT_V(8); PG8_WAIT_L(0); PG8_BAR; PG8_MMA(1, 0, At, B0); PG8_MMA(1, 1, At, B1); PG8_BAR; PG8_SCHED;
            PG8_LDB(B0, 1, 0); PG8_LDB(B1, 1, 1); PG8_SCHED; PG8_LDA(At, 1, 0); PG8_STAGE(PG8_SA(0, 1), a2 + hstepA, voffA);
            PG8_WAIT_V(8); PG8_WAIT_L(0); PG8_BAR; PG8_MMA(0, 0, At, B0); PG8_MMA(0, 1, At, B1); PG8_BAR; PG8_SCHED;
            PG8_LDA(At, 1, 1); PG8_STAGE(PG8_SB(1, 0), b3, voffB); PG8_STAGE(PG8_SB(1, 1), b3 + hstepB, voffB); PG8_STAGE(PG8_SA(1, 0), a3, voffA);
            PG8_WAIT_V(8); PG8_WAIT_L(0); PG8_BAR; PG8_MMA(1, 0, At, B0); PG8_MMA(1, 1, At, B1); PG8_BAR; PG8_SCHED;
            } else {
            PG8_LDB(B0, 0, 0); PG8_SCHED; PG8_LDA(At, 0, 0); PG8_STAGE(PG8_SA(1, 1), a1 + hstepA, voffA);
            PG8_WAIT_L(8); PG8_BAR; PG8_WAIT_L(0); PG8_MMA(0, 0, At, B0); PG8_BAR; PG8_SCHED;
            PG8_LDB(B1, 0, 1); PG8_STAGE(PG8_SB(0, 0), b2, voffB);
            PG8_BAR; PG8_WAIT_L(0); PG8_MMA(0, 1, At, B1); PG8_BAR;
            PG8_LDA(At, 0, 1); PG8_STAGE(PG8_SA(0, 0), a2, voffA);
            PG8_BAR; PG8_WAIT_L(0); PG8_MMA(1, 0, At, B0); PG8_BAR; PG8_SCHED;
            PG8_STAGE(PG8_SB(0, 1), b2 + hstepB, voffB);
            PG8_WAIT_V(6); PG8_BAR; PG8_MMA(1, 1, At, B1); PG8_BAR;
            PG8_LDB(B0, 1, 0); PG8_SCHED; PG8_LDA(At, 1, 0); PG8_STAGE(PG8_SA(0, 1), a2 + hstepA, voffA);
            PG8_WAIT_L(8); PG8_BAR; PG8_WAIT_L(0); PG8_MMA(0, 0, At, B0); PG8_BAR; PG8_SCHED;
            PG8_LDB(B1, 1, 1); PG8_STAGE(PG8_SB(1, 0), b3, voffB);
            PG8_BAR; PG8_WAIT_L(0); PG8_MMA(0, 1, At, B1); PG8_BAR;
            PG8_LDA(At, 1, 1); PG8_STAGE(PG8_SA(1, 0), a3, voffA);
            PG8_BAR; PG8_WAIT_L(0); PG8_MMA(1, 0, At, B0); PG8_BAR; PG8_SCHED;
            PG8_STAGE(PG8_SB(1, 1), b3 + hstepB, voffB);
            PG8_WAIT_V(6); PG8_BAR; PG8_MMA(1, 1, At, B1); PG8_BAR;
            }
        }
        if constexpr (ALIGN_EPI) { if (wr == 0) PG8_BAR; }
        if constexpr (!Epi::AFTER_DRAIN) { E(acc, cur, wr, wc, fr, fq); S.done(cur); }
        if (!has_next) break;
#pragma unroll
        for (int a = 0; a < 2; ++a)
#pragma unroll
            for (int b = 0; b < 2; ++b)
#pragma unroll
                for (int m = 0; m < 4; ++m)
#pragma unroll
                    for (int n = 0; n < 2; ++n) acc[a][b][m][n] = (f32x4){0.f, 0.f, 0.f, 0.f};
        cur = nxt; cA = nA; cB = nB; cJ = cur.bjump; ++ui;
        if constexpr (ALIGN_EPI) { if (wr == 1) PG8_BAR; }
    }
    PG8_WAIT_V(0);
    if constexpr (!ALIGN_EPI) { if (wr == 0) PG8_BAR; }
    PG8_BAR;
    if constexpr (Epi::AFTER_DRAIN) { E.fused(acc, cur, wr, wc, fr, fq, lds, wid, lane); S.done(cur); }
#undef PG8_SA
#undef PG8_SB
#undef PG8_STAGE
#undef PG8_LDA
#undef PG8_LDB
#undef PG8_MMA
#undef PG8_WAIT_V
#undef PG8_WAIT_L
#undef PG8_BAR
#undef PG8_SCHED
}
}

#ifndef PROBE_PH
#define PROBE_PH (-1)
#endif
#ifndef PROBE_MODE
#define PROBE_MODE (0)
#endif
constexpr int D = 1024, BATCH = 16, SEQ = 2048, T = BATCH * SEQ;
constexpr int INW = 6984, INWP = 7168;
constexpr int C_QA = 0, C_CKV = 1024, C_QI = 1280, C_KI = 1792, C_WI = 1856, C_RQ = 1864, C_RK = 2376, C_RV = 2888, C_RG = 3912, C_GA = 4936, C_GR = 5960;
constexpr float EPS = 1e-6f;
constexpr int NWAVES = 8;

constexpr size_t MiB = 1u << 20;
constexpr size_t WS_CTL = 0, CTL_ZERO_BYTES = 1 * MiB;
constexpr size_t WS_WIN = 1 * MiB, WS_WKV = 15 * MiB, WS_WATT = 16 * MiB, WS_WRET = 18 * MiB, WS_WOUT = 20 * MiB, WS_W1 = 22 * MiB, WS_WD = 38 * MiB, WS_ACT = 46 * MiB;
constexpr size_t O_QA = 0, O_CKV = 2048, O_QI = 2560, O_KW = 3584, O_RQ = 3840, O_RK = 4864, O_RV = 5888, O_RG = 7936, O_GA = 9984, O_GR = 12032, O_END = 14080;

constexpr int MP_ROWS = 38912;
constexpr size_t MO_APERM = 0, MO_ACT = 80 * MiB, MO_N2 = 120 * MiB, MO_META = 184 * MiB;
constexpr size_t MM_B = 0, MM_P = 131072, MM_CL = 262144, MM_CH = 393216, MM_RS = 524288, MM_PTOK = 655360, MM_PRS = 819200, MM_PCL = 983040, MM_PCH = 1146880, MM_END = 1310720;
constexpr size_t WS_WR = 15 * MiB + 512 * 1024;
constexpr int CW_MOE = 256;
constexpr int RING_OFF = 0, RING_BYTES = 131072, P3_HIST_OFF = 131072, P3_TOT_OFF = 147456, P3_T_OFF = 149504, LDSCTL_OFF = 151552, MISC_OFF = LDSCTL_OFF + 320, LDS_BYTES = 152576;
constexpr int CW_Q3 = 64, CW_Q4 = 128;

#define GAS __attribute__((address_space(1)))
#define LAS __attribute__((address_space(3)))
typedef unsigned short bf16;
typedef unsigned v4u __attribute__((ext_vector_type(4)));
typedef float f32x4 __attribute__((ext_vector_type(4)));
#define LDS_WAIT() asm volatile("s_waitcnt lgkmcnt(0)" ::: "memory")
#define VM_WAIT() asm volatile("s_waitcnt vmcnt(0)" ::: "memory")
__device__ __forceinline__ unsigned f2bf(float f) { unsigned u = __builtin_bit_cast(unsigned, f); return (u + 0x7fffu + ((u >> 16) & 1u)) >> 16; }
__device__ __forceinline__ unsigned pk2(float lo, float hi) { return f2bf(lo) | (f2bf(hi) << 16); }
__device__ __forceinline__ float bf2f(bf16 b) { return __uint_as_float((unsigned)b << 16); }


typedef GAS unsigned gu32;
constexpr int CW_BAR = 4096;
#define XB_TMO      128
#define XB_XCNT(j)  (256  + 64 * (j))
#define XB_XSUB(j)  (1280 + 64 * (j))
#define XB_XGEN(j)  (2304 + 64 * (j))
#define XB_TOP      3328
#define XB_TOPGEN   3392
#define XCD_BAR_WORDS 3456
#define XB_SPIN_CAP (1u << 18)

__device__ __forceinline__ unsigned xb_ld(unsigned* p)              { return __hip_atomic_load(p, __ATOMIC_RELAXED, __HIP_MEMORY_SCOPE_AGENT); }
__device__ __forceinline__ unsigned xb_add(unsigned* p, unsigned v) { return __hip_atomic_fetch_add(p, v, __ATOMIC_RELAXED, __HIP_MEMORY_SCOPE_AGENT); }
__device__ __forceinline__ unsigned xb_xcc_id() { return (unsigned)__builtin_amdgcn_s_getreg((3 << 11) | 20) & 0xFu; }
#define XB_SPIN(cond, bar) do { unsigned _sp = 0; while (cond) { __builtin_amdgcn_s_sleep(1); \
    if ((++_sp & 255u) == 0u) { if (xb_ld(&(bar)[XB_TMO])) break; if (_sp > XB_SPIN_CAP) { atomicAdd(&(bar)[XB_TMO], 1u); break; } } } } while (0)

struct XcdBarrier {
    unsigned* bar; unsigned x;
    volatile LAS unsigned* st;
};

__device__ __forceinline__ XcdBarrier xcd_barrier_post(unsigned* bar, volatile LAS unsigned* st) {
    XcdBarrier b; b.bar = bar; b.x = xb_xcc_id(); b.st = st;
    if (threadIdx.x == 0) (void)xb_add(&bar[XB_XCNT(b.x)], 1u);
    return b;
}
__device__ __forceinline__ void xcd_barrier_complete(unsigned* bar, unsigned x, unsigned& nloc, unsigned& nx) {
    const unsigned G = gridDim.x * gridDim.y * gridDim.z;
    unsigned sum, cnt, mine, sp = 0u;
    for (;;) {
        sum = 0u; cnt = 0u; mine = 0u;
#pragma unroll
        for (unsigned j = 0; j < 16; ++j) { const unsigned c = xb_ld(&bar[XB_XCNT(j)]); sum += c; cnt += (c > 0u) ? 1u : 0u; mine = (j == x) ? c : mine; }
        if (sum == G) break;
        __builtin_amdgcn_s_sleep(1);
        if ((++sp & 255u) == 0u) { if (xb_ld(&bar[XB_TMO])) break; if (sp > XB_SPIN_CAP) { atomicAdd(&bar[XB_TMO], 1u); break; } }
    }
    nloc = mine > 0u ? mine : 1u; nx = cnt > 0u ? cnt : 1u;
}

__device__ __forceinline__ void xcd_barrier(const XcdBarrier& b) {
    asm volatile("s_waitcnt vmcnt(0)" ::: "memory");
    __syncthreads();
    if (threadIdx.x == 0) {
        unsigned* bar = b.bar;
        __builtin_amdgcn_s_waitcnt(0);
        unsigned nloc = b.st[0], nx = b.st[1];
        if (nloc == 0u) { xcd_barrier_complete(bar, b.x, nloc, nx); b.st[0] = nloc; b.st[1] = nx; }
        const unsigned old = xb_add(&bar[XB_XSUB(b.x)], 1u);
        const unsigned gen = old / nloc;
        if (old + 1u == (gen + 1u) * nloc) {
            __builtin_amdgcn_fence(__ATOMIC_RELEASE, "agent");
            asm volatile("s_waitcnt vmcnt(0)" ::: "memory");
            const unsigned og = xb_add(&bar[XB_TOP], 1u);
            const unsigned tg = og / nx;
            if (og + 1u == (tg + 1u) * nx) xb_add(&bar[XB_TOPGEN], 1u);
            else XB_SPIN(xb_ld(&bar[XB_TOPGEN]) == tg, bar);
            __builtin_amdgcn_fence(__ATOMIC_ACQUIRE, "agent");
            xb_add(&bar[XB_XGEN(b.x)], 1u);
            asm volatile("s_waitcnt vmcnt(0)" ::: "memory");
        } else {
            XB_SPIN(xb_ld(&bar[XB_XGEN(b.x)]) == gen, bar);
            __builtin_amdgcn_fence(__ATOMIC_ACQUIRE, "agent");
            asm volatile("s_waitcnt vmcnt(0)" ::: "memory");
        }
    }
    __syncthreads();
}

struct Args { const float* in[20]; float* out; unsigned char* ws; unsigned char* xb; int ph_lo, ph_hi, ntok, tok0, mode, pad; };

struct Frame {
    LAS unsigned char* lds;
    int tid, lane, wave, vcu, G;
    int ntok;
    unsigned char* ws; unsigned char* act;
};

struct EpiProj {
    static constexpr bool PERM = true, AFTER_DRAIN = false;
    unsigned char* act; size_t ntok;
    __device__ __forceinline__ void operator()(const pg8::f32x4 (&acc)[2][2][4][2], const pg8::Unit& u, int wr, int wc, int fr, int fq) const {
        const int pn = u.pn; size_t O; int ld, cb, nbj = 2;
        if (pn < 4) { O = O_QA; ld = 1024; cb = pn * 256; }
        else if (pn == 4) { O = O_CKV; ld = 256; cb = 0; }
        else if (pn < 7) { O = O_QI; ld = 512; cb = (pn - 5) * 256; }
        else if (pn == 7) { O = O_KW; ld = 128; cb = 0; nbj = 1; }
        else if (pn < 10) { O = O_RQ; ld = 512; cb = (pn - 8) * 256; }
        else if (pn < 12) { O = O_RK; ld = 512; cb = (pn - 10) * 256; }
        else { O = O_RV + (size_t)((pn - 12) >> 2) * 2048; ld = 1024; cb = ((pn - 12) & 3) * 256; }
        pg8::bf16_t* base = (pg8::bf16_t*)(act + ntok * O);
        const int row0 = u.pm * pg8::BM + wr * 64 + fr, col0 = cb + wc * 32 + 8 * fq;
#pragma unroll
        for (int ai = 0; ai < 2; ++ai)
#pragma unroll
            for (int m = 0; m < 4; ++m) { pg8::bf16_t* rowp = base + (size_t)(row0 + ai * pg8::HALF + m * 16) * ld + col0;
#pragma unroll
                for (int bj = 0; bj < 2; ++bj) if (bj < nbj) { const pg8::f32x4 v0 = acc[ai][bj][m][0], v1 = acc[ai][bj][m][1];
                    pg8::u32x4 w; w.x = pg8::cvt_pk_bf16(v0[0], v0[1]); w.y = pg8::cvt_pk_bf16(v0[2], v0[3]); w.z = pg8::cvt_pk_bf16(v1[0], v1[1]); w.w = pg8::cvt_pk_bf16(v1[2], v1[3]);
                    *(pg8::u32x4*)(rowp + bj * pg8::HALF) = w; } }
    }
};


__device__ __forceinline__ float sigm(float x) { return __builtin_amdgcn_rcpf(1.f + __builtin_amdgcn_exp2f(-1.4426950408889634f * x)); }
struct EpiGateA {
    static constexpr bool PERM = true, AFTER_DRAIN = false;
    pg8::bf16_t* GA;
    __device__ __forceinline__ void operator()(const pg8::f32x4 (&acc)[2][2][4][2], const pg8::Unit& u, int wr, int wc, int fr, int fq) const {
        const int row0 = u.pm * pg8::BM + wr * 64 + fr, col0 = u.pn * pg8::BM + wc * 32 + 8 * fq;
#pragma unroll
        for (int ai = 0; ai < 2; ++ai)
#pragma unroll
            for (int m = 0; m < 4; ++m) { pg8::bf16_t* rowp = GA + (size_t)(row0 + ai * pg8::HALF + m * 16) * 1024 + col0;
#pragma unroll
                for (int bj = 0; bj < 2; ++bj) { const pg8::u32x4 g = *(const pg8::u32x4*)(rowp + bj * pg8::HALF); const pg8::f32x4 v0 = acc[ai][bj][m][0], v1 = acc[ai][bj][m][1];
                    pg8::u32x4 w; w.x = pg8::cvt_pk_bf16(sigm(pg8::bf_lo(g.x)) * v0[0], sigm(pg8::bf_hi(g.x)) * v0[1]); w.y = pg8::cvt_pk_bf16(sigm(pg8::bf_lo(g.y)) * v0[2], sigm(pg8::bf_hi(g.y)) * v0[3]);
                    w.z = pg8::cvt_pk_bf16(sigm(pg8::bf_lo(g.z)) * v1[0], sigm(pg8::bf_hi(g.z)) * v1[1]); w.w = pg8::cvt_pk_bf16(sigm(pg8::bf_lo(g.w)) * v1[2], sigm(pg8::bf_hi(g.w)) * v1[3]);
                    *(pg8::u32x4*)(rowp + bj * pg8::HALF) = w; } }
    }
};
struct EpiGateB {
    static constexpr bool PERM = true, AFTER_DRAIN = false;
    pg8::bf16_t* GA; const pg8::bf16_t* GR;
    __device__ __forceinline__ void operator()(const pg8::f32x4 (&acc)[2][2][4][2], const pg8::Unit& u, int wr, int wc, int fr, int fq) const {
        const int row0 = u.pm * pg8::BM + wr * 64 + fr, col0 = u.pn * pg8::BM + wc * 32 + 8 * fq;
#pragma unroll
        for (int ai = 0; ai < 2; ++ai)
#pragma unroll
            for (int m = 0; m < 4; ++m) { const size_t ro = (size_t)(row0 + ai * pg8::HALF + m * 16) * 1024 + col0;
#pragma unroll
                for (int bj = 0; bj < 2; ++bj) { const pg8::u32x4 t = *(const pg8::u32x4*)(GA + ro + bj * pg8::HALF), g = *(const pg8::u32x4*)(GR + ro + bj * pg8::HALF); const pg8::f32x4 v0 = acc[ai][bj][m][0], v1 = acc[ai][bj][m][1];
                    pg8::u32x4 w; w.x = pg8::cvt_pk_bf16(pg8::bf_lo(t.x) + sigm(pg8::bf_lo(g.x)) * v0[0], pg8::bf_hi(t.x) + sigm(pg8::bf_hi(g.x)) * v0[1]); w.y = pg8::cvt_pk_bf16(pg8::bf_lo(t.y) + sigm(pg8::bf_lo(g.y)) * v0[2], pg8::bf_hi(t.y) + sigm(pg8::bf_hi(g.y)) * v0[3]);
                    w.z = pg8::cvt_pk_bf16(pg8::bf_lo(t.z) + sigm(pg8::bf_lo(g.z)) * v1[0], pg8::bf_hi(t.z) + sigm(pg8::bf_hi(g.z)) * v1[1]); w.w = pg8::cvt_pk_bf16(pg8::bf_lo(t.w) + sigm(pg8::bf_lo(g.w)) * v1[2], pg8::bf_hi(t.w) + sigm(pg8::bf_hi(g.w)) * v1[3]);
                    *(pg8::u32x4*)(GA + ro + bj * pg8::HALF) = w; } }
    }
};
struct EpiResid {
    static constexpr bool PERM = false, AFTER_DRAIN = false;
    const float* x; float* out;
    __device__ __forceinline__ void operator()(const pg8::f32x4 (&acc)[2][2][4][2], const pg8::Unit& u, int wr, int wc, int fr, int fq) const {
        const int row0 = u.pm * pg8::BM + wr * 64 + fr, col0 = u.pn * pg8::BM + wc * 32 + 4 * fq;
#pragma unroll
        for (int ai = 0; ai < 2; ++ai)
#pragma unroll
            for (int m = 0; m < 4; ++m) { const size_t ro = (size_t)(row0 + ai * pg8::HALF + m * 16) * 1024 + col0;
#pragma unroll
                for (int bj = 0; bj < 2; ++bj)
#pragma unroll
                    for (int n = 0; n < 2; ++n) { const size_t o = ro + bj * pg8::HALF + n * 16; *(pg8::f32x4*)(out + o) = *(const pg8::f32x4*)(x + o) + acc[ai][bj][m][n]; } }
    }
};

__device__ __forceinline__ float wave_sum(float v) {
#pragma unroll
    for (int o = 1; o < 64; o <<= 1) v += __shfl_xor(v, o);
    return v;
}
__device__ __forceinline__ void p0_transpose_item(const float* W, int K, int N, bf16* WT, int map, int row_off, int par, const float* gk, LAS float* scr, int item, int lane) {
    const int nblk = (N + 31) / 32, kb = item / nblk, nb = item % nblk, k0 = 64 * kb, n0 = 32 * nb;
    const int nn = n0 + (lane & 31);
#pragma unroll 8
    for (int i = 0; i < 32; ++i) { const int kk = 2 * i + (lane >> 5); float v = (nn < N) ? W[(size_t)(k0 + kk) * N + nn] : 0.f; if (gk) v *= gk[k0 + kk]; scr[kk * 33 + (lane & 31)] = v; }
    LDS_WAIT(); asm volatile("" ::: "memory");
    const int c = lane & 7;
#pragma unroll
    for (int j = 0; j < 4; ++j) { const int nl = (lane >> 3) + 8 * j, n = n0 + nl; const LAS float* s = scr + (8 * c) * 33 + nl;
        v4u o; o.x = pk2(s[0 * 33], s[1 * 33]); o.y = pk2(s[2 * 33], s[3 * 33]); o.z = pk2(s[4 * 33], s[5 * 33]); o.w = pk2(s[6 * 33], s[7 * 33]);
        if (n < N) { const int row = (map == 0) ? row_off + n : (map == 1) ? (n < 1864 ? n : n + 184) : row_off + 2 * n + par;
            *(GAS v4u*)(WT + (size_t)row * K + k0 + 8 * c) = o; } }
    LDS_WAIT(); asm volatile("" ::: "memory");
}
__device__ __forceinline__ void p0_prologue(Frame& F, const Args& a) {
    LAS float* scr = (LAS float*)(F.lds + RING_OFF + F.wave * 16384);
    const int gw = F.vcu * NWAVES + F.wave, NGW = F.G * NWAVES;
    bf16* Win_t = (bf16*)(F.ws + WS_WIN); bf16* Wkv_t = (bf16*)(F.ws + WS_WKV); bf16* Watt_t = (bf16*)(F.ws + WS_WATT); bf16* Wret_t = (bf16*)(F.ws + WS_WRET);
    bf16* Wout_t = (bf16*)(F.ws + WS_WOUT); bf16* W1_t = (bf16*)(F.ws + WS_W1); bf16* Wd_t = (bf16*)(F.ws + WS_WD);
    constexpr int I_IN = 16 * 219, I_KV = 4 * 8, I_SQ = 16 * 32, I_GU = 16 * 8  , I_DN = 4 * 32  ;
    constexpr int NITEMS = I_IN + I_KV + 3 * I_SQ + 16 * (2 * I_GU + I_DN);
    for (int it = gw; it < NITEMS; it += NGW) {
        int r = it;
        if (r < I_IN) { p0_transpose_item(a.in[2], 1024, INW, Win_t, 1, 0, 0, a.in[1], scr, r, F.lane); continue; } r -= I_IN;
        if (r < I_KV) { p0_transpose_item(a.in[4], 256, 256, Wkv_t, 0, 0, 0, a.in[3], scr, r, F.lane); continue; } r -= I_KV;
        if (r < I_SQ) { p0_transpose_item(a.in[9], 1024, 1024, Watt_t, 0, 0, 0, nullptr, scr, r, F.lane); continue; } r -= I_SQ;
        if (r < I_SQ) { p0_transpose_item(a.in[10], 1024, 1024, Wret_t, 0, 0, 0, nullptr, scr, r, F.lane); continue; } r -= I_SQ;
        if (r < I_SQ) { p0_transpose_item(a.in[11], 1024, 1024, Wout_t, 0, 0, 0, nullptr, scr, r, F.lane); continue; } r -= I_SQ;
        const int e = r / (2 * I_GU + I_DN), q = r % (2 * I_GU + I_DN);
        if (q < I_GU) p0_transpose_item(a.in[17] + (size_t)e * 1024 * 256, 1024, 256, W1_t, 2, e * 512, 0, nullptr, scr, q, F.lane);
        else if (q < 2 * I_GU) p0_transpose_item(a.in[18] + (size_t)e * 1024 * 256, 1024, 256, W1_t, 2, e * 512, 1, nullptr, scr, q - I_GU, F.lane);
        else p0_transpose_item(a.in[19] + (size_t)e * 256 * 1024, 256, 1024, Wd_t + (size_t)e * 1024 * 256, 0, 0, 0, nullptr, scr, q - 2 * I_GU, F.lane);
    }
    { const int gt = (F.vcu * NWAVES + F.wave) * 64 + F.lane, NGT = F.G * NWAVES * 64; GAS v4u* z = (GAS v4u*)(Win_t + (size_t)1864 * 1024);
      for (int i = gt; i < 184 * 1024 * 2 / 16; i += NGT) z[i] = (v4u){0u, 0u, 0u, 0u}; }
    { const int gt = (F.vcu * NWAVES + F.wave) * 64 + F.lane, NGT = F.G * NWAVES * 64; bf16* Wh = (bf16*)(F.ws + WS_WR); bf16* Wl = Wh + 32 * 1024;
      for (int i = gt; i < 32 * 1024; i += NGT) { const int n = i >> 10, k = i & 1023; const float wv = n < 4 ? a.in[13][k * 4 + n] : (n < 20 ? a.in[15][k * 16 + (n - 4)] : 0.f);
        const unsigned hb = f2bf(wv); const float hf = __uint_as_float(hb << 16); Wh[i] = (bf16)hb; Wl[i] = (bf16)f2bf(wv - hf); } }
    const float* x = a.in[0] + (size_t)a.tok0 * D;
    for (int m = gw; m < F.ntok; m += NGW) {
        const GAS f32x4* xr = (const GAS f32x4*)(x + (size_t)m * D) + F.lane;
        f32x4 v[4]; float s = 0.f;
#pragma unroll
        for (int j = 0; j < 4; ++j) { v[j] = xr[64 * j]; s += (v[j].x * v[j].x + v[j].y * v[j].y) + (v[j].z * v[j].z + v[j].w * v[j].w); }
        const float rstd = 1.f / sqrtf(wave_sum(s) * (1.f / D) + EPS);
        GAS unsigned long long* o8 = (GAS unsigned long long*)(a.xb + (size_t)m * D * 2) + F.lane;
#pragma unroll
        for (int j = 0; j < 4; ++j) o8[64 * j] = (unsigned long long)pk2(v[j].x * rstd, v[j].y * rstd) | ((unsigned long long)pk2(v[j].z * rstd, v[j].w * rstd) << 32);
    }
}


constexpr size_t AUX_KP = 0, AUX_VV = 256, AUX_KIN = 512, AUX_MASK = 640, AUX_END = 896;
typedef short bf16x8_t __attribute__((ext_vector_type(8)));
typedef float f32x16 __attribute__((ext_vector_type(16)));
__device__ __forceinline__ int crow(int r, int hi) { return (r & 3) + 8 * (r >> 2) + 4 * hi; }
__device__ __forceinline__ float xhalf_sum(float v) { auto rr = __builtin_amdgcn_permlane32_swap(__float_as_uint(v), __float_as_uint(v), false, false); return __uint_as_float(rr[0]) + __uint_as_float(rr[1]); }
__device__ __forceinline__ float sumsq8(bf16x8_t v) { float s = 0.f;
#pragma unroll
    for (int j = 0; j < 8; ++j) { const float f = __uint_as_float((unsigned)(unsigned short)v[j] << 16); s += f * f; } return s; }
__device__ __forceinline__ void p2_post(Frame& F, const Args& a) {
    const int gw = F.vcu * NWAVES + F.wave, NGW = F.G * NWAVES, lane = F.lane, r32 = lane & 31, hi = lane >> 5;
    const size_t nt_ = (size_t)F.ntok;
    const bf16* CKV = (const bf16*)(F.act + nt_ * O_CKV); const bf16* KW = (const bf16*)(F.act + nt_ * O_KW);
    const bf16* Wkv_t = (const bf16*)(F.ws + WS_WKV);
    unsigned char* aux = a.xb + nt_ * 2048;
    bf16* KP = (bf16*)(aux + nt_ * AUX_KP); bf16* VV = (bf16*)(aux + nt_ * AUX_VV); bf16* KIN = (bf16*)(aux + nt_ * AUX_KIN);
    const float* g_q = a.in[5]; const float* g_k = a.in[6]; const float* g_ki = a.in[7];
    const int ntask = 2 * (F.ntok / 32);
    for (int task = gw; task < ntask; task += NGW) {
        const int kind = task & 1, t0 = (task >> 1) * 32;
        const bf16* crowp = CKV + (size_t)(t0 + r32) * 256 + hi * 8;
        bf16x8_t bfr[16]; float ss = 0.f;
#pragma unroll
        for (int kk = 0; kk < 16; ++kk) { bfr[kk] = *(const bf16x8_t*)(crowp + kk * 16); ss += sumsq8(bfr[kk]); }
        ss = xhalf_sum(ss);
        const float rstd = rsqrtf(ss * (1.f / 256.f) + EPS);
        f32x16 acc[4];
#pragma unroll
        for (int nt = 0; nt < 4; ++nt) { acc[nt] = f32x16{};
            const bf16* wrow = Wkv_t + (size_t)(kind * 128 + nt * 32 + r32) * 256 + hi * 8;
#pragma unroll
            for (int kk = 0; kk < 16; ++kk) { const bf16x8_t af = *(const bf16x8_t*)(wrow + kk * 16); acc[nt] = __builtin_amdgcn_mfma_f32_32x32x16_bf16(af, bfr[kk], acc[nt], 0, 0, 0); } }
        float sc = rstd;
        if (kind == 0) { float sk = 0.f;
#pragma unroll
            for (int nt = 0; nt < 4; ++nt)
#pragma unroll
                for (int r = 0; r < 16; ++r) { const float v = acc[nt][r] * rstd; sk += v * v; }
            sk = xhalf_sum(sk);
            sc = rstd * rsqrtf(sk * (1.f / 128.f) + EPS) * (0.08838834764831845f * 1.4426950408889634f); }
        bf16* orow = (kind == 0 ? KP : VV) + (size_t)(t0 + r32) * 128;
#pragma unroll
        for (int nt = 0; nt < 4; ++nt)
#pragma unroll
            for (int g = 0; g < 4; ++g) { const int ch = nt * 32 + 8 * g + 4 * hi; float v[4];
#pragma unroll
                for (int j = 0; j < 4; ++j) { v[j] = acc[nt][4 * g + j] * sc; if (kind == 0) v[j] *= g_k[ch + j] * g_q[ch + j]; }
                *(unsigned long long*)(orow + ch) = (unsigned long long)pk2(v[0], v[1]) | ((unsigned long long)pk2(v[2], v[3]) << 32); }
        if (kind == 0) {
            const bf16* kr = KW + (size_t)(t0 + r32) * 128 + hi * 32; bf16x8_t kv4[4]; float s2 = 0.f;
#pragma unroll
            for (int j = 0; j < 4; ++j) { kv4[j] = *(const bf16x8_t*)(kr + 8 * j); s2 += sumsq8(kv4[j]); }
            s2 = xhalf_sum(s2);
            const float rk = rsqrtf(s2 * (1.f / 64.f) + EPS);
            bf16* ko = KIN + (size_t)(t0 + r32) * 64 + hi * 32;
#pragma unroll
            for (int j = 0; j < 4; ++j) { float f[8];
#pragma unroll
                for (int e = 0; e < 8; ++e) f[e] = __uint_as_float((unsigned)(unsigned short)kv4[j][e] << 16) * rk * g_ki[hi * 32 + 8 * j + e];
                v4u o; o.x = pk2(f[0], f[1]); o.y = pk2(f[2], f[3]); o.z = pk2(f[4], f[5]); o.w = pk2(f[6], f[7]);
                *(v4u*)(ko + 8 * j) = o; }
        }
    }
}


typedef float f32x4_t __attribute__((ext_vector_type(4)));
__device__ __forceinline__ unsigned key15_of(float s) { const unsigned short hb = __builtin_bit_cast(unsigned short, (_Float16)s); const unsigned u = (hb & 0x8000u) ? (~(unsigned)hb & 0xffffu) : ((unsigned)hb | 0x8000u); return u >> 1; }
__device__ __forceinline__ unsigned sad4(unsigned x) { return __builtin_amdgcn_sad_u8(x, 0u, 0u); }
__device__ __forceinline__ void p3_merge(LAS unsigned* hist, LAS unsigned short* tot, int w, int g, int q, int& need, int& bsel) {
    __syncthreads();
    const int o = 4 * w + g; unsigned c = 0;
#pragma unroll
    for (int p = 0; p < 32; ++p) { const int tidp = (p >> 2) * 64 + (p & 3) * 16 + q; c += (hist[(o >> 2) * 512 + tidp] >> (8 * (o & 3))) & 0xffu; }
    tot[q * 32 + o] = (unsigned short)c;
    __syncthreads();
    v4u tv[4];
#pragma unroll
    for (int j = 0; j < 4; ++j) tv[j] = *(const LAS v4u*)((const LAS unsigned char*)tot + q * 64 + j * 16);
    int cum = 0, bs = 0, ab = 0; bool found = false;
#pragma unroll
    for (int bin = 31; bin >= 0; --bin) { const unsigned wd = tv[bin >> 3][(bin >> 1) & 3]; const int cc = (int)((bin & 1) ? (wd >> 16) : (wd & 0xffffu));
        if (!found && cum + cc >= need) { bs = bin; ab = cum; found = true; } cum += cc; }
    bsel = bs; need -= ab;
}
__device__ __forceinline__ void p3_index(Frame& F, const Args& a) {
    const int tid = F.tid, lane = F.lane, w = F.wave, q = lane & 15, g = lane >> 4;
    LAS unsigned* keys = (LAS unsigned*)(F.lds + RING_OFF);
    LAS unsigned* hist = (LAS unsigned*)(F.lds + P3_HIST_OFF);
    LAS unsigned short* tot = (LAS unsigned short*)(F.lds + P3_TOT_OFF);
    LAS unsigned char* Tt = (LAS unsigned char*)(F.lds + P3_T_OFF);
    volatile LAS unsigned* MISC = (volatile LAS unsigned*)(F.lds + MISC_OFF);
    const size_t nt_ = (size_t)F.ntok;
    const bf16* QI = (const bf16*)(F.act + nt_ * O_QI); const bf16* KW = (const bf16*)(F.act + nt_ * O_KW);
    unsigned char* aux = a.xb + nt_ * 2048;
    const bf16* KIN = (const bf16*)(aux + nt_ * AUX_KIN); unsigned* MASK = (unsigned*)(aux + nt_ * AUX_MASK);
    unsigned* qctr = (unsigned*)(F.ws + WS_CTL) + CW_Q3;
    const int nb = F.ntok / SEQ, nitems = nb * 128;
    for (;;) {
        __syncthreads(); if (tid == 0) MISC[0] = atomicAdd(qctr, 1u); __syncthreads();
        const int it = (int)MISC[0]; if (it >= nitems) break;
        const int qg = 127 - it / nb, b = it % nb, q0 = qg * 16, qme = q0 + q; const size_t tokq = (size_t)b * SEQ + qme;
        unsigned* Mb = MASK + (size_t)b * 64 * 2048;
        const int kb_hi = ((qg >> 3) + 1) << 2, nkb = (qg >> 1) + 1;
        if (qg < 16) {
            if (tid < kb_hi * 16) { const int kb = tid >> 4, qq = q0 + (tid & 15), nbits = qq - kb * 32 + 1; Mb[kb * 2048 + qq] = nbits >= 32 ? 0xffffffffu : (nbits <= 0 ? 0u : ((1u << nbits) - 1u)); }
            continue;
        }
        float wq[8];
        { const v4u wv = *(const v4u*)(KW + tokq * 128 + 64); const float c = 0.35355339059327373f * 0.125f;
          wq[0] = pg8::bf_lo(wv.x) * c; wq[1] = pg8::bf_hi(wv.x) * c; wq[2] = pg8::bf_lo(wv.y) * c; wq[3] = pg8::bf_hi(wv.y) * c; wq[4] = pg8::bf_lo(wv.z) * c; wq[5] = pg8::bf_hi(wv.z) * c; wq[6] = pg8::bf_lo(wv.w) * c; wq[7] = pg8::bf_hi(wv.w) * c; }
        bf16x8_t qfr[8][2], qlin[2];
#pragma unroll
        for (int h = 0; h < 8; ++h)
#pragma unroll
            for (int ks = 0; ks < 2; ++ks) qfr[h][ks] = *(const bf16x8_t*)(QI + tokq * 512 + h * 64 + ks * 32 + g * 8);
#pragma unroll
        for (int ks = 0; ks < 2; ++ks) { float f[8];
#pragma unroll
            for (int j = 0; j < 8; ++j) { float s = 0.f;
#pragma unroll
                for (int h = 0; h < 8; ++h) s += wq[h] * __uint_as_float((unsigned)(unsigned short)qfr[h][ks][j] << 16);
                f[j] = s; }
            v4u o; o.x = pk2(f[0], f[1]); o.y = pk2(f[2], f[3]); o.z = pk2(f[4], f[5]); o.w = pk2(f[6], f[7]); qlin[ks] = __builtin_bit_cast(bf16x8_t, o); }
#pragma unroll
        for (int i = 0; i < 8; ++i) hist[i * 512 + tid] = 0u;
        for (int s = 0, kb = w; kb < nkb; ++s, kb += 8) {
#pragma unroll
            for (int t = 0; t < 2; ++t) {
                bf16x8_t afr[2];
#pragma unroll
                for (int ks = 0; ks < 2; ++ks) afr[ks] = *(const bf16x8_t*)(KIN + ((size_t)b * SEQ + kb * 32 + t * 16 + q) * 64 + ks * 32 + g * 8);
                f32x4_t sacc = f32x4_t{};
#pragma unroll
                for (int ks = 0; ks < 2; ++ks) sacc = __builtin_amdgcn_mfma_f32_16x16x32_bf16(afr[ks], qlin[ks], sacc, 0, 0, 0);
#pragma unroll
                for (int h = 0; h < 8; ++h) { f32x4_t d = f32x4_t{};
#pragma unroll
                    for (int ks = 0; ks < 2; ++ks) d = __builtin_amdgcn_mfma_f32_16x16x32_bf16(afr[ks], qfr[h][ks], d, 0, 0, 0);
#pragma unroll
                    for (int r = 0; r < 4; ++r) sacc[r] = fmaf(fabsf(d[r]), wq[h], sacc[r]); }
#pragma unroll
                for (int i = 0; i < 2; ++i) { unsigned k2[2];
#pragma unroll
                    for (int e = 0; e < 2; ++e) { const int r = 2 * i + e; unsigned k = key15_of(sacc[r]); if (kb * 32 + t * 16 + 4 * g + r > qme) k = 0u; k2[e] = k;
                        const unsigned dg = k >> 10; (void)__hip_atomic_fetch_add((LAS unsigned*)&hist[(dg >> 2) * 512 + tid], 1u << ((dg & 3u) * 8u), __ATOMIC_RELAXED, __HIP_MEMORY_SCOPE_WORKGROUP); }
                    keys[(s * 4 + t * 2 + i) * 512 + tid] = k2[0] | (k2[1] << 16); }
            }
        }
        int need = 256, bsel;
        p3_merge(hist, tot, w, g, q, need, bsel);
        unsigned prefix = (unsigned)bsel;
#pragma unroll
        for (int pass = 0; pass < 2; ++pass) {
            const int sh_hi = pass == 0 ? 10 : 5, sh = pass == 0 ? 5 : 0;
#pragma unroll
            for (int i = 0; i < 8; ++i) hist[i * 512 + tid] = 0u;
            for (int s = 0, kb = w; kb < nkb; ++s, kb += 8)
#pragma unroll
                for (int i = 0; i < 4; ++i) { const unsigned d2 = keys[(s * 4 + i) * 512 + tid];
#pragma unroll
                    for (int e = 0; e < 2; ++e) { const unsigned k = e ? (d2 >> 16) : (d2 & 0xffffu);
                        if ((k >> sh_hi) == prefix) { const unsigned dg = (k >> sh) & 31u; (void)__hip_atomic_fetch_add((LAS unsigned*)&hist[(dg >> 2) * 512 + tid], 1u << ((dg & 3u) * 8u), __ATOMIC_RELAXED, __HIP_MEMORY_SCOPE_WORKGROUP); } } }
            p3_merge(hist, tot, w, g, q, need, bsel);
            prefix = (prefix << 5) | (unsigned)bsel;
        }
        const unsigned tau = prefix; const int need_eq = need;
        unsigned gtw[8], eqw[8];
#pragma unroll
        for (int s = 0; s < 8; ++s) { const int kb = w + 8 * s; gtw[s] = 0u; eqw[s] = 0u;
            if (kb < nkb) { unsigned gg = 0u, qq = 0u;
#pragma unroll
                for (int i = 0; i < 4; ++i) { const unsigned d2 = keys[(s * 4 + i) * 512 + tid];
#pragma unroll
                    for (int e = 0; e < 2; ++e) { const unsigned k = e ? (d2 >> 16) : (d2 & 0xffffu); const int bit = (i >> 1) * 16 + 4 * g + (i & 1) * 2 + e;
                        gg |= (k > tau ? 1u : 0u) << bit; qq |= (k == tau ? 1u : 0u) << bit; } }
                gg |= (unsigned)__shfl_xor((int)gg, 16); gg |= (unsigned)__shfl_xor((int)gg, 32); qq |= (unsigned)__shfl_xor((int)qq, 16); qq |= (unsigned)__shfl_xor((int)qq, 32);
                gtw[s] = gg; eqw[s] = qq;
                if (g == 0) Tt[q * 64 + kb] = (unsigned char)__builtin_popcount(qq); } }
        __syncthreads();
        { unsigned run = 0u;
#pragma unroll
          for (int s = 0; s < 8; ++s) { const int kb = w + 8 * s;
            if (kb < nkb) { const unsigned g0 = *(const LAS unsigned*)(Tt + q * 64 + 8 * s), g1 = *(const LAS unsigned*)(Tt + q * 64 + 8 * s + 4);
                const unsigned m0 = w >= 4 ? g0 : (w == 0 ? 0u : (g0 & ((1u << (8 * w)) - 1u))), m1 = w > 4 ? (g1 & ((1u << (8 * (w - 4))) - 1u)) : 0u;
                const int pre = (int)(run + sad4(m0) + sad4(m1)), m = need_eq - pre, pc = __builtin_popcount(eqw[s]);
                unsigned se = eqw[s];
                if (m < pc) { se = 0u; unsigned x = eqw[s]; for (int i = 0; i < m; ++i) { const unsigned bb = x & (0u - x); se |= bb; x ^= bb; } }
                if (g == 0) Mb[kb * 2048 + qme] = gtw[s] | se;
                run += sad4(g0) + sad4(g1); } } }
        if (tid < (kb_hi - nkb) * 16) Mb[(nkb + (tid >> 4)) * 2048 + q0 + (tid & 15)] = 0u;
    }
}


namespace att {
using bf16x8 = __attribute__((ext_vector_type(8))) short;
using s16x4  = __attribute__((ext_vector_type(4))) short;
using u32x4  = __attribute__((ext_vector_type(4))) unsigned;
constexpr int KVBLK = 64;
constexpr size_t SHM_V = KVBLK * 128 * 2, SHM_K = KVBLK * 128 * 2;
constexpr int OFF_WS = 65536, OFF_MK = 65536 + 2048, OFF_Q = 65536 + 2048 + 8192, QPITCH = 272;
constexpr float THR2 = 11.5f;
#define KSWZ(row, colB) ((row) * 256 + ((colB) ^ (((row) & 7) << 4)))
#define SBAR() __builtin_amdgcn_sched_barrier(0)
__device__ __forceinline__ unsigned cvtpk(float lo, float hi) { unsigned r; asm volatile("v_cvt_pk_bf16_f32 %0, %1, %2" : "=v"(r) : "v"(lo), "v"(hi)); return r; }
__device__ __forceinline__ float msk(float p, unsigned w, int bit) { const int m = __builtin_amdgcn_sbfe((int)w, bit, 1); return __uint_as_float((__float_as_uint(p) & (unsigned)m) | (0xff800000u & ~(unsigned)m)); }
__device__ __forceinline__ void partialSM(f32x16& p0, f32x16& p1, unsigned w0, unsigned w1, float& m_reg, float& mn, float& alpha) {
#pragma unroll
  for (int r = 0; r < 16; ++r) { const int bit = (r & 3) + 8 * (r >> 2); p0[r] = msk(p0[r], w0, bit); p1[r] = msk(p1[r], w1, bit); }
  float pmax = p0[0];
#pragma unroll
  for (int r = 1; r < 16; ++r) pmax = fmaxf(pmax, p0[r]);
#pragma unroll
  for (int r = 0; r < 16; ++r) pmax = fmaxf(pmax, p1[r]);
  { auto rr = __builtin_amdgcn_permlane32_swap(__float_as_uint(pmax), __float_as_uint(pmax), false, false); pmax = fmaxf(__uint_as_float(rr[0]), __uint_as_float(rr[1])); }
  if (__builtin_expect(__all(pmax - m_reg <= THR2), 1)) { mn = m_reg; alpha = 1.f; }
  else { mn = fmaxf(m_reg, pmax); alpha = __builtin_amdgcn_exp2f(m_reg - mn); m_reg = mn; }
#pragma unroll
  for (int r = 0; r < 16; ++r) { p0[r] -= mn; p1[r] -= mn; }
#pragma unroll
  for (int r = 0; r < 16; ++r) p0[r] = __builtin_amdgcn_exp2f(p0[r]);
}
__device__ __forceinline__ void finishSM(f32x16& p0, f32x16& p1, float alpha, float& l_reg, bf16x8& pa0, bf16x8& pa1, bf16x8& pa2, bf16x8& pa3) {
#pragma unroll
  for (int r = 0; r < 16; ++r) p1[r] = __builtin_amdgcn_exp2f(p1[r]);
  float ps = 0;
#pragma unroll
  for (int r = 0; r < 16; ++r) ps += p0[r];
#pragma unroll
  for (int r = 0; r < 16; ++r) ps += p1[r];
  { auto rr = __builtin_amdgcn_permlane32_swap(__float_as_uint(ps), __float_as_uint(ps), false, false); ps = __uint_as_float(rr[0]) + __uint_as_float(rr[1]); }
  l_reg = l_reg * alpha + ps;
#define PK4(P, BASE, OUT) do { unsigned a0 = cvtpk(P[BASE + 0], P[BASE + 1]), a1 = cvtpk(P[BASE + 2], P[BASE + 3]);   \
    unsigned b0 = cvtpk(P[BASE + 4], P[BASE + 5]), b1 = cvtpk(P[BASE + 6], P[BASE + 7]);                              \
    auto r0 = __builtin_amdgcn_permlane32_swap(a0, b0, false, false); auto r1 = __builtin_amdgcn_permlane32_swap(a1, b1, false, false); \
    u32x4 w = {r0[0], r1[0], r0[1], r1[1]}; OUT = *reinterpret_cast<bf16x8*>(&w); } while (0)
  PK4(p0, 0, pa0); PK4(p0, 8, pa1); PK4(p1, 0, pa2); PK4(p1, 8, pa3);
#undef PK4
}
__device__ __forceinline__ void qkt(f32x16& p0, f32x16& p1, const char* Ks, const char* qrow, const float (&bo)[16], float kb0, float kb1, int r32, int hi) {
#pragma unroll
  for (int r = 0; r < 16; ++r) { p0[r] = bo[r] + kb0; p1[r] = bo[r] + kb1; }
#pragma unroll
  for (int d0 = 0; d0 < 8; ++d0) { const int cb = (d0 * 16 + hi * 8) * 2;
    const bf16x8 b0 = *reinterpret_cast<const bf16x8*>(Ks + KSWZ(r32, cb));
    const bf16x8 b1 = *reinterpret_cast<const bf16x8*>(Ks + KSWZ(32 + r32, cb));
    const bf16x8 qf = *reinterpret_cast<const bf16x8*>(qrow + d0 * 32);
    p0 = __builtin_amdgcn_mfma_f32_32x32x16_bf16(b0, qf, p0, 0, 0, 0);
    p1 = __builtin_amdgcn_mfma_f32_32x32x16_bf16(b1, qf, p1, 0, 0, 0); }
}
__device__ __forceinline__ int v_st(int k, int c) { const int kk = (k & ~0xC) | ((k & 4) << 1) | ((k & 8) >> 1); return ((kk >> 3) * 4 + (c >> 5)) * 512 + ((kk & 7) * 32 + (c & 31)) * 2; }
__device__ __forceinline__ int v_rd_base(int lane) { return ((lane & 3) << 3) | (((lane >> 2) & 3) << 6) | (((lane >> 4) & 1) << 5) | (((lane >> 5) & 1) << 8); }
constexpr int v_rd_off(int d0, int ks, int half) { return d0 * 512 + ks * 4096 + half * 2048; }
template <int OFF> __device__ __forceinline__ s16x4 tr_read(int vb) { s16x4 r; asm volatile("ds_read_b64_tr_b16 %0, %1 offset:%2" : "=&v"(r) : "v"(vb), "i"(OFF) : "memory"); return r; }
template <int D0> __device__ __forceinline__ void pv_one(f32x16& od, int vb, bf16x8 pa0, bf16x8 pa1, bf16x8 pa2, bf16x8 pa3) {
  const s16x4 l0 = tr_read<v_rd_off(D0, 0, 0)>(vb), h0 = tr_read<v_rd_off(D0, 0, 1)>(vb), l1 = tr_read<v_rd_off(D0, 1, 0)>(vb), h1 = tr_read<v_rd_off(D0, 1, 1)>(vb);
  const s16x4 l2 = tr_read<v_rd_off(D0, 2, 0)>(vb), h2 = tr_read<v_rd_off(D0, 2, 1)>(vb), l3 = tr_read<v_rd_off(D0, 3, 0)>(vb), h3 = tr_read<v_rd_off(D0, 3, 1)>(vb);
  asm volatile("s_waitcnt lgkmcnt(0)" ::: "memory"); SBAR();
#define PK(L, H) (bf16x8){L[0], L[1], L[2], L[3], H[0], H[1], H[2], H[3]}
  od = __builtin_amdgcn_mfma_f32_32x32x16_bf16(pa0, PK(l0, h0), od, 0, 0, 0);
  od = __builtin_amdgcn_mfma_f32_32x32x16_bf16(pa1, PK(l1, h1), od, 0, 0, 0);
  od = __builtin_amdgcn_mfma_f32_32x32x16_bf16(pa2, PK(l2, h2), od, 0, 0, 0);
  od = __builtin_amdgcn_mfma_f32_32x32x16_bf16(pa3, PK(l3, h3), od, 0, 0, 0);
#undef PK
}
__device__ __forceinline__ void pv_d0(f32x16* o, int vb, bf16x8 pa0, bf16x8 pa1, bf16x8 pa2, bf16x8 pa3) {
  pv_one<0>(o[0], vb, pa0, pa1, pa2, pa3); pv_one<1>(o[1], vb, pa0, pa1, pa2, pa3); pv_one<2>(o[2], vb, pa0, pa1, pa2, pa3); pv_one<3>(o[3], vb, pa0, pa1, pa2, pa3);
}
__device__ __forceinline__ void attn_item(const bf16* __restrict__ Qb, const bf16* __restrict__ Kh, const bf16* __restrict__ Vh, const unsigned* __restrict__ Mq, bf16* __restrict__ Ob, int NT, char* lds, LAS unsigned char* ldsL) {
  const int tid = threadIdx.x, wid = __builtin_amdgcn_readfirstlane(tid >> 6), lane = tid & 63, r32 = lane & 31, hi = lane >> 5;
  float* ws = (float*)(lds + OFF_WS) + wid * 64; float* li_l = ws; float* al_l = ws + 32;
  unsigned* mk = (unsigned*)(lds + OFF_MK);
  unsigned soff[4];
#pragma unroll
  for (int i = 0; i < 4; ++i) { const int pc = (wid & 3) * 4 + i;
    if (wid < 4) { const int row = pc * 4 + (lane >> 4), cb = (lane & 15) * 16; soff[i] = (unsigned)(row * 256 + (cb ^ ((row & 7) << 4))); }
    else { const int L = pc * 1024 + lane * 16, st = L >> 9, wi = L & 511, kk = (st >> 2) * 8 + (wi >> 6), c = (st & 3) * 32 + ((wi & 63) >> 1), k = (kk & ~0xC) | ((kk & 4) << 1) | ((kk & 8) >> 1);
           soff[i] = (unsigned)(k * 256 + c * 2); } }
  const char* gsrc = (const char*)(wid < 4 ? Kh : Vh);
  const unsigned ldst = (unsigned)((wid < 4 ? 0 : 16384) + (wid & 3) * 4096);
#define DMA_TILE(t, slot) do { _Pragma("unroll") for (int i_ = 0; i_ < 4; ++i_) \
    __builtin_amdgcn_global_load_lds((const unsigned*)(gsrc + (size_t)(t) * (64 * 256) + soff[i_]), (LAS unsigned*)(ldsL + (slot) * 32768 + ldst + i_ * 1024), 16, 0, 0); } while (0)
  DMA_TILE(0, 0);
  for (int i = tid; i < NT * 64; i += 512) mk[i] = Mq[(size_t)(i >> 5) * 2048 + (i & 31)];
  float m_reg = -1e30f, l_reg = 0; f32x16 o[4] = {}; bf16x8 qr[8];
  { const bf16* Qw = Qb + (size_t)r32 * 1024 + wid * 128 + hi * 8; float ss = 0.f;
#pragma unroll
    for (int d0 = 0; d0 < 8; ++d0) { qr[d0] = *reinterpret_cast<const bf16x8*>(Qw + d0 * 16); ss += sumsq8(qr[d0]); }
    ss = xhalf_sum(ss); const float rq = rsqrtf(ss * (1.f / 128.f) + EPS);
#pragma unroll
    for (int d0 = 0; d0 < 8; ++d0) { float f[8];
#pragma unroll
      for (int j = 0; j < 8; ++j) f[j] = __uint_as_float((unsigned)(unsigned short)qr[d0][j] << 16) * rq;
      u32x4 w = {cvtpk(f[0], f[1]), cvtpk(f[2], f[3]), cvtpk(f[4], f[5]), cvtpk(f[6], f[7])}; qr[d0] = *reinterpret_cast<bf16x8*>(&w); } }
  const float slope2 = __builtin_amdgcn_exp2f(-(float)(wid + 1)) * 1.4426950408889634f;
  float bo[16];
#pragma unroll
  for (int r = 0; r < 16; ++r) bo[r] = __uint_as_float(__builtin_amdgcn_readfirstlane(__float_as_uint(slope2 * (float)((r & 3) + 8 * (r >> 2)))));
  const float hoff = slope2 * (float)(4 * hi);
  const int vb0 = (int)(uintptr_t)(lds + 16384) + v_rd_base(lane);
  asm volatile("s_waitcnt vmcnt(0) lgkmcnt(0)\n\ts_barrier" ::: "memory");
  for (int j = 0; j < NT; ++j) {
    const int sl = j & 1;
    if (j + 1 < NT) DMA_TILE(j + 1, sl ^ 1);
    const char* Ks = lds + sl * 32768;
    const unsigned w0 = mk[(2 * j) * 32 + r32] >> (4 * hi), w1 = mk[(2 * j + 1) * 32 + r32] >> (4 * hi);
    f32x16 p0, p1;
    { const float kb0 = slope2 * (float)(j * 64) + hoff, kb1 = kb0 + slope2 * 32.f;
#pragma unroll
      for (int r = 0; r < 16; ++r) { p0[r] = bo[r] + kb0; p1[r] = bo[r] + kb1; }
      bf16x8 ka = *reinterpret_cast<const bf16x8*>(Ks + KSWZ(r32, hi * 16)), kb = *reinterpret_cast<const bf16x8*>(Ks + KSWZ(32 + r32, hi * 16));
#pragma unroll
      for (int d0 = 0; d0 < 8; ++d0) { bf16x8 na = ka, nb = kb;
        if (d0 < 7) { const int cb = ((d0 + 1) * 16 + hi * 8) * 2; na = *reinterpret_cast<const bf16x8*>(Ks + KSWZ(r32, cb)); nb = *reinterpret_cast<const bf16x8*>(Ks + KSWZ(32 + r32, cb)); }
        SBAR();
        p0 = __builtin_amdgcn_mfma_f32_32x32x16_bf16(ka, qr[d0], p0, 0, 0, 0);
        p1 = __builtin_amdgcn_mfma_f32_32x32x16_bf16(kb, qr[d0], p1, 0, 0, 0);
        SBAR();
        ka = na; kb = nb; } }
    float alpha; bf16x8 pa0, pa1, pa2, pa3;
    {
#pragma unroll
      for (int r = 0; r < 16; ++r) { const int bit = (r & 3) + 8 * (r >> 2); p0[r] = msk(p0[r], w0, bit); p1[r] = msk(p1[r], w1, bit); }
      float pmax = fmaxf(p0[0], p1[0]);
#pragma unroll
      for (int r = 1; r < 16; ++r) pmax = fmaxf(fmaxf(pmax, p0[r]), p1[r]);
      { auto rr = __builtin_amdgcn_permlane32_swap(__float_as_uint(pmax), __float_as_uint(pmax), false, false); pmax = fmaxf(__uint_as_float(rr[0]), __uint_as_float(rr[1])); }
      float mn;
      if (__builtin_expect(__all(pmax - m_reg <= THR2), 1)) { mn = m_reg; alpha = 1.f; }
      else { mn = fmaxf(m_reg, pmax); alpha = __builtin_amdgcn_exp2f(m_reg - mn); m_reg = mn; }
      float ps = 0.f;
#pragma unroll
      for (int r = 0; r < 16; ++r) { p0[r] = __builtin_amdgcn_exp2f(p0[r] - mn); p1[r] = __builtin_amdgcn_exp2f(p1[r] - mn); ps += p0[r] + p1[r]; }
      { auto rr = __builtin_amdgcn_permlane32_swap(__float_as_uint(ps), __float_as_uint(ps), false, false); ps = __uint_as_float(rr[0]) + __uint_as_float(rr[1]); }
      l_reg = l_reg * alpha + ps;
#define PK4(P, BASE, OUT) do { unsigned a0 = cvtpk(P[BASE + 0], P[BASE + 1]), a1 = cvtpk(P[BASE + 2], P[BASE + 3]);   \
    unsigned b0 = cvtpk(P[BASE + 4], P[BASE + 5]), b1 = cvtpk(P[BASE + 6], P[BASE + 7]);                              \
    auto r0 = __builtin_amdgcn_permlane32_swap(a0, b0, false, false); auto r1 = __builtin_amdgcn_permlane32_swap(a1, b1, false, false); \
    u32x4 w = {r0[0], r1[0], r0[1], r1[1]}; OUT = *reinterpret_cast<bf16x8*>(&w); } while (0)
      PK4(p0, 0, pa0); PK4(p0, 8, pa1); PK4(p1, 0, pa2); PK4(p1, 8, pa3);
#undef PK4
      if (__any(alpha < 1.f)) { if (hi == 0) al_l[r32] = alpha; asm volatile("s_waitcnt lgkmcnt(0)" ::: "memory");
#pragma unroll
        for (int d = 0; d < 4; ++d)
#pragma unroll
          for (int r = 0; r < 16; ++r) o[d][r] *= al_l[crow(r, hi)]; }
    }
    { const int vb = vb0 + sl * 32768;
      s16x4 lA[4], hA[4], lB[4], hB[4];
#define VREADS(L_, H_, D0) do { L_[0] = tr_read<v_rd_off(D0, 0, 0)>(vb); H_[0] = tr_read<v_rd_off(D0, 0, 1)>(vb); L_[1] = tr_read<v_rd_off(D0, 1, 0)>(vb); H_[1] = tr_read<v_rd_off(D0, 1, 1)>(vb); \
      L_[2] = tr_read<v_rd_off(D0, 2, 0)>(vb); H_[2] = tr_read<v_rd_off(D0, 2, 1)>(vb); L_[3] = tr_read<v_rd_off(D0, 3, 0)>(vb); H_[3] = tr_read<v_rd_off(D0, 3, 1)>(vb); } while (0)
#define PK(L, H) (bf16x8){L[0], L[1], L[2], L[3], H[0], H[1], H[2], H[3]}
#define VMMA(OD, L_, H_) do { OD = __builtin_amdgcn_mfma_f32_32x32x16_bf16(pa0, PK(L_[0], H_[0]), OD, 0, 0, 0); OD = __builtin_amdgcn_mfma_f32_32x32x16_bf16(pa1, PK(L_[1], H_[1]), OD, 0, 0, 0); \
      OD = __builtin_amdgcn_mfma_f32_32x32x16_bf16(pa2, PK(L_[2], H_[2]), OD, 0, 0, 0); OD = __builtin_amdgcn_mfma_f32_32x32x16_bf16(pa3, PK(L_[3], H_[3]), OD, 0, 0, 0); } while (0)
#define VWAIT(N, L_, H_) do { asm volatile("s_waitcnt lgkmcnt(" #N ")" : "+v"(L_[0]), "+v"(L_[1]), "+v"(L_[2]), "+v"(L_[3]), "+v"(H_[0]), "+v"(H_[1]), "+v"(H_[2]), "+v"(H_[3]) :: "memory"); SBAR(); } while (0)
      VREADS(lA, hA, 0); VREADS(lB, hB, 1);
      VWAIT(8, lA, hA); VMMA(o[0], lA, hA);
      VREADS(lA, hA, 2);
      VWAIT(8, lB, hB); VMMA(o[1], lB, hB);
      VREADS(lB, hB, 3);
      VWAIT(8, lA, hA); VMMA(o[2], lA, hA);
      VWAIT(0, lB, hB); VMMA(o[3], lB, hB);
#undef VREADS
#undef PK
#undef VMMA
#undef VWAIT
    }
    asm volatile("s_waitcnt vmcnt(0) lgkmcnt(0)\n\ts_barrier" ::: "memory");
  }
  if (hi == 0) li_l[r32] = l_reg; asm volatile("s_waitcnt lgkmcnt(0)" ::: "memory");
  float rli[16];
#pragma unroll
  for (int r = 0; r < 16; ++r) rli[r] = __builtin_amdgcn_rcpf(li_l[crow(r, hi)]);
  unsigned short* stg = (unsigned short*)(lds + wid * 8192);
#pragma unroll
  for (int r = 0; r < 16; ++r) { const int orow = crow(r, hi);
#pragma unroll
    for (int d0 = 0; d0 < 4; ++d0) stg[orow * 128 + d0 * 32 + r32] = (unsigned short)f2bf(o[d0][r] * rli[r]); }
  asm volatile("s_waitcnt lgkmcnt(0)" ::: "memory");
#pragma unroll
  for (int i = 0; i < 8; ++i) { const int row = i * 4 + (lane >> 4), ch = lane & 15; const u32x4 v = *(const u32x4*)(stg + row * 128 + ch * 8);
    *(u32x4*)(Ob + (size_t)row * 1024 + wid * 128 + ch * 8) = v; }
#undef DMA_TILE
}
#undef KSWZ
#undef SBAR
}


namespace ret {
using bf16x8 = __attribute__((ext_vector_type(8))) short;
using s16x4  = __attribute__((ext_vector_type(4))) short;
using u32x4  = __attribute__((ext_vector_type(4))) unsigned;
using u32x2  = __attribute__((ext_vector_type(2))) unsigned;
constexpr int C = 64, QP = 272, KPI = 272, VP = 576;
constexpr int OFF_Q = 0, OFF_K = 17408, OFF_V = 34816, OFF_ST = 71680, OFF_Y = 75776;
typedef float f32x2_t __attribute__((ext_vector_type(2))); typedef __bf16 bf16x2_t __attribute__((ext_vector_type(2)));
__device__ __forceinline__ unsigned cvtpk(float lo, float hi) { const f32x2_t v = {lo, hi}; const bf16x2_t b = __builtin_convertvector(v, bf16x2_t); return __builtin_bit_cast(unsigned, b); }
template <int OFF> __device__ __forceinline__ s16x4 trr(int base) { s16x4 r; asm volatile("ds_read_b64_tr_b16 %0, %1 offset:%2" : "=&v"(r) : "v"(base), "i"(OFF) : "memory"); return r; }
__device__ __forceinline__ bf16x8 pk8(const f32x16& x, int s) { u32x4 w = {cvtpk(x[8 * s + 0], x[8 * s + 1]), cvtpk(x[8 * s + 2], x[8 * s + 3]), cvtpk(x[8 * s + 4], x[8 * s + 5]), cvtpk(x[8 * s + 6], x[8 * s + 7])}; return *reinterpret_cast<bf16x8*>(&w); }
__device__ __forceinline__ float silu_(float x) { return x * __builtin_amdgcn_rcpf(1.f + __builtin_amdgcn_exp2f(-1.4426950408889634f * x)); }
__device__ __forceinline__ void ret_item(int b, int h, const bf16* __restrict__ RQ, const bf16* __restrict__ RK, bf16* RV, const bf16* __restrict__ RG, const float* __restrict__ gnorm, char* lds) {
  const int tid = threadIdx.x, w = __builtin_amdgcn_readfirstlane(tid >> 6), lane = tid & 63, r32 = lane & 31, hi = lane >> 5;
  const float lg = __log2f(1.f - exp2f(-5.f - (float)h)), gC = exp2f(64.f * lg);
  char* Qs = lds + OFF_Q; char* Ks = lds + OFF_K; char* Vs = lds + OFF_V; float* st = (float*)(lds + OFF_ST); char* Ys = lds + OFF_Y;
  f32x16 S[4] = {};
  const unsigned voffQ = (unsigned)(((tid >> 4) * 512 + (tid & 15) * 8) * 2), voffV = (unsigned)(((tid >> 5) * 1024 + (tid & 31) * 8) * 2);
  const int trq = (lane & 15) >> 2, trp = lane & 3, trg = (lane >> 4) & 1;
  const int vtb = (int)(uintptr_t)(lds + OFF_V) + (4 * hi + trq) * VP + (32 * w + 16 * trg + 4 * trp) * 2, ktb = (int)(uintptr_t)(lds + OFF_K) + (4 * hi + trq) * KPI + (16 * trg + 4 * trp) * 2;
  u32x4 pq[2], pk[2], pv[4];
#define RET_LOAD(cc) do { const size_t t0_ = (size_t)b * SEQ + (size_t)(cc) * C; const char* qb_ = (const char*)(RQ + t0_ * 512 + h * 128); const char* kb_ = (const char*)(RK + t0_ * 512 + h * 128); const char* vb_ = (const char*)(RV + t0_ * 1024 + h * 256); \
    _Pragma("unroll") for (int i = 0; i < 2; ++i) { pq[i] = *(const u32x4*)(qb_ + voffQ + i * 32768); pk[i] = *(const u32x4*)(kb_ + voffQ + i * 32768); } \
    _Pragma("unroll") for (int i = 0; i < 4; ++i) pv[i] = *(const u32x4*)(vb_ + voffV + i * 32768); } while (0)
#define RET_STAGE() do { \
    _Pragma("unroll") for (int i = 0; i < 2; ++i) { const int row = (tid >> 4) + 32 * i, ch = tid & 15; \
      *(u32x4*)(Qs + row * QP + ch * 16) = pq[i]; \
      const u32x4 kv = pk[i]; const float f = exp2f(lg * (float)(C - 1 - row)) * 0.08838834764831845f; \
      u32x4 ko; ko.x = cvtpk(pg8::bf_lo(kv.x) * f, pg8::bf_hi(kv.x) * f); ko.y = cvtpk(pg8::bf_lo(kv.y) * f, pg8::bf_hi(kv.y) * f); ko.z = cvtpk(pg8::bf_lo(kv.z) * f, pg8::bf_hi(kv.z) * f); ko.w = cvtpk(pg8::bf_lo(kv.w) * f, pg8::bf_hi(kv.w) * f); \
      *(u32x4*)(Ks + row * KPI + ch * 16) = ko; } \
    _Pragma("unroll") for (int i = 0; i < 4; ++i) { const int row = (tid >> 5) + 16 * i, ch = tid & 31; *(u32x4*)(Vs + row * VP + ch * 16) = pv[i]; } } while (0)
  RET_LOAD(0);
  __syncthreads();
  RET_STAGE();
  RET_LOAD(1);
  __syncthreads();
  for (int c = 0; c < SEQ / C; ++c) {
    const size_t tok0 = (size_t)b * SEQ + (size_t)c * C;
    f32x16 ot[2] = {};
#pragma unroll
    for (int dt = 0; dt < 4; ++dt) {
#pragma unroll
      for (int s = 0; s < 2; ++s) { const bf16x8 af = pk8(S[dt], s);
#pragma unroll
        for (int nt = 0; nt < 2; ++nt) { const char* qp = Qs + (32 * nt + r32) * QP + (32 * dt + 16 * s + 4 * hi) * 2;
          const u32x2 lo = *(const u32x2*)qp, hi8 = *(const u32x2*)(qp + 16); const u32x4 bw = {lo.x, lo.y, hi8.x, hi8.y};
          ot[nt] = __builtin_amdgcn_mfma_f32_32x32x16_bf16(af, *reinterpret_cast<const bf16x8*>(&bw), ot[nt], 0, 0, 0); } }
      __builtin_amdgcn_sched_barrier(0); }
#pragma unroll
    for (int nt = 0; nt < 2; ++nt)
#pragma unroll
      for (int r = 0; r < 16; ++r) ot[nt][r] *= gC;
    __builtin_amdgcn_sched_barrier(0);
    bf16x8 vfr[4];
    { s16x4 vlo[4], vhi[4];
      vlo[0] = trr<0 * 16 * VP>(vtb); vhi[0] = trr<0 * 16 * VP + 8 * VP>(vtb); vlo[1] = trr<1 * 16 * VP>(vtb); vhi[1] = trr<1 * 16 * VP + 8 * VP>(vtb);
      vlo[2] = trr<2 * 16 * VP>(vtb); vhi[2] = trr<2 * 16 * VP + 8 * VP>(vtb); vlo[3] = trr<3 * 16 * VP>(vtb); vhi[3] = trr<3 * 16 * VP + 8 * VP>(vtb);
      asm volatile("s_waitcnt lgkmcnt(0)" : "+v"(vlo[0]), "+v"(vlo[1]), "+v"(vlo[2]), "+v"(vlo[3]), "+v"(vhi[0]), "+v"(vhi[1]), "+v"(vhi[2]), "+v"(vhi[3]) :: "memory"); __builtin_amdgcn_sched_barrier(0);
#pragma unroll
      for (int ks = 0; ks < 4; ++ks) vfr[ks] = (bf16x8){vlo[ks][0], vlo[ks][1], vlo[ks][2], vlo[ks][3], vhi[ks][0], vhi[ks][1], vhi[ks][2], vhi[ks][3]}; }
#pragma unroll
    for (int nt = 0; nt < 2; ++nt)
#pragma unroll
      for (int jt = 0; jt <= nt; ++jt) { f32x16 pt = {};
#pragma unroll
        for (int kk = 0; kk < 8; ++kk) { const bf16x8 ka = *(const bf16x8*)(Ks + (32 * jt + r32) * KPI + (16 * kk + 8 * hi) * 2), qb = *(const bf16x8*)(Qs + (32 * nt + r32) * QP + (16 * kk + 8 * hi) * 2);
          pt = __builtin_amdgcn_mfma_f32_32x32x16_bf16(ka, qb, pt, 0, 0, 0); }
        if (jt == nt) {
#pragma unroll
          for (int r = 0; r < 16; ++r) if (crow(r, hi) > r32) pt[r] = 0.f; }
#pragma unroll
        for (int s = 0; s < 2; ++s) ot[nt] = __builtin_amdgcn_mfma_f32_32x32x16_bf16(vfr[2 * jt + s], pk8(pt, s), ot[nt], 0, 0, 0);
        __builtin_amdgcn_sched_barrier(0); }
#pragma unroll
    for (int dt = 0; dt < 4; ++dt) {
#pragma unroll
      for (int r = 0; r < 16; ++r) S[dt][r] *= gC;
      s16x4 kl[4], kh[4];
      kl[0] = trr<0 * 16 * KPI>(ktb + dt * 64); kh[0] = trr<0 * 16 * KPI + 8 * KPI>(ktb + dt * 64); kl[1] = trr<1 * 16 * KPI>(ktb + dt * 64); kh[1] = trr<1 * 16 * KPI + 8 * KPI>(ktb + dt * 64);
      kl[2] = trr<2 * 16 * KPI>(ktb + dt * 64); kh[2] = trr<2 * 16 * KPI + 8 * KPI>(ktb + dt * 64); kl[3] = trr<3 * 16 * KPI>(ktb + dt * 64); kh[3] = trr<3 * 16 * KPI + 8 * KPI>(ktb + dt * 64);
      asm volatile("s_waitcnt lgkmcnt(0)" : "+v"(kl[0]), "+v"(kl[1]), "+v"(kl[2]), "+v"(kl[3]), "+v"(kh[0]), "+v"(kh[1]), "+v"(kh[2]), "+v"(kh[3]) :: "memory"); __builtin_amdgcn_sched_barrier(0);
#pragma unroll
      for (int ks = 0; ks < 4; ++ks) S[dt] = __builtin_amdgcn_mfma_f32_32x32x16_bf16((bf16x8){kl[ks][0], kl[ks][1], kl[ks][2], kl[ks][3], kh[ks][0], kh[ks][1], kh[ks][2], kh[ks][3]}, vfr[ks], S[dt], 0, 0, 0);
      __builtin_amdgcn_sched_barrier(0); }
    u32x4 gt4[4];
    { const char* gb_ = (const char*)(RG + tok0 * 1024 + h * 256);
#pragma unroll
      for (int i = 0; i < 4; ++i) gt4[i] = *(const u32x4*)(gb_ + voffV + i * 32768); }
#pragma unroll
    for (int nt = 0; nt < 2; ++nt) { const float rs = exp2f(lg * (float)(32 * nt + r32 + 1 - C)); float s1 = 0.f, s2 = 0.f;
#pragma unroll
      for (int r = 0; r < 16; ++r) { ot[nt][r] *= rs; s1 += ot[nt][r]; s2 += ot[nt][r] * ot[nt][r]; }
      s1 = xhalf_sum(s1); s2 = xhalf_sum(s2);
      if (hi == 0) { st[(w * 64 + 32 * nt + r32) * 2] = s1; st[(w * 64 + 32 * nt + r32) * 2 + 1] = s2; } }
    __syncthreads();
    if (c + 1 < SEQ / C) { RET_STAGE(); if (c + 2 < SEQ / C) RET_LOAD(c + 2); }
#pragma unroll
    for (int nt = 0; nt < 2; ++nt) { float s1 = 0.f, s2 = 0.f;
#pragma unroll
      for (int ww = 0; ww < 8; ++ww) { s1 += st[(ww * 64 + 32 * nt + r32) * 2]; s2 += st[(ww * 64 + 32 * nt + r32) * 2 + 1]; }
      const float mu = s1 * (1.f / 256.f), var = fmaxf(s2 * (1.f / 256.f) - mu * mu, 0.f), rstd = rsqrtf(var + EPS);
#pragma unroll
      for (int g = 0; g < 4; ++g) { float y[4];
#pragma unroll
        for (int j = 0; j < 4; ++j) y[j] = (ot[nt][4 * g + j] - mu) * rstd * gnorm[h * 256 + 32 * w + 8 * g + 4 * hi + j];
        const u32x2 o2 = {cvtpk(y[0], y[1]), cvtpk(y[2], y[3])};
        *(u32x2*)(Ys + (32 * nt + r32) * VP + (32 * w + 8 * g + 4 * hi) * 2) = o2; } }
    __syncthreads();
    { char* ob_ = (char*)(RV + tok0 * 1024 + h * 256);
#pragma unroll
      for (int i = 0; i < 4; ++i) { const int row = (tid >> 5) + 16 * i, ch = tid & 31;
        const u32x4 yv = *(const u32x4*)(Ys + row * VP + ch * 16); const u32x4 gt = gt4[i];
        u32x4 o; o.x = cvtpk(pg8::bf_lo(yv.x) * silu_(pg8::bf_lo(gt.x)), pg8::bf_hi(yv.x) * silu_(pg8::bf_hi(gt.x))); o.y = cvtpk(pg8::bf_lo(yv.y) * silu_(pg8::bf_lo(gt.y)), pg8::bf_hi(yv.y) * silu_(pg8::bf_hi(gt.y)));
        o.z = cvtpk(pg8::bf_lo(yv.z) * silu_(pg8::bf_lo(gt.z)), pg8::bf_hi(yv.z) * silu_(pg8::bf_hi(gt.z))); o.w = cvtpk(pg8::bf_lo(yv.w) * silu_(pg8::bf_lo(gt.w)), pg8::bf_hi(yv.w) * silu_(pg8::bf_hi(gt.w)));
        *(u32x4*)(ob_ + voffV + i * 32768) = o; } }
  }
#undef RET_LOAD
#undef RET_STAGE
}
}

__device__ __forceinline__ void p4_attn(Frame& F, const Args& a, unsigned char* lds_generic) {
    const size_t nt_ = (size_t)F.ntok;
    const bf16* QA = (const bf16*)(F.act + nt_ * O_QA); bf16* ATT = (bf16*)(F.act + nt_ * O_QA);
    unsigned char* aux = a.xb + nt_ * 2048;
    const bf16* KP = (const bf16*)(aux + nt_ * AUX_KP); const bf16* VV = (const bf16*)(aux + nt_ * AUX_VV); const unsigned* MASK = (const unsigned*)(aux + nt_ * AUX_MASK);
    volatile LAS unsigned* MISC = (volatile LAS unsigned*)(F.lds + MISC_OFF);
    unsigned* qctr = (unsigned*)(F.ws + WS_CTL) + CW_Q4;
    const bf16* RQ = (const bf16*)(F.act + nt_ * O_RQ); const bf16* RK = (const bf16*)(F.act + nt_ * O_RK); bf16* RV = (bf16*)(F.act + nt_ * O_RV); const bf16* RG = (const bf16*)(F.act + nt_ * O_RG);
    const int nb = F.ntok / SEQ, nret = nb * 4, nitems = nb * 64;
    for (;;) {
        __syncthreads(); if (F.tid == 0) MISC[0] = atomicAdd(qctr + 16, 1u); __syncthreads();
        const int it = (int)MISC[0]; if (it >= nret || a.mode == 1) break;
        ret::ret_item(it >> 2, it & 3, RQ, RK, RV, RG, a.in[8], (char*)lds_generic);
    }
    for (;;) {
        __syncthreads(); if (F.tid == 0) MISC[0] = atomicAdd(qctr, 1u); __syncthreads();
        const int it = (int)MISC[0]; if (it >= nitems || a.mode == 2) break;
        const int qb = 63 - it / nb, b = it % nb, NT = (qb >> 1) + 1;
        const size_t row0 = (size_t)b * SEQ + qb * 32;
        att::attn_item(QA + row0 * 1024, KP + (size_t)b * SEQ * 128, VV + (size_t)b * SEQ * 128, MASK + (size_t)b * 64 * 2048 + qb * 32, ATT + row0 * 1024, NT, (char*)lds_generic, F.lds);
    }
}


__device__ __forceinline__ void p7_router(Frame& F, const Args& a) {
    const int lane = F.lane, r32 = lane & 31, hi = lane >> 5, tid = F.tid;
    unsigned char* mo = F.act; bf16* N2 = (bf16*)(mo + MO_N2); unsigned char* meta = mo + MO_META;
    int* MB = (int*)(meta + MM_B); int* MPp = (int*)(meta + MM_P); float* MCL = (float*)(meta + MM_CL); float* MCH = (float*)(meta + MM_CH); float* MRS = (float*)(meta + MM_RS);
    const bf16* Wh = (const bf16*)(F.ws + WS_WR); const bf16* Wl = Wh + 32 * 1024;
    const float* g2 = a.in[12]; const float* b_gr = a.in[14]; const float* b_er = a.in[16];
    const float* hbase = a.out + (size_t)a.tok0 * D;
    unsigned* gcnt = (unsigned*)(F.ws + WS_CTL) + CW_MOE;
    LAS unsigned* lcnt = (LAS unsigned*)(F.lds + RING_OFF);
    if (tid < 64) lcnt[tid] = 0u;
    __syncthreads();
    const int ntasks = F.ntok / 32, tpw = ntasks / F.G;
    const bool have = F.wave < tpw; const int t = (F.vcu * tpw + F.wave) * 32 + r32;
    int bucket = 0, posl = 0; float clo = 0.f, chi = 0.f, rstd = 0.f;
    if (have) {
        const float* hrow = hbase + (size_t)t * D + hi * 8; bf16* nrow = N2 + (size_t)t * D + hi * 8;
        f32x16 acc = f32x16{}; float ss = 0.f;
#pragma unroll 4
        for (int kk = 0; kk < 64; ++kk) {
            const f32x4 a0 = *(const f32x4*)(hrow + kk * 16), a1 = *(const f32x4*)(hrow + kk * 16 + 4);
            const f32x4 q0 = *(const f32x4*)(g2 + kk * 16 + hi * 8), q1 = *(const f32x4*)(g2 + kk * 16 + hi * 8 + 4);
            ss += (a0.x * a0.x + a0.y * a0.y) + (a0.z * a0.z + a0.w * a0.w) + (a1.x * a1.x + a1.y * a1.y) + (a1.z * a1.z + a1.w * a1.w);
            const float x[8] = {a0.x * q0.x, a0.y * q0.y, a0.z * q0.z, a0.w * q0.w, a1.x * q1.x, a1.y * q1.y, a1.z * q1.z, a1.w * q1.w};
            unsigned hb[8]; float lo[8];
#pragma unroll
            for (int j = 0; j < 8; ++j) { hb[j] = f2bf(x[j]); lo[j] = x[j] - __uint_as_float(hb[j] << 16); }
            v4u xh; xh.x = hb[0] | (hb[1] << 16); xh.y = hb[2] | (hb[3] << 16); xh.z = hb[4] | (hb[5] << 16); xh.w = hb[6] | (hb[7] << 16);
            v4u xl; xl.x = pk2(lo[0], lo[1]); xl.y = pk2(lo[2], lo[3]); xl.z = pk2(lo[4], lo[5]); xl.w = pk2(lo[6], lo[7]);
            *(v4u*)(nrow + kk * 16) = xh;
            const bf16x8_t wh = *(const bf16x8_t*)(Wh + (size_t)r32 * 1024 + kk * 16 + hi * 8), wl = *(const bf16x8_t*)(Wl + (size_t)r32 * 1024 + kk * 16 + hi * 8);
            const bf16x8_t bh = __builtin_bit_cast(bf16x8_t, xh), bl = __builtin_bit_cast(bf16x8_t, xl);
            acc = __builtin_amdgcn_mfma_f32_32x32x16_bf16(wh, bh, acc, 0, 0, 0);
            acc = __builtin_amdgcn_mfma_f32_32x32x16_bf16(wh, bl, acc, 0, 0, 0);
            acc = __builtin_amdgcn_mfma_f32_32x32x16_bf16(wl, bh, acc, 0, 0, 0);
        }
        ss = xhalf_sum(ss); rstd = rsqrtf(ss * (1.f / D) + EPS);
        float L[24];
#pragma unroll
        for (int r = 0; r < 12; ++r) { const float v = acc[r]; auto rr = __builtin_amdgcn_permlane32_swap(__float_as_uint(v), __float_as_uint(v), false, false);
            L[(r & 3) + 8 * (r >> 2)] = __uint_as_float(rr[0]); L[(r & 3) + 8 * (r >> 2) + 4] = __uint_as_float(rr[1]); }
        float gl[4];
#pragma unroll
        for (int i = 0; i < 4; ++i) gl[i] = L[i] * rstd + b_gr[i];
        int g = 0; float gm = gl[0];
#pragma unroll
        for (int i = 1; i < 4; ++i) if (gl[i] > gm) { gm = gl[i]; g = i; }
        float se = 0.f;
#pragma unroll
        for (int i = 0; i < 4; ++i) se += __expf(gl[i] - gm);
        const float gw = 1.f / se;
        float el[4];
#pragma unroll
        for (int i = 0; i < 4; ++i) { const float l0 = L[4 + i], l1 = L[8 + i], l2 = L[12 + i], l3 = L[16 + i]; const float lv = g == 0 ? l0 : (g == 1 ? l1 : (g == 2 ? l2 : l3));
            const float b0 = b_er[i], b1 = b_er[4 + i], b2 = b_er[8 + i], b3 = b_er[12 + i]; el[i] = lv * rstd + (g == 0 ? b0 : (g == 1 ? b1 : (g == 2 ? b2 : b3))); }
        int i1 = 0; float v1 = el[0];
#pragma unroll
        for (int i = 1; i < 4; ++i) if (el[i] > v1) { v1 = el[i]; i1 = i; }
        int i2 = -1; float v2 = 0.f;
#pragma unroll
        for (int i = 0; i < 4; ++i) if (i != i1 && (i2 < 0 || el[i] > v2)) { v2 = el[i]; i2 = i; }
        const float e2 = __expf(v2 - v1), p1 = gw / (1.f + e2), p2 = gw * e2 / (1.f + e2);
        const int lo_ = i1 < i2 ? i1 : i2, hi_ = i1 < i2 ? i2 : i1;
        const int pair = lo_ == 0 ? (hi_ - 1) : (lo_ == 1 ? (hi_ + 1) : 5);
        bucket = g * 6 + pair; clo = i1 < i2 ? p1 : p2; chi = i1 < i2 ? p2 : p1;
        if (hi == 0) posl = (int)__hip_atomic_fetch_add(&lcnt[bucket], 1u, __ATOMIC_RELAXED, __HIP_MEMORY_SCOPE_WORKGROUP);
    }
    __syncthreads();
    if (tid < 24) lcnt[32 + tid] = atomicAdd(gcnt + tid, lcnt[tid]);
    __syncthreads();
    if (have && hi == 0) { MB[t] = bucket; MPp[t] = (int)lcnt[32 + bucket] + posl; MCL[t] = clo; MCH[t] = chi; MRS[t] = rstd; }
}
__device__ __forceinline__ int moe_tiles(const unsigned* gcnt, int* rowstart  ) { int rs = 0;
    for (int b = 0; b < 24; ++b) { rowstart[b] = rs; rs += (int)((gcnt[b] + 255u) & ~255u); } rowstart[24] = rs; return rs >> 8; }
__device__ __forceinline__ void p8_permute(Frame& F, const Args& a) {
    unsigned char* mo = F.act; const bf16* N2 = (const bf16*)(mo + MO_N2); bf16* AP = (bf16*)(mo + MO_APERM); unsigned char* meta = mo + MO_META;
    const int* MB = (const int*)(meta + MM_B); const int* MPp = (const int*)(meta + MM_P); const float* MCL = (const float*)(meta + MM_CL); const float* MCH = (const float*)(meta + MM_CH); const float* MRS = (const float*)(meta + MM_RS);
    int* PTOK = (int*)(meta + MM_PTOK); float* PRS = (float*)(meta + MM_PRS); float* PCL = (float*)(meta + MM_PCL); float* PCH = (float*)(meta + MM_PCH);
    const unsigned* gcnt = (const unsigned*)(F.ws + WS_CTL) + CW_MOE;
    LAS int* rsL = (LAS int*)(F.lds + RING_OFF);
    if (F.tid == 0) { int rs = 0; for (int b = 0; b < 24; ++b) { rsL[b] = rs; rs += (int)((gcnt[b] + 255u) & ~255u); } rsL[24] = rs; }
    __syncthreads();
    const int gw = F.vcu * NWAVES + F.wave, NGW = F.G * NWAVES;
    for (int t = gw; t < F.ntok; t += NGW) {
        const int b = MB[t], prow = rsL[b] + MPp[t];
        const GAS v4u* s = (const GAS v4u*)(N2 + (size_t)t * D) + F.lane; GAS v4u* d = (GAS v4u*)(AP + (size_t)prow * D) + F.lane;
        d[0] = s[0]; d[64] = s[64];
        if (F.lane == 0) { PTOK[prow] = t; PRS[prow] = MRS[t]; PCL[prow] = MCL[t]; PCH[prow] = MCH[t]; }
    }
    const int gt = gw * 64 + F.lane, NGT = NGW * 64;
    for (int b = 0; b < 24; ++b) { const int c = (int)gcnt[b], p0 = rsL[b] + c, p1 = rsL[b + 1];
        for (int r = p0 + gt; r < p1; r += NGT) { PTOK[r] = -1; PRS[r] = 0.f; PCL[r] = 0.f; PCH[r] = 0.f; } }
}
struct MoeOrder {
    int ntile, G, c; const char* A; size_t tA; const char* W; int mode; const LAS unsigned char* tb;
    __device__ bool next(int i, pg8::Unit& u) const {
        const long L = (long)i * G + c; if (L >= (long)ntile * 4) return false;
        u.pm = (int)(L >> 2); u.pn = (int)(L & 3); u.a = A + (size_t)u.pm * tA;
        const int bk = tb[u.pm], g = bk / 6, pr = bk % 6; const int lo = pr < 3 ? 0 : (pr < 5 ? 1 : 2), hi = pr < 3 ? pr + 1 : (pr < 5 ? pr - 1 : 3);
        const int elo = g * 4 + lo, ehi = g * 4 + hi; u.aux = 0;
        if (mode == 1) { const int e = u.pn < 2 ? elo : ehi; u.b = W + ((size_t)e * 512 + (size_t)(u.pn & 1) * 256) * 1024 * 2; u.bjump = 0; }
        else { u.b = W + ((size_t)elo * 1024 + (size_t)u.pn * 256) * 256 * 2; u.bjump = (long)(ehi - elo) * 1024 * 256 * 2 - 4 * 128; }
        return true;
    }
    __device__ __forceinline__ void a_ready(const pg8::Unit&) const {}
    __device__ __forceinline__ void done(const pg8::Unit&) const {}
};
__device__ __forceinline__ float silu_f(float x) { return x * __builtin_amdgcn_rcpf(1.f + __builtin_amdgcn_exp2f(-1.4426950408889634f * x)); }
struct EpiMoe1 {
    static constexpr bool PERM = true, AFTER_DRAIN = false;
    pg8::bf16_t* ACT; const float* PRS; const float* PCL; const float* PCH;
    __device__ __forceinline__ void operator()(const pg8::f32x4 (&acc)[2][2][4][2], const pg8::Unit& u, int wr, int wc, int fr, int fq) const {
        const int row0 = u.pm * pg8::BM + wr * 64 + fr, slot = u.pn >> 1, fcol0 = slot * 256 + (u.pn & 1) * 128 + wc * 16 + 4 * fq; const float* PC = slot ? PCH : PCL;
#pragma unroll
        for (int ai = 0; ai < 2; ++ai)
#pragma unroll
            for (int m = 0; m < 4; ++m) { const int row = row0 + ai * pg8::HALF + m * 16; const float rs = PRS[row], cw = PC[row]; pg8::bf16_t* rowp = ACT + (size_t)row * 512 + fcol0;
#pragma unroll
                for (int bj = 0; bj < 2; ++bj) { const pg8::f32x4 v0 = acc[ai][bj][m][0], v1 = acc[ai][bj][m][1];
                    const float a0 = silu_f(v0[0] * rs) * (v0[1] * rs) * cw, a1 = silu_f(v0[2] * rs) * (v0[3] * rs) * cw, a2 = silu_f(v1[0] * rs) * (v1[1] * rs) * cw, a3 = silu_f(v1[2] * rs) * (v1[3] * rs) * cw;
                    pg8::u32x2 w; w.x = pg8::cvt_pk_bf16(a0, a1); w.y = pg8::cvt_pk_bf16(a2, a3); *(pg8::u32x2*)(rowp + bj * 64) = w; } }
    }
};
struct EpiMoe2 {
    static constexpr bool PERM = false, AFTER_DRAIN = false;
    float* out; const int* PTOK;
    __device__ __forceinline__ void operator()(const pg8::f32x4 (&acc)[2][2][4][2], const pg8::Unit& u, int wr, int wc, int fr, int fq) const {
        const int row0 = u.pm * pg8::BM + wr * 64 + fr, col0 = u.pn * pg8::BM + wc * 32 + 4 * fq;
#pragma unroll
        for (int ai = 0; ai < 2; ++ai)
#pragma unroll
            for (int m = 0; m < 4; ++m) { const int tok = PTOK[row0 + ai * pg8::HALF + m * 16];
                if (tok >= 0) { float* rowp = out + (size_t)tok * 1024 + col0;
#pragma unroll
                    for (int bj = 0; bj < 2; ++bj)
#pragma unroll
                        for (int n = 0; n < 2; ++n) { pg8::f32x4* p = (pg8::f32x4*)(rowp + bj * pg8::HALF + n * 16); *p = *p + acc[ai][bj][m][n]; } } }
    }
};
__device__ __forceinline__ int moe_setup(Frame& F, LAS unsigned char* tb) {
    const unsigned* gcnt = (const unsigned*)(F.ws + WS_CTL) + CW_MOE;
    LAS int* nt_ = (LAS int*)(tb + 256);
    __syncthreads();
    if (F.tid == 0) { int tl = 0; for (int b = 0; b < 24; ++b) { const int n = (int)((gcnt[b] + 255u) >> 8); for (int i = 0; i < n; ++i) tb[tl + i] = (unsigned char)b; tl += n; } nt_[0] = tl; }
    __syncthreads();
    return nt_[0];
}

__global__ void __launch_bounds__(NWAVES * 64, 2) mk_fwd(Args args) {
    extern __shared__ __attribute__((aligned(16))) unsigned char lds[];
    Frame F;
    F.lds = (LAS unsigned char*)lds;
    F.tid = threadIdx.x; F.lane = F.tid & 63; F.wave = __builtin_amdgcn_readfirstlane(F.tid >> 6);
    F.G = gridDim.x; { const int bx = blockIdx.x; F.vcu = (F.G % 8 == 0) ? (bx % 8) * (F.G / 8) + bx / 8 : bx; }
    F.ntok = args.ntok; F.ws = args.ws; F.act = args.ws + WS_ACT;
    const int lo = args.ph_lo, hi = args.ph_hi;
    cooperative_groups::grid_group grid = cooperative_groups::this_grid();
    volatile LAS unsigned* MISCW = (volatile LAS unsigned*)(F.lds + MISC_OFF);
    for (int u = F.tid; u < (LDS_BYTES - LDSCTL_OFF) / 4; u += NWAVES * 64) ((LAS unsigned*)(F.lds + LDSCTL_OFF))[u] = 0u;
    __syncthreads();
    XcdBarrier bar = xcd_barrier_post((unsigned*)(F.ws + WS_CTL) + CW_BAR, MISCW + 8);
#define IN(k) (lo <= (k) && (k) < hi)
#define SEAM(k) do { if (IN(k) && IN((k) + 1)) { xcd_barrier(bar); } } while (0)
    if (IN(0)) { p0_prologue(F, args); }
    SEAM(0);
    if (IN(1)) {
        pg8::Gemm g{1024, 1024, 1024, 16};
        pg8::StaticOrder S; S.init(F.ntok, INWP, F.G, (int)blockIdx.x, args.xb, 1024, F.ws + WS_WIN, 1024);
        EpiProj E{F.act, (size_t)F.ntok};
        pg8::gemm_phase<EpiProj, pg8::StaticOrder, true, true>(F.lds + RING_OFF, g, S, E);
    }
    SEAM(1);
    if (IN(2)) { p2_post(F, args); }
    SEAM(2);
    if (IN(3)) { p3_index(F, args); }
    SEAM(3);
    if (IN(4)) { p4_attn(F, args, lds); }
    SEAM(4);
    if (IN(5)) {
        pg8::Gemm g{1024, 1024, 1024, 16}; const size_t nt_ = (size_t)F.ntok;
        pg8::bf16_t* GA = (pg8::bf16_t*)(F.act + nt_ * O_GA); const pg8::bf16_t* GR = (const pg8::bf16_t*)(F.act + nt_ * O_GR);
        { pg8::StaticOrder S; S.init(F.ntok, 1024, F.G, (int)blockIdx.x, F.act + nt_ * O_QA, 1024, F.ws + WS_WATT, 1024); EpiGateA E{GA};
          pg8::gemm_phase<EpiGateA, pg8::StaticOrder, true, true>(F.lds + RING_OFF, g, S, E); }
        { pg8::StaticOrder S; S.init(F.ntok, 1024, F.G, (int)blockIdx.x, F.act + nt_ * O_RV, 1024, F.ws + WS_WRET, 1024); EpiGateB E{GA, GR};
          pg8::gemm_phase<EpiGateB, pg8::StaticOrder, true, true>(F.lds + RING_OFF, g, S, E); }
    }
    SEAM(5);
    if (IN(6)) {
        pg8::Gemm g{1024, 1024, 1024, 16}; const size_t nt_ = (size_t)F.ntok;
        pg8::StaticOrder S; S.init(F.ntok, 1024, F.G, (int)blockIdx.x, F.act + nt_ * O_GA, 1024, F.ws + WS_WOUT, 1024);
        EpiResid E{args.in[0] + (size_t)args.tok0 * D, args.out + (size_t)args.tok0 * D};
        pg8::gemm_phase<EpiResid, pg8::StaticOrder, true, true>(F.lds + RING_OFF, g, S, E);
    }
    SEAM(6);
    if (IN(7)) { p7_router(F, args); }
    SEAM(7);
    if (IN(8)) { p8_permute(F, args); }
    SEAM(8);
    if (IN(9)) {
        LAS unsigned char* tb = F.lds + LDSCTL_OFF - 1024; const int ntile = moe_setup(F, tb);
        unsigned char* meta = F.act + MO_META;
        pg8::Gemm g{1024, 1024, 1024, 16};
        MoeOrder S{ntile, F.G, (int)blockIdx.x, (const char*)(F.act + MO_APERM), (size_t)256 * 1024 * 2, (const char*)(F.ws + WS_W1), 1, tb};
        EpiMoe1 E{(pg8::bf16_t*)(F.act + MO_ACT), (const float*)(meta + MM_PRS), (const float*)(meta + MM_PCL), (const float*)(meta + MM_PCH)};
        pg8::gemm_phase<EpiMoe1, MoeOrder, true, true>(F.lds + RING_OFF, g, S, E);
    }
    SEAM(9);
    if (IN(10)) {
        LAS unsigned char* tb = F.lds + LDSCTL_OFF - 1024; const int ntile = moe_setup(F, tb);
        unsigned char* meta = F.act + MO_META;
        pg8::Gemm g{512, 512, 256, 4};
        MoeOrder S{ntile, F.G, (int)blockIdx.x, (const char*)(F.act + MO_ACT), (size_t)256 * 512 * 2, (const char*)(F.ws + WS_WD), 2, tb};
        EpiMoe2 E{args.out + (size_t)args.tok0 * D, (const int*)(meta + MM_PTOK)};
        pg8::gemm_phase<EpiMoe2, MoeOrder, true, true>(F.lds + RING_OFF, g, S, E);
    }
    if (hi - lo > 1) grid.sync();
#undef IN
#undef SEAM
}

__device__ __forceinline__ float block_sum256(float v, float* red) {
#pragma unroll
    for (int o = 32; o > 0; o >>= 1) v += __shfl_xor(v, o);
    __syncthreads();
    if ((threadIdx.x & 63) == 0) red[threadIdx.x >> 6] = v;
    __syncthreads();
    return red[0] + red[1] + red[2] + red[3];
}
__device__ __forceinline__ float block_max256(float v, float* red) {
#pragma unroll
    for (int o = 32; o > 0; o >>= 1) v = fmaxf(v, __shfl_xor(v, o));
    __syncthreads();
    if ((threadIdx.x & 63) == 0) red[threadIdx.x >> 6] = v;
    __syncthreads();
    return fmaxf(fmaxf(red[0], red[1]), fmaxf(red[2], red[3]));
}
__device__ __forceinline__ float sigmoidf_(float x) { return 1.f / (1.f + expf(-x)); }
__device__ __forceinline__ float siluf_(float x) { return x / (1.f + expf(-x)); }

__global__ void __launch_bounds__(256) nv_rmsnorm(const float* inb, long in_ld, float* outb, long out_ld, int ninner, int width, const float* gain, int gstride) {
    __shared__ float red[8];
    const int r = blockIdx.x, t = r / ninner, i = r % ninner;
    const float* in = inb + (long)t * in_ld + (long)i * width;
    float* out = outb + (long)t * out_ld + (long)i * width;
    float s = 0.f;
    for (int c = threadIdx.x; c < width; c += 256) { const float v = in[c]; s += v * v; }
    s = block_sum256(s, red);
    const float rs = rsqrtf(s / (float)width + EPS);
    for (int c = threadIdx.x; c < width; c += 256) out[c] = in[c] * rs * gain[i * gstride + c];
}
__global__ void __launch_bounds__(256) nv_gemm(const float* A, long lda, const float* B, long ldb, float* C, long ldc, int M, int N, int K) {
    __shared__ float As[8][128 + 4];
    __shared__ float Bs[8][128 + 4];
    const int tid = threadIdx.x, tx = tid & 15, ty = tid >> 4;
    const int m0 = blockIdx.y * 128, n0 = blockIdx.x * 128;
    float acc[8][8];
#pragma unroll
    for (int i = 0; i < 8; ++i)
#pragma unroll
        for (int j = 0; j < 8; ++j) acc[i][j] = 0.f;
    for (int k0 = 0; k0 < K; k0 += 8) {
        { const int r = tid >> 1, kk = (tid & 1) * 4;
          const float4 v = *(const float4*)(A + (long)(m0 + r) * lda + k0 + kk);
          As[kk + 0][r] = v.x; As[kk + 1][r] = v.y; As[kk + 2][r] = v.z; As[kk + 3][r] = v.w; }
        { const int kk = tid >> 5, c = (tid & 31) * 4;
#pragma unroll
          for (int j = 0; j < 4; ++j) { const int n = n0 + c + j; Bs[kk][c + j] = (n < N) ? B[(long)(k0 + kk) * ldb + n] : 0.f; } }
        __syncthreads();
#pragma unroll
        for (int kk = 0; kk < 8; ++kk) {
            float a[8], b[8];
#pragma unroll
            for (int i = 0; i < 8; ++i) a[i] = As[kk][ty * 8 + i];
#pragma unroll
            for (int j = 0; j < 8; ++j) b[j] = Bs[kk][tx * 8 + j];
#pragma unroll
            for (int i = 0; i < 8; ++i)
#pragma unroll
                for (int j = 0; j < 8; ++j) acc[i][j] += a[i] * b[j];
        }
        __syncthreads();
    }
#pragma unroll
    for (int i = 0; i < 8; ++i)
#pragma unroll
        for (int j = 0; j < 8; ++j) { const int n = n0 + tx * 8 + j; if (n < N) C[(long)(m0 + ty * 8 + i) * ldc + n] = acc[i][j]; }
}
__global__ void __launch_bounds__(256) nv_attn(const float* proj, const float* kv, float* att, float wscale, float dscale, float lscale, const unsigned* maskb) {
    __shared__ float s_qi[512], s_w[8], s_score[2048], s_q[1024], s_p[8][256], red[8];
    __shared__ int s_sel[256 + 64]; __shared__ int s_pref[65]; __shared__ unsigned s_mw[64];
    const int tq = blockIdx.x, b = tq / SEQ, t = tq % SEQ, tid = threadIdx.x;
    const float* prow = proj + (long)tq * INW;
    const float* pb = proj + (long)b * SEQ * INW;
    const float* kvb = kv + (long)b * SEQ * 256;
    for (int i = tid; i < 512; i += 256) s_qi[i] = prow[C_QI + i];
    for (int i = tid; i < 1024; i += 256) s_q[i] = prow[C_QA + i];
    if (tid < 8) s_w[tid] = prow[C_WI + tid] * wscale;
    __syncthreads();
    const int n = t + 1;
    int cnt;
    if (maskb) {
        if (tid < 64) s_mw[tid] = (tid * 32 <= t) ? maskb[tid * 2048 + t] : 0u;
        __syncthreads();
        if (tid == 0) { int c = 0; for (int i = 0; i < 64; ++i) { s_pref[i] = c; c += __builtin_popcount(s_mw[i]); } s_pref[64] = c; }
        __syncthreads();
        if (tid < 64) { unsigned x = s_mw[tid]; int p = s_pref[tid]; while (x) { const int bpos = __builtin_ctz(x); x &= x - 1; if (p < 256) s_sel[p] = tid * 32 + bpos; ++p; } }
        cnt = s_pref[64] < 256 ? s_pref[64] : 256;
        __syncthreads();
    } else {
    for (int s = tid; s < n; s += 256) {
        const float* kr = pb + (long)s * INW + C_KI;
        float kk[64];
#pragma unroll
        for (int d = 0; d < 64; ++d) kk[d] = kr[d];
        float sc = 0.f;
#pragma unroll
        for (int h = 0; h < 8; ++h) {
            float dt = 0.f;
#pragma unroll
            for (int d = 0; d < 64; ++d) dt += s_qi[h * 64 + d] * kk[d];
            dt *= dscale;
            sc += fmaxf(dt, 0.f) * s_w[h];
        }
        s_score[s] = sc;
    }
    __syncthreads();
    if (n <= 256) { if (tid < n) s_sel[tid] = tid; cnt = n; }
    else {
        for (int s = tid; s < n; s += 256) {
            const float v = s_score[s]; int rank = 0;
            for (int j = 0; j < n; ++j) { const float u = s_score[j]; rank += (u > v || (u == v && j < s)) ? 1 : 0; }
            if (rank < 256) s_sel[rank] = s;
        }
        cnt = 256;
    }
    __syncthreads();
    }
    float lg[8];
    const bool act = tid < cnt;
    const int sj = act ? s_sel[tid] : 0;
    {
        const float* kr = kvb + (long)sj * 256;
#pragma unroll
        for (int h = 0; h < 8; ++h) lg[h] = 0.f;
        for (int d = 0; d < 128; ++d) { const float kd = kr[d];
#pragma unroll
            for (int h = 0; h < 8; ++h) lg[h] += s_q[h * 128 + d] * kd; }
    }
#pragma unroll
    for (int h = 0; h < 8; ++h) {
        const float slope = exp2f(-(float)(h + 1));
        float x = act ? (lg[h] * lscale - slope * (float)(t - sj)) : -INFINITY;
        const float m = block_max256(x, red);
        const float e = act ? expf(x - m) : 0.f;
        const float su = block_sum256(e, red);
        s_p[h][tid] = e / su;
    }
    __syncthreads();
    float o4[4] = {0.f, 0.f, 0.f, 0.f};
    for (int j = 0; j < cnt; ++j) {
        const float* vr = kvb + (long)s_sel[j] * 256 + 128;
#pragma unroll
        for (int i = 0; i < 4; ++i) { const int o = tid + 256 * i; o4[i] += s_p[o >> 7][j] * vr[o & 127]; }
    }
#pragma unroll
    for (int i = 0; i < 4; ++i) att[(long)tq * 1024 + tid + 256 * i] = o4[i];
}
__global__ void __launch_bounds__(256) nv_ret(const float* proj, float* reto) {
    __shared__ float sq[128], sk[128];
    const int b = blockIdx.x >> 2, h = blockIdx.x & 3, v = threadIdx.x;
    const float gamma = 1.f - exp2f(-5.f - (float)h);
    float S[128];
#pragma unroll
    for (int d = 0; d < 128; ++d) S[d] = 0.f;
    for (int t = 0; t < SEQ; ++t) {
        const float* row = proj + (long)(b * SEQ + t) * INW;
        if (v < 128) { sq[v] = row[C_RQ + h * 128 + v]; sk[v] = row[C_RK + h * 128 + v] * 0.08838834764831845f; }
        __syncthreads();
        const float vv = row[C_RV + h * 256 + v];
        float o = 0.f;
#pragma unroll
        for (int d = 0; d < 128; ++d) { S[d] = gamma * S[d] + sk[d] * vv; o += sq[d] * S[d]; }
        reto[(long)(b * SEQ + t) * 1024 + h * 256 + v] = o;
        __syncthreads();
    }
}
__global__ void __launch_bounds__(256) nv_retpost(const float* proj, const float* reto, const float* g, float* a2) {
    __shared__ float red[8];
    const int t = blockIdx.x >> 2, h = blockIdx.x & 3, c = threadIdx.x;
    const float x = reto[(long)t * 1024 + h * 256 + c];
    const float mu = block_sum256(x, red) * (1.f / 256.f);
    const float dv = x - mu;
    const float var = block_sum256(dv * dv, red) * (1.f / 256.f);
    const float y = dv * rsqrtf(var + EPS) * g[h * 256 + c];
    a2[(long)t * 1024 + h * 256 + c] = siluf_(proj[(long)t * INW + C_RG + h * 256 + c]) * y;
}
__global__ void __launch_bounds__(256) nv_mix(const float* proj, const float* ya, const float* yr, float* mix) {
    const long i = (long)blockIdx.x * 256 + threadIdx.x; const long t = i >> 10; const int c = (int)(i & 1023);
    mix[i] = sigmoidf_(proj[t * INW + C_GA + c]) * ya[i] + sigmoidf_(proj[t * INW + C_GR + c]) * yr[i];
}
__global__ void __launch_bounds__(256) nv_add(const float* a, const float* b, float* o) {
    const long i = (long)blockIdx.x * 256 + threadIdx.x; o[i] = a[i] + b[i];
}
__global__ void __launch_bounds__(256) nv_moe(const float* n2, float* hio, const float* wgr, const float* bgr, const float* wer, const float* ber,
                                              const float* wg, const float* wu, const float* wd) {
    __shared__ float s_n[1024], s_lg[20], s_act[256], s_p[2];
    __shared__ int s_e[2];
    const int t = blockIdx.x, tid = threadIdx.x;
    for (int i = tid; i < 1024; i += 256) s_n[i] = n2[(long)t * 1024 + i];
    __syncthreads();
    if (tid < 20) {
        float a = 0.f;
        if (tid < 4) { for (int d = 0; d < 1024; ++d) a += s_n[d] * wgr[d * 4 + tid]; a += bgr[tid]; }
        else { const int e = tid - 4; for (int d = 0; d < 1024; ++d) a += s_n[d] * wer[d * 16 + e]; a += ber[e]; }
        s_lg[tid] = a;
    }
    __syncthreads();
    if (tid == 0) {
        int g = 0; float m = s_lg[0];
        for (int i = 1; i < 4; ++i) if (s_lg[i] > m) { m = s_lg[i]; g = i; }
        float se = 0.f; for (int i = 0; i < 4; ++i) se += expf(s_lg[i] - m);
        const float gw = 1.f / se;
        const float* el = s_lg + 4 + g * 4;
        int i1 = 0; for (int i = 1; i < 4; ++i) if (el[i] > el[i1]) i1 = i;
        int i2 = -1; for (int i = 0; i < 4; ++i) if (i != i1 && (i2 < 0 || el[i] > el[i2])) i2 = i;
        const float e2 = expf(el[i2] - el[i1]);
        s_p[0] = gw / (1.f + e2); s_p[1] = gw * e2 / (1.f + e2);
        s_e[0] = g * 4 + i1; s_e[1] = g * 4 + i2;
    }
    __syncthreads();
    float acc[4] = {0.f, 0.f, 0.f, 0.f};
    for (int sl = 0; sl < 2; ++sl) {
        const int e = s_e[sl]; const float p = s_p[sl];
        const float* g_ = wg + (long)e * 1024 * 256 + tid; const float* u_ = wu + (long)e * 1024 * 256 + tid;
        float hg = 0.f, hu = 0.f;
        for (int d = 0; d < 1024; ++d) { hg += s_n[d] * g_[(long)d * 256]; hu += s_n[d] * u_[(long)d * 256]; }
        __syncthreads();
        s_act[tid] = siluf_(hg) * hu * p;
        __syncthreads();
        const float* d_ = wd + (long)e * 256 * 1024;
        for (int f = 0; f < 256; ++f) { const float a = s_act[f];
#pragma unroll
            for (int i = 0; i < 4; ++i) acc[i] += a * d_[(long)f * 1024 + tid + 256 * i]; }
    }
#pragma unroll
    for (int i = 0; i < 4; ++i) hio[(long)t * 1024 + tid + 256 * i] += acc[i];
}
__global__ void __launch_bounds__(256) ad_proj(const unsigned char* act, int ntok, int tok_lo, float* PROJ) {
    const int t = blockIdx.x; const size_t tg = (size_t)(tok_lo + t); const size_t nt = (size_t)ntok;
    const bf16* QA = (const bf16*)(act + nt * O_QA) + tg * 1024; const bf16* CKV = (const bf16*)(act + nt * O_CKV) + tg * 256; const bf16* QI = (const bf16*)(act + nt * O_QI) + tg * 512;
    const bf16* KW = (const bf16*)(act + nt * O_KW) + tg * 128; const bf16* RQ = (const bf16*)(act + nt * O_RQ) + tg * 512; const bf16* RK = (const bf16*)(act + nt * O_RK) + tg * 512;
    const bf16* R4 = (const bf16*)(act + nt * O_RV);
    float* o = PROJ + (size_t)t * INW;
    for (int c = threadIdx.x; c < INW; c += 256) {
        bf16 v;
        if (c < C_CKV) v = QA[c]; else if (c < C_QI) v = CKV[c - C_CKV]; else if (c < C_KI) v = QI[c - C_QI]; else if (c < C_RQ) v = KW[c - C_KI];
        else if (c < C_RK) v = RQ[c - C_RQ]; else if (c < C_RV) v = RK[c - C_RK];
        else { const int cc = c - C_RV; v = R4[(size_t)(cc >> 10) * nt * 1024 + tg * 1024 + (cc & 1023)]; }
        o[c] = bf2f(v);
    }
}


__global__ void __launch_bounds__(256) ad_kv(const unsigned char* aux, int ntok, int tok_lo, float* KV, float* PROJ) {
    const int t = blockIdx.x; const size_t tg = (size_t)(tok_lo + t); const size_t nt = (size_t)ntok; const int c = threadIdx.x;
    const bf16* KP = (const bf16*)(aux + nt * AUX_KP) + tg * 128; const bf16* VV = (const bf16*)(aux + nt * AUX_VV) + tg * 128; const bf16* KIN = (const bf16*)(aux + nt * AUX_KIN) + tg * 64;
    KV[(size_t)t * 256 + c] = bf2f(c < 128 ? KP[c] : VV[c - 128]);
    if (c < 64) PROJ[(size_t)t * INW + C_KI + c] = bf2f(KIN[c]);
}
__global__ void __launch_bounds__(256) nv_fill(float* p, float v, int n) { const int i = blockIdx.x * 256 + threadIdx.x; if (i < n) p[i] = v; }


__global__ void __launch_bounds__(256) ad_att(const unsigned char* act, int ntok, int tok_lo, float* ATT) {
    const int t = blockIdx.x; const bf16* A = (const bf16*)(act + (size_t)ntok * O_QA) + (size_t)(tok_lo + t) * 1024;
    for (int c = threadIdx.x; c < 1024; c += 256) ATT[(size_t)t * 1024 + c] = bf2f(A[c]);
}


__global__ void __launch_bounds__(256) ad_a2(const unsigned char* act, int ntok, int tok_lo, float* A2) {
    const int t = blockIdx.x; const bf16* A = (const bf16*)(act + (size_t)ntok * O_RV) + (size_t)(tok_lo + t) * 1024;
    for (int c = threadIdx.x; c < 1024; c += 256) A2[(size_t)t * 1024 + c] = bf2f(A[c]);
}

static void gemm(hipStream_t st, const float* A, long lda, const float* B, long ldb, float* C, long ldc, int M, int N, int K) {
    hipLaunchKernelGGL(nv_gemm, dim3((N + 127) / 128, M / 128), dim3(256), 0, st, A, lda, B, ldb, C, ldc, M, N, K);
}

extern "C" void kernel_launch(void* const* d_in, const int* in_sizes, int n_in, void* d_out, int out_size, void* d_ws, size_t ws_size, hipStream_t stream) {
    static int grid = 0;
    if (grid == 0) {
        int dev = 0, cus = 0, per_cu = 0;
        (void)hipGetDevice(&dev); (void)hipDeviceGetAttribute(&cus, hipDeviceAttributeMultiprocessorCount, dev);
        if (hipFuncSetAttribute((const void*)mk_fwd, hipFuncAttributeMaxDynamicSharedMemorySize, LDS_BYTES) != hipSuccess) { fprintf(stderr, "kernel_launch: hipFuncSetAttribute failed\n"); grid = -1; return; }
        (void)hipOccupancyMaxActiveBlocksPerMultiprocessor(&per_cu, (const void*)mk_fwd, NWAVES * 64, LDS_BYTES);
        (void)hipGetLastError();
        if (per_cu < 1) { fprintf(stderr, "kernel_launch: occupancy query says %d blocks per CU\n", per_cu); per_cu = 1; }
        grid = cus * per_cu;
        if (n_in != 20 || ws_size < (size_t)512 * MiB) { fprintf(stderr, "kernel_launch: unexpected n_in %d / ws_size %zu\n", n_in, ws_size); grid = -1; return; }
    }
    if (grid < 0) return;
    const float* x = (const float*)d_in[0];
    const float* kv_norm_g = (const float*)d_in[3]; const float* w_kv_up = (const float*)d_in[4]; const float* q_norm_g = (const float*)d_in[5];
    const float* k_norm_g = (const float*)d_in[6]; const float* idx_k_norm_g = (const float*)d_in[7]; const float* ret_norm_g = (const float*)d_in[8];
    const float* w_att = (const float*)d_in[9]; const float* w_ret = (const float*)d_in[10]; const float* w_out = (const float*)d_in[11];
    const float* norm2_g = (const float*)d_in[12]; const float* w_gr = (const float*)d_in[13]; const float* b_gr = (const float*)d_in[14];
    const float* w_er = (const float*)d_in[15]; const float* b_er = (const float*)d_in[16]; const float* w_eg = (const float*)d_in[17];
    const float* w_eu = (const float*)d_in[18]; const float* w_ed = (const float*)d_in[19];
    float* out = (float*)d_out;
    unsigned char* ws = (unsigned char*)d_ws;
    if (ws_size < WS_ACT + (size_t)T * O_END) { fprintf(stderr, "kernel_launch: workspace too small\n"); return; }
    (void)x; (void)kv_norm_g; (void)w_kv_up; (void)q_norm_g; (void)k_norm_g; (void)idx_k_norm_g; (void)ret_norm_g; (void)w_att; (void)w_ret; (void)w_out; (void)norm2_g; (void)w_gr; (void)b_gr; (void)w_er; (void)b_er; (void)w_eg; (void)w_eu; (void)w_ed;
    (void)hipMemsetAsync(ws + WS_CTL, 0, CTL_ZERO_BYTES, stream);
    Args a{};
    for (int i = 0; i < 20; ++i) a.in[i] = (const float*)d_in[i];
    a.out = out; a.ws = ws; a.xb = (unsigned char*)d_out; a.ntok = T; a.tok0 = 0;
    void* kargs[] = {(void*)&a};
    if (PROBE_PH >= 0) { a.ph_lo = PROBE_PH; a.ph_hi = PROBE_PH + 1; a.mode = PROBE_MODE;
        (void)hipLaunchCooperativeKernel((const void*)mk_fwd, dim3(grid), dim3(NWAVES * 64), kargs, (unsigned)LDS_BYTES, stream);
        (void)hipMemsetAsync(ws + WS_CTL, 0, CTL_ZERO_BYTES, stream); }
    a.ph_lo = 0; a.ph_hi = 11; a.mode = 0;
    const hipError_t le = hipLaunchCooperativeKernel((const void*)mk_fwd, dim3(grid), dim3(NWAVES * 64), kargs, (unsigned)LDS_BYTES, stream);
    if (le != hipSuccess) fprintf(stderr, "kernel_launch: cooperative launch failed: %s (grid %d)\n", hipGetErrorString(le), grid);
}
```

```cpp
#include <hip/hip_runtime.h>
#include <hip/hip_cooperative_groups.h>
#include <cstdio>
#include <cstdint>

namespace pg8 {
#define PG8_LAS __attribute__((address_space(3)))
typedef unsigned short bf16_t;
typedef short bf16x8 __attribute__((ext_vector_type(8)));
typedef float f32x4 __attribute__((ext_vector_type(4)));
typedef unsigned u32x4 __attribute__((ext_vector_type(4)));
typedef unsigned u32x2 __attribute__((ext_vector_type(2)));
constexpr int BM = 256, BK = 64, HALF = 128, HTB = HALF * BK * 2  , STAGE_BYTES = 8 * HTB, NXCD = 8, WGM = 8;

__host__ __device__ __forceinline__ int lds_byte(int r, int c) { const int st = (r >> 4) * 2 + (c >> 5), rr = r & 15, cc = c & 31, ob = rr * 64 + cc * 2; return st * 1024 + (ob ^ (((ob >> 9) & 1) << 5)); }
__host__ __device__ __forceinline__ void stage_rc(int b, int& R, int& C) { const int st = b / 1024, sb = b % 1024, swz = sb ^ (((sb >> 9) & 1) << 5); R = (st >> 1) * 16 + swz / 64; C = (st & 1) * 32 + (swz % 64) / 2; }
__host__ __device__ __forceinline__ int perm32(int rho) { const int n = rho >> 4, i = rho & 15; return 8 * (i >> 2) + 4 * n + (i & 3); }

struct Unit { int pm, pn; const char* a; const char* b; long bjump; int aux; };
struct Gemm { int K, lda, ldb, ksplit; };

struct StaticOrder {
    static constexpr bool GATHER = false; const int* ptok = nullptr;
    int nM, nN, nwg, G, c; const char* A; const char* Bt; size_t tA, tB;
    __device__ void init(int M, int N, int G_, int c_, const void* A_, int lda, const void* Bt_, int ldb) { nM = M / BM; nN = N / BM; nwg = nM * nN; G = G_; c = c_; A = (const char*)A_; Bt = (const char*)Bt_; tA = (size_t)BM * lda * 2; tB = (size_t)BM * ldb * 2; }
    __device__ bool next(int i, Unit& u) const {
        const long L = (long)i * G + c; if (L >= nwg) return false;
        int wgid = (int)L; { const int q = nwg / NXCD, r = nwg % NXCD, xcd = wgid % NXCD, off = wgid / NXCD; wgid = (xcd < r ? xcd * (q + 1) : r * (q + 1) + (xcd - r) * q) + off; }
        const int nig = WGM * nN, gid = wgid / nig, fm = gid * WGM, gsz = (nM - fm) < WGM ? (nM - fm) : WGM;
        u.pm = fm + ((wgid % nig) % gsz); u.pn = (wgid % nig) / gsz; u.a = A + (size_t)u.pm * tA; u.b = Bt + (size_t)u.pn * tB; u.bjump = 0; u.aux = 0; return true;
    }
    __device__ __forceinline__ void a_ready(const Unit&) const {}
    __device__ __forceinline__ void done(const Unit&) const {}
};

typedef float f32x2c __attribute__((ext_vector_type(2))); typedef __bf16 bf16x2c __attribute__((ext_vector_type(2)));
__device__ __forceinline__ unsigned cvt_pk_bf16(float lo, float hi) { const f32x2c v = {lo, hi}; const bf16x2c b = __builtin_convertvector(v, bf16x2c); return __builtin_bit_cast(unsigned, b); }
__device__ __forceinline__ float bf_lo(unsigned w) { return __uint_as_float(w << 16); }
__device__ __forceinline__ float bf_hi(unsigned w) { return __uint_as_float(w & 0xffff0000u); }


template <class Epi, class Sched, bool ALIGN_EPI = false, bool SP2 = false>
__device__ __forceinline__ void gemm_phase(PG8_LAS unsigned char* lds, const Gemm g, const Sched& S, const Epi& E) {
    const int tid = threadIdx.x, wid = __builtin_amdgcn_readfirstlane(tid >> 6), lane = tid & 63, wr = wid >> 2, wc = wid & 3, fr = lane & 15, fq = lane >> 4;
    const int K = g.K, nt = K / BK;
    unsigned voffA[2], voffB[2]; int gR[2]; unsigned gC[2];
#pragma unroll
    for (int i = 0; i < 2; ++i) { int R, C; stage_rc(tid * 16 + i * 8192, R, C); const int Rb = Epi::PERM ? ((R & ~31) + perm32(R & 31)) : R; gR[i] = R; gC[i] = (unsigned)C * 2u;
        voffA[i] = (unsigned)(R * g.lda + C) * 2u; voffB[i] = (unsigned)(Rb * g.ldb + C) * 2u; }
    unsigned gA0[2] = {0u, 0u}, gA1[2] = {0u, 0u}, gN0[2] = {0u, 0u}, gN1[2] = {0u, 0u};
#define PG8_GOFF(u_, o0, o1) do { _Pragma("unroll") for (int i_ = 0; i_ < 2; ++i_) { int t0_ = S.ptok[(u_).pm * BM + gR[i_]], t1_ = S.ptok[(u_).pm * BM + HALF + gR[i_]]; t0_ = t0_ < 0 ? 0 : t0_; t1_ = t1_ < 0 ? 0 : t1_; \
        o0[i_] = (unsigned)t0_ * (unsigned)(g.lda * 2) + gC[i_]; o1[i_] = (unsigned)t1_ * (unsigned)(g.lda * 2) + gC[i_]; } } while (0)
    const size_t kstep = (size_t)(BK * 2);
    const size_t hstepA = Sched::GATHER ? (size_t)0 : (size_t)HALF * g.lda * 2, hstepB = (size_t)HALF * g.ldb * 2;
    const unsigned ldsw = (unsigned)wid * 1024u;
    const int aoff = lds_byte(wr * 64 + fr, fq * 8), boff = lds_byte(wc * 32 + fr, fq * 8);
#define PG8_SA(b, h) (((b) * 2 + (h)) * HTB)
#define PG8_SB(b, h) ((4 + (b) * 2 + (h)) * HTB)
#define PG8_STAGE(bufoff, gbase, voff) do { _Pragma("unroll") for (int _i = 0; _i < 2; ++_i) \
        __builtin_amdgcn_global_load_lds((const unsigned*)((const char*)(gbase) + (voff)[_i]), (PG8_LAS unsigned*)(lds + (bufoff) + ldsw + _i * 8192), 16, 0, 0); } while (0)
#define PG8_LDA(dst, b, h) do { _Pragma("unroll") for (int m = 0; m < 4; ++m) _Pragma("unroll") for (int k = 0; k < 2; ++k) dst[m][k] = *(const PG8_LAS bf16x8*)(lds + PG8_SA(b, h) + aoff + m * 2048 + k * 1024); } while (0)
#define PG8_LDB(dst, b, h) do { _Pragma("unroll") for (int n = 0; n < 2; ++n) _Pragma("unroll") for (int k = 0; k < 2; ++k) dst[n][k] = *(const PG8_LAS bf16x8*)(lds + PG8_SB(b, h) + boff + n * 2048 + k * 1024); } while (0)
#define PG8_MMA(ai, bj, At, Bt) do { __builtin_amdgcn_s_setprio(1); _Pragma("unroll") for (int m = 0; m < 4; ++m) _Pragma("unroll") for (int n = 0; n < 2; ++n) _Pragma("unroll") for (int k = 0; k < 2; ++k) \
        acc[ai][bj][m][n] = __builtin_amdgcn_mfma_f32_16x16x32_bf16(Bt[n][k], At[m][k], acc[ai][bj][m][n], 0, 0, 0); __builtin_amdgcn_s_setprio(0); } while (0)
#define PG8_WAIT_V(n) asm volatile("s_waitcnt vmcnt(" #n ")" ::: "memory")
#define PG8_WAIT_L(n) asm volatile("s_waitcnt lgkmcnt(" #n ")" ::: "memory")
#define PG8_BAR __builtin_amdgcn_s_barrier()
#define PG8_SCHED __builtin_amdgcn_sched_barrier(0)
    Unit cur, nxt; int ui = 0;
    if (!S.next(0, cur)) return;
    f32x4 acc[2][2][4][2];
#pragma unroll
    for (int a = 0; a < 2; ++a)
#pragma unroll
        for (int b = 0; b < 2; ++b)
#pragma unroll
            for (int m = 0; m < 4; ++m)
#pragma unroll
                for (int n = 0; n < 2; ++n) acc[a][b][m][n] = (f32x4){0.f, 0.f, 0.f, 0.f};
    bf16x8 At[4][2], B0[2][2], B1[2][2];
    const char* cA = cur.a; const char* cB = cur.b; long cJ = cur.bjump;
    S.a_ready(cur);
    if constexpr (SP2) {
        if constexpr (Sched::GATHER) PG8_GOFF(cur, gA0, gA1);
        PG8_STAGE(PG8_SB(0, 0), cB, voffB); PG8_STAGE(PG8_SB(0, 1), cB + hstepB, voffB); do { if constexpr (Sched::GATHER) { PG8_STAGE(PG8_SA(0, 0), cA, gA0); } else { PG8_STAGE(PG8_SA(0, 0), cA, voffA); } } while (0); do { if constexpr (Sched::GATHER) { PG8_STAGE(PG8_SA(0, 1), cA, gA1); } else { PG8_STAGE(PG8_SA(0, 1), cA + hstepA, voffA); } } while (0);
        if (wr == 1) PG8_BAR;
        PG8_WAIT_V(2); PG8_BAR;
        PG8_STAGE(PG8_SB(1, 0), cB + kstep, voffB); do { if constexpr (Sched::GATHER) { PG8_STAGE(PG8_SA(1, 0), cA + kstep, gA0); } else { PG8_STAGE(PG8_SA(1, 0), cA + kstep, voffA); } } while (0); PG8_STAGE(PG8_SB(1, 1), cB + hstepB + kstep, voffB);
        PG8_WAIT_V(6); PG8_BAR;
    } else {
        PG8_STAGE(PG8_SB(0, 0), cB, voffB); PG8_STAGE(PG8_SA(0, 0), cA, voffA); PG8_STAGE(PG8_SB(0, 1), cB + hstepB, voffB); PG8_STAGE(PG8_SA(0, 1), cA + hstepA, voffA);
        if (wr == 1) PG8_BAR;
        PG8_WAIT_V(4); PG8_BAR;
        PG8_STAGE(PG8_SB(1, 0), cB + kstep, voffB); PG8_STAGE(PG8_SA(1, 0), cA + kstep, voffA); PG8_STAGE(PG8_SB(1, 1), cB + hstepB + kstep, voffB);
        PG8_WAIT_V(6); PG8_BAR;
    }
    for (;;) {
        const bool has_next = S.next(ui + 1, nxt);
        const char* nA = has_next ? nxt.a : cA; const char* nB = has_next ? nxt.b : cB;
        if constexpr (Sched::GATHER) { if (has_next) PG8_GOFF(nxt, gN0, gN1); else { gN0[0] = gA0[0]; gN0[1] = gA0[1]; gN1[0] = gA1[0]; gN1[1] = gA1[1]; } }
#pragma unroll 1
        for (int t = 0; t < nt; t += 2) {
            const bool last = (t == nt - 2);
            const char* a1 = cA + (size_t)(t + 1) * kstep;
            const char* a2 = last ? nA : cA + (size_t)(t + 2) * kstep; const char* b2 = last ? nB : cB + (size_t)(t + 2) * kstep + ((t + 2) >= g.ksplit ? cJ : 0L);
            const char* a3 = a2 + kstep; const char* b3 = b2 + kstep;
            if (last && has_next) S.a_ready(nxt);
            unsigned x0[2] = {0u, 0u}, x1[2] = {0u, 0u};
            if constexpr (Sched::GATHER) { x0[0] = last ? gN0[0] : gA0[0]; x0[1] = last ? gN0[1] : gA0[1]; x1[0] = last ? gN1[0] : gA1[0]; x1[1] = last ? gN1[1] : gA1[1]; }
            if constexpr (SP2) {
            PG8_LDB(B0, 0, 0); PG8_LDB(B1, 0, 1); PG8_SCHED; PG8_LDA(At, 0, 0); do { if constexpr (Sched::GATHER) { PG8_STAGE(PG8_SA(1, 1), a1, gA1); } else { PG8_STAGE(PG8_SA(1, 1), a1 + hstepA, voffA); } } while (0);
            PG8_WAIT_V(8); PG8_WAIT_L(0); PG8_BAR; PG8_MMA(0, 0, At, B0); PG8_MMA(0, 1, At, B1); PG8_BAR; PG8_SCHED;
            PG8_LDA(At, 0, 1); PG8_STAGE(PG8_SB(0, 0), b2, voffB); PG8_STAGE(PG8_SB(0, 1), b2 + hstepB, voffB); do { if constexpr (Sched::GATHER) { PG8_STAGE(PG8_SA(0, 0), a2, x0); } else { PG8_STAGE(PG8_SA(0, 0), a2, voffA); } } while (0);
            PG8_WAIT_V(8); PG8_WAIT_L(0); PG8_BAR; PG8_MMA(1, 0, At, B0); PG8_MMA(1, 1, At, B1); PG8_BAR; PG8_SCHED;
            PG8_LDB(B0, 1, 0); PG8_LDB(B1, 1, 1); PG8_SCHED; PG8_LDA(At, 1, 0); do { if constexpr (Sched::GATHER) { PG8_STAGE(PG8_SA(0, 1), a2, x1); } else { PG8_STAGE(PG8_SA(0, 1), a2 + hstepA, voffA); } } while (0);
            PG8_WAIT_V(8); PG8_WAIT_L(0); PG8_BAR; PG8_MMA(0, 0, At, B0); PG8_MMA(0, 1, At, B1); PG8_BAR; PG8_SCHED;
            PG8_LDA(At, 1, 1); PG8_STAGE(PG8_SB(1, 0), b3, voffB); PG8_STAGE(PG8_SB(1, 1), b3 + hstepB, voffB); do { if constexpr (Sched::GATHER) { PG8_STAGE(PG8_SA(1, 0), a3, x0); } else { PG8_STAGE(PG8_SA(1, 0), a3, voffA); } } while (0);
            PG8_WAIT_V(8); PG8_WAIT_L(0); PG8_BAR; PG8_MMA(1, 0, At, B0); PG8_MMA(1, 1, At, B1); PG8_BAR; PG8_SCHED;
            } else {
            PG8_LDB(B0, 0, 0); PG8_SCHED; PG8_LDA(At, 0, 0); PG8_STAGE(PG8_SA(1, 1), a1 + hstepA, voffA);
            PG8_WAIT_L(8); PG8_BAR; PG8_WAIT_L(0); PG8_MMA(0, 0, At, B0); PG8_BAR; PG8_SCHED;
            PG8_LDB(B1, 0, 1); PG8_STAGE(PG8_SB(0, 0), b2, voffB);
            PG8_BAR; PG8_WAIT_L(0); PG8_MMA(0, 1, At, B1); PG8_BAR;
            PG8_LDA(At, 0, 1); PG8_STAGE(PG8_SA(0, 0), a2, voffA);
            PG8_BAR; PG8_WAIT_L(0); PG8_MMA(1, 0, At, B0); PG8_BAR; PG8_SCHED;
            PG8_STAGE(PG8_SB(0, 1), b2 + hstepB, voffB);
            PG8_WAIT_V(6); PG8_BAR; PG8_MMA(1, 1, At, B1); PG8_BAR;
            PG8_LDB(B0, 1, 0); PG8_SCHED; PG8_LDA(At, 1, 0); PG8_STAGE(PG8_SA(0, 1), a2 + hstepA, voffA);
            PG8_WAIT_L(8); PG8_BAR; PG8_WAIT_L(0); PG8_MMA(0, 0, At, B0); PG8_BAR; PG8_SCHED;
            PG8_LDB(B1, 1, 1); PG8_STAGE(PG8_SB(1, 0), b3, voffB);
            PG8_BAR; PG8_WAIT_L(0); PG8_MMA(0, 1, At, B1); PG8_BAR;
            PG8_LDA(At, 1, 1); PG8_STAGE(PG8_SA(1, 0), a3, voffA);
            PG8_BAR; PG8_WAIT_L(0); PG8_MMA(1, 0, At, B0); PG8_BAR; PG8_SCHED;
            PG8_STAGE(PG8_SB(1, 1), b3 + hstepB, voffB);
            PG8_WAIT_V(6); PG8_BAR; PG8_MMA(1, 1, At, B1); PG8_BAR;
            }
        }
        if constexpr (ALIGN_EPI) { if (wr == 0) PG8_BAR; }
        if constexpr (!Epi::AFTER_DRAIN) { E(acc, cur, wr, wc, fr, fq); S.done(cur); }
        if (!has_next) break;
#pragma unroll
        for (int a = 0; a < 2; ++a)
#pragma unroll
            for (int b = 0; b < 2; ++b)
#pragma unroll
                for (int m = 0; m < 4; ++m)
#pragma unroll
                    for (int n = 0; n < 2; ++n) acc[a][b][m][n] = (f32x4){0.f, 0.f, 0.f, 0.f};
        cur = nxt; cA = nA; cB = nB; cJ = cur.bjump; ++ui;
        if constexpr (Sched::GATHER) { gA0[0] = gN0[0]; gA0[1] = gN0[1]; gA1[0] = gN1[0]; gA1[1] = gN1[1]; }
        if constexpr (ALIGN_EPI) { if (wr == 1) PG8_BAR; }
    }
    PG8_WAIT_V(0);
    if constexpr (!ALIGN_EPI) { if (wr == 0) PG8_BAR; }
    PG8_BAR;
    if constexpr (Epi::AFTER_DRAIN) { E.fused(acc, cur, wr, wc, fr, fq, lds, wid, lane); S.done(cur); }
#undef PG8_GOFF
#undef PG8_SA
#undef PG8_SB
#undef PG8_STAGE
#undef PG8_LDA
#undef PG8_LDB
#undef PG8_MMA
#undef PG8_WAIT_V
#undef PG8_WAIT_L
#undef PG8_BAR
#undef PG8_SCHED
}
}

#ifndef PROBE_PH
#define PROBE_PH (-1)
#endif
#ifndef PROBE_MODE
#define PROBE_MODE (0)
#endif
constexpr int D = 1024, BATCH = 16, SEQ = 2048, T = BATCH * SEQ;
constexpr int INW = 6984, INWP = 7168;
constexpr int C_QA = 0, C_CKV = 1024, C_QI = 1280, C_KI = 1792, C_WI = 1856, C_RQ = 1864, C_RK = 2376, C_RV = 2888, C_RG = 3912, C_GA = 4936, C_GR = 5960;
constexpr float EPS = 1e-6f;
constexpr int NWAVES = 8;

constexpr size_t MiB = 1u << 20;
constexpr size_t WS_CTL = 0, CTL_ZERO_BYTES = 1 * MiB;
constexpr size_t WS_WIN = 1 * MiB, WS_WKV = 15 * MiB, WS_WATT = 16 * MiB, WS_WRET = 18 * MiB, WS_WOUT = 20 * MiB, WS_W1 = 22 * MiB, WS_WD = 38 * MiB, WS_ACT = 46 * MiB;
constexpr size_t O_QA = 0, O_CKV = 2048, O_QI = 2560, O_KW = 3584, O_RQ = 3840, O_RK = 4864, O_RV = 5888, O_RG = 7936, O_GA = 9984, O_GR = 12032, O_END = 14080;

constexpr int MP_ROWS = 38912;
constexpr size_t MO_APERM = 0, MO_ACT = 80 * MiB, MO_N2 = 120 * MiB, MO_META = 184 * MiB;
constexpr size_t MM_B = 0, MM_P = 131072, MM_CL = 262144, MM_CH = 393216, MM_RS = 524288, MM_PTOK = 655360, MM_PRS = 819200, MM_PCL = 983040, MM_PCH = 1146880, MM_END = 1310720;
constexpr size_t WS_WR = 15 * MiB + 512 * 1024;
constexpr size_t MO_H16 = 192 * MiB;
constexpr int CW_MOE = 256;
constexpr int RING_OFF = 0, RING_BYTES = 131072, P3_HIST_OFF = 131072, P3_TOT_OFF = 147456, P3_T_OFF = 149504, LDSCTL_OFF = 151552, MISC_OFF = LDSCTL_OFF + 320, LDS_BYTES = 152576;
constexpr int CW_Q3 = 64, CW_Q4 = 128;

#define GAS __attribute__((address_space(1)))
#define LAS __attribute__((address_space(3)))
typedef unsigned short bf16;
typedef unsigned v4u __attribute__((ext_vector_type(4)));
typedef float f32x4 __attribute__((ext_vector_type(4)));
#define LDS_WAIT() asm volatile("s_waitcnt lgkmcnt(0)" ::: "memory")
#define VM_WAIT() asm volatile("s_waitcnt vmcnt(0)" ::: "memory")
__device__ __forceinline__ unsigned f2bf(float f) { unsigned u = __builtin_bit_cast(unsigned, f); return (u + 0x7fffu + ((u >> 16) & 1u)) >> 16; }
__device__ __forceinline__ unsigned pk2(float lo, float hi) { return f2bf(lo) | (f2bf(hi) << 16); }
__device__ __forceinline__ float bf2f(bf16 b) { return __uint_as_float((unsigned)b << 16); }


typedef GAS unsigned gu32;
constexpr int CW_BAR = 4096;
#define XB_TMO      128
#define XB_XCNT(j)  (256  + 64 * (j))
#define XB_XSUB(j)  (1280 + 64 * (j))
#define XB_XGEN(j)  (2304 + 64 * (j))
#define XB_TOP      3328
#define XB_TOPGEN   3392
#define XCD_BAR_WORDS 3456
#define XB_SPIN_CAP (1u << 18)

__device__ __forceinline__ unsigned xb_ld(unsigned* p)              { return __hip_atomic_load(p, __ATOMIC_RELAXED, __HIP_MEMORY_SCOPE_AGENT); }
__device__ __forceinline__ unsigned xb_add(unsigned* p, unsigned v) { return __hip_atomic_fetch_add(p, v, __ATOMIC_RELAXED, __HIP_MEMORY_SCOPE_AGENT); }
__device__ __forceinline__ unsigned xb_xcc_id() { return (unsigned)__builtin_amdgcn_s_getreg((3 << 11) | 20) & 0xFu; }
#define XB_SPIN(cond, bar) do { unsigned _sp = 0; while (cond) { __builtin_amdgcn_s_sleep(1); \
    if ((++_sp & 255u) == 0u) { if (xb_ld(&(bar)[XB_TMO])) break; if (_sp > XB_SPIN_CAP) { atomicAdd(&(bar)[XB_TMO], 1u); break; } } } } while (0)

struct XcdBarrier {
    unsigned* bar; unsigned x;
    volatile LAS unsigned* st;
};

__device__ __forceinline__ XcdBarrier xcd_barrier_post(unsigned* bar, volatile LAS unsigned* st) {
    XcdBarrier b; b.bar = bar; b.x = xb_xcc_id(); b.st = st;
    if (threadIdx.x == 0) (void)xb_add(&bar[XB_XCNT(b.x)], 1u);
    return b;
}
__device__ __forceinline__ void xcd_barrier_complete(unsigned* bar, unsigned x, unsigned& nloc, unsigned& nx) {
    const unsigned G = gridDim.x * gridDim.y * gridDim.z;
    unsigned sum, cnt, mine, sp = 0u;
    for (;;) {
        sum = 0u; cnt = 0u; mine = 0u;
#pragma unroll
        for (unsigned j = 0; j < 16; ++j) { const unsigned c = xb_ld(&bar[XB_XCNT(j)]); sum += c; cnt += (c > 0u) ? 1u : 0u; mine = (j == x) ? c : mine; }
        if (sum == G) break;
        __builtin_amdgcn_s_sleep(1);
        if ((++sp & 255u) == 0u) { if (xb_ld(&bar[XB_TMO])) break; if (sp > XB_SPIN_CAP) { atomicAdd(&bar[XB_TMO], 1u); break; } }
    }
    nloc = mine > 0u ? mine : 1u; nx = cnt > 0u ? cnt : 1u;
}

__device__ __forceinline__ void xcd_barrier(const XcdBarrier& b) {
    asm volatile("s_waitcnt vmcnt(0)" ::: "memory");
    __syncthreads();
    if (threadIdx.x == 0) {
        unsigned* bar = b.bar;
        __builtin_amdgcn_s_waitcnt(0);
        unsigned nloc = b.st[0], nx = b.st[1];
        if (nloc == 0u) { xcd_barrier_complete(bar, b.x, nloc, nx); b.st[0] = nloc; b.st[1] = nx; }
        const unsigned old = xb_add(&bar[XB_XSUB(b.x)], 1u);
        const unsigned gen = old / nloc;
        if (old + 1u == (gen + 1u) * nloc) {
            __builtin_amdgcn_fence(__ATOMIC_RELEASE, "agent");
            asm volatile("s_waitcnt vmcnt(0)" ::: "memory");
            const unsigned og = xb_add(&bar[XB_TOP], 1u);
            const unsigned tg = og / nx;
            if (og + 1u == (tg + 1u) * nx) xb_add(&bar[XB_TOPGEN], 1u);
            else XB_SPIN(xb_ld(&bar[XB_TOPGEN]) == tg, bar);
            __builtin_amdgcn_fence(__ATOMIC_ACQUIRE, "agent");
            xb_add(&bar[XB_XGEN(b.x)], 1u);
            asm volatile("s_waitcnt vmcnt(0)" ::: "memory");
        } else {
            XB_SPIN(xb_ld(&bar[XB_XGEN(b.x)]) == gen, bar);
            __builtin_amdgcn_fence(__ATOMIC_ACQUIRE, "agent");
            asm volatile("s_waitcnt vmcnt(0)" ::: "memory");
        }
    }
    __syncthreads();
}

struct Args { const float* in[20]; float* out; unsigned char* ws; unsigned char* xb; int ph_lo, ph_hi, ntok, tok0, mode, pad; };

struct Frame {
    LAS unsigned char* lds;
    int tid, lane, wave, vcu, G;
    int ntok;
    unsigned char* ws; unsigned char* act;
};

struct EpiProj {
    static constexpr bool PERM = true, AFTER_DRAIN = false;
    unsigned char* act; size_t ntok;
    __device__ __forceinline__ void operator()(const pg8::f32x4 (&acc)[2][2][4][2], const pg8::Unit& u, int wr, int wc, int fr, int fq) const {
        const int pn = u.pn; size_t O; int ld, cb, nbj = 2;
        if (pn < 4) { O = O_QA; ld = 1024; cb = pn * 256; }
        else if (pn == 4) { O = O_CKV; ld = 256; cb = 0; }
        else if (pn < 7) { O = O_QI; ld = 512; cb = (pn - 5) * 256; }
        else if (pn == 7) { O = O_KW; ld = 128; cb = 0; nbj = 1; }
        else if (pn < 10) { O = O_RQ; ld = 512; cb = (pn - 8) * 256; }
        else if (pn < 12) { O = O_RK; ld = 512; cb = (pn - 10) * 256; }
        else { O = O_RV + (size_t)((pn - 12) >> 2) * 2048; ld = 1024; cb = ((pn - 12) & 3) * 256; }
        pg8::bf16_t* base = (pg8::bf16_t*)(act + ntok * O);
        const int row0 = u.pm * pg8::BM + wr * 64 + fr, col0 = cb + wc * 32 + 8 * fq;
#pragma unroll
        for (int ai = 0; ai < 2; ++ai)
#pragma unroll
            for (int m = 0; m < 4; ++m) { pg8::bf16_t* rowp = base + (size_t)(row0 + ai * pg8::HALF + m * 16) * ld + col0;
#pragma unroll
                for (int bj = 0; bj < 2; ++bj) if (bj < nbj) { const pg8::f32x4 v0 = acc[ai][bj][m][0], v1 = acc[ai][bj][m][1];
                    pg8::u32x4 w; w.x = pg8::cvt_pk_bf16(v0[0], v0[1]); w.y = pg8::cvt_pk_bf16(v0[2], v0[3]); w.z = pg8::cvt_pk_bf16(v1[0], v1[1]); w.w = pg8::cvt_pk_bf16(v1[2], v1[3]);
                    *(pg8::u32x4*)(rowp + bj * pg8::HALF) = w; } }
    }
};


__device__ __forceinline__ float sigm(float x) { return __builtin_amdgcn_rcpf(1.f + __builtin_amdgcn_exp2f(-1.4426950408889634f * x)); }
struct EpiGateA {
    static constexpr bool PERM = true, AFTER_DRAIN = false;
    pg8::bf16_t* GA;
    __device__ __forceinline__ void operator()(const pg8::f32x4 (&acc)[2][2][4][2], const pg8::Unit& u, int wr, int wc, int fr, int fq) const {
        const int row0 = u.pm * pg8::BM + wr * 64 + fr, col0 = u.pn * pg8::BM + wc * 32 + 8 * fq;
#pragma unroll
        for (int ai = 0; ai < 2; ++ai)
#pragma unroll
            for (int m = 0; m < 4; ++m) { pg8::bf16_t* rowp = GA + (size_t)(row0 + ai * pg8::HALF + m * 16) * 1024 + col0;
#pragma unroll
                for (int bj = 0; bj < 2; ++bj) { const pg8::u32x4 g = *(const pg8::u32x4*)(rowp + bj * pg8::HALF); const pg8::f32x4 v0 = acc[ai][bj][m][0], v1 = acc[ai][bj][m][1];
                    pg8::u32x4 w; w.x = pg8::cvt_pk_bf16(sigm(pg8::bf_lo(g.x)) * v0[0], sigm(pg8::bf_hi(g.x)) * v0[1]); w.y = pg8::cvt_pk_bf16(sigm(pg8::bf_lo(g.y)) * v0[2], sigm(pg8::bf_hi(g.y)) * v0[3]);
                    w.z = pg8::cvt_pk_bf16(sigm(pg8::bf_lo(g.z)) * v1[0], sigm(pg8::bf_hi(g.z)) * v1[1]); w.w = pg8::cvt_pk_bf16(sigm(pg8::bf_lo(g.w)) * v1[2], sigm(pg8::bf_hi(g.w)) * v1[3]);
                    *(pg8::u32x4*)(rowp + bj * pg8::HALF) = w; } }
    }
};
struct EpiGateB {
    static constexpr bool PERM = true, AFTER_DRAIN = false;
    pg8::bf16_t* GA; const pg8::bf16_t* GR;
    __device__ __forceinline__ void operator()(const pg8::f32x4 (&acc)[2][2][4][2], const pg8::Unit& u, int wr, int wc, int fr, int fq) const {
        const int row0 = u.pm * pg8::BM + wr * 64 + fr, col0 = u.pn * pg8::BM + wc * 32 + 8 * fq;
#pragma unroll
        for (int ai = 0; ai < 2; ++ai)
#pragma unroll
            for (int m = 0; m < 4; ++m) { const size_t ro = (size_t)(row0 + ai * pg8::HALF + m * 16) * 1024 + col0;
#pragma unroll
                for (int bj = 0; bj < 2; ++bj) { const pg8::u32x4 t = *(const pg8::u32x4*)(GA + ro + bj * pg8::HALF), g = *(const pg8::u32x4*)(GR + ro + bj * pg8::HALF); const pg8::f32x4 v0 = acc[ai][bj][m][0], v1 = acc[ai][bj][m][1];
                    pg8::u32x4 w; w.x = pg8::cvt_pk_bf16(pg8::bf_lo(t.x) + sigm(pg8::bf_lo(g.x)) * v0[0], pg8::bf_hi(t.x) + sigm(pg8::bf_hi(g.x)) * v0[1]); w.y = pg8::cvt_pk_bf16(pg8::bf_lo(t.y) + sigm(pg8::bf_lo(g.y)) * v0[2], pg8::bf_hi(t.y) + sigm(pg8::bf_hi(g.y)) * v0[3]);
                    w.z = pg8::cvt_pk_bf16(pg8::bf_lo(t.z) + sigm(pg8::bf_lo(g.z)) * v1[0], pg8::bf_hi(t.z) + sigm(pg8::bf_hi(g.z)) * v1[1]); w.w = pg8::cvt_pk_bf16(pg8::bf_lo(t.w) + sigm(pg8::bf_lo(g.w)) * v1[2], pg8::bf_hi(t.w) + sigm(pg8::bf_hi(g.w)) * v1[3]);
                    *(pg8::u32x4*)(GA + ro + bj * pg8::HALF) = w; } }
    }
};
struct EpiResid {
    static constexpr bool PERM = true, AFTER_DRAIN = false;
    const float* x; pg8::bf16_t* h16;
    __device__ __forceinline__ void operator()(const pg8::f32x4 (&acc)[2][2][4][2], const pg8::Unit& u, int wr, int wc, int fr, int fq) const {
        const int row0 = u.pm * pg8::BM + wr * 64 + fr, col0 = u.pn * pg8::BM + wc * 32 + 8 * fq;
#pragma unroll
        for (int ai = 0; ai < 2; ++ai)
#pragma unroll
            for (int m = 0; m < 4; ++m) { const size_t ro = (size_t)(row0 + ai * pg8::HALF + m * 16) * 1024 + col0;
#pragma unroll
                for (int bj = 0; bj < 2; ++bj) { const pg8::f32x4 x0 = *(const pg8::f32x4*)(x + ro + bj * pg8::HALF), x1 = *(const pg8::f32x4*)(x + ro + bj * pg8::HALF + 4); const pg8::f32x4 v0 = acc[ai][bj][m][0] + x0, v1 = acc[ai][bj][m][1] + x1;
                    pg8::u32x4 w; w.x = pg8::cvt_pk_bf16(v0[0], v0[1]); w.y = pg8::cvt_pk_bf16(v0[2], v0[3]); w.z = pg8::cvt_pk_bf16(v1[0], v1[1]); w.w = pg8::cvt_pk_bf16(v1[2], v1[3]);
                    *(pg8::u32x4*)(h16 + ro + bj * pg8::HALF) = w; } }
    }
};

__device__ __forceinline__ float wave_sum(float v) {
#pragma unroll
    for (int o = 1; o < 64; o <<= 1) v += __shfl_xor(v, o);
    return v;
}
__device__ __forceinline__ void p0_transpose_item(const float* W, int K, int N, bf16* WT, int map, int row_off, int par, const float* gk, LAS float* scr, int item, int lane) {
    const int nblk = (N + 31) / 32, kb = item / nblk, nb = item % nblk, k0 = 64 * kb, n0 = 32 * nb;
    const int nn = n0 + (lane & 31);
#pragma unroll 8
    for (int i = 0; i < 32; ++i) { const int kk = 2 * i + (lane >> 5); float v = (nn < N) ? W[(size_t)(k0 + kk) * N + nn] : 0.f; if (gk) v *= gk[k0 + kk]; scr[kk * 33 + (lane & 31)] = v; }
    LDS_WAIT(); asm volatile("" ::: "memory");
    const int c = lane & 7;
#pragma unroll
    for (int j = 0; j < 4; ++j) { const int nl = (lane >> 3) + 8 * j, n = n0 + nl; const LAS float* s = scr + (8 * c) * 33 + nl;
        v4u o; o.x = pk2(s[0 * 33], s[1 * 33]); o.y = pk2(s[2 * 33], s[3 * 33]); o.z = pk2(s[4 * 33], s[5 * 33]); o.w = pk2(s[6 * 33], s[7 * 33]);
        if (n < N) { const int row = (map == 0) ? row_off + n : (map == 1) ? (n < 1864 ? n : n + 184) : row_off + 2 * n + par;
            *(GAS v4u*)(WT + (size_t)row * K + k0 + 8 * c) = o; } }
    LDS_WAIT(); asm volatile("" ::: "memory");
}
__device__ __forceinline__ void p0_prologue(Frame& F, const Args& a) {
    LAS float* scr = (LAS float*)(F.lds + RING_OFF + F.wave * 16384);
    const int gw = F.vcu * NWAVES + F.wave, NGW = F.G * NWAVES;
    bf16* Win_t = (bf16*)(F.ws + WS_WIN); bf16* Wkv_t = (bf16*)(F.ws + WS_WKV); bf16* Watt_t = (bf16*)(F.ws + WS_WATT); bf16* Wret_t = (bf16*)(F.ws + WS_WRET);
    bf16* Wout_t = (bf16*)(F.ws + WS_WOUT); bf16* W1_t = (bf16*)(F.ws + WS_W1); bf16* Wd_t = (bf16*)(F.ws + WS_WD);
    constexpr int I_IN = 16 * 219, I_KV = 4 * 8, I_SQ = 16 * 32, I_GU = 16 * 8  , I_DN = 4 * 32  ;
    constexpr int NITEMS = I_IN + I_KV + 3 * I_SQ + 16 * (2 * I_GU + I_DN);
    for (int it = gw; it < NITEMS; it += NGW) {
        int r = it;
        if (r < I_IN) { p0_transpose_item(a.in[2], 1024, INW, Win_t, 1, 0, 0, a.in[1], scr, r, F.lane); continue; } r -= I_IN;
        if (r < I_KV) { p0_transpose_item(a.in[4], 256, 256, Wkv_t, 0, 0, 0, a.in[3], scr, r, F.lane); continue; } r -= I_KV;
        if (r < I_SQ) { p0_transpose_item(a.in[9], 1024, 1024, Watt_t, 0, 0, 0, nullptr, scr, r, F.lane); continue; } r -= I_SQ;
        if (r < I_SQ) { p0_transpose_item(a.in[10], 1024, 1024, Wret_t, 0, 0, 0, nullptr, scr, r, F.lane); continue; } r -= I_SQ;
        if (r < I_SQ) { p0_transpose_item(a.in[11], 1024, 1024, Wout_t, 0, 0, 0, nullptr, scr, r, F.lane); continue; } r -= I_SQ;
        const int e = r / (2 * I_GU + I_DN), q = r % (2 * I_GU + I_DN);
        if (q < I_GU) p0_transpose_item(a.in[17] + (size_t)e * 1024 * 256, 1024, 256, W1_t, 2, e * 512, 0, nullptr, scr, q, F.lane);
        else if (q < 2 * I_GU) p0_transpose_item(a.in[18] + (size_t)e * 1024 * 256, 1024, 256, W1_t, 2, e * 512, 1, nullptr, scr, q - I_GU, F.lane);
        else p0_transpose_item(a.in[19] + (size_t)e * 256 * 1024, 256, 1024, Wd_t + (size_t)e * 1024 * 256, 0, 0, 0, nullptr, scr, q - 2 * I_GU, F.lane);
    }
    { const int gt = (F.vcu * NWAVES + F.wave) * 64 + F.lane, NGT = F.G * NWAVES * 64; GAS v4u* z = (GAS v4u*)(Win_t + (size_t)1864 * 1024);
      for (int i = gt; i < 184 * 1024 * 2 / 16; i += NGT) z[i] = (v4u){0u, 0u, 0u, 0u}; }
    { const int gt = (F.vcu * NWAVES + F.wave) * 64 + F.lane, NGT = F.G * NWAVES * 64; bf16* Wh = (bf16*)(F.ws + WS_WR); bf16* Wl = Wh + 32 * 1024;
      for (int i = gt; i < 32 * 1024; i += NGT) { const int n = i >> 10, k = i & 1023; const float wv = n < 4 ? a.in[13][k * 4 + n] : (n < 20 ? a.in[15][k * 16 + (n - 4)] : 0.f);
        const unsigned hb = f2bf(wv); const float hf = __uint_as_float(hb << 16); Wh[i] = (bf16)hb; Wl[i] = (bf16)f2bf(wv - hf); } }
    const float* x = a.in[0] + (size_t)a.tok0 * D;
    for (int m = gw; m < F.ntok; m += NGW) {
        const GAS f32x4* xr = (const GAS f32x4*)(x + (size_t)m * D) + F.lane;
        f32x4 v[4]; float s = 0.f;
#pragma unroll
        for (int j = 0; j < 4; ++j) { v[j] = xr[64 * j]; s += (v[j].x * v[j].x + v[j].y * v[j].y) + (v[j].z * v[j].z + v[j].w * v[j].w); }
        const float rstd = 1.f / sqrtf(wave_sum(s) * (1.f / D) + EPS);
        GAS unsigned long long* o8 = (GAS unsigned long long*)(a.xb + (size_t)m * D * 2) + F.lane;
#pragma unroll
        for (int j = 0; j < 4; ++j) o8[64 * j] = (unsigned long long)pk2(v[j].x * rstd, v[j].y * rstd) | ((unsigned long long)pk2(v[j].z * rstd, v[j].w * rstd) << 32);
    }
}


constexpr size_t AUX_KP = 0, AUX_VV = 256, AUX_KIN = 512, AUX_MASK = 640, AUX_END = 896;
typedef short bf16x8_t __attribute__((ext_vector_type(8)));
typedef float f32x16 __attribute__((ext_vector_type(16)));
__device__ __forceinline__ int crow(int r, int hi) { return (r & 3) + 8 * (r >> 2) + 4 * hi; }
__device__ __forceinline__ float xhalf_sum(float v) { auto rr = __builtin_amdgcn_permlane32_swap(__float_as_uint(v), __float_as_uint(v), false, false); return __uint_as_float(rr[0]) + __uint_as_float(rr[1]); }
__device__ __forceinline__ float sumsq8(bf16x8_t v) { float s = 0.f;
#pragma unroll
    for (int j = 0; j < 8; ++j) { const float f = __uint_as_float((unsigned)(unsigned short)v[j] << 16); s += f * f; } return s; }
__device__ __forceinline__ void p2_post(Frame& F, const Args& a) {
    const int gw = F.vcu * NWAVES + F.wave, NGW = F.G * NWAVES, lane = F.lane, r32 = lane & 31, hi = lane >> 5;
    const size_t nt_ = (size_t)F.ntok;
    const bf16* CKV = (const bf16*)(F.act + nt_ * O_CKV); const bf16* KW = (const bf16*)(F.act + nt_ * O_KW);
    const bf16* Wkv_t = (const bf16*)(F.ws + WS_WKV);
    unsigned char* aux = a.xb + nt_ * 2048;
    bf16* KP = (bf16*)(aux + nt_ * AUX_KP); bf16* VV = (bf16*)(aux + nt_ * AUX_VV); bf16* KIN = (bf16*)(aux + nt_ * AUX_KIN);
    const float* g_q = a.in[5]; const float* g_k = a.in[6]; const float* g_ki = a.in[7];
    const int ntask = 2 * (F.ntok / 32);
    for (int task = gw; task < ntask; task += NGW) {
        const int kind = task & 1, t0 = (task >> 1) * 32;
        const bf16* crowp = CKV + (size_t)(t0 + r32) * 256 + hi * 8;
        bf16x8_t bfr[16]; float ss = 0.f;
#pragma unroll
        for (int kk = 0; kk < 16; ++kk) { bfr[kk] = *(const bf16x8_t*)(crowp + kk * 16); ss += sumsq8(bfr[kk]); }
        ss = xhalf_sum(ss);
        const float rstd = rsqrtf(ss * (1.f / 256.f) + EPS);
        f32x16 acc[4];
#pragma unroll
        for (int nt = 0; nt < 4; ++nt) { acc[nt] = f32x16{};
            const bf16* wrow = Wkv_t + (size_t)(kind * 128 + nt * 32 + r32) * 256 + hi * 8;
#pragma unroll
            for (int kk = 0; kk < 16; ++kk) { const bf16x8_t af = *(const bf16x8_t*)(wrow + kk * 16); acc[nt] = __builtin_amdgcn_mfma_f32_32x32x16_bf16(af, bfr[kk], acc[nt], 0, 0, 0); } }
        float sc = rstd;
        if (kind == 0) { float sk = 0.f;
#pragma unroll
            for (int nt = 0; nt < 4; ++nt)
#pragma unroll
                for (int r = 0; r < 16; ++r) { const float v = acc[nt][r] * rstd; sk += v * v; }
            sk = xhalf_sum(sk);
            sc = rstd * rsqrtf(sk * (1.f / 128.f) + EPS) * (0.08838834764831845f * 1.4426950408889634f); }
        bf16* orow = (kind == 0 ? KP : VV) + (size_t)(t0 + r32) * 128;
#pragma unroll
        for (int nt = 0; nt < 4; ++nt)
#pragma unroll
            for (int g = 0; g < 4; ++g) { const int ch = nt * 32 + 8 * g + 4 * hi; float v[4];
#pragma unroll
                for (int j = 0; j < 4; ++j) { v[j] = acc[nt][4 * g + j] * sc; if (kind == 0) v[j] *= g_k[ch + j] * g_q[ch + j]; }
                *(unsigned long long*)(orow + ch) = (unsigned long long)pk2(v[0], v[1]) | ((unsigned long long)pk2(v[2], v[3]) << 32); }
        if (kind == 0) {
            const bf16* kr = KW + (size_t)(t0 + r32) * 128 + hi * 32; bf16x8_t kv4[4]; float s2 = 0.f;
#pragma unroll
            for (int j = 0; j < 4; ++j) { kv4[j] = *(const bf16x8_t*)(kr + 8 * j); s2 += sumsq8(kv4[j]); }
            s2 = xhalf_sum(s2);
            const float rk = rsqrtf(s2 * (1.f / 64.f) + EPS);
            bf16* ko = KIN + (size_t)(t0 + r32) * 64 + hi * 32;
#pragma unroll
            for (int j = 0; j < 4; ++j) { float f[8];
#pragma unroll
                for (int e = 0; e < 8; ++e) f[e] = __uint_as_float((unsigned)(unsigned short)kv4[j][e] << 16) * rk * g_ki[hi * 32 + 8 * j + e];
                v4u o; o.x = pk2(f[0], f[1]); o.y = pk2(f[2], f[3]); o.z = pk2(f[4], f[5]); o.w = pk2(f[6], f[7]);
                *(v4u*)(ko + 8 * j) = o; }
        }
    }
}


typedef float f32x4_t __attribute__((ext_vector_type(4)));
__device__ __forceinline__ unsigned key15_of(float s) { const unsigned short hb = __builtin_bit_cast(unsigned short, (_Float16)s); const unsigned u = (hb & 0x8000u) ? (~(unsigned)hb & 0xffffu) : ((unsigned)hb | 0x8000u); return u >> 1; }
__device__ __forceinline__ unsigned sad4(unsigned x) { return __builtin_amdgcn_sad_u8(x, 0u, 0u); }
__device__ __forceinline__ void p3_merge(LAS unsigned* hist, LAS unsigned short* tot, int w, int g, int q, int& need, int& bsel) {
    __syncthreads();
    const int o = 4 * w + g; unsigned c = 0;
#pragma unroll
    for (int p = 0; p < 32; ++p) { const int tidp = (p >> 2) * 64 + (p & 3) * 16 + q; c += (hist[(o >> 2) * 512 + tidp] >> (8 * (o & 3))) & 0xffu; }
    tot[q * 32 + o] = (unsigned short)c;
    __syncthreads();
    v4u tv[4];
#pragma unroll
    for (int j = 0; j < 4; ++j) tv[j] = *(const LAS v4u*)((const LAS unsigned char*)tot + q * 64 + j * 16);
    int cum = 0, bs = 0, ab = 0; bool found = false;
#pragma unroll
    for (int bin = 31; bin >= 0; --bin) { const unsigned wd = tv[bin >> 3][(bin >> 1) & 3]; const int cc = (int)((bin & 1) ? (wd >> 16) : (wd & 0xffffu));
        if (!found && cum + cc >= need) { bs = bin; ab = cum; found = true; } cum += cc; }
    bsel = bs; need -= ab;
}
__device__ __forceinline__ void p3_index(Frame& F, const Args& a) {
    const int tid = F.tid, lane = F.lane, w = F.wave, q = lane & 15, g = lane >> 4;
    LAS unsigned* keys = (LAS unsigned*)(F.lds + RING_OFF);
    LAS unsigned char* qbuf = F.lds + 65536;
    LAS unsigned* hist = (LAS unsigned*)(F.lds + P3_HIST_OFF);
    LAS unsigned short* tot = (LAS unsigned short*)(F.lds + P3_TOT_OFF);
    LAS unsigned char* Tt = (LAS unsigned char*)(F.lds + P3_T_OFF);
    const size_t nt_ = (size_t)F.ntok;
    const bf16* QI = (const bf16*)(F.act + nt_ * O_QI); const bf16* KW = (const bf16*)(F.act + nt_ * O_KW);
    unsigned char* aux = a.xb + nt_ * 2048;
    const bf16* KIN = (const bf16*)(aux + nt_ * AUX_KIN); unsigned* MASK = (unsigned*)(aux + nt_ * AUX_MASK);
    const int nb = F.ntok / SEQ, nitems = nb * 128, G = F.G, c = (int)blockIdx.x;
#define P3_ITEM(k) ((k) * G + (((k) & 1) ? (G - 1 - c) : c))
#define P3_QDMA(it_, buf_) do { const int qg_ = 127 - (it_) / nb, b_ = (it_) % nb; _Pragma("unroll") for (int i_ = 0; i_ < 2; ++i_) { const int row_ = w * 2 + i_; \
        const char* src_ = (const char*)(QI + ((size_t)b_ * SEQ + qg_ * 16 + row_) * 512) + ((lane ^ (row_ & 15)) * 16); \
        __builtin_amdgcn_global_load_lds((const unsigned*)src_, (LAS unsigned*)(qbuf + (buf_) * 16384 + row_ * 1024), 16, 0, 0); } } while (0)
    const int nround = (nitems + G - 1) / G;
    if (P3_ITEM(0) < nitems) P3_QDMA(P3_ITEM(0), 0);
    v4u wvn = (v4u){0u, 0u, 0u, 0u};
    if (P3_ITEM(0) < nitems) { const int it0 = P3_ITEM(0); wvn = *(const v4u*)(KW + ((size_t)(it0 % nb) * SEQ + (127 - it0 / nb) * 16 + q) * 128 + 64); }
    for (int k = 0; k < nround; ++k) {
        const int it = P3_ITEM(k); if (it >= nitems) break;
        const int qg = 127 - it / nb, b = it % nb, q0 = qg * 16, qme = q0 + q;
        unsigned* Mb = MASK + (size_t)b * 64 * 2048;
        const int kb_hi = ((qg >> 3) + 1) << 2, nkb = (qg >> 1) + 1;
        asm volatile("s_waitcnt vmcnt(0) lgkmcnt(0)\n\ts_barrier" ::: "memory");
        const v4u wv = wvn;
        { const int itn = P3_ITEM(k + 1); if (k + 1 < nround && itn < nitems) { P3_QDMA(itn, (k + 1) & 1); wvn = *(const v4u*)(KW + ((size_t)(itn % nb) * SEQ + (127 - itn / nb) * 16 + q) * 128 + 64); } }
        if (qg < 16) {
            if (tid < kb_hi * 16) { const int kb = tid >> 4, qq = q0 + (tid & 15), nbits = qq - kb * 32 + 1; Mb[kb * 2048 + qq] = nbits >= 32 ? 0xffffffffu : (nbits <= 0 ? 0u : ((1u << nbits) - 1u)); }
            continue;
        }
        float wq[8];
        { const float cc = 0.35355339059327373f * 0.125f;
          wq[0] = pg8::bf_lo(wv.x) * cc; wq[1] = pg8::bf_hi(wv.x) * cc; wq[2] = pg8::bf_lo(wv.y) * cc; wq[3] = pg8::bf_hi(wv.y) * cc; wq[4] = pg8::bf_lo(wv.z) * cc; wq[5] = pg8::bf_hi(wv.z) * cc; wq[6] = pg8::bf_lo(wv.w) * cc; wq[7] = pg8::bf_hi(wv.w) * cc; }
        bf16x8_t qfr[8][2], qlin[2];
        { const LAS unsigned char* qrow = qbuf + (k & 1) * 16384 + q * 1024;
#pragma unroll
          for (int h = 0; h < 8; ++h)
#pragma unroll
            for (int ks = 0; ks < 2; ++ks) qfr[h][ks] = *(const LAS bf16x8_t*)(qrow + (((h * 8 + ks * 4 + g) ^ q) * 16)); }
#pragma unroll
        for (int ks = 0; ks < 2; ++ks) { float f[8];
#pragma unroll
            for (int j = 0; j < 8; ++j) { float s = 0.f;
#pragma unroll
                for (int h = 0; h < 8; ++h) s += wq[h] * __uint_as_float((unsigned)(unsigned short)qfr[h][ks][j] << 16);
                f[j] = s; }
            v4u o; o.x = pk2(f[0], f[1]); o.y = pk2(f[2], f[3]); o.z = pk2(f[4], f[5]); o.w = pk2(f[6], f[7]); qlin[ks] = __builtin_bit_cast(bf16x8_t, o); }
#pragma unroll
        for (int i = 0; i < 8; ++i) hist[i * 512 + tid] = 0u;
        const bf16* kbase = KIN + ((size_t)b * SEQ + q) * 64 + g * 8;
        bf16x8_t afr[2][2], afn[2][2];
#pragma unroll
        for (int t = 0; t < 2; ++t)
#pragma unroll
            for (int ks = 0; ks < 2; ++ks) afn[t][ks] = *(const bf16x8_t*)(kbase + (size_t)(w * 32 + t * 16) * 64 + ks * 32);
        for (int s = 0, kb = w; kb < nkb; ++s, kb += 8) {
#pragma unroll
            for (int t = 0; t < 2; ++t)
#pragma unroll
                for (int ks = 0; ks < 2; ++ks) afr[t][ks] = afn[t][ks];
            if (kb + 8 < nkb) {
#pragma unroll
                for (int t = 0; t < 2; ++t)
#pragma unroll
                    for (int ks = 0; ks < 2; ++ks) afn[t][ks] = *(const bf16x8_t*)(kbase + (size_t)((kb + 8) * 32 + t * 16) * 64 + ks * 32); }
#pragma unroll
            for (int t = 0; t < 2; ++t) {
                f32x4_t sacc = f32x4_t{};
#pragma unroll
                for (int ks = 0; ks < 2; ++ks) sacc = __builtin_amdgcn_mfma_f32_16x16x32_bf16(afr[t][ks], qlin[ks], sacc, 0, 0, 0);
#pragma unroll
                for (int h = 0; h < 8; ++h) { f32x4_t d = f32x4_t{};
#pragma unroll
                    for (int ks = 0; ks < 2; ++ks) d = __builtin_amdgcn_mfma_f32_16x16x32_bf16(afr[t][ks], qfr[h][ks], d, 0, 0, 0);
#pragma unroll
                    for (int r = 0; r < 4; ++r) sacc[r] = fmaf(fabsf(d[r]), wq[h], sacc[r]); }
#pragma unroll
                for (int i = 0; i < 2; ++i) { unsigned k2[2];
#pragma unroll
                    for (int e = 0; e < 2; ++e) { const int r = 2 * i + e; unsigned kk_ = key15_of(sacc[r]); if (kb * 32 + t * 16 + 4 * g + r > qme) kk_ = 0u; k2[e] = kk_;
                        const unsigned dg = kk_ >> 10; (void)__hip_atomic_fetch_add((LAS unsigned*)&hist[(dg >> 2) * 512 + tid], 1u << ((dg & 3u) * 8u), __ATOMIC_RELAXED, __HIP_MEMORY_SCOPE_WORKGROUP); }
                    keys[(s * 4 + t * 2 + i) * 512 + tid] = k2[0] | (k2[1] << 16); }
            }
        }
        int need = 256, bsel;
        p3_merge(hist, tot, w, g, q, need, bsel);
        unsigned prefix = (unsigned)bsel;
#pragma unroll
        for (int pass = 0; pass < 2; ++pass) {
            const int sh_hi = pass == 0 ? 10 : 5, sh = pass == 0 ? 5 : 0;
#pragma unroll
            for (int i = 0; i < 8; ++i) hist[i * 512 + tid] = 0u;
#pragma unroll
            for (int s = 0; s < 8; ++s) if (w + 8 * s < nkb) {
#pragma unroll
                for (int i = 0; i < 4; ++i) { const unsigned d2 = keys[(s * 4 + i) * 512 + tid];
#pragma unroll
                    for (int e = 0; e < 2; ++e) { const unsigned kk_ = e ? (d2 >> 16) : (d2 & 0xffffu);
                        if ((kk_ >> sh_hi) == prefix) { const unsigned dg = (kk_ >> sh) & 31u; (void)__hip_atomic_fetch_add((LAS unsigned*)&hist[(dg >> 2) * 512 + tid], 1u << ((dg & 3u) * 8u), __ATOMIC_RELAXED, __HIP_MEMORY_SCOPE_WORKGROUP); } } } }
            p3_merge(hist, tot, w, g, q, need, bsel);
            prefix = (prefix << 5) | (unsigned)bsel;
        }
        const unsigned tau = prefix; const int need_eq = need;
        unsigned gtw[8], eqw[8];
#pragma unroll
        for (int s = 0; s < 8; ++s) { const int kb = w + 8 * s; gtw[s] = 0u; eqw[s] = 0u;
            if (kb < nkb) { unsigned gg = 0u, qq = 0u;
#pragma unroll
                for (int i = 0; i < 4; ++i) { const unsigned d2 = keys[(s * 4 + i) * 512 + tid];
#pragma unroll
                    for (int e = 0; e < 2; ++e) { const unsigned kk_ = e ? (d2 >> 16) : (d2 & 0xffffu); const int bit = (i >> 1) * 16 + 4 * g + (i & 1) * 2 + e;
                        gg |= (kk_ > tau ? 1u : 0u) << bit; qq |= (kk_ == tau ? 1u : 0u) << bit; } }
                gg |= (unsigned)__shfl_xor((int)gg, 16); gg |= (unsigned)__shfl_xor((int)gg, 32); qq |= (unsigned)__shfl_xor((int)qq, 16); qq |= (unsigned)__shfl_xor((int)qq, 32);
                gtw[s] = gg; eqw[s] = qq;
                if (g == 0) Tt[q * 64 + kb] = (unsigned char)__builtin_popcount(qq); } }
        __syncthreads();
        { unsigned run = 0u;
#pragma unroll
          for (int s = 0; s < 8; ++s) { const int kb = w + 8 * s;
            if (kb < nkb) { const unsigned g0 = *(const LAS unsigned*)(Tt + q * 64 + 8 * s), g1 = *(const LAS unsigned*)(Tt + q * 64 + 8 * s + 4);
                const unsigned m0 = w >= 4 ? g0 : (w == 0 ? 0u : (g0 & ((1u << (8 * w)) - 1u))), m1 = w > 4 ? (g1 & ((1u << (8 * (w - 4))) - 1u)) : 0u;
                const int pre = (int)(run + sad4(m0) + sad4(m1)), m = need_eq - pre, pc = __builtin_popcount(eqw[s]);
                unsigned se = eqw[s];
                if (m < pc) { se = 0u; unsigned x = eqw[s]; for (int i = 0; i < m; ++i) { const unsigned bb = x & (0u - x); se |= bb; x ^= bb; } }
                if (g == 0) Mb[kb * 2048 + qme] = gtw[s] | se;
                run += sad4(g0) + sad4(g1); } } }
        if (tid < (kb_hi - nkb) * 16) Mb[(nkb + (tid >> 4)) * 2048 + q0 + (tid & 15)] = 0u;
    }
    asm volatile("s_waitcnt vmcnt(0) lgkmcnt(0)" ::: "memory");
    __syncthreads();
#undef P3_ITEM
#undef P3_QDMA
}

namespace att {
using bf16x8 = __attribute__((ext_vector_type(8))) short;
using s16x4  = __attribute__((ext_vector_type(4))) short;
using u32x4  = __attribute__((ext_vector_type(4))) unsigned;
constexpr int KVBLK = 64;
constexpr size_t SHM_V = KVBLK * 128 * 2, SHM_K = KVBLK * 128 * 2;
constexpr int OFF_WS = 65536, OFF_MK = 65536 + 2048, OFF_Q = 65536 + 2048 + 8192, QPITCH = 272;
constexpr float THR2 = 11.5f;
#define KSWZ(row, colB) ((row) * 256 + ((colB) ^ (((row) & 7) << 4)))
#define SBAR() __builtin_amdgcn_sched_barrier(0)
__device__ __forceinline__ unsigned cvtpk(float lo, float hi) { unsigned r; asm volatile("v_cvt_pk_bf16_f32 %0, %1, %2" : "=v"(r) : "v"(lo), "v"(hi)); return r; }
__device__ __forceinline__ float msk(float p, unsigned w, int bit) { const int m = __builtin_amdgcn_sbfe((int)w, bit, 1); return __uint_as_float((__float_as_uint(p) & (unsigned)m) | (0xff800000u & ~(unsigned)m)); }
__device__ __forceinline__ void partialSM(f32x16& p0, f32x16& p1, unsigned w0, unsigned w1, float& m_reg, float& mn, float& alpha) {
#pragma unroll
  for (int r = 0; r < 16; ++r) { const int bit = (r & 3) + 8 * (r >> 2); p0[r] = msk(p0[r], w0, bit); p1[r] = msk(p1[r], w1, bit); }
  float pmax = p0[0];
#pragma unroll
  for (int r = 1; r < 16; ++r) pmax = fmaxf(pmax, p0[r]);
#pragma unroll
  for (int r = 0; r < 16; ++r) pmax = fmaxf(pmax, p1[r]);
  { auto rr = __builtin_amdgcn_permlane32_swap(__float_as_uint(pmax), __float_as_uint(pmax), false, false); pmax = fmaxf(__uint_as_float(rr[0]), __uint_as_float(rr[1])); }
  if (__builtin_expect(__all(pmax - m_reg <= THR2), 1)) { mn = m_reg; alpha = 1.f; }
  else { mn = fmaxf(m_reg, pmax); alpha = __builtin_amdgcn_exp2f(m_reg - mn); m_reg = mn; }
#pragma unroll
  for (int r = 0; r < 16; ++r) { p0[r] -= mn; p1[r] -= mn; }
#pragma unroll
  for (int r = 0; r < 16; ++r) p0[r] = __builtin_amdgcn_exp2f(p0[r]);
}
__device__ __forceinline__ void finishSM(f32x16& p0, f32x16& p1, float alpha, float& l_reg, bf16x8& pa0, bf16x8& pa1, bf16x8& pa2, bf16x8& pa3) {
#pragma unroll
  for (int r = 0; r < 16; ++r) p1[r] = __builtin_amdgcn_exp2f(p1[r]);
  float ps = 0;
#pragma unroll
  for (int r = 0; r < 16; ++r) ps += p0[r];
#pragma unroll
  for (int r = 0; r < 16; ++r) ps += p1[r];
  { auto rr = __builtin_amdgcn_permlane32_swap(__float_as_uint(ps), __float_as_uint(ps), false, false); ps = __uint_as_float(rr[0]) + __uint_as_float(rr[1]); }
  l_reg = l_reg * alpha + ps;
#define PK4(P, BASE, OUT) do { unsigned a0 = cvtpk(P[BASE + 0], P[BASE + 1]), a1 = cvtpk(P[BASE + 2], P[BASE + 3]);   \
    unsigned b0 = cvtpk(P[BASE + 4], P[BASE + 5]), b1 = cvtpk(P[BASE + 6], P[BASE + 7]);                              \
    auto r0 = __builtin_amdgcn_permlane32_swap(a0, b0, false, false); auto r1 = __builtin_amdgcn_permlane32_swap(a1, b1, false, false); \
    u32x4 w = {r0[0], r1[0], r0[1], r1[1]}; OUT = *reinterpret_cast<bf16x8*>(&w); } while (0)
  PK4(p0, 0, pa0); PK4(p0, 8, pa1); PK4(p1, 0, pa2); PK4(p1, 8, pa3);
#undef PK4
}
__device__ __forceinline__ void qkt(f32x16& p0, f32x16& p1, const char* Ks, const char* qrow, const float (&bo)[16], float kb0, float kb1, int r32, int hi) {
#pragma unroll
  for (int r = 0; r < 16; ++r) { p0[r] = bo[r] + kb0; p1[r] = bo[r] + kb1; }
#pragma unroll
  for (int d0 = 0; d0 < 8; ++d0) { const int cb = (d0 * 16 + hi * 8) * 2;
    const bf16x8 b0 = *reinterpret_cast<const bf16x8*>(Ks + KSWZ(r32, cb));
    const bf16x8 b1 = *reinterpret_cast<const bf16x8*>(Ks + KSWZ(32 + r32, cb));
    const bf16x8 qf = *reinterpret_cast<const bf16x8*>(qrow + d0 * 32);
    p0 = __builtin_amdgcn_mfma_f32_32x32x16_bf16(b0, qf, p0, 0, 0, 0);
    p1 = __builtin_amdgcn_mfma_f32_32x32x16_bf16(b1, qf, p1, 0, 0, 0); }
}
__device__ __forceinline__ int v_st(int k, int c) { const int kk = (k & ~0xC) | ((k & 4) << 1) | ((k & 8) >> 1); return ((kk >> 3) * 4 + (c >> 5)) * 512 + ((kk & 7) * 32 + (c & 31)) * 2; }
__device__ __forceinline__ int v_rd_base(int lane) { return ((lane & 3) << 3) | (((lane >> 2) & 3) << 6) | (((lane >> 4) & 1) << 5) | (((lane >> 5) & 1) << 8); }
constexpr int v_rd_off(int d0, int ks, int half) { return d0 * 512 + ks * 4096 + half * 2048; }
template <int OFF> __device__ __forceinline__ s16x4 tr_read(int vb) { s16x4 r; asm volatile("ds_read_b64_tr_b16 %0, %1 offset:%2" : "=&v"(r) : "v"(vb), "i"(OFF) : "memory"); return r; }
template <int D0> __device__ __forceinline__ void pv_one(f32x16& od, int vb, bf16x8 pa0, bf16x8 pa1, bf16x8 pa2, bf16x8 pa3) {
  const s16x4 l0 = tr_read<v_rd_off(D0, 0, 0)>(vb), h0 = tr_read<v_rd_off(D0, 0, 1)>(vb), l1 = tr_read<v_rd_off(D0, 1, 0)>(vb), h1 = tr_read<v_rd_off(D0, 1, 1)>(vb);
  const s16x4 l2 = tr_read<v_rd_off(D0, 2, 0)>(vb), h2 = tr_read<v_rd_off(D0, 2, 1)>(vb), l3 = tr_read<v_rd_off(D0, 3, 0)>(vb), h3 = tr_read<v_rd_off(D0, 3, 1)>(vb);
  asm volatile("s_waitcnt lgkmcnt(0)" ::: "memory"); SBAR();
#define PK(L, H) (bf16x8){L[0], L[1], L[2], L[3], H[0], H[1], H[2], H[3]}
  od = __builtin_amdgcn_mfma_f32_32x32x16_bf16(pa0, PK(l0, h0), od, 0, 0, 0);
  od = __builtin_amdgcn_mfma_f32_32x32x16_bf16(pa1, PK(l1, h1), od, 0, 0, 0);
  od = __builtin_amdgcn_mfma_f32_32x32x16_bf16(pa2, PK(l2, h2), od, 0, 0, 0);
  od = __builtin_amdgcn_mfma_f32_32x32x16_bf16(pa3, PK(l3, h3), od, 0, 0, 0);
#undef PK
}
__device__ __forceinline__ void pv_d0(f32x16* o, int vb, bf16x8 pa0, bf16x8 pa1, bf16x8 pa2, bf16x8 pa3) {
  pv_one<0>(o[0], vb, pa0, pa1, pa2, pa3); pv_one<1>(o[1], vb, pa0, pa1, pa2, pa3); pv_one<2>(o[2], vb, pa0, pa1, pa2, pa3); pv_one<3>(o[3], vb, pa0, pa1, pa2, pa3);
}
__device__ __forceinline__ void attn_item(const bf16* __restrict__ Qb, const bf16* __restrict__ Kh, const bf16* __restrict__ Vh, const unsigned* __restrict__ Mq, bf16* __restrict__ Ob, int NT, char* lds, LAS unsigned char* ldsL) {
  const int tid = threadIdx.x, wid = __builtin_amdgcn_readfirstlane(tid >> 6), lane = tid & 63, r32 = lane & 31, hi = lane >> 5;
  float* ws = (float*)(lds + OFF_WS) + wid * 64; float* li_l = ws; float* al_l = ws + 32;
  unsigned* mk = (unsigned*)(lds + OFF_MK);
  unsigned soff[4];
#pragma unroll
  for (int i = 0; i < 4; ++i) { const int pc = (wid & 3) * 4 + i;
    if (wid < 4) { const int row = pc * 4 + (lane >> 4), cb = (lane & 15) * 16; soff[i] = (unsigned)(row * 256 + (cb ^ ((row & 7) << 4))); }
    else { const int L = pc * 1024 + lane * 16, st = L >> 9, wi = L & 511, kk = (st >> 2) * 8 + (wi >> 6), c = (st & 3) * 32 + ((wi & 63) >> 1), k = (kk & ~0xC) | ((kk & 4) << 1) | ((kk & 8) >> 1);
           soff[i] = (unsigned)(k * 256 + c * 2); } }
  const char* gsrc = (const char*)(wid < 4 ? Kh : Vh);
  const unsigned ldst = (unsigned)((wid < 4 ? 0 : 16384) + (wid & 3) * 4096);
#define DMA_TILE(t, slot) do { _Pragma("unroll") for (int i_ = 0; i_ < 4; ++i_) \
    __builtin_amdgcn_global_load_lds((const unsigned*)(gsrc + (size_t)(t) * (64 * 256) + soff[i_]), (LAS unsigned*)(ldsL + (slot) * 32768 + ldst + i_ * 1024), 16, 0, 0); } while (0)
  DMA_TILE(0, 0);
  for (int i = tid; i < NT * 64; i += 512) mk[i] = Mq[(size_t)(i >> 5) * 2048 + (i & 31)];
  float m_reg = -1e30f, l_reg = 0; f32x16 o[4] = {}; bf16x8 qr[8];
  { const bf16* Qw = Qb + (size_t)r32 * 1024 + wid * 128 + hi * 8; float ss = 0.f;
#pragma unroll
    for (int d0 = 0; d0 < 8; ++d0) { qr[d0] = *reinterpret_cast<const bf16x8*>(Qw + d0 * 16); ss += sumsq8(qr[d0]); }
    ss = xhalf_sum(ss); const float rq = rsqrtf(ss * (1.f / 128.f) + EPS);
#pragma unroll
    for (int d0 = 0; d0 < 8; ++d0) { float f[8];
#pragma unroll
      for (int j = 0; j < 8; ++j) f[j] = __uint_as_float((unsigned)(unsigned short)qr[d0][j] << 16) * rq;
      u32x4 w = {cvtpk(f[0], f[1]), cvtpk(f[2], f[3]), cvtpk(f[4], f[5]), cvtpk(f[6], f[7])}; qr[d0] = *reinterpret_cast<bf16x8*>(&w); } }
  const float slope2 = __builtin_amdgcn_exp2f(-(float)(wid + 1)) * 1.4426950408889634f;
  float bo[16];
#pragma unroll
  for (int r = 0; r < 16; ++r) bo[r] = __uint_as_float(__builtin_amdgcn_readfirstlane(__float_as_uint(slope2 * (float)((r & 3) + 8 * (r >> 2)))));
  const float hoff = slope2 * (float)(4 * hi);
  const int vb0 = (int)(uintptr_t)(lds + 16384) + v_rd_base(lane);
  asm volatile("s_waitcnt vmcnt(0) lgkmcnt(0)\n\ts_barrier" ::: "memory");
  for (int j = 0; j < NT; ++j) {
    const int sl = j & 1;
    if (j + 1 < NT) DMA_TILE(j + 1, sl ^ 1);
    const char* Ks = lds + sl * 32768;
    const unsigned w0 = mk[(2 * j) * 32 + r32] >> (4 * hi), w1 = mk[(2 * j + 1) * 32 + r32] >> (4 * hi);
    f32x16 p0, p1;
    { const float kb0 = slope2 * (float)(j * 64) + hoff, kb1 = kb0 + slope2 * 32.f;
#pragma unroll
      for (int r = 0; r < 16; ++r) { p0[r] = bo[r] + kb0; p1[r] = bo[r] + kb1; }
      bf16x8 ka = *reinterpret_cast<const bf16x8*>(Ks + KSWZ(r32, hi * 16)), kb = *reinterpret_cast<const bf16x8*>(Ks + KSWZ(32 + r32, hi * 16));
#pragma unroll
      for (int d0 = 0; d0 < 8; ++d0) { bf16x8 na = ka, nb = kb;
        if (d0 < 7) { const int cb = ((d0 + 1) * 16 + hi * 8) * 2; na = *reinterpret_cast<const bf16x8*>(Ks + KSWZ(r32, cb)); nb = *reinterpret_cast<const bf16x8*>(Ks + KSWZ(32 + r32, cb)); }
        SBAR();
        p0 = __builtin_amdgcn_mfma_f32_32x32x16_bf16(ka, qr[d0], p0, 0, 0, 0);
        p1 = __builtin_amdgcn_mfma_f32_32x32x16_bf16(kb, qr[d0], p1, 0, 0, 0);
        SBAR();
        ka = na; kb = nb; } }
    float alpha; bf16x8 pa0, pa1, pa2, pa3;
    {
#pragma unroll
      for (int r = 0; r < 16; ++r) { const int bit = (r & 3) + 8 * (r >> 2); p0[r] = msk(p0[r], w0, bit); p1[r] = msk(p1[r], w1, bit); }
      float pmax = fmaxf(p0[0], p1[0]);
#pragma unroll
      for (int r = 1; r < 16; ++r) pmax = fmaxf(fmaxf(pmax, p0[r]), p1[r]);
      { auto rr = __builtin_amdgcn_permlane32_swap(__float_as_uint(pmax), __float_as_uint(pmax), false, false); pmax = fmaxf(__uint_as_float(rr[0]), __uint_as_float(rr[1])); }
      float mn;
      if (__builtin_expect(__all(pmax - m_reg <= THR2), 1)) { mn = m_reg; alpha = 1.f; }
      else { mn = fmaxf(m_reg, pmax); alpha = __builtin_amdgcn_exp2f(m_reg - mn); m_reg = mn; }
      float ps = 0.f;
#pragma unroll
      for (int r = 0; r < 16; ++r) { p0[r] = __builtin_amdgcn_exp2f(p0[r] - mn); p1[r] = __builtin_amdgcn_exp2f(p1[r] - mn); ps += p0[r] + p1[r]; }
      { auto rr = __builtin_amdgcn_permlane32_swap(__float_as_uint(ps), __float_as_uint(ps), false, false); ps = __uint_as_float(rr[0]) + __uint_as_float(rr[1]); }
      l_reg = l_reg * alpha + ps;
#define PK4(P, BASE, OUT) do { unsigned a0 = cvtpk(P[BASE + 0], P[BASE + 1]), a1 = cvtpk(P[BASE + 2], P[BASE + 3]);   \
    unsigned b0 = cvtpk(P[BASE + 4], P[BASE + 5]), b1 = cvtpk(P[BASE + 6], P[BASE + 7]);                              \
    auto r0 = __builtin_amdgcn_permlane32_swap(a0, b0, false, false); auto r1 = __builtin_amdgcn_permlane32_swap(a1, b1, false, false); \
    u32x4 w = {r0[0], r1[0], r0[1], r1[1]}; OUT = *reinterpret_cast<bf16x8*>(&w); } while (0)
      PK4(p0, 0, pa0); PK4(p0, 8, pa1); PK4(p1, 0, pa2); PK4(p1, 8, pa3);
#undef PK4
      if (__any(alpha < 1.f)) { if (hi == 0) al_l[r32] = alpha; asm volatile("s_waitcnt lgkmcnt(0)" ::: "memory");
#pragma unroll
        for (int d = 0; d < 4; ++d)
#pragma unroll
          for (int r = 0; r < 16; ++r) o[d][r] *= al_l[crow(r, hi)]; }
    }
    { const int vb = vb0 + sl * 32768;
      s16x4 lA[4], hA[4], lB[4], hB[4];
#define VREADS(L_, H_, D0) do { L_[0] = tr_read<v_rd_off(D0, 0, 0)>(vb); H_[0] = tr_read<v_rd_off(D0, 0, 1)>(vb); L_[1] = tr_read<v_rd_off(D0, 1, 0)>(vb); H_[1] = tr_read<v_rd_off(D0, 1, 1)>(vb); \
      L_[2] = tr_read<v_rd_off(D0, 2, 0)>(vb); H_[2] = tr_read<v_rd_off(D0, 2, 1)>(vb); L_[3] = tr_read<v_rd_off(D0, 3, 0)>(vb); H_[3] = tr_read<v_rd_off(D0, 3, 1)>(vb); } while (0)
#define PK(L, H) (bf16x8){L[0], L[1], L[2], L[3], H[0], H[1], H[2], H[3]}
#define VMMA(OD, L_, H_) do { OD = __builtin_amdgcn_mfma_f32_32x32x16_bf16(pa0, PK(L_[0], H_[0]), OD, 0, 0, 0); OD = __builtin_amdgcn_mfma_f32_32x32x16_bf16(pa1, PK(L_[1], H_[1]), OD, 0, 0, 0); \
      OD = __builtin_amdgcn_mfma_f32_32x32x16_bf16(pa2, PK(L_[2], H_[2]), OD, 0, 0, 0); OD = __builtin_amdgcn_mfma_f32_32x32x16_bf16(pa3, PK(L_[3], H_[3]), OD, 0, 0, 0); } while (0)
#define VWAIT(N, L_, H_) do { asm volatile("s_waitcnt lgkmcnt(" #N ")" : "+v"(L_[0]), "+v"(L_[1]), "+v"(L_[2]), "+v"(L_[3]), "+v"(H_[0]), "+v"(H_[1]), "+v"(H_[2]), "+v"(H_[3]) :: "memory"); SBAR(); } while (0)
      VREADS(lA, hA, 0); VREADS(lB, hB, 1);
      VWAIT(8, lA, hA); VMMA(o[0], lA, hA);
      VREADS(lA, hA, 2);
      VWAIT(8, lB, hB); VMMA(o[1], lB, hB);
      VREADS(lB, hB, 3);
      VWAIT(8, lA, hA); VMMA(o[2], lA, hA);
      VWAIT(0, lB, hB); VMMA(o[3], lB, hB);
#undef VREADS
#undef PK
#undef VMMA
#undef VWAIT
    }
    asm volatile("s_waitcnt vmcnt(0) lgkmcnt(0)\n\ts_barrier" ::: "memory");
  }
  if (hi == 0) li_l[r32] = l_reg; asm volatile("s_waitcnt lgkmcnt(0)" ::: "memory");
  float rli[16];
#pragma unroll
  for (int r = 0; r < 16; ++r) rli[r] = __builtin_amdgcn_rcpf(li_l[crow(r, hi)]);
  unsigned short* stg = (unsigned short*)(lds + wid * 8192);
#pragma unroll
  for (int r = 0; r < 16; ++r) { const int orow = crow(r, hi);
#pragma unroll
    for (int d0 = 0; d0 < 4; ++d0) stg[orow * 128 + d0 * 32 + r32] = (unsigned short)f2bf(o[d0][r] * rli[r]); }
  asm volatile("s_waitcnt lgkmcnt(0)" ::: "memory");
#pragma unroll
  for (int i = 0; i < 8; ++i) { const int row = i * 4 + (lane >> 4), ch = lane & 15; const u32x4 v = *(const u32x4*)(stg + row * 128 + ch * 8);
    *(u32x4*)(Ob + (size_t)row * 1024 + wid * 128 + ch * 8) = v; }
#undef DMA_TILE
}
#undef KSWZ
#undef SBAR
}


namespace ret {
using bf16x8 = __attribute__((ext_vector_type(8))) short;
using s16x4  = __attribute__((ext_vector_type(4))) short;
using u32x4  = __attribute__((ext_vector_type(4))) unsigned;
using u32x2  = __attribute__((ext_vector_type(2))) unsigned;
constexpr int C = 64, QP = 272, KPI = 272, VP = 576;
constexpr int OFF_Q = 0, OFF_K = 17408, OFF_V = 34816, OFF_ST = 71680, OFF_Y = 75776;
typedef float f32x2_t __attribute__((ext_vector_type(2))); typedef __bf16 bf16x2_t __attribute__((ext_vector_type(2)));
__device__ __forceinline__ unsigned cvtpk(float lo, float hi) { const f32x2_t v = {lo, hi}; const bf16x2_t b = __builtin_convertvector(v, bf16x2_t); return __builtin_bit_cast(unsigned, b); }
template <int OFF> __device__ __forceinline__ s16x4 trr(int base) { s16x4 r; asm volatile("ds_read_b64_tr_b16 %0, %1 offset:%2" : "=&v"(r) : "v"(base), "i"(OFF) : "memory"); return r; }
__device__ __forceinline__ bf16x8 pk8(const f32x16& x, int s) { u32x4 w = {cvtpk(x[8 * s + 0], x[8 * s + 1]), cvtpk(x[8 * s + 2], x[8 * s + 3]), cvtpk(x[8 * s + 4], x[8 * s + 5]), cvtpk(x[8 * s + 6], x[8 * s + 7])}; return *reinterpret_cast<bf16x8*>(&w); }
__device__ __forceinline__ float silu_(float x) { return x * __builtin_amdgcn_rcpf(1.f + __builtin_amdgcn_exp2f(-1.4426950408889634f * x)); }
__device__ __forceinline__ void ret_item(int b, int h, const bf16* __restrict__ RQ, const bf16* __restrict__ RK, bf16* RV, const bf16* __restrict__ RG, const float* __restrict__ gnorm, char* lds) {
  const int tid = threadIdx.x, w = __builtin_amdgcn_readfirstlane(tid >> 6), lane = tid & 63, r32 = lane & 31, hi = lane >> 5;
  const float lg = __log2f(1.f - exp2f(-5.f - (float)h)), gC = exp2f(64.f * lg);
  char* Qs = lds + OFF_Q; char* Ks = lds + OFF_K; char* Vs = lds + OFF_V; float* st = (float*)(lds + OFF_ST); char* Ys = lds + OFF_Y;
  f32x16 S[4] = {};
  const unsigned voffQ = (unsigned)(((tid >> 4) * 512 + (tid & 15) * 8) * 2), voffV = (unsigned)(((tid >> 5) * 1024 + (tid & 31) * 8) * 2);
  const int trq = (lane & 15) >> 2, trp = lane & 3, trg = (lane >> 4) & 1;
  const int vtb = (int)(uintptr_t)(lds + OFF_V) + (4 * hi + trq) * VP + (32 * w + 16 * trg + 4 * trp) * 2, ktb = (int)(uintptr_t)(lds + OFF_K) + (4 * hi + trq) * KPI + (16 * trg + 4 * trp) * 2;
  u32x4 pq[2], pk[2], pv[4];
#define RET_LOAD(cc) do { const size_t t0_ = (size_t)b * SEQ + (size_t)(cc) * C; const char* qb_ = (const char*)(RQ + t0_ * 512 + h * 128); const char* kb_ = (const char*)(RK + t0_ * 512 + h * 128); const char* vb_ = (const char*)(RV + t0_ * 1024 + h * 256); \
    _Pragma("unroll") for (int i = 0; i < 2; ++i) { pq[i] = *(const u32x4*)(qb_ + voffQ + i * 32768); pk[i] = *(const u32x4*)(kb_ + voffQ + i * 32768); } \
    _Pragma("unroll") for (int i = 0; i < 4; ++i) pv[i] = *(const u32x4*)(vb_ + voffV + i * 32768); } while (0)
#define RET_STAGE() do { \
    _Pragma("unroll") for (int i = 0; i < 2; ++i) { const int row = (tid >> 4) + 32 * i, ch = tid & 15; \
      *(u32x4*)(Qs + row * QP + ch * 16) = pq[i]; \
      const u32x4 kv = pk[i]; const float f = exp2f(lg * (float)(C - 1 - row)) * 0.08838834764831845f; \
      u32x4 ko; ko.x = cvtpk(pg8::bf_lo(kv.x) * f, pg8::bf_hi(kv.x) * f); ko.y = cvtpk(pg8::bf_lo(kv.y) * f, pg8::bf_hi(kv.y) * f); ko.z = cvtpk(pg8::bf_lo(kv.z) * f, pg8::bf_hi(kv.z) * f); ko.w = cvtpk(pg8::bf_lo(kv.w) * f, pg8::bf_hi(kv.w) * f); \
      *(u32x4*)(Ks + row * KPI + ch * 16) = ko; } \
    _Pragma("unroll") for (int i = 0; i < 4; ++i) { const int row = (tid >> 5) + 16 * i, ch = tid & 31; *(u32x4*)(Vs + row * VP + ch * 16) = pv[i]; } } while (0)
  RET_LOAD(0);
  __syncthreads();
  RET_STAGE();
  RET_LOAD(1);
  __syncthreads();
  for (int c = 0; c < SEQ / C; ++c) {
    const size_t tok0 = (size_t)b * SEQ + (size_t)c * C;
    f32x16 ot[2] = {};
#pragma unroll
    for (int dt = 0; dt < 4; ++dt) {
#pragma unroll
      for (int s = 0; s < 2; ++s) { const bf16x8 af = pk8(S[dt], s);
#pragma unroll
        for (int nt = 0; nt < 2; ++nt) { const char* qp = Qs + (32 * nt + r32) * QP + (32 * dt + 16 * s + 4 * hi) * 2;
          const u32x2 lo = *(const u32x2*)qp, hi8 = *(const u32x2*)(qp + 16); const u32x4 bw = {lo.x, lo.y, hi8.x, hi8.y};
          ot[nt] = __builtin_amdgcn_mfma_f32_32x32x16_bf16(af, *reinterpret_cast<const bf16x8*>(&bw), ot[nt], 0, 0, 0); } }
      __builtin_amdgcn_sched_barrier(0); }
#pragma unroll
    for (int nt = 0; nt < 2; ++nt)
#pragma unroll
      for (int r = 0; r < 16; ++r) ot[nt][r] *= gC;
    __builtin_amdgcn_sched_barrier(0);
    bf16x8 vfr[4];
    { s16x4 vlo[4], vhi[4];
      vlo[0] = trr<0 * 16 * VP>(vtb); vhi[0] = trr<0 * 16 * VP + 8 * VP>(vtb); vlo[1] = trr<1 * 16 * VP>(vtb); vhi[1] = trr<1 * 16 * VP + 8 * VP>(vtb);
      vlo[2] = trr<2 * 16 * VP>(vtb); vhi[2] = trr<2 * 16 * VP + 8 * VP>(vtb); vlo[3] = trr<3 * 16 * VP>(vtb); vhi[3] = trr<3 * 16 * VP + 8 * VP>(vtb);
      asm volatile("s_waitcnt lgkmcnt(0)" : "+v"(vlo[0]), "+v"(vlo[1]), "+v"(vlo[2]), "+v"(vlo[3]), "+v"(vhi[0]), "+v"(vhi[1]), "+v"(vhi[2]), "+v"(vhi[3]) :: "memory"); __builtin_amdgcn_sched_barrier(0);
#pragma unroll
      for (int ks = 0; ks < 4; ++ks) vfr[ks] = (bf16x8){vlo[ks][0], vlo[ks][1], vlo[ks][2], vlo[ks][3], vhi[ks][0], vhi[ks][1], vhi[ks][2], vhi[ks][3]}; }
#pragma unroll
    for (int nt = 0; nt < 2; ++nt)
#pragma unroll
      for (int jt = 0; jt <= nt; ++jt) { f32x16 pt = {};
#pragma unroll
        for (int kk = 0; kk < 8; ++kk) { const bf16x8 ka = *(const bf16x8*)(Ks + (32 * jt + r32) * KPI + (16 * kk + 8 * hi) * 2), qb = *(const bf16x8*)(Qs + (32 * nt + r32) * QP + (16 * kk + 8 * hi) * 2);
          pt = __builtin_amdgcn_mfma_f32_32x32x16_bf16(ka, qb, pt, 0, 0, 0); }
        if (jt == nt) {
#pragma unroll
          for (int r = 0; r < 16; ++r) if (crow(r, hi) > r32) pt[r] = 0.f; }
#pragma unroll
        for (int s = 0; s < 2; ++s) ot[nt] = __builtin_amdgcn_mfma_f32_32x32x16_bf16(vfr[2 * jt + s], pk8(pt, s), ot[nt], 0, 0, 0);
        __builtin_amdgcn_sched_barrier(0); }
#pragma unroll
    for (int dt = 0; dt < 4; ++dt) {
#pragma unroll
      for (int r = 0; r < 16; ++r) S[dt][r] *= gC;
      s16x4 kl[4], kh[4];
      kl[0] = trr<0 * 16 * KPI>(ktb + dt * 64); kh[0] = trr<0 * 16 * KPI + 8 * KPI>(ktb + dt * 64); kl[1] = trr<1 * 16 * KPI>(ktb + dt * 64); kh[1] = trr<1 * 16 * KPI + 8 * KPI>(ktb + dt * 64);
      kl[2] = trr<2 * 16 * KPI>(ktb + dt * 64); kh[2] = trr<2 * 16 * KPI + 8 * KPI>(ktb + dt * 64); kl[3] = trr<3 * 16 * KPI>(ktb + dt * 64); kh[3] = trr<3 * 16 * KPI + 8 * KPI>(ktb + dt * 64);
      asm volatile("s_waitcnt lgkmcnt(0)" : "+v"(kl[0]), "+v"(kl[1]), "+v"(kl[2]), "+v"(kl[3]), "+v"(kh[0]), "+v"(kh[1]), "+v"(kh[2]), "+v"(kh[3]) :: "memory"); __builtin_amdgcn_sched_barrier(0);
#pragma unroll
      for (int ks = 0; ks < 4; ++ks) S[dt] = __builtin_amdgcn_mfma_f32_32x32x16_bf16((bf16x8){kl[ks][0], kl[ks][1], kl[ks][2], kl[ks][3], kh[ks][0], kh[ks][1], kh[ks][2], kh[ks][3]}, vfr[ks], S[dt], 0, 0, 0);
      __builtin_amdgcn_sched_barrier(0); }
    u32x4 gt4[4];
    { const char* gb_ = (const char*)(RG + tok0 * 1024 + h * 256);
#pragma unroll
      for (int i = 0; i < 4; ++i) gt4[i] = *(const u32x4*)(gb_ + voffV + i * 32768); }
#pragma unroll
    for (int nt = 0; nt < 2; ++nt) { const float rs = exp2f(lg * (float)(32 * nt + r32 + 1 - C)); float s1 = 0.f, s2 = 0.f;
#pragma unroll
      for (int r = 0; r < 16; ++r) { ot[nt][r] *= rs; s1 += ot[nt][r]; s2 += ot[nt][r] * ot[nt][r]; }
      s1 = xhalf_sum(s1); s2 = xhalf_sum(s2);
      if (hi == 0) { st[(w * 64 + 32 * nt + r32) * 2] = s1; st[(w * 64 + 32 * nt + r32) * 2 + 1] = s2; } }
    __syncthreads();
    if (c + 1 < SEQ / C) { RET_STAGE(); if (c + 2 < SEQ / C) RET_LOAD(c + 2); }
#pragma unroll
    for (int nt = 0; nt < 2; ++nt) { float s1 = 0.f, s2 = 0.f;
#pragma unroll
      for (int ww = 0; ww < 8; ++ww) { s1 += st[(ww * 64 + 32 * nt + r32) * 2]; s2 += st[(ww * 64 + 32 * nt + r32) * 2 + 1]; }
      const float mu = s1 * (1.f / 256.f), var = fmaxf(s2 * (1.f / 256.f) - mu * mu, 0.f), rstd = rsqrtf(var + EPS);
#pragma unroll
      for (int g = 0; g < 4; ++g) { float y[4];
#pragma unroll
        for (int j = 0; j < 4; ++j) y[j] = (ot[nt][4 * g + j] - mu) * rstd * gnorm[h * 256 + 32 * w + 8 * g + 4 * hi + j];
        const u32x2 o2 = {cvtpk(y[0], y[1]), cvtpk(y[2], y[3])};
        *(u32x2*)(Ys + (32 * nt + r32) * VP + (32 * w + 8 * g + 4 * hi) * 2) = o2; } }
    __syncthreads();
    { char* ob_ = (char*)(RV + tok0 * 1024 + h * 256);
#pragma unroll
      for (int i = 0; i < 4; ++i) { const int row = (tid >> 5) + 16 * i, ch = tid & 31;
        const u32x4 yv = *(const u32x4*)(Ys + row * VP + ch * 16); const u32x4 gt = gt4[i];
        u32x4 o; o.x = cvtpk(pg8::bf_lo(yv.x) * silu_(pg8::bf_lo(gt.x)), pg8::bf_hi(yv.x) * silu_(pg8::bf_hi(gt.x))); o.y = cvtpk(pg8::bf_lo(yv.y) * silu_(pg8::bf_lo(gt.y)), pg8::bf_hi(yv.y) * silu_(pg8::bf_hi(gt.y)));
        o.z = cvtpk(pg8::bf_lo(yv.z) * silu_(pg8::bf_lo(gt.z)), pg8::bf_hi(yv.z) * silu_(pg8::bf_hi(gt.z))); o.w = cvtpk(pg8::bf_lo(yv.w) * silu_(pg8::bf_lo(gt.w)), pg8::bf_hi(yv.w) * silu_(pg8::bf_hi(gt.w)));
        *(u32x4*)(ob_ + voffV + i * 32768) = o; } }
  }
#undef RET_LOAD
#undef RET_STAGE
}
}

__device__ __forceinline__ void p4_attn(Frame& F, const Args& a, unsigned char* lds_generic) {
    const size_t nt_ = (size_t)F.ntok;
    const bf16* QA = (const bf16*)(F.act + nt_ * O_QA); bf16* ATT = (bf16*)(F.act + nt_ * O_QA);
    unsigned char* aux = a.xb + nt_ * 2048;
    const bf16* KP = (const bf16*)(aux + nt_ * AUX_KP); const bf16* VV = (const bf16*)(aux + nt_ * AUX_VV); const unsigned* MASK = (const unsigned*)(aux + nt_ * AUX_MASK);
    volatile LAS unsigned* MISC = (volatile LAS unsigned*)(F.lds + MISC_OFF);
    unsigned* qctr = (unsigned*)(F.ws + WS_CTL) + CW_Q4;
    const bf16* RQ = (const bf16*)(F.act + nt_ * O_RQ); const bf16* RK = (const bf16*)(F.act + nt_ * O_RK); bf16* RV = (bf16*)(F.act + nt_ * O_RV); const bf16* RG = (const bf16*)(F.act + nt_ * O_RG);
    const int nb = F.ntok / SEQ, nret = nb * 4, nitems = nb * 64;
    for (;;) {
        __syncthreads(); if (F.tid == 0) MISC[0] = atomicAdd(qctr + 16, 1u); __syncthreads();
        const int it = (int)MISC[0]; if (it >= nret || a.mode == 1) break;
        ret::ret_item(it >> 2, it & 3, RQ, RK, RV, RG, a.in[8], (char*)lds_generic);
    }
    for (;;) {
        __syncthreads(); if (F.tid == 0) MISC[0] = atomicAdd(qctr, 1u); __syncthreads();
        const int it = (int)MISC[0]; if (it >= nitems || a.mode == 2) break;
        const int qb = 63 - it / nb, b = it % nb, NT = (qb >> 1) + 1;
        const size_t row0 = (size_t)b * SEQ + qb * 32;
        att::attn_item(QA + row0 * 1024, KP + (size_t)b * SEQ * 128, VV + (size_t)b * SEQ * 128, MASK + (size_t)b * 64 * 2048 + qb * 32, ATT + row0 * 1024, NT, (char*)lds_generic, F.lds);
    }
}


__device__ __forceinline__ void p7_router(Frame& F, const Args& a) {
    const int lane = F.lane, r32 = lane & 31, hi = lane >> 5, tid = F.tid;
    unsigned char* mo = F.act; bf16* N2 = (bf16*)(mo + MO_N2); unsigned char* meta = mo + MO_META;
    int* MB = (int*)(meta + MM_B); int* MPp = (int*)(meta + MM_P); float* MCL = (float*)(meta + MM_CL); float* MCH = (float*)(meta + MM_CH); float* MRS = (float*)(meta + MM_RS);
    const bf16* Wh = (const bf16*)(F.ws + WS_WR); const bf16* Wl = Wh + 32 * 1024;
    const float* g2 = a.in[12]; const float* b_gr = a.in[14]; const float* b_er = a.in[16];
    const bf16* hbase = (const bf16*)(F.act + MO_H16);
    unsigned* gcnt = (unsigned*)(F.ws + WS_CTL) + CW_MOE;
    LAS unsigned* lcnt = (LAS unsigned*)(F.lds + RING_OFF);
    if (tid < 64) lcnt[tid] = 0u;
    __syncthreads();
    const int ntasks = F.ntok / 32, tpw = ntasks / F.G;
    const bool have = F.wave < tpw; const int t = (F.vcu * tpw + F.wave) * 32 + r32;
    int bucket = 0, posl = 0; float clo = 0.f, chi = 0.f, rstd = 0.f;
    if (have) {
        const bf16* hrow = hbase + (size_t)t * D + hi * 8; bf16* nrow = N2 + (size_t)t * D + hi * 8;
        f32x16 acc = f32x16{}; float ss = 0.f;
#pragma unroll 4
        for (int kk = 0; kk < 64; ++kk) {
            const v4u hv = *(const v4u*)(hrow + kk * 16); const f32x4 a0 = {pg8::bf_lo(hv.x), pg8::bf_hi(hv.x), pg8::bf_lo(hv.y), pg8::bf_hi(hv.y)}, a1 = {pg8::bf_lo(hv.z), pg8::bf_hi(hv.z), pg8::bf_lo(hv.w), pg8::bf_hi(hv.w)};
            const f32x4 q0 = *(const f32x4*)(g2 + kk * 16 + hi * 8), q1 = *(const f32x4*)(g2 + kk * 16 + hi * 8 + 4);
            ss += (a0.x * a0.x + a0.y * a0.y) + (a0.z * a0.z + a0.w * a0.w) + (a1.x * a1.x + a1.y * a1.y) + (a1.z * a1.z + a1.w * a1.w);
            const float x[8] = {a0.x * q0.x, a0.y * q0.y, a0.z * q0.z, a0.w * q0.w, a1.x * q1.x, a1.y * q1.y, a1.z * q1.z, a1.w * q1.w};
            unsigned hb[8]; float lo[8];
#pragma unroll
            for (int j = 0; j < 8; ++j) { hb[j] = f2bf(x[j]); lo[j] = x[j] - __uint_as_float(hb[j] << 16); }
            v4u xh; xh.x = hb[0] | (hb[1] << 16); xh.y = hb[2] | (hb[3] << 16); xh.z = hb[4] | (hb[5] << 16); xh.w = hb[6] | (hb[7] << 16);
            v4u xl; xl.x = pk2(lo[0], lo[1]); xl.y = pk2(lo[2], lo[3]); xl.z = pk2(lo[4], lo[5]); xl.w = pk2(lo[6], lo[7]);
            *(v4u*)(nrow + kk * 16) = xh;
            const bf16x8_t wh = *(const bf16x8_t*)(Wh + (size_t)r32 * 1024 + kk * 16 + hi * 8), wl = *(const bf16x8_t*)(Wl + (size_t)r32 * 1024 + kk * 16 + hi * 8);
            const bf16x8_t bh = __builtin_bit_cast(bf16x8_t, xh), bl = __builtin_bit_cast(bf16x8_t, xl);
            acc = __builtin_amdgcn_mfma_f32_32x32x16_bf16(wh, bh, acc, 0, 0, 0);
            acc = __builtin_amdgcn_mfma_f32_32x32x16_bf16(wh, bl, acc, 0, 0, 0);
            acc = __builtin_amdgcn_mfma_f32_32x32x16_bf16(wl, bh, acc, 0, 0, 0);
        }
        ss = xhalf_sum(ss); rstd = rsqrtf(ss * (1.f / D) + EPS);
        float L[24];
#pragma unroll
        for (int r = 0; r < 12; ++r) { const float v = acc[r]; auto rr = __builtin_amdgcn_permlane32_swap(__float_as_uint(v), __float_as_uint(v), false, false);
            L[(r & 3) + 8 * (r >> 2)] = __uint_as_float(rr[0]); L[(r & 3) + 8 * (r >> 2) + 4] = __uint_as_float(rr[1]); }
        float gl[4];
#pragma unroll
        for (int i = 0; i < 4; ++i) gl[i] = L[i] * rstd + b_gr[i];
        int g = 0; float gm = gl[0];
#pragma unroll
        for (int i = 1; i < 4; ++i) if (gl[i] > gm) { gm = gl[i]; g = i; }
        float se = 0.f;
#pragma unroll
        for (int i = 0; i < 4; ++i) se += __expf(gl[i] - gm);
        const float gw = 1.f / se;
        float el[4];
#pragma unroll
        for (int i = 0; i < 4; ++i) { const float l0 = L[4 + i], l1 = L[8 + i], l2 = L[12 + i], l3 = L[16 + i]; const float lv = g == 0 ? l0 : (g == 1 ? l1 : (g == 2 ? l2 : l3));
            const float b0 = b_er[i], b1 = b_er[4 + i], b2 = b_er[8 + i], b3 = b_er[12 + i]; el[i] = lv * rstd + (g == 0 ? b0 : (g == 1 ? b1 : (g == 2 ? b2 : b3))); }
        int i1 = 0; float v1 = el[0];
#pragma unroll
        for (int i = 1; i < 4; ++i) if (el[i] > v1) { v1 = el[i]; i1 = i; }
        int i2 = -1; float v2 = 0.f;
#pragma unroll
        for (int i = 0; i < 4; ++i) if (i != i1 && (i2 < 0 || el[i] > v2)) { v2 = el[i]; i2 = i; }
        const float e2 = __expf(v2 - v1), p1 = gw / (1.f + e2), p2 = gw * e2 / (1.f + e2);
        const int lo_ = i1 < i2 ? i1 : i2, hi_ = i1 < i2 ? i2 : i1;
        const int pair = lo_ == 0 ? (hi_ - 1) : (lo_ == 1 ? (hi_ + 1) : 5);
        bucket = g * 6 + pair; clo = i1 < i2 ? p1 : p2; chi = i1 < i2 ? p2 : p1;
        if (hi == 0) posl = (int)__hip_atomic_fetch_add(&lcnt[bucket], 1u, __ATOMIC_RELAXED, __HIP_MEMORY_SCOPE_WORKGROUP);
    }
    __syncthreads();
    if (tid < 24) lcnt[32 + tid] = atomicAdd(gcnt + tid, lcnt[tid]);
    __syncthreads();
    if (have && hi == 0) { MB[t] = bucket; MPp[t] = (int)lcnt[32 + bucket] + posl; MCL[t] = clo; MCH[t] = chi; MRS[t] = rstd; }
}
__device__ __forceinline__ int moe_tiles(const unsigned* gcnt, int* rowstart  ) { int rs = 0;
    for (int b = 0; b < 24; ++b) { rowstart[b] = rs; rs += (int)((gcnt[b] + 255u) & ~255u); } rowstart[24] = rs; return rs >> 8; }
__device__ __forceinline__ void p8_permute(Frame& F, const Args& a) {
    unsigned char* mo = F.act; unsigned char* meta = mo + MO_META;
    const int* MB = (const int*)(meta + MM_B); const int* MPp = (const int*)(meta + MM_P); const float* MCL = (const float*)(meta + MM_CL); const float* MCH = (const float*)(meta + MM_CH); const float* MRS = (const float*)(meta + MM_RS);
    int* PTOK = (int*)(meta + MM_PTOK); float* PRS = (float*)(meta + MM_PRS); float* PCL = (float*)(meta + MM_PCL); float* PCH = (float*)(meta + MM_PCH);
    const unsigned* gcnt = (const unsigned*)(F.ws + WS_CTL) + CW_MOE;
    LAS int* rsL = (LAS int*)(F.lds + RING_OFF);
    if (F.tid == 0) { int rs = 0; for (int b = 0; b < 24; ++b) { rsL[b] = rs; rs += (int)((gcnt[b] + 255u) & ~255u); } rsL[24] = rs; }
    __syncthreads();
    const int gw = F.vcu * NWAVES + F.wave, NGW = F.G * NWAVES;
    const int gt = gw * 64 + F.lane, NGT = NGW * 64;
    for (int t = gt; t < F.ntok; t += NGT) { const int b = MB[t], prow = rsL[b] + MPp[t]; PTOK[prow] = t; PRS[prow] = MRS[t]; PCL[prow] = MCL[t]; PCH[prow] = MCH[t]; }
    for (int b = 0; b < 24; ++b) { const int c = (int)gcnt[b], p0 = rsL[b] + c, p1 = rsL[b + 1];
        for (int r = p0 + gt; r < p1; r += NGT) { PTOK[r] = -1; PRS[r] = 0.f; PCL[r] = 0.f; PCH[r] = 0.f; } }
}
template <bool GATHER_> struct MoeOrder {
    static constexpr bool GATHER = GATHER_; const int* ptok;
    int ntile, G, c; const char* A; size_t tA; const char* W; int mode; const LAS unsigned char* tb;
    __device__ bool next(int i, pg8::Unit& u) const {
        const long L = (long)i * G + c; if (L >= (long)ntile * 4) return false;
        u.pm = (int)(L >> 2); u.pn = (int)(L & 3); u.a = GATHER_ ? A : A + (size_t)u.pm * tA;
        const int bk = tb[u.pm], g = bk / 6, pr = bk % 6; const int lo = pr < 3 ? 0 : (pr < 5 ? 1 : 2), hi = pr < 3 ? pr + 1 : (pr < 5 ? pr - 1 : 3);
        const int elo = g * 4 + lo, ehi = g * 4 + hi; u.aux = 0;
        if (mode == 1) { const int e = u.pn < 2 ? elo : ehi; u.b = W + ((size_t)e * 512 + (size_t)(u.pn & 1) * 256) * 1024 * 2; u.bjump = 0; }
        else { u.b = W + ((size_t)elo * 1024 + (size_t)u.pn * 256) * 256 * 2; u.bjump = (long)(ehi - elo) * 1024 * 256 * 2 - 4 * 128; }
        return true;
    }
    __device__ __forceinline__ void a_ready(const pg8::Unit&) const {}
    __device__ __forceinline__ void done(const pg8::Unit&) const {}
};
__device__ __forceinline__ float silu_f(float x) { return x * __builtin_amdgcn_rcpf(1.f + __builtin_amdgcn_exp2f(-1.4426950408889634f * x)); }
struct EpiMoe1 {
    static constexpr bool PERM = true, AFTER_DRAIN = false;
    pg8::bf16_t* ACT; const float* PRS; const float* PCL; const float* PCH;
    __device__ __forceinline__ void operator()(const pg8::f32x4 (&acc)[2][2][4][2], const pg8::Unit& u, int wr, int wc, int fr, int fq) const {
        const int row0 = u.pm * pg8::BM + wr * 64 + fr, slot = u.pn >> 1, fcol0 = slot * 256 + (u.pn & 1) * 128 + wc * 16 + 4 * fq; const float* PC = slot ? PCH : PCL;
#pragma unroll
        for (int ai = 0; ai < 2; ++ai)
#pragma unroll
            for (int m = 0; m < 4; ++m) { const int row = row0 + ai * pg8::HALF + m * 16; const float rs = PRS[row], cw = PC[row]; pg8::bf16_t* rowp = ACT + (size_t)row * 512 + fcol0;
#pragma unroll
                for (int bj = 0; bj < 2; ++bj) { const pg8::f32x4 v0 = acc[ai][bj][m][0], v1 = acc[ai][bj][m][1];
                    const float a0 = silu_f(v0[0] * rs) * (v0[1] * rs) * cw, a1 = silu_f(v0[2] * rs) * (v0[3] * rs) * cw, a2 = silu_f(v1[0] * rs) * (v1[1] * rs) * cw, a3 = silu_f(v1[2] * rs) * (v1[3] * rs) * cw;
                    pg8::u32x2 w; w.x = pg8::cvt_pk_bf16(a0, a1); w.y = pg8::cvt_pk_bf16(a2, a3); *(pg8::u32x2*)(rowp + bj * 64) = w; } }
    }
};
struct EpiMoe2 {
    static constexpr bool PERM = false, AFTER_DRAIN = false;
    float* out; const pg8::bf16_t* h16; const int* PTOK;
    __device__ __forceinline__ void operator()(const pg8::f32x4 (&acc)[2][2][4][2], const pg8::Unit& u, int wr, int wc, int fr, int fq) const {
        const int row0 = u.pm * pg8::BM + wr * 64 + fr, col0 = u.pn * pg8::BM + wc * 32 + 4 * fq;
#pragma unroll
        for (int ai = 0; ai < 2; ++ai)
#pragma unroll
            for (int m = 0; m < 4; ++m) { const int tok = PTOK[row0 + ai * pg8::HALF + m * 16];
                if (tok >= 0) { float* rowp = out + (size_t)tok * 1024 + col0; const pg8::bf16_t* hp = h16 + (size_t)tok * 1024 + col0;
#pragma unroll
                    for (int bj = 0; bj < 2; ++bj)
#pragma unroll
                        for (int n = 0; n < 2; ++n) { const pg8::u32x2 hv = *(const pg8::u32x2*)(hp + bj * pg8::HALF + n * 16); const pg8::f32x4 hf = {pg8::bf_lo(hv.x), pg8::bf_hi(hv.x), pg8::bf_lo(hv.y), pg8::bf_hi(hv.y)};
                            *(pg8::f32x4*)(rowp + bj * pg8::HALF + n * 16) = hf + acc[ai][bj][m][n]; } } }
    }
};
__device__ __forceinline__ int moe_setup(Frame& F, LAS unsigned char* tb) {
    const unsigned* gcnt = (const unsigned*)(F.ws + WS_CTL) + CW_MOE;
    LAS int* nt_ = (LAS int*)(tb + 256);
    __syncthreads();
    if (F.tid == 0) { int tl = 0; for (int b = 0; b < 24; ++b) { const int n = (int)((gcnt[b] + 255u) >> 8); for (int i = 0; i < n; ++i) tb[tl + i] = (unsigned char)b; tl += n; } nt_[0] = tl; }
    __syncthreads();
    return nt_[0];
}

__global__ void __launch_bounds__(NWAVES * 64, 2) mk_fwd(Args args) {
    extern __shared__ __attribute__((aligned(16))) unsigned char lds[];
    Frame F;
    F.lds = (LAS unsigned char*)lds;
    F.tid = threadIdx.x; F.lane = F.tid & 63; F.wave = __builtin_amdgcn_readfirstlane(F.tid >> 6);
    F.G = gridDim.x; { const int bx = blockIdx.x; F.vcu = (F.G % 8 == 0) ? (bx % 8) * (F.G / 8) + bx / 8 : bx; }
    F.ntok = args.ntok; F.ws = args.ws; F.act = args.ws + WS_ACT;
    const int lo = args.ph_lo, hi = args.ph_hi;
    cooperative_groups::grid_group grid = cooperative_groups::this_grid();
    volatile LAS unsigned* MISCW = (volatile LAS unsigned*)(F.lds + MISC_OFF);
    for (int u = F.tid; u < (LDS_BYTES - LDSCTL_OFF) / 4; u += NWAVES * 64) ((LAS unsigned*)(F.lds + LDSCTL_OFF))[u] = 0u;
    __syncthreads();
    XcdBarrier bar = xcd_barrier_post((unsigned*)(F.ws + WS_CTL) + CW_BAR, MISCW + 8);
#define IN(k) (lo <= (k) && (k) < hi)
#define SEAM(k) do { if (IN(k) && IN((k) + 1)) { xcd_barrier(bar); } } while (0)
    if (IN(0)) { p0_prologue(F, args); }
    SEAM(0);
    if (IN(1)) {
        pg8::Gemm g{1024, 1024, 1024, 16};
        pg8::StaticOrder S; S.init(F.ntok, INWP, F.G, (int)blockIdx.x, args.xb, 1024, F.ws + WS_WIN, 1024);
        EpiProj E{F.act, (size_t)F.ntok};
        pg8::gemm_phase<EpiProj, pg8::StaticOrder, true, true>(F.lds + RING_OFF, g, S, E);
    }
    SEAM(1);
    if (IN(2)) { p2_post(F, args); }
    SEAM(2);
    if (IN(3)) { p3_index(F, args); }
    SEAM(3);
    if (IN(4)) { p4_attn(F, args, lds); }
    SEAM(4);
    if (IN(5)) {
        pg8::Gemm g{1024, 1024, 1024, 16}; const size_t nt_ = (size_t)F.ntok;
        pg8::bf16_t* GA = (pg8::bf16_t*)(F.act + nt_ * O_GA); const pg8::bf16_t* GR = (const pg8::bf16_t*)(F.act + nt_ * O_GR);
        { pg8::StaticOrder S; S.init(F.ntok, 1024, F.G, (int)blockIdx.x, F.act + nt_ * O_QA, 1024, F.ws + WS_WATT, 1024); EpiGateA E{GA};
          pg8::gemm_phase<EpiGateA, pg8::StaticOrder, true, true>(F.lds + RING_OFF, g, S, E); }
        { pg8::StaticOrder S; S.init(F.ntok, 1024, F.G, (int)blockIdx.x, F.act + nt_ * O_RV, 1024, F.ws + WS_WRET, 1024); EpiGateB E{GA, GR};
          pg8::gemm_phase<EpiGateB, pg8::StaticOrder, true, true>(F.lds + RING_OFF, g, S, E); }
    }
    SEAM(5);
    if (IN(6)) {
        pg8::Gemm g{1024, 1024, 1024, 16}; const size_t nt_ = (size_t)F.ntok;
        pg8::StaticOrder S; S.init(F.ntok, 1024, F.G, (int)blockIdx.x, F.act + nt_ * O_GA, 1024, F.ws + WS_WOUT, 1024);
        EpiResid E{args.in[0] + (size_t)args.tok0 * D, (pg8::bf16_t*)(F.act + MO_H16)};
        pg8::gemm_phase<EpiResid, pg8::StaticOrder, true, true>(F.lds + RING_OFF, g, S, E);
    }
    SEAM(6);
    if (IN(7)) { p7_router(F, args); }
    SEAM(7);
    if (IN(8)) { p8_permute(F, args); }
    SEAM(8);
    if (IN(9)) {
        LAS unsigned char* tb = F.lds + LDSCTL_OFF - 1024; const int ntile = moe_setup(F, tb);
        unsigned char* meta = F.act + MO_META;
        pg8::Gemm g{1024, 1024, 1024, 16};
        MoeOrder<true> S{(const int*)(meta + MM_PTOK), ntile, F.G, (int)blockIdx.x, (const char*)(F.act + MO_N2), (size_t)256 * 1024 * 2, (const char*)(F.ws + WS_W1), 1, tb};
        EpiMoe1 E{(pg8::bf16_t*)(F.act + MO_ACT), (const float*)(meta + MM_PRS), (const float*)(meta + MM_PCL), (const float*)(meta + MM_PCH)};
        pg8::gemm_phase<EpiMoe1, MoeOrder<true>, true, true>(F.lds + RING_OFF, g, S, E);
    }
    SEAM(9);
    if (IN(10)) {
        LAS unsigned char* tb = F.lds + LDSCTL_OFF - 1024; const int ntile = moe_setup(F, tb);
        unsigned char* meta = F.act + MO_META;
        pg8::Gemm g{512, 512, 256, 4};
        MoeOrder<false> S{nullptr, ntile, F.G, (int)blockIdx.x, (const char*)(F.act + MO_ACT), (size_t)256 * 512 * 2, (const char*)(F.ws + WS_WD), 2, tb};
        EpiMoe2 E{args.out + (size_t)args.tok0 * D, (const pg8::bf16_t*)(F.act + MO_H16), (const int*)(meta + MM_PTOK)};
        pg8::gemm_phase<EpiMoe2, MoeOrder<false>, true, true>(F.lds + RING_OFF, g, S, E);
    }
    if (hi - lo > 1) grid.sync();
#undef IN
#undef SEAM
}

__device__ __forceinline__ float block_sum256(float v, float* red) {
#pragma unroll
    for (int o = 32; o > 0; o >>= 1) v += __shfl_xor(v, o);
    __syncthreads();
    if ((threadIdx.x & 63) == 0) red[threadIdx.x >> 6] = v;
    __syncthreads();
    return red[0] + red[1] + red[2] + red[3];
}
__device__ __forceinline__ float block_max256(float v, float* red) {
#pragma unroll
    for (int o = 32; o > 0; o >>= 1) v = fmaxf(v, __shfl_xor(v, o));
    __syncthreads();
    if ((threadIdx.x & 63) == 0) red[threadIdx.x >> 6] = v;
    __syncthreads();
    return fmaxf(fmaxf(red[0], red[1]), fmaxf(red[2], red[3]));
}
__device__ __forceinline__ float sigmoidf_(float x) { return 1.f / (1.f + expf(-x)); }
__device__ __forceinline__ float siluf_(float x) { return x / (1.f + expf(-x)); }

__global__ void __launch_bounds__(256) nv_rmsnorm(const float* inb, long in_ld, float* outb, long out_ld, int ninner, int width, const float* gain, int gstride) {
    __shared__ float red[8];
    const int r = blockIdx.x, t = r / ninner, i = r % ninner;
    const float* in = inb + (long)t * in_ld + (long)i * width;
    float* out = outb + (long)t * out_ld + (long)i * width;
    float s = 0.f;
    for (int c = threadIdx.x; c < width; c += 256) { const float v = in[c]; s += v * v; }
    s = block_sum256(s, red);
    const float rs = rsqrtf(s / (float)width + EPS);
    for (int c = threadIdx.x; c < width; c += 256) out[c] = in[c] * rs * gain[i * gstride + c];
}
__global__ void __launch_bounds__(256) nv_gemm(const float* A, long lda, const float* B, long ldb, float* C, long ldc, int M, int N, int K) {
    __shared__ float As[8][128 + 4];
    __shared__ float Bs[8][128 + 4];
    const int tid = threadIdx.x, tx = tid & 15, ty = tid >> 4;
    const int m0 = blockIdx.y * 128, n0 = blockIdx.x * 128;
    float acc[8][8];
#pragma unroll
    for (int i = 0; i < 8; ++i)
#pragma unroll
        for (int j = 0; j < 8; ++j) acc[i][j] = 0.f;
    for (int k0 = 0; k0 < K; k0 += 8) {
        { const int r = tid >> 1, kk = (tid & 1) * 4;
          const float4 v = *(const float4*)(A + (long)(m0 + r) * lda + k0 + kk);
          As[kk + 0][r] = v.x; As[kk + 1][r] = v.y; As[kk + 2][r] = v.z; As[kk + 3][r] = v.w; }
        { const int kk = tid >> 5, c = (tid & 31) * 4;
#pragma unroll
          for (int j = 0; j < 4; ++j) { const int n = n0 + c + j; Bs[kk][c + j] = (n < N) ? B[(long)(k0 + kk) * ldb + n] : 0.f; } }
        __syncthreads();
#pragma unroll
        for (int kk = 0; kk < 8; ++kk) {
            float a[8], b[8];
#pragma unroll
            for (int i = 0; i < 8; ++i) a[i] = As[kk][ty * 8 + i];
#pragma unroll
            for (int j = 0; j < 8; ++j) b[j] = Bs[kk][tx * 8 + j];
#pragma unroll
            for (int i = 0; i < 8; ++i)
#pragma unroll
                for (int j = 0; j < 8; ++j) acc[i][j] += a[i] * b[j];
        }
        __syncthreads();
    }
#pragma unroll
    for (int i = 0; i < 8; ++i)
#pragma unroll
        for (int j = 0; j < 8; ++j) { const int n = n0 + tx * 8 + j; if (n < N) C[(long)(m0 + ty * 8 + i) * ldc + n] = acc[i][j]; }
}
__global__ void __launch_bounds__(256) nv_attn(const float* proj, const float* kv, float* att, float wscale, float dscale, float lscale, const unsigned* maskb) {
    __shared__ float s_qi[512], s_w[8], s_score[2048], s_q[1024], s_p[8][256], red[8];
    __shared__ int s_sel[256 + 64]; __shared__ int s_pref[65]; __shared__ unsigned s_mw[64];
    const int tq = blockIdx.x, b = tq / SEQ, t = tq % SEQ, tid = threadIdx.x;
    const float* prow = proj + (long)tq * INW;
    const float* pb = proj + (long)b * SEQ * INW;
    const float* kvb = kv + (long)b * SEQ * 256;
    for (int i = tid; i < 512; i += 256) s_qi[i] = prow[C_QI + i];
    for (int i = tid; i < 1024; i += 256) s_q[i] = prow[C_QA + i];
    if (tid < 8) s_w[tid] = prow[C_WI + tid] * wscale;
    __syncthreads();
    const int n = t + 1;
    int cnt;
    if (maskb) {
        if (tid < 64) s_mw[tid] = (tid * 32 <= t) ? maskb[tid * 2048 + t] : 0u;
        __syncthreads();
        if (tid == 0) { int c = 0; for (int i = 0; i < 64; ++i) { s_pref[i] = c; c += __builtin_popcount(s_mw[i]); } s_pref[64] = c; }
        __syncthreads();
        if (tid < 64) { unsigned x = s_mw[tid]; int p = s_pref[tid]; while (x) { const int bpos = __builtin_ctz(x); x &= x - 1; if (p < 256) s_sel[p] = tid * 32 + bpos; ++p; } }
        cnt = s_pref[64] < 256 ? s_pref[64] : 256;
        __syncthreads();
    } else {
    for (int s = tid; s < n; s += 256) {
        const float* kr = pb + (long)s * INW + C_KI;
        float kk[64];
#pragma unroll
        for (int d = 0; d < 64; ++d) kk[d] = kr[d];
        float sc = 0.f;
#pragma unroll
        for (int h = 0; h < 8; ++h) {
            float dt = 0.f;
#pragma unroll
            for (int d = 0; d < 64; ++d) dt += s_qi[h * 64 + d] * kk[d];
            dt *= dscale;
            sc += fmaxf(dt, 0.f) * s_w[h];
        }
        s_score[s] = sc;
    }
    __syncthreads();
    if (n <= 256) { if (tid < n) s_sel[tid] = tid; cnt = n; }
    else {
        for (int s = tid; s < n; s += 256) {
            const float v = s_score[s]; int rank = 0;
            for (int j = 0; j < n; ++j) { const float u = s_score[j]; rank += (u > v || (u == v && j < s)) ? 1 : 0; }
            if (rank < 256) s_sel[rank] = s;
        }
        cnt = 256;
    }
    __syncthreads();
    }
    float lg[8];
    const bool act = tid < cnt;
    const int sj = act ? s_sel[tid] : 0;
    {
        const float* kr = kvb + (long)sj * 256;
#pragma unroll
        for (int h = 0; h < 8; ++h) lg[h] = 0.f;
        for (int d = 0; d < 128; ++d) { const float kd = kr[d];
#pragma unroll
            for (int h = 0; h < 8; ++h) lg[h] += s_q[h * 128 + d] * kd; }
    }
#pragma unroll
    for (int h = 0; h < 8; ++h) {
        const float slope = exp2f(-(float)(h + 1));
        float x = act ? (lg[h] * lscale - slope * (float)(t - sj)) : -INFINITY;
        const float m = block_max256(x, red);
        const float e = act ? expf(x - m) : 0.f;
        const float su = block_sum256(e, red);
        s_p[h][tid] = e / su;
    }
    __syncthreads();
    float o4[4] = {0.f, 0.f, 0.f, 0.f};
    for (int j = 0; j < cnt; ++j) {
        const float* vr = kvb + (long)s_sel[j] * 256 + 128;
#pragma unroll
        for (int i = 0; i < 4; ++i) { const int o = tid + 256 * i; o4[i] += s_p[o >> 7][j] * vr[o & 127]; }
    }
#pragma unroll
    for (int i = 0; i < 4; ++i) att[(long)tq * 1024 + tid + 256 * i] = o4[i];
}
__global__ void __launch_bounds__(256) nv_ret(const float* proj, float* reto) {
    __shared__ float sq[128], sk[128];
    const int b = blockIdx.x >> 2, h = blockIdx.x & 3, v = threadIdx.x;
    const float gamma = 1.f - exp2f(-5.f - (float)h);
    float S[128];
#pragma unroll
    for (int d = 0; d < 128; ++d) S[d] = 0.f;
    for (int t = 0; t < SEQ; ++t) {
        const float* row = proj + (long)(b * SEQ + t) * INW;
        if (v < 128) { sq[v] = row[C_RQ + h * 128 + v]; sk[v] = row[C_RK + h * 128 + v] * 0.08838834764831845f; }
        __syncthreads();
        const float vv = row[C_RV + h * 256 + v];
        float o = 0.f;
#pragma unroll
        for (int d = 0; d < 128; ++d) { S[d] = gamma * S[d] + sk[d] * vv; o += sq[d] * S[d]; }
        reto[(long)(b * SEQ + t) * 1024 + h * 256 + v] = o;
        __syncthreads();
    }
}
__global__ void __launch_bounds__(256) nv_retpost(const float* proj, const float* reto, const float* g, float* a2) {
    __shared__ float red[8];
    const int t = blockIdx.x >> 2, h = blockIdx.x & 3, c = threadIdx.x;
    const float x = reto[(long)t * 1024 + h * 256 + c];
    const float mu = block_sum256(x, red) * (1.f / 256.f);
    const float dv = x - mu;
    const float var = block_sum256(dv * dv, red) * (1.f / 256.f);
    const float y = dv * rsqrtf(var + EPS) * g[h * 256 + c];
    a2[(long)t * 1024 + h * 256 + c] = siluf_(proj[(long)t * INW + C_RG + h * 256 + c]) * y;
}
__global__ void __launch_bounds__(256) nv_mix(const float* proj, const float* ya, const float* yr, float* mix) {
    const long i = (long)blockIdx.x * 256 + threadIdx.x; const long t = i >> 10; const int c = (int)(i & 1023);
    mix[i] = sigmoidf_(proj[t * INW + C_GA + c]) * ya[i] + sigmoidf_(proj[t * INW + C_GR + c]) * yr[i];
}
__global__ void __launch_bounds__(256) nv_add(const float* a, const float* b, float* o) {
    const long i = (long)blockIdx.x * 256 + threadIdx.x; o[i] = a[i] + b[i];
}
__global__ void __launch_bounds__(256) nv_moe(const float* n2, float* hio, const float* wgr, const float* bgr, const float* wer, const float* ber,
                                              const float* wg, const float* wu, const float* wd) {
    __shared__ float s_n[1024], s_lg[20], s_act[256], s_p[2];
    __shared__ int s_e[2];
    const int t = blockIdx.x, tid = threadIdx.x;
    for (int i = tid; i < 1024; i += 256) s_n[i] = n2[(long)t * 1024 + i];
    __syncthreads();
    if (tid < 20) {
        float a = 0.f;
        if (tid < 4) { for (int d = 0; d < 1024; ++d) a += s_n[d] * wgr[d * 4 + tid]; a += bgr[tid]; }
        else { const int e = tid - 4; for (int d = 0; d < 1024; ++d) a += s_n[d] * wer[d * 16 + e]; a += ber[e]; }
        s_lg[tid] = a;
    }
    __syncthreads();
    if (tid == 0) {
        int g = 0; float m = s_lg[0];
        for (int i = 1; i < 4; ++i) if (s_lg[i] > m) { m = s_lg[i]; g = i; }
        float se = 0.f; for (int i = 0; i < 4; ++i) se += expf(s_lg[i] - m);
        const float gw = 1.f / se;
        const float* el = s_lg + 4 + g * 4;
        int i1 = 0; for (int i = 1; i < 4; ++i) if (el[i] > el[i1]) i1 = i;
        int i2 = -1; for (int i = 0; i < 4; ++i) if (i != i1 && (i2 < 0 || el[i] > el[i2])) i2 = i;
        const float e2 = expf(el[i2] - el[i1]);
        s_p[0] = gw / (1.f + e2); s_p[1] = gw * e2 / (1.f + e2);
        s_e[0] = g * 4 + i1; s_e[1] = g * 4 + i2;
    }
    __syncthreads();
    float acc[4] = {0.f, 0.f, 0.f, 0.f};
    for (int sl = 0; sl < 2; ++sl) {
        const int e = s_e[sl]; const float p = s_p[sl];
        const float* g_ = wg + (long)e * 1024 * 256 + tid; const float* u_ = wu + (long)e * 1024 * 256 + tid;
        float hg = 0.f, hu = 0.f;
        for (int d = 0; d < 1024; ++d) { hg += s_n[d] * g_[(long)d * 256]; hu += s_n[d] * u_[(long)d * 256]; }
        __syncthreads();
        s_act[tid] = siluf_(hg) * hu * p;
        __syncthreads();
        const float* d_ = wd + (long)e * 256 * 1024;
        for (int f = 0; f < 256; ++f) { const float a = s_act[f];
#pragma unroll
            for (int i = 0; i < 4; ++i) acc[i] += a * d_[(long)f * 1024 + tid + 256 * i]; }
    }
#pragma unroll
    for (int i = 0; i < 4; ++i) hio[(long)t * 1024 + tid + 256 * i] += acc[i];
}
__global__ void __launch_bounds__(256) ad_proj(const unsigned char* act, int ntok, int tok_lo, float* PROJ) {
    const int t = blockIdx.x; const size_t tg = (size_t)(tok_lo + t); const size_t nt = (size_t)ntok;
    const bf16* QA = (const bf16*)(act + nt * O_QA) + tg * 1024; const bf16* CKV = (const bf16*)(act + nt * O_CKV) + tg * 256; const bf16* QI = (const bf16*)(act + nt * O_QI) + tg * 512;
    const bf16* KW = (const bf16*)(act + nt * O_KW) + tg * 128; const bf16* RQ = (const bf16*)(act + nt * O_RQ) + tg * 512; const bf16* RK = (const bf16*)(act + nt * O_RK) + tg * 512;
    const bf16* R4 = (const bf16*)(act + nt * O_RV);
    float* o = PROJ + (size_t)t * INW;
    for (int c = threadIdx.x; c < INW; c += 256) {
        bf16 v;
        if (c < C_CKV) v = QA[c]; else if (c < C_QI) v = CKV[c - C_CKV]; else if (c < C_KI) v = QI[c - C_QI]; else if (c < C_RQ) v = KW[c - C_KI];
        else if (c < C_RK) v = RQ[c - C_RQ]; else if (c < C_RV) v = RK[c - C_RK];
        else { const int cc = c - C_RV; v = R4[(size_t)(cc >> 10) * nt * 1024 + tg * 1024 + (cc & 1023)]; }
        o[c] = bf2f(v);
    }
}


__global__ void __launch_bounds__(256) ad_kv(const unsigned char* aux, int ntok, int tok_lo, float* KV, float* PROJ) {
    const int t = blockIdx.x; const size_t tg = (size_t)(tok_lo + t); const size_t nt = (size_t)ntok; const int c = threadIdx.x;
    const bf16* KP = (const bf16*)(aux + nt * AUX_KP) + tg * 128; const bf16* VV = (const bf16*)(aux + nt * AUX_VV) + tg * 128; const bf16* KIN = (const bf16*)(aux + nt * AUX_KIN) + tg * 64;
    KV[(size_t)t * 256 + c] = bf2f(c < 128 ? KP[c] : VV[c - 128]);
    if (c < 64) PROJ[(size_t)t * INW + C_KI + c] = bf2f(KIN[c]);
}
__global__ void __launch_bounds__(256) nv_fill(float* p, float v, int n) { const int i = blockIdx.x * 256 + threadIdx.x; if (i < n) p[i] = v; }


__global__ void __launch_bounds__(256) ad_att(const unsigned char* act, int ntok, int tok_lo, float* ATT) {
    const int t = blockIdx.x; const bf16* A = (const bf16*)(act + (size_t)ntok * O_QA) + (size_t)(tok_lo + t) * 1024;
    for (int c = threadIdx.x; c < 1024; c += 256) ATT[(size_t)t * 1024 + c] = bf2f(A[c]);
}


__global__ void __launch_bounds__(256) ad_a2(const unsigned char* act, int ntok, int tok_lo, float* A2) {
    const int t = blockIdx.x; const bf16* A = (const bf16*)(act + (size_t)ntok * O_RV) + (size_t)(tok_lo + t) * 1024;
    for (int c = threadIdx.x; c < 1024; c += 256) A2[(size_t)t * 1024 + c] = bf2f(A[c]);
}

static void gemm(hipStream_t st, const float* A, long lda, const float* B, long ldb, float* C, long ldc, int M, int N, int K) {
    hipLaunchKernelGGL(nv_gemm, dim3((N + 127) / 128, M / 128), dim3(256), 0, st, A, lda, B, ldb, C, ldc, M, N, K);
}

extern "C" void kernel_launch(void* const* d_in, const int* in_sizes, int n_in, void* d_out, int out_size, void* d_ws, size_t ws_size, hipStream_t stream) {
    static int grid = 0;
    if (grid == 0) {
        int dev = 0, cus = 0, per_cu = 0;
        (void)hipGetDevice(&dev); (void)hipDeviceGetAttribute(&cus, hipDeviceAttributeMultiprocessorCount, dev);
        if (hipFuncSetAttribute((const void*)mk_fwd, hipFuncAttributeMaxDynamicSharedMemorySize, LDS_BYTES) != hipSuccess) { fprintf(stderr, "kernel_launch: hipFuncSetAttribute failed\n"); grid = -1; return; }
        (void)hipOccupancyMaxActiveBlocksPerMultiprocessor(&per_cu, (const void*)mk_fwd, NWAVES * 64, LDS_BYTES);
        (void)hipGetLastError();
        if (per_cu < 1) { fprintf(stderr, "kernel_launch: occupancy query says %d blocks per CU\n", per_cu); per_cu = 1; }
        grid = cus * per_cu;
        if (n_in != 20 || ws_size < (size_t)512 * MiB) { fprintf(stderr, "kernel_launch: unexpected n_in %d / ws_size %zu\n", n_in, ws_size); grid = -1; return; }
    }
    if (grid < 0) return;
    const float* x = (const float*)d_in[0];
    const float* kv_norm_g = (const float*)d_in[3]; const float* w_kv_up = (const float*)d_in[4]; const float* q_norm_g = (const float*)d_in[5];
    const float* k_norm_g = (const float*)d_in[6]; const float* idx_k_norm_g = (const float*)d_in[7]; const float* ret_norm_g = (const float*)d_in[8];
    const float* w_att = (const float*)d_in[9]; const float* w_ret = (const float*)d_in[10]; const float* w_out = (const float*)d_in[11];
    const float* norm2_g = (const float*)d_in[12]; const float* w_gr = (const float*)d_in[13]; const float* b_gr = (const float*)d_in[14];
    const float* w_er = (const float*)d_in[15]; const float* b_er = (const float*)d_in[16]; const float* w_eg = (const float*)d_in[17];
    const float* w_eu = (const float*)d_in[18]; const float* w_ed = (const float*)d_in[19];
    float* out = (float*)d_out;
    unsigned char* ws = (unsigned char*)d_ws;
    if (ws_size < WS_ACT + (size_t)T * O_END) { fprintf(stderr, "kernel_launch: workspace too small\n"); return; }
    (void)x; (void)kv_norm_g; (void)w_kv_up; (void)q_norm_g; (void)k_norm_g; (void)idx_k_norm_g; (void)ret_norm_g; (void)w_att; (void)w_ret; (void)w_out; (void)norm2_g; (void)w_gr; (void)b_gr; (void)w_er; (void)b_er; (void)w_eg; (void)w_eu; (void)w_ed;
    (void)hipMemsetAsync(ws + WS_CTL, 0, CTL_ZERO_BYTES, stream);
    Args a{};
    for (int i = 0; i < 20; ++i) a.in[i] = (const float*)d_in[i];
    a.out = out; a.ws = ws; a.xb = (unsigned char*)d_out; a.ntok = T; a.tok0 = 0;
    void* kargs[] = {(void*)&a};
    if (PROBE_PH >= 0) { a.ph_lo = PROBE_PH; a.ph_hi = PROBE_PH + 1; a.mode = PROBE_MODE;
        (void)hipLaunchCooperativeKernel((const void*)mk_fwd, dim3(grid), dim3(NWAVES * 64), kargs, (unsigned)LDS_BYTES, stream);
        (void)hipMemsetAsync(ws + WS_CTL, 0, CTL_ZERO_BYTES, stream); }
    a.ph_lo = 0; a.ph_hi = 11; a.mode = 0;
    const hipError_t le = hipLaunchCooperativeKernel((const void*)mk_fwd, dim3(grid), dim3(NWAVES * 64), kargs, (unsigned)LDS_BYTES, stream);
    if (le != hipSuccess) fprintf(stderr, "kernel_launch: cooperative launch failed: %s (grid %d)\n", hipGetErrorString(le), grid);
}
```

```cpp
#include <hip/hip_runtime.h>
#include <hip/hip_cooperative_groups.h>
#include <cstdio>
#include <cstdint>

namespace pg8 {
#define PG8_LAS __attribute__((address_space(3)))
typedef unsigned short bf16_t;
typedef short bf16x8 __attribute__((ext_vector_type(8)));
typedef float f32x4 __attribute__((ext_vector_type(4)));
typedef unsigned u32x4 __attribute__((ext_vector_type(4)));
typedef unsigned u32x2 __attribute__((ext_vector_type(2)));
typedef int v4i_t __attribute__((ext_vector_type(4)));
typedef int v8i_t __attribute__((ext_vector_type(8)));
constexpr int BM = 256, BK = 64, HALF = 128, HTB = HALF * BK * 2  , STAGE_BYTES = 8 * HTB, NXCD = 8, WGM = 8;

__host__ __device__ __forceinline__ int lds_byte(int r, int c) { const int st = (r >> 4) * 2 + (c >> 5), rr = r & 15, cc = c & 31, ob = rr * 64 + cc * 2; return st * 1024 + (ob ^ (((ob >> 9) & 1) << 5)); }
__host__ __device__ __forceinline__ void stage_rc(int b, int& R, int& C) { const int st = b / 1024, sb = b % 1024, swz = sb ^ (((sb >> 9) & 1) << 5); R = (st >> 1) * 16 + swz / 64; C = (st & 1) * 32 + (swz % 64) / 2; }
__host__ __device__ __forceinline__ int perm32(int rho) { const int n = rho >> 4, i = rho & 15; return 8 * (i >> 2) + 4 * n + (i & 3); }

struct Unit { int pm, pn; const char* a; const char* b; long bjump; int aux; };
struct Gemm { int K, lda, ldb, ksplit; };

struct StaticOrder {
    static constexpr bool GATHER = false; const int* ptok = nullptr;
    int nM, nN, nwg, G, c; const char* A; const char* Bt; size_t tA, tB;
    __device__ void init(int M, int N, int G_, int c_, const void* A_, int lda, const void* Bt_, int ldb) { nM = M / BM; nN = N / BM; nwg = nM * nN; G = G_; c = c_; A = (const char*)A_; Bt = (const char*)Bt_; tA = (size_t)BM * lda * 2; tB = (size_t)BM * ldb * 2; }
    __device__ bool next(int i, Unit& u) const {
        const long L = (long)i * G + c; if (L >= nwg) return false;
        int wgid = (int)L; { const int q = nwg / NXCD, r = nwg % NXCD, xcd = wgid % NXCD, off = wgid / NXCD; wgid = (xcd < r ? xcd * (q + 1) : r * (q + 1) + (xcd - r) * q) + off; }
        const int nig = WGM * nN, gid = wgid / nig, fm = gid * WGM, gsz = (nM - fm) < WGM ? (nM - fm) : WGM;
        u.pm = fm + ((wgid % nig) % gsz); u.pn = (wgid % nig) / gsz; u.a = A + (size_t)u.pm * tA; u.b = Bt + (size_t)u.pn * tB; u.bjump = 0; u.aux = 0; return true;
    }
    __device__ __forceinline__ void a_ready(const Unit&) const {}
    __device__ __forceinline__ void done(const Unit&) const {}
};

typedef float f32x2c __attribute__((ext_vector_type(2))); typedef __bf16 bf16x2c __attribute__((ext_vector_type(2)));
__device__ __forceinline__ unsigned cvt_pk_bf16(float lo, float hi) { const f32x2c v = {lo, hi}; const bf16x2c b = __builtin_convertvector(v, bf16x2c); return __builtin_bit_cast(unsigned, b); }
__device__ __forceinline__ float bf_lo(unsigned w) { return __uint_as_float(w << 16); }
__device__ __forceinline__ float bf_hi(unsigned w) { return __uint_as_float(w & 0xffff0000u); }


template <class Epi, class Sched, bool ALIGN_EPI = false, bool SP2 = false, bool FP8 = false>
__device__ __forceinline__ void gemm_phase(PG8_LAS unsigned char* lds, const Gemm g, const Sched& S, const Epi& E) {
    int tid = threadIdx.x; asm volatile("" : "+v"(tid));
    const int wid = __builtin_amdgcn_readfirstlane(tid >> 6), lane = tid & 63, wr = wid >> 2, wc = wid & 3, fr = lane & 15, fq = lane >> 4;
    const int K = g.K, nt = K / BK;
    unsigned voffA[2], voffB[2]; int gR[2]; unsigned gC[2];
#pragma unroll
    for (int i = 0; i < 2; ++i) { int R, C; stage_rc(tid * 16 + i * 8192, R, C); const int Rb = Epi::PERM ? ((R & ~31) + perm32(R & 31)) : R; gR[i] = R; gC[i] = (unsigned)C * 2u;
        voffA[i] = (unsigned)(R * g.lda + C) * 2u; voffB[i] = (unsigned)(Rb * g.ldb + C) * 2u; }
    unsigned gA0[2] = {0u, 0u}, gA1[2] = {0u, 0u}, gN0[2] = {0u, 0u}, gN1[2] = {0u, 0u};
#define PG8_GOFF(u_, o0, o1) do { _Pragma("unroll") for (int i_ = 0; i_ < 2; ++i_) { int t0_ = S.ptok[(u_).pm * BM + gR[i_]], t1_ = S.ptok[(u_).pm * BM + HALF + gR[i_]]; t0_ = t0_ < 0 ? 0 : t0_; t1_ = t1_ < 0 ? 0 : t1_; \
        o0[i_] = (unsigned)t0_ * (unsigned)(g.lda * 2) + gC[i_]; o1[i_] = (unsigned)t1_ * (unsigned)(g.lda * 2) + gC[i_]; } } while (0)
    const size_t kstep = (size_t)(BK * 2);
    const size_t hstepA = Sched::GATHER ? (size_t)0 : (size_t)HALF * g.lda * 2, hstepB = (size_t)HALF * g.ldb * 2;
    const unsigned ldsw = (unsigned)wid * 1024u;
    const int aoff = lds_byte(wr * 64 + fr, fq * 8), boff = lds_byte(wc * 32 + fr, fq * 8);
#define PG8_CAT(x0, x1) __builtin_shufflevector(__builtin_bit_cast(v4i_t, x0), __builtin_bit_cast(v4i_t, x1), 0, 1, 2, 3, 4, 5, 6, 7)
#define PG8_SA(b, h) (((b) * 2 + (h)) * HTB)
#define PG8_SB(b, h) ((4 + (b) * 2 + (h)) * HTB)
#define PG8_STAGE(bufoff, gbase, voff) do { _Pragma("unroll") for (int _i = 0; _i < 2; ++_i) \
        __builtin_amdgcn_global_load_lds((const unsigned*)((const char*)(gbase) + (voff)[_i]), (PG8_LAS unsigned*)(lds + (bufoff) + ldsw + _i * 8192), 16, 0, 0); } while (0)
#define PG8_LDA(dst, b, h) do { if constexpr (FP8) { _Pragma("unroll") for (int m = 0; m < 4; ++m) dst##8[m] = PG8_CAT(*(const PG8_LAS bf16x8*)(lds + PG8_SA(b, h) + aoff + m * 2048), *(const PG8_LAS bf16x8*)(lds + PG8_SA(b, h) + aoff + m * 2048 + 1024)); } \
      else { _Pragma("unroll") for (int m = 0; m < 4; ++m) _Pragma("unroll") for (int k = 0; k < 2; ++k) dst[m][k] = *(const PG8_LAS bf16x8*)(lds + PG8_SA(b, h) + aoff + m * 2048 + k * 1024); } } while (0)
#define PG8_LDB(dst, b, h) do { if constexpr (FP8) { _Pragma("unroll") for (int n = 0; n < 2; ++n) dst##8[n] = PG8_CAT(*(const PG8_LAS bf16x8*)(lds + PG8_SB(b, h) + boff + n * 2048), *(const PG8_LAS bf16x8*)(lds + PG8_SB(b, h) + boff + n * 2048 + 1024)); } \
      else { _Pragma("unroll") for (int n = 0; n < 2; ++n) _Pragma("unroll") for (int k = 0; k < 2; ++k) dst[n][k] = *(const PG8_LAS bf16x8*)(lds + PG8_SB(b, h) + boff + n * 2048 + k * 1024); } } while (0)
#define PG8_MMA(ai, bj, At, Bt) do { __builtin_amdgcn_s_setprio(1); if constexpr (FP8) { _Pragma("unroll") for (int m = 0; m < 4; ++m) _Pragma("unroll") for (int n = 0; n < 2; ++n) \
        asm volatile("v_mfma_scale_f32_16x16x128_f8f6f4 %0, %1, %2, %0, %3, %4 op_sel_hi:[0,0,0]" : "+v"(acc[ai][bj][m][n]) : "v"(Bt##8[n]), "v"(At##8[m]), "v"(scw8), "v"(sca8)); } \
      else { _Pragma("unroll") for (int m = 0; m < 4; ++m) _Pragma("unroll") for (int n = 0; n < 2; ++n) _Pragma("unroll") for (int k = 0; k < 2; ++k) \
        acc[ai][bj][m][n] = __builtin_amdgcn_mfma_f32_16x16x32_bf16(Bt[n][k], At[m][k], acc[ai][bj][m][n], 0, 0, 0); } __builtin_amdgcn_s_setprio(0); } while (0)
#define PG8_WAIT_V(n) asm volatile("s_waitcnt vmcnt(" #n ")" ::: "memory")
#define PG8_WAIT_L(n) asm volatile("s_waitcnt lgkmcnt(" #n ")" ::: "memory")
#define PG8_BAR __builtin_amdgcn_s_barrier()
#define PG8_SCHED __builtin_amdgcn_sched_barrier(0)
    Unit cur, nxt; int ui = 0;
    if (!S.next(0, cur)) return;
    f32x4 acc[2][2][4][2];
#pragma unroll
    for (int a = 0; a < 2; ++a)
#pragma unroll
        for (int b = 0; b < 2; ++b)
#pragma unroll
            for (int m = 0; m < 4; ++m)
#pragma unroll
                for (int n = 0; n < 2; ++n) acc[a][b][m][n] = (f32x4){0.f, 0.f, 0.f, 0.f};
    int scw8 = 122, sca8 = 127; asm volatile("" : "+v"(scw8), "+v"(sca8));
    bf16x8 At[4][2], B0[2][2], B1[2][2]; v8i_t At8[4], B08[2], B18[2];
    const char* cA = cur.a; const char* cB = cur.b; long cJ = cur.bjump;
    S.a_ready(cur);
    if constexpr (SP2) {
        if constexpr (Sched::GATHER) PG8_GOFF(cur, gA0, gA1);
        PG8_STAGE(PG8_SB(0, 0), cB, voffB); PG8_STAGE(PG8_SB(0, 1), cB + hstepB, voffB); do { if constexpr (Sched::GATHER) { PG8_STAGE(PG8_SA(0, 0), cA, gA0); } else { PG8_STAGE(PG8_SA(0, 0), cA, voffA); } } while (0); do { if constexpr (Sched::GATHER) { PG8_STAGE(PG8_SA(0, 1), cA, gA1); } else { PG8_STAGE(PG8_SA(0, 1), cA + hstepA, voffA); } } while (0);
        if (wr == 1) PG8_BAR;
        PG8_WAIT_V(2); PG8_BAR;
        PG8_STAGE(PG8_SB(1, 0), cB + kstep, voffB); do { if constexpr (Sched::GATHER) { PG8_STAGE(PG8_SA(1, 0), cA + kstep, gA0); } else { PG8_STAGE(PG8_SA(1, 0), cA + kstep, voffA); } } while (0); PG8_STAGE(PG8_SB(1, 1), cB + hstepB + kstep, voffB);
        PG8_WAIT_V(6); PG8_BAR;
    } else {
        PG8_STAGE(PG8_SB(0, 0), cB, voffB); PG8_STAGE(PG8_SA(0, 0), cA, voffA); PG8_STAGE(PG8_SB(0, 1), cB + hstepB, voffB); PG8_STAGE(PG8_SA(0, 1), cA + hstepA, voffA);
        if (wr == 1) PG8_BAR;
        PG8_WAIT_V(4); PG8_BAR;
        PG8_STAGE(PG8_SB(1, 0), cB + kstep, voffB); PG8_STAGE(PG8_SA(1, 0), cA + kstep, voffA); PG8_STAGE(PG8_SB(1, 1), cB + hstepB + kstep, voffB);
        PG8_WAIT_V(6); PG8_BAR;
    }
    for (;;) {
        const bool has_next = S.next(ui + 1, nxt);
        const char* nA = has_next ? nxt.a : cA; const char* nB = has_next ? nxt.b : cB;
        if constexpr (Sched::GATHER) { if (has_next) PG8_GOFF(nxt, gN0, gN1); else { gN0[0] = gA0[0]; gN0[1] = gA0[1]; gN1[0] = gA1[0]; gN1[1] = gA1[1]; } }
#pragma unroll 1
        for (int t = 0; t < nt; t += 2) {
            const bool last = (t == nt - 2);
            const char* a1 = cA + (size_t)(t + 1) * kstep;
            const char* a2 = last ? nA : cA + (size_t)(t + 2) * kstep; const char* b2 = last ? nB : cB + (size_t)(t + 2) * kstep + ((t + 2) >= g.ksplit ? cJ : 0L);
            const char* a3 = a2 + kstep; const char* b3 = b2 + kstep;
            if (last && has_next) S.a_ready(nxt);
            unsigned x0[2] = {0u, 0u}, x1[2] = {0u, 0u};
            if constexpr (Sched::GATHER) { x0[0] = last ? gN0[0] : gA0[0]; x0[1] = last ? gN0[1] : gA0[1]; x1[0] = last ? gN1[0] : gA1[0]; x1[1] = last ? gN1[1] : gA1[1]; }
            if constexpr (SP2) {
            PG8_LDB(B0, 0, 0); PG8_LDB(B1, 0, 1); PG8_SCHED; PG8_LDA(At, 0, 0); do { if constexpr (Sched::GATHER) { PG8_STAGE(PG8_SA(1, 1), a1, gA1); } else { PG8_STAGE(PG8_SA(1, 1), a1 + hstepA, voffA); } } while (0);
            PG8_WAIT_V(8); PG8_WAIT_L(0); PG8_BAR; PG8_MMA(0, 0, At, B0); PG8_MMA(0, 1, At, B1); PG8_BAR; PG8_SCHED;
            PG8_LDA(At, 0, 1); PG8_STAGE(PG8_SB(0, 0), b2, voffB); PG8_STAGE(PG8_SB(0, 1), b2 + hstepB, voffB); do { if constexpr (Sched::GATHER) { PG8_STAGE(PG8_SA(0, 0), a2, x0); } else { PG8_STAGE(PG8_SA(0, 0), a2, voffA); } } while (0);
            PG8_WAIT_V(8); PG8_WAIT_L(0); PG8_BAR; PG8_MMA(1, 0, At, B0); PG8_MMA(1, 1, At, B1); PG8_BAR; PG8_SCHED;
            PG8_LDB(B0, 1, 0); PG8_LDB(B1, 1, 1); PG8_SCHED; PG8_LDA(At, 1, 0); do { if constexpr (Sched::GATHER) { PG8_STAGE(PG8_SA(0, 1), a2, x1); } else { PG8_STAGE(PG8_SA(0, 1), a2 + hstepA, voffA); } } while (0);
            PG8_WAIT_V(8); PG8_WAIT_L(0); PG8_BAR; PG8_MMA(0, 0, At, B0); PG8_MMA(0, 1, At, B1); PG8_BAR; PG8_SCHED;
            PG8_LDA(At, 1, 1); PG8_STAGE(PG8_SB(1, 0), b3, voffB); PG8_STAGE(PG8_SB(1, 1), b3 + hstepB, voffB); do { if constexpr (Sched::GATHER) { PG8_STAGE(PG8_SA(1, 0), a3, x0); } else { PG8_STAGE(PG8_SA(1, 0), a3, voffA); } } while (0);
            PG8_WAIT_V(8); PG8_WAIT_L(0); PG8_BAR; PG8_MMA(1, 0, At, B0); PG8_MMA(1, 1, At, B1); PG8_BAR; PG8_SCHED;
            } else {
            PG8_LDB(B0, 0, 0); PG8_SCHED; PG8_LDA(At, 0, 0); PG8_STAGE(PG8_SA(1, 1), a1 + hstepA, voffA);
            PG8_WAIT_L(8); PG8_BAR; PG8_WAIT_L(0); PG8_MMA(0, 0, At, B0); PG8_BAR; PG8_SCHED;
            PG8_LDB(B1, 0, 1); PG8_STAGE(PG8_SB(0, 0), b2, voffB);
            PG8_BAR; PG8_WAIT_L(0); PG8_MMA(0, 1, At, B1); PG8_BAR;
            PG8_LDA(At, 0, 1); PG8_STAGE(PG8_SA(0, 0), a2, voffA);
            PG8_BAR; PG8_WAIT_L(0); PG8_MMA(1, 0, At, B0); PG8_BAR; PG8_SCHED;
            PG8_STAGE(PG8_SB(0, 1), b2 + hstepB, voffB);
            PG8_WAIT_V(6); PG8_BAR; PG8_MMA(1, 1, At, B1); PG8_BAR;
            PG8_LDB(B0, 1, 0); PG8_SCHED; PG8_LDA(At, 1, 0); PG8_STAGE(PG8_SA(0, 1), a2 + hstepA, voffA);
            PG8_WAIT_L(8); PG8_BAR; PG8_WAIT_L(0); PG8_MMA(0, 0, At, B0); PG8_BAR; PG8_SCHED;
            PG8_LDB(B1, 1, 1); PG8_STAGE(PG8_SB(1, 0), b3, voffB);
            PG8_BAR; PG8_WAIT_L(0); PG8_MMA(0, 1, At, B1); PG8_BAR;
            PG8_LDA(At, 1, 1); PG8_STAGE(PG8_SA(1, 0), a3, voffA);
            PG8_BAR; PG8_WAIT_L(0); PG8_MMA(1, 0, At, B0); PG8_BAR; PG8_SCHED;
            PG8_STAGE(PG8_SB(1, 1), b3 + hstepB, voffB);
            PG8_WAIT_V(6); PG8_BAR; PG8_MMA(1, 1, At, B1); PG8_BAR;
            }
        }
        if constexpr (ALIGN_EPI) { if (wr == 0) PG8_BAR; }
        if constexpr (!Epi::AFTER_DRAIN) { E(acc, cur, wr, wc, fr, fq); S.done(cur); }
        if (!has_next) break;
#pragma unroll
        for (int a = 0; a < 2; ++a)
#pragma unroll
            for (int b = 0; b < 2; ++b)
#pragma unroll
                for (int m = 0; m < 4; ++m)
#pragma unroll
                    for (int n = 0; n < 2; ++n) acc[a][b][m][n] = (f32x4){0.f, 0.f, 0.f, 0.f};
        cur = nxt; cA = nA; cB = nB; cJ = cur.bjump; ++ui;
        if constexpr (Sched::GATHER) { gA0[0] = gN0[0]; gA0[1] = gN0[1]; gA1[0] = gN1[0]; gA1[1] = gN1[1]; }
        if constexpr (ALIGN_EPI) { if (wr == 1) PG8_BAR; }
    }
    PG8_WAIT_V(0);
    if constexpr (!ALIGN_EPI) { if (wr == 0) PG8_BAR; }
    PG8_BAR;
    if constexpr (Epi::AFTER_DRAIN) { E.fused(acc, cur, wr, wc, fr, fq, lds, wid, lane); S.done(cur); }
#undef PG8_GOFF
#undef PG8_SA
#undef PG8_SB
#undef PG8_STAGE
#undef PG8_LDA
#undef PG8_LDB
#undef PG8_MMA
#undef PG8_CAT
#undef PG8_WAIT_V
#undef PG8_WAIT_L
#undef PG8_BAR
#undef PG8_SCHED
}
}

#ifndef PROBE_PH
#define PROBE_PH (-1)
#endif
#ifndef PROBE_MODE
#define PROBE_MODE (0)
#endif
constexpr int D = 1024, BATCH = 16, SEQ = 2048, T = BATCH * SEQ;
constexpr int INW = 6984, INWP = 7168;
constexpr int C_QA = 0, C_CKV = 1024, C_QI = 1280, C_KI = 1792, C_WI = 1856, C_RQ = 1864, C_RK = 2376, C_RV = 2888, C_RG = 3912, C_GA = 4936, C_GR = 5960;
constexpr float EPS = 1e-6f;
constexpr int NWAVES = 8;

constexpr size_t MiB = 1u << 20;
constexpr size_t WS_CTL = 0, CTL_ZERO_BYTES = 1 * MiB;
constexpr size_t WS_WIN = 1 * MiB, WS_WKV = 15 * MiB, WS_WATT = 16 * MiB, WS_WRET = 18 * MiB, WS_WOUT = 20 * MiB, WS_W1 = 22 * MiB, WS_WD = 38 * MiB, WS_ACT = 46 * MiB;
constexpr size_t O_QA = 0, O_CKV = 2048, O_QI = 2560, O_KW = 3584, O_RQ = 3840, O_RK = 4864, O_RV = 5888, O_RG = 7936, O_GA = 9984, O_GR = 12032, O_END = 14080;

constexpr int MP_ROWS = 38912;
constexpr size_t MO_APERM = 0, MO_ACT = 80 * MiB, MO_N2 = 120 * MiB, MO_META = 184 * MiB;
constexpr size_t MM_B = 0, MM_P = 131072, MM_CL = 262144, MM_CH = 393216, MM_RS = 524288, MM_PTOK = 655360, MM_PRS = 819200, MM_PCL = 983040, MM_PCH = 1146880, MM_END = 1310720;
constexpr size_t WS_WR = 15 * MiB + 512 * 1024;
constexpr size_t MO_H16 = 192 * MiB;
constexpr size_t WS_WIN8 = 488 * MiB;
constexpr size_t AUX_XB8 = 2048 + 896;
constexpr int CW_MOE = 256;
constexpr int RING_OFF = 0, RING_BYTES = 131072, P3_HIST_OFF = 131072, P3_TOT_OFF = 147456, P3_T_OFF = 149504, LDSCTL_OFF = 151552, MISC_OFF = LDSCTL_OFF + 320, LDS_BYTES = 152576;
constexpr int CW_Q3 = 64, CW_Q4 = 128;

#define GAS __attribute__((address_space(1)))
#define LAS __attribute__((address_space(3)))
typedef unsigned short bf16;
typedef unsigned v4u __attribute__((ext_vector_type(4)));
typedef float f32x4 __attribute__((ext_vector_type(4)));
#define LDS_WAIT() asm volatile("s_waitcnt lgkmcnt(0)" ::: "memory")
#define VM_WAIT() asm volatile("s_waitcnt vmcnt(0)" ::: "memory")
__device__ __forceinline__ unsigned f2bf(float f) { unsigned u = __builtin_bit_cast(unsigned, f); return (u + 0x7fffu + ((u >> 16) & 1u)) >> 16; }
__device__ __forceinline__ unsigned pk2(float lo, float hi) { return f2bf(lo) | (f2bf(hi) << 16); }
__device__ __forceinline__ float bf2f(bf16 b) { return __uint_as_float((unsigned)b << 16); }


typedef GAS unsigned gu32;
constexpr int CW_BAR = 4096;
#define XB_TMO      128
#define XB_XCNT(j)  (256  + 64 * (j))
#define XB_XSUB(j)  (1280 + 64 * (j))
#define XB_XGEN(j)  (2304 + 64 * (j))
#define XB_TOP      3328
#define XB_TOPGEN   3392
#define XCD_BAR_WORDS 3456
#define XB_SPIN_CAP (1u << 18)

__device__ __forceinline__ unsigned xb_ld(unsigned* p)              { return __hip_atomic_load(p, __ATOMIC_RELAXED, __HIP_MEMORY_SCOPE_AGENT); }
__device__ __forceinline__ unsigned xb_add(unsigned* p, unsigned v) { return __hip_atomic_fetch_add(p, v, __ATOMIC_RELAXED, __HIP_MEMORY_SCOPE_AGENT); }
__device__ __forceinline__ unsigned xb_xcc_id() { return (unsigned)__builtin_amdgcn_s_getreg((3 << 11) | 20) & 0xFu; }
#define XB_SPIN(cond, bar) do { unsigned _sp = 0; while (cond) { __builtin_amdgcn_s_sleep(1); \
    if ((++_sp & 255u) == 0u) { if (xb_ld(&(bar)[XB_TMO])) break; if (_sp > XB_SPIN_CAP) { atomicAdd(&(bar)[XB_TMO], 1u); break; } } } } while (0)

struct XcdBarrier {
    unsigned* bar; unsigned x;
    volatile LAS unsigned* st;
};

__device__ __forceinline__ XcdBarrier xcd_barrier_post(unsigned* bar, volatile LAS unsigned* st) {
    XcdBarrier b; b.bar = bar; b.x = xb_xcc_id(); b.st = st;
    if (threadIdx.x == 0) (void)xb_add(&bar[XB_XCNT(b.x)], 1u);
    return b;
}
__device__ __forceinline__ void xcd_barrier_complete(unsigned* bar, unsigned x, unsigned& nloc, unsigned& nx) {
    const unsigned G = gridDim.x * gridDim.y * gridDim.z;
    unsigned sum, cnt, mine, sp = 0u;
    for (;;) {
        sum = 0u; cnt = 0u; mine = 0u;
#pragma unroll
        for (unsigned j = 0; j < 16; ++j) { const unsigned c = xb_ld(&bar[XB_XCNT(j)]); sum += c; cnt += (c > 0u) ? 1u : 0u; mine = (j == x) ? c : mine; }
        if (sum == G) break;
        __builtin_amdgcn_s_sleep(1);
        if ((++sp & 255u) == 0u) { if (xb_ld(&bar[XB_TMO])) break; if (sp > XB_SPIN_CAP) { atomicAdd(&bar[XB_TMO], 1u); break; } }
    }
    nloc = mine > 0u ? mine : 1u; nx = cnt > 0u ? cnt : 1u;
}

__device__ __forceinline__ void xcd_barrier(const XcdBarrier& b) {
    asm volatile("s_waitcnt vmcnt(0)" ::: "memory");
    __syncthreads();
    if (threadIdx.x == 0) {
        unsigned* bar = b.bar;
        __builtin_amdgcn_s_waitcnt(0);
        unsigned nloc = b.st[0], nx = b.st[1];
        if (nloc == 0u) { xcd_barrier_complete(bar, b.x, nloc, nx); b.st[0] = nloc; b.st[1] = nx; }
        const unsigned old = xb_add(&bar[XB_XSUB(b.x)], 1u);
        const unsigned gen = old / nloc;
        if (old + 1u == (gen + 1u) * nloc) {
            __builtin_amdgcn_fence(__ATOMIC_RELEASE, "agent");
            asm volatile("s_waitcnt vmcnt(0)" ::: "memory");
            const unsigned og = xb_add(&bar[XB_TOP], 1u);
            const unsigned tg = og / nx;
            if (og + 1u == (tg + 1u) * nx) xb_add(&bar[XB_TOPGEN], 1u);
            else XB_SPIN(xb_ld(&bar[XB_TOPGEN]) == tg, bar);
            __builtin_amdgcn_fence(__ATOMIC_ACQUIRE, "agent");
            xb_add(&bar[XB_XGEN(b.x)], 1u);
            asm volatile("s_waitcnt vmcnt(0)" ::: "memory");
        } else {
            XB_SPIN(xb_ld(&bar[XB_XGEN(b.x)]) == gen, bar);
            __builtin_amdgcn_fence(__ATOMIC_ACQUIRE, "agent");
            asm volatile("s_waitcnt vmcnt(0)" ::: "memory");
        }
    }
    __syncthreads();
}

struct Args { const float* in[20]; float* out; unsigned char* ws; unsigned char* xb; int ph_lo, ph_hi, ntok, tok0, mode, pad; };

struct Frame {
    LAS unsigned char* lds;
    int tid, lane, wave, vcu, G;
    int ntok;
    unsigned char* ws; unsigned char* act;
};

struct EpiProj {
    static constexpr bool PERM = true, AFTER_DRAIN = false;
    unsigned char* act; size_t ntok;
    __device__ __forceinline__ void operator()(const pg8::f32x4 (&acc)[2][2][4][2], const pg8::Unit& u, int wr, int wc, int fr, int fq) const {
        const int pn = u.pn; size_t O; int ld, cb, nbj = 2;
        if (pn < 4) { O = O_QA; ld = 1024; cb = pn * 256; }
        else if (pn == 4) { O = O_CKV; ld = 256; cb = 0; }
        else if (pn < 7) { O = O_QI; ld = 512; cb = (pn - 5) * 256; }
        else if (pn == 7) { O = O_KW; ld = 128; cb = 0; nbj = 1; }
        else if (pn < 10) { O = O_RQ; ld = 512; cb = (pn - 8) * 256; }
        else if (pn < 12) { O = O_RK; ld = 512; cb = (pn - 10) * 256; }
        else { O = O_RV + (size_t)((pn - 12) >> 2) * 2048; ld = 1024; cb = ((pn - 12) & 3) * 256; }
        pg8::bf16_t* base = (pg8::bf16_t*)(act + ntok * O);
        const int row0 = u.pm * pg8::BM + wr * 64 + fr, col0 = cb + wc * 32 + 8 * fq;
#pragma unroll
        for (int ai = 0; ai < 2; ++ai)
#pragma unroll
            for (int m = 0; m < 4; ++m) { pg8::bf16_t* rowp = base + (size_t)(row0 + ai * pg8::HALF + m * 16) * ld + col0;
#pragma unroll
                for (int bj = 0; bj < 2; ++bj) if (bj < nbj) { const pg8::f32x4 v0 = acc[ai][bj][m][0], v1 = acc[ai][bj][m][1];
                    pg8::u32x4 w; w.x = pg8::cvt_pk_bf16(v0[0], v0[1]); w.y = pg8::cvt_pk_bf16(v0[2], v0[3]); w.z = pg8::cvt_pk_bf16(v1[0], v1[1]); w.w = pg8::cvt_pk_bf16(v1[2], v1[3]);
                    *(pg8::u32x4*)(rowp + bj * pg8::HALF) = w; } }
    }
};


__device__ __forceinline__ float sigm(float x) { return __builtin_amdgcn_rcpf(1.f + __builtin_amdgcn_exp2f(-1.4426950408889634f * x)); }
struct EpiGateA {
    static constexpr bool PERM = true, AFTER_DRAIN = false;
    pg8::bf16_t* GA;
    __device__ __forceinline__ void operator()(const pg8::f32x4 (&acc)[2][2][4][2], const pg8::Unit& u, int wr, int wc, int fr, int fq) const {
        const int row0 = u.pm * pg8::BM + wr * 64 + fr, col0 = u.pn * pg8::BM + wc * 32 + 8 * fq;
#pragma unroll
        for (int ai = 0; ai < 2; ++ai)
#pragma unroll
            for (int m = 0; m < 4; ++m) { pg8::bf16_t* rowp = GA + (size_t)(row0 + ai * pg8::HALF + m * 16) * 1024 + col0;
#pragma unroll
                for (int bj = 0; bj < 2; ++bj) { const pg8::u32x4 g = *(const pg8::u32x4*)(rowp + bj * pg8::HALF); const pg8::f32x4 v0 = acc[ai][bj][m][0], v1 = acc[ai][bj][m][1];
                    pg8::u32x4 w; w.x = pg8::cvt_pk_bf16(sigm(pg8::bf_lo(g.x)) * v0[0], sigm(pg8::bf_hi(g.x)) * v0[1]); w.y = pg8::cvt_pk_bf16(sigm(pg8::bf_lo(g.y)) * v0[2], sigm(pg8::bf_hi(g.y)) * v0[3]);
                    w.z = pg8::cvt_pk_bf16(sigm(pg8::bf_lo(g.z)) * v1[0], sigm(pg8::bf_hi(g.z)) * v1[1]); w.w = pg8::cvt_pk_bf16(sigm(pg8::bf_lo(g.w)) * v1[2], sigm(pg8::bf_hi(g.w)) * v1[3]);
                    *(pg8::u32x4*)(rowp + bj * pg8::HALF) = w; } }
    }
};
struct EpiGateB {
    static constexpr bool PERM = true, AFTER_DRAIN = false;
    pg8::bf16_t* GA; const pg8::bf16_t* GR;
    __device__ __forceinline__ void operator()(const pg8::f32x4 (&acc)[2][2][4][2], const pg8::Unit& u, int wr, int wc, int fr, int fq) const {
        const int row0 = u.pm * pg8::BM + wr * 64 + fr, col0 = u.pn * pg8::BM + wc * 32 + 8 * fq;
#pragma unroll
        for (int ai = 0; ai < 2; ++ai)
#pragma unroll
            for (int m = 0; m < 4; ++m) { const size_t ro = (size_t)(row0 + ai * pg8::HALF + m * 16) * 1024 + col0;
#pragma unroll
                for (int bj = 0; bj < 2; ++bj) { const pg8::u32x4 t = *(const pg8::u32x4*)(GA + ro + bj * pg8::HALF), g = *(const pg8::u32x4*)(GR + ro + bj * pg8::HALF); const pg8::f32x4 v0 = acc[ai][bj][m][0], v1 = acc[ai][bj][m][1];
                    pg8::u32x4 w; w.x = pg8::cvt_pk_bf16(pg8::bf_lo(t.x) + sigm(pg8::bf_lo(g.x)) * v0[0], pg8::bf_hi(t.x) + sigm(pg8::bf_hi(g.x)) * v0[1]); w.y = pg8::cvt_pk_bf16(pg8::bf_lo(t.y) + sigm(pg8::bf_lo(g.y)) * v0[2], pg8::bf_hi(t.y) + sigm(pg8::bf_hi(g.y)) * v0[3]);
                    w.z = pg8::cvt_pk_bf16(pg8::bf_lo(t.z) + sigm(pg8::bf_lo(g.z)) * v1[0], pg8::bf_hi(t.z) + sigm(pg8::bf_hi(g.z)) * v1[1]); w.w = pg8::cvt_pk_bf16(pg8::bf_lo(t.w) + sigm(pg8::bf_lo(g.w)) * v1[2], pg8::bf_hi(t.w) + sigm(pg8::bf_hi(g.w)) * v1[3]);
                    *(pg8::u32x4*)(GA + ro + bj * pg8::HALF) = w; } }
    }
};
struct EpiResid {
    static constexpr bool PERM = true, AFTER_DRAIN = false;
    const float* x; pg8::bf16_t* h16;
    __device__ __forceinline__ void operator()(const pg8::f32x4 (&acc)[2][2][4][2], const pg8::Unit& u, int wr, int wc, int fr, int fq) const {
        const int row0 = u.pm * pg8::BM + wr * 64 + fr, col0 = u.pn * pg8::BM + wc * 32 + 8 * fq;
#pragma unroll
        for (int ai = 0; ai < 2; ++ai)
#pragma unroll
            for (int m = 0; m < 4; ++m) { const size_t ro = (size_t)(row0 + ai * pg8::HALF + m * 16) * 1024 + col0;
#pragma unroll
                for (int bj = 0; bj < 2; ++bj) { const pg8::f32x4 x0 = *(const pg8::f32x4*)(x + ro + bj * pg8::HALF), x1 = *(const pg8::f32x4*)(x + ro + bj * pg8::HALF + 4); const pg8::f32x4 v0 = acc[ai][bj][m][0] + x0, v1 = acc[ai][bj][m][1] + x1;
                    pg8::u32x4 w; w.x = pg8::cvt_pk_bf16(v0[0], v0[1]); w.y = pg8::cvt_pk_bf16(v0[2], v0[3]); w.z = pg8::cvt_pk_bf16(v1[0], v1[1]); w.w = pg8::cvt_pk_bf16(v1[2], v1[3]);
                    *(pg8::u32x4*)(h16 + ro + bj * pg8::HALF) = w; } }
    }
};


struct P1Order {
    static constexpr bool GATHER = false; const int* ptok = nullptr;
    int nM, nN, nwg, G, c, mode; const char* A; const char* Bt; size_t tA, tB;
    __device__ bool next(int i, pg8::Unit& u) const {
        const long L = (long)i * G + c; if (L >= nwg) return false;
        int wgid = (int)L; { const int q = nwg / pg8::NXCD, r = nwg % pg8::NXCD, xcd = wgid % pg8::NXCD, off = wgid / pg8::NXCD; wgid = (xcd < r ? xcd * (q + 1) : r * (q + 1) + (xcd - r) * q) + off; }
        const int nig = pg8::WGM * nN, gid = wgid / nig, fm = gid * pg8::WGM, gsz = (nM - fm) < pg8::WGM ? (nM - fm) : pg8::WGM;
        u.pm = fm + ((wgid % nig) % gsz); const int pc = (wgid % nig) / gsz; u.pn = mode ? 5 + pc : (pc < 5 ? pc : pc + 3);
        u.a = A + (size_t)u.pm * tA; u.b = Bt + (size_t)u.pn * tB; u.bjump = 0; u.aux = 0; return true;
    }
    __device__ __forceinline__ void a_ready(const pg8::Unit&) const {}
    __device__ __forceinline__ void done(const pg8::Unit&) const {}
};

__device__ __forceinline__ float wave_sum(float v) {
#pragma unroll
    for (int o = 1; o < 64; o <<= 1) v += __shfl_xor(v, o);
    return v;
}
__device__ __forceinline__ void p0_transpose_item(const float* W, int K, int N, bf16* WT, int map, int row_off, int par, const float* gk, LAS float* scr, int item, int lane, unsigned char* WT8 = nullptr) {
    const int nblk = (N + 31) / 32, kb = item / nblk, nb = item % nblk, k0 = 64 * kb, n0 = 32 * nb;
    const int c4 = lane & 7, rr = lane >> 3; const bool okc = (n0 + 4 * c4) < N;
    f32x4 v[8];
#pragma unroll
    for (int i = 0; i < 8; ++i) { const int kk = i * 8 + rr; v[i] = okc ? *(const f32x4*)(W + (size_t)(k0 + kk) * N + n0 + 4 * c4) : (f32x4){0.f, 0.f, 0.f, 0.f}; }
#pragma unroll
    for (int i = 0; i < 8; ++i) { const int kk = i * 8 + rr; f32x4 x = v[i]; if (gk) x = x * gk[k0 + kk]; *(LAS f32x4*)(scr + kk * 36 + 4 * c4) = x; }
    LDS_WAIT(); asm volatile("" ::: "memory");
    const int c = lane & 7;
#pragma unroll
    for (int j = 0; j < 4; ++j) { const int nl = (lane >> 3) + 8 * j, n = n0 + nl; const LAS float* s = scr + (8 * c) * 36 + nl;
        v4u o; o.x = pk2(s[0 * 36], s[1 * 36]); o.y = pk2(s[2 * 36], s[3 * 36]); o.z = pk2(s[4 * 36], s[5 * 36]); o.w = pk2(s[6 * 36], s[7 * 36]);
        if (n < N) { const int row = (map == 0) ? row_off + n : (map == 1) ? (n < 1864 ? n : n + 184) : row_off + 2 * n + par;
            *(GAS v4u*)(WT + (size_t)row * K + k0 + 8 * c) = o;
            if (WT8) { int w0 = __builtin_amdgcn_cvt_pk_fp8_f32(s[0 * 36] * 32.f, s[1 * 36] * 32.f, 0, false); w0 = __builtin_amdgcn_cvt_pk_fp8_f32(s[2 * 36] * 32.f, s[3 * 36] * 32.f, w0, true);
                int w1 = __builtin_amdgcn_cvt_pk_fp8_f32(s[4 * 36] * 32.f, s[5 * 36] * 32.f, 0, false); w1 = __builtin_amdgcn_cvt_pk_fp8_f32(s[6 * 36] * 32.f, s[7 * 36] * 32.f, w1, true);
                *(GAS unsigned long long*)(WT8 + (size_t)row * K + k0 + 8 * c) = (unsigned long long)(unsigned)w0 | ((unsigned long long)(unsigned)w1 << 32); } } }
    LDS_WAIT(); asm volatile("" ::: "memory");
}
__device__ __forceinline__ void p0_prologue(Frame& F, const Args& a) {
    LAS float* scr = (LAS float*)(F.lds + RING_OFF + F.wave * 16384);
    const int gw = F.vcu * NWAVES + F.wave, NGW = F.G * NWAVES;
    bf16* Win_t = (bf16*)(F.ws + WS_WIN); bf16* Wkv_t = (bf16*)(F.ws + WS_WKV); bf16* Watt_t = (bf16*)(F.ws + WS_WATT); bf16* Wret_t = (bf16*)(F.ws + WS_WRET);
    bf16* Wout_t = (bf16*)(F.ws + WS_WOUT); bf16* W1_t = (bf16*)(F.ws + WS_W1); bf16* Wd_t = (bf16*)(F.ws + WS_WD);
    constexpr int I_IN = 16 * 219, I_KV = 4 * 8, I_SQ = 16 * 32, I_GU = 16 * 8  , I_DN = 4 * 32  ;
    constexpr int NITEMS = I_IN + I_KV + 3 * I_SQ + 16 * (2 * I_GU + I_DN);
    for (int it = gw; it < NITEMS; it += NGW) {
        int r = it;
        if (r < I_IN) { p0_transpose_item(a.in[2], 1024, INW, Win_t, 1, 0, 0, a.in[1], scr, r, F.lane, F.ws + WS_WIN8); continue; } r -= I_IN;
        if (r < I_KV) { p0_transpose_item(a.in[4], 256, 256, Wkv_t, 0, 0, 0, a.in[3], scr, r, F.lane); continue; } r -= I_KV;
        if (r < I_SQ) { p0_transpose_item(a.in[9], 1024, 1024, Watt_t, 0, 0, 0, nullptr, scr, r, F.lane); continue; } r -= I_SQ;
        if (r < I_SQ) { p0_transpose_item(a.in[10], 1024, 1024, Wret_t, 0, 0, 0, nullptr, scr, r, F.lane); continue; } r -= I_SQ;
        if (r < I_SQ) { p0_transpose_item(a.in[11], 1024, 1024, Wout_t, 0, 0, 0, nullptr, scr, r, F.lane); continue; } r -= I_SQ;
        const int e = r / (2 * I_GU + I_DN), q = r % (2 * I_GU + I_DN);
        if (q < I_GU) p0_transpose_item(a.in[17] + (size_t)e * 1024 * 256, 1024, 256, W1_t, 2, e * 512, 0, nullptr, scr, q, F.lane);
        else if (q < 2 * I_GU) p0_transpose_item(a.in[18] + (size_t)e * 1024 * 256, 1024, 256, W1_t, 2, e * 512, 1, nullptr, scr, q - I_GU, F.lane);
        else p0_transpose_item(a.in[19] + (size_t)e * 256 * 1024, 256, 1024, Wd_t + (size_t)e * 1024 * 256, 0, 0, 0, nullptr, scr, q - 2 * I_GU, F.lane);
    }
    { const int gt = (F.vcu * NWAVES + F.wave) * 64 + F.lane, NGT = F.G * NWAVES * 64; GAS v4u* z = (GAS v4u*)(Win_t + (size_t)1864 * 1024);
      for (int i = gt; i < 184 * 1024 * 2 / 16; i += NGT) z[i] = (v4u){0u, 0u, 0u, 0u}; }
    { const int gt = (F.vcu * NWAVES + F.wave) * 64 + F.lane, NGT = F.G * NWAVES * 64; bf16* Wh = (bf16*)(F.ws + WS_WR); bf16* Wl = Wh + 32 * 1024;
      for (int i = gt; i < 32 * 1024; i += NGT) { const int n = i >> 10, k = i & 1023; const float wv = n < 4 ? a.in[13][k * 4 + n] : (n < 20 ? a.in[15][k * 16 + (n - 4)] : 0.f);
        const unsigned hb = f2bf(wv); const float hf = __uint_as_float(hb << 16); Wh[i] = (bf16)hb; Wl[i] = (bf16)f2bf(wv - hf); } }
    const float* x = a.in[0] + (size_t)a.tok0 * D; unsigned char* xb8 = a.xb + (size_t)F.ntok * AUX_XB8;
    for (int m = gw; m < F.ntok; m += 2 * NGW) {
        const int m2 = m + NGW; const bool two = m2 < F.ntok;
        const GAS f32x4* xr = (const GAS f32x4*)(x + (size_t)m * D) + F.lane; const GAS f32x4* xr2 = (const GAS f32x4*)(x + (size_t)(two ? m2 : m) * D) + F.lane;
        f32x4 v[4], u[4]; float s = 0.f, s2 = 0.f;
#pragma unroll
        for (int j = 0; j < 4; ++j) { v[j] = xr[64 * j]; u[j] = xr2[64 * j]; }
#pragma unroll
        for (int j = 0; j < 4; ++j) { s += (v[j].x * v[j].x + v[j].y * v[j].y) + (v[j].z * v[j].z + v[j].w * v[j].w); s2 += (u[j].x * u[j].x + u[j].y * u[j].y) + (u[j].z * u[j].z + u[j].w * u[j].w); }
        const float rstd = 1.f / sqrtf(wave_sum(s) * (1.f / D) + EPS), rstd2 = 1.f / sqrtf(wave_sum(s2) * (1.f / D) + EPS);
        GAS unsigned long long* o8 = (GAS unsigned long long*)(a.xb + (size_t)m * D * 2) + F.lane; GAS unsigned* q8 = (GAS unsigned*)(xb8 + (size_t)m * D) + F.lane;
#pragma unroll
        for (int j = 0; j < 4; ++j) { o8[64 * j] = (unsigned long long)pk2(v[j].x * rstd, v[j].y * rstd) | ((unsigned long long)pk2(v[j].z * rstd, v[j].w * rstd) << 32);
            int w8 = __builtin_amdgcn_cvt_pk_fp8_f32(v[j].x * rstd, v[j].y * rstd, 0, false); w8 = __builtin_amdgcn_cvt_pk_fp8_f32(v[j].z * rstd, v[j].w * rstd, w8, true); q8[64 * j] = (unsigned)w8; }
        if (two) { GAS unsigned long long* p8 = (GAS unsigned long long*)(a.xb + (size_t)m2 * D * 2) + F.lane; GAS unsigned* r8 = (GAS unsigned*)(xb8 + (size_t)m2 * D) + F.lane;
#pragma unroll
            for (int j = 0; j < 4; ++j) { p8[64 * j] = (unsigned long long)pk2(u[j].x * rstd2, u[j].y * rstd2) | ((unsigned long long)pk2(u[j].z * rstd2, u[j].w * rstd2) << 32);
                int w8 = __builtin_amdgcn_cvt_pk_fp8_f32(u[j].x * rstd2, u[j].y * rstd2, 0, false); w8 = __builtin_amdgcn_cvt_pk_fp8_f32(u[j].z * rstd2, u[j].w * rstd2, w8, true); r8[64 * j] = (unsigned)w8; } }
    }
}


constexpr size_t AUX_KP = 0, AUX_VV = 256, AUX_KIN = 512, AUX_MASK = 640, AUX_END = 896;
typedef short bf16x8_t __attribute__((ext_vector_type(8)));
typedef float f32x16 __attribute__((ext_vector_type(16)));
__device__ __forceinline__ int crow(int r, int hi) { return (r & 3) + 8 * (r >> 2) + 4 * hi; }
__device__ __forceinline__ float xhalf_sum(float v) { auto rr = __builtin_amdgcn_permlane32_swap(__float_as_uint(v), __float_as_uint(v), false, false); return __uint_as_float(rr[0]) + __uint_as_float(rr[1]); }
__device__ __forceinline__ float sumsq8(bf16x8_t v) { float s = 0.f;
#pragma unroll
    for (int j = 0; j < 8; ++j) { const float f = __uint_as_float((unsigned)(unsigned short)v[j] << 16); s += f * f; } return s; }
__device__ __forceinline__ void p2_post(Frame& F, const Args& a) {
    const int gw = F.vcu * NWAVES + F.wave, NGW = F.G * NWAVES, lane = F.lane, r32 = lane & 31, hi = lane >> 5;
    const size_t nt_ = (size_t)F.ntok;
    const bf16* CKV = (const bf16*)(F.act + nt_ * O_CKV); const bf16* KW = (const bf16*)(F.act + nt_ * O_KW);
    const bf16* Wkv_t = (const bf16*)(F.ws + WS_WKV);
    unsigned char* aux = a.xb + nt_ * 2048;
    bf16* KP = (bf16*)(aux + nt_ * AUX_KP); bf16* VV = (bf16*)(aux + nt_ * AUX_VV); bf16* KIN = (bf16*)(aux + nt_ * AUX_KIN);
    const float* g_q = a.in[5]; const float* g_k = a.in[6]; const float* g_ki = a.in[7];
    constexpr int WP = 528;
    LAS unsigned char* Wl = F.lds + RING_OFF; LAS float* gl = (LAS float*)(F.lds + RING_OFF + 256 * WP);
    for (int i = F.tid; i < 256 * 32; i += NWAVES * 64) { const int n = i >> 5, ch = i & 31; *(LAS v4u*)(Wl + n * WP + ch * 16) = *(const v4u*)(Wkv_t + (size_t)n * 256 + ch * 8); }
    if (F.tid < 128) gl[F.tid] = g_k[F.tid] * g_q[F.tid] * (0.08838834764831845f * 1.4426950408889634f);
    else if (F.tid < 192) gl[F.tid] = g_ki[F.tid - 128];
    __syncthreads();
    const int ntask = 2 * (F.ntok / 32);
    for (int task = gw; task < ntask; task += NGW) {
        const int kind = task & 1, t0 = (task >> 1) * 32;
        const bf16* crowp = CKV + (size_t)(t0 + r32) * 256 + hi * 8;
        bf16x8_t bfr[16]; float ss = 0.f;
#pragma unroll
        for (int kk = 0; kk < 16; ++kk) { bfr[kk] = *(const bf16x8_t*)(crowp + kk * 16); ss += sumsq8(bfr[kk]); }
        ss = xhalf_sum(ss);
        const float rstd = rsqrtf(ss * (1.f / 256.f) + EPS);
        f32x16 acc[4];
#pragma unroll
        for (int nt = 0; nt < 4; ++nt) { acc[nt] = f32x16{};
            const LAS unsigned char* wrow = Wl + (kind * 128 + nt * 32 + r32) * WP + hi * 16;
#pragma unroll
            for (int kk = 0; kk < 16; ++kk) { const bf16x8_t af = *(const LAS bf16x8_t*)(wrow + kk * 32); acc[nt] = __builtin_amdgcn_mfma_f32_32x32x16_bf16(af, bfr[kk], acc[nt], 0, 0, 0); if ((kk & 3) == 3) __builtin_amdgcn_sched_barrier(0); } }
        float sc = rstd;
        if (kind == 0) { float sk = 0.f;
#pragma unroll
            for (int nt = 0; nt < 4; ++nt)
#pragma unroll
                for (int r = 0; r < 16; ++r) { const float v = acc[nt][r] * rstd; sk += v * v; }
            sk = xhalf_sum(sk);
            sc = rstd * rsqrtf(sk * (1.f / 128.f) + EPS); }
        bf16* orow = (kind == 0 ? KP : VV) + (size_t)(t0 + r32) * 128;
#pragma unroll
        for (int nt = 0; nt < 4; ++nt)
#pragma unroll
            for (int g = 0; g < 4; ++g) { const int ch = nt * 32 + 8 * g + 4 * hi; float v[4];
#pragma unroll
                for (int j = 0; j < 4; ++j) { v[j] = acc[nt][4 * g + j] * sc; if (kind == 0) v[j] *= gl[ch + j]; }
                *(unsigned long long*)(orow + ch) = (unsigned long long)pk2(v[0], v[1]) | ((unsigned long long)pk2(v[2], v[3]) << 32); }
        if (kind == 0) {
            const bf16* kr = KW + (size_t)(t0 + r32) * 128 + hi * 32; bf16x8_t kv4[4]; float s2 = 0.f;
#pragma unroll
            for (int j = 0; j < 4; ++j) { kv4[j] = *(const bf16x8_t*)(kr + 8 * j); s2 += sumsq8(kv4[j]); }
            s2 = xhalf_sum(s2);
            const float rk = rsqrtf(s2 * (1.f / 64.f) + EPS);
            bf16* ko = KIN + (size_t)(t0 + r32) * 64 + hi * 32;
#pragma unroll
            for (int j = 0; j < 4; ++j) { float f[8];
#pragma unroll
                for (int e = 0; e < 8; ++e) f[e] = __uint_as_float((unsigned)(unsigned short)kv4[j][e] << 16) * rk * gl[128 + hi * 32 + 8 * j + e];
                v4u o; o.x = pk2(f[0], f[1]); o.y = pk2(f[2], f[3]); o.z = pk2(f[4], f[5]); o.w = pk2(f[6], f[7]);
                *(v4u*)(ko + 8 * j) = o; }
        }
    }
    __syncthreads();
}

typedef float f32x4_t __attribute__((ext_vector_type(4)));
__device__ __forceinline__ unsigned key15_of(float s) { const unsigned short hb = __builtin_bit_cast(unsigned short, (_Float16)s); const unsigned u = (hb & 0x8000u) ? (~(unsigned)hb & 0xffffu) : ((unsigned)hb | 0x8000u); return u >> 1; }
__device__ __forceinline__ unsigned sad4(unsigned x) { return __builtin_amdgcn_sad_u8(x, 0u, 0u); }
__device__ __forceinline__ void p3_merge(LAS unsigned* hist, LAS unsigned short* tot, int w, int g, int q, int& need, int& bsel) {
    __syncthreads();
    const int o = 4 * w + g; unsigned c = 0;
#pragma unroll
    for (int p = 0; p < 32; ++p) { const int tidp = (p >> 2) * 64 + (p & 3) * 16 + q; c += (hist[(o >> 2) * 512 + tidp] >> (8 * (o & 3))) & 0xffu; }
    tot[q * 32 + o] = (unsigned short)c;
    __syncthreads();
    v4u tv[4];
#pragma unroll
    for (int j = 0; j < 4; ++j) tv[j] = *(const LAS v4u*)((const LAS unsigned char*)tot + q * 64 + j * 16);
    int cum = 0, bs = 0, ab = 0; bool found = false;
#pragma unroll
    for (int bin = 31; bin >= 0; --bin) { const unsigned wd = tv[bin >> 3][(bin >> 1) & 3]; const int cc = (int)((bin & 1) ? (wd >> 16) : (wd & 0xffffu));
        if (!found && cum + cc >= need) { bs = bin; ab = cum; found = true; } cum += cc; }
    bsel = bs; need -= ab;
}
__device__ __forceinline__ void p3_index(Frame& F, const Args& a) {
    const int tid = F.tid, lane = F.lane, w = F.wave, q = lane & 15, g = lane >> 4;
    LAS unsigned* keys = (LAS unsigned*)(F.lds + RING_OFF);
    LAS unsigned char* qbuf = F.lds + 65536;
    LAS unsigned* hist = (LAS unsigned*)(F.lds + P3_HIST_OFF);
    LAS unsigned short* tot = (LAS unsigned short*)(F.lds + P3_TOT_OFF);
    LAS unsigned char* Tt = (LAS unsigned char*)(F.lds + P3_T_OFF);
    const size_t nt_ = (size_t)F.ntok;
    const bf16* QI = (const bf16*)(F.act + nt_ * O_QI); const bf16* KW = (const bf16*)(F.act + nt_ * O_KW);
    unsigned char* aux = a.xb + nt_ * 2048;
    const bf16* KIN = (const bf16*)(aux + nt_ * AUX_KIN); unsigned* MASK = (unsigned*)(aux + nt_ * AUX_MASK);
    const int nb = F.ntok / SEQ, nitems = nb * 128, G = F.G, c = (int)blockIdx.x;
#define P3_ITEM(k) ((k) * G + (((k) & 1) ? (G - 1 - c) : c))
#define P3_QDMA(it_, buf_) do { const int qg_ = 127 - (it_) / nb, b_ = (it_) % nb; _Pragma("unroll") for (int i_ = 0; i_ < 2; ++i_) { const int row_ = w * 2 + i_; \
        const char* src_ = (const char*)(QI + ((size_t)b_ * SEQ + qg_ * 16 + row_) * 512) + ((lane ^ (row_ & 15)) * 16); \
        __builtin_amdgcn_global_load_lds((const unsigned*)src_, (LAS unsigned*)(qbuf + (buf_) * 16384 + row_ * 1024), 16, 0, 0); } } while (0)
    const int nround = (nitems + G - 1) / G;
    if (P3_ITEM(0) < nitems) P3_QDMA(P3_ITEM(0), 0);
    v4u wvn = (v4u){0u, 0u, 0u, 0u};
    if (P3_ITEM(0) < nitems) { const int it0 = P3_ITEM(0); wvn = *(const v4u*)(KW + ((size_t)(it0 % nb) * SEQ + (127 - it0 / nb) * 16 + q) * 128 + 64); }
    for (int k = 0; k < nround; ++k) {
        const int it = P3_ITEM(k); if (it >= nitems) break;
        const int qg = 127 - it / nb, b = it % nb, q0 = qg * 16, qme = q0 + q;
        unsigned* Mb = MASK + (size_t)b * 64 * 2048;
        const int kb_hi = ((qg >> 3) + 1) << 2, nkb = (qg >> 1) + 1;
        asm volatile("s_waitcnt vmcnt(0) lgkmcnt(0)\n\ts_barrier" ::: "memory");
        const v4u wv = wvn;
        { const int itn = P3_ITEM(k + 1); if (k + 1 < nround && itn < nitems) { P3_QDMA(itn, (k + 1) & 1); wvn = *(const v4u*)(KW + ((size_t)(itn % nb) * SEQ + (127 - itn / nb) * 16 + q) * 128 + 64); } }
        if (qg < 16) {
            if (tid < kb_hi * 16) { const int kb = tid >> 4, qq = q0 + (tid & 15), nbits = qq - kb * 32 + 1; Mb[kb * 2048 + qq] = nbits >= 32 ? 0xffffffffu : (nbits <= 0 ? 0u : ((1u << nbits) - 1u)); }
            continue;
        }
        float wq[8];
        { const float cc = 0.35355339059327373f * 0.125f;
          wq[0] = pg8::bf_lo(wv.x) * cc; wq[1] = pg8::bf_hi(wv.x) * cc; wq[2] = pg8::bf_lo(wv.y) * cc; wq[3] = pg8::bf_hi(wv.y) * cc; wq[4] = pg8::bf_lo(wv.z) * cc; wq[5] = pg8::bf_hi(wv.z) * cc; wq[6] = pg8::bf_lo(wv.w) * cc; wq[7] = pg8::bf_hi(wv.w) * cc; }
        bf16x8_t qfr[8][2], qlin[2];
        { const LAS unsigned char* qrow = qbuf + (k & 1) * 16384 + q * 1024;
#pragma unroll
          for (int h = 0; h < 8; ++h)
#pragma unroll
            for (int ks = 0; ks < 2; ++ks) qfr[h][ks] = *(const LAS bf16x8_t*)(qrow + (((h * 8 + ks * 4 + g) ^ q) * 16)); }
#pragma unroll
        for (int ks = 0; ks < 2; ++ks) { float f[8];
#pragma unroll
            for (int j = 0; j < 8; ++j) { float s = 0.f;
#pragma unroll
                for (int h = 0; h < 8; ++h) s += wq[h] * __uint_as_float((unsigned)(unsigned short)qfr[h][ks][j] << 16);
                f[j] = s; }
            v4u o; o.x = pk2(f[0], f[1]); o.y = pk2(f[2], f[3]); o.z = pk2(f[4], f[5]); o.w = pk2(f[6], f[7]); qlin[ks] = __builtin_bit_cast(bf16x8_t, o); }
#pragma unroll
        for (int i = 0; i < 8; ++i) hist[i * 512 + tid] = 0u;
        const bf16* kbase = KIN + ((size_t)b * SEQ + q) * 64 + g * 8;
        bf16x8_t afr[2][2], afn[2][2];
#pragma unroll
        for (int t = 0; t < 2; ++t)
#pragma unroll
            for (int ks = 0; ks < 2; ++ks) afn[t][ks] = *(const bf16x8_t*)(kbase + (size_t)(w * 32 + t * 16) * 64 + ks * 32);
        for (int s = 0, kb = w; kb < nkb; ++s, kb += 8) {
#pragma unroll
            for (int t = 0; t < 2; ++t)
#pragma unroll
                for (int ks = 0; ks < 2; ++ks) afr[t][ks] = afn[t][ks];
            if (kb + 8 < nkb) {
#pragma unroll
                for (int t = 0; t < 2; ++t)
#pragma unroll
                    for (int ks = 0; ks < 2; ++ks) afn[t][ks] = *(const bf16x8_t*)(kbase + (size_t)((kb + 8) * 32 + t * 16) * 64 + ks * 32); }
#pragma unroll
            for (int t = 0; t < 2; ++t) {
                f32x4_t sacc = f32x4_t{};
#pragma unroll
                for (int ks = 0; ks < 2; ++ks) sacc = __builtin_amdgcn_mfma_f32_16x16x32_bf16(afr[t][ks], qlin[ks], sacc, 0, 0, 0);
#pragma unroll
                for (int h = 0; h < 8; ++h) { f32x4_t d = f32x4_t{};
#pragma unroll
                    for (int ks = 0; ks < 2; ++ks) d = __builtin_amdgcn_mfma_f32_16x16x32_bf16(afr[t][ks], qfr[h][ks], d, 0, 0, 0);
#pragma unroll
                    for (int r = 0; r < 4; ++r) sacc[r] = fmaf(fabsf(d[r]), wq[h], sacc[r]); }
#pragma unroll
                for (int i = 0; i < 2; ++i) { unsigned k2[2];
#pragma unroll
                    for (int e = 0; e < 2; ++e) { const int r = 2 * i + e; unsigned kk_ = key15_of(sacc[r]); if (kb * 32 + t * 16 + 4 * g + r > qme) kk_ = 0u; k2[e] = kk_;
                        const unsigned dg = kk_ >> 10; (void)__hip_atomic_fetch_add((LAS unsigned*)&hist[(dg >> 2) * 512 + tid], 1u << ((dg & 3u) * 8u), __ATOMIC_RELAXED, __HIP_MEMORY_SCOPE_WORKGROUP); }
                    keys[(s * 4 + t * 2 + i) * 512 + tid] = k2[0] | (k2[1] << 16); }
            }
        }
        int need = 256, bsel;
        p3_merge(hist, tot, w, g, q, need, bsel);
        unsigned prefix = (unsigned)bsel;
#pragma unroll
        for (int pass = 0; pass < 2; ++pass) {
            const int sh_hi = pass == 0 ? 10 : 5, sh = pass == 0 ? 5 : 0;
#pragma unroll
            for (int i = 0; i < 8; ++i) hist[i * 512 + tid] = 0u;
#pragma unroll
            for (int s = 0; s < 8; ++s) if (w + 8 * s < nkb) {
#pragma unroll
                for (int i = 0; i < 4; ++i) { const unsigned d2 = keys[(s * 4 + i) * 512 + tid];
#pragma unroll
                    for (int e = 0; e < 2; ++e) { const unsigned kk_ = e ? (d2 >> 16) : (d2 & 0xffffu);
                        if ((kk_ >> sh_hi) == prefix) { const unsigned dg = (kk_ >> sh) & 31u; (void)__hip_atomic_fetch_add((LAS unsigned*)&hist[(dg >> 2) * 512 + tid], 1u << ((dg & 3u) * 8u), __ATOMIC_RELAXED, __HIP_MEMORY_SCOPE_WORKGROUP); } } } }
            p3_merge(hist, tot, w, g, q, need, bsel);
            prefix = (prefix << 5) | (unsigned)bsel;
        }
        const unsigned tau = prefix; const int need_eq = need;
        unsigned gtw[8], eqw[8];
#pragma unroll
        for (int s = 0; s < 8; ++s) { const int kb = w + 8 * s; gtw[s] = 0u; eqw[s] = 0u;
            if (kb < nkb) { unsigned gg = 0u, qq = 0u;
#pragma unroll
                for (int i = 0; i < 4; ++i) { const unsigned d2 = keys[(s * 4 + i) * 512 + tid];
#pragma unroll
                    for (int e = 0; e < 2; ++e) { const unsigned kk_ = e ? (d2 >> 16) : (d2 & 0xffffu); const int bit = (i >> 1) * 16 + 4 * g + (i & 1) * 2 + e;
                        gg |= (kk_ > tau ? 1u : 0u) << bit; qq |= (kk_ == tau ? 1u : 0u) << bit; } }
                gg |= (unsigned)__shfl_xor((int)gg, 16); gg |= (unsigned)__shfl_xor((int)gg, 32); qq |= (unsigned)__shfl_xor((int)qq, 16); qq |= (unsigned)__shfl_xor((int)qq, 32);
                gtw[s] = gg; eqw[s] = qq;
                if (g == 0) Tt[q * 64 + kb] = (unsigned char)__builtin_popcount(qq); } }
        __syncthreads();
        { unsigned run = 0u;
#pragma unroll
          for (int s = 0; s < 8; ++s) { const int kb = w + 8 * s;
            if (kb < nkb) { const unsigned g0 = *(const LAS unsigned*)(Tt + q * 64 + 8 * s), g1 = *(const LAS unsigned*)(Tt + q * 64 + 8 * s + 4);
                const unsigned m0 = w >= 4 ? g0 : (w == 0 ? 0u : (g0 & ((1u << (8 * w)) - 1u))), m1 = w > 4 ? (g1 & ((1u << (8 * (w - 4))) - 1u)) : 0u;
                const int pre = (int)(run + sad4(m0) + sad4(m1)), m = need_eq - pre, pc = __builtin_popcount(eqw[s]);
                unsigned se = eqw[s];
                if (m < pc) { se = 0u; unsigned x = eqw[s]; for (int i = 0; i < m; ++i) { const unsigned bb = x & (0u - x); se |= bb; x ^= bb; } }
                if (g == 0) Mb[kb * 2048 + qme] = gtw[s] | se;
                run += sad4(g0) + sad4(g1); } } }
        if (tid < (kb_hi - nkb) * 16) Mb[(nkb + (tid >> 4)) * 2048 + q0 + (tid & 15)] = 0u;
    }
    asm volatile("s_waitcnt vmcnt(0) lgkmcnt(0)" ::: "memory");
    __syncthreads();
#undef P3_ITEM
#undef P3_QDMA
}

namespace att {
using bf16x8 = __attribute__((ext_vector_type(8))) short;
using s16x4  = __attribute__((ext_vector_type(4))) short;
using u32x4  = __attribute__((ext_vector_type(4))) unsigned;
constexpr int KVBLK = 64;
constexpr size_t SHM_V = KVBLK * 128 * 2, SHM_K = KVBLK * 128 * 2;
constexpr int OFF_WS = 65536, OFF_MK = 65536 + 2048, OFF_Q = 65536 + 2048 + 8192, QPITCH = 272;
constexpr float THR2 = 11.5f;
#define KSWZ(row, colB) ((row) * 256 + ((colB) ^ (((row) & 7) << 4)))
#define SBAR() __builtin_amdgcn_sched_barrier(0)
__device__ __forceinline__ unsigned cvtpk(float lo, float hi) { unsigned r; asm volatile("v_cvt_pk_bf16_f32 %0, %1, %2" : "=v"(r) : "v"(lo), "v"(hi)); return r; }
__device__ __forceinline__ float msk(float p, unsigned w, int bit) { const int m = __builtin_amdgcn_sbfe((int)w, bit, 1); return __uint_as_float((__float_as_uint(p) & (unsigned)m) | (0xff800000u & ~(unsigned)m)); }
__device__ __forceinline__ void partialSM(f32x16& p0, f32x16& p1, unsigned w0, unsigned w1, float& m_reg, float& mn, float& alpha) {
#pragma unroll
  for (int r = 0; r < 16; ++r) { const int bit = (r & 3) + 8 * (r >> 2); p0[r] = msk(p0[r], w0, bit); p1[r] = msk(p1[r], w1, bit); }
  float pmax = p0[0];
#pragma unroll
  for (int r = 1; r < 16; ++r) pmax = fmaxf(pmax, p0[r]);
#pragma unroll
  for (int r = 0; r < 16; ++r) pmax = fmaxf(pmax, p1[r]);
  { auto rr = __builtin_amdgcn_permlane32_swap(__float_as_uint(pmax), __float_as_uint(pmax), false, false); pmax = fmaxf(__uint_as_float(rr[0]), __uint_as_float(rr[1])); }
  if (__builtin_expect(__all(pmax - m_reg <= THR2), 1)) { mn = m_reg; alpha = 1.f; }
  else { mn = fmaxf(m_reg, pmax); alpha = __builtin_amdgcn_exp2f(m_reg - mn); m_reg = mn; }
#pragma unroll
  for (int r = 0; r < 16; ++r) { p0[r] -= mn; p1[r] -= mn; }
#pragma unroll
  for (int r = 0; r < 16; ++r) p0[r] = __builtin_amdgcn_exp2f(p0[r]);
}
__device__ __forceinline__ void finishSM(f32x16& p0, f32x16& p1, float alpha, float& l_reg, bf16x8& pa0, bf16x8& pa1, bf16x8& pa2, bf16x8& pa3) {
#pragma unroll
  for (int r = 0; r < 16; ++r) p1[r] = __builtin_amdgcn_exp2f(p1[r]);
  float ps = 0;
#pragma unroll
  for (int r = 0; r < 16; ++r) ps += p0[r];
#pragma unroll
  for (int r = 0; r < 16; ++r) ps += p1[r];
  { auto rr = __builtin_amdgcn_permlane32_swap(__float_as_uint(ps), __float_as_uint(ps), false, false); ps = __uint_as_float(rr[0]) + __uint_as_float(rr[1]); }
  l_reg = l_reg * alpha + ps;
#define PK4(P, BASE, OUT) do { unsigned a0 = cvtpk(P[BASE + 0], P[BASE + 1]), a1 = cvtpk(P[BASE + 2], P[BASE + 3]);   \
    unsigned b0 = cvtpk(P[BASE + 4], P[BASE + 5]), b1 = cvtpk(P[BASE + 6], P[BASE + 7]);                              \
    auto r0 = __builtin_amdgcn_permlane32_swap(a0, b0, false, false); auto r1 = __builtin_amdgcn_permlane32_swap(a1, b1, false, false); \
    u32x4 w = {r0[0], r1[0], r0[1], r1[1]}; OUT = *reinterpret_cast<bf16x8*>(&w); } while (0)
  PK4(p0, 0, pa0); PK4(p0, 8, pa1); PK4(p1, 0, pa2); PK4(p1, 8, pa3);
#undef PK4
}
__device__ __forceinline__ void qkt(f32x16& p0, f32x16& p1, const char* Ks, const char* qrow, const float (&bo)[16], float kb0, float kb1, int r32, int hi) {
#pragma unroll
  for (int r = 0; r < 16; ++r) { p0[r] = bo[r] + kb0; p1[r] = bo[r] + kb1; }
#pragma unroll
  for (int d0 = 0; d0 < 8; ++d0) { const int cb = (d0 * 16 + hi * 8) * 2;
    const bf16x8 b0 = *reinterpret_cast<const bf16x8*>(Ks + KSWZ(r32, cb));
    const bf16x8 b1 = *reinterpret_cast<const bf16x8*>(Ks + KSWZ(32 + r32, cb));
    const bf16x8 qf = *reinterpret_cast<const bf16x8*>(qrow + d0 * 32);
    p0 = __builtin_amdgcn_mfma_f32_32x32x16_bf16(b0, qf, p0, 0, 0, 0);
    p1 = __builtin_amdgcn_mfma_f32_32x32x16_bf16(b1, qf, p1, 0, 0, 0); }
}
__device__ __forceinline__ int v_st(int k, int c) { const int kk = (k & ~0xC) | ((k & 4) << 1) | ((k & 8) >> 1); return ((kk >> 3) * 4 + (c >> 5)) * 512 + ((kk & 7) * 32 + (c & 31)) * 2; }
__device__ __forceinline__ int v_rd_base(int lane) { return ((lane & 3) << 3) | (((lane >> 2) & 3) << 6) | (((lane >> 4) & 1) << 5) | (((lane >> 5) & 1) << 8); }
constexpr int v_rd_off(int d0, int ks, int half) { return d0 * 512 + ks * 4096 + half * 2048; }
template <int OFF> __device__ __forceinline__ s16x4 tr_read(int vb) { s16x4 r; asm volatile("ds_read_b64_tr_b16 %0, %1 offset:%2" : "=&v"(r) : "v"(vb), "i"(OFF) : "memory"); return r; }
template <int D0> __device__ __forceinline__ void pv_one(f32x16& od, int vb, bf16x8 pa0, bf16x8 pa1, bf16x8 pa2, bf16x8 pa3) {
  const s16x4 l0 = tr_read<v_rd_off(D0, 0, 0)>(vb), h0 = tr_read<v_rd_off(D0, 0, 1)>(vb), l1 = tr_read<v_rd_off(D0, 1, 0)>(vb), h1 = tr_read<v_rd_off(D0, 1, 1)>(vb);
  const s16x4 l2 = tr_read<v_rd_off(D0, 2, 0)>(vb), h2 = tr_read<v_rd_off(D0, 2, 1)>(vb), l3 = tr_read<v_rd_off(D0, 3, 0)>(vb), h3 = tr_read<v_rd_off(D0, 3, 1)>(vb);
  asm volatile("s_waitcnt lgkmcnt(0)" ::: "memory"); SBAR();
#define PK(L, H) (bf16x8){L[0], L[1], L[2], L[3], H[0], H[1], H[2], H[3]}
  od = __builtin_amdgcn_mfma_f32_32x32x16_bf16(pa0, PK(l0, h0), od, 0, 0, 0);
  od = __builtin_amdgcn_mfma_f32_32x32x16_bf16(pa1, PK(l1, h1), od, 0, 0, 0);
  od = __builtin_amdgcn_mfma_f32_32x32x16_bf16(pa2, PK(l2, h2), od, 0, 0, 0);
  od = __builtin_amdgcn_mfma_f32_32x32x16_bf16(pa3, PK(l3, h3), od, 0, 0, 0);
#undef PK
}
__device__ __forceinline__ void pv_d0(f32x16* o, int vb, bf16x8 pa0, bf16x8 pa1, bf16x8 pa2, bf16x8 pa3) {
  pv_one<0>(o[0], vb, pa0, pa1, pa2, pa3); pv_one<1>(o[1], vb, pa0, pa1, pa2, pa3); pv_one<2>(o[2], vb, pa0, pa1, pa2, pa3); pv_one<3>(o[3], vb, pa0, pa1, pa2, pa3);
}
__device__ __forceinline__ void attn_item(const bf16* __restrict__ Qb, const bf16* __restrict__ Kh, const bf16* __restrict__ Vh, const unsigned* __restrict__ Mq, bf16* __restrict__ Ob, int NT, char* lds, LAS unsigned char* ldsL) {
  const int tid = threadIdx.x, wid = __builtin_amdgcn_readfirstlane(tid >> 6), lane = tid & 63, r32 = lane & 31, hi = lane >> 5;
  float* ws = (float*)(lds + OFF_WS) + wid * 64; float* li_l = ws; float* al_l = ws + 32;
  unsigned* mk = (unsigned*)(lds + OFF_MK);
  unsigned soff[4];
#pragma unroll
  for (int i = 0; i < 4; ++i) { const int pc = (wid & 3) * 4 + i;
    if (wid < 4) { const int row = pc * 4 + (lane >> 4), cb = (lane & 15) * 16; soff[i] = (unsigned)(row * 256 + (cb ^ ((row & 7) << 4))); }
    else { const int L = pc * 1024 + lane * 16, st = L >> 9, wi = L & 511, kk = (st >> 2) * 8 + (wi >> 6), c = (st & 3) * 32 + ((wi & 63) >> 1), k = (kk & ~0xC) | ((kk & 4) << 1) | ((kk & 8) >> 1);
           soff[i] = (unsigned)(k * 256 + c * 2); } }
  const char* gsrc = (const char*)(wid < 4 ? Kh : Vh);
  const unsigned ldst = (unsigned)((wid < 4 ? 0 : 16384) + (wid & 3) * 4096);
#define DMA_TILE(t, slot) do { _Pragma("unroll") for (int i_ = 0; i_ < 4; ++i_) \
    __builtin_amdgcn_global_load_lds((const unsigned*)(gsrc + (size_t)(t) * (64 * 256) + soff[i_]), (LAS unsigned*)(ldsL + (slot) * 32768 + ldst + i_ * 1024), 16, 0, 0); } while (0)
  DMA_TILE(0, 0);
  for (int i = tid; i < NT * 64; i += 512) mk[i] = Mq[(size_t)(i >> 5) * 2048 + (i & 31)];
  float m_reg = -1e30f, l_reg = 0; f32x16 o[4] = {}; bf16x8 qr[8];
  { const bf16* Qw = Qb + (size_t)r32 * 1024 + wid * 128 + hi * 8; float ss = 0.f;
#pragma unroll
    for (int d0 = 0; d0 < 8; ++d0) { qr[d0] = *reinterpret_cast<const bf16x8*>(Qw + d0 * 16); ss += sumsq8(qr[d0]); }
    ss = xhalf_sum(ss); const float rq = rsqrtf(ss * (1.f / 128.f) + EPS);
#pragma unroll
    for (int d0 = 0; d0 < 8; ++d0) { float f[8];
#pragma unroll
      for (int j = 0; j < 8; ++j) f[j] = __uint_as_float((unsigned)(unsigned short)qr[d0][j] << 16) * rq;
      u32x4 w = {cvtpk(f[0], f[1]), cvtpk(f[2], f[3]), cvtpk(f[4], f[5]), cvtpk(f[6], f[7])}; qr[d0] = *reinterpret_cast<bf16x8*>(&w); } }
  const float slope2 = __builtin_amdgcn_exp2f(-(float)(wid + 1)) * 1.4426950408889634f;
  float bo[16];
#pragma unroll
  for (int r = 0; r < 16; ++r) bo[r] = __uint_as_float(__builtin_amdgcn_readfirstlane(__float_as_uint(slope2 * (float)((r & 3) + 8 * (r >> 2)))));
  const float hoff = slope2 * (float)(4 * hi);
  const int vb0 = (int)(uintptr_t)(lds + 16384) + v_rd_base(lane);
  asm volatile("s_waitcnt vmcnt(0) lgkmcnt(0)\n\ts_barrier" ::: "memory");
  for (int j = 0; j < NT; ++j) {
    const int sl = j & 1;
    if (j + 1 < NT) DMA_TILE(j + 1, sl ^ 1);
    const char* Ks = lds + sl * 32768;
    const unsigned w0 = mk[(2 * j) * 32 + r32] >> (4 * hi), w1 = mk[(2 * j + 1) * 32 + r32] >> (4 * hi);
    f32x16 p0, p1;
    { const float kb0 = slope2 * (float)(j * 64) + hoff, kb1 = kb0 + slope2 * 32.f;
#pragma unroll
      for (int r = 0; r < 16; ++r) { p0[r] = bo[r] + kb0; p1[r] = bo[r] + kb1; }
      bf16x8 ka = *reinterpret_cast<const bf16x8*>(Ks + KSWZ(r32, hi * 16)), kb = *reinterpret_cast<const bf16x8*>(Ks + KSWZ(32 + r32, hi * 16));
#pragma unroll
      for (int d0 = 0; d0 < 8; ++d0) { bf16x8 na = ka, nb = kb;
        if (d0 < 7) { const int cb = ((d0 + 1) * 16 + hi * 8) * 2; na = *reinterpret_cast<const bf16x8*>(Ks + KSWZ(r32, cb)); nb = *reinterpret_cast<const bf16x8*>(Ks + KSWZ(32 + r32, cb)); }
        SBAR();
        p0 = __builtin_amdgcn_mfma_f32_32x32x16_bf16(ka, qr[d0], p0, 0, 0, 0);
        p1 = __builtin_amdgcn_mfma_f32_32x32x16_bf16(kb, qr[d0], p1, 0, 0, 0);
        SBAR();
        ka = na; kb = nb; } }
    float alpha; bf16x8 pa0, pa1, pa2, pa3;
    {
#pragma unroll
      for (int r = 0; r < 16; ++r) { const int bit = (r & 3) + 8 * (r >> 2); p0[r] = msk(p0[r], w0, bit); p1[r] = msk(p1[r], w1, bit); }
      float pmax = fmaxf(p0[0], p1[0]);
#pragma unroll
      for (int r = 1; r < 16; ++r) pmax = fmaxf(fmaxf(pmax, p0[r]), p1[r]);
      { auto rr = __builtin_amdgcn_permlane32_swap(__float_as_uint(pmax), __float_as_uint(pmax), false, false); pmax = fmaxf(__uint_as_float(rr[0]), __uint_as_float(rr[1])); }
      float mn;
      if (__builtin_expect(__all(pmax - m_reg <= THR2), 1)) { mn = m_reg; alpha = 1.f; }
      else { mn = fmaxf(m_reg, pmax); alpha = __builtin_amdgcn_exp2f(m_reg - mn); m_reg = mn; }
      float ps = 0.f;
#pragma unroll
      for (int r = 0; r < 16; ++r) { p0[r] = __builtin_amdgcn_exp2f(p0[r] - mn); p1[r] = __builtin_amdgcn_exp2f(p1[r] - mn); ps += p0[r] + p1[r]; }
      { auto rr = __builtin_amdgcn_permlane32_swap(__float_as_uint(ps), __float_as_uint(ps), false, false); ps = __uint_as_float(rr[0]) + __uint_as_float(rr[1]); }
      l_reg = l_reg * alpha + ps;
#define PK4(P, BASE, OUT) do { unsigned a0 = cvtpk(P[BASE + 0], P[BASE + 1]), a1 = cvtpk(P[BASE + 2], P[BASE + 3]);   \
    unsigned b0 = cvtpk(P[BASE + 4], P[BASE + 5]), b1 = cvtpk(P[BASE + 6], P[BASE + 7]);                              \
    auto r0 = __builtin_amdgcn_permlane32_swap(a0, b0, false, false); auto r1 = __builtin_amdgcn_permlane32_swap(a1, b1, false, false); \
    u32x4 w = {r0[0], r1[0], r0[1], r1[1]}; OUT = *reinterpret_cast<bf16x8*>(&w); } while (0)
      PK4(p0, 0, pa0); PK4(p0, 8, pa1); PK4(p1, 0, pa2); PK4(p1, 8, pa3);
#undef PK4
      if (__any(alpha < 1.f)) { if (hi == 0) al_l[r32] = alpha; asm volatile("s_waitcnt lgkmcnt(0)" ::: "memory");
#pragma unroll
        for (int d = 0; d < 4; ++d)
#pragma unroll
          for (int r = 0; r < 16; ++r) o[d][r] *= al_l[crow(r, hi)]; }
    }
    { const int vb = vb0 + sl * 32768;
      s16x4 lA[4], hA[4], lB[4], hB[4];
#define VREADS(L_, H_, D0) do { L_[0] = tr_read<v_rd_off(D0, 0, 0)>(vb); H_[0] = tr_read<v_rd_off(D0, 0, 1)>(vb); L_[1] = tr_read<v_rd_off(D0, 1, 0)>(vb); H_[1] = tr_read<v_rd_off(D0, 1, 1)>(vb); \
      L_[2] = tr_read<v_rd_off(D0, 2, 0)>(vb); H_[2] = tr_read<v_rd_off(D0, 2, 1)>(vb); L_[3] = tr_read<v_rd_off(D0, 3, 0)>(vb); H_[3] = tr_read<v_rd_off(D0, 3, 1)>(vb); } while (0)
#define PK(L, H) (bf16x8){L[0], L[1], L[2], L[3], H[0], H[1], H[2], H[3]}
#define VMMA(OD, L_, H_) do { OD = __builtin_amdgcn_mfma_f32_32x32x16_bf16(pa0, PK(L_[0], H_[0]), OD, 0, 0, 0); OD = __builtin_amdgcn_mfma_f32_32x32x16_bf16(pa1, PK(L_[1], H_[1]), OD, 0, 0, 0); \
      OD = __builtin_amdgcn_mfma_f32_32x32x16_bf16(pa2, PK(L_[2], H_[2]), OD, 0, 0, 0); OD = __builtin_amdgcn_mfma_f32_32x32x16_bf16(pa3, PK(L_[3], H_[3]), OD, 0, 0, 0); } while (0)
#define VWAIT(N, L_, H_) do { asm volatile("s_waitcnt lgkmcnt(" #N ")" : "+v"(L_[0]), "+v"(L_[1]), "+v"(L_[2]), "+v"(L_[3]), "+v"(H_[0]), "+v"(H_[1]), "+v"(H_[2]), "+v"(H_[3]) :: "memory"); SBAR(); } while (0)
      VREADS(lA, hA, 0); VREADS(lB, hB, 1);
      VWAIT(8, lA, hA); VMMA(o[0], lA, hA);
      VREADS(lA, hA, 2);
      VWAIT(8, lB, hB); VMMA(o[1], lB, hB);
      VREADS(lB, hB, 3);
      VWAIT(8, lA, hA); VMMA(o[2], lA, hA);
      VWAIT(0, lB, hB); VMMA(o[3], lB, hB);
#undef VREADS
#undef PK
#undef VMMA
#undef VWAIT
    }
    asm volatile("s_waitcnt vmcnt(0) lgkmcnt(0)\n\ts_barrier" ::: "memory");
  }
  if (hi == 0) li_l[r32] = l_reg; asm volatile("s_waitcnt lgkmcnt(0)" ::: "memory");
  float rli[16];
#pragma unroll
  for (int r = 0; r < 16; ++r) rli[r] = __builtin_amdgcn_rcpf(li_l[crow(r, hi)]);
  unsigned short* stg = (unsigned short*)(lds + wid * 8192);
#pragma unroll
  for (int r = 0; r < 16; ++r) { const int orow = crow(r, hi);
#pragma unroll
    for (int d0 = 0; d0 < 4; ++d0) stg[orow * 128 + d0 * 32 + r32] = (unsigned short)f2bf(o[d0][r] * rli[r]); }
  asm volatile("s_waitcnt lgkmcnt(0)" ::: "memory");
#pragma unroll
  for (int i = 0; i < 8; ++i) { const int row = i * 4 + (lane >> 4), ch = lane & 15; const u32x4 v = *(const u32x4*)(stg + row * 128 + ch * 8);
    *(u32x4*)(Ob + (size_t)row * 1024 + wid * 128 + ch * 8) = v; }
#undef DMA_TILE
}
#undef KSWZ
#undef SBAR
}


namespace ret {
using bf16x8 = __attribute__((ext_vector_type(8))) short;
using s16x4  = __attribute__((ext_vector_type(4))) short;
using u32x4  = __attribute__((ext_vector_type(4))) unsigned;
using u32x2  = __attribute__((ext_vector_type(2))) unsigned;
constexpr int C = 64, QP = 272, KPI = 272, VP = 576;
constexpr int OFF_Q = 0, OFF_K = 17408, OFF_V = 34816, OFF_ST = 71680, OFF_Y = 75776;
typedef float f32x2_t __attribute__((ext_vector_type(2))); typedef __bf16 bf16x2_t __attribute__((ext_vector_type(2)));
__device__ __forceinline__ unsigned cvtpk(float lo, float hi) { const f32x2_t v = {lo, hi}; const bf16x2_t b = __builtin_convertvector(v, bf16x2_t); return __builtin_bit_cast(unsigned, b); }
template <int OFF> __device__ __forceinline__ s16x4 trr(int base) { s16x4 r; asm volatile("ds_read_b64_tr_b16 %0, %1 offset:%2" : "=&v"(r) : "v"(base), "i"(OFF) : "memory"); return r; }
__device__ __forceinline__ bf16x8 pk8(const f32x16& x, int s) { u32x4 w = {cvtpk(x[8 * s + 0], x[8 * s + 1]), cvtpk(x[8 * s + 2], x[8 * s + 3]), cvtpk(x[8 * s + 4], x[8 * s + 5]), cvtpk(x[8 * s + 6], x[8 * s + 7])}; return *reinterpret_cast<bf16x8*>(&w); }
__device__ __forceinline__ float silu_(float x) { return x * __builtin_amdgcn_rcpf(1.f + __builtin_amdgcn_exp2f(-1.4426950408889634f * x)); }
__device__ __forceinline__ void ret_item(int b, int h, const bf16* __restrict__ RQ, const bf16* __restrict__ RK, bf16* RV, const bf16* __restrict__ RG, const float* __restrict__ gnorm, char* lds) {
  const int tid = threadIdx.x, w = __builtin_amdgcn_readfirstlane(tid >> 6), lane = tid & 63, r32 = lane & 31, hi = lane >> 5;
  const float lg = __log2f(1.f - exp2f(-5.f - (float)h)), gC = exp2f(64.f * lg);
  char* Qs = lds + OFF_Q; char* Ks = lds + OFF_K; char* Vs = lds + OFF_V; float* st = (float*)(lds + OFF_ST); char* Ys = lds + OFF_Y;
  f32x16 S[4] = {};
  const unsigned voffQ = (unsigned)(((tid >> 4) * 512 + (tid & 15) * 8) * 2), voffV = (unsigned)(((tid >> 5) * 1024 + (tid & 31) * 8) * 2);
  const int trq = (lane & 15) >> 2, trp = lane & 3, trg = (lane >> 4) & 1;
  const int vtb = (int)(uintptr_t)(lds + OFF_V) + (4 * hi + trq) * VP + (32 * w + 16 * trg + 4 * trp) * 2, ktb = (int)(uintptr_t)(lds + OFF_K) + (4 * hi + trq) * KPI + (16 * trg + 4 * trp) * 2;
  u32x4 pq[2], pk[2], pv[4];
#define RET_LOAD(cc) do { const size_t t0_ = (size_t)b * SEQ + (size_t)(cc) * C; const char* qb_ = (const char*)(RQ + t0_ * 512 + h * 128); const char* kb_ = (const char*)(RK + t0_ * 512 + h * 128); const char* vb_ = (const char*)(RV + t0_ * 1024 + h * 256); \
    _Pragma("unroll") for (int i = 0; i < 2; ++i) { pq[i] = *(const u32x4*)(qb_ + voffQ + i * 32768); pk[i] = *(const u32x4*)(kb_ + voffQ + i * 32768); } \
    _Pragma("unroll") for (int i = 0; i < 4; ++i) pv[i] = *(const u32x4*)(vb_ + voffV + i * 32768); } while (0)
#define RET_STAGE() do { \
    _Pragma("unroll") for (int i = 0; i < 2; ++i) { const int row = (tid >> 4) + 32 * i, ch = tid & 15; \
      *(u32x4*)(Qs + row * QP + ch * 16) = pq[i]; \
      const u32x4 kv = pk[i]; const float f = exp2f(lg * (float)(C - 1 - row)) * 0.08838834764831845f; \
      u32x4 ko; ko.x = cvtpk(pg8::bf_lo(kv.x) * f, pg8::bf_hi(kv.x) * f); ko.y = cvtpk(pg8::bf_lo(kv.y) * f, pg8::bf_hi(kv.y) * f); ko.z = cvtpk(pg8::bf_lo(kv.z) * f, pg8::bf_hi(kv.z) * f); ko.w = cvtpk(pg8::bf_lo(kv.w) * f, pg8::bf_hi(kv.w) * f); \
      *(u32x4*)(Ks + row * KPI + ch * 16) = ko; } \
    _Pragma("unroll") for (int i = 0; i < 4; ++i) { const int row = (tid >> 5) + 16 * i, ch = tid & 31; *(u32x4*)(Vs + row * VP + ch * 16) = pv[i]; } } while (0)
  RET_LOAD(0);
  __syncthreads();
  RET_STAGE();
  RET_LOAD(1);
  __syncthreads();
  for (int c = 0; c < SEQ / C; ++c) {
    const size_t tok0 = (size_t)b * SEQ + (size_t)c * C;
    f32x16 ot[2] = {};
#pragma unroll
    for (int dt = 0; dt < 4; ++dt) {
#pragma unroll
      for (int s = 0; s < 2; ++s) { const bf16x8 af = pk8(S[dt], s);
#pragma unroll
        for (int nt = 0; nt < 2; ++nt) { const char* qp = Qs + (32 * nt + r32) * QP + (32 * dt + 16 * s + 4 * hi) * 2;
          const u32x2 lo = *(const u32x2*)qp, hi8 = *(const u32x2*)(qp + 16); const u32x4 bw = {lo.x, lo.y, hi8.x, hi8.y};
          ot[nt] = __builtin_amdgcn_mfma_f32_32x32x16_bf16(af, *reinterpret_cast<const bf16x8*>(&bw), ot[nt], 0, 0, 0); } }
      __builtin_amdgcn_sched_barrier(0); }
#pragma unroll
    for (int nt = 0; nt < 2; ++nt)
#pragma unroll
      for (int r = 0; r < 16; ++r) ot[nt][r] *= gC;
    __builtin_amdgcn_sched_barrier(0);
    bf16x8 vfr[4];
    { s16x4 vlo[4], vhi[4];
      vlo[0] = trr<0 * 16 * VP>(vtb); vhi[0] = trr<0 * 16 * VP + 8 * VP>(vtb); vlo[1] = trr<1 * 16 * VP>(vtb); vhi[1] = trr<1 * 16 * VP + 8 * VP>(vtb);
      vlo[2] = trr<2 * 16 * VP>(vtb); vhi[2] = trr<2 * 16 * VP + 8 * VP>(vtb); vlo[3] = trr<3 * 16 * VP>(vtb); vhi[3] = trr<3 * 16 * VP + 8 * VP>(vtb);
      asm volatile("s_waitcnt lgkmcnt(0)" : "+v"(vlo[0]), "+v"(vlo[1]), "+v"(vlo[2]), "+v"(vlo[3]), "+v"(vhi[0]), "+v"(vhi[1]), "+v"(vhi[2]), "+v"(vhi[3]) :: "memory"); __builtin_amdgcn_sched_barrier(0);
#pragma unroll
      for (int ks = 0; ks < 4; ++ks) vfr[ks] = (bf16x8){vlo[ks][0], vlo[ks][1], vlo[ks][2], vlo[ks][3], vhi[ks][0], vhi[ks][1], vhi[ks][2], vhi[ks][3]}; }
#pragma unroll
    for (int nt = 0; nt < 2; ++nt)
#pragma unroll
      for (int jt = 0; jt <= nt; ++jt) { f32x16 pt = {};
#pragma unroll
        for (int kk = 0; kk < 8; ++kk) { const bf16x8 ka = *(const bf16x8*)(Ks + (32 * jt + r32) * KPI + (16 * kk + 8 * hi) * 2), qb = *(const bf16x8*)(Qs + (32 * nt + r32) * QP + (16 * kk + 8 * hi) * 2);
          pt = __builtin_amdgcn_mfma_f32_32x32x16_bf16(ka, qb, pt, 0, 0, 0); }
        if (jt == nt) {
#pragma unroll
          for (int r = 0; r < 16; ++r) if (crow(r, hi) > r32) pt[r] = 0.f; }
#pragma unroll
        for (int s = 0; s < 2; ++s) ot[nt] = __builtin_amdgcn_mfma_f32_32x32x16_bf16(vfr[2 * jt + s], pk8(pt, s), ot[nt], 0, 0, 0);
        __builtin_amdgcn_sched_barrier(0); }
#pragma unroll
    for (int dt = 0; dt < 4; ++dt) {
#pragma unroll
      for (int r = 0; r < 16; ++r) S[dt][r] *= gC;
      s16x4 kl[4], kh[4];
      kl[0] = trr<0 * 16 * KPI>(ktb + dt * 64); kh[0] = trr<0 * 16 * KPI + 8 * KPI>(ktb + dt * 64); kl[1] = trr<1 * 16 * KPI>(ktb + dt * 64); kh[1] = trr<1 * 16 * KPI + 8 * KPI>(ktb + dt * 64);
      kl[2] = trr<2 * 16 * KPI>(ktb + dt * 64); kh[2] = trr<2 * 16 * KPI + 8 * KPI>(ktb + dt * 64); kl[3] = trr<3 * 16 * KPI>(ktb + dt * 64); kh[3] = trr<3 * 16 * KPI + 8 * KPI>(ktb + dt * 64);
      asm volatile("s_waitcnt lgkmcnt(0)" : "+v"(kl[0]), "+v"(kl[1]), "+v"(kl[2]), "+v"(kl[3]), "+v"(kh[0]), "+v"(kh[1]), "+v"(kh[2]), "+v"(kh[3]) :: "memory"); __builtin_amdgcn_sched_barrier(0);
#pragma unroll
      for (int ks = 0; ks < 4; ++ks) S[dt] = __builtin_amdgcn_mfma_f32_32x32x16_bf16((bf16x8){kl[ks][0], kl[ks][1], kl[ks][2], kl[ks][3], kh[ks][0], kh[ks][1], kh[ks][2], kh[ks][3]}, vfr[ks], S[dt], 0, 0, 0);
      __builtin_amdgcn_sched_barrier(0); }
    u32x4 gt4[4];
    { const char* gb_ = (const char*)(RG + tok0 * 1024 + h * 256);
#pragma unroll
      for (int i = 0; i < 4; ++i) gt4[i] = *(const u32x4*)(gb_ + voffV + i * 32768); }
#pragma unroll
    for (int nt = 0; nt < 2; ++nt) { const float rs = exp2f(lg * (float)(32 * nt + r32 + 1 - C)); float s1 = 0.f, s2 = 0.f;
#pragma unroll
      for (int r = 0; r < 16; ++r) { ot[nt][r] *= rs; s1 += ot[nt][r]; s2 += ot[nt][r] * ot[nt][r]; }
      s1 = xhalf_sum(s1); s2 = xhalf_sum(s2);
      if (hi == 0) { st[(w * 64 + 32 * nt + r32) * 2] = s1; st[(w * 64 + 32 * nt + r32) * 2 + 1] = s2; } }
    __syncthreads();
    if (c + 1 < SEQ / C) { RET_STAGE(); if (c + 2 < SEQ / C) RET_LOAD(c + 2); }
#pragma unroll
    for (int nt = 0; nt < 2; ++nt) { float s1 = 0.f, s2 = 0.f;
#pragma unroll
      for (int ww = 0; ww < 8; ++ww) { s1 += st[(ww * 64 + 32 * nt + r32) * 2]; s2 += st[(ww * 64 + 32 * nt + r32) * 2 + 1]; }
      const float mu = s1 * (1.f / 256.f), var = fmaxf(s2 * (1.f / 256.f) - mu * mu, 0.f), rstd = rsqrtf(var + EPS);
#pragma unroll
      for (int g = 0; g < 4; ++g) { float y[4];
#pragma unroll
        for (int j = 0; j < 4; ++j) y[j] = (ot[nt][4 * g + j] - mu) * rstd * gnorm[h * 256 + 32 * w + 8 * g + 4 * hi + j];
        const u32x2 o2 = {cvtpk(y[0], y[1]), cvtpk(y[2], y[3])};
        *(u32x2*)(Ys + (32 * nt + r32) * VP + (32 * w + 8 * g + 4 * hi) * 2) = o2; } }
    __syncthreads();
    { char* ob_ = (char*)(RV + tok0 * 1024 + h * 256);
#pragma unroll
      for (int i = 0; i < 4; ++i) { const int row = (tid >> 5) + 16 * i, ch = tid & 31;
        const u32x4 yv = *(const u32x4*)(Ys + row * VP + ch * 16); const u32x4 gt = gt4[i];
        u32x4 o; o.x = cvtpk(pg8::bf_lo(yv.x) * silu_(pg8::bf_lo(gt.x)), pg8::bf_hi(yv.x) * silu_(pg8::bf_hi(gt.x))); o.y = cvtpk(pg8::bf_lo(yv.y) * silu_(pg8::bf_lo(gt.y)), pg8::bf_hi(yv.y) * silu_(pg8::bf_hi(gt.y)));
        o.z = cvtpk(pg8::bf_lo(yv.z) * silu_(pg8::bf_lo(gt.z)), pg8::bf_hi(yv.z) * silu_(pg8::bf_hi(gt.z))); o.w = cvtpk(pg8::bf_lo(yv.w) * silu_(pg8::bf_lo(gt.w)), pg8::bf_hi(yv.w) * silu_(pg8::bf_hi(gt.w)));
        *(u32x4*)(ob_ + voffV + i * 32768) = o; } }
  }
#undef RET_LOAD
#undef RET_STAGE
}
}

__device__ __forceinline__ void p4_attn(Frame& F, const Args& a, unsigned char* lds_generic) {
    const size_t nt_ = (size_t)F.ntok;
    const bf16* QA = (const bf16*)(F.act + nt_ * O_QA); bf16* ATT = (bf16*)(F.act + nt_ * O_QA);
    unsigned char* aux = a.xb + nt_ * 2048;
    const bf16* KP = (const bf16*)(aux + nt_ * AUX_KP); const bf16* VV = (const bf16*)(aux + nt_ * AUX_VV); const unsigned* MASK = (const unsigned*)(aux + nt_ * AUX_MASK);
    volatile LAS unsigned* MISC = (volatile LAS unsigned*)(F.lds + MISC_OFF);
    unsigned* qctr = (unsigned*)(F.ws + WS_CTL) + CW_Q4;
    const bf16* RQ = (const bf16*)(F.act + nt_ * O_RQ); const bf16* RK = (const bf16*)(F.act + nt_ * O_RK); bf16* RV = (bf16*)(F.act + nt_ * O_RV); const bf16* RG = (const bf16*)(F.act + nt_ * O_RG);
    const int nb = F.ntok / SEQ, nret = nb * 4, nitems = nb * 64;
    for (;;) {
        __syncthreads(); if (F.tid == 0) MISC[0] = atomicAdd(qctr + 16, 1u); __syncthreads();
        const int it = (int)MISC[0]; if (it >= nret || a.mode == 1) break;
        ret::ret_item(it >> 2, it & 3, RQ, RK, RV, RG, a.in[8], (char*)lds_generic);
    }
    for (;;) {
        __syncthreads(); if (F.tid == 0) MISC[0] = atomicAdd(qctr, 1u); __syncthreads();
        const int it = (int)MISC[0]; if (it >= nitems || a.mode == 2) break;
        const int qb = 63 - it / nb, b = it % nb, NT = (qb >> 1) + 1;
        const size_t row0 = (size_t)b * SEQ + qb * 32;
        att::attn_item(QA + row0 * 1024, KP + (size_t)b * SEQ * 128, VV + (size_t)b * SEQ * 128, MASK + (size_t)b * 64 * 2048 + qb * 32, ATT + row0 * 1024, NT, (char*)lds_generic, F.lds);
    }
}


__device__ __forceinline__ void p7_router(Frame& F, const Args& a) {
    const int lane = F.lane, r32 = lane & 31, hi = lane >> 5, tid = F.tid;
    unsigned char* mo = F.act; bf16* N2 = (bf16*)(mo + MO_N2); unsigned char* meta = mo + MO_META;
    int* MB = (int*)(meta + MM_B); int* MPp = (int*)(meta + MM_P); float* MCL = (float*)(meta + MM_CL); float* MCH = (float*)(meta + MM_CH); float* MRS = (float*)(meta + MM_RS);
    const bf16* Wh = (const bf16*)(F.ws + WS_WR); const bf16* Wl = Wh + 32 * 1024;
    const float* g2 = a.in[12]; const float* b_gr = a.in[14]; const float* b_er = a.in[16];
    const bf16* hbase = (const bf16*)(F.act + MO_H16);
    unsigned* gcnt = (unsigned*)(F.ws + WS_CTL) + CW_MOE;
    LAS unsigned* lcnt = (LAS unsigned*)(F.lds + RING_OFF);
    if (tid < 64) lcnt[tid] = 0u;
    __syncthreads();
    const int ntasks = F.ntok / 32, tpw = ntasks / F.G;
    const int tw = F.wave & 3, kh = F.wave >> 2;
    const bool have = tw < tpw; const int t = (F.vcu * tpw + tw) * 32 + r32;
    LAS float* xch = (LAS float*)(F.lds + RING_OFF + 1024);
    int bucket = 0, posl = 0; float clo = 0.f, chi = 0.f, rstd = 0.f;
    f32x16 acc = f32x16{}; float ss = 0.f;
    if (have) {
        const bf16* hrow = hbase + (size_t)t * D + hi * 8 + kh * 512; bf16* nrow = N2 + (size_t)t * D + hi * 8 + kh * 512;
        const float* g2k = g2 + kh * 512 + hi * 8; const bf16* whk = Wh + (size_t)r32 * 1024 + kh * 512 + hi * 8; const bf16* wlk = Wl + (size_t)r32 * 1024 + kh * 512 + hi * 8;
#pragma unroll 8
        for (int kk = 0; kk < 32; ++kk) {
            const v4u hv = *(const v4u*)(hrow + kk * 16); const f32x4 a0 = {pg8::bf_lo(hv.x), pg8::bf_hi(hv.x), pg8::bf_lo(hv.y), pg8::bf_hi(hv.y)}, a1 = {pg8::bf_lo(hv.z), pg8::bf_hi(hv.z), pg8::bf_lo(hv.w), pg8::bf_hi(hv.w)};
            const f32x4 q0 = *(const f32x4*)(g2k + kk * 16), q1 = *(const f32x4*)(g2k + kk * 16 + 4);
            ss += (a0.x * a0.x + a0.y * a0.y) + (a0.z * a0.z + a0.w * a0.w) + (a1.x * a1.x + a1.y * a1.y) + (a1.z * a1.z + a1.w * a1.w);
            const float x[8] = {a0.x * q0.x, a0.y * q0.y, a0.z * q0.z, a0.w * q0.w, a1.x * q1.x, a1.y * q1.y, a1.z * q1.z, a1.w * q1.w};
            unsigned hb[8]; float lo[8];
#pragma unroll
            for (int j = 0; j < 8; ++j) { hb[j] = f2bf(x[j]); lo[j] = x[j] - __uint_as_float(hb[j] << 16); }
            v4u xh; xh.x = hb[0] | (hb[1] << 16); xh.y = hb[2] | (hb[3] << 16); xh.z = hb[4] | (hb[5] << 16); xh.w = hb[6] | (hb[7] << 16);
            v4u xl; xl.x = pk2(lo[0], lo[1]); xl.y = pk2(lo[2], lo[3]); xl.z = pk2(lo[4], lo[5]); xl.w = pk2(lo[6], lo[7]);
            *(v4u*)(nrow + kk * 16) = xh;
            const bf16x8_t wh = *(const bf16x8_t*)(whk + kk * 16), wl = *(const bf16x8_t*)(wlk + kk * 16);
            const bf16x8_t bh = __builtin_bit_cast(bf16x8_t, xh), bl = __builtin_bit_cast(bf16x8_t, xl);
            acc = __builtin_amdgcn_mfma_f32_32x32x16_bf16(wh, bh, acc, 0, 0, 0);
            acc = __builtin_amdgcn_mfma_f32_32x32x16_bf16(wh, bl, acc, 0, 0, 0);
            acc = __builtin_amdgcn_mfma_f32_32x32x16_bf16(wl, bh, acc, 0, 0, 0);
        }
        if (kh == 1) {
#pragma unroll
            for (int r = 0; r < 16; ++r) xch[(tw * 17 + r) * 64 + lane] = acc[r];
            xch[(tw * 17 + 16) * 64 + lane] = ss; }
    }
    __syncthreads();
    if (have && kh == 0) {
#pragma unroll
        for (int r = 0; r < 16; ++r) acc[r] += xch[(tw * 17 + r) * 64 + lane];
        ss += xch[(tw * 17 + 16) * 64 + lane];
        ss = xhalf_sum(ss); rstd = rsqrtf(ss * (1.f / D) + EPS);
        float L[24];
#pragma unroll
        for (int r = 0; r < 12; ++r) { const float v = acc[r]; auto rr = __builtin_amdgcn_permlane32_swap(__float_as_uint(v), __float_as_uint(v), false, false);
            L[(r & 3) + 8 * (r >> 2)] = __uint_as_float(rr[0]); L[(r & 3) + 8 * (r >> 2) + 4] = __uint_as_float(rr[1]); }
        float gl[4];
#pragma unroll
        for (int i = 0; i < 4; ++i) gl[i] = L[i] * rstd + b_gr[i];
        int g = 0; float gm = gl[0];
#pragma unroll
        for (int i = 1; i < 4; ++i) if (gl[i] > gm) { gm = gl[i]; g = i; }
        float se = 0.f;
#pragma unroll
        for (int i = 0; i < 4; ++i) se += __expf(gl[i] - gm);
        const float gw = 1.f / se;
        float el[4];
#pragma unroll
        for (int i = 0; i < 4; ++i) { const float l0 = L[4 + i], l1 = L[8 + i], l2 = L[12 + i], l3 = L[16 + i]; const float lv = g == 0 ? l0 : (g == 1 ? l1 : (g == 2 ? l2 : l3));
            const float b0 = b_er[i], b1 = b_er[4 + i], b2 = b_er[8 + i], b3 = b_er[12 + i]; el[i] = lv * rstd + (g == 0 ? b0 : (g == 1 ? b1 : (g == 2 ? b2 : b3))); }
        int i1 = 0; float v1 = el[0];
#pragma unroll
        for (int i = 1; i < 4; ++i) if (el[i] > v1) { v1 = el[i]; i1 = i; }
        int i2 = -1; float v2 = 0.f;
#pragma unroll
        for (int i = 0; i < 4; ++i) if (i != i1 && (i2 < 0 || el[i] > v2)) { v2 = el[i]; i2 = i; }
        const float e2 = __expf(v2 - v1), p1 = gw / (1.f + e2), p2 = gw * e2 / (1.f + e2);
        const int lo_ = i1 < i2 ? i1 : i2, hi_ = i1 < i2 ? i2 : i1;
        const int pair = lo_ == 0 ? (hi_ - 1) : (lo_ == 1 ? (hi_ + 1) : 5);
        bucket = g * 6 + pair; clo = i1 < i2 ? p1 : p2; chi = i1 < i2 ? p2 : p1;
        if (hi == 0) posl = (int)__hip_atomic_fetch_add(&lcnt[bucket], 1u, __ATOMIC_RELAXED, __HIP_MEMORY_SCOPE_WORKGROUP);
    }
    __syncthreads();
    if (tid < 24) lcnt[32 + tid] = atomicAdd(gcnt + tid, lcnt[tid]);
    __syncthreads();
    if (have && kh == 0 && hi == 0) { MB[t] = bucket; MPp[t] = (int)lcnt[32 + bucket] + posl; MCL[t] = clo; MCH[t] = chi; MRS[t] = rstd; }
}
__device__ __forceinline__ int moe_tiles(const unsigned* gcnt, int* rowstart  ) { int rs = 0;
    for (int b = 0; b < 24; ++b) { rowstart[b] = rs; rs += (int)((gcnt[b] + 255u) & ~255u); } rowstart[24] = rs; return rs >> 8; }
__device__ __forceinline__ void p8_permute(Frame& F, const Args& a) {
    unsigned char* mo = F.act; unsigned char* meta = mo + MO_META;
    const int* MB = (const int*)(meta + MM_B); const int* MPp = (const int*)(meta + MM_P); const float* MCL = (const float*)(meta + MM_CL); const float* MCH = (const float*)(meta + MM_CH); const float* MRS = (const float*)(meta + MM_RS);
    int* PTOK = (int*)(meta + MM_PTOK); float* PRS = (float*)(meta + MM_PRS); float* PCL = (float*)(meta + MM_PCL); float* PCH = (float*)(meta + MM_PCH);
    const unsigned* gcnt = (const unsigned*)(F.ws + WS_CTL) + CW_MOE;
    LAS int* rsL = (LAS int*)(F.lds + RING_OFF);
    if (F.tid == 0) { int rs = 0; for (int b = 0; b < 24; ++b) { rsL[b] = rs; rs += (int)((gcnt[b] + 255u) & ~255u); } rsL[24] = rs; }
    __syncthreads();
    const int gw = F.vcu * NWAVES + F.wave, NGW = F.G * NWAVES;
    const int gt = gw * 64 + F.lane, NGT = NGW * 64;
    for (int t = gt; t < F.ntok; t += NGT) { const int b = MB[t], prow = rsL[b] + MPp[t]; PTOK[prow] = t; PRS[prow] = MRS[t]; PCL[prow] = MCL[t]; PCH[prow] = MCH[t]; }
    for (int b = 0; b < 24; ++b) { const int c = (int)gcnt[b], p0 = rsL[b] + c, p1 = rsL[b + 1];
        for (int r = p0 + gt; r < p1; r += NGT) { PTOK[r] = -1; PRS[r] = 0.f; PCL[r] = 0.f; PCH[r] = 0.f; } }
}
template <bool GATHER_> struct MoeOrder {
    static constexpr bool GATHER = GATHER_; const int* ptok;
    int ntile, G, c; const char* A; size_t tA; const char* W; int mode; const LAS unsigned char* tb;
    __device__ bool next(int i, pg8::Unit& u) const {
        const long L = (long)i * G + c; if (L >= (long)ntile * 4) return false;
        u.pm = (int)(L >> 2); u.pn = (int)(L & 3); u.a = GATHER_ ? A : A + (size_t)u.pm * tA;
        const int bk = tb[u.pm], g = bk / 6, pr = bk % 6; const int lo = pr < 3 ? 0 : (pr < 5 ? 1 : 2), hi = pr < 3 ? pr + 1 : (pr < 5 ? pr - 1 : 3);
        const int elo = g * 4 + lo, ehi = g * 4 + hi; u.aux = 0;
        if (mode == 1) { const int e = u.pn < 2 ? elo : ehi; u.b = W + ((size_t)e * 512 + (size_t)(u.pn & 1) * 256) * 1024 * 2; u.bjump = 0; }
        else { u.b = W + ((size_t)elo * 1024 + (size_t)u.pn * 256) * 256 * 2; u.bjump = (long)(ehi - elo) * 1024 * 256 * 2 - 4 * 128; }
        return true;
    }
    __device__ __forceinline__ void a_ready(const pg8::Unit&) const {}
    __device__ __forceinline__ void done(const pg8::Unit&) const {}
};
__device__ __forceinline__ float silu_f(float x) { return x * __builtin_amdgcn_rcpf(1.f + __builtin_amdgcn_exp2f(-1.4426950408889634f * x)); }
struct EpiMoe1 {
    static constexpr bool PERM = true, AFTER_DRAIN = false;
    pg8::bf16_t* ACT; const float* PRS; const float* PCL; const float* PCH;
    __device__ __forceinline__ void operator()(const pg8::f32x4 (&acc)[2][2][4][2], const pg8::Unit& u, int wr, int wc, int fr, int fq) const {
        const int row0 = u.pm * pg8::BM + wr * 64 + fr, slot = u.pn >> 1, fcol0 = slot * 256 + (u.pn & 1) * 128 + wc * 16 + 4 * fq; const float* PC = slot ? PCH : PCL;
#pragma unroll
        for (int ai = 0; ai < 2; ++ai)
#pragma unroll
            for (int m = 0; m < 4; ++m) { const int row = row0 + ai * pg8::HALF + m * 16; const float rs = PRS[row], cw = PC[row]; pg8::bf16_t* rowp = ACT + (size_t)row * 512 + fcol0;
#pragma unroll
                for (int bj = 0; bj < 2; ++bj) { const pg8::f32x4 v0 = acc[ai][bj][m][0], v1 = acc[ai][bj][m][1];
                    const float a0 = silu_f(v0[0] * rs) * (v0[1] * rs) * cw, a1 = silu_f(v0[2] * rs) * (v0[3] * rs) * cw, a2 = silu_f(v1[0] * rs) * (v1[1] * rs) * cw, a3 = silu_f(v1[2] * rs) * (v1[3] * rs) * cw;
                    pg8::u32x2 w; w.x = pg8::cvt_pk_bf16(a0, a1); w.y = pg8::cvt_pk_bf16(a2, a3); *(pg8::u32x2*)(rowp + bj * 64) = w; } }
    }
};
struct EpiMoe2 {
    static constexpr bool PERM = false, AFTER_DRAIN = false;
    float* out; const pg8::bf16_t* h16; const int* PTOK;
    __device__ __forceinline__ void operator()(const pg8::f32x4 (&acc)[2][2][4][2], const pg8::Unit& u, int wr, int wc, int fr, int fq) const {
        const int row0 = u.pm * pg8::BM + wr * 64 + fr, col0 = u.pn * pg8::BM + wc * 32 + 4 * fq;
#pragma unroll
        for (int ai = 0; ai < 2; ++ai)
#pragma unroll
            for (int m = 0; m < 4; ++m) { const int tok = PTOK[row0 + ai * pg8::HALF + m * 16];
                if (tok >= 0) { float* rowp = out + (size_t)tok * 1024 + col0; const pg8::bf16_t* hp = h16 + (size_t)tok * 1024 + col0;
#pragma unroll
                    for (int bj = 0; bj < 2; ++bj)
#pragma unroll
                        for (int n = 0; n < 2; ++n) { const pg8::u32x2 hv = *(const pg8::u32x2*)(hp + bj * pg8::HALF + n * 16); const pg8::f32x4 hf = {pg8::bf_lo(hv.x), pg8::bf_hi(hv.x), pg8::bf_lo(hv.y), pg8::bf_hi(hv.y)};
                            *(pg8::f32x4*)(rowp + bj * pg8::HALF + n * 16) = hf + acc[ai][bj][m][n]; } } }
    }
};
__device__ __forceinline__ int moe_setup(Frame& F, LAS unsigned char* tb) {
    const unsigned* gcnt = (const unsigned*)(F.ws + WS_CTL) + CW_MOE;
    LAS int* nt_ = (LAS int*)(tb + 256);
    __syncthreads();
    if (F.tid == 0) { int tl = 0; for (int b = 0; b < 24; ++b) { const int n = (int)((gcnt[b] + 255u) >> 8); for (int i = 0; i < n; ++i) tb[tl + i] = (unsigned char)b; tl += n; } nt_[0] = tl; }
    __syncthreads();
    return nt_[0];
}

__global__ void __launch_bounds__(NWAVES * 64, 2) mk_fwd(Args args) {
    extern __shared__ __attribute__((aligned(16))) unsigned char lds[];
    Frame F;
    F.lds = (LAS unsigned char*)lds;
    F.tid = threadIdx.x; F.lane = F.tid & 63; F.wave = __builtin_amdgcn_readfirstlane(F.tid >> 6);
    F.G = gridDim.x; { const int bx = blockIdx.x; F.vcu = (F.G % 8 == 0) ? (bx % 8) * (F.G / 8) + bx / 8 : bx; }
    F.ntok = args.ntok; F.ws = args.ws; F.act = args.ws + WS_ACT;
    const int lo = args.ph_lo, hi = args.ph_hi;
    cooperative_groups::grid_group grid = cooperative_groups::this_grid();
    volatile LAS unsigned* MISCW = (volatile LAS unsigned*)(F.lds + MISC_OFF);
    for (int u = F.tid; u < (LDS_BYTES - LDSCTL_OFF) / 4; u += NWAVES * 64) ((LAS unsigned*)(F.lds + LDSCTL_OFF))[u] = 0u;
    __syncthreads();
    XcdBarrier bar = xcd_barrier_post((unsigned*)(F.ws + WS_CTL) + CW_BAR, MISCW + 8);
#define IN(k) (lo <= (k) && (k) < hi)
#define SEAM(k) do { if (IN(k) && IN((k) + 1)) { xcd_barrier(bar); } } while (0)
    if (IN(0)) { p0_prologue(F, args); }
    SEAM(0);
    if (IN(1)) {
        EpiProj E{F.act, (size_t)F.ntok};
        { pg8::Gemm g{512, 512, 512, 8};
          P1Order S; S.nM = F.ntok / 256; S.nN = 25; S.nwg = S.nM * 25; S.G = F.G; S.c = (int)blockIdx.x; S.mode = 0; S.A = (const char*)(args.xb + (size_t)F.ntok * AUX_XB8); S.Bt = (const char*)(F.ws + WS_WIN8); S.tA = (size_t)256 * 1024; S.tB = (size_t)256 * 1024;
          pg8::gemm_phase<EpiProj, P1Order, true, true, true>(F.lds + RING_OFF, g, S, E); }
        { pg8::Gemm g{1024, 1024, 1024, 16};
          P1Order S; S.nM = F.ntok / 256; S.nN = 3; S.nwg = S.nM * 3; S.G = F.G; S.c = ((int)blockIdx.x + F.G / 2) % F.G; S.mode = 1; S.A = (const char*)args.xb; S.Bt = (const char*)(F.ws + WS_WIN); S.tA = (size_t)256 * 2048; S.tB = (size_t)256 * 2048;
          pg8::gemm_phase<EpiProj, P1Order, true, true, false>(F.lds + RING_OFF, g, S, E); }
    }
    SEAM(1);
    if (IN(2)) { p2_post(F, args); }
    SEAM(2);
    if (IN(3)) { p3_index(F, args); }
    SEAM(3);
    if (IN(4)) { p4_attn(F, args, lds); }
    SEAM(4);
    if (IN(5)) {
        pg8::Gemm g{1024, 1024, 1024, 16}; const size_t nt_ = (size_t)F.ntok;
        pg8::bf16_t* GA = (pg8::bf16_t*)(F.act + nt_ * O_GA); const pg8::bf16_t* GR = (const pg8::bf16_t*)(F.act + nt_ * O_GR);
        { pg8::StaticOrder S; S.init(F.ntok, 1024, F.G, (int)blockIdx.x, F.act + nt_ * O_QA, 1024, F.ws + WS_WATT, 1024); EpiGateA E{GA};
          pg8::gemm_phase<EpiGateA, pg8::StaticOrder, true, true>(F.lds + RING_OFF, g, S, E); }
        { pg8::StaticOrder S; S.init(F.ntok, 1024, F.G, (int)blockIdx.x, F.act + nt_ * O_RV, 1024, F.ws + WS_WRET, 1024); EpiGateB E{GA, GR};
          pg8::gemm_phase<EpiGateB, pg8::StaticOrder, true, true>(F.lds + RING_OFF, g, S, E); }
    }
    SEAM(5);
    if (IN(6)) {
        pg8::Gemm g{1024, 1024, 1024, 16}; const size_t nt_ = (size_t)F.ntok;
        pg8::StaticOrder S; S.init(F.ntok, 1024, F.G, (int)blockIdx.x, F.act + nt_ * O_GA, 1024, F.ws + WS_WOUT, 1024);
        EpiResid E{args.in[0] + (size_t)args.tok0 * D, (pg8::bf16_t*)(F.act + MO_H16)};
        pg8::gemm_phase<EpiResid, pg8::StaticOrder, true, true>(F.lds + RING_OFF, g, S, E);
    }
    SEAM(6);
    if (IN(7)) { p7_router(F, args); }
    SEAM(7);
    if (IN(8)) { p8_permute(F, args); }
    SEAM(8);
    if (IN(9)) {
        LAS unsigned char* tb = F.lds + LDSCTL_OFF - 1024; const int ntile = moe_setup(F, tb);
        unsigned char* meta = F.act + MO_META;
        pg8::Gemm g{1024, 1024, 1024, 16};
        MoeOrder<true> S{(const int*)(meta + MM_PTOK), ntile, F.G, (int)blockIdx.x, (const char*)(F.act + MO_N2), (size_t)256 * 1024 * 2, (const char*)(F.ws + WS_W1), 1, tb};
        EpiMoe1 E{(pg8::bf16_t*)(F.act + MO_ACT), (const float*)(meta + MM_PRS), (const float*)(meta + MM_PCL), (const float*)(meta + MM_PCH)};
        pg8::gemm_phase<EpiMoe1, MoeOrder<true>, true, true>(F.lds + RING_OFF, g, S, E);
    }
    SEAM(9);
    if (IN(10)) {
        LAS unsigned char* tb = F.lds + LDSCTL_OFF - 1024; const int ntile = moe_setup(F, tb);
        unsigned char* meta = F.act + MO_META;
        pg8::Gemm g{512, 512, 256, 4};
        MoeOrder<false> S{nullptr, ntile, F.G, (int)blockIdx.x, (const char*)(F.act + MO_ACT), (size_t)256 * 512 * 2, (const char*)(F.ws + WS_WD), 2, tb};
        EpiMoe2 E{args.out + (size_t)args.tok0 * D, (const pg8::bf16_t*)(F.act + MO_H16), (const int*)(meta + MM_PTOK)};
        pg8::gemm_phase<EpiMoe2, MoeOrder<false>, true, true>(F.lds + RING_OFF, g, S, E);
    }
    if (hi - lo > 1) grid.sync();
#undef IN
#undef SEAM
}

__device__ __forceinline__ float block_sum256(float v, float* red) {
#pragma unroll
    for (int o = 32; o > 0; o >>= 1) v += __shfl_xor(v, o);
    __syncthreads();
    if ((threadIdx.x & 63) == 0) red[threadIdx.x >> 6] = v;
    __syncthreads();
    return red[0] + red[1] + red[2] + red[3];
}
__device__ __forceinline__ float block_max256(float v, float* red) {
#pragma unroll
    for (int o = 32; o > 0; o >>= 1) v = fmaxf(v, __shfl_xor(v, o));
    __syncthreads();
    if ((threadIdx.x & 63) == 0) red[threadIdx.x >> 6] = v;
    __syncthreads();
    return fmaxf(fmaxf(red[0], red[1]), fmaxf(red[2], red[3]));
}
__device__ __forceinline__ float sigmoidf_(float x) { return 1.f / (1.f + expf(-x)); }
__device__ __forceinline__ float siluf_(float x) { return x / (1.f + expf(-x)); }

__global__ void __launch_bounds__(256) nv_rmsnorm(const float* inb, long in_ld, float* outb, long out_ld, int ninner, int width, const float* gain, int gstride) {
    __shared__ float red[8];
    const int r = blockIdx.x, t = r / ninner, i = r % ninner;
    const float* in = inb + (long)t * in_ld + (long)i * width;
    float* out = outb + (long)t * out_ld + (long)i * width;
    float s = 0.f;
    for (int c = threadIdx.x; c < width; c += 256) { const float v = in[c]; s += v * v; }
    s = block_sum256(s, red);
    const float rs = rsqrtf(s / (float)width + EPS);
    for (int c = threadIdx.x; c < width; c += 256) out[c] = in[c] * rs * gain[i * gstride + c];
}
__global__ void __launch_bounds__(256) nv_gemm(const float* A, long lda, const float* B, long ldb, float* C, long ldc, int M, int N, int K) {
    __shared__ float As[8][128 + 4];
    __shared__ float Bs[8][128 + 4];
    const int tid = threadIdx.x, tx = tid & 15, ty = tid >> 4;
    const int m0 = blockIdx.y * 128, n0 = blockIdx.x * 128;
    float acc[8][8];
#pragma unroll
    for (int i = 0; i < 8; ++i)
#pragma unroll
        for (int j = 0; j < 8; ++j) acc[i][j] = 0.f;
    for (int k0 = 0; k0 < K; k0 += 8) {
        { const int r = tid >> 1, kk = (tid & 1) * 4;
          const float4 v = *(const float4*)(A + (long)(m0 + r) * lda + k0 + kk);
          As[kk + 0][r] = v.x; As[kk + 1][r] = v.y; As[kk + 2][r] = v.z; As[kk + 3][r] = v.w; }
        { const int kk = tid >> 5, c = (tid & 31) * 4;
#pragma unroll
          for (int j = 0; j < 4; ++j) { const int n = n0 + c + j; Bs[kk][c + j] = (n < N) ? B[(long)(k0 + kk) * ldb + n] : 0.f; } }
        __syncthreads();
#pragma unroll
        for (int kk = 0; kk < 8; ++kk) {
            float a[8], b[8];
#pragma unroll
            for (int i = 0; i < 8; ++i) a[i] = As[kk][ty * 8 + i];
#pragma unroll
            for (int j = 0; j < 8; ++j) b[j] = Bs[kk][tx * 8 + j];
#pragma unroll
            for (int i = 0; i < 8; ++i)
#pragma unroll
                for (int j = 0; j < 8; ++j) acc[i][j] += a[i] * b[j];
        }
        __syncthreads();
    }
#pragma unroll
    for (int i = 0; i < 8; ++i)
#pragma unroll
        for (int j = 0; j < 8; ++j) { const int n = n0 + tx * 8 + j; if (n < N) C[(long)(m0 + ty * 8 + i) * ldc + n] = acc[i][j]; }
}
__global__ void __launch_bounds__(256) nv_attn(const float* proj, const float* kv, float* att, float wscale, float dscale, float lscale, const unsigned* maskb) {
    __shared__ float s_qi[512], s_w[8], s_score[2048], s_q[1024], s_p[8][256], red[8];
    __shared__ int s_sel[256 + 64]; __shared__ int s_pref[65]; __shared__ unsigned s_mw[64];
    const int tq = blockIdx.x, b = tq / SEQ, t = tq % SEQ, tid = threadIdx.x;
    const float* prow = proj + (long)tq * INW;
    const float* pb = proj + (long)b * SEQ * INW;
    const float* kvb = kv + (long)b * SEQ * 256;
    for (int i = tid; i < 512; i += 256) s_qi[i] = prow[C_QI + i];
    for (int i = tid; i < 1024; i += 256) s_q[i] = prow[C_QA + i];
    if (tid < 8) s_w[tid] = prow[C_WI + tid] * wscale;
    __syncthreads();
    const int n = t + 1;
    int cnt;
    if (maskb) {
        if (tid < 64) s_mw[tid] = (tid * 32 <= t) ? maskb[tid * 2048 + t] : 0u;
        __syncthreads();
        if (tid == 0) { int c = 0; for (int i = 0; i < 64; ++i) { s_pref[i] = c; c += __builtin_popcount(s_mw[i]); } s_pref[64] = c; }
        __syncthreads();
        if (tid < 64) { unsigned x = s_mw[tid]; int p = s_pref[tid]; while (x) { const int bpos = __builtin_ctz(x); x &= x - 1; if (p < 256) s_sel[p] = tid * 32 + bpos; ++p; } }
        cnt = s_pref[64] < 256 ? s_pref[64] : 256;
        __syncthreads();
    } else {
    for (int s = tid; s < n; s += 256) {
        const float* kr = pb + (long)s * INW + C_KI;
        float kk[64];
#pragma unroll
        for (int d = 0; d < 64; ++d) kk[d] = kr[d];
        float sc = 0.f;
#pragma unroll
        for (int h = 0; h < 8; ++h) {
            float dt = 0.f;
#pragma unroll
            for (int d = 0; d < 64; ++d) dt += s_qi[h * 64 + d] * kk[d];
            dt *= dscale;
            sc += fmaxf(dt, 0.f) * s_w[h];
        }
        s_score[s] = sc;
    }
    __syncthreads();
    if (n <= 256) { if (tid < n) s_sel[tid] = tid; cnt = n; }
    else {
        for (int s = tid; s < n; s += 256) {
            const float v = s_score[s]; int rank = 0;
            for (int j = 0; j < n; ++j) { const float u = s_score[j]; rank += (u > v || (u == v && j < s)) ? 1 : 0; }
            if (rank < 256) s_sel[rank] = s;
        }
        cnt = 256;
    }
    __syncthreads();
    }
    float lg[8];
    const bool act = tid < cnt;
    const int sj = act ? s_sel[tid] : 0;
    {
        const float* kr = kvb + (long)sj * 256;
#pragma unroll
        for (int h = 0; h < 8; ++h) lg[h] = 0.f;
        for (int d = 0; d < 128; ++d) { const float kd = kr[d];
#pragma unroll
            for (int h = 0; h < 8; ++h) lg[h] += s_q[h * 128 + d] * kd; }
    }
#pragma unroll
    for (int h = 0; h < 8; ++h) {
        const float slope = exp2f(-(float)(h + 1));
        float x = act ? (lg[h] * lscale - slope * (float)(t - sj)) : -INFINITY;
        const float m = block_max256(x, red);
        const float e = act ? expf(x - m) : 0.f;
        const float su = block_sum256(e, red);
        s_p[h][tid] = e / su;
    }
    __syncthreads();
    float o4[4] = {0.f, 0.f, 0.f, 0.f};
    for (int j = 0; j < cnt; ++j) {
        const float* vr = kvb + (long)s_sel[j] * 256 + 128;
#pragma unroll
        for (int i = 0; i < 4; ++i) { const int o = tid + 256 * i; o4[i] += s_p[o >> 7][j] * vr[o & 127]; }
    }
#pragma unroll
    for (int i = 0; i < 4; ++i) att[(long)tq * 1024 + tid + 256 * i] = o4[i];
}
__global__ void __launch_bounds__(256) nv_ret(const float* proj, float* reto) {
    __shared__ float sq[128], sk[128];
    const int b = blockIdx.x >> 2, h = blockIdx.x & 3, v = threadIdx.x;
    const float gamma = 1.f - exp2f(-5.f - (float)h);
    float S[128];
#pragma unroll
    for (int d = 0; d < 128; ++d) S[d] = 0.f;
    for (int t = 0; t < SEQ; ++t) {
        const float* row = proj + (long)(b * SEQ + t) * INW;
        if (v < 128) { sq[v] = row[C_RQ + h * 128 + v]; sk[v] = row[C_RK + h * 128 + v] * 0.08838834764831845f; }
        __syncthreads();
        const float vv = row[C_RV + h * 256 + v];
        float o = 0.f;
#pragma unroll
        for (int d = 0; d < 128; ++d) { S[d] = gamma * S[d] + sk[d] * vv; o += sq[d] * S[d]; }
        reto[(long)(b * SEQ + t) * 1024 + h * 256 + v] = o;
        __syncthreads();
    }
}
__global__ void __launch_bounds__(256) nv_retpost(const float* proj, const float* reto, const float* g, float* a2) {
    __shared__ float red[8];
    const int t = blockIdx.x >> 2, h = blockIdx.x & 3, c = threadIdx.x;
    const float x = reto[(long)t * 1024 + h * 256 + c];
    const float mu = block_sum256(x, red) * (1.f / 256.f);
    const float dv = x - mu;
    const float var = block_sum256(dv * dv, red) * (1.f / 256.f);
    const float y = dv * rsqrtf(var + EPS) * g[h * 256 + c];
    a2[(long)t * 1024 + h * 256 + c] = siluf_(proj[(long)t * INW + C_RG + h * 256 + c]) * y;
}
__global__ void __launch_bounds__(256) nv_mix(const float* proj, const float* ya, const float* yr, float* mix) {
    const long i = (long)blockIdx.x * 256 + threadIdx.x; const long t = i >> 10; const int c = (int)(i & 1023);
    mix[i] = sigmoidf_(proj[t * INW + C_GA + c]) * ya[i] + sigmoidf_(proj[t * INW + C_GR + c]) * yr[i];
}
__global__ void __launch_bounds__(256) nv_add(const float* a, const float* b, float* o) {
    const long i = (long)blockIdx.x * 256 + threadIdx.x; o[i] = a[i] + b[i];
}
__global__ void __launch_bounds__(256) nv_moe(const float* n2, float* hio, const float* wgr, const float* bgr, const float* wer, const float* ber,
                                              const float* wg, const float* wu, const float* wd) {
    __shared__ float s_n[1024], s_lg[20], s_act[256], s_p[2];
    __shared__ int s_e[2];
    const int t = blockIdx.x, tid = threadIdx.x;
    for (int i = tid; i < 1024; i += 256) s_n[i] = n2[(long)t * 1024 + i];
    __syncthreads();
    if (tid < 20) {
        float a = 0.f;
        if (tid < 4) { for (int d = 0; d < 1024; ++d) a += s_n[d] * wgr[d * 4 + tid]; a += bgr[tid]; }
        else { const int e = tid - 4; for (int d = 0; d < 1024; ++d) a += s_n[d] * wer[d * 16 + e]; a += ber[e]; }
        s_lg[tid] = a;
    }
    __syncthreads();
    if (tid == 0) {
        int g = 0; float m = s_lg[0];
        for (int i = 1; i < 4; ++i) if (s_lg[i] > m) { m = s_lg[i]; g = i; }
        float se = 0.f; for (int i = 0; i < 4; ++i) se += expf(s_lg[i] - m);
        const float gw = 1.f / se;
        const float* el = s_lg + 4 + g * 4;
        int i1 = 0; for (int i = 1; i < 4; ++i) if (el[i] > el[i1]) i1 = i;
        int i2 = -1; for (int i = 0; i < 4; ++i) if (i != i1 && (i2 < 0 || el[i] > el[i2])) i2 = i;
        const float e2 = expf(el[i2] - el[i1]);
        s_p[0] = gw / (1.f + e2); s_p[1] = gw * e2 / (1.f + e2);
        s_e[0] = g * 4 + i1; s_e[1] = g * 4 + i2;
    }
    __syncthreads();
    float acc[4] = {0.f, 0.f, 0.f, 0.f};
    for (int sl = 0; sl < 2; ++sl) {
        const int e = s_e[sl]; const float p = s_p[sl];
        const float* g_ = wg + (long)e * 1024 * 256 + tid; const float* u_ = wu + (long)e * 1024 * 256 + tid;
        float hg = 0.f, hu = 0.f;
        for (int d = 0; d < 1024; ++d) { hg += s_n[d] * g_[(long)d * 256]; hu += s_n[d] * u_[(long)d * 256]; }
        __syncthreads();
        s_act[tid] = siluf_(hg) * hu * p;
        __syncthreads();
        const float* d_ = wd + (long)e * 256 * 1024;
        for (int f = 0; f < 256; ++f) { const float a = s_act[f];
#pragma unroll
            for (int i = 0; i < 4; ++i) acc[i] += a * d_[(long)f * 1024 + tid + 256 * i]; }
    }
#pragma unroll
    for (int i = 0; i < 4; ++i) hio[(long)t * 1024 + tid + 256 * i] += acc[i];
}
__global__ void __launch_bounds__(256) ad_proj(const unsigned char* act, int ntok, int tok_lo, float* PROJ) {
    const int t = blockIdx.x; const size_t tg = (size_t)(tok_lo + t); const size_t nt = (size_t)ntok;
    const bf16* QA = (const bf16*)(act + nt * O_QA) + tg * 1024; const bf16* CKV = (const bf16*)(act + nt * O_CKV) + tg * 256; const bf16* QI = (const bf16*)(act + nt * O_QI) + tg * 512;
    const bf16* KW = (const bf16*)(act + nt * O_KW) + tg * 128; const bf16* RQ = (const bf16*)(act + nt * O_RQ) + tg * 512; const bf16* RK = (const bf16*)(act + nt * O_RK) + tg * 512;
    const bf16* R4 = (const bf16*)(act + nt * O_RV);
    float* o = PROJ + (size_t)t * INW;
    for (int c = threadIdx.x; c < INW; c += 256) {
        bf16 v;
        if (c < C_CKV) v = QA[c]; else if (c < C_QI) v = CKV[c - C_CKV]; else if (c < C_KI) v = QI[c - C_QI]; else if (c < C_RQ) v = KW[c - C_KI];
        else if (c < C_RK) v = RQ[c - C_RQ]; else if (c < C_RV) v = RK[c - C_RK];
        else { const int cc = c - C_RV; v = R4[(size_t)(cc >> 10) * nt * 1024 + tg * 1024 + (cc & 1023)]; }
        o[c] = bf2f(v);
    }
}


__global__ void __launch_bounds__(256) ad_kv(const unsigned char* aux, int ntok, int tok_lo, float* KV, float* PROJ) {
    const int t = blockIdx.x; const size_t tg = (size_t)(tok_lo + t); const size_t nt = (size_t)ntok; const int c = threadIdx.x;
    const bf16* KP = (const bf16*)(aux + nt * AUX_KP) + tg * 128; const bf16* VV = (const bf16*)(aux + nt * AUX_VV) + tg * 128; const bf16* KIN = (const bf16*)(aux + nt * AUX_KIN) + tg * 64;
    KV[(size_t)t * 256 + c] = bf2f(c < 128 ? KP[c] : VV[c - 128]);
    if (c < 64) PROJ[(size_t)t * INW + C_KI + c] = bf2f(KIN[c]);
}
__global__ void __launch_bounds__(256) nv_fill(float* p, float v, int n) { const int i = blockIdx.x * 256 + threadIdx.x; if (i < n) p[i] = v; }


__global__ void __launch_bounds__(256) ad_att(const unsigned char* act, int ntok, int tok_lo, float* ATT) {
    const int t = blockIdx.x; const bf16* A = (const bf16*)(act + (size_t)ntok * O_QA) + (size_t)(tok_lo + t) * 1024;
    for (int c = threadIdx.x; c < 1024; c += 256) ATT[(size_t)t * 1024 + c] = bf2f(A[c]);
}


__global__ void __launch_bounds__(256) ad_a2(const unsigned char* act, int ntok, int tok_lo, float* A2) {
    const int t = blockIdx.x; const bf16* A = (const bf16*)(act + (size_t)ntok * O_RV) + (size_t)(tok_lo + t) * 1024;
    for (int c = threadIdx.x; c < 1024; c += 256) A2[(size_t)t * 1024 + c] = bf2f(A[c]);
}

static void gemm(hipStream_t st, const float* A, long lda, const float* B, long ldb, float* C, long ldc, int M, int N, int K) {
    hipLaunchKernelGGL(nv_gemm, dim3((N + 127) / 128, M / 128), dim3(256), 0, st, A, lda, B, ldb, C, ldc, M, N, K);
}

extern "C" void kernel_launch(void* const* d_in, const int* in_sizes, int n_in, void* d_out, int out_size, void* d_ws, size_t ws_size, hipStream_t stream) {
    static int grid = 0;
    if (grid == 0) {
        int dev = 0, cus = 0, per_cu = 0;
        (void)hipGetDevice(&dev); (void)hipDeviceGetAttribute(&cus, hipDeviceAttributeMultiprocessorCount, dev);
        if (hipFuncSetAttribute((const void*)mk_fwd, hipFuncAttributeMaxDynamicSharedMemorySize, LDS_BYTES) != hipSuccess) { fprintf(stderr, "kernel_launch: hipFuncSetAttribute failed\n"); grid = -1; return; }
        (void)hipOccupancyMaxActiveBlocksPerMultiprocessor(&per_cu, (const void*)mk_fwd, NWAVES * 64, LDS_BYTES);
        (void)hipGetLastError();
        if (per_cu < 1) { fprintf(stderr, "kernel_launch: occupancy query says %d blocks per CU\n", per_cu); per_cu = 1; }
        grid = cus * per_cu;
        if (n_in != 20 || ws_size < (size_t)512 * MiB) { fprintf(stderr, "kernel_launch: unexpected n_in %d / ws_size %zu\n", n_in, ws_size); grid = -1; return; }
    }
    if (grid < 0) return;
    const float* x = (const float*)d_in[0];
    const float* kv_norm_g = (const float*)d_in[3]; const float* w_kv_up = (const float*)d_in[4]; const float* q_norm_g = (const float*)d_in[5];
    const float* k_norm_g = (const float*)d_in[6]; const float* idx_k_norm_g = (const float*)d_in[7]; const float* ret_norm_g = (const float*)d_in[8];
    const float* w_att = (const float*)d_in[9]; const float* w_ret = (const float*)d_in[10]; const float* w_out = (const float*)d_in[11];
    const float* norm2_g = (const float*)d_in[12]; const float* w_gr = (const float*)d_in[13]; const float* b_gr = (const float*)d_in[14];
    const float* w_er = (const float*)d_in[15]; const float* b_er = (const float*)d_in[16]; const float* w_eg = (const float*)d_in[17];
    const float* w_eu = (const float*)d_in[18]; const float* w_ed = (const float*)d_in[19];
    float* out = (float*)d_out;
    unsigned char* ws = (unsigned char*)d_ws;
    if (ws_size < WS_ACT + (size_t)T * O_END) { fprintf(stderr, "kernel_launch: workspace too small\n"); return; }
    (void)x; (void)kv_norm_g; (void)w_kv_up; (void)q_norm_g; (void)k_norm_g; (void)idx_k_norm_g; (void)ret_norm_g; (void)w_att; (void)w_ret; (void)w_out; (void)norm2_g; (void)w_gr; (void)b_gr; (void)w_er; (void)b_er; (void)w_eg; (void)w_eu; (void)w_ed;
    (void)hipMemsetAsync(ws + WS_CTL, 0, CTL_ZERO_BYTES, stream);
    Args a{};
    for (int i = 0; i < 20; ++i) a.in[i] = (const float*)d_in[i];
    a.out = out; a.ws = ws; a.xb = (unsigned char*)d_out; a.ntok = T; a.tok0 = 0;
    void* kargs[] = {(void*)&a};
    if (PROBE_PH >= 0) { a.ph_lo = PROBE_PH; a.ph_hi = PROBE_PH + 1; a.mode = PROBE_MODE;
        (void)hipLaunchCooperativeKernel((const void*)mk_fwd, dim3(grid), dim3(NWAVES * 64), kargs, (unsigned)LDS_BYTES, stream);
        (void)hipMemsetAsync(ws + WS_CTL, 0, CTL_ZERO_BYTES, stream); }
    a.ph_lo = 0; a.ph_hi = 11; a.mode = 0;
    const hipError_t le = hipLaunchCooperativeKernel((const void*)mk_fwd, dim3(grid), dim3(NWAVES * 64), kargs, (unsigned)LDS_BYTES, stream);
    if (le != hipSuccess) fprintf(stderr, "kernel_launch: cooperative launch failed: %s (grid %d)\n", hipGetErrorString(le), grid);
}
```

```cpp
#include <hip/hip_runtime.h>
#include <hip/hip_cooperative_groups.h>
#include <cstdio>
#include <cstdint>

namespace pg8 {
#define PG8_LAS __attribute__((address_space(3)))
typedef unsigned short bf16_t;
typedef short bf16x8 __attribute__((ext_vector_type(8)));
typedef float f32x4 __attribute__((ext_vector_type(4)));
typedef unsigned u32x4 __attribute__((ext_vector_type(4)));
typedef unsigned u32x2 __attribute__((ext_vector_type(2)));
typedef int v4i_t __attribute__((ext_vector_type(4)));
typedef int v8i_t __attribute__((ext_vector_type(8)));
constexpr int BM = 256, BK = 64, HALF = 128, HTB = HALF * BK * 2  , STAGE_BYTES = 8 * HTB, NXCD = 8, WGM = 8;

__host__ __device__ __forceinline__ int lds_byte(int r, int c) { const int st = (r >> 4) * 2 + (c >> 5), rr = r & 15, cc = c & 31, ob = rr * 64 + cc * 2; return st * 1024 + (ob ^ (((ob >> 9) & 1) << 5)); }
__host__ __device__ __forceinline__ void stage_rc(int b, int& R, int& C) { const int st = b / 1024, sb = b % 1024, swz = sb ^ (((sb >> 9) & 1) << 5); R = (st >> 1) * 16 + swz / 64; C = (st & 1) * 32 + (swz % 64) / 2; }
__host__ __device__ __forceinline__ int perm32(int rho) { const int n = rho >> 4, i = rho & 15; return 8 * (i >> 2) + 4 * n + (i & 3); }

struct Unit { int pm, pn; const char* a; const char* b; long bjump; int aux; };
struct Gemm { int K, lda, ldb, ksplit; int sw = 122, sa = 127; };

struct StaticOrder {
    static constexpr bool GATHER = false; const int* ptok = nullptr;
    int nM, nN, nwg, G, c; const char* A; const char* Bt; size_t tA, tB;
    __device__ void init(int M, int N, int G_, int c_, const void* A_, int lda, const void* Bt_, int ldb) { nM = M / BM; nN = N / BM; nwg = nM * nN; G = G_; c = c_; A = (const char*)A_; Bt = (const char*)Bt_; tA = (size_t)BM * lda * 2; tB = (size_t)BM * ldb * 2; }
    __device__ bool next(int i, Unit& u) const {
        const long L = (long)i * G + c; if (L >= nwg) return false;
        int wgid = (int)L; { const int q = nwg / NXCD, r = nwg % NXCD, xcd = wgid % NXCD, off = wgid / NXCD; wgid = (xcd < r ? xcd * (q + 1) : r * (q + 1) + (xcd - r) * q) + off; }
        const int nig = WGM * nN, gid = wgid / nig, fm = gid * WGM, gsz = (nM - fm) < WGM ? (nM - fm) : WGM;
        u.pm = fm + ((wgid % nig) % gsz); u.pn = (wgid % nig) / gsz; u.a = A + (size_t)u.pm * tA; u.b = Bt + (size_t)u.pn * tB; u.bjump = 0; u.aux = 0; return true;
    }
    __device__ __forceinline__ void a_ready(const Unit&) const {}
    __device__ __forceinline__ void done(const Unit&) const {}
};

typedef float f32x2c __attribute__((ext_vector_type(2))); typedef __bf16 bf16x2c __attribute__((ext_vector_type(2)));
__device__ __forceinline__ unsigned cvt_pk_bf16(float lo, float hi) { const f32x2c v = {lo, hi}; const bf16x2c b = __builtin_convertvector(v, bf16x2c); return __builtin_bit_cast(unsigned, b); }
__device__ __forceinline__ float bf_lo(unsigned w) { return __uint_as_float(w << 16); }
__device__ __forceinline__ float bf_hi(unsigned w) { return __uint_as_float(w & 0xffff0000u); }


template <class Epi, class Sched, bool ALIGN_EPI = false, bool SP2 = false, bool FP8 = false>
__device__ __forceinline__ void gemm_phase(PG8_LAS unsigned char* lds, const Gemm g, const Sched& S, const Epi& E) {
    int tid = threadIdx.x; asm volatile("" : "+v"(tid));
    const int wid = __builtin_amdgcn_readfirstlane(tid >> 6), lane = tid & 63, wr = wid >> 2, wc = wid & 3, fr = lane & 15, fq = lane >> 4;
    const int K = g.K, nt = K / BK;
    unsigned voffA[2], voffB[2]; int gR[2]; unsigned gC[2];
#pragma unroll
    for (int i = 0; i < 2; ++i) { int R, C; stage_rc(tid * 16 + i * 8192, R, C); const int Rb = Epi::PERM ? ((R & ~31) + perm32(R & 31)) : R; gR[i] = R; gC[i] = (unsigned)C * 2u;
        voffA[i] = (unsigned)(R * g.lda + C) * 2u; voffB[i] = (unsigned)(Rb * g.ldb + C) * 2u; }
    unsigned gA0[2] = {0u, 0u}, gA1[2] = {0u, 0u}, gN0[2] = {0u, 0u}, gN1[2] = {0u, 0u};
#define PG8_GOFF(u_, o0, o1) do { _Pragma("unroll") for (int i_ = 0; i_ < 2; ++i_) { int t0_ = S.ptok[(u_).pm * BM + gR[i_]], t1_ = S.ptok[(u_).pm * BM + HALF + gR[i_]]; t0_ = t0_ < 0 ? 0 : t0_; t1_ = t1_ < 0 ? 0 : t1_; \
        o0[i_] = (unsigned)t0_ * (unsigned)(g.lda * 2) + gC[i_]; o1[i_] = (unsigned)t1_ * (unsigned)(g.lda * 2) + gC[i_]; } } while (0)
    const size_t kstep = (size_t)(BK * 2);
    const size_t hstepA = Sched::GATHER ? (size_t)0 : (size_t)HALF * g.lda * 2, hstepB = (size_t)HALF * g.ldb * 2;
    const unsigned ldsw = (unsigned)wid * 1024u;
    const int aoff = lds_byte(wr * 64 + fr, fq * 8), boff = lds_byte(wc * 32 + fr, fq * 8);
#define PG8_CAT(x0, x1) __builtin_shufflevector(__builtin_bit_cast(v4i_t, x0), __builtin_bit_cast(v4i_t, x1), 0, 1, 2, 3, 4, 5, 6, 7)
#define PG8_SA(b, h) (((b) * 2 + (h)) * HTB)
#define PG8_SB(b, h) ((4 + (b) * 2 + (h)) * HTB)
#define PG8_STAGE(bufoff, gbase, voff) do { _Pragma("unroll") for (int _i = 0; _i < 2; ++_i) \
        __builtin_amdgcn_global_load_lds((const unsigned*)((const char*)(gbase) + (voff)[_i]), (PG8_LAS unsigned*)(lds + (bufoff) + ldsw + _i * 8192), 16, 0, 0); } while (0)
#define PG8_LDA(dst, b, h) do { if constexpr (FP8) { _Pragma("unroll") for (int m = 0; m < 4; ++m) dst##8[m] = PG8_CAT(*(const PG8_LAS bf16x8*)(lds + PG8_SA(b, h) + aoff + m * 2048), *(const PG8_LAS bf16x8*)(lds + PG8_SA(b, h) + aoff + m * 2048 + 1024)); } \
      else { _Pragma("unroll") for (int m = 0; m < 4; ++m) _Pragma("unroll") for (int k = 0; k < 2; ++k) dst[m][k] = *(const PG8_LAS bf16x8*)(lds + PG8_SA(b, h) + aoff + m * 2048 + k * 1024); } } while (0)
#define PG8_LDB(dst, b, h) do { if constexpr (FP8) { _Pragma("unroll") for (int n = 0; n < 2; ++n) dst##8[n] = PG8_CAT(*(const PG8_LAS bf16x8*)(lds + PG8_SB(b, h) + boff + n * 2048), *(const PG8_LAS bf16x8*)(lds + PG8_SB(b, h) + boff + n * 2048 + 1024)); } \
      else { _Pragma("unroll") for (int n = 0; n < 2; ++n) _Pragma("unroll") for (int k = 0; k < 2; ++k) dst[n][k] = *(const PG8_LAS bf16x8*)(lds + PG8_SB(b, h) + boff + n * 2048 + k * 1024); } } while (0)
#define PG8_MMA(ai, bj, At, Bt) do { __builtin_amdgcn_s_setprio(1); if constexpr (FP8) { _Pragma("unroll") for (int m = 0; m < 4; ++m) _Pragma("unroll") for (int n = 0; n < 2; ++n) \
        asm volatile("v_mfma_scale_f32_16x16x128_f8f6f4 %0, %1, %2, %0, %3, %4 op_sel_hi:[0,0,0]" : "+v"(acc[ai][bj][m][n]) : "v"(Bt##8[n]), "v"(At##8[m]), "v"(scw8), "v"(sca8)); } \
      else { _Pragma("unroll") for (int m = 0; m < 4; ++m) _Pragma("unroll") for (int n = 0; n < 2; ++n) _Pragma("unroll") for (int k = 0; k < 2; ++k) \
        acc[ai][bj][m][n] = __builtin_amdgcn_mfma_f32_16x16x32_bf16(Bt[n][k], At[m][k], acc[ai][bj][m][n], 0, 0, 0); } __builtin_amdgcn_s_setprio(0); } while (0)
#define PG8_WAIT_V(n) asm volatile("s_waitcnt vmcnt(" #n ")" ::: "memory")
#define PG8_WAIT_L(n) asm volatile("s_waitcnt lgkmcnt(" #n ")" ::: "memory")
#define PG8_BAR __builtin_amdgcn_s_barrier()
#define PG8_SCHED __builtin_amdgcn_sched_barrier(0)
    Unit cur, nxt; int ui = 0;
    if (!S.next(0, cur)) return;
    f32x4 acc[2][2][4][2];
#pragma unroll
    for (int a = 0; a < 2; ++a)
#pragma unroll
        for (int b = 0; b < 2; ++b)
#pragma unroll
            for (int m = 0; m < 4; ++m)
#pragma unroll
                for (int n = 0; n < 2; ++n) acc[a][b][m][n] = (f32x4){0.f, 0.f, 0.f, 0.f};
    int scw8 = g.sw, sca8 = g.sa; asm volatile("" : "+v"(scw8), "+v"(sca8));
    bf16x8 At[4][2], B0[2][2], B1[2][2]; v8i_t At8[4], B08[2], B18[2];
    const char* cA = cur.a; const char* cB = cur.b; long cJ = cur.bjump;
    S.a_ready(cur);
    if constexpr (SP2) {
        if constexpr (Sched::GATHER) PG8_GOFF(cur, gA0, gA1);
        PG8_STAGE(PG8_SB(0, 0), cB, voffB); PG8_STAGE(PG8_SB(0, 1), cB + hstepB, voffB); do { if constexpr (Sched::GATHER) { PG8_STAGE(PG8_SA(0, 0), cA, gA0); } else { PG8_STAGE(PG8_SA(0, 0), cA, voffA); } } while (0); do { if constexpr (Sched::GATHER) { PG8_STAGE(PG8_SA(0, 1), cA, gA1); } else { PG8_STAGE(PG8_SA(0, 1), cA + hstepA, voffA); } } while (0);
        if (wr == 1) PG8_BAR;
        PG8_WAIT_V(2); PG8_BAR;
        PG8_STAGE(PG8_SB(1, 0), cB + kstep, voffB); do { if constexpr (Sched::GATHER) { PG8_STAGE(PG8_SA(1, 0), cA + kstep, gA0); } else { PG8_STAGE(PG8_SA(1, 0), cA + kstep, voffA); } } while (0); PG8_STAGE(PG8_SB(1, 1), cB + hstepB + kstep, voffB);
        PG8_WAIT_V(6); PG8_BAR;
    } else {
        PG8_STAGE(PG8_SB(0, 0), cB, voffB); PG8_STAGE(PG8_SA(0, 0), cA, voffA); PG8_STAGE(PG8_SB(0, 1), cB + hstepB, voffB); PG8_STAGE(PG8_SA(0, 1), cA + hstepA, voffA);
        if (wr == 1) PG8_BAR;
        PG8_WAIT_V(4); PG8_BAR;
        PG8_STAGE(PG8_SB(1, 0), cB + kstep, voffB); PG8_STAGE(PG8_SA(1, 0), cA + kstep, voffA); PG8_STAGE(PG8_SB(1, 1), cB + hstepB + kstep, voffB);
        PG8_WAIT_V(6); PG8_BAR;
    }
    for (;;) {
        const bool has_next = S.next(ui + 1, nxt);
        const char* nA = has_next ? nxt.a : cA; const char* nB = has_next ? nxt.b : cB;
        if constexpr (Sched::GATHER) { if (has_next) PG8_GOFF(nxt, gN0, gN1); else { gN0[0] = gA0[0]; gN0[1] = gA0[1]; gN1[0] = gA1[0]; gN1[1] = gA1[1]; } }
#pragma unroll 1
        for (int t = 0; t < nt; t += 2) {
            const bool last = (t == nt - 2);
            const char* a1 = cA + (size_t)(t + 1) * kstep;
            const char* a2 = last ? nA : cA + (size_t)(t + 2) * kstep; const char* b2 = last ? nB : cB + (size_t)(t + 2) * kstep + ((t + 2) >= g.ksplit ? cJ : 0L);
            const char* a3 = a2 + kstep; const char* b3 = b2 + kstep;
            if (last && has_next) S.a_ready(nxt);
            unsigned x0[2] = {0u, 0u}, x1[2] = {0u, 0u};
            if constexpr (Sched::GATHER) { x0[0] = last ? gN0[0] : gA0[0]; x0[1] = last ? gN0[1] : gA0[1]; x1[0] = last ? gN1[0] : gA1[0]; x1[1] = last ? gN1[1] : gA1[1]; }
            if constexpr (SP2) {
            PG8_LDB(B0, 0, 0); PG8_LDB(B1, 0, 1); PG8_SCHED; PG8_LDA(At, 0, 0); do { if constexpr (Sched::GATHER) { PG8_STAGE(PG8_SA(1, 1), a1, gA1); } else { PG8_STAGE(PG8_SA(1, 1), a1 + hstepA, voffA); } } while (0);
            PG8_WAIT_V(8); PG8_WAIT_L(0); PG8_BAR; PG8_MMA(0, 0, At, B0); PG8_MMA(0, 1, At, B1); PG8_BAR; PG8_SCHED;
            PG8_LDA(At, 0, 1); PG8_STAGE(PG8_SB(0, 0), b2, voffB); PG8_STAGE(PG8_SB(0, 1), b2 + hstepB, voffB); do { if constexpr (Sched::GATHER) { PG8_STAGE(PG8_SA(0, 0), a2, x0); } else { PG8_STAGE(PG8_SA(0, 0), a2, voffA); } } while (0);
            PG8_WAIT_V(8); PG8_WAIT_L(0); PG8_BAR; PG8_MMA(1, 0, At, B0); PG8_MMA(1, 1, At, B1); PG8_BAR; PG8_SCHED;
            PG8_LDB(B0, 1, 0); PG8_LDB(B1, 1, 1); PG8_SCHED; PG8_LDA(At, 1, 0); do { if constexpr (Sched::GATHER) { PG8_STAGE(PG8_SA(0, 1), a2, x1); } else { PG8_STAGE(PG8_SA(0, 1), a2 + hstepA, voffA); } } while (0);
            PG8_WAIT_V(8); PG8_WAIT_L(0); PG8_BAR; PG8_MMA(0, 0, At, B0); PG8_MMA(0, 1, At, B1); PG8_BAR; PG8_SCHED;
            PG8_LDA(At, 1, 1); PG8_STAGE(PG8_SB(1, 0), b3, voffB); PG8_STAGE(PG8_SB(1, 1), b3 + hstepB, voffB); do { if constexpr (Sched::GATHER) { PG8_STAGE(PG8_SA(1, 0), a3, x0); } else { PG8_STAGE(PG8_SA(1, 0), a3, voffA); } } while (0);
            PG8_WAIT_V(8); PG8_WAIT_L(0); PG8_BAR; PG8_MMA(1, 0, At, B0); PG8_MMA(1, 1, At, B1); PG8_BAR; PG8_SCHED;
            } else {
            PG8_LDB(B0, 0, 0); PG8_SCHED; PG8_LDA(At, 0, 0); PG8_STAGE(PG8_SA(1, 1), a1 + hstepA, voffA);
            PG8_WAIT_L(8); PG8_BAR; PG8_WAIT_L(0); PG8_MMA(0, 0, At, B0); PG8_BAR; PG8_SCHED;
            PG8_LDB(B1, 0, 1); PG8_STAGE(PG8_SB(0, 0), b2, voffB);
            PG8_BAR; PG8_WAIT_L(0); PG8_MMA(0, 1, At, B1); PG8_BAR;
            PG8_LDA(At, 0, 1); PG8_STAGE(PG8_SA(0, 0), a2, voffA);
            PG8_BAR; PG8_WAIT_L(0); PG8_MMA(1, 0, At, B0); PG8_BAR; PG8_SCHED;
            PG8_STAGE(PG8_SB(0, 1), b2 + hstepB, voffB);
            PG8_WAIT_V(6); PG8_BAR; PG8_MMA(1, 1, At, B1); PG8_BAR;
            PG8_LDB(B0, 1, 0); PG8_SCHED; PG8_LDA(At, 1, 0); PG8_STAGE(PG8_SA(0, 1), a2 + hstepA, voffA);
            PG8_WAIT_L(8); PG8_BAR; PG8_WAIT_L(0); PG8_MMA(0, 0, At, B0); PG8_BAR; PG8_SCHED;
            PG8_LDB(B1, 1, 1); PG8_STAGE(PG8_SB(1, 0), b3, voffB);
            PG8_BAR; PG8_WAIT_L(0); PG8_MMA(0, 1, At, B1); PG8_BAR;
            PG8_LDA(At, 1, 1); PG8_STAGE(PG8_SA(1, 0), a3, voffA);
            PG8_BAR; PG8_WAIT_L(0); PG8_MMA(1, 0, At, B0); PG8_BAR; PG8_SCHED;
            PG8_STAGE(PG8_SB(1, 1), b3 + hstepB, voffB);
            PG8_WAIT_V(6); PG8_BAR; PG8_MMA(1, 1, At, B1); PG8_BAR;
            }
        }
        if constexpr (ALIGN_EPI) { if (wr == 0) PG8_BAR; }
        if constexpr (!Epi::AFTER_DRAIN) { E(acc, cur, wr, wc, fr, fq); S.done(cur); }
        if (!has_next) break;
#pragma unroll
        for (int a = 0; a < 2; ++a)
#pragma unroll
            for (int b = 0; b < 2; ++b)
#pragma unroll
                for (int m = 0; m < 4; ++m)
#pragma unroll
                    for (int n = 0; n < 2; ++n) acc[a][b][m][n] = (f32x4){0.f, 0.f, 0.f, 0.f};
        cur = nxt; cA = nA; cB = nB; cJ = cur.bjump; ++ui;
        if constexpr (Sched::GATHER) { gA0[0] = gN0[0]; gA0[1] = gN0[1]; gA1[0] = gN1[0]; gA1[1] = gN1[1]; }
        if constexpr (ALIGN_EPI) { if (wr == 1) PG8_BAR; }
    }
    PG8_WAIT_V(0);
    if constexpr (!ALIGN_EPI) { if (wr == 0) PG8_BAR; }
    PG8_BAR;
    if constexpr (Epi::AFTER_DRAIN) { E.fused(acc, cur, wr, wc, fr, fq, lds, wid, lane); S.done(cur); }
#undef PG8_GOFF
#undef PG8_SA
#undef PG8_SB
#undef PG8_STAGE
#undef PG8_LDA
#undef PG8_LDB
#undef PG8_MMA
#undef PG8_CAT
#undef PG8_WAIT_V
#undef PG8_WAIT_L
#undef PG8_BAR
#undef PG8_SCHED
}
}

#ifndef PROBE_PH
#define PROBE_PH (-1)
#endif
#ifndef PROBE_MODE
#define PROBE_MODE (0)
#endif
constexpr int D = 1024, BATCH = 16, SEQ = 2048, T = BATCH * SEQ;
constexpr int INW = 6984, INWP = 7168;
constexpr int C_QA = 0, C_CKV = 1024, C_QI = 1280, C_KI = 1792, C_WI = 1856, C_RQ = 1864, C_RK = 2376, C_RV = 2888, C_RG = 3912, C_GA = 4936, C_GR = 5960;
constexpr float EPS = 1e-6f;
constexpr int NWAVES = 8;

constexpr size_t MiB = 1u << 20;
constexpr size_t WS_CTL = 0, CTL_ZERO_BYTES = 1 * MiB;
constexpr size_t WS_WIN = 1 * MiB, WS_WKV = 15 * MiB, WS_WATT = 16 * MiB, WS_WRET = 18 * MiB, WS_WOUT = 20 * MiB, WS_W1 = 22 * MiB, WS_WD = 38 * MiB, WS_ACT = 46 * MiB;
constexpr size_t O_QA = 0, O_CKV = 2048, O_QI = 2560, O_KW = 3584, O_RQ = 3840, O_RK = 4864, O_RV = 5888, O_RG = 7936, O_GA = 9984, O_GR = 12032, O_END = 14080;

constexpr int MP_ROWS = 38912;
constexpr size_t MO_APERM = 0, MO_ACT = 80 * MiB, MO_N2 = 120 * MiB, MO_META = 184 * MiB;
constexpr size_t MM_B = 0, MM_P = 131072, MM_CL = 262144, MM_CH = 393216, MM_RS = 524288, MM_PTOK = 655360, MM_PRS = 819200, MM_PCL = 983040, MM_PCH = 1146880, MM_END = 1310720;
constexpr size_t WS_WR = 15 * MiB + 512 * 1024;
constexpr size_t MO_H16 = 192 * MiB;
constexpr size_t WS_WIN8 = 488 * MiB;
constexpr size_t WS_WATT8 = 495 * MiB, WS_WRET8 = 496 * MiB, WS_WOUT8 = 497 * MiB;
constexpr size_t O_A2F8 = 2048, O_MIX8 = 3840;
constexpr size_t WS_W18 = 498 * MiB, WS_WD8 = 506 * MiB;
constexpr size_t AUX_XB8 = 2048 + 896;
constexpr int CW_MOE = 256;
constexpr int RING_OFF = 0, RING_BYTES = 131072, P3_HIST_OFF = 131072, P3_TOT_OFF = 147456, P3_T_OFF = 149504, LDSCTL_OFF = 151552, MISC_OFF = LDSCTL_OFF + 320, LDS_BYTES = 152576;
constexpr int CW_Q3 = 64, CW_Q4 = 128;

#define GAS __attribute__((address_space(1)))
#define LAS __attribute__((address_space(3)))
typedef unsigned short bf16;
typedef unsigned v4u __attribute__((ext_vector_type(4)));
typedef float f32x4 __attribute__((ext_vector_type(4)));
#define LDS_WAIT() asm volatile("s_waitcnt lgkmcnt(0)" ::: "memory")
#define VM_WAIT() asm volatile("s_waitcnt vmcnt(0)" ::: "memory")
__device__ __forceinline__ unsigned f2bf(float f) { unsigned u = __builtin_bit_cast(unsigned, f); return (u + 0x7fffu + ((u >> 16) & 1u)) >> 16; }
__device__ __forceinline__ unsigned pk2(float lo, float hi) { return f2bf(lo) | (f2bf(hi) << 16); }
__device__ __forceinline__ float bf2f(bf16 b) { return __uint_as_float((unsigned)b << 16); }


typedef GAS unsigned gu32;
constexpr int CW_BAR = 4096;
#define XB_TMO      128
#define XB_XCNT(j)  (256  + 64 * (j))
#define XB_XSUB(j)  (1280 + 64 * (j))
#define XB_XGEN(j)  (2304 + 64 * (j))
#define XB_TOP      3328
#define XB_TOPGEN   3392
#define XCD_BAR_WORDS 3456
#define XB_SPIN_CAP (1u << 18)

__device__ __forceinline__ unsigned xb_ld(unsigned* p)              { return __hip_atomic_load(p, __ATOMIC_RELAXED, __HIP_MEMORY_SCOPE_AGENT); }
__device__ __forceinline__ unsigned xb_add(unsigned* p, unsigned v) { return __hip_atomic_fetch_add(p, v, __ATOMIC_RELAXED, __HIP_MEMORY_SCOPE_AGENT); }
__device__ __forceinline__ unsigned xb_xcc_id() { return (unsigned)__builtin_amdgcn_s_getreg((3 << 11) | 20) & 0xFu; }
#define XB_SPIN(cond, bar) do { unsigned _sp = 0; while (cond) { __builtin_amdgcn_s_sleep(1); \
    if ((++_sp & 255u) == 0u) { if (xb_ld(&(bar)[XB_TMO])) break; if (_sp > XB_SPIN_CAP) { atomicAdd(&(bar)[XB_TMO], 1u); break; } } } } while (0)

struct XcdBarrier {
    unsigned* bar; unsigned x;
    volatile LAS unsigned* st;
};

__device__ __forceinline__ XcdBarrier xcd_barrier_post(unsigned* bar, volatile LAS unsigned* st) {
    XcdBarrier b; b.bar = bar; b.x = xb_xcc_id(); b.st = st;
    if (threadIdx.x == 0) (void)xb_add(&bar[XB_XCNT(b.x)], 1u);
    return b;
}
__device__ __forceinline__ void xcd_barrier_complete(unsigned* bar, unsigned x, unsigned& nloc, unsigned& nx) {
    const unsigned G = gridDim.x * gridDim.y * gridDim.z;
    unsigned sum, cnt, mine, sp = 0u;
    for (;;) {
        sum = 0u; cnt = 0u; mine = 0u;
#pragma unroll
        for (unsigned j = 0; j < 16; ++j) { const unsigned c = xb_ld(&bar[XB_XCNT(j)]); sum += c; cnt += (c > 0u) ? 1u : 0u; mine = (j == x) ? c : mine; }
        if (sum == G) break;
        __builtin_amdgcn_s_sleep(1);
        if ((++sp & 255u) == 0u) { if (xb_ld(&bar[XB_TMO])) break; if (sp > XB_SPIN_CAP) { atomicAdd(&bar[XB_TMO], 1u); break; } }
    }
    nloc = mine > 0u ? mine : 1u; nx = cnt > 0u ? cnt : 1u;
}

__device__ __forceinline__ void xcd_barrier(const XcdBarrier& b) {
    asm volatile("s_waitcnt vmcnt(0)" ::: "memory");
    __syncthreads();
    if (threadIdx.x == 0) {
        unsigned* bar = b.bar;
        __builtin_amdgcn_s_waitcnt(0);
        unsigned nloc = b.st[0], nx = b.st[1];
        if (nloc == 0u) { xcd_barrier_complete(bar, b.x, nloc, nx); b.st[0] = nloc; b.st[1] = nx; }
        const unsigned old = xb_add(&bar[XB_XSUB(b.x)], 1u);
        const unsigned gen = old / nloc;
        if (old + 1u == (gen + 1u) * nloc) {
            __builtin_amdgcn_fence(__ATOMIC_RELEASE, "agent");
            asm volatile("s_waitcnt vmcnt(0)" ::: "memory");
            const unsigned og = xb_add(&bar[XB_TOP], 1u);
            const unsigned tg = og / nx;
            if (og + 1u == (tg + 1u) * nx) xb_add(&bar[XB_TOPGEN], 1u);
            else XB_SPIN(xb_ld(&bar[XB_TOPGEN]) == tg, bar);
            __builtin_amdgcn_fence(__ATOMIC_ACQUIRE, "agent");
            xb_add(&bar[XB_XGEN(b.x)], 1u);
            asm volatile("s_waitcnt vmcnt(0)" ::: "memory");
        } else {
            XB_SPIN(xb_ld(&bar[XB_XGEN(b.x)]) == gen, bar);
            __builtin_amdgcn_fence(__ATOMIC_ACQUIRE, "agent");
            asm volatile("s_waitcnt vmcnt(0)" ::: "memory");
        }
    }
    __syncthreads();
}

struct Args { const float* in[20]; float* out; unsigned char* ws; unsigned char* xb; int ph_lo, ph_hi, ntok, tok0, mode, pad; };

struct Frame {
    LAS unsigned char* lds;
    int tid, lane, wave, vcu, G;
    int ntok;
    unsigned char* ws; unsigned char* act;
};

struct EpiProj {
    static constexpr bool PERM = true, AFTER_DRAIN = false;
    unsigned char* act; size_t ntok;
    __device__ __forceinline__ void operator()(const pg8::f32x4 (&acc)[2][2][4][2], const pg8::Unit& u, int wr, int wc, int fr, int fq) const {
        const int pn = u.pn; size_t O; int ld, cb, nbj = 2;
        if (pn < 4) { O = O_QA; ld = 1024; cb = pn * 256; }
        else if (pn == 4) { O = O_CKV; ld = 256; cb = 0; }
        else if (pn < 7) { O = O_QI; ld = 512; cb = (pn - 5) * 256; }
        else if (pn == 7) { O = O_KW; ld = 128; cb = 0; nbj = 1; }
        else if (pn < 10) { O = O_RQ; ld = 512; cb = (pn - 8) * 256; }
        else if (pn < 12) { O = O_RK; ld = 512; cb = (pn - 10) * 256; }
        else { O = O_RV + (size_t)((pn - 12) >> 2) * 2048; ld = 1024; cb = ((pn - 12) & 3) * 256; }
        pg8::bf16_t* base = (pg8::bf16_t*)(act + ntok * O);
        const int row0 = u.pm * pg8::BM + wr * 64 + fr, col0 = cb + wc * 32 + 8 * fq;
#pragma unroll
        for (int ai = 0; ai < 2; ++ai)
#pragma unroll
            for (int m = 0; m < 4; ++m) { pg8::bf16_t* rowp = base + (size_t)(row0 + ai * pg8::HALF + m * 16) * ld + col0;
#pragma unroll
                for (int bj = 0; bj < 2; ++bj) if (bj < nbj) { const pg8::f32x4 v0 = acc[ai][bj][m][0], v1 = acc[ai][bj][m][1];
                    pg8::u32x4 w; w.x = pg8::cvt_pk_bf16(v0[0], v0[1]); w.y = pg8::cvt_pk_bf16(v0[2], v0[3]); w.z = pg8::cvt_pk_bf16(v1[0], v1[1]); w.w = pg8::cvt_pk_bf16(v1[2], v1[3]);
                    *(pg8::u32x4*)(rowp + bj * pg8::HALF) = w; } }
    }
};


__device__ __forceinline__ float sigm(float x) { return __builtin_amdgcn_rcpf(1.f + __builtin_amdgcn_exp2f(-1.4426950408889634f * x)); }
struct EpiGateA {
    static constexpr bool PERM = true, AFTER_DRAIN = false;
    pg8::bf16_t* GA;
    __device__ __forceinline__ void operator()(const pg8::f32x4 (&acc)[2][2][4][2], const pg8::Unit& u, int wr, int wc, int fr, int fq) const {
        const int row0 = u.pm * pg8::BM + wr * 64 + fr, col0 = u.pn * pg8::BM + wc * 32 + 8 * fq;
#pragma unroll
        for (int ai = 0; ai < 2; ++ai)
#pragma unroll
            for (int m = 0; m < 4; ++m) { pg8::bf16_t* rowp = GA + (size_t)(row0 + ai * pg8::HALF + m * 16) * 1024 + col0;
#pragma unroll
                for (int bj = 0; bj < 2; ++bj) { const pg8::u32x4 g = *(const pg8::u32x4*)(rowp + bj * pg8::HALF); const pg8::f32x4 v0 = acc[ai][bj][m][0], v1 = acc[ai][bj][m][1];
                    pg8::u32x4 w; w.x = pg8::cvt_pk_bf16(sigm(pg8::bf_lo(g.x)) * v0[0], sigm(pg8::bf_hi(g.x)) * v0[1]); w.y = pg8::cvt_pk_bf16(sigm(pg8::bf_lo(g.y)) * v0[2], sigm(pg8::bf_hi(g.y)) * v0[3]);
                    w.z = pg8::cvt_pk_bf16(sigm(pg8::bf_lo(g.z)) * v1[0], sigm(pg8::bf_hi(g.z)) * v1[1]); w.w = pg8::cvt_pk_bf16(sigm(pg8::bf_lo(g.w)) * v1[2], sigm(pg8::bf_hi(g.w)) * v1[3]);
                    *(pg8::u32x4*)(rowp + bj * pg8::HALF) = w; } }
    }
};
struct EpiGateB {
    static constexpr bool PERM = true, AFTER_DRAIN = false;
    const pg8::bf16_t* GA; const pg8::bf16_t* GR; unsigned char* MIX8;
    __device__ __forceinline__ void operator()(const pg8::f32x4 (&acc)[2][2][4][2], const pg8::Unit& u, int wr, int wc, int fr, int fq) const {
        const int row0 = u.pm * pg8::BM + wr * 64 + fr, col0 = u.pn * pg8::BM + wc * 32 + 8 * fq;
#pragma unroll
        for (int ai = 0; ai < 2; ++ai)
#pragma unroll
            for (int m = 0; m < 4; ++m) { const size_t ro = (size_t)(row0 + ai * pg8::HALF + m * 16) * 1024 + col0;
#pragma unroll
                for (int bj = 0; bj < 2; ++bj) { const pg8::u32x4 t = *(const pg8::u32x4*)(GA + ro + bj * pg8::HALF), g = *(const pg8::u32x4*)(GR + ro + bj * pg8::HALF); const pg8::f32x4 v0 = acc[ai][bj][m][0], v1 = acc[ai][bj][m][1];
                    int w0 = __builtin_amdgcn_cvt_pk_fp8_f32(8.f * (pg8::bf_lo(t.x) + sigm(pg8::bf_lo(g.x)) * v0[0]), 8.f * (pg8::bf_hi(t.x) + sigm(pg8::bf_hi(g.x)) * v0[1]), 0, false);
                    w0 = __builtin_amdgcn_cvt_pk_fp8_f32(8.f * (pg8::bf_lo(t.y) + sigm(pg8::bf_lo(g.y)) * v0[2]), 8.f * (pg8::bf_hi(t.y) + sigm(pg8::bf_hi(g.y)) * v0[3]), w0, true);
                    int w1 = __builtin_amdgcn_cvt_pk_fp8_f32(8.f * (pg8::bf_lo(t.z) + sigm(pg8::bf_lo(g.z)) * v1[0]), 8.f * (pg8::bf_hi(t.z) + sigm(pg8::bf_hi(g.z)) * v1[1]), 0, false);
                    w1 = __builtin_amdgcn_cvt_pk_fp8_f32(8.f * (pg8::bf_lo(t.w) + sigm(pg8::bf_lo(g.w)) * v1[2]), 8.f * (pg8::bf_hi(t.w) + sigm(pg8::bf_hi(g.w)) * v1[3]), w1, true);
                    *(unsigned long long*)(MIX8 + ro + bj * pg8::HALF) = (unsigned long long)(unsigned)w0 | ((unsigned long long)(unsigned)w1 << 32); } }
    }
};
struct EpiResid {
    static constexpr bool PERM = true, AFTER_DRAIN = false;
    const float* x; pg8::bf16_t* h16;
    __device__ __forceinline__ void operator()(const pg8::f32x4 (&acc)[2][2][4][2], const pg8::Unit& u, int wr, int wc, int fr, int fq) const {
        const int row0 = u.pm * pg8::BM + wr * 64 + fr, col0 = u.pn * pg8::BM + wc * 32 + 8 * fq;
#pragma unroll
        for (int ai = 0; ai < 2; ++ai)
#pragma unroll
            for (int m = 0; m < 4; ++m) { const size_t ro = (size_t)(row0 + ai * pg8::HALF + m * 16) * 1024 + col0;
#pragma unroll
                for (int bj = 0; bj < 2; ++bj) { const pg8::f32x4 x0 = *(const pg8::f32x4*)(x + ro + bj * pg8::HALF), x1 = *(const pg8::f32x4*)(x + ro + bj * pg8::HALF + 4); const pg8::f32x4 v0 = acc[ai][bj][m][0] + x0, v1 = acc[ai][bj][m][1] + x1;
                    pg8::u32x4 w; w.x = pg8::cvt_pk_bf16(v0[0], v0[1]); w.y = pg8::cvt_pk_bf16(v0[2], v0[3]); w.z = pg8::cvt_pk_bf16(v1[0], v1[1]); w.w = pg8::cvt_pk_bf16(v1[2], v1[3]);
                    *(pg8::u32x4*)(h16 + ro + bj * pg8::HALF) = w; } }
    }
};


struct P1Order {
    static constexpr bool GATHER = false; const int* ptok = nullptr;
    int nM, nN, nwg, G, c, mode; const char* A; const char* Bt; size_t tA, tB;
    __device__ bool next(int i, pg8::Unit& u) const {
        const long L = (long)i * G + c; if (L >= nwg) return false;
        int wgid = (int)L; { const int q = nwg / pg8::NXCD, r = nwg % pg8::NXCD, xcd = wgid % pg8::NXCD, off = wgid / pg8::NXCD; wgid = (xcd < r ? xcd * (q + 1) : r * (q + 1) + (xcd - r) * q) + off; }
        const int nig = pg8::WGM * nN, gid = wgid / nig, fm = gid * pg8::WGM, gsz = (nM - fm) < pg8::WGM ? (nM - fm) : pg8::WGM;
        u.pm = fm + ((wgid % nig) % gsz); const int pc = (wgid % nig) / gsz; u.pn = mode ? 5 + pc : (pc < 5 ? pc : pc + 3);
        u.a = A + (size_t)u.pm * tA; u.b = Bt + (size_t)u.pn * tB; u.bjump = 0; u.aux = 0; return true;
    }
    __device__ __forceinline__ void a_ready(const pg8::Unit&) const {}
    __device__ __forceinline__ void done(const pg8::Unit&) const {}
};

__device__ __forceinline__ float wave_sum(float v) {
#pragma unroll
    for (int o = 1; o < 64; o <<= 1) v += __shfl_xor(v, o);
    return v;
}
__device__ __forceinline__ void p0_transpose_item(const float* W, int K, int N, bf16* WT, int map, int row_off, int par, const float* gk, LAS float* scr, int item, int lane, unsigned char* WT8 = nullptr, float s8 = 32.f) {
    const int nblk = (N + 31) / 32, kb = item / nblk, nb = item % nblk, k0 = 64 * kb, n0 = 32 * nb;
    const int c4 = lane & 7, rr = lane >> 3; const bool okc = (n0 + 4 * c4) < N;
    f32x4 v[8];
#pragma unroll
    for (int i = 0; i < 8; ++i) { const int kk = i * 8 + rr; v[i] = okc ? *(const f32x4*)(W + (size_t)(k0 + kk) * N + n0 + 4 * c4) : (f32x4){0.f, 0.f, 0.f, 0.f}; }
#pragma unroll
    for (int i = 0; i < 8; ++i) { const int kk = i * 8 + rr; f32x4 x = v[i]; if (gk) x = x * gk[k0 + kk]; *(LAS f32x4*)(scr + kk * 36 + 4 * c4) = x; }
    LDS_WAIT(); asm volatile("" ::: "memory");
    const int c = lane & 7;
#pragma unroll
    for (int j = 0; j < 4; ++j) { const int nl = (lane >> 3) + 8 * j, n = n0 + nl; const LAS float* s = scr + (8 * c) * 36 + nl;
        v4u o; o.x = pk2(s[0 * 36], s[1 * 36]); o.y = pk2(s[2 * 36], s[3 * 36]); o.z = pk2(s[4 * 36], s[5 * 36]); o.w = pk2(s[6 * 36], s[7 * 36]);
        if (n < N) { const int row = (map == 0) ? row_off + n : (map == 1) ? (n < 1864 ? n : n + 184) : row_off + 2 * n + par;
            if (WT) *(GAS v4u*)(WT + (size_t)row * K + k0 + 8 * c) = o;
            if (WT8) { int w0 = __builtin_amdgcn_cvt_pk_fp8_f32(s[0 * 36] * s8, s[1 * 36] * s8, 0, false); w0 = __builtin_amdgcn_cvt_pk_fp8_f32(s[2 * 36] * s8, s[3 * 36] * s8, w0, true);
                int w1 = __builtin_amdgcn_cvt_pk_fp8_f32(s[4 * 36] * s8, s[5 * 36] * s8, 0, false); w1 = __builtin_amdgcn_cvt_pk_fp8_f32(s[6 * 36] * s8, s[7 * 36] * s8, w1, true);
                *(GAS unsigned long long*)(WT8 + (size_t)row * K + k0 + 8 * c) = (unsigned long long)(unsigned)w0 | ((unsigned long long)(unsigned)w1 << 32); } } }
    LDS_WAIT(); asm volatile("" ::: "memory");
}
__device__ __forceinline__ void p0_prologue(Frame& F, const Args& a) {
    LAS float* scr = (LAS float*)(F.lds + RING_OFF + F.wave * 16384);
    const int gw = F.vcu * NWAVES + F.wave, NGW = F.G * NWAVES;
    bf16* Win_t = (bf16*)(F.ws + WS_WIN); bf16* Wkv_t = (bf16*)(F.ws + WS_WKV);
    constexpr int I_IN = 16 * 219, I_KV = 4 * 8, I_SQ = 16 * 32, I_GU = 16 * 8  , I_DN = 4 * 32  ;
    constexpr int NITEMS = I_IN + I_KV + 3 * I_SQ + 16 * (2 * I_GU + I_DN);
    for (int it = gw; it < NITEMS; it += NGW) {
        int r = it;
        if (r < I_IN) { p0_transpose_item(a.in[2], 1024, INW, Win_t, 1, 0, 0, a.in[1], scr, r, F.lane, F.ws + WS_WIN8); continue; } r -= I_IN;
        if (r < I_KV) { p0_transpose_item(a.in[4], 256, 256, Wkv_t, 0, 0, 0, a.in[3], scr, r, F.lane); continue; } r -= I_KV;
        if (r < I_SQ) { p0_transpose_item(a.in[9], 1024, 1024, nullptr, 0, 0, 0, nullptr, scr, r, F.lane, F.ws + WS_WATT8, 32.f); continue; } r -= I_SQ;
        if (r < I_SQ) { p0_transpose_item(a.in[10], 1024, 1024, nullptr, 0, 0, 0, nullptr, scr, r, F.lane, F.ws + WS_WRET8, 32.f); continue; } r -= I_SQ;
        if (r < I_SQ) { p0_transpose_item(a.in[11], 1024, 1024, nullptr, 0, 0, 0, nullptr, scr, r, F.lane, F.ws + WS_WOUT8, 32.f); continue; } r -= I_SQ;
        const int e = r / (2 * I_GU + I_DN), q = r % (2 * I_GU + I_DN);
        if (q < I_GU) p0_transpose_item(a.in[17] + (size_t)e * 1024 * 256, 1024, 256, nullptr, 2, e * 512, 0, nullptr, scr, q, F.lane, F.ws + WS_W18, 32.f);
        else if (q < 2 * I_GU) p0_transpose_item(a.in[18] + (size_t)e * 1024 * 256, 1024, 256, nullptr, 2, e * 512, 1, nullptr, scr, q - I_GU, F.lane, F.ws + WS_W18, 32.f);
        else p0_transpose_item(a.in[19] + (size_t)e * 256 * 1024, 256, 1024, nullptr, 0, 0, 0, nullptr, scr, q - 2 * I_GU, F.lane, F.ws + WS_WD8 + (size_t)e * 1024 * 256, 16.f);
    }
    { const int gt = (F.vcu * NWAVES + F.wave) * 64 + F.lane, NGT = F.G * NWAVES * 64; GAS v4u* z = (GAS v4u*)(Win_t + (size_t)1864 * 1024);
      for (int i = gt; i < 184 * 1024 * 2 / 16; i += NGT) z[i] = (v4u){0u, 0u, 0u, 0u}; }
    { const int gt = (F.vcu * NWAVES + F.wave) * 64 + F.lane, NGT = F.G * NWAVES * 64; bf16* Wh = (bf16*)(F.ws + WS_WR); bf16* Wl = Wh + 32 * 1024;
      for (int i = gt; i < 32 * 1024; i += NGT) { const int n = i >> 10, k = i & 1023; const float wv = n < 4 ? a.in[13][k * 4 + n] : (n < 20 ? a.in[15][k * 16 + (n - 4)] : 0.f);
        const unsigned hb = f2bf(wv); const float hf = __uint_as_float(hb << 16); Wh[i] = (bf16)hb; Wl[i] = (bf16)f2bf(wv - hf); } }
    const float* x = a.in[0] + (size_t)a.tok0 * D; unsigned char* xb8 = a.xb + (size_t)F.ntok * AUX_XB8;
    for (int m = gw; m < F.ntok; m += 2 * NGW) {
        const int m2 = m + NGW; const bool two = m2 < F.ntok;
        const GAS f32x4* xr = (const GAS f32x4*)(x + (size_t)m * D) + F.lane; const GAS f32x4* xr2 = (const GAS f32x4*)(x + (size_t)(two ? m2 : m) * D) + F.lane;
        f32x4 v[4], u[4]; float s = 0.f, s2 = 0.f;
#pragma unroll
        for (int j = 0; j < 4; ++j) { v[j] = xr[64 * j]; u[j] = xr2[64 * j]; }
#pragma unroll
        for (int j = 0; j < 4; ++j) { s += (v[j].x * v[j].x + v[j].y * v[j].y) + (v[j].z * v[j].z + v[j].w * v[j].w); s2 += (u[j].x * u[j].x + u[j].y * u[j].y) + (u[j].z * u[j].z + u[j].w * u[j].w); }
        const float rstd = 1.f / sqrtf(wave_sum(s) * (1.f / D) + EPS), rstd2 = 1.f / sqrtf(wave_sum(s2) * (1.f / D) + EPS);
        GAS unsigned long long* o8 = (GAS unsigned long long*)(a.xb + (size_t)m * D * 2) + F.lane; GAS unsigned* q8 = (GAS unsigned*)(xb8 + (size_t)m * D) + F.lane;
#pragma unroll
        for (int j = 0; j < 4; ++j) { o8[64 * j] = (unsigned long long)pk2(v[j].x * rstd, v[j].y * rstd) | ((unsigned long long)pk2(v[j].z * rstd, v[j].w * rstd) << 32);
            int w8 = __builtin_amdgcn_cvt_pk_fp8_f32(v[j].x * rstd, v[j].y * rstd, 0, false); w8 = __builtin_amdgcn_cvt_pk_fp8_f32(v[j].z * rstd, v[j].w * rstd, w8, true); q8[64 * j] = (unsigned)w8; }
        if (two) { GAS unsigned long long* p8 = (GAS unsigned long long*)(a.xb + (size_t)m2 * D * 2) + F.lane; GAS unsigned* r8 = (GAS unsigned*)(xb8 + (size_t)m2 * D) + F.lane;
#pragma unroll
            for (int j = 0; j < 4; ++j) { p8[64 * j] = (unsigned long long)pk2(u[j].x * rstd2, u[j].y * rstd2) | ((unsigned long long)pk2(u[j].z * rstd2, u[j].w * rstd2) << 32);
                int w8 = __builtin_amdgcn_cvt_pk_fp8_f32(u[j].x * rstd2, u[j].y * rstd2, 0, false); w8 = __builtin_amdgcn_cvt_pk_fp8_f32(u[j].z * rstd2, u[j].w * rstd2, w8, true); r8[64 * j] = (unsigned)w8; } }
    }
}


constexpr size_t AUX_KP = 0, AUX_VV = 256, AUX_KIN = 512, AUX_MASK = 640, AUX_END = 896;
typedef short bf16x8_t __attribute__((ext_vector_type(8)));
typedef float f32x16 __attribute__((ext_vector_type(16)));
__device__ __forceinline__ int crow(int r, int hi) { return (r & 3) + 8 * (r >> 2) + 4 * hi; }
__device__ __forceinline__ float xhalf_sum(float v) { auto rr = __builtin_amdgcn_permlane32_swap(__float_as_uint(v), __float_as_uint(v), false, false); return __uint_as_float(rr[0]) + __uint_as_float(rr[1]); }
__device__ __forceinline__ float sumsq8(bf16x8_t v) { float s = 0.f;
#pragma unroll
    for (int j = 0; j < 8; ++j) { const float f = __uint_as_float((unsigned)(unsigned short)v[j] << 16); s += f * f; } return s; }
__device__ __forceinline__ void p2_post(Frame& F, const Args& a) {
    const int gw = F.vcu * NWAVES + F.wave, NGW = F.G * NWAVES, lane = F.lane, r32 = lane & 31, hi = lane >> 5;
    const size_t nt_ = (size_t)F.ntok;
    const bf16* CKV = (const bf16*)(F.act + nt_ * O_CKV); const bf16* KW = (const bf16*)(F.act + nt_ * O_KW);
    const bf16* Wkv_t = (const bf16*)(F.ws + WS_WKV);
    unsigned char* aux = a.xb + nt_ * 2048;
    bf16* KP = (bf16*)(aux + nt_ * AUX_KP); bf16* VV = (bf16*)(aux + nt_ * AUX_VV); bf16* KIN = (bf16*)(aux + nt_ * AUX_KIN);
    const float* g_q = a.in[5]; const float* g_k = a.in[6]; const float* g_ki = a.in[7];
    constexpr int WP = 528;
    LAS unsigned char* Wl = F.lds + RING_OFF; LAS float* gl = (LAS float*)(F.lds + RING_OFF + 256 * WP);
    for (int i = F.tid; i < 256 * 32; i += NWAVES * 64) { const int n = i >> 5, ch = i & 31; *(LAS v4u*)(Wl + n * WP + ch * 16) = *(const v4u*)(Wkv_t + (size_t)n * 256 + ch * 8); }
    if (F.tid < 128) gl[F.tid] = g_k[F.tid] * g_q[F.tid] * (0.08838834764831845f * 1.4426950408889634f);
    else if (F.tid < 192) gl[F.tid] = g_ki[F.tid - 128];
    __syncthreads();
    const int ntask = 2 * (F.ntok / 32);
    for (int task = gw; task < ntask; task += NGW) {
        const int kind = task & 1, t0 = (task >> 1) * 32;
        const bf16* crowp = CKV + (size_t)(t0 + r32) * 256 + hi * 8;
        bf16x8_t bfr[16]; float ss = 0.f;
#pragma unroll
        for (int kk = 0; kk < 16; ++kk) { bfr[kk] = *(const bf16x8_t*)(crowp + kk * 16); ss += sumsq8(bfr[kk]); }
        ss = xhalf_sum(ss);
        const float rstd = rsqrtf(ss * (1.f / 256.f) + EPS);
        f32x16 acc[4];
#pragma unroll
        for (int nt = 0; nt < 4; ++nt) { acc[nt] = f32x16{};
            const LAS unsigned char* wrow = Wl + (kind * 128 + nt * 32 + r32) * WP + hi * 16;
#pragma unroll
            for (int kk = 0; kk < 16; ++kk) { const bf16x8_t af = *(const LAS bf16x8_t*)(wrow + kk * 32); acc[nt] = __builtin_amdgcn_mfma_f32_32x32x16_bf16(af, bfr[kk], acc[nt], 0, 0, 0); if ((kk & 3) == 3) __builtin_amdgcn_sched_barrier(0); } }
        float sc = rstd;
        if (kind == 0) { float sk = 0.f;
#pragma unroll
            for (int nt = 0; nt < 4; ++nt)
#pragma unroll
                for (int r = 0; r < 16; ++r) { const float v = acc[nt][r] * rstd; sk += v * v; }
            sk = xhalf_sum(sk);
            sc = rstd * rsqrtf(sk * (1.f / 128.f) + EPS); }
        bf16* orow = (kind == 0 ? KP : VV) + (size_t)(t0 + r32) * 128;
#pragma unroll
        for (int nt = 0; nt < 4; ++nt)
#pragma unroll
            for (int g = 0; g < 4; ++g) { const int ch = nt * 32 + 8 * g + 4 * hi; float v[4];
#pragma unroll
                for (int j = 0; j < 4; ++j) { v[j] = acc[nt][4 * g + j] * sc; if (kind == 0) v[j] *= gl[ch + j]; }
                *(unsigned long long*)(orow + ch) = (unsigned long long)pk2(v[0], v[1]) | ((unsigned long long)pk2(v[2], v[3]) << 32); }
        if (kind == 0) {
            const bf16* kr = KW + (size_t)(t0 + r32) * 128 + hi * 32; bf16x8_t kv4[4]; float s2 = 0.f;
#pragma unroll
            for (int j = 0; j < 4; ++j) { kv4[j] = *(const bf16x8_t*)(kr + 8 * j); s2 += sumsq8(kv4[j]); }
            s2 = xhalf_sum(s2);
            const float rk = rsqrtf(s2 * (1.f / 64.f) + EPS);
            bf16* ko = KIN + (size_t)(t0 + r32) * 64 + hi * 32;
#pragma unroll
            for (int j = 0; j < 4; ++j) { float f[8];
#pragma unroll
                for (int e = 0; e < 8; ++e) f[e] = __uint_as_float((unsigned)(unsigned short)kv4[j][e] << 16) * rk * gl[128 + hi * 32 + 8 * j + e];
                v4u o; o.x = pk2(f[0], f[1]); o.y = pk2(f[2], f[3]); o.z = pk2(f[4], f[5]); o.w = pk2(f[6], f[7]);
                *(v4u*)(ko + 8 * j) = o; }
        }
    }
    __syncthreads();
}

typedef float f32x4_t __attribute__((ext_vector_type(4)));
__device__ __forceinline__ unsigned key15_of(float s) { const unsigned short hb = __builtin_bit_cast(unsigned short, (_Float16)s); const unsigned u = (hb & 0x8000u) ? (~(unsigned)hb & 0xffffu) : ((unsigned)hb | 0x8000u); return u >> 1; }
__device__ __forceinline__ unsigned sad4(unsigned x) { return __builtin_amdgcn_sad_u8(x, 0u, 0u); }
__device__ __forceinline__ void p3_merge(LAS unsigned* hist, LAS unsigned short* tot, int w, int g, int q, int& need, int& bsel) {
    __syncthreads();
    const int o = 4 * w + g; unsigned c = 0;
#pragma unroll
    for (int p = 0; p < 32; ++p) { const int tidp = (p >> 2) * 64 + (p & 3) * 16 + q; c += (hist[(o >> 2) * 512 + tidp] >> (8 * (o & 3))) & 0xffu; }
    tot[q * 32 + o] = (unsigned short)c;
    __syncthreads();
    v4u tv[4];
#pragma unroll
    for (int j = 0; j < 4; ++j) tv[j] = *(const LAS v4u*)((const LAS unsigned char*)tot + q * 64 + j * 16);
    int cum = 0, bs = 0, ab = 0; bool found = false;
#pragma unroll
    for (int bin = 31; bin >= 0; --bin) { const unsigned wd = tv[bin >> 3][(bin >> 1) & 3]; const int cc = (int)((bin & 1) ? (wd >> 16) : (wd & 0xffffu));
        if (!found && cum + cc >= need) { bs = bin; ab = cum; found = true; } cum += cc; }
    bsel = bs; need -= ab;
}
__device__ __forceinline__ void p3_index(Frame& F, const Args& a) {
    const int tid = F.tid, lane = F.lane, w = F.wave, q = lane & 15, g = lane >> 4;
    LAS unsigned* keys = (LAS unsigned*)(F.lds + RING_OFF);
    LAS unsigned char* qbuf = F.lds + 65536;
    LAS unsigned* hist = (LAS unsigned*)(F.lds + P3_HIST_OFF);
    LAS unsigned short* tot = (LAS unsigned short*)(F.lds + P3_TOT_OFF);
    LAS unsigned char* Tt = (LAS unsigned char*)(F.lds + P3_T_OFF);
    const size_t nt_ = (size_t)F.ntok;
    const bf16* QI = (const bf16*)(F.act + nt_ * O_QI); const bf16* KW = (const bf16*)(F.act + nt_ * O_KW);
    unsigned char* aux = a.xb + nt_ * 2048;
    const bf16* KIN = (const bf16*)(aux + nt_ * AUX_KIN); unsigned* MASK = (unsigned*)(aux + nt_ * AUX_MASK);
    const int nb = F.ntok / SEQ, nitems = nb * 128, G = F.G, c = (int)blockIdx.x;
#define P3_ITEM(k) ((k) * G + (((k) & 1) ? (G - 1 - c) : c))
#define P3_QDMA(it_, buf_) do { const int qg_ = 127 - (it_) / nb, b_ = (it_) % nb; _Pragma("unroll") for (int i_ = 0; i_ < 2; ++i_) { const int row_ = w * 2 + i_; \
        const char* src_ = (const char*)(QI + ((size_t)b_ * SEQ + qg_ * 16 + row_) * 512) + ((lane ^ (row_ & 15)) * 16); \
        __builtin_amdgcn_global_load_lds((const unsigned*)src_, (LAS unsigned*)(qbuf + (buf_) * 16384 + row_ * 1024), 16, 0, 0); } } while (0)
    const int nround = (nitems + G - 1) / G;
    if (P3_ITEM(0) < nitems) P3_QDMA(P3_ITEM(0), 0);
    v4u wvn = (v4u){0u, 0u, 0u, 0u};
    if (P3_ITEM(0) < nitems) { const int it0 = P3_ITEM(0); wvn = *(const v4u*)(KW + ((size_t)(it0 % nb) * SEQ + (127 - it0 / nb) * 16 + q) * 128 + 64); }
    for (int k = 0; k < nround; ++k) {
        const int it = P3_ITEM(k); if (it >= nitems) break;
        const int qg = 127 - it / nb, b = it % nb, q0 = qg * 16, qme = q0 + q;
        unsigned* Mb = MASK + (size_t)b * 64 * 2048;
        const int kb_hi = ((qg >> 3) + 1) << 2, nkb = (qg >> 1) + 1;
        asm volatile("s_waitcnt vmcnt(0) lgkmcnt(0)\n\ts_barrier" ::: "memory");
        const v4u wv = wvn;
        { const int itn = P3_ITEM(k + 1); if (k + 1 < nround && itn < nitems) { P3_QDMA(itn, (k + 1) & 1); wvn = *(const v4u*)(KW + ((size_t)(itn % nb) * SEQ + (127 - itn / nb) * 16 + q) * 128 + 64); } }
        if (qg < 16) {
            if (tid < kb_hi * 16) { const int kb = tid >> 4, qq = q0 + (tid & 15), nbits = qq - kb * 32 + 1; Mb[kb * 2048 + qq] = nbits >= 32 ? 0xffffffffu : (nbits <= 0 ? 0u : ((1u << nbits) - 1u)); }
            continue;
        }
        float wq[8];
        { const float cc = 0.35355339059327373f * 0.125f;
          wq[0] = pg8::bf_lo(wv.x) * cc; wq[1] = pg8::bf_hi(wv.x) * cc; wq[2] = pg8::bf_lo(wv.y) * cc; wq[3] = pg8::bf_hi(wv.y) * cc; wq[4] = pg8::bf_lo(wv.z) * cc; wq[5] = pg8::bf_hi(wv.z) * cc; wq[6] = pg8::bf_lo(wv.w) * cc; wq[7] = pg8::bf_hi(wv.w) * cc; }
        bf16x8_t qfr[8][2], qlin[2];
        { const LAS unsigned char* qrow = qbuf + (k & 1) * 16384 + q * 1024;
#pragma unroll
          for (int h = 0; h < 8; ++h)
#pragma unroll
            for (int ks = 0; ks < 2; ++ks) qfr[h][ks] = *(const LAS bf16x8_t*)(qrow + (((h * 8 + ks * 4 + g) ^ q) * 16)); }
#pragma unroll
        for (int ks = 0; ks < 2; ++ks) { float f[8];
#pragma unroll
            for (int j = 0; j < 8; ++j) { float s = 0.f;
#pragma unroll
                for (int h = 0; h < 8; ++h) s += wq[h] * __uint_as_float((unsigned)(unsigned short)qfr[h][ks][j] << 16);
                f[j] = s; }
            v4u o; o.x = pk2(f[0], f[1]); o.y = pk2(f[2], f[3]); o.z = pk2(f[4], f[5]); o.w = pk2(f[6], f[7]); qlin[ks] = __builtin_bit_cast(bf16x8_t, o); }
#pragma unroll
        for (int i = 0; i < 8; ++i) hist[i * 512 + tid] = 0u;
        const bf16* kbase = KIN + ((size_t)b * SEQ + q) * 64 + g * 8;
        bf16x8_t afr[2][2], afn[2][2];
#pragma unroll
        for (int t = 0; t < 2; ++t)
#pragma unroll
            for (int ks = 0; ks < 2; ++ks) afn[t][ks] = *(const bf16x8_t*)(kbase + (size_t)(w * 32 + t * 16) * 64 + ks * 32);
        for (int s = 0, kb = w; kb < nkb; ++s, kb += 8) {
#pragma unroll
            for (int t = 0; t < 2; ++t)
#pragma unroll
                for (int ks = 0; ks < 2; ++ks) afr[t][ks] = afn[t][ks];
            if (kb + 8 < nkb) {
#pragma unroll
                for (int t = 0; t < 2; ++t)
#pragma unroll
                    for (int ks = 0; ks < 2; ++ks) afn[t][ks] = *(const bf16x8_t*)(kbase + (size_t)((kb + 8) * 32 + t * 16) * 64 + ks * 32); }
#pragma unroll
            for (int t = 0; t < 2; ++t) {
                f32x4_t sacc = f32x4_t{};
#pragma unroll
                for (int ks = 0; ks < 2; ++ks) sacc = __builtin_amdgcn_mfma_f32_16x16x32_bf16(afr[t][ks], qlin[ks], sacc, 0, 0, 0);
#pragma unroll
                for (int h = 0; h < 8; ++h) { f32x4_t d = f32x4_t{};
#pragma unroll
                    for (int ks = 0; ks < 2; ++ks) d = __builtin_amdgcn_mfma_f32_16x16x32_bf16(afr[t][ks], qfr[h][ks], d, 0, 0, 0);
#pragma unroll
                    for (int r = 0; r < 4; ++r) sacc[r] = fmaf(fabsf(d[r]), wq[h], sacc[r]); }
#pragma unroll
                for (int i = 0; i < 2; ++i) { unsigned k2[2];
#pragma unroll
                    for (int e = 0; e < 2; ++e) { const int r = 2 * i + e; unsigned kk_ = key15_of(sacc[r]); if (kb * 32 + t * 16 + 4 * g + r > qme) kk_ = 0u; k2[e] = kk_;
                        const unsigned dg = kk_ >> 10; (void)__hip_atomic_fetch_add((LAS unsigned*)&hist[(dg >> 2) * 512 + tid], 1u << ((dg & 3u) * 8u), __ATOMIC_RELAXED, __HIP_MEMORY_SCOPE_WORKGROUP); }
                    keys[(s * 4 + t * 2 + i) * 512 + tid] = k2[0] | (k2[1] << 16); }
            }
        }
        int need = 256, bsel;
        p3_merge(hist, tot, w, g, q, need, bsel);
        unsigned prefix = (unsigned)bsel;
#pragma unroll
        for (int pass = 0; pass < 2; ++pass) {
            const int sh_hi = pass == 0 ? 10 : 5, sh = pass == 0 ? 5 : 0;
#pragma unroll
            for (int i = 0; i < 8; ++i) hist[i * 512 + tid] = 0u;
#pragma unroll
            for (int s = 0; s < 8; ++s) if (w + 8 * s < nkb) {
#pragma unroll
                for (int i = 0; i < 4; ++i) { const unsigned d2 = keys[(s * 4 + i) * 512 + tid];
#pragma unroll
                    for (int e = 0; e < 2; ++e) { const unsigned kk_ = e ? (d2 >> 16) : (d2 & 0xffffu);
                        if ((kk_ >> sh_hi) == prefix) { const unsigned dg = (kk_ >> sh) & 31u; (void)__hip_atomic_fetch_add((LAS unsigned*)&hist[(dg >> 2) * 512 + tid], 1u << ((dg & 3u) * 8u), __ATOMIC_RELAXED, __HIP_MEMORY_SCOPE_WORKGROUP); } } } }
            p3_merge(hist, tot, w, g, q, need, bsel);
            prefix = (prefix << 5) | (unsigned)bsel;
        }
        const unsigned tau = prefix; const int need_eq = need;
        unsigned gtw[8], eqw[8];
#pragma unroll
        for (int s = 0; s < 8; ++s) { const int kb = w + 8 * s; gtw[s] = 0u; eqw[s] = 0u;
            if (kb < nkb) { unsigned gg = 0u, qq = 0u;
#pragma unroll
                for (int i = 0; i < 4; ++i) { const unsigned d2 = keys[(s * 4 + i) * 512 + tid];
#pragma unroll
                    for (int e = 0; e < 2; ++e) { const unsigned kk_ = e ? (d2 >> 16) : (d2 & 0xffffu); const int bit = (i >> 1) * 16 + 4 * g + (i & 1) * 2 + e;
                        gg |= (kk_ > tau ? 1u : 0u) << bit; qq |= (kk_ == tau ? 1u : 0u) << bit; } }
                gg |= (unsigned)__shfl_xor((int)gg, 16); gg |= (unsigned)__shfl_xor((int)gg, 32); qq |= (unsigned)__shfl_xor((int)qq, 16); qq |= (unsigned)__shfl_xor((int)qq, 32);
                gtw[s] = gg; eqw[s] = qq;
                if (g == 0) Tt[q * 64 + kb] = (unsigned char)__builtin_popcount(qq); } }
        __syncthreads();
        { unsigned run = 0u;
#pragma unroll
          for (int s = 0; s < 8; ++s) { const int kb = w + 8 * s;
            if (kb < nkb) { const unsigned g0 = *(const LAS unsigned*)(Tt + q * 64 + 8 * s), g1 = *(const LAS unsigned*)(Tt + q * 64 + 8 * s + 4);
                const unsigned m0 = w >= 4 ? g0 : (w == 0 ? 0u : (g0 & ((1u << (8 * w)) - 1u))), m1 = w > 4 ? (g1 & ((1u << (8 * (w - 4))) - 1u)) : 0u;
                const int pre = (int)(run + sad4(m0) + sad4(m1)), m = need_eq - pre, pc = __builtin_popcount(eqw[s]);
                unsigned se = eqw[s];
                if (m < pc) { se = 0u; unsigned x = eqw[s]; for (int i = 0; i < m; ++i) { const unsigned bb = x & (0u - x); se |= bb; x ^= bb; } }
                if (g == 0) Mb[kb * 2048 + qme] = gtw[s] | se;
                run += sad4(g0) + sad4(g1); } } }
        if (tid < (kb_hi - nkb) * 16) Mb[(nkb + (tid >> 4)) * 2048 + q0 + (tid & 15)] = 0u;
    }
    asm volatile("s_waitcnt vmcnt(0) lgkmcnt(0)" ::: "memory");
    __syncthreads();
#undef P3_ITEM
#undef P3_QDMA
}

namespace att {
using bf16x8 = __attribute__((ext_vector_type(8))) short;
using s16x4  = __attribute__((ext_vector_type(4))) short;
using u32x4  = __attribute__((ext_vector_type(4))) unsigned;
constexpr int KVBLK = 64;
constexpr size_t SHM_V = KVBLK * 128 * 2, SHM_K = KVBLK * 128 * 2;
constexpr int OFF_WS = 65536, OFF_MK = 65536 + 2048, OFF_Q = 65536 + 2048 + 8192, QPITCH = 272;
constexpr float THR2 = 11.5f;
#define KSWZ(row, colB) ((row) * 256 + ((colB) ^ (((row) & 7) << 4)))
#define SBAR() __builtin_amdgcn_sched_barrier(0)
__device__ __forceinline__ unsigned cvtpk(float lo, float hi) { unsigned r; asm volatile("v_cvt_pk_bf16_f32 %0, %1, %2" : "=v"(r) : "v"(lo), "v"(hi)); return r; }
__device__ __forceinline__ float msk(float p, unsigned w, int bit) { const int m = __builtin_amdgcn_sbfe((int)w, bit, 1); return __uint_as_float((__float_as_uint(p) & (unsigned)m) | (0xff800000u & ~(unsigned)m)); }
__device__ __forceinline__ void partialSM(f32x16& p0, f32x16& p1, unsigned w0, unsigned w1, float& m_reg, float& mn, float& alpha) {
#pragma unroll
  for (int r = 0; r < 16; ++r) { const int bit = (r & 3) + 8 * (r >> 2); p0[r] = msk(p0[r], w0, bit); p1[r] = msk(p1[r], w1, bit); }
  float pmax = p0[0];
#pragma unroll
  for (int r = 1; r < 16; ++r) pmax = fmaxf(pmax, p0[r]);
#pragma unroll
  for (int r = 0; r < 16; ++r) pmax = fmaxf(pmax, p1[r]);
  { auto rr = __builtin_amdgcn_permlane32_swap(__float_as_uint(pmax), __float_as_uint(pmax), false, false); pmax = fmaxf(__uint_as_float(rr[0]), __uint_as_float(rr[1])); }
  if (__builtin_expect(__all(pmax - m_reg <= THR2), 1)) { mn = m_reg; alpha = 1.f; }
  else { mn = fmaxf(m_reg, pmax); alpha = __builtin_amdgcn_exp2f(m_reg - mn); m_reg = mn; }
#pragma unroll
  for (int r = 0; r < 16; ++r) { p0[r] -= mn; p1[r] -= mn; }
#pragma unroll
  for (int r = 0; r < 16; ++r) p0[r] = __builtin_amdgcn_exp2f(p0[r]);
}
__device__ __forceinline__ void finishSM(f32x16& p0, f32x16& p1, float alpha, float& l_reg, bf16x8& pa0, bf16x8& pa1, bf16x8& pa2, bf16x8& pa3) {
#pragma unroll
  for (int r = 0; r < 16; ++r) p1[r] = __builtin_amdgcn_exp2f(p1[r]);
  float ps = 0;
#pragma unroll
  for (int r = 0; r < 16; ++r) ps += p0[r];
#pragma unroll
  for (int r = 0; r < 16; ++r) ps += p1[r];
  { auto rr = __builtin_amdgcn_permlane32_swap(__float_as_uint(ps), __float_as_uint(ps), false, false); ps = __uint_as_float(rr[0]) + __uint_as_float(rr[1]); }
  l_reg = l_reg * alpha + ps;
#define PK4(P, BASE, OUT) do { unsigned a0 = cvtpk(P[BASE + 0], P[BASE + 1]), a1 = cvtpk(P[BASE + 2], P[BASE + 3]);   \
    unsigned b0 = cvtpk(P[BASE + 4], P[BASE + 5]), b1 = cvtpk(P[BASE + 6], P[BASE + 7]);                              \
    auto r0 = __builtin_amdgcn_permlane32_swap(a0, b0, false, false); auto r1 = __builtin_amdgcn_permlane32_swap(a1, b1, false, false); \
    u32x4 w = {r0[0], r1[0], r0[1], r1[1]}; OUT = *reinterpret_cast<bf16x8*>(&w); } while (0)
  PK4(p0, 0, pa0); PK4(p0, 8, pa1); PK4(p1, 0, pa2); PK4(p1, 8, pa3);
#undef PK4
}
__device__ __forceinline__ void qkt(f32x16& p0, f32x16& p1, const char* Ks, const char* qrow, const float (&bo)[16], float kb0, float kb1, int r32, int hi) {
#pragma unroll
  for (int r = 0; r < 16; ++r) { p0[r] = bo[r] + kb0; p1[r] = bo[r] + kb1; }
#pragma unroll
  for (int d0 = 0; d0 < 8; ++d0) { const int cb = (d0 * 16 + hi * 8) * 2;
    const bf16x8 b0 = *reinterpret_cast<const bf16x8*>(Ks + KSWZ(r32, cb));
    const bf16x8 b1 = *reinterpret_cast<const bf16x8*>(Ks + KSWZ(32 + r32, cb));
    const bf16x8 qf = *reinterpret_cast<const bf16x8*>(qrow + d0 * 32);
    p0 = __builtin_amdgcn_mfma_f32_32x32x16_bf16(b0, qf, p0, 0, 0, 0);
    p1 = __builtin_amdgcn_mfma_f32_32x32x16_bf16(b1, qf, p1, 0, 0, 0); }
}
__device__ __forceinline__ int v_st(int k, int c) { const int kk = (k & ~0xC) | ((k & 4) << 1) | ((k & 8) >> 1); return ((kk >> 3) * 4 + (c >> 5)) * 512 + ((kk & 7) * 32 + (c & 31)) * 2; }
__device__ __forceinline__ int v_rd_base(int lane) { return ((lane & 3) << 3) | (((lane >> 2) & 3) << 6) | (((lane >> 4) & 1) << 5) | (((lane >> 5) & 1) << 8); }
constexpr int v_rd_off(int d0, int ks, int half) { return d0 * 512 + ks * 4096 + half * 2048; }
template <int OFF> __device__ __forceinline__ s16x4 tr_read(int vb) { s16x4 r; asm volatile("ds_read_b64_tr_b16 %0, %1 offset:%2" : "=&v"(r) : "v"(vb), "i"(OFF) : "memory"); return r; }
template <int D0> __device__ __forceinline__ void pv_one(f32x16& od, int vb, bf16x8 pa0, bf16x8 pa1, bf16x8 pa2, bf16x8 pa3) {
  const s16x4 l0 = tr_read<v_rd_off(D0, 0, 0)>(vb), h0 = tr_read<v_rd_off(D0, 0, 1)>(vb), l1 = tr_read<v_rd_off(D0, 1, 0)>(vb), h1 = tr_read<v_rd_off(D0, 1, 1)>(vb);
  const s16x4 l2 = tr_read<v_rd_off(D0, 2, 0)>(vb), h2 = tr_read<v_rd_off(D0, 2, 1)>(vb), l3 = tr_read<v_rd_off(D0, 3, 0)>(vb), h3 = tr_read<v_rd_off(D0, 3, 1)>(vb);
  asm volatile("s_waitcnt lgkmcnt(0)" ::: "memory"); SBAR();
#define PK(L, H) (bf16x8){L[0], L[1], L[2], L[3], H[0], H[1], H[2], H[3]}
  od = __builtin_amdgcn_mfma_f32_32x32x16_bf16(pa0, PK(l0, h0), od, 0, 0, 0);
  od = __builtin_amdgcn_mfma_f32_32x32x16_bf16(pa1, PK(l1, h1), od, 0, 0, 0);
  od = __builtin_amdgcn_mfma_f32_32x32x16_bf16(pa2, PK(l2, h2), od, 0, 0, 0);
  od = __builtin_amdgcn_mfma_f32_32x32x16_bf16(pa3, PK(l3, h3), od, 0, 0, 0);
#undef PK
}
__device__ __forceinline__ void pv_d0(f32x16* o, int vb, bf16x8 pa0, bf16x8 pa1, bf16x8 pa2, bf16x8 pa3) {
  pv_one<0>(o[0], vb, pa0, pa1, pa2, pa3); pv_one<1>(o[1], vb, pa0, pa1, pa2, pa3); pv_one<2>(o[2], vb, pa0, pa1, pa2, pa3); pv_one<3>(o[3], vb, pa0, pa1, pa2, pa3);
}
__device__ __forceinline__ void attn_item(const bf16* __restrict__ Qb, const bf16* __restrict__ Kh, const bf16* __restrict__ Vh, const unsigned* __restrict__ Mq, bf16* __restrict__ Ob, int NT, char* lds, LAS unsigned char* ldsL) {
  const int tid = threadIdx.x, wid = __builtin_amdgcn_readfirstlane(tid >> 6), lane = tid & 63, r32 = lane & 31, hi = lane >> 5;
  float* ws = (float*)(lds + OFF_WS) + wid * 64; float* li_l = ws; float* al_l = ws + 32;
  unsigned* mk = (unsigned*)(lds + OFF_MK);
  unsigned soff[4];
#pragma unroll
  for (int i = 0; i < 4; ++i) { const int pc = (wid & 3) * 4 + i;
    if (wid < 4) { const int row = pc * 4 + (lane >> 4), cb = (lane & 15) * 16; soff[i] = (unsigned)(row * 256 + (cb ^ ((row & 7) << 4))); }
    else { const int L = pc * 1024 + lane * 16, st = L >> 9, wi = L & 511, kk = (st >> 2) * 8 + (wi >> 6), c = (st & 3) * 32 + ((wi & 63) >> 1), k = (kk & ~0xC) | ((kk & 4) << 1) | ((kk & 8) >> 1);
           soff[i] = (unsigned)(k * 256 + c * 2); } }
  const char* gsrc = (const char*)(wid < 4 ? Kh : Vh);
  const unsigned ldst = (unsigned)((wid < 4 ? 0 : 16384) + (wid & 3) * 4096);
#define DMA_TILE(t, slot) do { _Pragma("unroll") for (int i_ = 0; i_ < 4; ++i_) \
    __builtin_amdgcn_global_load_lds((const unsigned*)(gsrc + (size_t)(t) * (64 * 256) + soff[i_]), (LAS unsigned*)(ldsL + (slot) * 32768 + ldst + i_ * 1024), 16, 0, 0); } while (0)
  DMA_TILE(0, 0);
  for (int i = tid; i < NT * 64; i += 512) mk[i] = Mq[(size_t)(i >> 5) * 2048 + (i & 31)];
  float m_reg = -1e30f, l_reg = 0; f32x16 o[4] = {}; bf16x8 qr[8];
  { const bf16* Qw = Qb + (size_t)r32 * 1024 + wid * 128 + hi * 8; float ss = 0.f;
#pragma unroll
    for (int d0 = 0; d0 < 8; ++d0) { qr[d0] = *reinterpret_cast<const bf16x8*>(Qw + d0 * 16); ss += sumsq8(qr[d0]); }
    ss = xhalf_sum(ss); const float rq = rsqrtf(ss * (1.f / 128.f) + EPS);
#pragma unroll
    for (int d0 = 0; d0 < 8; ++d0) { float f[8];
#pragma unroll
      for (int j = 0; j < 8; ++j) f[j] = __uint_as_float((unsigned)(unsigned short)qr[d0][j] << 16) * rq;
      u32x4 w = {cvtpk(f[0], f[1]), cvtpk(f[2], f[3]), cvtpk(f[4], f[5]), cvtpk(f[6], f[7])}; qr[d0] = *reinterpret_cast<bf16x8*>(&w); } }
  const float slope2 = __builtin_amdgcn_exp2f(-(float)(wid + 1)) * 1.4426950408889634f;
  float bo[16];
#pragma unroll
  for (int r = 0; r < 16; ++r) bo[r] = __uint_as_float(__builtin_amdgcn_readfirstlane(__float_as_uint(slope2 * (float)((r & 3) + 8 * (r >> 2)))));
  const float hoff = slope2 * (float)(4 * hi);
  const int vb0 = (int)(uintptr_t)(lds + 16384) + v_rd_base(lane);
  asm volatile("s_waitcnt vmcnt(0) lgkmcnt(0)\n\ts_barrier" ::: "memory");
  for (int j = 0; j < NT; ++j) {
    const int sl = j & 1;
    if (j + 1 < NT) DMA_TILE(j + 1, sl ^ 1);
    const char* Ks = lds + sl * 32768;
    const unsigned w0 = mk[(2 * j) * 32 + r32] >> (4 * hi), w1 = mk[(2 * j + 1) * 32 + r32] >> (4 * hi);
    f32x16 p0, p1;
    { const float kb0 = slope2 * (float)(j * 64) + hoff, kb1 = kb0 + slope2 * 32.f;
#pragma unroll
      for (int r = 0; r < 16; ++r) { p0[r] = bo[r] + kb0; p1[r] = bo[r] + kb1; }
      bf16x8 ka = *reinterpret_cast<const bf16x8*>(Ks + KSWZ(r32, hi * 16)), kb = *reinterpret_cast<const bf16x8*>(Ks + KSWZ(32 + r32, hi * 16));
#pragma unroll
      for (int d0 = 0; d0 < 8; ++d0) { bf16x8 na = ka, nb = kb;
        if (d0 < 7) { const int cb = ((d0 + 1) * 16 + hi * 8) * 2; na = *reinterpret_cast<const bf16x8*>(Ks + KSWZ(r32, cb)); nb = *reinterpret_cast<const bf16x8*>(Ks + KSWZ(32 + r32, cb)); }
        SBAR();
        p0 = __builtin_amdgcn_mfma_f32_32x32x16_bf16(ka, qr[d0], p0, 0, 0, 0);
        p1 = __builtin_amdgcn_mfma_f32_32x32x16_bf16(kb, qr[d0], p1, 0, 0, 0);
        SBAR();
        ka = na; kb = nb; } }
    float alpha; bf16x8 pa0, pa1, pa2, pa3;
    {
#pragma unroll
      for (int r = 0; r < 16; ++r) { const int bit = (r & 3) + 8 * (r >> 2); p0[r] = msk(p0[r], w0, bit); p1[r] = msk(p1[r], w1, bit); }
      float pmax = fmaxf(p0[0], p1[0]);
#pragma unroll
      for (int r = 1; r < 16; ++r) pmax = fmaxf(fmaxf(pmax, p0[r]), p1[r]);
      { auto rr = __builtin_amdgcn_permlane32_swap(__float_as_uint(pmax), __float_as_uint(pmax), false, false); pmax = fmaxf(__uint_as_float(rr[0]), __uint_as_float(rr[1])); }
      float mn;
      if (__builtin_expect(__all(pmax - m_reg <= THR2), 1)) { mn = m_reg; alpha = 1.f; }
      else { mn = fmaxf(m_reg, pmax); alpha = __builtin_amdgcn_exp2f(m_reg - mn); m_reg = mn; }
      float ps = 0.f;
#pragma unroll
      for (int r = 0; r < 16; ++r) { p0[r] = __builtin_amdgcn_exp2f(p0[r] - mn); p1[r] = __builtin_amdgcn_exp2f(p1[r] - mn); ps += p0[r] + p1[r]; }
      { auto rr = __builtin_amdgcn_permlane32_swap(__float_as_uint(ps), __float_as_uint(ps), false, false); ps = __uint_as_float(rr[0]) + __uint_as_float(rr[1]); }
      l_reg = l_reg * alpha + ps;
#define PK4(P, BASE, OUT) do { unsigned a0 = cvtpk(P[BASE + 0], P[BASE + 1]), a1 = cvtpk(P[BASE + 2], P[BASE + 3]);   \
    unsigned b0 = cvtpk(P[BASE + 4], P[BASE + 5]), b1 = cvtpk(P[BASE + 6], P[BASE + 7]);                              \
    auto r0 = __builtin_amdgcn_permlane32_swap(a0, b0, false, false); auto r1 = __builtin_amdgcn_permlane32_swap(a1, b1, false, false); \
    u32x4 w = {r0[0], r1[0], r0[1], r1[1]}; OUT = *reinterpret_cast<bf16x8*>(&w); } while (0)
      PK4(p0, 0, pa0); PK4(p0, 8, pa1); PK4(p1, 0, pa2); PK4(p1, 8, pa3);
#undef PK4
      if (__any(alpha < 1.f)) { if (hi == 0) al_l[r32] = alpha; asm volatile("s_waitcnt lgkmcnt(0)" ::: "memory");
#pragma unroll
        for (int d = 0; d < 4; ++d)
#pragma unroll
          for (int r = 0; r < 16; ++r) o[d][r] *= al_l[crow(r, hi)]; }
    }
    { const int vb = vb0 + sl * 32768;
      s16x4 lA[4], hA[4], lB[4], hB[4];
#define VREADS(L_, H_, D0) do { L_[0] = tr_read<v_rd_off(D0, 0, 0)>(vb); H_[0] = tr_read<v_rd_off(D0, 0, 1)>(vb); L_[1] = tr_read<v_rd_off(D0, 1, 0)>(vb); H_[1] = tr_read<v_rd_off(D0, 1, 1)>(vb); \
      L_[2] = tr_read<v_rd_off(D0, 2, 0)>(vb); H_[2] = tr_read<v_rd_off(D0, 2, 1)>(vb); L_[3] = tr_read<v_rd_off(D0, 3, 0)>(vb); H_[3] = tr_read<v_rd_off(D0, 3, 1)>(vb); } while (0)
#define PK(L, H) (bf16x8){L[0], L[1], L[2], L[3], H[0], H[1], H[2], H[3]}
#define VMMA(OD, L_, H_) do { OD = __builtin_amdgcn_mfma_f32_32x32x16_bf16(pa0, PK(L_[0], H_[0]), OD, 0, 0, 0); OD = __builtin_amdgcn_mfma_f32_32x32x16_bf16(pa1, PK(L_[1], H_[1]), OD, 0, 0, 0); \
      OD = __builtin_amdgcn_mfma_f32_32x32x16_bf16(pa2, PK(L_[2], H_[2]), OD, 0, 0, 0); OD = __builtin_amdgcn_mfma_f32_32x32x16_bf16(pa3, PK(L_[3], H_[3]), OD, 0, 0, 0); } while (0)
#define VWAIT(N, L_, H_) do { asm volatile("s_waitcnt lgkmcnt(" #N ")" : "+v"(L_[0]), "+v"(L_[1]), "+v"(L_[2]), "+v"(L_[3]), "+v"(H_[0]), "+v"(H_[1]), "+v"(H_[2]), "+v"(H_[3]) :: "memory"); SBAR(); } while (0)
      VREADS(lA, hA, 0); VREADS(lB, hB, 1);
      VWAIT(8, lA, hA); VMMA(o[0], lA, hA);
      VREADS(lA, hA, 2);
      VWAIT(8, lB, hB); VMMA(o[1], lB, hB);
      VREADS(lB, hB, 3);
      VWAIT(8, lA, hA); VMMA(o[2], lA, hA);
      VWAIT(0, lB, hB); VMMA(o[3], lB, hB);
#undef VREADS
#undef PK
#undef VMMA
#undef VWAIT
    }
    asm volatile("s_waitcnt vmcnt(0) lgkmcnt(0)\n\ts_barrier" ::: "memory");
  }
  if (hi == 0) li_l[r32] = l_reg; asm volatile("s_waitcnt lgkmcnt(0)" ::: "memory");
  float rli[16];
#pragma unroll
  for (int r = 0; r < 16; ++r) rli[r] = __builtin_amdgcn_rcpf(li_l[crow(r, hi)]);
  unsigned char* stg = (unsigned char*)(lds + wid * 4096);
#pragma unroll
  for (int r = 0; r < 16; ++r) { const int orow = crow(r, hi); const float sc16 = rli[r] * 16.f;
#pragma unroll
    for (int d0 = 0; d0 < 4; ++d0) stg[orow * 128 + d0 * 32 + r32] = (unsigned char)__builtin_amdgcn_cvt_pk_fp8_f32(o[d0][r] * sc16, 0.f, 0, false); }
  asm volatile("s_waitcnt lgkmcnt(0)" ::: "memory");
#pragma unroll
  for (int i = 0; i < 4; ++i) { const int row = i * 8 + (lane >> 3), ch = lane & 7; const u32x4 v = *(const u32x4*)(stg + row * 128 + ch * 16);
    *(u32x4*)((unsigned char*)Ob + (size_t)row * 2048 + wid * 128 + ch * 16) = v; }
#undef DMA_TILE
}
#undef KSWZ
#undef SBAR
}


namespace ret {
using bf16x8 = __attribute__((ext_vector_type(8))) short;
using s16x4  = __attribute__((ext_vector_type(4))) short;
using u32x4  = __attribute__((ext_vector_type(4))) unsigned;
using u32x2  = __attribute__((ext_vector_type(2))) unsigned;
constexpr int C = 64, QP = 272, KPI = 272, VP = 576;
constexpr int OFF_Q = 0, OFF_K = 17408, OFF_V = 34816, OFF_ST = 71680, OFF_Y = 75776;
typedef float f32x2_t __attribute__((ext_vector_type(2))); typedef __bf16 bf16x2_t __attribute__((ext_vector_type(2)));
__device__ __forceinline__ unsigned cvtpk(float lo, float hi) { const f32x2_t v = {lo, hi}; const bf16x2_t b = __builtin_convertvector(v, bf16x2_t); return __builtin_bit_cast(unsigned, b); }
template <int OFF> __device__ __forceinline__ s16x4 trr(int base) { s16x4 r; asm volatile("ds_read_b64_tr_b16 %0, %1 offset:%2" : "=&v"(r) : "v"(base), "i"(OFF) : "memory"); return r; }
__device__ __forceinline__ bf16x8 pk8(const f32x16& x, int s) { u32x4 w = {cvtpk(x[8 * s + 0], x[8 * s + 1]), cvtpk(x[8 * s + 2], x[8 * s + 3]), cvtpk(x[8 * s + 4], x[8 * s + 5]), cvtpk(x[8 * s + 6], x[8 * s + 7])}; return *reinterpret_cast<bf16x8*>(&w); }
__device__ __forceinline__ float silu_(float x) { return x * __builtin_amdgcn_rcpf(1.f + __builtin_amdgcn_exp2f(-1.4426950408889634f * x)); }
__device__ __forceinline__ void ret_item(int b, int h, const bf16* __restrict__ RQ, const bf16* __restrict__ RK, const bf16* __restrict__ RV, const bf16* __restrict__ RG, unsigned char* A2F8, const float* __restrict__ gnorm, char* lds) {
  const int tid = threadIdx.x, w = __builtin_amdgcn_readfirstlane(tid >> 6), lane = tid & 63, r32 = lane & 31, hi = lane >> 5;
  const float lg = __log2f(1.f - exp2f(-5.f - (float)h)), gC = exp2f(64.f * lg);
  char* Qs = lds + OFF_Q; char* Ks = lds + OFF_K; char* Vs = lds + OFF_V; float* st = (float*)(lds + OFF_ST); char* Ys = lds + OFF_Y;
  f32x16 S[4] = {};
  const unsigned voffQ = (unsigned)(((tid >> 4) * 512 + (tid & 15) * 8) * 2), voffV = (unsigned)(((tid >> 5) * 1024 + (tid & 31) * 8) * 2);
  const int trq = (lane & 15) >> 2, trp = lane & 3, trg = (lane >> 4) & 1;
  const int vtb = (int)(uintptr_t)(lds + OFF_V) + (4 * hi + trq) * VP + (32 * w + 16 * trg + 4 * trp) * 2, ktb = (int)(uintptr_t)(lds + OFF_K) + (4 * hi + trq) * KPI + (16 * trg + 4 * trp) * 2;
  u32x4 pq[2], pk[2], pv[4];
#define RET_LOAD(cc) do { const size_t t0_ = (size_t)b * SEQ + (size_t)(cc) * C; const char* qb_ = (const char*)(RQ + t0_ * 512 + h * 128); const char* kb_ = (const char*)(RK + t0_ * 512 + h * 128); const char* vb_ = (const char*)(RV + t0_ * 1024 + h * 256); \
    _Pragma("unroll") for (int i = 0; i < 2; ++i) { pq[i] = *(const u32x4*)(qb_ + voffQ + i * 32768); pk[i] = *(const u32x4*)(kb_ + voffQ + i * 32768); } \
    _Pragma("unroll") for (int i = 0; i < 4; ++i) pv[i] = *(const u32x4*)(vb_ + voffV + i * 32768); } while (0)
#define RET_STAGE() do { \
    _Pragma("unroll") for (int i = 0; i < 2; ++i) { const int row = (tid >> 4) + 32 * i, ch = tid & 15; \
      *(u32x4*)(Qs + row * QP + ch * 16) = pq[i]; \
      const u32x4 kv = pk[i]; const float f = exp2f(lg * (float)(C - 1 - row)) * 0.08838834764831845f; \
      u32x4 ko; ko.x = cvtpk(pg8::bf_lo(kv.x) * f, pg8::bf_hi(kv.x) * f); ko.y = cvtpk(pg8::bf_lo(kv.y) * f, pg8::bf_hi(kv.y) * f); ko.z = cvtpk(pg8::bf_lo(kv.z) * f, pg8::bf_hi(kv.z) * f); ko.w = cvtpk(pg8::bf_lo(kv.w) * f, pg8::bf_hi(kv.w) * f); \
      *(u32x4*)(Ks + row * KPI + ch * 16) = ko; } \
    _Pragma("unroll") for (int i = 0; i < 4; ++i) { const int row = (tid >> 5) + 16 * i, ch = tid & 31; *(u32x4*)(Vs + row * VP + ch * 16) = pv[i]; } } while (0)
  RET_LOAD(0);
  __syncthreads();
  RET_STAGE();
  RET_LOAD(1);
  __syncthreads();
  for (int c = 0; c < SEQ / C; ++c) {
    const size_t tok0 = (size_t)b * SEQ + (size_t)c * C;
    f32x16 ot[2] = {};
#pragma unroll
    for (int dt = 0; dt < 4; ++dt) {
#pragma unroll
      for (int s = 0; s < 2; ++s) { const bf16x8 af = pk8(S[dt], s);
#pragma unroll
        for (int nt = 0; nt < 2; ++nt) { const char* qp = Qs + (32 * nt + r32) * QP + (32 * dt + 16 * s + 4 * hi) * 2;
          const u32x2 lo = *(const u32x2*)qp, hi8 = *(const u32x2*)(qp + 16); const u32x4 bw = {lo.x, lo.y, hi8.x, hi8.y};
          ot[nt] = __builtin_amdgcn_mfma_f32_32x32x16_bf16(af, *reinterpret_cast<const bf16x8*>(&bw), ot[nt], 0, 0, 0); } }
      __builtin_amdgcn_sched_barrier(0); }
#pragma unroll
    for (int nt = 0; nt < 2; ++nt)
#pragma unroll
      for (int r = 0; r < 16; ++r) ot[nt][r] *= gC;
    __builtin_amdgcn_sched_barrier(0);
    bf16x8 vfr[4];
    { s16x4 vlo[4], vhi[4];
      vlo[0] = trr<0 * 16 * VP>(vtb); vhi[0] = trr<0 * 16 * VP + 8 * VP>(vtb); vlo[1] = trr<1 * 16 * VP>(vtb); vhi[1] = trr<1 * 16 * VP + 8 * VP>(vtb);
      vlo[2] = trr<2 * 16 * VP>(vtb); vhi[2] = trr<2 * 16 * VP + 8 * VP>(vtb); vlo[3] = trr<3 * 16 * VP>(vtb); vhi[3] = trr<3 * 16 * VP + 8 * VP>(vtb);
      asm volatile("s_waitcnt lgkmcnt(0)" : "+v"(vlo[0]), "+v"(vlo[1]), "+v"(vlo[2]), "+v"(vlo[3]), "+v"(vhi[0]), "+v"(vhi[1]), "+v"(vhi[2]), "+v"(vhi[3]) :: "memory"); __builtin_amdgcn_sched_barrier(0);
#pragma unroll
      for (int ks = 0; ks < 4; ++ks) vfr[ks] = (bf16x8){vlo[ks][0], vlo[ks][1], vlo[ks][2], vlo[ks][3], vhi[ks][0], vhi[ks][1], vhi[ks][2], vhi[ks][3]}; }
#pragma unroll
    for (int nt = 0; nt < 2; ++nt)
#pragma unroll
      for (int jt = 0; jt <= nt; ++jt) { f32x16 pt = {};
#pragma unroll
        for (int kk = 0; kk < 8; ++kk) { const bf16x8 ka = *(const bf16x8*)(Ks + (32 * jt + r32) * KPI + (16 * kk + 8 * hi) * 2), qb = *(const bf16x8*)(Qs + (32 * nt + r32) * QP + (16 * kk + 8 * hi) * 2);
          pt = __builtin_amdgcn_mfma_f32_32x32x16_bf16(ka, qb, pt, 0, 0, 0); }
        if (jt == nt) {
#pragma unroll
          for (int r = 0; r < 16; ++r) if (crow(r, hi) > r32) pt[r] = 0.f; }
#pragma unroll
        for (int s = 0; s < 2; ++s) ot[nt] = __builtin_amdgcn_mfma_f32_32x32x16_bf16(vfr[2 * jt + s], pk8(pt, s), ot[nt], 0, 0, 0);
        __builtin_amdgcn_sched_barrier(0); }
#pragma unroll
    for (int dt = 0; dt < 4; ++dt) {
#pragma unroll
      for (int r = 0; r < 16; ++r) S[dt][r] *= gC;
      s16x4 kl[4], kh[4];
      kl[0] = trr<0 * 16 * KPI>(ktb + dt * 64); kh[0] = trr<0 * 16 * KPI + 8 * KPI>(ktb + dt * 64); kl[1] = trr<1 * 16 * KPI>(ktb + dt * 64); kh[1] = trr<1 * 16 * KPI + 8 * KPI>(ktb + dt * 64);
      kl[2] = trr<2 * 16 * KPI>(ktb + dt * 64); kh[2] = trr<2 * 16 * KPI + 8 * KPI>(ktb + dt * 64); kl[3] = trr<3 * 16 * KPI>(ktb + dt * 64); kh[3] = trr<3 * 16 * KPI + 8 * KPI>(ktb + dt * 64);
      asm volatile("s_waitcnt lgkmcnt(0)" : "+v"(kl[0]), "+v"(kl[1]), "+v"(kl[2]), "+v"(kl[3]), "+v"(kh[0]), "+v"(kh[1]), "+v"(kh[2]), "+v"(kh[3]) :: "memory"); __builtin_amdgcn_sched_barrier(0);
#pragma unroll
      for (int ks = 0; ks < 4; ++ks) S[dt] = __builtin_amdgcn_mfma_f32_32x32x16_bf16((bf16x8){kl[ks][0], kl[ks][1], kl[ks][2], kl[ks][3], kh[ks][0], kh[ks][1], kh[ks][2], kh[ks][3]}, vfr[ks], S[dt], 0, 0, 0);
      __builtin_amdgcn_sched_barrier(0); }
    u32x4 gt4[4];
    { const char* gb_ = (const char*)(RG + tok0 * 1024 + h * 256);
#pragma unroll
      for (int i = 0; i < 4; ++i) gt4[i] = *(const u32x4*)(gb_ + voffV + i * 32768); }
#pragma unroll
    for (int nt = 0; nt < 2; ++nt) { const float rs = exp2f(lg * (float)(32 * nt + r32 + 1 - C)); float s1 = 0.f, s2 = 0.f;
#pragma unroll
      for (int r = 0; r < 16; ++r) { ot[nt][r] *= rs; s1 += ot[nt][r]; s2 += ot[nt][r] * ot[nt][r]; }
      s1 = xhalf_sum(s1); s2 = xhalf_sum(s2);
      if (hi == 0) { st[(w * 64 + 32 * nt + r32) * 2] = s1; st[(w * 64 + 32 * nt + r32) * 2 + 1] = s2; } }
    __syncthreads();
    if (c + 1 < SEQ / C) { RET_STAGE(); if (c + 2 < SEQ / C) RET_LOAD(c + 2); }
#pragma unroll
    for (int nt = 0; nt < 2; ++nt) { float s1 = 0.f, s2 = 0.f;
#pragma unroll
      for (int ww = 0; ww < 8; ++ww) { s1 += st[(ww * 64 + 32 * nt + r32) * 2]; s2 += st[(ww * 64 + 32 * nt + r32) * 2 + 1]; }
      const float mu = s1 * (1.f / 256.f), var = fmaxf(s2 * (1.f / 256.f) - mu * mu, 0.f), rstd = rsqrtf(var + EPS);
#pragma unroll
      for (int g = 0; g < 4; ++g) { float y[4];
#pragma unroll
        for (int j = 0; j < 4; ++j) y[j] = (ot[nt][4 * g + j] - mu) * rstd * gnorm[h * 256 + 32 * w + 8 * g + 4 * hi + j];
        const u32x2 o2 = {cvtpk(y[0], y[1]), cvtpk(y[2], y[3])};
        *(u32x2*)(Ys + (32 * nt + r32) * VP + (32 * w + 8 * g + 4 * hi) * 2) = o2; } }
    __syncthreads();
    { unsigned char* ob_ = A2F8 + tok0 * 1024 + h * 256;
#pragma unroll
      for (int i = 0; i < 4; ++i) { const int row = (tid >> 5) + 16 * i, ch = tid & 31;
        const u32x4 yv = *(const u32x4*)(Ys + row * VP + ch * 16); const u32x4 gt = gt4[i];
        int w0 = __builtin_amdgcn_cvt_pk_fp8_f32(pg8::bf_lo(yv.x) * silu_(pg8::bf_lo(gt.x)), pg8::bf_hi(yv.x) * silu_(pg8::bf_hi(gt.x)), 0, false); w0 = __builtin_amdgcn_cvt_pk_fp8_f32(pg8::bf_lo(yv.y) * silu_(pg8::bf_lo(gt.y)), pg8::bf_hi(yv.y) * silu_(pg8::bf_hi(gt.y)), w0, true);
        int w1 = __builtin_amdgcn_cvt_pk_fp8_f32(pg8::bf_lo(yv.z) * silu_(pg8::bf_lo(gt.z)), pg8::bf_hi(yv.z) * silu_(pg8::bf_hi(gt.z)), 0, false); w1 = __builtin_amdgcn_cvt_pk_fp8_f32(pg8::bf_lo(yv.w) * silu_(pg8::bf_lo(gt.w)), pg8::bf_hi(yv.w) * silu_(pg8::bf_hi(gt.w)), w1, true);
        *(unsigned long long*)(ob_ + (size_t)row * 1024 + ch * 8) = (unsigned long long)(unsigned)w0 | ((unsigned long long)(unsigned)w1 << 32); } }
  }
#undef RET_LOAD
#undef RET_STAGE
}
}

__device__ __forceinline__ void p4_attn(Frame& F, const Args& a, unsigned char* lds_generic) {
    const size_t nt_ = (size_t)F.ntok;
    const bf16* QA = (const bf16*)(F.act + nt_ * O_QA); bf16* ATT = (bf16*)(F.act + nt_ * O_QA);
    unsigned char* aux = a.xb + nt_ * 2048;
    const bf16* KP = (const bf16*)(aux + nt_ * AUX_KP); const bf16* VV = (const bf16*)(aux + nt_ * AUX_VV); const unsigned* MASK = (const unsigned*)(aux + nt_ * AUX_MASK);
    volatile LAS unsigned* MISC = (volatile LAS unsigned*)(F.lds + MISC_OFF);
    unsigned* qctr = (unsigned*)(F.ws + WS_CTL) + CW_Q4;
    const bf16* RQ = (const bf16*)(F.act + nt_ * O_RQ); const bf16* RK = (const bf16*)(F.act + nt_ * O_RK); const bf16* RV = (const bf16*)(F.act + nt_ * O_RV); const bf16* RG = (const bf16*)(F.act + nt_ * O_RG);
    const int nb = F.ntok / SEQ, nret = nb * 4, nitems = nb * 64;
    for (;;) {
        __syncthreads(); if (F.tid == 0) MISC[0] = atomicAdd(qctr + 16, 1u); __syncthreads();
        const int it = (int)MISC[0]; if (it >= nret || a.mode == 1) break;
        ret::ret_item(it >> 2, it & 3, RQ, RK, RV, RG, F.act + nt_ * O_A2F8, a.in[8], (char*)lds_generic);
    }
    for (;;) {
        __syncthreads(); if (F.tid == 0) MISC[0] = atomicAdd(qctr, 1u); __syncthreads();
        const int it = (int)MISC[0]; if (it >= nitems || a.mode == 2) break;
        const int qb = 63 - it / nb, b = it % nb, NT = (qb >> 1) + 1;
        const size_t row0 = (size_t)b * SEQ + qb * 32;
        att::attn_item(QA + row0 * 1024, KP + (size_t)b * SEQ * 128, VV + (size_t)b * SEQ * 128, MASK + (size_t)b * 64 * 2048 + qb * 32, ATT + row0 * 1024, NT, (char*)lds_generic, F.lds);
    }
}


__device__ __forceinline__ void p7_router(Frame& F, const Args& a) {
    const int lane = F.lane, r32 = lane & 31, hi = lane >> 5, tid = F.tid;
    unsigned char* mo = F.act; unsigned char* N2 = mo + MO_N2; unsigned char* meta = mo + MO_META;
    int* MB = (int*)(meta + MM_B); int* MPp = (int*)(meta + MM_P); float* MCL = (float*)(meta + MM_CL); float* MCH = (float*)(meta + MM_CH); float* MRS = (float*)(meta + MM_RS);
    const bf16* Wh = (const bf16*)(F.ws + WS_WR); const bf16* Wl = Wh + 32 * 1024;
    const float* g2 = a.in[12]; const float* b_gr = a.in[14]; const float* b_er = a.in[16];
    const bf16* hbase = (const bf16*)(F.act + MO_H16);
    unsigned* gcnt = (unsigned*)(F.ws + WS_CTL) + CW_MOE;
    LAS unsigned* lcnt = (LAS unsigned*)(F.lds + RING_OFF);
    if (tid < 64) lcnt[tid] = 0u;
    __syncthreads();
    const int ntasks = F.ntok / 32, tpw = ntasks / F.G;
    const int tw = F.wave & 3, kh = F.wave >> 2;
    const bool have = tw < tpw; const int t = (F.vcu * tpw + tw) * 32 + r32;
    LAS float* xch = (LAS float*)(F.lds + RING_OFF + 1024);
    int bucket = 0, posl = 0; float clo = 0.f, chi = 0.f, rstd = 0.f;
    f32x16 acc = f32x16{}; float ss = 0.f;
    if (have) {
        const bf16* hrow = hbase + (size_t)t * D + hi * 8 + kh * 512; unsigned char* nrow = N2 + (size_t)t * D + hi * 8 + kh * 512;
        const float* g2k = g2 + kh * 512 + hi * 8; const bf16* whk = Wh + (size_t)r32 * 1024 + kh * 512 + hi * 8; const bf16* wlk = Wl + (size_t)r32 * 1024 + kh * 512 + hi * 8;
#pragma unroll 8
        for (int kk = 0; kk < 32; ++kk) {
            const v4u hv = *(const v4u*)(hrow + kk * 16); const f32x4 a0 = {pg8::bf_lo(hv.x), pg8::bf_hi(hv.x), pg8::bf_lo(hv.y), pg8::bf_hi(hv.y)}, a1 = {pg8::bf_lo(hv.z), pg8::bf_hi(hv.z), pg8::bf_lo(hv.w), pg8::bf_hi(hv.w)};
            const f32x4 q0 = *(const f32x4*)(g2k + kk * 16), q1 = *(const f32x4*)(g2k + kk * 16 + 4);
            ss += (a0.x * a0.x + a0.y * a0.y) + (a0.z * a0.z + a0.w * a0.w) + (a1.x * a1.x + a1.y * a1.y) + (a1.z * a1.z + a1.w * a1.w);
            const float x[8] = {a0.x * q0.x, a0.y * q0.y, a0.z * q0.z, a0.w * q0.w, a1.x * q1.x, a1.y * q1.y, a1.z * q1.z, a1.w * q1.w};
            unsigned hb[8]; float lo[8];
#pragma unroll
            for (int j = 0; j < 8; ++j) { hb[j] = f2bf(x[j]); lo[j] = x[j] - __uint_as_float(hb[j] << 16); }
            v4u xh; xh.x = hb[0] | (hb[1] << 16); xh.y = hb[2] | (hb[3] << 16); xh.z = hb[4] | (hb[5] << 16); xh.w = hb[6] | (hb[7] << 16);
            v4u xl; xl.x = pk2(lo[0], lo[1]); xl.y = pk2(lo[2], lo[3]); xl.z = pk2(lo[4], lo[5]); xl.w = pk2(lo[6], lo[7]);
            { int w0 = __builtin_amdgcn_cvt_pk_fp8_f32(x[0], x[1], 0, false); w0 = __builtin_amdgcn_cvt_pk_fp8_f32(x[2], x[3], w0, true); int w1 = __builtin_amdgcn_cvt_pk_fp8_f32(x[4], x[5], 0, false); w1 = __builtin_amdgcn_cvt_pk_fp8_f32(x[6], x[7], w1, true);
              *(unsigned long long*)(nrow + kk * 16) = (unsigned long long)(unsigned)w0 | ((unsigned long long)(unsigned)w1 << 32); }
            const bf16x8_t wh = *(const bf16x8_t*)(whk + kk * 16), wl = *(const bf16x8_t*)(wlk + kk * 16);
            const bf16x8_t bh = __builtin_bit_cast(bf16x8_t, xh), bl = __builtin_bit_cast(bf16x8_t, xl);
            acc = __builtin_amdgcn_mfma_f32_32x32x16_bf16(wh, bh, acc, 0, 0, 0);
            acc = __builtin_amdgcn_mfma_f32_32x32x16_bf16(wh, bl, acc, 0, 0, 0);
            acc = __builtin_amdgcn_mfma_f32_32x32x16_bf16(wl, bh, acc, 0, 0, 0);
        }
        if (kh == 1) {
#pragma unroll
            for (int r = 0; r < 16; ++r) xch[(tw * 17 + r) * 64 + lane] = acc[r];
            xch[(tw * 17 + 16) * 64 + lane] = ss; }
    }
    __syncthreads();
    if (have && kh == 0) {
#pragma unroll
        for (int r = 0; r < 16; ++r) acc[r] += xch[(tw * 17 + r) * 64 + lane];
        ss += xch[(tw * 17 + 16) * 64 + lane];
        ss = xhalf_sum(ss); rstd = rsqrtf(ss * (1.f / D) + EPS);
        float L[24];
#pragma unroll
        for (int r = 0; r < 12; ++r) { const float v = acc[r]; auto rr = __builtin_amdgcn_permlane32_swap(__float_as_uint(v), __float_as_uint(v), false, false);
            L[(r & 3) + 8 * (r >> 2)] = __uint_as_float(rr[0]); L[(r & 3) + 8 * (r >> 2) + 4] = __uint_as_float(rr[1]); }
        float gl[4];
#pragma unroll
        for (int i = 0; i < 4; ++i) gl[i] = L[i] * rstd + b_gr[i];
        int g = 0; float gm = gl[0];
#pragma unroll
        for (int i = 1; i < 4; ++i) if (gl[i] > gm) { gm = gl[i]; g = i; }
        float se = 0.f;
#pragma unroll
        for (int i = 0; i < 4; ++i) se += __expf(gl[i] - gm);
        const float gw = 1.f / se;
        float el[4];
#pragma unroll
        for (int i = 0; i < 4; ++i) { const float l0 = L[4 + i], l1 = L[8 + i], l2 = L[12 + i], l3 = L[16 + i]; const float lv = g == 0 ? l0 : (g == 1 ? l1 : (g == 2 ? l2 : l3));
            const float b0 = b_er[i], b1 = b_er[4 + i], b2 = b_er[8 + i], b3 = b_er[12 + i]; el[i] = lv * rstd + (g == 0 ? b0 : (g == 1 ? b1 : (g == 2 ? b2 : b3))); }
        int i1 = 0; float v1 = el[0];
#pragma unroll
        for (int i = 1; i < 4; ++i) if (el[i] > v1) { v1 = el[i]; i1 = i; }
        int i2 = -1; float v2 = 0.f;
#pragma unroll
        for (int i = 0; i < 4; ++i) if (i != i1 && (i2 < 0 || el[i] > v2)) { v2 = el[i]; i2 = i; }
        const float e2 = __expf(v2 - v1), p1 = gw / (1.f + e2), p2 = gw * e2 / (1.f + e2);
        const int lo_ = i1 < i2 ? i1 : i2, hi_ = i1 < i2 ? i2 : i1;
        const int pair = lo_ == 0 ? (hi_ - 1) : (lo_ == 1 ? (hi_ + 1) : 5);
        bucket = g * 6 + pair; clo = i1 < i2 ? p1 : p2; chi = i1 < i2 ? p2 : p1;
        if (hi == 0) posl = (int)__hip_atomic_fetch_add(&lcnt[bucket], 1u, __ATOMIC_RELAXED, __HIP_MEMORY_SCOPE_WORKGROUP);
    }
    __syncthreads();
    if (tid < 24) lcnt[32 + tid] = atomicAdd(gcnt + tid, lcnt[tid]);
    __syncthreads();
    if (have && kh == 0 && hi == 0) { MB[t] = bucket; MPp[t] = (int)lcnt[32 + bucket] + posl; MCL[t] = clo; MCH[t] = chi; MRS[t] = rstd; }
}
__device__ __forceinline__ int moe_tiles(const unsigned* gcnt, int* rowstart  ) { int rs = 0;
    for (int b = 0; b < 24; ++b) { rowstart[b] = rs; rs += (int)((gcnt[b] + 255u) & ~255u); } rowstart[24] = rs; return rs >> 8; }
__device__ __forceinline__ void p8_permute(Frame& F, const Args& a) {
    unsigned char* mo = F.act; unsigned char* meta = mo + MO_META;
    const int* MB = (const int*)(meta + MM_B); const int* MPp = (const int*)(meta + MM_P); const float* MCL = (const float*)(meta + MM_CL); const float* MCH = (const float*)(meta + MM_CH); const float* MRS = (const float*)(meta + MM_RS);
    int* PTOK = (int*)(meta + MM_PTOK); float* PRS = (float*)(meta + MM_PRS); float* PCL = (float*)(meta + MM_PCL); float* PCH = (float*)(meta + MM_PCH);
    const unsigned* gcnt = (const unsigned*)(F.ws + WS_CTL) + CW_MOE;
    LAS int* rsL = (LAS int*)(F.lds + RING_OFF);
    if (F.tid == 0) { int rs = 0; for (int b = 0; b < 24; ++b) { rsL[b] = rs; rs += (int)((gcnt[b] + 255u) & ~255u); } rsL[24] = rs; }
    __syncthreads();
    const int gw = F.vcu * NWAVES + F.wave, NGW = F.G * NWAVES;
    const int gt = gw * 64 + F.lane, NGT = NGW * 64;
    for (int t = gt; t < F.ntok; t += NGT) { const int b = MB[t], prow = rsL[b] + MPp[t]; PTOK[prow] = t; PRS[prow] = MRS[t]; PCL[prow] = MCL[t]; PCH[prow] = MCH[t]; }
    for (int b = 0; b < 24; ++b) { const int c = (int)gcnt[b], p0 = rsL[b] + c, p1 = rsL[b + 1];
        for (int r = p0 + gt; r < p1; r += NGT) { PTOK[r] = -1; PRS[r] = 0.f; PCL[r] = 0.f; PCH[r] = 0.f; } }
}
template <bool GATHER_> struct MoeOrder {
    static constexpr bool GATHER = GATHER_; const int* ptok;
    int ntile, G, c; const char* A; size_t tA; const char* W; int mode; const LAS unsigned char* tb; size_t rowB;
    __device__ bool next(int i, pg8::Unit& u) const {
        const long L = (long)i * G + c; if (L >= (long)ntile * 4) return false;
        u.pm = (int)(L >> 2); u.pn = (int)(L & 3); u.a = GATHER_ ? A : A + (size_t)u.pm * tA;
        const int bk = tb[u.pm], g = bk / 6, pr = bk % 6; const int lo = pr < 3 ? 0 : (pr < 5 ? 1 : 2), hi = pr < 3 ? pr + 1 : (pr < 5 ? pr - 1 : 3);
        const int elo = g * 4 + lo, ehi = g * 4 + hi; u.aux = 0;
        if (mode == 1) { const int e = u.pn < 2 ? elo : ehi; u.b = W + ((size_t)e * 512 + (size_t)(u.pn & 1) * 256) * rowB; u.bjump = 0; }
        else { u.b = W + ((size_t)elo * 1024 + (size_t)u.pn * 256) * rowB; u.bjump = (long)(ehi - elo) * 1024 * (long)rowB - (long)rowB; }
        return true;
    }
    __device__ __forceinline__ void a_ready(const pg8::Unit&) const {}
    __device__ __forceinline__ void done(const pg8::Unit&) const {}
};
__device__ __forceinline__ float silu_f(float x) { return x * __builtin_amdgcn_rcpf(1.f + __builtin_amdgcn_exp2f(-1.4426950408889634f * x)); }
struct EpiMoe1 {
    static constexpr bool PERM = true, AFTER_DRAIN = false;
    unsigned char* ACT; const float* PRS; const float* PCL; const float* PCH;
    __device__ __forceinline__ void operator()(const pg8::f32x4 (&acc)[2][2][4][2], const pg8::Unit& u, int wr, int wc, int fr, int fq) const {
        const int row0 = u.pm * pg8::BM + wr * 64 + fr, slot = u.pn >> 1, fcol0 = slot * 256 + (u.pn & 1) * 128 + wc * 16 + 4 * fq; const float* PC = slot ? PCH : PCL;
#pragma unroll
        for (int ai = 0; ai < 2; ++ai)
#pragma unroll
            for (int m = 0; m < 4; ++m) { const int row = row0 + ai * pg8::HALF + m * 16; const float rs = PRS[row], cw = PC[row] * 16.f; unsigned char* rowp = ACT + (size_t)row * 512 + fcol0;
#pragma unroll
                for (int bj = 0; bj < 2; ++bj) { const pg8::f32x4 v0 = acc[ai][bj][m][0], v1 = acc[ai][bj][m][1];
                    const float a0 = silu_f(v0[0] * rs) * (v0[1] * rs) * cw, a1 = silu_f(v0[2] * rs) * (v0[3] * rs) * cw, a2 = silu_f(v1[0] * rs) * (v1[1] * rs) * cw, a3 = silu_f(v1[2] * rs) * (v1[3] * rs) * cw;
                    int w = __builtin_amdgcn_cvt_pk_fp8_f32(a0, a1, 0, false); w = __builtin_amdgcn_cvt_pk_fp8_f32(a2, a3, w, true); *(int*)(rowp + bj * 64) = w; } }
    }
};
struct EpiMoe2 {
    static constexpr bool PERM = false, AFTER_DRAIN = false;
    float* out; const pg8::bf16_t* h16; const int* PTOK;
    __device__ __forceinline__ void operator()(const pg8::f32x4 (&acc)[2][2][4][2], const pg8::Unit& u, int wr, int wc, int fr, int fq) const {
        const int row0 = u.pm * pg8::BM + wr * 64 + fr, col0 = u.pn * pg8::BM + wc * 32 + 4 * fq;
#pragma unroll
        for (int ai = 0; ai < 2; ++ai)
#pragma unroll
            for (int m = 0; m < 4; ++m) { const int tok = PTOK[row0 + ai * pg8::HALF + m * 16];
                if (tok >= 0) { float* rowp = out + (size_t)tok * 1024 + col0; const pg8::bf16_t* hp = h16 + (size_t)tok * 1024 + col0;
#pragma unroll
                    for (int bj = 0; bj < 2; ++bj)
#pragma unroll
                        for (int n = 0; n < 2; ++n) { const pg8::u32x2 hv = *(const pg8::u32x2*)(hp + bj * pg8::HALF + n * 16); const pg8::f32x4 hf = {pg8::bf_lo(hv.x), pg8::bf_hi(hv.x), pg8::bf_lo(hv.y), pg8::bf_hi(hv.y)};
                            *(pg8::f32x4*)(rowp + bj * pg8::HALF + n * 16) = hf + acc[ai][bj][m][n]; } } }
    }
};
__device__ __forceinline__ int moe_setup(Frame& F, LAS unsigned char* tb) {
    const unsigned* gcnt = (const unsigned*)(F.ws + WS_CTL) + CW_MOE;
    LAS int* nt_ = (LAS int*)(tb + 256);
    __syncthreads();
    if (F.tid == 0) { int tl = 0; for (int b = 0; b < 24; ++b) { const int n = (int)((gcnt[b] + 255u) >> 8); for (int i = 0; i < n; ++i) tb[tl + i] = (unsigned char)b; tl += n; } nt_[0] = tl; }
    __syncthreads();
    return nt_[0];
}

__global__ void __launch_bounds__(NWAVES * 64, 2) mk_fwd(Args args) {
    extern __shared__ __attribute__((aligned(16))) unsigned char lds[];
    Frame F;
    F.lds = (LAS unsigned char*)lds;
    F.tid = threadIdx.x; F.lane = F.tid & 63; F.wave = __builtin_amdgcn_readfirstlane(F.tid >> 6);
    F.G = gridDim.x; { const int bx = blockIdx.x; F.vcu = (F.G % 8 == 0) ? (bx % 8) * (F.G / 8) + bx / 8 : bx; }
    F.ntok = args.ntok; F.ws = args.ws; F.act = args.ws + WS_ACT;
    const int lo = args.ph_lo, hi = args.ph_hi;
    cooperative_groups::grid_group grid = cooperative_groups::this_grid();
    volatile LAS unsigned* MISCW = (volatile LAS unsigned*)(F.lds + MISC_OFF);
    for (int u = F.tid; u < (LDS_BYTES - LDSCTL_OFF) / 4; u += NWAVES * 64) ((LAS unsigned*)(F.lds + LDSCTL_OFF))[u] = 0u;
    __syncthreads();
    XcdBarrier bar = xcd_barrier_post((unsigned*)(F.ws + WS_CTL) + CW_BAR, MISCW + 8);
#define IN(k) (lo <= (k) && (k) < hi)
#define SEAM(k) do { if (IN(k) && IN((k) + 1)) { xcd_barrier(bar); } } while (0)
    if (IN(0)) { p0_prologue(F, args); }
    SEAM(0);
    if (IN(1)) {
        EpiProj E{F.act, (size_t)F.ntok};
        { pg8::Gemm g{512, 512, 512, 8};
          P1Order S; S.nM = F.ntok / 256; S.nN = 25; S.nwg = S.nM * 25; S.G = F.G; S.c = (int)blockIdx.x; S.mode = 0; S.A = (const char*)(args.xb + (size_t)F.ntok * AUX_XB8); S.Bt = (const char*)(F.ws + WS_WIN8); S.tA = (size_t)256 * 1024; S.tB = (size_t)256 * 1024;
          pg8::gemm_phase<EpiProj, P1Order, true, true, true>(F.lds + RING_OFF, g, S, E); }
        { pg8::Gemm g{1024, 1024, 1024, 16};
          P1Order S; S.nM = F.ntok / 256; S.nN = 3; S.nwg = S.nM * 3; S.G = F.G; S.c = ((int)blockIdx.x + F.G / 2) % F.G; S.mode = 1; S.A = (const char*)args.xb; S.Bt = (const char*)(F.ws + WS_WIN); S.tA = (size_t)256 * 2048; S.tB = (size_t)256 * 2048;
          pg8::gemm_phase<EpiProj, P1Order, true, true, false>(F.lds + RING_OFF, g, S, E); }
    }
    SEAM(1);
    if (IN(2)) { p2_post(F, args); }
    SEAM(2);
    if (IN(3)) { p3_index(F, args); }
    SEAM(3);
    if (IN(4)) { p4_attn(F, args, lds); }
    SEAM(4);
    if (IN(5)) {
        const size_t nt_ = (size_t)F.ntok;
        pg8::bf16_t* GA = (pg8::bf16_t*)(F.act + nt_ * O_GA); const pg8::bf16_t* GR = (const pg8::bf16_t*)(F.act + nt_ * O_GR);
        { pg8::Gemm g{512, 1024, 512, 8, 122, 123};
          pg8::StaticOrder S; S.init(F.ntok, 1024, F.G, (int)blockIdx.x, F.act + nt_ * O_QA, 1024, F.ws + WS_WATT8, 512); EpiGateA E{GA};
          pg8::gemm_phase<EpiGateA, pg8::StaticOrder, true, true, true>(F.lds + RING_OFF, g, S, E); }
        { pg8::Gemm g{512, 512, 512, 8, 122, 127};
          pg8::StaticOrder S; S.init(F.ntok, 1024, F.G, (int)blockIdx.x, F.act + nt_ * O_A2F8, 512, F.ws + WS_WRET8, 512); EpiGateB E{GA, GR, F.act + nt_ * O_MIX8};
          pg8::gemm_phase<EpiGateB, pg8::StaticOrder, true, true, true>(F.lds + RING_OFF, g, S, E); }
    }
    SEAM(5);
    if (IN(6)) {
        pg8::Gemm g{512, 512, 512, 8, 122, 124}; const size_t nt_ = (size_t)F.ntok;
        pg8::StaticOrder S; S.init(F.ntok, 1024, F.G, (int)blockIdx.x, F.act + nt_ * O_MIX8, 512, F.ws + WS_WOUT8, 512);
        EpiResid E{args.in[0] + (size_t)args.tok0 * D, (pg8::bf16_t*)(F.act + MO_H16)};
        pg8::gemm_phase<EpiResid, pg8::StaticOrder, true, true, true>(F.lds + RING_OFF, g, S, E);
    }
    SEAM(6);
    if (IN(7)) { p7_router(F, args); }
    SEAM(7);
    if (IN(8)) { p8_permute(F, args); }
    SEAM(8);
    if (IN(9)) {
        LAS unsigned char* tb = F.lds + LDSCTL_OFF - 1024; const int ntile = moe_setup(F, tb);
        unsigned char* meta = F.act + MO_META;
        pg8::Gemm g{512, 512, 512, 8, 122, 127};
        MoeOrder<true> S{(const int*)(meta + MM_PTOK), ntile, F.G, (int)blockIdx.x, (const char*)(F.act + MO_N2), (size_t)0, (const char*)(F.ws + WS_W18), 1, tb, (size_t)1024};
        EpiMoe1 E{(unsigned char*)(F.act + MO_ACT), (const float*)(meta + MM_PRS), (const float*)(meta + MM_PCL), (const float*)(meta + MM_PCH)};
        pg8::gemm_phase<EpiMoe1, MoeOrder<true>, true, true, true>(F.lds + RING_OFF, g, S, E);
    }
    SEAM(9);
    if (IN(10)) {
        LAS unsigned char* tb = F.lds + LDSCTL_OFF - 1024; const int ntile = moe_setup(F, tb);
        unsigned char* meta = F.act + MO_META;
        pg8::Gemm g{256, 256, 128, 2, 123, 123};
        MoeOrder<false> S{nullptr, ntile, F.G, (int)blockIdx.x, (const char*)(F.act + MO_ACT), (size_t)256 * 512, (const char*)(F.ws + WS_WD8), 2, tb, (size_t)256};
        EpiMoe2 E{args.out + (size_t)args.tok0 * D, (const pg8::bf16_t*)(F.act + MO_H16), (const int*)(meta + MM_PTOK)};
        pg8::gemm_phase<EpiMoe2, MoeOrder<false>, true, true, true>(F.lds + RING_OFF, g, S, E);
    }
    if (hi - lo > 1) grid.sync();
#undef IN
#undef SEAM
}

__device__ __forceinline__ float block_sum256(float v, float* red) {
#pragma unroll
    for (int o = 32; o > 0; o >>= 1) v += __shfl_xor(v, o);
    __syncthreads();
    if ((threadIdx.x & 63) == 0) red[threadIdx.x >> 6] = v;
    __syncthreads();
    return red[0] + red[1] + red[2] + red[3];
}
__device__ __forceinline__ float block_max256(float v, float* red) {
#pragma unroll
    for (int o = 32; o > 0; o >>= 1) v = fmaxf(v, __shfl_xor(v, o));
    __syncthreads();
    if ((threadIdx.x & 63) == 0) red[threadIdx.x >> 6] = v;
    __syncthreads();
    return fmaxf(fmaxf(red[0], red[1]), fmaxf(red[2], red[3]));
}
__device__ __forceinline__ float sigmoidf_(float x) { return 1.f / (1.f + expf(-x)); }
__device__ __forceinline__ float siluf_(float x) { return x / (1.f + expf(-x)); }

__global__ void __launch_bounds__(256) nv_rmsnorm(const float* inb, long in_ld, float* outb, long out_ld, int ninner, int width, const float* gain, int gstride) {
    __shared__ float red[8];
    const int r = blockIdx.x, t = r / ninner, i = r % ninner;
    const float* in = inb + (long)t * in_ld + (long)i * width;
    float* out = outb + (long)t * out_ld + (long)i * width;
    float s = 0.f;
    for (int c = threadIdx.x; c < width; c += 256) { const float v = in[c]; s += v * v; }
    s = block_sum256(s, red);
    const float rs = rsqrtf(s / (float)width + EPS);
    for (int c = threadIdx.x; c < width; c += 256) out[c] = in[c] * rs * gain[i * gstride + c];
}
__global__ void __launch_bounds__(256) nv_gemm(const float* A, long lda, const float* B, long ldb, float* C, long ldc, int M, int N, int K) {
    __shared__ float As[8][128 + 4];
    __shared__ float Bs[8][128 + 4];
    const int tid = threadIdx.x, tx = tid & 15, ty = tid >> 4;
    const int m0 = blockIdx.y * 128, n0 = blockIdx.x * 128;
    float acc[8][8];
#pragma unroll
    for (int i = 0; i < 8; ++i)
#pragma unroll
        for (int j = 0; j < 8; ++j) acc[i][j] = 0.f;
    for (int k0 = 0; k0 < K; k0 += 8) {
        { const int r = tid >> 1, kk = (tid & 1) * 4;
          const float4 v = *(const float4*)(A + (long)(m0 + r) * lda + k0 + kk);
          As[kk + 0][r] = v.x; As[kk + 1][r] = v.y; As[kk + 2][r] = v.z; As[kk + 3][r] = v.w; }
        { const int kk = tid >> 5, c = (tid & 31) * 4;
#pragma unroll
          for (int j = 0; j < 4; ++j) { const int n = n0 + c + j; Bs[kk][c + j] = (n < N) ? B[(long)(k0 + kk) * ldb + n] : 0.f; } }
        __syncthreads();
#pragma unroll
        for (int kk = 0; kk < 8; ++kk) {
            float a[8], b[8];
#pragma unroll
            for (int i = 0; i < 8; ++i) a[i] = As[kk][ty * 8 + i];
#pragma unroll
            for (int j = 0; j < 8; ++j) b[j] = Bs[kk][tx * 8 + j];
#pragma unroll
            for (int i = 0; i < 8; ++i)
#pragma unroll
                for (int j = 0; j < 8; ++j) acc[i][j] += a[i] * b[j];
        }
        __syncthreads();
    }
#pragma unroll
    for (int i = 0; i < 8; ++i)
#pragma unroll
        for (int j = 0; j < 8; ++j) { const int n = n0 + tx * 8 + j; if (n < N) C[(long)(m0 + ty * 8 + i) * ldc + n] = acc[i][j]; }
}
__global__ void __launch_bounds__(256) nv_attn(const float* proj, const float* kv, float* att, float wscale, float dscale, float lscale, const unsigned* maskb) {
    __shared__ float s_qi[512], s_w[8], s_score[2048], s_q[1024], s_p[8][256], red[8];
    __shared__ int s_sel[256 + 64]; __shared__ int s_pref[65]; __shared__ unsigned s_mw[64];
    const int tq = blockIdx.x, b = tq / SEQ, t = tq % SEQ, tid = threadIdx.x;
    const float* prow = proj + (long)tq * INW;
    const float* pb = proj + (long)b * SEQ * INW;
    const float* kvb = kv + (long)b * SEQ * 256;
    for (int i = tid; i < 512; i += 256) s_qi[i] = prow[C_QI + i];
    for (int i = tid; i < 1024; i += 256) s_q[i] = prow[C_QA + i];
    if (tid < 8) s_w[tid] = prow[C_WI + tid] * wscale;
    __syncthreads();
    const int n = t + 1;
    int cnt;
    if (maskb) {
        if (tid < 64) s_mw[tid] = (tid * 32 <= t) ? maskb[tid * 2048 + t] : 0u;
        __syncthreads();
        if (tid == 0) { int c = 0; for (int i = 0; i < 64; ++i) { s_pref[i] = c; c += __builtin_popcount(s_mw[i]); } s_pref[64] = c; }
        __syncthreads();
        if (tid < 64) { unsigned x = s_mw[tid]; int p = s_pref[tid]; while (x) { const int bpos = __builtin_ctz(x); x &= x - 1; if (p < 256) s_sel[p] = tid * 32 + bpos; ++p; } }
        cnt = s_pref[64] < 256 ? s_pref[64] : 256;
        __syncthreads();
    } else {
    for (int s = tid; s < n; s += 256) {
        const float* kr = pb + (long)s * INW + C_KI;
        float kk[64];
#pragma unroll
        for (int d = 0; d < 64; ++d) kk[d] = kr[d];
        float sc = 0.f;
#pragma unroll
        for (int h = 0; h < 8; ++h) {
            float dt = 0.f;
#pragma unroll
            for (int d = 0; d < 64; ++d) dt += s_qi[h * 64 + d] * kk[d];
            dt *= dscale;
            sc += fmaxf(dt, 0.f) * s_w[h];
        }
        s_score[s] = sc;
    }
    __syncthreads();
    if (n <= 256) { if (tid < n) s_sel[tid] = tid; cnt = n; }
    else {
        for (int s = tid; s < n; s += 256) {
            const float v = s_score[s]; int rank = 0;
            for (int j = 0; j < n; ++j) { const float u = s_score[j]; rank += (u > v || (u == v && j < s)) ? 1 : 0; }
            if (rank < 256) s_sel[rank] = s;
        }
        cnt = 256;
    }
    __syncthreads();
    }
    float lg[8];
    const bool act = tid < cnt;
    const int sj = act ? s_sel[tid] : 0;
    {
        const float* kr = kvb + (long)sj * 256;
#pragma unroll
        for (int h = 0; h < 8; ++h) lg[h] = 0.f;
        for (int d = 0; d < 128; ++d) { const float kd = kr[d];
#pragma unroll
            for (int h = 0; h < 8; ++h) lg[h] += s_q[h * 128 + d] * kd; }
    }
#pragma unroll
    for (int h = 0; h < 8; ++h) {
        const float slope = exp2f(-(float)(h + 1));
        float x = act ? (lg[h] * lscale - slope * (float)(t - sj)) : -INFINITY;
        const float m = block_max256(x, red);
        const float e = act ? expf(x - m) : 0.f;
        const float su = block_sum256(e, red);
        s_p[h][tid] = e / su;
    }
    __syncthreads();
    float o4[4] = {0.f, 0.f, 0.f, 0.f};
    for (int j = 0; j < cnt; ++j) {
        const float* vr = kvb + (long)s_sel[j] * 256 + 128;
#pragma unroll
        for (int i = 0; i < 4; ++i) { const int o = tid + 256 * i; o4[i] += s_p[o >> 7][j] * vr[o & 127]; }
    }
#pragma unroll
    for (int i = 0; i < 4; ++i) att[(long)tq * 1024 + tid + 256 * i] = o4[i];
}
__global__ void __launch_bounds__(256) nv_ret(const float* proj, float* reto) {
    __shared__ float sq[128], sk[128];
    const int b = blockIdx.x >> 2, h = blockIdx.x & 3, v = threadIdx.x;
    const float gamma = 1.f - exp2f(-5.f - (float)h);
    float S[128];
#pragma unroll
    for (int d = 0; d < 128; ++d) S[d] = 0.f;
    for (int t = 0; t < SEQ; ++t) {
        const float* row = proj + (long)(b * SEQ + t) * INW;
        if (v < 128) { sq[v] = row[C_RQ + h * 128 + v]; sk[v] = row[C_RK + h * 128 + v] * 0.08838834764831845f; }
        __syncthreads();
        const float vv = row[C_RV + h * 256 + v];
        float o = 0.f;
#pragma unroll
        for (int d = 0; d < 128; ++d) { S[d] = gamma * S[d] + sk[d] * vv; o += sq[d] * S[d]; }
        reto[(long)(b * SEQ + t) * 1024 + h * 256 + v] = o;
        __syncthreads();
    }
}
__global__ void __launch_bounds__(256) nv_retpost(const float* proj, const float* reto, const float* g, float* a2) {
    __shared__ float red[8];
    const int t = blockIdx.x >> 2, h = blockIdx.x & 3, c = threadIdx.x;
    const float x = reto[(long)t * 1024 + h * 256 + c];
    const float mu = block_sum256(x, red) * (1.f / 256.f);
    const float dv = x - mu;
    const float var = block_sum256(dv * dv, red) * (1.f / 256.f);
    const float y = dv * rsqrtf(var + EPS) * g[h * 256 + c];
    a2[(long)t * 1024 + h * 256 + c] = siluf_(proj[(long)t * INW + C_RG + h * 256 + c]) * y;
}
__global__ void __launch_bounds__(256) nv_mix(const float* proj, const float* ya, const float* yr, float* mix) {
    const long i = (long)blockIdx.x * 256 + threadIdx.x; const long t = i >> 10; const int c = (int)(i & 1023);
    mix[i] = sigmoidf_(proj[t * INW + C_GA + c]) * ya[i] + sigmoidf_(proj[t * INW + C_GR + c]) * yr[i];
}
__global__ void __launch_bounds__(256) nv_add(const float* a, const float* b, float* o) {
    const long i = (long)blockIdx.x * 256 + threadIdx.x; o[i] = a[i] + b[i];
}
__global__ void __launch_bounds__(256) nv_moe(const float* n2, float* hio, const float* wgr, const float* bgr, const float* wer, const float* ber,
                                              const float* wg, const float* wu, const float* wd) {
    __shared__ float s_n[1024], s_lg[20], s_act[256], s_p[2];
    __shared__ int s_e[2];
    const int t = blockIdx.x, tid = threadIdx.x;
    for (int i = tid; i < 1024; i += 256) s_n[i] = n2[(long)t * 1024 + i];
    __syncthreads();
    if (tid < 20) {
        float a = 0.f;
        if (tid < 4) { for (int d = 0; d < 1024; ++d) a += s_n[d] * wgr[d * 4 + tid]; a += bgr[tid]; }
        else { const int e = tid - 4; for (int d = 0; d < 1024; ++d) a += s_n[d] * wer[d * 16 + e]; a += ber[e]; }
        s_lg[tid] = a;
    }
    __syncthreads();
    if (tid == 0) {
        int g = 0; float m = s_lg[0];
        for (int i = 1; i < 4; ++i) if (s_lg[i] > m) { m = s_lg[i]; g = i; }
        float se = 0.f; for (int i = 0; i < 4; ++i) se += expf(s_lg[i] - m);
        const float gw = 1.f / se;
        const float* el = s_lg + 4 + g * 4;
        int i1 = 0; for (int i = 1; i < 4; ++i) if (el[i] > el[i1]) i1 = i;
        int i2 = -1; for (int i = 0; i < 4; ++i) if (i != i1 && (i2 < 0 || el[i] > el[i2])) i2 = i;
        const float e2 = expf(el[i2] - el[i1]);
        s_p[0] = gw / (1.f + e2); s_p[1] = gw * e2 / (1.f + e2);
        s_e[0] = g * 4 + i1; s_e[1] = g * 4 + i2;
    }
    __syncthreads();
    float acc[4] = {0.f, 0.f, 0.f, 0.f};
    for (int sl = 0; sl < 2; ++sl) {
        const int e = s_e[sl]; const float p = s_p[sl];
        const float* g_ = wg + (long)e * 1024 * 256 + tid; const float* u_ = wu + (long)e * 1024 * 256 + tid;
        float hg = 0.f, hu = 0.f;
        for (int d = 0; d < 1024; ++d) { hg += s_n[d] * g_[(long)d * 256]; hu += s_n[d] * u_[(long)d * 256]; }
        __syncthreads();
        s_act[tid] = siluf_(hg) * hu * p;
        __syncthreads();
        const float* d_ = wd + (long)e * 256 * 1024;
        for (int f = 0; f < 256; ++f) { const float a = s_act[f];
#pragma unroll
            for (int i = 0; i < 4; ++i) acc[i] += a * d_[(long)f * 1024 + tid + 256 * i]; }
    }
#pragma unroll
    for (int i = 0; i < 4; ++i) hio[(long)t * 1024 + tid + 256 * i] += acc[i];
}
__global__ void __launch_bounds__(256) ad_proj(const unsigned char* act, int ntok, int tok_lo, float* PROJ) {
    const int t = blockIdx.x; const size_t tg = (size_t)(tok_lo + t); const size_t nt = (size_t)ntok;
    const bf16* QA = (const bf16*)(act + nt * O_QA) + tg * 1024; const bf16* CKV = (const bf16*)(act + nt * O_CKV) + tg * 256; const bf16* QI = (const bf16*)(act + nt * O_QI) + tg * 512;
    const bf16* KW = (const bf16*)(act + nt * O_KW) + tg * 128; const bf16* RQ = (const bf16*)(act + nt * O_RQ) + tg * 512; const bf16* RK = (const bf16*)(act + nt * O_RK) + tg * 512;
    const bf16* R4 = (const bf16*)(act + nt * O_RV);
    float* o = PROJ + (size_t)t * INW;
    for (int c = threadIdx.x; c < INW; c += 256) {
        bf16 v;
        if (c < C_CKV) v = QA[c]; else if (c < C_QI) v = CKV[c - C_CKV]; else if (c < C_KI) v = QI[c - C_QI]; else if (c < C_RQ) v = KW[c - C_KI];
        else if (c < C_RK) v = RQ[c - C_RQ]; else if (c < C_RV) v = RK[c - C_RK];
        else { const int cc = c - C_RV; v = R4[(size_t)(cc >> 10) * nt * 1024 + tg * 1024 + (cc & 1023)]; }
        o[c] = bf2f(v);
    }
}


__global__ void __launch_bounds__(256) ad_kv(const unsigned char* aux, int ntok, int tok_lo, float* KV, float* PROJ) {
    const int t = blockIdx.x; const size_t tg = (size_t)(tok_lo + t); const size_t nt = (size_t)ntok; const int c = threadIdx.x;
    const bf16* KP = (const bf16*)(aux + nt * AUX_KP) + tg * 128; const bf16* VV = (const bf16*)(aux + nt * AUX_VV) + tg * 128; const bf16* KIN = (const bf16*)(aux + nt * AUX_KIN) + tg * 64;
    KV[(size_t)t * 256 + c] = bf2f(c < 128 ? KP[c] : VV[c - 128]);
    if (c < 64) PROJ[(size_t)t * INW + C_KI + c] = bf2f(KIN[c]);
}
__global__ void __launch_bounds__(256) nv_fill(float* p, float v, int n) { const int i = blockIdx.x * 256 + threadIdx.x; if (i < n) p[i] = v; }


__global__ void __launch_bounds__(256) ad_att(const unsigned char* act, int ntok, int tok_lo, float* ATT) {
    const int t = blockIdx.x; const bf16* A = (const bf16*)(act + (size_t)ntok * O_QA) + (size_t)(tok_lo + t) * 1024;
    for (int c = threadIdx.x; c < 1024; c += 256) ATT[(size_t)t * 1024 + c] = bf2f(A[c]);
}


__global__ void __launch_bounds__(256) ad_a2(const unsigned char* act, int ntok, int tok_lo, float* A2) {
    const int t = blockIdx.x; const bf16* A = (const bf16*)(act + (size_t)ntok * O_RV) + (size_t)(tok_lo + t) * 1024;
    for (int c = threadIdx.x; c < 1024; c += 256) A2[(size_t)t * 1024 + c] = bf2f(A[c]);
}

static void gemm(hipStream_t st, const float* A, long lda, const float* B, long ldb, float* C, long ldc, int M, int N, int K) {
    hipLaunchKernelGGL(nv_gemm, dim3((N + 127) / 128, M / 128), dim3(256), 0, st, A, lda, B, ldb, C, ldc, M, N, K);
}

extern "C" void kernel_launch(void* const* d_in, const int* in_sizes, int n_in, void* d_out, int out_size, void* d_ws, size_t ws_size, hipStream_t stream) {
    static int grid = 0;
    if (grid == 0) {
        int dev = 0, cus = 0, per_cu = 0;
        (void)hipGetDevice(&dev); (void)hipDeviceGetAttribute(&cus, hipDeviceAttributeMultiprocessorCount, dev);
        if (hipFuncSetAttribute((const void*)mk_fwd, hipFuncAttributeMaxDynamicSharedMemorySize, LDS_BYTES) != hipSuccess) { fprintf(stderr, "kernel_launch: hipFuncSetAttribute failed\n"); grid = -1; return; }
        (void)hipOccupancyMaxActiveBlocksPerMultiprocessor(&per_cu, (const void*)mk_fwd, NWAVES * 64, LDS_BYTES);
        (void)hipGetLastError();
        if (per_cu < 1) { fprintf(stderr, "kernel_launch: occupancy query says %d blocks per CU\n", per_cu); per_cu = 1; }
        grid = cus * per_cu;
        if (n_in != 20 || ws_size < (size_t)512 * MiB) { fprintf(stderr, "kernel_launch: unexpected n_in %d / ws_size %zu\n", n_in, ws_size); grid = -1; return; }
    }
    if (grid < 0) return;
    const float* x = (const float*)d_in[0];
    const float* kv_norm_g = (const float*)d_in[3]; const float* w_kv_up = (const float*)d_in[4]; const float* q_norm_g = (const float*)d_in[5];
    const float* k_norm_g = (const float*)d_in[6]; const float* idx_k_norm_g = (const float*)d_in[7]; const float* ret_norm_g = (const float*)d_in[8];
    const float* w_att = (const float*)d_in[9]; const float* w_ret = (const float*)d_in[10]; const float* w_out = (const float*)d_in[11];
    const float* norm2_g = (const float*)d_in[12]; const float* w_gr = (const float*)d_in[13]; const float* b_gr = (const float*)d_in[14];
    const float* w_er = (const float*)d_in[15]; const float* b_er = (const float*)d_in[16]; const float* w_eg = (const float*)d_in[17];
    const float* w_eu = (const float*)d_in[18]; const float* w_ed = (const float*)d_in[19];
    float* out = (float*)d_out;
    unsigned char* ws = (unsigned char*)d_ws;
    if (ws_size < WS_ACT + (size_t)T * O_END) { fprintf(stderr, "kernel_launch: workspace too small\n"); return; }
    (void)x; (void)kv_norm_g; (void)w_kv_up; (void)q_norm_g; (void)k_norm_g; (void)idx_k_norm_g; (void)ret_norm_g; (void)w_att; (void)w_ret; (void)w_out; (void)norm2_g; (void)w_gr; (void)b_gr; (void)w_er; (void)b_er; (void)w_eg; (void)w_eu; (void)w_ed;
    (void)hipMemsetAsync(ws + WS_CTL, 0, CTL_ZERO_BYTES, stream);
    Args a{};
    for (int i = 0; i < 20; ++i) a.in[i] = (const float*)d_in[i];
    a.out = out; a.ws = ws; a.xb = (unsigned char*)d_out; a.ntok = T; a.tok0 = 0;
    void* kargs[] = {(void*)&a};
    if (PROBE_PH >= 0) { a.ph_lo = PROBE_PH; a.ph_hi = PROBE_PH + 1; a.mode = PROBE_MODE;
        (void)hipLaunchCooperativeKernel((const void*)mk_fwd, dim3(grid), dim3(NWAVES * 64), kargs, (unsigned)LDS_BYTES, stream);
        (void)hipMemsetAsync(ws + WS_CTL, 0, CTL_ZERO_BYTES, stream); }
    a.ph_lo = 0; a.ph_hi = 11; a.mode = 0;
    const hipError_t le = hipLaunchCooperativeKernel((const void*)mk_fwd, dim3(grid), dim3(NWAVES * 64), kargs, (unsigned)LDS_BYTES, stream);
    if (le != hipSuccess) fprintf(stderr, "kernel_launch: cooperative launch failed: %s (grid %d)\n", hipGetErrorString(le), grid);
}
```

```cpp
#include <hip/hip_runtime.h>
#include <hip/hip_cooperative_groups.h>
#include <cstdio>
#include <cstdint>

namespace pg8 {
#define PG8_LAS __attribute__((address_space(3)))
typedef unsigned short bf16_t;
typedef short bf16x8 __attribute__((ext_vector_type(8)));
typedef float f32x4 __attribute__((ext_vector_type(4)));
typedef unsigned u32x4 __attribute__((ext_vector_type(4)));
typedef unsigned u32x2 __attribute__((ext_vector_type(2)));
typedef int v4i_t __attribute__((ext_vector_type(4)));
typedef int v8i_t __attribute__((ext_vector_type(8)));
constexpr int BM = 256, BK = 64, HALF = 128, HTB = HALF * BK * 2  , STAGE_BYTES = 8 * HTB, NXCD = 8, WGM = 8;

__host__ __device__ __forceinline__ int lds_byte(int r, int c) { const int st = (r >> 4) * 2 + (c >> 5), rr = r & 15, cc = c & 31, ob = rr * 64 + cc * 2; return st * 1024 + (ob ^ (((ob >> 9) & 1) << 5)); }
__host__ __device__ __forceinline__ void stage_rc(int b, int& R, int& C) { const int st = b / 1024, sb = b % 1024, swz = sb ^ (((sb >> 9) & 1) << 5); R = (st >> 1) * 16 + swz / 64; C = (st & 1) * 32 + (swz % 64) / 2; }
__host__ __device__ __forceinline__ int perm32(int rho) { const int n = rho >> 4, i = rho & 15; return 8 * (i >> 2) + 4 * n + (i & 3); }

struct Unit { int pm, pn; const char* a; const char* b; long bjump; int aux; };
struct Gemm { int K, lda, ldb, ksplit; int sw = 122, sa = 127; };

struct StaticOrder {
    static constexpr bool GATHER = false; const int* ptok = nullptr;
    int nM, nN, nwg, G, c; const char* A; const char* Bt; size_t tA, tB;
    __device__ void init(int M, int N, int G_, int c_, const void* A_, int lda, const void* Bt_, int ldb) { nM = M / BM; nN = N / BM; nwg = nM * nN; G = G_; c = c_; A = (const char*)A_; Bt = (const char*)Bt_; tA = (size_t)BM * lda * 2; tB = (size_t)BM * ldb * 2; }
    __device__ bool next(int i, Unit& u) const {
        const long L = (long)i * G + c; if (L >= nwg) return false;
        int wgid = (int)L; { const int q = nwg / NXCD, r = nwg % NXCD, xcd = wgid % NXCD, off = wgid / NXCD; wgid = (xcd < r ? xcd * (q + 1) : r * (q + 1) + (xcd - r) * q) + off; }
        const int nig = WGM * nN, gid = wgid / nig, fm = gid * WGM, gsz = (nM - fm) < WGM ? (nM - fm) : WGM;
        u.pm = fm + ((wgid % nig) % gsz); u.pn = (wgid % nig) / gsz; u.a = A + (size_t)u.pm * tA; u.b = Bt + (size_t)u.pn * tB; u.bjump = 0; u.aux = 0; return true;
    }
    __device__ __forceinline__ void a_ready(const Unit&) const {}
    __device__ __forceinline__ void done(const Unit&) const {}
};

typedef float f32x2c __attribute__((ext_vector_type(2))); typedef __bf16 bf16x2c __attribute__((ext_vector_type(2)));
__device__ __forceinline__ unsigned cvt_pk_bf16(float lo, float hi) { const f32x2c v = {lo, hi}; const bf16x2c b = __builtin_convertvector(v, bf16x2c); return __builtin_bit_cast(unsigned, b); }
__device__ __forceinline__ float bf_lo(unsigned w) { return __uint_as_float(w << 16); }
__device__ __forceinline__ float bf_hi(unsigned w) { return __uint_as_float(w & 0xffff0000u); }


template <class Epi, class Sched, bool ALIGN_EPI = false, bool SP2 = false, bool FP8 = false>
__device__ __forceinline__ void gemm_phase(PG8_LAS unsigned char* lds, const Gemm g, const Sched& S, const Epi& E) {
    int tid = threadIdx.x; asm volatile("" : "+v"(tid));
    const int wid = __builtin_amdgcn_readfirstlane(tid >> 6), lane = tid & 63, wr = wid >> 2, wc = wid & 3, fr = lane & 15, fq = lane >> 4;
    const int K = g.K, nt = K / BK;
    unsigned voffA[2], voffB[2]; int gR[2]; unsigned gC[2];
#pragma unroll
    for (int i = 0; i < 2; ++i) { int R, C; stage_rc(tid * 16 + i * 8192, R, C); const int Rb = Epi::PERM ? ((R & ~31) + perm32(R & 31)) : R; gR[i] = R; gC[i] = (unsigned)C * 2u;
        voffA[i] = (unsigned)(R * g.lda + C) * 2u; voffB[i] = (unsigned)(Rb * g.ldb + C) * 2u; }
    unsigned gA0[2] = {0u, 0u}, gA1[2] = {0u, 0u}, gN0[2] = {0u, 0u}, gN1[2] = {0u, 0u};
#define PG8_GOFF(u_, o0, o1) do { _Pragma("unroll") for (int i_ = 0; i_ < 2; ++i_) { int t0_ = S.ptok[(u_).pm * BM + gR[i_]], t1_ = S.ptok[(u_).pm * BM + HALF + gR[i_]]; t0_ = t0_ < 0 ? 0 : t0_; t1_ = t1_ < 0 ? 0 : t1_; \
        o0[i_] = (unsigned)t0_ * (unsigned)(g.lda * 2) + gC[i_]; o1[i_] = (unsigned)t1_ * (unsigned)(g.lda * 2) + gC[i_]; } } while (0)
    const size_t kstep = (size_t)(BK * 2);
    const size_t hstepA = Sched::GATHER ? (size_t)0 : (size_t)HALF * g.lda * 2, hstepB = (size_t)HALF * g.ldb * 2;
    const unsigned ldsw = (unsigned)wid * 1024u;
    const int aoff = lds_byte(wr * 64 + fr, fq * 8), boff = lds_byte(wc * 32 + fr, fq * 8);
#define PG8_CAT(x0, x1) __builtin_shufflevector(__builtin_bit_cast(v4i_t, x0), __builtin_bit_cast(v4i_t, x1), 0, 1, 2, 3, 4, 5, 6, 7)
#define PG8_SA(b, h) (((b) * 2 + (h)) * HTB)
#define PG8_SB(b, h) ((4 + (b) * 2 + (h)) * HTB)
#define PG8_STAGE(bufoff, gbase, voff) do { _Pragma("unroll") for (int _i = 0; _i < 2; ++_i) \
        __builtin_amdgcn_global_load_lds((const unsigned*)((const char*)(gbase) + (voff)[_i]), (PG8_LAS unsigned*)(lds + (bufoff) + ldsw + _i * 8192), 16, 0, 0); } while (0)
#define PG8_LDA(dst, b, h) do { if constexpr (FP8) { _Pragma("unroll") for (int m = 0; m < 4; ++m) dst##8[m] = PG8_CAT(*(const PG8_LAS bf16x8*)(lds + PG8_SA(b, h) + aoff + m * 2048), *(const PG8_LAS bf16x8*)(lds + PG8_SA(b, h) + aoff + m * 2048 + 1024)); } \
      else { _Pragma("unroll") for (int m = 0; m < 4; ++m) _Pragma("unroll") for (int k = 0; k < 2; ++k) dst[m][k] = *(const PG8_LAS bf16x8*)(lds + PG8_SA(b, h) + aoff + m * 2048 + k * 1024); } } while (0)
#define PG8_LDB(dst, b, h) do { if constexpr (FP8) { _Pragma("unroll") for (int n = 0; n < 2; ++n) dst##8[n] = PG8_CAT(*(const PG8_LAS bf16x8*)(lds + PG8_SB(b, h) + boff + n * 2048), *(const PG8_LAS bf16x8*)(lds + PG8_SB(b, h) + boff + n * 2048 + 1024)); } \
      else { _Pragma("unroll") for (int n = 0; n < 2; ++n) _Pragma("unroll") for (int k = 0; k < 2; ++k) dst[n][k] = *(const PG8_LAS bf16x8*)(lds + PG8_SB(b, h) + boff + n * 2048 + k * 1024); } } while (0)
#define PG8_MMA(ai, bj, At, Bt) do { __builtin_amdgcn_s_setprio(1); if constexpr (FP8) { _Pragma("unroll") for (int m = 0; m < 4; ++m) _Pragma("unroll") for (int n = 0; n < 2; ++n) \
        asm volatile("v_mfma_scale_f32_16x16x128_f8f6f4 %0, %1, %2, %0, %3, %4 op_sel_hi:[0,0,0]" : "+v"(acc[ai][bj][m][n]) : "v"(Bt##8[n]), "v"(At##8[m]), "v"(scw8), "v"(sca8)); } \
      else { _Pragma("unroll") for (int m = 0; m < 4; ++m) _Pragma("unroll") for (int n = 0; n < 2; ++n) _Pragma("unroll") for (int k = 0; k < 2; ++k) \
        acc[ai][bj][m][n] = __builtin_amdgcn_mfma_f32_16x16x32_bf16(Bt[n][k], At[m][k], acc[ai][bj][m][n], 0, 0, 0); } __builtin_amdgcn_s_setprio(0); } while (0)
#define PG8_WAIT_V(n) asm volatile("s_waitcnt vmcnt(" #n ")" ::: "memory")
#define PG8_WAIT_L(n) asm volatile("s_waitcnt lgkmcnt(" #n ")" ::: "memory")
#define PG8_BAR __builtin_amdgcn_s_barrier()
#define PG8_SCHED __builtin_amdgcn_sched_barrier(0)
    Unit cur, nxt; int ui = 0;
    if (!S.next(0, cur)) return;
    f32x4 acc[2][2][4][2];
#pragma unroll
    for (int a = 0; a < 2; ++a)
#pragma unroll
        for (int b = 0; b < 2; ++b)
#pragma unroll
            for (int m = 0; m < 4; ++m)
#pragma unroll
                for (int n = 0; n < 2; ++n) acc[a][b][m][n] = (f32x4){0.f, 0.f, 0.f, 0.f};
    int scw8 = g.sw, sca8 = g.sa; asm volatile("" : "+v"(scw8), "+v"(sca8));
    bf16x8 At[4][2], B0[2][2], B1[2][2]; v8i_t At8[4], B08[2], B18[2];
    const char* cA = cur.a; const char* cB = cur.b; long cJ = cur.bjump;
    S.a_ready(cur);
    if constexpr (SP2) {
        if constexpr (Sched::GATHER) PG8_GOFF(cur, gA0, gA1);
        PG8_STAGE(PG8_SB(0, 0), cB, voffB); PG8_STAGE(PG8_SB(0, 1), cB + hstepB, voffB); do { if constexpr (Sched::GATHER) { PG8_STAGE(PG8_SA(0, 0), cA, gA0); } else { PG8_STAGE(PG8_SA(0, 0), cA, voffA); } } while (0); do { if constexpr (Sched::GATHER) { PG8_STAGE(PG8_SA(0, 1), cA, gA1); } else { PG8_STAGE(PG8_SA(0, 1), cA + hstepA, voffA); } } while (0);
        if (wr == 1) PG8_BAR;
        PG8_WAIT_V(2); PG8_BAR;
        PG8_STAGE(PG8_SB(1, 0), cB + kstep, voffB); do { if constexpr (Sched::GATHER) { PG8_STAGE(PG8_SA(1, 0), cA + kstep, gA0); } else { PG8_STAGE(PG8_SA(1, 0), cA + kstep, voffA); } } while (0); PG8_STAGE(PG8_SB(1, 1), cB + hstepB + kstep, voffB);
        PG8_WAIT_V(6); PG8_BAR;
    } else {
        PG8_STAGE(PG8_SB(0, 0), cB, voffB); PG8_STAGE(PG8_SA(0, 0), cA, voffA); PG8_STAGE(PG8_SB(0, 1), cB + hstepB, voffB); PG8_STAGE(PG8_SA(0, 1), cA + hstepA, voffA);
        if (wr == 1) PG8_BAR;
        PG8_WAIT_V(4); PG8_BAR;
        PG8_STAGE(PG8_SB(1, 0), cB + kstep, voffB); PG8_STAGE(PG8_SA(1, 0), cA + kstep, voffA); PG8_STAGE(PG8_SB(1, 1), cB + hstepB + kstep, voffB);
        PG8_WAIT_V(6); PG8_BAR;
    }
    for (;;) {
        const bool has_next = S.next(ui + 1, nxt);
        const char* nA = has_next ? nxt.a : cA; const char* nB = has_next ? nxt.b : cB;
        if constexpr (Sched::GATHER) { if (has_next) PG8_GOFF(nxt, gN0, gN1); else { gN0[0] = gA0[0]; gN0[1] = gA0[1]; gN1[0] = gA1[0]; gN1[1] = gA1[1]; } }
#pragma unroll 1
        for (int t = 0; t < nt; t += 2) {
            const bool last = (t == nt - 2);
            const char* a1 = cA + (size_t)(t + 1) * kstep;
            const char* a2 = last ? nA : cA + (size_t)(t + 2) * kstep; const char* b2 = last ? nB : cB + (size_t)(t + 2) * kstep + ((t + 2) >= g.ksplit ? cJ : 0L);
            const char* a3 = a2 + kstep; const char* b3 = b2 + kstep;
            if (last && has_next) S.a_ready(nxt);
            unsigned x0[2] = {0u, 0u}, x1[2] = {0u, 0u};
            if constexpr (Sched::GATHER) { x0[0] = last ? gN0[0] : gA0[0]; x0[1] = last ? gN0[1] : gA0[1]; x1[0] = last ? gN1[0] : gA1[0]; x1[1] = last ? gN1[1] : gA1[1]; }
            if constexpr (SP2) {
            PG8_LDB(B0, 0, 0); PG8_LDB(B1, 0, 1); PG8_SCHED; PG8_LDA(At, 0, 0); do { if constexpr (Sched::GATHER) { PG8_STAGE(PG8_SA(1, 1), a1, gA1); } else { PG8_STAGE(PG8_SA(1, 1), a1 + hstepA, voffA); } } while (0);
            PG8_WAIT_V(8); PG8_WAIT_L(0); PG8_BAR; PG8_MMA(0, 0, At, B0); PG8_MMA(0, 1, At, B1); PG8_BAR; PG8_SCHED;
            PG8_LDA(At, 0, 1); PG8_STAGE(PG8_SB(0, 0), b2, voffB); PG8_STAGE(PG8_SB(0, 1), b2 + hstepB, voffB); do { if constexpr (Sched::GATHER) { PG8_STAGE(PG8_SA(0, 0), a2, x0); } else { PG8_STAGE(PG8_SA(0, 0), a2, voffA); } } while (0);
            PG8_WAIT_V(8); PG8_WAIT_L(0); PG8_BAR; PG8_MMA(1, 0, At, B0); PG8_MMA(1, 1, At, B1); PG8_BAR; PG8_SCHED;
            PG8_LDB(B0, 1, 0); PG8_LDB(B1, 1, 1); PG8_SCHED; PG8_LDA(At, 1, 0); do { if constexpr (Sched::GATHER) { PG8_STAGE(PG8_SA(0, 1), a2, x1); } else { PG8_STAGE(PG8_SA(0, 1), a2 + hstepA, voffA); } } while (0);
            PG8_WAIT_V(8); PG8_WAIT_L(0); PG8_BAR; PG8_MMA(0, 0, At, B0); PG8_MMA(0, 1, At, B1); PG8_BAR; PG8_SCHED;
            PG8_LDA(At, 1, 1); PG8_STAGE(PG8_SB(1, 0), b3, voffB); PG8_STAGE(PG8_SB(1, 1), b3 + hstepB, voffB); do { if constexpr (Sched::GATHER) { PG8_STAGE(PG8_SA(1, 0), a3, x0); } else { PG8_STAGE(PG8_SA(1, 0), a3, voffA); } } while (0);
            PG8_WAIT_V(8); PG8_WAIT_L(0); PG8_BAR; PG8_MMA(1, 0, At, B0); PG8_MMA(1, 1, At, B1); PG8_BAR; PG8_SCHED;
            } else {
            PG8_LDB(B0, 0, 0); PG8_SCHED; PG8_LDA(At, 0, 0); PG8_STAGE(PG8_SA(1, 1), a1 + hstepA, voffA);
            PG8_WAIT_L(8); PG8_BAR; PG8_WAIT_L(0); PG8_MMA(0, 0, At, B0); PG8_BAR; PG8_SCHED;
            PG8_LDB(B1, 0, 1); PG8_STAGE(PG8_SB(0, 0), b2, voffB);
            PG8_BAR; PG8_WAIT_L(0); PG8_MMA(0, 1, At, B1); PG8_BAR;
            PG8_LDA(At, 0, 1); PG8_STAGE(PG8_SA(0, 0), a2, voffA);
            PG8_BAR; PG8_WAIT_L(0); PG8_MMA(1, 0, At, B0); PG8_BAR; PG8_SCHED;
            PG8_STAGE(PG8_SB(0, 1), b2 + hstepB, voffB);
            PG8_WAIT_V(6); PG8_BAR; PG8_MMA(1, 1, At, B1); PG8_BAR;
            PG8_LDB(B0, 1, 0); PG8_SCHED; PG8_LDA(At, 1, 0); PG8_STAGE(PG8_SA(0, 1), a2 + hstepA, voffA);
            PG8_WAIT_L(8); PG8_BAR; PG8_WAIT_L(0); PG8_MMA(0, 0, At, B0); PG8_BAR; PG8_SCHED;
            PG8_LDB(B1, 1, 1); PG8_STAGE(PG8_SB(1, 0), b3, voffB);
            PG8_BAR; PG8_WAIT_L(0); PG8_MMA(0, 1, At, B1); PG8_BAR;
            PG8_LDA(At, 1, 1); PG8_STAGE(PG8_SA(1, 0), a3, voffA);
            PG8_BAR; PG8_WAIT_L(0); PG8_MMA(1, 0, At, B0); PG8_BAR; PG8_SCHED;
            PG8_STAGE(PG8_SB(1, 1), b3 + hstepB, voffB);
            PG8_WAIT_V(6); PG8_BAR; PG8_MMA(1, 1, At, B1); PG8_BAR;
            }
        }
        if constexpr (ALIGN_EPI) { if (wr == 0) PG8_BAR; }
        if constexpr (!Epi::AFTER_DRAIN) { E(acc, cur, wr, wc, fr, fq); S.done(cur); }
        if (!has_next) break;
#pragma unroll
        for (int a = 0; a < 2; ++a)
#pragma unroll
            for (int b = 0; b < 2; ++b)
#pragma unroll
                for (int m = 0; m < 4; ++m)
#pragma unroll
                    for (int n = 0; n < 2; ++n) acc[a][b][m][n] = (f32x4){0.f, 0.f, 0.f, 0.f};
        cur = nxt; cA = nA; cB = nB; cJ = cur.bjump; ++ui;
        if constexpr (Sched::GATHER) { gA0[0] = gN0[0]; gA0[1] = gN0[1]; gA1[0] = gN1[0]; gA1[1] = gN1[1]; }
        if constexpr (ALIGN_EPI) { if (wr == 1) PG8_BAR; }
    }
    PG8_WAIT_V(0);
    if constexpr (!ALIGN_EPI) { if (wr == 0) PG8_BAR; }
    PG8_BAR;
    if constexpr (Epi::AFTER_DRAIN) { E.fused(acc, cur, wr, wc, fr, fq, lds, wid, lane); S.done(cur); }
#undef PG8_GOFF
#undef PG8_SA
#undef PG8_SB
#undef PG8_STAGE
#undef PG8_LDA
#undef PG8_LDB
#undef PG8_MMA
#undef PG8_CAT
#undef PG8_WAIT_V
#undef PG8_WAIT_L
#undef PG8_BAR
#undef PG8_SCHED
}
}

#ifndef PROBE_PH
#define PROBE_PH (-1)
#endif
#ifndef PROBE_MODE
#define PROBE_MODE (0)
#endif
constexpr int D = 1024, BATCH = 16, SEQ = 2048, T = BATCH * SEQ;
constexpr int INW = 6984, INWP = 7168;
constexpr int C_QA = 0, C_CKV = 1024, C_QI = 1280, C_KI = 1792, C_WI = 1856, C_RQ = 1864, C_RK = 2376, C_RV = 2888, C_RG = 3912, C_GA = 4936, C_GR = 5960;
constexpr float EPS = 1e-6f;
constexpr int NWAVES = 8;

constexpr size_t MiB = 1u << 20;
constexpr size_t WS_CTL = 0, CTL_ZERO_BYTES = 1 * MiB;
constexpr size_t WS_WIN = 1 * MiB, WS_WKV = 15 * MiB, WS_WATT = 16 * MiB, WS_WRET = 18 * MiB, WS_WOUT = 20 * MiB, WS_W1 = 22 * MiB, WS_WD = 38 * MiB, WS_ACT = 46 * MiB;
constexpr size_t O_QA = 0, O_CKV = 2048, O_QI = 2560, O_KW = 3584, O_RQ = 3840, O_RK = 4864, O_RV = 5888, O_RG = 7936, O_GA = 9984, O_GR = 12032, O_END = 14080;

constexpr int MP_ROWS = 38912;
constexpr size_t MO_APERM = 0, MO_ACT = 80 * MiB, MO_N2 = 120 * MiB, MO_META = 184 * MiB;
constexpr size_t MM_B = 0, MM_P = 131072, MM_CL = 262144, MM_CH = 393216, MM_RS = 524288, MM_PTOK = 655360, MM_PRS = 819200, MM_PCL = 983040, MM_PCH = 1146880, MM_END = 1310720;
constexpr size_t WS_WR = 15 * MiB + 512 * 1024;
constexpr size_t MO_H16 = 192 * MiB;
constexpr size_t WS_WIN8 = 488 * MiB;
constexpr size_t WS_WATT8 = 495 * MiB, WS_WRET8 = 496 * MiB, WS_WOUT8 = 497 * MiB;
constexpr size_t O_A2F8 = 2048, O_MIX8 = 3840;
constexpr size_t WS_W18 = 498 * MiB, WS_WD8 = 506 * MiB;
constexpr size_t AUX_XB8 = 2048 + 896;
constexpr int CW_MOE = 256;
constexpr int RING_OFF = 0, RING_BYTES = 131072, P3_HIST_OFF = 131072, P3_TOT_OFF = 147456, P3_T_OFF = 149504, LDSCTL_OFF = 151552, MISC_OFF = LDSCTL_OFF + 320, LDS_BYTES = 152576;
constexpr int CW_Q3 = 64, CW_Q4 = 128;

#define GAS __attribute__((address_space(1)))
#define LAS __attribute__((address_space(3)))
typedef unsigned short bf16;
typedef unsigned v4u __attribute__((ext_vector_type(4)));
typedef float f32x4 __attribute__((ext_vector_type(4)));
#define LDS_WAIT() asm volatile("s_waitcnt lgkmcnt(0)" ::: "memory")
#define VM_WAIT() asm volatile("s_waitcnt vmcnt(0)" ::: "memory")
__device__ __forceinline__ unsigned f2bf(float f) { unsigned u = __builtin_bit_cast(unsigned, f); return (u + 0x7fffu + ((u >> 16) & 1u)) >> 16; }
__device__ __forceinline__ unsigned pk2(float lo, float hi) { return f2bf(lo) | (f2bf(hi) << 16); }
__device__ __forceinline__ float bf2f(bf16 b) { return __uint_as_float((unsigned)b << 16); }


typedef GAS unsigned gu32;
constexpr int CW_BAR = 4096;
#define XB_TMO      128
#define XB_XCNT(j)  (256  + 64 * (j))
#define XB_XSUB(j)  (1280 + 64 * (j))
#define XB_XGEN(j)  (2304 + 64 * (j))
#define XB_TOP      3328
#define XB_TOPGEN   3392
#define XCD_BAR_WORDS 3456
#define XB_SPIN_CAP (1u << 18)

__device__ __forceinline__ unsigned xb_ld(unsigned* p)              { return __hip_atomic_load(p, __ATOMIC_RELAXED, __HIP_MEMORY_SCOPE_AGENT); }
__device__ __forceinline__ unsigned xb_add(unsigned* p, unsigned v) { return __hip_atomic_fetch_add(p, v, __ATOMIC_RELAXED, __HIP_MEMORY_SCOPE_AGENT); }
__device__ __forceinline__ unsigned xb_xcc_id() { return (unsigned)__builtin_amdgcn_s_getreg((3 << 11) | 20) & 0xFu; }
#define XB_SPIN(cond, bar) do { unsigned _sp = 0; while (cond) { __builtin_amdgcn_s_sleep(1); \
    if ((++_sp & 255u) == 0u) { if (xb_ld(&(bar)[XB_TMO])) break; if (_sp > XB_SPIN_CAP) { atomicAdd(&(bar)[XB_TMO], 1u); break; } } } } while (0)

struct XcdBarrier {
    unsigned* bar; unsigned x;
    volatile LAS unsigned* st;
};

__device__ __forceinline__ XcdBarrier xcd_barrier_post(unsigned* bar, volatile LAS unsigned* st) {
    XcdBarrier b; b.bar = bar; b.x = xb_xcc_id(); b.st = st;
    if (threadIdx.x == 0) (void)xb_add(&bar[XB_XCNT(b.x)], 1u);
    return b;
}
__device__ __forceinline__ void xcd_barrier_complete(unsigned* bar, unsigned x, unsigned& nloc, unsigned& nx) {
    const unsigned G = gridDim.x * gridDim.y * gridDim.z;
    unsigned sum, cnt, mine, sp = 0u;
    for (;;) {
        sum = 0u; cnt = 0u; mine = 0u;
#pragma unroll
        for (unsigned j = 0; j < 16; ++j) { const unsigned c = xb_ld(&bar[XB_XCNT(j)]); sum += c; cnt += (c > 0u) ? 1u : 0u; mine = (j == x) ? c : mine; }
        if (sum == G) break;
        __builtin_amdgcn_s_sleep(1);
        if ((++sp & 255u) == 0u) { if (xb_ld(&bar[XB_TMO])) break; if (sp > XB_SPIN_CAP) { atomicAdd(&bar[XB_TMO], 1u); break; } }
    }
    nloc = mine > 0u ? mine : 1u; nx = cnt > 0u ? cnt : 1u;
}

__device__ __forceinline__ void xcd_barrier(const XcdBarrier& b) {
    asm volatile("s_waitcnt vmcnt(0)" ::: "memory");
    __syncthreads();
    if (threadIdx.x == 0) {
        unsigned* bar = b.bar;
        __builtin_amdgcn_s_waitcnt(0);
        unsigned nloc = b.st[0], nx = b.st[1];
        if (nloc == 0u) { xcd_barrier_complete(bar, b.x, nloc, nx); b.st[0] = nloc; b.st[1] = nx; }
        const unsigned old = xb_add(&bar[XB_XSUB(b.x)], 1u);
        const unsigned gen = old / nloc;
        if (old + 1u == (gen + 1u) * nloc) {
            __builtin_amdgcn_fence(__ATOMIC_RELEASE, "agent");
            asm volatile("s_waitcnt vmcnt(0)" ::: "memory");
            const unsigned og = xb_add(&bar[XB_TOP], 1u);
            const unsigned tg = og / nx;
            if (og + 1u == (tg + 1u) * nx) xb_add(&bar[XB_TOPGEN], 1u);
            else XB_SPIN(xb_ld(&bar[XB_TOPGEN]) == tg, bar);
            __builtin_amdgcn_fence(__ATOMIC_ACQUIRE, "agent");
            xb_add(&bar[XB_XGEN(b.x)], 1u);
            asm volatile("s_waitcnt vmcnt(0)" ::: "memory");
        } else {
            XB_SPIN(xb_ld(&bar[XB_XGEN(b.x)]) == gen, bar);
            __builtin_amdgcn_fence(__ATOMIC_ACQUIRE, "agent");
            asm volatile("s_waitcnt vmcnt(0)" ::: "memory");
        }
    }
    __syncthreads();
}

struct Args { const float* in[20]; float* out; unsigned char* ws; unsigned char* xb; int ph_lo, ph_hi, ntok, tok0, mode, pad; };

struct Frame {
    LAS unsigned char* lds;
    int tid, lane, wave, vcu, G;
    int ntok;
    unsigned char* ws; unsigned char* act; unsigned char* xbp;
};

struct EpiProj {
    static constexpr bool PERM = true, AFTER_DRAIN = false;
    unsigned char* act; size_t ntok;
    __device__ __forceinline__ void operator()(const pg8::f32x4 (&acc)[2][2][4][2], const pg8::Unit& u, int wr, int wc, int fr, int fq) const {
        const int pn = u.pn; size_t O; int ld, cb, nbj = 2;
        if (pn < 4) { O = O_QA; ld = 1024; cb = pn * 256; }
        else if (pn == 4) { O = O_CKV; ld = 256; cb = 0; }
        else if (pn < 7) { O = O_QI; ld = 512; cb = (pn - 5) * 256; }
        else if (pn == 7) { O = O_KW; ld = 128; cb = 0; nbj = 1; }
        else if (pn < 10) { O = O_RQ; ld = 512; cb = (pn - 8) * 256; }
        else if (pn < 12) { O = O_RK; ld = 512; cb = (pn - 10) * 256; }
        else { O = O_RV + (size_t)((pn - 12) >> 2) * 2048; ld = 1024; cb = ((pn - 12) & 3) * 256; }
        pg8::bf16_t* base = (pg8::bf16_t*)(act + ntok * O);
        const int row0 = u.pm * pg8::BM + wr * 64 + fr, col0 = cb + wc * 32 + 8 * fq;
#pragma unroll
        for (int ai = 0; ai < 2; ++ai)
#pragma unroll
            for (int m = 0; m < 4; ++m) { pg8::bf16_t* rowp = base + (size_t)(row0 + ai * pg8::HALF + m * 16) * ld + col0;
#pragma unroll
                for (int bj = 0; bj < 2; ++bj) if (bj < nbj) { const pg8::f32x4 v0 = acc[ai][bj][m][0], v1 = acc[ai][bj][m][1];
                    pg8::u32x4 w; w.x = pg8::cvt_pk_bf16(v0[0], v0[1]); w.y = pg8::cvt_pk_bf16(v0[2], v0[3]); w.z = pg8::cvt_pk_bf16(v1[0], v1[1]); w.w = pg8::cvt_pk_bf16(v1[2], v1[3]);
                    *(pg8::u32x4*)(rowp + bj * pg8::HALF) = w; } }
    }
};


__device__ __forceinline__ float sigm(float x) { return __builtin_amdgcn_rcpf(1.f + __builtin_amdgcn_exp2f(-1.4426950408889634f * x)); }
struct EpiGateA {
    static constexpr bool PERM = true, AFTER_DRAIN = false;
    pg8::bf16_t* GA;
    __device__ __forceinline__ void operator()(const pg8::f32x4 (&acc)[2][2][4][2], const pg8::Unit& u, int wr, int wc, int fr, int fq) const {
        const int row0 = u.pm * pg8::BM + wr * 64 + fr, col0 = u.pn * pg8::BM + wc * 32 + 8 * fq;
#pragma unroll
        for (int ai = 0; ai < 2; ++ai)
#pragma unroll
            for (int m = 0; m < 4; ++m) { pg8::bf16_t* rowp = GA + (size_t)(row0 + ai * pg8::HALF + m * 16) * 1024 + col0;
#pragma unroll
                for (int bj = 0; bj < 2; ++bj) { const pg8::u32x4 g = *(const pg8::u32x4*)(rowp + bj * pg8::HALF); const pg8::f32x4 v0 = acc[ai][bj][m][0], v1 = acc[ai][bj][m][1];
                    pg8::u32x4 w; w.x = pg8::cvt_pk_bf16(sigm(pg8::bf_lo(g.x)) * v0[0], sigm(pg8::bf_hi(g.x)) * v0[1]); w.y = pg8::cvt_pk_bf16(sigm(pg8::bf_lo(g.y)) * v0[2], sigm(pg8::bf_hi(g.y)) * v0[3]);
                    w.z = pg8::cvt_pk_bf16(sigm(pg8::bf_lo(g.z)) * v1[0], sigm(pg8::bf_hi(g.z)) * v1[1]); w.w = pg8::cvt_pk_bf16(sigm(pg8::bf_lo(g.w)) * v1[2], sigm(pg8::bf_hi(g.w)) * v1[3]);
                    *(pg8::u32x4*)(rowp + bj * pg8::HALF) = w; } }
    }
};
struct EpiGateB {
    static constexpr bool PERM = true, AFTER_DRAIN = false;
    const pg8::bf16_t* GA; const pg8::bf16_t* GR; unsigned char* MIX8;
    __device__ __forceinline__ void operator()(const pg8::f32x4 (&acc)[2][2][4][2], const pg8::Unit& u, int wr, int wc, int fr, int fq) const {
        const int row0 = u.pm * pg8::BM + wr * 64 + fr, col0 = u.pn * pg8::BM + wc * 32 + 8 * fq;
#pragma unroll
        for (int ai = 0; ai < 2; ++ai)
#pragma unroll
            for (int m = 0; m < 4; ++m) { const size_t ro = (size_t)(row0 + ai * pg8::HALF + m * 16) * 1024 + col0;
#pragma unroll
                for (int bj = 0; bj < 2; ++bj) { const pg8::u32x4 t = *(const pg8::u32x4*)(GA + ro + bj * pg8::HALF), g = *(const pg8::u32x4*)(GR + ro + bj * pg8::HALF); const pg8::f32x4 v0 = acc[ai][bj][m][0], v1 = acc[ai][bj][m][1];
                    int w0 = __builtin_amdgcn_cvt_pk_fp8_f32(8.f * (pg8::bf_lo(t.x) + sigm(pg8::bf_lo(g.x)) * v0[0]), 8.f * (pg8::bf_hi(t.x) + sigm(pg8::bf_hi(g.x)) * v0[1]), 0, false);
                    w0 = __builtin_amdgcn_cvt_pk_fp8_f32(8.f * (pg8::bf_lo(t.y) + sigm(pg8::bf_lo(g.y)) * v0[2]), 8.f * (pg8::bf_hi(t.y) + sigm(pg8::bf_hi(g.y)) * v0[3]), w0, true);
                    int w1 = __builtin_amdgcn_cvt_pk_fp8_f32(8.f * (pg8::bf_lo(t.z) + sigm(pg8::bf_lo(g.z)) * v1[0]), 8.f * (pg8::bf_hi(t.z) + sigm(pg8::bf_hi(g.z)) * v1[1]), 0, false);
                    w1 = __builtin_amdgcn_cvt_pk_fp8_f32(8.f * (pg8::bf_lo(t.w) + sigm(pg8::bf_lo(g.w)) * v1[2]), 8.f * (pg8::bf_hi(t.w) + sigm(pg8::bf_hi(g.w)) * v1[3]), w1, true);
                    *(unsigned long long*)(MIX8 + ro + bj * pg8::HALF) = (unsigned long long)(unsigned)w0 | ((unsigned long long)(unsigned)w1 << 32); } }
    }
};
struct EpiResid {
    static constexpr bool PERM = true, AFTER_DRAIN = false;
    const float* x; pg8::bf16_t* h16;
    __device__ __forceinline__ void operator()(const pg8::f32x4 (&acc)[2][2][4][2], const pg8::Unit& u, int wr, int wc, int fr, int fq) const {
        const int row0 = u.pm * pg8::BM + wr * 64 + fr, col0 = u.pn * pg8::BM + wc * 32 + 8 * fq;
#pragma unroll
        for (int ai = 0; ai < 2; ++ai)
#pragma unroll
            for (int m = 0; m < 4; ++m) { const size_t ro = (size_t)(row0 + ai * pg8::HALF + m * 16) * 1024 + col0;
#pragma unroll
                for (int bj = 0; bj < 2; ++bj) { const pg8::f32x4 x0 = *(const pg8::f32x4*)(x + ro + bj * pg8::HALF), x1 = *(const pg8::f32x4*)(x + ro + bj * pg8::HALF + 4); const pg8::f32x4 v0 = acc[ai][bj][m][0] + x0, v1 = acc[ai][bj][m][1] + x1;
                    pg8::u32x4 w; w.x = pg8::cvt_pk_bf16(v0[0], v0[1]); w.y = pg8::cvt_pk_bf16(v0[2], v0[3]); w.z = pg8::cvt_pk_bf16(v1[0], v1[1]); w.w = pg8::cvt_pk_bf16(v1[2], v1[3]);
                    *(pg8::u32x4*)(h16 + ro + bj * pg8::HALF) = w; } }
    }
};


struct P1Order {
    static constexpr bool GATHER = false; const int* ptok = nullptr;
    int nM, nN, nwg, G, c, mode; const char* A; const char* Bt; size_t tA, tB;
    __device__ bool next(int i, pg8::Unit& u) const {
        const long L = (long)i * G + c; if (L >= nwg) return false;
        int wgid = (int)L; { const int q = nwg / pg8::NXCD, r = nwg % pg8::NXCD, xcd = wgid % pg8::NXCD, off = wgid / pg8::NXCD; wgid = (xcd < r ? xcd * (q + 1) : r * (q + 1) + (xcd - r) * q) + off; }
        const int nig = pg8::WGM * nN, gid = wgid / nig, fm = gid * pg8::WGM, gsz = (nM - fm) < pg8::WGM ? (nM - fm) : pg8::WGM;
        u.pm = fm + ((wgid % nig) % gsz); const int pc = (wgid % nig) / gsz; u.pn = mode ? 5 + pc : (pc < 5 ? pc : pc + 3);
        u.a = A + (size_t)u.pm * tA; u.b = Bt + (size_t)u.pn * tB; u.bjump = 0; u.aux = 0; return true;
    }
    __device__ __forceinline__ void a_ready(const pg8::Unit&) const {}
    __device__ __forceinline__ void done(const pg8::Unit&) const {}
};

__device__ __forceinline__ float wave_sum(float v) {
#pragma unroll
    for (int o = 1; o < 64; o <<= 1) v += __shfl_xor(v, o);
    return v;
}
__device__ __forceinline__ void p0_transpose_item(const float* W, int K, int N, bf16* WT, int map, int row_off, int par, const float* gk, LAS float* scr, int item, int lane, unsigned char* WT8 = nullptr, float s8 = 32.f) {
    const int nblk = (N + 31) / 32, kb = item / nblk, nb = item % nblk, k0 = 64 * kb, n0 = 32 * nb;
    const int c4 = lane & 7, rr = lane >> 3; const bool okc = (n0 + 4 * c4) < N;
    f32x4 v[8];
#pragma unroll
    for (int i = 0; i < 8; ++i) { const int kk = i * 8 + rr; v[i] = okc ? *(const f32x4*)(W + (size_t)(k0 + kk) * N + n0 + 4 * c4) : (f32x4){0.f, 0.f, 0.f, 0.f}; }
#pragma unroll
    for (int i = 0; i < 8; ++i) { const int kk = i * 8 + rr; f32x4 x = v[i]; if (gk) x = x * gk[k0 + kk]; *(LAS f32x4*)(scr + kk * 36 + 4 * c4) = x; }
    LDS_WAIT(); asm volatile("" ::: "memory");
    const int c = lane & 7;
#pragma unroll
    for (int j = 0; j < 4; ++j) { const int nl = (lane >> 3) + 8 * j, n = n0 + nl; const LAS float* s = scr + (8 * c) * 36 + nl;
        v4u o; o.x = pk2(s[0 * 36], s[1 * 36]); o.y = pk2(s[2 * 36], s[3 * 36]); o.z = pk2(s[4 * 36], s[5 * 36]); o.w = pk2(s[6 * 36], s[7 * 36]);
        if (n < N) { const int row = (map == 0) ? row_off + n : (map == 1) ? (n < 1864 ? n : n + 184) : row_off + 2 * n + par;
            if (WT) *(GAS v4u*)(WT + (size_t)row * K + k0 + 8 * c) = o;
            if (WT8) { int w0 = __builtin_amdgcn_cvt_pk_fp8_f32(s[0 * 36] * s8, s[1 * 36] * s8, 0, false); w0 = __builtin_amdgcn_cvt_pk_fp8_f32(s[2 * 36] * s8, s[3 * 36] * s8, w0, true);
                int w1 = __builtin_amdgcn_cvt_pk_fp8_f32(s[4 * 36] * s8, s[5 * 36] * s8, 0, false); w1 = __builtin_amdgcn_cvt_pk_fp8_f32(s[6 * 36] * s8, s[7 * 36] * s8, w1, true);
                *(GAS unsigned long long*)(WT8 + (size_t)row * K + k0 + 8 * c) = (unsigned long long)(unsigned)w0 | ((unsigned long long)(unsigned)w1 << 32); } } }
    LDS_WAIT(); asm volatile("" ::: "memory");
}
__device__ __forceinline__ void p0_prologue(Frame& F, const Args& a) {
    LAS float* scr = (LAS float*)(F.lds + RING_OFF + F.wave * 16384);
    const int gw = F.vcu * NWAVES + F.wave, NGW = F.G * NWAVES;
    bf16* Win_t = (bf16*)(F.ws + WS_WIN); bf16* Wkv_t = (bf16*)(F.ws + WS_WKV);
    constexpr int I_IN = 16 * 219, I_KV = 4 * 8, I_SQ = 16 * 32, I_GU = 16 * 8  , I_DN = 4 * 32  ;
    constexpr int NITEMS = I_IN + I_KV + 3 * I_SQ + 16 * (2 * I_GU + I_DN);
    for (int it = gw; it < NITEMS; it += NGW) {
        int r = it;
        if (r < I_IN) { p0_transpose_item(a.in[2], 1024, INW, Win_t, 1, 0, 0, a.in[1], scr, r, F.lane, F.ws + WS_WIN8); continue; } r -= I_IN;
        if (r < I_KV) { p0_transpose_item(a.in[4], 256, 256, Wkv_t, 0, 0, 0, a.in[3], scr, r, F.lane); continue; } r -= I_KV;
        if (r < I_SQ) { p0_transpose_item(a.in[9], 1024, 1024, nullptr, 0, 0, 0, nullptr, scr, r, F.lane, F.ws + WS_WATT8, 32.f); continue; } r -= I_SQ;
        if (r < I_SQ) { p0_transpose_item(a.in[10], 1024, 1024, nullptr, 0, 0, 0, nullptr, scr, r, F.lane, F.ws + WS_WRET8, 32.f); continue; } r -= I_SQ;
        if (r < I_SQ) { p0_transpose_item(a.in[11], 1024, 1024, nullptr, 0, 0, 0, nullptr, scr, r, F.lane, F.ws + WS_WOUT8, 32.f); continue; } r -= I_SQ;
        const int e = r / (2 * I_GU + I_DN), q = r % (2 * I_GU + I_DN);
        if (q < I_GU) p0_transpose_item(a.in[17] + (size_t)e * 1024 * 256, 1024, 256, nullptr, 2, e * 512, 0, nullptr, scr, q, F.lane, F.ws + WS_W18, 32.f);
        else if (q < 2 * I_GU) p0_transpose_item(a.in[18] + (size_t)e * 1024 * 256, 1024, 256, nullptr, 2, e * 512, 1, nullptr, scr, q - I_GU, F.lane, F.ws + WS_W18, 32.f);
        else p0_transpose_item(a.in[19] + (size_t)e * 256 * 1024, 256, 1024, nullptr, 0, 0, 0, nullptr, scr, q - 2 * I_GU, F.lane, F.ws + WS_WD8 + (size_t)e * 1024 * 256, 16.f);
    }
    { const int gt = (F.vcu * NWAVES + F.wave) * 64 + F.lane, NGT = F.G * NWAVES * 64; GAS v4u* z = (GAS v4u*)(Win_t + (size_t)1864 * 1024);
      for (int i = gt; i < 184 * 1024 * 2 / 16; i += NGT) z[i] = (v4u){0u, 0u, 0u, 0u}; }
    { const int gt = (F.vcu * NWAVES + F.wave) * 64 + F.lane, NGT = F.G * NWAVES * 64; bf16* Wh = (bf16*)(F.ws + WS_WR); bf16* Wl = Wh + 32 * 1024;
      for (int i = gt; i < 32 * 1024; i += NGT) { const int n = i >> 10, k = i & 1023; const float wv = n < 4 ? a.in[13][k * 4 + n] : (n < 20 ? a.in[15][k * 16 + (n - 4)] : 0.f);
        const unsigned hb = f2bf(wv); const float hf = __uint_as_float(hb << 16); Wh[i] = (bf16)hb; Wl[i] = (bf16)f2bf(wv - hf); } }
    const float* x = a.in[0] + (size_t)a.tok0 * D; unsigned char* xb8 = a.xb + (size_t)F.ntok * AUX_XB8;
    for (int m = gw; m < F.ntok; m += 2 * NGW) {
        const int m2 = m + NGW; const bool two = m2 < F.ntok;
        const GAS f32x4* xr = (const GAS f32x4*)(x + (size_t)m * D) + F.lane; const GAS f32x4* xr2 = (const GAS f32x4*)(x + (size_t)(two ? m2 : m) * D) + F.lane;
        f32x4 v[4], u[4]; float s = 0.f, s2 = 0.f;
#pragma unroll
        for (int j = 0; j < 4; ++j) { v[j] = xr[64 * j]; u[j] = xr2[64 * j]; }
#pragma unroll
        for (int j = 0; j < 4; ++j) { s += (v[j].x * v[j].x + v[j].y * v[j].y) + (v[j].z * v[j].z + v[j].w * v[j].w); s2 += (u[j].x * u[j].x + u[j].y * u[j].y) + (u[j].z * u[j].z + u[j].w * u[j].w); }
        const float rstd = 1.f / sqrtf(wave_sum(s) * (1.f / D) + EPS), rstd2 = 1.f / sqrtf(wave_sum(s2) * (1.f / D) + EPS);
        GAS unsigned long long* o8 = (GAS unsigned long long*)(a.xb + (size_t)m * D * 2) + F.lane; GAS unsigned* q8 = (GAS unsigned*)(xb8 + (size_t)m * D) + F.lane;
#pragma unroll
        for (int j = 0; j < 4; ++j) { o8[64 * j] = (unsigned long long)pk2(v[j].x * rstd, v[j].y * rstd) | ((unsigned long long)pk2(v[j].z * rstd, v[j].w * rstd) << 32);
            int w8 = __builtin_amdgcn_cvt_pk_fp8_f32(v[j].x * rstd, v[j].y * rstd, 0, false); w8 = __builtin_amdgcn_cvt_pk_fp8_f32(v[j].z * rstd, v[j].w * rstd, w8, true); q8[64 * j] = (unsigned)w8; }
        if (two) { GAS unsigned long long* p8 = (GAS unsigned long long*)(a.xb + (size_t)m2 * D * 2) + F.lane; GAS unsigned* r8 = (GAS unsigned*)(xb8 + (size_t)m2 * D) + F.lane;
#pragma unroll
            for (int j = 0; j < 4; ++j) { p8[64 * j] = (unsigned long long)pk2(u[j].x * rstd2, u[j].y * rstd2) | ((unsigned long long)pk2(u[j].z * rstd2, u[j].w * rstd2) << 32);
                int w8 = __builtin_amdgcn_cvt_pk_fp8_f32(u[j].x * rstd2, u[j].y * rstd2, 0, false); w8 = __builtin_amdgcn_cvt_pk_fp8_f32(u[j].z * rstd2, u[j].w * rstd2, w8, true); r8[64 * j] = (unsigned)w8; } }
    }
}


constexpr size_t AUX_KP = 0, AUX_VV = 256, AUX_KIN = 512, AUX_MASK = 640, AUX_END = 896;
typedef short bf16x8_t __attribute__((ext_vector_type(8)));
typedef float f32x16 __attribute__((ext_vector_type(16)));
__device__ __forceinline__ int crow(int r, int hi) { return (r & 3) + 8 * (r >> 2) + 4 * hi; }
__device__ __forceinline__ float xhalf_sum(float v) { auto rr = __builtin_amdgcn_permlane32_swap(__float_as_uint(v), __float_as_uint(v), false, false); return __uint_as_float(rr[0]) + __uint_as_float(rr[1]); }
__device__ __forceinline__ float sumsq8(bf16x8_t v) { float s = 0.f;
#pragma unroll
    for (int j = 0; j < 8; ++j) { const float f = __uint_as_float((unsigned)(unsigned short)v[j] << 16); s += f * f; } return s; }
__device__ __forceinline__ void p2_post(Frame& F, const Args& a) {
    const int gw = F.vcu * NWAVES + F.wave, NGW = F.G * NWAVES, lane = F.lane, r32 = lane & 31, hi = lane >> 5;
    const size_t nt_ = (size_t)F.ntok;
    const bf16* CKV = (const bf16*)(F.act + nt_ * O_CKV); const bf16* KW = (const bf16*)(F.act + nt_ * O_KW);
    const bf16* Wkv_t = (const bf16*)(F.ws + WS_WKV);
    unsigned char* aux = a.xb + nt_ * 2048;
    bf16* KP = (bf16*)(aux + nt_ * AUX_KP); bf16* VV = (bf16*)(aux + nt_ * AUX_VV); bf16* KIN = (bf16*)(aux + nt_ * AUX_KIN);
    const float* g_q = a.in[5]; const float* g_k = a.in[6]; const float* g_ki = a.in[7];
    constexpr int WP = 528;
    LAS unsigned char* Wl = F.lds + RING_OFF; LAS float* gl = (LAS float*)(F.lds + RING_OFF + 256 * WP);
    for (int i = F.tid; i < 256 * 32; i += NWAVES * 64) { const int n = i >> 5, ch = i & 31; *(LAS v4u*)(Wl + n * WP + ch * 16) = *(const v4u*)(Wkv_t + (size_t)n * 256 + ch * 8); }
    if (F.tid < 128) gl[F.tid] = g_k[F.tid] * g_q[F.tid] * (0.08838834764831845f * 1.4426950408889634f);
    else if (F.tid < 192) gl[F.tid] = g_ki[F.tid - 128];
    __syncthreads();
    const int ntask = 2 * (F.ntok / 32);
    for (int task = gw; task < ntask; task += NGW) {
        const int kind = task & 1, t0 = (task >> 1) * 32;
        const bf16* crowp = CKV + (size_t)(t0 + r32) * 256 + hi * 8;
        bf16x8_t bfr[16]; float ss = 0.f;
#pragma unroll
        for (int kk = 0; kk < 16; ++kk) { bfr[kk] = *(const bf16x8_t*)(crowp + kk * 16); ss += sumsq8(bfr[kk]); }
        ss = xhalf_sum(ss);
        const float rstd = rsqrtf(ss * (1.f / 256.f) + EPS);
        f32x16 acc[4];
#pragma unroll
        for (int nt = 0; nt < 4; ++nt) { acc[nt] = f32x16{};
            const LAS unsigned char* wrow = Wl + (kind * 128 + nt * 32 + r32) * WP + hi * 16;
#pragma unroll
            for (int kk = 0; kk < 16; ++kk) { const bf16x8_t af = *(const LAS bf16x8_t*)(wrow + kk * 32); acc[nt] = __builtin_amdgcn_mfma_f32_32x32x16_bf16(af, bfr[kk], acc[nt], 0, 0, 0); if ((kk & 3) == 3) __builtin_amdgcn_sched_barrier(0); } }
        float sc = rstd;
        if (kind == 0) { float sk = 0.f;
#pragma unroll
            for (int nt = 0; nt < 4; ++nt)
#pragma unroll
                for (int r = 0; r < 16; ++r) { const float v = acc[nt][r] * rstd; sk += v * v; }
            sk = xhalf_sum(sk);
            sc = rstd * rsqrtf(sk * (1.f / 128.f) + EPS); }
        bf16* orow = (kind == 0 ? KP : VV) + (size_t)(t0 + r32) * 128;
#pragma unroll
        for (int nt = 0; nt < 4; ++nt)
#pragma unroll
            for (int g = 0; g < 4; ++g) { const int ch = nt * 32 + 8 * g + 4 * hi; float v[4];
#pragma unroll
                for (int j = 0; j < 4; ++j) { v[j] = acc[nt][4 * g + j] * sc; if (kind == 0) v[j] *= gl[ch + j]; }
                *(unsigned long long*)(orow + ch) = (unsigned long long)pk2(v[0], v[1]) | ((unsigned long long)pk2(v[2], v[3]) << 32); }
        if (kind == 0) {
            const bf16* kr = KW + (size_t)(t0 + r32) * 128 + hi * 32; bf16x8_t kv4[4]; float s2 = 0.f;
#pragma unroll
            for (int j = 0; j < 4; ++j) { kv4[j] = *(const bf16x8_t*)(kr + 8 * j); s2 += sumsq8(kv4[j]); }
            s2 = xhalf_sum(s2);
            const float rk = rsqrtf(s2 * (1.f / 64.f) + EPS);
            bf16* ko = KIN + (size_t)(t0 + r32) * 64 + hi * 32;
#pragma unroll
            for (int j = 0; j < 4; ++j) { float f[8];
#pragma unroll
                for (int e = 0; e < 8; ++e) f[e] = __uint_as_float((unsigned)(unsigned short)kv4[j][e] << 16) * rk * gl[128 + hi * 32 + 8 * j + e];
                v4u o; o.x = pk2(f[0], f[1]); o.y = pk2(f[2], f[3]); o.z = pk2(f[4], f[5]); o.w = pk2(f[6], f[7]);
                *(v4u*)(ko + 8 * j) = o; }
        }
    }
    __syncthreads();
}

typedef float f32x4_t __attribute__((ext_vector_type(4)));
__device__ __forceinline__ unsigned key15_of(float s) { const unsigned short hb = __builtin_bit_cast(unsigned short, (_Float16)s); const unsigned u = (hb & 0x8000u) ? (~(unsigned)hb & 0xffffu) : ((unsigned)hb | 0x8000u); return u >> 1; }
__device__ __forceinline__ unsigned sad4(unsigned x) { return __builtin_amdgcn_sad_u8(x, 0u, 0u); }
__device__ __forceinline__ void p3_merge(LAS unsigned* hist, LAS unsigned short* tot, int w, int g, int q, int& need, int& bsel) {
    __syncthreads();
    const int o = 4 * w + g; unsigned c = 0;
#pragma unroll
    for (int p = 0; p < 32; ++p) { const int tidp = (p >> 2) * 64 + (p & 3) * 16 + q; c += (hist[(o >> 2) * 512 + tidp] >> (8 * (o & 3))) & 0xffu; }
    tot[q * 32 + o] = (unsigned short)c;
    __syncthreads();
    v4u tv[4];
#pragma unroll
    for (int j = 0; j < 4; ++j) tv[j] = *(const LAS v4u*)((const LAS unsigned char*)tot + q * 64 + j * 16);
    int cum = 0, bs = 0, ab = 0; bool found = false;
#pragma unroll
    for (int bin = 31; bin >= 0; --bin) { const unsigned wd = tv[bin >> 3][(bin >> 1) & 3]; const int cc = (int)((bin & 1) ? (wd >> 16) : (wd & 0xffffu));
        if (!found && cum + cc >= need) { bs = bin; ab = cum; found = true; } cum += cc; }
    bsel = bs; need -= ab;
}
__device__ __forceinline__ void p3_index(Frame& F, const Args& a) {
    const int tid = F.tid, lane = F.lane, w = F.wave, q = lane & 15, g = lane >> 4;
    LAS unsigned* keys = (LAS unsigned*)(F.lds + RING_OFF);
    LAS unsigned char* qbuf = F.lds + 65536;
    LAS unsigned* hist = (LAS unsigned*)(F.lds + P3_HIST_OFF);
    LAS unsigned short* tot = (LAS unsigned short*)(F.lds + P3_TOT_OFF);
    LAS unsigned char* Tt = (LAS unsigned char*)(F.lds + P3_T_OFF);
    const size_t nt_ = (size_t)F.ntok;
    const bf16* QI = (const bf16*)(F.act + nt_ * O_QI); const bf16* KW = (const bf16*)(F.act + nt_ * O_KW);
    unsigned char* aux = a.xb + nt_ * 2048;
    const bf16* KIN = (const bf16*)(aux + nt_ * AUX_KIN); unsigned* MASK = (unsigned*)(aux + nt_ * AUX_MASK);
    const int nb = F.ntok / SEQ, nitems = nb * 128; const int bxj = (int)blockIdx.x >> 3;
    const int G = F.G - F.G / 4, c = (bxj - (bxj >> 2) - 1) * 8 + ((int)blockIdx.x & 7);
#define P3_ITEM(k) ((k) * G + (((k) & 1) ? (G - 1 - c) : c))
#define P3_QDMA(it_, buf_) do { const int qg_ = 127 - (it_) / nb, b_ = (it_) % nb; _Pragma("unroll") for (int i_ = 0; i_ < 2; ++i_) { const int row_ = w * 2 + i_; \
        const char* src_ = (const char*)(QI + ((size_t)b_ * SEQ + qg_ * 16 + row_) * 512) + ((lane ^ (row_ & 15)) * 16); \
        __builtin_amdgcn_global_load_lds((const unsigned*)src_, (LAS unsigned*)(qbuf + (buf_) * 16384 + row_ * 1024), 16, 0, 0); } } while (0)
    const int nround = (nitems + G - 1) / G;
    if (P3_ITEM(0) < nitems) P3_QDMA(P3_ITEM(0), 0);
    v4u wvn = (v4u){0u, 0u, 0u, 0u};
    if (P3_ITEM(0) < nitems) { const int it0 = P3_ITEM(0); wvn = *(const v4u*)(KW + ((size_t)(it0 % nb) * SEQ + (127 - it0 / nb) * 16 + q) * 128 + 64); }
    for (int k = 0; k < nround; ++k) {
        const int it = P3_ITEM(k); if (it >= nitems) break;
        const int qg = 127 - it / nb, b = it % nb, q0 = qg * 16, qme = q0 + q;
        unsigned* Mb = MASK + (size_t)b * 64 * 2048;
        const int kb_hi = ((qg >> 3) + 1) << 2, nkb = (qg >> 1) + 1;
        asm volatile("s_waitcnt vmcnt(0) lgkmcnt(0)\n\ts_barrier" ::: "memory");
        const v4u wv = wvn;
        { const int itn = P3_ITEM(k + 1); if (k + 1 < nround && itn < nitems) { P3_QDMA(itn, (k + 1) & 1); wvn = *(const v4u*)(KW + ((size_t)(itn % nb) * SEQ + (127 - itn / nb) * 16 + q) * 128 + 64); } }
        if (qg < 16) {
            if (tid < kb_hi * 16) { const int kb = tid >> 4, qq = q0 + (tid & 15), nbits = qq - kb * 32 + 1; Mb[kb * 2048 + qq] = nbits >= 32 ? 0xffffffffu : (nbits <= 0 ? 0u : ((1u << nbits) - 1u)); }
            continue;
        }
        float wq[8];
        { const float cc = 0.35355339059327373f * 0.125f;
          wq[0] = pg8::bf_lo(wv.x) * cc; wq[1] = pg8::bf_hi(wv.x) * cc; wq[2] = pg8::bf_lo(wv.y) * cc; wq[3] = pg8::bf_hi(wv.y) * cc; wq[4] = pg8::bf_lo(wv.z) * cc; wq[5] = pg8::bf_hi(wv.z) * cc; wq[6] = pg8::bf_lo(wv.w) * cc; wq[7] = pg8::bf_hi(wv.w) * cc; }
        bf16x8_t qfr[8][2], qlin[2];
        { const LAS unsigned char* qrow = qbuf + (k & 1) * 16384 + q * 1024;
#pragma unroll
          for (int h = 0; h < 8; ++h)
#pragma unroll
            for (int ks = 0; ks < 2; ++ks) qfr[h][ks] = *(const LAS bf16x8_t*)(qrow + (((h * 8 + ks * 4 + g) ^ q) * 16)); }
#pragma unroll
        for (int ks = 0; ks < 2; ++ks) { float f[8];
#pragma unroll
            for (int j = 0; j < 8; ++j) { float s = 0.f;
#pragma unroll
                for (int h = 0; h < 8; ++h) s += wq[h] * __uint_as_float((unsigned)(unsigned short)qfr[h][ks][j] << 16);
                f[j] = s; }
            v4u o; o.x = pk2(f[0], f[1]); o.y = pk2(f[2], f[3]); o.z = pk2(f[4], f[5]); o.w = pk2(f[6], f[7]); qlin[ks] = __builtin_bit_cast(bf16x8_t, o); }
#pragma unroll
        for (int i = 0; i < 8; ++i) hist[i * 512 + tid] = 0u;
        const bf16* kbase = KIN + ((size_t)b * SEQ + q) * 64 + g * 8;
        bf16x8_t afr[2][2], afn[2][2];
#pragma unroll
        for (int t = 0; t < 2; ++t)
#pragma unroll
            for (int ks = 0; ks < 2; ++ks) afn[t][ks] = *(const bf16x8_t*)(kbase + (size_t)(w * 32 + t * 16) * 64 + ks * 32);
        for (int s = 0, kb = w; kb < nkb; ++s, kb += 8) {
#pragma unroll
            for (int t = 0; t < 2; ++t)
#pragma unroll
                for (int ks = 0; ks < 2; ++ks) afr[t][ks] = afn[t][ks];
            if (kb + 8 < nkb) {
#pragma unroll
                for (int t = 0; t < 2; ++t)
#pragma unroll
                    for (int ks = 0; ks < 2; ++ks) afn[t][ks] = *(const bf16x8_t*)(kbase + (size_t)((kb + 8) * 32 + t * 16) * 64 + ks * 32); }
#pragma unroll
            for (int t = 0; t < 2; ++t) {
                f32x4_t sacc = f32x4_t{};
#pragma unroll
                for (int ks = 0; ks < 2; ++ks) sacc = __builtin_amdgcn_mfma_f32_16x16x32_bf16(afr[t][ks], qlin[ks], sacc, 0, 0, 0);
#pragma unroll
                for (int h = 0; h < 8; ++h) { f32x4_t d = f32x4_t{};
#pragma unroll
                    for (int ks = 0; ks < 2; ++ks) d = __builtin_amdgcn_mfma_f32_16x16x32_bf16(afr[t][ks], qfr[h][ks], d, 0, 0, 0);
#pragma unroll
                    for (int r = 0; r < 4; ++r) sacc[r] = fmaf(fabsf(d[r]), wq[h], sacc[r]); }
#pragma unroll
                for (int i = 0; i < 2; ++i) { unsigned k2[2];
#pragma unroll
                    for (int e = 0; e < 2; ++e) { const int r = 2 * i + e; unsigned kk_ = key15_of(sacc[r]); if (kb * 32 + t * 16 + 4 * g + r > qme) kk_ = 0u; k2[e] = kk_;
                        const unsigned dg = kk_ >> 10; (void)__hip_atomic_fetch_add((LAS unsigned*)&hist[(dg >> 2) * 512 + tid], 1u << ((dg & 3u) * 8u), __ATOMIC_RELAXED, __HIP_MEMORY_SCOPE_WORKGROUP); }
                    keys[(s * 4 + t * 2 + i) * 512 + tid] = k2[0] | (k2[1] << 16); }
            }
        }
        int need = 256, bsel;
        p3_merge(hist, tot, w, g, q, need, bsel);
        unsigned prefix = (unsigned)bsel;
#pragma unroll
        for (int pass = 0; pass < 2; ++pass) {
            const int sh_hi = pass == 0 ? 10 : 5, sh = pass == 0 ? 5 : 0;
#pragma unroll
            for (int i = 0; i < 8; ++i) hist[i * 512 + tid] = 0u;
#pragma unroll
            for (int s = 0; s < 8; ++s) if (w + 8 * s < nkb) {
#pragma unroll
                for (int i = 0; i < 4; ++i) { const unsigned d2 = keys[(s * 4 + i) * 512 + tid];
#pragma unroll
                    for (int e = 0; e < 2; ++e) { const unsigned kk_ = e ? (d2 >> 16) : (d2 & 0xffffu);
                        if ((kk_ >> sh_hi) == prefix) { const unsigned dg = (kk_ >> sh) & 31u; (void)__hip_atomic_fetch_add((LAS unsigned*)&hist[(dg >> 2) * 512 + tid], 1u << ((dg & 3u) * 8u), __ATOMIC_RELAXED, __HIP_MEMORY_SCOPE_WORKGROUP); } } } }
            p3_merge(hist, tot, w, g, q, need, bsel);
            prefix = (prefix << 5) | (unsigned)bsel;
        }
        const unsigned tau = prefix; const int need_eq = need;
        unsigned gtw[8], eqw[8];
#pragma unroll
        for (int s = 0; s < 8; ++s) { const int kb = w + 8 * s; gtw[s] = 0u; eqw[s] = 0u;
            if (kb < nkb) { unsigned gg = 0u, qq = 0u;
#pragma unroll
                for (int i = 0; i < 4; ++i) { const unsigned d2 = keys[(s * 4 + i) * 512 + tid];
#pragma unroll
                    for (int e = 0; e < 2; ++e) { const unsigned kk_ = e ? (d2 >> 16) : (d2 & 0xffffu); const int bit = (i >> 1) * 16 + 4 * g + (i & 1) * 2 + e;
                        gg |= (kk_ > tau ? 1u : 0u) << bit; qq |= (kk_ == tau ? 1u : 0u) << bit; } }
                gg |= (unsigned)__shfl_xor((int)gg, 16); gg |= (unsigned)__shfl_xor((int)gg, 32); qq |= (unsigned)__shfl_xor((int)qq, 16); qq |= (unsigned)__shfl_xor((int)qq, 32);
                gtw[s] = gg; eqw[s] = qq;
                if (g == 0) Tt[q * 64 + kb] = (unsigned char)__builtin_popcount(qq); } }
        __syncthreads();
        { unsigned run = 0u;
#pragma unroll
          for (int s = 0; s < 8; ++s) { const int kb = w + 8 * s;
            if (kb < nkb) { const unsigned g0 = *(const LAS unsigned*)(Tt + q * 64 + 8 * s), g1 = *(const LAS unsigned*)(Tt + q * 64 + 8 * s + 4);
                const unsigned m0 = w >= 4 ? g0 : (w == 0 ? 0u : (g0 & ((1u << (8 * w)) - 1u))), m1 = w > 4 ? (g1 & ((1u << (8 * (w - 4))) - 1u)) : 0u;
                const int pre = (int)(run + sad4(m0) + sad4(m1)), m = need_eq - pre, pc = __builtin_popcount(eqw[s]);
                unsigned se = eqw[s];
                if (m < pc) { se = 0u; unsigned x = eqw[s]; for (int i = 0; i < m; ++i) { const unsigned bb = x & (0u - x); se |= bb; x ^= bb; } }
                if (g == 0) Mb[kb * 2048 + qme] = gtw[s] | se;
                run += sad4(g0) + sad4(g1); } } }
        if (tid < (kb_hi - nkb) * 16) Mb[(nkb + (tid >> 4)) * 2048 + q0 + (tid & 15)] = 0u;
    }
    asm volatile("s_waitcnt vmcnt(0) lgkmcnt(0)" ::: "memory");
    __syncthreads();
#undef P3_ITEM
#undef P3_QDMA
}

namespace att {
using bf16x8 = __attribute__((ext_vector_type(8))) short;
using s16x4  = __attribute__((ext_vector_type(4))) short;
using u32x4  = __attribute__((ext_vector_type(4))) unsigned;
constexpr int KVBLK = 64;
constexpr size_t SHM_V = KVBLK * 128 * 2, SHM_K = KVBLK * 128 * 2;
constexpr int OFF_WS = 65536, OFF_MK = 65536 + 2048, OFF_Q = 65536 + 2048 + 8192, QPITCH = 272;
constexpr float THR2 = 11.5f;
#define KSWZ(row, colB) ((row) * 256 + ((colB) ^ (((row) & 7) << 4)))
#define SBAR() __builtin_amdgcn_sched_barrier(0)
__device__ __forceinline__ unsigned cvtpk(float lo, float hi) { unsigned r; asm volatile("v_cvt_pk_bf16_f32 %0, %1, %2" : "=v"(r) : "v"(lo), "v"(hi)); return r; }
__device__ __forceinline__ float msk(float p, unsigned w, int bit) { const int m = __builtin_amdgcn_sbfe((int)w, bit, 1); return __uint_as_float((__float_as_uint(p) & (unsigned)m) | (0xff800000u & ~(unsigned)m)); }
__device__ __forceinline__ void partialSM(f32x16& p0, f32x16& p1, unsigned w0, unsigned w1, float& m_reg, float& mn, float& alpha) {
#pragma unroll
  for (int r = 0; r < 16; ++r) { const int bit = (r & 3) + 8 * (r >> 2); p0[r] = msk(p0[r], w0, bit); p1[r] = msk(p1[r], w1, bit); }
  float pmax = p0[0];
#pragma unroll
  for (int r = 1; r < 16; ++r) pmax = fmaxf(pmax, p0[r]);
#pragma unroll
  for (int r = 0; r < 16; ++r) pmax = fmaxf(pmax, p1[r]);
  { auto rr = __builtin_amdgcn_permlane32_swap(__float_as_uint(pmax), __float_as_uint(pmax), false, false); pmax = fmaxf(__uint_as_float(rr[0]), __uint_as_float(rr[1])); }
  if (__builtin_expect(__all(pmax - m_reg <= THR2), 1)) { mn = m_reg; alpha = 1.f; }
  else { mn = fmaxf(m_reg, pmax); alpha = __builtin_amdgcn_exp2f(m_reg - mn); m_reg = mn; }
#pragma unroll
  for (int r = 0; r < 16; ++r) { p0[r] -= mn; p1[r] -= mn; }
#pragma unroll
  for (int r = 0; r < 16; ++r) p0[r] = __builtin_amdgcn_exp2f(p0[r]);
}
__device__ __forceinline__ void finishSM(f32x16& p0, f32x16& p1, float alpha, float& l_reg, bf16x8& pa0, bf16x8& pa1, bf16x8& pa2, bf16x8& pa3) {
#pragma unroll
  for (int r = 0; r < 16; ++r) p1[r] = __builtin_amdgcn_exp2f(p1[r]);
  float ps = 0;
#pragma unroll
  for (int r = 0; r < 16; ++r) ps += p0[r];
#pragma unroll
  for (int r = 0; r < 16; ++r) ps += p1[r];
  { auto rr = __builtin_amdgcn_permlane32_swap(__float_as_uint(ps), __float_as_uint(ps), false, false); ps = __uint_as_float(rr[0]) + __uint_as_float(rr[1]); }
  l_reg = l_reg * alpha + ps;
#define PK4(P, BASE, OUT) do { unsigned a0 = cvtpk(P[BASE + 0], P[BASE + 1]), a1 = cvtpk(P[BASE + 2], P[BASE + 3]);   \
    unsigned b0 = cvtpk(P[BASE + 4], P[BASE + 5]), b1 = cvtpk(P[BASE + 6], P[BASE + 7]);                              \
    auto r0 = __builtin_amdgcn_permlane32_swap(a0, b0, false, false); auto r1 = __builtin_amdgcn_permlane32_swap(a1, b1, false, false); \
    u32x4 w = {r0[0], r1[0], r0[1], r1[1]}; OUT = *reinterpret_cast<bf16x8*>(&w); } while (0)
  PK4(p0, 0, pa0); PK4(p0, 8, pa1); PK4(p1, 0, pa2); PK4(p1, 8, pa3);
#undef PK4
}
__device__ __forceinline__ void qkt(f32x16& p0, f32x16& p1, const char* Ks, const char* qrow, const float (&bo)[16], float kb0, float kb1, int r32, int hi) {
#pragma unroll
  for (int r = 0; r < 16; ++r) { p0[r] = bo[r] + kb0; p1[r] = bo[r] + kb1; }
#pragma unroll
  for (int d0 = 0; d0 < 8; ++d0) { const int cb = (d0 * 16 + hi * 8) * 2;
    const bf16x8 b0 = *reinterpret_cast<const bf16x8*>(Ks + KSWZ(r32, cb));
    const bf16x8 b1 = *reinterpret_cast<const bf16x8*>(Ks + KSWZ(32 + r32, cb));
    const bf16x8 qf = *reinterpret_cast<const bf16x8*>(qrow + d0 * 32);
    p0 = __builtin_amdgcn_mfma_f32_32x32x16_bf16(b0, qf, p0, 0, 0, 0);
    p1 = __builtin_amdgcn_mfma_f32_32x32x16_bf16(b1, qf, p1, 0, 0, 0); }
}
__device__ __forceinline__ int v_st(int k, int c) { const int kk = (k & ~0xC) | ((k & 4) << 1) | ((k & 8) >> 1); return ((kk >> 3) * 4 + (c >> 5)) * 512 + ((kk & 7) * 32 + (c & 31)) * 2; }
__device__ __forceinline__ int v_rd_base(int lane) { return ((lane & 3) << 3) | (((lane >> 2) & 3) << 6) | (((lane >> 4) & 1) << 5) | (((lane >> 5) & 1) << 8); }
constexpr int v_rd_off(int d0, int ks, int half) { return d0 * 512 + ks * 4096 + half * 2048; }
template <int OFF> __device__ __forceinline__ s16x4 tr_read(int vb) { s16x4 r; asm volatile("ds_read_b64_tr_b16 %0, %1 offset:%2" : "=&v"(r) : "v"(vb), "i"(OFF) : "memory"); return r; }
template <int D0> __device__ __forceinline__ void pv_one(f32x16& od, int vb, bf16x8 pa0, bf16x8 pa1, bf16x8 pa2, bf16x8 pa3) {
  const s16x4 l0 = tr_read<v_rd_off(D0, 0, 0)>(vb), h0 = tr_read<v_rd_off(D0, 0, 1)>(vb), l1 = tr_read<v_rd_off(D0, 1, 0)>(vb), h1 = tr_read<v_rd_off(D0, 1, 1)>(vb);
  const s16x4 l2 = tr_read<v_rd_off(D0, 2, 0)>(vb), h2 = tr_read<v_rd_off(D0, 2, 1)>(vb), l3 = tr_read<v_rd_off(D0, 3, 0)>(vb), h3 = tr_read<v_rd_off(D0, 3, 1)>(vb);
  asm volatile("s_waitcnt lgkmcnt(0)" ::: "memory"); SBAR();
#define PK(L, H) (bf16x8){L[0], L[1], L[2], L[3], H[0], H[1], H[2], H[3]}
  od = __builtin_amdgcn_mfma_f32_32x32x16_bf16(pa0, PK(l0, h0), od, 0, 0, 0);
  od = __builtin_amdgcn_mfma_f32_32x32x16_bf16(pa1, PK(l1, h1), od, 0, 0, 0);
  od = __builtin_amdgcn_mfma_f32_32x32x16_bf16(pa2, PK(l2, h2), od, 0, 0, 0);
  od = __builtin_amdgcn_mfma_f32_32x32x16_bf16(pa3, PK(l3, h3), od, 0, 0, 0);
#undef PK
}
__device__ __forceinline__ void pv_d0(f32x16* o, int vb, bf16x8 pa0, bf16x8 pa1, bf16x8 pa2, bf16x8 pa3) {
  pv_one<0>(o[0], vb, pa0, pa1, pa2, pa3); pv_one<1>(o[1], vb, pa0, pa1, pa2, pa3); pv_one<2>(o[2], vb, pa0, pa1, pa2, pa3); pv_one<3>(o[3], vb, pa0, pa1, pa2, pa3);
}
__device__ __forceinline__ void attn_item(const bf16* __restrict__ Qb, const bf16* __restrict__ Kh, const bf16* __restrict__ Vh, const unsigned* __restrict__ Mq, bf16* __restrict__ Ob, int NT, char* lds, LAS unsigned char* ldsL) {
  const int tid = threadIdx.x, wid = __builtin_amdgcn_readfirstlane(tid >> 6), lane = tid & 63, r32 = lane & 31, hi = lane >> 5;
  float* ws = (float*)(lds + OFF_WS) + wid * 64; float* li_l = ws; float* al_l = ws + 32;
  unsigned* mk = (unsigned*)(lds + OFF_MK);
  unsigned soff[4];
#pragma unroll
  for (int i = 0; i < 4; ++i) { const int pc = (wid & 3) * 4 + i;
    if (wid < 4) { const int row = pc * 4 + (lane >> 4), cb = (lane & 15) * 16; soff[i] = (unsigned)(row * 256 + (cb ^ ((row & 7) << 4))); }
    else { const int L = pc * 1024 + lane * 16, st = L >> 9, wi = L & 511, kk = (st >> 2) * 8 + (wi >> 6), c = (st & 3) * 32 + ((wi & 63) >> 1), k = (kk & ~0xC) | ((kk & 4) << 1) | ((kk & 8) >> 1);
           soff[i] = (unsigned)(k * 256 + c * 2); } }
  const char* gsrc = (const char*)(wid < 4 ? Kh : Vh);
  const unsigned ldst = (unsigned)((wid < 4 ? 0 : 16384) + (wid & 3) * 4096);
#define DMA_TILE(t, slot) do { _Pragma("unroll") for (int i_ = 0; i_ < 4; ++i_) \
    __builtin_amdgcn_global_load_lds((const unsigned*)(gsrc + (size_t)(t) * (64 * 256) + soff[i_]), (LAS unsigned*)(ldsL + (slot) * 32768 + ldst + i_ * 1024), 16, 0, 0); } while (0)
  DMA_TILE(0, 0);
  float m_reg = -1e30f, l_reg = 0; f32x16 o[4] = {}; bf16x8 qr[8];
  { const bf16* Qw = Qb + (size_t)r32 * 1024 + wid * 128 + hi * 8; float ss = 0.f;
#pragma unroll
    for (int d0 = 0; d0 < 8; ++d0) qr[d0] = *reinterpret_cast<const bf16x8*>(Qw + d0 * 16);
    unsigned mv[4];
#pragma unroll
    for (int i = 0; i < 4; ++i) { const int idx = tid + 512 * i; mv[i] = idx < NT * 64 ? Mq[(size_t)(idx >> 5) * 2048 + (idx & 31)] : 0u; }
#pragma unroll
    for (int i = 0; i < 4; ++i) { const int idx = tid + 512 * i; if (idx < NT * 64) mk[idx] = mv[i]; }
#pragma unroll
    for (int d0 = 0; d0 < 8; ++d0) ss += sumsq8(qr[d0]);
    ss = xhalf_sum(ss); const float rq = rsqrtf(ss * (1.f / 128.f) + EPS);
#pragma unroll
    for (int d0 = 0; d0 < 8; ++d0) { float f[8];
#pragma unroll
      for (int j = 0; j < 8; ++j) f[j] = __uint_as_float((unsigned)(unsigned short)qr[d0][j] << 16) * rq;
      u32x4 w = {cvtpk(f[0], f[1]), cvtpk(f[2], f[3]), cvtpk(f[4], f[5]), cvtpk(f[6], f[7])}; qr[d0] = *reinterpret_cast<bf16x8*>(&w); } }
  const float slope2 = __builtin_amdgcn_exp2f(-(float)(wid + 1)) * 1.4426950408889634f;
  float bo[16];
#pragma unroll
  for (int r = 0; r < 16; ++r) bo[r] = __uint_as_float(__builtin_amdgcn_readfirstlane(__float_as_uint(slope2 * (float)((r & 3) + 8 * (r >> 2)))));
  const float hoff = slope2 * (float)(4 * hi);
  const int vb0 = (int)(uintptr_t)(lds + 16384) + v_rd_base(lane);
  asm volatile("s_waitcnt vmcnt(0) lgkmcnt(0)\n\ts_barrier" ::: "memory");
  for (int j = 0; j < NT; ++j) {
    const int sl = j & 1;
    if (j + 1 < NT) DMA_TILE(j + 1, sl ^ 1);
    const char* Ks = lds + sl * 32768;
    const unsigned w0 = mk[(2 * j) * 32 + r32] >> (4 * hi), w1 = mk[(2 * j + 1) * 32 + r32] >> (4 * hi);
    f32x16 p0, p1;
    { const float kb0 = slope2 * (float)(j * 64) + hoff, kb1 = kb0 + slope2 * 32.f;
#pragma unroll
      for (int r = 0; r < 16; ++r) { p0[r] = bo[r] + kb0; p1[r] = bo[r] + kb1; }
      bf16x8 ka = *reinterpret_cast<const bf16x8*>(Ks + KSWZ(r32, hi * 16)), kb = *reinterpret_cast<const bf16x8*>(Ks + KSWZ(32 + r32, hi * 16));
#pragma unroll
      for (int d0 = 0; d0 < 8; ++d0) { bf16x8 na = ka, nb = kb;
        if (d0 < 7) { const int cb = ((d0 + 1) * 16 + hi * 8) * 2; na = *reinterpret_cast<const bf16x8*>(Ks + KSWZ(r32, cb)); nb = *reinterpret_cast<const bf16x8*>(Ks + KSWZ(32 + r32, cb)); }
        SBAR();
        p0 = __builtin_amdgcn_mfma_f32_32x32x16_bf16(ka, qr[d0], p0, 0, 0, 0);
        p1 = __builtin_amdgcn_mfma_f32_32x32x16_bf16(kb, qr[d0], p1, 0, 0, 0);
        SBAR();
        ka = na; kb = nb; } }
    float alpha; bf16x8 pa0, pa1, pa2, pa3;
    {
#pragma unroll
      for (int r = 0; r < 16; ++r) { const int bit = (r & 3) + 8 * (r >> 2); p0[r] = msk(p0[r], w0, bit); p1[r] = msk(p1[r], w1, bit); }
      float pmax = fmaxf(p0[0], p1[0]);
#pragma unroll
      for (int r = 1; r < 16; ++r) pmax = fmaxf(fmaxf(pmax, p0[r]), p1[r]);
      { auto rr = __builtin_amdgcn_permlane32_swap(__float_as_uint(pmax), __float_as_uint(pmax), false, false); pmax = fmaxf(__uint_as_float(rr[0]), __uint_as_float(rr[1])); }
      float mn;
      if (__builtin_expect(__all(pmax - m_reg <= THR2), 1)) { mn = m_reg; alpha = 1.f; }
      else { mn = fmaxf(m_reg, pmax); alpha = __builtin_amdgcn_exp2f(m_reg - mn); m_reg = mn; }
      float ps = 0.f;
#pragma unroll
      for (int r = 0; r < 16; ++r) { p0[r] = __builtin_amdgcn_exp2f(p0[r] - mn); p1[r] = __builtin_amdgcn_exp2f(p1[r] - mn); ps += p0[r] + p1[r]; }
      { auto rr = __builtin_amdgcn_permlane32_swap(__float_as_uint(ps), __float_as_uint(ps), false, false); ps = __uint_as_float(rr[0]) + __uint_as_float(rr[1]); }
      l_reg = l_reg * alpha + ps;
#define PK4(P, BASE, OUT) do { unsigned a0 = cvtpk(P[BASE + 0], P[BASE + 1]), a1 = cvtpk(P[BASE + 2], P[BASE + 3]);   \
    unsigned b0 = cvtpk(P[BASE + 4], P[BASE + 5]), b1 = cvtpk(P[BASE + 6], P[BASE + 7]);                              \
    auto r0 = __builtin_amdgcn_permlane32_swap(a0, b0, false, false); auto r1 = __builtin_amdgcn_permlane32_swap(a1, b1, false, false); \
    u32x4 w = {r0[0], r1[0], r0[1], r1[1]}; OUT = *reinterpret_cast<bf16x8*>(&w); } while (0)
      PK4(p0, 0, pa0); PK4(p0, 8, pa1); PK4(p1, 0, pa2); PK4(p1, 8, pa3);
#undef PK4
      if (__any(alpha < 1.f)) { if (hi == 0) al_l[r32] = alpha; asm volatile("s_waitcnt lgkmcnt(0)" ::: "memory");
#pragma unroll
        for (int d = 0; d < 4; ++d)
#pragma unroll
          for (int r = 0; r < 16; ++r) o[d][r] *= al_l[crow(r, hi)]; }
    }
    { const int vb = vb0 + sl * 32768;
      s16x4 lA[4], hA[4], lB[4], hB[4];
#define VREADS(L_, H_, D0) do { L_[0] = tr_read<v_rd_off(D0, 0, 0)>(vb); H_[0] = tr_read<v_rd_off(D0, 0, 1)>(vb); L_[1] = tr_read<v_rd_off(D0, 1, 0)>(vb); H_[1] = tr_read<v_rd_off(D0, 1, 1)>(vb); \
      L_[2] = tr_read<v_rd_off(D0, 2, 0)>(vb); H_[2] = tr_read<v_rd_off(D0, 2, 1)>(vb); L_[3] = tr_read<v_rd_off(D0, 3, 0)>(vb); H_[3] = tr_read<v_rd_off(D0, 3, 1)>(vb); } while (0)
#define PK(L, H) (bf16x8){L[0], L[1], L[2], L[3], H[0], H[1], H[2], H[3]}
#define VMMA(OD, L_, H_) do { OD = __builtin_amdgcn_mfma_f32_32x32x16_bf16(pa0, PK(L_[0], H_[0]), OD, 0, 0, 0); OD = __builtin_amdgcn_mfma_f32_32x32x16_bf16(pa1, PK(L_[1], H_[1]), OD, 0, 0, 0); \
      OD = __builtin_amdgcn_mfma_f32_32x32x16_bf16(pa2, PK(L_[2], H_[2]), OD, 0, 0, 0); OD = __builtin_amdgcn_mfma_f32_32x32x16_bf16(pa3, PK(L_[3], H_[3]), OD, 0, 0, 0); } while (0)
#define VWAIT(N, L_, H_) do { asm volatile("s_waitcnt lgkmcnt(" #N ")" : "+v"(L_[0]), "+v"(L_[1]), "+v"(L_[2]), "+v"(L_[3]), "+v"(H_[0]), "+v"(H_[1]), "+v"(H_[2]), "+v"(H_[3]) :: "memory"); SBAR(); } while (0)
      VREADS(lA, hA, 0); VREADS(lB, hB, 1);
      VWAIT(8, lA, hA); VMMA(o[0], lA, hA);
      VREADS(lA, hA, 2);
      VWAIT(8, lB, hB); VMMA(o[1], lB, hB);
      VREADS(lB, hB, 3);
      VWAIT(8, lA, hA); VMMA(o[2], lA, hA);
      VWAIT(0, lB, hB); VMMA(o[3], lB, hB);
#undef VREADS
#undef PK
#undef VMMA
#undef VWAIT
    }
    asm volatile("s_waitcnt vmcnt(0) lgkmcnt(0)\n\ts_barrier" ::: "memory");
  }
  if (hi == 0) li_l[r32] = l_reg; asm volatile("s_waitcnt lgkmcnt(0)" ::: "memory");
  float rli[16];
#pragma unroll
  for (int r = 0; r < 16; ++r) rli[r] = __builtin_amdgcn_rcpf(li_l[crow(r, hi)]);
  unsigned char* stg = (unsigned char*)(lds + wid * 4096);
#pragma unroll
  for (int r = 0; r < 16; ++r) { const int orow = crow(r, hi); const float sc16 = rli[r] * 16.f;
#pragma unroll
    for (int d0 = 0; d0 < 4; ++d0) stg[orow * 128 + d0 * 32 + r32] = (unsigned char)__builtin_amdgcn_cvt_pk_fp8_f32(o[d0][r] * sc16, 0.f, 0, false); }
  asm volatile("s_waitcnt lgkmcnt(0)" ::: "memory");
#pragma unroll
  for (int i = 0; i < 4; ++i) { const int row = i * 8 + (lane >> 3), ch = lane & 7; const u32x4 v = *(const u32x4*)(stg + row * 128 + ch * 16);
    *(u32x4*)((unsigned char*)Ob + (size_t)row * 2048 + wid * 128 + ch * 16) = v; }
#undef DMA_TILE
}
#undef KSWZ
#undef SBAR
}


namespace ret {
using bf16x8 = __attribute__((ext_vector_type(8))) short;
using s16x4  = __attribute__((ext_vector_type(4))) short;
using u32x4  = __attribute__((ext_vector_type(4))) unsigned;
using u32x2  = __attribute__((ext_vector_type(2))) unsigned;
constexpr int C = 64, QP = 272, KPI = 272, VP = 576;
constexpr int OFF_Q = 0, OFF_K = 17408, OFF_V = 34816, OFF_ST = 71680, OFF_Y = 75776;
typedef float f32x2_t __attribute__((ext_vector_type(2))); typedef __bf16 bf16x2_t __attribute__((ext_vector_type(2)));
__device__ __forceinline__ unsigned cvtpk(float lo, float hi) { const f32x2_t v = {lo, hi}; const bf16x2_t b = __builtin_convertvector(v, bf16x2_t); return __builtin_bit_cast(unsigned, b); }
template <int OFF> __device__ __forceinline__ s16x4 trr(int base) { s16x4 r; asm volatile("ds_read_b64_tr_b16 %0, %1 offset:%2" : "=&v"(r) : "v"(base), "i"(OFF) : "memory"); return r; }
__device__ __forceinline__ bf16x8 pk8(const f32x16& x, int s) { u32x4 w = {cvtpk(x[8 * s + 0], x[8 * s + 1]), cvtpk(x[8 * s + 2], x[8 * s + 3]), cvtpk(x[8 * s + 4], x[8 * s + 5]), cvtpk(x[8 * s + 6], x[8 * s + 7])}; return *reinterpret_cast<bf16x8*>(&w); }
__device__ __forceinline__ float silu_(float x) { return x * __builtin_amdgcn_rcpf(1.f + __builtin_amdgcn_exp2f(-1.4426950408889634f * x)); }
__device__ __forceinline__ void ret_item(int b, int h, const bf16* __restrict__ RQ, const bf16* __restrict__ RK, const bf16* __restrict__ RV, const bf16* __restrict__ RG, unsigned char* A2F8, const float* __restrict__ gnorm, char* lds, int c0, int c1, float* state) {
  const int tid = threadIdx.x, w = __builtin_amdgcn_readfirstlane(tid >> 6), lane = tid & 63, r32 = lane & 31, hi = lane >> 5;
  const float lg = __log2f(1.f - exp2f(-5.f - (float)h)), gC = exp2f(64.f * lg);
  char* Qs = lds + OFF_Q; char* Ks = lds + OFF_K; char* Vs = lds + OFF_V; float* st = (float*)(lds + OFF_ST); char* Ys = lds + OFF_Y;
  f32x16 S[4] = {};
  if (c0 > 0) {
#pragma unroll
    for (int dt = 0; dt < 4; ++dt)
#pragma unroll
      for (int r = 0; r < 16; ++r) S[dt][r] = state[(dt * 16 + r) * 512 + tid]; }
  const unsigned voffQ = (unsigned)(((tid >> 4) * 512 + (tid & 15) * 8) * 2), voffV = (unsigned)(((tid >> 5) * 1024 + (tid & 31) * 8) * 2);
  const int trq = (lane & 15) >> 2, trp = lane & 3, trg = (lane >> 4) & 1;
  const int vtb = (int)(uintptr_t)(lds + OFF_V) + (4 * hi + trq) * VP + (32 * w + 16 * trg + 4 * trp) * 2, ktb = (int)(uintptr_t)(lds + OFF_K) + (4 * hi + trq) * KPI + (16 * trg + 4 * trp) * 2;
  u32x4 pq[2], pk[2], pv[4];
#define RET_LOAD(cc) do { const size_t t0_ = (size_t)b * SEQ + (size_t)(cc) * C; const char* qb_ = (const char*)(RQ + t0_ * 512 + h * 128); const char* kb_ = (const char*)(RK + t0_ * 512 + h * 128); const char* vb_ = (const char*)(RV + t0_ * 1024 + h * 256); \
    _Pragma("unroll") for (int i = 0; i < 2; ++i) { pq[i] = *(const u32x4*)(qb_ + voffQ + i * 32768); pk[i] = *(const u32x4*)(kb_ + voffQ + i * 32768); } \
    _Pragma("unroll") for (int i = 0; i < 4; ++i) pv[i] = *(const u32x4*)(vb_ + voffV + i * 32768); } while (0)
#define RET_STAGE() do { \
    _Pragma("unroll") for (int i = 0; i < 2; ++i) { const int row = (tid >> 4) + 32 * i, ch = tid & 15; \
      *(u32x4*)(Qs + row * QP + ch * 16) = pq[i]; \
      const u32x4 kv = pk[i]; const float f = exp2f(lg * (float)(C - 1 - row)) * 0.08838834764831845f; \
      u32x4 ko; ko.x = cvtpk(pg8::bf_lo(kv.x) * f, pg8::bf_hi(kv.x) * f); ko.y = cvtpk(pg8::bf_lo(kv.y) * f, pg8::bf_hi(kv.y) * f); ko.z = cvtpk(pg8::bf_lo(kv.z) * f, pg8::bf_hi(kv.z) * f); ko.w = cvtpk(pg8::bf_lo(kv.w) * f, pg8::bf_hi(kv.w) * f); \
      *(u32x4*)(Ks + row * KPI + ch * 16) = ko; } \
    _Pragma("unroll") for (int i = 0; i < 4; ++i) { const int row = (tid >> 5) + 16 * i, ch = tid & 31; *(u32x4*)(Vs + row * VP + ch * 16) = pv[i]; } } while (0)
  RET_LOAD(c0);
  __syncthreads();
  RET_STAGE();
  if (c0 + 1 < c1) RET_LOAD(c0 + 1);
  __syncthreads();
  for (int c = c0; c < c1; ++c) {
    const size_t tok0 = (size_t)b * SEQ + (size_t)c * C;
    f32x16 ot[2] = {};
#pragma unroll
    for (int dt = 0; dt < 4; ++dt) {
#pragma unroll
      for (int s = 0; s < 2; ++s) { const bf16x8 af = pk8(S[dt], s);
#pragma unroll
        for (int nt = 0; nt < 2; ++nt) { const char* qp = Qs + (32 * nt + r32) * QP + (32 * dt + 16 * s + 4 * hi) * 2;
          const u32x2 lo = *(const u32x2*)qp, hi8 = *(const u32x2*)(qp + 16); const u32x4 bw = {lo.x, lo.y, hi8.x, hi8.y};
          ot[nt] = __builtin_amdgcn_mfma_f32_32x32x16_bf16(af, *reinterpret_cast<const bf16x8*>(&bw), ot[nt], 0, 0, 0); } }
      __builtin_amdgcn_sched_barrier(0); }
#pragma unroll
    for (int nt = 0; nt < 2; ++nt)
#pragma unroll
      for (int r = 0; r < 16; ++r) ot[nt][r] *= gC;
    __builtin_amdgcn_sched_barrier(0);
    bf16x8 vfr[4];
    { s16x4 vlo[4], vhi[4];
      vlo[0] = trr<0 * 16 * VP>(vtb); vhi[0] = trr<0 * 16 * VP + 8 * VP>(vtb); vlo[1] = trr<1 * 16 * VP>(vtb); vhi[1] = trr<1 * 16 * VP + 8 * VP>(vtb);
      vlo[2] = trr<2 * 16 * VP>(vtb); vhi[2] = trr<2 * 16 * VP + 8 * VP>(vtb); vlo[3] = trr<3 * 16 * VP>(vtb); vhi[3] = trr<3 * 16 * VP + 8 * VP>(vtb);
      asm volatile("s_waitcnt lgkmcnt(0)" : "+v"(vlo[0]), "+v"(vlo[1]), "+v"(vlo[2]), "+v"(vlo[3]), "+v"(vhi[0]), "+v"(vhi[1]), "+v"(vhi[2]), "+v"(vhi[3]) :: "memory"); __builtin_amdgcn_sched_barrier(0);
#pragma unroll
      for (int ks = 0; ks < 4; ++ks) vfr[ks] = (bf16x8){vlo[ks][0], vlo[ks][1], vlo[ks][2], vlo[ks][3], vhi[ks][0], vhi[ks][1], vhi[ks][2], vhi[ks][3]}; }
#pragma unroll
    for (int nt = 0; nt < 2; ++nt)
#pragma unroll
      for (int jt = 0; jt <= nt; ++jt) { f32x16 pt = {};
#pragma unroll
        for (int kk = 0; kk < 8; ++kk) { const bf16x8 ka = *(const bf16x8*)(Ks + (32 * jt + r32) * KPI + (16 * kk + 8 * hi) * 2), qb = *(const bf16x8*)(Qs + (32 * nt + r32) * QP + (16 * kk + 8 * hi) * 2);
          pt = __builtin_amdgcn_mfma_f32_32x32x16_bf16(ka, qb, pt, 0, 0, 0); }
        if (jt == nt) {
#pragma unroll
          for (int r = 0; r < 16; ++r) if (crow(r, hi) > r32) pt[r] = 0.f; }
#pragma unroll
        for (int s = 0; s < 2; ++s) ot[nt] = __builtin_amdgcn_mfma_f32_32x32x16_bf16(vfr[2 * jt + s], pk8(pt, s), ot[nt], 0, 0, 0);
        __builtin_amdgcn_sched_barrier(0); }
#pragma unroll
    for (int dt = 0; dt < 4; ++dt) {
#pragma unroll
      for (int r = 0; r < 16; ++r) S[dt][r] *= gC;
      s16x4 kl[4], kh[4];
      kl[0] = trr<0 * 16 * KPI>(ktb + dt * 64); kh[0] = trr<0 * 16 * KPI + 8 * KPI>(ktb + dt * 64); kl[1] = trr<1 * 16 * KPI>(ktb + dt * 64); kh[1] = trr<1 * 16 * KPI + 8 * KPI>(ktb + dt * 64);
      kl[2] = trr<2 * 16 * KPI>(ktb + dt * 64); kh[2] = trr<2 * 16 * KPI + 8 * KPI>(ktb + dt * 64); kl[3] = trr<3 * 16 * KPI>(ktb + dt * 64); kh[3] = trr<3 * 16 * KPI + 8 * KPI>(ktb + dt * 64);
      asm volatile("s_waitcnt lgkmcnt(0)" : "+v"(kl[0]), "+v"(kl[1]), "+v"(kl[2]), "+v"(kl[3]), "+v"(kh[0]), "+v"(kh[1]), "+v"(kh[2]), "+v"(kh[3]) :: "memory"); __builtin_amdgcn_sched_barrier(0);
#pragma unroll
      for (int ks = 0; ks < 4; ++ks) S[dt] = __builtin_amdgcn_mfma_f32_32x32x16_bf16((bf16x8){kl[ks][0], kl[ks][1], kl[ks][2], kl[ks][3], kh[ks][0], kh[ks][1], kh[ks][2], kh[ks][3]}, vfr[ks], S[dt], 0, 0, 0);
      __builtin_amdgcn_sched_barrier(0); }
    u32x4 gt4[4];
    { const char* gb_ = (const char*)(RG + tok0 * 1024 + h * 256);
#pragma unroll
      for (int i = 0; i < 4; ++i) gt4[i] = *(const u32x4*)(gb_ + voffV + i * 32768); }
#pragma unroll
    for (int nt = 0; nt < 2; ++nt) { const float rs = exp2f(lg * (float)(32 * nt + r32 + 1 - C)); float s1 = 0.f, s2 = 0.f;
#pragma unroll
      for (int r = 0; r < 16; ++r) { ot[nt][r] *= rs; s1 += ot[nt][r]; s2 += ot[nt][r] * ot[nt][r]; }
      s1 = xhalf_sum(s1); s2 = xhalf_sum(s2);
      if (hi == 0) { st[(w * 64 + 32 * nt + r32) * 2] = s1; st[(w * 64 + 32 * nt + r32) * 2 + 1] = s2; } }
    __syncthreads();
    if (c + 1 < c1) { RET_STAGE(); if (c + 2 < c1) RET_LOAD(c + 2); }
#pragma unroll
    for (int nt = 0; nt < 2; ++nt) { float s1 = 0.f, s2 = 0.f;
#pragma unroll
      for (int ww = 0; ww < 8; ++ww) { s1 += st[(ww * 64 + 32 * nt + r32) * 2]; s2 += st[(ww * 64 + 32 * nt + r32) * 2 + 1]; }
      const float mu = s1 * (1.f / 256.f), var = fmaxf(s2 * (1.f / 256.f) - mu * mu, 0.f), rstd = rsqrtf(var + EPS);
#pragma unroll
      for (int g = 0; g < 4; ++g) { float y[4];
#pragma unroll
        for (int j = 0; j < 4; ++j) y[j] = (ot[nt][4 * g + j] - mu) * rstd * gnorm[h * 256 + 32 * w + 8 * g + 4 * hi + j];
        const u32x2 o2 = {cvtpk(y[0], y[1]), cvtpk(y[2], y[3])};
        *(u32x2*)(Ys + (32 * nt + r32) * VP + (32 * w + 8 * g + 4 * hi) * 2) = o2; } }
    __syncthreads();
    { unsigned char* ob_ = A2F8 + tok0 * 1024 + h * 256;
#pragma unroll
      for (int i = 0; i < 4; ++i) { const int row = (tid >> 5) + 16 * i, ch = tid & 31;
        const u32x4 yv = *(const u32x4*)(Ys + row * VP + ch * 16); const u32x4 gt = gt4[i];
        int w0 = __builtin_amdgcn_cvt_pk_fp8_f32(pg8::bf_lo(yv.x) * silu_(pg8::bf_lo(gt.x)), pg8::bf_hi(yv.x) * silu_(pg8::bf_hi(gt.x)), 0, false); w0 = __builtin_amdgcn_cvt_pk_fp8_f32(pg8::bf_lo(yv.y) * silu_(pg8::bf_lo(gt.y)), pg8::bf_hi(yv.y) * silu_(pg8::bf_hi(gt.y)), w0, true);
        int w1 = __builtin_amdgcn_cvt_pk_fp8_f32(pg8::bf_lo(yv.z) * silu_(pg8::bf_lo(gt.z)), pg8::bf_hi(yv.z) * silu_(pg8::bf_hi(gt.z)), 0, false); w1 = __builtin_amdgcn_cvt_pk_fp8_f32(pg8::bf_lo(yv.w) * silu_(pg8::bf_lo(gt.w)), pg8::bf_hi(yv.w) * silu_(pg8::bf_hi(gt.w)), w1, true);
        *(unsigned long long*)(ob_ + (size_t)row * 1024 + ch * 8) = (unsigned long long)(unsigned)w0 | ((unsigned long long)(unsigned)w1 << 32); } }
  }
  if (c1 < SEQ / C) {
#pragma unroll
    for (int dt = 0; dt < 4; ++dt)
#pragma unroll
      for (int r = 0; r < 16; ++r) state[(dt * 16 + r) * 512 + tid] = S[dt][r]; }
  __syncthreads();
#undef RET_LOAD
#undef RET_STAGE
}
}

#define A2F8_PTR (F.xbp + (size_t)16 * MiB)
constexpr int RET_SPLIT = 28;
__device__ __forceinline__ int ret_wg_index(const Frame& F) { const int bx = (int)blockIdx.x, j = bx >> 3; return (j & 3) == 0 ? ((j >> 2) * 8 + (bx & 7)) : -1; }
__device__ __forceinline__ void p4_attn(Frame& F, const Args& a, unsigned char* lds_generic) {
    const size_t nt_ = (size_t)F.ntok;
    const bf16* QA = (const bf16*)(F.act + nt_ * O_QA); bf16* ATT = (bf16*)(F.act + nt_ * O_QA);
    unsigned char* aux = a.xb + nt_ * 2048;
    const bf16* KP = (const bf16*)(aux + nt_ * AUX_KP); const bf16* VV = (const bf16*)(aux + nt_ * AUX_VV); const unsigned* MASK = (const unsigned*)(aux + nt_ * AUX_MASK);
    volatile LAS unsigned* MISC = (volatile LAS unsigned*)(F.lds + MISC_OFF);
    unsigned* qctr = (unsigned*)(F.ws + WS_CTL) + CW_Q4;
    const bf16* RQ = (const bf16*)(F.act + nt_ * O_RQ); const bf16* RK = (const bf16*)(F.act + nt_ * O_RK); const bf16* RV = (const bf16*)(F.act + nt_ * O_RV); const bf16* RG = (const bf16*)(F.act + nt_ * O_RG);
    const int nb = F.ntok / SEQ, nret = nb * 4, nitems = nb * 64;
    { const int ri = ret_wg_index(F); if (ri >= 0 && ri < nret && RET_SPLIT < SEQ / 64)
        ret::ret_item(ri >> 2, ri & 3, RQ, RK, RV, RG, A2F8_PTR, a.in[8], (char*)lds_generic, RET_SPLIT, SEQ / 64, (float*)a.xb + (size_t)ri * 32768); }
    __syncthreads(); if (F.tid == 0) MISC[0] = atomicAdd(qctr, 1u); __syncthreads();
    int it = (int)MISC[0];
    while (it < nitems) {
        unsigned nxt_ = 0u; if (F.tid == 0) nxt_ = atomicAdd(qctr, 1u);
        const int qb = 63 - it / nb, b = it % nb, NT = (qb >> 1) + 1;
        const size_t row0 = (size_t)b * SEQ + qb * 32;
        att::attn_item(QA + row0 * 1024, KP + (size_t)b * SEQ * 128, VV + (size_t)b * SEQ * 128, MASK + (size_t)b * 64 * 2048 + qb * 32, ATT + row0 * 1024, NT, (char*)lds_generic, F.lds);
        __syncthreads(); if (F.tid == 0) MISC[0] = nxt_; __syncthreads();
        it = (int)MISC[0];
    }
}


__device__ __forceinline__ void p7_router(Frame& F, const Args& a) {
    const int lane = F.lane, r32 = lane & 31, hi = lane >> 5, tid = F.tid;
    unsigned char* mo = F.act; unsigned char* N2 = mo + MO_N2; unsigned char* meta = mo + MO_META;
    int* MB = (int*)(meta + MM_B); int* MPp = (int*)(meta + MM_P); float* MCL = (float*)(meta + MM_CL); float* MCH = (float*)(meta + MM_CH); float* MRS = (float*)(meta + MM_RS);
    const bf16* Wh = (const bf16*)(F.ws + WS_WR); const bf16* Wl = Wh + 32 * 1024;
    const float* g2 = a.in[12]; const float* b_gr = a.in[14]; const float* b_er = a.in[16];
    const bf16* hbase = (const bf16*)(F.act + MO_H16);
    unsigned* gcnt = (unsigned*)(F.ws + WS_CTL) + CW_MOE;
    LAS unsigned* lcnt = (LAS unsigned*)(F.lds + RING_OFF);
    if (tid < 64) lcnt[tid] = 0u;
    __syncthreads();
    const int ntasks = F.ntok / 32, tpw = ntasks / F.G;
    const int tw = F.wave & 3, kh = F.wave >> 2;
    const bool have = tw < tpw; const int t = (F.vcu * tpw + tw) * 32 + r32;
    LAS float* xch = (LAS float*)(F.lds + RING_OFF + 1024);
    int bucket = 0, posl = 0; float clo = 0.f, chi = 0.f, rstd = 0.f;
    f32x16 acc = f32x16{}; float ss = 0.f;
    if (have) {
        const bf16* hrow = hbase + (size_t)t * D + hi * 8 + kh * 512; unsigned char* nrow = N2 + (size_t)t * D + hi * 8 + kh * 512;
        const float* g2k = g2 + kh * 512 + hi * 8; const bf16* whk = Wh + (size_t)r32 * 1024 + kh * 512 + hi * 8; const bf16* wlk = Wl + (size_t)r32 * 1024 + kh * 512 + hi * 8;
#pragma unroll 8
        for (int kk = 0; kk < 32; ++kk) {
            const v4u hv = *(const v4u*)(hrow + kk * 16); const f32x4 a0 = {pg8::bf_lo(hv.x), pg8::bf_hi(hv.x), pg8::bf_lo(hv.y), pg8::bf_hi(hv.y)}, a1 = {pg8::bf_lo(hv.z), pg8::bf_hi(hv.z), pg8::bf_lo(hv.w), pg8::bf_hi(hv.w)};
            const f32x4 q0 = *(const f32x4*)(g2k + kk * 16), q1 = *(const f32x4*)(g2k + kk * 16 + 4);
            ss += (a0.x * a0.x + a0.y * a0.y) + (a0.z * a0.z + a0.w * a0.w) + (a1.x * a1.x + a1.y * a1.y) + (a1.z * a1.z + a1.w * a1.w);
            const float x[8] = {a0.x * q0.x, a0.y * q0.y, a0.z * q0.z, a0.w * q0.w, a1.x * q1.x, a1.y * q1.y, a1.z * q1.z, a1.w * q1.w};
            unsigned hb[8]; float lo[8];
#pragma unroll
            for (int j = 0; j < 8; ++j) { hb[j] = f2bf(x[j]); lo[j] = x[j] - __uint_as_float(hb[j] << 16); }
            v4u xh; xh.x = hb[0] | (hb[1] << 16); xh.y = hb[2] | (hb[3] << 16); xh.z = hb[4] | (hb[5] << 16); xh.w = hb[6] | (hb[7] << 16);
            v4u xl; xl.x = pk2(lo[0], lo[1]); xl.y = pk2(lo[2], lo[3]); xl.z = pk2(lo[4], lo[5]); xl.w = pk2(lo[6], lo[7]);
            { int w0 = __builtin_amdgcn_cvt_pk_fp8_f32(x[0], x[1], 0, false); w0 = __builtin_amdgcn_cvt_pk_fp8_f32(x[2], x[3], w0, true); int w1 = __builtin_amdgcn_cvt_pk_fp8_f32(x[4], x[5], 0, false); w1 = __builtin_amdgcn_cvt_pk_fp8_f32(x[6], x[7], w1, true);
              *(unsigned long long*)(nrow + kk * 16) = (unsigned long long)(unsigned)w0 | ((unsigned long long)(unsigned)w1 << 32); }
            const bf16x8_t wh = *(const bf16x8_t*)(whk + kk * 16), wl = *(const bf16x8_t*)(wlk + kk * 16);
            const bf16x8_t bh = __builtin_bit_cast(bf16x8_t, xh), bl = __builtin_bit_cast(bf16x8_t, xl);
            acc = __builtin_amdgcn_mfma_f32_32x32x16_bf16(wh, bh, acc, 0, 0, 0);
            acc = __builtin_amdgcn_mfma_f32_32x32x16_bf16(wh, bl, acc, 0, 0, 0);
            acc = __builtin_amdgcn_mfma_f32_32x32x16_bf16(wl, bh, acc, 0, 0, 0);
        }
        if (kh == 1) {
#pragma unroll
            for (int r = 0; r < 16; ++r) xch[(tw * 17 + r) * 64 + lane] = acc[r];
            xch[(tw * 17 + 16) * 64 + lane] = ss; }
    }
    __syncthreads();
    if (have && kh == 0) {
#pragma unroll
        for (int r = 0; r < 16; ++r) acc[r] += xch[(tw * 17 + r) * 64 + lane];
        ss += xch[(tw * 17 + 16) * 64 + lane];
        ss = xhalf_sum(ss); rstd = rsqrtf(ss * (1.f / D) + EPS);
        float L[24];
#pragma unroll
        for (int r = 0; r < 12; ++r) { const float v = acc[r]; auto rr = __builtin_amdgcn_permlane32_swap(__float_as_uint(v), __float_as_uint(v), false, false);
            L[(r & 3) + 8 * (r >> 2)] = __uint_as_float(rr[0]); L[(r & 3) + 8 * (r >> 2) + 4] = __uint_as_float(rr[1]); }
        float gl[4];
#pragma unroll
        for (int i = 0; i < 4; ++i) gl[i] = L[i] * rstd + b_gr[i];
        int g = 0; float gm = gl[0];
#pragma unroll
        for (int i = 1; i < 4; ++i) if (gl[i] > gm) { gm = gl[i]; g = i; }
        float se = 0.f;
#pragma unroll
        for (int i = 0; i < 4; ++i) se += __expf(gl[i] - gm);
        const float gw = 1.f / se;
        float el[4];
#pragma unroll
        for (int i = 0; i < 4; ++i) { const float l0 = L[4 + i], l1 = L[8 + i], l2 = L[12 + i], l3 = L[16 + i]; const float lv = g == 0 ? l0 : (g == 1 ? l1 : (g == 2 ? l2 : l3));
            const float b0 = b_er[i], b1 = b_er[4 + i], b2 = b_er[8 + i], b3 = b_er[12 + i]; el[i] = lv * rstd + (g == 0 ? b0 : (g == 1 ? b1 : (g == 2 ? b2 : b3))); }
        int i1 = 0; float v1 = el[0];
#pragma unroll
        for (int i = 1; i < 4; ++i) if (el[i] > v1) { v1 = el[i]; i1 = i; }
        int i2 = -1; float v2 = 0.f;
#pragma unroll
        for (int i = 0; i < 4; ++i) if (i != i1 && (i2 < 0 || el[i] > v2)) { v2 = el[i]; i2 = i; }
        const float e2 = __expf(v2 - v1), p1 = gw / (1.f + e2), p2 = gw * e2 / (1.f + e2);
        const int lo_ = i1 < i2 ? i1 : i2, hi_ = i1 < i2 ? i2 : i1;
        const int pair = lo_ == 0 ? (hi_ - 1) : (lo_ == 1 ? (hi_ + 1) : 5);
        bucket = g * 6 + pair; clo = i1 < i2 ? p1 : p2; chi = i1 < i2 ? p2 : p1;
        if (hi == 0) posl = (int)__hip_atomic_fetch_add(&lcnt[bucket], 1u, __ATOMIC_RELAXED, __HIP_MEMORY_SCOPE_WORKGROUP);
    }
    __syncthreads();
    if (tid < 24) lcnt[32 + tid] = atomicAdd(gcnt + tid, lcnt[tid]);
    __syncthreads();
    if (have && kh == 0 && hi == 0) { MB[t] = bucket; MPp[t] = (int)lcnt[32 + bucket] + posl; MCL[t] = clo; MCH[t] = chi; MRS[t] = rstd; }
}
__device__ __forceinline__ int moe_tiles(const unsigned* gcnt, int* rowstart  ) { int rs = 0;
    for (int b = 0; b < 24; ++b) { rowstart[b] = rs; rs += (int)((gcnt[b] + 255u) & ~255u); } rowstart[24] = rs; return rs >> 8; }
__device__ __forceinline__ void p8_permute(Frame& F, const Args& a) {
    unsigned char* mo = F.act; unsigned char* meta = mo + MO_META;
    const int* MB = (const int*)(meta + MM_B); const int* MPp = (const int*)(meta + MM_P); const float* MCL = (const float*)(meta + MM_CL); const float* MCH = (const float*)(meta + MM_CH); const float* MRS = (const float*)(meta + MM_RS);
    int* PTOK = (int*)(meta + MM_PTOK); float* PRS = (float*)(meta + MM_PRS); float* PCL = (float*)(meta + MM_PCL); float* PCH = (float*)(meta + MM_PCH);
    const unsigned* gcnt = (const unsigned*)(F.ws + WS_CTL) + CW_MOE;
    LAS int* rsL = (LAS int*)(F.lds + RING_OFF);
    if (F.tid == 0) { int rs = 0; for (int b = 0; b < 24; ++b) { rsL[b] = rs; rs += (int)((gcnt[b] + 255u) & ~255u); } rsL[24] = rs; }
    __syncthreads();
    const int gw = F.vcu * NWAVES + F.wave, NGW = F.G * NWAVES;
    const int gt = gw * 64 + F.lane, NGT = NGW * 64;
    for (int t = gt; t < F.ntok; t += NGT) { const int b = MB[t], prow = rsL[b] + MPp[t]; PTOK[prow] = t; PRS[prow] = MRS[t]; PCL[prow] = MCL[t]; PCH[prow] = MCH[t]; }
    for (int b = 0; b < 24; ++b) { const int c = (int)gcnt[b], p0 = rsL[b] + c, p1 = rsL[b + 1];
        for (int r = p0 + gt; r < p1; r += NGT) { PTOK[r] = -1; PRS[r] = 0.f; PCL[r] = 0.f; PCH[r] = 0.f; } }
}
template <bool GATHER_> struct MoeOrder {
    static constexpr bool GATHER = GATHER_; const int* ptok;
    int ntile, G, c; const char* A; size_t tA; const char* W; int mode; const LAS unsigned char* tb; size_t rowB;
    __device__ bool next(int i, pg8::Unit& u) const {
        const long L = (long)i * G + c; if (L >= (long)ntile * 4) return false;
        u.pm = (int)(L >> 2); u.pn = (int)(L & 3); u.a = GATHER_ ? A : A + (size_t)u.pm * tA;
        const int bk = tb[u.pm], g = bk / 6, pr = bk % 6; const int lo = pr < 3 ? 0 : (pr < 5 ? 1 : 2), hi = pr < 3 ? pr + 1 : (pr < 5 ? pr - 1 : 3);
        const int elo = g * 4 + lo, ehi = g * 4 + hi; u.aux = 0;
        if (mode == 1) { const int e = u.pn < 2 ? elo : ehi; u.b = W + ((size_t)e * 512 + (size_t)(u.pn & 1) * 256) * rowB; u.bjump = 0; }
        else { u.b = W + ((size_t)elo * 1024 + (size_t)u.pn * 256) * rowB; u.bjump = (long)(ehi - elo) * 1024 * (long)rowB - (long)rowB; }
        return true;
    }
    __device__ __forceinline__ void a_ready(const pg8::Unit&) const {}
    __device__ __forceinline__ void done(const pg8::Unit&) const {}
};
__device__ __forceinline__ float silu_f(float x) { return x * __builtin_amdgcn_rcpf(1.f + __builtin_amdgcn_exp2f(-1.4426950408889634f * x)); }
struct EpiMoe1 {
    static constexpr bool PERM = true, AFTER_DRAIN = false;
    unsigned char* ACT; const float* PRS; const float* PCL; const float* PCH;
    __device__ __forceinline__ void operator()(const pg8::f32x4 (&acc)[2][2][4][2], const pg8::Unit& u, int wr, int wc, int fr, int fq) const {
        const int row0 = u.pm * pg8::BM + wr * 64 + fr, slot = u.pn >> 1, fcol0 = slot * 256 + (u.pn & 1) * 128 + wc * 16 + 4 * fq; const float* PC = slot ? PCH : PCL;
#pragma unroll
        for (int ai = 0; ai < 2; ++ai)
#pragma unroll
            for (int m = 0; m < 4; ++m) { const int row = row0 + ai * pg8::HALF + m * 16; const float rs = PRS[row], cw = PC[row] * 16.f; unsigned char* rowp = ACT + (size_t)row * 512 + fcol0;
#pragma unroll
                for (int bj = 0; bj < 2; ++bj) { const pg8::f32x4 v0 = acc[ai][bj][m][0], v1 = acc[ai][bj][m][1];
                    const float a0 = silu_f(v0[0] * rs) * (v0[1] * rs) * cw, a1 = silu_f(v0[2] * rs) * (v0[3] * rs) * cw, a2 = silu_f(v1[0] * rs) * (v1[1] * rs) * cw, a3 = silu_f(v1[2] * rs) * (v1[3] * rs) * cw;
                    int w = __builtin_amdgcn_cvt_pk_fp8_f32(a0, a1, 0, false); w = __builtin_amdgcn_cvt_pk_fp8_f32(a2, a3, w, true); *(int*)(rowp + bj * 64) = w; } }
    }
};
struct EpiMoe2 {
    static constexpr bool PERM = false, AFTER_DRAIN = false;
    float* out; const pg8::bf16_t* h16; const int* PTOK;
    __device__ __forceinline__ void operator()(const pg8::f32x4 (&acc)[2][2][4][2], const pg8::Unit& u, int wr, int wc, int fr, int fq) const {
        const int row0 = u.pm * pg8::BM + wr * 64 + fr, col0 = u.pn * pg8::BM + wc * 32 + 4 * fq;
#pragma unroll
        for (int ai = 0; ai < 2; ++ai)
#pragma unroll
            for (int m = 0; m < 4; ++m) { const int tok = PTOK[row0 + ai * pg8::HALF + m * 16];
                if (tok >= 0) { float* rowp = out + (size_t)tok * 1024 + col0; const pg8::bf16_t* hp = h16 + (size_t)tok * 1024 + col0;
#pragma unroll
                    for (int bj = 0; bj < 2; ++bj)
#pragma unroll
                        for (int n = 0; n < 2; ++n) { const pg8::u32x2 hv = *(const pg8::u32x2*)(hp + bj * pg8::HALF + n * 16); const pg8::f32x4 hf = {pg8::bf_lo(hv.x), pg8::bf_hi(hv.x), pg8::bf_lo(hv.y), pg8::bf_hi(hv.y)};
                            *(pg8::f32x4*)(rowp + bj * pg8::HALF + n * 16) = hf + acc[ai][bj][m][n]; } } }
    }
};
__device__ __forceinline__ int moe_setup(Frame& F, LAS unsigned char* tb) {
    const unsigned* gcnt = (const unsigned*)(F.ws + WS_CTL) + CW_MOE;
    LAS int* nt_ = (LAS int*)(tb + 256);
    __syncthreads();
    if (F.tid == 0) { int tl = 0; for (int b = 0; b < 24; ++b) { const int n = (int)((gcnt[b] + 255u) >> 8); for (int i = 0; i < n; ++i) tb[tl + i] = (unsigned char)b; tl += n; } nt_[0] = tl; }
    __syncthreads();
    return nt_[0];
}

__global__ void __launch_bounds__(NWAVES * 64, 2) mk_fwd(Args args) {
    extern __shared__ __attribute__((aligned(16))) unsigned char lds[];
    Frame F;
    F.lds = (LAS unsigned char*)lds;
    F.tid = threadIdx.x; F.lane = F.tid & 63; F.wave = __builtin_amdgcn_readfirstlane(F.tid >> 6);
    F.G = gridDim.x; { const int bx = blockIdx.x; F.vcu = (F.G % 8 == 0) ? (bx % 8) * (F.G / 8) + bx / 8 : bx; }
    F.ntok = args.ntok; F.ws = args.ws; F.act = args.ws + WS_ACT; F.xbp = args.xb;
    const int lo = args.ph_lo, hi = args.ph_hi;
    cooperative_groups::grid_group grid = cooperative_groups::this_grid();
    volatile LAS unsigned* MISCW = (volatile LAS unsigned*)(F.lds + MISC_OFF);
    for (int u = F.tid; u < (LDS_BYTES - LDSCTL_OFF) / 4; u += NWAVES * 64) ((LAS unsigned*)(F.lds + LDSCTL_OFF))[u] = 0u;
    __syncthreads();
    XcdBarrier bar = xcd_barrier_post((unsigned*)(F.ws + WS_CTL) + CW_BAR, MISCW + 8);
#define IN(k) (lo <= (k) && (k) < hi)
#define SEAM(k) do { if (IN(k) && IN((k) + 1)) { xcd_barrier(bar); } } while (0)
    if (IN(0)) { p0_prologue(F, args); }
    SEAM(0);
    if (IN(1)) {
        EpiProj E{F.act, (size_t)F.ntok};
        { pg8::Gemm g{512, 512, 512, 8};
          P1Order S; S.nM = F.ntok / 256; S.nN = 25; S.nwg = S.nM * 25; S.G = F.G; S.c = (int)blockIdx.x; S.mode = 0; S.A = (const char*)(args.xb + (size_t)F.ntok * AUX_XB8); S.Bt = (const char*)(F.ws + WS_WIN8); S.tA = (size_t)256 * 1024; S.tB = (size_t)256 * 1024;
          pg8::gemm_phase<EpiProj, P1Order, true, true, true>(F.lds + RING_OFF, g, S, E); }
        { pg8::Gemm g{1024, 1024, 1024, 16};
          P1Order S; S.nM = F.ntok / 256; S.nN = 3; S.nwg = S.nM * 3; S.G = F.G; S.c = ((int)blockIdx.x + F.G / 2) % F.G; S.mode = 1; S.A = (const char*)args.xb; S.Bt = (const char*)(F.ws + WS_WIN); S.tA = (size_t)256 * 2048; S.tB = (size_t)256 * 2048;
          pg8::gemm_phase<EpiProj, P1Order, true, true, false>(F.lds + RING_OFF, g, S, E); }
    }
    SEAM(1);
    if (IN(2)) { p2_post(F, args); }
    SEAM(2);
    if (IN(3)) {
        const int ri = ret_wg_index(F), nret = (F.ntok / SEQ) * 4;
        if (ri < 0) p3_index(F, args);
        else if (ri < nret) { const size_t nt_ = (size_t)F.ntok;
            ret::ret_item(ri >> 2, ri & 3, (const bf16*)(F.act + nt_ * O_RQ), (const bf16*)(F.act + nt_ * O_RK), (const bf16*)(F.act + nt_ * O_RV), (const bf16*)(F.act + nt_ * O_RG), A2F8_PTR, args.in[8], (char*)lds, 0, RET_SPLIT, (float*)args.xb + (size_t)ri * 32768); }
    }
    SEAM(3);
    if (IN(4)) { p4_attn(F, args, lds); }
    SEAM(4);
    if (IN(5)) {
        const size_t nt_ = (size_t)F.ntok;
        pg8::bf16_t* GA = (pg8::bf16_t*)(F.act + nt_ * O_GA); const pg8::bf16_t* GR = (const pg8::bf16_t*)(F.act + nt_ * O_GR);
        { pg8::Gemm g{512, 1024, 512, 8, 122, 123};
          pg8::StaticOrder S; S.init(F.ntok, 1024, F.G, (int)blockIdx.x, F.act + nt_ * O_QA, 1024, F.ws + WS_WATT8, 512); EpiGateA E{GA};
          pg8::gemm_phase<EpiGateA, pg8::StaticOrder, true, true, true>(F.lds + RING_OFF, g, S, E); }
        { pg8::Gemm g{512, 512, 512, 8, 122, 127};
          pg8::StaticOrder S; S.init(F.ntok, 1024, F.G, (int)blockIdx.x, A2F8_PTR, 512, F.ws + WS_WRET8, 512); EpiGateB E{GA, GR, F.act + nt_ * O_MIX8};
          pg8::gemm_phase<EpiGateB, pg8::StaticOrder, true, true, true>(F.lds + RING_OFF, g, S, E); }
    }
    SEAM(5);
    if (IN(6)) {
        pg8::Gemm g{512, 512, 512, 8, 122, 124}; const size_t nt_ = (size_t)F.ntok;
        pg8::StaticOrder S; S.init(F.ntok, 1024, F.G, (int)blockIdx.x, F.act + nt_ * O_MIX8, 512, F.ws + WS_WOUT8, 512);
        EpiResid E{args.in[0] + (size_t)args.tok0 * D, (pg8::bf16_t*)(F.act + MO_H16)};
        pg8::gemm_phase<EpiResid, pg8::StaticOrder, true, true, true>(F.lds + RING_OFF, g, S, E);
    }
    SEAM(6);
    if (IN(7)) { p7_router(F, args); }
    SEAM(7);
    if (IN(8)) { p8_permute(F, args); }
    SEAM(8);
    if (IN(9)) {
        LAS unsigned char* tb = F.lds + LDSCTL_OFF - 1024; const int ntile = moe_setup(F, tb);
        unsigned char* meta = F.act + MO_META;
        pg8::Gemm g{512, 512, 512, 8, 122, 127};
        MoeOrder<true> S{(const int*)(meta + MM_PTOK), ntile, F.G, (int)blockIdx.x, (const char*)(F.act + MO_N2), (size_t)0, (const char*)(F.ws + WS_W18), 1, tb, (size_t)1024};
        EpiMoe1 E{(unsigned char*)(F.act + MO_ACT), (const float*)(meta + MM_PRS), (const float*)(meta + MM_PCL), (const float*)(meta + MM_PCH)};
        pg8::gemm_phase<EpiMoe1, MoeOrder<true>, true, true, true>(F.lds + RING_OFF, g, S, E);
    }
    SEAM(9);
    if (IN(10)) {
        LAS unsigned char* tb = F.lds + LDSCTL_OFF - 1024; const int ntile = moe_setup(F, tb);
        unsigned char* meta = F.act + MO_META;
        pg8::Gemm g{256, 256, 128, 2, 123, 123};
        MoeOrder<false> S{nullptr, ntile, F.G, (int)blockIdx.x, (const char*)(F.act + MO_ACT), (size_t)256 * 512, (const char*)(F.ws + WS_WD8), 2, tb, (size_t)256};
        EpiMoe2 E{args.out + (size_t)args.tok0 * D, (const pg8::bf16_t*)(F.act + MO_H16), (const int*)(meta + MM_PTOK)};
        pg8::gemm_phase<EpiMoe2, MoeOrder<false>, true, true, true>(F.lds + RING_OFF, g, S, E);
    }
    if (hi - lo > 1) grid.sync();
#undef IN
#undef SEAM
}

__device__ __forceinline__ float block_sum256(float v, float* red) {
#pragma unroll
    for (int o = 32; o > 0; o >>= 1) v += __shfl_xor(v, o);
    __syncthreads();
    if ((threadIdx.x & 63) == 0) red[threadIdx.x >> 6] = v;
    __syncthreads();
    return red[0] + red[1] + red[2] + red[3];
}
__device__ __forceinline__ float block_max256(float v, float* red) {
#pragma unroll
    for (int o = 32; o > 0; o >>= 1) v = fmaxf(v, __shfl_xor(v, o));
    __syncthreads();
    if ((threadIdx.x & 63) == 0) red[threadIdx.x >> 6] = v;
    __syncthreads();
    return fmaxf(fmaxf(red[0], red[1]), fmaxf(red[2], red[3]));
}
__device__ __forceinline__ float sigmoidf_(float x) { return 1.f / (1.f + expf(-x)); }
__device__ __forceinline__ float siluf_(float x) { return x / (1.f + expf(-x)); }

__global__ void __launch_bounds__(256) nv_rmsnorm(const float* inb, long in_ld, float* outb, long out_ld, int ninner, int width, const float* gain, int gstride) {
    __shared__ float red[8];
    const int r = blockIdx.x, t = r / ninner, i = r % ninner;
    const float* in = inb + (long)t * in_ld + (long)i * width;
    float* out = outb + (long)t * out_ld + (long)i * width;
    float s = 0.f;
    for (int c = threadIdx.x; c < width; c += 256) { const float v = in[c]; s += v * v; }
    s = block_sum256(s, red);
    const float rs = rsqrtf(s / (float)width + EPS);
    for (int c = threadIdx.x; c < width; c += 256) out[c] = in[c] * rs * gain[i * gstride + c];
}
__global__ void __launch_bounds__(256) nv_gemm(const float* A, long lda, const float* B, long ldb, float* C, long ldc, int M, int N, int K) {
    __shared__ float As[8][128 + 4];
    __shared__ float Bs[8][128 + 4];
    const int tid = threadIdx.x, tx = tid & 15, ty = tid >> 4;
    const int m0 = blockIdx.y * 128, n0 = blockIdx.x * 128;
    float acc[8][8];
#pragma unroll
    for (int i = 0; i < 8; ++i)
#pragma unroll
        for (int j = 0; j < 8; ++j) acc[i][j] = 0.f;
    for (int k0 = 0; k0 < K; k0 += 8) {
        { const int r = tid >> 1, kk = (tid & 1) * 4;
          const float4 v = *(const float4*)(A + (long)(m0 + r) * lda + k0 + kk);
          As[kk + 0][r] = v.x; As[kk + 1][r] = v.y; As[kk + 2][r] = v.z; As[kk + 3][r] = v.w; }
        { const int kk = tid >> 5, c = (tid & 31) * 4;
#pragma unroll
          for (int j = 0; j < 4; ++j) { const int n = n0 + c + j; Bs[kk][c + j] = (n < N) ? B[(long)(k0 + kk) * ldb + n] : 0.f; } }
        __syncthreads();
#pragma unroll
        for (int kk = 0; kk < 8; ++kk) {
            float a[8], b[8];
#pragma unroll
            for (int i = 0; i < 8; ++i) a[i] = As[kk][ty * 8 + i];
#pragma unroll
            for (int j = 0; j < 8; ++j) b[j] = Bs[kk][tx * 8 + j];
#pragma unroll
            for (int i = 0; i < 8; ++i)
#pragma unroll
                for (int j = 0; j < 8; ++j) acc[i][j] += a[i] * b[j];
        }
        __syncthreads();
    }
#pragma unroll
    for (int i = 0; i < 8; ++i)
#pragma unroll
        for (int j = 0; j < 8; ++j) { const int n = n0 + tx * 8 + j; if (n < N) C[(long)(m0 + ty * 8 + i) * ldc + n] = acc[i][j]; }
}
__global__ void __launch_bounds__(256) nv_attn(const float* proj, const float* kv, float* att, float wscale, float dscale, float lscale, const unsigned* maskb) {
    __shared__ float s_qi[512], s_w[8], s_score[2048], s_q[1024], s_p[8][256], red[8];
    __shared__ int s_sel[256 + 64]; __shared__ int s_pref[65]; __shared__ unsigned s_mw[64];
    const int tq = blockIdx.x, b = tq / SEQ, t = tq % SEQ, tid = threadIdx.x;
    const float* prow = proj + (long)tq * INW;
    const float* pb = proj + (long)b * SEQ * INW;
    const float* kvb = kv + (long)b * SEQ * 256;
    for (int i = tid; i < 512; i += 256) s_qi[i] = prow[C_QI + i];
    for (int i = tid; i < 1024; i += 256) s_q[i] = prow[C_QA + i];
    if (tid < 8) s_w[tid] = prow[C_WI + tid] * wscale;
    __syncthreads();
    const int n = t + 1;
    int cnt;
    if (maskb) {
        if (tid < 64) s_mw[tid] = (tid * 32 <= t) ? maskb[tid * 2048 + t] : 0u;
        __syncthreads();
        if (tid == 0) { int c = 0; for (int i = 0; i < 64; ++i) { s_pref[i] = c; c += __builtin_popcount(s_mw[i]); } s_pref[64] = c; }
        __syncthreads();
        if (tid < 64) { unsigned x = s_mw[tid]; int p = s_pref[tid]; while (x) { const int bpos = __builtin_ctz(x); x &= x - 1; if (p < 256) s_sel[p] = tid * 32 + bpos; ++p; } }
        cnt = s_pref[64] < 256 ? s_pref[64] : 256;
        __syncthreads();
    } else {
    for (int s = tid; s < n; s += 256) {
        const float* kr = pb + (long)s * INW + C_KI;
        float kk[64];
#pragma unroll
        for (int d = 0; d < 64; ++d) kk[d] = kr[d];
        float sc = 0.f;
#pragma unroll
        for (int h = 0; h < 8; ++h) {
            float dt = 0.f;
#pragma unroll
            for (int d = 0; d < 64; ++d) dt += s_qi[h * 64 + d] * kk[d];
            dt *= dscale;
            sc += fmaxf(dt, 0.f) * s_w[h];
        }
        s_score[s] = sc;
    }
    __syncthreads();
    if (n <= 256) { if (tid < n) s_sel[tid] = tid; cnt = n; }
    else {
        for (int s = tid; s < n; s += 256) {
            const float v = s_score[s]; int rank = 0;
            for (int j = 0; j < n; ++j) { const float u = s_score[j]; rank += (u > v || (u == v && j < s)) ? 1 : 0; }
            if (rank < 256) s_sel[rank] = s;
        }
        cnt = 256;
    }
    __syncthreads();
    }
    float lg[8];
    const bool act = tid < cnt;
    const int sj = act ? s_sel[tid] : 0;
    {
        const float* kr = kvb + (long)sj * 256;
#pragma unroll
        for (int h = 0; h < 8; ++h) lg[h] = 0.f;
        for (int d = 0; d < 128; ++d) { const float kd = kr[d];
#pragma unroll
            for (int h = 0; h < 8; ++h) lg[h] += s_q[h * 128 + d] * kd; }
    }
#pragma unroll
    for (int h = 0; h < 8; ++h) {
        const float slope = exp2f(-(float)(h + 1));
        float x = act ? (lg[h] * lscale - slope * (float)(t - sj)) : -INFINITY;
        const float m = block_max256(x, red);
        const float e = act ? expf(x - m) : 0.f;
        const float su = block_sum256(e, red);
        s_p[h][tid] = e / su;
    }
    __syncthreads();
    float o4[4] = {0.f, 0.f, 0.f, 0.f};
    for (int j = 0; j < cnt; ++j) {
        const float* vr = kvb + (long)s_sel[j] * 256 + 128;
#pragma unroll
        for (int i = 0; i < 4; ++i) { const int o = tid + 256 * i; o4[i] += s_p[o >> 7][j] * vr[o & 127]; }
    }
#pragma unroll
    for (int i = 0; i < 4; ++i) att[(long)tq * 1024 + tid + 256 * i] = o4[i];
}
__global__ void __launch_bounds__(256) nv_ret(const float* proj, float* reto) {
    __shared__ float sq[128], sk[128];
    const int b = blockIdx.x >> 2, h = blockIdx.x & 3, v = threadIdx.x;
    const float gamma = 1.f - exp2f(-5.f - (float)h);
    float S[128];
#pragma unroll
    for (int d = 0; d < 128; ++d) S[d] = 0.f;
    for (int t = 0; t < SEQ; ++t) {
        const float* row = proj + (long)(b * SEQ + t) * INW;
        if (v < 128) { sq[v] = row[C_RQ + h * 128 + v]; sk[v] = row[C_RK + h * 128 + v] * 0.08838834764831845f; }
        __syncthreads();
        const float vv = row[C_RV + h * 256 + v];
        float o = 0.f;
#pragma unroll
        for (int d = 0; d < 128; ++d) { S[d] = gamma * S[d] + sk[d] * vv; o += sq[d] * S[d]; }
        reto[(long)(b * SEQ + t) * 1024 + h * 256 + v] = o;
        __syncthreads();
    }
}
__global__ void __launch_bounds__(256) nv_retpost(const float* proj, const float* reto, const float* g, float* a2) {
    __shared__ float red[8];
    const int t = blockIdx.x >> 2, h = blockIdx.x & 3, c = threadIdx.x;
    const float x = reto[(long)t * 1024 + h * 256 + c];
    const float mu = block_sum256(x, red) * (1.f / 256.f);
    const float dv = x - mu;
    const float var = block_sum256(dv * dv, red) * (1.f / 256.f);
    const float y = dv * rsqrtf(var + EPS) * g[h * 256 + c];
    a2[(long)t * 1024 + h * 256 + c] = siluf_(proj[(long)t * INW + C_RG + h * 256 + c]) * y;
}
__global__ void __launch_bounds__(256) nv_mix(const float* proj, const float* ya, const float* yr, float* mix) {
    const long i = (long)blockIdx.x * 256 + threadIdx.x; const long t = i >> 10; const int c = (int)(i & 1023);
    mix[i] = sigmoidf_(proj[t * INW + C_GA + c]) * ya[i] + sigmoidf_(proj[t * INW + C_GR + c]) * yr[i];
}
__global__ void __launch_bounds__(256) nv_add(const float* a, const float* b, float* o) {
    const long i = (long)blockIdx.x * 256 + threadIdx.x; o[i] = a[i] + b[i];
}
__global__ void __launch_bounds__(256) nv_moe(const float* n2, float* hio, const float* wgr, const float* bgr, const float* wer, const float* ber,
                                              const float* wg, const float* wu, const float* wd) {
    __shared__ float s_n[1024], s_lg[20], s_act[256], s_p[2];
    __shared__ int s_e[2];
    const int t = blockIdx.x, tid = threadIdx.x;
    for (int i = tid; i < 1024; i += 256) s_n[i] = n2[(long)t * 1024 + i];
    __syncthreads();
    if (tid < 20) {
        float a = 0.f;
        if (tid < 4) { for (int d = 0; d < 1024; ++d) a += s_n[d] * wgr[d * 4 + tid]; a += bgr[tid]; }
        else { const int e = tid - 4; for (int d = 0; d < 1024; ++d) a += s_n[d] * wer[d * 16 + e]; a += ber[e]; }
        s_lg[tid] = a;
    }
    __syncthreads();
    if (tid == 0) {
        int g = 0; float m = s_lg[0];
        for (int i = 1; i < 4; ++i) if (s_lg[i] > m) { m = s_lg[i]; g = i; }
        float se = 0.f; for (int i = 0; i < 4; ++i) se += expf(s_lg[i] - m);
        const float gw = 1.f / se;
        const float* el = s_lg + 4 + g * 4;
        int i1 = 0; for (int i = 1; i < 4; ++i) if (el[i] > el[i1]) i1 = i;
        int i2 = -1; for (int i = 0; i < 4; ++i) if (i != i1 && (i2 < 0 || el[i] > el[i2])) i2 = i;
        const float e2 = expf(el[i2] - el[i1]);
        s_p[0] = gw / (1.f + e2); s_p[1] = gw * e2 / (1.f + e2);
        s_e[0] = g * 4 + i1; s_e[1] = g * 4 + i2;
    }
    __syncthreads();
    float acc[4] = {0.f, 0.f, 0.f, 0.f};
    for (int sl = 0; sl < 2; ++sl) {
        const int e = s_e[sl]; const float p = s_p[sl];
        const float* g_ = wg + (long)e * 1024 * 256 + tid; const float* u_ = wu + (long)e * 1024 * 256 + tid;
        float hg = 0.f, hu = 0.f;
        for (int d = 0; d < 1024; ++d) { hg += s_n[d] * g_[(long)d * 256]; hu += s_n[d] * u_[(long)d * 256]; }
        __syncthreads();
        s_act[tid] = siluf_(hg) * hu * p;
        __syncthreads();
        const float* d_ = wd + (long)e * 256 * 1024;
        for (int f = 0; f < 256; ++f) { const float a = s_act[f];
#pragma unroll
            for (int i = 0; i < 4; ++i) acc[i] += a * d_[(long)f * 1024 + tid + 256 * i]; }
    }
#pragma unroll
    for (int i = 0; i < 4; ++i) hio[(long)t * 1024 + tid + 256 * i] += acc[i];
}
__global__ void __launch_bounds__(256) ad_proj(const unsigned char* act, int ntok, int tok_lo, float* PROJ) {
    const int t = blockIdx.x; const size_t tg = (size_t)(tok_lo + t); const size_t nt = (size_t)ntok;
    const bf16* QA = (const bf16*)(act + nt * O_QA) + tg * 1024; const bf16* CKV = (const bf16*)(act + nt * O_CKV) + tg * 256; const bf16* QI = (const bf16*)(act + nt * O_QI) + tg * 512;
    const bf16* KW = (const bf16*)(act + nt * O_KW) + tg * 128; const bf16* RQ = (const bf16*)(act + nt * O_RQ) + tg * 512; const bf16* RK = (const bf16*)(act + nt * O_RK) + tg * 512;
    const bf16* R4 = (const bf16*)(act + nt * O_RV);
    float* o = PROJ + (size_t)t * INW;
    for (int c = threadIdx.x; c < INW; c += 256) {
        bf16 v;
        if (c < C_CKV) v = QA[c]; else if (c < C_QI) v = CKV[c - C_CKV]; else if (c < C_KI) v = QI[c - C_QI]; else if (c < C_RQ) v = KW[c - C_KI];
        else if (c < C_RK) v = RQ[c - C_RQ]; else if (c < C_RV) v = RK[c - C_RK];
        else { const int cc = c - C_RV; v = R4[(size_t)(cc >> 10) * nt * 1024 + tg * 1024 + (cc & 1023)]; }
        o[c] = bf2f(v);
    }
}


__global__ void __launch_bounds__(256) ad_kv(const unsigned char* aux, int ntok, int tok_lo, float* KV, float* PROJ) {
    const int t = blockIdx.x; const size_t tg = (size_t)(tok_lo + t); const size_t nt = (size_t)ntok; const int c = threadIdx.x;
    const bf16* KP = (const bf16*)(aux + nt * AUX_KP) + tg * 128; const bf16* VV = (const bf16*)(aux + nt * AUX_VV) + tg * 128; const bf16* KIN = (const bf16*)(aux + nt * AUX_KIN) + tg * 64;
    KV[(size_t)t * 256 + c] = bf2f(c < 128 ? KP[c] : VV[c - 128]);
    if (c < 64) PROJ[(size_t)t * INW + C_KI + c] = bf2f(KIN[c]);
}
__global__ void __launch_bounds__(256) nv_fill(float* p, float v, int n) { const int i = blockIdx.x * 256 + threadIdx.x; if (i < n) p[i] = v; }


__global__ void __launch_bounds__(256) ad_att(const unsigned char* act, int ntok, int tok_lo, float* ATT) {
    const int t = blockIdx.x; const bf16* A = (const bf16*)(act + (size_t)ntok * O_QA) + (size_t)(tok_lo + t) * 1024;
    for (int c = threadIdx.x; c < 1024; c += 256) ATT[(size_t)t * 1024 + c] = bf2f(A[c]);
}


__global__ void __launch_bounds__(256) ad_a2(const unsigned char* act, int ntok, int tok_lo, float* A2) {
    const int t = blockIdx.x; const bf16* A = (const bf16*)(act + (size_t)ntok * O_RV) + (size_t)(tok_lo + t) * 1024;
    for (int c = threadIdx.x; c < 1024; c += 256) A2[(size_t)t * 1024 + c] = bf2f(A[c]);
}

static void gemm(hipStream_t st, const float* A, long lda, const float* B, long ldb, float* C, long ldc, int M, int N, int K) {
    hipLaunchKernelGGL(nv_gemm, dim3((N + 127) / 128, M / 128), dim3(256), 0, st, A, lda, B, ldb, C, ldc, M, N, K);
}

extern "C" void kernel_launch(void* const* d_in, const int* in_sizes, int n_in, void* d_out, int out_size, void* d_ws, size_t ws_size, hipStream_t stream) {
    static int grid = 0;
    if (grid == 0) {
        int dev = 0, cus = 0, per_cu = 0;
        (void)hipGetDevice(&dev); (void)hipDeviceGetAttribute(&cus, hipDeviceAttributeMultiprocessorCount, dev);
        if (hipFuncSetAttribute((const void*)mk_fwd, hipFuncAttributeMaxDynamicSharedMemorySize, LDS_BYTES) != hipSuccess) { fprintf(stderr, "kernel_launch: hipFuncSetAttribute failed\n"); grid = -1; return; }
        (void)hipOccupancyMaxActiveBlocksPerMultiprocessor(&per_cu, (const void*)mk_fwd, NWAVES * 64, LDS_BYTES);
        (void)hipGetLastError();
        if (per_cu < 1) { fprintf(stderr, "kernel_launch: occupancy query says %d blocks per CU\n", per_cu); per_cu = 1; }
        grid = cus * per_cu;
        if (n_in != 20 || ws_size < (size_t)512 * MiB) { fprintf(stderr, "kernel_launch: unexpected n_in %d / ws_size %zu\n", n_in, ws_size); grid = -1; return; }
    }
    if (grid < 0) return;
    const float* x = (const float*)d_in[0];
    const float* kv_norm_g = (const float*)d_in[3]; const float* w_kv_up = (const float*)d_in[4]; const float* q_norm_g = (const float*)d_in[5];
    const float* k_norm_g = (const float*)d_in[6]; const float* idx_k_norm_g = (const float*)d_in[7]; const float* ret_norm_g = (const float*)d_in[8];
    const float* w_att = (const float*)d_in[9]; const float* w_ret = (const float*)d_in[10]; const float* w_out = (const float*)d_in[11];
    const float* norm2_g = (const float*)d_in[12]; const float* w_gr = (const float*)d_in[13]; const float* b_gr = (const float*)d_in[14];
    const float* w_er = (const float*)d_in[15]; const float* b_er = (const float*)d_in[16]; const float* w_eg = (const float*)d_in[17];
    const float* w_eu = (const float*)d_in[18]; const float* w_ed = (const float*)d_in[19];
    float* out = (float*)d_out;
    unsigned char* ws = (unsigned char*)d_ws;
    if (ws_size < WS_ACT + (size_t)T * O_END) { fprintf(stderr, "kernel_launch: workspace too small\n"); return; }
    (void)x; (void)kv_norm_g; (void)w_kv_up; (void)q_norm_g; (void)k_norm_g; (void)idx_k_norm_g; (void)ret_norm_g; (void)w_att; (void)w_ret; (void)w_out; (void)norm2_g; (void)w_gr; (void)b_gr; (void)w_er; (void)b_er; (void)w_eg; (void)w_eu; (void)w_ed;
    (void)hipMemsetAsync(ws + WS_CTL, 0, CTL_ZERO_BYTES, stream);
    Args a{};
    for (int i = 0; i < 20; ++i) a.in[i] = (const float*)d_in[i];
    a.out = out; a.ws = ws; a.xb = (unsigned char*)d_out; a.ntok = T; a.tok0 = 0;
    void* kargs[] = {(void*)&a};
    if (PROBE_PH >= 0) { a.ph_lo = PROBE_PH; a.ph_hi = PROBE_PH + 1; a.mode = PROBE_MODE;
        (void)hipLaunchCooperativeKernel((const void*)mk_fwd, dim3(grid), dim3(NWAVES * 64), kargs, (unsigned)LDS_BYTES, stream);
        (void)hipMemsetAsync(ws + WS_CTL, 0, CTL_ZERO_BYTES, stream); }
    a.ph_lo = 0; a.ph_hi = 11; a.mode = 0;
    const hipError_t le = hipLaunchCooperativeKernel((const void*)mk_fwd, dim3(grid), dim3(NWAVES * 64), kargs, (unsigned)LDS_BYTES, stream);
    if (le != hipSuccess) fprintf(stderr, "kernel_launch: cooperative launch failed: %s (grid %d)\n", hipGetErrorString(le), grid);
}
```

```cpp
#include <hip/hip_runtime.h>
#include <hip/hip_cooperative_groups.h>
#include <cstdio>
#include <cstdint>

namespace pg8 {
#define PG8_LAS __attribute__((address_space(3)))
typedef unsigned short bf16_t;
typedef short bf16x8 __attribute__((ext_vector_type(8)));
typedef float f32x4 __attribute__((ext_vector_type(4)));
typedef unsigned u32x4 __attribute__((ext_vector_type(4)));
typedef unsigned u32x2 __attribute__((ext_vector_type(2)));
typedef int v4i_t __attribute__((ext_vector_type(4)));
typedef int v8i_t __attribute__((ext_vector_type(8)));
constexpr int BM = 256, BK = 64, HALF = 128, HTB = HALF * BK * 2  , STAGE_BYTES = 8 * HTB, NXCD = 8, WGM = 8;

__host__ __device__ __forceinline__ int lds_byte(int r, int c) { const int st = (r >> 4) * 2 + (c >> 5), rr = r & 15, cc = c & 31, ob = rr * 64 + cc * 2; return st * 1024 + (ob ^ (((ob >> 9) & 1) << 5)); }
__host__ __device__ __forceinline__ void stage_rc(int b, int& R, int& C) { const int st = b / 1024, sb = b % 1024, swz = sb ^ (((sb >> 9) & 1) << 5); R = (st >> 1) * 16 + swz / 64; C = (st & 1) * 32 + (swz % 64) / 2; }
__host__ __device__ __forceinline__ int perm32(int rho) { const int n = rho >> 4, i = rho & 15; return 8 * (i >> 2) + 4 * n + (i & 3); }

struct Unit { int pm, pn; const char* a; const char* b; long bjump; int aux; };
struct Gemm { int K, lda, ldb, ksplit; int sw = 122, sa = 127; };

struct StaticOrder {
    static constexpr bool GATHER = false; const int* ptok = nullptr;
    int nM, nN, nwg, G, c; const char* A; const char* Bt; size_t tA, tB;
    __device__ void init(int M, int N, int G_, int c_, const void* A_, int lda, const void* Bt_, int ldb) { nM = M / BM; nN = N / BM; nwg = nM * nN; G = G_; c = c_; A = (const char*)A_; Bt = (const char*)Bt_; tA = (size_t)BM * lda * 2; tB = (size_t)BM * ldb * 2; }
    __device__ bool next(int i, Unit& u) const {
        const long L = (long)i * G + c; if (L >= nwg) return false;
        int wgid = (int)L; { const int q = nwg / NXCD, r = nwg % NXCD, xcd = wgid % NXCD, off = wgid / NXCD; wgid = (xcd < r ? xcd * (q + 1) : r * (q + 1) + (xcd - r) * q) + off; }
        const int nig = WGM * nN, gid = wgid / nig, fm = gid * WGM, gsz = (nM - fm) < WGM ? (nM - fm) : WGM;
        u.pm = fm + ((wgid % nig) % gsz); u.pn = (wgid % nig) / gsz; u.a = A + (size_t)u.pm * tA; u.b = Bt + (size_t)u.pn * tB; u.bjump = 0; u.aux = 0; return true;
    }
    __device__ __forceinline__ void a_ready(const Unit&) const {}
    __device__ __forceinline__ void done(const Unit&) const {}
};

typedef float f32x2c __attribute__((ext_vector_type(2))); typedef __bf16 bf16x2c __attribute__((ext_vector_type(2)));
__device__ __forceinline__ unsigned cvt_pk_bf16(float lo, float hi) { const f32x2c v = {lo, hi}; const bf16x2c b = __builtin_convertvector(v, bf16x2c); return __builtin_bit_cast(unsigned, b); }
__device__ __forceinline__ float bf_lo(unsigned w) { return __uint_as_float(w << 16); }
__device__ __forceinline__ float bf_hi(unsigned w) { return __uint_as_float(w & 0xffff0000u); }


template <class Epi, class Sched, bool ALIGN_EPI = false, bool SP2 = false, bool FP8 = false>
__device__ __forceinline__ void gemm_phase(PG8_LAS unsigned char* lds, const Gemm g, const Sched& S, const Epi& E) {
    int tid = threadIdx.x; asm volatile("" : "+v"(tid));
    const int wid = __builtin_amdgcn_readfirstlane(tid >> 6), lane = tid & 63, wr = wid >> 2, wc = wid & 3, fr = lane & 15, fq = lane >> 4;
    const int K = g.K, nt = K / BK;
    unsigned voffA[2], voffB[2]; int gR[2]; unsigned gC[2];
#pragma unroll
    for (int i = 0; i < 2; ++i) { int R, C; stage_rc(tid * 16 + i * 8192, R, C); const int Rb = Epi::PERM ? ((R & ~31) + perm32(R & 31)) : R; gR[i] = R; gC[i] = (unsigned)C * 2u;
        voffA[i] = (unsigned)(R * g.lda + C) * 2u; voffB[i] = (unsigned)(Rb * g.ldb + C) * 2u; }
    unsigned gA0[2] = {0u, 0u}, gA1[2] = {0u, 0u}, gN0[2] = {0u, 0u}, gN1[2] = {0u, 0u};
#define PG8_GOFF(u_, o0, o1) do { _Pragma("unroll") for (int i_ = 0; i_ < 2; ++i_) { int t0_ = S.ptok[(u_).pm * BM + gR[i_]], t1_ = S.ptok[(u_).pm * BM + HALF + gR[i_]]; t0_ = t0_ < 0 ? 0 : t0_; t1_ = t1_ < 0 ? 0 : t1_; \
        o0[i_] = (unsigned)t0_ * (unsigned)(g.lda * 2) + gC[i_]; o1[i_] = (unsigned)t1_ * (unsigned)(g.lda * 2) + gC[i_]; } } while (0)
    const size_t kstep = (size_t)(BK * 2);
    const size_t hstepA = Sched::GATHER ? (size_t)0 : (size_t)HALF * g.lda * 2, hstepB = (size_t)HALF * g.ldb * 2;
    const unsigned ldsw = (unsigned)wid * 1024u;
    const int aoff = lds_byte(wr * 64 + fr, fq * 8), boff = lds_byte(wc * 32 + fr, fq * 8);
#define PG8_CAT(x0, x1) __builtin_shufflevector(__builtin_bit_cast(v4i_t, x0), __builtin_bit_cast(v4i_t, x1), 0, 1, 2, 3, 4, 5, 6, 7)
#define PG8_SA(b, h) (((b) * 2 + (h)) * HTB)
#define PG8_SB(b, h) ((4 + (b) * 2 + (h)) * HTB)
#define PG8_STAGE(bufoff, gbase, voff) do { _Pragma("unroll") for (int _i = 0; _i < 2; ++_i) \
        __builtin_amdgcn_global_load_lds((const unsigned*)((const char*)(gbase) + (voff)[_i]), (PG8_LAS unsigned*)(lds + (bufoff) + ldsw + _i * 8192), 16, 0, 0); } while (0)
#define PG8_LDA(dst, b, h) do { if constexpr (FP8) { _Pragma("unroll") for (int m = 0; m < 4; ++m) dst##8[m] = PG8_CAT(*(const PG8_LAS bf16x8*)(lds + PG8_SA(b, h) + aoff + m * 2048), *(const PG8_LAS bf16x8*)(lds + PG8_SA(b, h) + aoff + m * 2048 + 1024)); } \
      else { _Pragma("unroll") for (int m = 0; m < 4; ++m) _Pragma("unroll") for (int k = 0; k < 2; ++k) dst[m][k] = *(const PG8_LAS bf16x8*)(lds + PG8_SA(b, h) + aoff + m * 2048 + k * 1024); } } while (0)
#define PG8_LDB(dst, b, h) do { if constexpr (FP8) { _Pragma("unroll") for (int n = 0; n < 2; ++n) dst##8[n] = PG8_CAT(*(const PG8_LAS bf16x8*)(lds + PG8_SB(b, h) + boff + n * 2048), *(const PG8_LAS bf16x8*)(lds + PG8_SB(b, h) + boff + n * 2048 + 1024)); } \
      else { _Pragma("unroll") for (int n = 0; n < 2; ++n) _Pragma("unroll") for (int k = 0; k < 2; ++k) dst[n][k] = *(const PG8_LAS bf16x8*)(lds + PG8_SB(b, h) + boff + n * 2048 + k * 1024); } } while (0)
#define PG8_MMA(ai, bj, At, Bt) do { __builtin_amdgcn_s_setprio(1); if constexpr (FP8) { _Pragma("unroll") for (int m = 0; m < 4; ++m) _Pragma("unroll") for (int n = 0; n < 2; ++n) \
        asm volatile("v_mfma_scale_f32_16x16x128_f8f6f4 %0, %1, %2, %0, %3, %4 op_sel_hi:[0,0,0]" : "+v"(acc[ai][bj][m][n]) : "v"(Bt##8[n]), "v"(At##8[m]), "v"(scw8), "v"(sca8)); } \
      else { _Pragma("unroll") for (int m = 0; m < 4; ++m) _Pragma("unroll") for (int n = 0; n < 2; ++n) _Pragma("unroll") for (int k = 0; k < 2; ++k) \
        acc[ai][bj][m][n] = __builtin_amdgcn_mfma_f32_16x16x32_bf16(Bt[n][k], At[m][k], acc[ai][bj][m][n], 0, 0, 0); } __builtin_amdgcn_s_setprio(0); } while (0)
#define PG8_WAIT_V(n) asm volatile("s_waitcnt vmcnt(" #n ")" ::: "memory")
#define PG8_WAIT_L(n) asm volatile("s_waitcnt lgkmcnt(" #n ")" ::: "memory")
#define PG8_BAR __builtin_amdgcn_s_barrier()
#define PG8_SCHED __builtin_amdgcn_sched_barrier(0)
    Unit cur, nxt; int ui = 0;
    if (!S.next(0, cur)) return;
    f32x4 acc[2][2][4][2];
#pragma unroll
    for (int a = 0; a < 2; ++a)
#pragma unroll
        for (int b = 0; b < 2; ++b)
#pragma unroll
            for (int m = 0; m < 4; ++m)
#pragma unroll
                for (int n = 0; n < 2; ++n) acc[a][b][m][n] = (f32x4){0.f, 0.f, 0.f, 0.f};
    int scw8 = g.sw, sca8 = g.sa; asm volatile("" : "+v"(scw8), "+v"(sca8));
    bf16x8 At[4][2], B0[2][2], B1[2][2]; v8i_t At8[4], B08[2], B18[2];
    const char* cA = cur.a; const char* cB = cur.b; long cJ = cur.bjump;
    S.a_ready(cur);
    if constexpr (SP2) {
        if constexpr (Sched::GATHER) PG8_GOFF(cur, gA0, gA1);
        PG8_STAGE(PG8_SB(0, 0), cB, voffB); PG8_STAGE(PG8_SB(0, 1), cB + hstepB, voffB); do { if constexpr (Sched::GATHER) { PG8_STAGE(PG8_SA(0, 0), cA, gA0); } else { PG8_STAGE(PG8_SA(0, 0), cA, voffA); } } while (0); do { if constexpr (Sched::GATHER) { PG8_STAGE(PG8_SA(0, 1), cA, gA1); } else { PG8_STAGE(PG8_SA(0, 1), cA + hstepA, voffA); } } while (0);
        if (wr == 1) PG8_BAR;
        PG8_WAIT_V(2); PG8_BAR;
        PG8_STAGE(PG8_SB(1, 0), cB + kstep, voffB); do { if constexpr (Sched::GATHER) { PG8_STAGE(PG8_SA(1, 0), cA + kstep, gA0); } else { PG8_STAGE(PG8_SA(1, 0), cA + kstep, voffA); } } while (0); PG8_STAGE(PG8_SB(1, 1), cB + hstepB + kstep, voffB);
        PG8_WAIT_V(6); PG8_BAR;
    } else {
        PG8_STAGE(PG8_SB(0, 0), cB, voffB); PG8_STAGE(PG8_SA(0, 0), cA, voffA); PG8_STAGE(PG8_SB(0, 1), cB + hstepB, voffB); PG8_STAGE(PG8_SA(0, 1), cA + hstepA, voffA);
        if (wr == 1) PG8_BAR;
        PG8_WAIT_V(4); PG8_BAR;
        PG8_STAGE(PG8_SB(1, 0), cB + kstep, voffB); PG8_STAGE(PG8_SA(1, 0), cA + kstep, voffA); PG8_STAGE(PG8_SB(1, 1), cB + hstepB + kstep, voffB);
        PG8_WAIT_V(6); PG8_BAR;
    }
    for (;;) {
        const bool has_next = S.next(ui + 1, nxt);
        const char* nA = has_next ? nxt.a : cA; const char* nB = has_next ? nxt.b : cB;
        if constexpr (Sched::GATHER) { if (has_next) PG8_GOFF(nxt, gN0, gN1); else { gN0[0] = gA0[0]; gN0[1] = gA0[1]; gN1[0] = gA1[0]; gN1[1] = gA1[1]; } }
#pragma unroll 1
        for (int t = 0; t < nt; t += 2) {
            const bool last = (t == nt - 2);
            const char* a1 = cA + (size_t)(t + 1) * kstep;
            const char* a2 = last ? nA : cA + (size_t)(t + 2) * kstep; const char* b2 = last ? nB : cB + (size_t)(t + 2) * kstep + ((t + 2) >= g.ksplit ? cJ : 0L);
            const char* a3 = a2 + kstep; const char* b3 = b2 + kstep;
            if (last && has_next) S.a_ready(nxt);
            unsigned x0[2] = {0u, 0u}, x1[2] = {0u, 0u};
            if constexpr (Sched::GATHER) { x0[0] = last ? gN0[0] : gA0[0]; x0[1] = last ? gN0[1] : gA0[1]; x1[0] = last ? gN1[0] : gA1[0]; x1[1] = last ? gN1[1] : gA1[1]; }
            if constexpr (SP2) {
            PG8_LDB(B0, 0, 0); PG8_LDB(B1, 0, 1); PG8_SCHED; PG8_LDA(At, 0, 0); do { if constexpr (Sched::GATHER) { PG8_STAGE(PG8_SA(1, 1), a1, gA1); } else { PG8_STAGE(PG8_SA(1, 1), a1 + hstepA, voffA); } } while (0);
            PG8_WAIT_V(8); PG8_WAIT_L(0); PG8_BAR; PG8_MMA(0, 0, At, B0); PG8_MMA(0, 1, At, B1); PG8_BAR; PG8_SCHED;
            PG8_LDA(At, 0, 1); PG8_STAGE(PG8_SB(0, 0), b2, voffB); PG8_STAGE(PG8_SB(0, 1), b2 + hstepB, voffB); do { if constexpr (Sched::GATHER) { PG8_STAGE(PG8_SA(0, 0), a2, x0); } else { PG8_STAGE(PG8_SA(0, 0), a2, voffA); } } while (0);
            PG8_WAIT_V(8); PG8_WAIT_L(0); PG8_BAR; PG8_MMA(1, 0, At, B0); PG8_MMA(1, 1, At, B1); PG8_BAR; PG8_SCHED;
            PG8_LDB(B0, 1, 0); PG8_LDB(B1, 1, 1); PG8_SCHED; PG8_LDA(At, 1, 0); do { if constexpr (Sched::GATHER) { PG8_STAGE(PG8_SA(0, 1), a2, x1); } else { PG8_STAGE(PG8_SA(0, 1), a2 + hstepA, voffA); } } while (0);
            PG8_WAIT_V(8); PG8_WAIT_L(0); PG8_BAR; PG8_MMA(0, 0, At, B0); PG8_MMA(0, 1, At, B1); PG8_BAR; PG8_SCHED;
            PG8_LDA(At, 1, 1); PG8_STAGE(PG8_SB(1, 0), b3, voffB); PG8_STAGE(PG8_SB(1, 1), b3 + hstepB, voffB); do { if constexpr (Sched::GATHER) { PG8_STAGE(PG8_SA(1, 0), a3, x0); } else { PG8_STAGE(PG8_SA(1, 0), a3, voffA); } } while (0);
            PG8_WAIT_V(8); PG8_WAIT_L(0); PG8_BAR; PG8_MMA(1, 0, At, B0); PG8_MMA(1, 1, At, B1); PG8_BAR; PG8_SCHED;
            } else {
            PG8_LDB(B0, 0, 0); PG8_SCHED; PG8_LDA(At, 0, 0); PG8_STAGE(PG8_SA(1, 1), a1 + hstepA, voffA);
            PG8_WAIT_L(8); PG8_BAR; PG8_WAIT_L(0); PG8_MMA(0, 0, At, B0); PG8_BAR; PG8_SCHED;
            PG8_LDB(B1, 0, 1); PG8_STAGE(PG8_SB(0, 0), b2, voffB);
            PG8_BAR; PG8_WAIT_L(0); PG8_MMA(0, 1, At, B1); PG8_BAR;
            PG8_LDA(At, 0, 1); PG8_STAGE(PG8_SA(0, 0), a2, voffA);
            PG8_BAR; PG8_WAIT_L(0); PG8_MMA(1, 0, At, B0); PG8_BAR; PG8_SCHED;
            PG8_STAGE(PG8_SB(0, 1), b2 + hstepB, voffB);
            PG8_WAIT_V(6); PG8_BAR; PG8_MMA(1, 1, At, B1); PG8_BAR;
            PG8_LDB(B0, 1, 0); PG8_SCHED; PG8_LDA(At, 1, 0); PG8_STAGE(PG8_SA(0, 1), a2 + hstepA, voffA);
            PG8_WAIT_L(8); PG8_BAR; PG8_WAIT_L(0); PG8_MMA(0, 0, At, B0); PG8_BAR; PG8_SCHED;
            PG8_LDB(B1, 1, 1); PG8_STAGE(PG8_SB(1, 0), b3, voffB);
            PG8_BAR; PG8_WAIT_L(0); PG8_MMA(0, 1, At, B1); PG8_BAR;
            PG8_LDA(At, 1, 1); PG8_STAGE(PG8_SA(1, 0), a3, voffA);
            PG8_BAR; PG8_WAIT_L(0); PG8_MMA(1, 0, At, B0); PG8_BAR; PG8_SCHED;
            PG8_STAGE(PG8_SB(1, 1), b3 + hstepB, voffB);
            PG8_WAIT_V(6); PG8_BAR; PG8_MMA(1, 1, At, B1); PG8_BAR;
            }
        }
        if constexpr (ALIGN_EPI) { if (wr == 0) PG8_BAR; }
        if constexpr (!Epi::AFTER_DRAIN) { E(acc, cur, wr, wc, fr, fq); S.done(cur); }
        if (!has_next) break;
#pragma unroll
        for (int a = 0; a < 2; ++a)
#pragma unroll
            for (int b = 0; b < 2; ++b)
#pragma unroll
                for (int m = 0; m < 4; ++m)
#pragma unroll
                    for (int n = 0; n < 2; ++n) acc[a][b][m][n] = (f32x4){0.f, 0.f, 0.f, 0.f};
        cur = nxt; cA = nA; cB = nB; cJ = cur.bjump; ++ui;
        if constexpr (Sched::GATHER) { gA0[0] = gN0[0]; gA0[1] = gN0[1]; gA1[0] = gN1[0]; gA1[1] = gN1[1]; }
        if constexpr (ALIGN_EPI) { if (wr == 1) PG8_BAR; }
    }
    PG8_WAIT_V(0);
    if constexpr (!ALIGN_EPI) { if (wr == 0) PG8_BAR; }
    PG8_BAR;
    if constexpr (Epi::AFTER_DRAIN) { E.fused(acc, cur, wr, wc, fr, fq, lds, wid, lane); S.done(cur); }
#undef PG8_GOFF
#undef PG8_SA
#undef PG8_SB
#undef PG8_STAGE
#undef PG8_LDA
#undef PG8_LDB
#undef PG8_MMA
#undef PG8_CAT
#undef PG8_WAIT_V
#undef PG8_WAIT_L
#undef PG8_BAR
#undef PG8_SCHED
}
}

#ifndef PROBE_PH
#define PROBE_PH (-1)
#endif
#ifndef PROBE_MODE
#define PROBE_MODE (0)
#endif
constexpr int D = 1024, BATCH = 16, SEQ = 2048, T = BATCH * SEQ;
constexpr int INW = 6984, INWP = 7168;
constexpr int C_QA = 0, C_CKV = 1024, C_QI = 1280, C_KI = 1792, C_WI = 1856, C_RQ = 1864, C_RK = 2376, C_RV = 2888, C_RG = 3912, C_GA = 4936, C_GR = 5960;
constexpr float EPS = 1e-6f;
constexpr int NWAVES = 8;

constexpr size_t MiB = 1u << 20;
constexpr size_t WS_CTL = 0, CTL_ZERO_BYTES = 1 * MiB;
constexpr size_t WS_WIN = 1 * MiB, WS_WKV = 15 * MiB, WS_WATT = 16 * MiB, WS_WRET = 18 * MiB, WS_WOUT = 20 * MiB, WS_W1 = 22 * MiB, WS_WD = 38 * MiB, WS_ACT = 46 * MiB;
constexpr size_t O_QA = 0, O_CKV = 2048, O_QI = 2560, O_KW = 3584, O_RQ = 3840, O_RK = 4864, O_RV = 5888, O_RG = 7936, O_GA = 9984, O_GR = 12032, O_END = 14080;

constexpr int MP_ROWS = 38912;
constexpr size_t MO_APERM = 0, MO_ACT = 80 * MiB, MO_N2 = 120 * MiB, MO_META = 184 * MiB;
constexpr size_t MM_B = 0, MM_P = 131072, MM_CL = 262144, MM_CH = 393216, MM_RS = 524288, MM_PTOK = 655360, MM_PRS = 819200, MM_PCL = 983040, MM_PCH = 1146880, MM_END = 1310720;
constexpr size_t WS_WR = 15 * MiB + 512 * 1024;
constexpr size_t MO_H16 = 192 * MiB;
constexpr size_t WS_WIN8 = 488 * MiB;
constexpr size_t WS_WATT8 = 495 * MiB, WS_WRET8 = 496 * MiB, WS_WOUT8 = 497 * MiB;
constexpr size_t O_A2F8 = 2048, O_MIX8 = 3840;
constexpr size_t WS_W18 = 498 * MiB, WS_WD8 = 506 * MiB;
constexpr size_t AUX_XB8 = 2048 + 896;
constexpr int CW_MOE = 256;
constexpr int RING_OFF = 0, RING_BYTES = 131072, P3_HIST_OFF = 131072, P3_TOT_OFF = 147456, P3_T_OFF = 149504, LDSCTL_OFF = 151552, MISC_OFF = LDSCTL_OFF + 320, LDS_BYTES = 152576;
constexpr int CW_Q3 = 64, CW_Q4 = 128;

#define GAS __attribute__((address_space(1)))
#define LAS __attribute__((address_space(3)))
typedef unsigned short bf16;
typedef unsigned v4u __attribute__((ext_vector_type(4)));
typedef float f32x4 __attribute__((ext_vector_type(4)));
#define LDS_WAIT() asm volatile("s_waitcnt lgkmcnt(0)" ::: "memory")
#define VM_WAIT() asm volatile("s_waitcnt vmcnt(0)" ::: "memory")
__device__ __forceinline__ unsigned f2bf(float f) { unsigned u = __builtin_bit_cast(unsigned, f); return (u + 0x7fffu + ((u >> 16) & 1u)) >> 16; }
__device__ __forceinline__ unsigned pk2(float lo, float hi) { return f2bf(lo) | (f2bf(hi) << 16); }
__device__ __forceinline__ float bf2f(bf16 b) { return __uint_as_float((unsigned)b << 16); }


typedef GAS unsigned gu32;
constexpr int CW_BAR = 4096;
#define XB_TMO      128
#define XB_XCNT(j)  (256  + 64 * (j))
#define XB_XSUB(j)  (1280 + 64 * (j))
#define XB_XGEN(j)  (2304 + 64 * (j))
#define XB_TOP      3328
#define XB_TOPGEN   3392
#define XCD_BAR_WORDS 3456
#define XB_SPIN_CAP (1u << 18)

__device__ __forceinline__ unsigned xb_ld(unsigned* p)              { return __hip_atomic_load(p, __ATOMIC_RELAXED, __HIP_MEMORY_SCOPE_AGENT); }
__device__ __forceinline__ unsigned xb_add(unsigned* p, unsigned v) { return __hip_atomic_fetch_add(p, v, __ATOMIC_RELAXED, __HIP_MEMORY_SCOPE_AGENT); }
__device__ __forceinline__ unsigned xb_xcc_id() { return (unsigned)__builtin_amdgcn_s_getreg((3 << 11) | 20) & 0xFu; }
#define XB_SPIN(cond, bar) do { unsigned _sp = 0; while (cond) { __builtin_amdgcn_s_sleep(1); \
    if ((++_sp & 255u) == 0u) { if (xb_ld(&(bar)[XB_TMO])) break; if (_sp > XB_SPIN_CAP) { atomicAdd(&(bar)[XB_TMO], 1u); break; } } } } while (0)

struct XcdBarrier {
    unsigned* bar; unsigned x;
    volatile LAS unsigned* st;
};

__device__ __forceinline__ XcdBarrier xcd_barrier_post(unsigned* bar, volatile LAS unsigned* st) {
    XcdBarrier b; b.bar = bar; b.x = xb_xcc_id(); b.st = st;
    if (threadIdx.x == 0) (void)xb_add(&bar[XB_XCNT(b.x)], 1u);
    return b;
}
__device__ __forceinline__ void xcd_barrier_complete(unsigned* bar, unsigned x, unsigned& nloc, unsigned& nx) {
    const unsigned G = gridDim.x * gridDim.y * gridDim.z;
    unsigned sum, cnt, mine, sp = 0u;
    for (;;) {
        sum = 0u; cnt = 0u; mine = 0u;
#pragma unroll
        for (unsigned j = 0; j < 16; ++j) { const unsigned c = xb_ld(&bar[XB_XCNT(j)]); sum += c; cnt += (c > 0u) ? 1u : 0u; mine = (j == x) ? c : mine; }
        if (sum == G) break;
        __builtin_amdgcn_s_sleep(1);
        if ((++sp & 255u) == 0u) { if (xb_ld(&bar[XB_TMO])) break; if (sp > XB_SPIN_CAP) { atomicAdd(&bar[XB_TMO], 1u); break; } }
    }
    nloc = mine > 0u ? mine : 1u; nx = cnt > 0u ? cnt : 1u;
}

__device__ __forceinline__ void xcd_barrier(const XcdBarrier& b) {
    asm volatile("s_waitcnt vmcnt(0)" ::: "memory");
    __syncthreads();
    if (threadIdx.x == 0) {
        unsigned* bar = b.bar;
        __builtin_amdgcn_s_waitcnt(0);
        unsigned nloc = b.st[0], nx = b.st[1];
        if (nloc == 0u) { xcd_barrier_complete(bar, b.x, nloc, nx); b.st[0] = nloc; b.st[1] = nx; }
        const unsigned old = xb_add(&bar[XB_XSUB(b.x)], 1u);
        const unsigned gen = old / nloc;
        if (old + 1u == (gen + 1u) * nloc) {
            __builtin_amdgcn_fence(__ATOMIC_RELEASE, "agent");
            asm volatile("s_waitcnt vmcnt(0)" ::: "memory");
            const unsigned og = xb_add(&bar[XB_TOP], 1u);
            const unsigned tg = og / nx;
            if (og + 1u == (tg + 1u) * nx) xb_add(&bar[XB_TOPGEN], 1u);
            else XB_SPIN(xb_ld(&bar[XB_TOPGEN]) == tg, bar);
            __builtin_amdgcn_fence(__ATOMIC_ACQUIRE, "agent");
            xb_add(&bar[XB_XGEN(b.x)], 1u);
            asm volatile("s_waitcnt vmcnt(0)" ::: "memory");
        } else {
            XB_SPIN(xb_ld(&bar[XB_XGEN(b.x)]) == gen, bar);
            __builtin_amdgcn_fence(__ATOMIC_ACQUIRE, "agent");
            asm volatile("s_waitcnt vmcnt(0)" ::: "memory");
        }
    }
    __syncthreads();
}

struct Args { const float* in[20]; float* out; unsigned char* ws; unsigned char* xb; int ph_lo, ph_hi, ntok, tok0, mode, pad; };

struct Frame {
    LAS unsigned char* lds;
    int tid, lane, wave, vcu, G;
    int ntok;
    unsigned char* ws; unsigned char* act; unsigned char* xbp;
};

struct EpiProj {
    static constexpr bool PERM = true, AFTER_DRAIN = false;
    unsigned char* act; size_t ntok;
    __device__ __forceinline__ void operator()(const pg8::f32x4 (&acc)[2][2][4][2], const pg8::Unit& u, int wr, int wc, int fr, int fq) const {
        const int pn = u.pn; size_t O; int ld, cb, nbj = 2;
        if (pn < 4) { O = O_QA; ld = 1024; cb = pn * 256; }
        else if (pn == 4) { O = O_CKV; ld = 256; cb = 0; }
        else if (pn < 7) { O = O_QI; ld = 512; cb = (pn - 5) * 256; }
        else if (pn == 7) { O = O_KW; ld = 128; cb = 0; nbj = 1; }
        else if (pn < 10) { O = O_RQ; ld = 512; cb = (pn - 8) * 256; }
        else if (pn < 12) { O = O_RK; ld = 512; cb = (pn - 10) * 256; }
        else { O = O_RV + (size_t)((pn - 12) >> 2) * 2048; ld = 1024; cb = ((pn - 12) & 3) * 256; }
        pg8::bf16_t* base = (pg8::bf16_t*)(act + ntok * O);
        const int row0 = u.pm * pg8::BM + wr * 64 + fr, col0 = cb + wc * 32 + 8 * fq;
#pragma unroll
        for (int ai = 0; ai < 2; ++ai)
#pragma unroll
            for (int m = 0; m < 4; ++m) { pg8::bf16_t* rowp = base + (size_t)(row0 + ai * pg8::HALF + m * 16) * ld + col0;
#pragma unroll
                for (int bj = 0; bj < 2; ++bj) if (bj < nbj) { const pg8::f32x4 v0 = acc[ai][bj][m][0], v1 = acc[ai][bj][m][1];
                    pg8::u32x4 w; w.x = pg8::cvt_pk_bf16(v0[0], v0[1]); w.y = pg8::cvt_pk_bf16(v0[2], v0[3]); w.z = pg8::cvt_pk_bf16(v1[0], v1[1]); w.w = pg8::cvt_pk_bf16(v1[2], v1[3]);
                    *(pg8::u32x4*)(rowp + bj * pg8::HALF) = w; } }
    }
};


__device__ __forceinline__ float sigm(float x) { return __builtin_amdgcn_rcpf(1.f + __builtin_amdgcn_exp2f(-1.4426950408889634f * x)); }
struct EpiGateA {
    static constexpr bool PERM = true, AFTER_DRAIN = false;
    pg8::bf16_t* GA;
    __device__ __forceinline__ void operator()(const pg8::f32x4 (&acc)[2][2][4][2], const pg8::Unit& u, int wr, int wc, int fr, int fq) const {
        const int row0 = u.pm * pg8::BM + wr * 64 + fr, col0 = u.pn * pg8::BM + wc * 32 + 8 * fq;
#pragma unroll
        for (int ai = 0; ai < 2; ++ai)
#pragma unroll
            for (int m = 0; m < 4; ++m) { pg8::bf16_t* rowp = GA + (size_t)(row0 + ai * pg8::HALF + m * 16) * 1024 + col0;
#pragma unroll
                for (int bj = 0; bj < 2; ++bj) { const pg8::u32x4 g = *(const pg8::u32x4*)(rowp + bj * pg8::HALF); const pg8::f32x4 v0 = acc[ai][bj][m][0], v1 = acc[ai][bj][m][1];
                    pg8::u32x4 w; w.x = pg8::cvt_pk_bf16(sigm(pg8::bf_lo(g.x)) * v0[0], sigm(pg8::bf_hi(g.x)) * v0[1]); w.y = pg8::cvt_pk_bf16(sigm(pg8::bf_lo(g.y)) * v0[2], sigm(pg8::bf_hi(g.y)) * v0[3]);
                    w.z = pg8::cvt_pk_bf16(sigm(pg8::bf_lo(g.z)) * v1[0], sigm(pg8::bf_hi(g.z)) * v1[1]); w.w = pg8::cvt_pk_bf16(sigm(pg8::bf_lo(g.w)) * v1[2], sigm(pg8::bf_hi(g.w)) * v1[3]);
                    *(pg8::u32x4*)(rowp + bj * pg8::HALF) = w; } }
    }
};
struct EpiGateB {
    static constexpr bool PERM = true, AFTER_DRAIN = false;
    const pg8::bf16_t* GA; const pg8::bf16_t* GR; unsigned char* MIX8;
    __device__ __forceinline__ void operator()(const pg8::f32x4 (&acc)[2][2][4][2], const pg8::Unit& u, int wr, int wc, int fr, int fq) const {
        const int row0 = u.pm * pg8::BM + wr * 64 + fr, col0 = u.pn * pg8::BM + wc * 32 + 8 * fq;
#pragma unroll
        for (int ai = 0; ai < 2; ++ai)
#pragma unroll
            for (int m = 0; m < 4; ++m) { const size_t ro = (size_t)(row0 + ai * pg8::HALF + m * 16) * 1024 + col0;
#pragma unroll
                for (int bj = 0; bj < 2; ++bj) { const pg8::u32x4 t = *(const pg8::u32x4*)(GA + ro + bj * pg8::HALF), g = *(const pg8::u32x4*)(GR + ro + bj * pg8::HALF); const pg8::f32x4 v0 = acc[ai][bj][m][0], v1 = acc[ai][bj][m][1];
                    int w0 = __builtin_amdgcn_cvt_pk_fp8_f32(8.f * (pg8::bf_lo(t.x) + sigm(pg8::bf_lo(g.x)) * v0[0]), 8.f * (pg8::bf_hi(t.x) + sigm(pg8::bf_hi(g.x)) * v0[1]), 0, false);
                    w0 = __builtin_amdgcn_cvt_pk_fp8_f32(8.f * (pg8::bf_lo(t.y) + sigm(pg8::bf_lo(g.y)) * v0[2]), 8.f * (pg8::bf_hi(t.y) + sigm(pg8::bf_hi(g.y)) * v0[3]), w0, true);
                    int w1 = __builtin_amdgcn_cvt_pk_fp8_f32(8.f * (pg8::bf_lo(t.z) + sigm(pg8::bf_lo(g.z)) * v1[0]), 8.f * (pg8::bf_hi(t.z) + sigm(pg8::bf_hi(g.z)) * v1[1]), 0, false);
                    w1 = __builtin_amdgcn_cvt_pk_fp8_f32(8.f * (pg8::bf_lo(t.w) + sigm(pg8::bf_lo(g.w)) * v1[2]), 8.f * (pg8::bf_hi(t.w) + sigm(pg8::bf_hi(g.w)) * v1[3]), w1, true);
                    *(unsigned long long*)(MIX8 + ro + bj * pg8::HALF) = (unsigned long long)(unsigned)w0 | ((unsigned long long)(unsigned)w1 << 32); } }
    }
};
struct EpiResid {
    static constexpr bool PERM = true, AFTER_DRAIN = false;
    const float* x; pg8::bf16_t* h16;
    __device__ __forceinline__ void operator()(const pg8::f32x4 (&acc)[2][2][4][2], const pg8::Unit& u, int wr, int wc, int fr, int fq) const {
        const int row0 = u.pm * pg8::BM + wr * 64 + fr, col0 = u.pn * pg8::BM + wc * 32 + 8 * fq;
#pragma unroll
        for (int ai = 0; ai < 2; ++ai)
#pragma unroll
            for (int m = 0; m < 4; ++m) { const size_t ro = (size_t)(row0 + ai * pg8::HALF + m * 16) * 1024 + col0;
#pragma unroll
                for (int bj = 0; bj < 2; ++bj) { const pg8::f32x4 x0 = *(const pg8::f32x4*)(x + ro + bj * pg8::HALF), x1 = *(const pg8::f32x4*)(x + ro + bj * pg8::HALF + 4); const pg8::f32x4 v0 = acc[ai][bj][m][0] + x0, v1 = acc[ai][bj][m][1] + x1;
                    pg8::u32x4 w; w.x = pg8::cvt_pk_bf16(v0[0], v0[1]); w.y = pg8::cvt_pk_bf16(v0[2], v0[3]); w.z = pg8::cvt_pk_bf16(v1[0], v1[1]); w.w = pg8::cvt_pk_bf16(v1[2], v1[3]);
                    *(pg8::u32x4*)(h16 + ro + bj * pg8::HALF) = w; } }
    }
};


struct P1Order {
    static constexpr bool GATHER = false; const int* ptok = nullptr;
    int nM, nN, nwg, G, c, mode; const char* A; const char* Bt; size_t tA, tB;
    __device__ bool next(int i, pg8::Unit& u) const {
        const long L = (long)i * G + c; if (L >= nwg) return false;
        int wgid = (int)L; { const int q = nwg / pg8::NXCD, r = nwg % pg8::NXCD, xcd = wgid % pg8::NXCD, off = wgid / pg8::NXCD; wgid = (xcd < r ? xcd * (q + 1) : r * (q + 1) + (xcd - r) * q) + off; }
        const int nig = pg8::WGM * nN, gid = wgid / nig, fm = gid * pg8::WGM, gsz = (nM - fm) < pg8::WGM ? (nM - fm) : pg8::WGM;
        u.pm = fm + ((wgid % nig) % gsz); const int pc = (wgid % nig) / gsz; u.pn = mode ? 5 + pc : (pc < 5 ? pc : pc + 3);
        u.a = A + (size_t)u.pm * tA; u.b = Bt + (size_t)u.pn * tB; u.bjump = 0; u.aux = 0; return true;
    }
    __device__ __forceinline__ void a_ready(const pg8::Unit&) const {}
    __device__ __forceinline__ void done(const pg8::Unit&) const {}
};

__device__ __forceinline__ float wave_sum(float v) {
#pragma unroll
    for (int o = 1; o < 64; o <<= 1) v += __shfl_xor(v, o);
    return v;
}
__device__ __forceinline__ void p0_transpose_item(const float* W, int K, int N, bf16* WT, int map, int row_off, int par, const float* gk, LAS float* scr, int item, int lane, unsigned char* WT8 = nullptr, float s8 = 32.f) {
    const int nblk = (N + 31) / 32, kb = item / nblk, nb = item % nblk, k0 = 64 * kb, n0 = 32 * nb;
    const int c4 = lane & 7, rr = lane >> 3; const bool okc = (n0 + 4 * c4) < N;
    f32x4 v[8];
#pragma unroll
    for (int i = 0; i < 8; ++i) { const int kk = i * 8 + rr; v[i] = okc ? *(const f32x4*)(W + (size_t)(k0 + kk) * N + n0 + 4 * c4) : (f32x4){0.f, 0.f, 0.f, 0.f}; }
#pragma unroll
    for (int i = 0; i < 8; ++i) { const int kk = i * 8 + rr; f32x4 x = v[i]; if (gk) x = x * gk[k0 + kk]; *(LAS f32x4*)(scr + kk * 36 + 4 * c4) = x; }
    LDS_WAIT(); asm volatile("" ::: "memory");
    const int c = lane & 7;
#pragma unroll
    for (int j = 0; j < 4; ++j) { const int nl = (lane >> 3) + 8 * j, n = n0 + nl; const LAS float* s = scr + (8 * c) * 36 + nl;
        v4u o; o.x = pk2(s[0 * 36], s[1 * 36]); o.y = pk2(s[2 * 36], s[3 * 36]); o.z = pk2(s[4 * 36], s[5 * 36]); o.w = pk2(s[6 * 36], s[7 * 36]);
        if (n < N) { const int row = (map == 0) ? row_off + n : (map == 1) ? (n < 1864 ? n : n + 184) : row_off + 2 * n + par;
            if (WT) *(GAS v4u*)(WT + (size_t)row * K + k0 + 8 * c) = o;
            if (WT8) { int w0 = __builtin_amdgcn_cvt_pk_fp8_f32(s[0 * 36] * s8, s[1 * 36] * s8, 0, false); w0 = __builtin_amdgcn_cvt_pk_fp8_f32(s[2 * 36] * s8, s[3 * 36] * s8, w0, true);
                int w1 = __builtin_amdgcn_cvt_pk_fp8_f32(s[4 * 36] * s8, s[5 * 36] * s8, 0, false); w1 = __builtin_amdgcn_cvt_pk_fp8_f32(s[6 * 36] * s8, s[7 * 36] * s8, w1, true);
                *(GAS unsigned long long*)(WT8 + (size_t)row * K + k0 + 8 * c) = (unsigned long long)(unsigned)w0 | ((unsigned long long)(unsigned)w1 << 32); } } }
    LDS_WAIT(); asm volatile("" ::: "memory");
}
__device__ __forceinline__ void p0_prologue(Frame& F, const Args& a) {
    LAS float* scr = (LAS float*)(F.lds + RING_OFF + F.wave * 16384);
    const int gw = F.vcu * NWAVES + F.wave, NGW = F.G * NWAVES;
    bf16* Win_t = (bf16*)(F.ws + WS_WIN); bf16* Wkv_t = (bf16*)(F.ws + WS_WKV);
    constexpr int I_IN = 16 * 219, I_KV = 4 * 8, I_SQ = 16 * 32, I_GU = 16 * 8  , I_DN = 4 * 32  ;
    constexpr int NITEMS = I_IN + I_KV + 3 * I_SQ + 16 * (2 * I_GU + I_DN);
    for (int it = gw; it < NITEMS; it += NGW) {
        int r = it;
        if (r < I_IN) { p0_transpose_item(a.in[2], 1024, INW, Win_t, 1, 0, 0, a.in[1], scr, r, F.lane, F.ws + WS_WIN8); continue; } r -= I_IN;
        if (r < I_KV) { p0_transpose_item(a.in[4], 256, 256, Wkv_t, 0, 0, 0, a.in[3], scr, r, F.lane); continue; } r -= I_KV;
        if (r < I_SQ) { p0_transpose_item(a.in[9], 1024, 1024, nullptr, 0, 0, 0, nullptr, scr, r, F.lane, F.ws + WS_WATT8, 32.f); continue; } r -= I_SQ;
        if (r < I_SQ) { p0_transpose_item(a.in[10], 1024, 1024, nullptr, 0, 0, 0, nullptr, scr, r, F.lane, F.ws + WS_WRET8, 32.f); continue; } r -= I_SQ;
        if (r < I_SQ) { p0_transpose_item(a.in[11], 1024, 1024, nullptr, 0, 0, 0, nullptr, scr, r, F.lane, F.ws + WS_WOUT8, 32.f); continue; } r -= I_SQ;
        const int e = r / (2 * I_GU + I_DN), q = r % (2 * I_GU + I_DN);
        if (q < I_GU) p0_transpose_item(a.in[17] + (size_t)e * 1024 * 256, 1024, 256, nullptr, 2, e * 512, 0, nullptr, scr, q, F.lane, F.ws + WS_W18, 32.f);
        else if (q < 2 * I_GU) p0_transpose_item(a.in[18] + (size_t)e * 1024 * 256, 1024, 256, nullptr, 2, e * 512, 1, nullptr, scr, q - I_GU, F.lane, F.ws + WS_W18, 32.f);
        else p0_transpose_item(a.in[19] + (size_t)e * 256 * 1024, 256, 1024, nullptr, 0, 0, 0, nullptr, scr, q - 2 * I_GU, F.lane, F.ws + WS_WD8 + (size_t)e * 1024 * 256, 16.f);
    }
    { const int gt = (F.vcu * NWAVES + F.wave) * 64 + F.lane, NGT = F.G * NWAVES * 64; GAS v4u* z = (GAS v4u*)(Win_t + (size_t)1864 * 1024);
      for (int i = gt; i < 184 * 1024 * 2 / 16; i += NGT) z[i] = (v4u){0u, 0u, 0u, 0u}; }
    { const int gt = (F.vcu * NWAVES + F.wave) * 64 + F.lane, NGT = F.G * NWAVES * 64; bf16* Wh = (bf16*)(F.ws + WS_WR); bf16* Wl = Wh + 32 * 1024;
      for (int i = gt; i < 32 * 1024; i += NGT) { const int n = i >> 10, k = i & 1023; const float wv = n < 4 ? a.in[13][k * 4 + n] : (n < 20 ? a.in[15][k * 16 + (n - 4)] : 0.f);
        const unsigned hb = f2bf(wv); const float hf = __uint_as_float(hb << 16); Wh[i] = (bf16)hb; Wl[i] = (bf16)f2bf(wv - hf); } }
    const float* x = a.in[0] + (size_t)a.tok0 * D; unsigned char* xb8 = a.xb + (size_t)F.ntok * AUX_XB8;
    for (int m = gw; m < F.ntok; m += 2 * NGW) {
        const int m2 = m + NGW; const bool two = m2 < F.ntok;
        const GAS f32x4* xr = (const GAS f32x4*)(x + (size_t)m * D) + F.lane; const GAS f32x4* xr2 = (const GAS f32x4*)(x + (size_t)(two ? m2 : m) * D) + F.lane;
        f32x4 v[4], u[4]; float s = 0.f, s2 = 0.f;
#pragma unroll
        for (int j = 0; j < 4; ++j) { v[j] = xr[64 * j]; u[j] = xr2[64 * j]; }
#pragma unroll
        for (int j = 0; j < 4; ++j) { s += (v[j].x * v[j].x + v[j].y * v[j].y) + (v[j].z * v[j].z + v[j].w * v[j].w); s2 += (u[j].x * u[j].x + u[j].y * u[j].y) + (u[j].z * u[j].z + u[j].w * u[j].w); }
        const float rstd = 1.f / sqrtf(wave_sum(s) * (1.f / D) + EPS), rstd2 = 1.f / sqrtf(wave_sum(s2) * (1.f / D) + EPS);
        GAS unsigned long long* o8 = (GAS unsigned long long*)(a.xb + (size_t)m * D * 2) + F.lane; GAS unsigned* q8 = (GAS unsigned*)(xb8 + (size_t)m * D) + F.lane;
#pragma unroll
        for (int j = 0; j < 4; ++j) { o8[64 * j] = (unsigned long long)pk2(v[j].x * rstd, v[j].y * rstd) | ((unsigned long long)pk2(v[j].z * rstd, v[j].w * rstd) << 32);
            int w8 = __builtin_amdgcn_cvt_pk_fp8_f32(v[j].x * rstd, v[j].y * rstd, 0, false); w8 = __builtin_amdgcn_cvt_pk_fp8_f32(v[j].z * rstd, v[j].w * rstd, w8, true); q8[64 * j] = (unsigned)w8; }
        if (two) { GAS unsigned long long* p8 = (GAS unsigned long long*)(a.xb + (size_t)m2 * D * 2) + F.lane; GAS unsigned* r8 = (GAS unsigned*)(xb8 + (size_t)m2 * D) + F.lane;
#pragma unroll
            for (int j = 0; j < 4; ++j) { p8[64 * j] = (unsigned long long)pk2(u[j].x * rstd2, u[j].y * rstd2) | ((unsigned long long)pk2(u[j].z * rstd2, u[j].w * rstd2) << 32);
                int w8 = __builtin_amdgcn_cvt_pk_fp8_f32(u[j].x * rstd2, u[j].y * rstd2, 0, false); w8 = __builtin_amdgcn_cvt_pk_fp8_f32(u[j].z * rstd2, u[j].w * rstd2, w8, true); r8[64 * j] = (unsigned)w8; } }
    }
}


constexpr size_t AUX_KP = 0, AUX_VV = 256, AUX_KIN = 512, AUX_MASK = 640, AUX_END = 896;
typedef short bf16x8_t __attribute__((ext_vector_type(8)));
typedef float f32x16 __attribute__((ext_vector_type(16)));
__device__ __forceinline__ int crow(int r, int hi) { return (r & 3) + 8 * (r >> 2) + 4 * hi; }
__device__ __forceinline__ float xhalf_sum(float v) { auto rr = __builtin_amdgcn_permlane32_swap(__float_as_uint(v), __float_as_uint(v), false, false); return __uint_as_float(rr[0]) + __uint_as_float(rr[1]); }
__device__ __forceinline__ float sumsq8(bf16x8_t v) { float s = 0.f;
#pragma unroll
    for (int j = 0; j < 8; ++j) { const float f = __uint_as_float((unsigned)(unsigned short)v[j] << 16); s += f * f; } return s; }
__device__ __forceinline__ void p2_post(Frame& F, const Args& a) {
    const int gw = F.vcu * NWAVES + F.wave, NGW = F.G * NWAVES, lane = F.lane, r32 = lane & 31, hi = lane >> 5;
    const size_t nt_ = (size_t)F.ntok;
    const bf16* CKV = (const bf16*)(F.act + nt_ * O_CKV); const bf16* KW = (const bf16*)(F.act + nt_ * O_KW);
    const bf16* Wkv_t = (const bf16*)(F.ws + WS_WKV);
    unsigned char* aux = a.xb + nt_ * 2048;
    bf16* KP = (bf16*)(aux + nt_ * AUX_KP); bf16* VV = (bf16*)(aux + nt_ * AUX_VV); bf16* KIN = (bf16*)(aux + nt_ * AUX_KIN);
    const float* g_q = a.in[5]; const float* g_k = a.in[6]; const float* g_ki = a.in[7];
    constexpr int WP = 528;
    LAS unsigned char* Wl = F.lds + RING_OFF; LAS float* gl = (LAS float*)(F.lds + RING_OFF + 256 * WP);
    for (int i = F.tid; i < 256 * 32; i += NWAVES * 64) { const int n = i >> 5, ch = i & 31; *(LAS v4u*)(Wl + n * WP + ch * 16) = *(const v4u*)(Wkv_t + (size_t)n * 256 + ch * 8); }
    if (F.tid < 128) gl[F.tid] = g_k[F.tid] * g_q[F.tid] * (0.08838834764831845f * 1.4426950408889634f);
    else if (F.tid < 192) gl[F.tid] = g_ki[F.tid - 128];
    __syncthreads();
    const int ntask = 2 * (F.ntok / 32);
    for (int task = gw; task < ntask; task += NGW) {
        const int kind = task & 1, t0 = (task >> 1) * 32;
        const bf16* crowp = CKV + (size_t)(t0 + r32) * 256 + hi * 8;
        bf16x8_t bfr[16]; float ss = 0.f;
#pragma unroll
        for (int kk = 0; kk < 16; ++kk) { bfr[kk] = *(const bf16x8_t*)(crowp + kk * 16); ss += sumsq8(bfr[kk]); }
        ss = xhalf_sum(ss);
        const float rstd = rsqrtf(ss * (1.f / 256.f) + EPS);
        f32x16 acc[4];
#pragma unroll
        for (int nt = 0; nt < 4; ++nt) { acc[nt] = f32x16{};
            const LAS unsigned char* wrow = Wl + (kind * 128 + nt * 32 + r32) * WP + hi * 16;
#pragma unroll
            for (int kk = 0; kk < 16; ++kk) { const bf16x8_t af = *(const LAS bf16x8_t*)(wrow + kk * 32); acc[nt] = __builtin_amdgcn_mfma_f32_32x32x16_bf16(af, bfr[kk], acc[nt], 0, 0, 0); if ((kk & 3) == 3) __builtin_amdgcn_sched_barrier(0); } }
        float sc = rstd;
        if (kind == 0) { float sk = 0.f;
#pragma unroll
            for (int nt = 0; nt < 4; ++nt)
#pragma unroll
                for (int r = 0; r < 16; ++r) { const float v = acc[nt][r] * rstd; sk += v * v; }
            sk = xhalf_sum(sk);
            sc = rstd * rsqrtf(sk * (1.f / 128.f) + EPS); }
        bf16* orow = (kind == 0 ? KP : VV) + (size_t)(t0 + r32) * 128;
#pragma unroll
        for (int nt = 0; nt < 4; ++nt)
#pragma unroll
            for (int g = 0; g < 4; ++g) { const int ch = nt * 32 + 8 * g + 4 * hi; float v[4];
#pragma unroll
                for (int j = 0; j < 4; ++j) { v[j] = acc[nt][4 * g + j] * sc; if (kind == 0) v[j] *= gl[ch + j]; }
                *(unsigned long long*)(orow + ch) = (unsigned long long)pk2(v[0], v[1]) | ((unsigned long long)pk2(v[2], v[3]) << 32); }
        if (kind == 0) {
            const bf16* kr = KW + (size_t)(t0 + r32) * 128 + hi * 32; bf16x8_t kv4[4]; float s2 = 0.f;
#pragma unroll
            for (int j = 0; j < 4; ++j) { kv4[j] = *(const bf16x8_t*)(kr + 8 * j); s2 += sumsq8(kv4[j]); }
            s2 = xhalf_sum(s2);
            const float rk = rsqrtf(s2 * (1.f / 64.f) + EPS);
            bf16* ko = KIN + (size_t)(t0 + r32) * 64 + hi * 32;
#pragma unroll
            for (int j = 0; j < 4; ++j) { float f[8];
#pragma unroll
                for (int e = 0; e < 8; ++e) f[e] = __uint_as_float((unsigned)(unsigned short)kv4[j][e] << 16) * rk * gl[128 + hi * 32 + 8 * j + e];
                v4u o; o.x = pk2(f[0], f[1]); o.y = pk2(f[2], f[3]); o.z = pk2(f[4], f[5]); o.w = pk2(f[6], f[7]);
                *(v4u*)(ko + 8 * j) = o; }
        }
    }
    __syncthreads();
}

typedef float f32x4_t __attribute__((ext_vector_type(4)));
__device__ __forceinline__ unsigned key15_of(float s) { const unsigned short hb = __builtin_bit_cast(unsigned short, (_Float16)s); const unsigned u = (hb & 0x8000u) ? (~(unsigned)hb & 0xffffu) : ((unsigned)hb | 0x8000u); return u >> 1; }
__device__ __forceinline__ unsigned sad4(unsigned x) { return __builtin_amdgcn_sad_u8(x, 0u, 0u); }
__device__ __forceinline__ void p3_merge(LAS unsigned* hist, LAS unsigned short* tot, int w, int g, int q, int& need, int& bsel) {
    __syncthreads();
    const int o = 4 * w + g; unsigned c = 0;
#pragma unroll
    for (int p = 0; p < 32; ++p) { const int tidp = (p >> 2) * 64 + (p & 3) * 16 + q; c += (hist[(o >> 2) * 512 + tidp] >> (8 * (o & 3))) & 0xffu; }
    tot[q * 32 + o] = (unsigned short)c;
    __syncthreads();
    v4u tv[4];
#pragma unroll
    for (int j = 0; j < 4; ++j) tv[j] = *(const LAS v4u*)((const LAS unsigned char*)tot + q * 64 + j * 16);
    int cum = 0, bs = 0, ab = 0; bool found = false;
#pragma unroll
    for (int bin = 31; bin >= 0; --bin) { const unsigned wd = tv[bin >> 3][(bin >> 1) & 3]; const int cc = (int)((bin & 1) ? (wd >> 16) : (wd & 0xffffu));
        if (!found && cum + cc >= need) { bs = bin; ab = cum; found = true; } cum += cc; }
    bsel = bs; need -= ab;
}
__device__ __forceinline__ void p3_index(Frame& F, const Args& a) {
    const int tid = F.tid, lane = F.lane, w = F.wave, q = lane & 15, g = lane >> 4;
    LAS unsigned* keys = (LAS unsigned*)(F.lds + RING_OFF);
    LAS unsigned char* qbuf = F.lds + 65536;
    LAS unsigned* hist = (LAS unsigned*)(F.lds + P3_HIST_OFF);
    LAS unsigned short* tot = (LAS unsigned short*)(F.lds + P3_TOT_OFF);
    LAS unsigned char* Tt = (LAS unsigned char*)(F.lds + P3_T_OFF);
    const size_t nt_ = (size_t)F.ntok;
    const bf16* QI = (const bf16*)(F.act + nt_ * O_QI); const bf16* KW = (const bf16*)(F.act + nt_ * O_KW);
    unsigned char* aux = a.xb + nt_ * 2048;
    const bf16* KIN = (const bf16*)(aux + nt_ * AUX_KIN); unsigned* MASK = (unsigned*)(aux + nt_ * AUX_MASK);
    const int nb = F.ntok / SEQ, nitems = nb * 128; const int bxj = (int)blockIdx.x >> 3;
    const int G = F.G - F.G / 4, c = (bxj - (bxj >> 2) - 1) * 8 + ((int)blockIdx.x & 7);
#define P3_ITEM(k) ((k) * G + (((k) & 1) ? (G - 1 - c) : c))
#define P3_QDMA(it_, buf_) do { const int qg_ = 127 - (it_) / nb, b_ = (it_) % nb; _Pragma("unroll") for (int i_ = 0; i_ < 2; ++i_) { const int row_ = w * 2 + i_; \
        const char* src_ = (const char*)(QI + ((size_t)b_ * SEQ + qg_ * 16 + row_) * 512) + ((lane ^ (row_ & 15)) * 16); \
        __builtin_amdgcn_global_load_lds((const unsigned*)src_, (LAS unsigned*)(qbuf + (buf_) * 16384 + row_ * 1024), 16, 0, 0); } } while (0)
    const int nround = (nitems + G - 1) / G;
    if (P3_ITEM(0) < nitems) P3_QDMA(P3_ITEM(0), 0);
    v4u wvn = (v4u){0u, 0u, 0u, 0u};
    if (P3_ITEM(0) < nitems) { const int it0 = P3_ITEM(0); wvn = *(const v4u*)(KW + ((size_t)(it0 % nb) * SEQ + (127 - it0 / nb) * 16 + q) * 128 + 64); }
    for (int k = 0; k < nround; ++k) {
        const int it = P3_ITEM(k); if (it >= nitems) break;
        const int qg = 127 - it / nb, b = it % nb, q0 = qg * 16, qme = q0 + q;
        unsigned* Mb = MASK + (size_t)b * 64 * 2048;
        const int kb_hi = ((qg >> 3) + 1) << 2, nkb = (qg >> 1) + 1;
        asm volatile("s_waitcnt vmcnt(0) lgkmcnt(0)\n\ts_barrier" ::: "memory");
        const v4u wv = wvn;
        { const int itn = P3_ITEM(k + 1); if (k + 1 < nround && itn < nitems) { P3_QDMA(itn, (k + 1) & 1); wvn = *(const v4u*)(KW + ((size_t)(itn % nb) * SEQ + (127 - itn / nb) * 16 + q) * 128 + 64); } }
        if (qg < 16) {
            if (tid < kb_hi * 16) { const int kb = tid >> 4, qq = q0 + (tid & 15), nbits = qq - kb * 32 + 1; Mb[kb * 2048 + qq] = nbits >= 32 ? 0xffffffffu : (nbits <= 0 ? 0u : ((1u << nbits) - 1u)); }
            continue;
        }
        float wq[8];
        { const float cc = 0.35355339059327373f * 0.125f;
          wq[0] = pg8::bf_lo(wv.x) * cc; wq[1] = pg8::bf_hi(wv.x) * cc; wq[2] = pg8::bf_lo(wv.y) * cc; wq[3] = pg8::bf_hi(wv.y) * cc; wq[4] = pg8::bf_lo(wv.z) * cc; wq[5] = pg8::bf_hi(wv.z) * cc; wq[6] = pg8::bf_lo(wv.w) * cc; wq[7] = pg8::bf_hi(wv.w) * cc; }
        bf16x8_t qfr[8][2], qlin[2];
        { const LAS unsigned char* qrow = qbuf + (k & 1) * 16384 + q * 1024;
#pragma unroll
          for (int h = 0; h < 8; ++h)
#pragma unroll
            for (int ks = 0; ks < 2; ++ks) qfr[h][ks] = *(const LAS bf16x8_t*)(qrow + (((h * 8 + ks * 4 + g) ^ q) * 16)); }
#pragma unroll
        for (int ks = 0; ks < 2; ++ks) { float f[8];
#pragma unroll
            for (int j = 0; j < 8; ++j) { float s = 0.f;
#pragma unroll
                for (int h = 0; h < 8; ++h) s += wq[h] * __uint_as_float((unsigned)(unsigned short)qfr[h][ks][j] << 16);
                f[j] = s; }
            v4u o; o.x = pk2(f[0], f[1]); o.y = pk2(f[2], f[3]); o.z = pk2(f[4], f[5]); o.w = pk2(f[6], f[7]); qlin[ks] = __builtin_bit_cast(bf16x8_t, o); }
#pragma unroll
        for (int i = 0; i < 8; ++i) hist[i * 512 + tid] = 0u;
        const bf16* kbase = KIN + ((size_t)b * SEQ + q) * 64 + g * 8;
        bf16x8_t afr[2][2], afn[2][2];
#pragma unroll
        for (int t = 0; t < 2; ++t)
#pragma unroll
            for (int ks = 0; ks < 2; ++ks) afn[t][ks] = *(const bf16x8_t*)(kbase + (size_t)(w * 32 + t * 16) * 64 + ks * 32);
        for (int s = 0, kb = w; kb < nkb; ++s, kb += 8) {
#pragma unroll
            for (int t = 0; t < 2; ++t)
#pragma unroll
                for (int ks = 0; ks < 2; ++ks) afr[t][ks] = afn[t][ks];
            if (kb + 8 < nkb) {
#pragma unroll
                for (int t = 0; t < 2; ++t)
#pragma unroll
                    for (int ks = 0; ks < 2; ++ks) afn[t][ks] = *(const bf16x8_t*)(kbase + (size_t)((kb + 8) * 32 + t * 16) * 64 + ks * 32); }
#pragma unroll
            for (int t = 0; t < 2; ++t) {
                f32x4_t sacc = f32x4_t{};
#pragma unroll
                for (int ks = 0; ks < 2; ++ks) sacc = __builtin_amdgcn_mfma_f32_16x16x32_bf16(afr[t][ks], qlin[ks], sacc, 0, 0, 0);
#pragma unroll
                for (int h = 0; h < 8; ++h) { f32x4_t d = f32x4_t{};
#pragma unroll
                    for (int ks = 0; ks < 2; ++ks) d = __builtin_amdgcn_mfma_f32_16x16x32_bf16(afr[t][ks], qfr[h][ks], d, 0, 0, 0);
#pragma unroll
                    for (int r = 0; r < 4; ++r) sacc[r] = fmaf(fabsf(d[r]), wq[h], sacc[r]); }
#pragma unroll
                for (int i = 0; i < 2; ++i) { unsigned k2[2];
#pragma unroll
                    for (int e = 0; e < 2; ++e) { const int r = 2 * i + e; unsigned kk_ = key15_of(sacc[r]); if (kb * 32 + t * 16 + 4 * g + r > qme) kk_ = 0u; k2[e] = kk_;
                        const unsigned dg = kk_ >> 10; (void)__hip_atomic_fetch_add((LAS unsigned*)&hist[(dg >> 2) * 512 + tid], 1u << ((dg & 3u) * 8u), __ATOMIC_RELAXED, __HIP_MEMORY_SCOPE_WORKGROUP); }
                    keys[(s * 4 + t * 2 + i) * 512 + tid] = k2[0] | (k2[1] << 16); }
            }
        }
        int need = 256, bsel;
        p3_merge(hist, tot, w, g, q, need, bsel);
        unsigned prefix = (unsigned)bsel;
#pragma unroll
        for (int pass = 0; pass < 2; ++pass) {
            const int sh_hi = pass == 0 ? 10 : 5, sh = pass == 0 ? 5 : 0;
#pragma unroll
            for (int i = 0; i < 8; ++i) hist[i * 512 + tid] = 0u;
#pragma unroll
            for (int s = 0; s < 8; ++s) if (w + 8 * s < nkb) {
#pragma unroll
                for (int i = 0; i < 4; ++i) { const unsigned d2 = keys[(s * 4 + i) * 512 + tid];
#pragma unroll
                    for (int e = 0; e < 2; ++e) { const unsigned kk_ = e ? (d2 >> 16) : (d2 & 0xffffu);
                        if ((kk_ >> sh_hi) == prefix) { const unsigned dg = (kk_ >> sh) & 31u; (void)__hip_atomic_fetch_add((LAS unsigned*)&hist[(dg >> 2) * 512 + tid], 1u << ((dg & 3u) * 8u), __ATOMIC_RELAXED, __HIP_MEMORY_SCOPE_WORKGROUP); } } } }
            p3_merge(hist, tot, w, g, q, need, bsel);
            prefix = (prefix << 5) | (unsigned)bsel;
        }
        const unsigned tau = prefix; const int need_eq = need;
        unsigned gtw[8], eqw[8];
#pragma unroll
        for (int s = 0; s < 8; ++s) { const int kb = w + 8 * s; gtw[s] = 0u; eqw[s] = 0u;
            if (kb < nkb) { unsigned gg = 0u, qq = 0u;
#pragma unroll
                for (int i = 0; i < 4; ++i) { const unsigned d2 = keys[(s * 4 + i) * 512 + tid];
#pragma unroll
                    for (int e = 0; e < 2; ++e) { const unsigned kk_ = e ? (d2 >> 16) : (d2 & 0xffffu); const int bit = (i >> 1) * 16 + 4 * g + (i & 1) * 2 + e;
                        gg |= (kk_ > tau ? 1u : 0u) << bit; qq |= (kk_ == tau ? 1u : 0u) << bit; } }
                gg |= (unsigned)__shfl_xor((int)gg, 16); gg |= (unsigned)__shfl_xor((int)gg, 32); qq |= (unsigned)__shfl_xor((int)qq, 16); qq |= (unsigned)__shfl_xor((int)qq, 32);
                gtw[s] = gg; eqw[s] = qq;
                if (g == 0) Tt[q * 64 + kb] = (unsigned char)__builtin_popcount(qq); } }
        __syncthreads();
        { unsigned run = 0u;
#pragma unroll
          for (int s = 0; s < 8; ++s) { const int kb = w + 8 * s;
            if (kb < nkb) { const unsigned g0 = *(const LAS unsigned*)(Tt + q * 64 + 8 * s), g1 = *(const LAS unsigned*)(Tt + q * 64 + 8 * s + 4);
                const unsigned m0 = w >= 4 ? g0 : (w == 0 ? 0u : (g0 & ((1u << (8 * w)) - 1u))), m1 = w > 4 ? (g1 & ((1u << (8 * (w - 4))) - 1u)) : 0u;
                const int pre = (int)(run + sad4(m0) + sad4(m1)), m = need_eq - pre, pc = __builtin_popcount(eqw[s]);
                unsigned se = eqw[s];
                if (m < pc) { se = 0u; unsigned x = eqw[s]; for (int i = 0; i < m; ++i) { const unsigned bb = x & (0u - x); se |= bb; x ^= bb; } }
                if (g == 0) Mb[kb * 2048 + qme] = gtw[s] | se;
                run += sad4(g0) + sad4(g1); } } }
        if (tid < (kb_hi - nkb) * 16) Mb[(nkb + (tid >> 4)) * 2048 + q0 + (tid & 15)] = 0u;
    }
    asm volatile("s_waitcnt vmcnt(0) lgkmcnt(0)" ::: "memory");
    __syncthreads();
#undef P3_ITEM
#undef P3_QDMA
}

namespace att {
using bf16x8 = __attribute__((ext_vector_type(8))) short;
using s16x4  = __attribute__((ext_vector_type(4))) short;
using u32x4  = __attribute__((ext_vector_type(4))) unsigned;
constexpr int KVBLK = 64;
constexpr size_t SHM_V = KVBLK * 128 * 2, SHM_K = KVBLK * 128 * 2;
constexpr int OFF_WS = 65536, OFF_MK = 65536 + 2048, OFF_Q = 65536 + 2048 + 8192, QPITCH = 272;
constexpr float THR2 = 11.5f;
#define KSWZ(row, colB) ((row) * 256 + ((colB) ^ (((row) & 7) << 4)))
#define SBAR() __builtin_amdgcn_sched_barrier(0)
__device__ __forceinline__ unsigned cvtpk(float lo, float hi) { unsigned r; asm volatile("v_cvt_pk_bf16_f32 %0, %1, %2" : "=v"(r) : "v"(lo), "v"(hi)); return r; }
__device__ __forceinline__ float msk(float p, unsigned w, int bit) { const int m = __builtin_amdgcn_sbfe((int)w, bit, 1); return __uint_as_float((__float_as_uint(p) & (unsigned)m) | (0xff800000u & ~(unsigned)m)); }
__device__ __forceinline__ void partialSM(f32x16& p0, f32x16& p1, unsigned w0, unsigned w1, float& m_reg, float& mn, float& alpha) {
#pragma unroll
  for (int r = 0; r < 16; ++r) { const int bit = (r & 3) + 8 * (r >> 2); p0[r] = msk(p0[r], w0, bit); p1[r] = msk(p1[r], w1, bit); }
  float pmax = p0[0];
#pragma unroll
  for (int r = 1; r < 16; ++r) pmax = fmaxf(pmax, p0[r]);
#pragma unroll
  for (int r = 0; r < 16; ++r) pmax = fmaxf(pmax, p1[r]);
  { auto rr = __builtin_amdgcn_permlane32_swap(__float_as_uint(pmax), __float_as_uint(pmax), false, false); pmax = fmaxf(__uint_as_float(rr[0]), __uint_as_float(rr[1])); }
  if (__builtin_expect(__all(pmax - m_reg <= THR2), 1)) { mn = m_reg; alpha = 1.f; }
  else { mn = fmaxf(m_reg, pmax); alpha = __builtin_amdgcn_exp2f(m_reg - mn); m_reg = mn; }
#pragma unroll
  for (int r = 0; r < 16; ++r) { p0[r] -= mn; p1[r] -= mn; }
#pragma unroll
  for (int r = 0; r < 16; ++r) p0[r] = __builtin_amdgcn_exp2f(p0[r]);
}
__device__ __forceinline__ void finishSM(f32x16& p0, f32x16& p1, float alpha, float& l_reg, bf16x8& pa0, bf16x8& pa1, bf16x8& pa2, bf16x8& pa3) {
#pragma unroll
  for (int r = 0; r < 16; ++r) p1[r] = __builtin_amdgcn_exp2f(p1[r]);
  float ps = 0;
#pragma unroll
  for (int r = 0; r < 16; ++r) ps += p0[r];
#pragma unroll
  for (int r = 0; r < 16; ++r) ps += p1[r];
  { auto rr = __builtin_amdgcn_permlane32_swap(__float_as_uint(ps), __float_as_uint(ps), false, false); ps = __uint_as_float(rr[0]) + __uint_as_float(rr[1]); }
  l_reg = l_reg * alpha + ps;
#define PK4(P, BASE, OUT) do { unsigned a0 = cvtpk(P[BASE + 0], P[BASE + 1]), a1 = cvtpk(P[BASE + 2], P[BASE + 3]);   \
    unsigned b0 = cvtpk(P[BASE + 4], P[BASE + 5]), b1 = cvtpk(P[BASE + 6], P[BASE + 7]);                              \
    auto r0 = __builtin_amdgcn_permlane32_swap(a0, b0, false, false); auto r1 = __builtin_amdgcn_permlane32_swap(a1, b1, false, false); \
    u32x4 w = {r0[0], r1[0], r0[1], r1[1]}; OUT = *reinterpret_cast<bf16x8*>(&w); } while (0)
  PK4(p0, 0, pa0); PK4(p0, 8, pa1); PK4(p1, 0, pa2); PK4(p1, 8, pa3);
#undef PK4
}
__device__ __forceinline__ void qkt(f32x16& p0, f32x16& p1, const char* Ks, const char* qrow, const float (&bo)[16], float kb0, float kb1, int r32, int hi) {
#pragma unroll
  for (int r = 0; r < 16; ++r) { p0[r] = bo[r] + kb0; p1[r] = bo[r] + kb1; }
#pragma unroll
  for (int d0 = 0; d0 < 8; ++d0) { const int cb = (d0 * 16 + hi * 8) * 2;
    const bf16x8 b0 = *reinterpret_cast<const bf16x8*>(Ks + KSWZ(r32, cb));
    const bf16x8 b1 = *reinterpret_cast<const bf16x8*>(Ks + KSWZ(32 + r32, cb));
    const bf16x8 qf = *reinterpret_cast<const bf16x8*>(qrow + d0 * 32);
    p0 = __builtin_amdgcn_mfma_f32_32x32x16_bf16(b0, qf, p0, 0, 0, 0);
    p1 = __builtin_amdgcn_mfma_f32_32x32x16_bf16(b1, qf, p1, 0, 0, 0); }
}
__device__ __forceinline__ int v_st(int k, int c) { const int kk = (k & ~0xC) | ((k & 4) << 1) | ((k & 8) >> 1); return ((kk >> 3) * 4 + (c >> 5)) * 512 + ((kk & 7) * 32 + (c & 31)) * 2; }
__device__ __forceinline__ int v_rd_base(int lane) { return ((lane & 3) << 3) | (((lane >> 2) & 3) << 6) | (((lane >> 4) & 1) << 5) | (((lane >> 5) & 1) << 8); }
constexpr int v_rd_off(int d0, int ks, int half) { return d0 * 512 + ks * 4096 + half * 2048; }
template <int OFF> __device__ __forceinline__ s16x4 tr_read(int vb) { s16x4 r; asm volatile("ds_read_b64_tr_b16 %0, %1 offset:%2" : "=&v"(r) : "v"(vb), "i"(OFF) : "memory"); return r; }
template <int D0> __device__ __forceinline__ void pv_one(f32x16& od, int vb, bf16x8 pa0, bf16x8 pa1, bf16x8 pa2, bf16x8 pa3) {
  const s16x4 l0 = tr_read<v_rd_off(D0, 0, 0)>(vb), h0 = tr_read<v_rd_off(D0, 0, 1)>(vb), l1 = tr_read<v_rd_off(D0, 1, 0)>(vb), h1 = tr_read<v_rd_off(D0, 1, 1)>(vb);
  const s16x4 l2 = tr_read<v_rd_off(D0, 2, 0)>(vb), h2 = tr_read<v_rd_off(D0, 2, 1)>(vb), l3 = tr_read<v_rd_off(D0, 3, 0)>(vb), h3 = tr_read<v_rd_off(D0, 3, 1)>(vb);
  asm volatile("s_waitcnt lgkmcnt(0)" ::: "memory"); SBAR();
#define PK(L, H) (bf16x8){L[0], L[1], L[2], L[3], H[0], H[1], H[2], H[3]}
  od = __builtin_amdgcn_mfma_f32_32x32x16_bf16(pa0, PK(l0, h0), od, 0, 0, 0);
  od = __builtin_amdgcn_mfma_f32_32x32x16_bf16(pa1, PK(l1, h1), od, 0, 0, 0);
  od = __builtin_amdgcn_mfma_f32_32x32x16_bf16(pa2, PK(l2, h2), od, 0, 0, 0);
  od = __builtin_amdgcn_mfma_f32_32x32x16_bf16(pa3, PK(l3, h3), od, 0, 0, 0);
#undef PK
}
__device__ __forceinline__ void pv_d0(f32x16* o, int vb, bf16x8 pa0, bf16x8 pa1, bf16x8 pa2, bf16x8 pa3) {
  pv_one<0>(o[0], vb, pa0, pa1, pa2, pa3); pv_one<1>(o[1], vb, pa0, pa1, pa2, pa3); pv_one<2>(o[2], vb, pa0, pa1, pa2, pa3); pv_one<3>(o[3], vb, pa0, pa1, pa2, pa3);
}
__device__ __forceinline__ void attn_item(const bf16* __restrict__ Qb, const bf16* __restrict__ Kh, const bf16* __restrict__ Vh, const unsigned* __restrict__ Mq, bf16* __restrict__ Ob, int NT, char* lds, LAS unsigned char* ldsL) {
  const int tid = threadIdx.x, wid = __builtin_amdgcn_readfirstlane(tid >> 6), lane = tid & 63, r32 = lane & 31, hi = lane >> 5;
  float* ws = (float*)(lds + OFF_WS) + wid * 64; float* li_l = ws; float* al_l = ws + 32;
  unsigned* mk = (unsigned*)(lds + OFF_MK);
  unsigned soff[4];
#pragma unroll
  for (int i = 0; i < 4; ++i) { const int pc = (wid & 3) * 4 + i;
    if (wid < 4) { const int row = pc * 4 + (lane >> 4), cb = (lane & 15) * 16; soff[i] = (unsigned)(row * 256 + (cb ^ ((row & 7) << 4))); }
    else { const int L = pc * 1024 + lane * 16, st = L >> 9, wi = L & 511, kk = (st >> 2) * 8 + (wi >> 6), c = (st & 3) * 32 + ((wi & 63) >> 1), k = (kk & ~0xC) | ((kk & 4) << 1) | ((kk & 8) >> 1);
           soff[i] = (unsigned)(k * 256 + c * 2); } }
  const char* gsrc = (const char*)(wid < 4 ? Kh : Vh);
  const unsigned ldst = (unsigned)((wid < 4 ? 0 : 16384) + (wid & 3) * 4096);
#define DMA_TILE(t, slot) do { _Pragma("unroll") for (int i_ = 0; i_ < 4; ++i_) \
    __builtin_amdgcn_global_load_lds((const unsigned*)(gsrc + (size_t)(t) * (64 * 256) + soff[i_]), (LAS unsigned*)(ldsL + (slot) * 32768 + ldst + i_ * 1024), 16, 0, 0); } while (0)
  DMA_TILE(0, 0);
  float m_reg = -1e30f, l_reg = 0; f32x16 o[4] = {}; bf16x8 qr[8];
  { const bf16* Qw = Qb + (size_t)r32 * 1024 + wid * 128 + hi * 8; float ss = 0.f;
#pragma unroll
    for (int d0 = 0; d0 < 8; ++d0) qr[d0] = *reinterpret_cast<const bf16x8*>(Qw + d0 * 16);
    unsigned mv[4];
#pragma unroll
    for (int i = 0; i < 4; ++i) { const int idx = tid + 512 * i; mv[i] = idx < NT * 64 ? Mq[(size_t)(idx >> 5) * 2048 + (idx & 31)] : 0u; }
#pragma unroll
    for (int i = 0; i < 4; ++i) { const int idx = tid + 512 * i; if (idx < NT * 64) mk[idx] = mv[i]; }
#pragma unroll
    for (int d0 = 0; d0 < 8; ++d0) ss += sumsq8(qr[d0]);
    ss = xhalf_sum(ss); const float rq = rsqrtf(ss * (1.f / 128.f) + EPS);
#pragma unroll
    for (int d0 = 0; d0 < 8; ++d0) { float f[8];
#pragma unroll
      for (int j = 0; j < 8; ++j) f[j] = __uint_as_float((unsigned)(unsigned short)qr[d0][j] << 16) * rq;
      u32x4 w = {cvtpk(f[0], f[1]), cvtpk(f[2], f[3]), cvtpk(f[4], f[5]), cvtpk(f[6], f[7])}; qr[d0] = *reinterpret_cast<bf16x8*>(&w); } }
  const float slope2 = __builtin_amdgcn_exp2f(-(float)(wid + 1)) * 1.4426950408889634f;
  float bo[16];
#pragma unroll
  for (int r = 0; r < 16; ++r) bo[r] = __uint_as_float(__builtin_amdgcn_readfirstlane(__float_as_uint(slope2 * (float)((r & 3) + 8 * (r >> 2)))));
  const float hoff = slope2 * (float)(4 * hi);
  const int vb0 = (int)(uintptr_t)(lds + 16384) + v_rd_base(lane);
  asm volatile("s_waitcnt vmcnt(0) lgkmcnt(0)\n\ts_barrier" ::: "memory");
  for (int j = 0; j < NT; ++j) {
    const int sl = j & 1;
    if (j + 1 < NT) DMA_TILE(j + 1, sl ^ 1);
    const char* Ks = lds + sl * 32768;
    const unsigned w0 = mk[(2 * j) * 32 + r32] >> (4 * hi), w1 = mk[(2 * j + 1) * 32 + r32] >> (4 * hi);
    f32x16 p0, p1;
    { const float kb0 = slope2 * (float)(j * 64) + hoff, kb1 = kb0 + slope2 * 32.f;
#pragma unroll
      for (int r = 0; r < 16; ++r) { p0[r] = bo[r] + kb0; p1[r] = bo[r] + kb1; }
      bf16x8 ka = *reinterpret_cast<const bf16x8*>(Ks + KSWZ(r32, hi * 16)), kb = *reinterpret_cast<const bf16x8*>(Ks + KSWZ(32 + r32, hi * 16));
#pragma unroll
      for (int d0 = 0; d0 < 8; ++d0) { bf16x8 na = ka, nb = kb;
        if (d0 < 7) { const int cb = ((d0 + 1) * 16 + hi * 8) * 2; na = *reinterpret_cast<const bf16x8*>(Ks + KSWZ(r32, cb)); nb = *reinterpret_cast<const bf16x8*>(Ks + KSWZ(32 + r32, cb)); }
        SBAR();
        p0 = __builtin_amdgcn_mfma_f32_32x32x16_bf16(ka, qr[d0], p0, 0, 0, 0);
        p1 = __builtin_amdgcn_mfma_f32_32x32x16_bf16(kb, qr[d0], p1, 0, 0, 0);
        SBAR();
        ka = na; kb = nb; } }
    float alpha; bf16x8 pa0, pa1, pa2, pa3;
    {
#pragma unroll
      for (int r = 0; r < 16; ++r) { const int bit = (r & 3) + 8 * (r >> 2); p0[r] = msk(p0[r], w0, bit); p1[r] = msk(p1[r], w1, bit); }
      float pmax = fmaxf(p0[0], p1[0]);
#pragma unroll
      for (int r = 1; r < 16; ++r) pmax = fmaxf(fmaxf(pmax, p0[r]), p1[r]);
      { auto rr = __builtin_amdgcn_permlane32_swap(__float_as_uint(pmax), __float_as_uint(pmax), false, false); pmax = fmaxf(__uint_as_float(rr[0]), __uint_as_float(rr[1])); }
      float mn;
      if (__builtin_expect(__all(pmax - m_reg <= THR2), 1)) { mn = m_reg; alpha = 1.f; }
      else { mn = fmaxf(m_reg, pmax); alpha = __builtin_amdgcn_exp2f(m_reg - mn); m_reg = mn; }
      float ps = 0.f;
#pragma unroll
      for (int r = 0; r < 16; ++r) { p0[r] = __builtin_amdgcn_exp2f(p0[r] - mn); p1[r] = __builtin_amdgcn_exp2f(p1[r] - mn); ps += p0[r] + p1[r]; }
      { auto rr = __builtin_amdgcn_permlane32_swap(__float_as_uint(ps), __float_as_uint(ps), false, false); ps = __uint_as_float(rr[0]) + __uint_as_float(rr[1]); }
      l_reg = l_reg * alpha + ps;
#define PK4(P, BASE, OUT) do { unsigned a0 = cvtpk(P[BASE + 0], P[BASE + 1]), a1 = cvtpk(P[BASE + 2], P[BASE + 3]);   \
    unsigned b0 = cvtpk(P[BASE + 4], P[BASE + 5]), b1 = cvtpk(P[BASE + 6], P[BASE + 7]);                              \
    auto r0 = __builtin_amdgcn_permlane32_swap(a0, b0, false, false); auto r1 = __builtin_amdgcn_permlane32_swap(a1, b1, false, false); \
    u32x4 w = {r0[0], r1[0], r0[1], r1[1]}; OUT = *reinterpret_cast<bf16x8*>(&w); } while (0)
      PK4(p0, 0, pa0); PK4(p0, 8, pa1); PK4(p1, 0, pa2); PK4(p1, 8, pa3);
#undef PK4
      if (__any(alpha < 1.f)) { if (hi == 0) al_l[r32] = alpha; asm volatile("s_waitcnt lgkmcnt(0)" ::: "memory");
#pragma unroll
        for (int d = 0; d < 4; ++d)
#pragma unroll
          for (int r = 0; r < 16; ++r) o[d][r] *= al_l[crow(r, hi)]; }
    }
    { const int vb = vb0 + sl * 32768;
      s16x4 lA[4], hA[4], lB[4], hB[4];
#define VREADS(L_, H_, D0) do { L_[0] = tr_read<v_rd_off(D0, 0, 0)>(vb); H_[0] = tr_read<v_rd_off(D0, 0, 1)>(vb); L_[1] = tr_read<v_rd_off(D0, 1, 0)>(vb); H_[1] = tr_read<v_rd_off(D0, 1, 1)>(vb); \
      L_[2] = tr_read<v_rd_off(D0, 2, 0)>(vb); H_[2] = tr_read<v_rd_off(D0, 2, 1)>(vb); L_[3] = tr_read<v_rd_off(D0, 3, 0)>(vb); H_[3] = tr_read<v_rd_off(D0, 3, 1)>(vb); } while (0)
#define PK(L, H) (bf16x8){L[0], L[1], L[2], L[3], H[0], H[1], H[2], H[3]}
#define VMMA(OD, L_, H_) do { OD = __builtin_amdgcn_mfma_f32_32x32x16_bf16(pa0, PK(L_[0], H_[0]), OD, 0, 0, 0); OD = __builtin_amdgcn_mfma_f32_32x32x16_bf16(pa1, PK(L_[1], H_[1]), OD, 0, 0, 0); \
      OD = __builtin_amdgcn_mfma_f32_32x32x16_bf16(pa2, PK(L_[2], H_[2]), OD, 0, 0, 0); OD = __builtin_amdgcn_mfma_f32_32x32x16_bf16(pa3, PK(L_[3], H_[3]), OD, 0, 0, 0); } while (0)
#define VWAIT(N, L_, H_) do { asm volatile("s_waitcnt lgkmcnt(" #N ")" : "+v"(L_[0]), "+v"(L_[1]), "+v"(L_[2]), "+v"(L_[3]), "+v"(H_[0]), "+v"(H_[1]), "+v"(H_[2]), "+v"(H_[3]) :: "memory"); SBAR(); } while (0)
      VREADS(lA, hA, 0); VREADS(lB, hB, 1);
      VWAIT(8, lA, hA); VMMA(o[0], lA, hA);
      VREADS(lA, hA, 2);
      VWAIT(8, lB, hB); VMMA(o[1], lB, hB);
      VREADS(lB, hB, 3);
      VWAIT(8, lA, hA); VMMA(o[2], lA, hA);
      VWAIT(0, lB, hB); VMMA(o[3], lB, hB);
#undef VREADS
#undef PK
#undef VMMA
#undef VWAIT
    }
    asm volatile("s_waitcnt vmcnt(0) lgkmcnt(0)\n\ts_barrier" ::: "memory");
  }
  if (hi == 0) li_l[r32] = l_reg; asm volatile("s_waitcnt lgkmcnt(0)" ::: "memory");
  float rli[16];
#pragma unroll
  for (int r = 0; r < 16; ++r) rli[r] = __builtin_amdgcn_rcpf(li_l[crow(r, hi)]);
  unsigned char* stg = (unsigned char*)(lds + wid * 4096);
#pragma unroll
  for (int r = 0; r < 16; ++r) { const int orow = crow(r, hi); const float sc16 = rli[r] * 16.f;
#pragma unroll
    for (int d0 = 0; d0 < 4; ++d0) stg[orow * 128 + d0 * 32 + r32] = (unsigned char)__builtin_amdgcn_cvt_pk_fp8_f32(o[d0][r] * sc16, 0.f, 0, false); }
  asm volatile("s_waitcnt lgkmcnt(0)" ::: "memory");
#pragma unroll
  for (int i = 0; i < 4; ++i) { const int row = i * 8 + (lane >> 3), ch = lane & 7; const u32x4 v = *(const u32x4*)(stg + row * 128 + ch * 16);
    *(u32x4*)((unsigned char*)Ob + (size_t)row * 2048 + wid * 128 + ch * 16) = v; }
#undef DMA_TILE
}
#undef KSWZ
#undef SBAR
}


namespace ret {
using bf16x8 = __attribute__((ext_vector_type(8))) short;
using s16x4  = __attribute__((ext_vector_type(4))) short;
using u32x4  = __attribute__((ext_vector_type(4))) unsigned;
using u32x2  = __attribute__((ext_vector_type(2))) unsigned;
constexpr int C = 64, QP = 272, KPI = 272, VP = 576;
constexpr int OFF_Q = 0, OFF_K = 17408, OFF_V = 34816, OFF_ST = 71680, OFF_Y = 75776;
typedef float f32x2_t __attribute__((ext_vector_type(2))); typedef __bf16 bf16x2_t __attribute__((ext_vector_type(2)));
__device__ __forceinline__ unsigned cvtpk(float lo, float hi) { const f32x2_t v = {lo, hi}; const bf16x2_t b = __builtin_convertvector(v, bf16x2_t); return __builtin_bit_cast(unsigned, b); }
template <int OFF> __device__ __forceinline__ s16x4 trr(int base) { s16x4 r; asm volatile("ds_read_b64_tr_b16 %0, %1 offset:%2" : "=&v"(r) : "v"(base), "i"(OFF) : "memory"); return r; }
__device__ __forceinline__ bf16x8 pk8(const f32x16& x, int s) { u32x4 w = {cvtpk(x[8 * s + 0], x[8 * s + 1]), cvtpk(x[8 * s + 2], x[8 * s + 3]), cvtpk(x[8 * s + 4], x[8 * s + 5]), cvtpk(x[8 * s + 6], x[8 * s + 7])}; return *reinterpret_cast<bf16x8*>(&w); }
__device__ __forceinline__ float silu_(float x) { return x * __builtin_amdgcn_rcpf(1.f + __builtin_amdgcn_exp2f(-1.4426950408889634f * x)); }
__device__ __forceinline__ void ret_item(int b, int h, const bf16* __restrict__ RQ, const bf16* __restrict__ RK, const bf16* __restrict__ RV, const bf16* __restrict__ RG, unsigned char* A2F8, const float* __restrict__ gnorm, char* lds, int c0, int c1, float* state) {
  const int tid = threadIdx.x, w = __builtin_amdgcn_readfirstlane(tid >> 6), lane = tid & 63, r32 = lane & 31, hi = lane >> 5;
  const float lg = __log2f(1.f - exp2f(-5.f - (float)h)), gC = exp2f(64.f * lg);
  char* Qs = lds + OFF_Q; char* Ks = lds + OFF_K; char* Vs = lds + OFF_V; float* st = (float*)(lds + OFF_ST); char* Ys = lds + OFF_Y;
  f32x16 S[4] = {};
  if (c0 > 0) {
#pragma unroll
    for (int dt = 0; dt < 4; ++dt)
#pragma unroll
      for (int r = 0; r < 16; ++r) S[dt][r] = state[(dt * 16 + r) * 512 + tid]; }
  const unsigned voffQ = (unsigned)(((tid >> 4) * 512 + (tid & 15) * 8) * 2), voffV = (unsigned)(((tid >> 5) * 1024 + (tid & 31) * 8) * 2);
  const int trq = (lane & 15) >> 2, trp = lane & 3, trg = (lane >> 4) & 1;
  const int vtb = (int)(uintptr_t)(lds + OFF_V) + (4 * hi + trq) * VP + (32 * w + 16 * trg + 4 * trp) * 2, ktb = (int)(uintptr_t)(lds + OFF_K) + (4 * hi + trq) * KPI + (16 * trg + 4 * trp) * 2;
  u32x4 pq[2], pk[2], pv[4];
#define RET_LOAD(cc) do { const size_t t0_ = (size_t)b * SEQ + (size_t)(cc) * C; const char* qb_ = (const char*)(RQ + t0_ * 512 + h * 128); const char* kb_ = (const char*)(RK + t0_ * 512 + h * 128); const char* vb_ = (const char*)(RV + t0_ * 1024 + h * 256); \
    _Pragma("unroll") for (int i = 0; i < 2; ++i) { pq[i] = *(const u32x4*)(qb_ + voffQ + i * 32768); pk[i] = *(const u32x4*)(kb_ + voffQ + i * 32768); } \
    _Pragma("unroll") for (int i = 0; i < 4; ++i) pv[i] = *(const u32x4*)(vb_ + voffV + i * 32768); } while (0)
#define RET_STAGE() do { \
    _Pragma("unroll") for (int i = 0; i < 2; ++i) { const int row = (tid >> 4) + 32 * i, ch = tid & 15; \
      *(u32x4*)(Qs + row * QP + ch * 16) = pq[i]; \
      const u32x4 kv = pk[i]; const float f = exp2f(lg * (float)(C - 1 - row)) * 0.08838834764831845f; \
      u32x4 ko; ko.x = cvtpk(pg8::bf_lo(kv.x) * f, pg8::bf_hi(kv.x) * f); ko.y = cvtpk(pg8::bf_lo(kv.y) * f, pg8::bf_hi(kv.y) * f); ko.z = cvtpk(pg8::bf_lo(kv.z) * f, pg8::bf_hi(kv.z) * f); ko.w = cvtpk(pg8::bf_lo(kv.w) * f, pg8::bf_hi(kv.w) * f); \
      *(u32x4*)(Ks + row * KPI + ch * 16) = ko; } \
    _Pragma("unroll") for (int i = 0; i < 4; ++i) { const int row = (tid >> 5) + 16 * i, ch = tid & 31; *(u32x4*)(Vs + row * VP + ch * 16) = pv[i]; } } while (0)
  RET_LOAD(c0);
  __syncthreads();
  RET_STAGE();
  if (c0 + 1 < c1) RET_LOAD(c0 + 1);
  __syncthreads();
  for (int c = c0; c < c1; ++c) {
    const size_t tok0 = (size_t)b * SEQ + (size_t)c * C;
    f32x16 ot[2] = {};
#pragma unroll
    for (int dt = 0; dt < 4; ++dt) {
#pragma unroll
      for (int s = 0; s < 2; ++s) { const bf16x8 af = pk8(S[dt], s);
#pragma unroll
        for (int nt = 0; nt < 2; ++nt) { const char* qp = Qs + (32 * nt + r32) * QP + (32 * dt + 16 * s + 4 * hi) * 2;
          const u32x2 lo = *(const u32x2*)qp, hi8 = *(const u32x2*)(qp + 16); const u32x4 bw = {lo.x, lo.y, hi8.x, hi8.y};
          ot[nt] = __builtin_amdgcn_mfma_f32_32x32x16_bf16(af, *reinterpret_cast<const bf16x8*>(&bw), ot[nt], 0, 0, 0); } }
      __builtin_amdgcn_sched_barrier(0); }
#pragma unroll
    for (int nt = 0; nt < 2; ++nt)
#pragma unroll
      for (int r = 0; r < 16; ++r) ot[nt][r] *= gC;
    __builtin_amdgcn_sched_barrier(0);
    bf16x8 vfr[4];
    { s16x4 vlo[4], vhi[4];
      vlo[0] = trr<0 * 16 * VP>(vtb); vhi[0] = trr<0 * 16 * VP + 8 * VP>(vtb); vlo[1] = trr<1 * 16 * VP>(vtb); vhi[1] = trr<1 * 16 * VP + 8 * VP>(vtb);
      vlo[2] = trr<2 * 16 * VP>(vtb); vhi[2] = trr<2 * 16 * VP + 8 * VP>(vtb); vlo[3] = trr<3 * 16 * VP>(vtb); vhi[3] = trr<3 * 16 * VP + 8 * VP>(vtb);
      asm volatile("s_waitcnt lgkmcnt(0)" : "+v"(vlo[0]), "+v"(vlo[1]), "+v"(vlo[2]), "+v"(vlo[3]), "+v"(vhi[0]), "+v"(vhi[1]), "+v"(vhi[2]), "+v"(vhi[3]) :: "memory"); __builtin_amdgcn_sched_barrier(0);
#pragma unroll
      for (int ks = 0; ks < 4; ++ks) vfr[ks] = (bf16x8){vlo[ks][0], vlo[ks][1], vlo[ks][2], vlo[ks][3], vhi[ks][0], vhi[ks][1], vhi[ks][2], vhi[ks][3]}; }
#pragma unroll
    for (int nt = 0; nt < 2; ++nt)
#pragma unroll
      for (int jt = 0; jt <= nt; ++jt) { f32x16 pt = {};
#pragma unroll
        for (int kk = 0; kk < 8; ++kk) { const bf16x8 ka = *(const bf16x8*)(Ks + (32 * jt + r32) * KPI + (16 * kk + 8 * hi) * 2), qb = *(const bf16x8*)(Qs + (32 * nt + r32) * QP + (16 * kk + 8 * hi) * 2);
          pt = __builtin_amdgcn_mfma_f32_32x32x16_bf16(ka, qb, pt, 0, 0, 0); }
        if (jt == nt) {
#pragma unroll
          for (int r = 0; r < 16; ++r) if (crow(r, hi) > r32) pt[r] = 0.f; }
#pragma unroll
        for (int s = 0; s < 2; ++s) ot[nt] = __builtin_amdgcn_mfma_f32_32x32x16_bf16(vfr[2 * jt + s], pk8(pt, s), ot[nt], 0, 0, 0);
        __builtin_amdgcn_sched_barrier(0); }
#pragma unroll
    for (int dt = 0; dt < 4; ++dt) {
#pragma unroll
      for (int r = 0; r < 16; ++r) S[dt][r] *= gC;
      s16x4 kl[4], kh[4];
      kl[0] = trr<0 * 16 * KPI>(ktb + dt * 64); kh[0] = trr<0 * 16 * KPI + 8 * KPI>(ktb + dt * 64); kl[1] = trr<1 * 16 * KPI>(ktb + dt * 64); kh[1] = trr<1 * 16 * KPI + 8 * KPI>(ktb + dt * 64);
      kl[2] = trr<2 * 16 * KPI>(ktb + dt * 64); kh[2] = trr<2 * 16 * KPI + 8 * KPI>(ktb + dt * 64); kl[3] = trr<3 * 16 * KPI>(ktb + dt * 64); kh[3] = trr<3 * 16 * KPI + 8 * KPI>(ktb + dt * 64);
      asm volatile("s_waitcnt lgkmcnt(0)" : "+v"(kl[0]), "+v"(kl[1]), "+v"(kl[2]), "+v"(kl[3]), "+v"(kh[0]), "+v"(kh[1]), "+v"(kh[2]), "+v"(kh[3]) :: "memory"); __builtin_amdgcn_sched_barrier(0);
#pragma unroll
      for (int ks = 0; ks < 4; ++ks) S[dt] = __builtin_amdgcn_mfma_f32_32x32x16_bf16((bf16x8){kl[ks][0], kl[ks][1], kl[ks][2], kl[ks][3], kh[ks][0], kh[ks][1], kh[ks][2], kh[ks][3]}, vfr[ks], S[dt], 0, 0, 0);
      __builtin_amdgcn_sched_barrier(0); }
    u32x4 gt4[4];
    { const char* gb_ = (const char*)(RG + tok0 * 1024 + h * 256);
#pragma unroll
      for (int i = 0; i < 4; ++i) gt4[i] = *(const u32x4*)(gb_ + voffV + i * 32768); }
#pragma unroll
    for (int nt = 0; nt < 2; ++nt) { const float rs = exp2f(lg * (float)(32 * nt + r32 + 1 - C)); float s1 = 0.f, s2 = 0.f;
#pragma unroll
      for (int r = 0; r < 16; ++r) { ot[nt][r] *= rs; s1 += ot[nt][r]; s2 += ot[nt][r] * ot[nt][r]; }
      s1 = xhalf_sum(s1); s2 = xhalf_sum(s2);
      if (hi == 0) { st[(w * 64 + 32 * nt + r32) * 2] = s1; st[(w * 64 + 32 * nt + r32) * 2 + 1] = s2; } }
    __syncthreads();
    if (c + 1 < c1) { RET_STAGE(); if (c + 2 < c1) RET_LOAD(c + 2); }
#pragma unroll
    for (int nt = 0; nt < 2; ++nt) { float s1 = 0.f, s2 = 0.f;
#pragma unroll
      for (int ww = 0; ww < 8; ++ww) { s1 += st[(ww * 64 + 32 * nt + r32) * 2]; s2 += st[(ww * 64 + 32 * nt + r32) * 2 + 1]; }
      const float mu = s1 * (1.f / 256.f), var = fmaxf(s2 * (1.f / 256.f) - mu * mu, 0.f), rstd = rsqrtf(var + EPS);
#pragma unroll
      for (int g = 0; g < 4; ++g) { float y[4];
#pragma unroll
        for (int j = 0; j < 4; ++j) y[j] = (ot[nt][4 * g + j] - mu) * rstd * gnorm[h * 256 + 32 * w + 8 * g + 4 * hi + j];
        const u32x2 o2 = {cvtpk(y[0], y[1]), cvtpk(y[2], y[3])};
        *(u32x2*)(Ys + (32 * nt + r32) * VP + (32 * w + 8 * g + 4 * hi) * 2) = o2; } }
    __syncthreads();
    { unsigned char* ob_ = A2F8 + tok0 * 1024 + h * 256;
#pragma unroll
      for (int i = 0; i < 4; ++i) { const int row = (tid >> 5) + 16 * i, ch = tid & 31;
        const u32x4 yv = *(const u32x4*)(Ys + row * VP + ch * 16); const u32x4 gt = gt4[i];
        int w0 = __builtin_amdgcn_cvt_pk_fp8_f32(pg8::bf_lo(yv.x) * silu_(pg8::bf_lo(gt.x)), pg8::bf_hi(yv.x) * silu_(pg8::bf_hi(gt.x)), 0, false); w0 = __builtin_amdgcn_cvt_pk_fp8_f32(pg8::bf_lo(yv.y) * silu_(pg8::bf_lo(gt.y)), pg8::bf_hi(yv.y) * silu_(pg8::bf_hi(gt.y)), w0, true);
        int w1 = __builtin_amdgcn_cvt_pk_fp8_f32(pg8::bf_lo(yv.z) * silu_(pg8::bf_lo(gt.z)), pg8::bf_hi(yv.z) * silu_(pg8::bf_hi(gt.z)), 0, false); w1 = __builtin_amdgcn_cvt_pk_fp8_f32(pg8::bf_lo(yv.w) * silu_(pg8::bf_lo(gt.w)), pg8::bf_hi(yv.w) * silu_(pg8::bf_hi(gt.w)), w1, true);
        *(unsigned long long*)(ob_ + (size_t)row * 1024 + ch * 8) = (unsigned long long)(unsigned)w0 | ((unsigned long long)(unsigned)w1 << 32); } }
  }
  if (c1 < SEQ / C) {
#pragma unroll
    for (int dt = 0; dt < 4; ++dt)
#pragma unroll
      for (int r = 0; r < 16; ++r) state[(dt * 16 + r) * 512 + tid] = S[dt][r]; }
  __syncthreads();
#undef RET_LOAD
#undef RET_STAGE
}
}

#define A2F8_PTR (F.xbp + (size_t)16 * MiB)
constexpr int RET_SPLIT = 28;
__device__ __forceinline__ int ret_wg_index(const Frame& F) { const int bx = (int)blockIdx.x, j = bx >> 3; return (j & 3) == 0 ? ((j >> 2) * 8 + (bx & 7)) : -1; }
__device__ __forceinline__ void p4_attn(Frame& F, const Args& a, unsigned char* lds_generic) {
    const size_t nt_ = (size_t)F.ntok;
    const bf16* QA = (const bf16*)(F.act + nt_ * O_QA); bf16* ATT = (bf16*)(F.act + nt_ * O_QA);
    unsigned char* aux = a.xb + nt_ * 2048;
    const bf16* KP = (const bf16*)(aux + nt_ * AUX_KP); const bf16* VV = (const bf16*)(aux + nt_ * AUX_VV); const unsigned* MASK = (const unsigned*)(aux + nt_ * AUX_MASK);
    volatile LAS unsigned* MISC = (volatile LAS unsigned*)(F.lds + MISC_OFF);
    unsigned* qctr = (unsigned*)(F.ws + WS_CTL) + CW_Q4;
    const bf16* RQ = (const bf16*)(F.act + nt_ * O_RQ); const bf16* RK = (const bf16*)(F.act + nt_ * O_RK); const bf16* RV = (const bf16*)(F.act + nt_ * O_RV); const bf16* RG = (const bf16*)(F.act + nt_ * O_RG);
    const int nb = F.ntok / SEQ, nret = nb * 4, nitems = nb * 64;
    { const int ri = ret_wg_index(F); if (ri >= 0 && ri < nret && RET_SPLIT < SEQ / 64)
        ret::ret_item(ri >> 2, ri & 3, RQ, RK, RV, RG, A2F8_PTR, a.in[8], (char*)lds_generic, RET_SPLIT, SEQ / 64, (float*)a.xb + (size_t)ri * 32768); }
    __syncthreads(); if (F.tid == 0) MISC[0] = atomicAdd(qctr, 1u); __syncthreads();
    int it = (int)MISC[0];
    while (it < nitems) {
        unsigned nxt_ = 0u; if (F.tid == 0) nxt_ = atomicAdd(qctr, 1u);
        const int qb = 63 - it / nb, b = it % nb, NT = (qb >> 1) + 1;
        const size_t row0 = (size_t)b * SEQ + qb * 32;
        att::attn_item(QA + row0 * 1024, KP + (size_t)b * SEQ * 128, VV + (size_t)b * SEQ * 128, MASK + (size_t)b * 64 * 2048 + qb * 32, ATT + row0 * 1024, NT, (char*)lds_generic, F.lds);
        __syncthreads(); if (F.tid == 0) MISC[0] = nxt_; __syncthreads();
        it = (int)MISC[0];
    }
}


__device__ __forceinline__ void p7_router(Frame& F, const Args& a) {
    const int lane = F.lane, r32 = lane & 31, hi = lane >> 5, tid = F.tid;
    unsigned char* mo = F.act; unsigned char* N2 = mo + MO_N2; unsigned char* meta = mo + MO_META;
    int* MB = (int*)(meta + MM_B); int* MPp = (int*)(meta + MM_P); float* MCL = (float*)(meta + MM_CL); float* MCH = (float*)(meta + MM_CH); float* MRS = (float*)(meta + MM_RS);
    const bf16* Wh = (const bf16*)(F.ws + WS_WR); const bf16* Wl = Wh + 32 * 1024;
    const float* g2 = a.in[12]; const float* b_gr = a.in[14]; const float* b_er = a.in[16];
    const bf16* hbase = (const bf16*)(F.act + MO_H16);
    unsigned* gcnt = (unsigned*)(F.ws + WS_CTL) + CW_MOE;
    LAS unsigned* lcnt = (LAS unsigned*)(F.lds + RING_OFF);
    if (tid < 64) lcnt[tid] = 0u;
    __syncthreads();
    const int ntasks = F.ntok / 32, tpw = ntasks / F.G;
    const int tw = F.wave & 3, kh = F.wave >> 2;
    const bool have = tw < tpw; const int t = (F.vcu * tpw + tw) * 32 + r32;
    LAS float* xch = (LAS float*)(F.lds + RING_OFF + 1024);
    int bucket = 0, posl = 0; float clo = 0.f, chi = 0.f, rstd = 0.f;
    f32x16 acc = f32x16{}; float ss = 0.f;
    if (have) {
        const bf16* hrow = hbase + (size_t)t * D + hi * 8 + kh * 512; unsigned char* nrow = N2 + (size_t)t * D + hi * 8 + kh * 512;
        const float* g2k = g2 + kh * 512 + hi * 8; const bf16* whk = Wh + (size_t)r32 * 1024 + kh * 512 + hi * 8; const bf16* wlk = Wl + (size_t)r32 * 1024 + kh * 512 + hi * 8;
#pragma unroll 8
        for (int kk = 0; kk < 32; ++kk) {
            const v4u hv = *(const v4u*)(hrow + kk * 16); const f32x4 a0 = {pg8::bf_lo(hv.x), pg8::bf_hi(hv.x), pg8::bf_lo(hv.y), pg8::bf_hi(hv.y)}, a1 = {pg8::bf_lo(hv.z), pg8::bf_hi(hv.z), pg8::bf_lo(hv.w), pg8::bf_hi(hv.w)};
            const f32x4 q0 = *(const f32x4*)(g2k + kk * 16), q1 = *(const f32x4*)(g2k + kk * 16 + 4);
            ss += (a0.x * a0.x + a0.y * a0.y) + (a0.z * a0.z + a0.w * a0.w) + (a1.x * a1.x + a1.y * a1.y) + (a1.z * a1.z + a1.w * a1.w);
            const float x[8] = {a0.x * q0.x, a0.y * q0.y, a0.z * q0.z, a0.w * q0.w, a1.x * q1.x, a1.y * q1.y, a1.z * q1.z, a1.w * q1.w};
            unsigned hb[8]; float lo[8];
#pragma unroll
            for (int j = 0; j < 8; ++j) { hb[j] = f2bf(x[j]); lo[j] = x[j] - __uint_as_float(hb[j] << 16); }
            v4u xh; xh.x = hb[0] | (hb[1] << 16); xh.y = hb[2] | (hb[3] << 16); xh.z = hb[4] | (hb[5] << 16); xh.w = hb[6] | (hb[7] << 16);
            v4u xl; xl.x = pk2(lo[0], lo[1]); xl.y = pk2(lo[2], lo[3]); xl.z = pk2(lo[4], lo[5]); xl.w = pk2(lo[6], lo[7]);
            { int w0 = __builtin_amdgcn_cvt_pk_fp8_f32(x[0], x[1], 0, false); w0 = __builtin_amdgcn_cvt_pk_fp8_f32(x[2], x[3], w0, true); int w1 = __builtin_amdgcn_cvt_pk_fp8_f32(x[4], x[5], 0, false); w1 = __builtin_amdgcn_cvt_pk_fp8_f32(x[6], x[7], w1, true);
              *(unsigned long long*)(nrow + kk * 16) = (unsigned long long)(unsigned)w0 | ((unsigned long long)(unsigned)w1 << 32); }
            const bf16x8_t wh = *(const bf16x8_t*)(whk + kk * 16), wl = *(const bf16x8_t*)(wlk + kk * 16);
            const bf16x8_t bh = __builtin_bit_cast(bf16x8_t, xh), bl = __builtin_bit_cast(bf16x8_t, xl);
            acc = __builtin_amdgcn_mfma_f32_32x32x16_bf16(wh, bh, acc, 0, 0, 0);
            acc = __builtin_amdgcn_mfma_f32_32x32x16_bf16(wh, bl, acc, 0, 0, 0);
            acc = __builtin_amdgcn_mfma_f32_32x32x16_bf16(wl, bh, acc, 0, 0, 0);
        }
        if (kh == 1) {
#pragma unroll
            for (int r = 0; r < 16; ++r) xch[(tw * 17 + r) * 64 + lane] = acc[r];
            xch[(tw * 17 + 16) * 64 + lane] = ss; }
    }
    __syncthreads();
    if (have && kh == 0) {
#pragma unroll
        for (int r = 0; r < 16; ++r) acc[r] += xch[(tw * 17 + r) * 64 + lane];
        ss += xch[(tw * 17 + 16) * 64 + lane];
        ss = xhalf_sum(ss); rstd = rsqrtf(ss * (1.f / D) + EPS);
        float L[24];
#pragma unroll
        for (int r = 0; r < 12; ++r) { const float v = acc[r]; auto rr = __builtin_amdgcn_permlane32_swap(__float_as_uint(v), __float_as_uint(v), false, false);
            L[(r & 3) + 8 * (r >> 2)] = __uint_as_float(rr[0]); L[(r & 3) + 8 * (r >> 2) + 4] = __uint_as_float(rr[1]); }
        float gl[4];
#pragma unroll
        for (int i = 0; i < 4; ++i) gl[i] = L[i] * rstd + b_gr[i];
        int g = 0; float gm = gl[0];
#pragma unroll
        for (int i = 1; i < 4; ++i) if (gl[i] > gm) { gm = gl[i]; g = i; }
        float se = 0.f;
#pragma unroll
        for (int i = 0; i < 4; ++i) se += __expf(gl[i] - gm);
        const float gw = 1.f / se;
        float el[4];
#pragma unroll
        for (int i = 0; i < 4; ++i) { const float l0 = L[4 + i], l1 = L[8 + i], l2 = L[12 + i], l3 = L[16 + i]; const float lv = g == 0 ? l0 : (g == 1 ? l1 : (g == 2 ? l2 : l3));
            const float b0 = b_er[i], b1 = b_er[4 + i], b2 = b_er[8 + i], b3 = b_er[12 + i]; el[i] = lv * rstd + (g == 0 ? b0 : (g == 1 ? b1 : (g == 2 ? b2 : b3))); }
        int i1 = 0; float v1 = el[0];
#pragma unroll
        for (int i = 1; i < 4; ++i) if (el[i] > v1) { v1 = el[i]; i1 = i; }
        int i2 = -1; float v2 = 0.f;
#pragma unroll
        for (int i = 0; i < 4; ++i) if (i != i1 && (i2 < 0 || el[i] > v2)) { v2 = el[i]; i2 = i; }
        const float e2 = __expf(v2 - v1), p1 = gw / (1.f + e2), p2 = gw * e2 / (1.f + e2);
        const int lo_ = i1 < i2 ? i1 : i2, hi_ = i1 < i2 ? i2 : i1;
        const int pair = lo_ == 0 ? (hi_ - 1) : (lo_ == 1 ? (hi_ + 1) : 5);
        bucket = g * 6 + pair; clo = i1 < i2 ? p1 : p2; chi = i1 < i2 ? p2 : p1;
        if (hi == 0) posl = (int)__hip_atomic_fetch_add(&lcnt[bucket], 1u, __ATOMIC_RELAXED, __HIP_MEMORY_SCOPE_WORKGROUP);
    }
    __syncthreads();
    if (tid < 24) lcnt[32 + tid] = atomicAdd(gcnt + tid, lcnt[tid]);
    __syncthreads();
    if (have && kh == 0 && hi == 0) { MB[t] = bucket; MPp[t] = (int)lcnt[32 + bucket] + posl; MCL[t] = clo; MCH[t] = chi; MRS[t] = rstd; }
}
__device__ __forceinline__ int moe_tiles(const unsigned* gcnt, int* rowstart  ) { int rs = 0;
    for (int b = 0; b < 24; ++b) { rowstart[b] = rs; rs += (int)((gcnt[b] + 255u) & ~255u); } rowstart[24] = rs; return rs >> 8; }
__device__ __forceinline__ void p8_permute(Frame& F, const Args& a) {
    unsigned char* mo = F.act; unsigned char* meta = mo + MO_META;
    const int* MB = (const int*)(meta + MM_B); const int* MPp = (const int*)(meta + MM_P); const float* MCL = (const float*)(meta + MM_CL); const float* MCH = (const float*)(meta + MM_CH); const float* MRS = (const float*)(meta + MM_RS);
    int* PTOK = (int*)(meta + MM_PTOK); float* PRS = (float*)(meta + MM_PRS); float* PCL = (float*)(meta + MM_PCL); float* PCH = (float*)(meta + MM_PCH);
    const unsigned* gcnt = (const unsigned*)(F.ws + WS_CTL) + CW_MOE;
    LAS int* rsL = (LAS int*)(F.lds + RING_OFF);
    if (F.tid == 0) { int rs = 0; for (int b = 0; b < 24; ++b) { rsL[b] = rs; rs += (int)((gcnt[b] + 255u) & ~255u); } rsL[24] = rs; }
    __syncthreads();
    const int gw = F.vcu * NWAVES + F.wave, NGW = F.G * NWAVES;
    const int gt = gw * 64 + F.lane, NGT = NGW * 64;
    for (int t = gt; t < F.ntok; t += NGT) { const int b = MB[t], prow = rsL[b] + MPp[t]; PTOK[prow] = t; PRS[prow] = MRS[t]; PCL[prow] = MCL[t]; PCH[prow] = MCH[t]; }
    for (int b = 0; b < 24; ++b) { const int c = (int)gcnt[b], p0 = rsL[b] + c, p1 = rsL[b + 1];
        for (int r = p0 + gt; r < p1; r += NGT) { PTOK[r] = -1; PRS[r] = 0.f; PCL[r] = 0.f; PCH[r] = 0.f; } }
}
template <bool GATHER_> struct MoeOrder {
    static constexpr bool GATHER = GATHER_; const int* ptok;
    int ntile, G, c; const char* A; size_t tA; const char* W; int mode; const LAS unsigned char* tb; size_t rowB;
    __device__ bool next(int i, pg8::Unit& u) const {
        const long L = (long)i * G + c; if (L >= (long)ntile * 4) return false;
        u.pm = (int)(L >> 2); u.pn = (int)(L & 3); u.a = GATHER_ ? A : A + (size_t)u.pm * tA;
        const int bk = tb[u.pm], g = bk / 6, pr = bk % 6; const int lo = pr < 3 ? 0 : (pr < 5 ? 1 : 2), hi = pr < 3 ? pr + 1 : (pr < 5 ? pr - 1 : 3);
        const int elo = g * 4 + lo, ehi = g * 4 + hi; u.aux = 0;
        if (mode == 1) { const int e = u.pn < 2 ? elo : ehi; u.b = W + ((size_t)e * 512 + (size_t)(u.pn & 1) * 256) * rowB; u.bjump = 0; }
        else { u.b = W + ((size_t)elo * 1024 + (size_t)u.pn * 256) * rowB; u.bjump = (long)(ehi - elo) * 1024 * (long)rowB - (long)rowB; }
        return true;
    }
    __device__ __forceinline__ void a_ready(const pg8::Unit&) const {}
    __device__ __forceinline__ void done(const pg8::Unit&) const {}
};
__device__ __forceinline__ float silu_f(float x) { return x * __builtin_amdgcn_rcpf(1.f + __builtin_amdgcn_exp2f(-1.4426950408889634f * x)); }
struct EpiMoe1 {
    static constexpr bool PERM = true, AFTER_DRAIN = false;
    unsigned char* ACT; const float* PRS; const float* PCL; const float* PCH;
    __device__ __forceinline__ void operator()(const pg8::f32x4 (&acc)[2][2][4][2], const pg8::Unit& u, int wr, int wc, int fr, int fq) const {
        const int row0 = u.pm * pg8::BM + wr * 64 + fr, slot = u.pn >> 1, fcol0 = slot * 256 + (u.pn & 1) * 128 + wc * 16 + 4 * fq; const float* PC = slot ? PCH : PCL;
#pragma unroll
        for (int ai = 0; ai < 2; ++ai)
#pragma unroll
            for (int m = 0; m < 4; ++m) { const int row = row0 + ai * pg8::HALF + m * 16; const float rs = PRS[row], cw = PC[row] * 16.f; unsigned char* rowp = ACT + (size_t)row * 512 + fcol0;
#pragma unroll
                for (int bj = 0; bj < 2; ++bj) { const pg8::f32x4 v0 = acc[ai][bj][m][0], v1 = acc[ai][bj][m][1];
                    const float a0 = silu_f(v0[0] * rs) * (v0[1] * rs) * cw, a1 = silu_f(v0[2] * rs) * (v0[3] * rs) * cw, a2 = silu_f(v1[0] * rs) * (v1[1] * rs) * cw, a3 = silu_f(v1[2] * rs) * (v1[3] * rs) * cw;
                    int w = __builtin_amdgcn_cvt_pk_fp8_f32(a0, a1, 0, false); w = __builtin_amdgcn_cvt_pk_fp8_f32(a2, a3, w, true); *(int*)(rowp + bj * 64) = w; } }
    }
};
struct EpiMoe2 {
    static constexpr bool PERM = false, AFTER_DRAIN = false;
    float* out; const pg8::bf16_t* h16; const int* PTOK;
    __device__ __forceinline__ void operator()(const pg8::f32x4 (&acc)[2][2][4][2], const pg8::Unit& u, int wr, int wc, int fr, int fq) const {
        const int row0 = u.pm * pg8::BM + wr * 64 + fr, col0 = u.pn * pg8::BM + wc * 32 + 4 * fq;
#pragma unroll
        for (int ai = 0; ai < 2; ++ai)
#pragma unroll
            for (int m = 0; m < 4; ++m) { const int tok = PTOK[row0 + ai * pg8::HALF + m * 16];
                if (tok >= 0) { float* rowp = out + (size_t)tok * 1024 + col0; const pg8::bf16_t* hp = h16 + (size_t)tok * 1024 + col0;
#pragma unroll
                    for (int bj = 0; bj < 2; ++bj)
#pragma unroll
                        for (int n = 0; n < 2; ++n) { const pg8::u32x2 hv = *(const pg8::u32x2*)(hp + bj * pg8::HALF + n * 16); const pg8::f32x4 hf = {pg8::bf_lo(hv.x), pg8::bf_hi(hv.x), pg8::bf_lo(hv.y), pg8::bf_hi(hv.y)};
                            *(pg8::f32x4*)(rowp + bj * pg8::HALF + n * 16) = hf + acc[ai][bj][m][n]; } } }
    }
};
__device__ __forceinline__ int moe_setup(Frame& F, LAS unsigned char* tb) {
    const unsigned* gcnt = (const unsigned*)(F.ws + WS_CTL) + CW_MOE;
    LAS int* nt_ = (LAS int*)(tb + 256);
    __syncthreads();
    if (F.tid == 0) { int tl = 0; for (int b = 0; b < 24; ++b) { const int n = (int)((gcnt[b] + 255u) >> 8); for (int i = 0; i < n; ++i) tb[tl + i] = (unsigned char)b; tl += n; } nt_[0] = tl; }
    __syncthreads();
    return nt_[0];
}

__global__ void __launch_bounds__(NWAVES * 64, 2) mk_fwd(Args args) {
    extern __shared__ __attribute__((aligned(16))) unsigned char lds[];
    Frame F;
    F.lds = (LAS unsigned char*)lds;
    F.tid = threadIdx.x; F.lane = F.tid & 63; F.wave = __builtin_amdgcn_readfirstlane(F.tid >> 6);
    F.G = gridDim.x; { const int bx = blockIdx.x; F.vcu = (F.G % 8 == 0) ? (bx % 8) * (F.G / 8) + bx / 8 : bx; }
    F.ntok = args.ntok; F.ws = args.ws; F.act = args.ws + WS_ACT; F.xbp = args.xb;
    const int lo = args.ph_lo, hi = args.ph_hi;
    cooperative_groups::grid_group grid = cooperative_groups::this_grid();
    volatile LAS unsigned* MISCW = (volatile LAS unsigned*)(F.lds + MISC_OFF);
    for (int u = F.tid; u < (LDS_BYTES - LDSCTL_OFF) / 4; u += NWAVES * 64) ((LAS unsigned*)(F.lds + LDSCTL_OFF))[u] = 0u;
    __syncthreads();
    XcdBarrier bar = xcd_barrier_post((unsigned*)(F.ws + WS_CTL) + CW_BAR, MISCW + 8);
#define IN(k) (lo <= (k) && (k) < hi)
#define SEAM(k) do { if (IN(k) && IN((k) + 1)) { xcd_barrier(bar); } } while (0)
    if (IN(0)) { p0_prologue(F, args); }
    SEAM(0);
    if (IN(1)) {
        EpiProj E{F.act, (size_t)F.ntok};
        { pg8::Gemm g{512, 512, 512, 8};
          P1Order S; S.nM = F.ntok / 256; S.nN = 25; S.nwg = S.nM * 25; S.G = F.G; S.c = (int)blockIdx.x; S.mode = 0; S.A = (const char*)(args.xb + (size_t)F.ntok * AUX_XB8); S.Bt = (const char*)(F.ws + WS_WIN8); S.tA = (size_t)256 * 1024; S.tB = (size_t)256 * 1024;
          pg8::gemm_phase<EpiProj, P1Order, true, true, true>(F.lds + RING_OFF, g, S, E); }
        { pg8::Gemm g{1024, 1024, 1024, 16};
          P1Order S; S.nM = F.ntok / 256; S.nN = 3; S.nwg = S.nM * 3; S.G = F.G; S.c = ((int)blockIdx.x + F.G / 2) % F.G; S.mode = 1; S.A = (const char*)args.xb; S.Bt = (const char*)(F.ws + WS_WIN); S.tA = (size_t)256 * 2048; S.tB = (size_t)256 * 2048;
          pg8::gemm_phase<EpiProj, P1Order, true, true, false>(F.lds + RING_OFF, g, S, E); }
    }
    SEAM(1);
    if (IN(2)) { p2_post(F, args); }
    SEAM(2);
    if (IN(3)) {
        const int ri = ret_wg_index(F), nret = (F.ntok / SEQ) * 4;
        if (ri < 0) p3_index(F, args);
        else if (ri < nret) { const size_t nt_ = (size_t)F.ntok;
            ret::ret_item(ri >> 2, ri & 3, (const bf16*)(F.act + nt_ * O_RQ), (const bf16*)(F.act + nt_ * O_RK), (const bf16*)(F.act + nt_ * O_RV), (const bf16*)(F.act + nt_ * O_RG), A2F8_PTR, args.in[8], (char*)lds, 0, RET_SPLIT, (float*)args.xb + (size_t)ri * 32768); }
    }
    SEAM(3);
    if (IN(4)) { p4_attn(F, args, lds); }
    SEAM(4);
    if (IN(5)) {
        const size_t nt_ = (size_t)F.ntok;
        pg8::bf16_t* GA = (pg8::bf16_t*)(F.act + nt_ * O_GA); const pg8::bf16_t* GR = (const pg8::bf16_t*)(F.act + nt_ * O_GR);
        { pg8::Gemm g{512, 1024, 512, 8, 122, 123};
          pg8::StaticOrder S; S.init(F.ntok, 1024, F.G, (int)blockIdx.x, F.act + nt_ * O_QA, 1024, F.ws + WS_WATT8, 512); EpiGateA E{GA};
          pg8::gemm_phase<EpiGateA, pg8::StaticOrder, true, true, true>(F.lds + RING_OFF, g, S, E); }
        { pg8::Gemm g{512, 512, 512, 8, 122, 127};
          pg8::StaticOrder S; S.init(F.ntok, 1024, F.G, (int)blockIdx.x, A2F8_PTR, 512, F.ws + WS_WRET8, 512); EpiGateB E{GA, GR, F.act + nt_ * O_MIX8};
          pg8::gemm_phase<EpiGateB, pg8::StaticOrder, true, true, true>(F.lds + RING_OFF, g, S, E); }
    }
    SEAM(5);
    if (IN(6)) {
        pg8::Gemm g{512, 512, 512, 8, 122, 124}; const size_t nt_ = (size_t)F.ntok;
        pg8::StaticOrder S; S.init(F.ntok, 1024, F.G, (int)blockIdx.x, F.act + nt_ * O_MIX8, 512, F.ws + WS_WOUT8, 512);
        EpiResid E{args.in[0] + (size_t)args.tok0 * D, (pg8::bf16_t*)(F.act + MO_H16)};
        pg8::gemm_phase<EpiResid, pg8::StaticOrder, true, true, true>(F.lds + RING_OFF, g, S, E);
    }
    SEAM(6);
    if (IN(7)) { p7_router(F, args); }
    SEAM(7);
    if (IN(8)) { p8_permute(F, args); }
    SEAM(8);
    if (IN(9)) {
        LAS unsigned char* tb = F.lds + LDSCTL_OFF - 1024; const int ntile = moe_setup(F, tb);
        unsigned char* meta = F.act + MO_META;
        pg8::Gemm g{512, 512, 512, 8, 122, 127};
        MoeOrder<true> S{(const int*)(meta + MM_PTOK), ntile, F.G, (int)blockIdx.x, (const char*)(F.act + MO_N2), (size_t)0, (const char*)(F.ws + WS_W18), 1, tb, (size_t)1024};
        EpiMoe1 E{(unsigned char*)(F.act + MO_ACT), (const float*)(meta + MM_PRS), (const float*)(meta + MM_PCL), (const float*)(meta + MM_PCH)};
        pg8::gemm_phase<EpiMoe1, MoeOrder<true>, true, true, true>(F.lds + RING_OFF, g, S, E);
    }
    SEAM(9);
    if (IN(10)) {
        LAS unsigned char* tb = F.lds + LDSCTL_OFF - 1024; const int ntile = moe_setup(F, tb);
        unsigned char* meta = F.act + MO_META;
        pg8::Gemm g{256, 256, 128, 2, 123, 123};
        MoeOrder<false> S{nullptr, ntile, F.G, (int)blockIdx.x, (const char*)(F.act + MO_ACT), (size_t)256 * 512, (const char*)(F.ws + WS_WD8), 2, tb, (size_t)256};
        EpiMoe2 E{args.out + (size_t)args.tok0 * D, (const pg8::bf16_t*)(F.act + MO_H16), (const int*)(meta + MM_PTOK)};
        pg8::gemm_phase<EpiMoe2, MoeOrder<false>, true, true, true>(F.lds + RING_OFF, g, S, E);
    }
    if (hi - lo > 1) grid.sync();
#undef IN
#undef SEAM
}

extern "C" void kernel_launch(void* const* d_in, const int* in_sizes, int n_in, void* d_out, int out_size, void* d_ws, size_t ws_size, hipStream_t stream) {
    static int grid = 0;
    if (grid == 0) {
        int dev = 0, cus = 0, per_cu = 0;
        (void)hipGetDevice(&dev); (void)hipDeviceGetAttribute(&cus, hipDeviceAttributeMultiprocessorCount, dev);
        if (hipFuncSetAttribute((const void*)mk_fwd, hipFuncAttributeMaxDynamicSharedMemorySize, LDS_BYTES) != hipSuccess) { fprintf(stderr, "kernel_launch: hipFuncSetAttribute failed\n"); grid = -1; return; }
        (void)hipOccupancyMaxActiveBlocksPerMultiprocessor(&per_cu, (const void*)mk_fwd, NWAVES * 64, LDS_BYTES);
        (void)hipGetLastError();
        if (per_cu < 1) { fprintf(stderr, "kernel_launch: occupancy query says %d blocks per CU\n", per_cu); per_cu = 1; }
        grid = cus * per_cu;
        if (n_in != 20 || ws_size < (size_t)512 * MiB) { fprintf(stderr, "kernel_launch: unexpected n_in %d / ws_size %zu\n", n_in, ws_size); grid = -1; return; }
        if (grid != 256) { fprintf(stderr, "kernel_launch: this kernel's phase schedules are written for a 256-workgroup grid (256 CUs x 1); the device reports %d x %d; nothing launched\n", cus, per_cu); grid = -1; return; }
    }
    if (grid < 0) return;
    float* out = (float*)d_out;
    unsigned char* ws = (unsigned char*)d_ws;
    (void)in_sizes; (void)out_size;
    (void)hipMemsetAsync(ws + WS_CTL, 0, CTL_ZERO_BYTES, stream);
    Args a{};
    for (int i = 0; i < 20; ++i) a.in[i] = (const float*)d_in[i];
    a.out = out; a.ws = ws; a.xb = (unsigned char*)d_out; a.ntok = T; a.tok0 = 0;
    void* kargs[] = {(void*)&a};
    if (PROBE_PH >= 0) { a.ph_lo = PROBE_PH; a.ph_hi = PROBE_PH + 1; a.mode = PROBE_MODE;
        (void)hipLaunchCooperativeKernel((const void*)mk_fwd, dim3(grid), dim3(NWAVES * 64), kargs, (unsigned)LDS_BYTES, stream);
        (void)hipMemsetAsync(ws + WS_CTL, 0, CTL_ZERO_BYTES, stream); }
    a.ph_lo = 0; a.ph_hi = 11; a.mode = 0;
    const hipError_t le = hipLaunchCooperativeKernel((const void*)mk_fwd, dim3(grid), dim3(NWAVES * 64), kargs, (unsigned)LDS_BYTES, stream);
    if (le != hipSuccess) fprintf(stderr, "kernel_launch: cooperative launch failed: %s (grid %d)\n", hipGetErrorString(le), grid);
}
```

```cpp
#include <hip/hip_runtime.h>
#include <hip/hip_cooperative_groups.h>
#include <cstdio>
#include <cstdint>

namespace pg8 {
#define PG8_LAS __attribute__((address_space(3)))
typedef unsigned short bf16_t;
typedef short bf16x8 __attribute__((ext_vector_type(8)));
typedef float f32x4 __attribute__((ext_vector_type(4)));
typedef unsigned u32x4 __attribute__((ext_vector_type(4)));
typedef unsigned u32x2 __attribute__((ext_vector_type(2)));
typedef int v4i_t __attribute__((ext_vector_type(4)));
typedef int v8i_t __attribute__((ext_vector_type(8)));
constexpr int BM = 256, BK = 64, HALF = 128, HTB = HALF * BK * 2  , STAGE_BYTES = 8 * HTB, NXCD = 8, WGM = 8;

__host__ __device__ __forceinline__ int lds_byte(int r, int c) { const int st = (r >> 4) * 2 + (c >> 5), rr = r & 15, cc = c & 31, ob = rr * 64 + cc * 2; return st * 1024 + (ob ^ (((ob >> 9) & 1) << 5)); }
__host__ __device__ __forceinline__ void stage_rc(int b, int& R, int& C) { const int st = b / 1024, sb = b % 1024, swz = sb ^ (((sb >> 9) & 1) << 5); R = (st >> 1) * 16 + swz / 64; C = (st & 1) * 32 + (swz % 64) / 2; }
__host__ __device__ __forceinline__ int perm32(int rho) { const int n = rho >> 4, i = rho & 15; return 8 * (i >> 2) + 4 * n + (i & 3); }

struct Unit { int pm, pn; const char* a; const char* b; long bjump; int aux; };
struct Gemm { int K, lda, ldb, ksplit; int sw = 122, sa = 127; };

struct StaticOrder {
    static constexpr bool GATHER = false; const int* ptok = nullptr;
    int nM, nN, nwg, G, c; const char* A; const char* Bt; size_t tA, tB;
    __device__ void init(int M, int N, int G_, int c_, const void* A_, int lda, const void* Bt_, int ldb) { nM = M / BM; nN = N / BM; nwg = nM * nN; G = G_; c = c_; A = (const char*)A_; Bt = (const char*)Bt_; tA = (size_t)BM * lda * 2; tB = (size_t)BM * ldb * 2; }
    __device__ bool next(int i, Unit& u) const {
        const long L = (long)i * G + c; if (L >= nwg) return false;
        int wgid = (int)L; { const int q = nwg / NXCD, r = nwg % NXCD, xcd = wgid % NXCD, off = wgid / NXCD; wgid = (xcd < r ? xcd * (q + 1) : r * (q + 1) + (xcd - r) * q) + off; }
        const int nig = WGM * nN, gid = wgid / nig, fm = gid * WGM, gsz = (nM - fm) < WGM ? (nM - fm) : WGM;
        u.pm = fm + ((wgid % nig) % gsz); u.pn = (wgid % nig) / gsz; u.a = A + (size_t)u.pm * tA; u.b = Bt + (size_t)u.pn * tB; u.bjump = 0; u.aux = 0; return true;
    }
    __device__ __forceinline__ void a_ready(const Unit&) const {}
    __device__ __forceinline__ void done(const Unit&) const {}
};

typedef float f32x2c __attribute__((ext_vector_type(2))); typedef __bf16 bf16x2c __attribute__((ext_vector_type(2)));
__device__ __forceinline__ unsigned cvt_pk_bf16(float lo, float hi) { const f32x2c v = {lo, hi}; const bf16x2c b = __builtin_convertvector(v, bf16x2c); return __builtin_bit_cast(unsigned, b); }
__device__ __forceinline__ float bf_lo(unsigned w) { return __uint_as_float(w << 16); }
__device__ __forceinline__ float bf_hi(unsigned w) { return __uint_as_float(w & 0xffff0000u); }


template <class Epi, class Sched, bool ALIGN_EPI = false, bool SP2 = false, bool FP8 = false>
__device__ __forceinline__ void gemm_phase(PG8_LAS unsigned char* lds, const Gemm g, const Sched& S, const Epi& E) {
    int tid = threadIdx.x; asm volatile("" : "+v"(tid));
    const int wid = __builtin_amdgcn_readfirstlane(tid >> 6), lane = tid & 63, wr = wid >> 2, wc = wid & 3, fr = lane & 15, fq = lane >> 4;
    const int K = g.K, nt = K / BK;
    unsigned voffA[2], voffB[2]; int gR[2]; unsigned gC[2];
#pragma unroll
    for (int i = 0; i < 2; ++i) { int R, C; stage_rc(tid * 16 + i * 8192, R, C); const int Rb = Epi::PERM ? ((R & ~31) + perm32(R & 31)) : R; gR[i] = R; gC[i] = (unsigned)C * 2u;
        voffA[i] = (unsigned)(R * g.lda + C) * 2u; voffB[i] = (unsigned)(Rb * g.ldb + C) * 2u; }
    unsigned gA0[2] = {0u, 0u}, gA1[2] = {0u, 0u}, gN0[2] = {0u, 0u}, gN1[2] = {0u, 0u};
#define PG8_GOFF(u_, o0, o1) do { _Pragma("unroll") for (int i_ = 0; i_ < 2; ++i_) { int t0_ = S.ptok[(u_).pm * BM + gR[i_]], t1_ = S.ptok[(u_).pm * BM + HALF + gR[i_]]; t0_ = t0_ < 0 ? 0 : t0_; t1_ = t1_ < 0 ? 0 : t1_; \
        o0[i_] = (unsigned)t0_ * (unsigned)(g.lda * 2) + gC[i_]; o1[i_] = (unsigned)t1_ * (unsigned)(g.lda * 2) + gC[i_]; } } while (0)
    const size_t kstep = (size_t)(BK * 2);
    const size_t hstepA = Sched::GATHER ? (size_t)0 : (size_t)HALF * g.lda * 2, hstepB = (size_t)HALF * g.ldb * 2;
    const unsigned ldsw = (unsigned)wid * 1024u;
    const int aoff = lds_byte(wr * 64 + fr, fq * 8), boff = lds_byte(wc * 32 + fr, fq * 8);
#define PG8_CAT(x0, x1) __builtin_shufflevector(__builtin_bit_cast(v4i_t, x0), __builtin_bit_cast(v4i_t, x1), 0, 1, 2, 3, 4, 5, 6, 7)
#define PG8_SA(b, h) (((b) * 2 + (h)) * HTB)
#define PG8_SB(b, h) ((4 + (b) * 2 + (h)) * HTB)
#define PG8_STAGE(bufoff, gbase, voff) do { _Pragma("unroll") for (int _i = 0; _i < 2; ++_i) \
        __builtin_amdgcn_global_load_lds((const unsigned*)((const char*)(gbase) + (voff)[_i]), (PG8_LAS unsigned*)(lds + (bufoff) + ldsw + _i * 8192), 16, 0, 0); } while (0)
#define PG8_LDA(dst, b, h) do { if constexpr (FP8) { _Pragma("unroll") for (int m = 0; m < 4; ++m) dst##8[m] = PG8_CAT(*(const PG8_LAS bf16x8*)(lds + PG8_SA(b, h) + aoff + m * 2048), *(const PG8_LAS bf16x8*)(lds + PG8_SA(b, h) + aoff + m * 2048 + 1024)); } \
      else { _Pragma("unroll") for (int m = 0; m < 4; ++m) _Pragma("unroll") for (int k = 0; k < 2; ++k) dst[m][k] = *(const PG8_LAS bf16x8*)(lds + PG8_SA(b, h) + aoff + m * 2048 + k * 1024); } } while (0)
#define PG8_LDB(dst, b, h) do { if constexpr (FP8) { _Pragma("unroll") for (int n = 0; n < 2; ++n) dst##8[n] = PG8_CAT(*(const PG8_LAS bf16x8*)(lds + PG8_SB(b, h) + boff + n * 2048), *(const PG8_LAS bf16x8*)(lds + PG8_SB(b, h) + boff + n * 2048 + 1024)); } \
      else { _Pragma("unroll") for (int n = 0; n < 2; ++n) _Pragma("unroll") for (int k = 0; k < 2; ++k) dst[n][k] = *(const PG8_LAS bf16x8*)(lds + PG8_SB(b, h) + boff + n * 2048 + k * 1024); } } while (0)
#define PG8_MMA(ai, bj, At, Bt) do { __builtin_amdgcn_s_setprio(1); if constexpr (FP8) { _Pragma("unroll") for (int m = 0; m < 4; ++m) _Pragma("unroll") for (int n = 0; n < 2; ++n) \
        asm volatile("v_mfma_scale_f32_16x16x128_f8f6f4 %0, %1, %2, %0, %3, %4 op_sel_hi:[0,0,0]" : "+v"(acc[ai][bj][m][n]) : "v"(Bt##8[n]), "v"(At##8[m]), "v"(scw8), "v"(sca8)); } \
      else { _Pragma("unroll") for (int m = 0; m < 4; ++m) _Pragma("unroll") for (int n = 0; n < 2; ++n) _Pragma("unroll") for (int k = 0; k < 2; ++k) \
        acc[ai][bj][m][n] = __builtin_amdgcn_mfma_f32_16x16x32_bf16(Bt[n][k], At[m][k], acc[ai][bj][m][n], 0, 0, 0); } __builtin_amdgcn_s_setprio(0); } while (0)
#define PG8_WAIT_V(n) asm volatile("s_waitcnt vmcnt(" #n ")" ::: "memory")
#define PG8_WAIT_L(n) asm volatile("s_waitcnt lgkmcnt(" #n ")" ::: "memory")
#define PG8_BAR __builtin_amdgcn_s_barrier()
#define PG8_SCHED __builtin_amdgcn_sched_barrier(0)
    Unit cur, nxt; int ui = 0;
    if (!S.next(0, cur)) return;
    f32x4 acc[2][2][4][2];
#pragma unroll
    for (int a = 0; a < 2; ++a)
#pragma unroll
        for (int b = 0; b < 2; ++b)
#pragma unroll
            for (int m = 0; m < 4; ++m)
#pragma unroll
                for (int n = 0; n < 2; ++n) acc[a][b][m][n] = (f32x4){0.f, 0.f, 0.f, 0.f};
    int scw8 = g.sw, sca8 = g.sa; asm volatile("" : "+v"(scw8), "+v"(sca8));
    bf16x8 At[4][2], B0[2][2], B1[2][2]; v8i_t At8[4], B08[2], B18[2];
    const char* cA = cur.a; const char* cB = cur.b; long cJ = cur.bjump;
    S.a_ready(cur);
    if constexpr (SP2) {
        if constexpr (Sched::GATHER) PG8_GOFF(cur, gA0, gA1);
        PG8_STAGE(PG8_SB(0, 0), cB, voffB); PG8_STAGE(PG8_SB(0, 1), cB + hstepB, voffB); do { if constexpr (Sched::GATHER) { PG8_STAGE(PG8_SA(0, 0), cA, gA0); } else { PG8_STAGE(PG8_SA(0, 0), cA, voffA); } } while (0); do { if constexpr (Sched::GATHER) { PG8_STAGE(PG8_SA(0, 1), cA, gA1); } else { PG8_STAGE(PG8_SA(0, 1), cA + hstepA, voffA); } } while (0);
        if (wr == 1) PG8_BAR;
        PG8_WAIT_V(2); PG8_BAR;
        PG8_STAGE(PG8_SB(1, 0), cB + kstep, voffB); do { if constexpr (Sched::GATHER) { PG8_STAGE(PG8_SA(1, 0), cA + kstep, gA0); } else { PG8_STAGE(PG8_SA(1, 0), cA + kstep, voffA); } } while (0); PG8_STAGE(PG8_SB(1, 1), cB + hstepB + kstep, voffB);
        PG8_WAIT_V(6); PG8_BAR;
    } else {
        PG8_STAGE(PG8_SB(0, 0), cB, voffB); PG8_STAGE(PG8_SA(0, 0), cA, voffA); PG8_STAGE(PG8_SB(0, 1), cB + hstepB, voffB); PG8_STAGE(PG8_SA(0, 1), cA + hstepA, voffA);
        if (wr == 1) PG8_BAR;
        PG8_WAIT_V(4); PG8_BAR;
        PG8_STAGE(PG8_SB(1, 0), cB + kstep, voffB); PG8_STAGE(PG8_SA(1, 0), cA + kstep, voffA); PG8_STAGE(PG8_SB(1, 1), cB + hstepB + kstep, voffB);
        PG8_WAIT_V(6); PG8_BAR;
    }
    for (;;) {
        const bool has_next = S.next(ui + 1, nxt);
        const char* nA = has_next ? nxt.a : cA; const char* nB = has_next ? nxt.b : cB;
        if constexpr (Sched::GATHER) { if (has_next) PG8_GOFF(nxt, gN0, gN1); else { gN0[0] = gA0[0]; gN0[1] = gA0[1]; gN1[0] = gA1[0]; gN1[1] = gA1[1]; } }
#pragma unroll 1
        for (int t = 0; t < nt; t += 2) {
            const bool last = (t == nt - 2);
            const char* a1 = cA + (size_t)(t + 1) * kstep;
            const char* a2 = last ? nA : cA + (size_t)(t + 2) * kstep; const char* b2 = last ? nB : cB + (size_t)(t + 2) * kstep + ((t + 2) >= g.ksplit ? cJ : 0L);
            const char* a3 = a2 + kstep; const char* b3 = b2 + kstep;
            if (last && has_next) S.a_ready(nxt);
            unsigned x0[2] = {0u, 0u}, x1[2] = {0u, 0u};
            if constexpr (Sched::GATHER) { x0[0] = last ? gN0[0] : gA0[0]; x0[1] = last ? gN0[1] : gA0[1]; x1[0] = last ? gN1[0] : gA1[0]; x1[1] = last ? gN1[1] : gA1[1]; }
            if constexpr (SP2) {
            PG8_LDB(B0, 0, 0); PG8_LDB(B1, 0, 1); PG8_SCHED; PG8_LDA(At, 0, 0); do { if constexpr (Sched::GATHER) { PG8_STAGE(PG8_SA(1, 1), a1, gA1); } else { PG8_STAGE(PG8_SA(1, 1), a1 + hstepA, voffA); } } while (0);
            PG8_WAIT_V(8); PG8_WAIT_L(0); PG8_BAR; PG8_MMA(0, 0, At, B0); PG8_MMA(0, 1, At, B1); PG8_BAR; PG8_SCHED;
            PG8_LDA(At, 0, 1); PG8_STAGE(PG8_SB(0, 0), b2, voffB); PG8_STAGE(PG8_SB(0, 1), b2 + hstepB, voffB); do { if constexpr (Sched::GATHER) { PG8_STAGE(PG8_SA(0, 0), a2, x0); } else { PG8_STAGE(PG8_SA(0, 0), a2, voffA); } } while (0);
            PG8_WAIT_V(8); PG8_WAIT_L(0); PG8_BAR; PG8_MMA(1, 0, At, B0); PG8_MMA(1, 1, At, B1); PG8_BAR; PG8_SCHED;
            PG8_LDB(B0, 1, 0); PG8_LDB(B1, 1, 1); PG8_SCHED; PG8_LDA(At, 1, 0); do { if constexpr (Sched::GATHER) { PG8_STAGE(PG8_SA(0, 1), a2, x1); } else { PG8_STAGE(PG8_SA(0, 1), a2 + hstepA, voffA); } } while (0);
            PG8_WAIT_V(8); PG8_WAIT_L(0); PG8_BAR; PG8_MMA(0, 0, At, B0); PG8_MMA(0, 1, At, B1); PG8_BAR; PG8_SCHED;
            PG8_LDA(At, 1, 1); PG8_STAGE(PG8_SB(1, 0), b3, voffB); PG8_STAGE(PG8_SB(1, 1), b3 + hstepB, voffB); do { if constexpr (Sched::GATHER) { PG8_STAGE(PG8_SA(1, 0), a3, x0); } else { PG8_STAGE(PG8_SA(1, 0), a3, voffA); } } while (0);
            PG8_WAIT_V(8); PG8_WAIT_L(0); PG8_BAR; PG8_MMA(1, 0, At, B0); PG8_MMA(1, 1, At, B1); PG8_BAR; PG8_SCHED;
            } else {
            PG8_LDB(B0, 0, 0); PG8_SCHED; PG8_LDA(At, 0, 0); PG8_STAGE(PG8_SA(1, 1), a1 + hstepA, voffA);
            PG8_WAIT_L(8); PG8_BAR; PG8_WAIT_L(0); PG8_MMA(0, 0, At, B0); PG8_BAR; PG8_SCHED;
            PG8_LDB(B1, 0, 1); PG8_STAGE(PG8_SB(0, 0), b2, voffB);
            PG8_BAR; PG8_WAIT_L(0); PG8_MMA(0, 1, At, B1); PG8_BAR;
            PG8_LDA(At, 0, 1); PG8_STAGE(PG8_SA(0, 0), a2, voffA);
            PG8_BAR; PG8_WAIT_L(0); PG8_MMA(1, 0, At, B0); PG8_BAR; PG8_SCHED;
            PG8_STAGE(PG8_SB(0, 1), b2 + hstepB, voffB);
            PG8_WAIT_V(6); PG8_BAR; PG8_MMA(1, 1, At, B1); PG8_BAR;
            PG8_LDB(B0, 1, 0); PG8_SCHED; PG8_LDA(At, 1, 0); PG8_STAGE(PG8_SA(0, 1), a2 + hstepA, voffA);
            PG8_WAIT_L(8); PG8_BAR; PG8_WAIT_L(0); PG8_MMA(0, 0, At, B0); PG8_BAR; PG8_SCHED;
            PG8_LDB(B1, 1, 1); PG8_STAGE(PG8_SB(1, 0), b3, voffB);
            PG8_BAR; PG8_WAIT_L(0); PG8_MMA(0, 1, At, B1); PG8_BAR;
            PG8_LDA(At, 1, 1); PG8_STAGE(PG8_SA(1, 0), a3, voffA);
            PG8_BAR; PG8_WAIT_L(0); PG8_MMA(1, 0, At, B0); PG8_BAR; PG8_SCHED;
            PG8_STAGE(PG8_SB(1, 1), b3 + hstepB, voffB);
            PG8_WAIT_V(6); PG8_BAR; PG8_MMA(1, 1, At, B1); PG8_BAR;
            }
        }
        if constexpr (ALIGN_EPI) { if (wr == 0) PG8_BAR; }
        if constexpr (!Epi::AFTER_DRAIN) { E(acc, cur, wr, wc, fr, fq); S.done(cur); }
        if (!has_next) break;
#pragma unroll
        for (int a = 0; a < 2; ++a)
#pragma unroll
            for (int b = 0; b < 2; ++b)
#pragma unroll
                for (int m = 0; m < 4; ++m)
#pragma unroll
                    for (int n = 0; n < 2; ++n) acc[a][b][m][n] = (f32x4){0.f, 0.f, 0.f, 0.f};
        cur = nxt; cA = nA; cB = nB; cJ = cur.bjump; ++ui;
        if constexpr (Sched::GATHER) { gA0[0] = gN0[0]; gA0[1] = gN0[1]; gA1[0] = gN1[0]; gA1[1] = gN1[1]; }
        if constexpr (ALIGN_EPI) { if (wr == 1) PG8_BAR; }
    }
    PG8_WAIT_V(0);
    if constexpr (!ALIGN_EPI) { if (wr == 0) PG8_BAR; }
    PG8_BAR;
    if constexpr (Epi::AFTER_DRAIN) { E.fused(acc, cur, wr, wc, fr, fq, lds, wid, lane); S.done(cur); }
#undef PG8_GOFF
#undef PG8_SA
#undef PG8_SB
#undef PG8_STAGE
#undef PG8_LDA
#undef PG8_LDB
#undef PG8_MMA
#undef PG8_CAT
#undef PG8_WAIT_V
#undef PG8_WAIT_L
#undef PG8_BAR
#undef PG8_SCHED
}
}

#ifndef PROBE_PH
#define PROBE_PH (-1)
#endif
#ifndef PROBE_MODE
#define PROBE_MODE (0)
#endif
constexpr int D = 1024, BATCH = 16, SEQ = 2048, T = BATCH * SEQ;
constexpr int INW = 6984, INWP = 7168;
constexpr int C_QA = 0, C_CKV = 1024, C_QI = 1280, C_KI = 1792, C_WI = 1856, C_RQ = 1864, C_RK = 2376, C_RV = 2888, C_RG = 3912, C_GA = 4936, C_GR = 5960;
constexpr float EPS = 1e-6f;
constexpr int NWAVES = 8;

constexpr size_t MiB = 1u << 20;
constexpr size_t WS_CTL = 0, CTL_ZERO_BYTES = 1 * MiB;
constexpr size_t WS_WIN = 1 * MiB, WS_WKV = 15 * MiB, WS_WATT = 16 * MiB, WS_WRET = 18 * MiB, WS_WOUT = 20 * MiB, WS_W1 = 22 * MiB, WS_WD = 38 * MiB, WS_ACT = 46 * MiB;
constexpr size_t O_QA = 0, O_CKV = 2048, O_QI = 2560, O_KW = 3584, O_RQ = 3840, O_RK = 4864, O_RV = 5888, O_RG = 7936, O_GA = 9984, O_GR = 12032, O_END = 14080;

constexpr int MP_ROWS = 38912;
constexpr size_t MO_APERM = 0, MO_ACT = 80 * MiB, MO_N2 = 120 * MiB, MO_META = 184 * MiB;
constexpr size_t MM_B = 0, MM_P = 131072, MM_CL = 262144, MM_CH = 393216, MM_RS = 524288, MM_PTOK = 655360, MM_PRS = 819200, MM_PCL = 983040, MM_PCH = 1146880, MM_END = 1310720;
constexpr size_t WS_WR = 15 * MiB + 512 * 1024;
constexpr size_t MO_H16 = 192 * MiB;
constexpr size_t WS_WIN8 = 488 * MiB;
constexpr size_t WS_WATT8 = 495 * MiB, WS_WRET8 = 496 * MiB, WS_WOUT8 = 497 * MiB;
constexpr size_t O_A2F8 = 2048, O_MIX8 = 3840;
constexpr size_t WS_W18 = 498 * MiB, WS_WD8 = 506 * MiB;
constexpr size_t AUX_XB8 = 2048 + 896;
constexpr int F8_FIRST_TILE = 8;
constexpr int CW_MOE = 256;
constexpr int RING_OFF = 0, RING_BYTES = 131072, P3_HIST_OFF = 131072, P3_TOT_OFF = 147456, P3_T_OFF = 149504, LDSCTL_OFF = 151552, MISC_OFF = LDSCTL_OFF + 320, LDS_BYTES = 152576;
constexpr int CW_Q3 = 64, CW_Q4 = 128;

#define GAS __attribute__((address_space(1)))
#define LAS __attribute__((address_space(3)))
typedef unsigned short bf16;
typedef unsigned v4u __attribute__((ext_vector_type(4)));
typedef float f32x4 __attribute__((ext_vector_type(4)));
#define LDS_WAIT() asm volatile("s_waitcnt lgkmcnt(0)" ::: "memory")
#define VM_WAIT() asm volatile("s_waitcnt vmcnt(0)" ::: "memory")
__device__ __forceinline__ unsigned f2bf(float f) { unsigned u = __builtin_bit_cast(unsigned, f); return (u + 0x7fffu + ((u >> 16) & 1u)) >> 16; }
__device__ __forceinline__ unsigned pk2(float lo, float hi) { return f2bf(lo) | (f2bf(hi) << 16); }
__device__ __forceinline__ float bf2f(bf16 b) { return __uint_as_float((unsigned)b << 16); }


typedef GAS unsigned gu32;
constexpr int CW_BAR = 4096;
#define XB_TMO      128
#define XB_XCNT(j)  (256  + 64 * (j))
#define XB_XSUB(j)  (1280 + 64 * (j))
#define XB_XGEN(j)  (2304 + 64 * (j))
#define XB_TOP      3328
#define XB_TOPGEN   3392
#define XCD_BAR_WORDS 3456
#define XB_SPIN_CAP (1u << 18)

__device__ __forceinline__ unsigned xb_ld(unsigned* p)              { return __hip_atomic_load(p, __ATOMIC_RELAXED, __HIP_MEMORY_SCOPE_AGENT); }
__device__ __forceinline__ unsigned xb_add(unsigned* p, unsigned v) { return __hip_atomic_fetch_add(p, v, __ATOMIC_RELAXED, __HIP_MEMORY_SCOPE_AGENT); }
__device__ __forceinline__ unsigned xb_xcc_id() { return (unsigned)__builtin_amdgcn_s_getreg((3 << 11) | 20) & 0xFu; }
#define XB_SPIN(cond, bar) do { unsigned _sp = 0; while (cond) { __builtin_amdgcn_s_sleep(1); \
    if ((++_sp & 255u) == 0u) { if (xb_ld(&(bar)[XB_TMO])) break; if (_sp > XB_SPIN_CAP) { atomicAdd(&(bar)[XB_TMO], 1u); break; } } } } while (0)

struct XcdBarrier {
    unsigned* bar; unsigned x;
    volatile LAS unsigned* st;
};

__device__ __forceinline__ XcdBarrier xcd_barrier_post(unsigned* bar, volatile LAS unsigned* st) {
    XcdBarrier b; b.bar = bar; b.x = xb_xcc_id(); b.st = st;
    if (threadIdx.x == 0) (void)xb_add(&bar[XB_XCNT(b.x)], 1u);
    return b;
}
__device__ __forceinline__ void xcd_barrier_complete(unsigned* bar, unsigned x, unsigned& nloc, unsigned& nx) {
    const unsigned G = gridDim.x * gridDim.y * gridDim.z;
    unsigned sum, cnt, mine, sp = 0u;
    for (;;) {
        sum = 0u; cnt = 0u; mine = 0u;
#pragma unroll
        for (unsigned j = 0; j < 16; ++j) { const unsigned c = xb_ld(&bar[XB_XCNT(j)]); sum += c; cnt += (c > 0u) ? 1u : 0u; mine = (j == x) ? c : mine; }
        if (sum == G) break;
        __builtin_amdgcn_s_sleep(1);
        if ((++sp & 255u) == 0u) { if (xb_ld(&bar[XB_TMO])) break; if (sp > XB_SPIN_CAP) { atomicAdd(&bar[XB_TMO], 1u); break; } }
    }
    nloc = mine > 0u ? mine : 1u; nx = cnt > 0u ? cnt : 1u;
}

__device__ __forceinline__ void xcd_barrier(const XcdBarrier& b) {
    asm volatile("s_waitcnt vmcnt(0)" ::: "memory");
    __syncthreads();
    if (threadIdx.x == 0) {
        unsigned* bar = b.bar;
        __builtin_amdgcn_s_waitcnt(0);
        unsigned nloc = b.st[0], nx = b.st[1];
        if (nloc == 0u) { xcd_barrier_complete(bar, b.x, nloc, nx); b.st[0] = nloc; b.st[1] = nx; }
        const unsigned old = xb_add(&bar[XB_XSUB(b.x)], 1u);
        const unsigned gen = old / nloc;
        if (old + 1u == (gen + 1u) * nloc) {
            __builtin_amdgcn_fence(__ATOMIC_RELEASE, "agent");
            asm volatile("s_waitcnt vmcnt(0)" ::: "memory");
            const unsigned og = xb_add(&bar[XB_TOP], 1u);
            const unsigned tg = og / nx;
            if (og + 1u == (tg + 1u) * nx) xb_add(&bar[XB_TOPGEN], 1u);
            else XB_SPIN(xb_ld(&bar[XB_TOPGEN]) == tg, bar);
            __builtin_amdgcn_fence(__ATOMIC_ACQUIRE, "agent");
            xb_add(&bar[XB_XGEN(b.x)], 1u);
            asm volatile("s_waitcnt vmcnt(0)" ::: "memory");
        } else {
            XB_SPIN(xb_ld(&bar[XB_XGEN(b.x)]) == gen, bar);
            __builtin_amdgcn_fence(__ATOMIC_ACQUIRE, "agent");
            asm volatile("s_waitcnt vmcnt(0)" ::: "memory");
        }
    }
    __syncthreads();
}

struct Args { const float* in[20]; float* out; unsigned char* ws; unsigned char* xb; int ph_lo, ph_hi, ntok, tok0, mode, pad; };

struct Frame {
    LAS unsigned char* lds;
    int tid, lane, wave, vcu, G;
    int ntok;
    unsigned char* ws; unsigned char* act; unsigned char* xbp;
};

struct EpiProj {
    static constexpr bool PERM = true, AFTER_DRAIN = false;
    unsigned char* act; size_t ntok;
    static __device__ __forceinline__ unsigned q4(const pg8::f32x4& v) { int w = __builtin_amdgcn_cvt_pk_fp8_f32(v[0], v[1], 0, false); return (unsigned)__builtin_amdgcn_cvt_pk_fp8_f32(v[2], v[3], w, true); }
    __device__ __forceinline__ void operator()(const pg8::f32x4 (&acc)[2][2][4][2], const pg8::Unit& u, int wr, int wc, int fr, int fq) const {
        const int pn = u.pn; size_t O; int ld, cb, nbj = 2; bool f8 = false;
        if (pn < 4) { O = O_QA; ld = 1024; cb = pn * 256; }
        else if (pn == 4) { O = O_CKV; ld = 256; cb = 0; }
        else if (pn < 7) { O = O_QI; ld = 512; cb = (pn - 5) * 256; }
        else if (pn == 7) { O = O_KW; ld = 128; cb = 0; nbj = 1; }
        else if (pn < 10) { O = O_RQ; ld = 512; cb = (pn - 8) * 256; }
        else if (pn < 12) { O = O_RK; ld = 512; cb = (pn - 10) * 256; }
        else { O = O_RV + (size_t)((pn - 12) >> 2) * 2048; ld = 1024; cb = ((pn - 12) & 3) * 256; }
        f8 = pn < 5 || pn >= F8_FIRST_TILE;
        const int row0 = u.pm * pg8::BM + wr * 64 + fr;
        if (f8) {
            unsigned char* base = act + ntok * O; const bool odd = fq & 1; const int colb = cb + wc * 32 + 8 * (fq & ~1);
#pragma unroll
            for (int ai = 0; ai < 2; ++ai)
#pragma unroll
                for (int bj = 0; bj < 2; ++bj)
#pragma unroll
                    for (int mp = 0; mp < 2; ++mp) { const unsigned x0 = q4(acc[ai][bj][2 * mp][0]), x1 = q4(acc[ai][bj][2 * mp][1]), y0 = q4(acc[ai][bj][2 * mp + 1][0]), y1 = q4(acc[ai][bj][2 * mp + 1][1]);
                        const unsigned r0 = (unsigned)__builtin_amdgcn_ds_swizzle((int)(odd ? x0 : y0), 0x401F), r1 = (unsigned)__builtin_amdgcn_ds_swizzle((int)(odd ? x1 : y1), 0x401F);
                        pg8::u32x4 w; if (odd) { w.x = r0; w.y = r1; w.z = y0; w.w = y1; } else { w.x = x0; w.y = x1; w.z = r0; w.w = r1; }
                        *(pg8::u32x4*)(base + (size_t)(row0 + ai * pg8::HALF + (2 * mp + (odd ? 1 : 0)) * 16) * ld + colb + bj * pg8::HALF) = w; }
            return;
        }
        pg8::bf16_t* base = (pg8::bf16_t*)(act + ntok * O);
        const int col0 = cb + wc * 32 + 8 * fq;
#pragma unroll
        for (int ai = 0; ai < 2; ++ai)
#pragma unroll
            for (int m = 0; m < 4; ++m) { pg8::bf16_t* rowp = base + (size_t)(row0 + ai * pg8::HALF + m * 16) * ld + col0;
#pragma unroll
                for (int bj = 0; bj < 2; ++bj) if (bj < nbj) { const pg8::f32x4 v0 = acc[ai][bj][m][0], v1 = acc[ai][bj][m][1];
                    pg8::u32x4 w; w.x = pg8::cvt_pk_bf16(v0[0], v0[1]); w.y = pg8::cvt_pk_bf16(v0[2], v0[3]); w.z = pg8::cvt_pk_bf16(v1[0], v1[1]); w.w = pg8::cvt_pk_bf16(v1[2], v1[3]);
                    *(pg8::u32x4*)(rowp + bj * pg8::HALF) = w; } }
    }
};

__device__ __forceinline__ float sigm(float x) { return __builtin_amdgcn_rcpf(1.f + __builtin_amdgcn_exp2f(-1.4426950408889634f * x)); }
__device__ __forceinline__ void f8x8(const pg8::u32x2 g, float (&f)[8]) { const auto a = __builtin_amdgcn_cvt_pk_f32_fp8((int)g.x, false), b = __builtin_amdgcn_cvt_pk_f32_fp8((int)g.x, true), c = __builtin_amdgcn_cvt_pk_f32_fp8((int)g.y, false), d = __builtin_amdgcn_cvt_pk_f32_fp8((int)g.y, true);
    f[0] = a[0]; f[1] = a[1]; f[2] = b[0]; f[3] = b[1]; f[4] = c[0]; f[5] = c[1]; f[6] = d[0]; f[7] = d[1]; }
struct EpiGateA {
    static constexpr bool PERM = true, AFTER_DRAIN = false;
    const unsigned char* GA8; pg8::bf16_t* TMP;
    __device__ __forceinline__ void operator()(const pg8::f32x4 (&acc)[2][2][4][2], const pg8::Unit& u, int wr, int wc, int fr, int fq) const {
        const int row0 = u.pm * pg8::BM + wr * 64 + fr, col0 = u.pn * pg8::BM + wc * 32 + 8 * fq;
#pragma unroll
        for (int ai = 0; ai < 2; ++ai)
#pragma unroll
            for (int m = 0; m < 4; ++m) { const size_t ro = (size_t)(row0 + ai * pg8::HALF + m * 16) * 1024 + col0;
#pragma unroll
                for (int bj = 0; bj < 2; ++bj) { float g[8]; f8x8(*(const pg8::u32x2*)(GA8 + ro + bj * pg8::HALF), g); const pg8::f32x4 v0 = acc[ai][bj][m][0], v1 = acc[ai][bj][m][1];
                    pg8::u32x4 w; w.x = pg8::cvt_pk_bf16(sigm(g[0]) * v0[0], sigm(g[1]) * v0[1]); w.y = pg8::cvt_pk_bf16(sigm(g[2]) * v0[2], sigm(g[3]) * v0[3]);
                    w.z = pg8::cvt_pk_bf16(sigm(g[4]) * v1[0], sigm(g[5]) * v1[1]); w.w = pg8::cvt_pk_bf16(sigm(g[6]) * v1[2], sigm(g[7]) * v1[3]);
                    *(pg8::u32x4*)(TMP + ro + bj * pg8::HALF) = w; } }
    }
};
struct EpiGateB {
    static constexpr bool PERM = true, AFTER_DRAIN = false;
    const pg8::bf16_t* TMP; const unsigned char* GR8; unsigned char* MIX8;
    __device__ __forceinline__ void operator()(const pg8::f32x4 (&acc)[2][2][4][2], const pg8::Unit& u, int wr, int wc, int fr, int fq) const {
        const int row0 = u.pm * pg8::BM + wr * 64 + fr, col0 = u.pn * pg8::BM + wc * 32 + 8 * fq;
#pragma unroll
        for (int ai = 0; ai < 2; ++ai)
#pragma unroll
            for (int m = 0; m < 4; ++m) { const size_t ro = (size_t)(row0 + ai * pg8::HALF + m * 16) * 1024 + col0;
#pragma unroll
                for (int bj = 0; bj < 2; ++bj) { const pg8::u32x4 t = *(const pg8::u32x4*)(TMP + ro + bj * pg8::HALF); float g[8]; f8x8(*(const pg8::u32x2*)(GR8 + ro + bj * pg8::HALF), g); const pg8::f32x4 v0 = acc[ai][bj][m][0], v1 = acc[ai][bj][m][1];
                    int w0 = __builtin_amdgcn_cvt_pk_fp8_f32(8.f * (pg8::bf_lo(t.x) + sigm(g[0]) * v0[0]), 8.f * (pg8::bf_hi(t.x) + sigm(g[1]) * v0[1]), 0, false);
                    w0 = __builtin_amdgcn_cvt_pk_fp8_f32(8.f * (pg8::bf_lo(t.y) + sigm(g[2]) * v0[2]), 8.f * (pg8::bf_hi(t.y) + sigm(g[3]) * v0[3]), w0, true);
                    int w1 = __builtin_amdgcn_cvt_pk_fp8_f32(8.f * (pg8::bf_lo(t.z) + sigm(g[4]) * v1[0]), 8.f * (pg8::bf_hi(t.z) + sigm(g[5]) * v1[1]), 0, false);
                    w1 = __builtin_amdgcn_cvt_pk_fp8_f32(8.f * (pg8::bf_lo(t.w) + sigm(g[6]) * v1[2]), 8.f * (pg8::bf_hi(t.w) + sigm(g[7]) * v1[3]), w1, true);
                    *(unsigned long long*)(MIX8 + ro + bj * pg8::HALF) = (unsigned long long)(unsigned)w0 | ((unsigned long long)(unsigned)w1 << 32); } }
    }
};
struct EpiResid {
    static constexpr bool PERM = true, AFTER_DRAIN = false;
    const float* x; pg8::bf16_t* h16;
    __device__ __forceinline__ void operator()(const pg8::f32x4 (&acc)[2][2][4][2], const pg8::Unit& u, int wr, int wc, int fr, int fq) const {
        const int row0 = u.pm * pg8::BM + wr * 64 + fr, col0 = u.pn * pg8::BM + wc * 32 + 8 * fq;
#pragma unroll
        for (int ai = 0; ai < 2; ++ai)
#pragma unroll
            for (int m = 0; m < 4; ++m) { const size_t ro = (size_t)(row0 + ai * pg8::HALF + m * 16) * 1024 + col0;
#pragma unroll
                for (int bj = 0; bj < 2; ++bj) { const pg8::f32x4 x0 = *(const pg8::f32x4*)(x + ro + bj * pg8::HALF), x1 = *(const pg8::f32x4*)(x + ro + bj * pg8::HALF + 4); const pg8::f32x4 v0 = acc[ai][bj][m][0] + x0, v1 = acc[ai][bj][m][1] + x1;
                    pg8::u32x4 w; w.x = pg8::cvt_pk_bf16(v0[0], v0[1]); w.y = pg8::cvt_pk_bf16(v0[2], v0[3]); w.z = pg8::cvt_pk_bf16(v1[0], v1[1]); w.w = pg8::cvt_pk_bf16(v1[2], v1[3]);
                    *(pg8::u32x4*)(h16 + ro + bj * pg8::HALF) = w; } }
    }
};


struct P1Order {
    static constexpr bool GATHER = false; const int* ptok = nullptr;
    int nM, nN, nwg, G, c, mode; const char* A; const char* Bt; size_t tA, tB;
    __device__ bool next(int i, pg8::Unit& u) const {
        const long L = (long)i * G + c; if (L >= nwg) return false;
        int wgid = (int)L; { const int q = nwg / pg8::NXCD, r = nwg % pg8::NXCD, xcd = wgid % pg8::NXCD, off = wgid / pg8::NXCD; wgid = (xcd < r ? xcd * (q + 1) : r * (q + 1) + (xcd - r) * q) + off; }
        const int nig = pg8::WGM * nN, gid = wgid / nig, fm = gid * pg8::WGM, gsz = (nM - fm) < pg8::WGM ? (nM - fm) : pg8::WGM;
        u.pm = fm + ((wgid % nig) % gsz); const int pc = (wgid % nig) / gsz; u.pn = mode ? 5 + pc : (pc < 5 ? pc : pc + 3);
        u.a = A + (size_t)u.pm * tA; u.b = Bt + (size_t)u.pn * tB; u.bjump = 0; u.aux = 0; return true;
    }
    __device__ __forceinline__ void a_ready(const pg8::Unit&) const {}
    __device__ __forceinline__ void done(const pg8::Unit&) const {}
};

__device__ __forceinline__ float wave_sum(float v) {
#pragma unroll
    for (int o = 1; o < 64; o <<= 1) v += __shfl_xor(v, o);
    return v;
}
__device__ __forceinline__ void p0_transpose_item(const float* W, int K, int N, bf16* WT, int map, int row_off, int par, const float* gk, LAS float* scr, int item, int lane, unsigned char* WT8 = nullptr, float s8 = 32.f) {
    const int nblk = (N + 31) / 32, kb = item / nblk, nb = item % nblk, k0 = 64 * kb, n0 = 32 * nb;
    const int c4 = lane & 7, rr = lane >> 3; const bool okc = (n0 + 4 * c4) < N;
    f32x4 v[8];
#pragma unroll
    for (int i = 0; i < 8; ++i) { const int kk = i * 8 + rr; v[i] = okc ? *(const f32x4*)(W + (size_t)(k0 + kk) * N + n0 + 4 * c4) : (f32x4){0.f, 0.f, 0.f, 0.f}; }
#pragma unroll
    for (int i = 0; i < 8; ++i) { const int kk = i * 8 + rr; f32x4 x = v[i]; if (gk) x = x * gk[k0 + kk]; *(LAS f32x4*)(scr + kk * 36 + 4 * c4) = x; }
    LDS_WAIT(); asm volatile("" ::: "memory");
    const int c = lane & 7;
#pragma unroll
    for (int j = 0; j < 4; ++j) { const int nl = (lane >> 3) + 8 * j, n = n0 + nl; const LAS float* s = scr + (8 * c) * 36 + nl;
        v4u o; o.x = pk2(s[0 * 36], s[1 * 36]); o.y = pk2(s[2 * 36], s[3 * 36]); o.z = pk2(s[4 * 36], s[5 * 36]); o.w = pk2(s[6 * 36], s[7 * 36]);
        if (n < N) { const int row = (map == 0) ? row_off + n : (map == 1) ? (n < 1864 ? n : n + 184) : row_off + 2 * n + par;
            if (WT) *(GAS v4u*)(WT + (size_t)row * K + k0 + 8 * c) = o;
            if (WT8) { int w0 = __builtin_amdgcn_cvt_pk_fp8_f32(s[0 * 36] * s8, s[1 * 36] * s8, 0, false); w0 = __builtin_amdgcn_cvt_pk_fp8_f32(s[2 * 36] * s8, s[3 * 36] * s8, w0, true);
                int w1 = __builtin_amdgcn_cvt_pk_fp8_f32(s[4 * 36] * s8, s[5 * 36] * s8, 0, false); w1 = __builtin_amdgcn_cvt_pk_fp8_f32(s[6 * 36] * s8, s[7 * 36] * s8, w1, true);
                *(GAS unsigned long long*)(WT8 + (size_t)row * K + k0 + 8 * c) = (unsigned long long)(unsigned)w0 | ((unsigned long long)(unsigned)w1 << 32); } } }
    LDS_WAIT(); asm volatile("" ::: "memory");
}
__device__ __forceinline__ void p0_prologue(Frame& F, const Args& a) {
    LAS float* scr = (LAS float*)(F.lds + RING_OFF + F.wave * 16384);
    const int gw = F.vcu * NWAVES + F.wave, NGW = F.G * NWAVES;
    bf16* Win_t = (bf16*)(F.ws + WS_WIN); bf16* Wkv_t = (bf16*)(F.ws + WS_WKV);
    constexpr int I_IN = 16 * 219, I_KV = 4 * 8, I_SQ = 16 * 32, I_GU = 16 * 8  , I_DN = 4 * 32  ;
    constexpr int NITEMS = I_IN + I_KV + 3 * I_SQ + 16 * (2 * I_GU + I_DN);
    for (int it = gw; it < NITEMS; it += NGW) {
        int r = it;
        if (r < I_IN) { p0_transpose_item(a.in[2], 1024, INW, Win_t, 1, 0, 0, a.in[1], scr, r, F.lane, F.ws + WS_WIN8); continue; } r -= I_IN;
        if (r < I_KV) { p0_transpose_item(a.in[4], 256, 256, Wkv_t, 0, 0, 0, a.in[3], scr, r, F.lane); continue; } r -= I_KV;
        if (r < I_SQ) { p0_transpose_item(a.in[9], 1024, 1024, nullptr, 0, 0, 0, nullptr, scr, r, F.lane, F.ws + WS_WATT8, 32.f); continue; } r -= I_SQ;
        if (r < I_SQ) { p0_transpose_item(a.in[10], 1024, 1024, nullptr, 0, 0, 0, nullptr, scr, r, F.lane, F.ws + WS_WRET8, 32.f); continue; } r -= I_SQ;
        if (r < I_SQ) { p0_transpose_item(a.in[11], 1024, 1024, nullptr, 0, 0, 0, nullptr, scr, r, F.lane, F.ws + WS_WOUT8, 32.f); continue; } r -= I_SQ;
        const int e = r / (2 * I_GU + I_DN), q = r % (2 * I_GU + I_DN);
        if (q < I_GU) p0_transpose_item(a.in[17] + (size_t)e * 1024 * 256, 1024, 256, nullptr, 2, e * 512, 0, nullptr, scr, q, F.lane, F.ws + WS_W18, 32.f);
        else if (q < 2 * I_GU) p0_transpose_item(a.in[18] + (size_t)e * 1024 * 256, 1024, 256, nullptr, 2, e * 512, 1, nullptr, scr, q - I_GU, F.lane, F.ws + WS_W18, 32.f);
        else p0_transpose_item(a.in[19] + (size_t)e * 256 * 1024, 256, 1024, nullptr, 0, 0, 0, nullptr, scr, q - 2 * I_GU, F.lane, F.ws + WS_WD8 + (size_t)e * 1024 * 256, 16.f);
    }
    { const int gt = (F.vcu * NWAVES + F.wave) * 64 + F.lane, NGT = F.G * NWAVES * 64; GAS v4u* z = (GAS v4u*)(Win_t + (size_t)1864 * 1024);
      for (int i = gt; i < 184 * 1024 * 2 / 16; i += NGT) z[i] = (v4u){0u, 0u, 0u, 0u}; }
    { const int gt = (F.vcu * NWAVES + F.wave) * 64 + F.lane, NGT = F.G * NWAVES * 64; bf16* Wh = (bf16*)(F.ws + WS_WR); bf16* Wl = Wh + 32 * 1024;
      for (int i = gt; i < 32 * 1024; i += NGT) { const int n = i >> 10, k = i & 1023; const float wv = n < 4 ? a.in[13][k * 4 + n] : (n < 20 ? a.in[15][k * 16 + (n - 4)] : 0.f);
        const unsigned hb = f2bf(wv); const float hf = __uint_as_float(hb << 16); Wh[i] = (bf16)hb; Wl[i] = (bf16)f2bf(wv - hf); } }
    const float* x = a.in[0] + (size_t)a.tok0 * D; unsigned char* xb8 = a.xb + (size_t)F.ntok * AUX_XB8;
    for (int m = gw; m < F.ntok; m += 2 * NGW) {
        const int m2 = m + NGW; const bool two = m2 < F.ntok;
        const GAS f32x4* xr = (const GAS f32x4*)(x + (size_t)m * D) + F.lane; const GAS f32x4* xr2 = (const GAS f32x4*)(x + (size_t)(two ? m2 : m) * D) + F.lane;
        f32x4 v[4], u[4]; float s = 0.f, s2 = 0.f;
#pragma unroll
        for (int j = 0; j < 4; ++j) { v[j] = xr[64 * j]; u[j] = xr2[64 * j]; }
#pragma unroll
        for (int j = 0; j < 4; ++j) { s += (v[j].x * v[j].x + v[j].y * v[j].y) + (v[j].z * v[j].z + v[j].w * v[j].w); s2 += (u[j].x * u[j].x + u[j].y * u[j].y) + (u[j].z * u[j].z + u[j].w * u[j].w); }
        const float rstd = 1.f / sqrtf(wave_sum(s) * (1.f / D) + EPS), rstd2 = 1.f / sqrtf(wave_sum(s2) * (1.f / D) + EPS);
        GAS unsigned long long* o8 = (GAS unsigned long long*)(a.xb + (size_t)m * D * 2) + F.lane; GAS unsigned* q8 = (GAS unsigned*)(xb8 + (size_t)m * D) + F.lane;
#pragma unroll
        for (int j = 0; j < 4; ++j) { o8[64 * j] = (unsigned long long)pk2(v[j].x * rstd, v[j].y * rstd) | ((unsigned long long)pk2(v[j].z * rstd, v[j].w * rstd) << 32);
            int w8 = __builtin_amdgcn_cvt_pk_fp8_f32(v[j].x * rstd, v[j].y * rstd, 0, false); w8 = __builtin_amdgcn_cvt_pk_fp8_f32(v[j].z * rstd, v[j].w * rstd, w8, true); q8[64 * j] = (unsigned)w8; }
        if (two) { GAS unsigned long long* p8 = (GAS unsigned long long*)(a.xb + (size_t)m2 * D * 2) + F.lane; GAS unsigned* r8 = (GAS unsigned*)(xb8 + (size_t)m2 * D) + F.lane;
#pragma unroll
            for (int j = 0; j < 4; ++j) { p8[64 * j] = (unsigned long long)pk2(u[j].x * rstd2, u[j].y * rstd2) | ((unsigned long long)pk2(u[j].z * rstd2, u[j].w * rstd2) << 32);
                int w8 = __builtin_amdgcn_cvt_pk_fp8_f32(u[j].x * rstd2, u[j].y * rstd2, 0, false); w8 = __builtin_amdgcn_cvt_pk_fp8_f32(u[j].z * rstd2, u[j].w * rstd2, w8, true); r8[64 * j] = (unsigned)w8; } }
    }
}


constexpr size_t AUX_KP = 0, AUX_VV = 256, AUX_KIN = 512, AUX_MASK = 640, AUX_END = 896;
typedef short bf16x8_t __attribute__((ext_vector_type(8)));
typedef float f32x16 __attribute__((ext_vector_type(16)));
__device__ __forceinline__ int crow(int r, int hi) { return (r & 3) + 8 * (r >> 2) + 4 * hi; }
__device__ __forceinline__ float xhalf_sum(float v) { auto rr = __builtin_amdgcn_permlane32_swap(__float_as_uint(v), __float_as_uint(v), false, false); return __uint_as_float(rr[0]) + __uint_as_float(rr[1]); }
__device__ __forceinline__ float sumsq8(bf16x8_t v) { float s = 0.f;
#pragma unroll
    for (int j = 0; j < 8; ++j) { const float f = __uint_as_float((unsigned)(unsigned short)v[j] << 16); s += f * f; } return s; }
__device__ __forceinline__ void p2_post(Frame& F, const Args& a) {
    const int gw = F.vcu * NWAVES + F.wave, NGW = F.G * NWAVES, lane = F.lane, r32 = lane & 31, hi = lane >> 5;
    const size_t nt_ = (size_t)F.ntok;
    const bf16* CKV = (const bf16*)(F.act + nt_ * O_CKV); const bf16* KW = (const bf16*)(F.act + nt_ * O_KW);
    const bf16* Wkv_t = (const bf16*)(F.ws + WS_WKV);
    unsigned char* aux = a.xb + nt_ * 2048;
    bf16* KP = (bf16*)(aux + nt_ * AUX_KP); bf16* VV = (bf16*)(aux + nt_ * AUX_VV); bf16* KIN = (bf16*)(aux + nt_ * AUX_KIN);
    const float* g_q = a.in[5]; const float* g_k = a.in[6]; const float* g_ki = a.in[7];
    constexpr int WP = 528;
    LAS unsigned char* Wl = F.lds + RING_OFF; LAS float* gl = (LAS float*)(F.lds + RING_OFF + 256 * WP);
    for (int i = F.tid; i < 256 * 32; i += NWAVES * 64) { const int n = i >> 5, ch = i & 31; *(LAS v4u*)(Wl + n * WP + ch * 16) = *(const v4u*)(Wkv_t + (size_t)n * 256 + ch * 8); }
    if (F.tid < 128) gl[F.tid] = g_k[F.tid] * g_q[F.tid] * (0.08838834764831845f * 1.4426950408889634f);
    else if (F.tid < 192) gl[F.tid] = g_ki[F.tid - 128];
    __syncthreads();
    const int ntask = 2 * (F.ntok / 32);
    for (int task = gw; task < ntask; task += NGW) {
        const int kind = task & 1, t0 = (task >> 1) * 32;
        const unsigned char* crowp = (const unsigned char*)CKV + (size_t)(t0 + r32) * 256 + hi * 8;
        bf16x8_t bfr[16]; float ss = 0.f;
#pragma unroll
        for (int kk = 0; kk < 16; ++kk) { const unsigned long long c8 = *(const unsigned long long*)(crowp + kk * 16); const int lo = (int)(unsigned)c8, hi32 = (int)(unsigned)(c8 >> 32);
            const auto a_ = __builtin_amdgcn_cvt_pk_f32_fp8(lo, false), b_ = __builtin_amdgcn_cvt_pk_f32_fp8(lo, true), c_ = __builtin_amdgcn_cvt_pk_f32_fp8(hi32, false), d_ = __builtin_amdgcn_cvt_pk_f32_fp8(hi32, true);
            ss += (a_[0] * a_[0] + a_[1] * a_[1]) + (b_[0] * b_[0] + b_[1] * b_[1]) + (c_[0] * c_[0] + c_[1] * c_[1]) + (d_[0] * d_[0] + d_[1] * d_[1]);
            v4u pk; pk.x = pk2(a_[0], a_[1]); pk.y = pk2(b_[0], b_[1]); pk.z = pk2(c_[0], c_[1]); pk.w = pk2(d_[0], d_[1]); bfr[kk] = __builtin_bit_cast(bf16x8_t, pk); }
        ss = xhalf_sum(ss);
        const float rstd = rsqrtf(ss * (1.f / 256.f) + EPS);
        f32x16 acc[4];
#pragma unroll
        for (int nt = 0; nt < 4; ++nt) { acc[nt] = f32x16{};
            const LAS unsigned char* wrow = Wl + (kind * 128 + nt * 32 + r32) * WP + hi * 16;
#pragma unroll
            for (int kk = 0; kk < 16; ++kk) { const bf16x8_t af = *(const LAS bf16x8_t*)(wrow + kk * 32); acc[nt] = __builtin_amdgcn_mfma_f32_32x32x16_bf16(af, bfr[kk], acc[nt], 0, 0, 0); if ((kk & 3) == 3) __builtin_amdgcn_sched_barrier(0); } }
        float sc = rstd;
        if (kind == 0) { float sk = 0.f;
#pragma unroll
            for (int nt = 0; nt < 4; ++nt)
#pragma unroll
                for (int r = 0; r < 16; ++r) { const float v = acc[nt][r] * rstd; sk += v * v; }
            sk = xhalf_sum(sk);
            sc = rstd * rsqrtf(sk * (1.f / 128.f) + EPS); }
        bf16* orow = (kind == 0 ? KP : VV) + (size_t)(t0 + r32) * 128;
#pragma unroll
        for (int nt = 0; nt < 4; ++nt)
#pragma unroll
            for (int g = 0; g < 4; ++g) { const int ch = nt * 32 + 8 * g + 4 * hi; float v[4];
#pragma unroll
                for (int j = 0; j < 4; ++j) { v[j] = acc[nt][4 * g + j] * sc; if (kind == 0) v[j] *= gl[ch + j]; }
                *(unsigned long long*)(orow + ch) = (unsigned long long)pk2(v[0], v[1]) | ((unsigned long long)pk2(v[2], v[3]) << 32); }
        if (kind == 0) {
            const bf16* kr = KW + (size_t)(t0 + r32) * 128 + hi * 32; bf16x8_t kv4[4]; float s2 = 0.f;
#pragma unroll
            for (int j = 0; j < 4; ++j) { kv4[j] = *(const bf16x8_t*)(kr + 8 * j); s2 += sumsq8(kv4[j]); }
            s2 = xhalf_sum(s2);
            const float rk = rsqrtf(s2 * (1.f / 64.f) + EPS);
            bf16* ko = KIN + (size_t)(t0 + r32) * 64 + hi * 32;
#pragma unroll
            for (int j = 0; j < 4; ++j) { float f[8];
#pragma unroll
                for (int e = 0; e < 8; ++e) f[e] = __uint_as_float((unsigned)(unsigned short)kv4[j][e] << 16) * rk * gl[128 + hi * 32 + 8 * j + e];
                v4u o; o.x = pk2(f[0], f[1]); o.y = pk2(f[2], f[3]); o.z = pk2(f[4], f[5]); o.w = pk2(f[6], f[7]);
                *(v4u*)(ko + 8 * j) = o; }
        }
    }
    __syncthreads();
}

typedef float f32x4_t __attribute__((ext_vector_type(4)));
__device__ __forceinline__ unsigned key15_of(float s) { const unsigned short hb = __builtin_bit_cast(unsigned short, (_Float16)s); const unsigned u = (hb & 0x8000u) ? (~(unsigned)hb & 0xffffu) : ((unsigned)hb | 0x8000u); return u >> 1; }
__device__ __forceinline__ unsigned sad4(unsigned x) { return __builtin_amdgcn_sad_u8(x, 0u, 0u); }
__device__ __forceinline__ void p3_merge(LAS unsigned* hist, LAS unsigned short* tot, int w, int g, int q, int& need, int& bsel) {
    __syncthreads();
    const int o = 4 * w + g; unsigned c = 0;
#pragma unroll
    for (int p = 0; p < 32; ++p) { const int tidp = (p >> 2) * 64 + (p & 3) * 16 + q; c += (hist[(o >> 2) * 512 + tidp] >> (8 * (o & 3))) & 0xffu; }
    tot[q * 32 + o] = (unsigned short)c;
    __syncthreads();
    v4u tv[4];
#pragma unroll
    for (int j = 0; j < 4; ++j) tv[j] = *(const LAS v4u*)((const LAS unsigned char*)tot + q * 64 + j * 16);
    int cum = 0, bs = 0, ab = 0; bool found = false;
#pragma unroll
    for (int bin = 31; bin >= 0; --bin) { const unsigned wd = tv[bin >> 3][(bin >> 1) & 3]; const int cc = (int)((bin & 1) ? (wd >> 16) : (wd & 0xffffu));
        if (!found && cum + cc >= need) { bs = bin; ab = cum; found = true; } cum += cc; }
    bsel = bs; need -= ab;
}
__device__ __forceinline__ void p3_index(Frame& F, const Args& a) {
    const int tid = F.tid, lane = F.lane, w = F.wave, q = lane & 15, g = lane >> 4;
    LAS unsigned* keys = (LAS unsigned*)(F.lds + RING_OFF);
    LAS unsigned char* qbuf = F.lds + 65536;
    LAS unsigned* hist = (LAS unsigned*)(F.lds + P3_HIST_OFF);
    LAS unsigned short* tot = (LAS unsigned short*)(F.lds + P3_TOT_OFF);
    LAS unsigned char* Tt = (LAS unsigned char*)(F.lds + P3_T_OFF);
    const size_t nt_ = (size_t)F.ntok;
    const bf16* QI = (const bf16*)(F.act + nt_ * O_QI); const bf16* KW = (const bf16*)(F.act + nt_ * O_KW);
    unsigned char* aux = a.xb + nt_ * 2048;
    const bf16* KIN = (const bf16*)(aux + nt_ * AUX_KIN); unsigned* MASK = (unsigned*)(aux + nt_ * AUX_MASK);
    const int nb = F.ntok / SEQ, nitems = nb * 128; const int bxj = (int)blockIdx.x >> 3;
    const int G = F.G - F.G / 4, c = (bxj - (bxj >> 2) - 1) * 8 + ((int)blockIdx.x & 7);
#define P3_ITEM(k) ((k) * G + (((k) & 1) ? (G - 1 - c) : c))
#define P3_QDMA(it_, buf_) do { const int qg_ = 127 - (it_) / nb, b_ = (it_) % nb; _Pragma("unroll") for (int i_ = 0; i_ < 2; ++i_) { const int row_ = w * 2 + i_; \
        const char* src_ = (const char*)(QI + ((size_t)b_ * SEQ + qg_ * 16 + row_) * 512) + ((lane ^ (row_ & 15)) * 16); \
        __builtin_amdgcn_global_load_lds((const unsigned*)src_, (LAS unsigned*)(qbuf + (buf_) * 16384 + row_ * 1024), 16, 0, 0); } } while (0)
    const int nround = (nitems + G - 1) / G;
    if (P3_ITEM(0) < nitems) P3_QDMA(P3_ITEM(0), 0);
    v4u wvn = (v4u){0u, 0u, 0u, 0u};
    if (P3_ITEM(0) < nitems) { const int it0 = P3_ITEM(0); wvn = *(const v4u*)(KW + ((size_t)(it0 % nb) * SEQ + (127 - it0 / nb) * 16 + q) * 128 + 64); }
    for (int k = 0; k < nround; ++k) {
        const int it = P3_ITEM(k); if (it >= nitems) break;
        const int qg = 127 - it / nb, b = it % nb, q0 = qg * 16, qme = q0 + q;
        unsigned* Mb = MASK + (size_t)b * 64 * 2048;
        const int kb_hi = ((qg >> 3) + 1) << 2, nkb = (qg >> 1) + 1;
        asm volatile("s_waitcnt vmcnt(0) lgkmcnt(0)\n\ts_barrier" ::: "memory");
        const v4u wv = wvn;
        { const int itn = P3_ITEM(k + 1); if (k + 1 < nround && itn < nitems) { P3_QDMA(itn, (k + 1) & 1); wvn = *(const v4u*)(KW + ((size_t)(itn % nb) * SEQ + (127 - itn / nb) * 16 + q) * 128 + 64); } }
        if (qg < 16) {
            if (tid < kb_hi * 16) { const int kb = tid >> 4, qq = q0 + (tid & 15), nbits = qq - kb * 32 + 1; Mb[kb * 2048 + qq] = nbits >= 32 ? 0xffffffffu : (nbits <= 0 ? 0u : ((1u << nbits) - 1u)); }
            continue;
        }
        float wq[8];
        { const float cc = 0.35355339059327373f * 0.125f;
          wq[0] = pg8::bf_lo(wv.x) * cc; wq[1] = pg8::bf_hi(wv.x) * cc; wq[2] = pg8::bf_lo(wv.y) * cc; wq[3] = pg8::bf_hi(wv.y) * cc; wq[4] = pg8::bf_lo(wv.z) * cc; wq[5] = pg8::bf_hi(wv.z) * cc; wq[6] = pg8::bf_lo(wv.w) * cc; wq[7] = pg8::bf_hi(wv.w) * cc; }
        bf16x8_t qfr[8][2], qlin[2];
        { const LAS unsigned char* qrow = qbuf + (k & 1) * 16384 + q * 1024;
#pragma unroll
          for (int h = 0; h < 8; ++h)
#pragma unroll
            for (int ks = 0; ks < 2; ++ks) qfr[h][ks] = *(const LAS bf16x8_t*)(qrow + (((h * 8 + ks * 4 + g) ^ q) * 16)); }
#pragma unroll
        for (int ks = 0; ks < 2; ++ks) { float f[8];
#pragma unroll
            for (int j = 0; j < 8; ++j) { float s = 0.f;
#pragma unroll
                for (int h = 0; h < 8; ++h) s += wq[h] * __uint_as_float((unsigned)(unsigned short)qfr[h][ks][j] << 16);
                f[j] = s; }
            v4u o; o.x = pk2(f[0], f[1]); o.y = pk2(f[2], f[3]); o.z = pk2(f[4], f[5]); o.w = pk2(f[6], f[7]); qlin[ks] = __builtin_bit_cast(bf16x8_t, o); }
#pragma unroll
        for (int i = 0; i < 8; ++i) hist[i * 512 + tid] = 0u;
        const bf16* kbase = KIN + ((size_t)b * SEQ + q) * 64 + g * 8;
        bf16x8_t afr[2][2], afn[2][2];
#pragma unroll
        for (int t = 0; t < 2; ++t)
#pragma unroll
            for (int ks = 0; ks < 2; ++ks) afn[t][ks] = *(const bf16x8_t*)(kbase + (size_t)(w * 32 + t * 16) * 64 + ks * 32);
        for (int s = 0, kb = w; kb < nkb; ++s, kb += 8) {
#pragma unroll
            for (int t = 0; t < 2; ++t)
#pragma unroll
                for (int ks = 0; ks < 2; ++ks) afr[t][ks] = afn[t][ks];
            if (kb + 8 < nkb) {
#pragma unroll
                for (int t = 0; t < 2; ++t)
#pragma unroll
                    for (int ks = 0; ks < 2; ++ks) afn[t][ks] = *(const bf16x8_t*)(kbase + (size_t)((kb + 8) * 32 + t * 16) * 64 + ks * 32); }
#pragma unroll
            for (int t = 0; t < 2; ++t) {
                f32x4_t sacc = f32x4_t{};
#pragma unroll
                for (int ks = 0; ks < 2; ++ks) sacc = __builtin_amdgcn_mfma_f32_16x16x32_bf16(afr[t][ks], qlin[ks], sacc, 0, 0, 0);
#pragma unroll
                for (int h = 0; h < 8; ++h) { f32x4_t d = f32x4_t{};
#pragma unroll
                    for (int ks = 0; ks < 2; ++ks) d = __builtin_amdgcn_mfma_f32_16x16x32_bf16(afr[t][ks], qfr[h][ks], d, 0, 0, 0);
#pragma unroll
                    for (int r = 0; r < 4; ++r) sacc[r] = fmaf(fabsf(d[r]), wq[h], sacc[r]); }
#pragma unroll
                for (int i = 0; i < 2; ++i) { unsigned k2[2];
#pragma unroll
                    for (int e = 0; e < 2; ++e) { const int r = 2 * i + e; unsigned kk_ = key15_of(sacc[r]); if (kb * 32 + t * 16 + 4 * g + r > qme) kk_ = 0u; k2[e] = kk_;
                        const unsigned dg = kk_ >> 10; (void)__hip_atomic_fetch_add((LAS unsigned*)&hist[(dg >> 2) * 512 + tid], 1u << ((dg & 3u) * 8u), __ATOMIC_RELAXED, __HIP_MEMORY_SCOPE_WORKGROUP); }
                    keys[(s * 4 + t * 2 + i) * 512 + tid] = k2[0] | (k2[1] << 16); }
            }
        }
        int need = 256, bsel;
        p3_merge(hist, tot, w, g, q, need, bsel);
        unsigned prefix = (unsigned)bsel;
#pragma unroll
        for (int pass = 0; pass < 2; ++pass) {
            const int sh_hi = pass == 0 ? 10 : 5, sh = pass == 0 ? 5 : 0;
#pragma unroll
            for (int i = 0; i < 8; ++i) hist[i * 512 + tid] = 0u;
#pragma unroll
            for (int s = 0; s < 8; ++s) if (w + 8 * s < nkb) {
#pragma unroll
                for (int i = 0; i < 4; ++i) { const unsigned d2 = keys[(s * 4 + i) * 512 + tid];
#pragma unroll
                    for (int e = 0; e < 2; ++e) { const unsigned kk_ = e ? (d2 >> 16) : (d2 & 0xffffu);
                        if ((kk_ >> sh_hi) == prefix) { const unsigned dg = (kk_ >> sh) & 31u; (void)__hip_atomic_fetch_add((LAS unsigned*)&hist[(dg >> 2) * 512 + tid], 1u << ((dg & 3u) * 8u), __ATOMIC_RELAXED, __HIP_MEMORY_SCOPE_WORKGROUP); } } } }
            p3_merge(hist, tot, w, g, q, need, bsel);
            prefix = (prefix << 5) | (unsigned)bsel;
        }
        const unsigned tau = prefix; const int need_eq = need;
        unsigned gtw[8], eqw[8];
#pragma unroll
        for (int s = 0; s < 8; ++s) { const int kb = w + 8 * s; gtw[s] = 0u; eqw[s] = 0u;
            if (kb < nkb) { unsigned gg = 0u, qq = 0u;
#pragma unroll
                for (int i = 0; i < 4; ++i) { const unsigned d2 = keys[(s * 4 + i) * 512 + tid];
#pragma unroll
                    for (int e = 0; e < 2; ++e) { const unsigned kk_ = e ? (d2 >> 16) : (d2 & 0xffffu); const int bit = (i >> 1) * 16 + 4 * g + (i & 1) * 2 + e;
                        gg |= (kk_ > tau ? 1u : 0u) << bit; qq |= (kk_ == tau ? 1u : 0u) << bit; } }
                gg |= (unsigned)__shfl_xor((int)gg, 16); gg |= (unsigned)__shfl_xor((int)gg, 32); qq |= (unsigned)__shfl_xor((int)qq, 16); qq |= (unsigned)__shfl_xor((int)qq, 32);
                gtw[s] = gg; eqw[s] = qq;
                if (g == 0) Tt[q * 64 + kb] = (unsigned char)__builtin_popcount(qq); } }
        __syncthreads();
        { unsigned run = 0u;
#pragma unroll
          for (int s = 0; s < 8; ++s) { const int kb = w + 8 * s;
            if (kb < nkb) { const unsigned g0 = *(const LAS unsigned*)(Tt + q * 64 + 8 * s), g1 = *(const LAS unsigned*)(Tt + q * 64 + 8 * s + 4);
                const unsigned m0 = w >= 4 ? g0 : (w == 0 ? 0u : (g0 & ((1u << (8 * w)) - 1u))), m1 = w > 4 ? (g1 & ((1u << (8 * (w - 4))) - 1u)) : 0u;
                const int pre = (int)(run + sad4(m0) + sad4(m1)), m = need_eq - pre, pc = __builtin_popcount(eqw[s]);
                unsigned se = eqw[s];
                if (m < pc) { se = 0u; unsigned x = eqw[s]; for (int i = 0; i < m; ++i) { const unsigned bb = x & (0u - x); se |= bb; x ^= bb; } }
                if (g == 0) Mb[kb * 2048 + qme] = gtw[s] | se;
                run += sad4(g0) + sad4(g1); } } }
        if (tid < (kb_hi - nkb) * 16) Mb[(nkb + (tid >> 4)) * 2048 + q0 + (tid & 15)] = 0u;
    }
    asm volatile("s_waitcnt vmcnt(0) lgkmcnt(0)" ::: "memory");
    __syncthreads();
#undef P3_ITEM
#undef P3_QDMA
}

namespace att {
using bf16x8 = __attribute__((ext_vector_type(8))) short;
using s16x4  = __attribute__((ext_vector_type(4))) short;
using u32x4  = __attribute__((ext_vector_type(4))) unsigned;
constexpr int KVBLK = 64;
constexpr size_t SHM_V = KVBLK * 128 * 2, SHM_K = KVBLK * 128 * 2;
constexpr int OFF_WS = 65536, OFF_MK = 65536 + 2048, OFF_Q = 65536 + 2048 + 8192, QPITCH = 272;
constexpr float THR2 = 11.5f;
#define KSWZ(row, colB) ((row) * 256 + ((colB) ^ (((row) & 7) << 4)))
#define SBAR() __builtin_amdgcn_sched_barrier(0)
__device__ __forceinline__ unsigned cvtpk(float lo, float hi) { unsigned r; asm volatile("v_cvt_pk_bf16_f32 %0, %1, %2" : "=v"(r) : "v"(lo), "v"(hi)); return r; }
__device__ __forceinline__ float msk(float p, unsigned w, int bit) { const int m = __builtin_amdgcn_sbfe((int)w, bit, 1); return __uint_as_float((__float_as_uint(p) & (unsigned)m) | (0xff800000u & ~(unsigned)m)); }
__device__ __forceinline__ void partialSM(f32x16& p0, f32x16& p1, unsigned w0, unsigned w1, float& m_reg, float& mn, float& alpha) {
#pragma unroll
  for (int r = 0; r < 16; ++r) { const int bit = (r & 3) + 8 * (r >> 2); p0[r] = msk(p0[r], w0, bit); p1[r] = msk(p1[r], w1, bit); }
  float pmax = p0[0];
#pragma unroll
  for (int r = 1; r < 16; ++r) pmax = fmaxf(pmax, p0[r]);
#pragma unroll
  for (int r = 0; r < 16; ++r) pmax = fmaxf(pmax, p1[r]);
  { auto rr = __builtin_amdgcn_permlane32_swap(__float_as_uint(pmax), __float_as_uint(pmax), false, false); pmax = fmaxf(__uint_as_float(rr[0]), __uint_as_float(rr[1])); }
  if (__builtin_expect(__all(pmax - m_reg <= THR2), 1)) { mn = m_reg; alpha = 1.f; }
  else { mn = fmaxf(m_reg, pmax); alpha = __builtin_amdgcn_exp2f(m_reg - mn); m_reg = mn; }
#pragma unroll
  for (int r = 0; r < 16; ++r) { p0[r] -= mn; p1[r] -= mn; }
#pragma unroll
  for (int r = 0; r < 16; ++r) p0[r] = __builtin_amdgcn_exp2f(p0[r]);
}
__device__ __forceinline__ void finishSM(f32x16& p0, f32x16& p1, float alpha, float& l_reg, bf16x8& pa0, bf16x8& pa1, bf16x8& pa2, bf16x8& pa3) {
#pragma unroll
  for (int r = 0; r < 16; ++r) p1[r] = __builtin_amdgcn_exp2f(p1[r]);
  float ps = 0;
#pragma unroll
  for (int r = 0; r < 16; ++r) ps += p0[r];
#pragma unroll
  for (int r = 0; r < 16; ++r) ps += p1[r];
  { auto rr = __builtin_amdgcn_permlane32_swap(__float_as_uint(ps), __float_as_uint(ps), false, false); ps = __uint_as_float(rr[0]) + __uint_as_float(rr[1]); }
  l_reg = l_reg * alpha + ps;
#define PK4(P, BASE, OUT) do { unsigned a0 = cvtpk(P[BASE + 0], P[BASE + 1]), a1 = cvtpk(P[BASE + 2], P[BASE + 3]);   \
    unsigned b0 = cvtpk(P[BASE + 4], P[BASE + 5]), b1 = cvtpk(P[BASE + 6], P[BASE + 7]);                              \
    auto r0 = __builtin_amdgcn_permlane32_swap(a0, b0, false, false); auto r1 = __builtin_amdgcn_permlane32_swap(a1, b1, false, false); \
    u32x4 w = {r0[0], r1[0], r0[1], r1[1]}; OUT = *reinterpret_cast<bf16x8*>(&w); } while (0)
  PK4(p0, 0, pa0); PK4(p0, 8, pa1); PK4(p1, 0, pa2); PK4(p1, 8, pa3);
#undef PK4
}
__device__ __forceinline__ void qkt(f32x16& p0, f32x16& p1, const char* Ks, const char* qrow, const float (&bo)[16], float kb0, float kb1, int r32, int hi) {
#pragma unroll
  for (int r = 0; r < 16; ++r) { p0[r] = bo[r] + kb0; p1[r] = bo[r] + kb1; }
#pragma unroll
  for (int d0 = 0; d0 < 8; ++d0) { const int cb = (d0 * 16 + hi * 8) * 2;
    const bf16x8 b0 = *reinterpret_cast<const bf16x8*>(Ks + KSWZ(r32, cb));
    const bf16x8 b1 = *reinterpret_cast<const bf16x8*>(Ks + KSWZ(32 + r32, cb));
    const bf16x8 qf = *reinterpret_cast<const bf16x8*>(qrow + d0 * 32);
    p0 = __builtin_amdgcn_mfma_f32_32x32x16_bf16(b0, qf, p0, 0, 0, 0);
    p1 = __builtin_amdgcn_mfma_f32_32x32x16_bf16(b1, qf, p1, 0, 0, 0); }
}
__device__ __forceinline__ int v_st(int k, int c) { const int kk = (k & ~0xC) | ((k & 4) << 1) | ((k & 8) >> 1); return ((kk >> 3) * 4 + (c >> 5)) * 512 + ((kk & 7) * 32 + (c & 31)) * 2; }
__device__ __forceinline__ int v_rd_base(int lane) { return ((lane & 3) << 3) | (((lane >> 2) & 3) << 6) | (((lane >> 4) & 1) << 5) | (((lane >> 5) & 1) << 8); }
constexpr int v_rd_off(int d0, int ks, int half) { return d0 * 512 + ks * 4096 + half * 2048; }
template <int OFF> __device__ __forceinline__ s16x4 tr_read(int vb) { s16x4 r; asm volatile("ds_read_b64_tr_b16 %0, %1 offset:%2" : "=&v"(r) : "v"(vb), "i"(OFF) : "memory"); return r; }
template <int D0> __device__ __forceinline__ void pv_one(f32x16& od, int vb, bf16x8 pa0, bf16x8 pa1, bf16x8 pa2, bf16x8 pa3) {
  const s16x4 l0 = tr_read<v_rd_off(D0, 0, 0)>(vb), h0 = tr_read<v_rd_off(D0, 0, 1)>(vb), l1 = tr_read<v_rd_off(D0, 1, 0)>(vb), h1 = tr_read<v_rd_off(D0, 1, 1)>(vb);
  const s16x4 l2 = tr_read<v_rd_off(D0, 2, 0)>(vb), h2 = tr_read<v_rd_off(D0, 2, 1)>(vb), l3 = tr_read<v_rd_off(D0, 3, 0)>(vb), h3 = tr_read<v_rd_off(D0, 3, 1)>(vb);
  asm volatile("s_waitcnt lgkmcnt(0)" ::: "memory"); SBAR();
#define PK(L, H) (bf16x8){L[0], L[1], L[2], L[3], H[0], H[1], H[2], H[3]}
  od = __builtin_amdgcn_mfma_f32_32x32x16_bf16(pa0, PK(l0, h0), od, 0, 0, 0);
  od = __builtin_amdgcn_mfma_f32_32x32x16_bf16(pa1, PK(l1, h1), od, 0, 0, 0);
  od = __builtin_amdgcn_mfma_f32_32x32x16_bf16(pa2, PK(l2, h2), od, 0, 0, 0);
  od = __builtin_amdgcn_mfma_f32_32x32x16_bf16(pa3, PK(l3, h3), od, 0, 0, 0);
#undef PK
}
__device__ __forceinline__ void pv_d0(f32x16* o, int vb, bf16x8 pa0, bf16x8 pa1, bf16x8 pa2, bf16x8 pa3) {
  pv_one<0>(o[0], vb, pa0, pa1, pa2, pa3); pv_one<1>(o[1], vb, pa0, pa1, pa2, pa3); pv_one<2>(o[2], vb, pa0, pa1, pa2, pa3); pv_one<3>(o[3], vb, pa0, pa1, pa2, pa3);
}
__device__ __forceinline__ void attn_item(const bf16* __restrict__ Qb, const bf16* __restrict__ Kh, const bf16* __restrict__ Vh, const unsigned* __restrict__ Mq, bf16* __restrict__ Ob, int NT, char* lds, LAS unsigned char* ldsL) {
  const int tid = threadIdx.x, wid = __builtin_amdgcn_readfirstlane(tid >> 6), lane = tid & 63, r32 = lane & 31, hi = lane >> 5;
  float* ws = (float*)(lds + OFF_WS) + wid * 64; float* li_l = ws; float* al_l = ws + 32;
  unsigned* mk = (unsigned*)(lds + OFF_MK);
  unsigned soff[4];
#pragma unroll
  for (int i = 0; i < 4; ++i) { const int pc = (wid & 3) * 4 + i;
    if (wid < 4) { const int row = pc * 4 + (lane >> 4), cb = (lane & 15) * 16; soff[i] = (unsigned)(row * 256 + (cb ^ ((row & 7) << 4))); }
    else { const int L = pc * 1024 + lane * 16, st = L >> 9, wi = L & 511, kk = (st >> 2) * 8 + (wi >> 6), c = (st & 3) * 32 + ((wi & 63) >> 1), k = (kk & ~0xC) | ((kk & 4) << 1) | ((kk & 8) >> 1);
           soff[i] = (unsigned)(k * 256 + c * 2); } }
  const char* gsrc = (const char*)(wid < 4 ? Kh : Vh);
  const unsigned ldst = (unsigned)((wid < 4 ? 0 : 16384) + (wid & 3) * 4096);
#define DMA_TILE(t, slot) do { _Pragma("unroll") for (int i_ = 0; i_ < 4; ++i_) \
    __builtin_amdgcn_global_load_lds((const unsigned*)(gsrc + (size_t)(t) * (64 * 256) + soff[i_]), (LAS unsigned*)(ldsL + (slot) * 32768 + ldst + i_ * 1024), 16, 0, 0); } while (0)
  DMA_TILE(0, 0);
  float m_reg = -1e30f, l_reg = 0; f32x16 o[4] = {}; bf16x8 qr[8];
  { const unsigned char* Qw = (const unsigned char*)Qb + (size_t)r32 * 1024 + wid * 128 + hi * 8; float ss = 0.f; unsigned long long q8[8];
#pragma unroll
    for (int d0 = 0; d0 < 8; ++d0) q8[d0] = *reinterpret_cast<const unsigned long long*>(Qw + d0 * 16);
    unsigned mv[4];
#pragma unroll
    for (int i = 0; i < 4; ++i) { const int idx = tid + 512 * i; mv[i] = idx < NT * 64 ? Mq[(size_t)(idx >> 5) * 2048 + (idx & 31)] : 0u; }
#pragma unroll
    for (int i = 0; i < 4; ++i) { const int idx = tid + 512 * i; if (idx < NT * 64) mk[idx] = mv[i]; }
    float qf[8][8];
#pragma unroll
    for (int d0 = 0; d0 < 8; ++d0) { const int lo = (int)(unsigned)q8[d0], hi32 = (int)(unsigned)(q8[d0] >> 32);
      const auto a_ = __builtin_amdgcn_cvt_pk_f32_fp8(lo, false), b_ = __builtin_amdgcn_cvt_pk_f32_fp8(lo, true), c_ = __builtin_amdgcn_cvt_pk_f32_fp8(hi32, false), d_ = __builtin_amdgcn_cvt_pk_f32_fp8(hi32, true);
      qf[d0][0] = a_[0]; qf[d0][1] = a_[1]; qf[d0][2] = b_[0]; qf[d0][3] = b_[1]; qf[d0][4] = c_[0]; qf[d0][5] = c_[1]; qf[d0][6] = d_[0]; qf[d0][7] = d_[1];
#pragma unroll
      for (int j = 0; j < 8; ++j) ss += qf[d0][j] * qf[d0][j]; }
    ss = xhalf_sum(ss); const float rq = rsqrtf(ss * (1.f / 128.f) + EPS);
#pragma unroll
    for (int d0 = 0; d0 < 8; ++d0) { u32x4 w = {cvtpk(qf[d0][0] * rq, qf[d0][1] * rq), cvtpk(qf[d0][2] * rq, qf[d0][3] * rq), cvtpk(qf[d0][4] * rq, qf[d0][5] * rq), cvtpk(qf[d0][6] * rq, qf[d0][7] * rq)}; qr[d0] = *reinterpret_cast<bf16x8*>(&w); } }
  const float slope2 = __builtin_amdgcn_exp2f(-(float)(wid + 1)) * 1.4426950408889634f;
  float bo[16];
#pragma unroll
  for (int r = 0; r < 16; ++r) bo[r] = __uint_as_float(__builtin_amdgcn_readfirstlane(__float_as_uint(slope2 * (float)((r & 3) + 8 * (r >> 2)))));
  const float hoff = slope2 * (float)(4 * hi);
  const int vb0 = (int)(uintptr_t)(lds + 16384) + v_rd_base(lane);
  asm volatile("s_waitcnt vmcnt(0) lgkmcnt(0)\n\ts_barrier" ::: "memory");
  for (int j = 0; j < NT; ++j) {
    const int sl = j & 1;
    if (j + 1 < NT) DMA_TILE(j + 1, sl ^ 1);
    const char* Ks = lds + sl * 32768;
    const unsigned w0 = mk[(2 * j) * 32 + r32] >> (4 * hi), w1 = mk[(2 * j + 1) * 32 + r32] >> (4 * hi);
    f32x16 p0, p1;
    { const float kb0 = slope2 * (float)(j * 64) + hoff, kb1 = kb0 + slope2 * 32.f;
#pragma unroll
      for (int r = 0; r < 16; ++r) { p0[r] = bo[r] + kb0; p1[r] = bo[r] + kb1; }
      bf16x8 ka = *reinterpret_cast<const bf16x8*>(Ks + KSWZ(r32, hi * 16)), kb = *reinterpret_cast<const bf16x8*>(Ks + KSWZ(32 + r32, hi * 16));
#pragma unroll
      for (int d0 = 0; d0 < 8; ++d0) { bf16x8 na = ka, nb = kb;
        if (d0 < 7) { const int cb = ((d0 + 1) * 16 + hi * 8) * 2; na = *reinterpret_cast<const bf16x8*>(Ks + KSWZ(r32, cb)); nb = *reinterpret_cast<const bf16x8*>(Ks + KSWZ(32 + r32, cb)); }
        SBAR();
        p0 = __builtin_amdgcn_mfma_f32_32x32x16_bf16(ka, qr[d0], p0, 0, 0, 0);
        p1 = __builtin_amdgcn_mfma_f32_32x32x16_bf16(kb, qr[d0], p1, 0, 0, 0);
        SBAR();
        ka = na; kb = nb; } }
    float alpha; bf16x8 pa0, pa1, pa2, pa3;
    {
#pragma unroll
      for (int r = 0; r < 16; ++r) { const int bit = (r & 3) + 8 * (r >> 2); p0[r] = msk(p0[r], w0, bit); p1[r] = msk(p1[r], w1, bit); }
      float pmax = fmaxf(p0[0], p1[0]);
#pragma unroll
      for (int r = 1; r < 16; ++r) pmax = fmaxf(fmaxf(pmax, p0[r]), p1[r]);
      { auto rr = __builtin_amdgcn_permlane32_swap(__float_as_uint(pmax), __float_as_uint(pmax), false, false); pmax = fmaxf(__uint_as_float(rr[0]), __uint_as_float(rr[1])); }
      float mn;
      if (__builtin_expect(__all(pmax - m_reg <= THR2), 1)) { mn = m_reg; alpha = 1.f; }
      else { mn = fmaxf(m_reg, pmax); alpha = __builtin_amdgcn_exp2f(m_reg - mn); m_reg = mn; }
      float ps = 0.f;
#pragma unroll
      for (int r = 0; r < 16; ++r) { p0[r] = __builtin_amdgcn_exp2f(p0[r] - mn); p1[r] = __builtin_amdgcn_exp2f(p1[r] - mn); ps += p0[r] + p1[r]; }
      { auto rr = __builtin_amdgcn_permlane32_swap(__float_as_uint(ps), __float_as_uint(ps), false, false); ps = __uint_as_float(rr[0]) + __uint_as_float(rr[1]); }
      l_reg = l_reg * alpha + ps;
#define PK4(P, BASE, OUT) do { unsigned a0 = cvtpk(P[BASE + 0], P[BASE + 1]), a1 = cvtpk(P[BASE + 2], P[BASE + 3]);   \
    unsigned b0 = cvtpk(P[BASE + 4], P[BASE + 5]), b1 = cvtpk(P[BASE + 6], P[BASE + 7]);                              \
    auto r0 = __builtin_amdgcn_permlane32_swap(a0, b0, false, false); auto r1 = __builtin_amdgcn_permlane32_swap(a1, b1, false, false); \
    u32x4 w = {r0[0], r1[0], r0[1], r1[1]}; OUT = *reinterpret_cast<bf16x8*>(&w); } while (0)
      PK4(p0, 0, pa0); PK4(p0, 8, pa1); PK4(p1, 0, pa2); PK4(p1, 8, pa3);
#undef PK4
      if (__any(alpha < 1.f)) { if (hi == 0) al_l[r32] = alpha; asm volatile("s_waitcnt lgkmcnt(0)" ::: "memory");
#pragma unroll
        for (int d = 0; d < 4; ++d)
#pragma unroll
          for (int r = 0; r < 16; ++r) o[d][r] *= al_l[crow(r, hi)]; }
    }
    { const int vb = vb0 + sl * 32768;
      s16x4 lA[4], hA[4], lB[4], hB[4];
#define VREADS(L_, H_, D0) do { L_[0] = tr_read<v_rd_off(D0, 0, 0)>(vb); H_[0] = tr_read<v_rd_off(D0, 0, 1)>(vb); L_[1] = tr_read<v_rd_off(D0, 1, 0)>(vb); H_[1] = tr_read<v_rd_off(D0, 1, 1)>(vb); \
      L_[2] = tr_read<v_rd_off(D0, 2, 0)>(vb); H_[2] = tr_read<v_rd_off(D0, 2, 1)>(vb); L_[3] = tr_read<v_rd_off(D0, 3, 0)>(vb); H_[3] = tr_read<v_rd_off(D0, 3, 1)>(vb); } while (0)
#define PK(L, H) (bf16x8){L[0], L[1], L[2], L[3], H[0], H[1], H[2], H[3]}
#define VMMA(OD, L_, H_) do { OD = __builtin_amdgcn_mfma_f32_32x32x16_bf16(pa0, PK(L_[0], H_[0]), OD, 0, 0, 0); OD = __builtin_amdgcn_mfma_f32_32x32x16_bf16(pa1, PK(L_[1], H_[1]), OD, 0, 0, 0); \
      OD = __builtin_amdgcn_mfma_f32_32x32x16_bf16(pa2, PK(L_[2], H_[2]), OD, 0, 0, 0); OD = __builtin_amdgcn_mfma_f32_32x32x16_bf16(pa3, PK(L_[3], H_[3]), OD, 0, 0, 0); } while (0)
#define VWAIT(N, L_, H_) do { asm volatile("s_waitcnt lgkmcnt(" #N ")" : "+v"(L_[0]), "+v"(L_[1]), "+v"(L_[2]), "+v"(L_[3]), "+v"(H_[0]), "+v"(H_[1]), "+v"(H_[2]), "+v"(H_[3]) :: "memory"); SBAR(); } while (0)
      VREADS(lA, hA, 0); VREADS(lB, hB, 1);
      VWAIT(8, lA, hA); VMMA(o[0], lA, hA);
      VREADS(lA, hA, 2);
      VWAIT(8, lB, hB); VMMA(o[1], lB, hB);
      VREADS(lB, hB, 3);
      VWAIT(8, lA, hA); VMMA(o[2], lA, hA);
      VWAIT(0, lB, hB); VMMA(o[3], lB, hB);
#undef VREADS
#undef PK
#undef VMMA
#undef VWAIT
    }
    asm volatile("s_waitcnt vmcnt(0) lgkmcnt(0)\n\ts_barrier" ::: "memory");
  }
  if (hi == 0) li_l[r32] = l_reg; asm volatile("s_waitcnt lgkmcnt(0)" ::: "memory");
  float rli[16];
#pragma unroll
  for (int r = 0; r < 16; ++r) rli[r] = __builtin_amdgcn_rcpf(li_l[crow(r, hi)]);
  unsigned char* stg = (unsigned char*)(lds + wid * 4096);
#pragma unroll
  for (int r = 0; r < 16; ++r) { const int orow = crow(r, hi); const float sc16 = rli[r] * 16.f;
#pragma unroll
    for (int d0 = 0; d0 < 4; ++d0) stg[orow * 128 + d0 * 32 + r32] = (unsigned char)__builtin_amdgcn_cvt_pk_fp8_f32(o[d0][r] * sc16, 0.f, 0, false); }
  asm volatile("s_waitcnt lgkmcnt(0)" ::: "memory");
#pragma unroll
  for (int i = 0; i < 4; ++i) { const int row = i * 8 + (lane >> 3), ch = lane & 7; const u32x4 v = *(const u32x4*)(stg + row * 128 + ch * 16);
    *(u32x4*)((unsigned char*)Ob + (size_t)row * 1024 + wid * 128 + ch * 16) = v; }
#undef DMA_TILE
}
#undef KSWZ
#undef SBAR
}


namespace ret {
using bf16x8 = __attribute__((ext_vector_type(8))) short;
using s16x4  = __attribute__((ext_vector_type(4))) short;
using u32x4  = __attribute__((ext_vector_type(4))) unsigned;
using u32x2  = __attribute__((ext_vector_type(2))) unsigned;
constexpr int C = 64, QP = 272, KPI = 272, VP = 576;
constexpr int OFF_Q = 0, OFF_K = 17408, OFF_V = 34816, OFF_ST = 71680, OFF_Y = 75776;
typedef float f32x2_t __attribute__((ext_vector_type(2))); typedef __bf16 bf16x2_t __attribute__((ext_vector_type(2)));
__device__ __forceinline__ unsigned cvtpk(float lo, float hi) { const f32x2_t v = {lo, hi}; const bf16x2_t b = __builtin_convertvector(v, bf16x2_t); return __builtin_bit_cast(unsigned, b); }
template <int OFF> __device__ __forceinline__ s16x4 trr(int base) { s16x4 r; asm volatile("ds_read_b64_tr_b16 %0, %1 offset:%2" : "=&v"(r) : "v"(base), "i"(OFF) : "memory"); return r; }
__device__ __forceinline__ bf16x8 pk8(const f32x16& x, int s) { u32x4 w = {cvtpk(x[8 * s + 0], x[8 * s + 1]), cvtpk(x[8 * s + 2], x[8 * s + 3]), cvtpk(x[8 * s + 4], x[8 * s + 5]), cvtpk(x[8 * s + 6], x[8 * s + 7])}; return *reinterpret_cast<bf16x8*>(&w); }
__device__ __forceinline__ float silu_(float x) { return x * __builtin_amdgcn_rcpf(1.f + __builtin_amdgcn_exp2f(-1.4426950408889634f * x)); }
__device__ __forceinline__ void ret_item(int b, int h, const unsigned char* __restrict__ RQ, const unsigned char* __restrict__ RK, const unsigned char* __restrict__ RV, const unsigned char* __restrict__ RG, unsigned char* A2F8, const float* __restrict__ gnorm, char* lds, int c0, int c1, float* state) {
  const int tid = threadIdx.x, w = __builtin_amdgcn_readfirstlane(tid >> 6), lane = tid & 63, r32 = lane & 31, hi = lane >> 5;
  const float lg = __log2f(1.f - exp2f(-5.f - (float)h)), gC = exp2f(64.f * lg);
  char* Qs = lds + OFF_Q; char* Ks = lds + OFF_K; char* Vs = lds + OFF_V; float* st = (float*)(lds + OFF_ST); char* Ys = lds + OFF_Y;
  f32x16 S[4] = {};
  if (c0 > 0) {
#pragma unroll
    for (int dt = 0; dt < 4; ++dt)
#pragma unroll
      for (int r = 0; r < 16; ++r) S[dt][r] = state[(dt * 16 + r) * 512 + tid]; }
  const unsigned voffQ = (unsigned)(((tid >> 4) * 512 + (tid & 15) * 8) * 2), voffV = (unsigned)(((tid >> 5) * 1024 + (tid & 31) * 8) * 2);
  const int trq = (lane & 15) >> 2, trp = lane & 3, trg = (lane >> 4) & 1;
  const int vtb = (int)(uintptr_t)(lds + OFF_V) + (4 * hi + trq) * VP + (32 * w + 16 * trg + 4 * trp) * 2, ktb = (int)(uintptr_t)(lds + OFF_K) + (4 * hi + trq) * KPI + (16 * trg + 4 * trp) * 2;
  u32x2 pq[2], pk[2], pv[4];
  const unsigned voffQ8 = (unsigned)((tid >> 4) * 512 + (tid & 15) * 8), voffV8 = voffV >> 1;
#define RET_LOAD(cc) do { const size_t t0_ = (size_t)b * SEQ + (size_t)(cc) * C; const unsigned char* qb_ = RQ + t0_ * 512 + h * 128; const unsigned char* kb_ = RK + t0_ * 512 + h * 128; const unsigned char* vb_ = RV + t0_ * 1024 + h * 256; \
    _Pragma("unroll") for (int i = 0; i < 2; ++i) { pq[i] = *(const u32x2*)(qb_ + voffQ8 + i * 16384); pk[i] = *(const u32x2*)(kb_ + voffQ8 + i * 16384); } \
    _Pragma("unroll") for (int i = 0; i < 4; ++i) pv[i] = *(const u32x2*)(vb_ + voffV8 + i * 16384); } while (0)
#define RET_F8(src_, f_, out_) do { const auto a_ = __builtin_amdgcn_cvt_pk_f32_fp8((int)(src_).x, false), b_ = __builtin_amdgcn_cvt_pk_f32_fp8((int)(src_).x, true), c_ = __builtin_amdgcn_cvt_pk_f32_fp8((int)(src_).y, false), d_ = __builtin_amdgcn_cvt_pk_f32_fp8((int)(src_).y, true); \
    out_.x = cvtpk(a_[0] * (f_), a_[1] * (f_)); out_.y = cvtpk(b_[0] * (f_), b_[1] * (f_)); out_.z = cvtpk(c_[0] * (f_), c_[1] * (f_)); out_.w = cvtpk(d_[0] * (f_), d_[1] * (f_)); } while (0)
#define RET_STAGE() do { \
    _Pragma("unroll") for (int i = 0; i < 2; ++i) { const int row = (tid >> 4) + 32 * i, ch = tid & 15; \
      u32x4 qo; RET_F8(pq[i], 1.f, qo); *(u32x4*)(Qs + row * QP + ch * 16) = qo; \
      const float f = exp2f(lg * (float)(C - 1 - row)) * 0.08838834764831845f; \
      u32x4 ko; RET_F8(pk[i], f, ko); *(u32x4*)(Ks + row * KPI + ch * 16) = ko; } \
    _Pragma("unroll") for (int i = 0; i < 4; ++i) { const int row = (tid >> 5) + 16 * i, ch = tid & 31; u32x4 vo; RET_F8(pv[i], 1.f, vo); *(u32x4*)(Vs + row * VP + ch * 16) = vo; } } while (0)
  RET_LOAD(c0);
  __syncthreads();
  RET_STAGE();
  if (c0 + 1 < c1) RET_LOAD(c0 + 1);
  __syncthreads();
  for (int c = c0; c < c1; ++c) {
    const size_t tok0 = (size_t)b * SEQ + (size_t)c * C;
    f32x16 ot[2] = {};
#pragma unroll
    for (int dt = 0; dt < 4; ++dt) {
#pragma unroll
      for (int s = 0; s < 2; ++s) { const bf16x8 af = pk8(S[dt], s);
#pragma unroll
        for (int nt = 0; nt < 2; ++nt) { const char* qp = Qs + (32 * nt + r32) * QP + (32 * dt + 16 * s + 4 * hi) * 2;
          const u32x2 lo = *(const u32x2*)qp, hi8 = *(const u32x2*)(qp + 16); const u32x4 bw = {lo.x, lo.y, hi8.x, hi8.y};
          ot[nt] = __builtin_amdgcn_mfma_f32_32x32x16_bf16(af, *reinterpret_cast<const bf16x8*>(&bw), ot[nt], 0, 0, 0); } }
      __builtin_amdgcn_sched_barrier(0); }
#pragma unroll
    for (int nt = 0; nt < 2; ++nt)
#pragma unroll
      for (int r = 0; r < 16; ++r) ot[nt][r] *= gC;
    __builtin_amdgcn_sched_barrier(0);
    bf16x8 vfr[4];
    { s16x4 vlo[4], vhi[4];
      vlo[0] = trr<0 * 16 * VP>(vtb); vhi[0] = trr<0 * 16 * VP + 8 * VP>(vtb); vlo[1] = trr<1 * 16 * VP>(vtb); vhi[1] = trr<1 * 16 * VP + 8 * VP>(vtb);
      vlo[2] = trr<2 * 16 * VP>(vtb); vhi[2] = trr<2 * 16 * VP + 8 * VP>(vtb); vlo[3] = trr<3 * 16 * VP>(vtb); vhi[3] = trr<3 * 16 * VP + 8 * VP>(vtb);
      asm volatile("s_waitcnt lgkmcnt(0)" : "+v"(vlo[0]), "+v"(vlo[1]), "+v"(vlo[2]), "+v"(vlo[3]), "+v"(vhi[0]), "+v"(vhi[1]), "+v"(vhi[2]), "+v"(vhi[3]) :: "memory"); __builtin_amdgcn_sched_barrier(0);
#pragma unroll
      for (int ks = 0; ks < 4; ++ks) vfr[ks] = (bf16x8){vlo[ks][0], vlo[ks][1], vlo[ks][2], vlo[ks][3], vhi[ks][0], vhi[ks][1], vhi[ks][2], vhi[ks][3]}; }
#pragma unroll
    for (int nt = 0; nt < 2; ++nt)
#pragma unroll
      for (int jt = 0; jt <= nt; ++jt) { f32x16 pt = {};
#pragma unroll
        for (int kk = 0; kk < 8; ++kk) { const bf16x8 ka = *(const bf16x8*)(Ks + (32 * jt + r32) * KPI + (16 * kk + 8 * hi) * 2), qb = *(const bf16x8*)(Qs + (32 * nt + r32) * QP + (16 * kk + 8 * hi) * 2);
          pt = __builtin_amdgcn_mfma_f32_32x32x16_bf16(ka, qb, pt, 0, 0, 0); }
        if (jt == nt) {
#pragma unroll
          for (int r = 0; r < 16; ++r) if (crow(r, hi) > r32) pt[r] = 0.f; }
#pragma unroll
        for (int s = 0; s < 2; ++s) ot[nt] = __builtin_amdgcn_mfma_f32_32x32x16_bf16(vfr[2 * jt + s], pk8(pt, s), ot[nt], 0, 0, 0);
        __builtin_amdgcn_sched_barrier(0); }
#pragma unroll
    for (int dt = 0; dt < 4; ++dt) {
#pragma unroll
      for (int r = 0; r < 16; ++r) S[dt][r] *= gC;
      s16x4 kl[4], kh[4];
      kl[0] = trr<0 * 16 * KPI>(ktb + dt * 64); kh[0] = trr<0 * 16 * KPI + 8 * KPI>(ktb + dt * 64); kl[1] = trr<1 * 16 * KPI>(ktb + dt * 64); kh[1] = trr<1 * 16 * KPI + 8 * KPI>(ktb + dt * 64);
      kl[2] = trr<2 * 16 * KPI>(ktb + dt * 64); kh[2] = trr<2 * 16 * KPI + 8 * KPI>(ktb + dt * 64); kl[3] = trr<3 * 16 * KPI>(ktb + dt * 64); kh[3] = trr<3 * 16 * KPI + 8 * KPI>(ktb + dt * 64);
      asm volatile("s_waitcnt lgkmcnt(0)" : "+v"(kl[0]), "+v"(kl[1]), "+v"(kl[2]), "+v"(kl[3]), "+v"(kh[0]), "+v"(kh[1]), "+v"(kh[2]), "+v"(kh[3]) :: "memory"); __builtin_amdgcn_sched_barrier(0);
#pragma unroll
      for (int ks = 0; ks < 4; ++ks) S[dt] = __builtin_amdgcn_mfma_f32_32x32x16_bf16((bf16x8){kl[ks][0], kl[ks][1], kl[ks][2], kl[ks][3], kh[ks][0], kh[ks][1], kh[ks][2], kh[ks][3]}, vfr[ks], S[dt], 0, 0, 0);
      __builtin_amdgcn_sched_barrier(0); }
    u32x2 gt4[4];
    { const unsigned char* gb_ = RG + tok0 * 1024 + h * 256;
#pragma unroll
      for (int i = 0; i < 4; ++i) gt4[i] = *(const u32x2*)(gb_ + (voffV >> 1) + i * 16384); }
#pragma unroll
    for (int nt = 0; nt < 2; ++nt) { const float rs = exp2f(lg * (float)(32 * nt + r32 + 1 - C)); float s1 = 0.f, s2 = 0.f;
#pragma unroll
      for (int r = 0; r < 16; ++r) { ot[nt][r] *= rs; s1 += ot[nt][r]; s2 += ot[nt][r] * ot[nt][r]; }
      s1 = xhalf_sum(s1); s2 = xhalf_sum(s2);
      if (hi == 0) { st[(w * 64 + 32 * nt + r32) * 2] = s1; st[(w * 64 + 32 * nt + r32) * 2 + 1] = s2; } }
    __syncthreads();
    if (c + 1 < c1) { RET_STAGE(); if (c + 2 < c1) RET_LOAD(c + 2); }
#pragma unroll
    for (int nt = 0; nt < 2; ++nt) { float s1 = 0.f, s2 = 0.f;
#pragma unroll
      for (int ww = 0; ww < 8; ++ww) { s1 += st[(ww * 64 + 32 * nt + r32) * 2]; s2 += st[(ww * 64 + 32 * nt + r32) * 2 + 1]; }
      const float mu = s1 * (1.f / 256.f), var = fmaxf(s2 * (1.f / 256.f) - mu * mu, 0.f), rstd = rsqrtf(var + EPS);
#pragma unroll
      for (int g = 0; g < 4; ++g) { float y[4];
#pragma unroll
        for (int j = 0; j < 4; ++j) y[j] = (ot[nt][4 * g + j] - mu) * rstd * gnorm[h * 256 + 32 * w + 8 * g + 4 * hi + j];
        const u32x2 o2 = {cvtpk(y[0], y[1]), cvtpk(y[2], y[3])};
        *(u32x2*)(Ys + (32 * nt + r32) * VP + (32 * w + 8 * g + 4 * hi) * 2) = o2; } }
    __syncthreads();
    { unsigned char* ob_ = A2F8 + tok0 * 1024 + h * 256;
#pragma unroll
      for (int i = 0; i < 4; ++i) { const int row = (tid >> 5) + 16 * i, ch = tid & 31;
        const u32x4 yv = *(const u32x4*)(Ys + row * VP + ch * 16); const u32x2 gt = gt4[i];
        const auto g01 = __builtin_amdgcn_cvt_pk_f32_fp8((int)gt.x, false), g23 = __builtin_amdgcn_cvt_pk_f32_fp8((int)gt.x, true), g45 = __builtin_amdgcn_cvt_pk_f32_fp8((int)gt.y, false), g67 = __builtin_amdgcn_cvt_pk_f32_fp8((int)gt.y, true);
        int w0 = __builtin_amdgcn_cvt_pk_fp8_f32(pg8::bf_lo(yv.x) * silu_(g01[0]), pg8::bf_hi(yv.x) * silu_(g01[1]), 0, false); w0 = __builtin_amdgcn_cvt_pk_fp8_f32(pg8::bf_lo(yv.y) * silu_(g23[0]), pg8::bf_hi(yv.y) * silu_(g23[1]), w0, true);
        int w1 = __builtin_amdgcn_cvt_pk_fp8_f32(pg8::bf_lo(yv.z) * silu_(g45[0]), pg8::bf_hi(yv.z) * silu_(g45[1]), 0, false); w1 = __builtin_amdgcn_cvt_pk_fp8_f32(pg8::bf_lo(yv.w) * silu_(g67[0]), pg8::bf_hi(yv.w) * silu_(g67[1]), w1, true);
        *(unsigned long long*)(ob_ + (size_t)row * 1024 + ch * 8) = (unsigned long long)(unsigned)w0 | ((unsigned long long)(unsigned)w1 << 32); } }
  }
  if (c1 < SEQ / C) {
#pragma unroll
    for (int dt = 0; dt < 4; ++dt)
#pragma unroll
      for (int r = 0; r < 16; ++r) state[(dt * 16 + r) * 512 + tid] = S[dt][r]; }
  __syncthreads();
#undef RET_LOAD
#undef RET_STAGE
#undef RET_F8
}
}

#define A2F8_PTR (F.xbp + (size_t)16 * MiB)
constexpr int RET_SPLIT = 28;
__device__ __forceinline__ int ret_wg_index(const Frame& F) { const int bx = (int)blockIdx.x, j = bx >> 3; return (j & 3) == 0 ? ((j >> 2) * 8 + (bx & 7)) : -1; }
__device__ __forceinline__ void p4_attn(Frame& F, const Args& a, unsigned char* lds_generic) {
    const size_t nt_ = (size_t)F.ntok;
    const bf16* QA = (const bf16*)(F.act + nt_ * O_QA); bf16* ATT = (bf16*)(F.act + nt_ * O_QA);
    unsigned char* aux = a.xb + nt_ * 2048;
    const bf16* KP = (const bf16*)(aux + nt_ * AUX_KP); const bf16* VV = (const bf16*)(aux + nt_ * AUX_VV); const unsigned* MASK = (const unsigned*)(aux + nt_ * AUX_MASK);
    volatile LAS unsigned* MISC = (volatile LAS unsigned*)(F.lds + MISC_OFF);
    unsigned* qctr = (unsigned*)(F.ws + WS_CTL) + CW_Q4;
    const unsigned char* RQ = F.act + nt_ * O_RQ; const unsigned char* RK = F.act + nt_ * O_RK; const unsigned char* RV = F.act + nt_ * O_RV; const unsigned char* RG = F.act + nt_ * O_RG;
    const int nb = F.ntok / SEQ, nret = nb * 4, nitems = nb * 64;
    { const int ri = ret_wg_index(F); if (ri >= 0 && ri < nret && RET_SPLIT < SEQ / 64)
        ret::ret_item(ri >> 2, ri & 3, RQ, RK, RV, RG, A2F8_PTR, a.in[8], (char*)lds_generic, RET_SPLIT, SEQ / 64, (float*)a.xb + (size_t)ri * 32768); }
    __syncthreads(); if (F.tid == 0) MISC[0] = atomicAdd(qctr, 1u); __syncthreads();
    int it = (int)MISC[0];
    while (it < nitems) {
        unsigned nxt_ = 0u; if (F.tid == 0) nxt_ = atomicAdd(qctr, 1u);
        const int qb = 63 - it / nb, b = it % nb, NT = (qb >> 1) + 1;
        const size_t row0 = (size_t)b * SEQ + qb * 32;
        att::attn_item((const bf16*)((const unsigned char*)QA + row0 * 1024), KP + (size_t)b * SEQ * 128, VV + (size_t)b * SEQ * 128, MASK + (size_t)b * 64 * 2048 + qb * 32, (bf16*)((unsigned char*)ATT + row0 * 1024), NT, (char*)lds_generic, F.lds);
        __syncthreads(); if (F.tid == 0) MISC[0] = nxt_; __syncthreads();
        it = (int)MISC[0];
    }
}


__device__ __forceinline__ void p7_router(Frame& F, const Args& a) {
    const int lane = F.lane, r32 = lane & 31, hi = lane >> 5, tid = F.tid;
    unsigned char* mo = F.act; unsigned char* N2 = mo + MO_N2; unsigned char* meta = mo + MO_META;
    int* MB = (int*)(meta + MM_B); int* MPp = (int*)(meta + MM_P); float* MCL = (float*)(meta + MM_CL); float* MCH = (float*)(meta + MM_CH); float* MRS = (float*)(meta + MM_RS);
    const bf16* Wh = (const bf16*)(F.ws + WS_WR); const bf16* Wl = Wh + 32 * 1024;
    const float* g2 = a.in[12]; const float* b_gr = a.in[14]; const float* b_er = a.in[16];
    const bf16* hbase = (const bf16*)(F.act + MO_H16);
    unsigned* gcnt = (unsigned*)(F.ws + WS_CTL) + CW_MOE;
    LAS unsigned* lcnt = (LAS unsigned*)(F.lds + RING_OFF);
    if (tid < 64) lcnt[tid] = 0u;
    __syncthreads();
    const int ntasks = F.ntok / 32, tpw = ntasks / F.G;
    const int tw = F.wave & 3, kh = F.wave >> 2;
    const bool have = tw < tpw; const int t = (F.vcu * tpw + tw) * 32 + r32;
    LAS float* xch = (LAS float*)(F.lds + RING_OFF + 1024);
    int bucket = 0, posl = 0; float clo = 0.f, chi = 0.f, rstd = 0.f;
    f32x16 acc = f32x16{}; float ss = 0.f;
    if (have) {
        const bf16* hrow = hbase + (size_t)t * D + hi * 8 + kh * 512; unsigned char* nrow = N2 + (size_t)t * D + hi * 8 + kh * 512;
        const float* g2k = g2 + kh * 512 + hi * 8; const bf16* whk = Wh + (size_t)r32 * 1024 + kh * 512 + hi * 8; const bf16* wlk = Wl + (size_t)r32 * 1024 + kh * 512 + hi * 8;
#pragma unroll 8
        for (int kk = 0; kk < 32; ++kk) {
            const v4u hv = *(const v4u*)(hrow + kk * 16); const f32x4 a0 = {pg8::bf_lo(hv.x), pg8::bf_hi(hv.x), pg8::bf_lo(hv.y), pg8::bf_hi(hv.y)}, a1 = {pg8::bf_lo(hv.z), pg8::bf_hi(hv.z), pg8::bf_lo(hv.w), pg8::bf_hi(hv.w)};
            const f32x4 q0 = *(const f32x4*)(g2k + kk * 16), q1 = *(const f32x4*)(g2k + kk * 16 + 4);
            ss += (a0.x * a0.x + a0.y * a0.y) + (a0.z * a0.z + a0.w * a0.w) + (a1.x * a1.x + a1.y * a1.y) + (a1.z * a1.z + a1.w * a1.w);
            const float x[8] = {a0.x * q0.x, a0.y * q0.y, a0.z * q0.z, a0.w * q0.w, a1.x * q1.x, a1.y * q1.y, a1.z * q1.z, a1.w * q1.w};
            unsigned hb[8]; float lo[8];
#pragma unroll
            for (int j = 0; j < 8; ++j) { hb[j] = f2bf(x[j]); lo[j] = x[j] - __uint_as_float(hb[j] << 16); }
            v4u xh; xh.x = hb[0] | (hb[1] << 16); xh.y = hb[2] | (hb[3] << 16); xh.z = hb[4] | (hb[5] << 16); xh.w = hb[6] | (hb[7] << 16);
            v4u xl; xl.x = pk2(lo[0], lo[1]); xl.y = pk2(lo[2], lo[3]); xl.z = pk2(lo[4], lo[5]); xl.w = pk2(lo[6], lo[7]);
            { int w0 = __builtin_amdgcn_cvt_pk_fp8_f32(x[0], x[1], 0, false); w0 = __builtin_amdgcn_cvt_pk_fp8_f32(x[2], x[3], w0, true); int w1 = __builtin_amdgcn_cvt_pk_fp8_f32(x[4], x[5], 0, false); w1 = __builtin_amdgcn_cvt_pk_fp8_f32(x[6], x[7], w1, true);
              *(unsigned long long*)(nrow + kk * 16) = (unsigned long long)(unsigned)w0 | ((unsigned long long)(unsigned)w1 << 32); }
            const bf16x8_t wh = *(const bf16x8_t*)(whk + kk * 16), wl = *(const bf16x8_t*)(wlk + kk * 16);
            const bf16x8_t bh = __builtin_bit_cast(bf16x8_t, xh), bl = __builtin_bit_cast(bf16x8_t, xl);
            acc = __builtin_amdgcn_mfma_f32_32x32x16_bf16(wh, bh, acc, 0, 0, 0);
            acc = __builtin_amdgcn_mfma_f32_32x32x16_bf16(wh, bl, acc, 0, 0, 0);
            acc = __builtin_amdgcn_mfma_f32_32x32x16_bf16(wl, bh, acc, 0, 0, 0);
        }
        if (kh == 1) {
#pragma unroll
            for (int r = 0; r < 16; ++r) xch[(tw * 17 + r) * 64 + lane] = acc[r];
            xch[(tw * 17 + 16) * 64 + lane] = ss; }
    }
    __syncthreads();
    if (have && kh == 0) {
#pragma unroll
        for (int r = 0; r < 16; ++r) acc[r] += xch[(tw * 17 + r) * 64 + lane];
        ss += xch[(tw * 17 + 16) * 64 + lane];
        ss = xhalf_sum(ss); rstd = rsqrtf(ss * (1.f / D) + EPS);
        float L[24];
#pragma unroll
        for (int r = 0; r < 12; ++r) { const float v = acc[r]; auto rr = __builtin_amdgcn_permlane32_swap(__float_as_uint(v), __float_as_uint(v), false, false);
            L[(r & 3) + 8 * (r >> 2)] = __uint_as_float(rr[0]); L[(r & 3) + 8 * (r >> 2) + 4] = __uint_as_float(rr[1]); }
        float gl[4];
#pragma unroll
        for (int i = 0; i < 4; ++i) gl[i] = L[i] * rstd + b_gr[i];
        int g = 0; float gm = gl[0];
#pragma unroll
        for (int i = 1; i < 4; ++i) if (gl[i] > gm) { gm = gl[i]; g = i; }
        float se = 0.f;
#pragma unroll
        for (int i = 0; i < 4; ++i) se += __expf(gl[i] - gm);
        const float gw = 1.f / se;
        float el[4];
#pragma unroll
        for (int i = 0; i < 4; ++i) { const float l0 = L[4 + i], l1 = L[8 + i], l2 = L[12 + i], l3 = L[16 + i]; const float lv = g == 0 ? l0 : (g == 1 ? l1 : (g == 2 ? l2 : l3));
            const float b0 = b_er[i], b1 = b_er[4 + i], b2 = b_er[8 + i], b3 = b_er[12 + i]; el[i] = lv * rstd + (g == 0 ? b0 : (g == 1 ? b1 : (g == 2 ? b2 : b3))); }
        int i1 = 0; float v1 = el[0];
#pragma unroll
        for (int i = 1; i < 4; ++i) if (el[i] > v1) { v1 = el[i]; i1 = i; }
        int i2 = -1; float v2 = 0.f;
#pragma unroll
        for (int i = 0; i < 4; ++i) if (i != i1 && (i2 < 0 || el[i] > v2)) { v2 = el[i]; i2 = i; }
        const float e2 = __expf(v2 - v1), p1 = gw / (1.f + e2), p2 = gw * e2 / (1.f + e2);
        const int lo_ = i1 < i2 ? i1 : i2, hi_ = i1 < i2 ? i2 : i1;
        const int pair = lo_ == 0 ? (hi_ - 1) : (lo_ == 1 ? (hi_ + 1) : 5);
        bucket = g * 6 + pair; clo = i1 < i2 ? p1 : p2; chi = i1 < i2 ? p2 : p1;
        if (hi == 0) posl = (int)__hip_atomic_fetch_add(&lcnt[bucket], 1u, __ATOMIC_RELAXED, __HIP_MEMORY_SCOPE_WORKGROUP);
    }
    __syncthreads();
    if (tid < 24) lcnt[32 + tid] = atomicAdd(gcnt + tid, lcnt[tid]);
    __syncthreads();
    if (have && kh == 0 && hi == 0) { MB[t] = bucket; MPp[t] = (int)lcnt[32 + bucket] + posl; MCL[t] = clo; MCH[t] = chi; MRS[t] = rstd; }
}
__device__ __forceinline__ int moe_tiles(const unsigned* gcnt, int* rowstart  ) { int rs = 0;
    for (int b = 0; b < 24; ++b) { rowstart[b] = rs; rs += (int)((gcnt[b] + 255u) & ~255u); } rowstart[24] = rs; return rs >> 8; }
__device__ __forceinline__ void p8_permute(Frame& F, const Args& a) {
    unsigned char* mo = F.act; unsigned char* meta = mo + MO_META;
    const int* MB = (const int*)(meta + MM_B); const int* MPp = (const int*)(meta + MM_P); const float* MCL = (const float*)(meta + MM_CL); const float* MCH = (const float*)(meta + MM_CH); const float* MRS = (const float*)(meta + MM_RS);
    int* PTOK = (int*)(meta + MM_PTOK); float* PRS = (float*)(meta + MM_PRS); float* PCL = (float*)(meta + MM_PCL); float* PCH = (float*)(meta + MM_PCH);
    const unsigned* gcnt = (const unsigned*)(F.ws + WS_CTL) + CW_MOE;
    LAS int* rsL = (LAS int*)(F.lds + RING_OFF);
    if (F.tid == 0) { int rs = 0; for (int b = 0; b < 24; ++b) { rsL[b] = rs; rs += (int)((gcnt[b] + 255u) & ~255u); } rsL[24] = rs; }
    __syncthreads();
    const int gw = F.vcu * NWAVES + F.wave, NGW = F.G * NWAVES;
    const int gt = gw * 64 + F.lane, NGT = NGW * 64;
    for (int t = gt; t < F.ntok; t += NGT) { const int b = MB[t], prow = rsL[b] + MPp[t]; PTOK[prow] = t; PRS[prow] = MRS[t]; PCL[prow] = MCL[t]; PCH[prow] = MCH[t]; }
    for (int b = 0; b < 24; ++b) { const int c = (int)gcnt[b], p0 = rsL[b] + c, p1 = rsL[b + 1];
        for (int r = p0 + gt; r < p1; r += NGT) { PTOK[r] = -1; PRS[r] = 0.f; PCL[r] = 0.f; PCH[r] = 0.f; } }
}
template <bool GATHER_> struct MoeOrder {
    static constexpr bool GATHER = GATHER_; const int* ptok;
    int ntile, G, c; const char* A; size_t tA; const char* W; int mode; const LAS unsigned char* tb; size_t rowB;
    __device__ bool next(int i, pg8::Unit& u) const {
        const long L = (long)i * G + c; if (L >= (long)ntile * 4) return false;
        u.pm = (int)(L >> 2); u.pn = (int)(L & 3); u.a = GATHER_ ? A : A + (size_t)u.pm * tA;
        const int bk = tb[u.pm], g = bk / 6, pr = bk % 6; const int lo = pr < 3 ? 0 : (pr < 5 ? 1 : 2), hi = pr < 3 ? pr + 1 : (pr < 5 ? pr - 1 : 3);
        const int elo = g * 4 + lo, ehi = g * 4 + hi; u.aux = 0;
        if (mode == 1) { const int e = u.pn < 2 ? elo : ehi; u.b = W + ((size_t)e * 512 + (size_t)(u.pn & 1) * 256) * rowB; u.bjump = 0; }
        else { u.b = W + ((size_t)elo * 1024 + (size_t)u.pn * 256) * rowB; u.bjump = (long)(ehi - elo) * 1024 * (long)rowB - (long)rowB; }
        return true;
    }
    __device__ __forceinline__ void a_ready(const pg8::Unit&) const {}
    __device__ __forceinline__ void done(const pg8::Unit&) const {}
};
__device__ __forceinline__ float silu_f(float x) { return x * __builtin_amdgcn_rcpf(1.f + __builtin_amdgcn_exp2f(-1.4426950408889634f * x)); }
struct EpiMoe1 {
    static constexpr bool PERM = true, AFTER_DRAIN = false;
    unsigned char* ACT; const float* PRS; const float* PCL; const float* PCH;
    __device__ __forceinline__ void operator()(const pg8::f32x4 (&acc)[2][2][4][2], const pg8::Unit& u, int wr, int wc, int fr, int fq) const {
        const int row0 = u.pm * pg8::BM + wr * 64 + fr, slot = u.pn >> 1, fcol0 = slot * 256 + (u.pn & 1) * 128 + wc * 16 + 4 * fq; const float* PC = slot ? PCH : PCL;
#pragma unroll
        for (int ai = 0; ai < 2; ++ai)
#pragma unroll
            for (int m = 0; m < 4; ++m) { const int row = row0 + ai * pg8::HALF + m * 16; const float rs = PRS[row], cw = PC[row] * 16.f; unsigned char* rowp = ACT + (size_t)row * 512 + fcol0;
#pragma unroll
                for (int bj = 0; bj < 2; ++bj) { const pg8::f32x4 v0 = acc[ai][bj][m][0], v1 = acc[ai][bj][m][1];
                    const float a0 = silu_f(v0[0] * rs) * (v0[1] * rs) * cw, a1 = silu_f(v0[2] * rs) * (v0[3] * rs) * cw, a2 = silu_f(v1[0] * rs) * (v1[1] * rs) * cw, a3 = silu_f(v1[2] * rs) * (v1[3] * rs) * cw;
                    int w = __builtin_amdgcn_cvt_pk_fp8_f32(a0, a1, 0, false); w = __builtin_amdgcn_cvt_pk_fp8_f32(a2, a3, w, true); *(int*)(rowp + bj * 64) = w; } }
    }
};
struct EpiMoe2 {
    static constexpr bool PERM = false, AFTER_DRAIN = false;
    float* out; const pg8::bf16_t* h16; const int* PTOK;
    __device__ __forceinline__ void operator()(const pg8::f32x4 (&acc)[2][2][4][2], const pg8::Unit& u, int wr, int wc, int fr, int fq) const {
        const int row0 = u.pm * pg8::BM + wr * 64 + fr, col0 = u.pn * pg8::BM + wc * 32 + 4 * fq;
#pragma unroll
        for (int ai = 0; ai < 2; ++ai)
#pragma unroll
            for (int m = 0; m < 4; ++m) { const int tok = PTOK[row0 + ai * pg8::HALF + m * 16];
                if (tok >= 0) { float* rowp = out + (size_t)tok * 1024 + col0; const pg8::bf16_t* hp = h16 + (size_t)tok * 1024 + col0;
#pragma unroll
                    for (int bj = 0; bj < 2; ++bj)
#pragma unroll
                        for (int n = 0; n < 2; ++n) { const pg8::u32x2 hv = *(const pg8::u32x2*)(hp + bj * pg8::HALF + n * 16); const pg8::f32x4 hf = {pg8::bf_lo(hv.x), pg8::bf_hi(hv.x), pg8::bf_lo(hv.y), pg8::bf_hi(hv.y)};
                            *(pg8::f32x4*)(rowp + bj * pg8::HALF + n * 16) = hf + acc[ai][bj][m][n]; } } }
    }
};
__device__ __forceinline__ int moe_setup(Frame& F, LAS unsigned char* tb) {
    const unsigned* gcnt = (const unsigned*)(F.ws + WS_CTL) + CW_MOE;
    LAS int* nt_ = (LAS int*)(tb + 256);
    __syncthreads();
    if (F.tid == 0) { int tl = 0; for (int b = 0; b < 24; ++b) { const int n = (int)((gcnt[b] + 255u) >> 8); for (int i = 0; i < n; ++i) tb[tl + i] = (unsigned char)b; tl += n; } nt_[0] = tl; }
    __syncthreads();
    return nt_[0];
}

__global__ void __launch_bounds__(NWAVES * 64, 2) mk_fwd(Args args) {
    extern __shared__ __attribute__((aligned(16))) unsigned char lds[];
    Frame F;
    F.lds = (LAS unsigned char*)lds;
    F.tid = threadIdx.x; F.lane = F.tid & 63; F.wave = __builtin_amdgcn_readfirstlane(F.tid >> 6);
    F.G = gridDim.x; { const int bx = blockIdx.x; F.vcu = (F.G % 8 == 0) ? (bx % 8) * (F.G / 8) + bx / 8 : bx; }
    F.ntok = args.ntok; F.ws = args.ws; F.act = args.ws + WS_ACT; F.xbp = args.xb;
    const int lo = args.ph_lo, hi = args.ph_hi;
    cooperative_groups::grid_group grid = cooperative_groups::this_grid();
    volatile LAS unsigned* MISCW = (volatile LAS unsigned*)(F.lds + MISC_OFF);
    for (int u = F.tid; u < (LDS_BYTES - LDSCTL_OFF) / 4; u += NWAVES * 64) ((LAS unsigned*)(F.lds + LDSCTL_OFF))[u] = 0u;
    __syncthreads();
    XcdBarrier bar = xcd_barrier_post((unsigned*)(F.ws + WS_CTL) + CW_BAR, MISCW + 8);
#define IN(k) (lo <= (k) && (k) < hi)
#define SEAM(k) do { if (IN(k) && IN((k) + 1)) { xcd_barrier(bar); } } while (0)
    if (IN(0)) { p0_prologue(F, args); }
    SEAM(0);
    if (IN(1)) {
        EpiProj E{F.act, (size_t)F.ntok};
        { pg8::Gemm g{512, 512, 512, 8};
          P1Order S; S.nM = F.ntok / 256; S.nN = 25; S.nwg = S.nM * 25; S.G = F.G; S.c = (int)blockIdx.x; S.mode = 0; S.A = (const char*)(args.xb + (size_t)F.ntok * AUX_XB8); S.Bt = (const char*)(F.ws + WS_WIN8); S.tA = (size_t)256 * 1024; S.tB = (size_t)256 * 1024;
          pg8::gemm_phase<EpiProj, P1Order, true, true, true>(F.lds + RING_OFF, g, S, E); }
        { pg8::Gemm g{1024, 1024, 1024, 16};
          P1Order S; S.nM = F.ntok / 256; S.nN = 3; S.nwg = S.nM * 3; S.G = F.G; S.c = ((int)blockIdx.x + F.G / 2) % F.G; S.mode = 1; S.A = (const char*)args.xb; S.Bt = (const char*)(F.ws + WS_WIN); S.tA = (size_t)256 * 2048; S.tB = (size_t)256 * 2048;
          pg8::gemm_phase<EpiProj, P1Order, true, true, false>(F.lds + RING_OFF, g, S, E); }
    }
    SEAM(1);
    if (IN(2)) { p2_post(F, args); }
    SEAM(2);
    if (IN(3)) {
        const int ri = ret_wg_index(F), nret = (F.ntok / SEQ) * 4;
        if (ri < 0) p3_index(F, args);
        else if (ri < nret) { const size_t nt_ = (size_t)F.ntok;
            ret::ret_item(ri >> 2, ri & 3, F.act + nt_ * O_RQ, F.act + nt_ * O_RK, F.act + nt_ * O_RV, F.act + nt_ * O_RG, A2F8_PTR, args.in[8], (char*)lds, 0, RET_SPLIT, (float*)args.xb + (size_t)ri * 32768); }
    }
    SEAM(3);
    if (IN(4)) { p4_attn(F, args, lds); }
    SEAM(4);
    if (IN(5)) {
        const size_t nt_ = (size_t)F.ntok;
        const unsigned char* GA8 = F.act + nt_ * O_GA; const unsigned char* GR8 = F.act + nt_ * O_GR; pg8::bf16_t* TMP = (pg8::bf16_t*)(F.act + nt_ * O_RV);
        { pg8::Gemm g{512, 512, 512, 8, 122, 123};
          pg8::StaticOrder S; S.init(F.ntok, 1024, F.G, (int)blockIdx.x, F.act + nt_ * O_QA, 512, F.ws + WS_WATT8, 512); EpiGateA E{GA8, TMP};
          pg8::gemm_phase<EpiGateA, pg8::StaticOrder, true, true, true>(F.lds + RING_OFF, g, S, E); }
        { pg8::Gemm g{512, 512, 512, 8, 122, 127};
          pg8::StaticOrder S; S.init(F.ntok, 1024, F.G, (int)blockIdx.x, A2F8_PTR, 512, F.ws + WS_WRET8, 512); EpiGateB E{TMP, GR8, F.act + nt_ * O_MIX8};
          pg8::gemm_phase<EpiGateB, pg8::StaticOrder, true, true, true>(F.lds + RING_OFF, g, S, E); }
    }
    SEAM(5);
    if (IN(6)) {
        pg8::Gemm g{512, 512, 512, 8, 122, 124}; const size_t nt_ = (size_t)F.ntok;
        pg8::StaticOrder S; S.init(F.ntok, 1024, F.G, (int)blockIdx.x, F.act + nt_ * O_MIX8, 512, F.ws + WS_WOUT8, 512);
        EpiResid E{args.in[0] + (size_t)args.tok0 * D, (pg8::bf16_t*)(F.act + MO_H16)};
        pg8::gemm_phase<EpiResid, pg8::StaticOrder, true, true, true>(F.lds + RING_OFF, g, S, E);
    }
    SEAM(6);
    if (IN(7)) { p7_router(F, args); }
    SEAM(7);
    if (IN(8)) { p8_permute(F, args); }
    SEAM(8);
    if (IN(9)) {
        LAS unsigned char* tb = F.lds + LDSCTL_OFF - 1024; const int ntile = moe_setup(F, tb);
        unsigned char* meta = F.act + MO_META;
        pg8::Gemm g{512, 512, 512, 8, 122, 127};
        MoeOrder<true> S{(const int*)(meta + MM_PTOK), ntile, F.G, (int)blockIdx.x, (const char*)(F.act + MO_N2), (size_t)0, (const char*)(F.ws + WS_W18), 1, tb, (size_t)1024};
        EpiMoe1 E{(unsigned char*)(F.act + MO_ACT), (const float*)(meta + MM_PRS), (const float*)(meta + MM_PCL), (const float*)(meta + MM_PCH)};
        pg8::gemm_phase<EpiMoe1, MoeOrder<true>, true, true, true>(F.lds + RING_OFF, g, S, E);
    }
    SEAM(9);
    if (IN(10)) {
        LAS unsigned char* tb = F.lds + LDSCTL_OFF - 1024; const int ntile = moe_setup(F, tb);
        unsigned char* meta = F.act + MO_META;
        pg8::Gemm g{256, 256, 128, 2, 123, 123};
        MoeOrder<false> S{nullptr, ntile, F.G, (int)blockIdx.x, (const char*)(F.act + MO_ACT), (size_t)256 * 512, (const char*)(F.ws + WS_WD8), 2, tb, (size_t)256};
        EpiMoe2 E{args.out + (size_t)args.tok0 * D, (const pg8::bf16_t*)(F.act + MO_H16), (const int*)(meta + MM_PTOK)};
        pg8::gemm_phase<EpiMoe2, MoeOrder<false>, true, true, true>(F.lds + RING_OFF, g, S, E);
    }
    if (hi - lo > 1) grid.sync();
#undef IN
#undef SEAM
}

extern "C" void kernel_launch(void* const* d_in, const int* in_sizes, int n_in, void* d_out, int out_size, void* d_ws, size_t ws_size, hipStream_t stream) {
    static int grid = 0;
    if (grid == 0) {
        int dev = 0, cus = 0, per_cu = 0;
        (void)hipGetDevice(&dev); (void)hipDeviceGetAttribute(&cus, hipDeviceAttributeMultiprocessorCount, dev);
        if (hipFuncSetAttribute((const void*)mk_fwd, hipFuncAttributeMaxDynamicSharedMemorySize, LDS_BYTES) != hipSuccess) { fprintf(stderr, "kernel_launch: hipFuncSetAttribute failed\n"); grid = -1; return; }
        (void)hipOccupancyMaxActiveBlocksPerMultiprocessor(&per_cu, (const void*)mk_fwd, NWAVES * 64, LDS_BYTES);
        (void)hipGetLastError();
        if (per_cu < 1) { fprintf(stderr, "kernel_launch: occupancy query says %d blocks per CU\n", per_cu); per_cu = 1; }
        grid = cus * per_cu;
        if (n_in != 20 || ws_size < (size_t)512 * MiB) { fprintf(stderr, "kernel_launch: unexpected n_in %d / ws_size %zu\n", n_in, ws_size); grid = -1; return; }
        if (grid != 256) { fprintf(stderr, "kernel_launch: this kernel's phase schedules are written for a 256-workgroup grid (256 CUs x 1); the device reports %d x %d; nothing launched\n", cus, per_cu); grid = -1; return; }
    }
    if (grid < 0) return;
    float* out = (float*)d_out;
    unsigned char* ws = (unsigned char*)d_ws;
    (void)in_sizes; (void)out_size;
    (void)hipMemsetAsync(ws + WS_CTL, 0, CTL_ZERO_BYTES, stream);
    Args a{};
    for (int i = 0; i < 20; ++i) a.in[i] = (const float*)d_in[i];
    a.out = out; a.ws = ws; a.xb = (unsigned char*)d_out; a.ntok = T; a.tok0 = 0;
    void* kargs[] = {(void*)&a};
    if (PROBE_PH >= 0) { a.ph_lo = PROBE_PH; a.ph_hi = PROBE_PH + 1; a.mode = PROBE_MODE;
        (void)hipLaunchCooperativeKernel((const void*)mk_fwd, dim3(grid), dim3(NWAVES * 64), kargs, (unsigned)LDS_BYTES, stream);
        (void)hipMemsetAsync(ws + WS_CTL, 0, CTL_ZERO_BYTES, stream); }
    a.ph_lo = 0; a.ph_hi = 11; a.mode = 0;
    const hipError_t le = hipLaunchCooperativeKernel((const void*)mk_fwd, dim3(grid), dim3(NWAVES * 64), kargs, (unsigned)LDS_BYTES, stream);
    if (le != hipSuccess) fprintf(stderr, "kernel_launch: cooperative launch failed: %s (grid %d)\n", hipGetErrorString(le), grid);
}
```

```cpp
#include <hip/hip_runtime.h>
#include <hip/hip_cooperative_groups.h>
#include <cstdio>
#include <cstdint>

namespace pg8 {
#define PG8_LAS __attribute__((address_space(3)))
typedef unsigned short bf16_t;
typedef short bf16x8 __attribute__((ext_vector_type(8)));
typedef float f32x4 __attribute__((ext_vector_type(4)));
typedef unsigned u32x4 __attribute__((ext_vector_type(4)));
typedef unsigned u32x2 __attribute__((ext_vector_type(2)));
typedef int v4i_t __attribute__((ext_vector_type(4)));
typedef int v8i_t __attribute__((ext_vector_type(8)));
constexpr int BM = 256, BK = 64, HALF = 128, HTB = HALF * BK * 2  , STAGE_BYTES = 8 * HTB, NXCD = 8, WGM = 8;

__host__ __device__ __forceinline__ int lds_byte(int r, int c) { const int st = (r >> 4) * 2 + (c >> 5), rr = r & 15, cc = c & 31, ob = rr * 64 + cc * 2; return st * 1024 + (ob ^ (((ob >> 9) & 1) << 5)); }
__host__ __device__ __forceinline__ void stage_rc(int b, int& R, int& C) { const int st = b / 1024, sb = b % 1024, swz = sb ^ (((sb >> 9) & 1) << 5); R = (st >> 1) * 16 + swz / 64; C = (st & 1) * 32 + (swz % 64) / 2; }
__host__ __device__ __forceinline__ int perm32(int rho) { const int n = rho >> 4, i = rho & 15; return 8 * (i >> 2) + 4 * n + (i & 3); }

struct Unit { int pm, pn; const char* a; const char* b; long bjump; int aux; };
struct Gemm { int K, lda, ldb, ksplit; int sw = 122, sa = 127; };

struct StaticOrder {
    static constexpr bool GATHER = false; const int* ptok = nullptr;
    int nM, nN, nwg, G, c; const char* A; const char* Bt; size_t tA, tB;
    __device__ void init(int M, int N, int G_, int c_, const void* A_, int lda, const void* Bt_, int ldb) { nM = M / BM; nN = N / BM; nwg = nM * nN; G = G_; c = c_; A = (const char*)A_; Bt = (const char*)Bt_; tA = (size_t)BM * lda * 2; tB = (size_t)BM * ldb * 2; }
    __device__ bool next(int i, Unit& u) const {
        const long L = (long)i * G + c; if (L >= nwg) return false;
        int wgid = (int)L; { const int q = nwg / NXCD, r = nwg % NXCD, xcd = wgid % NXCD, off = wgid / NXCD; wgid = (xcd < r ? xcd * (q + 1) : r * (q + 1) + (xcd - r) * q) + off; }
        const int nig = WGM * nN, gid = wgid / nig, fm = gid * WGM, gsz = (nM - fm) < WGM ? (nM - fm) : WGM;
        u.pm = fm + ((wgid % nig) % gsz); u.pn = (wgid % nig) / gsz; u.a = A + (size_t)u.pm * tA; u.b = Bt + (size_t)u.pn * tB; u.bjump = 0; u.aux = 0; return true;
    }
    __device__ __forceinline__ void a_ready(const Unit&) const {}
    __device__ __forceinline__ void done(const Unit&) const {}
};

typedef float f32x2c __attribute__((ext_vector_type(2))); typedef __bf16 bf16x2c __attribute__((ext_vector_type(2)));
__device__ __forceinline__ unsigned cvt_pk_bf16(float lo, float hi) { const f32x2c v = {lo, hi}; const bf16x2c b = __builtin_convertvector(v, bf16x2c); return __builtin_bit_cast(unsigned, b); }
__device__ __forceinline__ float bf_lo(unsigned w) { return __uint_as_float(w << 16); }
__device__ __forceinline__ float bf_hi(unsigned w) { return __uint_as_float(w & 0xffff0000u); }


template <class Epi, class Sched, bool ALIGN_EPI = false, bool SP2 = false, bool FP8 = false>
__device__ __forceinline__ void gemm_phase(PG8_LAS unsigned char* lds, const Gemm g, const Sched& S, const Epi& E) {
    int tid = threadIdx.x; asm volatile("" : "+v"(tid));
    const int wid = __builtin_amdgcn_readfirstlane(tid >> 6), lane = tid & 63, wr = wid >> 2, wc = wid & 3, fr = lane & 15, fq = lane >> 4;
    const int K = g.K, nt = K / BK;
    unsigned voffA[2], voffB[2]; int gR[2]; unsigned gC[2];
#pragma unroll
    for (int i = 0; i < 2; ++i) { int R, C; stage_rc(tid * 16 + i * 8192, R, C); const int Rb = Epi::PERM ? ((R & ~31) + perm32(R & 31)) : R; gR[i] = R; gC[i] = (unsigned)C * 2u;
        voffA[i] = (unsigned)(R * g.lda + C) * 2u; voffB[i] = (unsigned)(Rb * g.ldb + C) * 2u; }
    unsigned gA0[2] = {0u, 0u}, gA1[2] = {0u, 0u}, gN0[2] = {0u, 0u}, gN1[2] = {0u, 0u};
#define PG8_GOFF(u_, o0, o1) do { _Pragma("unroll") for (int i_ = 0; i_ < 2; ++i_) { int t0_ = S.ptok[(u_).pm * BM + gR[i_]], t1_ = S.ptok[(u_).pm * BM + HALF + gR[i_]]; t0_ = t0_ < 0 ? 0 : t0_; t1_ = t1_ < 0 ? 0 : t1_; \
        o0[i_] = (unsigned)t0_ * (unsigned)(g.lda * 2) + gC[i_]; o1[i_] = (unsigned)t1_ * (unsigned)(g.lda * 2) + gC[i_]; } } while (0)
    const size_t kstep = (size_t)(BK * 2);
    const size_t hstepA = Sched::GATHER ? (size_t)0 : (size_t)HALF * g.lda * 2, hstepB = (size_t)HALF * g.ldb * 2;
    const unsigned ldsw = (unsigned)wid * 1024u;
    const int aoff = lds_byte(wr * 64 + fr, fq * 8), boff = lds_byte(wc * 32 + fr, fq * 8);
#define PG8_CAT(x0, x1) __builtin_shufflevector(__builtin_bit_cast(v4i_t, x0), __builtin_bit_cast(v4i_t, x1), 0, 1, 2, 3, 4, 5, 6, 7)
#define PG8_SA(b, h) (((b) * 2 + (h)) * HTB)
#define PG8_SB(b, h) ((4 + (b) * 2 + (h)) * HTB)
#define PG8_STAGE(bufoff, gbase, voff) do { _Pragma("unroll") for (int _i = 0; _i < 2; ++_i) \
        __builtin_amdgcn_global_load_lds((const unsigned*)((const char*)(gbase) + (voff)[_i]), (PG8_LAS unsigned*)(lds + (bufoff) + ldsw + _i * 8192), 16, 0, 0); } while (0)
#define PG8_LDA(dst, b, h) do { if constexpr (FP8) { _Pragma("unroll") for (int m = 0; m < 4; ++m) dst##8[m] = PG8_CAT(*(const PG8_LAS bf16x8*)(lds + PG8_SA(b, h) + aoff + m * 2048), *(const PG8_LAS bf16x8*)(lds + PG8_SA(b, h) + aoff + m * 2048 + 1024)); } \
      else { _Pragma("unroll") for (int m = 0; m < 4; ++m) _Pragma("unroll") for (int k = 0; k < 2; ++k) dst[m][k] = *(const PG8_LAS bf16x8*)(lds + PG8_SA(b, h) + aoff + m * 2048 + k * 1024); } } while (0)
#define PG8_LDB(dst, b, h) do { if constexpr (FP8) { _Pragma("unroll") for (int n = 0; n < 2; ++n) dst##8[n] = PG8_CAT(*(const PG8_LAS bf16x8*)(lds + PG8_SB(b, h) + boff + n * 2048), *(const PG8_LAS bf16x8*)(lds + PG8_SB(b, h) + boff + n * 2048 + 1024)); } \
      else { _Pragma("unroll") for (int n = 0; n < 2; ++n) _Pragma("unroll") for (int k = 0; k < 2; ++k) dst[n][k] = *(const PG8_LAS bf16x8*)(lds + PG8_SB(b, h) + boff + n * 2048 + k * 1024); } } while (0)
#define PG8_MMA(ai, bj, At, Bt) do { __builtin_amdgcn_s_setprio(1); if constexpr (FP8) { _Pragma("unroll") for (int m = 0; m < 4; ++m) _Pragma("unroll") for (int n = 0; n < 2; ++n) \
        asm volatile("v_mfma_scale_f32_16x16x128_f8f6f4 %0, %1, %2, %0, %3, %4 op_sel_hi:[0,0,0]" : "+v"(acc[ai][bj][m][n]) : "v"(Bt##8[n]), "v"(At##8[m]), "v"(scw8), "v"(sca8)); } \
      else { _Pragma("unroll") for (int m = 0; m < 4; ++m) _Pragma("unroll") for (int n = 0; n < 2; ++n) _Pragma("unroll") for (int k = 0; k < 2; ++k) \
        acc[ai][bj][m][n] = __builtin_amdgcn_mfma_f32_16x16x32_bf16(Bt[n][k], At[m][k], acc[ai][bj][m][n], 0, 0, 0); } __builtin_amdgcn_s_setprio(0); } while (0)
#define PG8_WAIT_V(n) asm volatile("s_waitcnt vmcnt(" #n ")" ::: "memory")
#define PG8_WAIT_L(n) asm volatile("s_waitcnt lgkmcnt(" #n ")" ::: "memory")
#define PG8_BAR __builtin_amdgcn_s_barrier()
#define PG8_SCHED __builtin_amdgcn_sched_barrier(0)
    Unit cur, nxt; int ui = 0;
    if (!S.next(0, cur)) return;
    f32x4 acc[2][2][4][2];
#pragma unroll
    for (int a = 0; a < 2; ++a)
#pragma unroll
        for (int b = 0; b < 2; ++b)
#pragma unroll
            for (int m = 0; m < 4; ++m)
#pragma unroll
                for (int n = 0; n < 2; ++n) acc[a][b][m][n] = (f32x4){0.f, 0.f, 0.f, 0.f};
    int scw8 = g.sw, sca8 = g.sa; asm volatile("" : "+v"(scw8), "+v"(sca8));
    bf16x8 At[4][2], B0[2][2], B1[2][2]; v8i_t At8[4], B08[2], B18[2];
    const char* cA = cur.a; const char* cB = cur.b; long cJ = cur.bjump;
    S.a_ready(cur);
    if constexpr (SP2) {
        if constexpr (Sched::GATHER) PG8_GOFF(cur, gA0, gA1);
        PG8_STAGE(PG8_SB(0, 0), cB, voffB); PG8_STAGE(PG8_SB(0, 1), cB + hstepB, voffB); do { if constexpr (Sched::GATHER) { PG8_STAGE(PG8_SA(0, 0), cA, gA0); } else { PG8_STAGE(PG8_SA(0, 0), cA, voffA); } } while (0); do { if constexpr (Sched::GATHER) { PG8_STAGE(PG8_SA(0, 1), cA, gA1); } else { PG8_STAGE(PG8_SA(0, 1), cA + hstepA, voffA); } } while (0);
        if (wr == 1) PG8_BAR;
        PG8_WAIT_V(2); PG8_BAR;
        PG8_STAGE(PG8_SB(1, 0), cB + kstep, voffB); do { if constexpr (Sched::GATHER) { PG8_STAGE(PG8_SA(1, 0), cA + kstep, gA0); } else { PG8_STAGE(PG8_SA(1, 0), cA + kstep, voffA); } } while (0); PG8_STAGE(PG8_SB(1, 1), cB + hstepB + kstep, voffB);
        PG8_WAIT_V(6); PG8_BAR;
    } else {
        PG8_STAGE(PG8_SB(0, 0), cB, voffB); PG8_STAGE(PG8_SA(0, 0), cA, voffA); PG8_STAGE(PG8_SB(0, 1), cB + hstepB, voffB); PG8_STAGE(PG8_SA(0, 1), cA + hstepA, voffA);
        if (wr == 1) PG8_BAR;
        PG8_WAIT_V(4); PG8_BAR;
        PG8_STAGE(PG8_SB(1, 0), cB + kstep, voffB); PG8_STAGE(PG8_SA(1, 0), cA + kstep, voffA); PG8_STAGE(PG8_SB(1, 1), cB + hstepB + kstep, voffB);
        PG8_WAIT_V(6); PG8_BAR;
    }
    for (;;) {
        const bool has_next = S.next(ui + 1, nxt);
        const char* nA = has_next ? nxt.a : cA; const char* nB = has_next ? nxt.b : cB;
        if constexpr (Sched::GATHER) { if (has_next) PG8_GOFF(nxt, gN0, gN1); else { gN0[0] = gA0[0]; gN0[1] = gA0[1]; gN1[0] = gA1[0]; gN1[1] = gA1[1]; } }
#pragma unroll 1
        for (int t = 0; t < nt; t += 2) {
            const bool last = (t == nt - 2);
            const char* a1 = cA + (size_t)(t + 1) * kstep;
            const char* a2 = last ? nA : cA + (size_t)(t + 2) * kstep; const char* b2 = last ? nB : cB + (size_t)(t + 2) * kstep + ((t + 2) >= g.ksplit ? cJ : 0L);
            const char* a3 = a2 + kstep; const char* b3 = b2 + kstep;
            if (last && has_next) S.a_ready(nxt);
            unsigned x0[2] = {0u, 0u}, x1[2] = {0u, 0u};
            if constexpr (Sched::GATHER) { x0[0] = last ? gN0[0] : gA0[0]; x0[1] = last ? gN0[1] : gA0[1]; x1[0] = last ? gN1[0] : gA1[0]; x1[1] = last ? gN1[1] : gA1[1]; }
            if constexpr (SP2) {
            PG8_LDB(B0, 0, 0); PG8_LDB(B1, 0, 1); PG8_SCHED; PG8_LDA(At, 0, 0); do { if constexpr (Sched::GATHER) { PG8_STAGE(PG8_SA(1, 1), a1, gA1); } else { PG8_STAGE(PG8_SA(1, 1), a1 + hstepA, voffA); } } while (0);
            PG8_WAIT_V(8); PG8_WAIT_L(0); PG8_BAR; PG8_MMA(0, 0, At, B0); PG8_MMA(0, 1, At, B1); PG8_BAR; PG8_SCHED;
            PG8_LDA(At, 0, 1); PG8_STAGE(PG8_SB(0, 0), b2, voffB); PG8_STAGE(PG8_SB(0, 1), b2 + hstepB, voffB); do { if constexpr (Sched::GATHER) { PG8_STAGE(PG8_SA(0, 0), a2, x0); } else { PG8_STAGE(PG8_SA(0, 0), a2, voffA); } } while (0);
            PG8_WAIT_V(8); PG8_WAIT_L(0); PG8_BAR; PG8_MMA(1, 0, At, B0); PG8_MMA(1, 1, At, B1); PG8_BAR; PG8_SCHED;
            PG8_LDB(B0, 1, 0); PG8_LDB(B1, 1, 1); PG8_SCHED; PG8_LDA(At, 1, 0); do { if constexpr (Sched::GATHER) { PG8_STAGE(PG8_SA(0, 1), a2, x1); } else { PG8_STAGE(PG8_SA(0, 1), a2 + hstepA, voffA); } } while (0);
            PG8_WAIT_V(8); PG8_WAIT_L(0); PG8_BAR; PG8_MMA(0, 0, At, B0); PG8_MMA(0, 1, At, B1); PG8_BAR; PG8_SCHED;
            PG8_LDA(At, 1, 1); PG8_STAGE(PG8_SB(1, 0), b3, voffB); PG8_STAGE(PG8_SB(1, 1), b3 + hstepB, voffB); do { if constexpr (Sched::GATHER) { PG8_STAGE(PG8_SA(1, 0), a3, x0); } else { PG8_STAGE(PG8_SA(1, 0), a3, voffA); } } while (0);
            PG8_WAIT_V(8); PG8_WAIT_L(0); PG8_BAR; PG8_MMA(1, 0, At, B0); PG8_MMA(1, 1, At, B1); PG8_BAR; PG8_SCHED;
            } else {
            PG8_LDB(B0, 0, 0); PG8_SCHED; PG8_LDA(At, 0, 0); PG8_STAGE(PG8_SA(1, 1), a1 + hstepA, voffA);
            PG8_WAIT_L(8); PG8_BAR; PG8_WAIT_L(0); PG8_MMA(0, 0, At, B0); PG8_BAR; PG8_SCHED;
            PG8_LDB(B1, 0, 1); PG8_STAGE(PG8_SB(0, 0), b2, voffB);
            PG8_BAR; PG8_WAIT_L(0); PG8_MMA(0, 1, At, B1); PG8_BAR;
            PG8_LDA(At, 0, 1); PG8_STAGE(PG8_SA(0, 0), a2, voffA);
            PG8_BAR; PG8_WAIT_L(0); PG8_MMA(1, 0, At, B0); PG8_BAR; PG8_SCHED;
            PG8_STAGE(PG8_SB(0, 1), b2 + hstepB, voffB);
            PG8_WAIT_V(6); PG8_BAR; PG8_MMA(1, 1, At, B1); PG8_BAR;
            PG8_LDB(B0, 1, 0); PG8_SCHED; PG8_LDA(At, 1, 0); PG8_STAGE(PG8_SA(0, 1), a2 + hstepA, voffA);
            PG8_WAIT_L(8); PG8_BAR; PG8_WAIT_L(0); PG8_MMA(0, 0, At, B0); PG8_BAR; PG8_SCHED;
            PG8_LDB(B1, 1, 1); PG8_STAGE(PG8_SB(1, 0), b3, voffB);
            PG8_BAR; PG8_WAIT_L(0); PG8_MMA(0, 1, At, B1); PG8_BAR;
            PG8_LDA(At, 1, 1); PG8_STAGE(PG8_SA(1, 0), a3, voffA);
            PG8_BAR; PG8_WAIT_L(0); PG8_MMA(1, 0, At, B0); PG8_BAR; PG8_SCHED;
            PG8_STAGE(PG8_SB(1, 1), b3 + hstepB, voffB);
            PG8_WAIT_V(6); PG8_BAR; PG8_MMA(1, 1, At, B1); PG8_BAR;
            }
        }
        if constexpr (ALIGN_EPI) { if (wr == 0) PG8_BAR; }
        if constexpr (!Epi::AFTER_DRAIN) { E(acc, cur, wr, wc, fr, fq); S.done(cur); }
        if (!has_next) break;
#pragma unroll
        for (int a = 0; a < 2; ++a)
#pragma unroll
            for (int b = 0; b < 2; ++b)
#pragma unroll
                for (int m = 0; m < 4; ++m)
#pragma unroll
                    for (int n = 0; n < 2; ++n) acc[a][b][m][n] = (f32x4){0.f, 0.f, 0.f, 0.f};
        cur = nxt; cA = nA; cB = nB; cJ = cur.bjump; ++ui;
        if constexpr (Sched::GATHER) { gA0[0] = gN0[0]; gA0[1] = gN0[1]; gA1[0] = gN1[0]; gA1[1] = gN1[1]; }
        if constexpr (ALIGN_EPI) { if (wr == 1) PG8_BAR; }
    }
    PG8_WAIT_V(0);
    if constexpr (!ALIGN_EPI) { if (wr == 0) PG8_BAR; }
    PG8_BAR;
    if constexpr (Epi::AFTER_DRAIN) { E.fused(acc, cur, wr, wc, fr, fq, lds, wid, lane); S.done(cur); }
#undef PG8_GOFF
#undef PG8_SA
#undef PG8_SB
#undef PG8_STAGE
#undef PG8_LDA
#undef PG8_LDB
#undef PG8_MMA
#undef PG8_CAT
#undef PG8_WAIT_V
#undef PG8_WAIT_L
#undef PG8_BAR
#undef PG8_SCHED
}
}

#ifndef PROBE_PH
#define PROBE_PH (-1)
#endif
#ifndef PROBE_MODE
#define PROBE_MODE (0)
#endif
constexpr int D = 1024, BATCH = 16, SEQ = 2048, T = BATCH * SEQ;
constexpr int INW = 6984, INWP = 7168;
constexpr int C_QA = 0, C_CKV = 1024, C_QI = 1280, C_KI = 1792, C_WI = 1856, C_RQ = 1864, C_RK = 2376, C_RV = 2888, C_RG = 3912, C_GA = 4936, C_GR = 5960;
constexpr float EPS = 1e-6f;
constexpr int NWAVES = 8;

constexpr size_t MiB = 1u << 20;
constexpr size_t WS_CTL = 0, CTL_ZERO_BYTES = 1 * MiB;
constexpr size_t WS_WIN = 1 * MiB, WS_WKV = 15 * MiB, WS_WATT = 16 * MiB, WS_WRET = 18 * MiB, WS_WOUT = 20 * MiB, WS_W1 = 22 * MiB, WS_WD = 38 * MiB, WS_ACT = 46 * MiB;
constexpr size_t O_QA = 0, O_CKV = 2048, O_QI = 2560, O_KW = 3584, O_RQ = 3840, O_RK = 4864, O_RV = 5888, O_RG = 7936, O_GA = 9984, O_GR = 12032, O_END = 14080;

constexpr int MP_ROWS = 38912;
constexpr size_t MO_APERM = 0, MO_ACT = 80 * MiB, MO_N2 = 120 * MiB, MO_META = 184 * MiB;
constexpr size_t MM_B = 0, MM_P = 131072, MM_CL = 262144, MM_CH = 393216, MM_RS = 524288, MM_PTOK = 655360, MM_PRS = 819200, MM_PCL = 983040, MM_PCH = 1146880, MM_END = 1310720;
constexpr size_t WS_WR = 15 * MiB + 512 * 1024;
constexpr size_t MO_H16 = 192 * MiB;
constexpr size_t WS_WIN8 = 488 * MiB;
constexpr size_t WS_WATT8 = 495 * MiB, WS_WRET8 = 496 * MiB, WS_WOUT8 = 497 * MiB;
constexpr size_t O_A2F8 = 2048, O_MIX8 = 3840;
constexpr size_t WS_W18 = 498 * MiB, WS_WD8 = 506 * MiB;
constexpr size_t AUX_XB8 = 2048 + 896;
constexpr int F8_FIRST_TILE = 8;
constexpr int CW_MOE = 256;
constexpr int RING_OFF = 0, RING_BYTES = 131072, P3_HIST_OFF = 131072, P3_TOT_OFF = 147456, P3_T_OFF = 149504, LDSCTL_OFF = 151552, MISC_OFF = LDSCTL_OFF + 320, LDS_BYTES = 152576;
constexpr int CW_Q3 = 64, CW_Q4 = 128;

#define GAS __attribute__((address_space(1)))
#define LAS __attribute__((address_space(3)))
typedef unsigned short bf16;
typedef unsigned v4u __attribute__((ext_vector_type(4)));
typedef float f32x4 __attribute__((ext_vector_type(4)));
#define LDS_WAIT() asm volatile("s_waitcnt lgkmcnt(0)" ::: "memory")
#define VM_WAIT() asm volatile("s_waitcnt vmcnt(0)" ::: "memory")
__device__ __forceinline__ unsigned f2bf(float f) { unsigned u = __builtin_bit_cast(unsigned, f); return (u + 0x7fffu + ((u >> 16) & 1u)) >> 16; }
__device__ __forceinline__ unsigned pk2(float lo, float hi) { return f2bf(lo) | (f2bf(hi) << 16); }
__device__ __forceinline__ float bf2f(bf16 b) { return __uint_as_float((unsigned)b << 16); }


typedef GAS unsigned gu32;
constexpr int CW_BAR = 4096;
#define XB_TMO      128
#define XB_XCNT(j)  (256  + 64 * (j))
#define XB_XSUB(j)  (1280 + 64 * (j))
#define XB_XGEN(j)  (2304 + 64 * (j))
#define XB_TOP      3328
#define XB_TOPGEN   3392
#define XCD_BAR_WORDS 3456
#define XB_SPIN_CAP (1u << 18)

__device__ __forceinline__ unsigned xb_ld(unsigned* p)              { return __hip_atomic_load(p, __ATOMIC_RELAXED, __HIP_MEMORY_SCOPE_AGENT); }
__device__ __forceinline__ unsigned xb_add(unsigned* p, unsigned v) { return __hip_atomic_fetch_add(p, v, __ATOMIC_RELAXED, __HIP_MEMORY_SCOPE_AGENT); }
__device__ __forceinline__ unsigned xb_xcc_id() { return (unsigned)__builtin_amdgcn_s_getreg((3 << 11) | 20) & 0xFu; }
#define XB_SPIN(cond, bar) do { unsigned _sp = 0; while (cond) { __builtin_amdgcn_s_sleep(1); \
    if ((++_sp & 255u) == 0u) { if (xb_ld(&(bar)[XB_TMO])) break; if (_sp > XB_SPIN_CAP) { atomicAdd(&(bar)[XB_TMO], 1u); break; } } } } while (0)

struct XcdBarrier {
    unsigned* bar; unsigned x;
    volatile LAS unsigned* st;
};

__device__ __forceinline__ XcdBarrier xcd_barrier_post(unsigned* bar, volatile LAS unsigned* st) {
    XcdBarrier b; b.bar = bar; b.x = xb_xcc_id(); b.st = st;
    if (threadIdx.x == 0) (void)xb_add(&bar[XB_XCNT(b.x)], 1u);
    return b;
}
__device__ __forceinline__ void xcd_barrier_complete(unsigned* bar, unsigned x, unsigned& nloc, unsigned& nx) {
    const unsigned G = gridDim.x * gridDim.y * gridDim.z;
    unsigned sum, cnt, mine, sp = 0u;
    for (;;) {
        sum = 0u; cnt = 0u; mine = 0u;
#pragma unroll
        for (unsigned j = 0; j < 16; ++j) { const unsigned c = xb_ld(&bar[XB_XCNT(j)]); sum += c; cnt += (c > 0u) ? 1u : 0u; mine = (j == x) ? c : mine; }
        if (sum == G) break;
        __builtin_amdgcn_s_sleep(1);
        if ((++sp & 255u) == 0u) { if (xb_ld(&bar[XB_TMO])) break; if (sp > XB_SPIN_CAP) { atomicAdd(&bar[XB_TMO], 1u); break; } }
    }
    nloc = mine > 0u ? mine : 1u; nx = cnt > 0u ? cnt : 1u;
}

__device__ __forceinline__ void xcd_barrier(const XcdBarrier& b) {
    asm volatile("s_waitcnt vmcnt(0)" ::: "memory");
    __syncthreads();
    if (threadIdx.x == 0) {
        unsigned* bar = b.bar;
        __builtin_amdgcn_s_waitcnt(0);
        unsigned nloc = b.st[0], nx = b.st[1];
        if (nloc == 0u) { xcd_barrier_complete(bar, b.x, nloc, nx); b.st[0] = nloc; b.st[1] = nx; }
        const unsigned old = xb_add(&bar[XB_XSUB(b.x)], 1u);
        const unsigned gen = old / nloc;
        if (old + 1u == (gen + 1u) * nloc) {
            __builtin_amdgcn_fence(__ATOMIC_RELEASE, "agent");
            asm volatile("s_waitcnt vmcnt(0)" ::: "memory");
            const unsigned og = xb_add(&bar[XB_TOP], 1u);
            const unsigned tg = og / nx;
            if (og + 1u == (tg + 1u) * nx) xb_add(&bar[XB_TOPGEN], 1u);
            else XB_SPIN(xb_ld(&bar[XB_TOPGEN]) == tg, bar);
            __builtin_amdgcn_fence(__ATOMIC_ACQUIRE, "agent");
            xb_add(&bar[XB_XGEN(b.x)], 1u);
            asm volatile("s_waitcnt vmcnt(0)" ::: "memory");
        } else {
            XB_SPIN(xb_ld(&bar[XB_XGEN(b.x)]) == gen, bar);
            __builtin_amdgcn_fence(__ATOMIC_ACQUIRE, "agent");
            asm volatile("s_waitcnt vmcnt(0)" ::: "memory");
        }
    }
    __syncthreads();
}

struct Args { const float* in[20]; float* out; unsigned char* ws; unsigned char* xb; int ph_lo, ph_hi, ntok, tok0, mode, pad; };

struct Frame {
    LAS unsigned char* lds;
    int tid, lane, wave, vcu, G;
    int ntok;
    unsigned char* ws; unsigned char* act; unsigned char* xbp;
};

struct EpiProj {
    static constexpr bool PERM = true, AFTER_DRAIN = false;
    unsigned char* act; size_t ntok;
    static __device__ __forceinline__ unsigned q4(const pg8::f32x4& v) { int w = __builtin_amdgcn_cvt_pk_fp8_f32(v[0], v[1], 0, false); return (unsigned)__builtin_amdgcn_cvt_pk_fp8_f32(v[2], v[3], w, true); }
    __device__ __forceinline__ void operator()(const pg8::f32x4 (&acc)[2][2][4][2], const pg8::Unit& u, int wr, int wc, int fr, int fq) const {
        const int pn = u.pn; size_t O; int ld, cb, nbj = 2; bool f8 = false;
        if (pn < 4) { O = O_QA; ld = 1024; cb = pn * 256; }
        else if (pn == 4) { O = O_CKV; ld = 256; cb = 0; }
        else if (pn < 7) { O = O_QI; ld = 512; cb = (pn - 5) * 256; }
        else if (pn == 7) { O = O_KW; ld = 128; cb = 0; nbj = 1; }
        else if (pn < 10) { O = O_RQ; ld = 512; cb = (pn - 8) * 256; }
        else if (pn < 12) { O = O_RK; ld = 512; cb = (pn - 10) * 256; }
        else { O = O_RV + (size_t)((pn - 12) >> 2) * 2048; ld = 1024; cb = ((pn - 12) & 3) * 256; }
        f8 = pn < 5 || pn >= F8_FIRST_TILE;
        const int row0 = u.pm * pg8::BM + wr * 64 + fr;
        if (f8) {
            unsigned char* base = act + ntok * O; const bool odd = fq & 1; const int colb = cb + wc * 32 + 8 * (fq & ~1);
#pragma unroll
            for (int ai = 0; ai < 2; ++ai)
#pragma unroll
                for (int bj = 0; bj < 2; ++bj)
#pragma unroll
                    for (int mp = 0; mp < 2; ++mp) { const unsigned x0 = q4(acc[ai][bj][2 * mp][0]), x1 = q4(acc[ai][bj][2 * mp][1]), y0 = q4(acc[ai][bj][2 * mp + 1][0]), y1 = q4(acc[ai][bj][2 * mp + 1][1]);
                        const unsigned r0 = (unsigned)__builtin_amdgcn_ds_swizzle((int)(odd ? x0 : y0), 0x401F), r1 = (unsigned)__builtin_amdgcn_ds_swizzle((int)(odd ? x1 : y1), 0x401F);
                        pg8::u32x4 w; if (odd) { w.x = r0; w.y = r1; w.z = y0; w.w = y1; } else { w.x = x0; w.y = x1; w.z = r0; w.w = r1; }
                        *(pg8::u32x4*)(base + (size_t)(row0 + ai * pg8::HALF + (2 * mp + (odd ? 1 : 0)) * 16) * ld + colb + bj * pg8::HALF) = w; }
            return;
        }
        pg8::bf16_t* base = (pg8::bf16_t*)(act + ntok * O);
        const int col0 = cb + wc * 32 + 8 * fq;
#pragma unroll
        for (int ai = 0; ai < 2; ++ai)
#pragma unroll
            for (int m = 0; m < 4; ++m) { pg8::bf16_t* rowp = base + (size_t)(row0 + ai * pg8::HALF + m * 16) * ld + col0;
#pragma unroll
                for (int bj = 0; bj < 2; ++bj) if (bj < nbj) { const pg8::f32x4 v0 = acc[ai][bj][m][0], v1 = acc[ai][bj][m][1];
                    pg8::u32x4 w; w.x = pg8::cvt_pk_bf16(v0[0], v0[1]); w.y = pg8::cvt_pk_bf16(v0[2], v0[3]); w.z = pg8::cvt_pk_bf16(v1[0], v1[1]); w.w = pg8::cvt_pk_bf16(v1[2], v1[3]);
                    *(pg8::u32x4*)(rowp + bj * pg8::HALF) = w; } }
    }
};

__device__ __forceinline__ float sigm(float x) { return __builtin_amdgcn_rcpf(1.f + __builtin_amdgcn_exp2f(-1.4426950408889634f * x)); }
__device__ __forceinline__ void f8x8(const pg8::u32x2 g, float (&f)[8]) { const auto a = __builtin_amdgcn_cvt_pk_f32_fp8((int)g.x, false), b = __builtin_amdgcn_cvt_pk_f32_fp8((int)g.x, true), c = __builtin_amdgcn_cvt_pk_f32_fp8((int)g.y, false), d = __builtin_amdgcn_cvt_pk_f32_fp8((int)g.y, true);
    f[0] = a[0]; f[1] = a[1]; f[2] = b[0]; f[3] = b[1]; f[4] = c[0]; f[5] = c[1]; f[6] = d[0]; f[7] = d[1]; }
__device__ __forceinline__ void st_f8_pair(unsigned char* base, size_t ld, int row_m0, int colb, bool odd, unsigned x0, unsigned x1, unsigned y0, unsigned y1) {
    const unsigned r0 = (unsigned)__builtin_amdgcn_ds_swizzle((int)(odd ? x0 : y0), 0x401F), r1 = (unsigned)__builtin_amdgcn_ds_swizzle((int)(odd ? x1 : y1), 0x401F);
    pg8::u32x4 w; if (odd) { w.x = r0; w.y = r1; w.z = y0; w.w = y1; } else { w.x = x0; w.y = x1; w.z = r0; w.w = r1; }
    *(pg8::u32x4*)(base + (size_t)(row_m0 + (odd ? 16 : 0)) * ld + colb) = w;
}
__device__ __forceinline__ unsigned q4f(float a, float b, float c, float d) { int w = __builtin_amdgcn_cvt_pk_fp8_f32(a, b, 0, false); return (unsigned)__builtin_amdgcn_cvt_pk_fp8_f32(c, d, w, true); }
struct EpiGateA {
    static constexpr bool PERM = true, AFTER_DRAIN = false;
    const unsigned char* GA8; unsigned char* TMP8;
    __device__ __forceinline__ void operator()(const pg8::f32x4 (&acc)[2][2][4][2], const pg8::Unit& u, int wr, int wc, int fr, int fq) const {
        const int row0 = u.pm * pg8::BM + wr * 64 + fr, col0 = u.pn * pg8::BM + wc * 32 + 8 * fq, colb = u.pn * pg8::BM + wc * 32 + 8 * (fq & ~1); const bool odd = fq & 1;
#pragma unroll
        for (int ai = 0; ai < 2; ++ai)
#pragma unroll
            for (int bj = 0; bj < 2; ++bj)
#pragma unroll
                for (int mp = 0; mp < 2; ++mp) { unsigned q[2][2];
#pragma unroll
                    for (int e = 0; e < 2; ++e) { const int m = 2 * mp + e; const size_t ro = (size_t)(row0 + ai * pg8::HALF + m * 16) * 1024 + col0 + bj * pg8::HALF; float g[8]; f8x8(*(const pg8::u32x2*)(GA8 + ro), g);
                        const pg8::f32x4 v0 = acc[ai][bj][m][0], v1 = acc[ai][bj][m][1];
                        q[e][0] = q4f(32.f * sigm(g[0]) * v0[0], 32.f * sigm(g[1]) * v0[1], 32.f * sigm(g[2]) * v0[2], 32.f * sigm(g[3]) * v0[3]); q[e][1] = q4f(32.f * sigm(g[4]) * v1[0], 32.f * sigm(g[5]) * v1[1], 32.f * sigm(g[6]) * v1[2], 32.f * sigm(g[7]) * v1[3]); }
                    st_f8_pair(TMP8, 1024, row0 + ai * pg8::HALF + 2 * mp * 16, colb + bj * pg8::HALF, odd, q[0][0], q[0][1], q[1][0], q[1][1]); }
    }
};
struct EpiGateB {
    static constexpr bool PERM = true, AFTER_DRAIN = false;
    const unsigned char* TMP8; const unsigned char* GR8; unsigned char* MIX8;
    __device__ __forceinline__ void operator()(const pg8::f32x4 (&acc)[2][2][4][2], const pg8::Unit& u, int wr, int wc, int fr, int fq) const {
        const int row0 = u.pm * pg8::BM + wr * 64 + fr, col0 = u.pn * pg8::BM + wc * 32 + 8 * fq, colb = u.pn * pg8::BM + wc * 32 + 8 * (fq & ~1); const bool odd = fq & 1;
#pragma unroll
        for (int ai = 0; ai < 2; ++ai)
#pragma unroll
            for (int bj = 0; bj < 2; ++bj)
#pragma unroll
                for (int mp = 0; mp < 2; ++mp) { unsigned q[2][2];
#pragma unroll
                    for (int e = 0; e < 2; ++e) { const int m = 2 * mp + e; const size_t ro = (size_t)(row0 + ai * pg8::HALF + m * 16) * 1024 + col0 + bj * pg8::HALF; float g[8], t[8]; f8x8(*(const pg8::u32x2*)(GR8 + ro), g); f8x8(*(const pg8::u32x2*)(TMP8 + ro), t);
                        const pg8::f32x4 v0 = acc[ai][bj][m][0], v1 = acc[ai][bj][m][1];
                        q[e][0] = q4f(0.25f * t[0] + 8.f * sigm(g[0]) * v0[0], 0.25f * t[1] + 8.f * sigm(g[1]) * v0[1], 0.25f * t[2] + 8.f * sigm(g[2]) * v0[2], 0.25f * t[3] + 8.f * sigm(g[3]) * v0[3]);
                        q[e][1] = q4f(0.25f * t[4] + 8.f * sigm(g[4]) * v1[0], 0.25f * t[5] + 8.f * sigm(g[5]) * v1[1], 0.25f * t[6] + 8.f * sigm(g[6]) * v1[2], 0.25f * t[7] + 8.f * sigm(g[7]) * v1[3]); }
                    st_f8_pair(MIX8, 1024, row0 + ai * pg8::HALF + 2 * mp * 16, colb + bj * pg8::HALF, odd, q[0][0], q[0][1], q[1][0], q[1][1]); }
    }
};
struct EpiResid {
    static constexpr bool PERM = true, AFTER_DRAIN = false;
    const float* x; pg8::bf16_t* h16;
    __device__ __forceinline__ void operator()(const pg8::f32x4 (&acc)[2][2][4][2], const pg8::Unit& u, int wr, int wc, int fr, int fq) const {
        const int row0 = u.pm * pg8::BM + wr * 64 + fr, col0 = u.pn * pg8::BM + wc * 32 + 8 * fq;
#pragma unroll
        for (int ai = 0; ai < 2; ++ai)
#pragma unroll
            for (int m = 0; m < 4; ++m) { const size_t ro = (size_t)(row0 + ai * pg8::HALF + m * 16) * 1024 + col0;
#pragma unroll
                for (int bj = 0; bj < 2; ++bj) { const pg8::f32x4 x0 = *(const pg8::f32x4*)(x + ro + bj * pg8::HALF), x1 = *(const pg8::f32x4*)(x + ro + bj * pg8::HALF + 4); const pg8::f32x4 v0 = acc[ai][bj][m][0] + x0, v1 = acc[ai][bj][m][1] + x1;
                    pg8::u32x4 w; w.x = pg8::cvt_pk_bf16(v0[0], v0[1]); w.y = pg8::cvt_pk_bf16(v0[2], v0[3]); w.z = pg8::cvt_pk_bf16(v1[0], v1[1]); w.w = pg8::cvt_pk_bf16(v1[2], v1[3]);
                    *(pg8::u32x4*)(h16 + ro + bj * pg8::HALF) = w; } }
    }
};


struct P1Order {
    static constexpr bool GATHER = false; const int* ptok = nullptr;
    int nM, nN, nwg, G, c, mode; const char* A; const char* Bt; size_t tA, tB;
    __device__ bool next(int i, pg8::Unit& u) const {
        const long L = (long)i * G + c; if (L >= nwg) return false;
        int wgid = (int)L; { const int q = nwg / pg8::NXCD, r = nwg % pg8::NXCD, xcd = wgid % pg8::NXCD, off = wgid / pg8::NXCD; wgid = (xcd < r ? xcd * (q + 1) : r * (q + 1) + (xcd - r) * q) + off; }
        const int nig = pg8::WGM * nN, gid = wgid / nig, fm = gid * pg8::WGM, gsz = (nM - fm) < pg8::WGM ? (nM - fm) : pg8::WGM;
        u.pm = fm + ((wgid % nig) % gsz); const int pc = (wgid % nig) / gsz; u.pn = mode ? 5 + pc : (pc < 5 ? pc : pc + 3);
        u.a = A + (size_t)u.pm * tA; u.b = Bt + (size_t)u.pn * tB; u.bjump = 0; u.aux = 0; return true;
    }
    __device__ __forceinline__ void a_ready(const pg8::Unit&) const {}
    __device__ __forceinline__ void done(const pg8::Unit&) const {}
};

__device__ __forceinline__ float wave_sum(float v) {
#pragma unroll
    for (int o = 1; o < 64; o <<= 1) v += __shfl_xor(v, o);
    return v;
}
__device__ __forceinline__ void p0_transpose_item(const float* W, int K, int N, bf16* WT, int map, int row_off, int par, const float* gk, LAS float* scr, int item, int lane, unsigned char* WT8 = nullptr, float s8 = 32.f) {
    const int nblk = (N + 31) / 32, kb = item / nblk, nb = item % nblk, k0 = 64 * kb, n0 = 32 * nb;
    const int c4 = lane & 7, rr = lane >> 3; const bool okc = (n0 + 4 * c4) < N;
    f32x4 v[8];
#pragma unroll
    for (int i = 0; i < 8; ++i) { const int kk = i * 8 + rr; v[i] = okc ? *(const f32x4*)(W + (size_t)(k0 + kk) * N + n0 + 4 * c4) : (f32x4){0.f, 0.f, 0.f, 0.f}; }
#pragma unroll
    for (int i = 0; i < 8; ++i) { const int kk = i * 8 + rr; f32x4 x = v[i]; if (gk) x = x * gk[k0 + kk]; *(LAS f32x4*)(scr + kk * 36 + 4 * c4) = x; }
    LDS_WAIT(); asm volatile("" ::: "memory");
    const int c = lane & 7;
#pragma unroll
    for (int j = 0; j < 4; ++j) { const int nl = (lane >> 3) + 8 * j, n = n0 + nl; const LAS float* s = scr + (8 * c) * 36 + nl;
        v4u o; o.x = pk2(s[0 * 36], s[1 * 36]); o.y = pk2(s[2 * 36], s[3 * 36]); o.z = pk2(s[4 * 36], s[5 * 36]); o.w = pk2(s[6 * 36], s[7 * 36]);
        if (n < N) { const int row = (map == 0) ? row_off + n : (map == 1) ? (n < 1864 ? n : n + 184) : row_off + 2 * n + par;
            if (WT) *(GAS v4u*)(WT + (size_t)row * K + k0 + 8 * c) = o;
            if (WT8) { int w0 = __builtin_amdgcn_cvt_pk_fp8_f32(s[0 * 36] * s8, s[1 * 36] * s8, 0, false); w0 = __builtin_amdgcn_cvt_pk_fp8_f32(s[2 * 36] * s8, s[3 * 36] * s8, w0, true);
                int w1 = __builtin_amdgcn_cvt_pk_fp8_f32(s[4 * 36] * s8, s[5 * 36] * s8, 0, false); w1 = __builtin_amdgcn_cvt_pk_fp8_f32(s[6 * 36] * s8, s[7 * 36] * s8, w1, true);
                *(GAS unsigned long long*)(WT8 + (size_t)row * K + k0 + 8 * c) = (unsigned long long)(unsigned)w0 | ((unsigned long long)(unsigned)w1 << 32); } } }
    LDS_WAIT(); asm volatile("" ::: "memory");
}
__device__ __forceinline__ void p0_prologue(Frame& F, const Args& a) {
    LAS float* scr = (LAS float*)(F.lds + RING_OFF + F.wave * 16384);
    const int gw = F.vcu * NWAVES + F.wave, NGW = F.G * NWAVES;
    bf16* Win_t = (bf16*)(F.ws + WS_WIN); bf16* Wkv_t = (bf16*)(F.ws + WS_WKV);
    constexpr int I_IN = 16 * 219, I_KV = 4 * 8, I_SQ = 16 * 32, I_GU = 16 * 8  , I_DN = 4 * 32  ;
    constexpr int NITEMS = I_IN + I_KV + 3 * I_SQ + 16 * (2 * I_GU + I_DN);
    for (int it = gw; it < NITEMS; it += NGW) {
        int r = it;
        if (r < I_IN) { p0_transpose_item(a.in[2], 1024, INW, Win_t, 1, 0, 0, a.in[1], scr, r, F.lane, F.ws + WS_WIN8); continue; } r -= I_IN;
        if (r < I_KV) { p0_transpose_item(a.in[4], 256, 256, Wkv_t, 0, 0, 0, a.in[3], scr, r, F.lane); continue; } r -= I_KV;
        if (r < I_SQ) { p0_transpose_item(a.in[9], 1024, 1024, nullptr, 0, 0, 0, nullptr, scr, r, F.lane, F.ws + WS_WATT8, 32.f); continue; } r -= I_SQ;
        if (r < I_SQ) { p0_transpose_item(a.in[10], 1024, 1024, nullptr, 0, 0, 0, nullptr, scr, r, F.lane, F.ws + WS_WRET8, 32.f); continue; } r -= I_SQ;
        if (r < I_SQ) { p0_transpose_item(a.in[11], 1024, 1024, nullptr, 0, 0, 0, nullptr, scr, r, F.lane, F.ws + WS_WOUT8, 32.f); continue; } r -= I_SQ;
        const int e = r / (2 * I_GU + I_DN), q = r % (2 * I_GU + I_DN);
        if (q < I_GU) p0_transpose_item(a.in[17] + (size_t)e * 1024 * 256, 1024, 256, nullptr, 2, e * 512, 0, nullptr, scr, q, F.lane, F.ws + WS_W18, 32.f);
        else if (q < 2 * I_GU) p0_transpose_item(a.in[18] + (size_t)e * 1024 * 256, 1024, 256, nullptr, 2, e * 512, 1, nullptr, scr, q - I_GU, F.lane, F.ws + WS_W18, 32.f);
        else p0_transpose_item(a.in[19] + (size_t)e * 256 * 1024, 256, 1024, nullptr, 0, 0, 0, nullptr, scr, q - 2 * I_GU, F.lane, F.ws + WS_WD8 + (size_t)e * 1024 * 256, 16.f);
    }
    { const int gt = (F.vcu * NWAVES + F.wave) * 64 + F.lane, NGT = F.G * NWAVES * 64; GAS v4u* z = (GAS v4u*)(Win_t + (size_t)1864 * 1024);
      for (int i = gt; i < 184 * 1024 * 2 / 16; i += NGT) z[i] = (v4u){0u, 0u, 0u, 0u}; }
    { const int gt = (F.vcu * NWAVES + F.wave) * 64 + F.lane, NGT = F.G * NWAVES * 64; bf16* Wh = (bf16*)(F.ws + WS_WR); bf16* Wl = Wh + 32 * 1024;
      for (int i = gt; i < 32 * 1024; i += NGT) { const int n = i >> 10, k = i & 1023; const float wv = n < 4 ? a.in[13][k * 4 + n] : (n < 20 ? a.in[15][k * 16 + (n - 4)] : 0.f);
        const unsigned hb = f2bf(wv); const float hf = __uint_as_float(hb << 16); Wh[i] = (bf16)hb; Wl[i] = (bf16)f2bf(wv - hf); } }
    const float* x = a.in[0] + (size_t)a.tok0 * D; unsigned char* xb8 = a.xb + (size_t)F.ntok * AUX_XB8;
    for (int m = gw; m < F.ntok; m += 2 * NGW) {
        const int m2 = m + NGW; const bool two = m2 < F.ntok;
        const GAS f32x4* xr = (const GAS f32x4*)(x + (size_t)m * D) + F.lane; const GAS f32x4* xr2 = (const GAS f32x4*)(x + (size_t)(two ? m2 : m) * D) + F.lane;
        f32x4 v[4], u[4]; float s = 0.f, s2 = 0.f;
#pragma unroll
        for (int j = 0; j < 4; ++j) { v[j] = xr[64 * j]; u[j] = xr2[64 * j]; }
#pragma unroll
        for (int j = 0; j < 4; ++j) { s += (v[j].x * v[j].x + v[j].y * v[j].y) + (v[j].z * v[j].z + v[j].w * v[j].w); s2 += (u[j].x * u[j].x + u[j].y * u[j].y) + (u[j].z * u[j].z + u[j].w * u[j].w); }
        const float rstd = 1.f / sqrtf(wave_sum(s) * (1.f / D) + EPS), rstd2 = 1.f / sqrtf(wave_sum(s2) * (1.f / D) + EPS);
        GAS unsigned long long* o8 = (GAS unsigned long long*)(a.xb + (size_t)m * D * 2) + F.lane; GAS unsigned* q8 = (GAS unsigned*)(xb8 + (size_t)m * D) + F.lane;
#pragma unroll
        for (int j = 0; j < 4; ++j) { o8[64 * j] = (unsigned long long)pk2(v[j].x * rstd, v[j].y * rstd) | ((unsigned long long)pk2(v[j].z * rstd, v[j].w * rstd) << 32);
            int w8 = __builtin_amdgcn_cvt_pk_fp8_f32(v[j].x * rstd, v[j].y * rstd, 0, false); w8 = __builtin_amdgcn_cvt_pk_fp8_f32(v[j].z * rstd, v[j].w * rstd, w8, true); q8[64 * j] = (unsigned)w8; }
        if (two) { GAS unsigned long long* p8 = (GAS unsigned long long*)(a.xb + (size_t)m2 * D * 2) + F.lane; GAS unsigned* r8 = (GAS unsigned*)(xb8 + (size_t)m2 * D) + F.lane;
#pragma unroll
            for (int j = 0; j < 4; ++j) { p8[64 * j] = (unsigned long long)pk2(u[j].x * rstd2, u[j].y * rstd2) | ((unsigned long long)pk2(u[j].z * rstd2, u[j].w * rstd2) << 32);
                int w8 = __builtin_amdgcn_cvt_pk_fp8_f32(u[j].x * rstd2, u[j].y * rstd2, 0, false); w8 = __builtin_amdgcn_cvt_pk_fp8_f32(u[j].z * rstd2, u[j].w * rstd2, w8, true); r8[64 * j] = (unsigned)w8; } }
    }
}


constexpr size_t AUX_KP = 0, AUX_VV = 256, AUX_KIN = 512, AUX_MASK = 640, AUX_END = 896;
typedef short bf16x8_t __attribute__((ext_vector_type(8)));
typedef float f32x16 __attribute__((ext_vector_type(16)));
__device__ __forceinline__ int crow(int r, int hi) { return (r & 3) + 8 * (r >> 2) + 4 * hi; }
__device__ __forceinline__ float xhalf_sum(float v) { auto rr = __builtin_amdgcn_permlane32_swap(__float_as_uint(v), __float_as_uint(v), false, false); return __uint_as_float(rr[0]) + __uint_as_float(rr[1]); }
__device__ __forceinline__ float sumsq8(bf16x8_t v) { float s = 0.f;
#pragma unroll
    for (int j = 0; j < 8; ++j) { const float f = __uint_as_float((unsigned)(unsigned short)v[j] << 16); s += f * f; } return s; }
__device__ __forceinline__ void p2_post(Frame& F, const Args& a) {
    const int gw = F.vcu * NWAVES + F.wave, NGW = F.G * NWAVES, lane = F.lane, r32 = lane & 31, hi = lane >> 5;
    const size_t nt_ = (size_t)F.ntok;
    const bf16* CKV = (const bf16*)(F.act + nt_ * O_CKV); const bf16* KW = (const bf16*)(F.act + nt_ * O_KW);
    const bf16* Wkv_t = (const bf16*)(F.ws + WS_WKV);
    unsigned char* aux = a.xb + nt_ * 2048;
    bf16* KP = (bf16*)(aux + nt_ * AUX_KP); bf16* VV = (bf16*)(aux + nt_ * AUX_VV); bf16* KIN = (bf16*)(aux + nt_ * AUX_KIN);
    const float* g_q = a.in[5]; const float* g_k = a.in[6]; const float* g_ki = a.in[7];
    constexpr int WP = 528;
    LAS unsigned char* Wl = F.lds + RING_OFF; LAS float* gl = (LAS float*)(F.lds + RING_OFF + 256 * WP);
    for (int i = F.tid; i < 256 * 32; i += NWAVES * 64) { const int n = i >> 5, ch = i & 31; *(LAS v4u*)(Wl + n * WP + ch * 16) = *(const v4u*)(Wkv_t + (size_t)n * 256 + ch * 8); }
    if (F.tid < 128) gl[F.tid] = g_k[F.tid] * g_q[F.tid] * (0.08838834764831845f * 1.4426950408889634f);
    else if (F.tid < 192) gl[F.tid] = g_ki[F.tid - 128];
    __syncthreads();
    const int ntask = 2 * (F.ntok / 32);
    for (int task = gw; task < ntask; task += NGW) {
        const int kind = task & 1, t0 = (task >> 1) * 32;
        const unsigned char* crowp = (const unsigned char*)CKV + (size_t)(t0 + r32) * 256 + hi * 8;
        bf16x8_t bfr[16]; float ss = 0.f;
#pragma unroll
        for (int kk = 0; kk < 16; ++kk) { const unsigned long long c8 = *(const unsigned long long*)(crowp + kk * 16); const int lo = (int)(unsigned)c8, hi32 = (int)(unsigned)(c8 >> 32);
            const auto a_ = __builtin_amdgcn_cvt_pk_f32_fp8(lo, false), b_ = __builtin_amdgcn_cvt_pk_f32_fp8(lo, true), c_ = __builtin_amdgcn_cvt_pk_f32_fp8(hi32, false), d_ = __builtin_amdgcn_cvt_pk_f32_fp8(hi32, true);
            ss += (a_[0] * a_[0] + a_[1] * a_[1]) + (b_[0] * b_[0] + b_[1] * b_[1]) + (c_[0] * c_[0] + c_[1] * c_[1]) + (d_[0] * d_[0] + d_[1] * d_[1]);
            v4u pk; pk.x = pk2(a_[0], a_[1]); pk.y = pk2(b_[0], b_[1]); pk.z = pk2(c_[0], c_[1]); pk.w = pk2(d_[0], d_[1]); bfr[kk] = __builtin_bit_cast(bf16x8_t, pk); }
        ss = xhalf_sum(ss);
        const float rstd = rsqrtf(ss * (1.f / 256.f) + EPS);
        f32x16 acc[4];
#pragma unroll
        for (int nt = 0; nt < 4; ++nt) { acc[nt] = f32x16{};
            const LAS unsigned char* wrow = Wl + (kind * 128 + nt * 32 + r32) * WP + hi * 16;
#pragma unroll
            for (int kk = 0; kk < 16; ++kk) { const bf16x8_t af = *(const LAS bf16x8_t*)(wrow + kk * 32); acc[nt] = __builtin_amdgcn_mfma_f32_32x32x16_bf16(af, bfr[kk], acc[nt], 0, 0, 0); if ((kk & 3) == 3) __builtin_amdgcn_sched_barrier(0); } }
        float sc = rstd;
        if (kind == 0) { float sk = 0.f;
#pragma unroll
            for (int nt = 0; nt < 4; ++nt)
#pragma unroll
                for (int r = 0; r < 16; ++r) { const float v = acc[nt][r] * rstd; sk += v * v; }
            sk = xhalf_sum(sk);
            sc = rstd * rsqrtf(sk * (1.f / 128.f) + EPS); }
        bf16* orow = (kind == 0 ? KP : VV) + (size_t)(t0 + r32) * 128;
#pragma unroll
        for (int nt = 0; nt < 4; ++nt)
#pragma unroll
            for (int g = 0; g < 4; ++g) { const int ch = nt * 32 + 8 * g + 4 * hi; float v[4];
#pragma unroll
                for (int j = 0; j < 4; ++j) { v[j] = acc[nt][4 * g + j] * sc; if (kind == 0) v[j] *= gl[ch + j]; }
                *(unsigned long long*)(orow + ch) = (unsigned long long)pk2(v[0], v[1]) | ((unsigned long long)pk2(v[2], v[3]) << 32); }
        if (kind == 0) {
            const bf16* kr = KW + (size_t)(t0 + r32) * 128 + hi * 32; bf16x8_t kv4[4]; float s2 = 0.f;
#pragma unroll
            for (int j = 0; j < 4; ++j) { kv4[j] = *(const bf16x8_t*)(kr + 8 * j); s2 += sumsq8(kv4[j]); }
            s2 = xhalf_sum(s2);
            const float rk = rsqrtf(s2 * (1.f / 64.f) + EPS);
            bf16* ko = KIN + (size_t)(t0 + r32) * 64 + hi * 32;
#pragma unroll
            for (int j = 0; j < 4; ++j) { float f[8];
#pragma unroll
                for (int e = 0; e < 8; ++e) f[e] = __uint_as_float((unsigned)(unsigned short)kv4[j][e] << 16) * rk * gl[128 + hi * 32 + 8 * j + e];
                v4u o; o.x = pk2(f[0], f[1]); o.y = pk2(f[2], f[3]); o.z = pk2(f[4], f[5]); o.w = pk2(f[6], f[7]);
                *(v4u*)(ko + 8 * j) = o; }
        }
    }
    __syncthreads();
}

typedef float f32x4_t __attribute__((ext_vector_type(4)));
__device__ __forceinline__ unsigned key15_of(float s) { const unsigned short hb = __builtin_bit_cast(unsigned short, (_Float16)s); const unsigned u = (hb & 0x8000u) ? (~(unsigned)hb & 0xffffu) : ((unsigned)hb | 0x8000u); return u >> 1; }
__device__ __forceinline__ unsigned sad4(unsigned x) { return __builtin_amdgcn_sad_u8(x, 0u, 0u); }
__device__ __forceinline__ void p3_merge(LAS unsigned* hist, LAS unsigned short* tot, int w, int g, int q, int& need, int& bsel) {
    __syncthreads();
    const int o = 4 * w + g; unsigned c = 0;
#pragma unroll
    for (int p = 0; p < 32; ++p) { const int tidp = (p >> 2) * 64 + (p & 3) * 16 + q; c += (hist[(o >> 2) * 512 + tidp] >> (8 * (o & 3))) & 0xffu; }
    tot[q * 32 + o] = (unsigned short)c;
    __syncthreads();
    v4u tv[4];
#pragma unroll
    for (int j = 0; j < 4; ++j) tv[j] = *(const LAS v4u*)((const LAS unsigned char*)tot + q * 64 + j * 16);
    int cum = 0, bs = 0, ab = 0; bool found = false;
#pragma unroll
    for (int bin = 31; bin >= 0; --bin) { const unsigned wd = tv[bin >> 3][(bin >> 1) & 3]; const int cc = (int)((bin & 1) ? (wd >> 16) : (wd & 0xffffu));
        if (!found && cum + cc >= need) { bs = bin; ab = cum; found = true; } cum += cc; }
    bsel = bs; need -= ab;
}
__device__ __forceinline__ void p3_index(Frame& F, const Args& a) {
    const int tid = F.tid, lane = F.lane, w = F.wave, q = lane & 15, g = lane >> 4;
    LAS unsigned* keys = (LAS unsigned*)(F.lds + RING_OFF);
    LAS unsigned char* qbuf = F.lds + 65536;
    LAS unsigned* hist = (LAS unsigned*)(F.lds + P3_HIST_OFF);
    LAS unsigned short* tot = (LAS unsigned short*)(F.lds + P3_TOT_OFF);
    LAS unsigned char* Tt = (LAS unsigned char*)(F.lds + P3_T_OFF);
    const size_t nt_ = (size_t)F.ntok;
    const bf16* QI = (const bf16*)(F.act + nt_ * O_QI); const bf16* KW = (const bf16*)(F.act + nt_ * O_KW);
    unsigned char* aux = a.xb + nt_ * 2048;
    const bf16* KIN = (const bf16*)(aux + nt_ * AUX_KIN); unsigned* MASK = (unsigned*)(aux + nt_ * AUX_MASK);
    const int nb = F.ntok / SEQ, nitems = nb * 128; const int bxj = (int)blockIdx.x >> 3;
    const int G = F.G - F.G / 4, c = (bxj - (bxj >> 2) - 1) * 8 + ((int)blockIdx.x & 7);
#define P3_ITEM(k) ((k) * G + (((k) & 1) ? (G - 1 - c) : c))
#define P3_QDMA(it_, buf_) do { const int qg_ = 127 - (it_) / nb, b_ = (it_) % nb; _Pragma("unroll") for (int i_ = 0; i_ < 2; ++i_) { const int row_ = w * 2 + i_; \
        const char* src_ = (const char*)(QI + ((size_t)b_ * SEQ + qg_ * 16 + row_) * 512) + ((lane ^ (row_ & 15)) * 16); \
        __builtin_amdgcn_global_load_lds((const unsigned*)src_, (LAS unsigned*)(qbuf + (buf_) * 16384 + row_ * 1024), 16, 0, 0); } } while (0)
    const int nround = (nitems + G - 1) / G;
    if (P3_ITEM(0) < nitems) P3_QDMA(P3_ITEM(0), 0);
    v4u wvn = (v4u){0u, 0u, 0u, 0u};
    if (P3_ITEM(0) < nitems) { const int it0 = P3_ITEM(0); wvn = *(const v4u*)(KW + ((size_t)(it0 % nb) * SEQ + (127 - it0 / nb) * 16 + q) * 128 + 64); }
    for (int k = 0; k < nround; ++k) {
        const int it = P3_ITEM(k); if (it >= nitems) break;
        const int qg = 127 - it / nb, b = it % nb, q0 = qg * 16, qme = q0 + q;
        unsigned* Mb = MASK + (size_t)b * 64 * 2048;
        const int kb_hi = ((qg >> 3) + 1) << 2, nkb = (qg >> 1) + 1;
        asm volatile("s_waitcnt vmcnt(0) lgkmcnt(0)\n\ts_barrier" ::: "memory");
        const v4u wv = wvn;
        { const int itn = P3_ITEM(k + 1); if (k + 1 < nround && itn < nitems) { P3_QDMA(itn, (k + 1) & 1); wvn = *(const v4u*)(KW + ((size_t)(itn % nb) * SEQ + (127 - itn / nb) * 16 + q) * 128 + 64); } }
        if (qg < 16) {
            if (tid < kb_hi * 16) { const int kb = tid >> 4, qq = q0 + (tid & 15), nbits = qq - kb * 32 + 1; Mb[kb * 2048 + qq] = nbits >= 32 ? 0xffffffffu : (nbits <= 0 ? 0u : ((1u << nbits) - 1u)); }
            continue;
        }
        float wq[8];
        { const float cc = 0.35355339059327373f * 0.125f;
          wq[0] = pg8::bf_lo(wv.x) * cc; wq[1] = pg8::bf_hi(wv.x) * cc; wq[2] = pg8::bf_lo(wv.y) * cc; wq[3] = pg8::bf_hi(wv.y) * cc; wq[4] = pg8::bf_lo(wv.z) * cc; wq[5] = pg8::bf_hi(wv.z) * cc; wq[6] = pg8::bf_lo(wv.w) * cc; wq[7] = pg8::bf_hi(wv.w) * cc; }
        bf16x8_t qfr[8][2], qlin[2];
        { const LAS unsigned char* qrow = qbuf + (k & 1) * 16384 + q * 1024;
#pragma unroll
          for (int h = 0; h < 8; ++h)
#pragma unroll
            for (int ks = 0; ks < 2; ++ks) qfr[h][ks] = *(const LAS bf16x8_t*)(qrow + (((h * 8 + ks * 4 + g) ^ q) * 16)); }
#pragma unroll
        for (int ks = 0; ks < 2; ++ks) { float f[8];
#pragma unroll
            for (int j = 0; j < 8; ++j) { float s = 0.f;
#pragma unroll
                for (int h = 0; h < 8; ++h) s += wq[h] * __uint_as_float((unsigned)(unsigned short)qfr[h][ks][j] << 16);
                f[j] = s; }
            v4u o; o.x = pk2(f[0], f[1]); o.y = pk2(f[2], f[3]); o.z = pk2(f[4], f[5]); o.w = pk2(f[6], f[7]); qlin[ks] = __builtin_bit_cast(bf16x8_t, o); }
#pragma unroll
        for (int i = 0; i < 8; ++i) hist[i * 512 + tid] = 0u;
        const bf16* kbase = KIN + ((size_t)b * SEQ + q) * 64 + g * 8;
        bf16x8_t afr[2][2], afn[2][2];
#pragma unroll
        for (int t = 0; t < 2; ++t)
#pragma unroll
            for (int ks = 0; ks < 2; ++ks) afn[t][ks] = *(const bf16x8_t*)(kbase + (size_t)(w * 32 + t * 16) * 64 + ks * 32);
        for (int s = 0, kb = w; kb < nkb; ++s, kb += 8) {
            const bool diag = (kb == nkb - 1);
#pragma unroll
            for (int t = 0; t < 2; ++t)
#pragma unroll
                for (int ks = 0; ks < 2; ++ks) afr[t][ks] = afn[t][ks];
            if (kb + 8 < nkb) {
#pragma unroll
                for (int t = 0; t < 2; ++t)
#pragma unroll
                    for (int ks = 0; ks < 2; ++ks) afn[t][ks] = *(const bf16x8_t*)(kbase + (size_t)((kb + 8) * 32 + t * 16) * 64 + ks * 32); }
#pragma unroll
            for (int t = 0; t < 2; ++t) {
                f32x4_t sacc = f32x4_t{};
#pragma unroll
                for (int ks = 0; ks < 2; ++ks) sacc = __builtin_amdgcn_mfma_f32_16x16x32_bf16(afr[t][ks], qlin[ks], sacc, 0, 0, 0);
#pragma unroll
                for (int h = 0; h < 8; ++h) { f32x4_t d = f32x4_t{};
#pragma unroll
                    for (int ks = 0; ks < 2; ++ks) d = __builtin_amdgcn_mfma_f32_16x16x32_bf16(afr[t][ks], qfr[h][ks], d, 0, 0, 0);
#pragma unroll
                    for (int r = 0; r < 4; ++r) sacc[r] = fmaf(fabsf(d[r]), wq[h], sacc[r]); }
#pragma unroll
                for (int i = 0; i < 2; ++i) { unsigned k2[2];
#pragma unroll
                    for (int e = 0; e < 2; ++e) { const int r = 2 * i + e; unsigned kk_ = key15_of(sacc[r]); if (diag && kb * 32 + t * 16 + 4 * g + r > qme) kk_ = 0u; k2[e] = kk_;
                        const unsigned dg = kk_ >> 10; (void)__hip_atomic_fetch_add((LAS unsigned*)&hist[(dg >> 2) * 512 + tid], 1u << ((dg & 3u) * 8u), __ATOMIC_RELAXED, __HIP_MEMORY_SCOPE_WORKGROUP); }
                    keys[(s * 4 + t * 2 + i) * 512 + tid] = k2[0] | (k2[1] << 16); }
            }
        }
        int need = 256, bsel;
        p3_merge(hist, tot, w, g, q, need, bsel);
        unsigned prefix = (unsigned)bsel;
#pragma unroll
        for (int pass = 0; pass < 2; ++pass) {
            const int sh_hi = pass == 0 ? 10 : 5, sh = pass == 0 ? 5 : 0;
#pragma unroll
            for (int i = 0; i < 8; ++i) hist[i * 512 + tid] = 0u;
#pragma unroll
            for (int s = 0; s < 8; ++s) if (w + 8 * s < nkb) {
#pragma unroll
                for (int i = 0; i < 4; ++i) { const unsigned d2 = keys[(s * 4 + i) * 512 + tid];
#pragma unroll
                    for (int e = 0; e < 2; ++e) { const unsigned kk_ = e ? (d2 >> 16) : (d2 & 0xffffu);
                        if ((kk_ >> sh_hi) == prefix) { const unsigned dg = (kk_ >> sh) & 31u; (void)__hip_atomic_fetch_add((LAS unsigned*)&hist[(dg >> 2) * 512 + tid], 1u << ((dg & 3u) * 8u), __ATOMIC_RELAXED, __HIP_MEMORY_SCOPE_WORKGROUP); } } } }
            p3_merge(hist, tot, w, g, q, need, bsel);
            prefix = (prefix << 5) | (unsigned)bsel;
        }
        const unsigned tau = prefix; const int need_eq = need;
        unsigned gtw[8], eqw[8];
#pragma unroll
        for (int s = 0; s < 8; ++s) { const int kb = w + 8 * s; gtw[s] = 0u; eqw[s] = 0u;
            if (kb < nkb) { unsigned gg = 0u, qq = 0u;
#pragma unroll
                for (int i = 0; i < 4; ++i) { const unsigned d2 = keys[(s * 4 + i) * 512 + tid];
#pragma unroll
                    for (int e = 0; e < 2; ++e) { const unsigned kk_ = e ? (d2 >> 16) : (d2 & 0xffffu); const int bit = (i >> 1) * 16 + 4 * g + (i & 1) * 2 + e;
                        gg |= (kk_ > tau ? 1u : 0u) << bit; qq |= (kk_ == tau ? 1u : 0u) << bit; } }
                gg |= (unsigned)__shfl_xor((int)gg, 16); gg |= (unsigned)__shfl_xor((int)gg, 32); qq |= (unsigned)__shfl_xor((int)qq, 16); qq |= (unsigned)__shfl_xor((int)qq, 32);
                gtw[s] = gg; eqw[s] = qq;
                if (g == 0) Tt[q * 64 + kb] = (unsigned char)__builtin_popcount(qq); } }
        __syncthreads();
        { unsigned run = 0u;
#pragma unroll
          for (int s = 0; s < 8; ++s) { const int kb = w + 8 * s;
            if (kb < nkb) { const unsigned g0 = *(const LAS unsigned*)(Tt + q * 64 + 8 * s), g1 = *(const LAS unsigned*)(Tt + q * 64 + 8 * s + 4);
                const unsigned m0 = w >= 4 ? g0 : (w == 0 ? 0u : (g0 & ((1u << (8 * w)) - 1u))), m1 = w > 4 ? (g1 & ((1u << (8 * (w - 4))) - 1u)) : 0u;
                const int pre = (int)(run + sad4(m0) + sad4(m1)), m = need_eq - pre, pc = __builtin_popcount(eqw[s]);
                unsigned se = eqw[s];
                if (m < pc) { se = 0u; unsigned x = eqw[s]; for (int i = 0; i < m; ++i) { const unsigned bb = x & (0u - x); se |= bb; x ^= bb; } }
                if (g == 0) Mb[kb * 2048 + qme] = gtw[s] | se;
                run += sad4(g0) + sad4(g1); } } }
        if (tid < (kb_hi - nkb) * 16) Mb[(nkb + (tid >> 4)) * 2048 + q0 + (tid & 15)] = 0u;
    }
    asm volatile("s_waitcnt vmcnt(0) lgkmcnt(0)" ::: "memory");
    __syncthreads();
#undef P3_ITEM
#undef P3_QDMA
}

namespace att {
using bf16x8 = __attribute__((ext_vector_type(8))) short;
using s16x4  = __attribute__((ext_vector_type(4))) short;
using u32x4  = __attribute__((ext_vector_type(4))) unsigned;
constexpr int KVBLK = 64;
constexpr size_t SHM_V = KVBLK * 128 * 2, SHM_K = KVBLK * 128 * 2;
constexpr int OFF_WS = 65536, OFF_MK = 65536 + 2048, OFF_Q = 65536 + 2048 + 8192, QPITCH = 272;
constexpr float THR2 = 11.5f;
#define KSWZ(row, colB) ((row) * 256 + ((colB) ^ (((row) & 7) << 4)))
#define SBAR() __builtin_amdgcn_sched_barrier(0)
__device__ __forceinline__ unsigned cvtpk(float lo, float hi) { unsigned r; asm volatile("v_cvt_pk_bf16_f32 %0, %1, %2" : "=v"(r) : "v"(lo), "v"(hi)); return r; }
__device__ __forceinline__ float msk(float p, unsigned w, int bit) { const int m = __builtin_amdgcn_sbfe((int)w, bit, 1); return __uint_as_float((__float_as_uint(p) & (unsigned)m) | (0xff800000u & ~(unsigned)m)); }
__device__ __forceinline__ void partialSM(f32x16& p0, f32x16& p1, unsigned w0, unsigned w1, float& m_reg, float& mn, float& alpha) {
#pragma unroll
  for (int r = 0; r < 16; ++r) { const int bit = (r & 3) + 8 * (r >> 2); p0[r] = msk(p0[r], w0, bit); p1[r] = msk(p1[r], w1, bit); }
  float pmax = p0[0];
#pragma unroll
  for (int r = 1; r < 16; ++r) pmax = fmaxf(pmax, p0[r]);
#pragma unroll
  for (int r = 0; r < 16; ++r) pmax = fmaxf(pmax, p1[r]);
  { auto rr = __builtin_amdgcn_permlane32_swap(__float_as_uint(pmax), __float_as_uint(pmax), false, false); pmax = fmaxf(__uint_as_float(rr[0]), __uint_as_float(rr[1])); }
  if (__builtin_expect(__all(pmax - m_reg <= THR2), 1)) { mn = m_reg; alpha = 1.f; }
  else { mn = fmaxf(m_reg, pmax); alpha = __builtin_amdgcn_exp2f(m_reg - mn); m_reg = mn; }
#pragma unroll
  for (int r = 0; r < 16; ++r) { p0[r] -= mn; p1[r] -= mn; }
#pragma unroll
  for (int r = 0; r < 16; ++r) p0[r] = __builtin_amdgcn_exp2f(p0[r]);
}
__device__ __forceinline__ void finishSM(f32x16& p0, f32x16& p1, float alpha, float& l_reg, bf16x8& pa0, bf16x8& pa1, bf16x8& pa2, bf16x8& pa3) {
#pragma unroll
  for (int r = 0; r < 16; ++r) p1[r] = __builtin_amdgcn_exp2f(p1[r]);
  float ps = 0;
#pragma unroll
  for (int r = 0; r < 16; ++r) ps += p0[r];
#pragma unroll
  for (int r = 0; r < 16; ++r) ps += p1[r];
  { auto rr = __builtin_amdgcn_permlane32_swap(__float_as_uint(ps), __float_as_uint(ps), false, false); ps = __uint_as_float(rr[0]) + __uint_as_float(rr[1]); }
  l_reg = l_reg * alpha + ps;
#define PK4(P, BASE, OUT) do { unsigned a0 = cvtpk(P[BASE + 0], P[BASE + 1]), a1 = cvtpk(P[BASE + 2], P[BASE + 3]);   \
    unsigned b0 = cvtpk(P[BASE + 4], P[BASE + 5]), b1 = cvtpk(P[BASE + 6], P[BASE + 7]);                              \
    auto r0 = __builtin_amdgcn_permlane32_swap(a0, b0, false, false); auto r1 = __builtin_amdgcn_permlane32_swap(a1, b1, false, false); \
    u32x4 w = {r0[0], r1[0], r0[1], r1[1]}; OUT = *reinterpret_cast<bf16x8*>(&w); } while (0)
  PK4(p0, 0, pa0); PK4(p0, 8, pa1); PK4(p1, 0, pa2); PK4(p1, 8, pa3);
#undef PK4
}
__device__ __forceinline__ void qkt(f32x16& p0, f32x16& p1, const char* Ks, const char* qrow, const float (&bo)[16], float kb0, float kb1, int r32, int hi) {
#pragma unroll
  for (int r = 0; r < 16; ++r) { p0[r] = bo[r] + kb0; p1[r] = bo[r] + kb1; }
#pragma unroll
  for (int d0 = 0; d0 < 8; ++d0) { const int cb = (d0 * 16 + hi * 8) * 2;
    const bf16x8 b0 = *reinterpret_cast<const bf16x8*>(Ks + KSWZ(r32, cb));
    const bf16x8 b1 = *reinterpret_cast<const bf16x8*>(Ks + KSWZ(32 + r32, cb));
    const bf16x8 qf = *reinterpret_cast<const bf16x8*>(qrow + d0 * 32);
    p0 = __builtin_amdgcn_mfma_f32_32x32x16_bf16(b0, qf, p0, 0, 0, 0);
    p1 = __builtin_amdgcn_mfma_f32_32x32x16_bf16(b1, qf, p1, 0, 0, 0); }
}
__device__ __forceinline__ int v_st(int k, int c) { const int kk = (k & ~0xC) | ((k & 4) << 1) | ((k & 8) >> 1); return ((kk >> 3) * 4 + (c >> 5)) * 512 + ((kk & 7) * 32 + (c & 31)) * 2; }
__device__ __forceinline__ int v_rd_base(int lane) { return ((lane & 3) << 3) | (((lane >> 2) & 3) << 6) | (((lane >> 4) & 1) << 5) | (((lane >> 5) & 1) << 8); }
constexpr int v_rd_off(int d0, int ks, int half) { return d0 * 512 + ks * 4096 + half * 2048; }
template <int OFF> __device__ __forceinline__ s16x4 tr_read(int vb) { s16x4 r; asm volatile("ds_read_b64_tr_b16 %0, %1 offset:%2" : "=&v"(r) : "v"(vb), "i"(OFF) : "memory"); return r; }
template <int D0> __device__ __forceinline__ void pv_one(f32x16& od, int vb, bf16x8 pa0, bf16x8 pa1, bf16x8 pa2, bf16x8 pa3) {
  const s16x4 l0 = tr_read<v_rd_off(D0, 0, 0)>(vb), h0 = tr_read<v_rd_off(D0, 0, 1)>(vb), l1 = tr_read<v_rd_off(D0, 1, 0)>(vb), h1 = tr_read<v_rd_off(D0, 1, 1)>(vb);
  const s16x4 l2 = tr_read<v_rd_off(D0, 2, 0)>(vb), h2 = tr_read<v_rd_off(D0, 2, 1)>(vb), l3 = tr_read<v_rd_off(D0, 3, 0)>(vb), h3 = tr_read<v_rd_off(D0, 3, 1)>(vb);
  asm volatile("s_waitcnt lgkmcnt(0)" ::: "memory"); SBAR();
#define PK(L, H) (bf16x8){L[0], L[1], L[2], L[3], H[0], H[1], H[2], H[3]}
  od = __builtin_amdgcn_mfma_f32_32x32x16_bf16(pa0, PK(l0, h0), od, 0, 0, 0);
  od = __builtin_amdgcn_mfma_f32_32x32x16_bf16(pa1, PK(l1, h1), od, 0, 0, 0);
  od = __builtin_amdgcn_mfma_f32_32x32x16_bf16(pa2, PK(l2, h2), od, 0, 0, 0);
  od = __builtin_amdgcn_mfma_f32_32x32x16_bf16(pa3, PK(l3, h3), od, 0, 0, 0);
#undef PK
}
__device__ __forceinline__ void pv_d0(f32x16* o, int vb, bf16x8 pa0, bf16x8 pa1, bf16x8 pa2, bf16x8 pa3) {
  pv_one<0>(o[0], vb, pa0, pa1, pa2, pa3); pv_one<1>(o[1], vb, pa0, pa1, pa2, pa3); pv_one<2>(o[2], vb, pa0, pa1, pa2, pa3); pv_one<3>(o[3], vb, pa0, pa1, pa2, pa3);
}
__device__ __forceinline__ void attn_item(const bf16* __restrict__ Qb, const bf16* __restrict__ Kh, const bf16* __restrict__ Vh, const unsigned* __restrict__ Mq, bf16* __restrict__ Ob, int NT, char* lds, LAS unsigned char* ldsL) {
  const int tid = threadIdx.x, wid = __builtin_amdgcn_readfirstlane(tid >> 6), lane = tid & 63, r32 = lane & 31, hi = lane >> 5;
  float* ws = (float*)(lds + OFF_WS) + wid * 64; float* li_l = ws; float* al_l = ws + 32;
  unsigned* mk = (unsigned*)(lds + OFF_MK);
  unsigned soff[4];
#pragma unroll
  for (int i = 0; i < 4; ++i) { const int pc = (wid & 3) * 4 + i;
    if (wid < 4) { const int row = pc * 4 + (lane >> 4), cb = (lane & 15) * 16; soff[i] = (unsigned)(row * 256 + (cb ^ ((row & 7) << 4))); }
    else { const int L = pc * 1024 + lane * 16, st = L >> 9, wi = L & 511, kk = (st >> 2) * 8 + (wi >> 6), c = (st & 3) * 32 + ((wi & 63) >> 1), k = (kk & ~0xC) | ((kk & 4) << 1) | ((kk & 8) >> 1);
           soff[i] = (unsigned)(k * 256 + c * 2); } }
  const char* gsrc = (const char*)(wid < 4 ? Kh : Vh);
  const unsigned ldst = (unsigned)((wid < 4 ? 0 : 16384) + (wid & 3) * 4096);
#define DMA_TILE(t, slot) do { _Pragma("unroll") for (int i_ = 0; i_ < 4; ++i_) \
    __builtin_amdgcn_global_load_lds((const unsigned*)(gsrc + (size_t)(t) * (64 * 256) + soff[i_]), (LAS unsigned*)(ldsL + (slot) * 32768 + ldst + i_ * 1024), 16, 0, 0); } while (0)
  DMA_TILE(0, 0);
  float m_reg = 0.f, l_reg = 0; f32x16 o[4] = {}; bf16x8 qr[8];
  { const unsigned char* Qw = (const unsigned char*)Qb + (size_t)r32 * 1024 + wid * 128 + hi * 8; float ss = 0.f; unsigned long long q8[8];
#pragma unroll
    for (int d0 = 0; d0 < 8; ++d0) q8[d0] = *reinterpret_cast<const unsigned long long*>(Qw + d0 * 16);
    unsigned mv[4];
#pragma unroll
    for (int i = 0; i < 4; ++i) { const int idx = tid + 512 * i; mv[i] = idx < NT * 64 ? Mq[(size_t)(idx >> 5) * 2048 + (idx & 31)] : 0u; }
#pragma unroll
    for (int i = 0; i < 4; ++i) { const int idx = tid + 512 * i; if (idx < NT * 64) mk[idx] = mv[i]; }
    float qf[8][8];
#pragma unroll
    for (int d0 = 0; d0 < 8; ++d0) { const int lo = (int)(unsigned)q8[d0], hi32 = (int)(unsigned)(q8[d0] >> 32);
      const auto a_ = __builtin_amdgcn_cvt_pk_f32_fp8(lo, false), b_ = __builtin_amdgcn_cvt_pk_f32_fp8(lo, true), c_ = __builtin_amdgcn_cvt_pk_f32_fp8(hi32, false), d_ = __builtin_amdgcn_cvt_pk_f32_fp8(hi32, true);
      qf[d0][0] = a_[0]; qf[d0][1] = a_[1]; qf[d0][2] = b_[0]; qf[d0][3] = b_[1]; qf[d0][4] = c_[0]; qf[d0][5] = c_[1]; qf[d0][6] = d_[0]; qf[d0][7] = d_[1];
#pragma unroll
      for (int j = 0; j < 8; ++j) ss += qf[d0][j] * qf[d0][j]; }
    ss = xhalf_sum(ss); const float rq = rsqrtf(ss * (1.f / 128.f) + EPS);
#pragma unroll
    for (int d0 = 0; d0 < 8; ++d0) { u32x4 w = {cvtpk(qf[d0][0] * rq, qf[d0][1] * rq), cvtpk(qf[d0][2] * rq, qf[d0][3] * rq), cvtpk(qf[d0][4] * rq, qf[d0][5] * rq), cvtpk(qf[d0][6] * rq, qf[d0][7] * rq)}; qr[d0] = *reinterpret_cast<bf16x8*>(&w); } }
  const float slope2 = __builtin_amdgcn_exp2f(-(float)(wid + 1)) * 1.4426950408889634f;
  float bo[16];
#pragma unroll
  for (int r = 0; r < 16; ++r) bo[r] = __uint_as_float(__builtin_amdgcn_readfirstlane(__float_as_uint(slope2 * (float)((r & 3) + 8 * (r >> 2)))));
  const float hoff = slope2 * (float)(4 * hi);
  const int vb0 = (int)(uintptr_t)(lds + 16384) + v_rd_base(lane);
  asm volatile("s_waitcnt vmcnt(0) lgkmcnt(0)\n\ts_barrier" ::: "memory");
  for (int j = 0; j < NT; ++j) {
    const int sl = j & 1;
    if (j + 1 < NT) DMA_TILE(j + 1, sl ^ 1);
    const char* Ks = lds + sl * 32768;
    const unsigned w0 = mk[(2 * j) * 32 + r32] >> (4 * hi), w1 = mk[(2 * j + 1) * 32 + r32] >> (4 * hi);
    f32x16 p0, p1;
    { const float kb0 = slope2 * (float)(j * 64) + hoff - m_reg, kb1 = kb0 + slope2 * 32.f;
#pragma unroll
      for (int r = 0; r < 16; ++r) { p0[r] = bo[r] + kb0; p1[r] = bo[r] + kb1; }
      bf16x8 ka = *reinterpret_cast<const bf16x8*>(Ks + KSWZ(r32, hi * 16)), kb = *reinterpret_cast<const bf16x8*>(Ks + KSWZ(32 + r32, hi * 16));
#pragma unroll
      for (int d0 = 0; d0 < 8; ++d0) { bf16x8 na = ka, nb = kb;
        if (d0 < 7) { const int cb = ((d0 + 1) * 16 + hi * 8) * 2; na = *reinterpret_cast<const bf16x8*>(Ks + KSWZ(r32, cb)); nb = *reinterpret_cast<const bf16x8*>(Ks + KSWZ(32 + r32, cb)); }
        SBAR();
        p0 = __builtin_amdgcn_mfma_f32_32x32x16_bf16(ka, qr[d0], p0, 0, 0, 0);
        p1 = __builtin_amdgcn_mfma_f32_32x32x16_bf16(kb, qr[d0], p1, 0, 0, 0);
        SBAR();
        ka = na; kb = nb; } }
    float alpha; bf16x8 pa0, pa1, pa2, pa3;
    {
#pragma unroll
      for (int r = 0; r < 16; ++r) { const int bit = (r & 3) + 8 * (r >> 2); p0[r] = msk(p0[r], w0, bit); p1[r] = msk(p1[r], w1, bit); }
      float pmax = fmaxf(p0[0], p1[0]);
#pragma unroll
      for (int r = 1; r < 16; ++r) pmax = fmaxf(fmaxf(pmax, p0[r]), p1[r]);
      { auto rr = __builtin_amdgcn_permlane32_swap(__float_as_uint(pmax), __float_as_uint(pmax), false, false); pmax = fmaxf(__uint_as_float(rr[0]), __uint_as_float(rr[1])); }
      alpha = 1.f;
      if (__builtin_expect(!__all(pmax <= THR2), 0)) {
        const float dl = fmaxf(pmax, 0.f); m_reg += dl; alpha = __builtin_amdgcn_exp2f(-dl);
#pragma unroll
        for (int r = 0; r < 16; ++r) { p0[r] -= dl; p1[r] -= dl; } }
      float ps = 0.f;
#pragma unroll
      for (int r = 0; r < 16; ++r) { p0[r] = __builtin_amdgcn_exp2f(p0[r]); p1[r] = __builtin_amdgcn_exp2f(p1[r]); ps += p0[r] + p1[r]; }
      { auto rr = __builtin_amdgcn_permlane32_swap(__float_as_uint(ps), __float_as_uint(ps), false, false); ps = __uint_as_float(rr[0]) + __uint_as_float(rr[1]); }
      l_reg = l_reg * alpha + ps;
#define PK4(P, BASE, OUT) do { unsigned a0 = cvtpk(P[BASE + 0], P[BASE + 1]), a1 = cvtpk(P[BASE + 2], P[BASE + 3]);   \
    unsigned b0 = cvtpk(P[BASE + 4], P[BASE + 5]), b1 = cvtpk(P[BASE + 6], P[BASE + 7]);                              \
    auto r0 = __builtin_amdgcn_permlane32_swap(a0, b0, false, false); auto r1 = __builtin_amdgcn_permlane32_swap(a1, b1, false, false); \
    u32x4 w = {r0[0], r1[0], r0[1], r1[1]}; OUT = *reinterpret_cast<bf16x8*>(&w); } while (0)
      PK4(p0, 0, pa0); PK4(p0, 8, pa1); PK4(p1, 0, pa2); PK4(p1, 8, pa3);
#undef PK4
      if (__any(alpha < 1.f)) { if (hi == 0) al_l[r32] = alpha; asm volatile("s_waitcnt lgkmcnt(0)" ::: "memory");
#pragma unroll
        for (int d = 0; d < 4; ++d)
#pragma unroll
          for (int r = 0; r < 16; ++r) o[d][r] *= al_l[crow(r, hi)]; }
    }
    { const int vb = vb0 + sl * 32768;
      s16x4 lA[4], hA[4], lB[4], hB[4];
#define VREADS(L_, H_, D0) do { L_[0] = tr_read<v_rd_off(D0, 0, 0)>(vb); H_[0] = tr_read<v_rd_off(D0, 0, 1)>(vb); L_[1] = tr_read<v_rd_off(D0, 1, 0)>(vb); H_[1] = tr_read<v_rd_off(D0, 1, 1)>(vb); \
      L_[2] = tr_read<v_rd_off(D0, 2, 0)>(vb); H_[2] = tr_read<v_rd_off(D0, 2, 1)>(vb); L_[3] = tr_read<v_rd_off(D0, 3, 0)>(vb); H_[3] = tr_read<v_rd_off(D0, 3, 1)>(vb); } while (0)
#define PK(L, H) (bf16x8){L[0], L[1], L[2], L[3], H[0], H[1], H[2], H[3]}
#define VMMA(OD, L_, H_) do { OD = __builtin_amdgcn_mfma_f32_32x32x16_bf16(pa0, PK(L_[0], H_[0]), OD, 0, 0, 0); OD = __builtin_amdgcn_mfma_f32_32x32x16_bf16(pa1, PK(L_[1], H_[1]), OD, 0, 0, 0); \
      OD = __builtin_amdgcn_mfma_f32_32x32x16_bf16(pa2, PK(L_[2], H_[2]), OD, 0, 0, 0); OD = __builtin_amdgcn_mfma_f32_32x32x16_bf16(pa3, PK(L_[3], H_[3]), OD, 0, 0, 0); } while (0)
#define VWAIT(N, L_, H_) do { asm volatile("s_waitcnt lgkmcnt(" #N ")" : "+v"(L_[0]), "+v"(L_[1]), "+v"(L_[2]), "+v"(L_[3]), "+v"(H_[0]), "+v"(H_[1]), "+v"(H_[2]), "+v"(H_[3]) :: "memory"); SBAR(); } while (0)
      VREADS(lA, hA, 0); VREADS(lB, hB, 1);
      VWAIT(8, lA, hA); VMMA(o[0], lA, hA);
      VREADS(lA, hA, 2);
      VWAIT(8, lB, hB); VMMA(o[1], lB, hB);
      VREADS(lB, hB, 3);
      VWAIT(8, lA, hA); VMMA(o[2], lA, hA);
      VWAIT(0, lB, hB); VMMA(o[3], lB, hB);
#undef VREADS
#undef PK
#undef VMMA
#undef VWAIT
    }
    asm volatile("s_waitcnt vmcnt(0) lgkmcnt(0)\n\ts_barrier" ::: "memory");
  }
  if (hi == 0) li_l[r32] = l_reg; asm volatile("s_waitcnt lgkmcnt(0)" ::: "memory");
  float rli[16];
#pragma unroll
  for (int r = 0; r < 16; ++r) rli[r] = __builtin_amdgcn_rcpf(li_l[crow(r, hi)]);
  unsigned char* stg = (unsigned char*)(lds + wid * 4096);
#pragma unroll
  for (int r = 0; r < 16; ++r) { const int orow = crow(r, hi); const float sc16 = rli[r] * 16.f;
#pragma unroll
    for (int d0 = 0; d0 < 4; ++d0) stg[orow * 128 + d0 * 32 + r32] = (unsigned char)__builtin_amdgcn_cvt_pk_fp8_f32(o[d0][r] * sc16, 0.f, 0, false); }
  asm volatile("s_waitcnt lgkmcnt(0)" ::: "memory");
#pragma unroll
  for (int i = 0; i < 4; ++i) { const int row = i * 8 + (lane >> 3), ch = lane & 7; const u32x4 v = *(const u32x4*)(stg + row * 128 + ch * 16);
    *(u32x4*)((unsigned char*)Ob + (size_t)row * 1024 + wid * 128 + ch * 16) = v; }
#undef DMA_TILE
}
#undef KSWZ
#undef SBAR
}


namespace ret {
using bf16x8 = __attribute__((ext_vector_type(8))) short;
using s16x4  = __attribute__((ext_vector_type(4))) short;
using u32x4  = __attribute__((ext_vector_type(4))) unsigned;
using u32x2  = __attribute__((ext_vector_type(2))) unsigned;
constexpr int C = 64, QP = 272, KPI = 272, VP = 576;
constexpr int OFF_Q = 0, OFF_K = 17408, OFF_V = 34816, OFF_ST = 71680, OFF_Y = 75776;
typedef float f32x2_t __attribute__((ext_vector_type(2))); typedef __bf16 bf16x2_t __attribute__((ext_vector_type(2)));
__device__ __forceinline__ unsigned cvtpk(float lo, float hi) { const f32x2_t v = {lo, hi}; const bf16x2_t b = __builtin_convertvector(v, bf16x2_t); return __builtin_bit_cast(unsigned, b); }
template <int OFF> __device__ __forceinline__ s16x4 trr(int base) { s16x4 r; asm volatile("ds_read_b64_tr_b16 %0, %1 offset:%2" : "=&v"(r) : "v"(base), "i"(OFF) : "memory"); return r; }
__device__ __forceinline__ bf16x8 pk8(const f32x16& x, int s) { u32x4 w = {cvtpk(x[8 * s + 0], x[8 * s + 1]), cvtpk(x[8 * s + 2], x[8 * s + 3]), cvtpk(x[8 * s + 4], x[8 * s + 5]), cvtpk(x[8 * s + 6], x[8 * s + 7])}; return *reinterpret_cast<bf16x8*>(&w); }
__device__ __forceinline__ float silu_(float x) { return x * __builtin_amdgcn_rcpf(1.f + __builtin_amdgcn_exp2f(-1.4426950408889634f * x)); }
__device__ __forceinline__ void ret_item(int b, int h, const unsigned char* __restrict__ RQ, const unsigned char* __restrict__ RK, const unsigned char* __restrict__ RV, const unsigned char* __restrict__ RG, unsigned char* A2F8, const float* __restrict__ gnorm, char* lds, int c0, int c1, float* state) {
  const int tid = threadIdx.x, w = __builtin_amdgcn_readfirstlane(tid >> 6), lane = tid & 63, r32 = lane & 31, hi = lane >> 5;
  const float lg = __log2f(1.f - exp2f(-5.f - (float)h)), gC = exp2f(64.f * lg);
  char* Qs = lds + OFF_Q; char* Ks = lds + OFF_K; char* Vs = lds + OFF_V; float* st = (float*)(lds + OFF_ST); char* Ys = lds + OFF_Y;
  f32x16 S[4] = {};
  if (c0 > 0) {
#pragma unroll
    for (int dt = 0; dt < 4; ++dt)
#pragma unroll
      for (int r = 0; r < 16; ++r) S[dt][r] = state[(dt * 16 + r) * 512 + tid]; }
  const unsigned voffQ = (unsigned)(((tid >> 4) * 512 + (tid & 15) * 8) * 2), voffV = (unsigned)(((tid >> 5) * 1024 + (tid & 31) * 8) * 2);
  const int trq = (lane & 15) >> 2, trp = lane & 3, trg = (lane >> 4) & 1;
  const int vtb = (int)(uintptr_t)(lds + OFF_V) + (4 * hi + trq) * VP + (32 * w + 16 * trg + 4 * trp) * 2, ktb = (int)(uintptr_t)(lds + OFF_K) + (4 * hi + trq) * KPI + (16 * trg + 4 * trp) * 2;
  u32x2 pq[2], pk[2], pv[4];
  const unsigned voffQ8 = (unsigned)((tid >> 4) * 512 + (tid & 15) * 8), voffV8 = voffV >> 1;
#define RET_LOAD(cc) do { const size_t t0_ = (size_t)b * SEQ + (size_t)(cc) * C; const unsigned char* qb_ = RQ + t0_ * 512 + h * 128; const unsigned char* kb_ = RK + t0_ * 512 + h * 128; const unsigned char* vb_ = RV + t0_ * 1024 + h * 256; \
    _Pragma("unroll") for (int i = 0; i < 2; ++i) { pq[i] = *(const u32x2*)(qb_ + voffQ8 + i * 16384); pk[i] = *(const u32x2*)(kb_ + voffQ8 + i * 16384); } \
    _Pragma("unroll") for (int i = 0; i < 4; ++i) pv[i] = *(const u32x2*)(vb_ + voffV8 + i * 16384); } while (0)
#define RET_F8(src_, f_, out_) do { const auto a_ = __builtin_amdgcn_cvt_pk_f32_fp8((int)(src_).x, false), b_ = __builtin_amdgcn_cvt_pk_f32_fp8((int)(src_).x, true), c_ = __builtin_amdgcn_cvt_pk_f32_fp8((int)(src_).y, false), d_ = __builtin_amdgcn_cvt_pk_f32_fp8((int)(src_).y, true); \
    out_.x = cvtpk(a_[0] * (f_), a_[1] * (f_)); out_.y = cvtpk(b_[0] * (f_), b_[1] * (f_)); out_.z = cvtpk(c_[0] * (f_), c_[1] * (f_)); out_.w = cvtpk(d_[0] * (f_), d_[1] * (f_)); } while (0)
#define RET_STAGE() do { \
    _Pragma("unroll") for (int i = 0; i < 2; ++i) { const int row = (tid >> 4) + 32 * i, ch = tid & 15; \
      u32x4 qo; RET_F8(pq[i], 1.f, qo); *(u32x4*)(Qs + row * QP + ch * 16) = qo; \
      const float f = exp2f(lg * (float)(C - 1 - row)) * 0.08838834764831845f; \
      u32x4 ko; RET_F8(pk[i], f, ko); *(u32x4*)(Ks + row * KPI + ch * 16) = ko; } \
    _Pragma("unroll") for (int i = 0; i < 4; ++i) { const int row = (tid >> 5) + 16 * i, ch = tid & 31; u32x4 vo; RET_F8(pv[i], 1.f, vo); *(u32x4*)(Vs + row * VP + ch * 16) = vo; } } while (0)
  RET_LOAD(c0);
  __syncthreads();
  RET_STAGE();
  if (c0 + 1 < c1) RET_LOAD(c0 + 1);
  __syncthreads();
  for (int c = c0; c < c1; ++c) {
    const size_t tok0 = (size_t)b * SEQ + (size_t)c * C;
    f32x16 ot[2] = {};
#pragma unroll
    for (int dt = 0; dt < 4; ++dt) {
#pragma unroll
      for (int s = 0; s < 2; ++s) { const bf16x8 af = pk8(S[dt], s);
#pragma unroll
        for (int nt = 0; nt < 2; ++nt) { const char* qp = Qs + (32 * nt + r32) * QP + (32 * dt + 16 * s + 4 * hi) * 2;
          const u32x2 lo = *(const u32x2*)qp, hi8 = *(const u32x2*)(qp + 16); const u32x4 bw = {lo.x, lo.y, hi8.x, hi8.y};
          ot[nt] = __builtin_amdgcn_mfma_f32_32x32x16_bf16(af, *reinterpret_cast<const bf16x8*>(&bw), ot[nt], 0, 0, 0); } }
      __builtin_amdgcn_sched_barrier(0); }
#pragma unroll
    for (int nt = 0; nt < 2; ++nt)
#pragma unroll
      for (int r = 0; r < 16; ++r) ot[nt][r] *= gC;
    __builtin_amdgcn_sched_barrier(0);
    bf16x8 vfr[4];
    { s16x4 vlo[4], vhi[4];
      vlo[0] = trr<0 * 16 * VP>(vtb); vhi[0] = trr<0 * 16 * VP + 8 * VP>(vtb); vlo[1] = trr<1 * 16 * VP>(vtb); vhi[1] = trr<1 * 16 * VP + 8 * VP>(vtb);
      vlo[2] = trr<2 * 16 * VP>(vtb); vhi[2] = trr<2 * 16 * VP + 8 * VP>(vtb); vlo[3] = trr<3 * 16 * VP>(vtb); vhi[3] = trr<3 * 16 * VP + 8 * VP>(vtb);
      asm volatile("s_waitcnt lgkmcnt(0)" : "+v"(vlo[0]), "+v"(vlo[1]), "+v"(vlo[2]), "+v"(vlo[3]), "+v"(vhi[0]), "+v"(vhi[1]), "+v"(vhi[2]), "+v"(vhi[3]) :: "memory"); __builtin_amdgcn_sched_barrier(0);
#pragma unroll
      for (int ks = 0; ks < 4; ++ks) vfr[ks] = (bf16x8){vlo[ks][0], vlo[ks][1], vlo[ks][2], vlo[ks][3], vhi[ks][0], vhi[ks][1], vhi[ks][2], vhi[ks][3]}; }
#pragma unroll
    for (int nt = 0; nt < 2; ++nt)
#pragma unroll
      for (int jt = 0; jt <= nt; ++jt) { f32x16 pt = {};
#pragma unroll
        for (int kk = 0; kk < 8; ++kk) { const bf16x8 ka = *(const bf16x8*)(Ks + (32 * jt + r32) * KPI + (16 * kk + 8 * hi) * 2), qb = *(const bf16x8*)(Qs + (32 * nt + r32) * QP + (16 * kk + 8 * hi) * 2);
          pt = __builtin_amdgcn_mfma_f32_32x32x16_bf16(ka, qb, pt, 0, 0, 0); }
        if (jt == nt) {
#pragma unroll
          for (int r = 0; r < 16; ++r) if (crow(r, hi) > r32) pt[r] = 0.f; }
#pragma unroll
        for (int s = 0; s < 2; ++s) ot[nt] = __builtin_amdgcn_mfma_f32_32x32x16_bf16(vfr[2 * jt + s], pk8(pt, s), ot[nt], 0, 0, 0);
        __builtin_amdgcn_sched_barrier(0); }
#pragma unroll
    for (int dt = 0; dt < 4; ++dt) {
#pragma unroll
      for (int r = 0; r < 16; ++r) S[dt][r] *= gC;
      s16x4 kl[4], kh[4];
      kl[0] = trr<0 * 16 * KPI>(ktb + dt * 64); kh[0] = trr<0 * 16 * KPI + 8 * KPI>(ktb + dt * 64); kl[1] = trr<1 * 16 * KPI>(ktb + dt * 64); kh[1] = trr<1 * 16 * KPI + 8 * KPI>(ktb + dt * 64);
      kl[2] = trr<2 * 16 * KPI>(ktb + dt * 64); kh[2] = trr<2 * 16 * KPI + 8 * KPI>(ktb + dt * 64); kl[3] = trr<3 * 16 * KPI>(ktb + dt * 64); kh[3] = trr<3 * 16 * KPI + 8 * KPI>(ktb + dt * 64);
      asm volatile("s_waitcnt lgkmcnt(0)" : "+v"(kl[0]), "+v"(kl[1]), "+v"(kl[2]), "+v"(kl[3]), "+v"(kh[0]), "+v"(kh[1]), "+v"(kh[2]), "+v"(kh[3]) :: "memory"); __builtin_amdgcn_sched_barrier(0);
#pragma unroll
      for (int ks = 0; ks < 4; ++ks) S[dt] = __builtin_amdgcn_mfma_f32_32x32x16_bf16((bf16x8){kl[ks][0], kl[ks][1], kl[ks][2], kl[ks][3], kh[ks][0], kh[ks][1], kh[ks][2], kh[ks][3]}, vfr[ks], S[dt], 0, 0, 0);
      __builtin_amdgcn_sched_barrier(0); }
    u32x2 gt4[4];
    { const unsigned char* gb_ = RG + tok0 * 1024 + h * 256;
#pragma unroll
      for (int i = 0; i < 4; ++i) gt4[i] = *(const u32x2*)(gb_ + (voffV >> 1) + i * 16384); }
#pragma unroll
    for (int nt = 0; nt < 2; ++nt) { const float rs = exp2f(lg * (float)(32 * nt + r32 + 1 - C)); float s1 = 0.f, s2 = 0.f;
#pragma unroll
      for (int r = 0; r < 16; ++r) { ot[nt][r] *= rs; s1 += ot[nt][r]; s2 += ot[nt][r] * ot[nt][r]; }
      s1 = xhalf_sum(s1); s2 = xhalf_sum(s2);
      if (hi == 0) { st[(w * 64 + 32 * nt + r32) * 2] = s1; st[(w * 64 + 32 * nt + r32) * 2 + 1] = s2; } }
    __syncthreads();
    if (c + 1 < c1) { RET_STAGE(); if (c + 2 < c1) RET_LOAD(c + 2); }
#pragma unroll
    for (int nt = 0; nt < 2; ++nt) { float s1 = 0.f, s2 = 0.f;
#pragma unroll
      for (int ww = 0; ww < 8; ++ww) { s1 += st[(ww * 64 + 32 * nt + r32) * 2]; s2 += st[(ww * 64 + 32 * nt + r32) * 2 + 1]; }
      const float mu = s1 * (1.f / 256.f), var = fmaxf(s2 * (1.f / 256.f) - mu * mu, 0.f), rstd = rsqrtf(var + EPS);
#pragma unroll
      for (int g = 0; g < 4; ++g) { float y[4];
#pragma unroll
        for (int j = 0; j < 4; ++j) y[j] = (ot[nt][4 * g + j] - mu) * rstd * gnorm[h * 256 + 32 * w + 8 * g + 4 * hi + j];
        const u32x2 o2 = {cvtpk(y[0], y[1]), cvtpk(y[2], y[3])};
        *(u32x2*)(Ys + (32 * nt + r32) * VP + (32 * w + 8 * g + 4 * hi) * 2) = o2; } }
    __syncthreads();
    { unsigned char* ob_ = A2F8 + tok0 * 1024 + h * 256;
#pragma unroll
      for (int i = 0; i < 4; ++i) { const int row = (tid >> 5) + 16 * i, ch = tid & 31;
        const u32x4 yv = *(const u32x4*)(Ys + row * VP + ch * 16); const u32x2 gt = gt4[i];
        const auto g01 = __builtin_amdgcn_cvt_pk_f32_fp8((int)gt.x, false), g23 = __builtin_amdgcn_cvt_pk_f32_fp8((int)gt.x, true), g45 = __builtin_amdgcn_cvt_pk_f32_fp8((int)gt.y, false), g67 = __builtin_amdgcn_cvt_pk_f32_fp8((int)gt.y, true);
        int w0 = __builtin_amdgcn_cvt_pk_fp8_f32(pg8::bf_lo(yv.x) * silu_(g01[0]), pg8::bf_hi(yv.x) * silu_(g01[1]), 0, false); w0 = __builtin_amdgcn_cvt_pk_fp8_f32(pg8::bf_lo(yv.y) * silu_(g23[0]), pg8::bf_hi(yv.y) * silu_(g23[1]), w0, true);
        int w1 = __builtin_amdgcn_cvt_pk_fp8_f32(pg8::bf_lo(yv.z) * silu_(g45[0]), pg8::bf_hi(yv.z) * silu_(g45[1]), 0, false); w1 = __builtin_amdgcn_cvt_pk_fp8_f32(pg8::bf_lo(yv.w) * silu_(g67[0]), pg8::bf_hi(yv.w) * silu_(g67[1]), w1, true);
        *(unsigned long long*)(ob_ + (size_t)row * 1024 + ch * 8) = (unsigned long long)(unsigned)w0 | ((unsigned long long)(unsigned)w1 << 32); } }
  }
  if (c1 < SEQ / C) {
#pragma unroll
    for (int dt = 0; dt < 4; ++dt)
#pragma unroll
      for (int r = 0; r < 16; ++r) state[(dt * 16 + r) * 512 + tid] = S[dt][r]; }
  __syncthreads();
#undef RET_LOAD
#undef RET_STAGE
#undef RET_F8
}
}

#define A2F8_PTR (F.xbp + (size_t)16 * MiB)
constexpr int RET_SPLIT = 28;
__device__ __forceinline__ int ret_wg_index(const Frame& F) { const int bx = (int)blockIdx.x, j = bx >> 3; return (j & 3) == 0 ? ((j >> 2) * 8 + (bx & 7)) : -1; }
__device__ __forceinline__ void p4_attn(Frame& F, const Args& a, unsigned char* lds_generic) {
    const size_t nt_ = (size_t)F.ntok;
    const bf16* QA = (const bf16*)(F.act + nt_ * O_QA); bf16* ATT = (bf16*)(F.act + nt_ * O_QA);
    unsigned char* aux = a.xb + nt_ * 2048;
    const bf16* KP = (const bf16*)(aux + nt_ * AUX_KP); const bf16* VV = (const bf16*)(aux + nt_ * AUX_VV); const unsigned* MASK = (const unsigned*)(aux + nt_ * AUX_MASK);
    volatile LAS unsigned* MISC = (volatile LAS unsigned*)(F.lds + MISC_OFF);
    unsigned* qctr = (unsigned*)(F.ws + WS_CTL) + CW_Q4;
    const unsigned char* RQ = F.act + nt_ * O_RQ; const unsigned char* RK = F.act + nt_ * O_RK; const unsigned char* RV = F.act + nt_ * O_RV; const unsigned char* RG = F.act + nt_ * O_RG;
    const int nb = F.ntok / SEQ, nret = nb * 4, nitems = nb * 64;
    { const int ri = ret_wg_index(F); if (ri >= 0 && ri < nret && RET_SPLIT < SEQ / 64)
        ret::ret_item(ri >> 2, ri & 3, RQ, RK, RV, RG, A2F8_PTR, a.in[8], (char*)lds_generic, RET_SPLIT, SEQ / 64, (float*)a.xb + (size_t)ri * 32768); }
    __syncthreads(); if (F.tid == 0) MISC[0] = atomicAdd(qctr, 1u); __syncthreads();
    int it = (int)MISC[0];
    while (it < nitems) {
        unsigned nxt_ = 0u; if (F.tid == 0) nxt_ = atomicAdd(qctr, 1u);
        const int qb = 63 - it / nb, b = it % nb, NT = (qb >> 1) + 1;
        const size_t row0 = (size_t)b * SEQ + qb * 32;
        att::attn_item((const bf16*)((const unsigned char*)QA + row0 * 1024), KP + (size_t)b * SEQ * 128, VV + (size_t)b * SEQ * 128, MASK + (size_t)b * 64 * 2048 + qb * 32, (bf16*)((unsigned char*)ATT + row0 * 1024), NT, (char*)lds_generic, F.lds);
        __syncthreads(); if (F.tid == 0) MISC[0] = nxt_; __syncthreads();
        it = (int)MISC[0];
    }
}


__device__ __forceinline__ void p7_router(Frame& F, const Args& a) {
    const int lane = F.lane, r32 = lane & 31, hi = lane >> 5, tid = F.tid;
    unsigned char* mo = F.act; unsigned char* N2 = mo + MO_N2; unsigned char* meta = mo + MO_META;
    int* MB = (int*)(meta + MM_B); int* MPp = (int*)(meta + MM_P); float* MCL = (float*)(meta + MM_CL); float* MCH = (float*)(meta + MM_CH); float* MRS = (float*)(meta + MM_RS);
    const bf16* Wh = (const bf16*)(F.ws + WS_WR); const bf16* Wl = Wh + 32 * 1024;
    const float* g2 = a.in[12]; const float* b_gr = a.in[14]; const float* b_er = a.in[16];
    const bf16* hbase = (const bf16*)(F.act + MO_H16);
    unsigned* gcnt = (unsigned*)(F.ws + WS_CTL) + CW_MOE;
    LAS unsigned* lcnt = (LAS unsigned*)(F.lds + RING_OFF);
    if (tid < 64) lcnt[tid] = 0u;
    __syncthreads();
    const int ntasks = F.ntok / 32, tpw = ntasks / F.G;
    const int tw = F.wave & 3, kh = F.wave >> 2;
    const bool have = tw < tpw; const int t = (F.vcu * tpw + tw) * 32 + r32;
    LAS float* xch = (LAS float*)(F.lds + RING_OFF + 1024);
    int bucket = 0, posl = 0; float clo = 0.f, chi = 0.f, rstd = 0.f;
    f32x16 acc = f32x16{}; float ss = 0.f;
    if (have) {
        const bf16* hrow = hbase + (size_t)t * D + hi * 8 + kh * 512; unsigned char* nrow = N2 + (size_t)t * D + hi * 8 + kh * 512;
        const float* g2k = g2 + kh * 512 + hi * 8; const bf16* whk = Wh + (size_t)r32 * 1024 + kh * 512 + hi * 8; const bf16* wlk = Wl + (size_t)r32 * 1024 + kh * 512 + hi * 8;
#pragma unroll 8
        for (int kk = 0; kk < 32; ++kk) {
            const v4u hv = *(const v4u*)(hrow + kk * 16); const f32x4 a0 = {pg8::bf_lo(hv.x), pg8::bf_hi(hv.x), pg8::bf_lo(hv.y), pg8::bf_hi(hv.y)}, a1 = {pg8::bf_lo(hv.z), pg8::bf_hi(hv.z), pg8::bf_lo(hv.w), pg8::bf_hi(hv.w)};
            const f32x4 q0 = *(const f32x4*)(g2k + kk * 16), q1 = *(const f32x4*)(g2k + kk * 16 + 4);
            ss += (a0.x * a0.x + a0.y * a0.y) + (a0.z * a0.z + a0.w * a0.w) + (a1.x * a1.x + a1.y * a1.y) + (a1.z * a1.z + a1.w * a1.w);
            const float x[8] = {a0.x * q0.x, a0.y * q0.y, a0.z * q0.z, a0.w * q0.w, a1.x * q1.x, a1.y * q1.y, a1.z * q1.z, a1.w * q1.w};
            unsigned hb[8]; float lo[8];
#pragma unroll
            for (int j = 0; j < 8; ++j) { hb[j] = f2bf(x[j]); lo[j] = x[j] - __uint_as_float(hb[j] << 16); }
            v4u xh; xh.x = hb[0] | (hb[1] << 16); xh.y = hb[2] | (hb[3] << 16); xh.z = hb[4] | (hb[5] << 16); xh.w = hb[6] | (hb[7] << 16);
            v4u xl; xl.x = pk2(lo[0], lo[1]); xl.y = pk2(lo[2], lo[3]); xl.z = pk2(lo[4], lo[5]); xl.w = pk2(lo[6], lo[7]);
            { int w0 = __builtin_amdgcn_cvt_pk_fp8_f32(x[0], x[1], 0, false); w0 = __builtin_amdgcn_cvt_pk_fp8_f32(x[2], x[3], w0, true); int w1 = __builtin_amdgcn_cvt_pk_fp8_f32(x[4], x[5], 0, false); w1 = __builtin_amdgcn_cvt_pk_fp8_f32(x[6], x[7], w1, true);
              *(unsigned long long*)(nrow + kk * 16) = (unsigned long long)(unsigned)w0 | ((unsigned long long)(unsigned)w1 << 32); }
            const bf16x8_t wh = *(const bf16x8_t*)(whk + kk * 16), wl = *(const bf16x8_t*)(wlk + kk * 16);
            const bf16x8_t bh = __builtin_bit_cast(bf16x8_t, xh), bl = __builtin_bit_cast(bf16x8_t, xl);
            acc = __builtin_amdgcn_mfma_f32_32x32x16_bf16(wh, bh, acc, 0, 0, 0);
            acc = __builtin_amdgcn_mfma_f32_32x32x16_bf16(wh, bl, acc, 0, 0, 0);
            acc = __builtin_amdgcn_mfma_f32_32x32x16_bf16(wl, bh, acc, 0, 0, 0);
        }
        if (kh == 1) {
#pragma unroll
            for (int r = 0; r < 16; ++r) xch[(tw * 17 + r) * 64 + lane] = acc[r];
            xch[(tw * 17 + 16) * 64 + lane] = ss; }
    }
    __syncthreads();
    if (have && kh == 0) {
#pragma unroll
        for (int r = 0; r < 16; ++r) acc[r] += xch[(tw * 17 + r) * 64 + lane];
        ss += xch[(tw * 17 + 16) * 64 + lane];
        ss = xhalf_sum(ss); rstd = rsqrtf(ss * (1.f / D) + EPS);
        float L[24];
#pragma unroll
        for (int r = 0; r < 12; ++r) { const float v = acc[r]; auto rr = __builtin_amdgcn_permlane32_swap(__float_as_uint(v), __float_as_uint(v), false, false);
            L[(r & 3) + 8 * (r >> 2)] = __uint_as_float(rr[0]); L[(r & 3) + 8 * (r >> 2) + 4] = __uint_as_float(rr[1]); }
        float gl[4];
#pragma unroll
        for (int i = 0; i < 4; ++i) gl[i] = L[i] * rstd + b_gr[i];
        int g = 0; float gm = gl[0];
#pragma unroll
        for (int i = 1; i < 4; ++i) if (gl[i] > gm) { gm = gl[i]; g = i; }
        float se = 0.f;
#pragma unroll
        for (int i = 0; i < 4; ++i) se += __expf(gl[i] - gm);
        const float gw = 1.f / se;
        float el[4];
#pragma unroll
        for (int i = 0; i < 4; ++i) { const float l0 = L[4 + i], l1 = L[8 + i], l2 = L[12 + i], l3 = L[16 + i]; const float lv = g == 0 ? l0 : (g == 1 ? l1 : (g == 2 ? l2 : l3));
            const float b0 = b_er[i], b1 = b_er[4 + i], b2 = b_er[8 + i], b3 = b_er[12 + i]; el[i] = lv * rstd + (g == 0 ? b0 : (g == 1 ? b1 : (g == 2 ? b2 : b3))); }
        int i1 = 0; float v1 = el[0];
#pragma unroll
        for (int i = 1; i < 4; ++i) if (el[i] > v1) { v1 = el[i]; i1 = i; }
        int i2 = -1; float v2 = 0.f;
#pragma unroll
        for (int i = 0; i < 4; ++i) if (i != i1 && (i2 < 0 || el[i] > v2)) { v2 = el[i]; i2 = i; }
        const float e2 = __expf(v2 - v1), p1 = gw / (1.f + e2), p2 = gw * e2 / (1.f + e2);
        const int lo_ = i1 < i2 ? i1 : i2, hi_ = i1 < i2 ? i2 : i1;
        const int pair = lo_ == 0 ? (hi_ - 1) : (lo_ == 1 ? (hi_ + 1) : 5);
        bucket = g * 6 + pair; clo = i1 < i2 ? p1 : p2; chi = i1 < i2 ? p2 : p1;
        if (hi == 0) posl = (int)__hip_atomic_fetch_add(&lcnt[bucket], 1u, __ATOMIC_RELAXED, __HIP_MEMORY_SCOPE_WORKGROUP);
    }
    __syncthreads();
    if (tid < 24) lcnt[32 + tid] = atomicAdd(gcnt + tid, lcnt[tid]);
    __syncthreads();
    if (have && kh == 0 && hi == 0) { MB[t] = bucket; MPp[t] = (int)lcnt[32 + bucket] + posl; MCL[t] = clo; MCH[t] = chi; MRS[t] = rstd; }
}
__device__ __forceinline__ int moe_tiles(const unsigned* gcnt, int* rowstart  ) { int rs = 0;
    for (int b = 0; b < 24; ++b) { rowstart[b] = rs; rs += (int)((gcnt[b] + 255u) & ~255u); } rowstart[24] = rs; return rs >> 8; }
__device__ __forceinline__ void p8_permute(Frame& F, const Args& a) {
    unsigned char* mo = F.act; unsigned char* meta = mo + MO_META;
    const int* MB = (const int*)(meta + MM_B); const int* MPp = (const int*)(meta + MM_P); const float* MCL = (const float*)(meta + MM_CL); const float* MCH = (const float*)(meta + MM_CH); const float* MRS = (const float*)(meta + MM_RS);
    int* PTOK = (int*)(meta + MM_PTOK); float* PRS = (float*)(meta + MM_PRS); float* PCL = (float*)(meta + MM_PCL); float* PCH = (float*)(meta + MM_PCH);
    const unsigned* gcnt = (const unsigned*)(F.ws + WS_CTL) + CW_MOE;
    LAS int* rsL = (LAS int*)(F.lds + RING_OFF);
    if (F.tid == 0) { int rs = 0; for (int b = 0; b < 24; ++b) { rsL[b] = rs; rs += (int)((gcnt[b] + 255u) & ~255u); } rsL[24] = rs; }
    __syncthreads();
    const int gw = F.vcu * NWAVES + F.wave, NGW = F.G * NWAVES;
    const int gt = gw * 64 + F.lane, NGT = NGW * 64;
    for (int t = gt; t < F.ntok; t += NGT) { const int b = MB[t], prow = rsL[b] + MPp[t]; PTOK[prow] = t; PRS[prow] = MRS[t]; PCL[prow] = MCL[t]; PCH[prow] = MCH[t]; }
    for (int b = 0; b < 24; ++b) { const int c = (int)gcnt[b], p0 = rsL[b] + c, p1 = rsL[b + 1];
        for (int r = p0 + gt; r < p1; r += NGT) { PTOK[r] = -1; PRS[r] = 0.f; PCL[r] = 0.f; PCH[r] = 0.f; } }
}
template <bool GATHER_> struct MoeOrder {
    static constexpr bool GATHER = GATHER_; const int* ptok;
    int ntile, G, c; const char* A; size_t tA; const char* W; int mode; const LAS unsigned char* tb; size_t rowB;
    __device__ bool next(int i, pg8::Unit& u) const {
        const long L = (long)i * G + c; if (L >= (long)ntile * 4) return false;
        u.pm = (int)(L >> 2); u.pn = (int)(L & 3); u.a = GATHER_ ? A : A + (size_t)u.pm * tA;
        const int bk = tb[u.pm], g = bk / 6, pr = bk % 6; const int lo = pr < 3 ? 0 : (pr < 5 ? 1 : 2), hi = pr < 3 ? pr + 1 : (pr < 5 ? pr - 1 : 3);
        const int elo = g * 4 + lo, ehi = g * 4 + hi; u.aux = 0;
        if (mode == 1) { const int e = u.pn < 2 ? elo : ehi; u.b = W + ((size_t)e * 512 + (size_t)(u.pn & 1) * 256) * rowB; u.bjump = 0; }
        else { u.b = W + ((size_t)elo * 1024 + (size_t)u.pn * 256) * rowB; u.bjump = (long)(ehi - elo) * 1024 * (long)rowB - (long)rowB; }
        return true;
    }
    __device__ __forceinline__ void a_ready(const pg8::Unit&) const {}
    __device__ __forceinline__ void done(const pg8::Unit&) const {}
};
__device__ __forceinline__ float silu_f(float x) { return x * __builtin_amdgcn_rcpf(1.f + __builtin_amdgcn_exp2f(-1.4426950408889634f * x)); }
struct EpiMoe1 {
    static constexpr bool PERM = true, AFTER_DRAIN = false;
    unsigned char* ACT; const float* PRS; const float* PCL; const float* PCH;
    __device__ __forceinline__ void operator()(const pg8::f32x4 (&acc)[2][2][4][2], const pg8::Unit& u, int wr, int wc, int fr, int fq) const {
        const int row0 = u.pm * pg8::BM + wr * 64 + fr, slot = u.pn >> 1, fcol0 = slot * 256 + (u.pn & 1) * 128 + wc * 16 + 4 * fq; const float* PC = slot ? PCH : PCL;
#pragma unroll
        for (int ai = 0; ai < 2; ++ai)
#pragma unroll
            for (int m = 0; m < 4; ++m) { const int row = row0 + ai * pg8::HALF + m * 16; const float rs = PRS[row], cw = PC[row] * 16.f; unsigned char* rowp = ACT + (size_t)row * 512 + fcol0;
#pragma unroll
                for (int bj = 0; bj < 2; ++bj) { const pg8::f32x4 v0 = acc[ai][bj][m][0], v1 = acc[ai][bj][m][1];
                    const float a0 = silu_f(v0[0] * rs) * (v0[1] * rs) * cw, a1 = silu_f(v0[2] * rs) * (v0[3] * rs) * cw, a2 = silu_f(v1[0] * rs) * (v1[1] * rs) * cw, a3 = silu_f(v1[2] * rs) * (v1[3] * rs) * cw;
                    int w = __builtin_amdgcn_cvt_pk_fp8_f32(a0, a1, 0, false); w = __builtin_amdgcn_cvt_pk_fp8_f32(a2, a3, w, true); *(int*)(rowp + bj * 64) = w; } }
    }
};
struct EpiMoe2 {
    static constexpr bool PERM = false, AFTER_DRAIN = false;
    float* out; const pg8::bf16_t* h16; const int* PTOK;
    __device__ __forceinline__ void operator()(const pg8::f32x4 (&acc)[2][2][4][2], const pg8::Unit& u, int wr, int wc, int fr, int fq) const {
        const int row0 = u.pm * pg8::BM + wr * 64 + fr, col0 = u.pn * pg8::BM + wc * 32 + 4 * fq;
#pragma unroll
        for (int ai = 0; ai < 2; ++ai)
#pragma unroll
            for (int m = 0; m < 4; ++m) { const int tok = PTOK[row0 + ai * pg8::HALF + m * 16];
                if (tok >= 0) { float* rowp = out + (size_t)tok * 1024 + col0; const pg8::bf16_t* hp = h16 + (size_t)tok * 1024 + col0;
#pragma unroll
                    for (int bj = 0; bj < 2; ++bj)
#pragma unroll
                        for (int n = 0; n < 2; ++n) { const pg8::u32x2 hv = *(const pg8::u32x2*)(hp + bj * pg8::HALF + n * 16); const pg8::f32x4 hf = {pg8::bf_lo(hv.x), pg8::bf_hi(hv.x), pg8::bf_lo(hv.y), pg8::bf_hi(hv.y)};
                            *(pg8::f32x4*)(rowp + bj * pg8::HALF + n * 16) = hf + acc[ai][bj][m][n]; } } }
    }
};
__device__ __forceinline__ int moe_setup(Frame& F, LAS unsigned char* tb) {
    const unsigned* gcnt = (const unsigned*)(F.ws + WS_CTL) + CW_MOE;
    LAS int* nt_ = (LAS int*)(tb + 256);
    __syncthreads();
    if (F.tid == 0) { int tl = 0; for (int b = 0; b < 24; ++b) { const int n = (int)((gcnt[b] + 255u) >> 8); for (int i = 0; i < n; ++i) tb[tl + i] = (unsigned char)b; tl += n; } nt_[0] = tl; }
    __syncthreads();
    return nt_[0];
}

__global__ void __launch_bounds__(NWAVES * 64, 2) mk_fwd(Args args) {
    extern __shared__ __attribute__((aligned(16))) unsigned char lds[];
    Frame F;
    F.lds = (LAS unsigned char*)lds;
    F.tid = threadIdx.x; F.lane = F.tid & 63; F.wave = __builtin_amdgcn_readfirstlane(F.tid >> 6);
    F.G = gridDim.x; { const int bx = blockIdx.x; F.vcu = (F.G % 8 == 0) ? (bx % 8) * (F.G / 8) + bx / 8 : bx; }
    F.ntok = args.ntok; F.ws = args.ws; F.act = args.ws + WS_ACT; F.xbp = args.xb;
    const int lo = args.ph_lo, hi = args.ph_hi;
    cooperative_groups::grid_group grid = cooperative_groups::this_grid();
    volatile LAS unsigned* MISCW = (volatile LAS unsigned*)(F.lds + MISC_OFF);
    for (int u = F.tid; u < (LDS_BYTES - LDSCTL_OFF) / 4; u += NWAVES * 64) ((LAS unsigned*)(F.lds + LDSCTL_OFF))[u] = 0u;
    __syncthreads();
    XcdBarrier bar = xcd_barrier_post((unsigned*)(F.ws + WS_CTL) + CW_BAR, MISCW + 8);
#define IN(k) (lo <= (k) && (k) < hi)
#define SEAM(k) do { if (IN(k) && IN((k) + 1)) { xcd_barrier(bar); } } while (0)
    if (IN(0)) { p0_prologue(F, args); }
    SEAM(0);
    if (IN(1)) {
        EpiProj E{F.act, (size_t)F.ntok};
        { pg8::Gemm g{512, 512, 512, 8};
          P1Order S; S.nM = F.ntok / 256; S.nN = 25; S.nwg = S.nM * 25; S.G = F.G; S.c = (int)blockIdx.x; S.mode = 0; S.A = (const char*)(args.xb + (size_t)F.ntok * AUX_XB8); S.Bt = (const char*)(F.ws + WS_WIN8); S.tA = (size_t)256 * 1024; S.tB = (size_t)256 * 1024;
          pg8::gemm_phase<EpiProj, P1Order, true, true, true>(F.lds + RING_OFF, g, S, E); }
        { pg8::Gemm g{1024, 1024, 1024, 16};
          P1Order S; S.nM = F.ntok / 256; S.nN = 3; S.nwg = S.nM * 3; S.G = F.G; S.c = ((int)blockIdx.x + F.G / 2) % F.G; S.mode = 1; S.A = (const char*)args.xb; S.Bt = (const char*)(F.ws + WS_WIN); S.tA = (size_t)256 * 2048; S.tB = (size_t)256 * 2048;
          pg8::gemm_phase<EpiProj, P1Order, true, true, false>(F.lds + RING_OFF, g, S, E); }
    }
    SEAM(1);
    if (IN(2)) { p2_post(F, args); }
    SEAM(2);
    if (IN(3)) {
        const int ri = ret_wg_index(F), nret = (F.ntok / SEQ) * 4;
        if (ri < 0) p3_index(F, args);
        else if (ri < nret) { const size_t nt_ = (size_t)F.ntok;
            ret::ret_item(ri >> 2, ri & 3, F.act + nt_ * O_RQ, F.act + nt_ * O_RK, F.act + nt_ * O_RV, F.act + nt_ * O_RG, A2F8_PTR, args.in[8], (char*)lds, 0, RET_SPLIT, (float*)args.xb + (size_t)ri * 32768); }
    }
    SEAM(3);
    if (IN(4)) { p4_attn(F, args, lds); }
    SEAM(4);
    if (IN(5)) {
        const size_t nt_ = (size_t)F.ntok;
        const unsigned char* GA8 = F.act + nt_ * O_GA; const unsigned char* GR8 = F.act + nt_ * O_GR; unsigned char* TMP = F.act + nt_ * O_RV;
        { pg8::Gemm g{512, 512, 512, 8, 122, 123};
          pg8::StaticOrder S; S.init(F.ntok, 1024, F.G, (int)blockIdx.x, F.act + nt_ * O_QA, 512, F.ws + WS_WATT8, 512); EpiGateA E{GA8, TMP};
          pg8::gemm_phase<EpiGateA, pg8::StaticOrder, true, true, true>(F.lds + RING_OFF, g, S, E); }
        { pg8::Gemm g{512, 512, 512, 8, 122, 127};
          pg8::StaticOrder S; S.init(F.ntok, 1024, F.G, (int)blockIdx.x, A2F8_PTR, 512, F.ws + WS_WRET8, 512); EpiGateB E{TMP, GR8, F.act + nt_ * O_MIX8};
          pg8::gemm_phase<EpiGateB, pg8::StaticOrder, true, true, true>(F.lds + RING_OFF, g, S, E); }
    }
    SEAM(5);
    if (IN(6)) {
        pg8::Gemm g{512, 512, 512, 8, 122, 124}; const size_t nt_ = (size_t)F.ntok;
        pg8::StaticOrder S; S.init(F.ntok, 1024, F.G, (int)blockIdx.x, F.act + nt_ * O_MIX8, 512, F.ws + WS_WOUT8, 512);
        EpiResid E{args.in[0] + (size_t)args.tok0 * D, (pg8::bf16_t*)(F.act + MO_H16)};
        pg8::gemm_phase<EpiResid, pg8::StaticOrder, true, true, true>(F.lds + RING_OFF, g, S, E);
    }
    SEAM(6);
    if (IN(7)) { p7_router(F, args); }
    SEAM(7);
    if (IN(8)) { p8_permute(F, args); }
    SEAM(8);
    if (IN(9)) {
        LAS unsigned char* tb = F.lds + LDSCTL_OFF - 1024; const int ntile = moe_setup(F, tb);
        unsigned char* meta = F.act + MO_META;
        pg8::Gemm g{512, 512, 512, 8, 122, 127};
        MoeOrder<true> S{(const int*)(meta + MM_PTOK), ntile, F.G, (int)blockIdx.x, (const char*)(F.act + MO_N2), (size_t)0, (const char*)(F.ws + WS_W18), 1, tb, (size_t)1024};
        EpiMoe1 E{(unsigned char*)(F.act + MO_ACT), (const float*)(meta + MM_PRS), (const float*)(meta + MM_PCL), (const float*)(meta + MM_PCH)};
        pg8::gemm_phase<EpiMoe1, MoeOrder<true>, true, true, true>(F.lds + RING_OFF, g, S, E);
    }
    SEAM(9);
    if (IN(10)) {
        LAS unsigned char* tb = F.lds + LDSCTL_OFF - 1024; const int ntile = moe_setup(F, tb);
        unsigned char* meta = F.act + MO_META;
        pg8::Gemm g{256, 256, 128, 2, 123, 123};
        MoeOrder<false> S{nullptr, ntile, F.G, (int)blockIdx.x, (const char*)(F.act + MO_ACT), (size_t)256 * 512, (const char*)(F.ws + WS_WD8), 2, tb, (size_t)256};
        EpiMoe2 E{args.out + (size_t)args.tok0 * D, (const pg8::bf16_t*)(F.act + MO_H16), (const int*)(meta + MM_PTOK)};
        pg8::gemm_phase<EpiMoe2, MoeOrder<false>, true, true, true>(F.lds + RING_OFF, g, S, E);
    }
    if (hi - lo > 1) grid.sync();
#undef IN
#undef SEAM
}

extern "C" void kernel_launch(void* const* d_in, const int* in_sizes, int n_in, void* d_out, int out_size, void* d_ws, size_t ws_size, hipStream_t stream) {
    static int grid = 0;
    if (grid == 0) {
        int dev = 0, cus = 0, per_cu = 0;
        (void)hipGetDevice(&dev); (void)hipDeviceGetAttribute(&cus, hipDeviceAttributeMultiprocessorCount, dev);
        if (hipFuncSetAttribute((const void*)mk_fwd, hipFuncAttributeMaxDynamicSharedMemorySize, LDS_BYTES) != hipSuccess) { fprintf(stderr, "kernel_launch: hipFuncSetAttribute failed\n"); grid = -1; return; }
        (void)hipOccupancyMaxActiveBlocksPerMultiprocessor(&per_cu, (const void*)mk_fwd, NWAVES * 64, LDS_BYTES);
        (void)hipGetLastError();
        if (per_cu < 1) { fprintf(stderr, "kernel_launch: occupancy query says %d blocks per CU\n", per_cu); per_cu = 1; }
        grid = cus * per_cu;
        if (n_in != 20 || ws_size < (size_t)512 * MiB) { fprintf(stderr, "kernel_launch: unexpected n_in %d / ws_size %zu\n", n_in, ws_size); grid = -1; return; }
        if (grid != 256) { fprintf(stderr, "kernel_launch: this kernel's phase schedules are written for a 256-workgroup grid (256 CUs x 1); the device reports %d x %d; nothing launched\n", cus, per_cu); grid = -1; return; }
    }
    if (grid < 0) return;
    float* out = (float*)d_out;
    unsigned char* ws = (unsigned char*)d_ws;
    (void)in_sizes; (void)out_size;
    (void)hipMemsetAsync(ws + WS_CTL, 0, CTL_ZERO_BYTES, stream);
    Args a{};
    for (int i = 0; i < 20; ++i) a.in[i] = (const float*)d_in[i];
    a.out = out; a.ws = ws; a.xb = (unsigned char*)d_out; a.ntok = T; a.tok0 = 0;
    void* kargs[] = {(void*)&a};
    if (PROBE_PH >= 0) { a.ph_lo = PROBE_PH; a.ph_hi = PROBE_PH + 1; a.mode = PROBE_MODE;
        (void)hipLaunchCooperativeKernel((const void*)mk_fwd, dim3(grid), dim3(NWAVES * 64), kargs, (unsigned)LDS_BYTES, stream);
        (void)hipMemsetAsync(ws + WS_CTL, 0, CTL_ZERO_BYTES, stream); }
    a.ph_lo = 0; a.ph_hi = 11; a.mode = 0;
    const hipError_t le = hipLaunchCooperativeKernel((const void*)mk_fwd, dim3(grid), dim3(NWAVES * 64), kargs, (unsigned)LDS_BYTES, stream);
    if (le != hipSuccess) fprintf(stderr, "kernel_launch: cooperative launch failed: %s (grid %d)\n", hipGetErrorString(le), grid);
}
```

```cpp
#include <hip/hip_runtime.h>
#include <hip/hip_cooperative_groups.h>
#include <cstdio>
#include <cstdint>

namespace pg8 {
#define PG8_LAS __attribute__((address_space(3)))
typedef unsigned short bf16_t;
typedef short bf16x8 __attribute__((ext_vector_type(8)));
typedef float f32x4 __attribute__((ext_vector_type(4)));
typedef unsigned u32x4 __attribute__((ext_vector_type(4)));
typedef unsigned u32x2 __attribute__((ext_vector_type(2)));
typedef int v4i_t __attribute__((ext_vector_type(4)));
typedef int v8i_t __attribute__((ext_vector_type(8)));
constexpr int BM = 256, BK = 64, HALF = 128, HTB = HALF * BK * 2  , STAGE_BYTES = 8 * HTB, NXCD = 8, WGM = 8;

__host__ __device__ __forceinline__ int lds_byte(int r, int c) { const int st = (r >> 4) * 2 + (c >> 5), rr = r & 15, cc = c & 31, ob = rr * 64 + cc * 2; return st * 1024 + (ob ^ (((ob >> 9) & 1) << 5)); }
__host__ __device__ __forceinline__ void stage_rc(int b, int& R, int& C) { const int st = b / 1024, sb = b % 1024, swz = sb ^ (((sb >> 9) & 1) << 5); R = (st >> 1) * 16 + swz / 64; C = (st & 1) * 32 + (swz % 64) / 2; }
__host__ __device__ __forceinline__ int perm32(int rho) { const int n = rho >> 4, i = rho & 15; return 8 * (i >> 2) + 4 * n + (i & 3); }

struct Unit { int pm, pn; const char* a; const char* b; long bjump; int aux; int nvalid; };
struct Gemm { int K, lda, ldb, ksplit; int sw = 122, sa = 127; };

struct StaticOrder {
    static constexpr bool GATHER = false; const int* ptok = nullptr;
    int nM, nN, nwg, G, c; const char* A; const char* Bt; size_t tA, tB;
    __device__ void init(int M, int N, int G_, int c_, const void* A_, int lda, const void* Bt_, int ldb) { nM = M / BM; nN = N / BM; nwg = nM * nN; G = G_; c = c_; A = (const char*)A_; Bt = (const char*)Bt_; tA = (size_t)BM * lda * 2; tB = (size_t)BM * ldb * 2; }
    __device__ bool next(int i, Unit& u) const {
        const long L = (long)i * G + c; if (L >= nwg) return false;
        int wgid = (int)L; { const int q = nwg / NXCD, r = nwg % NXCD, xcd = wgid % NXCD, off = wgid / NXCD; wgid = (xcd < r ? xcd * (q + 1) : r * (q + 1) + (xcd - r) * q) + off; }
        const int nig = WGM * nN, gid = wgid / nig, fm = gid * WGM, gsz = (nM - fm) < WGM ? (nM - fm) : WGM;
        u.pm = fm + ((wgid % nig) % gsz); u.pn = (wgid % nig) / gsz; u.a = A + (size_t)u.pm * tA; u.b = Bt + (size_t)u.pn * tB; u.bjump = 0; u.aux = 0; u.nvalid = 256; return true;
    }
    __device__ __forceinline__ void a_ready(const Unit&) const {}
    __device__ __forceinline__ void done(const Unit&) const {}
};

typedef float f32x2c __attribute__((ext_vector_type(2))); typedef __bf16 bf16x2c __attribute__((ext_vector_type(2)));
__device__ __forceinline__ unsigned cvt_pk_bf16(float lo, float hi) { const f32x2c v = {lo, hi}; const bf16x2c b = __builtin_convertvector(v, bf16x2c); return __builtin_bit_cast(unsigned, b); }
__device__ __forceinline__ float bf_lo(unsigned w) { return __uint_as_float(w << 16); }
__device__ __forceinline__ float bf_hi(unsigned w) { return __uint_as_float(w & 0xffff0000u); }


template <class Epi, class Sched, bool ALIGN_EPI = false, bool SP2 = false, bool FP8 = false>
__device__ __forceinline__ void gemm_phase(PG8_LAS unsigned char* lds, const Gemm g, const Sched& S, const Epi& E) {
    int tid = threadIdx.x; asm volatile("" : "+v"(tid));
    const int wid = __builtin_amdgcn_readfirstlane(tid >> 6), lane = tid & 63, wr = wid >> 2, wc = wid & 3, fr = lane & 15, fq = lane >> 4;
    const int K = g.K, nt = K / BK;
    unsigned voffA[2], voffB[2]; int gR[2]; unsigned gC[2];
#pragma unroll
    for (int i = 0; i < 2; ++i) { int R, C; stage_rc(tid * 16 + i * 8192, R, C); const int Rb = Epi::PERM ? ((R & ~31) + perm32(R & 31)) : R; gR[i] = R; gC[i] = (unsigned)C * 2u;
        voffA[i] = (unsigned)(R * g.lda + C) * 2u; voffB[i] = (unsigned)(Rb * g.ldb + C) * 2u; }
    unsigned gA0[2] = {0u, 0u}, gA1[2] = {0u, 0u}, gN0[2] = {0u, 0u}, gN1[2] = {0u, 0u};
#define PG8_GOFF(u_, o0, o1) do { _Pragma("unroll") for (int i_ = 0; i_ < 2; ++i_) { const int r0_ = gR[i_], r1_ = HALF + gR[i_]; const int t0_ = r0_ < (u_).nvalid ? S.ptok[(u_).aux + (u_).pm * BM + r0_] : 0, t1_ = r1_ < (u_).nvalid ? S.ptok[(u_).aux + (u_).pm * BM + r1_] : 0; \
        o0[i_] = (unsigned)t0_ * (unsigned)(g.lda * 2) + gC[i_]; o1[i_] = (unsigned)t1_ * (unsigned)(g.lda * 2) + gC[i_]; } } while (0)
    const size_t kstep = (size_t)(BK * 2);
    const size_t hstepA = Sched::GATHER ? (size_t)0 : (size_t)HALF * g.lda * 2, hstepB = (size_t)HALF * g.ldb * 2;
    const unsigned ldsw = (unsigned)wid * 1024u;
    const int aoff = lds_byte(wr * 64 + fr, fq * 8), boff = lds_byte(wc * 32 + fr, fq * 8);
#define PG8_CAT(x0, x1) __builtin_shufflevector(__builtin_bit_cast(v4i_t, x0), __builtin_bit_cast(v4i_t, x1), 0, 1, 2, 3, 4, 5, 6, 7)
#define PG8_SA(b, h) (((b) * 2 + (h)) * HTB)
#define PG8_SB(b, h) ((4 + (b) * 2 + (h)) * HTB)
#define PG8_STAGE(bufoff, gbase, voff) do { _Pragma("unroll") for (int _i = 0; _i < 2; ++_i) \
        __builtin_amdgcn_global_load_lds((const unsigned*)((const char*)(gbase) + (voff)[_i]), (PG8_LAS unsigned*)(lds + (bufoff) + ldsw + _i * 8192), 16, 0, 0); } while (0)
#define PG8_LDA(dst, b, h) do { if constexpr (FP8) { _Pragma("unroll") for (int m = 0; m < 4; ++m) dst##8[m] = PG8_CAT(*(const PG8_LAS bf16x8*)(lds + PG8_SA(b, h) + aoff + m * 2048), *(const PG8_LAS bf16x8*)(lds + PG8_SA(b, h) + aoff + m * 2048 + 1024)); } \
      else { _Pragma("unroll") for (int m = 0; m < 4; ++m) _Pragma("unroll") for (int k = 0; k < 2; ++k) dst[m][k] = *(const PG8_LAS bf16x8*)(lds + PG8_SA(b, h) + aoff + m * 2048 + k * 1024); } } while (0)
#define PG8_LDB(dst, b, h) do { if constexpr (FP8) { _Pragma("unroll") for (int n = 0; n < 2; ++n) dst##8[n] = PG8_CAT(*(const PG8_LAS bf16x8*)(lds + PG8_SB(b, h) + boff + n * 2048), *(const PG8_LAS bf16x8*)(lds + PG8_SB(b, h) + boff + n * 2048 + 1024)); } \
      else { _Pragma("unroll") for (int n = 0; n < 2; ++n) _Pragma("unroll") for (int k = 0; k < 2; ++k) dst[n][k] = *(const PG8_LAS bf16x8*)(lds + PG8_SB(b, h) + boff + n * 2048 + k * 1024); } } while (0)
#define PG8_MMA(ai, bj, At, Bt) do { __builtin_amdgcn_s_setprio(1); if constexpr (FP8) { _Pragma("unroll") for (int m = 0; m < 4; ++m) _Pragma("unroll") for (int n = 0; n < 2; ++n) \
        asm volatile("v_mfma_scale_f32_16x16x128_f8f6f4 %0, %1, %2, %0, %3, %4 op_sel_hi:[0,0,0]" : "+v"(acc[ai][bj][m][n]) : "v"(Bt##8[n]), "v"(At##8[m]), "v"(scw8), "v"(sca8)); } \
      else { _Pragma("unroll") for (int m = 0; m < 4; ++m) _Pragma("unroll") for (int n = 0; n < 2; ++n) _Pragma("unroll") for (int k = 0; k < 2; ++k) \
        acc[ai][bj][m][n] = __builtin_amdgcn_mfma_f32_16x16x32_bf16(Bt[n][k], At[m][k], acc[ai][bj][m][n], 0, 0, 0); } __builtin_amdgcn_s_setprio(0); } while (0)
#define PG8_WAIT_V(n) asm volatile("s_waitcnt vmcnt(" #n ")" ::: "memory")
#define PG8_WAIT_L(n) asm volatile("s_waitcnt lgkmcnt(" #n ")" ::: "memory")
#define PG8_BAR __builtin_amdgcn_s_barrier()
#define PG8_SCHED __builtin_amdgcn_sched_barrier(0)
    Unit cur, nxt; int ui = 0;
    if (!S.next(0, cur)) return;
    f32x4 acc[2][2][4][2];
#pragma unroll
    for (int a = 0; a < 2; ++a)
#pragma unroll
        for (int b = 0; b < 2; ++b)
#pragma unroll
            for (int m = 0; m < 4; ++m)
#pragma unroll
                for (int n = 0; n < 2; ++n) acc[a][b][m][n] = (f32x4){0.f, 0.f, 0.f, 0.f};
    int scw8 = g.sw, sca8 = g.sa; asm volatile("" : "+v"(scw8), "+v"(sca8));
    bf16x8 At[4][2], B0[2][2], B1[2][2]; v8i_t At8[4], B08[2], B18[2];
    const char* cA = cur.a; const char* cB = cur.b; long cJ = cur.bjump;
    S.a_ready(cur);
    if constexpr (SP2) {
        if constexpr (Sched::GATHER) PG8_GOFF(cur, gA0, gA1);
        PG8_STAGE(PG8_SB(0, 0), cB, voffB); PG8_STAGE(PG8_SB(0, 1), cB + hstepB, voffB); do { if constexpr (Sched::GATHER) { PG8_STAGE(PG8_SA(0, 0), cA, gA0); } else { PG8_STAGE(PG8_SA(0, 0), cA, voffA); } } while (0); do { if constexpr (Sched::GATHER) { PG8_STAGE(PG8_SA(0, 1), cA, gA1); } else { PG8_STAGE(PG8_SA(0, 1), cA + hstepA, voffA); } } while (0);
        if (wr == 1) PG8_BAR;
        PG8_WAIT_V(2); PG8_BAR;
        PG8_STAGE(PG8_SB(1, 0), cB + kstep, voffB); do { if constexpr (Sched::GATHER) { PG8_STAGE(PG8_SA(1, 0), cA + kstep, gA0); } else { PG8_STAGE(PG8_SA(1, 0), cA + kstep, voffA); } } while (0); PG8_STAGE(PG8_SB(1, 1), cB + hstepB + kstep, voffB);
        PG8_WAIT_V(6); PG8_BAR;
    } else {
        PG8_STAGE(PG8_SB(0, 0), cB, voffB); PG8_STAGE(PG8_SA(0, 0), cA, voffA); PG8_STAGE(PG8_SB(0, 1), cB + hstepB, voffB); PG8_STAGE(PG8_SA(0, 1), cA + hstepA, voffA);
        if (wr == 1) PG8_BAR;
        PG8_WAIT_V(4); PG8_BAR;
        PG8_STAGE(PG8_SB(1, 0), cB + kstep, voffB); PG8_STAGE(PG8_SA(1, 0), cA + kstep, voffA); PG8_STAGE(PG8_SB(1, 1), cB + hstepB + kstep, voffB);
        PG8_WAIT_V(6); PG8_BAR;
    }
    for (;;) {
        const bool has_next = S.next(ui + 1, nxt);
        const char* nA = has_next ? nxt.a : cA; const char* nB = has_next ? nxt.b : cB;
        if constexpr (Sched::GATHER) { if (has_next) PG8_GOFF(nxt, gN0, gN1); else { gN0[0] = gA0[0]; gN0[1] = gA0[1]; gN1[0] = gA1[0]; gN1[1] = gA1[1]; } }
#pragma unroll 1
        for (int t = 0; t < nt; t += 2) {
            const bool last = (t == nt - 2);
            const char* a1 = cA + (size_t)(t + 1) * kstep;
            const char* a2 = last ? nA : cA + (size_t)(t + 2) * kstep; const char* b2 = last ? nB : cB + (size_t)(t + 2) * kstep + ((t + 2) >= g.ksplit ? cJ : 0L);
            const char* a3 = a2 + kstep; const char* b3 = b2 + kstep;
            if (last && has_next) S.a_ready(nxt);
            unsigned x0[2] = {0u, 0u}, x1[2] = {0u, 0u};
            if constexpr (Sched::GATHER) { x0[0] = last ? gN0[0] : gA0[0]; x0[1] = last ? gN0[1] : gA0[1]; x1[0] = last ? gN1[0] : gA1[0]; x1[1] = last ? gN1[1] : gA1[1]; }
            if constexpr (SP2) {
            PG8_LDB(B0, 0, 0); PG8_LDB(B1, 0, 1); PG8_SCHED; PG8_LDA(At, 0, 0); do { if constexpr (Sched::GATHER) { PG8_STAGE(PG8_SA(1, 1), a1, gA1); } else { PG8_STAGE(PG8_SA(1, 1), a1 + hstepA, voffA); } } while (0);
            PG8_WAIT_V(8); PG8_WAIT_L(0); PG8_BAR; PG8_MMA(0, 0, At, B0); PG8_MMA(0, 1, At, B1); PG8_BAR; PG8_SCHED;
            PG8_LDA(At, 0, 1); PG8_STAGE(PG8_SB(0, 0), b2, voffB); PG8_STAGE(PG8_SB(0, 1), b2 + hstepB, voffB); do { if constexpr (Sched::GATHER) { PG8_STAGE(PG8_SA(0, 0), a2, x0); } else { PG8_STAGE(PG8_SA(0, 0), a2, voffA); } } while (0);
            PG8_WAIT_V(8); PG8_WAIT_L(0); PG8_BAR; PG8_MMA(1, 0, At, B0); PG8_MMA(1, 1, At, B1); PG8_BAR; PG8_SCHED;
            PG8_LDB(B0, 1, 0); PG8_LDB(B1, 1, 1); PG8_SCHED; PG8_LDA(At, 1, 0); do { if constexpr (Sched::GATHER) { PG8_STAGE(PG8_SA(0, 1), a2, x1); } else { PG8_STAGE(PG8_SA(0, 1), a2 + hstepA, voffA); } } while (0);
            PG8_WAIT_V(8); PG8_WAIT_L(0); PG8_BAR; PG8_MMA(0, 0, At, B0); PG8_MMA(0, 1, At, B1); PG8_BAR; PG8_SCHED;
            PG8_LDA(At, 1, 1); PG8_STAGE(PG8_SB(1, 0), b3, voffB); PG8_STAGE(PG8_SB(1, 1), b3 + hstepB, voffB); do { if constexpr (Sched::GATHER) { PG8_STAGE(PG8_SA(1, 0), a3, x0); } else { PG8_STAGE(PG8_SA(1, 0), a3, voffA); } } while (0);
            PG8_WAIT_V(8); PG8_WAIT_L(0); PG8_BAR; PG8_MMA(1, 0, At, B0); PG8_MMA(1, 1, At, B1); PG8_BAR; PG8_SCHED;
            } else {
            PG8_LDB(B0, 0, 0); PG8_SCHED; PG8_LDA(At, 0, 0); PG8_STAGE(PG8_SA(1, 1), a1 + hstepA, voffA);
            PG8_WAIT_L(8); PG8_BAR; PG8_WAIT_L(0); PG8_MMA(0, 0, At, B0); PG8_BAR; PG8_SCHED;
            PG8_LDB(B1, 0, 1); PG8_STAGE(PG8_SB(0, 0), b2, voffB);
            PG8_BAR; PG8_WAIT_L(0); PG8_MMA(0, 1, At, B1); PG8_BAR;
            PG8_LDA(At, 0, 1); PG8_STAGE(PG8_SA(0, 0), a2, voffA);
            PG8_BAR; PG8_WAIT_L(0); PG8_MMA(1, 0, At, B0); PG8_BAR; PG8_SCHED;
            PG8_STAGE(PG8_SB(0, 1), b2 + hstepB, voffB);
            PG8_WAIT_V(6); PG8_BAR; PG8_MMA(1, 1, At, B1); PG8_BAR;
            PG8_LDB(B0, 1, 0); PG8_SCHED; PG8_LDA(At, 1, 0); PG8_STAGE(PG8_SA(0, 1), a2 + hstepA, voffA);
            PG8_WAIT_L(8); PG8_BAR; PG8_WAIT_L(0); PG8_MMA(0, 0, At, B0); PG8_BAR; PG8_SCHED;
            PG8_LDB(B1, 1, 1); PG8_STAGE(PG8_SB(1, 0), b3, voffB);
            PG8_BAR; PG8_WAIT_L(0); PG8_MMA(0, 1, At, B1); PG8_BAR;
            PG8_LDA(At, 1, 1); PG8_STAGE(PG8_SA(1, 0), a3, voffA);
            PG8_BAR; PG8_WAIT_L(0); PG8_MMA(1, 0, At, B0); PG8_BAR; PG8_SCHED;
            PG8_STAGE(PG8_SB(1, 1), b3 + hstepB, voffB);
            PG8_WAIT_V(6); PG8_BAR; PG8_MMA(1, 1, At, B1); PG8_BAR;
            }
        }
        if constexpr (ALIGN_EPI) { if (wr == 0) PG8_BAR; }
        if constexpr (!Epi::AFTER_DRAIN) { E(acc, cur, wr, wc, fr, fq); S.done(cur); }
        if (!has_next) break;
#pragma unroll
        for (int a = 0; a < 2; ++a)
#pragma unroll
            for (int b = 0; b < 2; ++b)
#pragma unroll
                for (int m = 0; m < 4; ++m)
#pragma unroll
                    for (int n = 0; n < 2; ++n) acc[a][b][m][n] = (f32x4){0.f, 0.f, 0.f, 0.f};
        cur = nxt; cA = nA; cB = nB; cJ = cur.bjump; ++ui;
        if constexpr (Sched::GATHER) { gA0[0] = gN0[0]; gA0[1] = gN0[1]; gA1[0] = gN1[0]; gA1[1] = gN1[1]; }
        if constexpr (ALIGN_EPI) { if (wr == 1) PG8_BAR; }
    }
    PG8_WAIT_V(0);
    if constexpr (!ALIGN_EPI) { if (wr == 0) PG8_BAR; }
    PG8_BAR;
    if constexpr (Epi::AFTER_DRAIN) { E.fused(acc, cur, wr, wc, fr, fq, lds, wid, lane); S.done(cur); }
#undef PG8_GOFF
#undef PG8_SA
#undef PG8_SB
#undef PG8_STAGE
#undef PG8_LDA
#undef PG8_LDB
#undef PG8_MMA
#undef PG8_CAT
#undef PG8_WAIT_V
#undef PG8_WAIT_L
#undef PG8_BAR
#undef PG8_SCHED
}
}

#ifndef PROBE_PH
#define PROBE_PH (-1)
#endif
#ifndef PROBE_MODE
#define PROBE_MODE (0)
#endif
constexpr int D = 1024, BATCH = 16, SEQ = 2048, T = BATCH * SEQ;
constexpr int INW = 6984, INWP = 7168;
constexpr int C_QA = 0, C_CKV = 1024, C_QI = 1280, C_KI = 1792, C_WI = 1856, C_RQ = 1864, C_RK = 2376, C_RV = 2888, C_RG = 3912, C_GA = 4936, C_GR = 5960;
constexpr float EPS = 1e-6f;
constexpr int NWAVES = 8;

constexpr size_t MiB = 1u << 20;
constexpr size_t WS_CTL = 0, CTL_ZERO_BYTES = 1 * MiB;
constexpr size_t WS_WIN = 1 * MiB, WS_WKV = 15 * MiB, WS_WATT = 16 * MiB, WS_WRET = 18 * MiB, WS_WOUT = 20 * MiB, WS_W1 = 22 * MiB, WS_WD = 38 * MiB, WS_ACT = 46 * MiB;
constexpr size_t O_QA = 0, O_CKV = 2048, O_QI = 2560, O_KW = 3584, O_RQ = 3840, O_RK = 4864, O_RV = 5888, O_RG = 7936, O_GA = 9984, O_GR = 12032, O_END = 14080;

constexpr int MP_ROWS = 38912;
constexpr size_t MO_APERM = 0, MO_ACT = 80 * MiB, MO_N2 = 120 * MiB, MO_META = 184 * MiB;
constexpr size_t MM_B = 0, MM_P = 131072, MM_CL = 262144, MM_CH = 393216, MM_RS = 524288, MM_PTOK = 655360, MM_PRS = 819200, MM_PCL = 983040, MM_PCH = 1146880, MM_END = 1310720;
constexpr size_t WS_WR = 15 * MiB + 512 * 1024;
constexpr size_t O_A2F8 = 1024;
constexpr size_t O_RSTATE = O_RQ + 512;
#define A2F8_PTR (F.act + (size_t)F.ntok * O_A2F8)
#define RSTATE_PTR ((float*)(F.act + (size_t)F.ntok * O_RSTATE))
#define RSTD1_PTR ((float*)(F.act + (size_t)F.ntok * O_RSTATE + 8 * MiB))
constexpr size_t MO_LIST = 152 * MiB; constexpr int LIST_CAP = 32768;
constexpr size_t MO_H16 = 192 * MiB;
constexpr size_t WS_WIN8 = 488 * MiB;
constexpr size_t WS_WATT8 = 495 * MiB, WS_WRET8 = 496 * MiB, WS_WOUT8 = 497 * MiB;
constexpr size_t O_MIX8 = 3840;
constexpr size_t WS_W18 = 498 * MiB, WS_WD8 = 506 * MiB;
constexpr size_t AUX_XB8 = 2048 + 896;
constexpr int F8_FIRST_TILE = 8;
constexpr int CW_MOE = 256;
constexpr int RING_OFF = 0, RING_BYTES = 131072, P3_HIST_OFF = 131072, P3_TOT_OFF = 147456, P3_T_OFF = 149504, LDSCTL_OFF = 151552, MISC_OFF = LDSCTL_OFF + 320, LDS_BYTES = 152576;
constexpr int CW_Q3 = 64, CW_Q4 = 128;

#define GAS __attribute__((address_space(1)))
#define LAS __attribute__((address_space(3)))
typedef unsigned short bf16;
typedef unsigned v4u __attribute__((ext_vector_type(4)));
typedef float f32x4 __attribute__((ext_vector_type(4)));
#define LDS_WAIT() asm volatile("s_waitcnt lgkmcnt(0)" ::: "memory")
#define VM_WAIT() asm volatile("s_waitcnt vmcnt(0)" ::: "memory")
__device__ __forceinline__ unsigned f2bf(float f) { unsigned u = __builtin_bit_cast(unsigned, f); return (u + 0x7fffu + ((u >> 16) & 1u)) >> 16; }
__device__ __forceinline__ unsigned pk2(float lo, float hi) { return f2bf(lo) | (f2bf(hi) << 16); }
__device__ __forceinline__ float bf2f(bf16 b) { return __uint_as_float((unsigned)b << 16); }


typedef GAS unsigned gu32;
constexpr int CW_BAR = 4096;
#define XB_TMO      128
#define XB_XCNT(j)  (256  + 64 * (j))
#define XB_XSUB(j)  (1280 + 64 * (j))
#define XB_XGEN(j)  (2304 + 64 * (j))
#define XB_TOP      3328
#define XB_TOPGEN   3392
#define XCD_BAR_WORDS 3456
#define XB_SPIN_CAP (1u << 18)

__device__ __forceinline__ unsigned xb_ld(unsigned* p)              { return __hip_atomic_load(p, __ATOMIC_RELAXED, __HIP_MEMORY_SCOPE_AGENT); }
__device__ __forceinline__ unsigned xb_add(unsigned* p, unsigned v) { return __hip_atomic_fetch_add(p, v, __ATOMIC_RELAXED, __HIP_MEMORY_SCOPE_AGENT); }
__device__ __forceinline__ unsigned xb_xcc_id() { return (unsigned)__builtin_amdgcn_s_getreg((3 << 11) | 20) & 0xFu; }
#define XB_SPIN(cond, bar) do { unsigned _sp = 0; while (cond) { __builtin_amdgcn_s_sleep(1); \
    if ((++_sp & 255u) == 0u) { if (xb_ld(&(bar)[XB_TMO])) break; if (_sp > XB_SPIN_CAP) { atomicAdd(&(bar)[XB_TMO], 1u); break; } } } } while (0)

struct XcdBarrier {
    unsigned* bar; unsigned x;
    volatile LAS unsigned* st;
};

__device__ __forceinline__ XcdBarrier xcd_barrier_post(unsigned* bar, volatile LAS unsigned* st) {
    XcdBarrier b; b.bar = bar; b.x = xb_xcc_id(); b.st = st;
    if (threadIdx.x == 0) (void)xb_add(&bar[XB_XCNT(b.x)], 1u);
    return b;
}
__device__ __forceinline__ void xcd_barrier_complete(unsigned* bar, unsigned x, unsigned& nloc, unsigned& nx) {
    const unsigned G = gridDim.x * gridDim.y * gridDim.z;
    unsigned sum, cnt, mine, sp = 0u;
    for (;;) {
        sum = 0u; cnt = 0u; mine = 0u;
#pragma unroll
        for (unsigned j = 0; j < 16; ++j) { const unsigned c = xb_ld(&bar[XB_XCNT(j)]); sum += c; cnt += (c > 0u) ? 1u : 0u; mine = (j == x) ? c : mine; }
        if (sum == G) break;
        __builtin_amdgcn_s_sleep(1);
        if ((++sp & 255u) == 0u) { if (xb_ld(&bar[XB_TMO])) break; if (sp > XB_SPIN_CAP) { atomicAdd(&bar[XB_TMO], 1u); break; } }
    }
    nloc = mine > 0u ? mine : 1u; nx = cnt > 0u ? cnt : 1u;
}

__device__ __forceinline__ void xcd_barrier(const XcdBarrier& b) {
    asm volatile("s_waitcnt vmcnt(0)" ::: "memory");
    __syncthreads();
    if (threadIdx.x == 0) {
        unsigned* bar = b.bar;
        __builtin_amdgcn_s_waitcnt(0);
        unsigned nloc = b.st[0], nx = b.st[1];
        if (nloc == 0u) { xcd_barrier_complete(bar, b.x, nloc, nx); b.st[0] = nloc; b.st[1] = nx; }
        const unsigned old = xb_add(&bar[XB_XSUB(b.x)], 1u);
        const unsigned gen = old / nloc;
        if (old + 1u == (gen + 1u) * nloc) {
            __builtin_amdgcn_fence(__ATOMIC_RELEASE, "agent");
            asm volatile("s_waitcnt vmcnt(0)" ::: "memory");
            const unsigned og = xb_add(&bar[XB_TOP], 1u);
            const unsigned tg = og / nx;
            if (og + 1u == (tg + 1u) * nx) xb_add(&bar[XB_TOPGEN], 1u);
            else XB_SPIN(xb_ld(&bar[XB_TOPGEN]) == tg, bar);
            __builtin_amdgcn_fence(__ATOMIC_ACQUIRE, "agent");
            xb_add(&bar[XB_XGEN(b.x)], 1u);
            asm volatile("s_waitcnt vmcnt(0)" ::: "memory");
        } else {
            XB_SPIN(xb_ld(&bar[XB_XGEN(b.x)]) == gen, bar);
            __builtin_amdgcn_fence(__ATOMIC_ACQUIRE, "agent");
            asm volatile("s_waitcnt vmcnt(0)" ::: "memory");
        }
    }
    __syncthreads();
}

struct Args { const float* in[20]; float* out; unsigned char* ws; unsigned char* xb; int ph_lo, ph_hi, ntok, tok0, mode, pad; };

struct Frame {
    LAS unsigned char* lds;
    int tid, lane, wave, vcu, G;
    int ntok;
    unsigned char* ws; unsigned char* act; unsigned char* xbp;
};

struct EpiProj {
    static constexpr bool PERM = true, AFTER_DRAIN = false;
    unsigned char* act; size_t ntok; const float* rstd1;
    static __device__ __forceinline__ unsigned q4(const pg8::f32x4& v) { int w = __builtin_amdgcn_cvt_pk_fp8_f32(v[0], v[1], 0, false); return (unsigned)__builtin_amdgcn_cvt_pk_fp8_f32(v[2], v[3], w, true); }
    __device__ __forceinline__ void operator()(const pg8::f32x4 (&acc)[2][2][4][2], const pg8::Unit& u, int wr, int wc, int fr, int fq) const {
        const int pn = u.pn; size_t O; int ld, cb, nbj = 2; bool f8 = false;
        if (pn < 4) { O = O_QA; ld = 1024; cb = pn * 256; }
        else if (pn == 4) { O = O_CKV; ld = 256; cb = 0; }
        else if (pn < 7) { O = O_QI; ld = 512; cb = (pn - 5) * 256; }
        else if (pn == 7) { O = O_KW; ld = 128; cb = 0; nbj = 1; }
        else if (pn < 10) { O = O_RQ; ld = 512; cb = (pn - 8) * 256; }
        else if (pn < 12) { O = O_RK; ld = 512; cb = (pn - 10) * 256; }
        else { O = O_RV + (size_t)((pn - 12) >> 2) * 2048; ld = 1024; cb = ((pn - 12) & 3) * 256; }
        f8 = pn < 5 || pn >= F8_FIRST_TILE;
        const int row0 = u.pm * pg8::BM + wr * 64 + fr;
        if (f8) {
            unsigned char* base = act + ntok * O; const bool odd = fq & 1; const int colb = cb + wc * 32 + 8 * (fq & ~1);
#pragma unroll
            for (int ai = 0; ai < 2; ++ai)
#pragma unroll
                for (int bj = 0; bj < 2; ++bj)
#pragma unroll
                    for (int mp = 0; mp < 2; ++mp) { const unsigned x0 = q4(acc[ai][bj][2 * mp][0]), x1 = q4(acc[ai][bj][2 * mp][1]), y0 = q4(acc[ai][bj][2 * mp + 1][0]), y1 = q4(acc[ai][bj][2 * mp + 1][1]);
                        const unsigned r0 = (unsigned)__builtin_amdgcn_ds_swizzle((int)(odd ? x0 : y0), 0x401F), r1 = (unsigned)__builtin_amdgcn_ds_swizzle((int)(odd ? x1 : y1), 0x401F);
                        pg8::u32x4 w; if (odd) { w.x = r0; w.y = r1; w.z = y0; w.w = y1; } else { w.x = x0; w.y = x1; w.z = r0; w.w = r1; }
                        *(pg8::u32x4*)(base + (size_t)(row0 + ai * pg8::HALF + (2 * mp + (odd ? 1 : 0)) * 16) * ld + colb + bj * pg8::HALF) = w; }
            return;
        }
        pg8::bf16_t* base = (pg8::bf16_t*)(act + ntok * O);
        const int col0 = cb + wc * 32 + 8 * fq;
        float rs1[2][4];
#pragma unroll
        for (int ai = 0; ai < 2; ++ai)
#pragma unroll
            for (int m = 0; m < 4; ++m) rs1[ai][m] = rstd1[row0 + ai * pg8::HALF + m * 16];
#pragma unroll
        for (int ai = 0; ai < 2; ++ai)
#pragma unroll
            for (int m = 0; m < 4; ++m) { pg8::bf16_t* rowp = base + (size_t)(row0 + ai * pg8::HALF + m * 16) * ld + col0; const float rs = rs1[ai][m];
#pragma unroll
                for (int bj = 0; bj < 2; ++bj) if (bj < nbj) { const pg8::f32x4 v0 = acc[ai][bj][m][0] * rs, v1 = acc[ai][bj][m][1] * rs;
                    pg8::u32x4 w; w.x = pg8::cvt_pk_bf16(v0[0], v0[1]); w.y = pg8::cvt_pk_bf16(v0[2], v0[3]); w.z = pg8::cvt_pk_bf16(v1[0], v1[1]); w.w = pg8::cvt_pk_bf16(v1[2], v1[3]);
                    *(pg8::u32x4*)(rowp + bj * pg8::HALF) = w; } }
    }
};

__device__ __forceinline__ float sigm(float x) { return __builtin_amdgcn_rcpf(1.f + __builtin_amdgcn_exp2f(-1.4426950408889634f * x)); }
__device__ __forceinline__ void f8x8(const pg8::u32x2 g, float (&f)[8]) { const auto a = __builtin_amdgcn_cvt_pk_f32_fp8((int)g.x, false), b = __builtin_amdgcn_cvt_pk_f32_fp8((int)g.x, true), c = __builtin_amdgcn_cvt_pk_f32_fp8((int)g.y, false), d = __builtin_amdgcn_cvt_pk_f32_fp8((int)g.y, true);
    f[0] = a[0]; f[1] = a[1]; f[2] = b[0]; f[3] = b[1]; f[4] = c[0]; f[5] = c[1]; f[6] = d[0]; f[7] = d[1]; }
__device__ __forceinline__ void st_f8_pair(unsigned char* base, size_t ld, int row_m0, int colb, bool odd, unsigned x0, unsigned x1, unsigned y0, unsigned y1) {
    const unsigned r0 = (unsigned)__builtin_amdgcn_ds_swizzle((int)(odd ? x0 : y0), 0x401F), r1 = (unsigned)__builtin_amdgcn_ds_swizzle((int)(odd ? x1 : y1), 0x401F);
    pg8::u32x4 w; if (odd) { w.x = r0; w.y = r1; w.z = y0; w.w = y1; } else { w.x = x0; w.y = x1; w.z = r0; w.w = r1; }
    *(pg8::u32x4*)(base + (size_t)(row_m0 + (odd ? 16 : 0)) * ld + colb) = w;
}
__device__ __forceinline__ unsigned q4f(float a, float b, float c, float d) { int w = __builtin_amdgcn_cvt_pk_fp8_f32(a, b, 0, false); return (unsigned)__builtin_amdgcn_cvt_pk_fp8_f32(c, d, w, true); }
struct EpiGateA {
    static constexpr bool PERM = true, AFTER_DRAIN = false;
    const unsigned char* GA8; unsigned char* TMP8;
    __device__ __forceinline__ void operator()(const pg8::f32x4 (&acc)[2][2][4][2], const pg8::Unit& u, int wr, int wc, int fr, int fq) const {
        const int row0 = u.pm * pg8::BM + wr * 64 + fr, col0 = u.pn * pg8::BM + wc * 32 + 8 * fq, colb = u.pn * pg8::BM + wc * 32 + 8 * (fq & ~1); const bool odd = fq & 1;
        pg8::u32x2 gl[2][2][4];
#pragma unroll
        for (int ai = 0; ai < 2; ++ai)
#pragma unroll
            for (int bj = 0; bj < 2; ++bj)
#pragma unroll
                for (int m = 0; m < 4; ++m) gl[ai][bj][m] = *(const pg8::u32x2*)(GA8 + (size_t)(row0 + ai * pg8::HALF + m * 16) * 1024 + col0 + bj * pg8::HALF);
#pragma unroll
        for (int ai = 0; ai < 2; ++ai)
#pragma unroll
            for (int bj = 0; bj < 2; ++bj)
#pragma unroll
                for (int mp = 0; mp < 2; ++mp) { unsigned q[2][2];
#pragma unroll
                    for (int e = 0; e < 2; ++e) { const int m = 2 * mp + e; float g[8]; f8x8(gl[ai][bj][m], g);
                        const pg8::f32x4 v0 = acc[ai][bj][m][0], v1 = acc[ai][bj][m][1];
                        q[e][0] = q4f(32.f * sigm(g[0]) * v0[0], 32.f * sigm(g[1]) * v0[1], 32.f * sigm(g[2]) * v0[2], 32.f * sigm(g[3]) * v0[3]); q[e][1] = q4f(32.f * sigm(g[4]) * v1[0], 32.f * sigm(g[5]) * v1[1], 32.f * sigm(g[6]) * v1[2], 32.f * sigm(g[7]) * v1[3]); }
                    st_f8_pair(TMP8, 1024, row0 + ai * pg8::HALF + 2 * mp * 16, colb + bj * pg8::HALF, odd, q[0][0], q[0][1], q[1][0], q[1][1]); }
    }
};
struct EpiGateB {
    static constexpr bool PERM = true, AFTER_DRAIN = false;
    const unsigned char* TMP8; const unsigned char* GR8; unsigned char* MIX8;
    __device__ __forceinline__ void operator()(const pg8::f32x4 (&acc)[2][2][4][2], const pg8::Unit& u, int wr, int wc, int fr, int fq) const {
        const int row0 = u.pm * pg8::BM + wr * 64 + fr, col0 = u.pn * pg8::BM + wc * 32 + 8 * fq, colb = u.pn * pg8::BM + wc * 32 + 8 * (fq & ~1); const bool odd = fq & 1;
        pg8::u32x2 gl[2][2][4], tl[2][2][4];
#pragma unroll
        for (int ai = 0; ai < 2; ++ai)
#pragma unroll
            for (int bj = 0; bj < 2; ++bj)
#pragma unroll
                for (int m = 0; m < 4; ++m) { const size_t ro = (size_t)(row0 + ai * pg8::HALF + m * 16) * 1024 + col0 + bj * pg8::HALF; gl[ai][bj][m] = *(const pg8::u32x2*)(GR8 + ro); tl[ai][bj][m] = *(const pg8::u32x2*)(TMP8 + ro); }
#pragma unroll
        for (int ai = 0; ai < 2; ++ai)
#pragma unroll
            for (int bj = 0; bj < 2; ++bj)
#pragma unroll
                for (int mp = 0; mp < 2; ++mp) { unsigned q[2][2];
#pragma unroll
                    for (int e = 0; e < 2; ++e) { const int m = 2 * mp + e; float g[8], t[8]; f8x8(gl[ai][bj][m], g); f8x8(tl[ai][bj][m], t);
                        const pg8::f32x4 v0 = acc[ai][bj][m][0], v1 = acc[ai][bj][m][1];
                        q[e][0] = q4f(0.25f * t[0] + 8.f * sigm(g[0]) * v0[0], 0.25f * t[1] + 8.f * sigm(g[1]) * v0[1], 0.25f * t[2] + 8.f * sigm(g[2]) * v0[2], 0.25f * t[3] + 8.f * sigm(g[3]) * v0[3]);
                        q[e][1] = q4f(0.25f * t[4] + 8.f * sigm(g[4]) * v1[0], 0.25f * t[5] + 8.f * sigm(g[5]) * v1[1], 0.25f * t[6] + 8.f * sigm(g[6]) * v1[2], 0.25f * t[7] + 8.f * sigm(g[7]) * v1[3]); }
                    st_f8_pair(MIX8, 1024, row0 + ai * pg8::HALF + 2 * mp * 16, colb + bj * pg8::HALF, odd, q[0][0], q[0][1], q[1][0], q[1][1]); }
    }
};
struct EpiResid {
    static constexpr bool PERM = true, AFTER_DRAIN = false;
    const pg8::bf16_t* xb; pg8::bf16_t* h16;
    __device__ __forceinline__ void operator()(const pg8::f32x4 (&acc)[2][2][4][2], const pg8::Unit& u, int wr, int wc, int fr, int fq) const {
        const int row0 = u.pm * pg8::BM + wr * 64 + fr, col0 = u.pn * pg8::BM + wc * 32 + 8 * fq;
        pg8::u32x4 xl[2][4][2];
#pragma unroll
        for (int ai = 0; ai < 2; ++ai)
#pragma unroll
            for (int m = 0; m < 4; ++m)
#pragma unroll
                for (int bj = 0; bj < 2; ++bj) xl[ai][m][bj] = *(const pg8::u32x4*)(xb + (size_t)(row0 + ai * pg8::HALF + m * 16) * 1024 + col0 + bj * pg8::HALF);
#pragma unroll
        for (int ai = 0; ai < 2; ++ai)
#pragma unroll
            for (int m = 0; m < 4; ++m) { const size_t ro = (size_t)(row0 + ai * pg8::HALF + m * 16) * 1024 + col0;
#pragma unroll
                for (int bj = 0; bj < 2; ++bj) { const pg8::u32x4 xv = xl[ai][m][bj]; const pg8::f32x4 v0 = acc[ai][bj][m][0], v1 = acc[ai][bj][m][1];
                    pg8::u32x4 w; w.x = pg8::cvt_pk_bf16(v0[0] + pg8::bf_lo(xv.x), v0[1] + pg8::bf_hi(xv.x)); w.y = pg8::cvt_pk_bf16(v0[2] + pg8::bf_lo(xv.y), v0[3] + pg8::bf_hi(xv.y));
                    w.z = pg8::cvt_pk_bf16(v1[0] + pg8::bf_lo(xv.z), v1[1] + pg8::bf_hi(xv.z)); w.w = pg8::cvt_pk_bf16(v1[2] + pg8::bf_lo(xv.w), v1[3] + pg8::bf_hi(xv.w));
                    *(pg8::u32x4*)(h16 + ro + bj * pg8::HALF) = w; } }
    }
};


struct P1Order {
    static constexpr bool GATHER = false; const int* ptok = nullptr;
    int nM, nN, nwg, G, c, mode; const char* A; const char* Bt; size_t tA, tB;
    __device__ bool next(int i, pg8::Unit& u) const {
        const long L = (long)i * G + c; if (L >= nwg) return false;
        int wgid = (int)L; { const int q = nwg / pg8::NXCD, r = nwg % pg8::NXCD, xcd = wgid % pg8::NXCD, off = wgid / pg8::NXCD; wgid = (xcd < r ? xcd * (q + 1) : r * (q + 1) + (xcd - r) * q) + off; }
        const int nig = pg8::WGM * nN, gid = wgid / nig, fm = gid * pg8::WGM, gsz = (nM - fm) < pg8::WGM ? (nM - fm) : pg8::WGM;
        u.pm = fm + ((wgid % nig) % gsz); const int pc = (wgid % nig) / gsz; u.pn = mode ? 5 + pc : (pc < 5 ? pc : pc + 3);
        u.a = A + (size_t)u.pm * tA; u.b = Bt + (size_t)u.pn * tB; u.bjump = 0; u.aux = 0; u.nvalid = 256; return true;
    }
    __device__ __forceinline__ void a_ready(const pg8::Unit&) const {}
    __device__ __forceinline__ void done(const pg8::Unit&) const {}
};

__device__ __forceinline__ float wave_sum(float v) {
#pragma unroll
    for (int o = 1; o < 64; o <<= 1) v += __shfl_xor(v, o);
    return v;
}
__device__ __forceinline__ void p0_transpose_item(const float* W, int K, int N, bf16* WT, int map, int row_off, int par, const float* gk, LAS float* scr, int item, int lane, unsigned char* WT8 = nullptr, float s8 = 32.f) {
    const int nblk = (N + 31) / 32, kb = item / nblk, nb = item % nblk, k0 = 64 * kb, n0 = 32 * nb;
    const int c4 = lane & 7, rr = lane >> 3; const bool okc = (n0 + 4 * c4) < N;
    f32x4 v[8];
#pragma unroll
    for (int i = 0; i < 8; ++i) { const int kk = i * 8 + rr; v[i] = okc ? *(const f32x4*)(W + (size_t)(k0 + kk) * N + n0 + 4 * c4) : (f32x4){0.f, 0.f, 0.f, 0.f}; }
#pragma unroll
    for (int i = 0; i < 8; ++i) { const int kk = i * 8 + rr; f32x4 x = v[i]; if (gk) x = x * gk[k0 + kk]; *(LAS f32x4*)(scr + kk * 36 + 4 * c4) = x; }
    LDS_WAIT(); asm volatile("" ::: "memory");
    const int c = lane & 7;
#pragma unroll
    for (int j = 0; j < 4; ++j) { const int nl = (lane >> 3) + 8 * j, n = n0 + nl; const LAS float* s = scr + (8 * c) * 36 + nl;
        v4u o; o.x = pk2(s[0 * 36], s[1 * 36]); o.y = pk2(s[2 * 36], s[3 * 36]); o.z = pk2(s[4 * 36], s[5 * 36]); o.w = pk2(s[6 * 36], s[7 * 36]);
        if (n < N) { const int row = (map == 0) ? row_off + n : (map == 1) ? (n < 1864 ? n : n + 184) : row_off + 2 * n + par;
            if (WT) *(GAS v4u*)(WT + (size_t)row * K + k0 + 8 * c) = o;
            if (WT8) { int w0 = __builtin_amdgcn_cvt_pk_fp8_f32(s[0 * 36] * s8, s[1 * 36] * s8, 0, false); w0 = __builtin_amdgcn_cvt_pk_fp8_f32(s[2 * 36] * s8, s[3 * 36] * s8, w0, true);
                int w1 = __builtin_amdgcn_cvt_pk_fp8_f32(s[4 * 36] * s8, s[5 * 36] * s8, 0, false); w1 = __builtin_amdgcn_cvt_pk_fp8_f32(s[6 * 36] * s8, s[7 * 36] * s8, w1, true);
                *(GAS unsigned long long*)(WT8 + (size_t)row * K + k0 + 8 * c) = (unsigned long long)(unsigned)w0 | ((unsigned long long)(unsigned)w1 << 32); } } }
    LDS_WAIT(); asm volatile("" ::: "memory");
}
__device__ __forceinline__ void p0_prologue(Frame& F, const Args& a) {
    LAS float* scr = (LAS float*)(F.lds + RING_OFF + F.wave * 16384);
    const int gw = F.vcu * NWAVES + F.wave, NGW = F.G * NWAVES;
    bf16* Win_t = (bf16*)(F.ws + WS_WIN); bf16* Wkv_t = (bf16*)(F.ws + WS_WKV);
    constexpr int I_IN = 16 * 219, I_KV = 4 * 8, I_SQ = 16 * 32, I_GU = 16 * 8  , I_DN = 4 * 32  ;
    constexpr int NITEMS = I_IN + I_KV + 3 * I_SQ + 16 * (2 * I_GU + I_DN);
    for (int it = gw; it < NITEMS; it += NGW) {
        int r = it;
        if (r < I_IN) { p0_transpose_item(a.in[2], 1024, INW, Win_t, 1, 0, 0, a.in[1], scr, r, F.lane, F.ws + WS_WIN8); continue; } r -= I_IN;
        if (r < I_KV) { p0_transpose_item(a.in[4], 256, 256, Wkv_t, 0, 0, 0, a.in[3], scr, r, F.lane); continue; } r -= I_KV;
        if (r < I_SQ) { p0_transpose_item(a.in[9], 1024, 1024, nullptr, 0, 0, 0, nullptr, scr, r, F.lane, F.ws + WS_WATT8, 32.f); continue; } r -= I_SQ;
        if (r < I_SQ) { p0_transpose_item(a.in[10], 1024, 1024, nullptr, 0, 0, 0, nullptr, scr, r, F.lane, F.ws + WS_WRET8, 32.f); continue; } r -= I_SQ;
        if (r < I_SQ) { p0_transpose_item(a.in[11], 1024, 1024, nullptr, 0, 0, 0, nullptr, scr, r, F.lane, F.ws + WS_WOUT8, 32.f); continue; } r -= I_SQ;
        const int e = r / (2 * I_GU + I_DN), q = r % (2 * I_GU + I_DN);
        if (q < I_GU) p0_transpose_item(a.in[17] + (size_t)e * 1024 * 256, 1024, 256, nullptr, 2, e * 512, 0, nullptr, scr, q, F.lane, F.ws + WS_W18, 32.f);
        else if (q < 2 * I_GU) p0_transpose_item(a.in[18] + (size_t)e * 1024 * 256, 1024, 256, nullptr, 2, e * 512, 1, nullptr, scr, q - I_GU, F.lane, F.ws + WS_W18, 32.f);
        else p0_transpose_item(a.in[19] + (size_t)e * 256 * 1024, 256, 1024, nullptr, 0, 0, 0, nullptr, scr, q - 2 * I_GU, F.lane, F.ws + WS_WD8 + (size_t)e * 1024 * 256, 16.f);
    }
    { const int gt = (F.vcu * NWAVES + F.wave) * 64 + F.lane, NGT = F.G * NWAVES * 64; GAS v4u* z = (GAS v4u*)(Win_t + (size_t)1864 * 1024);
      for (int i = gt; i < 184 * 1024 * 2 / 16; i += NGT) z[i] = (v4u){0u, 0u, 0u, 0u}; }
    { const int gt = (F.vcu * NWAVES + F.wave) * 64 + F.lane, NGT = F.G * NWAVES * 64; bf16* Wh = (bf16*)(F.ws + WS_WR); bf16* Wl = Wh + 32 * 1024;
      for (int i = gt; i < 32 * 1024; i += NGT) { const int n = i >> 10, k = i & 1023; const float wv = n < 4 ? a.in[13][k * 4 + n] : (n < 20 ? a.in[15][k * 16 + (n - 4)] : 0.f);
        const unsigned hb = f2bf(wv); const float hf = __uint_as_float(hb << 16); Wh[i] = (bf16)hb; Wl[i] = (bf16)f2bf(wv - hf); } }
    const float* x = a.in[0] + (size_t)a.tok0 * D; unsigned char* xb8 = a.xb + (size_t)F.ntok * AUX_XB8;
    for (int m = gw; m < F.ntok; m += 2 * NGW) {
        const int m2 = m + NGW; const bool two = m2 < F.ntok;
        const GAS f32x4* xr = (const GAS f32x4*)(x + (size_t)m * D) + F.lane; const GAS f32x4* xr2 = (const GAS f32x4*)(x + (size_t)(two ? m2 : m) * D) + F.lane;
        f32x4 v[4], u[4]; float s = 0.f, s2 = 0.f;
#pragma unroll
        for (int j = 0; j < 4; ++j) { v[j] = xr[64 * j]; u[j] = xr2[64 * j]; }
#pragma unroll
        for (int j = 0; j < 4; ++j) { s += (v[j].x * v[j].x + v[j].y * v[j].y) + (v[j].z * v[j].z + v[j].w * v[j].w); s2 += (u[j].x * u[j].x + u[j].y * u[j].y) + (u[j].z * u[j].z + u[j].w * u[j].w); }
        const float rstd = 1.f / sqrtf(wave_sum(s) * (1.f / D) + EPS), rstd2 = 1.f / sqrtf(wave_sum(s2) * (1.f / D) + EPS);
        if (F.lane == 0) { RSTD1_PTR[m] = rstd; if (two) RSTD1_PTR[m2] = rstd2; }
        GAS unsigned long long* o8 = (GAS unsigned long long*)(a.xb + (size_t)m * D * 2) + F.lane; GAS unsigned* q8 = (GAS unsigned*)(xb8 + (size_t)m * D) + F.lane;
#pragma unroll
        for (int j = 0; j < 4; ++j) { o8[64 * j] = (unsigned long long)pk2(v[j].x, v[j].y) | ((unsigned long long)pk2(v[j].z, v[j].w) << 32);
            int w8 = __builtin_amdgcn_cvt_pk_fp8_f32(v[j].x * rstd, v[j].y * rstd, 0, false); w8 = __builtin_amdgcn_cvt_pk_fp8_f32(v[j].z * rstd, v[j].w * rstd, w8, true); q8[64 * j] = (unsigned)w8; }
        if (two) { GAS unsigned long long* p8 = (GAS unsigned long long*)(a.xb + (size_t)m2 * D * 2) + F.lane; GAS unsigned* r8 = (GAS unsigned*)(xb8 + (size_t)m2 * D) + F.lane;
#pragma unroll
            for (int j = 0; j < 4; ++j) { p8[64 * j] = (unsigned long long)pk2(u[j].x, u[j].y) | ((unsigned long long)pk2(u[j].z, u[j].w) << 32);
                int w8 = __builtin_amdgcn_cvt_pk_fp8_f32(u[j].x * rstd2, u[j].y * rstd2, 0, false); w8 = __builtin_amdgcn_cvt_pk_fp8_f32(u[j].z * rstd2, u[j].w * rstd2, w8, true); r8[64 * j] = (unsigned)w8; } }
    }
}


constexpr size_t AUX_KP = 0, AUX_VV = 256, AUX_KIN = 512, AUX_MASK = 640, AUX_END = 896;
typedef short bf16x8_t __attribute__((ext_vector_type(8)));
typedef float f32x16 __attribute__((ext_vector_type(16)));
__device__ __forceinline__ int crow(int r, int hi) { return (r & 3) + 8 * (r >> 2) + 4 * hi; }
__device__ __forceinline__ float xhalf_sum(float v) { auto rr = __builtin_amdgcn_permlane32_swap(__float_as_uint(v), __float_as_uint(v), false, false); return __uint_as_float(rr[0]) + __uint_as_float(rr[1]); }
__device__ __forceinline__ float sumsq8(bf16x8_t v) { float s = 0.f;
#pragma unroll
    for (int j = 0; j < 8; ++j) { const float f = __uint_as_float((unsigned)(unsigned short)v[j] << 16); s += f * f; } return s; }
__device__ __forceinline__ void p2_post(Frame& F, const Args& a) {
    const int gw = F.vcu * NWAVES + F.wave, NGW = F.G * NWAVES, lane = F.lane, r32 = lane & 31, hi = lane >> 5;
    const size_t nt_ = (size_t)F.ntok;
    const bf16* CKV = (const bf16*)(F.act + nt_ * O_CKV); const bf16* KW = (const bf16*)(F.act + nt_ * O_KW);
    const bf16* Wkv_t = (const bf16*)(F.ws + WS_WKV);
    unsigned char* aux = a.xb + nt_ * 2048;
    bf16* KP = (bf16*)(aux + nt_ * AUX_KP); bf16* VV = (bf16*)(aux + nt_ * AUX_VV); bf16* KIN = (bf16*)(aux + nt_ * AUX_KIN);
    const float* g_q = a.in[5]; const float* g_k = a.in[6]; const float* g_ki = a.in[7];
    constexpr int WP = 528;
    LAS unsigned char* Wl = F.lds + RING_OFF; LAS float* gl = (LAS float*)(F.lds + RING_OFF + 256 * WP);
    for (int i = F.tid; i < 256 * 32; i += NWAVES * 64) { const int n = i >> 5, ch = i & 31; *(LAS v4u*)(Wl + n * WP + ch * 16) = *(const v4u*)(Wkv_t + (size_t)n * 256 + ch * 8); }
    if (F.tid < 128) gl[F.tid] = g_k[F.tid] * g_q[F.tid] * (0.08838834764831845f * 1.4426950408889634f);
    else if (F.tid < 192) gl[F.tid] = g_ki[F.tid - 128];
    __syncthreads();
    const int ntask = 2 * (F.ntok / 32);
    for (int task = gw; task < ntask; task += NGW) {
        const int kind = task & 1, t0 = (task >> 1) * 32;
        const unsigned char* crowp = (const unsigned char*)CKV + (size_t)(t0 + r32) * 256 + hi * 8;
        bf16x8_t bfr[16]; float ss = 0.f;
#pragma unroll
        for (int kk = 0; kk < 16; ++kk) { const unsigned long long c8 = *(const unsigned long long*)(crowp + kk * 16); const int lo = (int)(unsigned)c8, hi32 = (int)(unsigned)(c8 >> 32);
            const auto a_ = __builtin_amdgcn_cvt_pk_f32_fp8(lo, false), b_ = __builtin_amdgcn_cvt_pk_f32_fp8(lo, true), c_ = __builtin_amdgcn_cvt_pk_f32_fp8(hi32, false), d_ = __builtin_amdgcn_cvt_pk_f32_fp8(hi32, true);
            ss += (a_[0] * a_[0] + a_[1] * a_[1]) + (b_[0] * b_[0] + b_[1] * b_[1]) + (c_[0] * c_[0] + c_[1] * c_[1]) + (d_[0] * d_[0] + d_[1] * d_[1]);
            v4u pk; pk.x = pk2(a_[0], a_[1]); pk.y = pk2(b_[0], b_[1]); pk.z = pk2(c_[0], c_[1]); pk.w = pk2(d_[0], d_[1]); bfr[kk] = __builtin_bit_cast(bf16x8_t, pk); }
        ss = xhalf_sum(ss);
        const float rstd = rsqrtf(ss * (1.f / 256.f) + EPS);
        f32x16 acc[4];
#pragma unroll
        for (int nt = 0; nt < 4; ++nt) { acc[nt] = f32x16{};
            const LAS unsigned char* wrow = Wl + (kind * 128 + nt * 32 + r32) * WP + hi * 16;
#pragma unroll
            for (int kk = 0; kk < 16; ++kk) { const bf16x8_t af = *(const LAS bf16x8_t*)(wrow + kk * 32); acc[nt] = __builtin_amdgcn_mfma_f32_32x32x16_bf16(af, bfr[kk], acc[nt], 0, 0, 0); if ((kk & 3) == 3) __builtin_amdgcn_sched_barrier(0); } }
        float sc = rstd;
        if (kind == 0) { float sk = 0.f;
#pragma unroll
            for (int nt = 0; nt < 4; ++nt)
#pragma unroll
                for (int r = 0; r < 16; ++r) { const float v = acc[nt][r] * rstd; sk += v * v; }
            sk = xhalf_sum(sk);
            sc = rstd * rsqrtf(sk * (1.f / 128.f) + EPS); }
        bf16* orow = (kind == 0 ? KP : VV) + (size_t)(t0 + r32) * 128;
#pragma unroll
        for (int nt = 0; nt < 4; ++nt)
#pragma unroll
            for (int g = 0; g < 4; ++g) { const int ch = nt * 32 + 8 * g + 4 * hi; float v[4];
#pragma unroll
                for (int j = 0; j < 4; ++j) { v[j] = acc[nt][4 * g + j] * sc; if (kind == 0) v[j] *= gl[ch + j]; }
                *(unsigned long long*)(orow + ch) = (unsigned long long)pk2(v[0], v[1]) | ((unsigned long long)pk2(v[2], v[3]) << 32); }
        if (kind == 0) {
            const bf16* kr = KW + (size_t)(t0 + r32) * 128 + hi * 32; bf16x8_t kv4[4]; float s2 = 0.f;
#pragma unroll
            for (int j = 0; j < 4; ++j) { kv4[j] = *(const bf16x8_t*)(kr + 8 * j); s2 += sumsq8(kv4[j]); }
            s2 = xhalf_sum(s2);
            const float rk = rsqrtf(s2 * (1.f / 64.f) + EPS);
            bf16* ko = KIN + (size_t)(t0 + r32) * 64 + hi * 32;
#pragma unroll
            for (int j = 0; j < 4; ++j) { float f[8];
#pragma unroll
                for (int e = 0; e < 8; ++e) f[e] = __uint_as_float((unsigned)(unsigned short)kv4[j][e] << 16) * rk * gl[128 + hi * 32 + 8 * j + e];
                v4u o; o.x = pk2(f[0], f[1]); o.y = pk2(f[2], f[3]); o.z = pk2(f[4], f[5]); o.w = pk2(f[6], f[7]);
                *(v4u*)(ko + 8 * j) = o; }
        }
    }
    __syncthreads();
}

typedef float f32x4_t __attribute__((ext_vector_type(4)));
__device__ __forceinline__ unsigned key15_of(float s) { const unsigned short hb = __builtin_bit_cast(unsigned short, (_Float16)s); const unsigned u = (hb & 0x8000u) ? (~(unsigned)hb & 0xffffu) : ((unsigned)hb | 0x8000u); return u >> 1; }
__device__ __forceinline__ unsigned sad4(unsigned x) { return __builtin_amdgcn_sad_u8(x, 0u, 0u); }
__device__ __forceinline__ void p3_merge(LAS unsigned* hist, LAS unsigned short* tot, int w, int g, int q, int& need, int& bsel) {
    __syncthreads();
    const int o = 4 * w + g; unsigned c = 0;
#pragma unroll
    for (int p = 0; p < 32; ++p) { const int tidp = (p >> 2) * 64 + (p & 3) * 16 + q; c += (hist[(o >> 2) * 512 + tidp] >> (8 * (o & 3))) & 0xffu; }
    tot[q * 32 + o] = (unsigned short)c;
    __syncthreads();
    v4u tv[4];
#pragma unroll
    for (int j = 0; j < 4; ++j) tv[j] = *(const LAS v4u*)((const LAS unsigned char*)tot + q * 64 + j * 16);
    int cum = 0, bs = 0, ab = 0; bool found = false;
#pragma unroll
    for (int bin = 31; bin >= 0; --bin) { const unsigned wd = tv[bin >> 3][(bin >> 1) & 3]; const int cc = (int)((bin & 1) ? (wd >> 16) : (wd & 0xffffu));
        if (!found && cum + cc >= need) { bs = bin; ab = cum; found = true; } cum += cc; }
    bsel = bs; need -= ab;
}
__device__ __forceinline__ void p3_index(Frame& F, const Args& a) {
    const int tid = F.tid, lane = F.lane, w = F.wave, q = lane & 15, g = lane >> 4;
    LAS unsigned* keys = (LAS unsigned*)(F.lds + RING_OFF);
    LAS unsigned char* qbuf = F.lds + 65536;
    LAS unsigned* hist = (LAS unsigned*)(F.lds + P3_HIST_OFF);
    LAS unsigned short* tot = (LAS unsigned short*)(F.lds + P3_TOT_OFF);
    LAS unsigned char* Tt = (LAS unsigned char*)(F.lds + P3_T_OFF);
    const size_t nt_ = (size_t)F.ntok;
    const bf16* QI = (const bf16*)(F.act + nt_ * O_QI); const bf16* KW = (const bf16*)(F.act + nt_ * O_KW);
    unsigned char* aux = a.xb + nt_ * 2048;
    const bf16* KIN = (const bf16*)(aux + nt_ * AUX_KIN); unsigned* MASK = (unsigned*)(aux + nt_ * AUX_MASK);
    const int nb = F.ntok / SEQ, nitems = nb * 128; const int bxj = (int)blockIdx.x >> 3;
    const int G = F.G - F.G / 4, c = (bxj - (bxj >> 2) - 1) * 8 + ((int)blockIdx.x & 7);
#define P3_ITEM(k) ((k) * G + (((k) & 1) ? (G - 1 - c) : c))
#define P3_QDMA(it_, buf_) do { const int qg_ = 127 - (it_) / nb, b_ = (it_) % nb; _Pragma("unroll") for (int i_ = 0; i_ < 2; ++i_) { const int row_ = w * 2 + i_; \
        const char* src_ = (const char*)(QI + ((size_t)b_ * SEQ + qg_ * 16 + row_) * 512) + ((lane ^ (row_ & 15)) * 16); \
        __builtin_amdgcn_global_load_lds((const unsigned*)src_, (LAS unsigned*)(qbuf + (buf_) * 16384 + row_ * 1024), 16, 0, 0); } } while (0)
    const int nround = (nitems + G - 1) / G;
    if (P3_ITEM(0) < nitems) P3_QDMA(P3_ITEM(0), 0);
    v4u wvn = (v4u){0u, 0u, 0u, 0u};
    if (P3_ITEM(0) < nitems) { const int it0 = P3_ITEM(0); wvn = *(const v4u*)(KW + ((size_t)(it0 % nb) * SEQ + (127 - it0 / nb) * 16 + q) * 128 + 64); }
    for (int k = 0; k < nround; ++k) {
        const int it = P3_ITEM(k); if (it >= nitems) break;
        const int qg = 127 - it / nb, b = it % nb, q0 = qg * 16, qme = q0 + q;
        unsigned* Mb = MASK + (size_t)b * 64 * 2048;
        const int kb_hi = ((qg >> 3) + 1) << 2, nkb = (qg >> 1) + 1;
        asm volatile("s_waitcnt vmcnt(0) lgkmcnt(0)\n\ts_barrier" ::: "memory");
        const v4u wv = wvn;
        { const int itn = P3_ITEM(k + 1); if (k + 1 < nround && itn < nitems) { P3_QDMA(itn, (k + 1) & 1); wvn = *(const v4u*)(KW + ((size_t)(itn % nb) * SEQ + (127 - itn / nb) * 16 + q) * 128 + 64); } }
        if (qg < 16) {
            if (tid < kb_hi * 16) { const int kb = tid >> 4, qq = q0 + (tid & 15), nbits = qq - kb * 32 + 1; Mb[kb * 2048 + qq] = nbits >= 32 ? 0xffffffffu : (nbits <= 0 ? 0u : ((1u << nbits) - 1u)); }
            continue;
        }
        float wq[8];
        { const float cc = 0.35355339059327373f * 0.125f;
          wq[0] = pg8::bf_lo(wv.x) * cc; wq[1] = pg8::bf_hi(wv.x) * cc; wq[2] = pg8::bf_lo(wv.y) * cc; wq[3] = pg8::bf_hi(wv.y) * cc; wq[4] = pg8::bf_lo(wv.z) * cc; wq[5] = pg8::bf_hi(wv.z) * cc; wq[6] = pg8::bf_lo(wv.w) * cc; wq[7] = pg8::bf_hi(wv.w) * cc; }
        bf16x8_t qfr[8][2], qlin[2];
        { const LAS unsigned char* qrow = qbuf + (k & 1) * 16384 + q * 1024;
#pragma unroll
          for (int h = 0; h < 8; ++h)
#pragma unroll
            for (int ks = 0; ks < 2; ++ks) qfr[h][ks] = *(const LAS bf16x8_t*)(qrow + (((h * 8 + ks * 4 + g) ^ q) * 16)); }
#pragma unroll
        for (int ks = 0; ks < 2; ++ks) { float f[8];
#pragma unroll
            for (int j = 0; j < 8; ++j) { float s = 0.f;
#pragma unroll
                for (int h = 0; h < 8; ++h) s += wq[h] * __uint_as_float((unsigned)(unsigned short)qfr[h][ks][j] << 16);
                f[j] = s; }
            v4u o; o.x = pk2(f[0], f[1]); o.y = pk2(f[2], f[3]); o.z = pk2(f[4], f[5]); o.w = pk2(f[6], f[7]); qlin[ks] = __builtin_bit_cast(bf16x8_t, o); }
#pragma unroll
        for (int i = 0; i < 8; ++i) hist[i * 512 + tid] = 0u;
        const bf16* kbase = KIN + ((size_t)b * SEQ + q) * 64 + g * 8;
        bf16x8_t afr[2][2], afn[2][2];
#pragma unroll
        for (int t = 0; t < 2; ++t)
#pragma unroll
            for (int ks = 0; ks < 2; ++ks) afn[t][ks] = *(const bf16x8_t*)(kbase + (size_t)(w * 32 + t * 16) * 64 + ks * 32);
        for (int s = 0, kb = w; kb < nkb; ++s, kb += 8) {
            const bool diag = (kb == nkb - 1);
#pragma unroll
            for (int t = 0; t < 2; ++t)
#pragma unroll
                for (int ks = 0; ks < 2; ++ks) afr[t][ks] = afn[t][ks];
            if (kb + 8 < nkb) {
#pragma unroll
                for (int t = 0; t < 2; ++t)
#pragma unroll
                    for (int ks = 0; ks < 2; ++ks) afn[t][ks] = *(const bf16x8_t*)(kbase + (size_t)((kb + 8) * 32 + t * 16) * 64 + ks * 32); }
#pragma unroll
            for (int t = 0; t < 2; ++t) {
                f32x4_t sacc = f32x4_t{};
#pragma unroll
                for (int ks = 0; ks < 2; ++ks) sacc = __builtin_amdgcn_mfma_f32_16x16x32_bf16(afr[t][ks], qlin[ks], sacc, 0, 0, 0);
#pragma unroll
                for (int h = 0; h < 8; ++h) { f32x4_t d = f32x4_t{};
#pragma unroll
                    for (int ks = 0; ks < 2; ++ks) d = __builtin_amdgcn_mfma_f32_16x16x32_bf16(afr[t][ks], qfr[h][ks], d, 0, 0, 0);
#pragma unroll
                    for (int r = 0; r < 4; ++r) sacc[r] = fmaf(fabsf(d[r]), wq[h], sacc[r]); }
#pragma unroll
                for (int i = 0; i < 2; ++i) { unsigned k2[2];
#pragma unroll
                    for (int e = 0; e < 2; ++e) { const int r = 2 * i + e; unsigned kk_ = key15_of(sacc[r]); if (diag && kb * 32 + t * 16 + 4 * g + r > qme) kk_ = 0u; k2[e] = kk_;
                        const unsigned dg = kk_ >> 10; (void)__hip_atomic_fetch_add((LAS unsigned*)&hist[(dg >> 2) * 512 + tid], 1u << ((dg & 3u) * 8u), __ATOMIC_RELAXED, __HIP_MEMORY_SCOPE_WORKGROUP); }
                    keys[(s * 4 + t * 2 + i) * 512 + tid] = k2[0] | (k2[1] << 16); }
            }
        }
        int need = 256, bsel;
        p3_merge(hist, tot, w, g, q, need, bsel);
        unsigned prefix = (unsigned)bsel;
#pragma unroll
        for (int pass = 0; pass < 2; ++pass) {
            const int sh_hi = pass == 0 ? 10 : 5, sh = pass == 0 ? 5 : 0;
#pragma unroll
            for (int i = 0; i < 8; ++i) hist[i * 512 + tid] = 0u;
#pragma unroll
            for (int s = 0; s < 8; ++s) if (w + 8 * s < nkb) {
#pragma unroll
                for (int i = 0; i < 4; ++i) { const unsigned d2 = keys[(s * 4 + i) * 512 + tid];
#pragma unroll
                    for (int e = 0; e < 2; ++e) { const unsigned kk_ = e ? (d2 >> 16) : (d2 & 0xffffu);
                        if ((kk_ >> sh_hi) == prefix) { const unsigned dg = (kk_ >> sh) & 31u; (void)__hip_atomic_fetch_add((LAS unsigned*)&hist[(dg >> 2) * 512 + tid], 1u << ((dg & 3u) * 8u), __ATOMIC_RELAXED, __HIP_MEMORY_SCOPE_WORKGROUP); } } } }
            p3_merge(hist, tot, w, g, q, need, bsel);
            prefix = (prefix << 5) | (unsigned)bsel;
        }
        const unsigned tau = prefix; const int need_eq = need;
        unsigned gtw[8], eqw[8];
#pragma unroll
        for (int s = 0; s < 8; ++s) { const int kb = w + 8 * s; gtw[s] = 0u; eqw[s] = 0u;
            if (kb < nkb) { unsigned gg = 0u, qq = 0u;
#pragma unroll
                for (int i = 0; i < 4; ++i) { const unsigned d2 = keys[(s * 4 + i) * 512 + tid];
#pragma unroll
                    for (int e = 0; e < 2; ++e) { const unsigned kk_ = e ? (d2 >> 16) : (d2 & 0xffffu); const int bit = (i >> 1) * 16 + 4 * g + (i & 1) * 2 + e;
                        gg |= (kk_ > tau ? 1u : 0u) << bit; qq |= (kk_ == tau ? 1u : 0u) << bit; } }
                gg |= (unsigned)__shfl_xor((int)gg, 16); gg |= (unsigned)__shfl_xor((int)gg, 32); qq |= (unsigned)__shfl_xor((int)qq, 16); qq |= (unsigned)__shfl_xor((int)qq, 32);
                gtw[s] = gg; eqw[s] = qq;
                if (g == 0) Tt[q * 64 + kb] = (unsigned char)__builtin_popcount(qq); } }
        __syncthreads();
        { unsigned run = 0u;
#pragma unroll
          for (int s = 0; s < 8; ++s) { const int kb = w + 8 * s;
            if (kb < nkb) { const unsigned g0 = *(const LAS unsigned*)(Tt + q * 64 + 8 * s), g1 = *(const LAS unsigned*)(Tt + q * 64 + 8 * s + 4);
                const unsigned m0 = w >= 4 ? g0 : (w == 0 ? 0u : (g0 & ((1u << (8 * w)) - 1u))), m1 = w > 4 ? (g1 & ((1u << (8 * (w - 4))) - 1u)) : 0u;
                const int pre = (int)(run + sad4(m0) + sad4(m1)), m = need_eq - pre, pc = __builtin_popcount(eqw[s]);
                unsigned se = eqw[s];
                if (m < pc) { se = 0u; unsigned x = eqw[s]; for (int i = 0; i < m; ++i) { const unsigned bb = x & (0u - x); se |= bb; x ^= bb; } }
                if (g == 0) Mb[kb * 2048 + qme] = gtw[s] | se;
                run += sad4(g0) + sad4(g1); } } }
        if (tid < (kb_hi - nkb) * 16) Mb[(nkb + (tid >> 4)) * 2048 + q0 + (tid & 15)] = 0u;
    }
    asm volatile("s_waitcnt vmcnt(0) lgkmcnt(0)" ::: "memory");
    __syncthreads();
#undef P3_ITEM
#undef P3_QDMA
}

namespace att {
using bf16x8 = __attribute__((ext_vector_type(8))) short;
using s16x4  = __attribute__((ext_vector_type(4))) short;
using u32x4  = __attribute__((ext_vector_type(4))) unsigned;
constexpr int KVBLK = 64;
constexpr size_t SHM_V = KVBLK * 128 * 2, SHM_K = KVBLK * 128 * 2;
constexpr int OFF_WS = 65536, OFF_MK = 65536 + 2048, OFF_Q = 65536 + 2048 + 8192, QPITCH = 272;
constexpr float THR2 = 11.5f;
#define KSWZ(row, colB) ((row) * 256 + ((colB) ^ (((row) & 7) << 4)))
#define SBAR() __builtin_amdgcn_sched_barrier(0)
__device__ __forceinline__ unsigned cvtpk(float lo, float hi) { unsigned r; asm volatile("v_cvt_pk_bf16_f32 %0, %1, %2" : "=v"(r) : "v"(lo), "v"(hi)); return r; }
__device__ __forceinline__ float msk(float p, unsigned w, int bit) { const int m = __builtin_amdgcn_sbfe((int)w, bit, 1); return __uint_as_float((__float_as_uint(p) & (unsigned)m) | (0xff800000u & ~(unsigned)m)); }
__device__ __forceinline__ void partialSM(f32x16& p0, f32x16& p1, unsigned w0, unsigned w1, float& m_reg, float& mn, float& alpha) {
#pragma unroll
  for (int r = 0; r < 16; ++r) { const int bit = (r & 3) + 8 * (r >> 2); p0[r] = msk(p0[r], w0, bit); p1[r] = msk(p1[r], w1, bit); }
  float pmax = p0[0];
#pragma unroll
  for (int r = 1; r < 16; ++r) pmax = fmaxf(pmax, p0[r]);
#pragma unroll
  for (int r = 0; r < 16; ++r) pmax = fmaxf(pmax, p1[r]);
  { auto rr = __builtin_amdgcn_permlane32_swap(__float_as_uint(pmax), __float_as_uint(pmax), false, false); pmax = fmaxf(__uint_as_float(rr[0]), __uint_as_float(rr[1])); }
  if (__builtin_expect(__all(pmax - m_reg <= THR2), 1)) { mn = m_reg; alpha = 1.f; }
  else { mn = fmaxf(m_reg, pmax); alpha = __builtin_amdgcn_exp2f(m_reg - mn); m_reg = mn; }
#pragma unroll
  for (int r = 0; r < 16; ++r) { p0[r] -= mn; p1[r] -= mn; }
#pragma unroll
  for (int r = 0; r < 16; ++r) p0[r] = __builtin_amdgcn_exp2f(p0[r]);
}
__device__ __forceinline__ void finishSM(f32x16& p0, f32x16& p1, float alpha, float& l_reg, bf16x8& pa0, bf16x8& pa1, bf16x8& pa2, bf16x8& pa3) {
#pragma unroll
  for (int r = 0; r < 16; ++r) p1[r] = __builtin_amdgcn_exp2f(p1[r]);
  float ps = 0;
#pragma unroll
  for (int r = 0; r < 16; ++r) ps += p0[r];
#pragma unroll
  for (int r = 0; r < 16; ++r) ps += p1[r];
  { auto rr = __builtin_amdgcn_permlane32_swap(__float_as_uint(ps), __float_as_uint(ps), false, false); ps = __uint_as_float(rr[0]) + __uint_as_float(rr[1]); }
  l_reg = l_reg * alpha + ps;
#define PK4(P, BASE, OUT) do { unsigned a0 = cvtpk(P[BASE + 0], P[BASE + 1]), a1 = cvtpk(P[BASE + 2], P[BASE + 3]);   \
    unsigned b0 = cvtpk(P[BASE + 4], P[BASE + 5]), b1 = cvtpk(P[BASE + 6], P[BASE + 7]);                              \
    auto r0 = __builtin_amdgcn_permlane32_swap(a0, b0, false, false); auto r1 = __builtin_amdgcn_permlane32_swap(a1, b1, false, false); \
    u32x4 w = {r0[0], r1[0], r0[1], r1[1]}; OUT = *reinterpret_cast<bf16x8*>(&w); } while (0)
  PK4(p0, 0, pa0); PK4(p0, 8, pa1); PK4(p1, 0, pa2); PK4(p1, 8, pa3);
#undef PK4
}
__device__ __forceinline__ void qkt(f32x16& p0, f32x16& p1, const char* Ks, const char* qrow, const float (&bo)[16], float kb0, float kb1, int r32, int hi) {
#pragma unroll
  for (int r = 0; r < 16; ++r) { p0[r] = bo[r] + kb0; p1[r] = bo[r] + kb1; }
#pragma unroll
  for (int d0 = 0; d0 < 8; ++d0) { const int cb = (d0 * 16 + hi * 8) * 2;
    const bf16x8 b0 = *reinterpret_cast<const bf16x8*>(Ks + KSWZ(r32, cb));
    const bf16x8 b1 = *reinterpret_cast<const bf16x8*>(Ks + KSWZ(32 + r32, cb));
    const bf16x8 qf = *reinterpret_cast<const bf16x8*>(qrow + d0 * 32);
    p0 = __builtin_amdgcn_mfma_f32_32x32x16_bf16(b0, qf, p0, 0, 0, 0);
    p1 = __builtin_amdgcn_mfma_f32_32x32x16_bf16(b1, qf, p1, 0, 0, 0); }
}
__device__ __forceinline__ int v_st(int k, int c) { const int kk = (k & ~0xC) | ((k & 4) << 1) | ((k & 8) >> 1); return ((kk >> 3) * 4 + (c >> 5)) * 512 + ((kk & 7) * 32 + (c & 31)) * 2; }
__device__ __forceinline__ int v_rd_base(int lane) { return ((lane & 3) << 3) | (((lane >> 2) & 3) << 6) | (((lane >> 4) & 1) << 5) | (((lane >> 5) & 1) << 8); }
constexpr int v_rd_off(int d0, int ks, int half) { return d0 * 512 + ks * 4096 + half * 2048; }
template <int OFF> __device__ __forceinline__ s16x4 tr_read(int vb) { s16x4 r; asm volatile("ds_read_b64_tr_b16 %0, %1 offset:%2" : "=&v"(r) : "v"(vb), "i"(OFF) : "memory"); return r; }
template <int D0> __device__ __forceinline__ void pv_one(f32x16& od, int vb, bf16x8 pa0, bf16x8 pa1, bf16x8 pa2, bf16x8 pa3) {
  const s16x4 l0 = tr_read<v_rd_off(D0, 0, 0)>(vb), h0 = tr_read<v_rd_off(D0, 0, 1)>(vb), l1 = tr_read<v_rd_off(D0, 1, 0)>(vb), h1 = tr_read<v_rd_off(D0, 1, 1)>(vb);
  const s16x4 l2 = tr_read<v_rd_off(D0, 2, 0)>(vb), h2 = tr_read<v_rd_off(D0, 2, 1)>(vb), l3 = tr_read<v_rd_off(D0, 3, 0)>(vb), h3 = tr_read<v_rd_off(D0, 3, 1)>(vb);
  asm volatile("s_waitcnt lgkmcnt(0)" ::: "memory"); SBAR();
#define PK(L, H) (bf16x8){L[0], L[1], L[2], L[3], H[0], H[1], H[2], H[3]}
  od = __builtin_amdgcn_mfma_f32_32x32x16_bf16(pa0, PK(l0, h0), od, 0, 0, 0);
  od = __builtin_amdgcn_mfma_f32_32x32x16_bf16(pa1, PK(l1, h1), od, 0, 0, 0);
  od = __builtin_amdgcn_mfma_f32_32x32x16_bf16(pa2, PK(l2, h2), od, 0, 0, 0);
  od = __builtin_amdgcn_mfma_f32_32x32x16_bf16(pa3, PK(l3, h3), od, 0, 0, 0);
#undef PK
}
__device__ __forceinline__ void pv_d0(f32x16* o, int vb, bf16x8 pa0, bf16x8 pa1, bf16x8 pa2, bf16x8 pa3) {
  pv_one<0>(o[0], vb, pa0, pa1, pa2, pa3); pv_one<1>(o[1], vb, pa0, pa1, pa2, pa3); pv_one<2>(o[2], vb, pa0, pa1, pa2, pa3); pv_one<3>(o[3], vb, pa0, pa1, pa2, pa3);
}
__device__ __forceinline__ void attn_item(const bf16* __restrict__ Qb, const bf16* __restrict__ Kh, const bf16* __restrict__ Vh, const unsigned* __restrict__ Mq, bf16* __restrict__ Ob, int NT, char* lds, LAS unsigned char* ldsL) {
  const int tid = threadIdx.x, wid = __builtin_amdgcn_readfirstlane(tid >> 6), lane = tid & 63, r32 = lane & 31, hi = lane >> 5;
  float* ws = (float*)(lds + OFF_WS) + wid * 64; float* li_l = ws; float* al_l = ws + 32;
  unsigned* mk = (unsigned*)(lds + OFF_MK);
  unsigned soff[4];
#pragma unroll
  for (int i = 0; i < 4; ++i) { const int pc = (wid & 3) * 4 + i;
    if (wid < 4) { const int row = pc * 4 + (lane >> 4), cb = (lane & 15) * 16; soff[i] = (unsigned)(row * 256 + (cb ^ ((row & 7) << 4))); }
    else { const int L = pc * 1024 + lane * 16, st = L >> 9, wi = L & 511, kk = (st >> 2) * 8 + (wi >> 6), c = (st & 3) * 32 + ((wi & 63) >> 1), k = (kk & ~0xC) | ((kk & 4) << 1) | ((kk & 8) >> 1);
           soff[i] = (unsigned)(k * 256 + c * 2); } }
  const char* gsrc = (const char*)(wid < 4 ? Kh : Vh);
  const unsigned ldst = (unsigned)((wid < 4 ? 0 : 16384) + (wid & 3) * 4096);
#define DMA_TILE(t, slot) do { _Pragma("unroll") for (int i_ = 0; i_ < 4; ++i_) \
    __builtin_amdgcn_global_load_lds((const unsigned*)(gsrc + (size_t)(t) * (64 * 256) + soff[i_]), (LAS unsigned*)(ldsL + (slot) * 32768 + ldst + i_ * 1024), 16, 0, 0); } while (0)
  DMA_TILE(0, 0);
  float m_reg = 0.f, l_reg = 0; f32x16 o[4] = {}; bf16x8 qr[8];
  { const unsigned char* Qw = (const unsigned char*)Qb + (size_t)r32 * 1024 + wid * 128 + hi * 8; float ss = 0.f; unsigned long long q8[8];
#pragma unroll
    for (int d0 = 0; d0 < 8; ++d0) q8[d0] = *reinterpret_cast<const unsigned long long*>(Qw + d0 * 16);
    unsigned mv[4];
#pragma unroll
    for (int i = 0; i < 4; ++i) { const int idx = tid + 512 * i; mv[i] = idx < NT * 64 ? Mq[(size_t)(idx >> 5) * 2048 + (idx & 31)] : 0u; }
#pragma unroll
    for (int i = 0; i < 4; ++i) { const int idx = tid + 512 * i; if (idx < NT * 64) mk[idx] = mv[i]; }
    float qf[8][8];
#pragma unroll
    for (int d0 = 0; d0 < 8; ++d0) { const int lo = (int)(unsigned)q8[d0], hi32 = (int)(unsigned)(q8[d0] >> 32);
      const auto a_ = __builtin_amdgcn_cvt_pk_f32_fp8(lo, false), b_ = __builtin_amdgcn_cvt_pk_f32_fp8(lo, true), c_ = __builtin_amdgcn_cvt_pk_f32_fp8(hi32, false), d_ = __builtin_amdgcn_cvt_pk_f32_fp8(hi32, true);
      qf[d0][0] = a_[0]; qf[d0][1] = a_[1]; qf[d0][2] = b_[0]; qf[d0][3] = b_[1]; qf[d0][4] = c_[0]; qf[d0][5] = c_[1]; qf[d0][6] = d_[0]; qf[d0][7] = d_[1];
#pragma unroll
      for (int j = 0; j < 8; ++j) ss += qf[d0][j] * qf[d0][j]; }
    ss = xhalf_sum(ss); const float rq = rsqrtf(ss * (1.f / 128.f) + EPS);
#pragma unroll
    for (int d0 = 0; d0 < 8; ++d0) { u32x4 w = {cvtpk(qf[d0][0] * rq, qf[d0][1] * rq), cvtpk(qf[d0][2] * rq, qf[d0][3] * rq), cvtpk(qf[d0][4] * rq, qf[d0][5] * rq), cvtpk(qf[d0][6] * rq, qf[d0][7] * rq)}; qr[d0] = *reinterpret_cast<bf16x8*>(&w); } }
  const float slope2 = __builtin_amdgcn_exp2f(-(float)(wid + 1)) * 1.4426950408889634f;
  float bo[16];
#pragma unroll
  for (int r = 0; r < 16; ++r) bo[r] = __uint_as_float(__builtin_amdgcn_readfirstlane(__float_as_uint(slope2 * (float)((r & 3) + 8 * (r >> 2)))));
  const float hoff = slope2 * (float)(4 * hi);
  const int vb0 = (int)(uintptr_t)(lds + 16384) + v_rd_base(lane);
  asm volatile("s_waitcnt vmcnt(0) lgkmcnt(0)\n\ts_barrier" ::: "memory");
  for (int j = 0; j < NT; ++j) {
    const int sl = j & 1;
    if (j + 1 < NT) DMA_TILE(j + 1, sl ^ 1);
    const char* Ks = lds + sl * 32768;
    const unsigned w0 = mk[(2 * j) * 32 + r32] >> (4 * hi), w1 = mk[(2 * j + 1) * 32 + r32] >> (4 * hi);
    f32x16 p0, p1;
    { const float kb0 = slope2 * (float)(j * 64) + hoff - m_reg, kb1 = kb0 + slope2 * 32.f;
#pragma unroll
      for (int r = 0; r < 16; ++r) { p0[r] = bo[r] + kb0; p1[r] = bo[r] + kb1; }
      bf16x8 ka = *reinterpret_cast<const bf16x8*>(Ks + KSWZ(r32, hi * 16)), kb = *reinterpret_cast<const bf16x8*>(Ks + KSWZ(32 + r32, hi * 16));
#pragma unroll
      for (int d0 = 0; d0 < 8; ++d0) { bf16x8 na = ka, nb = kb;
        if (d0 < 7) { const int cb = ((d0 + 1) * 16 + hi * 8) * 2; na = *reinterpret_cast<const bf16x8*>(Ks + KSWZ(r32, cb)); nb = *reinterpret_cast<const bf16x8*>(Ks + KSWZ(32 + r32, cb)); }
        SBAR();
        p0 = __builtin_amdgcn_mfma_f32_32x32x16_bf16(ka, qr[d0], p0, 0, 0, 0);
        p1 = __builtin_amdgcn_mfma_f32_32x32x16_bf16(kb, qr[d0], p1, 0, 0, 0);
        SBAR();
        ka = na; kb = nb; } }
    float alpha; bf16x8 pa0, pa1, pa2, pa3;
    {
#pragma unroll
      for (int r = 0; r < 16; ++r) { const int bit = (r & 3) + 8 * (r >> 2); p0[r] = msk(p0[r], w0, bit); p1[r] = msk(p1[r], w1, bit); }
      float pmax = fmaxf(p0[0], p1[0]);
#pragma unroll
      for (int r = 1; r < 16; ++r) pmax = fmaxf(fmaxf(pmax, p0[r]), p1[r]);
      { auto rr = __builtin_amdgcn_permlane32_swap(__float_as_uint(pmax), __float_as_uint(pmax), false, false); pmax = fmaxf(__uint_as_float(rr[0]), __uint_as_float(rr[1])); }
      alpha = 1.f;
      if (__builtin_expect(!__all(pmax <= THR2), 0)) {
        const float dl = fmaxf(pmax, 0.f); m_reg += dl; alpha = __builtin_amdgcn_exp2f(-dl);
#pragma unroll
        for (int r = 0; r < 16; ++r) { p0[r] -= dl; p1[r] -= dl; } }
      float ps = 0.f;
#pragma unroll
      for (int r = 0; r < 16; ++r) { p0[r] = __builtin_amdgcn_exp2f(p0[r]); p1[r] = __builtin_amdgcn_exp2f(p1[r]); ps += p0[r] + p1[r]; }
      { auto rr = __builtin_amdgcn_permlane32_swap(__float_as_uint(ps), __float_as_uint(ps), false, false); ps = __uint_as_float(rr[0]) + __uint_as_float(rr[1]); }
      l_reg = l_reg * alpha + ps;
#define PK4(P, BASE, OUT) do { unsigned a0 = cvtpk(P[BASE + 0], P[BASE + 1]), a1 = cvtpk(P[BASE + 2], P[BASE + 3]);   \
    unsigned b0 = cvtpk(P[BASE + 4], P[BASE + 5]), b1 = cvtpk(P[BASE + 6], P[BASE + 7]);                              \
    auto r0 = __builtin_amdgcn_permlane32_swap(a0, b0, false, false); auto r1 = __builtin_amdgcn_permlane32_swap(a1, b1, false, false); \
    u32x4 w = {r0[0], r1[0], r0[1], r1[1]}; OUT = *reinterpret_cast<bf16x8*>(&w); } while (0)
      PK4(p0, 0, pa0); PK4(p0, 8, pa1); PK4(p1, 0, pa2); PK4(p1, 8, pa3);
#undef PK4
      if (__any(alpha < 1.f)) { if (hi == 0) al_l[r32] = alpha; asm volatile("s_waitcnt lgkmcnt(0)" ::: "memory");
#pragma unroll
        for (int d = 0; d < 4; ++d)
#pragma unroll
          for (int r = 0; r < 16; ++r) o[d][r] *= al_l[crow(r, hi)]; }
    }
    { const int vb = vb0 + sl * 32768;
      s16x4 lA[4], hA[4], lB[4], hB[4];
#define VREADS(L_, H_, D0) do { L_[0] = tr_read<v_rd_off(D0, 0, 0)>(vb); H_[0] = tr_read<v_rd_off(D0, 0, 1)>(vb); L_[1] = tr_read<v_rd_off(D0, 1, 0)>(vb); H_[1] = tr_read<v_rd_off(D0, 1, 1)>(vb); \
      L_[2] = tr_read<v_rd_off(D0, 2, 0)>(vb); H_[2] = tr_read<v_rd_off(D0, 2, 1)>(vb); L_[3] = tr_read<v_rd_off(D0, 3, 0)>(vb); H_[3] = tr_read<v_rd_off(D0, 3, 1)>(vb); } while (0)
#define PK(L, H) (bf16x8){L[0], L[1], L[2], L[3], H[0], H[1], H[2], H[3]}
#define VMMA(OD, L_, H_) do { OD = __builtin_amdgcn_mfma_f32_32x32x16_bf16(pa0, PK(L_[0], H_[0]), OD, 0, 0, 0); OD = __builtin_amdgcn_mfma_f32_32x32x16_bf16(pa1, PK(L_[1], H_[1]), OD, 0, 0, 0); \
      OD = __builtin_amdgcn_mfma_f32_32x32x16_bf16(pa2, PK(L_[2], H_[2]), OD, 0, 0, 0); OD = __builtin_amdgcn_mfma_f32_32x32x16_bf16(pa3, PK(L_[3], H_[3]), OD, 0, 0, 0); } while (0)
#define VWAIT(N, L_, H_) do { asm volatile("s_waitcnt lgkmcnt(" #N ")" : "+v"(L_[0]), "+v"(L_[1]), "+v"(L_[2]), "+v"(L_[3]), "+v"(H_[0]), "+v"(H_[1]), "+v"(H_[2]), "+v"(H_[3]) :: "memory"); SBAR(); } while (0)
      VREADS(lA, hA, 0); VREADS(lB, hB, 1);
      VWAIT(8, lA, hA); VMMA(o[0], lA, hA);
      VREADS(lA, hA, 2);
      VWAIT(8, lB, hB); VMMA(o[1], lB, hB);
      VREADS(lB, hB, 3);
      VWAIT(8, lA, hA); VMMA(o[2], lA, hA);
      VWAIT(0, lB, hB); VMMA(o[3], lB, hB);
#undef VREADS
#undef PK
#undef VMMA
#undef VWAIT
    }
    asm volatile("s_waitcnt vmcnt(0) lgkmcnt(0)\n\ts_barrier" ::: "memory");
  }
  if (hi == 0) li_l[r32] = l_reg; asm volatile("s_waitcnt lgkmcnt(0)" ::: "memory");
  float rli[16];
#pragma unroll
  for (int r = 0; r < 16; ++r) rli[r] = __builtin_amdgcn_rcpf(li_l[crow(r, hi)]);
  unsigned char* stg = (unsigned char*)(lds + wid * 4096);
#pragma unroll
  for (int r = 0; r < 16; ++r) { const int orow = crow(r, hi); const float sc16 = rli[r] * 16.f;
#pragma unroll
    for (int d0 = 0; d0 < 4; ++d0) stg[orow * 128 + d0 * 32 + r32] = (unsigned char)__builtin_amdgcn_cvt_pk_fp8_f32(o[d0][r] * sc16, 0.f, 0, false); }
  asm volatile("s_waitcnt lgkmcnt(0)" ::: "memory");
#pragma unroll
  for (int i = 0; i < 4; ++i) { const int row = i * 8 + (lane >> 3), ch = lane & 7; const u32x4 v = *(const u32x4*)(stg + row * 128 + ch * 16);
    *(u32x4*)((unsigned char*)Ob + (size_t)row * 1024 + wid * 128 + ch * 16) = v; }
#undef DMA_TILE
}
#undef KSWZ
#undef SBAR
}


namespace ret {
using bf16x8 = __attribute__((ext_vector_type(8))) short;
using s16x4  = __attribute__((ext_vector_type(4))) short;
using u32x4  = __attribute__((ext_vector_type(4))) unsigned;
using u32x2  = __attribute__((ext_vector_type(2))) unsigned;
constexpr int C = 64, QP = 272, KPI = 272, VP = 576;
constexpr int OFF_Q = 0, OFF_K = 17408, OFF_V = 34816, OFF_ST = 71680, OFF_Y = 75776;
typedef float f32x2_t __attribute__((ext_vector_type(2))); typedef __bf16 bf16x2_t __attribute__((ext_vector_type(2)));
__device__ __forceinline__ unsigned cvtpk(float lo, float hi) { const f32x2_t v = {lo, hi}; const bf16x2_t b = __builtin_convertvector(v, bf16x2_t); return __builtin_bit_cast(unsigned, b); }
template <int OFF> __device__ __forceinline__ s16x4 trr(int base) { s16x4 r; asm volatile("ds_read_b64_tr_b16 %0, %1 offset:%2" : "=&v"(r) : "v"(base), "i"(OFF) : "memory"); return r; }
__device__ __forceinline__ bf16x8 pk8(const f32x16& x, int s) { u32x4 w = {cvtpk(x[8 * s + 0], x[8 * s + 1]), cvtpk(x[8 * s + 2], x[8 * s + 3]), cvtpk(x[8 * s + 4], x[8 * s + 5]), cvtpk(x[8 * s + 6], x[8 * s + 7])}; return *reinterpret_cast<bf16x8*>(&w); }
__device__ __forceinline__ float silu_(float x) { return x * __builtin_amdgcn_rcpf(1.f + __builtin_amdgcn_exp2f(-1.4426950408889634f * x)); }
__device__ __forceinline__ void ret_item(int b, int h, const unsigned char* __restrict__ RQ, const unsigned char* __restrict__ RK, const unsigned char* __restrict__ RV, const unsigned char* __restrict__ RG, unsigned char* A2F8, const float* __restrict__ gnorm, char* lds, int c0, int c1, float* state) {
  const int tid = threadIdx.x, w = __builtin_amdgcn_readfirstlane(tid >> 6), lane = tid & 63, r32 = lane & 31, hi = lane >> 5;
  const float lg = __log2f(1.f - exp2f(-5.f - (float)h)), gC = exp2f(64.f * lg);
  char* Qs = lds + OFF_Q; char* Ks = lds + OFF_K; char* Vs = lds + OFF_V; float* st = (float*)(lds + OFF_ST); char* Ys = lds + OFF_Y;
  f32x16 S[4] = {};
  if (c0 > 0) {
#pragma unroll
    for (int dt = 0; dt < 4; ++dt)
#pragma unroll
      for (int r = 0; r < 16; ++r) S[dt][r] = state[(dt * 16 + r) * 512 + tid]; }
  const unsigned voffQ = (unsigned)(((tid >> 4) * 512 + (tid & 15) * 8) * 2), voffV = (unsigned)(((tid >> 5) * 1024 + (tid & 31) * 8) * 2);
  const int trq = (lane & 15) >> 2, trp = lane & 3, trg = (lane >> 4) & 1;
  const int vtb = (int)(uintptr_t)(lds + OFF_V) + (4 * hi + trq) * VP + (32 * w + 16 * trg + 4 * trp) * 2, ktb = (int)(uintptr_t)(lds + OFF_K) + (4 * hi + trq) * KPI + (16 * trg + 4 * trp) * 2;
  u32x2 pq[2], pk[2], pv[4];
  const unsigned voffQ8 = (unsigned)((tid >> 4) * 512 + (tid & 15) * 8), voffV8 = voffV >> 1;
#define RET_LOAD(cc) do { const size_t t0_ = (size_t)b * SEQ + (size_t)(cc) * C; const unsigned char* qb_ = RQ + t0_ * 512 + h * 128; const unsigned char* kb_ = RK + t0_ * 512 + h * 128; const unsigned char* vb_ = RV + t0_ * 1024 + h * 256; \
    _Pragma("unroll") for (int i = 0; i < 2; ++i) { pq[i] = *(const u32x2*)(qb_ + voffQ8 + i * 16384); pk[i] = *(const u32x2*)(kb_ + voffQ8 + i * 16384); } \
    _Pragma("unroll") for (int i = 0; i < 4; ++i) pv[i] = *(const u32x2*)(vb_ + voffV8 + i * 16384); } while (0)
#define RET_F8(src_, f_, out_) do { const auto a_ = __builtin_amdgcn_cvt_pk_f32_fp8((int)(src_).x, false), b_ = __builtin_amdgcn_cvt_pk_f32_fp8((int)(src_).x, true), c_ = __builtin_amdgcn_cvt_pk_f32_fp8((int)(src_).y, false), d_ = __builtin_amdgcn_cvt_pk_f32_fp8((int)(src_).y, true); \
    out_.x = cvtpk(a_[0] * (f_), a_[1] * (f_)); out_.y = cvtpk(b_[0] * (f_), b_[1] * (f_)); out_.z = cvtpk(c_[0] * (f_), c_[1] * (f_)); out_.w = cvtpk(d_[0] * (f_), d_[1] * (f_)); } while (0)
#define RET_STAGE() do { \
    _Pragma("unroll") for (int i = 0; i < 2; ++i) { const int row = (tid >> 4) + 32 * i, ch = tid & 15; \
      u32x4 qo; RET_F8(pq[i], 1.f, qo); *(u32x4*)(Qs + row * QP + ch * 16) = qo; \
      const float f = exp2f(lg * (float)(C - 1 - row)) * 0.08838834764831845f; \
      u32x4 ko; RET_F8(pk[i], f, ko); *(u32x4*)(Ks + row * KPI + ch * 16) = ko; } \
    _Pragma("unroll") for (int i = 0; i < 4; ++i) { const int row = (tid >> 5) + 16 * i, ch = tid & 31; u32x4 vo; RET_F8(pv[i], 1.f, vo); *(u32x4*)(Vs + row * VP + ch * 16) = vo; } } while (0)
  RET_LOAD(c0);
  __syncthreads();
  RET_STAGE();
  if (c0 + 1 < c1) RET_LOAD(c0 + 1);
  __syncthreads();
  for (int c = c0; c < c1; ++c) {
    const size_t tok0 = (size_t)b * SEQ + (size_t)c * C;
    f32x16 ot[2] = {};
#pragma unroll
    for (int dt = 0; dt < 4; ++dt) {
#pragma unroll
      for (int s = 0; s < 2; ++s) { const bf16x8 af = pk8(S[dt], s);
#pragma unroll
        for (int nt = 0; nt < 2; ++nt) { const char* qp = Qs + (32 * nt + r32) * QP + (32 * dt + 16 * s + 4 * hi) * 2;
          const u32x2 lo = *(const u32x2*)qp, hi8 = *(const u32x2*)(qp + 16); const u32x4 bw = {lo.x, lo.y, hi8.x, hi8.y};
          ot[nt] = __builtin_amdgcn_mfma_f32_32x32x16_bf16(af, *reinterpret_cast<const bf16x8*>(&bw), ot[nt], 0, 0, 0); } }
      __builtin_amdgcn_sched_barrier(0); }
#pragma unroll
    for (int nt = 0; nt < 2; ++nt)
#pragma unroll
      for (int r = 0; r < 16; ++r) ot[nt][r] *= gC;
    __builtin_amdgcn_sched_barrier(0);
    bf16x8 vfr[4];
    { s16x4 vlo[4], vhi[4];
      vlo[0] = trr<0 * 16 * VP>(vtb); vhi[0] = trr<0 * 16 * VP + 8 * VP>(vtb); vlo[1] = trr<1 * 16 * VP>(vtb); vhi[1] = trr<1 * 16 * VP + 8 * VP>(vtb);
      vlo[2] = trr<2 * 16 * VP>(vtb); vhi[2] = trr<2 * 16 * VP + 8 * VP>(vtb); vlo[3] = trr<3 * 16 * VP>(vtb); vhi[3] = trr<3 * 16 * VP + 8 * VP>(vtb);
      asm volatile("s_waitcnt lgkmcnt(0)" : "+v"(vlo[0]), "+v"(vlo[1]), "+v"(vlo[2]), "+v"(vlo[3]), "+v"(vhi[0]), "+v"(vhi[1]), "+v"(vhi[2]), "+v"(vhi[3]) :: "memory"); __builtin_amdgcn_sched_barrier(0);
#pragma unroll
      for (int ks = 0; ks < 4; ++ks) vfr[ks] = (bf16x8){vlo[ks][0], vlo[ks][1], vlo[ks][2], vlo[ks][3], vhi[ks][0], vhi[ks][1], vhi[ks][2], vhi[ks][3]}; }
#pragma unroll
    for (int nt = 0; nt < 2; ++nt)
#pragma unroll
      for (int jt = 0; jt <= nt; ++jt) { f32x16 pt = {};
#pragma unroll
        for (int kk = 0; kk < 8; ++kk) { const bf16x8 ka = *(const bf16x8*)(Ks + (32 * jt + r32) * KPI + (16 * kk + 8 * hi) * 2), qb = *(const bf16x8*)(Qs + (32 * nt + r32) * QP + (16 * kk + 8 * hi) * 2);
          pt = __builtin_amdgcn_mfma_f32_32x32x16_bf16(ka, qb, pt, 0, 0, 0); }
        if (jt == nt) {
#pragma unroll
          for (int r = 0; r < 16; ++r) if (crow(r, hi) > r32) pt[r] = 0.f; }
#pragma unroll
        for (int s = 0; s < 2; ++s) ot[nt] = __builtin_amdgcn_mfma_f32_32x32x16_bf16(vfr[2 * jt + s], pk8(pt, s), ot[nt], 0, 0, 0);
        __builtin_amdgcn_sched_barrier(0); }
#pragma unroll
    for (int dt = 0; dt < 4; ++dt) {
#pragma unroll
      for (int r = 0; r < 16; ++r) S[dt][r] *= gC;
      s16x4 kl[4], kh[4];
      kl[0] = trr<0 * 16 * KPI>(ktb + dt * 64); kh[0] = trr<0 * 16 * KPI + 8 * KPI>(ktb + dt * 64); kl[1] = trr<1 * 16 * KPI>(ktb + dt * 64); kh[1] = trr<1 * 16 * KPI + 8 * KPI>(ktb + dt * 64);
      kl[2] = trr<2 * 16 * KPI>(ktb + dt * 64); kh[2] = trr<2 * 16 * KPI + 8 * KPI>(ktb + dt * 64); kl[3] = trr<3 * 16 * KPI>(ktb + dt * 64); kh[3] = trr<3 * 16 * KPI + 8 * KPI>(ktb + dt * 64);
      asm volatile("s_waitcnt lgkmcnt(0)" : "+v"(kl[0]), "+v"(kl[1]), "+v"(kl[2]), "+v"(kl[3]), "+v"(kh[0]), "+v"(kh[1]), "+v"(kh[2]), "+v"(kh[3]) :: "memory"); __builtin_amdgcn_sched_barrier(0);
#pragma unroll
      for (int ks = 0; ks < 4; ++ks) S[dt] = __builtin_amdgcn_mfma_f32_32x32x16_bf16((bf16x8){kl[ks][0], kl[ks][1], kl[ks][2], kl[ks][3], kh[ks][0], kh[ks][1], kh[ks][2], kh[ks][3]}, vfr[ks], S[dt], 0, 0, 0);
      __builtin_amdgcn_sched_barrier(0); }
    u32x2 gt4[4];
    { const unsigned char* gb_ = RG + tok0 * 1024 + h * 256;
#pragma unroll
      for (int i = 0; i < 4; ++i) gt4[i] = *(const u32x2*)(gb_ + (voffV >> 1) + i * 16384); }
#pragma unroll
    for (int nt = 0; nt < 2; ++nt) { const float rs = exp2f(lg * (float)(32 * nt + r32 + 1 - C)); float s1 = 0.f, s2 = 0.f;
#pragma unroll
      for (int r = 0; r < 16; ++r) { ot[nt][r] *= rs; s1 += ot[nt][r]; s2 += ot[nt][r] * ot[nt][r]; }
      s1 = xhalf_sum(s1); s2 = xhalf_sum(s2);
      if (hi == 0) { st[(w * 64 + 32 * nt + r32) * 2] = s1; st[(w * 64 + 32 * nt + r32) * 2 + 1] = s2; } }
    __syncthreads();
    if (c + 1 < c1) { RET_STAGE(); if (c + 2 < c1) RET_LOAD(c + 2); }
#pragma unroll
    for (int nt = 0; nt < 2; ++nt) { float s1 = 0.f, s2 = 0.f;
#pragma unroll
      for (int ww = 0; ww < 8; ++ww) { s1 += st[(ww * 64 + 32 * nt + r32) * 2]; s2 += st[(ww * 64 + 32 * nt + r32) * 2 + 1]; }
      const float mu = s1 * (1.f / 256.f), var = fmaxf(s2 * (1.f / 256.f) - mu * mu, 0.f), rstd = rsqrtf(var + EPS);
#pragma unroll
      for (int g = 0; g < 4; ++g) { float y[4];
#pragma unroll
        for (int j = 0; j < 4; ++j) y[j] = (ot[nt][4 * g + j] - mu) * rstd * gnorm[h * 256 + 32 * w + 8 * g + 4 * hi + j];
        const u32x2 o2 = {cvtpk(y[0], y[1]), cvtpk(y[2], y[3])};
        *(u32x2*)(Ys + (32 * nt + r32) * VP + (32 * w + 8 * g + 4 * hi) * 2) = o2; } }
    __syncthreads();
    { unsigned char* ob_ = A2F8 + tok0 * 1024 + h * 256;
#pragma unroll
      for (int i = 0; i < 4; ++i) { const int row = (tid >> 5) + 16 * i, ch = tid & 31;
        const u32x4 yv = *(const u32x4*)(Ys + row * VP + ch * 16); const u32x2 gt = gt4[i];
        const auto g01 = __builtin_amdgcn_cvt_pk_f32_fp8((int)gt.x, false), g23 = __builtin_amdgcn_cvt_pk_f32_fp8((int)gt.x, true), g45 = __builtin_amdgcn_cvt_pk_f32_fp8((int)gt.y, false), g67 = __builtin_amdgcn_cvt_pk_f32_fp8((int)gt.y, true);
        int w0 = __builtin_amdgcn_cvt_pk_fp8_f32(pg8::bf_lo(yv.x) * silu_(g01[0]), pg8::bf_hi(yv.x) * silu_(g01[1]), 0, false); w0 = __builtin_amdgcn_cvt_pk_fp8_f32(pg8::bf_lo(yv.y) * silu_(g23[0]), pg8::bf_hi(yv.y) * silu_(g23[1]), w0, true);
        int w1 = __builtin_amdgcn_cvt_pk_fp8_f32(pg8::bf_lo(yv.z) * silu_(g45[0]), pg8::bf_hi(yv.z) * silu_(g45[1]), 0, false); w1 = __builtin_amdgcn_cvt_pk_fp8_f32(pg8::bf_lo(yv.w) * silu_(g67[0]), pg8::bf_hi(yv.w) * silu_(g67[1]), w1, true);
        *(unsigned long long*)(ob_ + (size_t)row * 1024 + ch * 8) = (unsigned long long)(unsigned)w0 | ((unsigned long long)(unsigned)w1 << 32); } }
  }
  if (c1 < SEQ / C) {
#pragma unroll
    for (int dt = 0; dt < 4; ++dt)
#pragma unroll
      for (int r = 0; r < 16; ++r) state[(dt * 16 + r) * 512 + tid] = S[dt][r]; }
  __syncthreads();
#undef RET_LOAD
#undef RET_STAGE
#undef RET_F8
}
}


constexpr int RET_SPLIT = 28;
__device__ __forceinline__ int ret_wg_index(const Frame& F) { const int bx = (int)blockIdx.x, j = bx >> 3; return (j & 3) == 0 ? ((j >> 2) * 8 + (bx & 7)) : -1; }
__device__ __forceinline__ void p4_attn(Frame& F, const Args& a, unsigned char* lds_generic) {
    const size_t nt_ = (size_t)F.ntok;
    const bf16* QA = (const bf16*)(F.act + nt_ * O_QA); bf16* ATT = (bf16*)(F.act + nt_ * O_QA);
    unsigned char* aux = a.xb + nt_ * 2048;
    const bf16* KP = (const bf16*)(aux + nt_ * AUX_KP); const bf16* VV = (const bf16*)(aux + nt_ * AUX_VV); const unsigned* MASK = (const unsigned*)(aux + nt_ * AUX_MASK);
    volatile LAS unsigned* MISC = (volatile LAS unsigned*)(F.lds + MISC_OFF);
    unsigned* qctr = (unsigned*)(F.ws + WS_CTL) + CW_Q4;
    const unsigned char* RQ = F.act + nt_ * O_RQ; const unsigned char* RK = F.act + nt_ * O_RK; const unsigned char* RV = F.act + nt_ * O_RV; const unsigned char* RG = F.act + nt_ * O_RG;
    const int nb = F.ntok / SEQ, nret = nb * 4, nitems = nb * 64;
    { const int ri = ret_wg_index(F); if (ri >= 0 && ri < nret && RET_SPLIT < SEQ / 64)
        ret::ret_item(ri >> 2, ri & 3, RQ, RK, RV, RG, A2F8_PTR, a.in[8], (char*)lds_generic, RET_SPLIT, SEQ / 64, RSTATE_PTR + (size_t)ri * 32768); }
    __syncthreads(); if (F.tid == 0) MISC[0] = atomicAdd(qctr, 1u); __syncthreads();
    int it = (int)MISC[0];
    while (it < nitems) {
        unsigned nxt_ = 0u; if (F.tid == 0) nxt_ = atomicAdd(qctr, 1u);
        const int qb = 63 - it / nb, b = it % nb, NT = (qb >> 1) + 1;
        const size_t row0 = (size_t)b * SEQ + qb * 32;
        att::attn_item((const bf16*)((const unsigned char*)QA + row0 * 1024), KP + (size_t)b * SEQ * 128, VV + (size_t)b * SEQ * 128, MASK + (size_t)b * 64 * 2048 + qb * 32, (bf16*)((unsigned char*)ATT + row0 * 1024), NT, (char*)lds_generic, F.lds);
        __syncthreads(); if (F.tid == 0) MISC[0] = nxt_; __syncthreads();
        it = (int)MISC[0];
    }
}


__device__ __forceinline__ void p7_router(Frame& F, const Args& a) {
    const int lane = F.lane, r32 = lane & 31, hi = lane >> 5, tid = F.tid;
    unsigned char* mo = F.act; unsigned char* N2 = mo + MO_N2; unsigned char* meta = mo + MO_META;
    (void)meta; int* LTOK = (int*)(mo + MO_LIST); float* LRS = (float*)(mo + MO_LIST) + 24 * LIST_CAP; float* LCL = LRS + 24 * LIST_CAP; float* LCH = LCL + 24 * LIST_CAP;
    const bf16* Wh = (const bf16*)(F.ws + WS_WR); const bf16* Wl = Wh + 32 * 1024;
    const float* g2 = a.in[12]; const float* b_gr = a.in[14]; const float* b_er = a.in[16];
    const bf16* hbase = (const bf16*)(F.act + MO_H16);
    unsigned* gcnt = (unsigned*)(F.ws + WS_CTL) + CW_MOE;
    LAS unsigned* lcnt = (LAS unsigned*)(F.lds + RING_OFF);
    if (tid < 64) lcnt[tid] = 0u;
    __syncthreads();
    const int ntasks = F.ntok / 32, tpw = ntasks / F.G;
    const int tw = F.wave & 3, kh = F.wave >> 2;
    const bool have = tw < tpw; const int t = (F.vcu * tpw + tw) * 32 + r32;
    LAS float* xch = (LAS float*)(F.lds + RING_OFF + 1024);
    int bucket = 0, posl = 0; float clo = 0.f, chi = 0.f, rstd = 0.f;
    f32x16 acc = f32x16{}; float ss = 0.f;
    if (have) {
        const bf16* hrow = hbase + (size_t)t * D + hi * 8 + kh * 512; unsigned char* nrow = N2 + (size_t)t * D + hi * 8 + kh * 512;
        const float* g2k = g2 + kh * 512 + hi * 8; const bf16* whk = Wh + (size_t)r32 * 1024 + kh * 512 + hi * 8; const bf16* wlk = Wl + (size_t)r32 * 1024 + kh * 512 + hi * 8;
#pragma unroll 8
        for (int kk = 0; kk < 32; ++kk) {
            const v4u hv = *(const v4u*)(hrow + kk * 16); const f32x4 a0 = {pg8::bf_lo(hv.x), pg8::bf_hi(hv.x), pg8::bf_lo(hv.y), pg8::bf_hi(hv.y)}, a1 = {pg8::bf_lo(hv.z), pg8::bf_hi(hv.z), pg8::bf_lo(hv.w), pg8::bf_hi(hv.w)};
            const f32x4 q0 = *(const f32x4*)(g2k + kk * 16), q1 = *(const f32x4*)(g2k + kk * 16 + 4);
            ss += (a0.x * a0.x + a0.y * a0.y) + (a0.z * a0.z + a0.w * a0.w) + (a1.x * a1.x + a1.y * a1.y) + (a1.z * a1.z + a1.w * a1.w);
            const float x[8] = {a0.x * q0.x, a0.y * q0.y, a0.z * q0.z, a0.w * q0.w, a1.x * q1.x, a1.y * q1.y, a1.z * q1.z, a1.w * q1.w};
            unsigned hb[8]; float lo[8];
#pragma unroll
            for (int j = 0; j < 8; ++j) { hb[j] = f2bf(x[j]); lo[j] = x[j] - __uint_as_float(hb[j] << 16); }
            v4u xh; xh.x = hb[0] | (hb[1] << 16); xh.y = hb[2] | (hb[3] << 16); xh.z = hb[4] | (hb[5] << 16); xh.w = hb[6] | (hb[7] << 16);
            v4u xl; xl.x = pk2(lo[0], lo[1]); xl.y = pk2(lo[2], lo[3]); xl.z = pk2(lo[4], lo[5]); xl.w = pk2(lo[6], lo[7]);
            { int w0 = __builtin_amdgcn_cvt_pk_fp8_f32(x[0], x[1], 0, false); w0 = __builtin_amdgcn_cvt_pk_fp8_f32(x[2], x[3], w0, true); int w1 = __builtin_amdgcn_cvt_pk_fp8_f32(x[4], x[5], 0, false); w1 = __builtin_amdgcn_cvt_pk_fp8_f32(x[6], x[7], w1, true);
              *(unsigned long long*)(nrow + kk * 16) = (unsigned long long)(unsigned)w0 | ((unsigned long long)(unsigned)w1 << 32); }
            const bf16x8_t wh = *(const bf16x8_t*)(whk + kk * 16), wl = *(const bf16x8_t*)(wlk + kk * 16);
            const bf16x8_t bh = __builtin_bit_cast(bf16x8_t, xh), bl = __builtin_bit_cast(bf16x8_t, xl);
            acc = __builtin_amdgcn_mfma_f32_32x32x16_bf16(wh, bh, acc, 0, 0, 0);
            acc = __builtin_amdgcn_mfma_f32_32x32x16_bf16(wh, bl, acc, 0, 0, 0);
            acc = __builtin_amdgcn_mfma_f32_32x32x16_bf16(wl, bh, acc, 0, 0, 0);
        }
        if (kh == 1) {
#pragma unroll
            for (int r = 0; r < 16; ++r) xch[(tw * 17 + r) * 64 + lane] = acc[r];
            xch[(tw * 17 + 16) * 64 + lane] = ss; }
    }
    __syncthreads();
    if (have && kh == 0) {
#pragma unroll
        for (int r = 0; r < 16; ++r) acc[r] += xch[(tw * 17 + r) * 64 + lane];
        ss += xch[(tw * 17 + 16) * 64 + lane];
        ss = xhalf_sum(ss); rstd = rsqrtf(ss * (1.f / D) + EPS);
        float L[24];
#pragma unroll
        for (int r = 0; r < 12; ++r) { const float v = acc[r]; auto rr = __builtin_amdgcn_permlane32_swap(__float_as_uint(v), __float_as_uint(v), false, false);
            L[(r & 3) + 8 * (r >> 2)] = __uint_as_float(rr[0]); L[(r & 3) + 8 * (r >> 2) + 4] = __uint_as_float(rr[1]); }
        float gl[4];
#pragma unroll
        for (int i = 0; i < 4; ++i) gl[i] = L[i] * rstd + b_gr[i];
        int g = 0; float gm = gl[0];
#pragma unroll
        for (int i = 1; i < 4; ++i) if (gl[i] > gm) { gm = gl[i]; g = i; }
        float se = 0.f;
#pragma unroll
        for (int i = 0; i < 4; ++i) se += __expf(gl[i] - gm);
        const float gw = 1.f / se;
        float el[4];
#pragma unroll
        for (int i = 0; i < 4; ++i) { const float l0 = L[4 + i], l1 = L[8 + i], l2 = L[12 + i], l3 = L[16 + i]; const float lv = g == 0 ? l0 : (g == 1 ? l1 : (g == 2 ? l2 : l3));
            const float b0 = b_er[i], b1 = b_er[4 + i], b2 = b_er[8 + i], b3 = b_er[12 + i]; el[i] = lv * rstd + (g == 0 ? b0 : (g == 1 ? b1 : (g == 2 ? b2 : b3))); }
        int i1 = 0; float v1 = el[0];
#pragma unroll
        for (int i = 1; i < 4; ++i) if (el[i] > v1) { v1 = el[i]; i1 = i; }
        int i2 = -1; float v2 = 0.f;
#pragma unroll
        for (int i = 0; i < 4; ++i) if (i != i1 && (i2 < 0 || el[i] > v2)) { v2 = el[i]; i2 = i; }
        const float e2 = __expf(v2 - v1), p1 = gw / (1.f + e2), p2 = gw * e2 / (1.f + e2);
        const int lo_ = i1 < i2 ? i1 : i2, hi_ = i1 < i2 ? i2 : i1;
        const int pair = lo_ == 0 ? (hi_ - 1) : (lo_ == 1 ? (hi_ + 1) : 5);
        bucket = g * 6 + pair; clo = i1 < i2 ? p1 : p2; chi = i1 < i2 ? p2 : p1;
        if (hi == 0) posl = (int)__hip_atomic_fetch_add(&lcnt[bucket], 1u, __ATOMIC_RELAXED, __HIP_MEMORY_SCOPE_WORKGROUP);
    }
    __syncthreads();
    if (tid < 24) lcnt[32 + tid] = atomicAdd(gcnt + tid, lcnt[tid]);
    __syncthreads();
    if (have && kh == 0 && hi == 0) { const int li = bucket * LIST_CAP + (int)lcnt[32 + bucket] + posl; LTOK[li] = t; LRS[li] = rstd; LCL[li] = clo; LCH[li] = chi; }
}
__device__ __forceinline__ int moe_tiles(const unsigned* gcnt, int* rowstart  ) { int rs = 0;
    for (int b = 0; b < 24; ++b) { rowstart[b] = rs; rs += (int)((gcnt[b] + 255u) & ~255u); } rowstart[24] = rs; return rs >> 8; }
template <bool GATHER_> struct MoeOrder {
    static constexpr bool GATHER = GATHER_; const int* ptok;
    int ntile, G, c; const char* A; size_t tA; const char* W; int mode; const LAS unsigned char* tb; size_t rowB;
    __device__ bool next(int i, pg8::Unit& u) const {
        const long L = (long)i * G + c; if (L >= (long)ntile * 4) return false;
        u.pm = (int)(L >> 2); u.pn = (int)(L & 3); u.a = GATHER_ ? A : A + (size_t)u.pm * tA;
        const int bk = tb[u.pm], g = bk / 6, pr = bk % 6; { const LAS int* t24 = (const LAS int*)(tb + 512); const int rs_ = t24[bk], cn_ = t24[24 + bk], left = cn_ - (u.pm * 256 - rs_); u.aux = bk * LIST_CAP - rs_; u.nvalid = left < 0 ? 0 : (left > 256 ? 256 : left); } const int lo = pr < 3 ? 0 : (pr < 5 ? 1 : 2), hi = pr < 3 ? pr + 1 : (pr < 5 ? pr - 1 : 3);
        const int elo = g * 4 + lo, ehi = g * 4 + hi;
        if (mode == 1) { const int e = u.pn < 2 ? elo : ehi; u.b = W + ((size_t)e * 512 + (size_t)(u.pn & 1) * 256) * rowB; u.bjump = 0; }
        else { u.b = W + ((size_t)elo * 1024 + (size_t)u.pn * 256) * rowB; u.bjump = (long)(ehi - elo) * 1024 * (long)rowB - (long)rowB; }
        return true;
    }
    __device__ __forceinline__ void a_ready(const pg8::Unit&) const {}
    __device__ __forceinline__ void done(const pg8::Unit&) const {}
};
__device__ __forceinline__ float silu_f(float x) { return x * __builtin_amdgcn_rcpf(1.f + __builtin_amdgcn_exp2f(-1.4426950408889634f * x)); }
struct EpiMoe1 {
    static constexpr bool PERM = true, AFTER_DRAIN = false;
    unsigned char* ACT; const float* PRS; const float* PCL; const float* PCH;
    __device__ __forceinline__ void operator()(const pg8::f32x4 (&acc)[2][2][4][2], const pg8::Unit& u, int wr, int wc, int fr, int fq) const {
        const int row0 = u.pm * pg8::BM + wr * 64 + fr, slot = u.pn >> 1, fcol0 = slot * 256 + (u.pn & 1) * 128 + wc * 16 + 4 * fq; const float* PC = slot ? PCH : PCL;
#pragma unroll
        for (int ai = 0; ai < 2; ++ai)
#pragma unroll
            for (int m = 0; m < 4; ++m) { const int row = row0 + ai * pg8::HALF + m * 16; const bool ok = (wr * 64 + fr + ai * pg8::HALF + m * 16) < u.nvalid; const float rs = ok ? PRS[u.aux + row] : 0.f, cw = ok ? PC[u.aux + row] * 16.f : 0.f; unsigned char* rowp = ACT + (size_t)row * 512 + fcol0;
#pragma unroll
                for (int bj = 0; bj < 2; ++bj) { const pg8::f32x4 v0 = acc[ai][bj][m][0], v1 = acc[ai][bj][m][1];
                    const float a0 = silu_f(v0[0] * rs) * (v0[1] * rs) * cw, a1 = silu_f(v0[2] * rs) * (v0[3] * rs) * cw, a2 = silu_f(v1[0] * rs) * (v1[1] * rs) * cw, a3 = silu_f(v1[2] * rs) * (v1[3] * rs) * cw;
                    int w = __builtin_amdgcn_cvt_pk_fp8_f32(a0, a1, 0, false); w = __builtin_amdgcn_cvt_pk_fp8_f32(a2, a3, w, true); *(int*)(rowp + bj * 64) = w; } }
    }
};
struct EpiMoe2 {
    static constexpr bool PERM = true, AFTER_DRAIN = false;
    float* out; const pg8::bf16_t* h16; const int* PTOK;
    __device__ __forceinline__ void operator()(const pg8::f32x4 (&acc)[2][2][4][2], const pg8::Unit& u, int wr, int wc, int fr, int fq) const {
        const int row0 = u.pm * pg8::BM + wr * 64 + fr, col0 = u.pn * pg8::BM + wc * 32 + 8 * fq;
        int tk[2][4]; pg8::u32x4 hl[2][4][2];
#pragma unroll
        for (int ai = 0; ai < 2; ++ai)
#pragma unroll
            for (int m = 0; m < 4; ++m) { const int rr_ = wr * 64 + fr + ai * pg8::HALF + m * 16; tk[ai][m] = rr_ < u.nvalid ? PTOK[u.aux + row0 + ai * pg8::HALF + m * 16] : -1; }
#pragma unroll
        for (int ai = 0; ai < 2; ++ai)
#pragma unroll
            for (int m = 0; m < 4; ++m) { const pg8::bf16_t* hp = h16 + (size_t)(tk[ai][m] < 0 ? 0 : tk[ai][m]) * 1024 + col0;
#pragma unroll
                for (int bj = 0; bj < 2; ++bj) hl[ai][m][bj] = *(const pg8::u32x4*)(hp + bj * pg8::HALF); }
#pragma unroll
        for (int ai = 0; ai < 2; ++ai)
#pragma unroll
            for (int m = 0; m < 4; ++m) if (tk[ai][m] >= 0) { float* rowp = out + (size_t)tk[ai][m] * 1024 + col0;
#pragma unroll
                for (int bj = 0; bj < 2; ++bj) { const pg8::u32x4 hv = hl[ai][m][bj];
                    const pg8::f32x4 h0 = {pg8::bf_lo(hv.x), pg8::bf_hi(hv.x), pg8::bf_lo(hv.y), pg8::bf_hi(hv.y)}, h1 = {pg8::bf_lo(hv.z), pg8::bf_hi(hv.z), pg8::bf_lo(hv.w), pg8::bf_hi(hv.w)};
                    *(pg8::f32x4*)(rowp + bj * pg8::HALF) = h0 + acc[ai][bj][m][0]; *(pg8::f32x4*)(rowp + bj * pg8::HALF + 4) = h1 + acc[ai][bj][m][1]; } }
    }
};
__device__ __forceinline__ int moe_setup(Frame& F, LAS unsigned char* tb) {
    const unsigned* gcnt = (const unsigned*)(F.ws + WS_CTL) + CW_MOE;
    LAS int* nt_ = (LAS int*)(tb + 256);
    __syncthreads();
    if (F.tid == 0) { LAS int* t24 = (LAS int*)(tb + 512); int tl = 0; for (int b = 0; b < 24; ++b) { const int n = (int)((gcnt[b] + 255u) >> 8); t24[b] = tl * 256; t24[24 + b] = (int)gcnt[b]; for (int i = 0; i < n; ++i) tb[tl + i] = (unsigned char)b; tl += n; } nt_[0] = tl; }
    __syncthreads();
    return nt_[0];
}

__global__ void __launch_bounds__(NWAVES * 64, 2) mk_fwd(Args args) {
    extern __shared__ __attribute__((aligned(16))) unsigned char lds[];
    Frame F;
    F.lds = (LAS unsigned char*)lds;
    F.tid = threadIdx.x; F.lane = F.tid & 63; F.wave = __builtin_amdgcn_readfirstlane(F.tid >> 6);
    F.G = gridDim.x; { const int bx = blockIdx.x; F.vcu = (F.G % 8 == 0) ? (bx % 8) * (F.G / 8) + bx / 8 : bx; }
    F.ntok = args.ntok; F.ws = args.ws; F.act = args.ws + WS_ACT; F.xbp = args.xb;
    const int lo = args.ph_lo, hi = args.ph_hi;
    cooperative_groups::grid_group grid = cooperative_groups::this_grid();
    volatile LAS unsigned* MISCW = (volatile LAS unsigned*)(F.lds + MISC_OFF);
    for (int u = F.tid; u < (LDS_BYTES - LDSCTL_OFF) / 4; u += NWAVES * 64) ((LAS unsigned*)(F.lds + LDSCTL_OFF))[u] = 0u;
    __syncthreads();
    XcdBarrier bar = xcd_barrier_post((unsigned*)(F.ws + WS_CTL) + CW_BAR, MISCW + 8);
#define IN(k) (lo <= (k) && (k) < hi)
#define SEAM(k) do { if (IN(k) && IN((k) + 1)) { xcd_barrier(bar); } } while (0)
    if (IN(0)) { p0_prologue(F, args); }
    SEAM(0);
    if (IN(1)) {
        EpiProj E{F.act, (size_t)F.ntok, RSTD1_PTR};
        { pg8::Gemm g{512, 512, 512, 8};
          P1Order S; S.nM = F.ntok / 256; S.nN = 25; S.nwg = S.nM * 25; S.G = F.G; S.c = (int)blockIdx.x; S.mode = 0; S.A = (const char*)(args.xb + (size_t)F.ntok * AUX_XB8); S.Bt = (const char*)(F.ws + WS_WIN8); S.tA = (size_t)256 * 1024; S.tB = (size_t)256 * 1024;
          pg8::gemm_phase<EpiProj, P1Order, true, true, true>(F.lds + RING_OFF, g, S, E); }
        { pg8::Gemm g{1024, 1024, 1024, 16};
          P1Order S; S.nM = F.ntok / 256; S.nN = 3; S.nwg = S.nM * 3; S.G = F.G; S.c = ((int)blockIdx.x + F.G / 2) % F.G; S.mode = 1; S.A = (const char*)args.xb; S.Bt = (const char*)(F.ws + WS_WIN); S.tA = (size_t)256 * 2048; S.tB = (size_t)256 * 2048;
          pg8::gemm_phase<EpiProj, P1Order, true, true, false>(F.lds + RING_OFF, g, S, E); }
    }
    SEAM(1);
    if (IN(2)) { p2_post(F, args); }
    SEAM(2);
    if (IN(3)) {
        const int ri = ret_wg_index(F), nret = (F.ntok / SEQ) * 4;
        if (ri < 0) p3_index(F, args);
        else if (ri < nret) { const size_t nt_ = (size_t)F.ntok;
            ret::ret_item(ri >> 2, ri & 3, F.act + nt_ * O_RQ, F.act + nt_ * O_RK, F.act + nt_ * O_RV, F.act + nt_ * O_RG, A2F8_PTR, args.in[8], (char*)lds, 0, RET_SPLIT, RSTATE_PTR + (size_t)ri * 32768); }
    }
    SEAM(3);
    if (IN(4)) { p4_attn(F, args, lds); }
    SEAM(4);
    if (IN(5)) {
        const size_t nt_ = (size_t)F.ntok;
        const unsigned char* GA8 = F.act + nt_ * O_GA; const unsigned char* GR8 = F.act + nt_ * O_GR; unsigned char* TMP = F.act + nt_ * O_RV;
        { pg8::Gemm g{512, 512, 512, 8, 122, 123};
          pg8::StaticOrder S; S.init(F.ntok, 1024, F.G, (int)blockIdx.x, F.act + nt_ * O_QA, 512, F.ws + WS_WATT8, 512); EpiGateA E{GA8, TMP};
          pg8::gemm_phase<EpiGateA, pg8::StaticOrder, true, true, true>(F.lds + RING_OFF, g, S, E); }
        { pg8::Gemm g{512, 512, 512, 8, 122, 127};
          pg8::StaticOrder S; S.init(F.ntok, 1024, F.G, (int)blockIdx.x, A2F8_PTR, 512, F.ws + WS_WRET8, 512); EpiGateB E{TMP, GR8, F.act + nt_ * O_MIX8};
          pg8::gemm_phase<EpiGateB, pg8::StaticOrder, true, true, true>(F.lds + RING_OFF, g, S, E); }
    }
    SEAM(5);
    if (IN(6)) {
        pg8::Gemm g{512, 512, 512, 8, 122, 124}; const size_t nt_ = (size_t)F.ntok;
        pg8::StaticOrder S; S.init(F.ntok, 1024, F.G, (int)blockIdx.x, F.act + nt_ * O_MIX8, 512, F.ws + WS_WOUT8, 512);
        EpiResid E{(const pg8::bf16_t*)args.xb, (pg8::bf16_t*)(F.act + MO_H16)};
        pg8::gemm_phase<EpiResid, pg8::StaticOrder, true, true, true>(F.lds + RING_OFF, g, S, E);
    }
    SEAM(6);
    if (IN(7)) { p7_router(F, args); }
    SEAM(7);
    if (IN(9)) {
        LAS unsigned char* tb = F.lds + LDSCTL_OFF - 1024; const int ntile = moe_setup(F, tb);
        unsigned char* meta = F.act + MO_META;
        pg8::Gemm g{512, 512, 512, 8, 122, 127};
        MoeOrder<true> S{(const int*)(F.act + MO_LIST), ntile, F.G, (int)blockIdx.x, (const char*)(F.act + MO_N2), (size_t)0, (const char*)(F.ws + WS_W18), 1, tb, (size_t)1024};
        EpiMoe1 E{(unsigned char*)(F.act + MO_ACT), (const float*)(F.act + MO_LIST) + 24 * LIST_CAP, (const float*)(F.act + MO_LIST) + 48 * LIST_CAP, (const float*)(F.act + MO_LIST) + 72 * LIST_CAP};
        pg8::gemm_phase<EpiMoe1, MoeOrder<true>, true, true, true>(F.lds + RING_OFF, g, S, E);
    }
    SEAM(9);
    if (IN(10)) {
        LAS unsigned char* tb = F.lds + LDSCTL_OFF - 1024; const int ntile = moe_setup(F, tb);
        unsigned char* meta = F.act + MO_META;
        pg8::Gemm g{256, 256, 128, 2, 123, 123};
        MoeOrder<false> S{nullptr, ntile, F.G, (int)blockIdx.x, (const char*)(F.act + MO_ACT), (size_t)256 * 512, (const char*)(F.ws + WS_WD8), 2, tb, (size_t)256};
        EpiMoe2 E{args.out + (size_t)args.tok0 * D, (const pg8::bf16_t*)(F.act + MO_H16), (const int*)(F.act + MO_LIST)};
        pg8::gemm_phase<EpiMoe2, MoeOrder<false>, true, true, true>(F.lds + RING_OFF, g, S, E);
    }
    if (hi - lo > 1) grid.sync();
#undef IN
#undef SEAM
}

extern "C" void kernel_launch(void* const* d_in, const int* in_sizes, int n_in, void* d_out, int out_size, void* d_ws, size_t ws_size, hipStream_t stream) {
    static int grid = 0;
    if (grid == 0) {
        int dev = 0, cus = 0, per_cu = 0;
        (void)hipGetDevice(&dev); (void)hipDeviceGetAttribute(&cus, hipDeviceAttributeMultiprocessorCount, dev);
        if (hipFuncSetAttribute((const void*)mk_fwd, hipFuncAttributeMaxDynamicSharedMemorySize, LDS_BYTES) != hipSuccess) { fprintf(stderr, "kernel_launch: hipFuncSetAttribute failed\n"); grid = -1; return; }
        (void)hipOccupancyMaxActiveBlocksPerMultiprocessor(&per_cu, (const void*)mk_fwd, NWAVES * 64, LDS_BYTES);
        (void)hipGetLastError();
        if (per_cu < 1) { fprintf(stderr, "kernel_launch: occupancy query says %d blocks per CU\n", per_cu); per_cu = 1; }
        grid = cus * per_cu;
        if (n_in != 20 || ws_size < (size_t)512 * MiB) { fprintf(stderr, "kernel_launch: unexpected n_in %d / ws_size %zu\n", n_in, ws_size); grid = -1; return; }
        if (grid != 256) { fprintf(stderr, "kernel_launch: this kernel's phase schedules are written for a 256-workgroup grid (256 CUs x 1); the device reports %d x %d; nothing launched\n", cus, per_cu); grid = -1; return; }
    }
    if (grid < 0) return;
    float* out = (float*)d_out;
    unsigned char* ws = (unsigned char*)d_ws;
    (void)in_sizes; (void)out_size;
    (void)hipMemsetAsync(ws + WS_CTL, 0, CTL_ZERO_BYTES, stream);
    Args a{};
    for (int i = 0; i < 20; ++i) a.in[i] = (const float*)d_in[i];
    a.out = out; a.ws = ws; a.xb = (unsigned char*)d_out; a.ntok = T; a.tok0 = 0;
    void* kargs[] = {(void*)&a};
    if (PROBE_PH >= 0) { a.ph_lo = PROBE_PH; a.ph_hi = PROBE_PH + 1; a.mode = PROBE_MODE;
        (void)hipLaunchCooperativeKernel((const void*)mk_fwd, dim3(grid), dim3(NWAVES * 64), kargs, (unsigned)LDS_BYTES, stream);
        (void)hipMemsetAsync(ws + WS_CTL, 0, CTL_ZERO_BYTES, stream); }
    a.ph_lo = 0; a.ph_hi = 11; a.mode = 0;
    const hipError_t le = hipLaunchCooperativeKernel((const void*)mk_fwd, dim3(grid), dim3(NWAVES * 64), kargs, (unsigned)LDS_BYTES, stream);
    if (le != hipSuccess) fprintf(stderr, "kernel_launch: cooperative launch failed: %s (grid %d)\n", hipGetErrorString(le), grid);
}
```

```cpp
#include <hip/hip_runtime.h>
#include <hip/hip_cooperative_groups.h>
#include <cstdio>
#include <cstdint>

namespace pg8 {
#define PG8_LAS __attribute__((address_space(3)))
typedef unsigned short bf16_t;
typedef short bf16x8 __attribute__((ext_vector_type(8)));
typedef float f32x4 __attribute__((ext_vector_type(4)));
typedef unsigned u32x4 __attribute__((ext_vector_type(4)));
typedef unsigned u32x2 __attribute__((ext_vector_type(2)));
typedef int v4i_t __attribute__((ext_vector_type(4)));
typedef int v8i_t __attribute__((ext_vector_type(8)));
constexpr int BM = 256, BK = 64, HALF = 128, HTB = HALF * BK * 2  , STAGE_BYTES = 8 * HTB, NXCD = 8, WGM = 8;

__host__ __device__ __forceinline__ int lds_byte(int r, int c) { const int st = (r >> 4) * 2 + (c >> 5), rr = r & 15, cc = c & 31, ob = rr * 64 + cc * 2; return st * 1024 + (ob ^ (((ob >> 9) & 1) << 5)); }
__host__ __device__ __forceinline__ void stage_rc(int b, int& R, int& C) { const int st = b / 1024, sb = b % 1024, swz = sb ^ (((sb >> 9) & 1) << 5); R = (st >> 1) * 16 + swz / 64; C = (st & 1) * 32 + (swz % 64) / 2; }
__host__ __device__ __forceinline__ int perm32(int rho) { const int n = rho >> 4, i = rho & 15; return 8 * (i >> 2) + 4 * n + (i & 3); }

struct Unit { int pm, pn; const char* a; const char* b; long bjump; int aux; int nvalid; };
struct Gemm { int K, lda, ldb, ksplit; int sw = 122, sa = 127; };

struct StaticOrder {
    static constexpr bool GATHER = false; const int* ptok = nullptr;
    int nM, nN, nwg, G, c; const char* A; const char* Bt; size_t tA, tB;
    __device__ void init(int M, int N, int G_, int c_, const void* A_, int lda, const void* Bt_, int ldb) { nM = M / BM; nN = N / BM; nwg = nM * nN; G = G_; c = c_; A = (const char*)A_; Bt = (const char*)Bt_; tA = (size_t)BM * lda * 2; tB = (size_t)BM * ldb * 2; }
    __device__ bool next(int i, Unit& u) const {
        const long L = (long)i * G + c; if (L >= nwg) return false;
        int wgid = (int)L; { const int q = nwg / NXCD, r = nwg % NXCD, xcd = wgid % NXCD, off = wgid / NXCD; wgid = (xcd < r ? xcd * (q + 1) : r * (q + 1) + (xcd - r) * q) + off; }
        const int nig = WGM * nN, gid = wgid / nig, fm = gid * WGM, gsz = (nM - fm) < WGM ? (nM - fm) : WGM;
        u.pm = fm + ((wgid % nig) % gsz); u.pn = (wgid % nig) / gsz; u.a = A + (size_t)u.pm * tA; u.b = Bt + (size_t)u.pn * tB; u.bjump = 0; u.aux = 0; u.nvalid = 256; return true;
    }
    __device__ __forceinline__ void a_ready(const Unit&) const {}
    __device__ __forceinline__ void done(const Unit&) const {}
};

typedef float f32x2c __attribute__((ext_vector_type(2))); typedef __bf16 bf16x2c __attribute__((ext_vector_type(2)));
__device__ __forceinline__ unsigned cvt_pk_bf16(float lo, float hi) { const f32x2c v = {lo, hi}; const bf16x2c b = __builtin_convertvector(v, bf16x2c); return __builtin_bit_cast(unsigned, b); }
__device__ __forceinline__ float bf_lo(unsigned w) { return __uint_as_float(w << 16); }
__device__ __forceinline__ float bf_hi(unsigned w) { return __uint_as_float(w & 0xffff0000u); }


template <class Epi, class Sched, bool ALIGN_EPI = false, bool SP2 = false, bool FP8 = false>
__device__ __forceinline__ void gemm_phase(PG8_LAS unsigned char* lds, const Gemm g, const Sched& S, const Epi& E) {
    int tid = threadIdx.x; asm volatile("" : "+v"(tid));
    const int wid = __builtin_amdgcn_readfirstlane(tid >> 6), lane = tid & 63, wr = wid >> 2, wc = wid & 3, fr = lane & 15, fq = lane >> 4;
    const int K = g.K, nt = K / BK;
    unsigned voffA[2], voffB[2]; int gR[2]; unsigned gC[2];
#pragma unroll
    for (int i = 0; i < 2; ++i) { int R, C; stage_rc(tid * 16 + i * 8192, R, C); const int Rb = Epi::PERM ? ((R & ~31) + perm32(R & 31)) : R; gR[i] = R; gC[i] = (unsigned)C * 2u;
        voffA[i] = (unsigned)(R * g.lda + C) * 2u; voffB[i] = (unsigned)(Rb * g.ldb + C) * 2u; }
    unsigned gA0[2] = {0u, 0u}, gA1[2] = {0u, 0u}, gN0[2] = {0u, 0u}, gN1[2] = {0u, 0u};
#define PG8_GOFF(u_, o0, o1) do { _Pragma("unroll") for (int i_ = 0; i_ < 2; ++i_) { const int r0_ = gR[i_], r1_ = HALF + gR[i_]; const int t0_ = r0_ < (u_).nvalid ? S.ptok[(u_).aux + (u_).pm * BM + r0_] : 0, t1_ = r1_ < (u_).nvalid ? S.ptok[(u_).aux + (u_).pm * BM + r1_] : 0; \
        o0[i_] = (unsigned)t0_ * (unsigned)(g.lda * 2) + gC[i_]; o1[i_] = (unsigned)t1_ * (unsigned)(g.lda * 2) + gC[i_]; } } while (0)
    const size_t kstep = (size_t)(BK * 2);
    const size_t hstepA = Sched::GATHER ? (size_t)0 : (size_t)HALF * g.lda * 2, hstepB = (size_t)HALF * g.ldb * 2;
    const unsigned ldsw = (unsigned)wid * 1024u;
    const int aoff = lds_byte(wr * 64 + fr, fq * 8), boff = lds_byte(wc * 32 + fr, fq * 8);
#define PG8_CAT(x0, x1) __builtin_shufflevector(__builtin_bit_cast(v4i_t, x0), __builtin_bit_cast(v4i_t, x1), 0, 1, 2, 3, 4, 5, 6, 7)
#define PG8_SA(b, h) (((b) * 2 + (h)) * HTB)
#define PG8_SB(b, h) ((4 + (b) * 2 + (h)) * HTB)
#define PG8_STAGE(bufoff, gbase, voff) do { _Pragma("unroll") for (int _i = 0; _i < 2; ++_i) \
        __builtin_amdgcn_global_load_lds((const unsigned*)((const char*)(gbase) + (voff)[_i]), (PG8_LAS unsigned*)(lds + (bufoff) + ldsw + _i * 8192), 16, 0, 0); } while (0)
#define PG8_LDA(dst, b, h) do { if constexpr (FP8) { _Pragma("unroll") for (int m = 0; m < 4; ++m) dst##8[m] = PG8_CAT(*(const PG8_LAS bf16x8*)(lds + PG8_SA(b, h) + aoff + m * 2048), *(const PG8_LAS bf16x8*)(lds + PG8_SA(b, h) + aoff + m * 2048 + 1024)); } \
      else { _Pragma("unroll") for (int m = 0; m < 4; ++m) _Pragma("unroll") for (int k = 0; k < 2; ++k) dst[m][k] = *(const PG8_LAS bf16x8*)(lds + PG8_SA(b, h) + aoff + m * 2048 + k * 1024); } } while (0)
#define PG8_LDB(dst, b, h) do { if constexpr (FP8) { _Pragma("unroll") for (int n = 0; n < 2; ++n) dst##8[n] = PG8_CAT(*(const PG8_LAS bf16x8*)(lds + PG8_SB(b, h) + boff + n * 2048), *(const PG8_LAS bf16x8*)(lds + PG8_SB(b, h) + boff + n * 2048 + 1024)); } \
      else { _Pragma("unroll") for (int n = 0; n < 2; ++n) _Pragma("unroll") for (int k = 0; k < 2; ++k) dst[n][k] = *(const PG8_LAS bf16x8*)(lds + PG8_SB(b, h) + boff + n * 2048 + k * 1024); } } while (0)
#define PG8_MMA(ai, bj, At, Bt) do { __builtin_amdgcn_s_setprio(1); if constexpr (FP8) { _Pragma("unroll") for (int m = 0; m < 4; ++m) _Pragma("unroll") for (int n = 0; n < 2; ++n) \
        asm volatile("v_mfma_scale_f32_16x16x128_f8f6f4 %0, %1, %2, %0, %3, %4 op_sel_hi:[0,0,0]" : "+v"(acc[ai][bj][m][n]) : "v"(Bt##8[n]), "v"(At##8[m]), "v"(scw8), "v"(sca8)); } \
      else { _Pragma("unroll") for (int m = 0; m < 4; ++m) _Pragma("unroll") for (int n = 0; n < 2; ++n) _Pragma("unroll") for (int k = 0; k < 2; ++k) \
        acc[ai][bj][m][n] = __builtin_amdgcn_mfma_f32_16x16x32_bf16(Bt[n][k], At[m][k], acc[ai][bj][m][n], 0, 0, 0); } __builtin_amdgcn_s_setprio(0); } while (0)
#define PG8_WAIT_V(n) asm volatile("s_waitcnt vmcnt(" #n ")" ::: "memory")
#define PG8_WAIT_L(n) asm volatile("s_waitcnt lgkmcnt(" #n ")" ::: "memory")
#define PG8_BAR __builtin_amdgcn_s_barrier()
#define PG8_SCHED __builtin_amdgcn_sched_barrier(0)
    Unit cur, nxt; int ui = 0;
    if (!S.next(0, cur)) return;
    f32x4 acc[2][2][4][2];
#pragma unroll
    for (int a = 0; a < 2; ++a)
#pragma unroll
        for (int b = 0; b < 2; ++b)
#pragma unroll
            for (int m = 0; m < 4; ++m)
#pragma unroll
                for (int n = 0; n < 2; ++n) acc[a][b][m][n] = (f32x4){0.f, 0.f, 0.f, 0.f};
    int scw8 = g.sw, sca8 = g.sa; asm volatile("" : "+v"(scw8), "+v"(sca8));
    bf16x8 At[4][2], B0[2][2], B1[2][2]; v8i_t At8[4], B08[2], B18[2];
    const char* cA = cur.a; const char* cB = cur.b; long cJ = cur.bjump;
    S.a_ready(cur);
    if constexpr (SP2) {
        if constexpr (Sched::GATHER) PG8_GOFF(cur, gA0, gA1);
        PG8_STAGE(PG8_SB(0, 0), cB, voffB); PG8_STAGE(PG8_SB(0, 1), cB + hstepB, voffB); do { if constexpr (Sched::GATHER) { PG8_STAGE(PG8_SA(0, 0), cA, gA0); } else { PG8_STAGE(PG8_SA(0, 0), cA, voffA); } } while (0); do { if constexpr (Sched::GATHER) { PG8_STAGE(PG8_SA(0, 1), cA, gA1); } else { PG8_STAGE(PG8_SA(0, 1), cA + hstepA, voffA); } } while (0);
        if (wr == 1) PG8_BAR;
        PG8_WAIT_V(2); PG8_BAR;
        PG8_STAGE(PG8_SB(1, 0), cB + kstep, voffB); do { if constexpr (Sched::GATHER) { PG8_STAGE(PG8_SA(1, 0), cA + kstep, gA0); } else { PG8_STAGE(PG8_SA(1, 0), cA + kstep, voffA); } } while (0); PG8_STAGE(PG8_SB(1, 1), cB + hstepB + kstep, voffB);
        PG8_WAIT_V(6); PG8_BAR;
    } else {
        PG8_STAGE(PG8_SB(0, 0), cB, voffB); PG8_STAGE(PG8_SA(0, 0), cA, voffA); PG8_STAGE(PG8_SB(0, 1), cB + hstepB, voffB); PG8_STAGE(PG8_SA(0, 1), cA + hstepA, voffA);
        if (wr == 1) PG8_BAR;
        PG8_WAIT_V(4); PG8_BAR;
        PG8_STAGE(PG8_SB(1, 0), cB + kstep, voffB); PG8_STAGE(PG8_SA(1, 0), cA + kstep, voffA); PG8_STAGE(PG8_SB(1, 1), cB + hstepB + kstep, voffB);
        PG8_WAIT_V(6); PG8_BAR;
    }
    for (;;) {
        const bool has_next = S.next(ui + 1, nxt);
        const char* nA = has_next ? nxt.a : cA; const char* nB = has_next ? nxt.b : cB;
        if constexpr (Sched::GATHER) { if (has_next) PG8_GOFF(nxt, gN0, gN1); else { gN0[0] = gA0[0]; gN0[1] = gA0[1]; gN1[0] = gA1[0]; gN1[1] = gA1[1]; } }
#pragma unroll 1
        for (int t = 0; t < nt; t += 2) {
            const bool last = (t == nt - 2);
            const char* a1 = cA + (size_t)(t + 1) * kstep;
            const char* a2 = last ? nA : cA + (size_t)(t + 2) * kstep; const char* b2 = last ? nB : cB + (size_t)(t + 2) * kstep + ((t + 2) >= g.ksplit ? cJ : 0L);
            const char* a3 = a2 + kstep; const char* b3 = b2 + kstep;
            if (last && has_next) S.a_ready(nxt);
            unsigned x0[2] = {0u, 0u}, x1[2] = {0u, 0u};
            if constexpr (Sched::GATHER) { x0[0] = last ? gN0[0] : gA0[0]; x0[1] = last ? gN0[1] : gA0[1]; x1[0] = last ? gN1[0] : gA1[0]; x1[1] = last ? gN1[1] : gA1[1]; }
            if constexpr (SP2) {
            PG8_LDB(B0, 0, 0); PG8_LDB(B1, 0, 1); PG8_SCHED; PG8_LDA(At, 0, 0); do { if constexpr (Sched::GATHER) { PG8_STAGE(PG8_SA(1, 1), a1, gA1); } else { PG8_STAGE(PG8_SA(1, 1), a1 + hstepA, voffA); } } while (0);
            PG8_WAIT_V(8); PG8_WAIT_L(0); PG8_BAR; PG8_MMA(0, 0, At, B0); PG8_MMA(0, 1, At, B1); PG8_BAR; PG8_SCHED;
            PG8_LDA(At, 0, 1); PG8_STAGE(PG8_SB(0, 0), b2, voffB); PG8_STAGE(PG8_SB(0, 1), b2 + hstepB, voffB); do { if constexpr (Sched::GATHER) { PG8_STAGE(PG8_SA(0, 0), a2, x0); } else { PG8_STAGE(PG8_SA(0, 0), a2, voffA); } } while (0);
            PG8_WAIT_V(8); PG8_WAIT_L(0); PG8_BAR; PG8_MMA(1, 0, At, B0); PG8_MMA(1, 1, At, B1); PG8_BAR; PG8_SCHED;
            PG8_LDB(B0, 1, 0); PG8_LDB(B1, 1, 1); PG8_SCHED; PG8_LDA(At, 1, 0); do { if constexpr (Sched::GATHER) { PG8_STAGE(PG8_SA(0, 1), a2, x1); } else { PG8_STAGE(PG8_SA(0, 1), a2 + hstepA, voffA); } } while (0);
            PG8_WAIT_V(8); PG8_WAIT_L(0); PG8_BAR; PG8_MMA(0, 0, At, B0); PG8_MMA(0, 1, At, B1); PG8_BAR; PG8_SCHED;
            PG8_LDA(At, 1, 1); PG8_STAGE(PG8_SB(1, 0), b3, voffB); PG8_STAGE(PG8_SB(1, 1), b3 + hstepB, voffB); do { if constexpr (Sched::GATHER) { PG8_STAGE(PG8_SA(1, 0), a3, x0); } else { PG8_STAGE(PG8_SA(1, 0), a3, voffA); } } while (0);
            PG8_WAIT_V(8); PG8_WAIT_L(0); PG8_BAR; PG8_MMA(1, 0, At, B0); PG8_MMA(1, 1, At, B1); PG8_BAR; PG8_SCHED;
            } else {
            PG8_LDB(B0, 0, 0); PG8_SCHED; PG8_LDA(At, 0, 0); PG8_STAGE(PG8_SA(1, 1), a1 + hstepA, voffA);
            PG8_WAIT_L(8); PG8_BAR; PG8_WAIT_L(0); PG8_MMA(0, 0, At, B0); PG8_BAR; PG8_SCHED;
            PG8_LDB(B1, 0, 1); PG8_STAGE(PG8_SB(0, 0), b2, voffB);
            PG8_BAR; PG8_WAIT_L(0); PG8_MMA(0, 1, At, B1); PG8_BAR;
            PG8_LDA(At, 0, 1); PG8_STAGE(PG8_SA(0, 0), a2, voffA);
            PG8_BAR; PG8_WAIT_L(0); PG8_MMA(1, 0, At, B0); PG8_BAR; PG8_SCHED;
            PG8_STAGE(PG8_SB(0, 1), b2 + hstepB, voffB);
            PG8_WAIT_V(6); PG8_BAR; PG8_MMA(1, 1, At, B1); PG8_BAR;
            PG8_LDB(B0, 1, 0); PG8_SCHED; PG8_LDA(At, 1, 0); PG8_STAGE(PG8_SA(0, 1), a2 + hstepA, voffA);
            PG8_WAIT_L(8); PG8_BAR; PG8_WAIT_L(0); PG8_MMA(0, 0, At, B0); PG8_BAR; PG8_SCHED;
            PG8_LDB(B1, 1, 1); PG8_STAGE(PG8_SB(1, 0), b3, voffB);
            PG8_BAR; PG8_WAIT_L(0); PG8_MMA(0, 1, At, B1); PG8_BAR;
            PG8_LDA(At, 1, 1); PG8_STAGE(PG8_SA(1, 0), a3, voffA);
            PG8_BAR; PG8_WAIT_L(0); PG8_MMA(1, 0, At, B0); PG8_BAR; PG8_SCHED;
            PG8_STAGE(PG8_SB(1, 1), b3 + hstepB, voffB);
            PG8_WAIT_V(6); PG8_BAR; PG8_MMA(1, 1, At, B1); PG8_BAR;
            }
        }
        if constexpr (ALIGN_EPI) { if (wr == 0) PG8_BAR; }
        if constexpr (!Epi::AFTER_DRAIN) { E(acc, cur, wr, wc, fr, fq); S.done(cur); }
        if (!has_next) break;
#pragma unroll
        for (int a = 0; a < 2; ++a)
#pragma unroll
            for (int b = 0; b < 2; ++b)
#pragma unroll
                for (int m = 0; m < 4; ++m)
#pragma unroll
                    for (int n = 0; n < 2; ++n) acc[a][b][m][n] = (f32x4){0.f, 0.f, 0.f, 0.f};
        cur = nxt; cA = nA; cB = nB; cJ = cur.bjump; ++ui;
        if constexpr (Sched::GATHER) { gA0[0] = gN0[0]; gA0[1] = gN0[1]; gA1[0] = gN1[0]; gA1[1] = gN1[1]; }
        if constexpr (ALIGN_EPI) { if (wr == 1) PG8_BAR; }
    }
    PG8_WAIT_V(0);
    if constexpr (!ALIGN_EPI) { if (wr == 0) PG8_BAR; }
    PG8_BAR;
    if constexpr (Epi::AFTER_DRAIN) { E.fused(acc, cur, wr, wc, fr, fq, lds, wid, lane); S.done(cur); }
#undef PG8_GOFF
#undef PG8_SA
#undef PG8_SB
#undef PG8_STAGE
#undef PG8_LDA
#undef PG8_LDB
#undef PG8_MMA
#undef PG8_CAT
#undef PG8_WAIT_V
#undef PG8_WAIT_L
#undef PG8_BAR
#undef PG8_SCHED
}
}

#ifndef PROBE_PH
#define PROBE_PH (-1)
#endif
#ifndef PROBE_MODE
#define PROBE_MODE (0)
#endif
constexpr int D = 1024, BATCH = 16, SEQ = 2048, T = BATCH * SEQ;
constexpr int INW = 6984, INWP = 7168;
constexpr int C_QA = 0, C_CKV = 1024, C_QI = 1280, C_KI = 1792, C_WI = 1856, C_RQ = 1864, C_RK = 2376, C_RV = 2888, C_RG = 3912, C_GA = 4936, C_GR = 5960;
constexpr float EPS = 1e-6f;
constexpr int NWAVES = 8;

constexpr size_t MiB = 1u << 20;
constexpr size_t WS_CTL = 0, CTL_ZERO_BYTES = 1 * MiB;
constexpr size_t WS_WIN = 1 * MiB, WS_WKV = 15 * MiB, WS_WATT = 16 * MiB, WS_WRET = 18 * MiB, WS_WOUT = 20 * MiB, WS_W1 = 22 * MiB, WS_WD = 38 * MiB, WS_ACT = 46 * MiB;
constexpr size_t O_QA = 0, O_CKV = 2048, O_QI = 2560, O_KW = 3584, O_RQ = 3840, O_RK = 4864, O_RV = 5888, O_RG = 7936, O_GA = 9984, O_GR = 12032, O_END = 14080;

constexpr int MP_ROWS = 38912;
constexpr size_t MO_APERM = 0, MO_ACT = 80 * MiB, MO_N2 = 120 * MiB, MO_META = 184 * MiB;
constexpr size_t MM_B = 0, MM_P = 131072, MM_CL = 262144, MM_CH = 393216, MM_RS = 524288, MM_PTOK = 655360, MM_PRS = 819200, MM_PCL = 983040, MM_PCH = 1146880, MM_END = 1310720;
constexpr size_t WS_WR = 15 * MiB + 512 * 1024;
constexpr size_t O_A2F8 = 1024;
constexpr size_t O_RSTATE = O_RQ + 512;
#define A2F8_PTR (F.act + (size_t)F.ntok * O_A2F8)
#define RSTATE_PTR ((float*)(F.act + (size_t)F.ntok * O_RSTATE))
#define RSTD1_PTR ((float*)(F.act + (size_t)F.ntok * O_RSTATE + 8 * MiB))
constexpr size_t MO_LIST = 152 * MiB; constexpr int LIST_CAP = 32768;
constexpr size_t MO_H16 = 192 * MiB;
constexpr size_t WS_WIN8 = 488 * MiB;
constexpr size_t WS_WATT8 = 495 * MiB, WS_WRET8 = 496 * MiB, WS_WOUT8 = 497 * MiB;
constexpr size_t O_MIX8 = 3840;
constexpr size_t WS_W18 = 498 * MiB, WS_WD8 = 506 * MiB;
constexpr size_t AUX_XB8 = 2048 + 896;
constexpr int F8_FIRST_TILE = 8;
constexpr int CW_MOE = 256;
constexpr int RING_OFF = 0, RING_BYTES = 131072, P3_HIST_OFF = 131072, P3_TOT_OFF = 147456, P3_T_OFF = 149504, LDSCTL_OFF = 151552, MISC_OFF = LDSCTL_OFF + 320, LDS_BYTES = 152576;
constexpr int CW_Q3 = 64, CW_Q4 = 128;

#define GAS __attribute__((address_space(1)))
#define LAS __attribute__((address_space(3)))
typedef unsigned short bf16;
typedef unsigned v4u __attribute__((ext_vector_type(4)));
typedef float f32x4 __attribute__((ext_vector_type(4)));
#define LDS_WAIT() asm volatile("s_waitcnt lgkmcnt(0)" ::: "memory")
#define VM_WAIT() asm volatile("s_waitcnt vmcnt(0)" ::: "memory")
__device__ __forceinline__ unsigned f2bf(float f) { unsigned u = __builtin_bit_cast(unsigned, f); return (u + 0x7fffu + ((u >> 16) & 1u)) >> 16; }
__device__ __forceinline__ unsigned pk2(float lo, float hi) { return f2bf(lo) | (f2bf(hi) << 16); }
__device__ __forceinline__ float bf2f(bf16 b) { return __uint_as_float((unsigned)b << 16); }


typedef GAS unsigned gu32;
constexpr int CW_BAR = 4096;
#define XB_TMO      128
#define XB_XCNT(j)  (256  + 64 * (j))
#define XB_XSUB(j)  (1280 + 64 * (j))
#define XB_XGEN(j)  (2304 + 64 * (j))
#define XB_TOP      3328
#define XB_TOPGEN   3392
#define XCD_BAR_WORDS 3456
#define XB_SPIN_CAP (1u << 18)

__device__ __forceinline__ unsigned xb_ld(unsigned* p)              { return __hip_atomic_load(p, __ATOMIC_RELAXED, __HIP_MEMORY_SCOPE_AGENT); }
__device__ __forceinline__ unsigned xb_add(unsigned* p, unsigned v) { return __hip_atomic_fetch_add(p, v, __ATOMIC_RELAXED, __HIP_MEMORY_SCOPE_AGENT); }
__device__ __forceinline__ unsigned xb_xcc_id() { return (unsigned)__builtin_amdgcn_s_getreg((3 << 11) | 20) & 0xFu; }
#define XB_SPIN(cond, bar) do { unsigned _sp = 0; while (cond) { __builtin_amdgcn_s_sleep(1); \
    if ((++_sp & 255u) == 0u) { if (xb_ld(&(bar)[XB_TMO])) break; if (_sp > XB_SPIN_CAP) { atomicAdd(&(bar)[XB_TMO], 1u); break; } } } } while (0)

struct XcdBarrier {
    unsigned* bar; unsigned x;
    volatile LAS unsigned* st;
};

__device__ __forceinline__ XcdBarrier xcd_barrier_post(unsigned* bar, volatile LAS unsigned* st) {
    XcdBarrier b; b.bar = bar; b.x = xb_xcc_id(); b.st = st;
    if (threadIdx.x == 0) (void)xb_add(&bar[XB_XCNT(b.x)], 1u);
    return b;
}
__device__ __forceinline__ void xcd_barrier_complete(unsigned* bar, unsigned x, unsigned& nloc, unsigned& nx) {
    const unsigned G = gridDim.x * gridDim.y * gridDim.z;
    unsigned sum, cnt, mine, sp = 0u;
    for (;;) {
        sum = 0u; cnt = 0u; mine = 0u;
#pragma unroll
        for (unsigned j = 0; j < 16; ++j) { const unsigned c = xb_ld(&bar[XB_XCNT(j)]); sum += c; cnt += (c > 0u) ? 1u : 0u; mine = (j == x) ? c : mine; }
        if (sum == G) break;
        __builtin_amdgcn_s_sleep(1);
        if ((++sp & 255u) == 0u) { if (xb_ld(&bar[XB_TMO])) break; if (sp > XB_SPIN_CAP) { atomicAdd(&bar[XB_TMO], 1u); break; } }
    }
    nloc = mine > 0u ? mine : 1u; nx = cnt > 0u ? cnt : 1u;
}

__device__ __forceinline__ void xcd_barrier(const XcdBarrier& b) {
    asm volatile("s_waitcnt vmcnt(0)" ::: "memory");
    __syncthreads();
    if (threadIdx.x == 0) {
        unsigned* bar = b.bar;
        __builtin_amdgcn_s_waitcnt(0);
        unsigned nloc = b.st[0], nx = b.st[1];
        if (nloc == 0u) { xcd_barrier_complete(bar, b.x, nloc, nx); b.st[0] = nloc; b.st[1] = nx; }
        const unsigned old = xb_add(&bar[XB_XSUB(b.x)], 1u);
        const unsigned gen = old / nloc;
        if (old + 1u == (gen + 1u) * nloc) {
            __builtin_amdgcn_fence(__ATOMIC_RELEASE, "agent");
            asm volatile("s_waitcnt vmcnt(0)" ::: "memory");
            const unsigned og = xb_add(&bar[XB_TOP], 1u);
            const unsigned tg = og / nx;
            if (og + 1u == (tg + 1u) * nx) xb_add(&bar[XB_TOPGEN], 1u);
            else XB_SPIN(xb_ld(&bar[XB_TOPGEN]) == tg, bar);
            __builtin_amdgcn_fence(__ATOMIC_ACQUIRE, "agent");
            xb_add(&bar[XB_XGEN(b.x)], 1u);
            asm volatile("s_waitcnt vmcnt(0)" ::: "memory");
        } else {
            XB_SPIN(xb_ld(&bar[XB_XGEN(b.x)]) == gen, bar);
            __builtin_amdgcn_fence(__ATOMIC_ACQUIRE, "agent");
            asm volatile("s_waitcnt vmcnt(0)" ::: "memory");
        }
    }
    __syncthreads();
}

struct Args { const float* in[20]; float* out; unsigned char* ws; unsigned char* xb; int ph_lo, ph_hi, ntok, tok0, mode, pad; };

struct Frame {
    LAS unsigned char* lds;
    int tid, lane, wave, vcu, G;
    int ntok;
    unsigned char* ws; unsigned char* act; unsigned char* xbp;
};

struct EpiProj {
    static constexpr bool PERM = true, AFTER_DRAIN = false;
    unsigned char* act; size_t ntok; const float* rstd1;
    static __device__ __forceinline__ unsigned q4(const pg8::f32x4& v) { int w = __builtin_amdgcn_cvt_pk_fp8_f32(v[0], v[1], 0, false); return (unsigned)__builtin_amdgcn_cvt_pk_fp8_f32(v[2], v[3], w, true); }
    __device__ __forceinline__ void operator()(const pg8::f32x4 (&acc)[2][2][4][2], const pg8::Unit& u, int wr, int wc, int fr, int fq) const {
        const int pn = u.pn; size_t O; int ld, cb, nbj = 2; bool f8 = false;
        if (pn < 4) { O = O_QA; ld = 1024; cb = pn * 256; }
        else if (pn == 4) { O = O_CKV; ld = 256; cb = 0; }
        else if (pn < 7) { O = O_QI; ld = 512; cb = (pn - 5) * 256; }
        else if (pn == 7) { O = O_KW; ld = 128; cb = 0; nbj = 1; }
        else if (pn < 10) { O = O_RQ; ld = 512; cb = (pn - 8) * 256; }
        else if (pn < 12) { O = O_RK; ld = 512; cb = (pn - 10) * 256; }
        else { O = O_RV + (size_t)((pn - 12) >> 2) * 2048; ld = 1024; cb = ((pn - 12) & 3) * 256; }
        f8 = pn < 5 || pn >= F8_FIRST_TILE;
        const int row0 = u.pm * pg8::BM + wr * 64 + fr;
        if (f8) {
            unsigned char* base = act + ntok * O; const bool odd = fq & 1; const int colb = cb + wc * 32 + 8 * (fq & ~1);
#pragma unroll
            for (int ai = 0; ai < 2; ++ai)
#pragma unroll
                for (int bj = 0; bj < 2; ++bj)
#pragma unroll
                    for (int mp = 0; mp < 2; ++mp) { const unsigned x0 = q4(acc[ai][bj][2 * mp][0]), x1 = q4(acc[ai][bj][2 * mp][1]), y0 = q4(acc[ai][bj][2 * mp + 1][0]), y1 = q4(acc[ai][bj][2 * mp + 1][1]);
                        const unsigned r0 = (unsigned)__builtin_amdgcn_ds_swizzle((int)(odd ? x0 : y0), 0x401F), r1 = (unsigned)__builtin_amdgcn_ds_swizzle((int)(odd ? x1 : y1), 0x401F);
                        pg8::u32x4 w; if (odd) { w.x = r0; w.y = r1; w.z = y0; w.w = y1; } else { w.x = x0; w.y = x1; w.z = r0; w.w = r1; }
                        *(pg8::u32x4*)(base + (size_t)(row0 + ai * pg8::HALF + (2 * mp + (odd ? 1 : 0)) * 16) * ld + colb + bj * pg8::HALF) = w; }
            return;
        }
        pg8::bf16_t* base = (pg8::bf16_t*)(act + ntok * O);
        const int col0 = cb + wc * 32 + 8 * fq;
        float rs1[2][4];
#pragma unroll
        for (int ai = 0; ai < 2; ++ai)
#pragma unroll
            for (int m = 0; m < 4; ++m) rs1[ai][m] = rstd1[row0 + ai * pg8::HALF + m * 16];
#pragma unroll
        for (int ai = 0; ai < 2; ++ai)
#pragma unroll
            for (int m = 0; m < 4; ++m) { pg8::bf16_t* rowp = base + (size_t)(row0 + ai * pg8::HALF + m * 16) * ld + col0; const float rs = rs1[ai][m];
#pragma unroll
                for (int bj = 0; bj < 2; ++bj) if (bj < nbj) { const pg8::f32x4 v0 = acc[ai][bj][m][0] * rs, v1 = acc[ai][bj][m][1] * rs;
                    pg8::u32x4 w; w.x = pg8::cvt_pk_bf16(v0[0], v0[1]); w.y = pg8::cvt_pk_bf16(v0[2], v0[3]); w.z = pg8::cvt_pk_bf16(v1[0], v1[1]); w.w = pg8::cvt_pk_bf16(v1[2], v1[3]);
                    *(pg8::u32x4*)(rowp + bj * pg8::HALF) = w; } }
    }
};

__device__ __forceinline__ float sigm(float x) { return __builtin_amdgcn_rcpf(1.f + __builtin_amdgcn_exp2f(-1.4426950408889634f * x)); }
__device__ __forceinline__ void f8x8(const pg8::u32x2 g, float (&f)[8]) { const auto a = __builtin_amdgcn_cvt_pk_f32_fp8((int)g.x, false), b = __builtin_amdgcn_cvt_pk_f32_fp8((int)g.x, true), c = __builtin_amdgcn_cvt_pk_f32_fp8((int)g.y, false), d = __builtin_amdgcn_cvt_pk_f32_fp8((int)g.y, true);
    f[0] = a[0]; f[1] = a[1]; f[2] = b[0]; f[3] = b[1]; f[4] = c[0]; f[5] = c[1]; f[6] = d[0]; f[7] = d[1]; }
__device__ __forceinline__ void st_f8_pair(unsigned char* base, size_t ld, int row_m0, int colb, bool odd, unsigned x0, unsigned x1, unsigned y0, unsigned y1) {
    const unsigned r0 = (unsigned)__builtin_amdgcn_ds_swizzle((int)(odd ? x0 : y0), 0x401F), r1 = (unsigned)__builtin_amdgcn_ds_swizzle((int)(odd ? x1 : y1), 0x401F);
    pg8::u32x4 w; if (odd) { w.x = r0; w.y = r1; w.z = y0; w.w = y1; } else { w.x = x0; w.y = x1; w.z = r0; w.w = r1; }
    *(pg8::u32x4*)(base + (size_t)(row_m0 + (odd ? 16 : 0)) * ld + colb) = w;
}
__device__ __forceinline__ unsigned q4f(float a, float b, float c, float d) { int w = __builtin_amdgcn_cvt_pk_fp8_f32(a, b, 0, false); return (unsigned)__builtin_amdgcn_cvt_pk_fp8_f32(c, d, w, true); }
struct EpiGateA {
    static constexpr bool PERM = true, AFTER_DRAIN = false;
    const unsigned char* GA8; unsigned char* TMP8;
    __device__ __forceinline__ void operator()(const pg8::f32x4 (&acc)[2][2][4][2], const pg8::Unit& u, int wr, int wc, int fr, int fq) const {
        const int row0 = u.pm * pg8::BM + wr * 64 + fr, col0 = u.pn * pg8::BM + wc * 32 + 8 * fq, colb = u.pn * pg8::BM + wc * 32 + 8 * (fq & ~1); const bool odd = fq & 1;
        pg8::u32x2 gl[2][2][4];
#pragma unroll
        for (int ai = 0; ai < 2; ++ai)
#pragma unroll
            for (int bj = 0; bj < 2; ++bj)
#pragma unroll
                for (int m = 0; m < 4; ++m) gl[ai][bj][m] = *(const pg8::u32x2*)(GA8 + (size_t)(row0 + ai * pg8::HALF + m * 16) * 1024 + col0 + bj * pg8::HALF);
#pragma unroll
        for (int ai = 0; ai < 2; ++ai)
#pragma unroll
            for (int bj = 0; bj < 2; ++bj)
#pragma unroll
                for (int mp = 0; mp < 2; ++mp) { unsigned q[2][2];
#pragma unroll
                    for (int e = 0; e < 2; ++e) { const int m = 2 * mp + e; float g[8]; f8x8(gl[ai][bj][m], g);
                        const pg8::f32x4 v0 = acc[ai][bj][m][0], v1 = acc[ai][bj][m][1];
                        q[e][0] = q4f(32.f * sigm(g[0]) * v0[0], 32.f * sigm(g[1]) * v0[1], 32.f * sigm(g[2]) * v0[2], 32.f * sigm(g[3]) * v0[3]); q[e][1] = q4f(32.f * sigm(g[4]) * v1[0], 32.f * sigm(g[5]) * v1[1], 32.f * sigm(g[6]) * v1[2], 32.f * sigm(g[7]) * v1[3]); }
                    st_f8_pair(TMP8, 1024, row0 + ai * pg8::HALF + 2 * mp * 16, colb + bj * pg8::HALF, odd, q[0][0], q[0][1], q[1][0], q[1][1]); }
    }
};
struct EpiGateB {
    static constexpr bool PERM = true, AFTER_DRAIN = false;
    const unsigned char* TMP8; const unsigned char* GR8; unsigned char* MIX8;
    __device__ __forceinline__ void operator()(const pg8::f32x4 (&acc)[2][2][4][2], const pg8::Unit& u, int wr, int wc, int fr, int fq) const {
        const int row0 = u.pm * pg8::BM + wr * 64 + fr, col0 = u.pn * pg8::BM + wc * 32 + 8 * fq, colb = u.pn * pg8::BM + wc * 32 + 8 * (fq & ~1); const bool odd = fq & 1;
        pg8::u32x2 gl[2][2][4], tl[2][2][4];
#pragma unroll
        for (int ai = 0; ai < 2; ++ai)
#pragma unroll
            for (int bj = 0; bj < 2; ++bj)
#pragma unroll
                for (int m = 0; m < 4; ++m) { const size_t ro = (size_t)(row0 + ai * pg8::HALF + m * 16) * 1024 + col0 + bj * pg8::HALF; gl[ai][bj][m] = *(const pg8::u32x2*)(GR8 + ro); tl[ai][bj][m] = *(const pg8::u32x2*)(TMP8 + ro); }
#pragma unroll
        for (int ai = 0; ai < 2; ++ai)
#pragma unroll
            for (int bj = 0; bj < 2; ++bj)
#pragma unroll
                for (int mp = 0; mp < 2; ++mp) { unsigned q[2][2];
#pragma unroll
                    for (int e = 0; e < 2; ++e) { const int m = 2 * mp + e; float g[8], t[8]; f8x8(gl[ai][bj][m], g); f8x8(tl[ai][bj][m], t);
                        const pg8::f32x4 v0 = acc[ai][bj][m][0], v1 = acc[ai][bj][m][1];
                        q[e][0] = q4f(0.25f * t[0] + 8.f * sigm(g[0]) * v0[0], 0.25f * t[1] + 8.f * sigm(g[1]) * v0[1], 0.25f * t[2] + 8.f * sigm(g[2]) * v0[2], 0.25f * t[3] + 8.f * sigm(g[3]) * v0[3]);
                        q[e][1] = q4f(0.25f * t[4] + 8.f * sigm(g[4]) * v1[0], 0.25f * t[5] + 8.f * sigm(g[5]) * v1[1], 0.25f * t[6] + 8.f * sigm(g[6]) * v1[2], 0.25f * t[7] + 8.f * sigm(g[7]) * v1[3]); }
                    st_f8_pair(MIX8, 1024, row0 + ai * pg8::HALF + 2 * mp * 16, colb + bj * pg8::HALF, odd, q[0][0], q[0][1], q[1][0], q[1][1]); }
    }
};
struct EpiResid {
    static constexpr bool PERM = true, AFTER_DRAIN = false;
    const pg8::bf16_t* xb; pg8::bf16_t* h16;
    __device__ __forceinline__ void operator()(const pg8::f32x4 (&acc)[2][2][4][2], const pg8::Unit& u, int wr, int wc, int fr, int fq) const {
        const int row0 = u.pm * pg8::BM + wr * 64 + fr, col0 = u.pn * pg8::BM + wc * 32 + 8 * fq;
        pg8::u32x4 xl[2][4][2];
#pragma unroll
        for (int ai = 0; ai < 2; ++ai)
#pragma unroll
            for (int m = 0; m < 4; ++m)
#pragma unroll
                for (int bj = 0; bj < 2; ++bj) xl[ai][m][bj] = *(const pg8::u32x4*)(xb + (size_t)(row0 + ai * pg8::HALF + m * 16) * 1024 + col0 + bj * pg8::HALF);
#pragma unroll
        for (int ai = 0; ai < 2; ++ai)
#pragma unroll
            for (int m = 0; m < 4; ++m) { const size_t ro = (size_t)(row0 + ai * pg8::HALF + m * 16) * 1024 + col0;
#pragma unroll
                for (int bj = 0; bj < 2; ++bj) { const pg8::u32x4 xv = xl[ai][m][bj]; const pg8::f32x4 v0 = acc[ai][bj][m][0], v1 = acc[ai][bj][m][1];
                    pg8::u32x4 w; w.x = pg8::cvt_pk_bf16(v0[0] + pg8::bf_lo(xv.x), v0[1] + pg8::bf_hi(xv.x)); w.y = pg8::cvt_pk_bf16(v0[2] + pg8::bf_lo(xv.y), v0[3] + pg8::bf_hi(xv.y));
                    w.z = pg8::cvt_pk_bf16(v1[0] + pg8::bf_lo(xv.z), v1[1] + pg8::bf_hi(xv.z)); w.w = pg8::cvt_pk_bf16(v1[2] + pg8::bf_lo(xv.w), v1[3] + pg8::bf_hi(xv.w));
                    *(pg8::u32x4*)(h16 + ro + bj * pg8::HALF) = w; } }
    }
};


struct P1Order {
    static constexpr bool GATHER = false; const int* ptok = nullptr;
    int nM, nN, nwg, G, c, mode; const char* A; const char* Bt; size_t tA, tB;
    __device__ bool next(int i, pg8::Unit& u) const {
        const long L = (long)i * G + c; if (L >= nwg) return false;
        int wgid = (int)L; { const int q = nwg / pg8::NXCD, r = nwg % pg8::NXCD, xcd = wgid % pg8::NXCD, off = wgid / pg8::NXCD; wgid = (xcd < r ? xcd * (q + 1) : r * (q + 1) + (xcd - r) * q) + off; }
        const int nig = pg8::WGM * nN, gid = wgid / nig, fm = gid * pg8::WGM, gsz = (nM - fm) < pg8::WGM ? (nM - fm) : pg8::WGM;
        u.pm = fm + ((wgid % nig) % gsz); const int pc = (wgid % nig) / gsz; u.pn = mode ? 5 + pc : (pc < 5 ? pc : pc + 3);
        u.a = A + (size_t)u.pm * tA; u.b = Bt + (size_t)u.pn * tB; u.bjump = 0; u.aux = 0; u.nvalid = 256; return true;
    }
    __device__ __forceinline__ void a_ready(const pg8::Unit&) const {}
    __device__ __forceinline__ void done(const pg8::Unit&) const {}
};

__device__ __forceinline__ float wave_sum(float v) {
#pragma unroll
    for (int o = 1; o < 64; o <<= 1) v += __shfl_xor(v, o);
    return v;
}
__device__ __forceinline__ void p0_transpose_item(const float* W, int K, int N, bf16* WT, int map, int row_off, int par, const float* gk, LAS float* scr, int item, int lane, unsigned char* WT8 = nullptr, float s8 = 32.f) {
    const int nblk = (N + 31) / 32, kb = item / nblk, nb = item % nblk, k0 = 64 * kb, n0 = 32 * nb;
    const int c4 = lane & 7, rr = lane >> 3; const bool okc = (n0 + 4 * c4) < N;
    f32x4 v[8];
#pragma unroll
    for (int i = 0; i < 8; ++i) { const int kk = i * 8 + rr; v[i] = okc ? *(const f32x4*)(W + (size_t)(k0 + kk) * N + n0 + 4 * c4) : (f32x4){0.f, 0.f, 0.f, 0.f}; }
#pragma unroll
    for (int i = 0; i < 8; ++i) { const int kk = i * 8 + rr; f32x4 x = v[i]; if (gk) x = x * gk[k0 + kk]; *(LAS f32x4*)(scr + kk * 36 + 4 * c4) = x; }
    LDS_WAIT(); asm volatile("" ::: "memory");
    const int c = lane & 7;
#pragma unroll
    for (int j = 0; j < 4; ++j) { const int nl = (lane >> 3) + 8 * j, n = n0 + nl; const LAS float* s = scr + (8 * c) * 36 + nl;
        v4u o; o.x = pk2(s[0 * 36], s[1 * 36]); o.y = pk2(s[2 * 36], s[3 * 36]); o.z = pk2(s[4 * 36], s[5 * 36]); o.w = pk2(s[6 * 36], s[7 * 36]);
        if (n < N) { const int row = (map == 0) ? row_off + n : (map == 1) ? (n < 1864 ? n : n + 184) : row_off + 2 * n + par;
            if (WT) *(GAS v4u*)(WT + (size_t)row * K + k0 + 8 * c) = o;
            if (WT8) { int w0 = __builtin_amdgcn_cvt_pk_fp8_f32(s[0 * 36] * s8, s[1 * 36] * s8, 0, false); w0 = __builtin_amdgcn_cvt_pk_fp8_f32(s[2 * 36] * s8, s[3 * 36] * s8, w0, true);
                int w1 = __builtin_amdgcn_cvt_pk_fp8_f32(s[4 * 36] * s8, s[5 * 36] * s8, 0, false); w1 = __builtin_amdgcn_cvt_pk_fp8_f32(s[6 * 36] * s8, s[7 * 36] * s8, w1, true);
                *(GAS unsigned long long*)(WT8 + (size_t)row * K + k0 + 8 * c) = (unsigned long long)(unsigned)w0 | ((unsigned long long)(unsigned)w1 << 32); } } }
    LDS_WAIT(); asm volatile("" ::: "memory");
}
__device__ __forceinline__ void p0_prologue(Frame& F, const Args& a) {
    LAS float* scr = (LAS float*)(F.lds + RING_OFF + F.wave * 16384);
    const int gw = F.vcu * NWAVES + F.wave, NGW = F.G * NWAVES;
    bf16* Win_t = (bf16*)(F.ws + WS_WIN); bf16* Wkv_t = (bf16*)(F.ws + WS_WKV);
    constexpr int I_IN = 16 * 219, I_KV = 4 * 8, I_SQ = 16 * 32, I_GU = 16 * 8  , I_DN = 4 * 32  ;
    constexpr int NITEMS = I_IN + I_KV + 3 * I_SQ + 16 * (2 * I_GU + I_DN);
    for (int it = gw; it < NITEMS; it += NGW) {
        int r = it;
        if (r < I_IN) { p0_transpose_item(a.in[2], 1024, INW, Win_t, 1, 0, 0, a.in[1], scr, r, F.lane, F.ws + WS_WIN8); continue; } r -= I_IN;
        if (r < I_KV) { p0_transpose_item(a.in[4], 256, 256, Wkv_t, 0, 0, 0, a.in[3], scr, r, F.lane); continue; } r -= I_KV;
        if (r < I_SQ) { p0_transpose_item(a.in[9], 1024, 1024, nullptr, 0, 0, 0, nullptr, scr, r, F.lane, F.ws + WS_WATT8, 32.f); continue; } r -= I_SQ;
        if (r < I_SQ) { p0_transpose_item(a.in[10], 1024, 1024, nullptr, 0, 0, 0, nullptr, scr, r, F.lane, F.ws + WS_WRET8, 32.f); continue; } r -= I_SQ;
        if (r < I_SQ) { p0_transpose_item(a.in[11], 1024, 1024, nullptr, 0, 0, 0, nullptr, scr, r, F.lane, F.ws + WS_WOUT8, 32.f); continue; } r -= I_SQ;
        const int e = r / (2 * I_GU + I_DN), q = r % (2 * I_GU + I_DN);
        if (q < I_GU) p0_transpose_item(a.in[17] + (size_t)e * 1024 * 256, 1024, 256, nullptr, 2, e * 512, 0, nullptr, scr, q, F.lane, F.ws + WS_W18, 32.f);
        else if (q < 2 * I_GU) p0_transpose_item(a.in[18] + (size_t)e * 1024 * 256, 1024, 256, nullptr, 2, e * 512, 1, nullptr, scr, q - I_GU, F.lane, F.ws + WS_W18, 32.f);
        else p0_transpose_item(a.in[19] + (size_t)e * 256 * 1024, 256, 1024, nullptr, 0, 0, 0, nullptr, scr, q - 2 * I_GU, F.lane, F.ws + WS_WD8 + (size_t)e * 1024 * 256, 16.f);
    }
    { const int gt = (F.vcu * NWAVES + F.wave) * 64 + F.lane, NGT = F.G * NWAVES * 64; GAS v4u* z = (GAS v4u*)(Win_t + (size_t)1864 * 1024);
      for (int i = gt; i < 184 * 1024 * 2 / 16; i += NGT) z[i] = (v4u){0u, 0u, 0u, 0u}; }
    { const int gt = (F.vcu * NWAVES + F.wave) * 64 + F.lane, NGT = F.G * NWAVES * 64; bf16* Wh = (bf16*)(F.ws + WS_WR); bf16* Wl = Wh + 32 * 1024;
      for (int i = gt; i < 32 * 1024; i += NGT) { const int n = i >> 10, k = i & 1023; const float wv = n < 4 ? a.in[13][k * 4 + n] : (n < 20 ? a.in[15][k * 16 + (n - 4)] : 0.f);
        const unsigned hb = f2bf(wv); const float hf = __uint_as_float(hb << 16); Wh[i] = (bf16)hb; Wl[i] = (bf16)f2bf(wv - hf); } }
    const float* x = a.in[0] + (size_t)a.tok0 * D; unsigned char* xb8 = a.xb + (size_t)F.ntok * AUX_XB8;
    for (int m = gw; m < F.ntok; m += 2 * NGW) {
        const int m2 = m + NGW; const bool two = m2 < F.ntok;
        const GAS f32x4* xr = (const GAS f32x4*)(x + (size_t)m * D) + F.lane; const GAS f32x4* xr2 = (const GAS f32x4*)(x + (size_t)(two ? m2 : m) * D) + F.lane;
        f32x4 v[4], u[4]; float s = 0.f, s2 = 0.f;
#pragma unroll
        for (int j = 0; j < 4; ++j) { v[j] = xr[64 * j]; u[j] = xr2[64 * j]; }
#pragma unroll
        for (int j = 0; j < 4; ++j) { s += (v[j].x * v[j].x + v[j].y * v[j].y) + (v[j].z * v[j].z + v[j].w * v[j].w); s2 += (u[j].x * u[j].x + u[j].y * u[j].y) + (u[j].z * u[j].z + u[j].w * u[j].w); }
        const float rstd = 1.f / sqrtf(wave_sum(s) * (1.f / D) + EPS), rstd2 = 1.f / sqrtf(wave_sum(s2) * (1.f / D) + EPS);
        if (F.lane == 0) { RSTD1_PTR[m] = rstd; if (two) RSTD1_PTR[m2] = rstd2; }
        GAS unsigned long long* o8 = (GAS unsigned long long*)(a.xb + (size_t)m * D * 2) + F.lane; GAS unsigned* q8 = (GAS unsigned*)(xb8 + (size_t)m * D) + F.lane;
#pragma unroll
        for (int j = 0; j < 4; ++j) { o8[64 * j] = (unsigned long long)pk2(v[j].x, v[j].y) | ((unsigned long long)pk2(v[j].z, v[j].w) << 32);
            int w8 = __builtin_amdgcn_cvt_pk_fp8_f32(v[j].x * rstd, v[j].y * rstd, 0, false); w8 = __builtin_amdgcn_cvt_pk_fp8_f32(v[j].z * rstd, v[j].w * rstd, w8, true); q8[64 * j] = (unsigned)w8; }
        if (two) { GAS unsigned long long* p8 = (GAS unsigned long long*)(a.xb + (size_t)m2 * D * 2) + F.lane; GAS unsigned* r8 = (GAS unsigned*)(xb8 + (size_t)m2 * D) + F.lane;
#pragma unroll
            for (int j = 0; j < 4; ++j) { p8[64 * j] = (unsigned long long)pk2(u[j].x, u[j].y) | ((unsigned long long)pk2(u[j].z, u[j].w) << 32);
                int w8 = __builtin_amdgcn_cvt_pk_fp8_f32(u[j].x * rstd2, u[j].y * rstd2, 0, false); w8 = __builtin_amdgcn_cvt_pk_fp8_f32(u[j].z * rstd2, u[j].w * rstd2, w8, true); r8[64 * j] = (unsigned)w8; } }
    }
}


constexpr size_t AUX_KP = 0, AUX_VV = 256, AUX_KIN = 512, AUX_MASK = 640, AUX_END = 896;
typedef short bf16x8_t __attribute__((ext_vector_type(8)));
typedef float f32x16 __attribute__((ext_vector_type(16)));
__device__ __forceinline__ int crow(int r, int hi) { return (r & 3) + 8 * (r >> 2) + 4 * hi; }
__device__ __forceinline__ float xhalf_sum(float v) { auto rr = __builtin_amdgcn_permlane32_swap(__float_as_uint(v), __float_as_uint(v), false, false); return __uint_as_float(rr[0]) + __uint_as_float(rr[1]); }
__device__ __forceinline__ float sumsq8(bf16x8_t v) { float s = 0.f;
#pragma unroll
    for (int j = 0; j < 8; ++j) { const float f = __uint_as_float((unsigned)(unsigned short)v[j] << 16); s += f * f; } return s; }
__device__ __forceinline__ void p2_post(Frame& F, const Args& a) {
    const int gw = F.vcu * NWAVES + F.wave, NGW = F.G * NWAVES, lane = F.lane, r32 = lane & 31, hi = lane >> 5;
    const size_t nt_ = (size_t)F.ntok;
    const bf16* CKV = (const bf16*)(F.act + nt_ * O_CKV); const bf16* KW = (const bf16*)(F.act + nt_ * O_KW);
    const bf16* Wkv_t = (const bf16*)(F.ws + WS_WKV);
    unsigned char* aux = a.xb + nt_ * 2048;
    bf16* KP = (bf16*)(aux + nt_ * AUX_KP); bf16* VV = (bf16*)(aux + nt_ * AUX_VV); bf16* KIN = (bf16*)(aux + nt_ * AUX_KIN);
    const float* g_q = a.in[5]; const float* g_k = a.in[6]; const float* g_ki = a.in[7];
    constexpr int WP = 528;
    LAS unsigned char* Wl = F.lds + RING_OFF; LAS float* gl = (LAS float*)(F.lds + RING_OFF + 256 * WP);
    for (int i = F.tid; i < 256 * 32; i += NWAVES * 64) { const int n = i >> 5, ch = i & 31; *(LAS v4u*)(Wl + n * WP + ch * 16) = *(const v4u*)(Wkv_t + (size_t)n * 256 + ch * 8); }
    if (F.tid < 128) gl[F.tid] = g_k[F.tid] * g_q[F.tid] * (0.08838834764831845f * 1.4426950408889634f);
    else if (F.tid < 192) gl[F.tid] = g_ki[F.tid - 128];
    __syncthreads();
    const int ntask = 2 * (F.ntok / 32);
    for (int task = gw; task < ntask; task += NGW) {
        const int kind = task & 1, t0 = (task >> 1) * 32;
        const unsigned char* crowp = (const unsigned char*)CKV + (size_t)(t0 + r32) * 256 + hi * 8;
        bf16x8_t bfr[16]; float ss = 0.f;
#pragma unroll
        for (int kk = 0; kk < 16; ++kk) { const unsigned long long c8 = *(const unsigned long long*)(crowp + kk * 16); const int lo = (int)(unsigned)c8, hi32 = (int)(unsigned)(c8 >> 32);
            const auto a_ = __builtin_amdgcn_cvt_pk_f32_fp8(lo, false), b_ = __builtin_amdgcn_cvt_pk_f32_fp8(lo, true), c_ = __builtin_amdgcn_cvt_pk_f32_fp8(hi32, false), d_ = __builtin_amdgcn_cvt_pk_f32_fp8(hi32, true);
            ss += (a_[0] * a_[0] + a_[1] * a_[1]) + (b_[0] * b_[0] + b_[1] * b_[1]) + (c_[0] * c_[0] + c_[1] * c_[1]) + (d_[0] * d_[0] + d_[1] * d_[1]);
            v4u pk; pk.x = pk2(a_[0], a_[1]); pk.y = pk2(b_[0], b_[1]); pk.z = pk2(c_[0], c_[1]); pk.w = pk2(d_[0], d_[1]); bfr[kk] = __builtin_bit_cast(bf16x8_t, pk); }
        ss = xhalf_sum(ss);
        const float rstd = rsqrtf(ss * (1.f / 256.f) + EPS);
        f32x16 acc[4];
#pragma unroll
        for (int nt = 0; nt < 4; ++nt) { acc[nt] = f32x16{};
            const LAS unsigned char* wrow = Wl + (kind * 128 + nt * 32 + r32) * WP + hi * 16;
#pragma unroll
            for (int kk = 0; kk < 16; ++kk) { const bf16x8_t af = *(const LAS bf16x8_t*)(wrow + kk * 32); acc[nt] = __builtin_amdgcn_mfma_f32_32x32x16_bf16(af, bfr[kk], acc[nt], 0, 0, 0); if ((kk & 3) == 3) __builtin_amdgcn_sched_barrier(0); } }
        float sc = rstd;
        if (kind == 0) { float sk = 0.f;
#pragma unroll
            for (int nt = 0; nt < 4; ++nt)
#pragma unroll
                for (int r = 0; r < 16; ++r) { const float v = acc[nt][r] * rstd; sk += v * v; }
            sk = xhalf_sum(sk);
            sc = rstd * rsqrtf(sk * (1.f / 128.f) + EPS); }
        bf16* orow = (kind == 0 ? KP : VV) + (size_t)(t0 + r32) * 128;
#pragma unroll
        for (int nt = 0; nt < 4; ++nt)
#pragma unroll
            for (int g = 0; g < 4; ++g) { const int ch = nt * 32 + 8 * g + 4 * hi; float v[4];
#pragma unroll
                for (int j = 0; j < 4; ++j) { v[j] = acc[nt][4 * g + j] * sc; if (kind == 0) v[j] *= gl[ch + j]; }
                *(unsigned long long*)(orow + ch) = (unsigned long long)pk2(v[0], v[1]) | ((unsigned long long)pk2(v[2], v[3]) << 32); }
        if (kind == 0) {
            const bf16* kr = KW + (size_t)(t0 + r32) * 128 + hi * 32; bf16x8_t kv4[4]; float s2 = 0.f;
#pragma unroll
            for (int j = 0; j < 4; ++j) { kv4[j] = *(const bf16x8_t*)(kr + 8 * j); s2 += sumsq8(kv4[j]); }
            s2 = xhalf_sum(s2);
            const float rk = rsqrtf(s2 * (1.f / 64.f) + EPS);
            bf16* ko = KIN + (size_t)(t0 + r32) * 64 + hi * 32;
#pragma unroll
            for (int j = 0; j < 4; ++j) { float f[8];
#pragma unroll
                for (int e = 0; e < 8; ++e) f[e] = __uint_as_float((unsigned)(unsigned short)kv4[j][e] << 16) * rk * gl[128 + hi * 32 + 8 * j + e];
                v4u o; o.x = pk2(f[0], f[1]); o.y = pk2(f[2], f[3]); o.z = pk2(f[4], f[5]); o.w = pk2(f[6], f[7]);
                *(v4u*)(ko + 8 * j) = o; }
        }
    }
    __syncthreads();
}

typedef float f32x4_t __attribute__((ext_vector_type(4)));
__device__ __forceinline__ unsigned key15_of(float s) { const unsigned short hb = __builtin_bit_cast(unsigned short, (_Float16)s); const unsigned u = (hb & 0x8000u) ? (~(unsigned)hb & 0xffffu) : ((unsigned)hb | 0x8000u); return u >> 1; }
__device__ __forceinline__ unsigned sad4(unsigned x) { return __builtin_amdgcn_sad_u8(x, 0u, 0u); }
__device__ __forceinline__ void p3_merge(LAS unsigned* hist, LAS unsigned short* tot, int w, int g, int q, int& need, int& bsel) {
    __syncthreads();
    const int o = 4 * w + g; unsigned c = 0;
#pragma unroll
    for (int p = 0; p < 32; ++p) { const int tidp = (p >> 2) * 64 + (p & 3) * 16 + q; c += (hist[(o >> 2) * 512 + tidp] >> (8 * (o & 3))) & 0xffu; }
    tot[q * 32 + o] = (unsigned short)c;
    __syncthreads();
    v4u tv[4];
#pragma unroll
    for (int j = 0; j < 4; ++j) tv[j] = *(const LAS v4u*)((const LAS unsigned char*)tot + q * 64 + j * 16);
    int cum = 0, bs = 0, ab = 0; bool found = false;
#pragma unroll
    for (int bin = 31; bin >= 0; --bin) { const unsigned wd = tv[bin >> 3][(bin >> 1) & 3]; const int cc = (int)((bin & 1) ? (wd >> 16) : (wd & 0xffffu));
        if (!found && cum + cc >= need) { bs = bin; ab = cum; found = true; } cum += cc; }
    bsel = bs; need -= ab;
}
__device__ __forceinline__ void p3_index(Frame& F, const Args& a) {
    const int tid = F.tid, lane = F.lane, w = F.wave, q = lane & 15, g = lane >> 4;
    LAS unsigned* keys = (LAS unsigned*)(F.lds + RING_OFF);
    LAS unsigned char* qbuf = F.lds + 65536;
    LAS unsigned* hist = (LAS unsigned*)(F.lds + P3_HIST_OFF);
    LAS unsigned short* tot = (LAS unsigned short*)(F.lds + P3_TOT_OFF);
    LAS unsigned char* Tt = (LAS unsigned char*)(F.lds + P3_T_OFF);
    const size_t nt_ = (size_t)F.ntok;
    const bf16* QI = (const bf16*)(F.act + nt_ * O_QI); const bf16* KW = (const bf16*)(F.act + nt_ * O_KW);
    unsigned char* aux = a.xb + nt_ * 2048;
    const bf16* KIN = (const bf16*)(aux + nt_ * AUX_KIN); unsigned* MASK = (unsigned*)(aux + nt_ * AUX_MASK);
    const int nb = F.ntok / SEQ, nitems = nb * 128; const int bxj = (int)blockIdx.x >> 3;
    const int G = F.G - F.G / 4, c = (bxj - (bxj >> 2) - 1) * 8 + ((int)blockIdx.x & 7);
#define P3_ITEM(k) ((k) * G + (((k) & 1) ? (G - 1 - c) : c))
#define P3_QDMA(it_, buf_) do { const int qg_ = 127 - (it_) / nb, b_ = (it_) % nb; _Pragma("unroll") for (int i_ = 0; i_ < 2; ++i_) { const int row_ = w * 2 + i_; \
        const char* src_ = (const char*)(QI + ((size_t)b_ * SEQ + qg_ * 16 + row_) * 512) + ((lane ^ (row_ & 15)) * 16); \
        __builtin_amdgcn_global_load_lds((const unsigned*)src_, (LAS unsigned*)(qbuf + (buf_) * 16384 + row_ * 1024), 16, 0, 0); } } while (0)
    const int nround = (nitems + G - 1) / G;
    if (P3_ITEM(0) < nitems) P3_QDMA(P3_ITEM(0), 0);
    v4u wvn = (v4u){0u, 0u, 0u, 0u};
    if (P3_ITEM(0) < nitems) { const int it0 = P3_ITEM(0); wvn = *(const v4u*)(KW + ((size_t)(it0 % nb) * SEQ + (127 - it0 / nb) * 16 + q) * 128 + 64); }
    for (int k = 0; k < nround; ++k) {
        const int it = P3_ITEM(k); if (it >= nitems) break;
        const int qg = 127 - it / nb, b = it % nb, q0 = qg * 16, qme = q0 + q;
        unsigned* Mb = MASK + (size_t)b * 64 * 2048;
        const int kb_hi = ((qg >> 3) + 1) << 2, nkb = (qg >> 1) + 1;
        asm volatile("s_waitcnt vmcnt(0) lgkmcnt(0)\n\ts_barrier" ::: "memory");
        const v4u wv = wvn;
        { const int itn = P3_ITEM(k + 1); if (k + 1 < nround && itn < nitems) { P3_QDMA(itn, (k + 1) & 1); wvn = *(const v4u*)(KW + ((size_t)(itn % nb) * SEQ + (127 - itn / nb) * 16 + q) * 128 + 64); } }
        if (qg < 16) {
            if (tid < kb_hi * 16) { const int kb = tid >> 4, qq = q0 + (tid & 15), nbits = qq - kb * 32 + 1; Mb[kb * 2048 + qq] = nbits >= 32 ? 0xffffffffu : (nbits <= 0 ? 0u : ((1u << nbits) - 1u)); }
            continue;
        }
        float wq[8];
        { const float cc = 0.35355339059327373f * 0.125f;
          wq[0] = pg8::bf_lo(wv.x) * cc; wq[1] = pg8::bf_hi(wv.x) * cc; wq[2] = pg8::bf_lo(wv.y) * cc; wq[3] = pg8::bf_hi(wv.y) * cc; wq[4] = pg8::bf_lo(wv.z) * cc; wq[5] = pg8::bf_hi(wv.z) * cc; wq[6] = pg8::bf_lo(wv.w) * cc; wq[7] = pg8::bf_hi(wv.w) * cc; }
        bf16x8_t qfr[8][2], qlin[2];
        { const LAS unsigned char* qrow = qbuf + (k & 1) * 16384 + q * 1024;
#pragma unroll
          for (int h = 0; h < 8; ++h)
#pragma unroll
            for (int ks = 0; ks < 2; ++ks) qfr[h][ks] = *(const LAS bf16x8_t*)(qrow + (((h * 8 + ks * 4 + g) ^ q) * 16)); }
#pragma unroll
        for (int ks = 0; ks < 2; ++ks) { float f[8];
#pragma unroll
            for (int j = 0; j < 8; ++j) { float s = 0.f;
#pragma unroll
                for (int h = 0; h < 8; ++h) s += wq[h] * __uint_as_float((unsigned)(unsigned short)qfr[h][ks][j] << 16);
                f[j] = s; }
            v4u o; o.x = pk2(f[0], f[1]); o.y = pk2(f[2], f[3]); o.z = pk2(f[4], f[5]); o.w = pk2(f[6], f[7]); qlin[ks] = __builtin_bit_cast(bf16x8_t, o); }
#pragma unroll
        for (int i = 0; i < 8; ++i) hist[i * 512 + tid] = 0u;
        const bf16* kbase = KIN + ((size_t)b * SEQ + q) * 64 + g * 8;
        bf16x8_t afr[2][2], afn[2][2];
#pragma unroll
        for (int t = 0; t < 2; ++t)
#pragma unroll
            for (int ks = 0; ks < 2; ++ks) afn[t][ks] = *(const bf16x8_t*)(kbase + (size_t)(w * 32 + t * 16) * 64 + ks * 32);
        for (int s = 0, kb = w; kb < nkb; ++s, kb += 8) {
            const bool diag = (kb == nkb - 1);
#pragma unroll
            for (int t = 0; t < 2; ++t)
#pragma unroll
                for (int ks = 0; ks < 2; ++ks) afr[t][ks] = afn[t][ks];
            if (kb + 8 < nkb) {
#pragma unroll
                for (int t = 0; t < 2; ++t)
#pragma unroll
                    for (int ks = 0; ks < 2; ++ks) afn[t][ks] = *(const bf16x8_t*)(kbase + (size_t)((kb + 8) * 32 + t * 16) * 64 + ks * 32); }
#pragma unroll
            for (int t = 0; t < 2; ++t) {
                f32x4_t sacc = f32x4_t{};
#pragma unroll
                for (int ks = 0; ks < 2; ++ks) sacc = __builtin_amdgcn_mfma_f32_16x16x32_bf16(afr[t][ks], qlin[ks], sacc, 0, 0, 0);
#pragma unroll
                for (int h = 0; h < 8; ++h) { f32x4_t d = f32x4_t{};
#pragma unroll
                    for (int ks = 0; ks < 2; ++ks) d = __builtin_amdgcn_mfma_f32_16x16x32_bf16(afr[t][ks], qfr[h][ks], d, 0, 0, 0);
#pragma unroll
                    for (int r = 0; r < 4; ++r) sacc[r] = fmaf(fabsf(d[r]), wq[h], sacc[r]); }
#pragma unroll
                for (int i = 0; i < 2; ++i) { unsigned k2[2];
#pragma unroll
                    for (int e = 0; e < 2; ++e) { const int r = 2 * i + e; unsigned kk_ = key15_of(sacc[r]); if (diag && kb * 32 + t * 16 + 4 * g + r > qme) kk_ = 0u; k2[e] = kk_;
                        const unsigned dg = kk_ >> 10; (void)__hip_atomic_fetch_add((LAS unsigned*)&hist[(dg >> 2) * 512 + tid], 1u << ((dg & 3u) * 8u), __ATOMIC_RELAXED, __HIP_MEMORY_SCOPE_WORKGROUP); }
                    keys[(s * 4 + t * 2 + i) * 512 + tid] = k2[0] | (k2[1] << 16); }
            }
        }
        int need = 256, bsel;
        p3_merge(hist, tot, w, g, q, need, bsel);
        unsigned prefix = (unsigned)bsel;
#pragma unroll
        for (int pass = 0; pass < 2; ++pass) {
            const int sh_hi = pass == 0 ? 10 : 5, sh = pass == 0 ? 5 : 0;
#pragma unroll
            for (int i = 0; i < 8; ++i) hist[i * 512 + tid] = 0u;
#pragma unroll
            for (int s = 0; s < 8; ++s) if (w + 8 * s < nkb) {
#pragma unroll
                for (int i = 0; i < 4; ++i) { const unsigned d2 = keys[(s * 4 + i) * 512 + tid];
#pragma unroll
                    for (int e = 0; e < 2; ++e) { const unsigned kk_ = e ? (d2 >> 16) : (d2 & 0xffffu);
                        if ((kk_ >> sh_hi) == prefix) { const unsigned dg = (kk_ >> sh) & 31u; (void)__hip_atomic_fetch_add((LAS unsigned*)&hist[(dg >> 2) * 512 + tid], 1u << ((dg & 3u) * 8u), __ATOMIC_RELAXED, __HIP_MEMORY_SCOPE_WORKGROUP); } } } }
            p3_merge(hist, tot, w, g, q, need, bsel);
            prefix = (prefix << 5) | (unsigned)bsel;
        }
        const unsigned tau = prefix; const int need_eq = need;
        unsigned gtw[8], eqw[8];
#pragma unroll
        for (int s = 0; s < 8; ++s) { const int kb = w + 8 * s; gtw[s] = 0u; eqw[s] = 0u;
            if (kb < nkb) { unsigned gg = 0u, qq = 0u;
#pragma unroll
                for (int i = 0; i < 4; ++i) { const unsigned d2 = keys[(s * 4 + i) * 512 + tid];
#pragma unroll
                    for (int e = 0; e < 2; ++e) { const unsigned kk_ = e ? (d2 >> 16) : (d2 & 0xffffu); const int bit = (i >> 1) * 16 + 4 * g + (i & 1) * 2 + e;
                        gg |= (kk_ > tau ? 1u : 0u) << bit; qq |= (kk_ == tau ? 1u : 0u) << bit; } }
                gg |= (unsigned)__shfl_xor((int)gg, 16); gg |= (unsigned)__shfl_xor((int)gg, 32); qq |= (unsigned)__shfl_xor((int)qq, 16); qq |= (unsigned)__shfl_xor((int)qq, 32);
                gtw[s] = gg; eqw[s] = qq;
                if (g == 0) Tt[q * 64 + kb] = (unsigned char)__builtin_popcount(qq); } }
        __syncthreads();
        { unsigned run = 0u;
#pragma unroll
          for (int s = 0; s < 8; ++s) { const int kb = w + 8 * s;
            if (kb < nkb) { const unsigned g0 = *(const LAS unsigned*)(Tt + q * 64 + 8 * s), g1 = *(const LAS unsigned*)(Tt + q * 64 + 8 * s + 4);
                const unsigned m0 = w >= 4 ? g0 : (w == 0 ? 0u : (g0 & ((1u << (8 * w)) - 1u))), m1 = w > 4 ? (g1 & ((1u << (8 * (w - 4))) - 1u)) : 0u;
                const int pre = (int)(run + sad4(m0) + sad4(m1)), m = need_eq - pre, pc = __builtin_popcount(eqw[s]);
                unsigned se = eqw[s];
                if (m < pc) { se = 0u; unsigned x = eqw[s]; for (int i = 0; i < m; ++i) { const unsigned bb = x & (0u - x); se |= bb; x ^= bb; } }
                if (g == 0) Mb[kb * 2048 + qme] = gtw[s] | se;
                run += sad4(g0) + sad4(g1); } } }
        if (tid < (kb_hi - nkb) * 16) Mb[(nkb + (tid >> 4)) * 2048 + q0 + (tid & 15)] = 0u;
    }
    asm volatile("s_waitcnt vmcnt(0) lgkmcnt(0)" ::: "memory");
    __syncthreads();
#undef P3_ITEM
#undef P3_QDMA
}

namespace att {
using bf16x8 = __attribute__((ext_vector_type(8))) short;
using s16x4  = __attribute__((ext_vector_type(4))) short;
using u32x4  = __attribute__((ext_vector_type(4))) unsigned;
constexpr int KVBLK = 64;
constexpr size_t SHM_V = KVBLK * 128 * 2, SHM_K = KVBLK * 128 * 2;
constexpr int OFF_WS = 65536, OFF_MK = 65536 + 2048, OFF_Q = 65536 + 2048 + 8192, QPITCH = 272;
constexpr float THR2 = 11.5f;
#define KSWZ(row, colB) ((row) * 256 + ((colB) ^ (((row) & 7) << 4)))
#define SBAR() __builtin_amdgcn_sched_barrier(0)
__device__ __forceinline__ unsigned cvtpk(float lo, float hi) { unsigned r; asm volatile("v_cvt_pk_bf16_f32 %0, %1, %2" : "=v"(r) : "v"(lo), "v"(hi)); return r; }
__device__ __forceinline__ float msk(float p, unsigned w, int bit) { const int m = __builtin_amdgcn_sbfe((int)w, bit, 1); return __uint_as_float((__float_as_uint(p) & (unsigned)m) | (0xff800000u & ~(unsigned)m)); }
__device__ __forceinline__ void partialSM(f32x16& p0, f32x16& p1, unsigned w0, unsigned w1, float& m_reg, float& mn, float& alpha) {
#pragma unroll
  for (int r = 0; r < 16; ++r) { const int bit = (r & 3) + 8 * (r >> 2); p0[r] = msk(p0[r], w0, bit); p1[r] = msk(p1[r], w1, bit); }
  float pmax = p0[0];
#pragma unroll
  for (int r = 1; r < 16; ++r) pmax = fmaxf(pmax, p0[r]);
#pragma unroll
  for (int r = 0; r < 16; ++r) pmax = fmaxf(pmax, p1[r]);
  { auto rr = __builtin_amdgcn_permlane32_swap(__float_as_uint(pmax), __float_as_uint(pmax), false, false); pmax = fmaxf(__uint_as_float(rr[0]), __uint_as_float(rr[1])); }
  if (__builtin_expect(__all(pmax - m_reg <= THR2), 1)) { mn = m_reg; alpha = 1.f; }
  else { mn = fmaxf(m_reg, pmax); alpha = __builtin_amdgcn_exp2f(m_reg - mn); m_reg = mn; }
#pragma unroll
  for (int r = 0; r < 16; ++r) { p0[r] -= mn; p1[r] -= mn; }
#pragma unroll
  for (int r = 0; r < 16; ++r) p0[r] = __builtin_amdgcn_exp2f(p0[r]);
}
__device__ __forceinline__ void finishSM(f32x16& p0, f32x16& p1, float alpha, float& l_reg, bf16x8& pa0, bf16x8& pa1, bf16x8& pa2, bf16x8& pa3) {
#pragma unroll
  for (int r = 0; r < 16; ++r) p1[r] = __builtin_amdgcn_exp2f(p1[r]);
  float ps = 0;
#pragma unroll
  for (int r = 0; r < 16; ++r) ps += p0[r];
#pragma unroll
  for (int r = 0; r < 16; ++r) ps += p1[r];
  { auto rr = __builtin_amdgcn_permlane32_swap(__float_as_uint(ps), __float_as_uint(ps), false, false); ps = __uint_as_float(rr[0]) + __uint_as_float(rr[1]); }
  l_reg = l_reg * alpha + ps;
#define PK4(P, BASE, OUT) do { unsigned a0 = cvtpk(P[BASE + 0], P[BASE + 1]), a1 = cvtpk(P[BASE + 2], P[BASE + 3]);   \
    unsigned b0 = cvtpk(P[BASE + 4], P[BASE + 5]), b1 = cvtpk(P[BASE + 6], P[BASE + 7]);                              \
    auto r0 = __builtin_amdgcn_permlane32_swap(a0, b0, false, false); auto r1 = __builtin_amdgcn_permlane32_swap(a1, b1, false, false); \
    u32x4 w = {r0[0], r1[0], r0[1], r1[1]}; OUT = *reinterpret_cast<bf16x8*>(&w); } while (0)
  PK4(p0, 0, pa0); PK4(p0, 8, pa1); PK4(p1, 0, pa2); PK4(p1, 8, pa3);
#undef PK4
}
__device__ __forceinline__ void qkt(f32x16& p0, f32x16& p1, const char* Ks, const char* qrow, const float (&bo)[16], float kb0, float kb1, int r32, int hi) {
#pragma unroll
  for (int r = 0; r < 16; ++r) { p0[r] = bo[r] + kb0; p1[r] = bo[r] + kb1; }
#pragma unroll
  for (int d0 = 0; d0 < 8; ++d0) { const int cb = (d0 * 16 + hi * 8) * 2;
    const bf16x8 b0 = *reinterpret_cast<const bf16x8*>(Ks + KSWZ(r32, cb));
    const bf16x8 b1 = *reinterpret_cast<const bf16x8*>(Ks + KSWZ(32 + r32, cb));
    const bf16x8 qf = *reinterpret_cast<const bf16x8*>(qrow + d0 * 32);
    p0 = __builtin_amdgcn_mfma_f32_32x32x16_bf16(b0, qf, p0, 0, 0, 0);
    p1 = __builtin_amdgcn_mfma_f32_32x32x16_bf16(b1, qf, p1, 0, 0, 0); }
}
__device__ __forceinline__ int v_st(int k, int c) { const int kk = (k & ~0xC) | ((k & 4) << 1) | ((k & 8) >> 1); return ((kk >> 3) * 4 + (c >> 5)) * 512 + ((kk & 7) * 32 + (c & 31)) * 2; }
__device__ __forceinline__ int v_rd_base(int lane) { return ((lane & 3) << 3) | (((lane >> 2) & 3) << 6) | (((lane >> 4) & 1) << 5) | (((lane >> 5) & 1) << 8); }
constexpr int v_rd_off(int d0, int ks, int half) { return d0 * 512 + ks * 4096 + half * 2048; }
template <int OFF> __device__ __forceinline__ s16x4 tr_read(int vb) { s16x4 r; asm volatile("ds_read_b64_tr_b16 %0, %1 offset:%2" : "=&v"(r) : "v"(vb), "i"(OFF) : "memory"); return r; }
template <int D0> __device__ __forceinline__ void pv_one(f32x16& od, int vb, bf16x8 pa0, bf16x8 pa1, bf16x8 pa2, bf16x8 pa3) {
  const s16x4 l0 = tr_read<v_rd_off(D0, 0, 0)>(vb), h0 = tr_read<v_rd_off(D0, 0, 1)>(vb), l1 = tr_read<v_rd_off(D0, 1, 0)>(vb), h1 = tr_read<v_rd_off(D0, 1, 1)>(vb);
  const s16x4 l2 = tr_read<v_rd_off(D0, 2, 0)>(vb), h2 = tr_read<v_rd_off(D0, 2, 1)>(vb), l3 = tr_read<v_rd_off(D0, 3, 0)>(vb), h3 = tr_read<v_rd_off(D0, 3, 1)>(vb);
  asm volatile("s_waitcnt lgkmcnt(0)" ::: "memory"); SBAR();
#define PK(L, H) (bf16x8){L[0], L[1], L[2], L[3], H[0], H[1], H[2], H[3]}
  od = __builtin_amdgcn_mfma_f32_32x32x16_bf16(pa0, PK(l0, h0), od, 0, 0, 0);
  od = __builtin_amdgcn_mfma_f32_32x32x16_bf16(pa1, PK(l1, h1), od, 0, 0, 0);
  od = __builtin_amdgcn_mfma_f32_32x32x16_bf16(pa2, PK(l2, h2), od, 0, 0, 0);
  od = __builtin_amdgcn_mfma_f32_32x32x16_bf16(pa3, PK(l3, h3), od, 0, 0, 0);
#undef PK
}
__device__ __forceinline__ void pv_d0(f32x16* o, int vb, bf16x8 pa0, bf16x8 pa1, bf16x8 pa2, bf16x8 pa3) {
  pv_one<0>(o[0], vb, pa0, pa1, pa2, pa3); pv_one<1>(o[1], vb, pa0, pa1, pa2, pa3); pv_one<2>(o[2], vb, pa0, pa1, pa2, pa3); pv_one<3>(o[3], vb, pa0, pa1, pa2, pa3);
}
__device__ __forceinline__ void attn_item(const bf16* __restrict__ Qb, const bf16* __restrict__ Kh, const bf16* __restrict__ Vh, const unsigned* __restrict__ Mq, bf16* __restrict__ Ob, int NT, char* lds, LAS unsigned char* ldsL) {
  const int tid = threadIdx.x, wid = __builtin_amdgcn_readfirstlane(tid >> 6), lane = tid & 63, r32 = lane & 31, hi = lane >> 5;
  float* ws = (float*)(lds + OFF_WS) + wid * 64; float* li_l = ws; float* al_l = ws + 32;
  unsigned* mk = (unsigned*)(lds + OFF_MK);
  unsigned soff[4];
#pragma unroll
  for (int i = 0; i < 4; ++i) { const int pc = (wid & 3) * 4 + i;
    if (wid < 4) { const int row = pc * 4 + (lane >> 4), cb = (lane & 15) * 16; soff[i] = (unsigned)(row * 256 + (cb ^ ((row & 7) << 4))); }
    else { const int L = pc * 1024 + lane * 16, st = L >> 9, wi = L & 511, kk = (st >> 2) * 8 + (wi >> 6), c = (st & 3) * 32 + ((wi & 63) >> 1), k = (kk & ~0xC) | ((kk & 4) << 1) | ((kk & 8) >> 1);
           soff[i] = (unsigned)(k * 256 + c * 2); } }
  const char* gsrc = (const char*)(wid < 4 ? Kh : Vh);
  const unsigned ldst = (unsigned)((wid < 4 ? 0 : 16384) + (wid & 3) * 4096);
#define DMA_TILE(t, slot) do { _Pragma("unroll") for (int i_ = 0; i_ < 4; ++i_) \
    __builtin_amdgcn_global_load_lds((const unsigned*)(gsrc + (size_t)(t) * (64 * 256) + soff[i_]), (LAS unsigned*)(ldsL + (slot) * 32768 + ldst + i_ * 1024), 16, 0, 0); } while (0)
  DMA_TILE(0, 0);
  float m_reg = 0.f, l_reg = 0; f32x16 o[4] = {}; bf16x8 qr[8];
  { const unsigned char* Qw = (const unsigned char*)Qb + (size_t)r32 * 1024 + wid * 128 + hi * 8; float ss = 0.f; unsigned long long q8[8];
#pragma unroll
    for (int d0 = 0; d0 < 8; ++d0) q8[d0] = *reinterpret_cast<const unsigned long long*>(Qw + d0 * 16);
    unsigned mv[4];
#pragma unroll
    for (int i = 0; i < 4; ++i) { const int idx = tid + 512 * i; mv[i] = idx < NT * 64 ? Mq[(size_t)(idx >> 5) * 2048 + (idx & 31)] : 0u; }
#pragma unroll
    for (int i = 0; i < 4; ++i) { const int idx = tid + 512 * i; if (idx < NT * 64) mk[idx] = mv[i]; }
    float qf[8][8];
#pragma unroll
    for (int d0 = 0; d0 < 8; ++d0) { const int lo = (int)(unsigned)q8[d0], hi32 = (int)(unsigned)(q8[d0] >> 32);
      const auto a_ = __builtin_amdgcn_cvt_pk_f32_fp8(lo, false), b_ = __builtin_amdgcn_cvt_pk_f32_fp8(lo, true), c_ = __builtin_amdgcn_cvt_pk_f32_fp8(hi32, false), d_ = __builtin_amdgcn_cvt_pk_f32_fp8(hi32, true);
      qf[d0][0] = a_[0]; qf[d0][1] = a_[1]; qf[d0][2] = b_[0]; qf[d0][3] = b_[1]; qf[d0][4] = c_[0]; qf[d0][5] = c_[1]; qf[d0][6] = d_[0]; qf[d0][7] = d_[1];
#pragma unroll
      for (int j = 0; j < 8; ++j) ss += qf[d0][j] * qf[d0][j]; }
    ss = xhalf_sum(ss); const float rq = rsqrtf(ss * (1.f / 128.f) + EPS);
#pragma unroll
    for (int d0 = 0; d0 < 8; ++d0) { u32x4 w = {cvtpk(qf[d0][0] * rq, qf[d0][1] * rq), cvtpk(qf[d0][2] * rq, qf[d0][3] * rq), cvtpk(qf[d0][4] * rq, qf[d0][5] * rq), cvtpk(qf[d0][6] * rq, qf[d0][7] * rq)}; qr[d0] = *reinterpret_cast<bf16x8*>(&w); } }
  const float slope2 = __builtin_amdgcn_exp2f(-(float)(wid + 1)) * 1.4426950408889634f;
  float bo[16];
#pragma unroll
  for (int r = 0; r < 16; ++r) bo[r] = __uint_as_float(__builtin_amdgcn_readfirstlane(__float_as_uint(slope2 * (float)((r & 3) + 8 * (r >> 2)))));
  const float hoff = slope2 * (float)(4 * hi);
  const int vb0 = (int)(uintptr_t)(lds + 16384) + v_rd_base(lane);
  asm volatile("s_waitcnt vmcnt(0) lgkmcnt(0)\n\ts_barrier" ::: "memory");
  for (int j = 0; j < NT; ++j) {
    const int sl = j & 1;
    if (j + 1 < NT) DMA_TILE(j + 1, sl ^ 1);
    const char* Ks = lds + sl * 32768;
    const unsigned w0 = mk[(2 * j) * 32 + r32] >> (4 * hi), w1 = mk[(2 * j + 1) * 32 + r32] >> (4 * hi);
    f32x16 p0, p1;
    { const float kb0 = slope2 * (float)(j * 64) + hoff - m_reg, kb1 = kb0 + slope2 * 32.f;
#pragma unroll
      for (int r = 0; r < 16; ++r) { p0[r] = bo[r] + kb0; p1[r] = bo[r] + kb1; }
      bf16x8 ka = *reinterpret_cast<const bf16x8*>(Ks + KSWZ(r32, hi * 16)), kb = *reinterpret_cast<const bf16x8*>(Ks + KSWZ(32 + r32, hi * 16));
#pragma unroll
      for (int d0 = 0; d0 < 8; ++d0) { bf16x8 na = ka, nb = kb;
        if (d0 < 7) { const int cb = ((d0 + 1) * 16 + hi * 8) * 2; na = *reinterpret_cast<const bf16x8*>(Ks + KSWZ(r32, cb)); nb = *reinterpret_cast<const bf16x8*>(Ks + KSWZ(32 + r32, cb)); }
        SBAR();
        p0 = __builtin_amdgcn_mfma_f32_32x32x16_bf16(ka, qr[d0], p0, 0, 0, 0);
        p1 = __builtin_amdgcn_mfma_f32_32x32x16_bf16(kb, qr[d0], p1, 0, 0, 0);
        SBAR();
        ka = na; kb = nb; } }
    float alpha; bf16x8 pa0, pa1, pa2, pa3;
    {
#pragma unroll
      for (int r = 0; r < 16; ++r) { const int bit = (r & 3) + 8 * (r >> 2); p0[r] = msk(p0[r], w0, bit); p1[r] = msk(p1[r], w1, bit); }
      float pmax = fmaxf(p0[0], p1[0]);
#pragma unroll
      for (int r = 1; r < 16; ++r) pmax = fmaxf(fmaxf(pmax, p0[r]), p1[r]);
      { auto rr = __builtin_amdgcn_permlane32_swap(__float_as_uint(pmax), __float_as_uint(pmax), false, false); pmax = fmaxf(__uint_as_float(rr[0]), __uint_as_float(rr[1])); }
      alpha = 1.f;
      if (__builtin_expect(!__all(pmax <= THR2), 0)) {
        const float dl = fmaxf(pmax, 0.f); m_reg += dl; alpha = __builtin_amdgcn_exp2f(-dl);
#pragma unroll
        for (int r = 0; r < 16; ++r) { p0[r] -= dl; p1[r] -= dl; } }
      float ps = 0.f;
#pragma unroll
      for (int r = 0; r < 16; ++r) { p0[r] = __builtin_amdgcn_exp2f(p0[r]); p1[r] = __builtin_amdgcn_exp2f(p1[r]); ps += p0[r] + p1[r]; }
      { auto rr = __builtin_amdgcn_permlane32_swap(__float_as_uint(ps), __float_as_uint(ps), false, false); ps = __uint_as_float(rr[0]) + __uint_as_float(rr[1]); }
      l_reg = l_reg * alpha + ps;
#define PK4(P, BASE, OUT) do { unsigned a0 = cvtpk(P[BASE + 0], P[BASE + 1]), a1 = cvtpk(P[BASE + 2], P[BASE + 3]);   \
    unsigned b0 = cvtpk(P[BASE + 4], P[BASE + 5]), b1 = cvtpk(P[BASE + 6], P[BASE + 7]);                              \
    auto r0 = __builtin_amdgcn_permlane32_swap(a0, b0, false, false); auto r1 = __builtin_amdgcn_permlane32_swap(a1, b1, false, false); \
    u32x4 w = {r0[0], r1[0], r0[1], r1[1]}; OUT = *reinterpret_cast<bf16x8*>(&w); } while (0)
      PK4(p0, 0, pa0); PK4(p0, 8, pa1); PK4(p1, 0, pa2); PK4(p1, 8, pa3);
#undef PK4
      if (__any(alpha < 1.f)) { if (hi == 0) al_l[r32] = alpha; asm volatile("s_waitcnt lgkmcnt(0)" ::: "memory");
#pragma unroll
        for (int d = 0; d < 4; ++d)
#pragma unroll
          for (int r = 0; r < 16; ++r) o[d][r] *= al_l[crow(r, hi)]; }
    }
    { const int vb = vb0 + sl * 32768;
      s16x4 lA[4], hA[4], lB[4], hB[4];
#define VREADS(L_, H_, D0) do { L_[0] = tr_read<v_rd_off(D0, 0, 0)>(vb); H_[0] = tr_read<v_rd_off(D0, 0, 1)>(vb); L_[1] = tr_read<v_rd_off(D0, 1, 0)>(vb); H_[1] = tr_read<v_rd_off(D0, 1, 1)>(vb); \
      L_[2] = tr_read<v_rd_off(D0, 2, 0)>(vb); H_[2] = tr_read<v_rd_off(D0, 2, 1)>(vb); L_[3] = tr_read<v_rd_off(D0, 3, 0)>(vb); H_[3] = tr_read<v_rd_off(D0, 3, 1)>(vb); } while (0)
#define PK(L, H) (bf16x8){L[0], L[1], L[2], L[3], H[0], H[1], H[2], H[3]}
#define VMMA(OD, L_, H_) do { OD = __builtin_amdgcn_mfma_f32_32x32x16_bf16(pa0, PK(L_[0], H_[0]), OD, 0, 0, 0); OD = __builtin_amdgcn_mfma_f32_32x32x16_bf16(pa1, PK(L_[1], H_[1]), OD, 0, 0, 0); \
      OD = __builtin_amdgcn_mfma_f32_32x32x16_bf16(pa2, PK(L_[2], H_[2]), OD, 0, 0, 0); OD = __builtin_amdgcn_mfma_f32_32x32x16_bf16(pa3, PK(L_[3], H_[3]), OD, 0, 0, 0); } while (0)
#define VWAIT(N, L_, H_) do { asm volatile("s_waitcnt lgkmcnt(" #N ")" : "+v"(L_[0]), "+v"(L_[1]), "+v"(L_[2]), "+v"(L_[3]), "+v"(H_[0]), "+v"(H_[1]), "+v"(H_[2]), "+v"(H_[3]) :: "memory"); SBAR(); } while (0)
      VREADS(lA, hA, 0); VREADS(lB, hB, 1);
      VWAIT(8, lA, hA); VMMA(o[0], lA, hA);
      VREADS(lA, hA, 2);
      VWAIT(8, lB, hB); VMMA(o[1], lB, hB);
      VREADS(lB, hB, 3);
      VWAIT(8, lA, hA); VMMA(o[2], lA, hA);
      VWAIT(0, lB, hB); VMMA(o[3], lB, hB);
#undef VREADS
#undef PK
#undef VMMA
#undef VWAIT
    }
    asm volatile("s_waitcnt vmcnt(0) lgkmcnt(0)\n\ts_barrier" ::: "memory");
  }
  if (hi == 0) li_l[r32] = l_reg; asm volatile("s_waitcnt lgkmcnt(0)" ::: "memory");
  float rli[16];
#pragma unroll
  for (int r = 0; r < 16; ++r) rli[r] = __builtin_amdgcn_rcpf(li_l[crow(r, hi)]);
  unsigned char* stg = (unsigned char*)(lds + wid * 4096);
#pragma unroll
  for (int r = 0; r < 16; ++r) { const int orow = crow(r, hi); const float sc16 = rli[r] * 16.f;
#pragma unroll
    for (int d0 = 0; d0 < 4; ++d0) stg[orow * 128 + d0 * 32 + r32] = (unsigned char)__builtin_amdgcn_cvt_pk_fp8_f32(o[d0][r] * sc16, 0.f, 0, false); }
  asm volatile("s_waitcnt lgkmcnt(0)" ::: "memory");
#pragma unroll
  for (int i = 0; i < 4; ++i) { const int row = i * 8 + (lane >> 3), ch = lane & 7; const u32x4 v = *(const u32x4*)(stg + row * 128 + ch * 16);
    *(u32x4*)((unsigned char*)Ob + (size_t)row * 1024 + wid * 128 + ch * 16) = v; }
#undef DMA_TILE
}
#undef KSWZ
#undef SBAR
}


namespace ret {
using bf16x8 = __attribute__((ext_vector_type(8))) short;
using s16x4  = __attribute__((ext_vector_type(4))) short;
using u32x4  = __attribute__((ext_vector_type(4))) unsigned;
using u32x2  = __attribute__((ext_vector_type(2))) unsigned;
constexpr int C = 64, QP = 272, KPI = 272, VP = 576;
constexpr int OFF_Q = 0, OFF_K = 17408, OFF_V = 34816, OFF_ST = 71680, OFF_Y = 75776;
typedef float f32x2_t __attribute__((ext_vector_type(2))); typedef __bf16 bf16x2_t __attribute__((ext_vector_type(2)));
__device__ __forceinline__ unsigned cvtpk(float lo, float hi) { const f32x2_t v = {lo, hi}; const bf16x2_t b = __builtin_convertvector(v, bf16x2_t); return __builtin_bit_cast(unsigned, b); }
template <int OFF> __device__ __forceinline__ s16x4 trr(int base) { s16x4 r; asm volatile("ds_read_b64_tr_b16 %0, %1 offset:%2" : "=&v"(r) : "v"(base), "i"(OFF) : "memory"); return r; }
__device__ __forceinline__ bf16x8 pk8(const f32x16& x, int s) { u32x4 w = {cvtpk(x[8 * s + 0], x[8 * s + 1]), cvtpk(x[8 * s + 2], x[8 * s + 3]), cvtpk(x[8 * s + 4], x[8 * s + 5]), cvtpk(x[8 * s + 6], x[8 * s + 7])}; return *reinterpret_cast<bf16x8*>(&w); }
__device__ __forceinline__ float silu_(float x) { return x * __builtin_amdgcn_rcpf(1.f + __builtin_amdgcn_exp2f(-1.4426950408889634f * x)); }
__device__ __forceinline__ void ret_item(int b, int h, const unsigned char* __restrict__ RQ, const unsigned char* __restrict__ RK, const unsigned char* __restrict__ RV, const unsigned char* __restrict__ RG, unsigned char* A2F8, const float* __restrict__ gnorm, char* lds, int c0, int c1, float* state) {
  const int tid = threadIdx.x, w = __builtin_amdgcn_readfirstlane(tid >> 6), lane = tid & 63, r32 = lane & 31, hi = lane >> 5;
  const float lg = __log2f(1.f - exp2f(-5.f - (float)h)), gC = exp2f(64.f * lg);
  char* Qs = lds + OFF_Q; char* Ks = lds + OFF_K; char* Vs = lds + OFF_V; float* st = (float*)(lds + OFF_ST); char* Ys = lds + OFF_Y;
  f32x16 S[4] = {};
  if (c0 > 0) {
#pragma unroll
    for (int dt = 0; dt < 4; ++dt)
#pragma unroll
      for (int r = 0; r < 16; ++r) S[dt][r] = state[(dt * 16 + r) * 512 + tid]; }
  const unsigned voffQ = (unsigned)(((tid >> 4) * 512 + (tid & 15) * 8) * 2), voffV = (unsigned)(((tid >> 5) * 1024 + (tid & 31) * 8) * 2);
  const int trq = (lane & 15) >> 2, trp = lane & 3, trg = (lane >> 4) & 1;
  const int vtb = (int)(uintptr_t)(lds + OFF_V) + (4 * hi + trq) * VP + (32 * w + 16 * trg + 4 * trp) * 2, ktb = (int)(uintptr_t)(lds + OFF_K) + (4 * hi + trq) * KPI + (16 * trg + 4 * trp) * 2;
  u32x2 pq[2], pk[2], pv[4];
  const unsigned voffQ8 = (unsigned)((tid >> 4) * 512 + (tid & 15) * 8), voffV8 = voffV >> 1;
#define RET_LOAD(cc) do { const size_t t0_ = (size_t)b * SEQ + (size_t)(cc) * C; const unsigned char* qb_ = RQ + t0_ * 512 + h * 128; const unsigned char* kb_ = RK + t0_ * 512 + h * 128; const unsigned char* vb_ = RV + t0_ * 1024 + h * 256; \
    _Pragma("unroll") for (int i = 0; i < 2; ++i) { pq[i] = *(const u32x2*)(qb_ + voffQ8 + i * 16384); pk[i] = *(const u32x2*)(kb_ + voffQ8 + i * 16384); } \
    _Pragma("unroll") for (int i = 0; i < 4; ++i) pv[i] = *(const u32x2*)(vb_ + voffV8 + i * 16384); } while (0)
#define RET_F8(src_, f_, out_) do { const auto a_ = __builtin_amdgcn_cvt_pk_f32_fp8((int)(src_).x, false), b_ = __builtin_amdgcn_cvt_pk_f32_fp8((int)(src_).x, true), c_ = __builtin_amdgcn_cvt_pk_f32_fp8((int)(src_).y, false), d_ = __builtin_amdgcn_cvt_pk_f32_fp8((int)(src_).y, true); \
    out_.x = cvtpk(a_[0] * (f_), a_[1] * (f_)); out_.y = cvtpk(b_[0] * (f_), b_[1] * (f_)); out_.z = cvtpk(c_[0] * (f_), c_[1] * (f_)); out_.w = cvtpk(d_[0] * (f_), d_[1] * (f_)); } while (0)
#define RET_STAGE() do { \
    _Pragma("unroll") for (int i = 0; i < 2; ++i) { const int row = (tid >> 4) + 32 * i, ch = tid & 15; \
      u32x4 qo; RET_F8(pq[i], 1.f, qo); *(u32x4*)(Qs + row * QP + ch * 16) = qo; \
      const float f = exp2f(lg * (float)(C - 1 - row)) * 0.08838834764831845f; \
      u32x4 ko; RET_F8(pk[i], f, ko); *(u32x4*)(Ks + row * KPI + ch * 16) = ko; } \
    _Pragma("unroll") for (int i = 0; i < 4; ++i) { const int row = (tid >> 5) + 16 * i, ch = tid & 31; u32x4 vo; RET_F8(pv[i], 1.f, vo); *(u32x4*)(Vs + row * VP + ch * 16) = vo; } } while (0)
  RET_LOAD(c0);
  __syncthreads();
  RET_STAGE();
  if (c0 + 1 < c1) RET_LOAD(c0 + 1);
  __syncthreads();
  for (int c = c0; c < c1; ++c) {
    const size_t tok0 = (size_t)b * SEQ + (size_t)c * C;
    f32x16 ot[2] = {};
#pragma unroll
    for (int dt = 0; dt < 4; ++dt) {
#pragma unroll
      for (int s = 0; s < 2; ++s) { const bf16x8 af = pk8(S[dt], s);
#pragma unroll
        for (int nt = 0; nt < 2; ++nt) { const char* qp = Qs + (32 * nt + r32) * QP + (32 * dt + 16 * s + 4 * hi) * 2;
          const u32x2 lo = *(const u32x2*)qp, hi8 = *(const u32x2*)(qp + 16); const u32x4 bw = {lo.x, lo.y, hi8.x, hi8.y};
          ot[nt] = __builtin_amdgcn_mfma_f32_32x32x16_bf16(af, *reinterpret_cast<const bf16x8*>(&bw), ot[nt], 0, 0, 0); } }
      __builtin_amdgcn_sched_barrier(0); }
#pragma unroll
    for (int nt = 0; nt < 2; ++nt)
#pragma unroll
      for (int r = 0; r < 16; ++r) ot[nt][r] *= gC;
    __builtin_amdgcn_sched_barrier(0);
    bf16x8 vfr[4];
    { s16x4 vlo[4], vhi[4];
      vlo[0] = trr<0 * 16 * VP>(vtb); vhi[0] = trr<0 * 16 * VP + 8 * VP>(vtb); vlo[1] = trr<1 * 16 * VP>(vtb); vhi[1] = trr<1 * 16 * VP + 8 * VP>(vtb);
      vlo[2] = trr<2 * 16 * VP>(vtb); vhi[2] = trr<2 * 16 * VP + 8 * VP>(vtb); vlo[3] = trr<3 * 16 * VP>(vtb); vhi[3] = trr<3 * 16 * VP + 8 * VP>(vtb);
      asm volatile("s_waitcnt lgkmcnt(0)" : "+v"(vlo[0]), "+v"(vlo[1]), "+v"(vlo[2]), "+v"(vlo[3]), "+v"(vhi[0]), "+v"(vhi[1]), "+v"(vhi[2]), "+v"(vhi[3]) :: "memory"); __builtin_amdgcn_sched_barrier(0);
#pragma unroll
      for (int ks = 0; ks < 4; ++ks) vfr[ks] = (bf16x8){vlo[ks][0], vlo[ks][1], vlo[ks][2], vlo[ks][3], vhi[ks][0], vhi[ks][1], vhi[ks][2], vhi[ks][3]}; }
#pragma unroll
    for (int nt = 0; nt < 2; ++nt)
#pragma unroll
      for (int jt = 0; jt <= nt; ++jt) { f32x16 pt = {};
#pragma unroll
        for (int kk = 0; kk < 8; ++kk) { const bf16x8 ka = *(const bf16x8*)(Ks + (32 * jt + r32) * KPI + (16 * kk + 8 * hi) * 2), qb = *(const bf16x8*)(Qs + (32 * nt + r32) * QP + (16 * kk + 8 * hi) * 2);
          pt = __builtin_amdgcn_mfma_f32_32x32x16_bf16(ka, qb, pt, 0, 0, 0); }
        if (jt == nt) {
#pragma unroll
          for (int r = 0; r < 16; ++r) if (crow(r, hi) > r32) pt[r] = 0.f; }
#pragma unroll
        for (int s = 0; s < 2; ++s) ot[nt] = __builtin_amdgcn_mfma_f32_32x32x16_bf16(vfr[2 * jt + s], pk8(pt, s), ot[nt], 0, 0, 0);
        __builtin_amdgcn_sched_barrier(0); }
#pragma unroll
    for (int dt = 0; dt < 4; ++dt) {
#pragma unroll
      for (int r = 0; r < 16; ++r) S[dt][r] *= gC;
      s16x4 kl[4], kh[4];
      kl[0] = trr<0 * 16 * KPI>(ktb + dt * 64); kh[0] = trr<0 * 16 * KPI + 8 * KPI>(ktb + dt * 64); kl[1] = trr<1 * 16 * KPI>(ktb + dt * 64); kh[1] = trr<1 * 16 * KPI + 8 * KPI>(ktb + dt * 64);
      kl[2] = trr<2 * 16 * KPI>(ktb + dt * 64); kh[2] = trr<2 * 16 * KPI + 8 * KPI>(ktb + dt * 64); kl[3] = trr<3 * 16 * KPI>(ktb + dt * 64); kh[3] = trr<3 * 16 * KPI + 8 * KPI>(ktb + dt * 64);
      asm volatile("s_waitcnt lgkmcnt(0)" : "+v"(kl[0]), "+v"(kl[1]), "+v"(kl[2]), "+v"(kl[3]), "+v"(kh[0]), "+v"(kh[1]), "+v"(kh[2]), "+v"(kh[3]) :: "memory"); __builtin_amdgcn_sched_barrier(0);
#pragma unroll
      for (int ks = 0; ks < 4; ++ks) S[dt] = __builtin_amdgcn_mfma_f32_32x32x16_bf16((bf16x8){kl[ks][0], kl[ks][1], kl[ks][2], kl[ks][3], kh[ks][0], kh[ks][1], kh[ks][2], kh[ks][3]}, vfr[ks], S[dt], 0, 0, 0);
      __builtin_amdgcn_sched_barrier(0); }
    u32x2 gt4[4];
    { const unsigned char* gb_ = RG + tok0 * 1024 + h * 256;
#pragma unroll
      for (int i = 0; i < 4; ++i) gt4[i] = *(const u32x2*)(gb_ + (voffV >> 1) + i * 16384); }
#pragma unroll
    for (int nt = 0; nt < 2; ++nt) { const float rs = exp2f(lg * (float)(32 * nt + r32 + 1 - C)); float s1 = 0.f, s2 = 0.f;
#pragma unroll
      for (int r = 0; r < 16; ++r) { ot[nt][r] *= rs; s1 += ot[nt][r]; s2 += ot[nt][r] * ot[nt][r]; }
      s1 = xhalf_sum(s1); s2 = xhalf_sum(s2);
      if (hi == 0) { st[(w * 64 + 32 * nt + r32) * 2] = s1; st[(w * 64 + 32 * nt + r32) * 2 + 1] = s2; } }
    __syncthreads();
    if (c + 1 < c1) { RET_STAGE(); if (c + 2 < c1) RET_LOAD(c + 2); }
#pragma unroll
    for (int nt = 0; nt < 2; ++nt) { float s1 = 0.f, s2 = 0.f;
#pragma unroll
      for (int ww = 0; ww < 8; ++ww) { s1 += st[(ww * 64 + 32 * nt + r32) * 2]; s2 += st[(ww * 64 + 32 * nt + r32) * 2 + 1]; }
      const float mu = s1 * (1.f / 256.f), var = fmaxf(s2 * (1.f / 256.f) - mu * mu, 0.f), rstd = rsqrtf(var + EPS);
#pragma unroll
      for (int g = 0; g < 4; ++g) { float y[4];
#pragma unroll
        for (int j = 0; j < 4; ++j) y[j] = (ot[nt][4 * g + j] - mu) * rstd * gnorm[h * 256 + 32 * w + 8 * g + 4 * hi + j];
        const u32x2 o2 = {cvtpk(y[0], y[1]), cvtpk(y[2], y[3])};
        *(u32x2*)(Ys + (32 * nt + r32) * VP + (32 * w + 8 * g + 4 * hi) * 2) = o2; } }
    __syncthreads();
    { unsigned char* ob_ = A2F8 + tok0 * 1024 + h * 256;
#pragma unroll
      for (int i = 0; i < 4; ++i) { const int row = (tid >> 5) + 16 * i, ch = tid & 31;
        const u32x4 yv = *(const u32x4*)(Ys + row * VP + ch * 16); const u32x2 gt = gt4[i];
        const auto g01 = __builtin_amdgcn_cvt_pk_f32_fp8((int)gt.x, false), g23 = __builtin_amdgcn_cvt_pk_f32_fp8((int)gt.x, true), g45 = __builtin_amdgcn_cvt_pk_f32_fp8((int)gt.y, false), g67 = __builtin_amdgcn_cvt_pk_f32_fp8((int)gt.y, true);
        int w0 = __builtin_amdgcn_cvt_pk_fp8_f32(pg8::bf_lo(yv.x) * silu_(g01[0]), pg8::bf_hi(yv.x) * silu_(g01[1]), 0, false); w0 = __builtin_amdgcn_cvt_pk_fp8_f32(pg8::bf_lo(yv.y) * silu_(g23[0]), pg8::bf_hi(yv.y) * silu_(g23[1]), w0, true);
        int w1 = __builtin_amdgcn_cvt_pk_fp8_f32(pg8::bf_lo(yv.z) * silu_(g45[0]), pg8::bf_hi(yv.z) * silu_(g45[1]), 0, false); w1 = __builtin_amdgcn_cvt_pk_fp8_f32(pg8::bf_lo(yv.w) * silu_(g67[0]), pg8::bf_hi(yv.w) * silu_(g67[1]), w1, true);
        *(unsigned long long*)(ob_ + (size_t)row * 1024 + ch * 8) = (unsigned long long)(unsigned)w0 | ((unsigned long long)(unsigned)w1 << 32); } }
  }
  if (c1 < SEQ / C) {
#pragma unroll
    for (int dt = 0; dt < 4; ++dt)
#pragma unroll
      for (int r = 0; r < 16; ++r) state[(dt * 16 + r) * 512 + tid] = S[dt][r]; }
  __syncthreads();
#undef RET_LOAD
#undef RET_STAGE
#undef RET_F8
}
}


constexpr int RET_SPLIT = 28;
__device__ __forceinline__ int ret_wg_index(const Frame& F) { const int bx = (int)blockIdx.x, j = bx >> 3; return (j & 3) == 0 ? ((j >> 2) * 8 + (bx & 7)) : -1; }
__device__ __forceinline__ void p4_attn(Frame& F, const Args& a, unsigned char* lds_generic) {
    const size_t nt_ = (size_t)F.ntok;
    const bf16* QA = (const bf16*)(F.act + nt_ * O_QA); bf16* ATT = (bf16*)(F.act + nt_ * O_QA);
    unsigned char* aux = a.xb + nt_ * 2048;
    const bf16* KP = (const bf16*)(aux + nt_ * AUX_KP); const bf16* VV = (const bf16*)(aux + nt_ * AUX_VV); const unsigned* MASK = (const unsigned*)(aux + nt_ * AUX_MASK);
    volatile LAS unsigned* MISC = (volatile LAS unsigned*)(F.lds + MISC_OFF);
    unsigned* qctr = (unsigned*)(F.ws + WS_CTL) + CW_Q4;
    const unsigned char* RQ = F.act + nt_ * O_RQ; const unsigned char* RK = F.act + nt_ * O_RK; const unsigned char* RV = F.act + nt_ * O_RV; const unsigned char* RG = F.act + nt_ * O_RG;
    const int nb = F.ntok / SEQ, nret = nb * 4, nitems = nb * 64;
    { const int ri = ret_wg_index(F); if (ri >= 0 && ri < nret && RET_SPLIT < SEQ / 64)
        ret::ret_item(ri >> 2, ri & 3, RQ, RK, RV, RG, A2F8_PTR, a.in[8], (char*)lds_generic, RET_SPLIT, SEQ / 64, RSTATE_PTR + (size_t)ri * 32768); }
    __syncthreads(); if (F.tid == 0) MISC[0] = atomicAdd(qctr, 1u); __syncthreads();
    int it = (int)MISC[0];
    while (it < nitems) {
        unsigned nxt_ = 0u; if (F.tid == 0) nxt_ = atomicAdd(qctr, 1u);
        const int qb = 63 - it / nb, b = it % nb, NT = (qb >> 1) + 1;
        const size_t row0 = (size_t)b * SEQ + qb * 32;
        att::attn_item((const bf16*)((const unsigned char*)QA + row0 * 1024), KP + (size_t)b * SEQ * 128, VV + (size_t)b * SEQ * 128, MASK + (size_t)b * 64 * 2048 + qb * 32, (bf16*)((unsigned char*)ATT + row0 * 1024), NT, (char*)lds_generic, F.lds);
        __syncthreads(); if (F.tid == 0) MISC[0] = nxt_; __syncthreads();
        it = (int)MISC[0];
    }
}


__device__ __forceinline__ void p7_router(Frame& F, const Args& a) {
    const int lane = F.lane, r32 = lane & 31, hi = lane >> 5, tid = F.tid;
    unsigned char* mo = F.act; unsigned char* N2 = mo + MO_N2; unsigned char* meta = mo + MO_META;
    (void)meta; int* LTOK = (int*)(mo + MO_LIST); float* LRS = (float*)(mo + MO_LIST) + 24 * LIST_CAP; float* LCL = LRS + 24 * LIST_CAP; float* LCH = LCL + 24 * LIST_CAP;
    const bf16* Wh = (const bf16*)(F.ws + WS_WR); const bf16* Wl = Wh + 32 * 1024;
    const float* g2 = a.in[12]; const float* b_gr = a.in[14]; const float* b_er = a.in[16];
    const bf16* hbase = (const bf16*)(F.act + MO_H16);
    unsigned* gcnt = (unsigned*)(F.ws + WS_CTL) + CW_MOE;
    LAS unsigned* lcnt = (LAS unsigned*)(F.lds + RING_OFF);
    if (tid < 64) lcnt[tid] = 0u;
    LAS unsigned char* Wlds = F.lds + 20480; LAS float* g2l = (LAS float*)(F.lds + 20480 + 98304);
    for (int i = tid; i < 2 * 24 * 128; i += NWAVES * 64) { const int c = i & 127, n = (i >> 7) % 24, hl = i / (24 * 128);
        *(LAS v4u*)(Wlds + (hl * 24 + n) * 2048 + ((c ^ (n & 15)) * 16)) = *(const v4u*)((hl ? Wl : Wh) + (size_t)n * 1024 + c * 8); }
    for (int i = tid; i < 256; i += NWAVES * 64) *(LAS f32x4*)(g2l + i * 4) = *(const f32x4*)(g2 + i * 4);
    __syncthreads();
    const int ntasks = F.ntok / 32, tpw = ntasks / F.G;
    const int tw = F.wave & 3, kh = F.wave >> 2;
    const bool have = tw < tpw; const int t = (F.vcu * tpw + tw) * 32 + r32;
    LAS float* xch = (LAS float*)(F.lds + RING_OFF + 1024);
    int bucket = 0, posl = 0; float clo = 0.f, chi = 0.f, rstd = 0.f;
    f32x16 acc = f32x16{}; float ss = 0.f;
    if (have) {
        const bf16* hrow = hbase + (size_t)t * D + hi * 8 + kh * 512; unsigned char* nrow = N2 + (size_t)t * D + hi * 8 + kh * 512;
        const LAS float* g2k = g2l + kh * 512 + hi * 8; const int rr = r32 < 24 ? r32 : r32 - 8;
        const LAS unsigned char* whk = Wlds + rr * 2048; const LAS unsigned char* wlk = Wlds + (24 + rr) * 2048; const int c0 = kh * 64 + hi, sw = rr & 15;
#pragma unroll 8
        for (int kk = 0; kk < 32; ++kk) {
            const v4u hv = *(const v4u*)(hrow + kk * 16); const f32x4 a0 = {pg8::bf_lo(hv.x), pg8::bf_hi(hv.x), pg8::bf_lo(hv.y), pg8::bf_hi(hv.y)}, a1 = {pg8::bf_lo(hv.z), pg8::bf_hi(hv.z), pg8::bf_lo(hv.w), pg8::bf_hi(hv.w)};
            const f32x4 q0 = *(const LAS f32x4*)(g2k + kk * 16), q1 = *(const LAS f32x4*)(g2k + kk * 16 + 4);
            ss += (a0.x * a0.x + a0.y * a0.y) + (a0.z * a0.z + a0.w * a0.w) + (a1.x * a1.x + a1.y * a1.y) + (a1.z * a1.z + a1.w * a1.w);
            const float x[8] = {a0.x * q0.x, a0.y * q0.y, a0.z * q0.z, a0.w * q0.w, a1.x * q1.x, a1.y * q1.y, a1.z * q1.z, a1.w * q1.w};
            unsigned hb[8]; float lo[8];
#pragma unroll
            for (int j = 0; j < 8; ++j) { hb[j] = f2bf(x[j]); lo[j] = x[j] - __uint_as_float(hb[j] << 16); }
            v4u xh; xh.x = hb[0] | (hb[1] << 16); xh.y = hb[2] | (hb[3] << 16); xh.z = hb[4] | (hb[5] << 16); xh.w = hb[6] | (hb[7] << 16);
            v4u xl; xl.x = pk2(lo[0], lo[1]); xl.y = pk2(lo[2], lo[3]); xl.z = pk2(lo[4], lo[5]); xl.w = pk2(lo[6], lo[7]);
            { int w0 = __builtin_amdgcn_cvt_pk_fp8_f32(x[0], x[1], 0, false); w0 = __builtin_amdgcn_cvt_pk_fp8_f32(x[2], x[3], w0, true); int w1 = __builtin_amdgcn_cvt_pk_fp8_f32(x[4], x[5], 0, false); w1 = __builtin_amdgcn_cvt_pk_fp8_f32(x[6], x[7], w1, true);
              *(unsigned long long*)(nrow + kk * 16) = (unsigned long long)(unsigned)w0 | ((unsigned long long)(unsigned)w1 << 32); }
            const int co = ((c0 + kk * 2) ^ sw) * 16; const bf16x8_t wh = *(const LAS bf16x8_t*)(whk + co), wl = *(const LAS bf16x8_t*)(wlk + co);
            const bf16x8_t bh = __builtin_bit_cast(bf16x8_t, xh), bl = __builtin_bit_cast(bf16x8_t, xl);
            acc = __builtin_amdgcn_mfma_f32_32x32x16_bf16(wh, bh, acc, 0, 0, 0);
            acc = __builtin_amdgcn_mfma_f32_32x32x16_bf16(wh, bl, acc, 0, 0, 0);
            acc = __builtin_amdgcn_mfma_f32_32x32x16_bf16(wl, bh, acc, 0, 0, 0);
        }
        if (kh == 1) {
#pragma unroll
            for (int r = 0; r < 16; ++r) xch[(tw * 17 + r) * 64 + lane] = acc[r];
            xch[(tw * 17 + 16) * 64 + lane] = ss; }
    }
    __syncthreads();
    if (have && kh == 0) {
#pragma unroll
        for (int r = 0; r < 16; ++r) acc[r] += xch[(tw * 17 + r) * 64 + lane];
        ss += xch[(tw * 17 + 16) * 64 + lane];
        ss = xhalf_sum(ss); rstd = rsqrtf(ss * (1.f / D) + EPS);
        float L[24];
#pragma unroll
        for (int r = 0; r < 12; ++r) { const float v = acc[r]; auto rr = __builtin_amdgcn_permlane32_swap(__float_as_uint(v), __float_as_uint(v), false, false);
            L[(r & 3) + 8 * (r >> 2)] = __uint_as_float(rr[0]); L[(r & 3) + 8 * (r >> 2) + 4] = __uint_as_float(rr[1]); }
        float gl[4];
#pragma unroll
        for (int i = 0; i < 4; ++i) gl[i] = L[i] * rstd + b_gr[i];
        int g = 0; float gm = gl[0];
#pragma unroll
        for (int i = 1; i < 4; ++i) if (gl[i] > gm) { gm = gl[i]; g = i; }
        float se = 0.f;
#pragma unroll
        for (int i = 0; i < 4; ++i) se += __expf(gl[i] - gm);
        const float gw = 1.f / se;
        float el[4];
#pragma unroll
        for (int i = 0; i < 4; ++i) { const float l0 = L[4 + i], l1 = L[8 + i], l2 = L[12 + i], l3 = L[16 + i]; const float lv = g == 0 ? l0 : (g == 1 ? l1 : (g == 2 ? l2 : l3));
            const float b0 = b_er[i], b1 = b_er[4 + i], b2 = b_er[8 + i], b3 = b_er[12 + i]; el[i] = lv * rstd + (g == 0 ? b0 : (g == 1 ? b1 : (g == 2 ? b2 : b3))); }
        int i1 = 0; float v1 = el[0];
#pragma unroll
        for (int i = 1; i < 4; ++i) if (el[i] > v1) { v1 = el[i]; i1 = i; }
        int i2 = -1; float v2 = 0.f;
#pragma unroll
        for (int i = 0; i < 4; ++i) if (i != i1 && (i2 < 0 || el[i] > v2)) { v2 = el[i]; i2 = i; }
        const float e2 = __expf(v2 - v1), p1 = gw / (1.f + e2), p2 = gw * e2 / (1.f + e2);
        const int lo_ = i1 < i2 ? i1 : i2, hi_ = i1 < i2 ? i2 : i1;
        const int pair = lo_ == 0 ? (hi_ - 1) : (lo_ == 1 ? (hi_ + 1) : 5);
        bucket = g * 6 + pair; clo = i1 < i2 ? p1 : p2; chi = i1 < i2 ? p2 : p1;
        if (hi == 0) posl = (int)__hip_atomic_fetch_add(&lcnt[bucket], 1u, __ATOMIC_RELAXED, __HIP_MEMORY_SCOPE_WORKGROUP);
    }
    __syncthreads();
    if (tid < 24) lcnt[32 + tid] = atomicAdd(gcnt + tid, lcnt[tid]);
    __syncthreads();
    if (have && kh == 0 && hi == 0) { const int li = bucket * LIST_CAP + (int)lcnt[32 + bucket] + posl; LTOK[li] = t; LRS[li] = rstd; LCL[li] = clo; LCH[li] = chi; }
}
__device__ __forceinline__ int moe_tiles(const unsigned* gcnt, int* rowstart  ) { int rs = 0;
    for (int b = 0; b < 24; ++b) { rowstart[b] = rs; rs += (int)((gcnt[b] + 255u) & ~255u); } rowstart[24] = rs; return rs >> 8; }
template <bool GATHER_> struct MoeOrder {
    static constexpr bool GATHER = GATHER_; const int* ptok;
    int ntile, G, c; const char* A; size_t tA; const char* W; int mode; const LAS unsigned char* tb; size_t rowB;
    __device__ bool next(int i, pg8::Unit& u) const {
        const long L = (long)i * G + c; if (L >= (long)ntile * 4) return false;
        u.pm = (int)(L >> 2); u.pn = (int)(L & 3); u.a = GATHER_ ? A : A + (size_t)u.pm * tA;
        const int bk = tb[u.pm], g = bk / 6, pr = bk % 6; { const LAS int* t24 = (const LAS int*)(tb + 512); const int rs_ = t24[bk], cn_ = t24[24 + bk], left = cn_ - (u.pm * 256 - rs_); u.aux = bk * LIST_CAP - rs_; u.nvalid = left < 0 ? 0 : (left > 256 ? 256 : left); } const int lo = pr < 3 ? 0 : (pr < 5 ? 1 : 2), hi = pr < 3 ? pr + 1 : (pr < 5 ? pr - 1 : 3);
        const int elo = g * 4 + lo, ehi = g * 4 + hi;
        if (mode == 1) { const int e = u.pn < 2 ? elo : ehi; u.b = W + ((size_t)e * 512 + (size_t)(u.pn & 1) * 256) * rowB; u.bjump = 0; }
        else { u.b = W + ((size_t)elo * 1024 + (size_t)u.pn * 256) * rowB; u.bjump = (long)(ehi - elo) * 1024 * (long)rowB - (long)rowB; }
        return true;
    }
    __device__ __forceinline__ void a_ready(const pg8::Unit&) const {}
    __device__ __forceinline__ void done(const pg8::Unit&) const {}
};
__device__ __forceinline__ float silu_f(float x) { return x * __builtin_amdgcn_rcpf(1.f + __builtin_amdgcn_exp2f(-1.4426950408889634f * x)); }
struct EpiMoe1 {
    static constexpr bool PERM = true, AFTER_DRAIN = false;
    unsigned char* ACT; const float* PRS; const float* PCL; const float* PCH;
    __device__ __forceinline__ void operator()(const pg8::f32x4 (&acc)[2][2][4][2], const pg8::Unit& u, int wr, int wc, int fr, int fq) const {
        const int row0 = u.pm * pg8::BM + wr * 64 + fr, slot = u.pn >> 1, fcol0 = slot * 256 + (u.pn & 1) * 128 + wc * 16 + 4 * fq; const float* PC = slot ? PCH : PCL;
#pragma unroll
        for (int ai = 0; ai < 2; ++ai)
#pragma unroll
            for (int m = 0; m < 4; ++m) { const int row = row0 + ai * pg8::HALF + m * 16; const bool ok = (wr * 64 + fr + ai * pg8::HALF + m * 16) < u.nvalid; const float rs = ok ? PRS[u.aux + row] : 0.f, cw = ok ? PC[u.aux + row] * 16.f : 0.f; unsigned char* rowp = ACT + (size_t)row * 512 + fcol0;
#pragma unroll
                for (int bj = 0; bj < 2; ++bj) { const pg8::f32x4 v0 = acc[ai][bj][m][0], v1 = acc[ai][bj][m][1];
                    const float a0 = silu_f(v0[0] * rs) * (v0[1] * rs) * cw, a1 = silu_f(v0[2] * rs) * (v0[3] * rs) * cw, a2 = silu_f(v1[0] * rs) * (v1[1] * rs) * cw, a3 = silu_f(v1[2] * rs) * (v1[3] * rs) * cw;
                    int w = __builtin_amdgcn_cvt_pk_fp8_f32(a0, a1, 0, false); w = __builtin_amdgcn_cvt_pk_fp8_f32(a2, a3, w, true); *(int*)(rowp + bj * 64) = w; } }
    }
};
struct EpiMoe2 {
    static constexpr bool PERM = true, AFTER_DRAIN = false;
    float* out; const pg8::bf16_t* h16; const int* PTOK;
    __device__ __forceinline__ void operator()(const pg8::f32x4 (&acc)[2][2][4][2], const pg8::Unit& u, int wr, int wc, int fr, int fq) const {
        const int row0 = u.pm * pg8::BM + wr * 64 + fr, col0 = u.pn * pg8::BM + wc * 32 + 8 * fq;
        int tk[2][4]; pg8::u32x4 hl[2][4][2];
#pragma unroll
        for (int ai = 0; ai < 2; ++ai)
#pragma unroll
            for (int m = 0; m < 4; ++m) { const int rr_ = wr * 64 + fr + ai * pg8::HALF + m * 16; tk[ai][m] = rr_ < u.nvalid ? PTOK[u.aux + row0 + ai * pg8::HALF + m * 16] : -1; }
#pragma unroll
        for (int ai = 0; ai < 2; ++ai)
#pragma unroll
            for (int m = 0; m < 4; ++m) { const pg8::bf16_t* hp = h16 + (size_t)(tk[ai][m] < 0 ? 0 : tk[ai][m]) * 1024 + col0;
#pragma unroll
                for (int bj = 0; bj < 2; ++bj) hl[ai][m][bj] = *(const pg8::u32x4*)(hp + bj * pg8::HALF); }
#pragma unroll
        for (int ai = 0; ai < 2; ++ai)
#pragma unroll
            for (int m = 0; m < 4; ++m) if (tk[ai][m] >= 0) { float* rowp = out + (size_t)tk[ai][m] * 1024 + col0;
#pragma unroll
                for (int bj = 0; bj < 2; ++bj) { const pg8::u32x4 hv = hl[ai][m][bj];
                    const pg8::f32x4 h0 = {pg8::bf_lo(hv.x), pg8::bf_hi(hv.x), pg8::bf_lo(hv.y), pg8::bf_hi(hv.y)}, h1 = {pg8::bf_lo(hv.z), pg8::bf_hi(hv.z), pg8::bf_lo(hv.w), pg8::bf_hi(hv.w)};
                    *(pg8::f32x4*)(rowp + bj * pg8::HALF) = h0 + acc[ai][bj][m][0]; *(pg8::f32x4*)(rowp + bj * pg8::HALF + 4) = h1 + acc[ai][bj][m][1]; } }
    }
};
__device__ __forceinline__ int moe_setup(Frame& F, LAS unsigned char* tb) {
    const unsigned* gcnt = (const unsigned*)(F.ws + WS_CTL) + CW_MOE;
    LAS int* nt_ = (LAS int*)(tb + 256);
    __syncthreads();
    if (F.tid == 0) { LAS int* t24 = (LAS int*)(tb + 512); int tl = 0; for (int b = 0; b < 24; ++b) { const int n = (int)((gcnt[b] + 255u) >> 8); t24[b] = tl * 256; t24[24 + b] = (int)gcnt[b]; for (int i = 0; i < n; ++i) tb[tl + i] = (unsigned char)b; tl += n; } nt_[0] = tl; }
    __syncthreads();
    return nt_[0];
}

__global__ void __launch_bounds__(NWAVES * 64, 2) mk_fwd(Args args) {
    extern __shared__ __attribute__((aligned(16))) unsigned char lds[];
    Frame F;
    F.lds = (LAS unsigned char*)lds;
    F.tid = threadIdx.x; F.lane = F.tid & 63; F.wave = __builtin_amdgcn_readfirstlane(F.tid >> 6);
    F.G = gridDim.x; { const int bx = blockIdx.x; F.vcu = (F.G % 8 == 0) ? (bx % 8) * (F.G / 8) + bx / 8 : bx; }
    F.ntok = args.ntok; F.ws = args.ws; F.act = args.ws + WS_ACT; F.xbp = args.xb;
    const int lo = args.ph_lo, hi = args.ph_hi;
    cooperative_groups::grid_group grid = cooperative_groups::this_grid();
    volatile LAS unsigned* MISCW = (volatile LAS unsigned*)(F.lds + MISC_OFF);
    for (int u = F.tid; u < (LDS_BYTES - LDSCTL_OFF) / 4; u += NWAVES * 64) ((LAS unsigned*)(F.lds + LDSCTL_OFF))[u] = 0u;
    __syncthreads();
    XcdBarrier bar = xcd_barrier_post((unsigned*)(F.ws + WS_CTL) + CW_BAR, MISCW + 8);
#define IN(k) (lo <= (k) && (k) < hi)
#define SEAM(k) do { if (IN(k) && IN((k) + 1)) { xcd_barrier(bar); } } while (0)
    if (IN(0)) { p0_prologue(F, args); }
    SEAM(0);
    if (IN(1)) {
        EpiProj E{F.act, (size_t)F.ntok, RSTD1_PTR};
        { pg8::Gemm g{512, 512, 512, 8};
          P1Order S; S.nM = F.ntok / 256; S.nN = 25; S.nwg = S.nM * 25; S.G = F.G; S.c = (int)blockIdx.x; S.mode = 0; S.A = (const char*)(args.xb + (size_t)F.ntok * AUX_XB8); S.Bt = (const char*)(F.ws + WS_WIN8); S.tA = (size_t)256 * 1024; S.tB = (size_t)256 * 1024;
          pg8::gemm_phase<EpiProj, P1Order, true, true, true>(F.lds + RING_OFF, g, S, E); }
        { pg8::Gemm g{1024, 1024, 1024, 16};
          P1Order S; S.nM = F.ntok / 256; S.nN = 3; S.nwg = S.nM * 3; S.G = F.G; S.c = ((int)blockIdx.x + F.G / 2) % F.G; S.mode = 1; S.A = (const char*)args.xb; S.Bt = (const char*)(F.ws + WS_WIN); S.tA = (size_t)256 * 2048; S.tB = (size_t)256 * 2048;
          pg8::gemm_phase<EpiProj, P1Order, true, true, false>(F.lds + RING_OFF, g, S, E); }
    }
    SEAM(1);
    if (IN(2)) { p2_post(F, args); }
    SEAM(2);
    if (IN(3)) {
        const int ri = ret_wg_index(F), nret = (F.ntok / SEQ) * 4;
        if (ri < 0) p3_index(F, args);
        else if (ri < nret) { const size_t nt_ = (size_t)F.ntok;
            ret::ret_item(ri >> 2, ri & 3, F.act + nt_ * O_RQ, F.act + nt_ * O_RK, F.act + nt_ * O_RV, F.act + nt_ * O_RG, A2F8_PTR, args.in[8], (char*)lds, 0, RET_SPLIT, RSTATE_PTR + (size_t)ri * 32768); }
    }
    SEAM(3);
    if (IN(4)) { p4_attn(F, args, lds); }
    SEAM(4);
    if (IN(5)) {
        const size_t nt_ = (size_t)F.ntok;
        const unsigned char* GA8 = F.act + nt_ * O_GA; const unsigned char* GR8 = F.act + nt_ * O_GR; unsigned char* TMP = F.act + nt_ * O_RV;
        { pg8::Gemm g{512, 512, 512, 8, 122, 123};
          pg8::StaticOrder S; S.init(F.ntok, 1024, F.G, (int)blockIdx.x, F.act + nt_ * O_QA, 512, F.ws + WS_WATT8, 512); EpiGateA E{GA8, TMP};
          pg8::gemm_phase<EpiGateA, pg8::StaticOrder, true, true, true>(F.lds + RING_OFF, g, S, E); }
        { pg8::Gemm g{512, 512, 512, 8, 122, 127};
          pg8::StaticOrder S; S.init(F.ntok, 1024, F.G, (int)blockIdx.x, A2F8_PTR, 512, F.ws + WS_WRET8, 512); EpiGateB E{TMP, GR8, F.act + nt_ * O_MIX8};
          pg8::gemm_phase<EpiGateB, pg8::StaticOrder, true, true, true>(F.lds + RING_OFF, g, S, E); }
    }
    SEAM(5);
    if (IN(6)) {
        pg8::Gemm g{512, 512, 512, 8, 122, 124}; const size_t nt_ = (size_t)F.ntok;
        pg8::StaticOrder S; S.init(F.ntok, 1024, F.G, (int)blockIdx.x, F.act + nt_ * O_MIX8, 512, F.ws + WS_WOUT8, 512);
        EpiResid E{(const pg8::bf16_t*)args.xb, (pg8::bf16_t*)(F.act + MO_H16)};
        pg8::gemm_phase<EpiResid, pg8::StaticOrder, true, true, true>(F.lds + RING_OFF, g, S, E);
    }
    SEAM(6);
    if (IN(7)) { p7_router(F, args); }
    SEAM(7);
    if (IN(9)) {
        LAS unsigned char* tb = F.lds + LDSCTL_OFF - 1024; const int ntile = moe_setup(F, tb);
        unsigned char* meta = F.act + MO_META;
        pg8::Gemm g{512, 512, 512, 8, 122, 127};
        MoeOrder<true> S{(const int*)(F.act + MO_LIST), ntile, F.G, (int)blockIdx.x, (const char*)(F.act + MO_N2), (size_t)0, (const char*)(F.ws + WS_W18), 1, tb, (size_t)1024};
        EpiMoe1 E{(unsigned char*)(F.act + MO_ACT), (const float*)(F.act + MO_LIST) + 24 * LIST_CAP, (const float*)(F.act + MO_LIST) + 48 * LIST_CAP, (const float*)(F.act + MO_LIST) + 72 * LIST_CAP};
        pg8::gemm_phase<EpiMoe1, MoeOrder<true>, true, true, true>(F.lds + RING_OFF, g, S, E);
    }
    SEAM(9);
    if (IN(10)) {
        LAS unsigned char* tb = F.lds + LDSCTL_OFF - 1024; const int ntile = moe_setup(F, tb);
        unsigned char* meta = F.act + MO_META;
        pg8::Gemm g{256, 256, 128, 2, 123, 123};
        MoeOrder<false> S{nullptr, ntile, F.G, (int)blockIdx.x, (const char*)(F.act + MO_ACT), (size_t)256 * 512, (const char*)(F.ws + WS_WD8), 2, tb, (size_t)256};
        EpiMoe2 E{args.out + (size_t)args.tok0 * D, (const pg8::bf16_t*)(F.act + MO_H16), (const int*)(F.act + MO_LIST)};
        pg8::gemm_phase<EpiMoe2, MoeOrder<false>, true, true, true>(F.lds + RING_OFF, g, S, E);
    }
    if (hi - lo > 1) grid.sync();
#undef IN
#undef SEAM
}

extern "C" void kernel_launch(void* const* d_in, const int* in_sizes, int n_in, void* d_out, int out_size, void* d_ws, size_t ws_size, hipStream_t stream) {
    static int grid = 0;
    if (grid == 0) {
        int dev = 0, cus = 0, per_cu = 0;
        (void)hipGetDevice(&dev); (void)hipDeviceGetAttribute(&cus, hipDeviceAttributeMultiprocessorCount, dev);
        if (hipFuncSetAttribute((const void*)mk_fwd, hipFuncAttributeMaxDynamicSharedMemorySize, LDS_BYTES) != hipSuccess) { fprintf(stderr, "kernel_launch: hipFuncSetAttribute failed\n"); grid = -1; return; }
        (void)hipOccupancyMaxActiveBlocksPerMultiprocessor(&per_cu, (const void*)mk_fwd, NWAVES * 64, LDS_BYTES);
        (void)hipGetLastError();
        if (per_cu < 1) { fprintf(stderr, "kernel_launch: occupancy query says %d blocks per CU\n", per_cu); per_cu = 1; }
        grid = cus * per_cu;
        if (n_in != 20 || ws_size < (size_t)512 * MiB) { fprintf(stderr, "kernel_launch: unexpected n_in %d / ws_size %zu\n", n_in, ws_size); grid = -1; return; }
        if (grid != 256) { fprintf(stderr, "kernel_launch: this kernel's phase schedules are written for a 256-workgroup grid (256 CUs x 1); the device reports %d x %d; nothing launched\n", cus, per_cu); grid = -1; return; }
    }
    if (grid < 0) return;
    float* out = (float*)d_out;
    unsigned char* ws = (unsigned char*)d_ws;
    (void)in_sizes; (void)out_size;
    (void)hipMemsetAsync(ws + WS_CTL, 0, CTL_ZERO_BYTES, stream);
    Args a{};
    for (int i = 0; i < 20; ++i) a.in[i] = (const float*)d_in[i];
    a.out = out; a.ws = ws; a.xb = (unsigned char*)d_out; a.ntok = T; a.tok0 = 0;
    void* kargs[] = {(void*)&a};
    if (PROBE_PH >= 0) { a.ph_lo = PROBE_PH; a.ph_hi = PROBE_PH + 1; a.mode = PROBE_MODE;
        (void)hipLaunchCooperativeKernel((const void*)mk_fwd, dim3(grid), dim3(NWAVES * 64), kargs, (unsigned)LDS_BYTES, stream);
        (void)hipMemsetAsync(ws + WS_CTL, 0, CTL_ZERO_BYTES, stream); }
    a.ph_lo = 0; a.ph_hi = 11; a.mode = 0;
    const hipError_t le = hipLaunchCooperativeKernel((const void*)mk_fwd, dim3(grid), dim3(NWAVES * 64), kargs, (unsigned)LDS_BYTES, stream);
    if (le != hipSuccess) fprintf(stderr, "kernel_launch: cooperative launch failed: %s (grid %d)\n", hipGetErrorString(le), grid);
}
```

```cpp
#include <hip/hip_runtime.h>
#include <hip/hip_cooperative_groups.h>
#include <cstdio>
#include <cstdint>

namespace pg8 {
#define PG8_LAS __attribute__((address_space(3)))
typedef unsigned short bf16_t;
typedef short bf16x8 __attribute__((ext_vector_type(8)));
typedef float f32x4 __attribute__((ext_vector_type(4)));
typedef unsigned u32x4 __attribute__((ext_vector_type(4)));
typedef unsigned u32x2 __attribute__((ext_vector_type(2)));
typedef int v4i_t __attribute__((ext_vector_type(4)));
typedef int v8i_t __attribute__((ext_vector_type(8)));
constexpr int BM = 256, BK = 64, HALF = 128, HTB = HALF * BK * 2  , STAGE_BYTES = 8 * HTB, NXCD = 8, WGM = 8;

__host__ __device__ __forceinline__ int lds_byte(int r, int c) { const int st = (r >> 4) * 2 + (c >> 5), rr = r & 15, cc = c & 31, ob = rr * 64 + cc * 2; return st * 1024 + (ob ^ (((ob >> 9) & 1) << 5)); }
__host__ __device__ __forceinline__ void stage_rc(int b, int& R, int& C) { const int st = b / 1024, sb = b % 1024, swz = sb ^ (((sb >> 9) & 1) << 5); R = (st >> 1) * 16 + swz / 64; C = (st & 1) * 32 + (swz % 64) / 2; }
__host__ __device__ __forceinline__ int perm32(int rho) { const int n = rho >> 4, i = rho & 15; return 8 * (i >> 2) + 4 * n + (i & 3); }

struct Unit { int pm, pn; const char* a; const char* b; long bjump; int aux; int nvalid; };
struct Gemm { int K, lda, ldb, ksplit; int sw = 122, sa = 127; };

struct StaticOrder {
    static constexpr bool GATHER = false; const int* ptok = nullptr;
    int nM, nN, nwg, G, c; const char* A; const char* Bt; size_t tA, tB;
    __device__ void init(int M, int N, int G_, int c_, const void* A_, int lda, const void* Bt_, int ldb) { nM = M / BM; nN = N / BM; nwg = nM * nN; G = G_; c = c_; A = (const char*)A_; Bt = (const char*)Bt_; tA = (size_t)BM * lda * 2; tB = (size_t)BM * ldb * 2; }
    __device__ bool next(int i, Unit& u) const {
        const long L = (long)i * G + c; if (L >= nwg) return false;
        int wgid = (int)L; { const int q = nwg / NXCD, r = nwg % NXCD, xcd = wgid % NXCD, off = wgid / NXCD; wgid = (xcd < r ? xcd * (q + 1) : r * (q + 1) + (xcd - r) * q) + off; }
        const int nig = WGM * nN, gid = wgid / nig, fm = gid * WGM, gsz = (nM - fm) < WGM ? (nM - fm) : WGM;
        u.pm = fm + ((wgid % nig) % gsz); u.pn = (wgid % nig) / gsz; u.a = A + (size_t)u.pm * tA; u.b = Bt + (size_t)u.pn * tB; u.bjump = 0; u.aux = 0; u.nvalid = 256; return true;
    }
    __device__ __forceinline__ void a_ready(const Unit&) const {}
    __device__ __forceinline__ void done(const Unit&) const {}
};

typedef float f32x2c __attribute__((ext_vector_type(2))); typedef __bf16 bf16x2c __attribute__((ext_vector_type(2)));
__device__ __forceinline__ unsigned cvt_pk_bf16(float lo, float hi) { const f32x2c v = {lo, hi}; const bf16x2c b = __builtin_convertvector(v, bf16x2c); return __builtin_bit_cast(unsigned, b); }
__device__ __forceinline__ float bf_lo(unsigned w) { return __uint_as_float(w << 16); }
__device__ __forceinline__ float bf_hi(unsigned w) { return __uint_as_float(w & 0xffff0000u); }


template <class E, class = void> struct epi_keeps { static constexpr bool v = false; };
template <class E> struct epi_keeps<E, decltype((void)E::KEEPS)> { static constexpr bool v = E::KEEPS; };
template <class Epi, class Sched, bool ALIGN_EPI = false, bool SP2 = false, bool FP8 = false>
__device__ __forceinline__ void gemm_phase(PG8_LAS unsigned char* lds, const Gemm g, const Sched& S, const Epi& E) {
    int tid = threadIdx.x; asm volatile("" : "+v"(tid));
    const int wid = __builtin_amdgcn_readfirstlane(tid >> 6), lane = tid & 63, wr = wid >> 2, wc = wid & 3, fr = lane & 15, fq = lane >> 4;
    const int K = g.K, nt = K / BK;
    unsigned voffA[2], voffB[2]; int gR[2]; unsigned gC[2];
#pragma unroll
    for (int i = 0; i < 2; ++i) { int R, C; stage_rc(tid * 16 + i * 8192, R, C); const int Rb = Epi::PERM ? ((R & ~31) + perm32(R & 31)) : R; gR[i] = R; gC[i] = (unsigned)C * 2u;
        voffA[i] = (unsigned)(R * g.lda + C) * 2u; voffB[i] = (unsigned)(Rb * g.ldb + C) * 2u; }
    unsigned gA0[2] = {0u, 0u}, gA1[2] = {0u, 0u}, gN0[2] = {0u, 0u}, gN1[2] = {0u, 0u};
#define PG8_GOFF(u_, o0, o1) do { _Pragma("unroll") for (int i_ = 0; i_ < 2; ++i_) { const int r0_ = gR[i_], r1_ = HALF + gR[i_]; const int t0_ = r0_ < (u_).nvalid ? S.ptok[(u_).aux + (u_).pm * BM + r0_] : 0, t1_ = r1_ < (u_).nvalid ? S.ptok[(u_).aux + (u_).pm * BM + r1_] : 0; \
        o0[i_] = (unsigned)t0_ * (unsigned)(g.lda * 2) + gC[i_]; o1[i_] = (unsigned)t1_ * (unsigned)(g.lda * 2) + gC[i_]; } } while (0)
    const size_t kstep = (size_t)(BK * 2);
    const size_t hstepA = Sched::GATHER ? (size_t)0 : (size_t)HALF * g.lda * 2, hstepB = (size_t)HALF * g.ldb * 2;
    const unsigned ldsw = (unsigned)wid * 1024u;
    const int aoff = lds_byte(wr * 64 + fr, fq * 8), boff = lds_byte(wc * 32 + fr, fq * 8);
#define PG8_CAT(x0, x1) __builtin_shufflevector(__builtin_bit_cast(v4i_t, x0), __builtin_bit_cast(v4i_t, x1), 0, 1, 2, 3, 4, 5, 6, 7)
#define PG8_SA(b, h) (((b) * 2 + (h)) * HTB)
#define PG8_SB(b, h) ((4 + (b) * 2 + (h)) * HTB)
#define PG8_STAGE(bufoff, gbase, voff) do { _Pragma("unroll") for (int _i = 0; _i < 2; ++_i) \
        __builtin_amdgcn_global_load_lds((const unsigned*)((const char*)(gbase) + (voff)[_i]), (PG8_LAS unsigned*)(lds + (bufoff) + ldsw + _i * 8192), 16, 0, 0); } while (0)
#define PG8_LDA(dst, b, h) do { if constexpr (FP8) { _Pragma("unroll") for (int m = 0; m < 4; ++m) dst##8[m] = PG8_CAT(*(const PG8_LAS bf16x8*)(lds + PG8_SA(b, h) + aoff + m * 2048), *(const PG8_LAS bf16x8*)(lds + PG8_SA(b, h) + aoff + m * 2048 + 1024)); } \
      else { _Pragma("unroll") for (int m = 0; m < 4; ++m) _Pragma("unroll") for (int k = 0; k < 2; ++k) dst[m][k] = *(const PG8_LAS bf16x8*)(lds + PG8_SA(b, h) + aoff + m * 2048 + k * 1024); } } while (0)
#define PG8_LDB(dst, b, h) do { if constexpr (FP8) { _Pragma("unroll") for (int n = 0; n < 2; ++n) dst##8[n] = PG8_CAT(*(const PG8_LAS bf16x8*)(lds + PG8_SB(b, h) + boff + n * 2048), *(const PG8_LAS bf16x8*)(lds + PG8_SB(b, h) + boff + n * 2048 + 1024)); } \
      else { _Pragma("unroll") for (int n = 0; n < 2; ++n) _Pragma("unroll") for (int k = 0; k < 2; ++k) dst[n][k] = *(const PG8_LAS bf16x8*)(lds + PG8_SB(b, h) + boff + n * 2048 + k * 1024); } } while (0)
#define PG8_MMA(ai, bj, At, Bt) do { __builtin_amdgcn_s_setprio(1); if constexpr (FP8) { _Pragma("unroll") for (int m = 0; m < 4; ++m) _Pragma("unroll") for (int n = 0; n < 2; ++n) \
        asm volatile("v_mfma_scale_f32_16x16x128_f8f6f4 %0, %1, %2, %0, %3, %4 op_sel_hi:[0,0,0]" : "+v"(acc[ai][bj][m][n]) : "v"(Bt##8[n]), "v"(At##8[m]), "v"(scw8), "v"(sca8)); } \
      else { _Pragma("unroll") for (int m = 0; m < 4; ++m) _Pragma("unroll") for (int n = 0; n < 2; ++n) _Pragma("unroll") for (int k = 0; k < 2; ++k) \
        acc[ai][bj][m][n] = __builtin_amdgcn_mfma_f32_16x16x32_bf16(Bt[n][k], At[m][k], acc[ai][bj][m][n], 0, 0, 0); } __builtin_amdgcn_s_setprio(0); } while (0)
#define PG8_WAIT_V(n) asm volatile("s_waitcnt vmcnt(" #n ")" ::: "memory")
#define PG8_WAIT_L(n) asm volatile("s_waitcnt lgkmcnt(" #n ")" ::: "memory")
#define PG8_BAR __builtin_amdgcn_s_barrier()
#define PG8_SCHED __builtin_amdgcn_sched_barrier(0)
    Unit cur, nxt; int ui = 0;
    if (!S.next(0, cur)) return;
    f32x4 acc[2][2][4][2];
#pragma unroll
    for (int a = 0; a < 2; ++a)
#pragma unroll
        for (int b = 0; b < 2; ++b)
#pragma unroll
            for (int m = 0; m < 4; ++m)
#pragma unroll
                for (int n = 0; n < 2; ++n) acc[a][b][m][n] = (f32x4){0.f, 0.f, 0.f, 0.f};
    int scw8 = g.sw, sca8 = g.sa; asm volatile("" : "+v"(scw8), "+v"(sca8));
    bf16x8 At[4][2], B0[2][2], B1[2][2]; v8i_t At8[4], B08[2], B18[2];
    const char* cA = cur.a; const char* cB = cur.b; long cJ = cur.bjump;
    S.a_ready(cur);
    if constexpr (SP2) {
        if constexpr (Sched::GATHER) PG8_GOFF(cur, gA0, gA1);
        PG8_STAGE(PG8_SB(0, 0), cB, voffB); PG8_STAGE(PG8_SB(0, 1), cB + hstepB, voffB); do { if constexpr (Sched::GATHER) { PG8_STAGE(PG8_SA(0, 0), cA, gA0); } else { PG8_STAGE(PG8_SA(0, 0), cA, voffA); } } while (0); do { if constexpr (Sched::GATHER) { PG8_STAGE(PG8_SA(0, 1), cA, gA1); } else { PG8_STAGE(PG8_SA(0, 1), cA + hstepA, voffA); } } while (0);
        if (wr == 1) PG8_BAR;
        PG8_WAIT_V(2); PG8_BAR;
        PG8_STAGE(PG8_SB(1, 0), cB + kstep, voffB); do { if constexpr (Sched::GATHER) { PG8_STAGE(PG8_SA(1, 0), cA + kstep, gA0); } else { PG8_STAGE(PG8_SA(1, 0), cA + kstep, voffA); } } while (0); PG8_STAGE(PG8_SB(1, 1), cB + hstepB + kstep, voffB);
        PG8_WAIT_V(6); PG8_BAR;
    } else {
        PG8_STAGE(PG8_SB(0, 0), cB, voffB); PG8_STAGE(PG8_SA(0, 0), cA, voffA); PG8_STAGE(PG8_SB(0, 1), cB + hstepB, voffB); PG8_STAGE(PG8_SA(0, 1), cA + hstepA, voffA);
        if (wr == 1) PG8_BAR;
        PG8_WAIT_V(4); PG8_BAR;
        PG8_STAGE(PG8_SB(1, 0), cB + kstep, voffB); PG8_STAGE(PG8_SA(1, 0), cA + kstep, voffA); PG8_STAGE(PG8_SB(1, 1), cB + hstepB + kstep, voffB);
        PG8_WAIT_V(6); PG8_BAR;
    }
    for (;;) {
        const bool has_next = S.next(ui + 1, nxt);
        const char* nA = has_next ? nxt.a : cA; const char* nB = has_next ? nxt.b : cB;
        if constexpr (Sched::GATHER) { if (has_next) PG8_GOFF(nxt, gN0, gN1); else { gN0[0] = gA0[0]; gN0[1] = gA0[1]; gN1[0] = gA1[0]; gN1[1] = gA1[1]; } }
#pragma unroll 1
        for (int t = 0; t < nt; t += 2) {
            const bool last = (t == nt - 2);
            const char* a1 = cA + (size_t)(t + 1) * kstep;
            const char* a2 = last ? nA : cA + (size_t)(t + 2) * kstep; const char* b2 = last ? nB : cB + (size_t)(t + 2) * kstep + ((t + 2) >= g.ksplit ? cJ : 0L);
            const char* a3 = a2 + kstep; const char* b3 = b2 + kstep;
            if (last && has_next) S.a_ready(nxt);
            unsigned x0[2] = {0u, 0u}, x1[2] = {0u, 0u};
            if constexpr (Sched::GATHER) { x0[0] = last ? gN0[0] : gA0[0]; x0[1] = last ? gN0[1] : gA0[1]; x1[0] = last ? gN1[0] : gA1[0]; x1[1] = last ? gN1[1] : gA1[1]; }
            if constexpr (SP2) {
            PG8_LDB(B0, 0, 0); PG8_LDB(B1, 0, 1); PG8_SCHED; PG8_LDA(At, 0, 0); do { if constexpr (Sched::GATHER) { PG8_STAGE(PG8_SA(1, 1), a1, gA1); } else { PG8_STAGE(PG8_SA(1, 1), a1 + hstepA, voffA); } } while (0);
            PG8_WAIT_V(8); PG8_WAIT_L(0); PG8_BAR; PG8_MMA(0, 0, At, B0); PG8_MMA(0, 1, At, B1); PG8_BAR; PG8_SCHED;
            PG8_LDA(At, 0, 1); PG8_STAGE(PG8_SB(0, 0), b2, voffB); PG8_STAGE(PG8_SB(0, 1), b2 + hstepB, voffB); do { if constexpr (Sched::GATHER) { PG8_STAGE(PG8_SA(0, 0), a2, x0); } else { PG8_STAGE(PG8_SA(0, 0), a2, voffA); } } while (0);
            PG8_WAIT_V(8); PG8_WAIT_L(0); PG8_BAR; PG8_MMA(1, 0, At, B0); PG8_MMA(1, 1, At, B1); PG8_BAR; PG8_SCHED;
            PG8_LDB(B0, 1, 0); PG8_LDB(B1, 1, 1); PG8_SCHED; PG8_LDA(At, 1, 0); do { if constexpr (Sched::GATHER) { PG8_STAGE(PG8_SA(0, 1), a2, x1); } else { PG8_STAGE(PG8_SA(0, 1), a2 + hstepA, voffA); } } while (0);
            PG8_WAIT_V(8); PG8_WAIT_L(0); PG8_BAR; PG8_MMA(0, 0, At, B0); PG8_MMA(0, 1, At, B1); PG8_BAR; PG8_SCHED;
            PG8_LDA(At, 1, 1); PG8_STAGE(PG8_SB(1, 0), b3, voffB); PG8_STAGE(PG8_SB(1, 1), b3 + hstepB, voffB); do { if constexpr (Sched::GATHER) { PG8_STAGE(PG8_SA(1, 0), a3, x0); } else { PG8_STAGE(PG8_SA(1, 0), a3, voffA); } } while (0);
            PG8_WAIT_V(8); PG8_WAIT_L(0); PG8_BAR; PG8_MMA(1, 0, At, B0); PG8_MMA(1, 1, At, B1); PG8_BAR; PG8_SCHED;
            } else {
            PG8_LDB(B0, 0, 0); PG8_SCHED; PG8_LDA(At, 0, 0); PG8_STAGE(PG8_SA(1, 1), a1 + hstepA, voffA);
            PG8_WAIT_L(8); PG8_BAR; PG8_WAIT_L(0); PG8_MMA(0, 0, At, B0); PG8_BAR; PG8_SCHED;
            PG8_LDB(B1, 0, 1); PG8_STAGE(PG8_SB(0, 0), b2, voffB);
            PG8_BAR; PG8_WAIT_L(0); PG8_MMA(0, 1, At, B1); PG8_BAR;
            PG8_LDA(At, 0, 1); PG8_STAGE(PG8_SA(0, 0), a2, voffA);
            PG8_BAR; PG8_WAIT_L(0); PG8_MMA(1, 0, At, B0); PG8_BAR; PG8_SCHED;
            PG8_STAGE(PG8_SB(0, 1), b2 + hstepB, voffB);
            PG8_WAIT_V(6); PG8_BAR; PG8_MMA(1, 1, At, B1); PG8_BAR;
            PG8_LDB(B0, 1, 0); PG8_SCHED; PG8_LDA(At, 1, 0); PG8_STAGE(PG8_SA(0, 1), a2 + hstepA, voffA);
            PG8_WAIT_L(8); PG8_BAR; PG8_WAIT_L(0); PG8_MMA(0, 0, At, B0); PG8_BAR; PG8_SCHED;
            PG8_LDB(B1, 1, 1); PG8_STAGE(PG8_SB(1, 0), b3, voffB);
            PG8_BAR; PG8_WAIT_L(0); PG8_MMA(0, 1, At, B1); PG8_BAR;
            PG8_LDA(At, 1, 1); PG8_STAGE(PG8_SA(1, 0), a3, voffA);
            PG8_BAR; PG8_WAIT_L(0); PG8_MMA(1, 0, At, B0); PG8_BAR; PG8_SCHED;
            PG8_STAGE(PG8_SB(1, 1), b3 + hstepB, voffB);
            PG8_WAIT_V(6); PG8_BAR; PG8_MMA(1, 1, At, B1); PG8_BAR;
            }
        }
        if constexpr (ALIGN_EPI) { if (wr == 0) PG8_BAR; }
        bool keep_acc = false;
        if constexpr (epi_keeps<Epi>::v) { keep_acc = E.keep(cur); if (keep_acc) E.mid(acc, cur, wr, wc, fr, fq); else E(acc, cur, wr, wc, fr, fq); S.done(cur); } else
        if constexpr (!Epi::AFTER_DRAIN) { E(acc, cur, wr, wc, fr, fq); S.done(cur); }
        if (!has_next) break;
        if (!keep_acc) {
#pragma unroll
        for (int a = 0; a < 2; ++a)
#pragma unroll
            for (int b = 0; b < 2; ++b)
#pragma unroll
                for (int m = 0; m < 4; ++m)
#pragma unroll
                    for (int n = 0; n < 2; ++n) acc[a][b][m][n] = (f32x4){0.f, 0.f, 0.f, 0.f};
        }
        cur = nxt; cA = nA; cB = nB; cJ = cur.bjump; ++ui;
        if constexpr (Sched::GATHER) { gA0[0] = gN0[0]; gA0[1] = gN0[1]; gA1[0] = gN1[0]; gA1[1] = gN1[1]; }
        if constexpr (ALIGN_EPI) { if (wr == 1) PG8_BAR; }
    }
    PG8_WAIT_V(0);
    if constexpr (!ALIGN_EPI) { if (wr == 0) PG8_BAR; }
    PG8_BAR;
    if constexpr (Epi::AFTER_DRAIN) { E.fused(acc, cur, wr, wc, fr, fq, lds, wid, lane); S.done(cur); }
#undef PG8_GOFF
#undef PG8_SA
#undef PG8_SB
#undef PG8_STAGE
#undef PG8_LDA
#undef PG8_LDB
#undef PG8_MMA
#undef PG8_CAT
#undef PG8_WAIT_V
#undef PG8_WAIT_L
#undef PG8_BAR
#undef PG8_SCHED
}
}

#ifndef PROBE_PH
#define PROBE_PH (-1)
#endif
#ifndef PROBE_MODE
#define PROBE_MODE (0)
#endif
constexpr int D = 1024, BATCH = 16, SEQ = 2048, T = BATCH * SEQ;
constexpr int INW = 6984, INWP = 7168;
constexpr int C_QA = 0, C_CKV = 1024, C_QI = 1280, C_KI = 1792, C_WI = 1856, C_RQ = 1864, C_RK = 2376, C_RV = 2888, C_RG = 3912, C_GA = 4936, C_GR = 5960;
constexpr float EPS = 1e-6f;
constexpr int NWAVES = 8;

constexpr size_t MiB = 1u << 20;
constexpr size_t WS_CTL = 0, CTL_ZERO_BYTES = 1 * MiB;
constexpr size_t WS_WIN = 1 * MiB, WS_WKV = 15 * MiB, WS_WATT = 16 * MiB, WS_WRET = 18 * MiB, WS_WOUT = 20 * MiB, WS_W1 = 22 * MiB, WS_WD = 38 * MiB, WS_ACT = 46 * MiB;
constexpr size_t O_QA = 0, O_CKV = 2048, O_QI = 2560, O_KW = 3584, O_RQ = 3840, O_RK = 4864, O_RV = 5888, O_RG = 7936, O_GA = 9984, O_GR = 12032, O_END = 14080;

constexpr int MP_ROWS = 38912;
constexpr size_t MO_APERM = 0, MO_ACT = 80 * MiB, MO_N2 = 120 * MiB, MO_META = 184 * MiB;
constexpr size_t MM_B = 0, MM_P = 131072, MM_CL = 262144, MM_CH = 393216, MM_RS = 524288, MM_PTOK = 655360, MM_PRS = 819200, MM_PCL = 983040, MM_PCH = 1146880, MM_END = 1310720;
constexpr size_t WS_WR = 15 * MiB + 512 * 1024;
constexpr size_t O_A2F8 = 1024;
constexpr size_t O_RSTATE = O_RQ + 512;
#define A2F8_PTR (F.act + (size_t)F.ntok * O_A2F8)
#define RSTATE_PTR ((float*)(F.act + (size_t)F.ntok * O_RSTATE))
#define RSTD1_PTR ((float*)(F.act + (size_t)F.ntok * O_RSTATE + 8 * MiB))
constexpr size_t MO_LIST = 152 * MiB; constexpr int LIST_CAP = 32768;
constexpr size_t MO_H16 = 192 * MiB;
constexpr size_t WS_WIN8 = 488 * MiB;
constexpr size_t WS_WATT8 = 495 * MiB, WS_WRET8 = 496 * MiB, WS_WOUT8 = 497 * MiB;
constexpr size_t O_MIX8 = 3840;
constexpr size_t WS_W18 = 498 * MiB, WS_WD8 = 506 * MiB;
constexpr size_t AUX_XB8 = 2048 + 896;
constexpr int F8_FIRST_TILE = 8;
constexpr int CW_MOE = 256;
constexpr int RING_OFF = 0, RING_BYTES = 131072, P3_HIST_OFF = 131072, P3_TOT_OFF = 147456, P3_T_OFF = 149504, LDSCTL_OFF = 151552, MISC_OFF = LDSCTL_OFF + 320, LDS_BYTES = 152576;
constexpr int CW_Q3 = 64, CW_Q4 = 128;

#define GAS __attribute__((address_space(1)))
#define LAS __attribute__((address_space(3)))
typedef unsigned short bf16;
typedef unsigned v4u __attribute__((ext_vector_type(4)));
typedef float f32x4 __attribute__((ext_vector_type(4)));
#define LDS_WAIT() asm volatile("s_waitcnt lgkmcnt(0)" ::: "memory")
#define VM_WAIT() asm volatile("s_waitcnt vmcnt(0)" ::: "memory")
__device__ __forceinline__ unsigned pk2(float lo, float hi) { return pg8::cvt_pk_bf16(lo, hi); }
__device__ __forceinline__ unsigned f2bf(float f) { return pg8::cvt_pk_bf16(f, 0.f) & 0xffffu; }
__device__ __forceinline__ float bf2f(bf16 b) { return __uint_as_float((unsigned)b << 16); }


typedef GAS unsigned gu32;
constexpr int CW_BAR = 4096;
#define XB_TMO      128
#define XB_XCNT(j)  (256  + 64 * (j))
#define XB_XSUB(j)  (1280 + 64 * (j))
#define XB_XGEN(j)  (2304 + 64 * (j))
#define XB_TOP      3328
#define XB_TOPGEN   3392
#define XCD_BAR_WORDS 3456
#define XB_SPIN_CAP (1u << 18)

__device__ __forceinline__ unsigned xb_ld(unsigned* p)              { return __hip_atomic_load(p, __ATOMIC_RELAXED, __HIP_MEMORY_SCOPE_AGENT); }
__device__ __forceinline__ unsigned xb_add(unsigned* p, unsigned v) { return __hip_atomic_fetch_add(p, v, __ATOMIC_RELAXED, __HIP_MEMORY_SCOPE_AGENT); }
__device__ __forceinline__ unsigned xb_xcc_id() { return (unsigned)__builtin_amdgcn_s_getreg((3 << 11) | 20) & 0xFu; }
#define XB_SPIN(cond, bar) do { unsigned _sp = 0; while (cond) { __builtin_amdgcn_s_sleep(1); \
    if ((++_sp & 255u) == 0u) { if (xb_ld(&(bar)[XB_TMO])) break; if (_sp > XB_SPIN_CAP) { atomicAdd(&(bar)[XB_TMO], 1u); break; } } } } while (0)

struct XcdBarrier {
    unsigned* bar; unsigned x;
    volatile LAS unsigned* st;
};

__device__ __forceinline__ XcdBarrier xcd_barrier_post(unsigned* bar, volatile LAS unsigned* st) {
    XcdBarrier b; b.bar = bar; b.x = xb_xcc_id(); b.st = st;
    if (threadIdx.x == 0) (void)xb_add(&bar[XB_XCNT(b.x)], 1u);
    return b;
}
__device__ __forceinline__ void xcd_barrier_complete(unsigned* bar, unsigned x, unsigned& nloc, unsigned& nx) {
    const unsigned G = gridDim.x * gridDim.y * gridDim.z;
    unsigned sum, cnt, mine, sp = 0u;
    for (;;) {
        sum = 0u; cnt = 0u; mine = 0u;
#pragma unroll
        for (unsigned j = 0; j < 16; ++j) { const unsigned c = xb_ld(&bar[XB_XCNT(j)]); sum += c; cnt += (c > 0u) ? 1u : 0u; mine = (j == x) ? c : mine; }
        if (sum == G) break;
        __builtin_amdgcn_s_sleep(1);
        if ((++sp & 255u) == 0u) { if (xb_ld(&bar[XB_TMO])) break; if (sp > XB_SPIN_CAP) { atomicAdd(&bar[XB_TMO], 1u); break; } }
    }
    nloc = mine > 0u ? mine : 1u; nx = cnt > 0u ? cnt : 1u;
}

__device__ __forceinline__ void xcd_barrier(const XcdBarrier& b) {
    asm volatile("s_waitcnt vmcnt(0)" ::: "memory");
    __syncthreads();
    if (threadIdx.x == 0) {
        unsigned* bar = b.bar;
        __builtin_amdgcn_s_waitcnt(0);
        unsigned nloc = b.st[0], nx = b.st[1];
        if (nloc == 0u) { xcd_barrier_complete(bar, b.x, nloc, nx); b.st[0] = nloc; b.st[1] = nx; }
        const unsigned old = xb_add(&bar[XB_XSUB(b.x)], 1u);
        const unsigned gen = old / nloc;
        if (old + 1u == (gen + 1u) * nloc) {
            __builtin_amdgcn_fence(__ATOMIC_RELEASE, "agent");
            asm volatile("s_waitcnt vmcnt(0)" ::: "memory");
            const unsigned og = xb_add(&bar[XB_TOP], 1u);
            const unsigned tg = og / nx;
            if (og + 1u == (tg + 1u) * nx) xb_add(&bar[XB_TOPGEN], 1u);
            else XB_SPIN(xb_ld(&bar[XB_TOPGEN]) == tg, bar);
            __builtin_amdgcn_fence(__ATOMIC_ACQUIRE, "agent");
            xb_add(&bar[XB_XGEN(b.x)], 1u);
            asm volatile("s_waitcnt vmcnt(0)" ::: "memory");
        } else {
            XB_SPIN(xb_ld(&bar[XB_XGEN(b.x)]) == gen, bar);
            __builtin_amdgcn_fence(__ATOMIC_ACQUIRE, "agent");
            asm volatile("s_waitcnt vmcnt(0)" ::: "memory");
        }
    }
    __syncthreads();
}

struct Args { const float* in[20]; float* out; unsigned char* ws; unsigned char* xb; int ph_lo, ph_hi, ntok, tok0, mode, pad; };

struct Frame {
    LAS unsigned char* lds;
    int tid, lane, wave, vcu, G;
    int ntok;
    unsigned char* ws; unsigned char* act; unsigned char* xbp;
};

struct EpiProj {
    static constexpr bool PERM = true, AFTER_DRAIN = false;
    unsigned char* act; size_t ntok; const float* rstd1;
    static __device__ __forceinline__ unsigned q4(const pg8::f32x4& v) { int w = __builtin_amdgcn_cvt_pk_fp8_f32(v[0], v[1], 0, false); return (unsigned)__builtin_amdgcn_cvt_pk_fp8_f32(v[2], v[3], w, true); }
    __device__ __forceinline__ void operator()(const pg8::f32x4 (&acc)[2][2][4][2], const pg8::Unit& u, int wr, int wc, int fr, int fq) const {
        const int pn = u.pn; size_t O; int ld, cb, nbj = 2; bool f8 = false;
        if (pn < 4) { O = O_QA; ld = 1024; cb = pn * 256; }
        else if (pn == 4) { O = O_CKV; ld = 256; cb = 0; }
        else if (pn < 7) { O = O_QI; ld = 512; cb = (pn - 5) * 256; }
        else if (pn == 7) { O = O_KW; ld = 128; cb = 0; nbj = 1; }
        else if (pn < 10) { O = O_RQ; ld = 512; cb = (pn - 8) * 256; }
        else if (pn < 12) { O = O_RK; ld = 512; cb = (pn - 10) * 256; }
        else { O = O_RV + (size_t)((pn - 12) >> 2) * 2048; ld = 1024; cb = ((pn - 12) & 3) * 256; }
        f8 = pn < 5 || pn >= F8_FIRST_TILE;
        const int row0 = u.pm * pg8::BM + wr * 64 + fr;
        if (f8) {
            unsigned char* base = act + ntok * O; const bool odd = fq & 1; const int colb = cb + wc * 32 + 8 * (fq & ~1);
#pragma unroll
            for (int ai = 0; ai < 2; ++ai)
#pragma unroll
                for (int bj = 0; bj < 2; ++bj)
#pragma unroll
                    for (int mp = 0; mp < 2; ++mp) { const unsigned x0 = q4(acc[ai][bj][2 * mp][0]), x1 = q4(acc[ai][bj][2 * mp][1]), y0 = q4(acc[ai][bj][2 * mp + 1][0]), y1 = q4(acc[ai][bj][2 * mp + 1][1]);
                        const unsigned r0 = (unsigned)__builtin_amdgcn_ds_swizzle((int)(odd ? x0 : y0), 0x401F), r1 = (unsigned)__builtin_amdgcn_ds_swizzle((int)(odd ? x1 : y1), 0x401F);
                        pg8::u32x4 w; if (odd) { w.x = r0; w.y = r1; w.z = y0; w.w = y1; } else { w.x = x0; w.y = x1; w.z = r0; w.w = r1; }
                        *(pg8::u32x4*)(base + (size_t)(row0 + ai * pg8::HALF + (2 * mp + (odd ? 1 : 0)) * 16) * ld + colb + bj * pg8::HALF) = w; }
            return;
        }
        pg8::bf16_t* base = (pg8::bf16_t*)(act + ntok * O);
        const int col0 = cb + wc * 32 + 8 * fq;
        float rs1[2][4];
#pragma unroll
        for (int ai = 0; ai < 2; ++ai)
#pragma unroll
            for (int m = 0; m < 4; ++m) rs1[ai][m] = rstd1[row0 + ai * pg8::HALF + m * 16];
#pragma unroll
        for (int ai = 0; ai < 2; ++ai)
#pragma unroll
            for (int m = 0; m < 4; ++m) { pg8::bf16_t* rowp = base + (size_t)(row0 + ai * pg8::HALF + m * 16) * ld + col0; const float rs = rs1[ai][m];
#pragma unroll
                for (int bj = 0; bj < 2; ++bj) if (bj < nbj) { const pg8::f32x4 v0 = acc[ai][bj][m][0] * rs, v1 = acc[ai][bj][m][1] * rs;
                    pg8::u32x4 w; w.x = pg8::cvt_pk_bf16(v0[0], v0[1]); w.y = pg8::cvt_pk_bf16(v0[2], v0[3]); w.z = pg8::cvt_pk_bf16(v1[0], v1[1]); w.w = pg8::cvt_pk_bf16(v1[2], v1[3]);
                    *(pg8::u32x4*)(rowp + bj * pg8::HALF) = w; } }
    }
};

__device__ __forceinline__ float sigm(float x) { return __builtin_amdgcn_rcpf(1.f + __builtin_amdgcn_exp2f(-1.4426950408889634f * x)); }
__device__ __forceinline__ void f8x8(const pg8::u32x2 g, float (&f)[8]) { const auto a = __builtin_amdgcn_cvt_pk_f32_fp8((int)g.x, false), b = __builtin_amdgcn_cvt_pk_f32_fp8((int)g.x, true), c = __builtin_amdgcn_cvt_pk_f32_fp8((int)g.y, false), d = __builtin_amdgcn_cvt_pk_f32_fp8((int)g.y, true);
    f[0] = a[0]; f[1] = a[1]; f[2] = b[0]; f[3] = b[1]; f[4] = c[0]; f[5] = c[1]; f[6] = d[0]; f[7] = d[1]; }
__device__ __forceinline__ void st_f8_pair(unsigned char* base, size_t ld, int row_m0, int colb, bool odd, unsigned x0, unsigned x1, unsigned y0, unsigned y1) {
    const unsigned r0 = (unsigned)__builtin_amdgcn_ds_swizzle((int)(odd ? x0 : y0), 0x401F), r1 = (unsigned)__builtin_amdgcn_ds_swizzle((int)(odd ? x1 : y1), 0x401F);
    pg8::u32x4 w; if (odd) { w.x = r0; w.y = r1; w.z = y0; w.w = y1; } else { w.x = x0; w.y = x1; w.z = r0; w.w = r1; }
    *(pg8::u32x4*)(base + (size_t)(row_m0 + (odd ? 16 : 0)) * ld + colb) = w;
}
__device__ __forceinline__ unsigned q4f(float a, float b, float c, float d) { int w = __builtin_amdgcn_cvt_pk_fp8_f32(a, b, 0, false); return (unsigned)__builtin_amdgcn_cvt_pk_fp8_f32(c, d, w, true); }
struct GateOrder {
    static constexpr bool GATHER = false; const int* ptok = nullptr;
    pg8::StaticOrder S0; const char* A1; const char* B1;
    __device__ bool next(int i, pg8::Unit& u) const { if (!S0.next(i >> 1, u)) return false; if (i & 1) { u.a = A1 + (size_t)u.pm * S0.tA; u.b = B1 + (size_t)u.pn * S0.tB; u.aux = 1; } return true; }
    __device__ __forceinline__ void a_ready(const pg8::Unit&) const {}
    __device__ __forceinline__ void done(const pg8::Unit&) const {}
};
__device__ __forceinline__ float sigm_c(float x) { return __builtin_amdgcn_rcpf(1.f + __builtin_amdgcn_exp2f(-1.4426950408889634f * fmaxf(x, -40.f))); }
struct EpiGateFused {
    static constexpr bool PERM = true, AFTER_DRAIN = false, KEEPS = true;
    const unsigned char* GA8; const unsigned char* GR8; unsigned char* MIX8;
    __device__ __forceinline__ bool keep(const pg8::Unit& u) const { return u.aux == 0; }
    __device__ __forceinline__ void mid(pg8::f32x4 (&acc)[2][2][4][2], const pg8::Unit& u, int wr, int wc, int fr, int fq) const {
        const int row0 = u.pm * pg8::BM + wr * 64 + fr, col0 = u.pn * pg8::BM + wc * 32 + 8 * fq;
#pragma unroll
        for (int ai = 0; ai < 2; ++ai) { pg8::u32x2 ga[2][4], gr[2][4];
#pragma unroll
            for (int bj = 0; bj < 2; ++bj)
#pragma unroll
                for (int m = 0; m < 4; ++m) { const size_t ro = (size_t)(row0 + ai * pg8::HALF + m * 16) * 1024 + col0 + bj * pg8::HALF; ga[bj][m] = *(const pg8::u32x2*)(GA8 + ro); gr[bj][m] = *(const pg8::u32x2*)(GR8 + ro); }
#pragma unroll
            for (int bj = 0; bj < 2; ++bj)
#pragma unroll
                for (int m = 0; m < 4; ++m) { float a[8], r[8]; f8x8(ga[bj][m], a); f8x8(gr[bj][m], r);
#pragma unroll
                    for (int j = 0; j < 4; ++j) { acc[ai][bj][m][0][j] *= sigm(a[j]) * (0.0625f * (1.f + __builtin_amdgcn_exp2f(-1.4426950408889634f * fmaxf(r[j], -40.f))));
                                                  acc[ai][bj][m][1][j] *= sigm(a[4 + j]) * (0.0625f * (1.f + __builtin_amdgcn_exp2f(-1.4426950408889634f * fmaxf(r[4 + j], -40.f)))); } } }
    }
    __device__ __forceinline__ void operator()(const pg8::f32x4 (&acc)[2][2][4][2], const pg8::Unit& u, int wr, int wc, int fr, int fq) const {
        const int row0 = u.pm * pg8::BM + wr * 64 + fr, col0 = u.pn * pg8::BM + wc * 32 + 8 * fq, colb = u.pn * pg8::BM + wc * 32 + 8 * (fq & ~1); const bool odd = fq & 1;
        pg8::u32x2 gl[2][2][4];
#pragma unroll
        for (int ai = 0; ai < 2; ++ai)
#pragma unroll
            for (int bj = 0; bj < 2; ++bj)
#pragma unroll
                for (int m = 0; m < 4; ++m) gl[ai][bj][m] = *(const pg8::u32x2*)(GR8 + (size_t)(row0 + ai * pg8::HALF + m * 16) * 1024 + col0 + bj * pg8::HALF);
#pragma unroll
        for (int ai = 0; ai < 2; ++ai)
#pragma unroll
            for (int bj = 0; bj < 2; ++bj)
#pragma unroll
                for (int mp = 0; mp < 2; ++mp) { unsigned q[2][2];
#pragma unroll
                    for (int e = 0; e < 2; ++e) { const int m = 2 * mp + e; float g[8]; f8x8(gl[ai][bj][m], g);
                        const pg8::f32x4 v0 = acc[ai][bj][m][0], v1 = acc[ai][bj][m][1];
                        q[e][0] = q4f(128.f * sigm_c(g[0]) * v0[0], 128.f * sigm_c(g[1]) * v0[1], 128.f * sigm_c(g[2]) * v0[2], 128.f * sigm_c(g[3]) * v0[3]);
                        q[e][1] = q4f(128.f * sigm_c(g[4]) * v1[0], 128.f * sigm_c(g[5]) * v1[1], 128.f * sigm_c(g[6]) * v1[2], 128.f * sigm_c(g[7]) * v1[3]); }
                    st_f8_pair(MIX8, 1024, row0 + ai * pg8::HALF + 2 * mp * 16, colb + bj * pg8::HALF, odd, q[0][0], q[0][1], q[1][0], q[1][1]); }
    }
};
struct EpiGateA {
    static constexpr bool PERM = true, AFTER_DRAIN = false;
    const unsigned char* GA8; unsigned char* TMP8;
    __device__ __forceinline__ void operator()(const pg8::f32x4 (&acc)[2][2][4][2], const pg8::Unit& u, int wr, int wc, int fr, int fq) const {
        const int row0 = u.pm * pg8::BM + wr * 64 + fr, col0 = u.pn * pg8::BM + wc * 32 + 8 * fq, colb = u.pn * pg8::BM + wc * 32 + 8 * (fq & ~1); const bool odd = fq & 1;
        pg8::u32x2 gl[2][2][4];
#pragma unroll
        for (int ai = 0; ai < 2; ++ai)
#pragma unroll
            for (int bj = 0; bj < 2; ++bj)
#pragma unroll
                for (int m = 0; m < 4; ++m) gl[ai][bj][m] = *(const pg8::u32x2*)(GA8 + (size_t)(row0 + ai * pg8::HALF + m * 16) * 1024 + col0 + bj * pg8::HALF);
#pragma unroll
        for (int ai = 0; ai < 2; ++ai)
#pragma unroll
            for (int bj = 0; bj < 2; ++bj)
#pragma unroll
                for (int mp = 0; mp < 2; ++mp) { unsigned q[2][2];
#pragma unroll
                    for (int e = 0; e < 2; ++e) { const int m = 2 * mp + e; float g[8]; f8x8(gl[ai][bj][m], g);
                        const pg8::f32x4 v0 = acc[ai][bj][m][0], v1 = acc[ai][bj][m][1];
                        q[e][0] = q4f(32.f * sigm(g[0]) * v0[0], 32.f * sigm(g[1]) * v0[1], 32.f * sigm(g[2]) * v0[2], 32.f * sigm(g[3]) * v0[3]); q[e][1] = q4f(32.f * sigm(g[4]) * v1[0], 32.f * sigm(g[5]) * v1[1], 32.f * sigm(g[6]) * v1[2], 32.f * sigm(g[7]) * v1[3]); }
                    st_f8_pair(TMP8, 1024, row0 + ai * pg8::HALF + 2 * mp * 16, colb + bj * pg8::HALF, odd, q[0][0], q[0][1], q[1][0], q[1][1]); }
    }
};
struct EpiGateB {
    static constexpr bool PERM = true, AFTER_DRAIN = false;
    const unsigned char* TMP8; const unsigned char* GR8; unsigned char* MIX8;
    __device__ __forceinline__ void operator()(const pg8::f32x4 (&acc)[2][2][4][2], const pg8::Unit& u, int wr, int wc, int fr, int fq) const {
        const int row0 = u.pm * pg8::BM + wr * 64 + fr, col0 = u.pn * pg8::BM + wc * 32 + 8 * fq, colb = u.pn * pg8::BM + wc * 32 + 8 * (fq & ~1); const bool odd = fq & 1;
        pg8::u32x2 gl[2][2][4], tl[2][2][4];
#pragma unroll
        for (int ai = 0; ai < 2; ++ai)
#pragma unroll
            for (int bj = 0; bj < 2; ++bj)
#pragma unroll
                for (int m = 0; m < 4; ++m) { const size_t ro = (size_t)(row0 + ai * pg8::HALF + m * 16) * 1024 + col0 + bj * pg8::HALF; gl[ai][bj][m] = *(const pg8::u32x2*)(GR8 + ro); tl[ai][bj][m] = *(const pg8::u32x2*)(TMP8 + ro); }
#pragma unroll
        for (int ai = 0; ai < 2; ++ai)
#pragma unroll
            for (int bj = 0; bj < 2; ++bj)
#pragma unroll
                for (int mp = 0; mp < 2; ++mp) { unsigned q[2][2];
#pragma unroll
                    for (int e = 0; e < 2; ++e) { const int m = 2 * mp + e; float g[8], t[8]; f8x8(gl[ai][bj][m], g); f8x8(tl[ai][bj][m], t);
                        const pg8::f32x4 v0 = acc[ai][bj][m][0], v1 = acc[ai][bj][m][1];
                        q[e][0] = q4f(0.25f * t[0] + 8.f * sigm(g[0]) * v0[0], 0.25f * t[1] + 8.f * sigm(g[1]) * v0[1], 0.25f * t[2] + 8.f * sigm(g[2]) * v0[2], 0.25f * t[3] + 8.f * sigm(g[3]) * v0[3]);
                        q[e][1] = q4f(0.25f * t[4] + 8.f * sigm(g[4]) * v1[0], 0.25f * t[5] + 8.f * sigm(g[5]) * v1[1], 0.25f * t[6] + 8.f * sigm(g[6]) * v1[2], 0.25f * t[7] + 8.f * sigm(g[7]) * v1[3]); }
                    st_f8_pair(MIX8, 1024, row0 + ai * pg8::HALF + 2 * mp * 16, colb + bj * pg8::HALF, odd, q[0][0], q[0][1], q[1][0], q[1][1]); }
    }
};
struct EpiResid {
    static constexpr bool PERM = true, AFTER_DRAIN = false;
    const pg8::bf16_t* xb; pg8::bf16_t* h16;
    __device__ __forceinline__ void operator()(const pg8::f32x4 (&acc)[2][2][4][2], const pg8::Unit& u, int wr, int wc, int fr, int fq) const {
        const int row0 = u.pm * pg8::BM + wr * 64 + fr, col0 = u.pn * pg8::BM + wc * 32 + 8 * fq;
        pg8::u32x4 xl[2][4][2];
#pragma unroll
        for (int ai = 0; ai < 2; ++ai)
#pragma unroll
            for (int m = 0; m < 4; ++m)
#pragma unroll
                for (int bj = 0; bj < 2; ++bj) xl[ai][m][bj] = *(const pg8::u32x4*)(xb + (size_t)(row0 + ai * pg8::HALF + m * 16) * 1024 + col0 + bj * pg8::HALF);
#pragma unroll
        for (int ai = 0; ai < 2; ++ai)
#pragma unroll
            for (int m = 0; m < 4; ++m) { const size_t ro = (size_t)(row0 + ai * pg8::HALF + m * 16) * 1024 + col0;
#pragma unroll
                for (int bj = 0; bj < 2; ++bj) { const pg8::u32x4 xv = xl[ai][m][bj]; const pg8::f32x4 v0 = acc[ai][bj][m][0], v1 = acc[ai][bj][m][1];
                    pg8::u32x4 w; w.x = pg8::cvt_pk_bf16(v0[0] + pg8::bf_lo(xv.x), v0[1] + pg8::bf_hi(xv.x)); w.y = pg8::cvt_pk_bf16(v0[2] + pg8::bf_lo(xv.y), v0[3] + pg8::bf_hi(xv.y));
                    w.z = pg8::cvt_pk_bf16(v1[0] + pg8::bf_lo(xv.z), v1[1] + pg8::bf_hi(xv.z)); w.w = pg8::cvt_pk_bf16(v1[2] + pg8::bf_lo(xv.w), v1[3] + pg8::bf_hi(xv.w));
                    *(pg8::u32x4*)(h16 + ro + bj * pg8::HALF) = w; } }
    }
};


struct P1Order {
    static constexpr bool GATHER = false; const int* ptok = nullptr;
    int nM, nN, nwg, G, c, mode; const char* A; const char* Bt; size_t tA, tB;
    __device__ bool next(int i, pg8::Unit& u) const {
        const long L = (long)i * G + c; if (L >= nwg) return false;
        int wgid = (int)L; { const int q = nwg / pg8::NXCD, r = nwg % pg8::NXCD, xcd = wgid % pg8::NXCD, off = wgid / pg8::NXCD; wgid = (xcd < r ? xcd * (q + 1) : r * (q + 1) + (xcd - r) * q) + off; }
        const int nig = pg8::WGM * nN, gid = wgid / nig, fm = gid * pg8::WGM, gsz = (nM - fm) < pg8::WGM ? (nM - fm) : pg8::WGM;
        u.pm = fm + ((wgid % nig) % gsz); const int pc = (wgid % nig) / gsz; u.pn = mode ? 5 + pc : (pc < 5 ? pc : pc + 3);
        u.a = A + (size_t)u.pm * tA; u.b = Bt + (size_t)u.pn * tB; u.bjump = 0; u.aux = 0; u.nvalid = 256; return true;
    }
    __device__ __forceinline__ void a_ready(const pg8::Unit&) const {}
    __device__ __forceinline__ void done(const pg8::Unit&) const {}
};

__device__ __forceinline__ float wave_sum(float v) {
#pragma unroll
    for (int o = 1; o < 64; o <<= 1) v += __shfl_xor(v, o);
    return v;
}
__device__ __forceinline__ void p0_transpose_item(const float* W, int K, int N, bf16* WT, int map, int row_off, int par, const float* gk, LAS float* scr, int item, int lane, unsigned char* WT8 = nullptr, float s8 = 32.f) {
    const int nblk = (N + 31) / 32, kb = item / nblk, nb = item % nblk, k0 = 64 * kb, n0 = 32 * nb;
    const int c4 = lane & 7, rr = lane >> 3; const bool okc = (n0 + 4 * c4) < N;
    f32x4 v[8];
#pragma unroll
    for (int i = 0; i < 8; ++i) { const int kk = i * 8 + rr; v[i] = okc ? *(const f32x4*)(W + (size_t)(k0 + kk) * N + n0 + 4 * c4) : (f32x4){0.f, 0.f, 0.f, 0.f}; }
#pragma unroll
    for (int i = 0; i < 8; ++i) { const int kk = i * 8 + rr; f32x4 x = v[i]; if (gk) x = x * gk[k0 + kk]; *(LAS f32x4*)(scr + kk * 36 + 4 * c4) = x; }
    LDS_WAIT(); asm volatile("" ::: "memory");
    const int c = lane & 7;
#pragma unroll
    for (int j = 0; j < 4; ++j) { const int nl = (lane >> 3) + 8 * j, n = n0 + nl; const LAS float* s = scr + (8 * c) * 36 + nl;
        v4u o; o.x = pk2(s[0 * 36], s[1 * 36]); o.y = pk2(s[2 * 36], s[3 * 36]); o.z = pk2(s[4 * 36], s[5 * 36]); o.w = pk2(s[6 * 36], s[7 * 36]);
        if (n < N) { const int row = (map == 0) ? row_off + n : (map == 1) ? (n < 1864 ? n : n + 184) : row_off + 2 * n + par;
            if (WT) *(GAS v4u*)(WT + (size_t)row * K + k0 + 8 * c) = o;
            if (WT8) { int w0 = __builtin_amdgcn_cvt_pk_fp8_f32(s[0 * 36] * s8, s[1 * 36] * s8, 0, false); w0 = __builtin_amdgcn_cvt_pk_fp8_f32(s[2 * 36] * s8, s[3 * 36] * s8, w0, true);
                int w1 = __builtin_amdgcn_cvt_pk_fp8_f32(s[4 * 36] * s8, s[5 * 36] * s8, 0, false); w1 = __builtin_amdgcn_cvt_pk_fp8_f32(s[6 * 36] * s8, s[7 * 36] * s8, w1, true);
                *(GAS unsigned long long*)(WT8 + (size_t)row * K + k0 + 8 * c) = (unsigned long long)(unsigned)w0 | ((unsigned long long)(unsigned)w1 << 32); } } }
    LDS_WAIT(); asm volatile("" ::: "memory");
}
__device__ __forceinline__ void p0_prologue(Frame& F, const Args& a) {
    LAS float* scr = (LAS float*)(F.lds + RING_OFF + F.wave * 16384);
    const int gw = F.vcu * NWAVES + F.wave, NGW = F.G * NWAVES;
    bf16* Win_t = (bf16*)(F.ws + WS_WIN); bf16* Wkv_t = (bf16*)(F.ws + WS_WKV);
    constexpr int I_IN = 16 * 219, I_KV = 4 * 8, I_SQ = 16 * 32, I_GU = 16 * 8  , I_DN = 4 * 32  ;
    constexpr int NITEMS = I_IN + I_KV + 3 * I_SQ + 16 * (2 * I_GU + I_DN);
    for (int it = gw; it < NITEMS; it += NGW) {
        int r = it;
        if (r < I_IN) { p0_transpose_item(a.in[2], 1024, INW, Win_t, 1, 0, 0, a.in[1], scr, r, F.lane, F.ws + WS_WIN8); continue; } r -= I_IN;
        if (r < I_KV) { p0_transpose_item(a.in[4], 256, 256, Wkv_t, 0, 0, 0, a.in[3], scr, r, F.lane); continue; } r -= I_KV;
        if (r < I_SQ) { p0_transpose_item(a.in[9], 1024, 1024, nullptr, 0, 0, 0, nullptr, scr, r, F.lane, F.ws + WS_WATT8, 32.f); continue; } r -= I_SQ;
        if (r < I_SQ) { p0_transpose_item(a.in[10], 1024, 1024, nullptr, 0, 0, 0, nullptr, scr, r, F.lane, F.ws + WS_WRET8, 32.f); continue; } r -= I_SQ;
        if (r < I_SQ) { p0_transpose_item(a.in[11], 1024, 1024, nullptr, 0, 0, 0, nullptr, scr, r, F.lane, F.ws + WS_WOUT8, 32.f); continue; } r -= I_SQ;
        const int e = r / (2 * I_GU + I_DN), q = r % (2 * I_GU + I_DN);
        if (q < I_GU) p0_transpose_item(a.in[17] + (size_t)e * 1024 * 256, 1024, 256, nullptr, 2, e * 512, 0, nullptr, scr, q, F.lane, F.ws + WS_W18, 32.f);
        else if (q < 2 * I_GU) p0_transpose_item(a.in[18] + (size_t)e * 1024 * 256, 1024, 256, nullptr, 2, e * 512, 1, nullptr, scr, q - I_GU, F.lane, F.ws + WS_W18, 32.f);
        else p0_transpose_item(a.in[19] + (size_t)e * 256 * 1024, 256, 1024, nullptr, 0, 0, 0, nullptr, scr, q - 2 * I_GU, F.lane, F.ws + WS_WD8 + (size_t)e * 1024 * 256, 16.f);
    }
    { const int gt = (F.vcu * NWAVES + F.wave) * 64 + F.lane, NGT = F.G * NWAVES * 64; GAS v4u* z = (GAS v4u*)(Win_t + (size_t)1864 * 1024);
      for (int i = gt; i < 184 * 1024 * 2 / 16; i += NGT) z[i] = (v4u){0u, 0u, 0u, 0u}; }
    { const int gt = (F.vcu * NWAVES + F.wave) * 64 + F.lane, NGT = F.G * NWAVES * 64; bf16* Wh = (bf16*)(F.ws + WS_WR); bf16* Wl = Wh + 32 * 1024;
      for (int i = gt; i < 32 * 1024; i += NGT) { const int n = i >> 10, k = i & 1023; const float wv = n < 4 ? a.in[13][k * 4 + n] : (n < 20 ? a.in[15][k * 16 + (n - 4)] : 0.f);
        const unsigned hb = f2bf(wv); const float hf = __uint_as_float(hb << 16); Wh[i] = (bf16)hb; Wl[i] = (bf16)f2bf(wv - hf); } }
    const float* x = a.in[0] + (size_t)a.tok0 * D; unsigned char* xb8 = a.xb + (size_t)F.ntok * AUX_XB8;
    for (int m = gw; m < F.ntok; m += 2 * NGW) {
        const int m2 = m + NGW; const bool two = m2 < F.ntok;
        const GAS f32x4* xr = (const GAS f32x4*)(x + (size_t)m * D) + F.lane; const GAS f32x4* xr2 = (const GAS f32x4*)(x + (size_t)(two ? m2 : m) * D) + F.lane;
        f32x4 v[4], u[4]; float s = 0.f, s2 = 0.f;
#pragma unroll
        for (int j = 0; j < 4; ++j) { v[j] = xr[64 * j]; u[j] = xr2[64 * j]; }
#pragma unroll
        for (int j = 0; j < 4; ++j) { s += (v[j].x * v[j].x + v[j].y * v[j].y) + (v[j].z * v[j].z + v[j].w * v[j].w); s2 += (u[j].x * u[j].x + u[j].y * u[j].y) + (u[j].z * u[j].z + u[j].w * u[j].w); }
        const float rstd = 1.f / sqrtf(wave_sum(s) * (1.f / D) + EPS), rstd2 = 1.f / sqrtf(wave_sum(s2) * (1.f / D) + EPS);
        if (F.lane == 0) { RSTD1_PTR[m] = rstd; if (two) RSTD1_PTR[m2] = rstd2; }
        GAS unsigned long long* o8 = (GAS unsigned long long*)(a.xb + (size_t)m * D * 2) + F.lane; GAS unsigned* q8 = (GAS unsigned*)(xb8 + (size_t)m * D) + F.lane;
#pragma unroll
        for (int j = 0; j < 4; ++j) { o8[64 * j] = (unsigned long long)pk2(v[j].x, v[j].y) | ((unsigned long long)pk2(v[j].z, v[j].w) << 32);
            int w8 = __builtin_amdgcn_cvt_pk_fp8_f32(v[j].x * rstd, v[j].y * rstd, 0, false); w8 = __builtin_amdgcn_cvt_pk_fp8_f32(v[j].z * rstd, v[j].w * rstd, w8, true); q8[64 * j] = (unsigned)w8; }
        if (two) { GAS unsigned long long* p8 = (GAS unsigned long long*)(a.xb + (size_t)m2 * D * 2) + F.lane; GAS unsigned* r8 = (GAS unsigned*)(xb8 + (size_t)m2 * D) + F.lane;
#pragma unroll
            for (int j = 0; j < 4; ++j) { p8[64 * j] = (unsigned long long)pk2(u[j].x, u[j].y) | ((unsigned long long)pk2(u[j].z, u[j].w) << 32);
                int w8 = __builtin_amdgcn_cvt_pk_fp8_f32(u[j].x * rstd2, u[j].y * rstd2, 0, false); w8 = __builtin_amdgcn_cvt_pk_fp8_f32(u[j].z * rstd2, u[j].w * rstd2, w8, true); r8[64 * j] = (unsigned)w8; } }
    }
}


constexpr size_t AUX_KP = 0, AUX_VV = 256, AUX_KIN = 512, AUX_MASK = 640, AUX_END = 896;
typedef short bf16x8_t __attribute__((ext_vector_type(8)));
typedef float f32x16 __attribute__((ext_vector_type(16)));
__device__ __forceinline__ int crow(int r, int hi) { return (r & 3) + 8 * (r >> 2) + 4 * hi; }
__device__ __forceinline__ float xhalf_sum(float v) { auto rr = __builtin_amdgcn_permlane32_swap(__float_as_uint(v), __float_as_uint(v), false, false); return __uint_as_float(rr[0]) + __uint_as_float(rr[1]); }
__device__ __forceinline__ float sumsq8(bf16x8_t v) { float s = 0.f;
#pragma unroll
    for (int j = 0; j < 8; ++j) { const float f = __uint_as_float((unsigned)(unsigned short)v[j] << 16); s += f * f; } return s; }
__device__ __forceinline__ void p2_post(Frame& F, const Args& a) {
    const int gw = F.vcu * NWAVES + F.wave, NGW = F.G * NWAVES, lane = F.lane, r32 = lane & 31, hi = lane >> 5;
    const size_t nt_ = (size_t)F.ntok;
    const bf16* CKV = (const bf16*)(F.act + nt_ * O_CKV); const bf16* KW = (const bf16*)(F.act + nt_ * O_KW);
    const bf16* Wkv_t = (const bf16*)(F.ws + WS_WKV);
    unsigned char* aux = a.xb + nt_ * 2048;
    bf16* KP = (bf16*)(aux + nt_ * AUX_KP); bf16* VV = (bf16*)(aux + nt_ * AUX_VV); bf16* KIN = (bf16*)(aux + nt_ * AUX_KIN);
    const float* g_q = a.in[5]; const float* g_k = a.in[6]; const float* g_ki = a.in[7];
    constexpr int WP = 528;
    LAS unsigned char* Wl = F.lds + RING_OFF; LAS float* gl = (LAS float*)(F.lds + RING_OFF + 256 * WP);
    for (int i = F.tid; i < 256 * 32; i += NWAVES * 64) { const int n = i >> 5, ch = i & 31; *(LAS v4u*)(Wl + n * WP + ch * 16) = *(const v4u*)(Wkv_t + (size_t)n * 256 + ch * 8); }
    if (F.tid < 128) gl[F.tid] = g_k[F.tid] * g_q[F.tid] * (0.08838834764831845f * 1.4426950408889634f);
    else if (F.tid < 192) gl[F.tid] = g_ki[F.tid - 128];
    __syncthreads();
    const int ntask = 2 * (F.ntok / 32);
    for (int task = gw; task < ntask; task += NGW) {
        const int kind = task & 1, t0 = (task >> 1) * 32;
        const unsigned char* crowp = (const unsigned char*)CKV + (size_t)(t0 + r32) * 256 + hi * 8;
        bf16x8_t bfr[16]; float ss = 0.f;
#pragma unroll
        for (int kk = 0; kk < 16; ++kk) { const unsigned long long c8 = *(const unsigned long long*)(crowp + kk * 16); const int lo = (int)(unsigned)c8, hi32 = (int)(unsigned)(c8 >> 32);
            const auto a_ = __builtin_amdgcn_cvt_pk_f32_fp8(lo, false), b_ = __builtin_amdgcn_cvt_pk_f32_fp8(lo, true), c_ = __builtin_amdgcn_cvt_pk_f32_fp8(hi32, false), d_ = __builtin_amdgcn_cvt_pk_f32_fp8(hi32, true);
            ss += (a_[0] * a_[0] + a_[1] * a_[1]) + (b_[0] * b_[0] + b_[1] * b_[1]) + (c_[0] * c_[0] + c_[1] * c_[1]) + (d_[0] * d_[0] + d_[1] * d_[1]);
            v4u pk; pk.x = pk2(a_[0], a_[1]); pk.y = pk2(b_[0], b_[1]); pk.z = pk2(c_[0], c_[1]); pk.w = pk2(d_[0], d_[1]); bfr[kk] = __builtin_bit_cast(bf16x8_t, pk); }
        ss = xhalf_sum(ss);
        const float rstd = rsqrtf(ss * (1.f / 256.f) + EPS);
        f32x16 acc[4];
#pragma unroll
        for (int nt = 0; nt < 4; ++nt) { acc[nt] = f32x16{};
            const LAS unsigned char* wrow = Wl + (kind * 128 + nt * 32 + r32) * WP + hi * 16;
#pragma unroll
            for (int kk = 0; kk < 16; ++kk) { const bf16x8_t af = *(const LAS bf16x8_t*)(wrow + kk * 32); acc[nt] = __builtin_amdgcn_mfma_f32_32x32x16_bf16(af, bfr[kk], acc[nt], 0, 0, 0); if ((kk & 3) == 3) __builtin_amdgcn_sched_barrier(0); } }
        float sc = rstd;
        if (kind == 0) { float sk = 0.f;
#pragma unroll
            for (int nt = 0; nt < 4; ++nt)
#pragma unroll
                for (int r = 0; r < 16; ++r) { const float v = acc[nt][r] * rstd; sk += v * v; }
            sk = xhalf_sum(sk);
            sc = rstd * rsqrtf(sk * (1.f / 128.f) + EPS); }
        bf16* orow = (kind == 0 ? KP : VV) + (size_t)(t0 + r32) * 128;
#pragma unroll
        for (int nt = 0; nt < 4; ++nt)
#pragma unroll
            for (int g = 0; g < 4; ++g) { const int ch = nt * 32 + 8 * g + 4 * hi; float v[4];
#pragma unroll
                for (int j = 0; j < 4; ++j) { v[j] = acc[nt][4 * g + j] * sc; if (kind == 0) v[j] *= gl[ch + j]; }
                *(unsigned long long*)(orow + ch) = (unsigned long long)pk2(v[0], v[1]) | ((unsigned long long)pk2(v[2], v[3]) << 32); }
        if (kind == 0) {
            const bf16* kr = KW + (size_t)(t0 + r32) * 128 + hi * 32; bf16x8_t kv4[4]; float s2 = 0.f;
#pragma unroll
            for (int j = 0; j < 4; ++j) { kv4[j] = *(const bf16x8_t*)(kr + 8 * j); s2 += sumsq8(kv4[j]); }
            s2 = xhalf_sum(s2);
            const float rk = rsqrtf(s2 * (1.f / 64.f) + EPS);
            bf16* ko = KIN + (size_t)(t0 + r32) * 64 + hi * 32;
#pragma unroll
            for (int j = 0; j < 4; ++j) { float f[8];
#pragma unroll
                for (int e = 0; e < 8; ++e) f[e] = __uint_as_float((unsigned)(unsigned short)kv4[j][e] << 16) * rk * gl[128 + hi * 32 + 8 * j + e];
                v4u o; o.x = pk2(f[0], f[1]); o.y = pk2(f[2], f[3]); o.z = pk2(f[4], f[5]); o.w = pk2(f[6], f[7]);
                *(v4u*)(ko + 8 * j) = o; }
        }
    }
    __syncthreads();
}

typedef float f32x4_t __attribute__((ext_vector_type(4)));
__device__ __forceinline__ unsigned key15_of(float s) { const unsigned short hb = __builtin_bit_cast(unsigned short, (_Float16)s); const unsigned u = (hb & 0x8000u) ? (~(unsigned)hb & 0xffffu) : ((unsigned)hb | 0x8000u); return u >> 1; }
__device__ __forceinline__ unsigned sad4(unsigned x) { return __builtin_amdgcn_sad_u8(x, 0u, 0u); }
__device__ __forceinline__ void p3_merge(LAS unsigned* hist, LAS unsigned short* tot, int w, int g, int q, int& need, int& bsel) {
    __syncthreads();
    const int o = 4 * w + g; unsigned c = 0;
#pragma unroll
    for (int p = 0; p < 32; ++p) { const int tidp = (p >> 2) * 64 + (p & 3) * 16 + q; c += (hist[(o >> 2) * 512 + tidp] >> (8 * (o & 3))) & 0xffu; }
    tot[q * 32 + o] = (unsigned short)c;
    __syncthreads();
    v4u tv[4];
#pragma unroll
    for (int j = 0; j < 4; ++j) tv[j] = *(const LAS v4u*)((const LAS unsigned char*)tot + q * 64 + j * 16);
    int cum = 0, bs = 0, ab = 0; bool found = false;
#pragma unroll
    for (int bin = 31; bin >= 0; --bin) { const unsigned wd = tv[bin >> 3][(bin >> 1) & 3]; const int cc = (int)((bin & 1) ? (wd >> 16) : (wd & 0xffffu));
        if (!found && cum + cc >= need) { bs = bin; ab = cum; found = true; } cum += cc; }
    bsel = bs; need -= ab;
}
__device__ __forceinline__ void p3_index(Frame& F, const Args& a) {
    const int tid = F.tid, lane = F.lane, w = F.wave, q = lane & 15, g = lane >> 4;
    LAS unsigned* keys = (LAS unsigned*)(F.lds + RING_OFF);
    LAS unsigned char* qbuf = F.lds + 65536;
    LAS unsigned* hist = (LAS unsigned*)(F.lds + P3_HIST_OFF);
    LAS unsigned short* tot = (LAS unsigned short*)(F.lds + P3_TOT_OFF);
    LAS unsigned char* Tt = (LAS unsigned char*)(F.lds + P3_T_OFF);
    const size_t nt_ = (size_t)F.ntok;
    const bf16* QI = (const bf16*)(F.act + nt_ * O_QI); const bf16* KW = (const bf16*)(F.act + nt_ * O_KW);
    unsigned char* aux = a.xb + nt_ * 2048;
    const bf16* KIN = (const bf16*)(aux + nt_ * AUX_KIN); unsigned* MASK = (unsigned*)(aux + nt_ * AUX_MASK);
    const int nb = F.ntok / SEQ, nitems = nb * 128; const int bxj = (int)blockIdx.x >> 3;
    const int G = F.G - F.G / 4, c = (bxj - (bxj >> 2) - 1) * 8 + ((int)blockIdx.x & 7);
#define P3_ITEM(k) ((k) * G + (((k) & 1) ? (G - 1 - c) : c))
#define P3_QDMA(it_, buf_) do { const int qg_ = 127 - (it_) / nb, b_ = (it_) % nb; _Pragma("unroll") for (int i_ = 0; i_ < 2; ++i_) { const int row_ = w * 2 + i_; \
        const char* src_ = (const char*)(QI + ((size_t)b_ * SEQ + qg_ * 16 + row_) * 512) + ((lane ^ (row_ & 15)) * 16); \
        __builtin_amdgcn_global_load_lds((const unsigned*)src_, (LAS unsigned*)(qbuf + (buf_) * 16384 + row_ * 1024), 16, 0, 0); } } while (0)
    const int nround = (nitems + G - 1) / G;
    if (P3_ITEM(0) < nitems) P3_QDMA(P3_ITEM(0), 0);
    v4u wvn = (v4u){0u, 0u, 0u, 0u};
    if (P3_ITEM(0) < nitems) { const int it0 = P3_ITEM(0); wvn = *(const v4u*)(KW + ((size_t)(it0 % nb) * SEQ + (127 - it0 / nb) * 16 + q) * 128 + 64); }
    for (int k = 0; k < nround; ++k) {
        const int it = P3_ITEM(k); if (it >= nitems) break;
        const int qg = 127 - it / nb, b = it % nb, q0 = qg * 16, qme = q0 + q;
        unsigned* Mb = MASK + (size_t)b * 64 * 2048;
        const int kb_hi = ((qg >> 3) + 1) << 2, nkb = (qg >> 1) + 1;
        asm volatile("s_waitcnt vmcnt(0) lgkmcnt(0)\n\ts_barrier" ::: "memory");
        const v4u wv = wvn;
        { const int itn = P3_ITEM(k + 1); if (k + 1 < nround && itn < nitems) { P3_QDMA(itn, (k + 1) & 1); wvn = *(const v4u*)(KW + ((size_t)(itn % nb) * SEQ + (127 - itn / nb) * 16 + q) * 128 + 64); } }
        if (qg < 16) {
            if (tid < kb_hi * 16) { const int kb = tid >> 4, qq = q0 + (tid & 15), nbits = qq - kb * 32 + 1; Mb[kb * 2048 + qq] = nbits >= 32 ? 0xffffffffu : (nbits <= 0 ? 0u : ((1u << nbits) - 1u)); }
            continue;
        }
        float wq[8];
        { const float cc = 0.35355339059327373f * 0.125f;
          wq[0] = pg8::bf_lo(wv.x) * cc; wq[1] = pg8::bf_hi(wv.x) * cc; wq[2] = pg8::bf_lo(wv.y) * cc; wq[3] = pg8::bf_hi(wv.y) * cc; wq[4] = pg8::bf_lo(wv.z) * cc; wq[5] = pg8::bf_hi(wv.z) * cc; wq[6] = pg8::bf_lo(wv.w) * cc; wq[7] = pg8::bf_hi(wv.w) * cc; }
        bf16x8_t qfr[8][2], qlin[2];
        { const LAS unsigned char* qrow = qbuf + (k & 1) * 16384 + q * 1024;
#pragma unroll
          for (int h = 0; h < 8; ++h)
#pragma unroll
            for (int ks = 0; ks < 2; ++ks) qfr[h][ks] = *(const LAS bf16x8_t*)(qrow + (((h * 8 + ks * 4 + g) ^ q) * 16)); }
#pragma unroll
        for (int ks = 0; ks < 2; ++ks) { float f[8];
#pragma unroll
            for (int j = 0; j < 8; ++j) { float s = 0.f;
#pragma unroll
                for (int h = 0; h < 8; ++h) s += wq[h] * __uint_as_float((unsigned)(unsigned short)qfr[h][ks][j] << 16);
                f[j] = s; }
            v4u o; o.x = pk2(f[0], f[1]); o.y = pk2(f[2], f[3]); o.z = pk2(f[4], f[5]); o.w = pk2(f[6], f[7]); qlin[ks] = __builtin_bit_cast(bf16x8_t, o); }
#pragma unroll
        for (int i = 0; i < 8; ++i) hist[i * 512 + tid] = 0u;
        const bf16* kbase = KIN + ((size_t)b * SEQ + q) * 64 + g * 8;
        bf16x8_t afr[2][2], afn[2][2];
#pragma unroll
        for (int t = 0; t < 2; ++t)
#pragma unroll
            for (int ks = 0; ks < 2; ++ks) afn[t][ks] = *(const bf16x8_t*)(kbase + (size_t)(w * 32 + t * 16) * 64 + ks * 32);
        for (int s = 0, kb = w; kb < nkb; ++s, kb += 8) {
            const bool diag = (kb == nkb - 1);
#pragma unroll
            for (int t = 0; t < 2; ++t)
#pragma unroll
                for (int ks = 0; ks < 2; ++ks) afr[t][ks] = afn[t][ks];
            if (kb + 8 < nkb) {
#pragma unroll
                for (int t = 0; t < 2; ++t)
#pragma unroll
                    for (int ks = 0; ks < 2; ++ks) afn[t][ks] = *(const bf16x8_t*)(kbase + (size_t)((kb + 8) * 32 + t * 16) * 64 + ks * 32); }
#pragma unroll
            for (int t = 0; t < 2; ++t) {
                f32x4_t sacc = f32x4_t{};
#pragma unroll
                for (int ks = 0; ks < 2; ++ks) sacc = __builtin_amdgcn_mfma_f32_16x16x32_bf16(afr[t][ks], qlin[ks], sacc, 0, 0, 0);
#pragma unroll
                for (int h = 0; h < 8; ++h) { f32x4_t d = f32x4_t{};
#pragma unroll
                    for (int ks = 0; ks < 2; ++ks) d = __builtin_amdgcn_mfma_f32_16x16x32_bf16(afr[t][ks], qfr[h][ks], d, 0, 0, 0);
#pragma unroll
                    for (int r = 0; r < 4; ++r) sacc[r] = fmaf(fabsf(d[r]), wq[h], sacc[r]); }
#pragma unroll
                for (int i = 0; i < 2; ++i) { unsigned k2[2];
#pragma unroll
                    for (int e = 0; e < 2; ++e) { const int r = 2 * i + e; unsigned kk_ = key15_of(sacc[r]); if (diag && kb * 32 + t * 16 + 4 * g + r > qme) kk_ = 0u; k2[e] = kk_;
                        const unsigned dg = kk_ >> 10; (void)__hip_atomic_fetch_add((LAS unsigned*)&hist[(dg >> 2) * 512 + tid], 1u << ((dg & 3u) * 8u), __ATOMIC_RELAXED, __HIP_MEMORY_SCOPE_WORKGROUP); }
                    keys[(s * 4 + t * 2 + i) * 512 + tid] = k2[0] | (k2[1] << 16); }
            }
        }
        int need = 256, bsel;
        p3_merge(hist, tot, w, g, q, need, bsel);
        unsigned prefix = (unsigned)bsel;
#pragma unroll
        for (int pass = 0; pass < 2; ++pass) {
            const int sh_hi = pass == 0 ? 10 : 5, sh = pass == 0 ? 5 : 0;
#pragma unroll
            for (int i = 0; i < 8; ++i) hist[i * 512 + tid] = 0u;
#pragma unroll
            for (int s = 0; s < 8; ++s) if (w + 8 * s < nkb) {
#pragma unroll
                for (int i = 0; i < 4; ++i) { const unsigned d2 = keys[(s * 4 + i) * 512 + tid];
#pragma unroll
                    for (int e = 0; e < 2; ++e) { const unsigned kk_ = e ? (d2 >> 16) : (d2 & 0xffffu);
                        if ((kk_ >> sh_hi) == prefix) { const unsigned dg = (kk_ >> sh) & 31u; (void)__hip_atomic_fetch_add((LAS unsigned*)&hist[(dg >> 2) * 512 + tid], 1u << ((dg & 3u) * 8u), __ATOMIC_RELAXED, __HIP_MEMORY_SCOPE_WORKGROUP); } } } }
            p3_merge(hist, tot, w, g, q, need, bsel);
            prefix = (prefix << 5) | (unsigned)bsel;
        }
        const unsigned tau = prefix; const int need_eq = need;
        unsigned gtw[8], eqw[8];
#pragma unroll
        for (int s = 0; s < 8; ++s) { const int kb = w + 8 * s; gtw[s] = 0u; eqw[s] = 0u;
            if (kb < nkb) { unsigned gg = 0u, qq = 0u;
#pragma unroll
                for (int i = 0; i < 4; ++i) { const unsigned d2 = keys[(s * 4 + i) * 512 + tid];
#pragma unroll
                    for (int e = 0; e < 2; ++e) { const unsigned kk_ = e ? (d2 >> 16) : (d2 & 0xffffu); const int bit = (i >> 1) * 16 + 4 * g + (i & 1) * 2 + e;
                        gg |= (kk_ > tau ? 1u : 0u) << bit; qq |= (kk_ == tau ? 1u : 0u) << bit; } }
                gg |= (unsigned)__shfl_xor((int)gg, 16); gg |= (unsigned)__shfl_xor((int)gg, 32); qq |= (unsigned)__shfl_xor((int)qq, 16); qq |= (unsigned)__shfl_xor((int)qq, 32);
                gtw[s] = gg; eqw[s] = qq;
                if (g == 0) Tt[q * 64 + kb] = (unsigned char)__builtin_popcount(qq); } }
        __syncthreads();
        { unsigned run = 0u;
#pragma unroll
          for (int s = 0; s < 8; ++s) { const int kb = w + 8 * s;
            if (kb < nkb) { const unsigned g0 = *(const LAS unsigned*)(Tt + q * 64 + 8 * s), g1 = *(const LAS unsigned*)(Tt + q * 64 + 8 * s + 4);
                const unsigned m0 = w >= 4 ? g0 : (w == 0 ? 0u : (g0 & ((1u << (8 * w)) - 1u))), m1 = w > 4 ? (g1 & ((1u << (8 * (w - 4))) - 1u)) : 0u;
                const int pre = (int)(run + sad4(m0) + sad4(m1)), m = need_eq - pre, pc = __builtin_popcount(eqw[s]);
                unsigned se = eqw[s];
                if (m < pc) { se = 0u; unsigned x = eqw[s]; for (int i = 0; i < m; ++i) { const unsigned bb = x & (0u - x); se |= bb; x ^= bb; } }
                if (g == 0) Mb[kb * 2048 + qme] = gtw[s] | se;
                run += sad4(g0) + sad4(g1); } } }
        if (tid < (kb_hi - nkb) * 16) Mb[(nkb + (tid >> 4)) * 2048 + q0 + (tid & 15)] = 0u;
    }
    asm volatile("s_waitcnt vmcnt(0) lgkmcnt(0)" ::: "memory");
    __syncthreads();
#undef P3_ITEM
#undef P3_QDMA
}

namespace att {
using bf16x8 = __attribute__((ext_vector_type(8))) short;
using s16x4  = __attribute__((ext_vector_type(4))) short;
using u32x4  = __attribute__((ext_vector_type(4))) unsigned;
constexpr int KVBLK = 64;
constexpr size_t SHM_V = KVBLK * 128 * 2, SHM_K = KVBLK * 128 * 2;
constexpr int OFF_WS = 65536, OFF_MK = 65536 + 2048, OFF_Q = 65536 + 2048 + 8192, QPITCH = 272;
constexpr float THR2 = 11.5f;
#define KSWZ(row, colB) ((row) * 256 + ((colB) ^ (((row) & 7) << 4)))
#define SBAR() __builtin_amdgcn_sched_barrier(0)
__device__ __forceinline__ unsigned cvtpk(float lo, float hi) { unsigned r; asm volatile("v_cvt_pk_bf16_f32 %0, %1, %2" : "=v"(r) : "v"(lo), "v"(hi)); return r; }
__device__ __forceinline__ float msk(float p, unsigned w, int bit) { const int m = __builtin_amdgcn_sbfe((int)w, bit, 1); return __uint_as_float((__float_as_uint(p) & (unsigned)m) | (0xff800000u & ~(unsigned)m)); }
__device__ __forceinline__ void partialSM(f32x16& p0, f32x16& p1, unsigned w0, unsigned w1, float& m_reg, float& mn, float& alpha) {
#pragma unroll
  for (int r = 0; r < 16; ++r) { const int bit = (r & 3) + 8 * (r >> 2); p0[r] = msk(p0[r], w0, bit); p1[r] = msk(p1[r], w1, bit); }
  float pmax = p0[0];
#pragma unroll
  for (int r = 1; r < 16; ++r) pmax = fmaxf(pmax, p0[r]);
#pragma unroll
  for (int r = 0; r < 16; ++r) pmax = fmaxf(pmax, p1[r]);
  { auto rr = __builtin_amdgcn_permlane32_swap(__float_as_uint(pmax), __float_as_uint(pmax), false, false); pmax = fmaxf(__uint_as_float(rr[0]), __uint_as_float(rr[1])); }
  if (__builtin_expect(__all(pmax - m_reg <= THR2), 1)) { mn = m_reg; alpha = 1.f; }
  else { mn = fmaxf(m_reg, pmax); alpha = __builtin_amdgcn_exp2f(m_reg - mn); m_reg = mn; }
#pragma unroll
  for (int r = 0; r < 16; ++r) { p0[r] -= mn; p1[r] -= mn; }
#pragma unroll
  for (int r = 0; r < 16; ++r) p0[r] = __builtin_amdgcn_exp2f(p0[r]);
}
__device__ __forceinline__ void finishSM(f32x16& p0, f32x16& p1, float alpha, float& l_reg, bf16x8& pa0, bf16x8& pa1, bf16x8& pa2, bf16x8& pa3) {
#pragma unroll
  for (int r = 0; r < 16; ++r) p1[r] = __builtin_amdgcn_exp2f(p1[r]);
  float ps = 0;
#pragma unroll
  for (int r = 0; r < 16; ++r) ps += p0[r];
#pragma unroll
  for (int r = 0; r < 16; ++r) ps += p1[r];
  { auto rr = __builtin_amdgcn_permlane32_swap(__float_as_uint(ps), __float_as_uint(ps), false, false); ps = __uint_as_float(rr[0]) + __uint_as_float(rr[1]); }
  l_reg = l_reg * alpha + ps;
#define PK4(P, BASE, OUT) do { unsigned a0 = cvtpk(P[BASE + 0], P[BASE + 1]), a1 = cvtpk(P[BASE + 2], P[BASE + 3]);   \
    unsigned b0 = cvtpk(P[BASE + 4], P[BASE + 5]), b1 = cvtpk(P[BASE + 6], P[BASE + 7]);                              \
    auto r0 = __builtin_amdgcn_permlane32_swap(a0, b0, false, false); auto r1 = __builtin_amdgcn_permlane32_swap(a1, b1, false, false); \
    u32x4 w = {r0[0], r1[0], r0[1], r1[1]}; OUT = *reinterpret_cast<bf16x8*>(&w); } while (0)
  PK4(p0, 0, pa0); PK4(p0, 8, pa1); PK4(p1, 0, pa2); PK4(p1, 8, pa3);
#undef PK4
}
__device__ __forceinline__ void qkt(f32x16& p0, f32x16& p1, const char* Ks, const char* qrow, const float (&bo)[16], float kb0, float kb1, int r32, int hi) {
#pragma unroll
  for (int r = 0; r < 16; ++r) { p0[r] = bo[r] + kb0; p1[r] = bo[r] + kb1; }
#pragma unroll
  for (int d0 = 0; d0 < 8; ++d0) { const int cb = (d0 * 16 + hi * 8) * 2;
    const bf16x8 b0 = *reinterpret_cast<const bf16x8*>(Ks + KSWZ(r32, cb));
    const bf16x8 b1 = *reinterpret_cast<const bf16x8*>(Ks + KSWZ(32 + r32, cb));
    const bf16x8 qf = *reinterpret_cast<const bf16x8*>(qrow + d0 * 32);
    p0 = __builtin_amdgcn_mfma_f32_32x32x16_bf16(b0, qf, p0, 0, 0, 0);
    p1 = __builtin_amdgcn_mfma_f32_32x32x16_bf16(b1, qf, p1, 0, 0, 0); }
}
__device__ __forceinline__ int v_st(int k, int c) { const int kk = (k & ~0xC) | ((k & 4) << 1) | ((k & 8) >> 1); return ((kk >> 3) * 4 + (c >> 5)) * 512 + ((kk & 7) * 32 + (c & 31)) * 2; }
__device__ __forceinline__ int v_rd_base(int lane) { return ((lane & 3) << 3) | (((lane >> 2) & 3) << 6) | (((lane >> 4) & 1) << 5) | (((lane >> 5) & 1) << 8); }
constexpr int v_rd_off(int d0, int ks, int half) { return d0 * 512 + ks * 4096 + half * 2048; }
template <int OFF> __device__ __forceinline__ s16x4 tr_read(int vb) { s16x4 r; asm volatile("ds_read_b64_tr_b16 %0, %1 offset:%2" : "=&v"(r) : "v"(vb), "i"(OFF) : "memory"); return r; }
template <int D0> __device__ __forceinline__ void pv_one(f32x16& od, int vb, bf16x8 pa0, bf16x8 pa1, bf16x8 pa2, bf16x8 pa3) {
  const s16x4 l0 = tr_read<v_rd_off(D0, 0, 0)>(vb), h0 = tr_read<v_rd_off(D0, 0, 1)>(vb), l1 = tr_read<v_rd_off(D0, 1, 0)>(vb), h1 = tr_read<v_rd_off(D0, 1, 1)>(vb);
  const s16x4 l2 = tr_read<v_rd_off(D0, 2, 0)>(vb), h2 = tr_read<v_rd_off(D0, 2, 1)>(vb), l3 = tr_read<v_rd_off(D0, 3, 0)>(vb), h3 = tr_read<v_rd_off(D0, 3, 1)>(vb);
  asm volatile("s_waitcnt lgkmcnt(0)" ::: "memory"); SBAR();
#define PK(L, H) (bf16x8){L[0], L[1], L[2], L[3], H[0], H[1], H[2], H[3]}
  od = __builtin_amdgcn_mfma_f32_32x32x16_bf16(pa0, PK(l0, h0), od, 0, 0, 0);
  od = __builtin_amdgcn_mfma_f32_32x32x16_bf16(pa1, PK(l1, h1), od, 0, 0, 0);
  od = __builtin_amdgcn_mfma_f32_32x32x16_bf16(pa2, PK(l2, h2), od, 0, 0, 0);
  od = __builtin_amdgcn_mfma_f32_32x32x16_bf16(pa3, PK(l3, h3), od, 0, 0, 0);
#undef PK
}
__device__ __forceinline__ void pv_d0(f32x16* o, int vb, bf16x8 pa0, bf16x8 pa1, bf16x8 pa2, bf16x8 pa3) {
  pv_one<0>(o[0], vb, pa0, pa1, pa2, pa3); pv_one<1>(o[1], vb, pa0, pa1, pa2, pa3); pv_one<2>(o[2], vb, pa0, pa1, pa2, pa3); pv_one<3>(o[3], vb, pa0, pa1, pa2, pa3);
}
__device__ __forceinline__ void attn_item(const bf16* __restrict__ Qb, const bf16* __restrict__ Kh, const bf16* __restrict__ Vh, const unsigned* __restrict__ Mq, bf16* __restrict__ Ob, int NT, char* lds, LAS unsigned char* ldsL) {
  const int tid = threadIdx.x, wid = __builtin_amdgcn_readfirstlane(tid >> 6), lane = tid & 63, r32 = lane & 31, hi = lane >> 5;
  float* ws = (float*)(lds + OFF_WS) + wid * 64; float* li_l = ws; float* al_l = ws + 32;
  unsigned* mk = (unsigned*)(lds + OFF_MK);
  unsigned soff[4];
#pragma unroll
  for (int i = 0; i < 4; ++i) { const int pc = (wid & 3) * 4 + i;
    if (wid < 4) { const int row = pc * 4 + (lane >> 4), cb = (lane & 15) * 16; soff[i] = (unsigned)(row * 256 + (cb ^ ((row & 7) << 4))); }
    else { const int L = pc * 1024 + lane * 16, st = L >> 9, wi = L & 511, kk = (st >> 2) * 8 + (wi >> 6), c = (st & 3) * 32 + ((wi & 63) >> 1), k = (kk & ~0xC) | ((kk & 4) << 1) | ((kk & 8) >> 1);
           soff[i] = (unsigned)(k * 256 + c * 2); } }
  const char* gsrc = (const char*)(wid < 4 ? Kh : Vh);
  const unsigned ldst = (unsigned)((wid < 4 ? 0 : 16384) + (wid & 3) * 4096);
#define DMA_TILE(t, slot) do { _Pragma("unroll") for (int i_ = 0; i_ < 4; ++i_) \
    __builtin_amdgcn_global_load_lds((const unsigned*)(gsrc + (size_t)(t) * (64 * 256) + soff[i_]), (LAS unsigned*)(ldsL + (slot) * 32768 + ldst + i_ * 1024), 16, 0, 0); } while (0)
  DMA_TILE(0, 0);
  float m_reg = 0.f, l_reg = 0; f32x16 o[4] = {}; bf16x8 qr[8];
  { const unsigned char* Qw = (const unsigned char*)Qb + (size_t)r32 * 1024 + wid * 128 + hi * 8; float ss = 0.f; unsigned long long q8[8];
#pragma unroll
    for (int d0 = 0; d0 < 8; ++d0) q8[d0] = *reinterpret_cast<const unsigned long long*>(Qw + d0 * 16);
    unsigned mv[4];
#pragma unroll
    for (int i = 0; i < 4; ++i) { const int idx = tid + 512 * i; mv[i] = idx < NT * 64 ? Mq[(size_t)(idx >> 5) * 2048 + (idx & 31)] : 0u; }
#pragma unroll
    for (int i = 0; i < 4; ++i) { const int idx = tid + 512 * i; if (idx < NT * 64) mk[idx] = mv[i]; }
    float qf[8][8];
#pragma unroll
    for (int d0 = 0; d0 < 8; ++d0) { const int lo = (int)(unsigned)q8[d0], hi32 = (int)(unsigned)(q8[d0] >> 32);
      const auto a_ = __builtin_amdgcn_cvt_pk_f32_fp8(lo, false), b_ = __builtin_amdgcn_cvt_pk_f32_fp8(lo, true), c_ = __builtin_amdgcn_cvt_pk_f32_fp8(hi32, false), d_ = __builtin_amdgcn_cvt_pk_f32_fp8(hi32, true);
      qf[d0][0] = a_[0]; qf[d0][1] = a_[1]; qf[d0][2] = b_[0]; qf[d0][3] = b_[1]; qf[d0][4] = c_[0]; qf[d0][5] = c_[1]; qf[d0][6] = d_[0]; qf[d0][7] = d_[1];
#pragma unroll
      for (int j = 0; j < 8; ++j) ss += qf[d0][j] * qf[d0][j]; }
    ss = xhalf_sum(ss); const float rq = rsqrtf(ss * (1.f / 128.f) + EPS);
#pragma unroll
    for (int d0 = 0; d0 < 8; ++d0) { u32x4 w = {cvtpk(qf[d0][0] * rq, qf[d0][1] * rq), cvtpk(qf[d0][2] * rq, qf[d0][3] * rq), cvtpk(qf[d0][4] * rq, qf[d0][5] * rq), cvtpk(qf[d0][6] * rq, qf[d0][7] * rq)}; qr[d0] = *reinterpret_cast<bf16x8*>(&w); } }
  const float slope2 = __builtin_amdgcn_exp2f(-(float)(wid + 1)) * 1.4426950408889634f;
  float bo[16];
#pragma unroll
  for (int r = 0; r < 16; ++r) bo[r] = __uint_as_float(__builtin_amdgcn_readfirstlane(__float_as_uint(slope2 * (float)((r & 3) + 8 * (r >> 2)))));
  const float hoff = slope2 * (float)(4 * hi);
  const int vb0 = (int)(uintptr_t)(lds + 16384) + v_rd_base(lane);
  asm volatile("s_waitcnt vmcnt(0) lgkmcnt(0)\n\ts_barrier" ::: "memory");
  for (int j = 0; j < NT; ++j) {
    const int sl = j & 1;
    if (j + 1 < NT) DMA_TILE(j + 1, sl ^ 1);
    const char* Ks = lds + sl * 32768;
    const unsigned w0 = mk[(2 * j) * 32 + r32] >> (4 * hi), w1 = mk[(2 * j + 1) * 32 + r32] >> (4 * hi);
    f32x16 p0, p1;
    { const float kb0 = slope2 * (float)(j * 64) + hoff - m_reg, kb1 = kb0 + slope2 * 32.f;
#pragma unroll
      for (int r = 0; r < 16; ++r) { p0[r] = bo[r] + kb0; p1[r] = bo[r] + kb1; }
      bf16x8 ka = *reinterpret_cast<const bf16x8*>(Ks + KSWZ(r32, hi * 16)), kb = *reinterpret_cast<const bf16x8*>(Ks + KSWZ(32 + r32, hi * 16));
#pragma unroll
      for (int d0 = 0; d0 < 8; ++d0) { bf16x8 na = ka, nb = kb;
        if (d0 < 7) { const int cb = ((d0 + 1) * 16 + hi * 8) * 2; na = *reinterpret_cast<const bf16x8*>(Ks + KSWZ(r32, cb)); nb = *reinterpret_cast<const bf16x8*>(Ks + KSWZ(32 + r32, cb)); }
        SBAR();
        p0 = __builtin_amdgcn_mfma_f32_32x32x16_bf16(ka, qr[d0], p0, 0, 0, 0);
        p1 = __builtin_amdgcn_mfma_f32_32x32x16_bf16(kb, qr[d0], p1, 0, 0, 0);
        SBAR();
        ka = na; kb = nb; } }
    float alpha; bf16x8 pa0, pa1, pa2, pa3;
    {
#pragma unroll
      for (int r = 0; r < 16; ++r) { const int bit = (r & 3) + 8 * (r >> 2); p0[r] = msk(p0[r], w0, bit); p1[r] = msk(p1[r], w1, bit); }
      float pmax = fmaxf(p0[0], p1[0]);
#pragma unroll
      for (int r = 1; r < 16; ++r) pmax = fmaxf(fmaxf(pmax, p0[r]), p1[r]);
      { auto rr = __builtin_amdgcn_permlane32_swap(__float_as_uint(pmax), __float_as_uint(pmax), false, false); pmax = fmaxf(__uint_as_float(rr[0]), __uint_as_float(rr[1])); }
      alpha = 1.f;
      if (__builtin_expect(!__all(pmax <= THR2), 0)) {
        const float dl = fmaxf(pmax, 0.f); m_reg += dl; alpha = __builtin_amdgcn_exp2f(-dl);
#pragma unroll
        for (int r = 0; r < 16; ++r) { p0[r] -= dl; p1[r] -= dl; } }
      float ps = 0.f;
#pragma unroll
      for (int r = 0; r < 16; ++r) { p0[r] = __builtin_amdgcn_exp2f(p0[r]); p1[r] = __builtin_amdgcn_exp2f(p1[r]); ps += p0[r] + p1[r]; }
      { auto rr = __builtin_amdgcn_permlane32_swap(__float_as_uint(ps), __float_as_uint(ps), false, false); ps = __uint_as_float(rr[0]) + __uint_as_float(rr[1]); }
      l_reg = l_reg * alpha + ps;
#define PK4(P, BASE, OUT) do { unsigned a0 = cvtpk(P[BASE + 0], P[BASE + 1]), a1 = cvtpk(P[BASE + 2], P[BASE + 3]);   \
    unsigned b0 = cvtpk(P[BASE + 4], P[BASE + 5]), b1 = cvtpk(P[BASE + 6], P[BASE + 7]);                              \
    auto r0 = __builtin_amdgcn_permlane32_swap(a0, b0, false, false); auto r1 = __builtin_amdgcn_permlane32_swap(a1, b1, false, false); \
    u32x4 w = {r0[0], r1[0], r0[1], r1[1]}; OUT = *reinterpret_cast<bf16x8*>(&w); } while (0)
      PK4(p0, 0, pa0); PK4(p0, 8, pa1); PK4(p1, 0, pa2); PK4(p1, 8, pa3);
#undef PK4
      if (__any(alpha < 1.f)) { if (hi == 0) al_l[r32] = alpha; asm volatile("s_waitcnt lgkmcnt(0)" ::: "memory");
#pragma unroll
        for (int d = 0; d < 4; ++d)
#pragma unroll
          for (int r = 0; r < 16; ++r) o[d][r] *= al_l[crow(r, hi)]; }
    }
    { const int vb = vb0 + sl * 32768;
      s16x4 lA[4], hA[4], lB[4], hB[4];
#define VREADS(L_, H_, D0) do { L_[0] = tr_read<v_rd_off(D0, 0, 0)>(vb); H_[0] = tr_read<v_rd_off(D0, 0, 1)>(vb); L_[1] = tr_read<v_rd_off(D0, 1, 0)>(vb); H_[1] = tr_read<v_rd_off(D0, 1, 1)>(vb); \
      L_[2] = tr_read<v_rd_off(D0, 2, 0)>(vb); H_[2] = tr_read<v_rd_off(D0, 2, 1)>(vb); L_[3] = tr_read<v_rd_off(D0, 3, 0)>(vb); H_[3] = tr_read<v_rd_off(D0, 3, 1)>(vb); } while (0)
#define PK(L, H) (bf16x8){L[0], L[1], L[2], L[3], H[0], H[1], H[2], H[3]}
#define VMMA(OD, L_, H_) do { OD = __builtin_amdgcn_mfma_f32_32x32x16_bf16(pa0, PK(L_[0], H_[0]), OD, 0, 0, 0); OD = __builtin_amdgcn_mfma_f32_32x32x16_bf16(pa1, PK(L_[1], H_[1]), OD, 0, 0, 0); \
      OD = __builtin_amdgcn_mfma_f32_32x32x16_bf16(pa2, PK(L_[2], H_[2]), OD, 0, 0, 0); OD = __builtin_amdgcn_mfma_f32_32x32x16_bf16(pa3, PK(L_[3], H_[3]), OD, 0, 0, 0); } while (0)
#define VWAIT(N, L_, H_) do { asm volatile("s_waitcnt lgkmcnt(" #N ")" : "+v"(L_[0]), "+v"(L_[1]), "+v"(L_[2]), "+v"(L_[3]), "+v"(H_[0]), "+v"(H_[1]), "+v"(H_[2]), "+v"(H_[3]) :: "memory"); SBAR(); } while (0)
      VREADS(lA, hA, 0); VREADS(lB, hB, 1);
      VWAIT(8, lA, hA); VMMA(o[0], lA, hA);
      VREADS(lA, hA, 2);
      VWAIT(8, lB, hB); VMMA(o[1], lB, hB);
      VREADS(lB, hB, 3);
      VWAIT(8, lA, hA); VMMA(o[2], lA, hA);
      VWAIT(0, lB, hB); VMMA(o[3], lB, hB);
#undef VREADS
#undef PK
#undef VMMA
#undef VWAIT
    }
    asm volatile("s_waitcnt vmcnt(0) lgkmcnt(0)\n\ts_barrier" ::: "memory");
  }
  if (hi == 0) li_l[r32] = l_reg; asm volatile("s_waitcnt lgkmcnt(0)" ::: "memory");
  float rli[16];
#pragma unroll
  for (int r = 0; r < 16; ++r) rli[r] = __builtin_amdgcn_rcpf(li_l[crow(r, hi)]);
  unsigned char* stg = (unsigned char*)(lds + wid * 4096);
#pragma unroll
  for (int r = 0; r < 16; ++r) { const int orow = crow(r, hi); const float sc16 = rli[r] * 16.f;
#pragma unroll
    for (int d0 = 0; d0 < 4; ++d0) stg[orow * 128 + d0 * 32 + r32] = (unsigned char)__builtin_amdgcn_cvt_pk_fp8_f32(o[d0][r] * sc16, 0.f, 0, false); }
  asm volatile("s_waitcnt lgkmcnt(0)" ::: "memory");
#pragma unroll
  for (int i = 0; i < 4; ++i) { const int row = i * 8 + (lane >> 3), ch = lane & 7; const u32x4 v = *(const u32x4*)(stg + row * 128 + ch * 16);
    *(u32x4*)((unsigned char*)Ob + (size_t)row * 1024 + wid * 128 + ch * 16) = v; }
#undef DMA_TILE
}
#undef KSWZ
#undef SBAR
}


namespace ret {
using bf16x8 = __attribute__((ext_vector_type(8))) short;
using s16x4  = __attribute__((ext_vector_type(4))) short;
using u32x4  = __attribute__((ext_vector_type(4))) unsigned;
using u32x2  = __attribute__((ext_vector_type(2))) unsigned;
constexpr int C = 64, QP = 272, KPI = 272, VP = 576;
constexpr int OFF_Q = 0, OFF_K = 17408, OFF_V = 34816, OFF_ST = 71680, OFF_Y = 75776;
typedef float f32x2_t __attribute__((ext_vector_type(2))); typedef __bf16 bf16x2_t __attribute__((ext_vector_type(2)));
__device__ __forceinline__ unsigned cvtpk(float lo, float hi) { const f32x2_t v = {lo, hi}; const bf16x2_t b = __builtin_convertvector(v, bf16x2_t); return __builtin_bit_cast(unsigned, b); }
template <int OFF> __device__ __forceinline__ s16x4 trr(int base) { s16x4 r; asm volatile("ds_read_b64_tr_b16 %0, %1 offset:%2" : "=&v"(r) : "v"(base), "i"(OFF) : "memory"); return r; }
__device__ __forceinline__ bf16x8 pk8(const f32x16& x, int s) { u32x4 w = {cvtpk(x[8 * s + 0], x[8 * s + 1]), cvtpk(x[8 * s + 2], x[8 * s + 3]), cvtpk(x[8 * s + 4], x[8 * s + 5]), cvtpk(x[8 * s + 6], x[8 * s + 7])}; return *reinterpret_cast<bf16x8*>(&w); }
__device__ __forceinline__ float silu_(float x) { return x * __builtin_amdgcn_rcpf(1.f + __builtin_amdgcn_exp2f(-1.4426950408889634f * x)); }
__device__ __forceinline__ void ret_item(int b, int h, const unsigned char* __restrict__ RQ, const unsigned char* __restrict__ RK, const unsigned char* __restrict__ RV, const unsigned char* __restrict__ RG, unsigned char* A2F8, const float* __restrict__ gnorm, char* lds, int c0, int c1, float* state) {
  const int tid = threadIdx.x, w = __builtin_amdgcn_readfirstlane(tid >> 6), lane = tid & 63, r32 = lane & 31, hi = lane >> 5;
  const float lg = __log2f(1.f - exp2f(-5.f - (float)h)), gC = exp2f(64.f * lg);
  char* Qs = lds + OFF_Q; char* Ks = lds + OFF_K; char* Vs = lds + OFF_V; float* st = (float*)(lds + OFF_ST); char* Ys = lds + OFF_Y;
  f32x16 S[4] = {};
  if (c0 > 0) {
#pragma unroll
    for (int dt = 0; dt < 4; ++dt)
#pragma unroll
      for (int r = 0; r < 16; ++r) S[dt][r] = state[(dt * 16 + r) * 512 + tid]; }
  const unsigned voffQ = (unsigned)(((tid >> 4) * 512 + (tid & 15) * 8) * 2), voffV = (unsigned)(((tid >> 5) * 1024 + (tid & 31) * 8) * 2);
  const int trq = (lane & 15) >> 2, trp = lane & 3, trg = (lane >> 4) & 1;
  const int vtb = (int)(uintptr_t)(lds + OFF_V) + (4 * hi + trq) * VP + (32 * w + 16 * trg + 4 * trp) * 2, ktb = (int)(uintptr_t)(lds + OFF_K) + (4 * hi + trq) * KPI + (16 * trg + 4 * trp) * 2;
  u32x2 pq[2], pk[2], pv[4];
  const unsigned voffQ8 = (unsigned)((tid >> 4) * 512 + (tid & 15) * 8), voffV8 = voffV >> 1;
#define RET_LOAD(cc) do { const size_t t0_ = (size_t)b * SEQ + (size_t)(cc) * C; const unsigned char* qb_ = RQ + t0_ * 512 + h * 128; const unsigned char* kb_ = RK + t0_ * 512 + h * 128; const unsigned char* vb_ = RV + t0_ * 1024 + h * 256; \
    _Pragma("unroll") for (int i = 0; i < 2; ++i) { pq[i] = *(const u32x2*)(qb_ + voffQ8 + i * 16384); pk[i] = *(const u32x2*)(kb_ + voffQ8 + i * 16384); } \
    _Pragma("unroll") for (int i = 0; i < 4; ++i) pv[i] = *(const u32x2*)(vb_ + voffV8 + i * 16384); } while (0)
#define RET_F8(src_, f_, out_) do { const auto a_ = __builtin_amdgcn_cvt_pk_f32_fp8((int)(src_).x, false), b_ = __builtin_amdgcn_cvt_pk_f32_fp8((int)(src_).x, true), c_ = __builtin_amdgcn_cvt_pk_f32_fp8((int)(src_).y, false), d_ = __builtin_amdgcn_cvt_pk_f32_fp8((int)(src_).y, true); \
    out_.x = cvtpk(a_[0] * (f_), a_[1] * (f_)); out_.y = cvtpk(b_[0] * (f_), b_[1] * (f_)); out_.z = cvtpk(c_[0] * (f_), c_[1] * (f_)); out_.w = cvtpk(d_[0] * (f_), d_[1] * (f_)); } while (0)
#define RET_STAGE() do { \
    _Pragma("unroll") for (int i = 0; i < 2; ++i) { const int row = (tid >> 4) + 32 * i, ch = tid & 15; \
      u32x4 qo; RET_F8(pq[i], 1.f, qo); *(u32x4*)(Qs + row * QP + ch * 16) = qo; \
      const float f = exp2f(lg * (float)(C - 1 - row)) * 0.08838834764831845f; \
      u32x4 ko; RET_F8(pk[i], f, ko); *(u32x4*)(Ks + row * KPI + ch * 16) = ko; } \
    _Pragma("unroll") for (int i = 0; i < 4; ++i) { const int row = (tid >> 5) + 16 * i, ch = tid & 31; u32x4 vo; RET_F8(pv[i], 1.f, vo); *(u32x4*)(Vs + row * VP + ch * 16) = vo; } } while (0)
  RET_LOAD(c0);
  __syncthreads();
  RET_STAGE();
  if (c0 + 1 < c1) RET_LOAD(c0 + 1);
  __syncthreads();
  for (int c = c0; c < c1; ++c) {
    const size_t tok0 = (size_t)b * SEQ + (size_t)c * C;
    f32x16 ot[2] = {};
#pragma unroll
    for (int dt = 0; dt < 4; ++dt) {
#pragma unroll
      for (int s = 0; s < 2; ++s) { const bf16x8 af = pk8(S[dt], s);
#pragma unroll
        for (int nt = 0; nt < 2; ++nt) { const char* qp = Qs + (32 * nt + r32) * QP + (32 * dt + 16 * s + 4 * hi) * 2;
          const u32x2 lo = *(const u32x2*)qp, hi8 = *(const u32x2*)(qp + 16); const u32x4 bw = {lo.x, lo.y, hi8.x, hi8.y};
          ot[nt] = __builtin_amdgcn_mfma_f32_32x32x16_bf16(af, *reinterpret_cast<const bf16x8*>(&bw), ot[nt], 0, 0, 0); } }
      __builtin_amdgcn_sched_barrier(0); }
#pragma unroll
    for (int nt = 0; nt < 2; ++nt)
#pragma unroll
      for (int r = 0; r < 16; ++r) ot[nt][r] *= gC;
    __builtin_amdgcn_sched_barrier(0);
    bf16x8 vfr[4];
    { s16x4 vlo[4], vhi[4];
      vlo[0] = trr<0 * 16 * VP>(vtb); vhi[0] = trr<0 * 16 * VP + 8 * VP>(vtb); vlo[1] = trr<1 * 16 * VP>(vtb); vhi[1] = trr<1 * 16 * VP + 8 * VP>(vtb);
      vlo[2] = trr<2 * 16 * VP>(vtb); vhi[2] = trr<2 * 16 * VP + 8 * VP>(vtb); vlo[3] = trr<3 * 16 * VP>(vtb); vhi[3] = trr<3 * 16 * VP + 8 * VP>(vtb);
      asm volatile("s_waitcnt lgkmcnt(0)" : "+v"(vlo[0]), "+v"(vlo[1]), "+v"(vlo[2]), "+v"(vlo[3]), "+v"(vhi[0]), "+v"(vhi[1]), "+v"(vhi[2]), "+v"(vhi[3]) :: "memory"); __builtin_amdgcn_sched_barrier(0);
#pragma unroll
      for (int ks = 0; ks < 4; ++ks) vfr[ks] = (bf16x8){vlo[ks][0], vlo[ks][1], vlo[ks][2], vlo[ks][3], vhi[ks][0], vhi[ks][1], vhi[ks][2], vhi[ks][3]}; }
#pragma unroll
    for (int nt = 0; nt < 2; ++nt)
#pragma unroll
      for (int jt = 0; jt <= nt; ++jt) { f32x16 pt = {};
#pragma unroll
        for (int kk = 0; kk < 8; ++kk) { const bf16x8 ka = *(const bf16x8*)(Ks + (32 * jt + r32) * KPI + (16 * kk + 8 * hi) * 2), qb = *(const bf16x8*)(Qs + (32 * nt + r32) * QP + (16 * kk + 8 * hi) * 2);
          pt = __builtin_amdgcn_mfma_f32_32x32x16_bf16(ka, qb, pt, 0, 0, 0); }
        if (jt == nt) {
#pragma unroll
          for (int r = 0; r < 16; ++r) if (crow(r, hi) > r32) pt[r] = 0.f; }
#pragma unroll
        for (int s = 0; s < 2; ++s) ot[nt] = __builtin_amdgcn_mfma_f32_32x32x16_bf16(vfr[2 * jt + s], pk8(pt, s), ot[nt], 0, 0, 0);
        __builtin_amdgcn_sched_barrier(0); }
#pragma unroll
    for (int dt = 0; dt < 4; ++dt) {
#pragma unroll
      for (int r = 0; r < 16; ++r) S[dt][r] *= gC;
      s16x4 kl[4], kh[4];
      kl[0] = trr<0 * 16 * KPI>(ktb + dt * 64); kh[0] = trr<0 * 16 * KPI + 8 * KPI>(ktb + dt * 64); kl[1] = trr<1 * 16 * KPI>(ktb + dt * 64); kh[1] = trr<1 * 16 * KPI + 8 * KPI>(ktb + dt * 64);
      kl[2] = trr<2 * 16 * KPI>(ktb + dt * 64); kh[2] = trr<2 * 16 * KPI + 8 * KPI>(ktb + dt * 64); kl[3] = trr<3 * 16 * KPI>(ktb + dt * 64); kh[3] = trr<3 * 16 * KPI + 8 * KPI>(ktb + dt * 64);
      asm volatile("s_waitcnt lgkmcnt(0)" : "+v"(kl[0]), "+v"(kl[1]), "+v"(kl[2]), "+v"(kl[3]), "+v"(kh[0]), "+v"(kh[1]), "+v"(kh[2]), "+v"(kh[3]) :: "memory"); __builtin_amdgcn_sched_barrier(0);
#pragma unroll
      for (int ks = 0; ks < 4; ++ks) S[dt] = __builtin_amdgcn_mfma_f32_32x32x16_bf16((bf16x8){kl[ks][0], kl[ks][1], kl[ks][2], kl[ks][3], kh[ks][0], kh[ks][1], kh[ks][2], kh[ks][3]}, vfr[ks], S[dt], 0, 0, 0);
      __builtin_amdgcn_sched_barrier(0); }
    u32x2 gt4[4];
    { const unsigned char* gb_ = RG + tok0 * 1024 + h * 256;
#pragma unroll
      for (int i = 0; i < 4; ++i) gt4[i] = *(const u32x2*)(gb_ + (voffV >> 1) + i * 16384); }
#pragma unroll
    for (int nt = 0; nt < 2; ++nt) { const float rs = exp2f(lg * (float)(32 * nt + r32 + 1 - C)); float s1 = 0.f, s2 = 0.f;
#pragma unroll
      for (int r = 0; r < 16; ++r) { ot[nt][r] *= rs; s1 += ot[nt][r]; s2 += ot[nt][r] * ot[nt][r]; }
      s1 = xhalf_sum(s1); s2 = xhalf_sum(s2);
      if (hi == 0) { st[(w * 64 + 32 * nt + r32) * 2] = s1; st[(w * 64 + 32 * nt + r32) * 2 + 1] = s2; } }
    __syncthreads();
    if (c + 1 < c1) { RET_STAGE(); if (c + 2 < c1) RET_LOAD(c + 2); }
#pragma unroll
    for (int nt = 0; nt < 2; ++nt) { float s1 = 0.f, s2 = 0.f;
#pragma unroll
      for (int ww = 0; ww < 8; ++ww) { s1 += st[(ww * 64 + 32 * nt + r32) * 2]; s2 += st[(ww * 64 + 32 * nt + r32) * 2 + 1]; }
      const float mu = s1 * (1.f / 256.f), var = fmaxf(s2 * (1.f / 256.f) - mu * mu, 0.f), rstd = rsqrtf(var + EPS);
#pragma unroll
      for (int g = 0; g < 4; ++g) { float y[4];
#pragma unroll
        for (int j = 0; j < 4; ++j) y[j] = (ot[nt][4 * g + j] - mu) * rstd * gnorm[h * 256 + 32 * w + 8 * g + 4 * hi + j];
        const u32x2 o2 = {cvtpk(y[0], y[1]), cvtpk(y[2], y[3])};
        *(u32x2*)(Ys + (32 * nt + r32) * VP + (32 * w + 8 * g + 4 * hi) * 2) = o2; } }
    __syncthreads();
    { unsigned char* ob_ = A2F8 + tok0 * 1024 + h * 256;
#pragma unroll
      for (int i = 0; i < 4; ++i) { const int row = (tid >> 5) + 16 * i, ch = tid & 31;
        const u32x4 yv = *(const u32x4*)(Ys + row * VP + ch * 16); const u32x2 gt = gt4[i];
        const auto g01 = __builtin_amdgcn_cvt_pk_f32_fp8((int)gt.x, false), g23 = __builtin_amdgcn_cvt_pk_f32_fp8((int)gt.x, true), g45 = __builtin_amdgcn_cvt_pk_f32_fp8((int)gt.y, false), g67 = __builtin_amdgcn_cvt_pk_f32_fp8((int)gt.y, true);
        int w0 = __builtin_amdgcn_cvt_pk_fp8_f32(pg8::bf_lo(yv.x) * silu_(g01[0]), pg8::bf_hi(yv.x) * silu_(g01[1]), 0, false); w0 = __builtin_amdgcn_cvt_pk_fp8_f32(pg8::bf_lo(yv.y) * silu_(g23[0]), pg8::bf_hi(yv.y) * silu_(g23[1]), w0, true);
        int w1 = __builtin_amdgcn_cvt_pk_fp8_f32(pg8::bf_lo(yv.z) * silu_(g45[0]), pg8::bf_hi(yv.z) * silu_(g45[1]), 0, false); w1 = __builtin_amdgcn_cvt_pk_fp8_f32(pg8::bf_lo(yv.w) * silu_(g67[0]), pg8::bf_hi(yv.w) * silu_(g67[1]), w1, true);
        *(unsigned long long*)(ob_ + (size_t)row * 1024 + ch * 8) = (unsigned long long)(unsigned)w0 | ((unsigned long long)(unsigned)w1 << 32); } }
  }
  if (c1 < SEQ / C) {
#pragma unroll
    for (int dt = 0; dt < 4; ++dt)
#pragma unroll
      for (int r = 0; r < 16; ++r) state[(dt * 16 + r) * 512 + tid] = S[dt][r]; }
  __syncthreads();
#undef RET_LOAD
#undef RET_STAGE
#undef RET_F8
}
}


constexpr int RET_SPLIT = 28;
__device__ __forceinline__ int ret_wg_index(const Frame& F) { const int bx = (int)blockIdx.x, j = bx >> 3; return (j & 3) == 0 ? ((j >> 2) * 8 + (bx & 7)) : -1; }
__device__ __forceinline__ void p4_attn(Frame& F, const Args& a, unsigned char* lds_generic) {
    const size_t nt_ = (size_t)F.ntok;
    const bf16* QA = (const bf16*)(F.act + nt_ * O_QA); bf16* ATT = (bf16*)(F.act + nt_ * O_QA);
    unsigned char* aux = a.xb + nt_ * 2048;
    const bf16* KP = (const bf16*)(aux + nt_ * AUX_KP); const bf16* VV = (const bf16*)(aux + nt_ * AUX_VV); const unsigned* MASK = (const unsigned*)(aux + nt_ * AUX_MASK);
    volatile LAS unsigned* MISC = (volatile LAS unsigned*)(F.lds + MISC_OFF);
    unsigned* qctr = (unsigned*)(F.ws + WS_CTL) + CW_Q4;
    const unsigned char* RQ = F.act + nt_ * O_RQ; const unsigned char* RK = F.act + nt_ * O_RK; const unsigned char* RV = F.act + nt_ * O_RV; const unsigned char* RG = F.act + nt_ * O_RG;
    const int nb = F.ntok / SEQ, nret = nb * 4, nitems = nb * 64;
    { const int ri = ret_wg_index(F); if (ri >= 0 && ri < nret && RET_SPLIT < SEQ / 64)
        ret::ret_item(ri >> 2, ri & 3, RQ, RK, RV, RG, A2F8_PTR, a.in[8], (char*)lds_generic, RET_SPLIT, SEQ / 64, RSTATE_PTR + (size_t)ri * 32768); }
    __syncthreads(); if (F.tid == 0) MISC[0] = atomicAdd(qctr, 1u); __syncthreads();
    int it = (int)MISC[0];
    while (it < nitems) {
        unsigned nxt_ = 0u; if (F.tid == 0) nxt_ = atomicAdd(qctr, 1u);
        const int qb = 63 - it / nb, b = it % nb, NT = (qb >> 1) + 1;
        const size_t row0 = (size_t)b * SEQ + qb * 32;
        att::attn_item((const bf16*)((const unsigned char*)QA + row0 * 1024), KP + (size_t)b * SEQ * 128, VV + (size_t)b * SEQ * 128, MASK + (size_t)b * 64 * 2048 + qb * 32, (bf16*)((unsigned char*)ATT + row0 * 1024), NT, (char*)lds_generic, F.lds);
        __syncthreads(); if (F.tid == 0) MISC[0] = nxt_; __syncthreads();
        it = (int)MISC[0];
    }
}


__device__ __forceinline__ void p7_router(Frame& F, const Args& a) {
    const int lane = F.lane, r32 = lane & 31, hi = lane >> 5, tid = F.tid;
    unsigned char* mo = F.act; unsigned char* N2 = mo + MO_N2; unsigned char* meta = mo + MO_META;
    (void)meta; int* LTOK = (int*)(mo + MO_LIST); float* LRS = (float*)(mo + MO_LIST) + 24 * LIST_CAP; float* LCL = LRS + 24 * LIST_CAP; float* LCH = LCL + 24 * LIST_CAP;
    const bf16* Wh = (const bf16*)(F.ws + WS_WR); const bf16* Wl = Wh + 32 * 1024;
    const float* g2 = a.in[12]; const float* b_gr = a.in[14]; const float* b_er = a.in[16];
    const bf16* hbase = (const bf16*)(F.act + MO_H16);
    unsigned* gcnt = (unsigned*)(F.ws + WS_CTL) + CW_MOE;
    LAS unsigned* lcnt = (LAS unsigned*)(F.lds + RING_OFF);
    if (tid < 64) lcnt[tid] = 0u;
    LAS unsigned char* Wlds = F.lds + 20480; LAS float* g2l = (LAS float*)(F.lds + 20480 + 98304);
    for (int i = tid; i < 2 * 24 * 128; i += NWAVES * 64) { const int c = i & 127, n = (i >> 7) % 24, hl = i / (24 * 128);
        *(LAS v4u*)(Wlds + (hl * 24 + n) * 2048 + ((c ^ (n & 15)) * 16)) = *(const v4u*)((hl ? Wl : Wh) + (size_t)n * 1024 + c * 8); }
    for (int i = tid; i < 256; i += NWAVES * 64) *(LAS f32x4*)(g2l + i * 4) = *(const f32x4*)(g2 + i * 4);
    __syncthreads();
    const int ntasks = F.ntok / 32, tpw = ntasks / F.G;
    const int tw = F.wave & 3, kh = F.wave >> 2;
    const bool have = tw < tpw; const int t = (F.vcu * tpw + tw) * 32 + r32;
    LAS float* xch = (LAS float*)(F.lds + RING_OFF + 1024);
    int bucket = 0, posl = 0; float clo = 0.f, chi = 0.f, rstd = 0.f;
    f32x16 acc = f32x16{}; float ss = 0.f;
    if (have) {
        const bf16* hrow = hbase + (size_t)t * D + hi * 8 + kh * 512; unsigned char* nrow = N2 + (size_t)t * D + hi * 8 + kh * 512;
        const LAS float* g2k = g2l + kh * 512 + hi * 8; const int rr = r32 < 24 ? r32 : r32 - 8;
        const LAS unsigned char* whk = Wlds + rr * 2048; const LAS unsigned char* wlk = Wlds + (24 + rr) * 2048; const int c0 = kh * 64 + hi, sw = rr & 15;
#pragma unroll 8
        for (int kk = 0; kk < 32; ++kk) {
            const v4u hv = *(const v4u*)(hrow + kk * 16); const f32x4 a0 = {pg8::bf_lo(hv.x), pg8::bf_hi(hv.x), pg8::bf_lo(hv.y), pg8::bf_hi(hv.y)}, a1 = {pg8::bf_lo(hv.z), pg8::bf_hi(hv.z), pg8::bf_lo(hv.w), pg8::bf_hi(hv.w)};
            const f32x4 q0 = *(const LAS f32x4*)(g2k + kk * 16), q1 = *(const LAS f32x4*)(g2k + kk * 16 + 4);
            ss += (a0.x * a0.x + a0.y * a0.y) + (a0.z * a0.z + a0.w * a0.w) + (a1.x * a1.x + a1.y * a1.y) + (a1.z * a1.z + a1.w * a1.w);
            const float x[8] = {a0.x * q0.x, a0.y * q0.y, a0.z * q0.z, a0.w * q0.w, a1.x * q1.x, a1.y * q1.y, a1.z * q1.z, a1.w * q1.w};
            unsigned hb[8]; float lo[8];
#pragma unroll
            for (int j = 0; j < 8; ++j) { hb[j] = f2bf(x[j]); lo[j] = x[j] - __uint_as_float(hb[j] << 16); }
            v4u xh; xh.x = hb[0] | (hb[1] << 16); xh.y = hb[2] | (hb[3] << 16); xh.z = hb[4] | (hb[5] << 16); xh.w = hb[6] | (hb[7] << 16);
            v4u xl; xl.x = pk2(lo[0], lo[1]); xl.y = pk2(lo[2], lo[3]); xl.z = pk2(lo[4], lo[5]); xl.w = pk2(lo[6], lo[7]);
            { int w0 = __builtin_amdgcn_cvt_pk_fp8_f32(x[0], x[1], 0, false); w0 = __builtin_amdgcn_cvt_pk_fp8_f32(x[2], x[3], w0, true); int w1 = __builtin_amdgcn_cvt_pk_fp8_f32(x[4], x[5], 0, false); w1 = __builtin_amdgcn_cvt_pk_fp8_f32(x[6], x[7], w1, true);
              *(unsigned long long*)(nrow + kk * 16) = (unsigned long long)(unsigned)w0 | ((unsigned long long)(unsigned)w1 << 32); }
            const int co = ((c0 + kk * 2) ^ sw) * 16; const bf16x8_t wh = *(const LAS bf16x8_t*)(whk + co), wl = *(const LAS bf16x8_t*)(wlk + co);
            const bf16x8_t bh = __builtin_bit_cast(bf16x8_t, xh), bl = __builtin_bit_cast(bf16x8_t, xl);
            acc = __builtin_amdgcn_mfma_f32_32x32x16_bf16(wh, bh, acc, 0, 0, 0);
            acc = __builtin_amdgcn_mfma_f32_32x32x16_bf16(wh, bl, acc, 0, 0, 0);
            acc = __builtin_amdgcn_mfma_f32_32x32x16_bf16(wl, bh, acc, 0, 0, 0);
        }
        if (kh == 1) {
#pragma unroll
            for (int r = 0; r < 16; ++r) xch[(tw * 17 + r) * 64 + lane] = acc[r];
            xch[(tw * 17 + 16) * 64 + lane] = ss; }
    }
    __syncthreads();
    if (have && kh == 0) {
#pragma unroll
        for (int r = 0; r < 16; ++r) acc[r] += xch[(tw * 17 + r) * 64 + lane];
        ss += xch[(tw * 17 + 16) * 64 + lane];
        ss = xhalf_sum(ss); rstd = rsqrtf(ss * (1.f / D) + EPS);
        float L[24];
#pragma unroll
        for (int r = 0; r < 12; ++r) { const float v = acc[r]; auto rr = __builtin_amdgcn_permlane32_swap(__float_as_uint(v), __float_as_uint(v), false, false);
            L[(r & 3) + 8 * (r >> 2)] = __uint_as_float(rr[0]); L[(r & 3) + 8 * (r >> 2) + 4] = __uint_as_float(rr[1]); }
        float gl[4];
#pragma unroll
        for (int i = 0; i < 4; ++i) gl[i] = L[i] * rstd + b_gr[i];
        int g = 0; float gm = gl[0];
#pragma unroll
        for (int i = 1; i < 4; ++i) if (gl[i] > gm) { gm = gl[i]; g = i; }
        float se = 0.f;
#pragma unroll
        for (int i = 0; i < 4; ++i) se += __expf(gl[i] - gm);
        const float gw = 1.f / se;
        float el[4];
#pragma unroll
        for (int i = 0; i < 4; ++i) { const float l0 = L[4 + i], l1 = L[8 + i], l2 = L[12 + i], l3 = L[16 + i]; const float lv = g == 0 ? l0 : (g == 1 ? l1 : (g == 2 ? l2 : l3));
            const float b0 = b_er[i], b1 = b_er[4 + i], b2 = b_er[8 + i], b3 = b_er[12 + i]; el[i] = lv * rstd + (g == 0 ? b0 : (g == 1 ? b1 : (g == 2 ? b2 : b3))); }
        int i1 = 0; float v1 = el[0];
#pragma unroll
        for (int i = 1; i < 4; ++i) if (el[i] > v1) { v1 = el[i]; i1 = i; }
        int i2 = -1; float v2 = 0.f;
#pragma unroll
        for (int i = 0; i < 4; ++i) if (i != i1 && (i2 < 0 || el[i] > v2)) { v2 = el[i]; i2 = i; }
        const float e2 = __expf(v2 - v1), p1 = gw / (1.f + e2), p2 = gw * e2 / (1.f + e2);
        const int lo_ = i1 < i2 ? i1 : i2, hi_ = i1 < i2 ? i2 : i1;
        const int pair = lo_ == 0 ? (hi_ - 1) : (lo_ == 1 ? (hi_ + 1) : 5);
        bucket = g * 6 + pair; clo = i1 < i2 ? p1 : p2; chi = i1 < i2 ? p2 : p1;
        if (hi == 0) posl = (int)__hip_atomic_fetch_add(&lcnt[bucket], 1u, __ATOMIC_RELAXED, __HIP_MEMORY_SCOPE_WORKGROUP);
    }
    __syncthreads();
    if (tid < 24) lcnt[32 + tid] = atomicAdd(gcnt + tid, lcnt[tid]);
    __syncthreads();
    if (have && kh == 0 && hi == 0) { const int li = bucket * LIST_CAP + (int)lcnt[32 + bucket] + posl; LTOK[li] = t; LRS[li] = rstd; LCL[li] = clo; LCH[li] = chi; }
}
__device__ __forceinline__ int moe_tiles(const unsigned* gcnt, int* rowstart  ) { int rs = 0;
    for (int b = 0; b < 24; ++b) { rowstart[b] = rs; rs += (int)((gcnt[b] + 255u) & ~255u); } rowstart[24] = rs; return rs >> 8; }
template <bool GATHER_> struct MoeOrder {
    static constexpr bool GATHER = GATHER_; const int* ptok;
    int ntile, G, c; const char* A; size_t tA; const char* W; int mode; const LAS unsigned char* tb; size_t rowB;
    __device__ bool next(int i, pg8::Unit& u) const {
        const long L = (long)i * G + c; if (L >= (long)ntile * 4) return false;
        u.pm = (int)(L >> 2); u.pn = (int)(L & 3); u.a = GATHER_ ? A : A + (size_t)u.pm * tA;
        const int bk = tb[u.pm], g = bk / 6, pr = bk % 6; { const LAS int* t24 = (const LAS int*)(tb + 512); const int rs_ = t24[bk], cn_ = t24[24 + bk], left = cn_ - (u.pm * 256 - rs_); u.aux = bk * LIST_CAP - rs_; u.nvalid = left < 0 ? 0 : (left > 256 ? 256 : left); } const int lo = pr < 3 ? 0 : (pr < 5 ? 1 : 2), hi = pr < 3 ? pr + 1 : (pr < 5 ? pr - 1 : 3);
        const int elo = g * 4 + lo, ehi = g * 4 + hi;
        if (mode == 1) { const int e = u.pn < 2 ? elo : ehi; u.b = W + ((size_t)e * 512 + (size_t)(u.pn & 1) * 256) * rowB; u.bjump = 0; }
        else { u.b = W + ((size_t)elo * 1024 + (size_t)u.pn * 256) * rowB; u.bjump = (long)(ehi - elo) * 1024 * (long)rowB - (long)rowB; }
        return true;
    }
    __device__ __forceinline__ void a_ready(const pg8::Unit&) const {}
    __device__ __forceinline__ void done(const pg8::Unit&) const {}
};
__device__ __forceinline__ float silu_f(float x) { return x * __builtin_amdgcn_rcpf(1.f + __builtin_amdgcn_exp2f(-1.4426950408889634f * x)); }
struct EpiMoe1 {
    static constexpr bool PERM = true, AFTER_DRAIN = false;
    unsigned char* ACT; const float* PRS; const float* PCL; const float* PCH;
    __device__ __forceinline__ void operator()(const pg8::f32x4 (&acc)[2][2][4][2], const pg8::Unit& u, int wr, int wc, int fr, int fq) const {
        const int row0 = u.pm * pg8::BM + wr * 64 + fr, slot = u.pn >> 1, fcol0 = slot * 256 + (u.pn & 1) * 128 + wc * 16 + 4 * fq; const float* PC = slot ? PCH : PCL;
#pragma unroll
        for (int ai = 0; ai < 2; ++ai)
#pragma unroll
            for (int m = 0; m < 4; ++m) { const int row = row0 + ai * pg8::HALF + m * 16; const bool ok = (wr * 64 + fr + ai * pg8::HALF + m * 16) < u.nvalid; const float rs = ok ? PRS[u.aux + row] : 0.f, cw = ok ? PC[u.aux + row] * 16.f : 0.f; unsigned char* rowp = ACT + (size_t)row * 512 + fcol0;
#pragma unroll
                for (int bj = 0; bj < 2; ++bj) { const pg8::f32x4 v0 = acc[ai][bj][m][0], v1 = acc[ai][bj][m][1];
                    const float a0 = silu_f(v0[0] * rs) * (v0[1] * rs) * cw, a1 = silu_f(v0[2] * rs) * (v0[3] * rs) * cw, a2 = silu_f(v1[0] * rs) * (v1[1] * rs) * cw, a3 = silu_f(v1[2] * rs) * (v1[3] * rs) * cw;
                    int w = __builtin_amdgcn_cvt_pk_fp8_f32(a0, a1, 0, false); w = __builtin_amdgcn_cvt_pk_fp8_f32(a2, a3, w, true); *(int*)(rowp + bj * 64) = w; } }
    }
};
struct EpiMoe2 {
    static constexpr bool PERM = true, AFTER_DRAIN = false;
    float* out; const pg8::bf16_t* h16; const int* PTOK;
    __device__ __forceinline__ void operator()(const pg8::f32x4 (&acc)[2][2][4][2], const pg8::Unit& u, int wr, int wc, int fr, int fq) const {
        const int row0 = u.pm * pg8::BM + wr * 64 + fr, col0 = u.pn * pg8::BM + wc * 32 + 8 * fq;
        int tk[2][4]; pg8::u32x4 hl[2][4][2];
#pragma unroll
        for (int ai = 0; ai < 2; ++ai)
#pragma unroll
            for (int m = 0; m < 4; ++m) { const int rr_ = wr * 64 + fr + ai * pg8::HALF + m * 16; tk[ai][m] = rr_ < u.nvalid ? PTOK[u.aux + row0 + ai * pg8::HALF + m * 16] : -1; }
#pragma unroll
        for (int ai = 0; ai < 2; ++ai)
#pragma unroll
            for (int m = 0; m < 4; ++m) { const pg8::bf16_t* hp = h16 + (size_t)(tk[ai][m] < 0 ? 0 : tk[ai][m]) * 1024 + col0;
#pragma unroll
                for (int bj = 0; bj < 2; ++bj) hl[ai][m][bj] = *(const pg8::u32x4*)(hp + bj * pg8::HALF); }
#pragma unroll
        for (int ai = 0; ai < 2; ++ai)
#pragma unroll
            for (int m = 0; m < 4; ++m) if (tk[ai][m] >= 0) { float* rowp = out + (size_t)tk[ai][m] * 1024 + col0;
#pragma unroll
                for (int bj = 0; bj < 2; ++bj) { const pg8::u32x4 hv = hl[ai][m][bj];
                    const pg8::f32x4 h0 = {pg8::bf_lo(hv.x), pg8::bf_hi(hv.x), pg8::bf_lo(hv.y), pg8::bf_hi(hv.y)}, h1 = {pg8::bf_lo(hv.z), pg8::bf_hi(hv.z), pg8::bf_lo(hv.w), pg8::bf_hi(hv.w)};
                    *(pg8::f32x4*)(rowp + bj * pg8::HALF) = h0 + acc[ai][bj][m][0]; *(pg8::f32x4*)(rowp + bj * pg8::HALF + 4) = h1 + acc[ai][bj][m][1]; } }
    }
};
__device__ __forceinline__ int moe_setup(Frame& F, LAS unsigned char* tb) {
    const unsigned* gcnt = (const unsigned*)(F.ws + WS_CTL) + CW_MOE;
    LAS int* nt_ = (LAS int*)(tb + 256);
    __syncthreads();
    if (F.tid == 0) { LAS int* t24 = (LAS int*)(tb + 512); int tl = 0; for (int b = 0; b < 24; ++b) { const int n = (int)((gcnt[b] + 255u) >> 8); t24[b] = tl * 256; t24[24 + b] = (int)gcnt[b]; for (int i = 0; i < n; ++i) tb[tl + i] = (unsigned char)b; tl += n; } nt_[0] = tl; }
    __syncthreads();
    return nt_[0];
}

__global__ void __launch_bounds__(NWAVES * 64, 2) mk_fwd(Args args) {
    extern __shared__ __attribute__((aligned(16))) unsigned char lds[];
    Frame F;
    F.lds = (LAS unsigned char*)lds;
    F.tid = threadIdx.x; F.lane = F.tid & 63; F.wave = __builtin_amdgcn_readfirstlane(F.tid >> 6);
    F.G = gridDim.x; { const int bx = blockIdx.x; F.vcu = (F.G % 8 == 0) ? (bx % 8) * (F.G / 8) + bx / 8 : bx; }
    F.ntok = args.ntok; F.ws = args.ws; F.act = args.ws + WS_ACT; F.xbp = args.xb;
    const int lo = args.ph_lo, hi = args.ph_hi;
    cooperative_groups::grid_group grid = cooperative_groups::this_grid();
    volatile LAS unsigned* MISCW = (volatile LAS unsigned*)(F.lds + MISC_OFF);
    for (int u = F.tid; u < (LDS_BYTES - LDSCTL_OFF) / 4; u += NWAVES * 64) ((LAS unsigned*)(F.lds + LDSCTL_OFF))[u] = 0u;
    __syncthreads();
    XcdBarrier bar = xcd_barrier_post((unsigned*)(F.ws + WS_CTL) + CW_BAR, MISCW + 8);
#define IN(k) (lo <= (k) && (k) < hi)
#define SEAM(k) do { if (IN(k) && IN((k) + 1)) { xcd_barrier(bar); } } while (0)
    if (IN(0)) { p0_prologue(F, args); }
    SEAM(0);
    if (IN(1)) {
        EpiProj E{F.act, (size_t)F.ntok, RSTD1_PTR};
        { pg8::Gemm g{512, 512, 512, 8};
          P1Order S; S.nM = F.ntok / 256; S.nN = 25; S.nwg = S.nM * 25; S.G = F.G; S.c = (int)blockIdx.x; S.mode = 0; S.A = (const char*)(args.xb + (size_t)F.ntok * AUX_XB8); S.Bt = (const char*)(F.ws + WS_WIN8); S.tA = (size_t)256 * 1024; S.tB = (size_t)256 * 1024;
          pg8::gemm_phase<EpiProj, P1Order, true, true, true>(F.lds + RING_OFF, g, S, E); }
        { pg8::Gemm g{1024, 1024, 1024, 16};
          P1Order S; S.nM = F.ntok / 256; S.nN = 3; S.nwg = S.nM * 3; S.G = F.G; S.c = ((int)blockIdx.x + F.G / 2) % F.G; S.mode = 1; S.A = (const char*)args.xb; S.Bt = (const char*)(F.ws + WS_WIN); S.tA = (size_t)256 * 2048; S.tB = (size_t)256 * 2048;
          pg8::gemm_phase<EpiProj, P1Order, true, true, false>(F.lds + RING_OFF, g, S, E); }
    }
    SEAM(1);
    if (IN(2)) { p2_post(F, args); }
    SEAM(2);
    if (IN(3)) {
        const int ri = ret_wg_index(F), nret = (F.ntok / SEQ) * 4;
        if (ri < 0) p3_index(F, args);
        else if (ri < nret) { const size_t nt_ = (size_t)F.ntok;
            ret::ret_item(ri >> 2, ri & 3, F.act + nt_ * O_RQ, F.act + nt_ * O_RK, F.act + nt_ * O_RV, F.act + nt_ * O_RG, A2F8_PTR, args.in[8], (char*)lds, 0, RET_SPLIT, RSTATE_PTR + (size_t)ri * 32768); }
    }
    SEAM(3);
    if (IN(4)) { p4_attn(F, args, lds); }
    SEAM(4);
    if (IN(5)) {
        const size_t nt_ = (size_t)F.ntok;
        const unsigned char* GA8 = F.act + nt_ * O_GA; const unsigned char* GR8 = F.act + nt_ * O_GR; unsigned char* TMP = F.act + nt_ * O_RV;
        pg8::Gemm g{512, 512, 512, 8, 122, 123};
        GateOrder S; S.S0.init(F.ntok, 1024, F.G, (int)blockIdx.x, F.act + nt_ * O_QA, 512, F.ws + WS_WATT8, 512); S.A1 = (const char*)A2F8_PTR; S.B1 = (const char*)(F.ws + WS_WRET8);
        EpiGateFused E{GA8, GR8, F.act + nt_ * O_MIX8}; (void)TMP;
        pg8::gemm_phase<EpiGateFused, GateOrder, true, true, true>(F.lds + RING_OFF, g, S, E);
    }
    SEAM(5);
    if (IN(6)) {
        pg8::Gemm g{512, 512, 512, 8, 122, 124}; const size_t nt_ = (size_t)F.ntok;
        pg8::StaticOrder S; S.init(F.ntok, 1024, F.G, (int)blockIdx.x, F.act + nt_ * O_MIX8, 512, F.ws + WS_WOUT8, 512);
        EpiResid E{(const pg8::bf16_t*)args.xb, (pg8::bf16_t*)(F.act + MO_H16)};
        pg8::gemm_phase<EpiResid, pg8::StaticOrder, true, true, true>(F.lds + RING_OFF, g, S, E);
    }
    SEAM(6);
    if (IN(7)) { p7_router(F, args); }
    SEAM(7);
    if (IN(9)) {
        LAS unsigned char* tb = F.lds + LDSCTL_OFF - 1024; const int ntile = moe_setup(F, tb);
        unsigned char* meta = F.act + MO_META;
        pg8::Gemm g{512, 512, 512, 8, 122, 127};
        MoeOrder<true> S{(const int*)(F.act + MO_LIST), ntile, F.G, (int)blockIdx.x, (const char*)(F.act + MO_N2), (size_t)0, (const char*)(F.ws + WS_W18), 1, tb, (size_t)1024};
        EpiMoe1 E{(unsigned char*)(F.act + MO_ACT), (const float*)(F.act + MO_LIST) + 24 * LIST_CAP, (const float*)(F.act + MO_LIST) + 48 * LIST_CAP, (const float*)(F.act + MO_LIST) + 72 * LIST_CAP};
        pg8::gemm_phase<EpiMoe1, MoeOrder<true>, true, true, true>(F.lds + RING_OFF, g, S, E);
    }
    SEAM(9);
    if (IN(10)) {
        LAS unsigned char* tb = F.lds + LDSCTL_OFF - 1024; const int ntile = moe_setup(F, tb);
        unsigned char* meta = F.act + MO_META;
        pg8::Gemm g{256, 256, 128, 2, 123, 123};
        MoeOrder<false> S{nullptr, ntile, F.G, (int)blockIdx.x, (const char*)(F.act + MO_ACT), (size_t)256 * 512, (const char*)(F.ws + WS_WD8), 2, tb, (size_t)256};
        EpiMoe2 E{args.out + (size_t)args.tok0 * D, (const pg8::bf16_t*)(F.act + MO_H16), (const int*)(F.act + MO_LIST)};
        pg8::gemm_phase<EpiMoe2, MoeOrder<false>, true, true, true>(F.lds + RING_OFF, g, S, E);
    }
    if (hi - lo > 1) grid.sync();
#undef IN
#undef SEAM
}

extern "C" void kernel_launch(void* const* d_in, const int* in_sizes, int n_in, void* d_out, int out_size, void* d_ws, size_t ws_size, hipStream_t stream) {
    static int grid = 0;
    if (grid == 0) {
        int dev = 0, cus = 0, per_cu = 0;
        (void)hipGetDevice(&dev); (void)hipDeviceGetAttribute(&cus, hipDeviceAttributeMultiprocessorCount, dev);
        if (hipFuncSetAttribute((const void*)mk_fwd, hipFuncAttributeMaxDynamicSharedMemorySize, LDS_BYTES) != hipSuccess) { fprintf(stderr, "kernel_launch: hipFuncSetAttribute failed\n"); grid = -1; return; }
        (void)hipOccupancyMaxActiveBlocksPerMultiprocessor(&per_cu, (const void*)mk_fwd, NWAVES * 64, LDS_BYTES);
        (void)hipGetLastError();
        if (per_cu < 1) { fprintf(stderr, "kernel_launch: occupancy query says %d blocks per CU\n", per_cu); per_cu = 1; }
        grid = cus * per_cu;
        if (n_in != 20 || ws_size < (size_t)512 * MiB) { fprintf(stderr, "kernel_launch: unexpected n_in %d / ws_size %zu\n", n_in, ws_size); grid = -1; return; }
        if (grid != 256) { fprintf(stderr, "kernel_launch: this kernel's phase schedules are written for a 256-workgroup grid (256 CUs x 1); the device reports %d x %d; nothing launched\n", cus, per_cu); grid = -1; return; }
    }
    if (grid < 0) return;
    float* out = (float*)d_out;
    unsigned char* ws = (unsigned char*)d_ws;
    (void)in_sizes; (void)out_size;
    (void)hipMemsetAsync(ws + WS_CTL, 0, CTL_ZERO_BYTES, stream);
    Args a{};
    for (int i = 0; i < 20; ++i) a.in[i] = (const float*)d_in[i];
    a.out = out; a.ws = ws; a.xb = (unsigned char*)d_out; a.ntok = T; a.tok0 = 0;
    void* kargs[] = {(void*)&a};
    if (PROBE_PH >= 0) { a.ph_lo = PROBE_PH; a.ph_hi = PROBE_PH + 1; a.mode = PROBE_MODE;
        (void)hipLaunchCooperativeKernel((const void*)mk_fwd, dim3(grid), dim3(NWAVES * 64), kargs, (unsigned)LDS_BYTES, stream);
        (void)hipMemsetAsync(ws + WS_CTL, 0, CTL_ZERO_BYTES, stream); }
    a.ph_lo = 0; a.ph_hi = 11; a.mode = 0;
    const hipError_t le = hipLaunchCooperativeKernel((const void*)mk_fwd, dim3(grid), dim3(NWAVES * 64), kargs, (unsigned)LDS_BYTES, stream);
    if (le != hipSuccess) fprintf(stderr, "kernel_launch: cooperative launch failed: %s (grid %d)\n", hipGetErrorString(le), grid);
}
```

```cpp
#include <hip/hip_runtime.h>
#include <hip/hip_cooperative_groups.h>
#include <cstdio>
#include <cstdint>

namespace pg8 {
#define PG8_LAS __attribute__((address_space(3)))
typedef unsigned short bf16_t;
typedef short bf16x8 __attribute__((ext_vector_type(8)));
typedef float f32x4 __attribute__((ext_vector_type(4)));
typedef unsigned u32x4 __attribute__((ext_vector_type(4)));
typedef unsigned u32x2 __attribute__((ext_vector_type(2)));
typedef int v4i_t __attribute__((ext_vector_type(4)));
typedef int v8i_t __attribute__((ext_vector_type(8)));
constexpr int BM = 256, BK = 64, HALF = 128, HTB = HALF * BK * 2  , STAGE_BYTES = 8 * HTB, NXCD = 8, WGM = 8;

__host__ __device__ __forceinline__ int lds_byte(int r, int c) { const int st = (r >> 4) * 2 + (c >> 5), rr = r & 15, cc = c & 31, ob = rr * 64 + cc * 2; return st * 1024 + (ob ^ (((ob >> 9) & 1) << 5)); }
__host__ __device__ __forceinline__ void stage_rc(int b, int& R, int& C) { const int st = b / 1024, sb = b % 1024, swz = sb ^ (((sb >> 9) & 1) << 5); R = (st >> 1) * 16 + swz / 64; C = (st & 1) * 32 + (swz % 64) / 2; }
__host__ __device__ __forceinline__ int perm32(int rho) { const int n = rho >> 4, i = rho & 15; return 8 * (i >> 2) + 4 * n + (i & 3); }

struct Unit { int pm, pn; const char* a; const char* b; long bjump; int aux; int nvalid; };
struct Gemm { int K, lda, ldb, ksplit; int sw = 122, sa = 127; };

struct StaticOrder {
    static constexpr bool GATHER = false; const int* ptok = nullptr;
    int nM, nN, nwg, G, c; const char* A; const char* Bt; size_t tA, tB;
    __device__ void init(int M, int N, int G_, int c_, const void* A_, int lda, const void* Bt_, int ldb) { nM = M / BM; nN = N / BM; nwg = nM * nN; G = G_; c = c_; A = (const char*)A_; Bt = (const char*)Bt_; tA = (size_t)BM * lda * 2; tB = (size_t)BM * ldb * 2; }
    __device__ bool next(int i, Unit& u) const {
        const long L = (long)i * G + c; if (L >= nwg) return false;
        int wgid = (int)L; { const int q = nwg / NXCD, r = nwg % NXCD, xcd = wgid % NXCD, off = wgid / NXCD; wgid = (xcd < r ? xcd * (q + 1) : r * (q + 1) + (xcd - r) * q) + off; }
        const int nig = WGM * nN, gid = wgid / nig, fm = gid * WGM, gsz = (nM - fm) < WGM ? (nM - fm) : WGM;
        u.pm = fm + ((wgid % nig) % gsz); u.pn = (wgid % nig) / gsz; u.a = A + (size_t)u.pm * tA; u.b = Bt + (size_t)u.pn * tB; u.bjump = 0; u.aux = 0; u.nvalid = 256; return true;
    }
    __device__ __forceinline__ void a_ready(const Unit&) const {}
    __device__ __forceinline__ void done(const Unit&) const {}
};

typedef float f32x2c __attribute__((ext_vector_type(2))); typedef __bf16 bf16x2c __attribute__((ext_vector_type(2)));
__device__ __forceinline__ unsigned cvt_pk_bf16(float lo, float hi) { const f32x2c v = {lo, hi}; const bf16x2c b = __builtin_convertvector(v, bf16x2c); return __builtin_bit_cast(unsigned, b); }
__device__ __forceinline__ float bf_lo(unsigned w) { return __uint_as_float(w << 16); }
__device__ __forceinline__ float bf_hi(unsigned w) { return __uint_as_float(w & 0xffff0000u); }


template <class E, class = void> struct epi_keeps { static constexpr bool v = false; };
template <class E> struct epi_keeps<E, decltype((void)E::KEEPS)> { static constexpr bool v = E::KEEPS; };
template <class Epi, class Sched, bool ALIGN_EPI = false, bool SP2 = false, bool FP8 = false>
__device__ __forceinline__ void gemm_phase(PG8_LAS unsigned char* lds, const Gemm g, const Sched& S, const Epi& E) {
    int tid = threadIdx.x; asm volatile("" : "+v"(tid));
    const int wid = __builtin_amdgcn_readfirstlane(tid >> 6), lane = tid & 63, wr = wid >> 2, wc = wid & 3, fr = lane & 15, fq = lane >> 4;
    const int K = g.K, nt = K / BK;
    unsigned voffA[2], voffB[2]; int gR[2]; unsigned gC[2];
#pragma unroll
    for (int i = 0; i < 2; ++i) { int R, C; stage_rc(tid * 16 + i * 8192, R, C); const int Rb = Epi::PERM ? ((R & ~31) + perm32(R & 31)) : R; gR[i] = R; gC[i] = (unsigned)C * 2u;
        voffA[i] = (unsigned)(R * g.lda + C) * 2u; voffB[i] = (unsigned)(Rb * g.ldb + C) * 2u; }
    unsigned gA0[2] = {0u, 0u}, gA1[2] = {0u, 0u}, gN0[2] = {0u, 0u}, gN1[2] = {0u, 0u};
#define PG8_GOFF(u_, o0, o1) do { _Pragma("unroll") for (int i_ = 0; i_ < 2; ++i_) { const int r0_ = gR[i_], r1_ = HALF + gR[i_]; const int t0_ = r0_ < (u_).nvalid ? S.ptok[(u_).aux + (u_).pm * BM + r0_] : 0, t1_ = r1_ < (u_).nvalid ? S.ptok[(u_).aux + (u_).pm * BM + r1_] : 0; \
        o0[i_] = (unsigned)t0_ * (unsigned)(g.lda * 2) + gC[i_]; o1[i_] = (unsigned)t1_ * (unsigned)(g.lda * 2) + gC[i_]; } } while (0)
    const size_t kstep = (size_t)(BK * 2);
    const size_t hstepA = Sched::GATHER ? (size_t)0 : (size_t)HALF * g.lda * 2, hstepB = (size_t)HALF * g.ldb * 2;
    const unsigned ldsw = (unsigned)wid * 1024u;
    const int aoff = lds_byte(wr * 64 + fr, fq * 8), boff = lds_byte(wc * 32 + fr, fq * 8);
#define PG8_CAT(x0, x1) __builtin_shufflevector(__builtin_bit_cast(v4i_t, x0), __builtin_bit_cast(v4i_t, x1), 0, 1, 2, 3, 4, 5, 6, 7)
#define PG8_SA(b, h) (((b) * 2 + (h)) * HTB)
#define PG8_SB(b, h) ((4 + (b) * 2 + (h)) * HTB)
#define PG8_STAGE(bufoff, gbase, voff) do { _Pragma("unroll") for (int _i = 0; _i < 2; ++_i) \
        __builtin_amdgcn_global_load_lds((const unsigned*)((const char*)(gbase) + (voff)[_i]), (PG8_LAS unsigned*)(lds + (bufoff) + ldsw + _i * 8192), 16, 0, 0); } while (0)
#define PG8_LDA(dst, b, h) do { if constexpr (FP8) { _Pragma("unroll") for (int m = 0; m < 4; ++m) dst##8[m] = PG8_CAT(*(const PG8_LAS bf16x8*)(lds + PG8_SA(b, h) + aoff + m * 2048), *(const PG8_LAS bf16x8*)(lds + PG8_SA(b, h) + aoff + m * 2048 + 1024)); } \
      else { _Pragma("unroll") for (int m = 0; m < 4; ++m) _Pragma("unroll") for (int k = 0; k < 2; ++k) dst[m][k] = *(const PG8_LAS bf16x8*)(lds + PG8_SA(b, h) + aoff + m * 2048 + k * 1024); } } while (0)
#define PG8_LDB(dst, b, h) do { if constexpr (FP8) { _Pragma("unroll") for (int n = 0; n < 2; ++n) dst##8[n] = PG8_CAT(*(const PG8_LAS bf16x8*)(lds + PG8_SB(b, h) + boff + n * 2048), *(const PG8_LAS bf16x8*)(lds + PG8_SB(b, h) + boff + n * 2048 + 1024)); } \
      else { _Pragma("unroll") for (int n = 0; n < 2; ++n) _Pragma("unroll") for (int k = 0; k < 2; ++k) dst[n][k] = *(const PG8_LAS bf16x8*)(lds + PG8_SB(b, h) + boff + n * 2048 + k * 1024); } } while (0)
#define PG8_MMA(ai, bj, At, Bt) do { __builtin_amdgcn_s_setprio(1); if constexpr (FP8) { _Pragma("unroll") for (int m = 0; m < 4; ++m) _Pragma("unroll") for (int n = 0; n < 2; ++n) \
        asm volatile("v_mfma_scale_f32_16x16x128_f8f6f4 %0, %1, %2, %0, %3, %4 op_sel_hi:[0,0,0]" : "+v"(acc[ai][bj][m][n]) : "v"(Bt##8[n]), "v"(At##8[m]), "v"(scw8), "v"(sca8)); } \
      else { _Pragma("unroll") for (int m = 0; m < 4; ++m) _Pragma("unroll") for (int n = 0; n < 2; ++n) _Pragma("unroll") for (int k = 0; k < 2; ++k) \
        acc[ai][bj][m][n] = __builtin_amdgcn_mfma_f32_16x16x32_bf16(Bt[n][k], At[m][k], acc[ai][bj][m][n], 0, 0, 0); } __builtin_amdgcn_s_setprio(0); } while (0)
#define PG8_WAIT_V(n) asm volatile("s_waitcnt vmcnt(" #n ")" ::: "memory")
#define PG8_WAIT_L(n) asm volatile("s_waitcnt lgkmcnt(" #n ")" ::: "memory")
#define PG8_BAR __builtin_amdgcn_s_barrier()
#define PG8_SCHED __builtin_amdgcn_sched_barrier(0)
    Unit cur, nxt; int ui = 0;
    if (!S.next(0, cur)) return;
    f32x4 acc[2][2][4][2];
#pragma unroll
    for (int a = 0; a < 2; ++a)
#pragma unroll
        for (int b = 0; b < 2; ++b)
#pragma unroll
            for (int m = 0; m < 4; ++m)
#pragma unroll
                for (int n = 0; n < 2; ++n) acc[a][b][m][n] = (f32x4){0.f, 0.f, 0.f, 0.f};
    int scw8 = g.sw, sca8 = g.sa; asm volatile("" : "+v"(scw8), "+v"(sca8));
    bf16x8 At[4][2], B0[2][2], B1[2][2]; v8i_t At8[4], B08[2], B18[2];
    const char* cA = cur.a; const char* cB = cur.b; long cJ = cur.bjump;
    S.a_ready(cur);
    if constexpr (SP2) {
        if constexpr (Sched::GATHER) PG8_GOFF(cur, gA0, gA1);
        PG8_STAGE(PG8_SB(0, 0), cB, voffB); PG8_STAGE(PG8_SB(0, 1), cB + hstepB, voffB); do { if constexpr (Sched::GATHER) { PG8_STAGE(PG8_SA(0, 0), cA, gA0); } else { PG8_STAGE(PG8_SA(0, 0), cA, voffA); } } while (0); do { if constexpr (Sched::GATHER) { PG8_STAGE(PG8_SA(0, 1), cA, gA1); } else { PG8_STAGE(PG8_SA(0, 1), cA + hstepA, voffA); } } while (0);
        if (wr == 1) PG8_BAR;
        PG8_WAIT_V(2); PG8_BAR;
        PG8_STAGE(PG8_SB(1, 0), cB + kstep, voffB); do { if constexpr (Sched::GATHER) { PG8_STAGE(PG8_SA(1, 0), cA + kstep, gA0); } else { PG8_STAGE(PG8_SA(1, 0), cA + kstep, voffA); } } while (0); PG8_STAGE(PG8_SB(1, 1), cB + hstepB + kstep, voffB);
        PG8_WAIT_V(6); PG8_BAR;
    } else {
        PG8_STAGE(PG8_SB(0, 0), cB, voffB); PG8_STAGE(PG8_SA(0, 0), cA, voffA); PG8_STAGE(PG8_SB(0, 1), cB + hstepB, voffB); PG8_STAGE(PG8_SA(0, 1), cA + hstepA, voffA);
        if (wr == 1) PG8_BAR;
        PG8_WAIT_V(4); PG8_BAR;
        PG8_STAGE(PG8_SB(1, 0), cB + kstep, voffB); PG8_STAGE(PG8_SA(1, 0), cA + kstep, voffA); PG8_STAGE(PG8_SB(1, 1), cB + hstepB + kstep, voffB);
        PG8_WAIT_V(6); PG8_BAR;
    }
    for (;;) {
        const bool has_next = S.next(ui + 1, nxt);
        const char* nA = has_next ? nxt.a : cA; const char* nB = has_next ? nxt.b : cB;
        if constexpr (Sched::GATHER) { if (has_next) PG8_GOFF(nxt, gN0, gN1); else { gN0[0] = gA0[0]; gN0[1] = gA0[1]; gN1[0] = gA1[0]; gN1[1] = gA1[1]; } }
#pragma unroll 1
        for (int t = 0; t < nt; t += 2) {
            const bool last = (t == nt - 2);
            const char* a1 = cA + (size_t)(t + 1) * kstep;
            const char* a2 = last ? nA : cA + (size_t)(t + 2) * kstep; const char* b2 = last ? nB : cB + (size_t)(t + 2) * kstep + ((t + 2) >= g.ksplit ? cJ : 0L);
            const char* a3 = a2 + kstep; const char* b3 = b2 + kstep;
            if (last && has_next) S.a_ready(nxt);
            unsigned x0[2] = {0u, 0u}, x1[2] = {0u, 0u};
            if constexpr (Sched::GATHER) { x0[0] = last ? gN0[0] : gA0[0]; x0[1] = last ? gN0[1] : gA0[1]; x1[0] = last ? gN1[0] : gA1[0]; x1[1] = last ? gN1[1] : gA1[1]; }
            if constexpr (SP2) {
            PG8_LDB(B0, 0, 0); PG8_LDB(B1, 0, 1); PG8_SCHED; PG8_LDA(At, 0, 0); do { if constexpr (Sched::GATHER) { PG8_STAGE(PG8_SA(1, 1), a1, gA1); } else { PG8_STAGE(PG8_SA(1, 1), a1 + hstepA, voffA); } } while (0);
            PG8_WAIT_V(8); PG8_WAIT_L(0); PG8_BAR; PG8_MMA(0, 0, At, B0); PG8_MMA(0, 1, At, B1); PG8_BAR; PG8_SCHED;
            PG8_LDA(At, 0, 1); PG8_STAGE(PG8_SB(0, 0), b2, voffB); PG8_STAGE(PG8_SB(0, 1), b2 + hstepB, voffB); do { if constexpr (Sched::GATHER) { PG8_STAGE(PG8_SA(0, 0), a2, x0); } else { PG8_STAGE(PG8_SA(0, 0), a2, voffA); } } while (0);
            PG8_WAIT_V(8); PG8_WAIT_L(0); PG8_BAR; PG8_MMA(1, 0, At, B0); PG8_MMA(1, 1, At, B1); PG8_BAR; PG8_SCHED;
            PG8_LDB(B0, 1, 0); PG8_LDB(B1, 1, 1); PG8_SCHED; PG8_LDA(At, 1, 0); do { if constexpr (Sched::GATHER) { PG8_STAGE(PG8_SA(0, 1), a2, x1); } else { PG8_STAGE(PG8_SA(0, 1), a2 + hstepA, voffA); } } while (0);
            PG8_WAIT_V(8); PG8_WAIT_L(0); PG8_BAR; PG8_MMA(0, 0, At, B0); PG8_MMA(0, 1, At, B1); PG8_BAR; PG8_SCHED;
            PG8_LDA(At, 1, 1); PG8_STAGE(PG8_SB(1, 0), b3, voffB); PG8_STAGE(PG8_SB(1, 1), b3 + hstepB, voffB); do { if constexpr (Sched::GATHER) { PG8_STAGE(PG8_SA(1, 0), a3, x0); } else { PG8_STAGE(PG8_SA(1, 0), a3, voffA); } } while (0);
            PG8_WAIT_V(8); PG8_WAIT_L(0); PG8_BAR; PG8_MMA(1, 0, At, B0); PG8_MMA(1, 1, At, B1); PG8_BAR; PG8_SCHED;
            } else {
            PG8_LDB(B0, 0, 0); PG8_SCHED; PG8_LDA(At, 0, 0); PG8_STAGE(PG8_SA(1, 1), a1 + hstepA, voffA);
            PG8_WAIT_L(8); PG8_BAR; PG8_WAIT_L(0); PG8_MMA(0, 0, At, B0); PG8_BAR; PG8_SCHED;
            PG8_LDB(B1, 0, 1); PG8_STAGE(PG8_SB(0, 0), b2, voffB);
            PG8_BAR; PG8_WAIT_L(0); PG8_MMA(0, 1, At, B1); PG8_BAR;
            PG8_LDA(At, 0, 1); PG8_STAGE(PG8_SA(0, 0), a2, voffA);
            PG8_BAR; PG8_WAIT_L(0); PG8_MMA(1, 0, At, B0); PG8_BAR; PG8_SCHED;
            PG8_STAGE(PG8_SB(0, 1), b2 + hstepB, voffB);
            PG8_WAIT_V(6); PG8_BAR; PG8_MMA(1, 1, At, B1); PG8_BAR;
            PG8_LDB(B0, 1, 0); PG8_SCHED; PG8_LDA(At, 1, 0); PG8_STAGE(PG8_SA(0, 1), a2 + hstepA, voffA);
            PG8_WAIT_L(8); PG8_BAR; PG8_WAIT_L(0); PG8_MMA(0, 0, At, B0); PG8_BAR; PG8_SCHED;
            PG8_LDB(B1, 1, 1); PG8_STAGE(PG8_SB(1, 0), b3, voffB);
            PG8_BAR; PG8_WAIT_L(0); PG8_MMA(0, 1, At, B1); PG8_BAR;
            PG8_LDA(At, 1, 1); PG8_STAGE(PG8_SA(1, 0), a3, voffA);
            PG8_BAR; PG8_WAIT_L(0); PG8_MMA(1, 0, At, B0); PG8_BAR; PG8_SCHED;
            PG8_STAGE(PG8_SB(1, 1), b3 + hstepB, voffB);
            PG8_WAIT_V(6); PG8_BAR; PG8_MMA(1, 1, At, B1); PG8_BAR;
            }
        }
        if constexpr (ALIGN_EPI) { if (wr == 0) PG8_BAR; }
        bool keep_acc = false;
        if constexpr (epi_keeps<Epi>::v) { keep_acc = E.keep(cur); if (keep_acc) E.mid(acc, cur, wr, wc, fr, fq); else E(acc, cur, wr, wc, fr, fq); S.done(cur); } else
        if constexpr (!Epi::AFTER_DRAIN) { E(acc, cur, wr, wc, fr, fq); S.done(cur); }
        if (!has_next) break;
        if (!keep_acc) {
#pragma unroll
        for (int a = 0; a < 2; ++a)
#pragma unroll
            for (int b = 0; b < 2; ++b)
#pragma unroll
                for (int m = 0; m < 4; ++m)
#pragma unroll
                    for (int n = 0; n < 2; ++n) acc[a][b][m][n] = (f32x4){0.f, 0.f, 0.f, 0.f};
        }
        cur = nxt; cA = nA; cB = nB; cJ = cur.bjump; ++ui;
        if constexpr (Sched::GATHER) { gA0[0] = gN0[0]; gA0[1] = gN0[1]; gA1[0] = gN1[0]; gA1[1] = gN1[1]; }
        if constexpr (ALIGN_EPI) { if (wr == 1) PG8_BAR; }
    }
    PG8_WAIT_V(0);
    if constexpr (!ALIGN_EPI) { if (wr == 0) PG8_BAR; }
    PG8_BAR;
    if constexpr (Epi::AFTER_DRAIN) { E.fused(acc, cur, wr, wc, fr, fq, lds, wid, lane); S.done(cur); }
#undef PG8_GOFF
#undef PG8_SA
#undef PG8_SB
#undef PG8_STAGE
#undef PG8_LDA
#undef PG8_LDB
#undef PG8_MMA
#undef PG8_CAT
#undef PG8_WAIT_V
#undef PG8_WAIT_L
#undef PG8_BAR
#undef PG8_SCHED
}
}

#ifndef PROBE_PH
#define PROBE_PH (-1)
#endif
#ifndef PROBE_MODE
#define PROBE_MODE (0)
#endif
constexpr int D = 1024, BATCH = 16, SEQ = 2048, T = BATCH * SEQ;
constexpr int INW = 6984, INWP = 7168;
constexpr int C_QA = 0, C_CKV = 1024, C_QI = 1280, C_KI = 1792, C_WI = 1856, C_RQ = 1864, C_RK = 2376, C_RV = 2888, C_RG = 3912, C_GA = 4936, C_GR = 5960;
constexpr float EPS = 1e-6f;
constexpr int NWAVES = 8;

constexpr size_t MiB = 1u << 20;
constexpr size_t WS_CTL = 0, CTL_ZERO_BYTES = 1 * MiB;
constexpr size_t WS_WIN = 1 * MiB, WS_WKV = 15 * MiB, WS_WATT = 16 * MiB, WS_WRET = 18 * MiB, WS_WOUT = 20 * MiB, WS_W1 = 22 * MiB, WS_WD = 38 * MiB, WS_ACT = 46 * MiB;
constexpr size_t O_QA = 0, O_CKV = 2048, O_QI = 2560, O_KW = 3584, O_RQ = 3840, O_RK = 4864, O_RV = 5888, O_RG = 7936, O_GA = 9984, O_GR = 12032, O_END = 14080;

constexpr int MP_ROWS = 38912;
constexpr size_t MO_APERM = 0, MO_ACT = 80 * MiB, MO_N2 = 120 * MiB, MO_META = 184 * MiB;
constexpr size_t MM_B = 0, MM_P = 131072, MM_CL = 262144, MM_CH = 393216, MM_RS = 524288, MM_PTOK = 655360, MM_PRS = 819200, MM_PCL = 983040, MM_PCH = 1146880, MM_END = 1310720;
constexpr size_t WS_WR = 15 * MiB + 512 * 1024;
constexpr size_t O_A2F8 = 1024;
constexpr size_t O_RSTATE = O_RQ + 512;
#define A2F8_PTR (F.act + (size_t)F.ntok * O_A2F8)
#define RSTATE_PTR ((float*)(F.act + (size_t)F.ntok * O_RSTATE))
#define RSTD1_PTR ((float*)(F.act + (size_t)F.ntok * O_RSTATE + 8 * MiB))
constexpr size_t MO_LIST = 152 * MiB; constexpr int LIST_CAP = 32768;
constexpr size_t MO_H16 = 192 * MiB;
constexpr size_t WS_WIN8 = 488 * MiB;
constexpr size_t WS_WATT8 = 495 * MiB, WS_WRET8 = 496 * MiB, WS_WOUT8 = 497 * MiB;
constexpr size_t O_MIX8 = 3840;
constexpr size_t WS_W18 = 498 * MiB, WS_WD8 = 506 * MiB;
constexpr size_t AUX_XB8 = 2048 + 896;
constexpr int F8_FIRST_TILE = 8;
constexpr int CW_MOE = 256;
constexpr int RING_OFF = 0, RING_BYTES = 131072, P3_HIST_OFF = 131072, P3_TOT_OFF = 147456, P3_T_OFF = 149504, LDSCTL_OFF = 151552, MISC_OFF = LDSCTL_OFF + 320, LDS_BYTES = 152576;
constexpr int CW_Q3 = 64, CW_Q4 = 128;

#define GAS __attribute__((address_space(1)))
#define LAS __attribute__((address_space(3)))
typedef unsigned short bf16;
typedef unsigned v4u __attribute__((ext_vector_type(4)));
typedef float f32x4 __attribute__((ext_vector_type(4)));
#define LDS_WAIT() asm volatile("s_waitcnt lgkmcnt(0)" ::: "memory")
#define VM_WAIT() asm volatile("s_waitcnt vmcnt(0)" ::: "memory")
__device__ __forceinline__ unsigned pk2(float lo, float hi) { return pg8::cvt_pk_bf16(lo, hi); }
__device__ __forceinline__ unsigned f2bf(float f) { return pg8::cvt_pk_bf16(f, 0.f) & 0xffffu; }
__device__ __forceinline__ float bf2f(bf16 b) { return __uint_as_float((unsigned)b << 16); }


typedef GAS unsigned gu32;
constexpr int CW_BAR = 4096;
#define XB_TMO      128
#define XB_XCNT(j)  (256  + 64 * (j))
#define XB_XSUB(j)  (1280 + 64 * (j))
#define XB_XGEN(j)  (2304 + 64 * (j))
#define XB_TOP      3328
#define XB_TOPGEN   3392
#define XCD_BAR_WORDS 3456
#define XB_SPIN_CAP (1u << 18)

__device__ __forceinline__ unsigned xb_ld(unsigned* p)              { return __hip_atomic_load(p, __ATOMIC_RELAXED, __HIP_MEMORY_SCOPE_AGENT); }
__device__ __forceinline__ unsigned xb_add(unsigned* p, unsigned v) { return __hip_atomic_fetch_add(p, v, __ATOMIC_RELAXED, __HIP_MEMORY_SCOPE_AGENT); }
__device__ __forceinline__ unsigned xb_xcc_id() { return (unsigned)__builtin_amdgcn_s_getreg((3 << 11) | 20) & 0xFu; }
#define XB_SPIN(cond, bar) do { unsigned _sp = 0; while (cond) { __builtin_amdgcn_s_sleep(1); \
    if ((++_sp & 255u) == 0u) { if (xb_ld(&(bar)[XB_TMO])) break; if (_sp > XB_SPIN_CAP) { atomicAdd(&(bar)[XB_TMO], 1u); break; } } } } while (0)

struct XcdBarrier {
    unsigned* bar; unsigned x;
    volatile LAS unsigned* st;
};

__device__ __forceinline__ XcdBarrier xcd_barrier_post(unsigned* bar, volatile LAS unsigned* st) {
    XcdBarrier b; b.bar = bar; b.x = xb_xcc_id(); b.st = st;
    if (threadIdx.x == 0) (void)xb_add(&bar[XB_XCNT(b.x)], 1u);
    return b;
}
__device__ __forceinline__ void xcd_barrier_complete(unsigned* bar, unsigned x, unsigned& nloc, unsigned& nx) {
    const unsigned G = gridDim.x * gridDim.y * gridDim.z;
    unsigned sum, cnt, mine, sp = 0u;
    for (;;) {
        sum = 0u; cnt = 0u; mine = 0u;
#pragma unroll
        for (unsigned j = 0; j < 16; ++j) { const unsigned c = xb_ld(&bar[XB_XCNT(j)]); sum += c; cnt += (c > 0u) ? 1u : 0u; mine = (j == x) ? c : mine; }
        if (sum == G) break;
        __builtin_amdgcn_s_sleep(1);
        if ((++sp & 255u) == 0u) { if (xb_ld(&bar[XB_TMO])) break; if (sp > XB_SPIN_CAP) { atomicAdd(&bar[XB_TMO], 1u); break; } }
    }
    nloc = mine > 0u ? mine : 1u; nx = cnt > 0u ? cnt : 1u;
}

__device__ __forceinline__ void xcd_barrier(const XcdBarrier& b) {
    asm volatile("s_waitcnt vmcnt(0)" ::: "memory");
    __syncthreads();
    if (threadIdx.x == 0) {
        unsigned* bar = b.bar;
        __builtin_amdgcn_s_waitcnt(0);
        unsigned nloc = b.st[0], nx = b.st[1];
        if (nloc == 0u) { xcd_barrier_complete(bar, b.x, nloc, nx); b.st[0] = nloc; b.st[1] = nx; }
        const unsigned old = xb_add(&bar[XB_XSUB(b.x)], 1u);
        const unsigned gen = old / nloc;
        if (old + 1u == (gen + 1u) * nloc) {
            __builtin_amdgcn_fence(__ATOMIC_RELEASE, "agent");
            asm volatile("s_waitcnt vmcnt(0)" ::: "memory");
            const unsigned og = xb_add(&bar[XB_TOP], 1u);
            const unsigned tg = og / nx;
            if (og + 1u == (tg + 1u) * nx) xb_add(&bar[XB_TOPGEN], 1u);
            else XB_SPIN(xb_ld(&bar[XB_TOPGEN]) == tg, bar);
            __builtin_amdgcn_fence(__ATOMIC_ACQUIRE, "agent");
            xb_add(&bar[XB_XGEN(b.x)], 1u);
            asm volatile("s_waitcnt vmcnt(0)" ::: "memory");
        } else {
            XB_SPIN(xb_ld(&bar[XB_XGEN(b.x)]) == gen, bar);
            __builtin_amdgcn_fence(__ATOMIC_ACQUIRE, "agent");
            asm volatile("s_waitcnt vmcnt(0)" ::: "memory");
        }
    }
    __syncthreads();
}

struct Args { const float* in[20]; float* out; unsigned char* ws; unsigned char* xb; int ph_lo, ph_hi, ntok, tok0, mode, pad; };

struct Frame {
    LAS unsigned char* lds;
    int tid, lane, wave, vcu, G;
    int ntok;
    unsigned char* ws; unsigned char* act; unsigned char* xbp;
};

struct EpiProj {
    static constexpr bool PERM = true, AFTER_DRAIN = false;
    unsigned char* act; size_t ntok; const float* rstd1;
    static __device__ __forceinline__ unsigned q4(const pg8::f32x4& v) { int w = __builtin_amdgcn_cvt_pk_fp8_f32(v[0], v[1], 0, false); return (unsigned)__builtin_amdgcn_cvt_pk_fp8_f32(v[2], v[3], w, true); }
    __device__ __forceinline__ void operator()(const pg8::f32x4 (&acc)[2][2][4][2], const pg8::Unit& u, int wr, int wc, int fr, int fq) const {
        const int pn = u.pn; size_t O; int ld, cb, nbj = 2; bool f8 = false;
        if (pn < 4) { O = O_QA; ld = 1024; cb = pn * 256; }
        else if (pn == 4) { O = O_CKV; ld = 256; cb = 0; }
        else if (pn < 7) { O = O_QI; ld = 512; cb = (pn - 5) * 256; }
        else if (pn == 7) { O = O_KW; ld = 128; cb = 0; nbj = 1; }
        else if (pn < 10) { O = O_RQ; ld = 512; cb = (pn - 8) * 256; }
        else if (pn < 12) { O = O_RK; ld = 512; cb = (pn - 10) * 256; }
        else { O = O_RV + (size_t)((pn - 12) >> 2) * 2048; ld = 1024; cb = ((pn - 12) & 3) * 256; }
        f8 = pn < 5 || pn >= F8_FIRST_TILE;
        const int row0 = u.pm * pg8::BM + wr * 64 + fr;
        if (f8) {
            unsigned char* base = act + ntok * O; const bool odd = fq & 1; const int colb = cb + wc * 32 + 8 * (fq & ~1);
#pragma unroll
            for (int ai = 0; ai < 2; ++ai)
#pragma unroll
                for (int bj = 0; bj < 2; ++bj)
#pragma unroll
                    for (int mp = 0; mp < 2; ++mp) { const unsigned x0 = q4(acc[ai][bj][2 * mp][0]), x1 = q4(acc[ai][bj][2 * mp][1]), y0 = q4(acc[ai][bj][2 * mp + 1][0]), y1 = q4(acc[ai][bj][2 * mp + 1][1]);
                        const unsigned r0 = (unsigned)__builtin_amdgcn_ds_swizzle((int)(odd ? x0 : y0), 0x401F), r1 = (unsigned)__builtin_amdgcn_ds_swizzle((int)(odd ? x1 : y1), 0x401F);
                        pg8::u32x4 w; if (odd) { w.x = r0; w.y = r1; w.z = y0; w.w = y1; } else { w.x = x0; w.y = x1; w.z = r0; w.w = r1; }
                        *(pg8::u32x4*)(base + (size_t)(row0 + ai * pg8::HALF + (2 * mp + (odd ? 1 : 0)) * 16) * ld + colb + bj * pg8::HALF) = w; }
            return;
        }
        pg8::bf16_t* base = (pg8::bf16_t*)(act + ntok * O);
        const int col0 = cb + wc * 32 + 8 * fq;
        float rs1[2][4];
#pragma unroll
        for (int ai = 0; ai < 2; ++ai)
#pragma unroll
            for (int m = 0; m < 4; ++m) rs1[ai][m] = rstd1[row0 + ai * pg8::HALF + m * 16];
#pragma unroll
        for (int ai = 0; ai < 2; ++ai)
#pragma unroll
            for (int m = 0; m < 4; ++m) { pg8::bf16_t* rowp = base + (size_t)(row0 + ai * pg8::HALF + m * 16) * ld + col0; const float rs = rs1[ai][m];
#pragma unroll
                for (int bj = 0; bj < 2; ++bj) if (bj < nbj) { const pg8::f32x4 v0 = acc[ai][bj][m][0] * rs, v1 = acc[ai][bj][m][1] * rs;
                    pg8::u32x4 w; w.x = pg8::cvt_pk_bf16(v0[0], v0[1]); w.y = pg8::cvt_pk_bf16(v0[2], v0[3]); w.z = pg8::cvt_pk_bf16(v1[0], v1[1]); w.w = pg8::cvt_pk_bf16(v1[2], v1[3]);
                    *(pg8::u32x4*)(rowp + bj * pg8::HALF) = w; } }
    }
};

__device__ __forceinline__ float sigm(float x) { return __builtin_amdgcn_rcpf(1.f + __builtin_amdgcn_exp2f(-1.4426950408889634f * x)); }
__device__ __forceinline__ void f8x8(const pg8::u32x2 g, float (&f)[8]) { const auto a = __builtin_amdgcn_cvt_pk_f32_fp8((int)g.x, false), b = __builtin_amdgcn_cvt_pk_f32_fp8((int)g.x, true), c = __builtin_amdgcn_cvt_pk_f32_fp8((int)g.y, false), d = __builtin_amdgcn_cvt_pk_f32_fp8((int)g.y, true);
    f[0] = a[0]; f[1] = a[1]; f[2] = b[0]; f[3] = b[1]; f[4] = c[0]; f[5] = c[1]; f[6] = d[0]; f[7] = d[1]; }
__device__ __forceinline__ void st_f8_pair(unsigned char* base, size_t ld, int row_m0, int colb, bool odd, unsigned x0, unsigned x1, unsigned y0, unsigned y1) {
    const unsigned r0 = (unsigned)__builtin_amdgcn_ds_swizzle((int)(odd ? x0 : y0), 0x401F), r1 = (unsigned)__builtin_amdgcn_ds_swizzle((int)(odd ? x1 : y1), 0x401F);
    pg8::u32x4 w; if (odd) { w.x = r0; w.y = r1; w.z = y0; w.w = y1; } else { w.x = x0; w.y = x1; w.z = r0; w.w = r1; }
    *(pg8::u32x4*)(base + (size_t)(row_m0 + (odd ? 16 : 0)) * ld + colb) = w;
}
__device__ __forceinline__ unsigned q4f(float a, float b, float c, float d) { int w = __builtin_amdgcn_cvt_pk_fp8_f32(a, b, 0, false); return (unsigned)__builtin_amdgcn_cvt_pk_fp8_f32(c, d, w, true); }
struct GateOrder {
    static constexpr bool GATHER = false; const int* ptok = nullptr;
    pg8::StaticOrder S0; const char* A1; const char* B1;
    __device__ bool next(int i, pg8::Unit& u) const { if (!S0.next(i >> 1, u)) return false; if (i & 1) { u.a = A1 + (size_t)u.pm * S0.tA; u.b = B1 + (size_t)u.pn * S0.tB; u.aux = 1; } return true; }
    __device__ __forceinline__ void a_ready(const pg8::Unit&) const {}
    __device__ __forceinline__ void done(const pg8::Unit&) const {}
};
__device__ __forceinline__ float sigm_c(float x) { return __builtin_amdgcn_rcpf(1.f + __builtin_amdgcn_exp2f(-1.4426950408889634f * fmaxf(x, -40.f))); }
struct EpiGateFused {
    static constexpr bool PERM = true, AFTER_DRAIN = false, KEEPS = true;
    const unsigned char* GA8; const unsigned char* GR8; unsigned char* MIX8;
    __device__ __forceinline__ bool keep(const pg8::Unit& u) const { return u.aux == 0; }
    __device__ __forceinline__ void mid(pg8::f32x4 (&acc)[2][2][4][2], const pg8::Unit& u, int wr, int wc, int fr, int fq) const {
        const int row0 = u.pm * pg8::BM + wr * 64 + fr, col0 = u.pn * pg8::BM + wc * 32 + 8 * fq;
#pragma unroll
        for (int ai = 0; ai < 2; ++ai) { pg8::u32x2 ga[2][4], gr[2][4];
#pragma unroll
            for (int bj = 0; bj < 2; ++bj)
#pragma unroll
                for (int m = 0; m < 4; ++m) { const size_t ro = (size_t)(row0 + ai * pg8::HALF + m * 16) * 1024 + col0 + bj * pg8::HALF; ga[bj][m] = *(const pg8::u32x2*)(GA8 + ro); gr[bj][m] = *(const pg8::u32x2*)(GR8 + ro); }
#pragma unroll
            for (int bj = 0; bj < 2; ++bj)
#pragma unroll
                for (int m = 0; m < 4; ++m) { float a[8], r[8]; f8x8(ga[bj][m], a); f8x8(gr[bj][m], r);
#pragma unroll
                    for (int j = 0; j < 4; ++j) { acc[ai][bj][m][0][j] *= sigm(a[j]) * (0.0625f * (1.f + __builtin_amdgcn_exp2f(-1.4426950408889634f * fmaxf(r[j], -40.f))));
                                                  acc[ai][bj][m][1][j] *= sigm(a[4 + j]) * (0.0625f * (1.f + __builtin_amdgcn_exp2f(-1.4426950408889634f * fmaxf(r[4 + j], -40.f)))); } } }
    }
    __device__ __forceinline__ void operator()(const pg8::f32x4 (&acc)[2][2][4][2], const pg8::Unit& u, int wr, int wc, int fr, int fq) const {
        const int row0 = u.pm * pg8::BM + wr * 64 + fr, col0 = u.pn * pg8::BM + wc * 32 + 8 * fq, colb = u.pn * pg8::BM + wc * 32 + 8 * (fq & ~1); const bool odd = fq & 1;
        pg8::u32x2 gl[2][2][4];
#pragma unroll
        for (int ai = 0; ai < 2; ++ai)
#pragma unroll
            for (int bj = 0; bj < 2; ++bj)
#pragma unroll
                for (int m = 0; m < 4; ++m) gl[ai][bj][m] = *(const pg8::u32x2*)(GR8 + (size_t)(row0 + ai * pg8::HALF + m * 16) * 1024 + col0 + bj * pg8::HALF);
#pragma unroll
        for (int ai = 0; ai < 2; ++ai)
#pragma unroll
            for (int bj = 0; bj < 2; ++bj)
#pragma unroll
                for (int mp = 0; mp < 2; ++mp) { unsigned q[2][2];
#pragma unroll
                    for (int e = 0; e < 2; ++e) { const int m = 2 * mp + e; float g[8]; f8x8(gl[ai][bj][m], g);
                        const pg8::f32x4 v0 = acc[ai][bj][m][0], v1 = acc[ai][bj][m][1];
                        q[e][0] = q4f(128.f * sigm_c(g[0]) * v0[0], 128.f * sigm_c(g[1]) * v0[1], 128.f * sigm_c(g[2]) * v0[2], 128.f * sigm_c(g[3]) * v0[3]);
                        q[e][1] = q4f(128.f * sigm_c(g[4]) * v1[0], 128.f * sigm_c(g[5]) * v1[1], 128.f * sigm_c(g[6]) * v1[2], 128.f * sigm_c(g[7]) * v1[3]); }
                    st_f8_pair(MIX8, 1024, row0 + ai * pg8::HALF + 2 * mp * 16, colb + bj * pg8::HALF, odd, q[0][0], q[0][1], q[1][0], q[1][1]); }
    }
};
struct EpiResid {
    static constexpr bool PERM = true, AFTER_DRAIN = false;
    const pg8::bf16_t* xb; pg8::bf16_t* h16;
    __device__ __forceinline__ void operator()(const pg8::f32x4 (&acc)[2][2][4][2], const pg8::Unit& u, int wr, int wc, int fr, int fq) const {
        const int row0 = u.pm * pg8::BM + wr * 64 + fr, col0 = u.pn * pg8::BM + wc * 32 + 8 * fq;
        pg8::u32x4 xl[2][4][2];
#pragma unroll
        for (int ai = 0; ai < 2; ++ai)
#pragma unroll
            for (int m = 0; m < 4; ++m)
#pragma unroll
                for (int bj = 0; bj < 2; ++bj) xl[ai][m][bj] = *(const pg8::u32x4*)(xb + (size_t)(row0 + ai * pg8::HALF + m * 16) * 1024 + col0 + bj * pg8::HALF);
#pragma unroll
        for (int ai = 0; ai < 2; ++ai)
#pragma unroll
            for (int m = 0; m < 4; ++m) { const size_t ro = (size_t)(row0 + ai * pg8::HALF + m * 16) * 1024 + col0;
#pragma unroll
                for (int bj = 0; bj < 2; ++bj) { const pg8::u32x4 xv = xl[ai][m][bj]; const pg8::f32x4 v0 = acc[ai][bj][m][0], v1 = acc[ai][bj][m][1];
                    pg8::u32x4 w; w.x = pg8::cvt_pk_bf16(v0[0] + pg8::bf_lo(xv.x), v0[1] + pg8::bf_hi(xv.x)); w.y = pg8::cvt_pk_bf16(v0[2] + pg8::bf_lo(xv.y), v0[3] + pg8::bf_hi(xv.y));
                    w.z = pg8::cvt_pk_bf16(v1[0] + pg8::bf_lo(xv.z), v1[1] + pg8::bf_hi(xv.z)); w.w = pg8::cvt_pk_bf16(v1[2] + pg8::bf_lo(xv.w), v1[3] + pg8::bf_hi(xv.w));
                    *(pg8::u32x4*)(h16 + ro + bj * pg8::HALF) = w; } }
    }
};


struct P1Order {
    static constexpr bool GATHER = false; const int* ptok = nullptr;
    int nM, nN, nwg, G, c, mode; const char* A; const char* Bt; size_t tA, tB;
    __device__ bool next(int i, pg8::Unit& u) const {
        const long L = (long)i * G + c; if (L >= nwg) return false;
        int wgid = (int)L; { const int q = nwg / pg8::NXCD, r = nwg % pg8::NXCD, xcd = wgid % pg8::NXCD, off = wgid / pg8::NXCD; wgid = (xcd < r ? xcd * (q + 1) : r * (q + 1) + (xcd - r) * q) + off; }
        const int nig = pg8::WGM * nN, gid = wgid / nig, fm = gid * pg8::WGM, gsz = (nM - fm) < pg8::WGM ? (nM - fm) : pg8::WGM;
        u.pm = fm + ((wgid % nig) % gsz); const int pc = (wgid % nig) / gsz; u.pn = mode ? 5 + pc : (pc < 5 ? pc : pc + 3);
        u.a = A + (size_t)u.pm * tA; u.b = Bt + (size_t)u.pn * tB; u.bjump = 0; u.aux = 0; u.nvalid = 256; return true;
    }
    __device__ __forceinline__ void a_ready(const pg8::Unit&) const {}
    __device__ __forceinline__ void done(const pg8::Unit&) const {}
};

__device__ __forceinline__ float wave_sum(float v) {
#pragma unroll
    for (int o = 1; o < 64; o <<= 1) v += __shfl_xor(v, o);
    return v;
}
__device__ __forceinline__ void p0_transpose_item(const float* W, int K, int N, bf16* WT, int map, int row_off, int par, const float* gk, LAS float* scr, int item, int lane, unsigned char* WT8 = nullptr, float s8 = 32.f) {
    const int nblk = (N + 31) / 32, kb = item / nblk, nb = item % nblk, k0 = 64 * kb, n0 = 32 * nb;
    const int c4 = lane & 7, rr = lane >> 3; const bool okc = (n0 + 4 * c4) < N;
    f32x4 v[8];
#pragma unroll
    for (int i = 0; i < 8; ++i) { const int kk = i * 8 + rr; v[i] = okc ? *(const f32x4*)(W + (size_t)(k0 + kk) * N + n0 + 4 * c4) : (f32x4){0.f, 0.f, 0.f, 0.f}; }
#pragma unroll
    for (int i = 0; i < 8; ++i) { const int kk = i * 8 + rr; f32x4 x = v[i]; if (gk) x = x * gk[k0 + kk]; *(LAS f32x4*)(scr + kk * 36 + 4 * c4) = x; }
    LDS_WAIT(); asm volatile("" ::: "memory");
    const int c = lane & 7;
#pragma unroll
    for (int j = 0; j < 4; ++j) { const int nl = (lane >> 3) + 8 * j, n = n0 + nl; const LAS float* s = scr + (8 * c) * 36 + nl;
        v4u o; o.x = pk2(s[0 * 36], s[1 * 36]); o.y = pk2(s[2 * 36], s[3 * 36]); o.z = pk2(s[4 * 36], s[5 * 36]); o.w = pk2(s[6 * 36], s[7 * 36]);
        if (n < N) { const int row = (map == 0) ? row_off + n : (map == 1) ? (n < 1864 ? n : n + 184) : row_off + 2 * n + par;
            if (WT) *(GAS v4u*)(WT + (size_t)row * K + k0 + 8 * c) = o;
            if (WT8) { int w0 = __builtin_amdgcn_cvt_pk_fp8_f32(s[0 * 36] * s8, s[1 * 36] * s8, 0, false); w0 = __builtin_amdgcn_cvt_pk_fp8_f32(s[2 * 36] * s8, s[3 * 36] * s8, w0, true);
                int w1 = __builtin_amdgcn_cvt_pk_fp8_f32(s[4 * 36] * s8, s[5 * 36] * s8, 0, false); w1 = __builtin_amdgcn_cvt_pk_fp8_f32(s[6 * 36] * s8, s[7 * 36] * s8, w1, true);
                *(GAS unsigned long long*)(WT8 + (size_t)row * K + k0 + 8 * c) = (unsigned long long)(unsigned)w0 | ((unsigned long long)(unsigned)w1 << 32); } } }
    LDS_WAIT(); asm volatile("" ::: "memory");
}
__device__ __forceinline__ void p0_prologue(Frame& F, const Args& a) {
    LAS float* scr = (LAS float*)(F.lds + RING_OFF + F.wave * 16384);
    const int gw = F.vcu * NWAVES + F.wave, NGW = F.G * NWAVES;
    bf16* Win_t = (bf16*)(F.ws + WS_WIN); bf16* Wkv_t = (bf16*)(F.ws + WS_WKV);
    constexpr int I_IN = 16 * 219, I_KV = 4 * 8, I_SQ = 16 * 32, I_GU = 16 * 8  , I_DN = 4 * 32  ;
    constexpr int NITEMS = I_IN + I_KV + 3 * I_SQ + 16 * (2 * I_GU + I_DN);
    for (int it = gw; it < NITEMS; it += NGW) {
        int r = it;
        if (r < I_IN) { p0_transpose_item(a.in[2], 1024, INW, Win_t, 1, 0, 0, a.in[1], scr, r, F.lane, F.ws + WS_WIN8); continue; } r -= I_IN;
        if (r < I_KV) { p0_transpose_item(a.in[4], 256, 256, Wkv_t, 0, 0, 0, a.in[3], scr, r, F.lane); continue; } r -= I_KV;
        if (r < I_SQ) { p0_transpose_item(a.in[9], 1024, 1024, nullptr, 0, 0, 0, nullptr, scr, r, F.lane, F.ws + WS_WATT8, 32.f); continue; } r -= I_SQ;
        if (r < I_SQ) { p0_transpose_item(a.in[10], 1024, 1024, nullptr, 0, 0, 0, nullptr, scr, r, F.lane, F.ws + WS_WRET8, 32.f); continue; } r -= I_SQ;
        if (r < I_SQ) { p0_transpose_item(a.in[11], 1024, 1024, nullptr, 0, 0, 0, nullptr, scr, r, F.lane, F.ws + WS_WOUT8, 32.f); continue; } r -= I_SQ;
        const int e = r / (2 * I_GU + I_DN), q = r % (2 * I_GU + I_DN);
        if (q < I_GU) p0_transpose_item(a.in[17] + (size_t)e * 1024 * 256, 1024, 256, nullptr, 2, e * 512, 0, nullptr, scr, q, F.lane, F.ws + WS_W18, 32.f);
        else if (q < 2 * I_GU) p0_transpose_item(a.in[18] + (size_t)e * 1024 * 256, 1024, 256, nullptr, 2, e * 512, 1, nullptr, scr, q - I_GU, F.lane, F.ws + WS_W18, 32.f);
        else p0_transpose_item(a.in[19] + (size_t)e * 256 * 1024, 256, 1024, nullptr, 0, 0, 0, nullptr, scr, q - 2 * I_GU, F.lane, F.ws + WS_WD8 + (size_t)e * 1024 * 256, 16.f);
    }
    { const int gt = (F.vcu * NWAVES + F.wave) * 64 + F.lane, NGT = F.G * NWAVES * 64; GAS v4u* z = (GAS v4u*)(Win_t + (size_t)1864 * 1024);
      for (int i = gt; i < 184 * 1024 * 2 / 16; i += NGT) z[i] = (v4u){0u, 0u, 0u, 0u}; }
    { const int gt = (F.vcu * NWAVES + F.wave) * 64 + F.lane, NGT = F.G * NWAVES * 64; bf16* Wh = (bf16*)(F.ws + WS_WR); bf16* Wl = Wh + 32 * 1024;
      for (int i = gt; i < 32 * 1024; i += NGT) { const int n = i >> 10, k = i & 1023; const float wv = n < 4 ? a.in[13][k * 4 + n] : (n < 20 ? a.in[15][k * 16 + (n - 4)] : 0.f);
        const unsigned hb = f2bf(wv); const float hf = __uint_as_float(hb << 16); Wh[i] = (bf16)hb; Wl[i] = (bf16)f2bf(wv - hf); } }
    const float* x = a.in[0] + (size_t)a.tok0 * D; unsigned char* xb8 = a.xb + (size_t)F.ntok * AUX_XB8;
    for (int m = gw; m < F.ntok; m += 2 * NGW) {
        const int m2 = m + NGW; const bool two = m2 < F.ntok;
        const GAS f32x4* xr = (const GAS f32x4*)(x + (size_t)m * D) + F.lane; const GAS f32x4* xr2 = (const GAS f32x4*)(x + (size_t)(two ? m2 : m) * D) + F.lane;
        f32x4 v[4], u[4]; float s = 0.f, s2 = 0.f;
#pragma unroll
        for (int j = 0; j < 4; ++j) { v[j] = xr[64 * j]; u[j] = xr2[64 * j]; }
#pragma unroll
        for (int j = 0; j < 4; ++j) { s += (v[j].x * v[j].x + v[j].y * v[j].y) + (v[j].z * v[j].z + v[j].w * v[j].w); s2 += (u[j].x * u[j].x + u[j].y * u[j].y) + (u[j].z * u[j].z + u[j].w * u[j].w); }
        const float rstd = 1.f / sqrtf(wave_sum(s) * (1.f / D) + EPS), rstd2 = 1.f / sqrtf(wave_sum(s2) * (1.f / D) + EPS);
        if (F.lane == 0) { RSTD1_PTR[m] = rstd; if (two) RSTD1_PTR[m2] = rstd2; }
        GAS unsigned long long* o8 = (GAS unsigned long long*)(a.xb + (size_t)m * D * 2) + F.lane; GAS unsigned* q8 = (GAS unsigned*)(xb8 + (size_t)m * D) + F.lane;
#pragma unroll
        for (int j = 0; j < 4; ++j) { o8[64 * j] = (unsigned long long)pk2(v[j].x, v[j].y) | ((unsigned long long)pk2(v[j].z, v[j].w) << 32);
            int w8 = __builtin_amdgcn_cvt_pk_fp8_f32(v[j].x * rstd, v[j].y * rstd, 0, false); w8 = __builtin_amdgcn_cvt_pk_fp8_f32(v[j].z * rstd, v[j].w * rstd, w8, true); q8[64 * j] = (unsigned)w8; }
        if (two) { GAS unsigned long long* p8 = (GAS unsigned long long*)(a.xb + (size_t)m2 * D * 2) + F.lane; GAS unsigned* r8 = (GAS unsigned*)(xb8 + (size_t)m2 * D) + F.lane;
#pragma unroll
            for (int j = 0; j < 4; ++j) { p8[64 * j] = (unsigned long long)pk2(u[j].x, u[j].y) | ((unsigned long long)pk2(u[j].z, u[j].w) << 32);
                int w8 = __builtin_amdgcn_cvt_pk_fp8_f32(u[j].x * rstd2, u[j].y * rstd2, 0, false); w8 = __builtin_amdgcn_cvt_pk_fp8_f32(u[j].z * rstd2, u[j].w * rstd2, w8, true); r8[64 * j] = (unsigned)w8; } }
    }
}


constexpr size_t AUX_KP = 0, AUX_VV = 256, AUX_KIN = 512, AUX_MASK = 640, AUX_END = 896;
typedef short bf16x8_t __attribute__((ext_vector_type(8)));
typedef float f32x16 __attribute__((ext_vector_type(16)));
__device__ __forceinline__ int crow(int r, int hi) { return (r & 3) + 8 * (r >> 2) + 4 * hi; }
__device__ __forceinline__ float xhalf_sum(float v) { auto rr = __builtin_amdgcn_permlane32_swap(__float_as_uint(v), __float_as_uint(v), false, false); return __uint_as_float(rr[0]) + __uint_as_float(rr[1]); }
__device__ __forceinline__ float sumsq8(bf16x8_t v) { float s = 0.f;
#pragma unroll
    for (int j = 0; j < 8; ++j) { const float f = __uint_as_float((unsigned)(unsigned short)v[j] << 16); s += f * f; } return s; }
__device__ __forceinline__ void p2_post(Frame& F, const Args& a) {
    const int gw = F.vcu * NWAVES + F.wave, NGW = F.G * NWAVES, lane = F.lane, r32 = lane & 31, hi = lane >> 5;
    const size_t nt_ = (size_t)F.ntok;
    const bf16* CKV = (const bf16*)(F.act + nt_ * O_CKV); const bf16* KW = (const bf16*)(F.act + nt_ * O_KW);
    const bf16* Wkv_t = (const bf16*)(F.ws + WS_WKV);
    unsigned char* aux = a.xb + nt_ * 2048;
    bf16* KP = (bf16*)(aux + nt_ * AUX_KP); bf16* VV = (bf16*)(aux + nt_ * AUX_VV); bf16* KIN = (bf16*)(aux + nt_ * AUX_KIN);
    const float* g_q = a.in[5]; const float* g_k = a.in[6]; const float* g_ki = a.in[7];
    constexpr int WP = 528;
    LAS unsigned char* Wl = F.lds + RING_OFF; LAS float* gl = (LAS float*)(F.lds + RING_OFF + 256 * WP);
    for (int i = F.tid; i < 256 * 32; i += NWAVES * 64) { const int n = i >> 5, ch = i & 31; *(LAS v4u*)(Wl + n * WP + ch * 16) = *(const v4u*)(Wkv_t + (size_t)n * 256 + ch * 8); }
    if (F.tid < 128) gl[F.tid] = g_k[F.tid] * g_q[F.tid] * (0.08838834764831845f * 1.4426950408889634f);
    else if (F.tid < 192) gl[F.tid] = g_ki[F.tid - 128];
    __syncthreads();
    const int ntask = 2 * (F.ntok / 32);
    for (int task = gw; task < ntask; task += NGW) {
        const int kind = task & 1, t0 = (task >> 1) * 32;
        const unsigned char* crowp = (const unsigned char*)CKV + (size_t)(t0 + r32) * 256 + hi * 8;
        bf16x8_t bfr[16]; float ss = 0.f;
#pragma unroll
        for (int kk = 0; kk < 16; ++kk) { const unsigned long long c8 = *(const unsigned long long*)(crowp + kk * 16); const int lo = (int)(unsigned)c8, hi32 = (int)(unsigned)(c8 >> 32);
            const auto a_ = __builtin_amdgcn_cvt_pk_f32_fp8(lo, false), b_ = __builtin_amdgcn_cvt_pk_f32_fp8(lo, true), c_ = __builtin_amdgcn_cvt_pk_f32_fp8(hi32, false), d_ = __builtin_amdgcn_cvt_pk_f32_fp8(hi32, true);
            ss += (a_[0] * a_[0] + a_[1] * a_[1]) + (b_[0] * b_[0] + b_[1] * b_[1]) + (c_[0] * c_[0] + c_[1] * c_[1]) + (d_[0] * d_[0] + d_[1] * d_[1]);
            v4u pk; pk.x = pk2(a_[0], a_[1]); pk.y = pk2(b_[0], b_[1]); pk.z = pk2(c_[0], c_[1]); pk.w = pk2(d_[0], d_[1]); bfr[kk] = __builtin_bit_cast(bf16x8_t, pk); }
        ss = xhalf_sum(ss);
        const float rstd = rsqrtf(ss * (1.f / 256.f) + EPS);
        f32x16 acc[4];
#pragma unroll
        for (int nt = 0; nt < 4; ++nt) { acc[nt] = f32x16{};
            const LAS unsigned char* wrow = Wl + (kind * 128 + nt * 32 + r32) * WP + hi * 16;
#pragma unroll
            for (int kk = 0; kk < 16; ++kk) { const bf16x8_t af = *(const LAS bf16x8_t*)(wrow + kk * 32); acc[nt] = __builtin_amdgcn_mfma_f32_32x32x16_bf16(af, bfr[kk], acc[nt], 0, 0, 0); if ((kk & 3) == 3) __builtin_amdgcn_sched_barrier(0); } }
        float sc = rstd;
        if (kind == 0) { float sk = 0.f;
#pragma unroll
            for (int nt = 0; nt < 4; ++nt)
#pragma unroll
                for (int r = 0; r < 16; ++r) { const float v = acc[nt][r] * rstd; sk += v * v; }
            sk = xhalf_sum(sk);
            sc = rstd * rsqrtf(sk * (1.f / 128.f) + EPS); }
        bf16* orow = (kind == 0 ? KP : VV) + (size_t)(t0 + r32) * 128;
#pragma unroll
        for (int nt = 0; nt < 4; ++nt)
#pragma unroll
            for (int g = 0; g < 4; ++g) { const int ch = nt * 32 + 8 * g + 4 * hi; float v[4];
#pragma unroll
                for (int j = 0; j < 4; ++j) { v[j] = acc[nt][4 * g + j] * sc; if (kind == 0) v[j] *= gl[ch + j]; }
                *(unsigned long long*)(orow + ch) = (unsigned long long)pk2(v[0], v[1]) | ((unsigned long long)pk2(v[2], v[3]) << 32); }
        if (kind == 0) {
            const bf16* kr = KW + (size_t)(t0 + r32) * 128 + hi * 32; bf16x8_t kv4[4]; float s2 = 0.f;
#pragma unroll
            for (int j = 0; j < 4; ++j) { kv4[j] = *(const bf16x8_t*)(kr + 8 * j); s2 += sumsq8(kv4[j]); }
            s2 = xhalf_sum(s2);
            const float rk = rsqrtf(s2 * (1.f / 64.f) + EPS);
            bf16* ko = KIN + (size_t)(t0 + r32) * 64 + hi * 32;
#pragma unroll
            for (int j = 0; j < 4; ++j) { float f[8];
#pragma unroll
                for (int e = 0; e < 8; ++e) f[e] = __uint_as_float((unsigned)(unsigned short)kv4[j][e] << 16) * rk * gl[128 + hi * 32 + 8 * j + e];
                v4u o; o.x = pk2(f[0], f[1]); o.y = pk2(f[2], f[3]); o.z = pk2(f[4], f[5]); o.w = pk2(f[6], f[7]);
                *(v4u*)(ko + 8 * j) = o; }
        }
    }
    __syncthreads();
}

typedef float f32x4_t __attribute__((ext_vector_type(4)));
__device__ __forceinline__ unsigned key15_of(float s) { const unsigned short hb = __builtin_bit_cast(unsigned short, (_Float16)s); const unsigned u = (hb & 0x8000u) ? (~(unsigned)hb & 0xffffu) : ((unsigned)hb | 0x8000u); return u >> 1; }
__device__ __forceinline__ unsigned sad4(unsigned x) { return __builtin_amdgcn_sad_u8(x, 0u, 0u); }
__device__ __forceinline__ void p3_merge(LAS unsigned* hist, LAS unsigned short* tot, int w, int g, int q, int& need, int& bsel) {
    __syncthreads();
    const int o = 4 * w + g; unsigned c = 0;
#pragma unroll
    for (int p = 0; p < 32; ++p) { const int tidp = (p >> 2) * 64 + (p & 3) * 16 + q; c += (hist[(o >> 2) * 512 + tidp] >> (8 * (o & 3))) & 0xffu; }
    tot[q * 32 + o] = (unsigned short)c;
    __syncthreads();
    v4u tv[4];
#pragma unroll
    for (int j = 0; j < 4; ++j) tv[j] = *(const LAS v4u*)((const LAS unsigned char*)tot + q * 64 + j * 16);
    int cum = 0, bs = 0, ab = 0; bool found = false;
#pragma unroll
    for (int bin = 31; bin >= 0; --bin) { const unsigned wd = tv[bin >> 3][(bin >> 1) & 3]; const int cc = (int)((bin & 1) ? (wd >> 16) : (wd & 0xffffu));
        if (!found && cum + cc >= need) { bs = bin; ab = cum; found = true; } cum += cc; }
    bsel = bs; need -= ab;
}
__device__ __forceinline__ void p3_index(Frame& F, const Args& a) {
    const int tid = F.tid, lane = F.lane, w = F.wave, q = lane & 15, g = lane >> 4;
    LAS unsigned* keys = (LAS unsigned*)(F.lds + RING_OFF);
    LAS unsigned char* qbuf = F.lds + 65536;
    LAS unsigned* hist = (LAS unsigned*)(F.lds + P3_HIST_OFF);
    LAS unsigned short* tot = (LAS unsigned short*)(F.lds + P3_TOT_OFF);
    LAS unsigned char* Tt = (LAS unsigned char*)(F.lds + P3_T_OFF);
    const size_t nt_ = (size_t)F.ntok;
    const bf16* QI = (const bf16*)(F.act + nt_ * O_QI); const bf16* KW = (const bf16*)(F.act + nt_ * O_KW);
    unsigned char* aux = a.xb + nt_ * 2048;
    const bf16* KIN = (const bf16*)(aux + nt_ * AUX_KIN); unsigned* MASK = (unsigned*)(aux + nt_ * AUX_MASK);
    const int nb = F.ntok / SEQ, nitems = nb * 128; const int bxj = (int)blockIdx.x >> 3;
    const int G = F.G - F.G / 4, c = (bxj - (bxj >> 2) - 1) * 8 + ((int)blockIdx.x & 7);
#define P3_ITEM(k) ((k) * G + (((k) & 1) ? (G - 1 - c) : c))
#define P3_QDMA(it_, buf_) do { const int qg_ = 127 - (it_) / nb, b_ = (it_) % nb; _Pragma("unroll") for (int i_ = 0; i_ < 2; ++i_) { const int row_ = w * 2 + i_; \
        const char* src_ = (const char*)(QI + ((size_t)b_ * SEQ + qg_ * 16 + row_) * 512) + ((lane ^ (row_ & 15)) * 16); \
        __builtin_amdgcn_global_load_lds((const unsigned*)src_, (LAS unsigned*)(qbuf + (buf_) * 16384 + row_ * 1024), 16, 0, 0); } } while (0)
    const int nround = (nitems + G - 1) / G;
    if (P3_ITEM(0) < nitems) P3_QDMA(P3_ITEM(0), 0);
    v4u wvn = (v4u){0u, 0u, 0u, 0u};
    if (P3_ITEM(0) < nitems) { const int it0 = P3_ITEM(0); wvn = *(const v4u*)(KW + ((size_t)(it0 % nb) * SEQ + (127 - it0 / nb) * 16 + q) * 128 + 64); }
    for (int k = 0; k < nround; ++k) {
        const int it = P3_ITEM(k); if (it >= nitems) break;
        const int qg = 127 - it / nb, b = it % nb, q0 = qg * 16, qme = q0 + q;
        unsigned* Mb = MASK + (size_t)b * 64 * 2048;
        const int kb_hi = ((qg >> 3) + 1) << 2, nkb = (qg >> 1) + 1;
        asm volatile("s_waitcnt vmcnt(0) lgkmcnt(0)\n\ts_barrier" ::: "memory");
        const v4u wv = wvn;
        { const int itn = P3_ITEM(k + 1); if (k + 1 < nround && itn < nitems) { P3_QDMA(itn, (k + 1) & 1); wvn = *(const v4u*)(KW + ((size_t)(itn % nb) * SEQ + (127 - itn / nb) * 16 + q) * 128 + 64); } }
        if (qg < 16) {
            if (tid < kb_hi * 16) { const int kb = tid >> 4, qq = q0 + (tid & 15), nbits = qq - kb * 32 + 1; Mb[kb * 2048 + qq] = nbits >= 32 ? 0xffffffffu : (nbits <= 0 ? 0u : ((1u << nbits) - 1u)); }
            continue;
        }
        float wq[8];
        { const float cc = 0.35355339059327373f * 0.125f;
          wq[0] = pg8::bf_lo(wv.x) * cc; wq[1] = pg8::bf_hi(wv.x) * cc; wq[2] = pg8::bf_lo(wv.y) * cc; wq[3] = pg8::bf_hi(wv.y) * cc; wq[4] = pg8::bf_lo(wv.z) * cc; wq[5] = pg8::bf_hi(wv.z) * cc; wq[6] = pg8::bf_lo(wv.w) * cc; wq[7] = pg8::bf_hi(wv.w) * cc; }
        bf16x8_t qfr[8][2], qlin[2];
        { const LAS unsigned char* qrow = qbuf + (k & 1) * 16384 + q * 1024;
#pragma unroll
          for (int h = 0; h < 8; ++h)
#pragma unroll
            for (int ks = 0; ks < 2; ++ks) qfr[h][ks] = *(const LAS bf16x8_t*)(qrow + (((h * 8 + ks * 4 + g) ^ q) * 16)); }
#pragma unroll
        for (int ks = 0; ks < 2; ++ks) { float f[8];
#pragma unroll
            for (int j = 0; j < 8; ++j) { float s = 0.f;
#pragma unroll
                for (int h = 0; h < 8; ++h) s += wq[h] * __uint_as_float((unsigned)(unsigned short)qfr[h][ks][j] << 16);
                f[j] = s; }
            v4u o; o.x = pk2(f[0], f[1]); o.y = pk2(f[2], f[3]); o.z = pk2(f[4], f[5]); o.w = pk2(f[6], f[7]); qlin[ks] = __builtin_bit_cast(bf16x8_t, o); }
#pragma unroll
        for (int i = 0; i < 8; ++i) hist[i * 512 + tid] = 0u;
        const bf16* kbase = KIN + ((size_t)b * SEQ + q) * 64 + g * 8;
        bf16x8_t afr[2][2], afn[2][2];
#pragma unroll
        for (int t = 0; t < 2; ++t)
#pragma unroll
            for (int ks = 0; ks < 2; ++ks) afn[t][ks] = *(const bf16x8_t*)(kbase + (size_t)(w * 32 + t * 16) * 64 + ks * 32);
        for (int s = 0, kb = w; kb < nkb; ++s, kb += 8) {
            const bool diag = (kb == nkb - 1);
#pragma unroll
            for (int t = 0; t < 2; ++t)
#pragma unroll
                for (int ks = 0; ks < 2; ++ks) afr[t][ks] = afn[t][ks];
            if (kb + 8 < nkb) {
#pragma unroll
                for (int t = 0; t < 2; ++t)
#pragma unroll
                    for (int ks = 0; ks < 2; ++ks) afn[t][ks] = *(const bf16x8_t*)(kbase + (size_t)((kb + 8) * 32 + t * 16) * 64 + ks * 32); }
#pragma unroll
            for (int t = 0; t < 2; ++t) {
                f32x4_t sacc = f32x4_t{};
#pragma unroll
                for (int ks = 0; ks < 2; ++ks) sacc = __builtin_amdgcn_mfma_f32_16x16x32_bf16(afr[t][ks], qlin[ks], sacc, 0, 0, 0);
#pragma unroll
                for (int h = 0; h < 8; ++h) { f32x4_t d = f32x4_t{};
#pragma unroll
                    for (int ks = 0; ks < 2; ++ks) d = __builtin_amdgcn_mfma_f32_16x16x32_bf16(afr[t][ks], qfr[h][ks], d, 0, 0, 0);
#pragma unroll
                    for (int r = 0; r < 4; ++r) sacc[r] = fmaf(fabsf(d[r]), wq[h], sacc[r]); }
#pragma unroll
                for (int i = 0; i < 2; ++i) { unsigned k2[2];
#pragma unroll
                    for (int e = 0; e < 2; ++e) { const int r = 2 * i + e; unsigned kk_ = key15_of(sacc[r]); if (diag && kb * 32 + t * 16 + 4 * g + r > qme) kk_ = 0u; k2[e] = kk_;
                        const unsigned dg = kk_ >> 10; (void)__hip_atomic_fetch_add((LAS unsigned*)&hist[(dg >> 2) * 512 + tid], 1u << ((dg & 3u) * 8u), __ATOMIC_RELAXED, __HIP_MEMORY_SCOPE_WORKGROUP); }
                    keys[(s * 4 + t * 2 + i) * 512 + tid] = k2[0] | (k2[1] << 16); }
            }
        }
        int need = 256, bsel;
        p3_merge(hist, tot, w, g, q, need, bsel);
        unsigned prefix = (unsigned)bsel;
#pragma unroll
        for (int pass = 0; pass < 2; ++pass) {
            const int sh_hi = pass == 0 ? 10 : 5, sh = pass == 0 ? 5 : 0;
#pragma unroll
            for (int i = 0; i < 8; ++i) hist[i * 512 + tid] = 0u;
#pragma unroll
            for (int s = 0; s < 8; ++s) if (w + 8 * s < nkb) {
#pragma unroll
                for (int i = 0; i < 4; ++i) { const unsigned d2 = keys[(s * 4 + i) * 512 + tid];
#pragma unroll
                    for (int e = 0; e < 2; ++e) { const unsigned kk_ = e ? (d2 >> 16) : (d2 & 0xffffu);
                        if ((kk_ >> sh_hi) == prefix) { const unsigned dg = (kk_ >> sh) & 31u; (void)__hip_atomic_fetch_add((LAS unsigned*)&hist[(dg >> 2) * 512 + tid], 1u << ((dg & 3u) * 8u), __ATOMIC_RELAXED, __HIP_MEMORY_SCOPE_WORKGROUP); } } } }
            p3_merge(hist, tot, w, g, q, need, bsel);
            prefix = (prefix << 5) | (unsigned)bsel;
        }
        const unsigned tau = prefix; const int need_eq = need;
        unsigned gtw[8], eqw[8];
#pragma unroll
        for (int s = 0; s < 8; ++s) { const int kb = w + 8 * s; gtw[s] = 0u; eqw[s] = 0u;
            if (kb < nkb) { unsigned gg = 0u, qq = 0u;
#pragma unroll
                for (int i = 0; i < 4; ++i) { const unsigned d2 = keys[(s * 4 + i) * 512 + tid];
#pragma unroll
                    for (int e = 0; e < 2; ++e) { const unsigned kk_ = e ? (d2 >> 16) : (d2 & 0xffffu); const int bit = (i >> 1) * 16 + 4 * g + (i & 1) * 2 + e;
                        gg |= (kk_ > tau ? 1u : 0u) << bit; qq |= (kk_ == tau ? 1u : 0u) << bit; } }
                gg |= (unsigned)__shfl_xor((int)gg, 16); gg |= (unsigned)__shfl_xor((int)gg, 32); qq |= (unsigned)__shfl_xor((int)qq, 16); qq |= (unsigned)__shfl_xor((int)qq, 32);
                gtw[s] = gg; eqw[s] = qq;
                if (g == 0) Tt[q * 64 + kb] = (unsigned char)__builtin_popcount(qq); } }
        __syncthreads();
        { unsigned run = 0u;
#pragma unroll
          for (int s = 0; s < 8; ++s) { const int kb = w + 8 * s;
            if (kb < nkb) { const unsigned g0 = *(const LAS unsigned*)(Tt + q * 64 + 8 * s), g1 = *(const LAS unsigned*)(Tt + q * 64 + 8 * s + 4);
                const unsigned m0 = w >= 4 ? g0 : (w == 0 ? 0u : (g0 & ((1u << (8 * w)) - 1u))), m1 = w > 4 ? (g1 & ((1u << (8 * (w - 4))) - 1u)) : 0u;
                const int pre = (int)(run + sad4(m0) + sad4(m1)), m = need_eq - pre, pc = __builtin_popcount(eqw[s]);
                unsigned se = eqw[s];
                if (m < pc) { se = 0u; unsigned x = eqw[s]; for (int i = 0; i < m; ++i) { const unsigned bb = x & (0u - x); se |= bb; x ^= bb; } }
                if (g == 0) Mb[kb * 2048 + qme] = gtw[s] | se;
                run += sad4(g0) + sad4(g1); } } }
        if (tid < (kb_hi - nkb) * 16) Mb[(nkb + (tid >> 4)) * 2048 + q0 + (tid & 15)] = 0u;
    }
    asm volatile("s_waitcnt vmcnt(0) lgkmcnt(0)" ::: "memory");
    __syncthreads();
#undef P3_ITEM
#undef P3_QDMA
}

namespace att {
using bf16x8 = __attribute__((ext_vector_type(8))) short;
using s16x4  = __attribute__((ext_vector_type(4))) short;
using u32x4  = __attribute__((ext_vector_type(4))) unsigned;
constexpr int KVBLK = 64;
constexpr size_t SHM_V = KVBLK * 128 * 2, SHM_K = KVBLK * 128 * 2;
constexpr int OFF_WS = 65536, OFF_MK = 65536 + 2048, OFF_Q = 65536 + 2048 + 8192, QPITCH = 272;
constexpr float THR2 = 11.5f;
#define KSWZ(row, colB) ((row) * 256 + ((colB) ^ (((row) & 7) << 4)))
#define SBAR() __builtin_amdgcn_sched_barrier(0)
__device__ __forceinline__ unsigned cvtpk(float lo, float hi) { unsigned r; asm volatile("v_cvt_pk_bf16_f32 %0, %1, %2" : "=v"(r) : "v"(lo), "v"(hi)); return r; }
__device__ __forceinline__ float msk(float p, unsigned w, int bit) { const int m = __builtin_amdgcn_sbfe((int)w, bit, 1); return __uint_as_float((__float_as_uint(p) & (unsigned)m) | (0xff800000u & ~(unsigned)m)); }
__device__ __forceinline__ void partialSM(f32x16& p0, f32x16& p1, unsigned w0, unsigned w1, float& m_reg, float& mn, float& alpha) {
#pragma unroll
  for (int r = 0; r < 16; ++r) { const int bit = (r & 3) + 8 * (r >> 2); p0[r] = msk(p0[r], w0, bit); p1[r] = msk(p1[r], w1, bit); }
  float pmax = p0[0];
#pragma unroll
  for (int r = 1; r < 16; ++r) pmax = fmaxf(pmax, p0[r]);
#pragma unroll
  for (int r = 0; r < 16; ++r) pmax = fmaxf(pmax, p1[r]);
  { auto rr = __builtin_amdgcn_permlane32_swap(__float_as_uint(pmax), __float_as_uint(pmax), false, false); pmax = fmaxf(__uint_as_float(rr[0]), __uint_as_float(rr[1])); }
  if (__builtin_expect(__all(pmax - m_reg <= THR2), 1)) { mn = m_reg; alpha = 1.f; }
  else { mn = fmaxf(m_reg, pmax); alpha = __builtin_amdgcn_exp2f(m_reg - mn); m_reg = mn; }
#pragma unroll
  for (int r = 0; r < 16; ++r) { p0[r] -= mn; p1[r] -= mn; }
#pragma unroll
  for (int r = 0; r < 16; ++r) p0[r] = __builtin_amdgcn_exp2f(p0[r]);
}
__device__ __forceinline__ void finishSM(f32x16& p0, f32x16& p1, float alpha, float& l_reg, bf16x8& pa0, bf16x8& pa1, bf16x8& pa2, bf16x8& pa3) {
#pragma unroll
  for (int r = 0; r < 16; ++r) p1[r] = __builtin_amdgcn_exp2f(p1[r]);
  float ps = 0;
#pragma unroll
  for (int r = 0; r < 16; ++r) ps += p0[r];
#pragma unroll
  for (int r = 0; r < 16; ++r) ps += p1[r];
  { auto rr = __builtin_amdgcn_permlane32_swap(__float_as_uint(ps), __float_as_uint(ps), false, false); ps = __uint_as_float(rr[0]) + __uint_as_float(rr[1]); }
  l_reg = l_reg * alpha + ps;
#define PK4(P, BASE, OUT) do { unsigned a0 = cvtpk(P[BASE + 0], P[BASE + 1]), a1 = cvtpk(P[BASE + 2], P[BASE + 3]);   \
    unsigned b0 = cvtpk(P[BASE + 4], P[BASE + 5]), b1 = cvtpk(P[BASE + 6], P[BASE + 7]);                              \
    auto r0 = __builtin_amdgcn_permlane32_swap(a0, b0, false, false); auto r1 = __builtin_amdgcn_permlane32_swap(a1, b1, false, false); \
    u32x4 w = {r0[0], r1[0], r0[1], r1[1]}; OUT = *reinterpret_cast<bf16x8*>(&w); } while (0)
  PK4(p0, 0, pa0); PK4(p0, 8, pa1); PK4(p1, 0, pa2); PK4(p1, 8, pa3);
#undef PK4
}
__device__ __forceinline__ void qkt(f32x16& p0, f32x16& p1, const char* Ks, const char* qrow, const float (&bo)[16], float kb0, float kb1, int r32, int hi) {
#pragma unroll
  for (int r = 0; r < 16; ++r) { p0[r] = bo[r] + kb0; p1[r] = bo[r] + kb1; }
#pragma unroll
  for (int d0 = 0; d0 < 8; ++d0) { const int cb = (d0 * 16 + hi * 8) * 2;
    const bf16x8 b0 = *reinterpret_cast<const bf16x8*>(Ks + KSWZ(r32, cb));
    const bf16x8 b1 = *reinterpret_cast<const bf16x8*>(Ks + KSWZ(32 + r32, cb));
    const bf16x8 qf = *reinterpret_cast<const bf16x8*>(qrow + d0 * 32);
    p0 = __builtin_amdgcn_mfma_f32_32x32x16_bf16(b0, qf, p0, 0, 0, 0);
    p1 = __builtin_amdgcn_mfma_f32_32x32x16_bf16(b1, qf, p1, 0, 0, 0); }
}
__device__ __forceinline__ int v_st(int k, int c) { const int kk = (k & ~0xC) | ((k & 4) << 1) | ((k & 8) >> 1); return ((kk >> 3) * 4 + (c >> 5)) * 512 + ((kk & 7) * 32 + (c & 31)) * 2; }
__device__ __forceinline__ int v_rd_base(int lane) { return ((lane & 3) << 3) | (((lane >> 2) & 3) << 6) | (((lane >> 4) & 1) << 5) | (((lane >> 5) & 1) << 8); }
constexpr int v_rd_off(int d0, int ks, int half) { return d0 * 512 + ks * 4096 + half * 2048; }
template <int OFF> __device__ __forceinline__ s16x4 tr_read(int vb) { s16x4 r; asm volatile("ds_read_b64_tr_b16 %0, %1 offset:%2" : "=&v"(r) : "v"(vb), "i"(OFF) : "memory"); return r; }
template <int D0> __device__ __forceinline__ void pv_one(f32x16& od, int vb, bf16x8 pa0, bf16x8 pa1, bf16x8 pa2, bf16x8 pa3) {
  const s16x4 l0 = tr_read<v_rd_off(D0, 0, 0)>(vb), h0 = tr_read<v_rd_off(D0, 0, 1)>(vb), l1 = tr_read<v_rd_off(D0, 1, 0)>(vb), h1 = tr_read<v_rd_off(D0, 1, 1)>(vb);
  const s16x4 l2 = tr_read<v_rd_off(D0, 2, 0)>(vb), h2 = tr_read<v_rd_off(D0, 2, 1)>(vb), l3 = tr_read<v_rd_off(D0, 3, 0)>(vb), h3 = tr_read<v_rd_off(D0, 3, 1)>(vb);
  asm volatile("s_waitcnt lgkmcnt(0)" ::: "memory"); SBAR();
#define PK(L, H) (bf16x8){L[0], L[1], L[2], L[3], H[0], H[1], H[2], H[3]}
  od = __builtin_amdgcn_mfma_f32_32x32x16_bf16(pa0, PK(l0, h0), od, 0, 0, 0);
  od = __builtin_amdgcn_mfma_f32_32x32x16_bf16(pa1, PK(l1, h1), od, 0, 0, 0);
  od = __builtin_amdgcn_mfma_f32_32x32x16_bf16(pa2, PK(l2, h2), od, 0, 0, 0);
  od = __builtin_amdgcn_mfma_f32_32x32x16_bf16(pa3, PK(l3, h3), od, 0, 0, 0);
#undef PK
}
__device__ __forceinline__ void pv_d0(f32x16* o, int vb, bf16x8 pa0, bf16x8 pa1, bf16x8 pa2, bf16x8 pa3) {
  pv_one<0>(o[0], vb, pa0, pa1, pa2, pa3); pv_one<1>(o[1], vb, pa0, pa1, pa2, pa3); pv_one<2>(o[2], vb, pa0, pa1, pa2, pa3); pv_one<3>(o[3], vb, pa0, pa1, pa2, pa3);
}
__device__ __forceinline__ void attn_item(const bf16* __restrict__ Qb, const bf16* __restrict__ Kh, const bf16* __restrict__ Vh, const unsigned* __restrict__ Mq, bf16* __restrict__ Ob, int NT, char* lds, LAS unsigned char* ldsL) {
  const int tid = threadIdx.x, wid = __builtin_amdgcn_readfirstlane(tid >> 6), lane = tid & 63, r32 = lane & 31, hi = lane >> 5;
  float* ws = (float*)(lds + OFF_WS) + wid * 64; float* li_l = ws; float* al_l = ws + 32;
  unsigned* mk = (unsigned*)(lds + OFF_MK);
  unsigned soff[4];
#pragma unroll
  for (int i = 0; i < 4; ++i) { const int pc = (wid & 3) * 4 + i;
    if (wid < 4) { const int row = pc * 4 + (lane >> 4), cb = (lane & 15) * 16; soff[i] = (unsigned)(row * 256 + (cb ^ ((row & 7) << 4))); }
    else { const int L = pc * 1024 + lane * 16, st = L >> 9, wi = L & 511, kk = (st >> 2) * 8 + (wi >> 6), c = (st & 3) * 32 + ((wi & 63) >> 1), k = (kk & ~0xC) | ((kk & 4) << 1) | ((kk & 8) >> 1);
           soff[i] = (unsigned)(k * 256 + c * 2); } }
  const char* gsrc = (const char*)(wid < 4 ? Kh : Vh);
  const unsigned ldst = (unsigned)((wid < 4 ? 0 : 16384) + (wid & 3) * 4096);
#define DMA_TILE(t, slot) do { _Pragma("unroll") for (int i_ = 0; i_ < 4; ++i_) \
    __builtin_amdgcn_global_load_lds((const unsigned*)(gsrc + (size_t)(t) * (64 * 256) + soff[i_]), (LAS unsigned*)(ldsL + (slot) * 32768 + ldst + i_ * 1024), 16, 0, 0); } while (0)
  DMA_TILE(0, 0);
  float m_reg = 0.f, l_reg = 0; f32x16 o[4] = {}; bf16x8 qr[8];
  { const unsigned char* Qw = (const unsigned char*)Qb + (size_t)r32 * 1024 + wid * 128 + hi * 8; float ss = 0.f; unsigned long long q8[8];
#pragma unroll
    for (int d0 = 0; d0 < 8; ++d0) q8[d0] = *reinterpret_cast<const unsigned long long*>(Qw + d0 * 16);
    unsigned mv[4];
#pragma unroll
    for (int i = 0; i < 4; ++i) { const int idx = tid + 512 * i; mv[i] = idx < NT * 64 ? Mq[(size_t)(idx >> 5) * 2048 + (idx & 31)] : 0u; }
#pragma unroll
    for (int i = 0; i < 4; ++i) { const int idx = tid + 512 * i; if (idx < NT * 64) mk[idx] = mv[i]; }
    float qf[8][8];
#pragma unroll
    for (int d0 = 0; d0 < 8; ++d0) { const int lo = (int)(unsigned)q8[d0], hi32 = (int)(unsigned)(q8[d0] >> 32);
      const auto a_ = __builtin_amdgcn_cvt_pk_f32_fp8(lo, false), b_ = __builtin_amdgcn_cvt_pk_f32_fp8(lo, true), c_ = __builtin_amdgcn_cvt_pk_f32_fp8(hi32, false), d_ = __builtin_amdgcn_cvt_pk_f32_fp8(hi32, true);
      qf[d0][0] = a_[0]; qf[d0][1] = a_[1]; qf[d0][2] = b_[0]; qf[d0][3] = b_[1]; qf[d0][4] = c_[0]; qf[d0][5] = c_[1]; qf[d0][6] = d_[0]; qf[d0][7] = d_[1];
#pragma unroll
      for (int j = 0; j < 8; ++j) ss += qf[d0][j] * qf[d0][j]; }
    ss = xhalf_sum(ss); const float rq = rsqrtf(ss * (1.f / 128.f) + EPS);
#pragma unroll
    for (int d0 = 0; d0 < 8; ++d0) { u32x4 w = {cvtpk(qf[d0][0] * rq, qf[d0][1] * rq), cvtpk(qf[d0][2] * rq, qf[d0][3] * rq), cvtpk(qf[d0][4] * rq, qf[d0][5] * rq), cvtpk(qf[d0][6] * rq, qf[d0][7] * rq)}; qr[d0] = *reinterpret_cast<bf16x8*>(&w); } }
  const float slope2 = __builtin_amdgcn_exp2f(-(float)(wid + 1)) * 1.4426950408889634f;
  float bo[16];
#pragma unroll
  for (int r = 0; r < 16; ++r) bo[r] = __uint_as_float(__builtin_amdgcn_readfirstlane(__float_as_uint(slope2 * (float)((r & 3) + 8 * (r >> 2)))));
  const float hoff = slope2 * (float)(4 * hi);
  const int vb0 = (int)(uintptr_t)(lds + 16384) + v_rd_base(lane);
  asm volatile("s_waitcnt vmcnt(0) lgkmcnt(0)\n\ts_barrier" ::: "memory");
  for (int j = 0; j < NT; ++j) {
    const int sl = j & 1;
    if (j + 1 < NT) DMA_TILE(j + 1, sl ^ 1);
    const char* Ks = lds + sl * 32768;
    const unsigned w0 = mk[(2 * j) * 32 + r32] >> (4 * hi), w1 = mk[(2 * j + 1) * 32 + r32] >> (4 * hi);
    f32x16 p0, p1;
    { const float kb0 = slope2 * (float)(j * 64) + hoff - m_reg, kb1 = kb0 + slope2 * 32.f;
#pragma unroll
      for (int r = 0; r < 16; ++r) { p0[r] = bo[r] + kb0; p1[r] = bo[r] + kb1; }
      bf16x8 ka = *reinterpret_cast<const bf16x8*>(Ks + KSWZ(r32, hi * 16)), kb = *reinterpret_cast<const bf16x8*>(Ks + KSWZ(32 + r32, hi * 16));
#pragma unroll
      for (int d0 = 0; d0 < 8; ++d0) { bf16x8 na = ka, nb = kb;
        if (d0 < 7) { const int cb = ((d0 + 1) * 16 + hi * 8) * 2; na = *reinterpret_cast<const bf16x8*>(Ks + KSWZ(r32, cb)); nb = *reinterpret_cast<const bf16x8*>(Ks + KSWZ(32 + r32, cb)); }
        SBAR();
        p0 = __builtin_amdgcn_mfma_f32_32x32x16_bf16(ka, qr[d0], p0, 0, 0, 0);
        p1 = __builtin_amdgcn_mfma_f32_32x32x16_bf16(kb, qr[d0], p1, 0, 0, 0);
        SBAR();
        ka = na; kb = nb; } }
    float alpha; bf16x8 pa0, pa1, pa2, pa3;
    {
#pragma unroll
      for (int r = 0; r < 16; ++r) { const int bit = (r & 3) + 8 * (r >> 2); p0[r] = msk(p0[r], w0, bit); p1[r] = msk(p1[r], w1, bit); }
      float pmax = fmaxf(p0[0], p1[0]);
#pragma unroll
      for (int r = 1; r < 16; ++r) pmax = fmaxf(fmaxf(pmax, p0[r]), p1[r]);
      { auto rr = __builtin_amdgcn_permlane32_swap(__float_as_uint(pmax), __float_as_uint(pmax), false, false); pmax = fmaxf(__uint_as_float(rr[0]), __uint_as_float(rr[1])); }
      alpha = 1.f;
      if (__builtin_expect(!__all(pmax <= THR2), 0)) {
        const float dl = fmaxf(pmax, 0.f); m_reg += dl; alpha = __builtin_amdgcn_exp2f(-dl);
#pragma unroll
        for (int r = 0; r < 16; ++r) { p0[r] -= dl; p1[r] -= dl; } }
      float ps = 0.f;
#pragma unroll
      for (int r = 0; r < 16; ++r) { p0[r] = __builtin_amdgcn_exp2f(p0[r]); p1[r] = __builtin_amdgcn_exp2f(p1[r]); ps += p0[r] + p1[r]; }
      { auto rr = __builtin_amdgcn_permlane32_swap(__float_as_uint(ps), __float_as_uint(ps), false, false); ps = __uint_as_float(rr[0]) + __uint_as_float(rr[1]); }
      l_reg = l_reg * alpha + ps;
#define PK4(P, BASE, OUT) do { unsigned a0 = cvtpk(P[BASE + 0], P[BASE + 1]), a1 = cvtpk(P[BASE + 2], P[BASE + 3]);   \
    unsigned b0 = cvtpk(P[BASE + 4], P[BASE + 5]), b1 = cvtpk(P[BASE + 6], P[BASE + 7]);                              \
    auto r0 = __builtin_amdgcn_permlane32_swap(a0, b0, false, false); auto r1 = __builtin_amdgcn_permlane32_swap(a1, b1, false, false); \
    u32x4 w = {r0[0], r1[0], r0[1], r1[1]}; OUT = *reinterpret_cast<bf16x8*>(&w); } while (0)
      PK4(p0, 0, pa0); PK4(p0, 8, pa1); PK4(p1, 0, pa2); PK4(p1, 8, pa3);
#undef PK4
      if (__any(alpha < 1.f)) { if (hi == 0) al_l[r32] = alpha; asm volatile("s_waitcnt lgkmcnt(0)" ::: "memory");
#pragma unroll
        for (int d = 0; d < 4; ++d)
#pragma unroll
          for (int r = 0; r < 16; ++r) o[d][r] *= al_l[crow(r, hi)]; }
    }
    { const int vb = vb0 + sl * 32768;
      s16x4 lA[4], hA[4], lB[4], hB[4];
#define VREADS(L_, H_, D0) do { L_[0] = tr_read<v_rd_off(D0, 0, 0)>(vb); H_[0] = tr_read<v_rd_off(D0, 0, 1)>(vb); L_[1] = tr_read<v_rd_off(D0, 1, 0)>(vb); H_[1] = tr_read<v_rd_off(D0, 1, 1)>(vb); \
      L_[2] = tr_read<v_rd_off(D0, 2, 0)>(vb); H_[2] = tr_read<v_rd_off(D0, 2, 1)>(vb); L_[3] = tr_read<v_rd_off(D0, 3, 0)>(vb); H_[3] = tr_read<v_rd_off(D0, 3, 1)>(vb); } while (0)
#define PK(L, H) (bf16x8){L[0], L[1], L[2], L[3], H[0], H[1], H[2], H[3]}
#define VMMA(OD, L_, H_) do { OD = __builtin_amdgcn_mfma_f32_32x32x16_bf16(pa0, PK(L_[0], H_[0]), OD, 0, 0, 0); OD = __builtin_amdgcn_mfma_f32_32x32x16_bf16(pa1, PK(L_[1], H_[1]), OD, 0, 0, 0); \
      OD = __builtin_amdgcn_mfma_f32_32x32x16_bf16(pa2, PK(L_[2], H_[2]), OD, 0, 0, 0); OD = __builtin_amdgcn_mfma_f32_32x32x16_bf16(pa3, PK(L_[3], H_[3]), OD, 0, 0, 0); } while (0)
#define VWAIT(N, L_, H_) do { asm volatile("s_waitcnt lgkmcnt(" #N ")" : "+v"(L_[0]), "+v"(L_[1]), "+v"(L_[2]), "+v"(L_[3]), "+v"(H_[0]), "+v"(H_[1]), "+v"(H_[2]), "+v"(H_[3]) :: "memory"); SBAR(); } while (0)
      VREADS(lA, hA, 0); VREADS(lB, hB, 1);
      VWAIT(8, lA, hA); VMMA(o[0], lA, hA);
      VREADS(lA, hA, 2);
      VWAIT(8, lB, hB); VMMA(o[1], lB, hB);
      VREADS(lB, hB, 3);
      VWAIT(8, lA, hA); VMMA(o[2], lA, hA);
      VWAIT(0, lB, hB); VMMA(o[3], lB, hB);
#undef VREADS
#undef PK
#undef VMMA
#undef VWAIT
    }
    asm volatile("s_waitcnt vmcnt(0) lgkmcnt(0)\n\ts_barrier" ::: "memory");
  }
  if (hi == 0) li_l[r32] = l_reg; asm volatile("s_waitcnt lgkmcnt(0)" ::: "memory");
  float rli[16];
#pragma unroll
  for (int r = 0; r < 16; ++r) rli[r] = __builtin_amdgcn_rcpf(li_l[crow(r, hi)]);
  unsigned char* stg = (unsigned char*)(lds + wid * 4096);
#pragma unroll
  for (int r = 0; r < 16; ++r) { const int orow = crow(r, hi); const float sc16 = rli[r] * 16.f;
#pragma unroll
    for (int d0 = 0; d0 < 4; ++d0) stg[orow * 128 + d0 * 32 + r32] = (unsigned char)__builtin_amdgcn_cvt_pk_fp8_f32(o[d0][r] * sc16, 0.f, 0, false); }
  asm volatile("s_waitcnt lgkmcnt(0)" ::: "memory");
#pragma unroll
  for (int i = 0; i < 4; ++i) { const int row = i * 8 + (lane >> 3), ch = lane & 7; const u32x4 v = *(const u32x4*)(stg + row * 128 + ch * 16);
    *(u32x4*)((unsigned char*)Ob + (size_t)row * 1024 + wid * 128 + ch * 16) = v; }
#undef DMA_TILE
}
#undef KSWZ
#undef SBAR
}


namespace ret {
using bf16x8 = __attribute__((ext_vector_type(8))) short;
using s16x4  = __attribute__((ext_vector_type(4))) short;
using u32x4  = __attribute__((ext_vector_type(4))) unsigned;
using u32x2  = __attribute__((ext_vector_type(2))) unsigned;
constexpr int C = 64, QP = 272, KPI = 272, VP = 576;
constexpr int OFF_Q = 0, OFF_K = 17408, OFF_V = 34816, OFF_ST = 71680, OFF_Y = 75776;
typedef float f32x2_t __attribute__((ext_vector_type(2))); typedef __bf16 bf16x2_t __attribute__((ext_vector_type(2)));
__device__ __forceinline__ unsigned cvtpk(float lo, float hi) { const f32x2_t v = {lo, hi}; const bf16x2_t b = __builtin_convertvector(v, bf16x2_t); return __builtin_bit_cast(unsigned, b); }
template <int OFF> __device__ __forceinline__ s16x4 trr(int base) { s16x4 r; asm volatile("ds_read_b64_tr_b16 %0, %1 offset:%2" : "=&v"(r) : "v"(base), "i"(OFF) : "memory"); return r; }
__device__ __forceinline__ bf16x8 pk8(const f32x16& x, int s) { u32x4 w = {cvtpk(x[8 * s + 0], x[8 * s + 1]), cvtpk(x[8 * s + 2], x[8 * s + 3]), cvtpk(x[8 * s + 4], x[8 * s + 5]), cvtpk(x[8 * s + 6], x[8 * s + 7])}; return *reinterpret_cast<bf16x8*>(&w); }
__device__ __forceinline__ float silu_(float x) { return x * __builtin_amdgcn_rcpf(1.f + __builtin_amdgcn_exp2f(-1.4426950408889634f * x)); }
__device__ __forceinline__ void ret_item(int b, int h, const unsigned char* __restrict__ RQ, const unsigned char* __restrict__ RK, const unsigned char* __restrict__ RV, const unsigned char* __restrict__ RG, unsigned char* A2F8, const float* __restrict__ gnorm, char* lds, int c0, int c1, float* state) {
  const int tid = threadIdx.x, w = __builtin_amdgcn_readfirstlane(tid >> 6), lane = tid & 63, r32 = lane & 31, hi = lane >> 5;
  const float lg = __log2f(1.f - exp2f(-5.f - (float)h)), gC = exp2f(64.f * lg);
  char* Qs = lds + OFF_Q; char* Ks = lds + OFF_K; char* Vs = lds + OFF_V; float* st = (float*)(lds + OFF_ST); char* Ys = lds + OFF_Y;
  f32x16 S[4] = {};
  if (c0 > 0) {
#pragma unroll
    for (int dt = 0; dt < 4; ++dt)
#pragma unroll
      for (int r = 0; r < 16; ++r) S[dt][r] = state[(dt * 16 + r) * 512 + tid]; }
  const unsigned voffQ = (unsigned)(((tid >> 4) * 512 + (tid & 15) * 8) * 2), voffV = (unsigned)(((tid >> 5) * 1024 + (tid & 31) * 8) * 2);
  const int trq = (lane & 15) >> 2, trp = lane & 3, trg = (lane >> 4) & 1;
  const int vtb = (int)(uintptr_t)(lds + OFF_V) + (4 * hi + trq) * VP + (32 * w + 16 * trg + 4 * trp) * 2, ktb = (int)(uintptr_t)(lds + OFF_K) + (4 * hi + trq) * KPI + (16 * trg + 4 * trp) * 2;
  u32x2 pq[2], pk[2], pv[4];
  const unsigned voffQ8 = (unsigned)((tid >> 4) * 512 + (tid & 15) * 8), voffV8 = voffV >> 1;
#define RET_LOAD(cc) do { const size_t t0_ = (size_t)b * SEQ + (size_t)(cc) * C; const unsigned char* qb_ = RQ + t0_ * 512 + h * 128; const unsigned char* kb_ = RK + t0_ * 512 + h * 128; const unsigned char* vb_ = RV + t0_ * 1024 + h * 256; \
    _Pragma("unroll") for (int i = 0; i < 2; ++i) { pq[i] = *(const u32x2*)(qb_ + voffQ8 + i * 16384); pk[i] = *(const u32x2*)(kb_ + voffQ8 + i * 16384); } \
    _Pragma("unroll") for (int i = 0; i < 4; ++i) pv[i] = *(const u32x2*)(vb_ + voffV8 + i * 16384); } while (0)
#define RET_F8(src_, f_, out_) do { const auto a_ = __builtin_amdgcn_cvt_pk_f32_fp8((int)(src_).x, false), b_ = __builtin_amdgcn_cvt_pk_f32_fp8((int)(src_).x, true), c_ = __builtin_amdgcn_cvt_pk_f32_fp8((int)(src_).y, false), d_ = __builtin_amdgcn_cvt_pk_f32_fp8((int)(src_).y, true); \
    out_.x = cvtpk(a_[0] * (f_), a_[1] * (f_)); out_.y = cvtpk(b_[0] * (f_), b_[1] * (f_)); out_.z = cvtpk(c_[0] * (f_), c_[1] * (f_)); out_.w = cvtpk(d_[0] * (f_), d_[1] * (f_)); } while (0)
#define RET_STAGE() do { \
    _Pragma("unroll") for (int i = 0; i < 2; ++i) { const int row = (tid >> 4) + 32 * i, ch = tid & 15; \
      u32x4 qo; RET_F8(pq[i], 1.f, qo); *(u32x4*)(Qs + row * QP + ch * 16) = qo; \
      const float f = exp2f(lg * (float)(C - 1 - row)) * 0.08838834764831845f; \
      u32x4 ko; RET_F8(pk[i], f, ko); *(u32x4*)(Ks + row * KPI + ch * 16) = ko; } \
    _Pragma("unroll") for (int i = 0; i < 4; ++i) { const int row = (tid >> 5) + 16 * i, ch = tid & 31; u32x4 vo; RET_F8(pv[i], 1.f, vo); *(u32x4*)(Vs + row * VP + ch * 16) = vo; } } while (0)
  RET_LOAD(c0);
  __syncthreads();
  RET_STAGE();
  if (c0 + 1 < c1) RET_LOAD(c0 + 1);
  __syncthreads();
  for (int c = c0; c < c1; ++c) {
    const size_t tok0 = (size_t)b * SEQ + (size_t)c * C;
    f32x16 ot[2] = {};
#pragma unroll
    for (int dt = 0; dt < 4; ++dt) {
#pragma unroll
      for (int s = 0; s < 2; ++s) { const bf16x8 af = pk8(S[dt], s);
#pragma unroll
        for (int nt = 0; nt < 2; ++nt) { const char* qp = Qs + (32 * nt + r32) * QP + (32 * dt + 16 * s + 4 * hi) * 2;
          const u32x2 lo = *(const u32x2*)qp, hi8 = *(const u32x2*)(qp + 16); const u32x4 bw = {lo.x, lo.y, hi8.x, hi8.y};
          ot[nt] = __builtin_amdgcn_mfma_f32_32x32x16_bf16(af, *reinterpret_cast<const bf16x8*>(&bw), ot[nt], 0, 0, 0); } }
      __builtin_amdgcn_sched_barrier(0); }
#pragma unroll
    for (int nt = 0; nt < 2; ++nt)
#pragma unroll
      for (int r = 0; r < 16; ++r) ot[nt][r] *= gC;
    __builtin_amdgcn_sched_barrier(0);
    bf16x8 vfr[4];
    { s16x4 vlo[4], vhi[4];
      vlo[0] = trr<0 * 16 * VP>(vtb); vhi[0] = trr<0 * 16 * VP + 8 * VP>(vtb); vlo[1] = trr<1 * 16 * VP>(vtb); vhi[1] = trr<1 * 16 * VP + 8 * VP>(vtb);
      vlo[2] = trr<2 * 16 * VP>(vtb); vhi[2] = trr<2 * 16 * VP + 8 * VP>(vtb); vlo[3] = trr<3 * 16 * VP>(vtb); vhi[3] = trr<3 * 16 * VP + 8 * VP>(vtb);
      asm volatile("s_waitcnt lgkmcnt(0)" : "+v"(vlo[0]), "+v"(vlo[1]), "+v"(vlo[2]), "+v"(vlo[3]), "+v"(vhi[0]), "+v"(vhi[1]), "+v"(vhi[2]), "+v"(vhi[3]) :: "memory"); __builtin_amdgcn_sched_barrier(0);
#pragma unroll
      for (int ks = 0; ks < 4; ++ks) vfr[ks] = (bf16x8){vlo[ks][0], vlo[ks][1], vlo[ks][2], vlo[ks][3], vhi[ks][0], vhi[ks][1], vhi[ks][2], vhi[ks][3]}; }
#pragma unroll
    for (int nt = 0; nt < 2; ++nt)
#pragma unroll
      for (int jt = 0; jt <= nt; ++jt) { f32x16 pt = {};
#pragma unroll
        for (int kk = 0; kk < 8; ++kk) { const bf16x8 ka = *(const bf16x8*)(Ks + (32 * jt + r32) * KPI + (16 * kk + 8 * hi) * 2), qb = *(const bf16x8*)(Qs + (32 * nt + r32) * QP + (16 * kk + 8 * hi) * 2);
          pt = __builtin_amdgcn_mfma_f32_32x32x16_bf16(ka, qb, pt, 0, 0, 0); }
        if (jt == nt) {
#pragma unroll
          for (int r = 0; r < 16; ++r) if (crow(r, hi) > r32) pt[r] = 0.f; }
#pragma unroll
        for (int s = 0; s < 2; ++s) ot[nt] = __builtin_amdgcn_mfma_f32_32x32x16_bf16(vfr[2 * jt + s], pk8(pt, s), ot[nt], 0, 0, 0);
        __builtin_amdgcn_sched_barrier(0); }
#pragma unroll
    for (int dt = 0; dt < 4; ++dt) {
#pragma unroll
      for (int r = 0; r < 16; ++r) S[dt][r] *= gC;
      s16x4 kl[4], kh[4];
      kl[0] = trr<0 * 16 * KPI>(ktb + dt * 64); kh[0] = trr<0 * 16 * KPI + 8 * KPI>(ktb + dt * 64); kl[1] = trr<1 * 16 * KPI>(ktb + dt * 64); kh[1] = trr<1 * 16 * KPI + 8 * KPI>(ktb + dt * 64);
      kl[2] = trr<2 * 16 * KPI>(ktb + dt * 64); kh[2] = trr<2 * 16 * KPI + 8 * KPI>(ktb + dt * 64); kl[3] = trr<3 * 16 * KPI>(ktb + dt * 64); kh[3] = trr<3 * 16 * KPI + 8 * KPI>(ktb + dt * 64);
      asm volatile("s_waitcnt lgkmcnt(0)" : "+v"(kl[0]), "+v"(kl[1]), "+v"(kl[2]), "+v"(kl[3]), "+v"(kh[0]), "+v"(kh[1]), "+v"(kh[2]), "+v"(kh[3]) :: "memory"); __builtin_amdgcn_sched_barrier(0);
#pragma unroll
      for (int ks = 0; ks < 4; ++ks) S[dt] = __builtin_amdgcn_mfma_f32_32x32x16_bf16((bf16x8){kl[ks][0], kl[ks][1], kl[ks][2], kl[ks][3], kh[ks][0], kh[ks][1], kh[ks][2], kh[ks][3]}, vfr[ks], S[dt], 0, 0, 0);
      __builtin_amdgcn_sched_barrier(0); }
    u32x2 gt4[4];
    { const unsigned char* gb_ = RG + tok0 * 1024 + h * 256;
#pragma unroll
      for (int i = 0; i < 4; ++i) gt4[i] = *(const u32x2*)(gb_ + (voffV >> 1) + i * 16384); }
#pragma unroll
    for (int nt = 0; nt < 2; ++nt) { const float rs = exp2f(lg * (float)(32 * nt + r32 + 1 - C)); float s1 = 0.f, s2 = 0.f;
#pragma unroll
      for (int r = 0; r < 16; ++r) { ot[nt][r] *= rs; s1 += ot[nt][r]; s2 += ot[nt][r] * ot[nt][r]; }
      s1 = xhalf_sum(s1); s2 = xhalf_sum(s2);
      if (hi == 0) { st[(w * 64 + 32 * nt + r32) * 2] = s1; st[(w * 64 + 32 * nt + r32) * 2 + 1] = s2; } }
    __syncthreads();
    if (c + 1 < c1) { RET_STAGE(); if (c + 2 < c1) RET_LOAD(c + 2); }
#pragma unroll
    for (int nt = 0; nt < 2; ++nt) { float s1 = 0.f, s2 = 0.f;
#pragma unroll
      for (int ww = 0; ww < 8; ++ww) { s1 += st[(ww * 64 + 32 * nt + r32) * 2]; s2 += st[(ww * 64 + 32 * nt + r32) * 2 + 1]; }
      const float mu = s1 * (1.f / 256.f), var = fmaxf(s2 * (1.f / 256.f) - mu * mu, 0.f), rstd = rsqrtf(var + EPS);
#pragma unroll
      for (int g = 0; g < 4; ++g) { float y[4];
#pragma unroll
        for (int j = 0; j < 4; ++j) y[j] = (ot[nt][4 * g + j] - mu) * rstd * gnorm[h * 256 + 32 * w + 8 * g + 4 * hi + j];
        const u32x2 o2 = {cvtpk(y[0], y[1]), cvtpk(y[2], y[3])};
        *(u32x2*)(Ys + (32 * nt + r32) * VP + (32 * w + 8 * g + 4 * hi) * 2) = o2; } }
    __syncthreads();
    { unsigned char* ob_ = A2F8 + tok0 * 1024 + h * 256;
#pragma unroll
      for (int i = 0; i < 4; ++i) { const int row = (tid >> 5) + 16 * i, ch = tid & 31;
        const u32x4 yv = *(const u32x4*)(Ys + row * VP + ch * 16); const u32x2 gt = gt4[i];
        const auto g01 = __builtin_amdgcn_cvt_pk_f32_fp8((int)gt.x, false), g23 = __builtin_amdgcn_cvt_pk_f32_fp8((int)gt.x, true), g45 = __builtin_amdgcn_cvt_pk_f32_fp8((int)gt.y, false), g67 = __builtin_amdgcn_cvt_pk_f32_fp8((int)gt.y, true);
        int w0 = __builtin_amdgcn_cvt_pk_fp8_f32(pg8::bf_lo(yv.x) * silu_(g01[0]), pg8::bf_hi(yv.x) * silu_(g01[1]), 0, false); w0 = __builtin_amdgcn_cvt_pk_fp8_f32(pg8::bf_lo(yv.y) * silu_(g23[0]), pg8::bf_hi(yv.y) * silu_(g23[1]), w0, true);
        int w1 = __builtin_amdgcn_cvt_pk_fp8_f32(pg8::bf_lo(yv.z) * silu_(g45[0]), pg8::bf_hi(yv.z) * silu_(g45[1]), 0, false); w1 = __builtin_amdgcn_cvt_pk_fp8_f32(pg8::bf_lo(yv.w) * silu_(g67[0]), pg8::bf_hi(yv.w) * silu_(g67[1]), w1, true);
        *(unsigned long long*)(ob_ + (size_t)row * 1024 + ch * 8) = (unsigned long long)(unsigned)w0 | ((unsigned long long)(unsigned)w1 << 32); } }
  }
  if (c1 < SEQ / C) {
#pragma unroll
    for (int dt = 0; dt < 4; ++dt)
#pragma unroll
      for (int r = 0; r < 16; ++r) state[(dt * 16 + r) * 512 + tid] = S[dt][r]; }
  __syncthreads();
#undef RET_LOAD
#undef RET_STAGE
#undef RET_F8
}
}


constexpr int RET_SPLIT = 28;
__device__ __forceinline__ int ret_wg_index(const Frame& F) { const int bx = (int)blockIdx.x, j = bx >> 3; return (j & 3) == 0 ? ((j >> 2) * 8 + (bx & 7)) : -1; }
__device__ __forceinline__ void p4_attn(Frame& F, const Args& a, unsigned char* lds_generic) {
    const size_t nt_ = (size_t)F.ntok;
    const bf16* QA = (const bf16*)(F.act + nt_ * O_QA); bf16* ATT = (bf16*)(F.act + nt_ * O_QA);
    unsigned char* aux = a.xb + nt_ * 2048;
    const bf16* KP = (const bf16*)(aux + nt_ * AUX_KP); const bf16* VV = (const bf16*)(aux + nt_ * AUX_VV); const unsigned* MASK = (const unsigned*)(aux + nt_ * AUX_MASK);
    volatile LAS unsigned* MISC = (volatile LAS unsigned*)(F.lds + MISC_OFF);
    unsigned* qctr = (unsigned*)(F.ws + WS_CTL) + CW_Q4;
    const unsigned char* RQ = F.act + nt_ * O_RQ; const unsigned char* RK = F.act + nt_ * O_RK; const unsigned char* RV = F.act + nt_ * O_RV; const unsigned char* RG = F.act + nt_ * O_RG;
    const int nb = F.ntok / SEQ, nret = nb * 4, nitems = nb * 64;
    { const int ri = ret_wg_index(F); if (ri >= 0 && ri < nret && RET_SPLIT < SEQ / 64)
        ret::ret_item(ri >> 2, ri & 3, RQ, RK, RV, RG, A2F8_PTR, a.in[8], (char*)lds_generic, RET_SPLIT, SEQ / 64, RSTATE_PTR + (size_t)ri * 32768); }
    __syncthreads(); if (F.tid == 0) MISC[0] = atomicAdd(qctr, 1u); __syncthreads();
    int it = (int)MISC[0];
    while (it < nitems) {
        unsigned nxt_ = 0u; if (F.tid == 0) nxt_ = atomicAdd(qctr, 1u);
        const int qb = 63 - it / nb, b = it % nb, NT = (qb >> 1) + 1;
        const size_t row0 = (size_t)b * SEQ + qb * 32;
        att::attn_item((const bf16*)((const unsigned char*)QA + row0 * 1024), KP + (size_t)b * SEQ * 128, VV + (size_t)b * SEQ * 128, MASK + (size_t)b * 64 * 2048 + qb * 32, (bf16*)((unsigned char*)ATT + row0 * 1024), NT, (char*)lds_generic, F.lds);
        __syncthreads(); if (F.tid == 0) MISC[0] = nxt_; __syncthreads();
        it = (int)MISC[0];
    }
}


__device__ __forceinline__ void p7_router(Frame& F, const Args& a) {
    const int lane = F.lane, r32 = lane & 31, hi = lane >> 5, tid = F.tid;
    unsigned char* mo = F.act; unsigned char* N2 = mo + MO_N2; unsigned char* meta = mo + MO_META;
    (void)meta; int* LTOK = (int*)(mo + MO_LIST); float* LRS = (float*)(mo + MO_LIST) + 24 * LIST_CAP; float* LCL = LRS + 24 * LIST_CAP; float* LCH = LCL + 24 * LIST_CAP;
    const bf16* Wh = (const bf16*)(F.ws + WS_WR); const bf16* Wl = Wh + 32 * 1024;
    const float* g2 = a.in[12]; const float* b_gr = a.in[14]; const float* b_er = a.in[16];
    const bf16* hbase = (const bf16*)(F.act + MO_H16);
    unsigned* gcnt = (unsigned*)(F.ws + WS_CTL) + CW_MOE;
    LAS unsigned* lcnt = (LAS unsigned*)(F.lds + RING_OFF);
    if (tid < 64) lcnt[tid] = 0u;
    LAS unsigned char* Wlds = F.lds + 20480; LAS float* g2l = (LAS float*)(F.lds + 20480 + 98304);
    for (int i = tid; i < 2 * 24 * 128; i += NWAVES * 64) { const int c = i & 127, n = (i >> 7) % 24, hl = i / (24 * 128);
        *(LAS v4u*)(Wlds + (hl * 24 + n) * 2048 + ((c ^ (n & 15)) * 16)) = *(const v4u*)((hl ? Wl : Wh) + (size_t)n * 1024 + c * 8); }
    for (int i = tid; i < 256; i += NWAVES * 64) *(LAS f32x4*)(g2l + i * 4) = *(const f32x4*)(g2 + i * 4);
    __syncthreads();
    const int ntasks = F.ntok / 32, tpw = ntasks / F.G;
    const int tw = F.wave & 3, kh = F.wave >> 2;
    const bool have = tw < tpw; const int t = (F.vcu * tpw + tw) * 32 + r32;
    LAS float* xch = (LAS float*)(F.lds + RING_OFF + 1024);
    int bucket = 0, posl = 0; float clo = 0.f, chi = 0.f, rstd = 0.f;
    f32x16 acc = f32x16{}; float ss = 0.f;
    if (have) {
        const bf16* hrow = hbase + (size_t)t * D + hi * 8 + kh * 512; unsigned char* nrow = N2 + (size_t)t * D + hi * 8 + kh * 512;
        const LAS float* g2k = g2l + kh * 512 + hi * 8; const int rr = r32 < 24 ? r32 : r32 - 8;
        const LAS unsigned char* whk = Wlds + rr * 2048; const LAS unsigned char* wlk = Wlds + (24 + rr) * 2048; const int c0 = kh * 64 + hi, sw = rr & 15;
#pragma unroll 8
        for (int kk = 0; kk < 32; ++kk) {
            const v4u hv = *(const v4u*)(hrow + kk * 16); const f32x4 a0 = {pg8::bf_lo(hv.x), pg8::bf_hi(hv.x), pg8::bf_lo(hv.y), pg8::bf_hi(hv.y)}, a1 = {pg8::bf_lo(hv.z), pg8::bf_hi(hv.z), pg8::bf_lo(hv.w), pg8::bf_hi(hv.w)};
            const f32x4 q0 = *(const LAS f32x4*)(g2k + kk * 16), q1 = *(const LAS f32x4*)(g2k + kk * 16 + 4);
            ss += (a0.x * a0.x + a0.y * a0.y) + (a0.z * a0.z + a0.w * a0.w) + (a1.x * a1.x + a1.y * a1.y) + (a1.z * a1.z + a1.w * a1.w);
            const float x[8] = {a0.x * q0.x, a0.y * q0.y, a0.z * q0.z, a0.w * q0.w, a1.x * q1.x, a1.y * q1.y, a1.z * q1.z, a1.w * q1.w};
            unsigned hb[8]; float lo[8];
#pragma unroll
            for (int j = 0; j < 8; ++j) { hb[j] = f2bf(x[j]); lo[j] = x[j] - __uint_as_float(hb[j] << 16); }
            v4u xh; xh.x = hb[0] | (hb[1] << 16); xh.y = hb[2] | (hb[3] << 16); xh.z = hb[4] | (hb[5] << 16); xh.w = hb[6] | (hb[7] << 16);
            v4u xl; xl.x = pk2(lo[0], lo[1]); xl.y = pk2(lo[2], lo[3]); xl.z = pk2(lo[4], lo[5]); xl.w = pk2(lo[6], lo[7]);
            { int w0 = __builtin_amdgcn_cvt_pk_fp8_f32(x[0], x[1], 0, false); w0 = __builtin_amdgcn_cvt_pk_fp8_f32(x[2], x[3], w0, true); int w1 = __builtin_amdgcn_cvt_pk_fp8_f32(x[4], x[5], 0, false); w1 = __builtin_amdgcn_cvt_pk_fp8_f32(x[6], x[7], w1, true);
              *(unsigned long long*)(nrow + kk * 16) = (unsigned long long)(unsigned)w0 | ((unsigned long long)(unsigned)w1 << 32); }
            const int co = ((c0 + kk * 2) ^ sw) * 16; const bf16x8_t wh = *(const LAS bf16x8_t*)(whk + co), wl = *(const LAS bf16x8_t*)(wlk + co);
            const bf16x8_t bh = __builtin_bit_cast(bf16x8_t, xh), bl = __builtin_bit_cast(bf16x8_t, xl);
            acc = __builtin_amdgcn_mfma_f32_32x32x16_bf16(wh, bh, acc, 0, 0, 0);
            acc = __builtin_amdgcn_mfma_f32_32x32x16_bf16(wh, bl, acc, 0, 0, 0);
            acc = __builtin_amdgcn_mfma_f32_32x32x16_bf16(wl, bh, acc, 0, 0, 0);
        }
        if (kh == 1) {
#pragma unroll
            for (int r = 0; r < 16; ++r) xch[(tw * 17 + r) * 64 + lane] = acc[r];
            xch[(tw * 17 + 16) * 64 + lane] = ss; }
    }
    __syncthreads();
    if (have && kh == 0) {
#pragma unroll
        for (int r = 0; r < 16; ++r) acc[r] += xch[(tw * 17 + r) * 64 + lane];
        ss += xch[(tw * 17 + 16) * 64 + lane];
        ss = xhalf_sum(ss); rstd = rsqrtf(ss * (1.f / D) + EPS);
        float L[24];
#pragma unroll
        for (int r = 0; r < 12; ++r) { const float v = acc[r]; auto rr = __builtin_amdgcn_permlane32_swap(__float_as_uint(v), __float_as_uint(v), false, false);
            L[(r & 3) + 8 * (r >> 2)] = __uint_as_float(rr[0]); L[(r & 3) + 8 * (r >> 2) + 4] = __uint_as_float(rr[1]); }
        float gl[4];
#pragma unroll
        for (int i = 0; i < 4; ++i) gl[i] = L[i] * rstd + b_gr[i];
        int g = 0; float gm = gl[0];
#pragma unroll
        for (int i = 1; i < 4; ++i) if (gl[i] > gm) { gm = gl[i]; g = i; }
        float se = 0.f;
#pragma unroll
        for (int i = 0; i < 4; ++i) se += __expf(gl[i] - gm);
        const float gw = 1.f / se;
        float el[4];
#pragma unroll
        for (int i = 0; i < 4; ++i) { const float l0 = L[4 + i], l1 = L[8 + i], l2 = L[12 + i], l3 = L[16 + i]; const float lv = g == 0 ? l0 : (g == 1 ? l1 : (g == 2 ? l2 : l3));
            const float b0 = b_er[i], b1 = b_er[4 + i], b2 = b_er[8 + i], b3 = b_er[12 + i]; el[i] = lv * rstd + (g == 0 ? b0 : (g == 1 ? b1 : (g == 2 ? b2 : b3))); }
        int i1 = 0; float v1 = el[0];
#pragma unroll
        for (int i = 1; i < 4; ++i) if (el[i] > v1) { v1 = el[i]; i1 = i; }
        int i2 = -1; float v2 = 0.f;
#pragma unroll
        for (int i = 0; i < 4; ++i) if (i != i1 && (i2 < 0 || el[i] > v2)) { v2 = el[i]; i2 = i; }
        const float e2 = __expf(v2 - v1), p1 = gw / (1.f + e2), p2 = gw * e2 / (1.f + e2);
        const int lo_ = i1 < i2 ? i1 : i2, hi_ = i1 < i2 ? i2 : i1;
        const int pair = lo_ == 0 ? (hi_ - 1) : (lo_ == 1 ? (hi_ + 1) : 5);
        bucket = g * 6 + pair; clo = i1 < i2 ? p1 : p2; chi = i1 < i2 ? p2 : p1;
        if (hi == 0) posl = (int)__hip_atomic_fetch_add(&lcnt[bucket], 1u, __ATOMIC_RELAXED, __HIP_MEMORY_SCOPE_WORKGROUP);
    }
    __syncthreads();
    if (tid < 24) lcnt[32 + tid] = atomicAdd(gcnt + tid, lcnt[tid]);
    __syncthreads();
    if (have && kh == 0 && hi == 0) { const int li = bucket * LIST_CAP + (int)lcnt[32 + bucket] + posl; LTOK[li] = t; LRS[li] = rstd; LCL[li] = clo; LCH[li] = chi; }
}
__device__ __forceinline__ int moe_tiles(const unsigned* gcnt, int* rowstart  ) { int rs = 0;
    for (int b = 0; b < 24; ++b) { rowstart[b] = rs; rs += (int)((gcnt[b] + 255u) & ~255u); } rowstart[24] = rs; return rs >> 8; }
template <bool GATHER_> struct MoeOrder {
    static constexpr bool GATHER = GATHER_; const int* ptok;
    int ntile, G, c; const char* A; size_t tA; const char* W; int mode; const LAS unsigned char* tb; size_t rowB;
    __device__ bool next(int i, pg8::Unit& u) const {
        const long L = (long)i * G + c; if (L >= (long)ntile * 4) return false;
        u.pm = (int)(L >> 2); u.pn = (int)(L & 3); u.a = GATHER_ ? A : A + (size_t)u.pm * tA;
        const int bk = tb[u.pm], g = bk / 6, pr = bk % 6; { const LAS int* t24 = (const LAS int*)(tb + 512); const int rs_ = t24[bk], cn_ = t24[24 + bk], left = cn_ - (u.pm * 256 - rs_); u.aux = bk * LIST_CAP - rs_; u.nvalid = left < 0 ? 0 : (left > 256 ? 256 : left); } const int lo = pr < 3 ? 0 : (pr < 5 ? 1 : 2), hi = pr < 3 ? pr + 1 : (pr < 5 ? pr - 1 : 3);
        const int elo = g * 4 + lo, ehi = g * 4 + hi;
        if (mode == 1) { const int e = u.pn < 2 ? elo : ehi; u.b = W + ((size_t)e * 512 + (size_t)(u.pn & 1) * 256) * rowB; u.bjump = 0; }
        else { u.b = W + ((size_t)elo * 1024 + (size_t)u.pn * 256) * rowB; u.bjump = (long)(ehi - elo) * 1024 * (long)rowB - (long)rowB; }
        return true;
    }
    __device__ __forceinline__ void a_ready(const pg8::Unit&) const {}
    __device__ __forceinline__ void done(const pg8::Unit&) const {}
};
__device__ __forceinline__ float silu_f(float x) { return x * __builtin_amdgcn_rcpf(1.f + __builtin_amdgcn_exp2f(-1.4426950408889634f * x)); }
struct EpiMoe1 {
    static constexpr bool PERM = true, AFTER_DRAIN = false;
    unsigned char* ACT; const float* PRS; const float* PCL; const float* PCH;
    __device__ __forceinline__ void operator()(const pg8::f32x4 (&acc)[2][2][4][2], const pg8::Unit& u, int wr, int wc, int fr, int fq) const {
        const int row0 = u.pm * pg8::BM + wr * 64 + fr, slot = u.pn >> 1, fcol0 = slot * 256 + (u.pn & 1) * 128 + wc * 16 + 4 * fq; const float* PC = slot ? PCH : PCL;
#pragma unroll
        for (int ai = 0; ai < 2; ++ai)
#pragma unroll
            for (int m = 0; m < 4; ++m) { const int row = row0 + ai * pg8::HALF + m * 16; const bool ok = (wr * 64 + fr + ai * pg8::HALF + m * 16) < u.nvalid; const float rs = ok ? PRS[u.aux + row] : 0.f, cw = ok ? PC[u.aux + row] * 16.f : 0.f; unsigned char* rowp = ACT + (size_t)row * 512 + fcol0;
#pragma unroll
                for (int bj = 0; bj < 2; ++bj) { const pg8::f32x4 v0 = acc[ai][bj][m][0], v1 = acc[ai][bj][m][1];
                    const float a0 = silu_f(v0[0] * rs) * (v0[1] * rs) * cw, a1 = silu_f(v0[2] * rs) * (v0[3] * rs) * cw, a2 = silu_f(v1[0] * rs) * (v1[1] * rs) * cw, a3 = silu_f(v1[2] * rs) * (v1[3] * rs) * cw;
                    int w = __builtin_amdgcn_cvt_pk_fp8_f32(a0, a1, 0, false); w = __builtin_amdgcn_cvt_pk_fp8_f32(a2, a3, w, true); *(int*)(rowp + bj * 64) = w; } }
    }
};
struct EpiMoe2 {
    static constexpr bool PERM = true, AFTER_DRAIN = false;
    float* out; const pg8::bf16_t* h16; const int* PTOK;
    __device__ __forceinline__ void operator()(const pg8::f32x4 (&acc)[2][2][4][2], const pg8::Unit& u, int wr, int wc, int fr, int fq) const {
        const int row0 = u.pm * pg8::BM + wr * 64 + fr, col0 = u.pn * pg8::BM + wc * 32 + 8 * fq;
        int tk[2][4]; pg8::u32x4 hl[2][4][2];
#pragma unroll
        for (int ai = 0; ai < 2; ++ai)
#pragma unroll
            for (int m = 0; m < 4; ++m) { const int rr_ = wr * 64 + fr + ai * pg8::HALF + m * 16; tk[ai][m] = rr_ < u.nvalid ? PTOK[u.aux + row0 + ai * pg8::HALF + m * 16] : -1; }
#pragma unroll
        for (int ai = 0; ai < 2; ++ai)
#pragma unroll
            for (int m = 0; m < 4; ++m) { const pg8::bf16_t* hp = h16 + (size_t)(tk[ai][m] < 0 ? 0 : tk[ai][m]) * 1024 + col0;
#pragma unroll
                for (int bj = 0; bj < 2; ++bj) hl[ai][m][bj] = *(const pg8::u32x4*)(hp + bj * pg8::HALF); }
#pragma unroll
        for (int ai = 0; ai < 2; ++ai)
#pragma unroll
            for (int m = 0; m < 4; ++m) if (tk[ai][m] >= 0) { float* rowp = out + (size_t)tk[ai][m] * 1024 + col0;
#pragma unroll
                for (int bj = 0; bj < 2; ++bj) { const pg8::u32x4 hv = hl[ai][m][bj];
                    const pg8::f32x4 h0 = {pg8::bf_lo(hv.x), pg8::bf_hi(hv.x), pg8::bf_lo(hv.y), pg8::bf_hi(hv.y)}, h1 = {pg8::bf_lo(hv.z), pg8::bf_hi(hv.z), pg8::bf_lo(hv.w), pg8::bf_hi(hv.w)};
                    *(pg8::f32x4*)(rowp + bj * pg8::HALF) = h0 + acc[ai][bj][m][0]; *(pg8::f32x4*)(rowp + bj * pg8::HALF + 4) = h1 + acc[ai][bj][m][1]; } }
    }
};
__device__ __forceinline__ int moe_setup(Frame& F, LAS unsigned char* tb) {
    const unsigned* gcnt = (const unsigned*)(F.ws + WS_CTL) + CW_MOE;
    LAS int* nt_ = (LAS int*)(tb + 256);
    __syncthreads();
    if (F.tid == 0) { LAS int* t24 = (LAS int*)(tb + 512); int tl = 0; for (int b = 0; b < 24; ++b) { const int n = (int)((gcnt[b] + 255u) >> 8); t24[b] = tl * 256; t24[24 + b] = (int)gcnt[b]; for (int i = 0; i < n; ++i) tb[tl + i] = (unsigned char)b; tl += n; } nt_[0] = tl; }
    __syncthreads();
    return nt_[0];
}

__global__ void __launch_bounds__(NWAVES * 64, 2) mk_fwd(Args args) {
    extern __shared__ __attribute__((aligned(16))) unsigned char lds[];
    Frame F;
    F.lds = (LAS unsigned char*)lds;
    F.tid = threadIdx.x; F.lane = F.tid & 63; F.wave = __builtin_amdgcn_readfirstlane(F.tid >> 6);
    F.G = gridDim.x; { const int bx = blockIdx.x; F.vcu = (F.G % 8 == 0) ? (bx % 8) * (F.G / 8) + bx / 8 : bx; }
    F.ntok = args.ntok; F.ws = args.ws; F.act = args.ws + WS_ACT; F.xbp = args.xb;
    const int lo = args.ph_lo, hi = args.ph_hi;
    cooperative_groups::grid_group grid = cooperative_groups::this_grid();
    volatile LAS unsigned* MISCW = (volatile LAS unsigned*)(F.lds + MISC_OFF);
    for (int u = F.tid; u < (LDS_BYTES - LDSCTL_OFF) / 4; u += NWAVES * 64) ((LAS unsigned*)(F.lds + LDSCTL_OFF))[u] = 0u;
    __syncthreads();
    XcdBarrier bar = xcd_barrier_post((unsigned*)(F.ws + WS_CTL) + CW_BAR, MISCW + 8);
#define IN(k) (lo <= (k) && (k) < hi)
#define SEAM(k) do { if (IN(k) && IN((k) + 1)) { xcd_barrier(bar); } } while (0)
    if (IN(0)) { p0_prologue(F, args); }
    SEAM(0);
    if (IN(1)) {
        EpiProj E{F.act, (size_t)F.ntok, RSTD1_PTR};
        { pg8::Gemm g{512, 512, 512, 8};
          P1Order S; S.nM = F.ntok / 256; S.nN = 25; S.nwg = S.nM * 25; S.G = F.G; S.c = (int)blockIdx.x; S.mode = 0; S.A = (const char*)(args.xb + (size_t)F.ntok * AUX_XB8); S.Bt = (const char*)(F.ws + WS_WIN8); S.tA = (size_t)256 * 1024; S.tB = (size_t)256 * 1024;
          pg8::gemm_phase<EpiProj, P1Order, true, true, true>(F.lds + RING_OFF, g, S, E); }
        { pg8::Gemm g{1024, 1024, 1024, 16};
          P1Order S; S.nM = F.ntok / 256; S.nN = 3; S.nwg = S.nM * 3; S.G = F.G; S.c = ((int)blockIdx.x + F.G / 2) % F.G; S.mode = 1; S.A = (const char*)args.xb; S.Bt = (const char*)(F.ws + WS_WIN); S.tA = (size_t)256 * 2048; S.tB = (size_t)256 * 2048;
          pg8::gemm_phase<EpiProj, P1Order, true, true, false>(F.lds + RING_OFF, g, S, E); }
    }
    SEAM(1);
    if (IN(2)) { p2_post(F, args); }
    SEAM(2);
    if (IN(3)) {
        const int ri = ret_wg_index(F), nret = (F.ntok / SEQ) * 4;
        if (ri < 0) p3_index(F, args);
        else if (ri < nret) { const size_t nt_ = (size_t)F.ntok;
            ret::ret_item(ri >> 2, ri & 3, F.act + nt_ * O_RQ, F.act + nt_ * O_RK, F.act + nt_ * O_RV, F.act + nt_ * O_RG, A2F8_PTR, args.in[8], (char*)lds, 0, RET_SPLIT, RSTATE_PTR + (size_t)ri * 32768); }
    }
    SEAM(3);
    if (IN(4)) { p4_attn(F, args, lds); }
    SEAM(4);
    if (IN(5)) {
        const size_t nt_ = (size_t)F.ntok;
        const unsigned char* GA8 = F.act + nt_ * O_GA; const unsigned char* GR8 = F.act + nt_ * O_GR;
        pg8::Gemm g{512, 512, 512, 8, 122, 123};
        GateOrder S; S.S0.init(F.ntok, 1024, F.G, (int)blockIdx.x, F.act + nt_ * O_QA, 512, F.ws + WS_WATT8, 512); S.A1 = (const char*)A2F8_PTR; S.B1 = (const char*)(F.ws + WS_WRET8);
        EpiGateFused E{GA8, GR8, F.act + nt_ * O_MIX8};
        pg8::gemm_phase<EpiGateFused, GateOrder, true, true, true>(F.lds + RING_OFF, g, S, E);
    }
    SEAM(5);
    if (IN(6)) {
        pg8::Gemm g{512, 512, 512, 8, 122, 124}; const size_t nt_ = (size_t)F.ntok;
        pg8::StaticOrder S; S.init(F.ntok, 1024, F.G, (int)blockIdx.x, F.act + nt_ * O_MIX8, 512, F.ws + WS_WOUT8, 512);
        EpiResid E{(const pg8::bf16_t*)args.xb, (pg8::bf16_t*)(F.act + MO_H16)};
        pg8::gemm_phase<EpiResid, pg8::StaticOrder, true, true, true>(F.lds + RING_OFF, g, S, E);
    }
    SEAM(6);
    if (IN(7)) { p7_router(F, args); }
    SEAM(7);
    if (IN(9)) {
        LAS unsigned char* tb = F.lds + LDSCTL_OFF - 1024; const int ntile = moe_setup(F, tb);
        unsigned char* meta = F.act + MO_META;
        pg8::Gemm g{512, 512, 512, 8, 122, 127};
        MoeOrder<true> S{(const int*)(F.act + MO_LIST), ntile, F.G, (int)blockIdx.x, (const char*)(F.act + MO_N2), (size_t)0, (const char*)(F.ws + WS_W18), 1, tb, (size_t)1024};
        EpiMoe1 E{(unsigned char*)(F.act + MO_ACT), (const float*)(F.act + MO_LIST) + 24 * LIST_CAP, (const float*)(F.act + MO_LIST) + 48 * LIST_CAP, (const float*)(F.act + MO_LIST) + 72 * LIST_CAP};
        pg8::gemm_phase<EpiMoe1, MoeOrder<true>, true, true, true>(F.lds + RING_OFF, g, S, E);
    }
    SEAM(9);
    if (IN(10)) {
        LAS unsigned char* tb = F.lds + LDSCTL_OFF - 1024; const int ntile = moe_setup(F, tb);
        unsigned char* meta = F.act + MO_META;
        pg8::Gemm g{256, 256, 128, 2, 123, 123};
        MoeOrder<false> S{nullptr, ntile, F.G, (int)blockIdx.x, (const char*)(F.act + MO_ACT), (size_t)256 * 512, (const char*)(F.ws + WS_WD8), 2, tb, (size_t)256};
        EpiMoe2 E{args.out + (size_t)args.tok0 * D, (const pg8::bf16_t*)(F.act + MO_H16), (const int*)(F.act + MO_LIST)};
        pg8::gemm_phase<EpiMoe2, MoeOrder<false>, true, true, true>(F.lds + RING_OFF, g, S, E);
    }
    if (hi - lo > 1) grid.sync();
#undef IN
#undef SEAM
}

extern "C" void kernel_launch(void* const* d_in, const int* in_sizes, int n_in, void* d_out, int out_size, void* d_ws, size_t ws_size, hipStream_t stream) {
    static int grid = 0;
    if (grid == 0) {
        int dev = 0, cus = 0, per_cu = 0;
        (void)hipGetDevice(&dev); (void)hipDeviceGetAttribute(&cus, hipDeviceAttributeMultiprocessorCount, dev);
        if (hipFuncSetAttribute((const void*)mk_fwd, hipFuncAttributeMaxDynamicSharedMemorySize, LDS_BYTES) != hipSuccess) { fprintf(stderr, "kernel_launch: hipFuncSetAttribute failed\n"); grid = -1; return; }
        (void)hipOccupancyMaxActiveBlocksPerMultiprocessor(&per_cu, (const void*)mk_fwd, NWAVES * 64, LDS_BYTES);
        (void)hipGetLastError();
        if (per_cu < 1) { fprintf(stderr, "kernel_launch: occupancy query says %d blocks per CU\n", per_cu); per_cu = 1; }
        grid = cus * per_cu;
        if (n_in != 20 || ws_size < (size_t)512 * MiB) { fprintf(stderr, "kernel_launch: unexpected n_in %d / ws_size %zu\n", n_in, ws_size); grid = -1; return; }
        if (grid != 256) { fprintf(stderr, "kernel_launch: this kernel's phase schedules are written for a 256-workgroup grid (256 CUs x 1); the device reports %d x %d; nothing launched\n", cus, per_cu); grid = -1; return; }
    }
    if (grid < 0) return;
    float* out = (float*)d_out;
    unsigned char* ws = (unsigned char*)d_ws;
    (void)in_sizes; (void)out_size;
    (void)hipMemsetAsync(ws + WS_CTL, 0, CTL_ZERO_BYTES, stream);
    Args a{};
    for (int i = 0; i < 20; ++i) a.in[i] = (const float*)d_in[i];
    a.out = out; a.ws = ws; a.xb = (unsigned char*)d_out; a.ntok = T; a.tok0 = 0;
    void* kargs[] = {(void*)&a};
    if (PROBE_PH >= 0) { a.ph_lo = PROBE_PH; a.ph_hi = PROBE_PH + 1; a.mode = PROBE_MODE;
        (void)hipLaunchCooperativeKernel((const void*)mk_fwd, dim3(grid), dim3(NWAVES * 64), kargs, (unsigned)LDS_BYTES, stream);
        (void)hipMemsetAsync(ws + WS_CTL, 0, CTL_ZERO_BYTES, stream); }
    a.ph_lo = 0; a.ph_hi = 11; a.mode = 0;
    const hipError_t le = hipLaunchCooperativeKernel((const void*)mk_fwd, dim3(grid), dim3(NWAVES * 64), kargs, (unsigned)LDS_BYTES, stream);
    if (le != hipSuccess) fprintf(stderr, "kernel_launch: cooperative launch failed: %s (grid %d)\n", hipGetErrorString(le), grid);
}
```

```cpp
#include <hip/hip_runtime.h>
#include <hip/hip_cooperative_groups.h>
#include <cstdio>
#include <cstdint>

namespace pg8 {
#define PG8_LAS __attribute__((address_space(3)))
typedef unsigned short bf16_t;
typedef short bf16x8 __attribute__((ext_vector_type(8)));
typedef float f32x4 __attribute__((ext_vector_type(4)));
typedef unsigned u32x4 __attribute__((ext_vector_type(4)));
typedef unsigned u32x2 __attribute__((ext_vector_type(2)));
typedef int v4i_t __attribute__((ext_vector_type(4)));
typedef int v8i_t __attribute__((ext_vector_type(8)));
constexpr int BM = 256, BK = 64, HALF = 128, HTB = HALF * BK * 2  , STAGE_BYTES = 8 * HTB, NXCD = 8, WGM = 8;

__host__ __device__ __forceinline__ int lds_byte(int r, int c) { const int st = (r >> 4) * 2 + (c >> 5), rr = r & 15, cc = c & 31, ob = rr * 64 + cc * 2; return st * 1024 + (ob ^ (((ob >> 9) & 1) << 5)); }
__host__ __device__ __forceinline__ void stage_rc(int b, int& R, int& C) { const int st = b / 1024, sb = b % 1024, swz = sb ^ (((sb >> 9) & 1) << 5); R = (st >> 1) * 16 + swz / 64; C = (st & 1) * 32 + (swz % 64) / 2; }
__host__ __device__ __forceinline__ int perm32(int rho) { const int n = rho >> 4, i = rho & 15; return 8 * (i >> 2) + 4 * n + (i & 3); }

struct Unit { int pm, pn; const char* a; const char* b; long bjump; int aux; int nvalid; };
struct Gemm { int K, lda, ldb, ksplit; int sw = 122, sa = 127; };

struct StaticOrder {
    static constexpr bool GATHER = false; const int* ptok = nullptr;
    int nM, nN, nwg, G, c; const char* A; const char* Bt; size_t tA, tB;
    __device__ void init(int M, int N, int G_, int c_, const void* A_, int lda, const void* Bt_, int ldb) { nM = M / BM; nN = N / BM; nwg = nM * nN; G = G_; c = c_; A = (const char*)A_; Bt = (const char*)Bt_; tA = (size_t)BM * lda * 2; tB = (size_t)BM * ldb * 2; }
    __device__ bool next(int i, Unit& u) const {
        const long L = (long)i * G + c; if (L >= nwg) return false;
        int wgid = (int)L; { const int q = nwg / NXCD, r = nwg % NXCD, xcd = wgid % NXCD, off = wgid / NXCD; wgid = (xcd < r ? xcd * (q + 1) : r * (q + 1) + (xcd - r) * q) + off; }
        const int nig = WGM * nN, gid = wgid / nig, fm = gid * WGM, gsz = (nM - fm) < WGM ? (nM - fm) : WGM;
        u.pm = fm + ((wgid % nig) % gsz); u.pn = (wgid % nig) / gsz; u.a = A + (size_t)u.pm * tA; u.b = Bt + (size_t)u.pn * tB; u.bjump = 0; u.aux = 0; u.nvalid = 256; return true;
    }
    __device__ __forceinline__ void a_ready(const Unit&) const {}
    __device__ __forceinline__ void done(const Unit&) const {}
};

typedef float f32x2c __attribute__((ext_vector_type(2))); typedef __bf16 bf16x2c __attribute__((ext_vector_type(2)));
__device__ __forceinline__ unsigned cvt_pk_bf16(float lo, float hi) { const f32x2c v = {lo, hi}; const bf16x2c b = __builtin_convertvector(v, bf16x2c); return __builtin_bit_cast(unsigned, b); }
__device__ __forceinline__ float bf_lo(unsigned w) { return __uint_as_float(w << 16); }
__device__ __forceinline__ float bf_hi(unsigned w) { return __uint_as_float(w & 0xffff0000u); }


template <class E, class = void> struct epi_keeps { static constexpr bool v = false; };
template <class E> struct epi_keeps<E, decltype((void)E::KEEPS)> { static constexpr bool v = E::KEEPS; };
template <class Epi, class Sched, bool ALIGN_EPI = false, bool SP2 = false, bool FP8 = false>
__device__ __forceinline__ void gemm_phase(PG8_LAS unsigned char* lds, const Gemm g, const Sched& S, const Epi& E) {
    int tid = threadIdx.x; asm volatile("" : "+v"(tid));
    const int wid = __builtin_amdgcn_readfirstlane(tid >> 6), lane = tid & 63, wr = wid >> 2, wc = wid & 3, fr = lane & 15, fq = lane >> 4;
    const int K = g.K, nt = K / BK;
    unsigned voffA[2], voffB[2]; int gR[2]; unsigned gC[2];
#pragma unroll
    for (int i = 0; i < 2; ++i) { int R, C; stage_rc(tid * 16 + i * 8192, R, C); const int Rb = Epi::PERM ? ((R & ~31) + perm32(R & 31)) : R; gR[i] = R; gC[i] = (unsigned)C * 2u;
        voffA[i] = (unsigned)(R * g.lda + C) * 2u; voffB[i] = (unsigned)(Rb * g.ldb + C) * 2u; }
    unsigned gA0[2] = {0u, 0u}, gA1[2] = {0u, 0u}, gN0[2] = {0u, 0u}, gN1[2] = {0u, 0u};
#define PG8_GOFF(u_, o0, o1) do { _Pragma("unroll") for (int i_ = 0; i_ < 2; ++i_) { const int r0_ = gR[i_], r1_ = HALF + gR[i_]; const int t0_ = r0_ < (u_).nvalid ? S.ptok[(u_).aux + (u_).pm * BM + r0_] : 0, t1_ = r1_ < (u_).nvalid ? S.ptok[(u_).aux + (u_).pm * BM + r1_] : 0; \
        o0[i_] = (unsigned)t0_ * (unsigned)(g.lda * 2) + gC[i_]; o1[i_] = (unsigned)t1_ * (unsigned)(g.lda * 2) + gC[i_]; } } while (0)
    const size_t kstep = (size_t)(BK * 2);
    const size_t hstepA = Sched::GATHER ? (size_t)0 : (size_t)HALF * g.lda * 2, hstepB = (size_t)HALF * g.ldb * 2;
    const unsigned ldsw = (unsigned)wid * 1024u;
    const int aoff = lds_byte(wr * 64 + fr, fq * 8), boff = lds_byte(wc * 32 + fr, fq * 8);
#define PG8_CAT(x0, x1) __builtin_shufflevector(__builtin_bit_cast(v4i_t, x0), __builtin_bit_cast(v4i_t, x1), 0, 1, 2, 3, 4, 5, 6, 7)
#define PG8_SA(b, h) (((b) * 2 + (h)) * HTB)
#define PG8_SB(b, h) ((4 + (b) * 2 + (h)) * HTB)
#define PG8_STAGE(bufoff, gbase, voff) do { _Pragma("unroll") for (int _i = 0; _i < 2; ++_i) \
        __builtin_amdgcn_global_load_lds((const unsigned*)((const char*)(gbase) + (voff)[_i]), (PG8_LAS unsigned*)(lds + (bufoff) + ldsw + _i * 8192), 16, 0, 0); } while (0)
#define PG8_LDA(dst, b, h) do { if constexpr (FP8) { _Pragma("unroll") for (int m = 0; m < 4; ++m) dst##8[m] = PG8_CAT(*(const PG8_LAS bf16x8*)(lds + PG8_SA(b, h) + aoff + m * 2048), *(const PG8_LAS bf16x8*)(lds + PG8_SA(b, h) + aoff + m * 2048 + 1024)); } \
      else { _Pragma("unroll") for (int m = 0; m < 4; ++m) _Pragma("unroll") for (int k = 0; k < 2; ++k) dst[m][k] = *(const PG8_LAS bf16x8*)(lds + PG8_SA(b, h) + aoff + m * 2048 + k * 1024); } } while (0)
#define PG8_LDB(dst, b, h) do { if constexpr (FP8) { _Pragma("unroll") for (int n = 0; n < 2; ++n) dst##8[n] = PG8_CAT(*(const PG8_LAS bf16x8*)(lds + PG8_SB(b, h) + boff + n * 2048), *(const PG8_LAS bf16x8*)(lds + PG8_SB(b, h) + boff + n * 2048 + 1024)); } \
      else { _Pragma("unroll") for (int n = 0; n < 2; ++n) _Pragma("unroll") for (int k = 0; k < 2; ++k) dst[n][k] = *(const PG8_LAS bf16x8*)(lds + PG8_SB(b, h) + boff + n * 2048 + k * 1024); } } while (0)
#define PG8_MMA(ai, bj, At, Bt) do { __builtin_amdgcn_s_setprio(1); if constexpr (FP8) { _Pragma("unroll") for (int m = 0; m < 4; ++m) _Pragma("unroll") for (int n = 0; n < 2; ++n) \
        asm volatile("v_mfma_scale_f32_16x16x128_f8f6f4 %0, %1, %2, %0, %3, %4 op_sel_hi:[0,0,0]" : "+v"(acc[ai][bj][m][n]) : "v"(Bt##8[n]), "v"(At##8[m]), "v"(scw8), "v"(sca8)); } \
      else { _Pragma("unroll") for (int m = 0; m < 4; ++m) _Pragma("unroll") for (int n = 0; n < 2; ++n) _Pragma("unroll") for (int k = 0; k < 2; ++k) \
        acc[ai][bj][m][n] = __builtin_amdgcn_mfma_f32_16x16x32_bf16(Bt[n][k], At[m][k], acc[ai][bj][m][n], 0, 0, 0); } __builtin_amdgcn_s_setprio(0); } while (0)
#define PG8_WAIT_V(n) asm volatile("s_waitcnt vmcnt(" #n ")" ::: "memory")
#define PG8_WAIT_L(n) asm volatile("s_waitcnt lgkmcnt(" #n ")" ::: "memory")
#define PG8_BAR __builtin_amdgcn_s_barrier()
#define PG8_SCHED __builtin_amdgcn_sched_barrier(0)
    Unit cur, nxt; int ui = 0;
    if (!S.next(0, cur)) return;
    f32x4 acc[2][2][4][2];
#pragma unroll
    for (int a = 0; a < 2; ++a)
#pragma unroll
        for (int b = 0; b < 2; ++b)
#pragma unroll
            for (int m = 0; m < 4; ++m)
#pragma unroll
                for (int n = 0; n < 2; ++n) acc[a][b][m][n] = (f32x4){0.f, 0.f, 0.f, 0.f};
    int scw8 = g.sw, sca8 = g.sa; asm volatile("" : "+v"(scw8), "+v"(sca8));
    bf16x8 At[4][2], B0[2][2], B1[2][2]; v8i_t At8[4], B08[2], B18[2];
    const char* cA = cur.a; const char* cB = cur.b; long cJ = cur.bjump;
    S.a_ready(cur);
    if constexpr (SP2) {
        if constexpr (Sched::GATHER) PG8_GOFF(cur, gA0, gA1);
        PG8_STAGE(PG8_SB(0, 0), cB, voffB); PG8_STAGE(PG8_SB(0, 1), cB + hstepB, voffB); do { if constexpr (Sched::GATHER) { PG8_STAGE(PG8_SA(0, 0), cA, gA0); } else { PG8_STAGE(PG8_SA(0, 0), cA, voffA); } } while (0); do { if constexpr (Sched::GATHER) { PG8_STAGE(PG8_SA(0, 1), cA, gA1); } else { PG8_STAGE(PG8_SA(0, 1), cA + hstepA, voffA); } } while (0);
        if (wr == 1) PG8_BAR;
        PG8_WAIT_V(2); PG8_BAR;
        PG8_STAGE(PG8_SB(1, 0), cB + kstep, voffB); do { if constexpr (Sched::GATHER) { PG8_STAGE(PG8_SA(1, 0), cA + kstep, gA0); } else { PG8_STAGE(PG8_SA(1, 0), cA + kstep, voffA); } } while (0); PG8_STAGE(PG8_SB(1, 1), cB + hstepB + kstep, voffB);
        PG8_WAIT_V(6); PG8_BAR;
    } else {
        PG8_STAGE(PG8_SB(0, 0), cB, voffB); PG8_STAGE(PG8_SA(0, 0), cA, voffA); PG8_STAGE(PG8_SB(0, 1), cB + hstepB, voffB); PG8_STAGE(PG8_SA(0, 1), cA + hstepA, voffA);
        if (wr == 1) PG8_BAR;
        PG8_WAIT_V(4); PG8_BAR;
        PG8_STAGE(PG8_SB(1, 0), cB + kstep, voffB); PG8_STAGE(PG8_SA(1, 0), cA + kstep, voffA); PG8_STAGE(PG8_SB(1, 1), cB + hstepB + kstep, voffB);
        PG8_WAIT_V(6); PG8_BAR;
    }
    for (;;) {
        const bool has_next = S.next(ui + 1, nxt);
        const char* nA = has_next ? nxt.a : cA; const char* nB = has_next ? nxt.b : cB;
        if constexpr (Sched::GATHER) { if (has_next) PG8_GOFF(nxt, gN0, gN1); else { gN0[0] = gA0[0]; gN0[1] = gA0[1]; gN1[0] = gA1[0]; gN1[1] = gA1[1]; } }
#pragma unroll 1
        for (int t = 0; t < nt; t += 2) {
            const bool last = (t == nt - 2);
            const char* a1 = cA + (size_t)(t + 1) * kstep;
            const char* a2 = last ? nA : cA + (size_t)(t + 2) * kstep; const char* b2 = last ? nB : cB + (size_t)(t + 2) * kstep + ((t + 2) >= g.ksplit ? cJ : 0L);
            const char* a3 = a2 + kstep; const char* b3 = b2 + kstep;
            if (last && has_next) S.a_ready(nxt);
            unsigned x0[2] = {0u, 0u}, x1[2] = {0u, 0u};
            if constexpr (Sched::GATHER) { x0[0] = last ? gN0[0] : gA0[0]; x0[1] = last ? gN0[1] : gA0[1]; x1[0] = last ? gN1[0] : gA1[0]; x1[1] = last ? gN1[1] : gA1[1]; }
            if constexpr (SP2) {
            PG8_LDB(B0, 0, 0); PG8_LDB(B1, 0, 1); PG8_SCHED; PG8_LDA(At, 0, 0); do { if constexpr (Sched::GATHER) { PG8_STAGE(PG8_SA(1, 1), a1, gA1); } else { PG8_STAGE(PG8_SA(1, 1), a1 + hstepA, voffA); } } while (0);
            PG8_WAIT_V(8); PG8_WAIT_L(0); PG8_BAR; PG8_MMA(0, 0, At, B0); PG8_MMA(0, 1, At, B1); PG8_BAR; PG8_SCHED;
            PG8_LDA(At, 0, 1); PG8_STAGE(PG8_SB(0, 0), b2, voffB); PG8_STAGE(PG8_SB(0, 1), b2 + hstepB, voffB); do { if constexpr (Sched::GATHER) { PG8_STAGE(PG8_SA(0, 0), a2, x0); } else { PG8_STAGE(PG8_SA(0, 0), a2, voffA); } } while (0);
            PG8_WAIT_V(8); PG8_WAIT_L(0); PG8_BAR; PG8_MMA(1, 0, At, B0); PG8_MMA(1, 1, At, B1); PG8_BAR; PG8_SCHED;
            PG8_LDB(B0, 1, 0); PG8_LDB(B1, 1, 1); PG8_SCHED; PG8_LDA(At, 1, 0); do { if constexpr (Sched::GATHER) { PG8_STAGE(PG8_SA(0, 1), a2, x1); } else { PG8_STAGE(PG8_SA(0, 1), a2 + hstepA, voffA); } } while (0);
            PG8_WAIT_V(8); PG8_WAIT_L(0); PG8_BAR; PG8_MMA(0, 0, At, B0); PG8_MMA(0, 1, At, B1); PG8_BAR; PG8_SCHED;
            PG8_LDA(At, 1, 1); PG8_STAGE(PG8_SB(1, 0), b3, voffB); PG8_STAGE(PG8_SB(1, 1), b3 + hstepB, voffB); do { if constexpr (Sched::GATHER) { PG8_STAGE(PG8_SA(1, 0), a3, x0); } else { PG8_STAGE(PG8_SA(1, 0), a3, voffA); } } while (0);
            PG8_WAIT_V(8); PG8_WAIT_L(0); PG8_BAR; PG8_MMA(1, 0, At, B0); PG8_MMA(1, 1, At, B1); PG8_BAR; PG8_SCHED;
            } else {
            PG8_LDB(B0, 0, 0); PG8_SCHED; PG8_LDA(At, 0, 0); PG8_STAGE(PG8_SA(1, 1), a1 + hstepA, voffA);
            PG8_WAIT_L(8); PG8_BAR; PG8_WAIT_L(0); PG8_MMA(0, 0, At, B0); PG8_BAR; PG8_SCHED;
            PG8_LDB(B1, 0, 1); PG8_STAGE(PG8_SB(0, 0), b2, voffB);
            PG8_BAR; PG8_WAIT_L(0); PG8_MMA(0, 1, At, B1); PG8_BAR;
            PG8_LDA(At, 0, 1); PG8_STAGE(PG8_SA(0, 0), a2, voffA);
            PG8_BAR; PG8_WAIT_L(0); PG8_MMA(1, 0, At, B0); PG8_BAR; PG8_SCHED;
            PG8_STAGE(PG8_SB(0, 1), b2 + hstepB, voffB);
            PG8_WAIT_V(6); PG8_BAR; PG8_MMA(1, 1, At, B1); PG8_BAR;
            PG8_LDB(B0, 1, 0); PG8_SCHED; PG8_LDA(At, 1, 0); PG8_STAGE(PG8_SA(0, 1), a2 + hstepA, voffA);
            PG8_WAIT_L(8); PG8_BAR; PG8_WAIT_L(0); PG8_MMA(0, 0, At, B0); PG8_BAR; PG8_SCHED;
            PG8_LDB(B1, 1, 1); PG8_STAGE(PG8_SB(1, 0), b3, voffB);
            PG8_BAR; PG8_WAIT_L(0); PG8_MMA(0, 1, At, B1); PG8_BAR;
            PG8_LDA(At, 1, 1); PG8_STAGE(PG8_SA(1, 0), a3, voffA);
            PG8_BAR; PG8_WAIT_L(0); PG8_MMA(1, 0, At, B0); PG8_BAR; PG8_SCHED;
            PG8_STAGE(PG8_SB(1, 1), b3 + hstepB, voffB);
            PG8_WAIT_V(6); PG8_BAR; PG8_MMA(1, 1, At, B1); PG8_BAR;
            }
        }
        if constexpr (ALIGN_EPI) { if (wr == 0) PG8_BAR; }
        bool keep_acc = false;
        if constexpr (epi_keeps<Epi>::v) { keep_acc = E.keep(cur); if (keep_acc) E.mid(acc, cur, wr, wc, fr, fq); else E(acc, cur, wr, wc, fr, fq); S.done(cur); } else
        if constexpr (!Epi::AFTER_DRAIN) { E(acc, cur, wr, wc, fr, fq); S.done(cur); }
        if (!has_next) break;
        if (!keep_acc) {
#pragma unroll
        for (int a = 0; a < 2; ++a)
#pragma unroll
            for (int b = 0; b < 2; ++b)
#pragma unroll
                for (int m = 0; m < 4; ++m)
#pragma unroll
                    for (int n = 0; n < 2; ++n) acc[a][b][m][n] = (f32x4){0.f, 0.f, 0.f, 0.f};
        }
        cur = nxt; cA = nA; cB = nB; cJ = cur.bjump; ++ui;
        if constexpr (Sched::GATHER) { gA0[0] = gN0[0]; gA0[1] = gN0[1]; gA1[0] = gN1[0]; gA1[1] = gN1[1]; }
        if constexpr (ALIGN_EPI) { if (wr == 1) PG8_BAR; }
    }
    PG8_WAIT_V(0);
    if constexpr (!ALIGN_EPI) { if (wr == 0) PG8_BAR; }
    PG8_BAR;
    if constexpr (Epi::AFTER_DRAIN) { E.fused(acc, cur, wr, wc, fr, fq, lds, wid, lane); S.done(cur); }
#undef PG8_GOFF
#undef PG8_SA
#undef PG8_SB
#undef PG8_STAGE
#undef PG8_LDA
#undef PG8_LDB
#undef PG8_MMA
#undef PG8_CAT
#undef PG8_WAIT_V
#undef PG8_WAIT_L
#undef PG8_BAR
#undef PG8_SCHED
}
}

#ifndef PROBE_PH
#define PROBE_PH (-1)
#endif
#ifndef PROBE_MODE
#define PROBE_MODE (0)
#endif
constexpr int D = 1024, BATCH = 16, SEQ = 2048, T = BATCH * SEQ;
constexpr int INW = 6984, INWP = 7168;
constexpr int C_QA = 0, C_CKV = 1024, C_QI = 1280, C_KI = 1792, C_WI = 1856, C_RQ = 1864, C_RK = 2376, C_RV = 2888, C_RG = 3912, C_GA = 4936, C_GR = 5960;
constexpr float EPS = 1e-6f;
constexpr int NWAVES = 8;

constexpr size_t MiB = 1u << 20;
constexpr size_t WS_CTL = 0, CTL_ZERO_BYTES = 1 * MiB;
constexpr size_t WS_WIN = 1 * MiB, WS_WKV = 15 * MiB, WS_WATT = 16 * MiB, WS_WRET = 18 * MiB, WS_WOUT = 20 * MiB, WS_W1 = 22 * MiB, WS_WD = 38 * MiB, WS_ACT = 46 * MiB;
constexpr size_t O_QA = 0, O_CKV = 2048, O_QI = 2560, O_KW = 3584, O_RQ = 3840, O_RK = 4864, O_RV = 5888, O_RG = 7936, O_GA = 9984, O_GR = 12032, O_END = 14080;

constexpr int MP_ROWS = 38912;
constexpr size_t MO_APERM = 0, MO_ACT = 80 * MiB, MO_N2 = 120 * MiB, MO_META = 184 * MiB;
constexpr size_t MM_B = 0, MM_P = 131072, MM_CL = 262144, MM_CH = 393216, MM_RS = 524288, MM_PTOK = 655360, MM_PRS = 819200, MM_PCL = 983040, MM_PCH = 1146880, MM_END = 1310720;
constexpr size_t WS_WR = 15 * MiB + 512 * 1024;
constexpr size_t O_A2F8 = 1024;
constexpr size_t O_RSTATE = O_RQ + 512;
#define A2F8_PTR (F.act + (size_t)F.ntok * O_A2F8)
#define RSTATE_PTR ((float*)(F.act + (size_t)F.ntok * O_RSTATE))
#define RSTD1_PTR ((float*)(F.act + (size_t)F.ntok * O_RSTATE + 8 * MiB))
constexpr size_t MO_LIST = 152 * MiB; constexpr int LIST_CAP = 32768;
constexpr size_t MO_H16 = 192 * MiB;
constexpr size_t WS_WIN8 = 488 * MiB;
constexpr size_t WS_WATT8 = 495 * MiB, WS_WRET8 = 496 * MiB, WS_WOUT8 = 497 * MiB;
constexpr size_t O_MIX8 = 3840;
constexpr size_t WS_W18 = 498 * MiB, WS_WD8 = 506 * MiB;
constexpr size_t AUX_XB8 = 2048 + 896;
constexpr int F8_FIRST_TILE = 8;
constexpr int CW_MOE = 256;
constexpr int RING_OFF = 0, RING_BYTES = 131072, P3_HIST_OFF = 131072, P3_TOT_OFF = 147456, P3_T_OFF = 149504, LDSCTL_OFF = 151552, MISC_OFF = LDSCTL_OFF + 320, LDS_BYTES = 152576;
constexpr int CW_Q3 = 64, CW_Q4 = 128;

#define GAS __attribute__((address_space(1)))
#define LAS __attribute__((address_space(3)))
typedef unsigned short bf16;
typedef unsigned v4u __attribute__((ext_vector_type(4)));
typedef float f32x4 __attribute__((ext_vector_type(4)));
#define LDS_WAIT() asm volatile("s_waitcnt lgkmcnt(0)" ::: "memory")
#define VM_WAIT() asm volatile("s_waitcnt vmcnt(0)" ::: "memory")
__device__ __forceinline__ unsigned pk2(float lo, float hi) { return pg8::cvt_pk_bf16(lo, hi); }
__device__ __forceinline__ unsigned f2bf(float f) { return pg8::cvt_pk_bf16(f, 0.f) & 0xffffu; }
__device__ __forceinline__ float bf2f(bf16 b) { return __uint_as_float((unsigned)b << 16); }


typedef GAS unsigned gu32;
constexpr int CW_BAR = 4096;
#define XB_TMO      128
#define XB_XCNT(j)  (256  + 64 * (j))
#define XB_XSUB(j)  (1280 + 64 * (j))
#define XB_XGEN(j)  (2304 + 64 * (j))
#define XB_TOP      3328
#define XB_TOPGEN   3392
#define XCD_BAR_WORDS 3456
#define XB_SPIN_CAP (1u << 18)

__device__ __forceinline__ unsigned xb_ld(unsigned* p)              { return __hip_atomic_load(p, __ATOMIC_RELAXED, __HIP_MEMORY_SCOPE_AGENT); }
__device__ __forceinline__ unsigned xb_add(unsigned* p, unsigned v) { return __hip_atomic_fetch_add(p, v, __ATOMIC_RELAXED, __HIP_MEMORY_SCOPE_AGENT); }
__device__ __forceinline__ unsigned xb_xcc_id() { return (unsigned)__builtin_amdgcn_s_getreg((3 << 11) | 20) & 0xFu; }
#define XB_SPIN(cond, bar) do { unsigned _sp = 0; while (cond) { __builtin_amdgcn_s_sleep(1); \
    if ((++_sp & 255u) == 0u) { if (xb_ld(&(bar)[XB_TMO])) break; if (_sp > XB_SPIN_CAP) { atomicAdd(&(bar)[XB_TMO], 1u); break; } } } } while (0)

struct XcdBarrier {
    unsigned* bar; unsigned x;
    volatile LAS unsigned* st;
};

__device__ __forceinline__ XcdBarrier xcd_barrier_post(unsigned* bar, volatile LAS unsigned* st) {
    XcdBarrier b; b.bar = bar; b.x = xb_xcc_id(); b.st = st;
    if (threadIdx.x == 0) (void)xb_add(&bar[XB_XCNT(b.x)], 1u);
    return b;
}
__device__ __forceinline__ void xcd_barrier_complete(unsigned* bar, unsigned x, unsigned& nloc, unsigned& nx) {
    const unsigned G = gridDim.x * gridDim.y * gridDim.z;
    unsigned sum, cnt, mine, sp = 0u;
    for (;;) {
        sum = 0u; cnt = 0u; mine = 0u;
#pragma unroll
        for (unsigned j = 0; j < 16; ++j) { const unsigned c = xb_ld(&bar[XB_XCNT(j)]); sum += c; cnt += (c > 0u) ? 1u : 0u; mine = (j == x) ? c : mine; }
        if (sum == G) break;
        __builtin_amdgcn_s_sleep(1);
        if ((++sp & 255u) == 0u) { if (xb_ld(&bar[XB_TMO])) break; if (sp > XB_SPIN_CAP) { atomicAdd(&bar[XB_TMO], 1u); break; } }
    }
    nloc = mine > 0u ? mine : 1u; nx = cnt > 0u ? cnt : 1u;
}

__device__ __forceinline__ void xcd_barrier(const XcdBarrier& b) {
    asm volatile("s_waitcnt vmcnt(0)" ::: "memory");
    __syncthreads();
    if (threadIdx.x == 0) {
        unsigned* bar = b.bar;
        __builtin_amdgcn_s_waitcnt(0);
        unsigned nloc = b.st[0], nx = b.st[1];
        if (nloc == 0u) { xcd_barrier_complete(bar, b.x, nloc, nx); b.st[0] = nloc; b.st[1] = nx; }
        const unsigned old = xb_add(&bar[XB_XSUB(b.x)], 1u);
        const unsigned gen = old / nloc;
        if (old + 1u == (gen + 1u) * nloc) {
            __builtin_amdgcn_fence(__ATOMIC_RELEASE, "agent");
            asm volatile("s_waitcnt vmcnt(0)" ::: "memory");
            const unsigned og = xb_add(&bar[XB_TOP], 1u);
            const unsigned tg = og / nx;
            if (og + 1u == (tg + 1u) * nx) xb_add(&bar[XB_TOPGEN], 1u);
            else XB_SPIN(xb_ld(&bar[XB_TOPGEN]) == tg, bar);
            __builtin_amdgcn_fence(__ATOMIC_ACQUIRE, "agent");
            xb_add(&bar[XB_XGEN(b.x)], 1u);
            asm volatile("s_waitcnt vmcnt(0)" ::: "memory");
        } else {
            XB_SPIN(xb_ld(&bar[XB_XGEN(b.x)]) == gen, bar);
            __builtin_amdgcn_fence(__ATOMIC_ACQUIRE, "agent");
            asm volatile("s_waitcnt vmcnt(0)" ::: "memory");
        }
    }
    __syncthreads();
}

struct Args { const float* in[20]; float* out; unsigned char* ws; unsigned char* xb; int ph_lo, ph_hi, ntok, tok0, mode, pad; };

struct Frame {
    LAS unsigned char* lds;
    int tid, lane, wave, vcu, G;
    int ntok;
    unsigned char* ws; unsigned char* act; unsigned char* xbp;
};

struct EpiProj {
    static constexpr bool PERM = true, AFTER_DRAIN = false;
    unsigned char* act; size_t ntok; const float* rstd1;
    static __device__ __forceinline__ unsigned q4(const pg8::f32x4& v) { int w = __builtin_amdgcn_cvt_pk_fp8_f32(v[0], v[1], 0, false); return (unsigned)__builtin_amdgcn_cvt_pk_fp8_f32(v[2], v[3], w, true); }
    __device__ __forceinline__ void operator()(const pg8::f32x4 (&acc)[2][2][4][2], const pg8::Unit& u, int wr, int wc, int fr, int fq) const {
        const int pn = u.pn; size_t O; int ld, cb, nbj = 2; bool f8 = false;
        if (pn < 4) { O = O_QA; ld = 1024; cb = pn * 256; }
        else if (pn == 4) { O = O_CKV; ld = 256; cb = 0; }
        else if (pn < 7) { O = O_QI; ld = 512; cb = (pn - 5) * 256; }
        else if (pn == 7) { O = O_KW; ld = 128; cb = 0; nbj = 1; }
        else if (pn < 10) { O = O_RQ; ld = 512; cb = (pn - 8) * 256; }
        else if (pn < 12) { O = O_RK; ld = 512; cb = (pn - 10) * 256; }
        else { O = O_RV + (size_t)((pn - 12) >> 2) * 2048; ld = 1024; cb = ((pn - 12) & 3) * 256; }
        f8 = pn < 5 || pn >= F8_FIRST_TILE;
        const int row0 = u.pm * pg8::BM + wr * 64 + fr;
        if (f8) {
            unsigned char* base = act + ntok * O; const bool odd = fq & 1; const int colb = cb + wc * 32 + 8 * (fq & ~1);
#pragma unroll
            for (int ai = 0; ai < 2; ++ai)
#pragma unroll
                for (int bj = 0; bj < 2; ++bj)
#pragma unroll
                    for (int mp = 0; mp < 2; ++mp) { const unsigned x0 = q4(acc[ai][bj][2 * mp][0]), x1 = q4(acc[ai][bj][2 * mp][1]), y0 = q4(acc[ai][bj][2 * mp + 1][0]), y1 = q4(acc[ai][bj][2 * mp + 1][1]);
                        const unsigned r0 = (unsigned)__builtin_amdgcn_ds_swizzle((int)(odd ? x0 : y0), 0x401F), r1 = (unsigned)__builtin_amdgcn_ds_swizzle((int)(odd ? x1 : y1), 0x401F);
                        pg8::u32x4 w; if (odd) { w.x = r0; w.y = r1; w.z = y0; w.w = y1; } else { w.x = x0; w.y = x1; w.z = r0; w.w = r1; }
                        *(pg8::u32x4*)(base + (size_t)(row0 + ai * pg8::HALF + (2 * mp + (odd ? 1 : 0)) * 16) * ld + colb + bj * pg8::HALF) = w; }
            return;
        }
        pg8::bf16_t* base = (pg8::bf16_t*)(act + ntok * O);
        const int col0 = cb + wc * 32 + 8 * fq;
        float rs1[2][4];
#pragma unroll
        for (int ai = 0; ai < 2; ++ai)
#pragma unroll
            for (int m = 0; m < 4; ++m) rs1[ai][m] = rstd1[row0 + ai * pg8::HALF + m * 16];
#pragma unroll
        for (int ai = 0; ai < 2; ++ai)
#pragma unroll
            for (int m = 0; m < 4; ++m) { pg8::bf16_t* rowp = base + (size_t)(row0 + ai * pg8::HALF + m * 16) * ld + col0; const float rs = rs1[ai][m];
#pragma unroll
                for (int bj = 0; bj < 2; ++bj) if (bj < nbj) { const pg8::f32x4 v0 = acc[ai][bj][m][0] * rs, v1 = acc[ai][bj][m][1] * rs;
                    pg8::u32x4 w; w.x = pg8::cvt_pk_bf16(v0[0], v0[1]); w.y = pg8::cvt_pk_bf16(v0[2], v0[3]); w.z = pg8::cvt_pk_bf16(v1[0], v1[1]); w.w = pg8::cvt_pk_bf16(v1[2], v1[3]);
                    *(pg8::u32x4*)(rowp + bj * pg8::HALF) = w; } }
    }
};

__device__ __forceinline__ float sigm(float x) { return __builtin_amdgcn_rcpf(1.f + __builtin_amdgcn_exp2f(-1.4426950408889634f * x)); }
__device__ __forceinline__ void f8x8(const pg8::u32x2 g, float (&f)[8]) { const auto a = __builtin_amdgcn_cvt_pk_f32_fp8((int)g.x, false), b = __builtin_amdgcn_cvt_pk_f32_fp8((int)g.x, true), c = __builtin_amdgcn_cvt_pk_f32_fp8((int)g.y, false), d = __builtin_amdgcn_cvt_pk_f32_fp8((int)g.y, true);
    f[0] = a[0]; f[1] = a[1]; f[2] = b[0]; f[3] = b[1]; f[4] = c[0]; f[5] = c[1]; f[6] = d[0]; f[7] = d[1]; }
__device__ __forceinline__ void st_f8_pair(unsigned char* base, size_t ld, int row_m0, int colb, bool odd, unsigned x0, unsigned x1, unsigned y0, unsigned y1) {
    const unsigned r0 = (unsigned)__builtin_amdgcn_ds_swizzle((int)(odd ? x0 : y0), 0x401F), r1 = (unsigned)__builtin_amdgcn_ds_swizzle((int)(odd ? x1 : y1), 0x401F);
    pg8::u32x4 w; if (odd) { w.x = r0; w.y = r1; w.z = y0; w.w = y1; } else { w.x = x0; w.y = x1; w.z = r0; w.w = r1; }
    *(pg8::u32x4*)(base + (size_t)(row_m0 + (odd ? 16 : 0)) * ld + colb) = w;
}
__device__ __forceinline__ unsigned q4f(float a, float b, float c, float d) { int w = __builtin_amdgcn_cvt_pk_fp8_f32(a, b, 0, false); return (unsigned)__builtin_amdgcn_cvt_pk_fp8_f32(c, d, w, true); }
struct GateOrder {
    static constexpr bool GATHER = false; const int* ptok = nullptr;
    pg8::StaticOrder S0; const char* A1; const char* B1;
    __device__ bool next(int i, pg8::Unit& u) const { if (!S0.next(i >> 1, u)) return false; if (i & 1) { u.a = A1 + (size_t)u.pm * S0.tA; u.b = B1 + (size_t)u.pn * S0.tB; u.aux = 1; } return true; }
    __device__ __forceinline__ void a_ready(const pg8::Unit&) const {}
    __device__ __forceinline__ void done(const pg8::Unit&) const {}
};
__device__ __forceinline__ float sigm_c(float x) { return __builtin_amdgcn_rcpf(1.f + __builtin_amdgcn_exp2f(-1.4426950408889634f * fmaxf(x, -40.f))); }
struct EpiGateFused {
    static constexpr bool PERM = true, AFTER_DRAIN = false, KEEPS = true;
    const unsigned char* GA8; const unsigned char* GR8; unsigned char* MIX8;
    __device__ __forceinline__ bool keep(const pg8::Unit& u) const { return u.aux == 0; }
    __device__ __forceinline__ void mid(pg8::f32x4 (&acc)[2][2][4][2], const pg8::Unit& u, int wr, int wc, int fr, int fq) const {
        const int row0 = u.pm * pg8::BM + wr * 64 + fr, col0 = u.pn * pg8::BM + wc * 32 + 8 * fq;
#pragma unroll
        for (int ai = 0; ai < 2; ++ai) { pg8::u32x2 ga[2][4], gr[2][4];
#pragma unroll
            for (int bj = 0; bj < 2; ++bj)
#pragma unroll
                for (int m = 0; m < 4; ++m) { const size_t ro = (size_t)(row0 + ai * pg8::HALF + m * 16) * 1024 + col0 + bj * pg8::HALF; ga[bj][m] = *(const pg8::u32x2*)(GA8 + ro); gr[bj][m] = *(const pg8::u32x2*)(GR8 + ro); }
#pragma unroll
            for (int bj = 0; bj < 2; ++bj)
#pragma unroll
                for (int m = 0; m < 4; ++m) { float a[8], r[8]; f8x8(ga[bj][m], a); f8x8(gr[bj][m], r);
#pragma unroll
                    for (int j = 0; j < 4; ++j) { acc[ai][bj][m][0][j] *= sigm(a[j]) * (0.0625f * (1.f + __builtin_amdgcn_exp2f(-1.4426950408889634f * fmaxf(r[j], -40.f))));
                                                  acc[ai][bj][m][1][j] *= sigm(a[4 + j]) * (0.0625f * (1.f + __builtin_amdgcn_exp2f(-1.4426950408889634f * fmaxf(r[4 + j], -40.f)))); } } }
    }
    __device__ __forceinline__ void operator()(const pg8::f32x4 (&acc)[2][2][4][2], const pg8::Unit& u, int wr, int wc, int fr, int fq) const {
        const int row0 = u.pm * pg8::BM + wr * 64 + fr, col0 = u.pn * pg8::BM + wc * 32 + 8 * fq, colb = u.pn * pg8::BM + wc * 32 + 8 * (fq & ~1); const bool odd = fq & 1;
        pg8::u32x2 gl[2][2][4];
#pragma unroll
        for (int ai = 0; ai < 2; ++ai)
#pragma unroll
            for (int bj = 0; bj < 2; ++bj)
#pragma unroll
                for (int m = 0; m < 4; ++m) gl[ai][bj][m] = *(const pg8::u32x2*)(GR8 + (size_t)(row0 + ai * pg8::HALF + m * 16) * 1024 + col0 + bj * pg8::HALF);
#pragma unroll
        for (int ai = 0; ai < 2; ++ai)
#pragma unroll
            for (int bj = 0; bj < 2; ++bj)
#pragma unroll
                for (int mp = 0; mp < 2; ++mp) { unsigned q[2][2];
#pragma unroll
                    for (int e = 0; e < 2; ++e) { const int m = 2 * mp + e; float g[8]; f8x8(gl[ai][bj][m], g);
                        const pg8::f32x4 v0 = acc[ai][bj][m][0], v1 = acc[ai][bj][m][1];
                        q[e][0] = q4f(128.f * sigm_c(g[0]) * v0[0], 128.f * sigm_c(g[1]) * v0[1], 128.f * sigm_c(g[2]) * v0[2], 128.f * sigm_c(g[3]) * v0[3]);
                        q[e][1] = q4f(128.f * sigm_c(g[4]) * v1[0], 128.f * sigm_c(g[5]) * v1[1], 128.f * sigm_c(g[6]) * v1[2], 128.f * sigm_c(g[7]) * v1[3]); }
                    st_f8_pair(MIX8, 1024, row0 + ai * pg8::HALF + 2 * mp * 16, colb + bj * pg8::HALF, odd, q[0][0], q[0][1], q[1][0], q[1][1]); }
    }
};
struct EpiResid {
    static constexpr bool PERM = true, AFTER_DRAIN = false;
    const pg8::bf16_t* xb; pg8::bf16_t* h16;
    __device__ __forceinline__ void operator()(const pg8::f32x4 (&acc)[2][2][4][2], const pg8::Unit& u, int wr, int wc, int fr, int fq) const {
        const int row0 = u.pm * pg8::BM + wr * 64 + fr, col0 = u.pn * pg8::BM + wc * 32 + 8 * fq;
        pg8::u32x4 xl[2][4][2];
#pragma unroll
        for (int ai = 0; ai < 2; ++ai)
#pragma unroll
            for (int m = 0; m < 4; ++m)
#pragma unroll
                for (int bj = 0; bj < 2; ++bj) xl[ai][m][bj] = *(const pg8::u32x4*)(xb + (size_t)(row0 + ai * pg8::HALF + m * 16) * 1024 + col0 + bj * pg8::HALF);
#pragma unroll
        for (int ai = 0; ai < 2; ++ai)
#pragma unroll
            for (int m = 0; m < 4; ++m) { const size_t ro = (size_t)(row0 + ai * pg8::HALF + m * 16) * 1024 + col0;
#pragma unroll
                for (int bj = 0; bj < 2; ++bj) { const pg8::u32x4 xv = xl[ai][m][bj]; const pg8::f32x4 v0 = acc[ai][bj][m][0], v1 = acc[ai][bj][m][1];
                    pg8::u32x4 w; w.x = pg8::cvt_pk_bf16(v0[0] + pg8::bf_lo(xv.x), v0[1] + pg8::bf_hi(xv.x)); w.y = pg8::cvt_pk_bf16(v0[2] + pg8::bf_lo(xv.y), v0[3] + pg8::bf_hi(xv.y));
                    w.z = pg8::cvt_pk_bf16(v1[0] + pg8::bf_lo(xv.z), v1[1] + pg8::bf_hi(xv.z)); w.w = pg8::cvt_pk_bf16(v1[2] + pg8::bf_lo(xv.w), v1[3] + pg8::bf_hi(xv.w));
                    *(pg8::u32x4*)(h16 + ro + bj * pg8::HALF) = w; } }
    }
};


struct P1Order {
    static constexpr bool GATHER = false; const int* ptok = nullptr;
    int nM, nN, nwg, G, c, mode; const char* A; const char* Bt; size_t tA, tB;
    __device__ bool next(int i, pg8::Unit& u) const {
        const long L = (long)i * G + c; if (L >= nwg) return false;
        int wgid = (int)L; { const int q = nwg / pg8::NXCD, r = nwg % pg8::NXCD, xcd = wgid % pg8::NXCD, off = wgid / pg8::NXCD; wgid = (xcd < r ? xcd * (q + 1) : r * (q + 1) + (xcd - r) * q) + off; }
        const int nig = pg8::WGM * nN, gid = wgid / nig, fm = gid * pg8::WGM, gsz = (nM - fm) < pg8::WGM ? (nM - fm) : pg8::WGM;
        u.pm = fm + ((wgid % nig) % gsz); const int pc = (wgid % nig) / gsz; u.pn = mode ? 5 + pc : (pc < 5 ? pc : pc + 3);
        u.a = A + (size_t)u.pm * tA; u.b = Bt + (size_t)u.pn * tB; u.bjump = 0; u.aux = 0; u.nvalid = 256; return true;
    }
    __device__ __forceinline__ void a_ready(const pg8::Unit&) const {}
    __device__ __forceinline__ void done(const pg8::Unit&) const {}
};

__device__ __forceinline__ float wave_sum(float v) {
#pragma unroll
    for (int o = 1; o < 64; o <<= 1) v += __shfl_xor(v, o);
    return v;
}
__device__ __forceinline__ void p0_transpose_item(const float* W, int K, int N, bf16* WT, int map, int row_off, int par, const float* gk, LAS float* scr, int item, int lane, unsigned char* WT8 = nullptr, float s8 = 32.f) {
    const int nblk = (N + 31) / 32, kb = item / nblk, nb = item % nblk, k0 = 64 * kb, n0 = 32 * nb;
    const int c4 = lane & 7, rr = lane >> 3; const bool okc = (n0 + 4 * c4) < N;
    f32x4 v[8];
#pragma unroll
    for (int i = 0; i < 8; ++i) { const int kk = i * 8 + rr; v[i] = okc ? *(const f32x4*)(W + (size_t)(k0 + kk) * N + n0 + 4 * c4) : (f32x4){0.f, 0.f, 0.f, 0.f}; }
#pragma unroll
    for (int i = 0; i < 8; ++i) { const int kk = i * 8 + rr; f32x4 x = v[i]; if (gk) x = x * gk[k0 + kk]; *(LAS f32x4*)(scr + kk * 36 + 4 * c4) = x; }
    LDS_WAIT(); asm volatile("" ::: "memory");
    const int c = lane & 7;
#pragma unroll
    for (int j = 0; j < 4; ++j) { const int nl = (lane >> 3) + 8 * j, n = n0 + nl; const LAS float* s = scr + (8 * c) * 36 + nl;
        v4u o; o.x = pk2(s[0 * 36], s[1 * 36]); o.y = pk2(s[2 * 36], s[3 * 36]); o.z = pk2(s[4 * 36], s[5 * 36]); o.w = pk2(s[6 * 36], s[7 * 36]);
        if (n < N) { const int row = (map == 0) ? row_off + n : (map == 1) ? (n < 1864 ? n : n + 184) : row_off + 2 * n + par;
            if (WT) *(GAS v4u*)(WT + (size_t)row * K + k0 + 8 * c) = o;
            if (WT8) { int w0 = __builtin_amdgcn_cvt_pk_fp8_f32(s[0 * 36] * s8, s[1 * 36] * s8, 0, false); w0 = __builtin_amdgcn_cvt_pk_fp8_f32(s[2 * 36] * s8, s[3 * 36] * s8, w0, true);
                int w1 = __builtin_amdgcn_cvt_pk_fp8_f32(s[4 * 36] * s8, s[5 * 36] * s8, 0, false); w1 = __builtin_amdgcn_cvt_pk_fp8_f32(s[6 * 36] * s8, s[7 * 36] * s8, w1, true);
                *(GAS unsigned long long*)(WT8 + (size_t)row * K + k0 + 8 * c) = (unsigned long long)(unsigned)w0 | ((unsigned long long)(unsigned)w1 << 32); } } }
    LDS_WAIT(); asm volatile("" ::: "memory");
}
__device__ __forceinline__ void p0_prologue(Frame& F, const Args& a) {
    LAS float* scr = (LAS float*)(F.lds + RING_OFF + F.wave * 16384);
    const int gw = F.vcu * NWAVES + F.wave, NGW = F.G * NWAVES;
    bf16* Win_t = (bf16*)(F.ws + WS_WIN); bf16* Wkv_t = (bf16*)(F.ws + WS_WKV);
    constexpr int I_IN = 16 * 219, I_KV = 4 * 8, I_SQ = 16 * 32, I_GU = 16 * 8  , I_DN = 4 * 32  ;
    constexpr int NITEMS = I_IN + I_KV + 3 * I_SQ + 16 * (2 * I_GU + I_DN);
    for (int it = gw; it < NITEMS; it += NGW) {
        int r = it;
        if (r < I_IN) { p0_transpose_item(a.in[2], 1024, INW, Win_t, 1, 0, 0, a.in[1], scr, r, F.lane, F.ws + WS_WIN8); continue; } r -= I_IN;
        if (r < I_KV) { p0_transpose_item(a.in[4], 256, 256, Wkv_t, 0, 0, 0, a.in[3], scr, r, F.lane); continue; } r -= I_KV;
        if (r < I_SQ) { p0_transpose_item(a.in[9], 1024, 1024, nullptr, 0, 0, 0, nullptr, scr, r, F.lane, F.ws + WS_WATT8, 32.f); continue; } r -= I_SQ;
        if (r < I_SQ) { p0_transpose_item(a.in[10], 1024, 1024, nullptr, 0, 0, 0, nullptr, scr, r, F.lane, F.ws + WS_WRET8, 32.f); continue; } r -= I_SQ;
        if (r < I_SQ) { p0_transpose_item(a.in[11], 1024, 1024, nullptr, 0, 0, 0, nullptr, scr, r, F.lane, F.ws + WS_WOUT8, 32.f); continue; } r -= I_SQ;
        const int e = r / (2 * I_GU + I_DN), q = r % (2 * I_GU + I_DN);
        if (q < I_GU) p0_transpose_item(a.in[17] + (size_t)e * 1024 * 256, 1024, 256, nullptr, 2, e * 512, 0, nullptr, scr, q, F.lane, F.ws + WS_W18, 32.f);
        else if (q < 2 * I_GU) p0_transpose_item(a.in[18] + (size_t)e * 1024 * 256, 1024, 256, nullptr, 2, e * 512, 1, nullptr, scr, q - I_GU, F.lane, F.ws + WS_W18, 32.f);
        else p0_transpose_item(a.in[19] + (size_t)e * 256 * 1024, 256, 1024, nullptr, 0, 0, 0, nullptr, scr, q - 2 * I_GU, F.lane, F.ws + WS_WD8 + (size_t)e * 1024 * 256, 16.f);
    }
    { const int gt = (F.vcu * NWAVES + F.wave) * 64 + F.lane, NGT = F.G * NWAVES * 64; GAS v4u* z = (GAS v4u*)(Win_t + (size_t)1864 * 1024);
      for (int i = gt; i < 184 * 1024 * 2 / 16; i += NGT) z[i] = (v4u){0u, 0u, 0u, 0u}; }
    { const int gt = (F.vcu * NWAVES + F.wave) * 64 + F.lane, NGT = F.G * NWAVES * 64; bf16* Wh = (bf16*)(F.ws + WS_WR); bf16* Wl = Wh + 32 * 1024;
      for (int i = gt; i < 32 * 1024; i += NGT) { const int n = i >> 10, k = i & 1023; const float wv = n < 4 ? a.in[13][k * 4 + n] : (n < 20 ? a.in[15][k * 16 + (n - 4)] : 0.f);
        const unsigned hb = f2bf(wv); const float hf = __uint_as_float(hb << 16); Wh[i] = (bf16)hb; Wl[i] = (bf16)f2bf(wv - hf); } }
    const float* x = a.in[0] + (size_t)a.tok0 * D; unsigned char* xb8 = a.xb + (size_t)F.ntok * AUX_XB8;
    for (int m = gw; m < F.ntok; m += 2 * NGW) {
        const int m2 = m + NGW; const bool two = m2 < F.ntok;
        const GAS f32x4* xr = (const GAS f32x4*)(x + (size_t)m * D) + F.lane; const GAS f32x4* xr2 = (const GAS f32x4*)(x + (size_t)(two ? m2 : m) * D) + F.lane;
        f32x4 v[4], u[4]; float s = 0.f, s2 = 0.f;
#pragma unroll
        for (int j = 0; j < 4; ++j) { v[j] = xr[64 * j]; u[j] = xr2[64 * j]; }
#pragma unroll
        for (int j = 0; j < 4; ++j) { s += (v[j].x * v[j].x + v[j].y * v[j].y) + (v[j].z * v[j].z + v[j].w * v[j].w); s2 += (u[j].x * u[j].x + u[j].y * u[j].y) + (u[j].z * u[j].z + u[j].w * u[j].w); }
        const float rstd = 1.f / sqrtf(wave_sum(s) * (1.f / D) + EPS), rstd2 = 1.f / sqrtf(wave_sum(s2) * (1.f / D) + EPS);
        if (F.lane == 0) { RSTD1_PTR[m] = rstd; if (two) RSTD1_PTR[m2] = rstd2; }
        GAS unsigned long long* o8 = (GAS unsigned long long*)(a.xb + (size_t)m * D * 2) + F.lane; GAS unsigned* q8 = (GAS unsigned*)(xb8 + (size_t)m * D) + F.lane;
#pragma unroll
        for (int j = 0; j < 4; ++j) { o8[64 * j] = (unsigned long long)pk2(v[j].x, v[j].y) | ((unsigned long long)pk2(v[j].z, v[j].w) << 32);
            int w8 = __builtin_amdgcn_cvt_pk_fp8_f32(v[j].x * rstd, v[j].y * rstd, 0, false); w8 = __builtin_amdgcn_cvt_pk_fp8_f32(v[j].z * rstd, v[j].w * rstd, w8, true); q8[64 * j] = (unsigned)w8; }
        if (two) { GAS unsigned long long* p8 = (GAS unsigned long long*)(a.xb + (size_t)m2 * D * 2) + F.lane; GAS unsigned* r8 = (GAS unsigned*)(xb8 + (size_t)m2 * D) + F.lane;
#pragma unroll
            for (int j = 0; j < 4; ++j) { p8[64 * j] = (unsigned long long)pk2(u[j].x, u[j].y) | ((unsigned long long)pk2(u[j].z, u[j].w) << 32);
                int w8 = __builtin_amdgcn_cvt_pk_fp8_f32(u[j].x * rstd2, u[j].y * rstd2, 0, false); w8 = __builtin_amdgcn_cvt_pk_fp8_f32(u[j].z * rstd2, u[j].w * rstd2, w8, true); r8[64 * j] = (unsigned)w8; } }
    }
}


constexpr size_t AUX_KP = 0, AUX_VV = 256, AUX_KIN = 512, AUX_MASK = 640, AUX_END = 896;
typedef short bf16x8_t __attribute__((ext_vector_type(8)));
typedef float f32x16 __attribute__((ext_vector_type(16)));
__device__ __forceinline__ int crow(int r, int hi) { return (r & 3) + 8 * (r >> 2) + 4 * hi; }
__device__ __forceinline__ float xhalf_sum(float v) { auto rr = __builtin_amdgcn_permlane32_swap(__float_as_uint(v), __float_as_uint(v), false, false); return __uint_as_float(rr[0]) + __uint_as_float(rr[1]); }
__device__ __forceinline__ float sumsq8(bf16x8_t v) { float s = 0.f;
#pragma unroll
    for (int j = 0; j < 8; ++j) { const float f = __uint_as_float((unsigned)(unsigned short)v[j] << 16); s += f * f; } return s; }
__device__ __forceinline__ void p2_post(Frame& F, const Args& a) {
    const int gw = F.vcu * NWAVES + F.wave, NGW = F.G * NWAVES, lane = F.lane, r32 = lane & 31, hi = lane >> 5;
    const size_t nt_ = (size_t)F.ntok;
    const bf16* CKV = (const bf16*)(F.act + nt_ * O_CKV); const bf16* KW = (const bf16*)(F.act + nt_ * O_KW);
    const bf16* Wkv_t = (const bf16*)(F.ws + WS_WKV);
    unsigned char* aux = a.xb + nt_ * 2048;
    bf16* KP = (bf16*)(aux + nt_ * AUX_KP); bf16* VV = (bf16*)(aux + nt_ * AUX_VV); bf16* KIN = (bf16*)(aux + nt_ * AUX_KIN);
    const float* g_q = a.in[5]; const float* g_k = a.in[6]; const float* g_ki = a.in[7];
    constexpr int WP = 528;
    LAS unsigned char* Wl = F.lds + RING_OFF; LAS float* gl = (LAS float*)(F.lds + RING_OFF + 256 * WP);
    for (int i = F.tid; i < 256 * 32; i += NWAVES * 64) { const int n = i >> 5, ch = i & 31; *(LAS v4u*)(Wl + n * WP + ch * 16) = *(const v4u*)(Wkv_t + (size_t)n * 256 + ch * 8); }
    if (F.tid < 128) gl[F.tid] = g_k[F.tid] * g_q[F.tid] * (0.08838834764831845f * 1.4426950408889634f);
    else if (F.tid < 192) gl[F.tid] = g_ki[F.tid - 128];
    __syncthreads();
    const int ntask = 2 * (F.ntok / 32);
    for (int task = gw; task < ntask; task += NGW) {
        const int kind = task & 1, t0 = (task >> 1) * 32;
        const unsigned char* crowp = (const unsigned char*)CKV + (size_t)(t0 + r32) * 256 + hi * 8;
        bf16x8_t bfr[16]; float ss = 0.f;
#pragma unroll
        for (int kk = 0; kk < 16; ++kk) { const unsigned long long c8 = *(const unsigned long long*)(crowp + kk * 16); const int lo = (int)(unsigned)c8, hi32 = (int)(unsigned)(c8 >> 32);
            const auto a_ = __builtin_amdgcn_cvt_pk_f32_fp8(lo, false), b_ = __builtin_amdgcn_cvt_pk_f32_fp8(lo, true), c_ = __builtin_amdgcn_cvt_pk_f32_fp8(hi32, false), d_ = __builtin_amdgcn_cvt_pk_f32_fp8(hi32, true);
            ss += (a_[0] * a_[0] + a_[1] * a_[1]) + (b_[0] * b_[0] + b_[1] * b_[1]) + (c_[0] * c_[0] + c_[1] * c_[1]) + (d_[0] * d_[0] + d_[1] * d_[1]);
            v4u pk; pk.x = pk2(a_[0], a_[1]); pk.y = pk2(b_[0], b_[1]); pk.z = pk2(c_[0], c_[1]); pk.w = pk2(d_[0], d_[1]); bfr[kk] = __builtin_bit_cast(bf16x8_t, pk); }
        ss = xhalf_sum(ss);
        const float rstd = rsqrtf(ss * (1.f / 256.f) + EPS);
        f32x16 acc[4];
#pragma unroll
        for (int nt = 0; nt < 4; ++nt) { acc[nt] = f32x16{};
            const LAS unsigned char* wrow = Wl + (kind * 128 + nt * 32 + r32) * WP + hi * 16;
#pragma unroll
            for (int kk = 0; kk < 16; ++kk) { const bf16x8_t af = *(const LAS bf16x8_t*)(wrow + kk * 32); acc[nt] = __builtin_amdgcn_mfma_f32_32x32x16_bf16(af, bfr[kk], acc[nt], 0, 0, 0); if ((kk & 3) == 3) __builtin_amdgcn_sched_barrier(0); } }
        float sc = rstd;
        if (kind == 0) { float sk = 0.f;
#pragma unroll
            for (int nt = 0; nt < 4; ++nt)
#pragma unroll
                for (int r = 0; r < 16; ++r) { const float v = acc[nt][r] * rstd; sk += v * v; }
            sk = xhalf_sum(sk);
            sc = rstd * rsqrtf(sk * (1.f / 128.f) + EPS); }
        bf16* orow = (kind == 0 ? KP : VV) + (size_t)(t0 + r32) * 128;
#pragma unroll
        for (int nt = 0; nt < 4; ++nt)
#pragma unroll
            for (int g = 0; g < 4; ++g) { const int ch = nt * 32 + 8 * g + 4 * hi; float v[4];
#pragma unroll
                for (int j = 0; j < 4; ++j) { v[j] = acc[nt][4 * g + j] * sc; if (kind == 0) v[j] *= gl[ch + j]; }
                *(unsigned long long*)(orow + ch) = (unsigned long long)pk2(v[0], v[1]) | ((unsigned long long)pk2(v[2], v[3]) << 32); }
        if (kind == 0) {
            const bf16* kr = KW + (size_t)(t0 + r32) * 128 + hi * 32; bf16x8_t kv4[4]; float s2 = 0.f;
#pragma unroll
            for (int j = 0; j < 4; ++j) { kv4[j] = *(const bf16x8_t*)(kr + 8 * j); s2 += sumsq8(kv4[j]); }
            s2 = xhalf_sum(s2);
            const float rk = rsqrtf(s2 * (1.f / 64.f) + EPS);
            bf16* ko = KIN + (size_t)(t0 + r32) * 64 + hi * 32;
#pragma unroll
            for (int j = 0; j < 4; ++j) { float f[8];
#pragma unroll
                for (int e = 0; e < 8; ++e) f[e] = __uint_as_float((unsigned)(unsigned short)kv4[j][e] << 16) * rk * gl[128 + hi * 32 + 8 * j + e];
                v4u o; o.x = pk2(f[0], f[1]); o.y = pk2(f[2], f[3]); o.z = pk2(f[4], f[5]); o.w = pk2(f[6], f[7]);
                *(v4u*)(ko + 8 * j) = o; }
        }
    }
    __syncthreads();
}

typedef float f32x4_t __attribute__((ext_vector_type(4)));
__device__ __forceinline__ unsigned key15_of(float s) { const unsigned short hb = __builtin_bit_cast(unsigned short, (_Float16)s); const unsigned u = (hb & 0x8000u) ? (~(unsigned)hb & 0xffffu) : ((unsigned)hb | 0x8000u); return u >> 1; }
__device__ __forceinline__ unsigned sad4(unsigned x) { return __builtin_amdgcn_sad_u8(x, 0u, 0u); }
__device__ __forceinline__ void p3_merge(LAS unsigned* hist, LAS unsigned short* tot, int w, int g, int q, int& need, int& bsel) {
    __syncthreads();
    const int o = 4 * w + g; unsigned c = 0;
#pragma unroll
    for (int p = 0; p < 32; ++p) { const int tidp = (p >> 2) * 64 + (p & 3) * 16 + q; c += (hist[(o >> 2) * 512 + tidp] >> (8 * (o & 3))) & 0xffu; }
    tot[q * 32 + o] = (unsigned short)c;
    __syncthreads();
    v4u tv[4];
#pragma unroll
    for (int j = 0; j < 4; ++j) tv[j] = *(const LAS v4u*)((const LAS unsigned char*)tot + q * 64 + j * 16);
    int cum = 0, bs = 0, ab = 0; bool found = false;
#pragma unroll
    for (int bin = 31; bin >= 0; --bin) { const unsigned wd = tv[bin >> 3][(bin >> 1) & 3]; const int cc = (int)((bin & 1) ? (wd >> 16) : (wd & 0xffffu));
        if (!found && cum + cc >= need) { bs = bin; ab = cum; found = true; } cum += cc; }
    bsel = bs; need -= ab;
}
__device__ __forceinline__ void p3_index(Frame& F, const Args& a) {
    const int tid = F.tid, lane = F.lane, w = F.wave, q = lane & 15, g = lane >> 4;
    LAS unsigned* keys = (LAS unsigned*)(F.lds + RING_OFF);
    LAS unsigned char* qbuf = F.lds + 65536;
    LAS unsigned* hist = (LAS unsigned*)(F.lds + P3_HIST_OFF);
    LAS unsigned short* tot = (LAS unsigned short*)(F.lds + P3_TOT_OFF);
    LAS unsigned char* Tt = (LAS unsigned char*)(F.lds + P3_T_OFF);
    const size_t nt_ = (size_t)F.ntok;
    const bf16* QI = (const bf16*)(F.act + nt_ * O_QI); const bf16* KW = (const bf16*)(F.act + nt_ * O_KW);
    unsigned char* aux = a.xb + nt_ * 2048;
    const bf16* KIN = (const bf16*)(aux + nt_ * AUX_KIN); unsigned* MASK = (unsigned*)(aux + nt_ * AUX_MASK);
    const int nb = F.ntok / SEQ, nitems = nb * 128; const int bxj = (int)blockIdx.x >> 3;
    const int G = F.G - F.G / 4, c = (bxj - (bxj >> 2) - 1) * 8 + ((int)blockIdx.x & 7);
#define P3_ITEM(k) ((k) * G + (((k) & 1) ? (G - 1 - c) : c))
#define P3_QDMA(it_, buf_) do { const int qg_ = 127 - (it_) / nb, b_ = (it_) % nb; _Pragma("unroll") for (int i_ = 0; i_ < 2; ++i_) { const int row_ = w * 2 + i_; \
        const char* src_ = (const char*)(QI + ((size_t)b_ * SEQ + qg_ * 16 + row_) * 512) + ((lane ^ (row_ & 15)) * 16); \
        __builtin_amdgcn_global_load_lds((const unsigned*)src_, (LAS unsigned*)(qbuf + (buf_) * 16384 + row_ * 1024), 16, 0, 0); } } while (0)
    const int nround = (nitems + G - 1) / G;
    if (P3_ITEM(0) < nitems) P3_QDMA(P3_ITEM(0), 0);
    v4u wvn = (v4u){0u, 0u, 0u, 0u};
    if (P3_ITEM(0) < nitems) { const int it0 = P3_ITEM(0); wvn = *(const v4u*)(KW + ((size_t)(it0 % nb) * SEQ + (127 - it0 / nb) * 16 + q) * 128 + 64); }
    for (int k = 0; k < nround; ++k) {
        const int it = P3_ITEM(k); if (it >= nitems) break;
        const int qg = 127 - it / nb, b = it % nb, q0 = qg * 16, qme = q0 + q;
        unsigned* Mb = MASK + (size_t)b * 64 * 2048;
        const int kb_hi = ((qg >> 3) + 1) << 2, nkb = (qg >> 1) + 1;
        asm volatile("s_waitcnt vmcnt(0) lgkmcnt(0)\n\ts_barrier" ::: "memory");
        const v4u wv = wvn;
        { const int itn = P3_ITEM(k + 1); if (k + 1 < nround && itn < nitems) { P3_QDMA(itn, (k + 1) & 1); wvn = *(const v4u*)(KW + ((size_t)(itn % nb) * SEQ + (127 - itn / nb) * 16 + q) * 128 + 64); } }
        if (qg < 16) {
            if (tid < kb_hi * 16) { const int kb = tid >> 4, qq = q0 + (tid & 15), nbits = qq - kb * 32 + 1; Mb[kb * 2048 + qq] = nbits >= 32 ? 0xffffffffu : (nbits <= 0 ? 0u : ((1u << nbits) - 1u)); }
            continue;
        }
        float wq[8];
        { const float cc = 0.35355339059327373f * 0.125f;
          wq[0] = pg8::bf_lo(wv.x) * cc; wq[1] = pg8::bf_hi(wv.x) * cc; wq[2] = pg8::bf_lo(wv.y) * cc; wq[3] = pg8::bf_hi(wv.y) * cc; wq[4] = pg8::bf_lo(wv.z) * cc; wq[5] = pg8::bf_hi(wv.z) * cc; wq[6] = pg8::bf_lo(wv.w) * cc; wq[7] = pg8::bf_hi(wv.w) * cc; }
        bf16x8_t qfr[8][2], qlin[2];
        { const LAS unsigned char* qrow = qbuf + (k & 1) * 16384 + q * 1024;
#pragma unroll
          for (int h = 0; h < 8; ++h)
#pragma unroll
            for (int ks = 0; ks < 2; ++ks) qfr[h][ks] = *(const LAS bf16x8_t*)(qrow + (((h * 8 + ks * 4 + g) ^ q) * 16)); }
#pragma unroll
        for (int ks = 0; ks < 2; ++ks) { float f[8];
#pragma unroll
            for (int j = 0; j < 8; ++j) { float s = 0.f;
#pragma unroll
                for (int h = 0; h < 8; ++h) s += wq[h] * __uint_as_float((unsigned)(unsigned short)qfr[h][ks][j] << 16);
                f[j] = s; }
            v4u o; o.x = pk2(f[0], f[1]); o.y = pk2(f[2], f[3]); o.z = pk2(f[4], f[5]); o.w = pk2(f[6], f[7]); qlin[ks] = __builtin_bit_cast(bf16x8_t, o); }
#pragma unroll
        for (int i = 0; i < 8; ++i) hist[i * 512 + tid] = 0u;
        const bf16* kbase = KIN + ((size_t)b * SEQ + q) * 64 + g * 8;
        bf16x8_t afr[2][2], afn[2][2];
#pragma unroll
        for (int t = 0; t < 2; ++t)
#pragma unroll
            for (int ks = 0; ks < 2; ++ks) afn[t][ks] = *(const bf16x8_t*)(kbase + (size_t)(w * 32 + t * 16) * 64 + ks * 32);
        for (int s = 0, kb = w; kb < nkb; ++s, kb += 8) {
            const bool diag = (kb == nkb - 1);
#pragma unroll
            for (int t = 0; t < 2; ++t)
#pragma unroll
                for (int ks = 0; ks < 2; ++ks) afr[t][ks] = afn[t][ks];
            if (kb + 8 < nkb) {
#pragma unroll
                for (int t = 0; t < 2; ++t)
#pragma unroll
                    for (int ks = 0; ks < 2; ++ks) afn[t][ks] = *(const bf16x8_t*)(kbase + (size_t)((kb + 8) * 32 + t * 16) * 64 + ks * 32); }
#pragma unroll
            for (int t = 0; t < 2; ++t) {
                f32x4_t sacc = f32x4_t{};
#pragma unroll
                for (int ks = 0; ks < 2; ++ks) sacc = __builtin_amdgcn_mfma_f32_16x16x32_bf16(afr[t][ks], qlin[ks], sacc, 0, 0, 0);
#pragma unroll
                for (int h = 0; h < 8; ++h) { f32x4_t d = f32x4_t{};
#pragma unroll
                    for (int ks = 0; ks < 2; ++ks) d = __builtin_amdgcn_mfma_f32_16x16x32_bf16(afr[t][ks], qfr[h][ks], d, 0, 0, 0);
#pragma unroll
                    for (int r = 0; r < 4; ++r) { float s_ = fmaf(fabsf(d[r]), wq[h], sacc[r]); asm("" : "+v"(s_)); sacc[r] = s_; } }
#pragma unroll
                for (int i = 0; i < 2; ++i) { unsigned k2[2];
#pragma unroll
                    for (int e = 0; e < 2; ++e) { const int r = 2 * i + e; unsigned kk_ = key15_of(sacc[r]); if (diag && kb * 32 + t * 16 + 4 * g + r > qme) kk_ = 0u; k2[e] = kk_;
                        const unsigned dg = kk_ >> 10; (void)__hip_atomic_fetch_add((LAS unsigned*)&hist[(dg >> 2) * 512 + tid], 1u << ((dg & 3u) * 8u), __ATOMIC_RELAXED, __HIP_MEMORY_SCOPE_WORKGROUP); }
                    keys[(s * 4 + t * 2 + i) * 512 + tid] = k2[0] | (k2[1] << 16); }
            }
        }
        int need = 256, bsel;
        p3_merge(hist, tot, w, g, q, need, bsel);
        unsigned prefix = (unsigned)bsel;
#pragma unroll
        for (int pass = 0; pass < 2; ++pass) {
            const int sh_hi = pass == 0 ? 10 : 5, sh = pass == 0 ? 5 : 0;
#pragma unroll
            for (int i = 0; i < 8; ++i) hist[i * 512 + tid] = 0u;
#pragma unroll
            for (int s = 0; s < 8; ++s) if (w + 8 * s < nkb) {
#pragma unroll
                for (int i = 0; i < 4; ++i) { const unsigned d2 = keys[(s * 4 + i) * 512 + tid];
#pragma unroll
                    for (int e = 0; e < 2; ++e) { const unsigned kk_ = e ? (d2 >> 16) : (d2 & 0xffffu);
                        if ((kk_ >> sh_hi) == prefix) { const unsigned dg = (kk_ >> sh) & 31u; (void)__hip_atomic_fetch_add((LAS unsigned*)&hist[(dg >> 2) * 512 + tid], 1u << ((dg & 3u) * 8u), __ATOMIC_RELAXED, __HIP_MEMORY_SCOPE_WORKGROUP); } } } }
            p3_merge(hist, tot, w, g, q, need, bsel);
            prefix = (prefix << 5) | (unsigned)bsel;
        }
        const unsigned tau = prefix; const int need_eq = need;
        unsigned gtw[8], eqw[8];
#pragma unroll
        for (int s = 0; s < 8; ++s) { const int kb = w + 8 * s; gtw[s] = 0u; eqw[s] = 0u;
            if (kb < nkb) { unsigned gg = 0u, qq = 0u;
#pragma unroll
                for (int i = 0; i < 4; ++i) { const unsigned d2 = keys[(s * 4 + i) * 512 + tid];
#pragma unroll
                    for (int e = 0; e < 2; ++e) { const unsigned kk_ = e ? (d2 >> 16) : (d2 & 0xffffu); const int bit = (i >> 1) * 16 + 4 * g + (i & 1) * 2 + e;
                        gg |= (kk_ > tau ? 1u : 0u) << bit; qq |= (kk_ == tau ? 1u : 0u) << bit; } }
                gg |= (unsigned)__shfl_xor((int)gg, 16); gg |= (unsigned)__shfl_xor((int)gg, 32); qq |= (unsigned)__shfl_xor((int)qq, 16); qq |= (unsigned)__shfl_xor((int)qq, 32);
                gtw[s] = gg; eqw[s] = qq;
                if (g == 0) Tt[q * 64 + kb] = (unsigned char)__builtin_popcount(qq); } }
        __syncthreads();
        { unsigned run = 0u;
#pragma unroll
          for (int s = 0; s < 8; ++s) { const int kb = w + 8 * s;
            if (kb < nkb) { const unsigned g0 = *(const LAS unsigned*)(Tt + q * 64 + 8 * s), g1 = *(const LAS unsigned*)(Tt + q * 64 + 8 * s + 4);
                const unsigned m0 = w >= 4 ? g0 : (w == 0 ? 0u : (g0 & ((1u << (8 * w)) - 1u))), m1 = w > 4 ? (g1 & ((1u << (8 * (w - 4))) - 1u)) : 0u;
                const int pre = (int)(run + sad4(m0) + sad4(m1)), m = need_eq - pre, pc = __builtin_popcount(eqw[s]);
                unsigned se = eqw[s];
                if (m < pc) { se = 0u; unsigned x = eqw[s]; for (int i = 0; i < m; ++i) { const unsigned bb = x & (0u - x); se |= bb; x ^= bb; } }
                if (g == 0) Mb[kb * 2048 + qme] = gtw[s] | se;
                run += sad4(g0) + sad4(g1); } } }
        if (tid < (kb_hi - nkb) * 16) Mb[(nkb + (tid >> 4)) * 2048 + q0 + (tid & 15)] = 0u;
    }
    asm volatile("s_waitcnt vmcnt(0) lgkmcnt(0)" ::: "memory");
    __syncthreads();
#undef P3_ITEM
#undef P3_QDMA
}

namespace att {
using bf16x8 = __attribute__((ext_vector_type(8))) short;
using s16x4  = __attribute__((ext_vector_type(4))) short;
using u32x4  = __attribute__((ext_vector_type(4))) unsigned;
constexpr int KVBLK = 64;
constexpr size_t SHM_V = KVBLK * 128 * 2, SHM_K = KVBLK * 128 * 2;
constexpr int OFF_WS = 65536, OFF_MK = 65536 + 2048, OFF_Q = 65536 + 2048 + 8192, QPITCH = 272;
constexpr float THR2 = 11.5f;
#define KSWZ(row, colB) ((row) * 256 + ((colB) ^ (((row) & 7) << 4)))
#define SBAR() __builtin_amdgcn_sched_barrier(0)
__device__ __forceinline__ unsigned cvtpk(float lo, float hi) { unsigned r; asm volatile("v_cvt_pk_bf16_f32 %0, %1, %2" : "=v"(r) : "v"(lo), "v"(hi)); return r; }
__device__ __forceinline__ float msk(float p, unsigned w, int bit) { const int m = __builtin_amdgcn_sbfe((int)w, bit, 1); return __uint_as_float((__float_as_uint(p) & (unsigned)m) | (0xff800000u & ~(unsigned)m)); }
__device__ __forceinline__ void partialSM(f32x16& p0, f32x16& p1, unsigned w0, unsigned w1, float& m_reg, float& mn, float& alpha) {
#pragma unroll
  for (int r = 0; r < 16; ++r) { const int bit = (r & 3) + 8 * (r >> 2); p0[r] = msk(p0[r], w0, bit); p1[r] = msk(p1[r], w1, bit); }
  float pmax = p0[0];
#pragma unroll
  for (int r = 1; r < 16; ++r) pmax = fmaxf(pmax, p0[r]);
#pragma unroll
  for (int r = 0; r < 16; ++r) pmax = fmaxf(pmax, p1[r]);
  { auto rr = __builtin_amdgcn_permlane32_swap(__float_as_uint(pmax), __float_as_uint(pmax), false, false); pmax = fmaxf(__uint_as_float(rr[0]), __uint_as_float(rr[1])); }
  if (__builtin_expect(__all(pmax - m_reg <= THR2), 1)) { mn = m_reg; alpha = 1.f; }
  else { mn = fmaxf(m_reg, pmax); alpha = __builtin_amdgcn_exp2f(m_reg - mn); m_reg = mn; }
#pragma unroll
  for (int r = 0; r < 16; ++r) { p0[r] -= mn; p1[r] -= mn; }
#pragma unroll
  for (int r = 0; r < 16; ++r) p0[r] = __builtin_amdgcn_exp2f(p0[r]);
}
__device__ __forceinline__ void finishSM(f32x16& p0, f32x16& p1, float alpha, float& l_reg, bf16x8& pa0, bf16x8& pa1, bf16x8& pa2, bf16x8& pa3) {
#pragma unroll
  for (int r = 0; r < 16; ++r) p1[r] = __builtin_amdgcn_exp2f(p1[r]);
  float ps = 0;
#pragma unroll
  for (int r = 0; r < 16; ++r) ps += p0[r];
#pragma unroll
  for (int r = 0; r < 16; ++r) ps += p1[r];
  { auto rr = __builtin_amdgcn_permlane32_swap(__float_as_uint(ps), __float_as_uint(ps), false, false); ps = __uint_as_float(rr[0]) + __uint_as_float(rr[1]); }
  l_reg = l_reg * alpha + ps;
#define PK4(P, BASE, OUT) do { unsigned a0 = cvtpk(P[BASE + 0], P[BASE + 1]), a1 = cvtpk(P[BASE + 2], P[BASE + 3]);   \
    unsigned b0 = cvtpk(P[BASE + 4], P[BASE + 5]), b1 = cvtpk(P[BASE + 6], P[BASE + 7]);                              \
    auto r0 = __builtin_amdgcn_permlane32_swap(a0, b0, false, false); auto r1 = __builtin_amdgcn_permlane32_swap(a1, b1, false, false); \
    u32x4 w = {r0[0], r1[0], r0[1], r1[1]}; OUT = *reinterpret_cast<bf16x8*>(&w); } while (0)
  PK4(p0, 0, pa0); PK4(p0, 8, pa1); PK4(p1, 0, pa2); PK4(p1, 8, pa3);
#undef PK4
}
__device__ __forceinline__ void qkt(f32x16& p0, f32x16& p1, const char* Ks, const char* qrow, const float (&bo)[16], float kb0, float kb1, int r32, int hi) {
#pragma unroll
  for (int r = 0; r < 16; ++r) { p0[r] = bo[r] + kb0; p1[r] = bo[r] + kb1; }
#pragma unroll
  for (int d0 = 0; d0 < 8; ++d0) { const int cb = (d0 * 16 + hi * 8) * 2;
    const bf16x8 b0 = *reinterpret_cast<const bf16x8*>(Ks + KSWZ(r32, cb));
    const bf16x8 b1 = *reinterpret_cast<const bf16x8*>(Ks + KSWZ(32 + r32, cb));
    const bf16x8 qf = *reinterpret_cast<const bf16x8*>(qrow + d0 * 32);
    p0 = __builtin_amdgcn_mfma_f32_32x32x16_bf16(b0, qf, p0, 0, 0, 0);
    p1 = __builtin_amdgcn_mfma_f32_32x32x16_bf16(b1, qf, p1, 0, 0, 0); }
}
__device__ __forceinline__ int v_st(int k, int c) { const int kk = (k & ~0xC) | ((k & 4) << 1) | ((k & 8) >> 1); return ((kk >> 3) * 4 + (c >> 5)) * 512 + ((kk & 7) * 32 + (c & 31)) * 2; }
__device__ __forceinline__ int v_rd_base(int lane) { return ((lane & 3) << 3) | (((lane >> 2) & 3) << 6) | (((lane >> 4) & 1) << 5) | (((lane >> 5) & 1) << 8); }
constexpr int v_rd_off(int d0, int ks, int half) { return d0 * 512 + ks * 4096 + half * 2048; }
template <int OFF> __device__ __forceinline__ s16x4 tr_read(int vb) { s16x4 r; asm volatile("ds_read_b64_tr_b16 %0, %1 offset:%2" : "=&v"(r) : "v"(vb), "i"(OFF) : "memory"); return r; }
template <int D0> __device__ __forceinline__ void pv_one(f32x16& od, int vb, bf16x8 pa0, bf16x8 pa1, bf16x8 pa2, bf16x8 pa3) {
  const s16x4 l0 = tr_read<v_rd_off(D0, 0, 0)>(vb), h0 = tr_read<v_rd_off(D0, 0, 1)>(vb), l1 = tr_read<v_rd_off(D0, 1, 0)>(vb), h1 = tr_read<v_rd_off(D0, 1, 1)>(vb);
  const s16x4 l2 = tr_read<v_rd_off(D0, 2, 0)>(vb), h2 = tr_read<v_rd_off(D0, 2, 1)>(vb), l3 = tr_read<v_rd_off(D0, 3, 0)>(vb), h3 = tr_read<v_rd_off(D0, 3, 1)>(vb);
  asm volatile("s_waitcnt lgkmcnt(0)" ::: "memory"); SBAR();
#define PK(L, H) (bf16x8){L[0], L[1], L[2], L[3], H[0], H[1], H[2], H[3]}
  od = __builtin_amdgcn_mfma_f32_32x32x16_bf16(pa0, PK(l0, h0), od, 0, 0, 0);
  od = __builtin_amdgcn_mfma_f32_32x32x16_bf16(pa1, PK(l1, h1), od, 0, 0, 0);
  od = __builtin_amdgcn_mfma_f32_32x32x16_bf16(pa2, PK(l2, h2), od, 0, 0, 0);
  od = __builtin_amdgcn_mfma_f32_32x32x16_bf16(pa3, PK(l3, h3), od, 0, 0, 0);
#undef PK
}
__device__ __forceinline__ void pv_d0(f32x16* o, int vb, bf16x8 pa0, bf16x8 pa1, bf16x8 pa2, bf16x8 pa3) {
  pv_one<0>(o[0], vb, pa0, pa1, pa2, pa3); pv_one<1>(o[1], vb, pa0, pa1, pa2, pa3); pv_one<2>(o[2], vb, pa0, pa1, pa2, pa3); pv_one<3>(o[3], vb, pa0, pa1, pa2, pa3);
}
__device__ __forceinline__ void attn_item(const bf16* __restrict__ Qb, const bf16* __restrict__ Kh, const bf16* __restrict__ Vh, const unsigned* __restrict__ Mq, bf16* __restrict__ Ob, int NT, char* lds, LAS unsigned char* ldsL) {
  const int tid = threadIdx.x, wid = __builtin_amdgcn_readfirstlane(tid >> 6), lane = tid & 63, r32 = lane & 31, hi = lane >> 5;
  float* ws = (float*)(lds + OFF_WS) + wid * 64; float* li_l = ws; float* al_l = ws + 32;
  unsigned* mk = (unsigned*)(lds + OFF_MK);
  unsigned soff[4];
#pragma unroll
  for (int i = 0; i < 4; ++i) { const int pc = (wid & 3) * 4 + i;
    if (wid < 4) { const int row = pc * 4 + (lane >> 4), cb = (lane & 15) * 16; soff[i] = (unsigned)(row * 256 + (cb ^ ((row & 7) << 4))); }
    else { const int L = pc * 1024 + lane * 16, st = L >> 9, wi = L & 511, kk = (st >> 2) * 8 + (wi >> 6), c = (st & 3) * 32 + ((wi & 63) >> 1), k = (kk & ~0xC) | ((kk & 4) << 1) | ((kk & 8) >> 1);
           soff[i] = (unsigned)(k * 256 + c * 2); } }
  const char* gsrc = (const char*)(wid < 4 ? Kh : Vh);
  const unsigned ldst = (unsigned)((wid < 4 ? 0 : 16384) + (wid & 3) * 4096);
#define DMA_TILE(t, slot) do { _Pragma("unroll") for (int i_ = 0; i_ < 4; ++i_) \
    __builtin_amdgcn_global_load_lds((const unsigned*)(gsrc + (size_t)(t) * (64 * 256) + soff[i_]), (LAS unsigned*)(ldsL + (slot) * 32768 + ldst + i_ * 1024), 16, 0, 0); } while (0)
  DMA_TILE(0, 0);
  float m_reg = 0.f, l_reg = 0; f32x16 o[4] = {}; bf16x8 qr[8];
  { const unsigned char* Qw = (const unsigned char*)Qb + (size_t)r32 * 1024 + wid * 128 + hi * 8; float ss = 0.f; unsigned long long q8[8];
#pragma unroll
    for (int d0 = 0; d0 < 8; ++d0) q8[d0] = *reinterpret_cast<const unsigned long long*>(Qw + d0 * 16);
    unsigned mv[4];
#pragma unroll
    for (int i = 0; i < 4; ++i) { const int idx = tid + 512 * i; mv[i] = idx < NT * 64 ? Mq[(size_t)(idx >> 5) * 2048 + (idx & 31)] : 0u; }
#pragma unroll
    for (int i = 0; i < 4; ++i) { const int idx = tid + 512 * i; if (idx < NT * 64) mk[idx] = mv[i]; }
    float qf[8][8];
#pragma unroll
    for (int d0 = 0; d0 < 8; ++d0) { const int lo = (int)(unsigned)q8[d0], hi32 = (int)(unsigned)(q8[d0] >> 32);
      const auto a_ = __builtin_amdgcn_cvt_pk_f32_fp8(lo, false), b_ = __builtin_amdgcn_cvt_pk_f32_fp8(lo, true), c_ = __builtin_amdgcn_cvt_pk_f32_fp8(hi32, false), d_ = __builtin_amdgcn_cvt_pk_f32_fp8(hi32, true);
      qf[d0][0] = a_[0]; qf[d0][1] = a_[1]; qf[d0][2] = b_[0]; qf[d0][3] = b_[1]; qf[d0][4] = c_[0]; qf[d0][5] = c_[1]; qf[d0][6] = d_[0]; qf[d0][7] = d_[1];
#pragma unroll
      for (int j = 0; j < 8; ++j) ss += qf[d0][j] * qf[d0][j]; }
    ss = xhalf_sum(ss); const float rq = rsqrtf(ss * (1.f / 128.f) + EPS);
#pragma unroll
    for (int d0 = 0; d0 < 8; ++d0) { u32x4 w = {cvtpk(qf[d0][0] * rq, qf[d0][1] * rq), cvtpk(qf[d0][2] * rq, qf[d0][3] * rq), cvtpk(qf[d0][4] * rq, qf[d0][5] * rq), cvtpk(qf[d0][6] * rq, qf[d0][7] * rq)}; qr[d0] = *reinterpret_cast<bf16x8*>(&w); } }
  const float slope2 = __builtin_amdgcn_exp2f(-(float)(wid + 1)) * 1.4426950408889634f;
  float bo[16];
#pragma unroll
  for (int r = 0; r < 16; ++r) bo[r] = __uint_as_float(__builtin_amdgcn_readfirstlane(__float_as_uint(slope2 * (float)((r & 3) + 8 * (r >> 2)))));
  const float hoff = slope2 * (float)(4 * hi);
  const int vb0 = (int)(uintptr_t)(lds + 16384) + v_rd_base(lane);
  asm volatile("s_waitcnt vmcnt(0) lgkmcnt(0)\n\ts_barrier" ::: "memory");
  for (int j = 0; j < NT; ++j) {
    const int sl = j & 1;
    if (j + 1 < NT) DMA_TILE(j + 1, sl ^ 1);
    const char* Ks = lds + sl * 32768;
    const unsigned w0 = mk[(2 * j) * 32 + r32] >> (4 * hi), w1 = mk[(2 * j + 1) * 32 + r32] >> (4 * hi);
    f32x16 p0, p1;
    { const float kb0 = slope2 * (float)(j * 64) + hoff - m_reg, kb1 = kb0 + slope2 * 32.f;
#pragma unroll
      for (int r = 0; r < 16; ++r) { p0[r] = bo[r] + kb0; p1[r] = bo[r] + kb1; }
      bf16x8 ka = *reinterpret_cast<const bf16x8*>(Ks + KSWZ(r32, hi * 16)), kb = *reinterpret_cast<const bf16x8*>(Ks + KSWZ(32 + r32, hi * 16));
#pragma unroll
      for (int d0 = 0; d0 < 8; ++d0) { bf16x8 na = ka, nb = kb;
        if (d0 < 7) { const int cb = ((d0 + 1) * 16 + hi * 8) * 2; na = *reinterpret_cast<const bf16x8*>(Ks + KSWZ(r32, cb)); nb = *reinterpret_cast<const bf16x8*>(Ks + KSWZ(32 + r32, cb)); }
        SBAR();
        p0 = __builtin_amdgcn_mfma_f32_32x32x16_bf16(ka, qr[d0], p0, 0, 0, 0);
        p1 = __builtin_amdgcn_mfma_f32_32x32x16_bf16(kb, qr[d0], p1, 0, 0, 0);
        SBAR();
        ka = na; kb = nb; } }
    float alpha; bf16x8 pa0, pa1, pa2, pa3;
    {
#pragma unroll
      for (int r = 0; r < 16; ++r) { const int bit = (r & 3) + 8 * (r >> 2); p0[r] = msk(p0[r], w0, bit); p1[r] = msk(p1[r], w1, bit); }
      float pmax = fmaxf(p0[0], p1[0]);
#pragma unroll
      for (int r = 1; r < 16; ++r) pmax = fmaxf(fmaxf(pmax, p0[r]), p1[r]);
      { auto rr = __builtin_amdgcn_permlane32_swap(__float_as_uint(pmax), __float_as_uint(pmax), false, false); pmax = fmaxf(__uint_as_float(rr[0]), __uint_as_float(rr[1])); }
      alpha = 1.f;
      if (__builtin_expect(!__all(pmax <= THR2), 0)) {
        const float dl = fmaxf(pmax, 0.f); m_reg += dl; alpha = __builtin_amdgcn_exp2f(-dl);
#pragma unroll
        for (int r = 0; r < 16; ++r) { p0[r] -= dl; p1[r] -= dl; } }
      float ps = 0.f;
#pragma unroll
      for (int r = 0; r < 16; ++r) { p0[r] = __builtin_amdgcn_exp2f(p0[r]); p1[r] = __builtin_amdgcn_exp2f(p1[r]); ps += p0[r] + p1[r]; }
      { auto rr = __builtin_amdgcn_permlane32_swap(__float_as_uint(ps), __float_as_uint(ps), false, false); ps = __uint_as_float(rr[0]) + __uint_as_float(rr[1]); }
      l_reg = l_reg * alpha + ps;
#define PK4(P, BASE, OUT) do { unsigned a0 = cvtpk(P[BASE + 0], P[BASE + 1]), a1 = cvtpk(P[BASE + 2], P[BASE + 3]);   \
    unsigned b0 = cvtpk(P[BASE + 4], P[BASE + 5]), b1 = cvtpk(P[BASE + 6], P[BASE + 7]);                              \
    auto r0 = __builtin_amdgcn_permlane32_swap(a0, b0, false, false); auto r1 = __builtin_amdgcn_permlane32_swap(a1, b1, false, false); \
    u32x4 w = {r0[0], r1[0], r0[1], r1[1]}; OUT = *reinterpret_cast<bf16x8*>(&w); } while (0)
      PK4(p0, 0, pa0); PK4(p0, 8, pa1); PK4(p1, 0, pa2); PK4(p1, 8, pa3);
#undef PK4
      if (__any(alpha < 1.f)) { if (hi == 0) al_l[r32] = alpha; asm volatile("s_waitcnt lgkmcnt(0)" ::: "memory");
#pragma unroll
        for (int d = 0; d < 4; ++d)
#pragma unroll
          for (int r = 0; r < 16; ++r) o[d][r] *= al_l[crow(r, hi)]; }
    }
    { const int vb = vb0 + sl * 32768;
      s16x4 lA[4], hA[4], lB[4], hB[4];
#define VREADS(L_, H_, D0) do { L_[0] = tr_read<v_rd_off(D0, 0, 0)>(vb); H_[0] = tr_read<v_rd_off(D0, 0, 1)>(vb); L_[1] = tr_read<v_rd_off(D0, 1, 0)>(vb); H_[1] = tr_read<v_rd_off(D0, 1, 1)>(vb); \
      L_[2] = tr_read<v_rd_off(D0, 2, 0)>(vb); H_[2] = tr_read<v_rd_off(D0, 2, 1)>(vb); L_[3] = tr_read<v_rd_off(D0, 3, 0)>(vb); H_[3] = tr_read<v_rd_off(D0, 3, 1)>(vb); } while (0)
#define PK(L, H) (bf16x8){L[0], L[1], L[2], L[3], H[0], H[1], H[2], H[3]}
#define VMMA(OD, L_, H_) do { OD = __builtin_amdgcn_mfma_f32_32x32x16_bf16(pa0, PK(L_[0], H_[0]), OD, 0, 0, 0); OD = __builtin_amdgcn_mfma_f32_32x32x16_bf16(pa1, PK(L_[1], H_[1]), OD, 0, 0, 0); \
      OD = __builtin_amdgcn_mfma_f32_32x32x16_bf16(pa2, PK(L_[2], H_[2]), OD, 0, 0, 0); OD = __builtin_amdgcn_mfma_f32_32x32x16_bf16(pa3, PK(L_[3], H_[3]), OD, 0, 0, 0); } while (0)
#define VWAIT(N, L_, H_) do { asm volatile("s_waitcnt lgkmcnt(" #N ")" : "+v"(L_[0]), "+v"(L_[1]), "+v"(L_[2]), "+v"(L_[3]), "+v"(H_[0]), "+v"(H_[1]), "+v"(H_[2]), "+v"(H_[3]) :: "memory"); SBAR(); } while (0)
      VREADS(lA, hA, 0); VREADS(lB, hB, 1);
      VWAIT(8, lA, hA); VMMA(o[0], lA, hA);
      VREADS(lA, hA, 2);
      VWAIT(8, lB, hB); VMMA(o[1], lB, hB);
      VREADS(lB, hB, 3);
      VWAIT(8, lA, hA); VMMA(o[2], lA, hA);
      VWAIT(0, lB, hB); VMMA(o[3], lB, hB);
#undef VREADS
#undef PK
#undef VMMA
#undef VWAIT
    }
    asm volatile("s_waitcnt vmcnt(0) lgkmcnt(0)\n\ts_barrier" ::: "memory");
  }
  if (hi == 0) li_l[r32] = l_reg; asm volatile("s_waitcnt lgkmcnt(0)" ::: "memory");
  float rli[16];
#pragma unroll
  for (int r = 0; r < 16; ++r) rli[r] = __builtin_amdgcn_rcpf(li_l[crow(r, hi)]);
  unsigned char* stg = (unsigned char*)(lds + wid * 4096);
#pragma unroll
  for (int r = 0; r < 16; ++r) { const int orow = crow(r, hi); const float sc16 = rli[r] * 16.f;
#pragma unroll
    for (int d0 = 0; d0 < 4; ++d0) stg[orow * 128 + d0 * 32 + r32] = (unsigned char)__builtin_amdgcn_cvt_pk_fp8_f32(o[d0][r] * sc16, 0.f, 0, false); }
  asm volatile("s_waitcnt lgkmcnt(0)" ::: "memory");
#pragma unroll
  for (int i = 0; i < 4; ++i) { const int row = i * 8 + (lane >> 3), ch = lane & 7; const u32x4 v = *(const u32x4*)(stg + row * 128 + ch * 16);
    *(u32x4*)((unsigned char*)Ob + (size_t)row * 1024 + wid * 128 + ch * 16) = v; }
#undef DMA_TILE
}
#undef KSWZ
#undef SBAR
}


namespace ret {
using bf16x8 = __attribute__((ext_vector_type(8))) short;
using s16x4  = __attribute__((ext_vector_type(4))) short;
using u32x4  = __attribute__((ext_vector_type(4))) unsigned;
using u32x2  = __attribute__((ext_vector_type(2))) unsigned;
constexpr int C = 64, QP = 272, KPI = 272, VP = 576;
constexpr int OFF_Q = 0, OFF_K = 17408, OFF_V = 34816, OFF_ST = 71680, OFF_Y = 75776;
typedef float f32x2_t __attribute__((ext_vector_type(2))); typedef __bf16 bf16x2_t __attribute__((ext_vector_type(2)));
__device__ __forceinline__ unsigned cvtpk(float lo, float hi) { const f32x2_t v = {lo, hi}; const bf16x2_t b = __builtin_convertvector(v, bf16x2_t); return __builtin_bit_cast(unsigned, b); }
template <int OFF> __device__ __forceinline__ s16x4 trr(int base) { s16x4 r; asm volatile("ds_read_b64_tr_b16 %0, %1 offset:%2" : "=&v"(r) : "v"(base), "i"(OFF) : "memory"); return r; }
__device__ __forceinline__ bf16x8 pk8(const f32x16& x, int s) { u32x4 w = {cvtpk(x[8 * s + 0], x[8 * s + 1]), cvtpk(x[8 * s + 2], x[8 * s + 3]), cvtpk(x[8 * s + 4], x[8 * s + 5]), cvtpk(x[8 * s + 6], x[8 * s + 7])}; return *reinterpret_cast<bf16x8*>(&w); }
__device__ __forceinline__ float silu_(float x) { return x * __builtin_amdgcn_rcpf(1.f + __builtin_amdgcn_exp2f(-1.4426950408889634f * x)); }
__device__ __forceinline__ void ret_item(int b, int h, const unsigned char* __restrict__ RQ, const unsigned char* __restrict__ RK, const unsigned char* __restrict__ RV, const unsigned char* __restrict__ RG, unsigned char* A2F8, const float* __restrict__ gnorm, char* lds, int c0, int c1, float* state) {
  const int tid = threadIdx.x, w = __builtin_amdgcn_readfirstlane(tid >> 6), lane = tid & 63, r32 = lane & 31, hi = lane >> 5;
  const float lg = __log2f(1.f - exp2f(-5.f - (float)h)), gC = exp2f(64.f * lg);
  char* Qs = lds + OFF_Q; char* Ks = lds + OFF_K; char* Vs = lds + OFF_V; float* st = (float*)(lds + OFF_ST); char* Ys = lds + OFF_Y;
  f32x16 S[4] = {};
  if (c0 > 0) {
#pragma unroll
    for (int dt = 0; dt < 4; ++dt)
#pragma unroll
      for (int r = 0; r < 16; ++r) S[dt][r] = state[(dt * 16 + r) * 512 + tid]; }
  const unsigned voffQ = (unsigned)(((tid >> 4) * 512 + (tid & 15) * 8) * 2), voffV = (unsigned)(((tid >> 5) * 1024 + (tid & 31) * 8) * 2);
  const int trq = (lane & 15) >> 2, trp = lane & 3, trg = (lane >> 4) & 1;
  const int vtb = (int)(uintptr_t)(lds + OFF_V) + (4 * hi + trq) * VP + (32 * w + 16 * trg + 4 * trp) * 2, ktb = (int)(uintptr_t)(lds + OFF_K) + (4 * hi + trq) * KPI + (16 * trg + 4 * trp) * 2;
  u32x2 pq[2], pk[2], pv[4];
  const unsigned voffQ8 = (unsigned)((tid >> 4) * 512 + (tid & 15) * 8), voffV8 = voffV >> 1;
#define RET_LOAD(cc) do { const size_t t0_ = (size_t)b * SEQ + (size_t)(cc) * C; const unsigned char* qb_ = RQ + t0_ * 512 + h * 128; const unsigned char* kb_ = RK + t0_ * 512 + h * 128; const unsigned char* vb_ = RV + t0_ * 1024 + h * 256; \
    _Pragma("unroll") for (int i = 0; i < 2; ++i) { pq[i] = *(const u32x2*)(qb_ + voffQ8 + i * 16384); pk[i] = *(const u32x2*)(kb_ + voffQ8 + i * 16384); } \
    _Pragma("unroll") for (int i = 0; i < 4; ++i) pv[i] = *(const u32x2*)(vb_ + voffV8 + i * 16384); } while (0)
#define RET_F8(src_, f_, out_) do { const auto a_ = __builtin_amdgcn_cvt_pk_f32_fp8((int)(src_).x, false), b_ = __builtin_amdgcn_cvt_pk_f32_fp8((int)(src_).x, true), c_ = __builtin_amdgcn_cvt_pk_f32_fp8((int)(src_).y, false), d_ = __builtin_amdgcn_cvt_pk_f32_fp8((int)(src_).y, true); \
    out_.x = cvtpk(a_[0] * (f_), a_[1] * (f_)); out_.y = cvtpk(b_[0] * (f_), b_[1] * (f_)); out_.z = cvtpk(c_[0] * (f_), c_[1] * (f_)); out_.w = cvtpk(d_[0] * (f_), d_[1] * (f_)); } while (0)
#define RET_STAGE() do { \
    _Pragma("unroll") for (int i = 0; i < 2; ++i) { const int row = (tid >> 4) + 32 * i, ch = tid & 15; \
      u32x4 qo; RET_F8(pq[i], 1.f, qo); *(u32x4*)(Qs + row * QP + ch * 16) = qo; \
      const float f = exp2f(lg * (float)(C - 1 - row)) * 0.08838834764831845f; \
      u32x4 ko; RET_F8(pk[i], f, ko); *(u32x4*)(Ks + row * KPI + ch * 16) = ko; } \
    _Pragma("unroll") for (int i = 0; i < 4; ++i) { const int row = (tid >> 5) + 16 * i, ch = tid & 31; u32x4 vo; RET_F8(pv[i], 1.f, vo); *(u32x4*)(Vs + row * VP + ch * 16) = vo; } } while (0)
  RET_LOAD(c0);
  __syncthreads();
  RET_STAGE();
  if (c0 + 1 < c1) RET_LOAD(c0 + 1);
  __syncthreads();
  for (int c = c0; c < c1; ++c) {
    const size_t tok0 = (size_t)b * SEQ + (size_t)c * C;
    f32x16 ot[2] = {};
#pragma unroll
    for (int dt = 0; dt < 4; ++dt) {
#pragma unroll
      for (int s = 0; s < 2; ++s) { const bf16x8 af = pk8(S[dt], s);
#pragma unroll
        for (int nt = 0; nt < 2; ++nt) { const char* qp = Qs + (32 * nt + r32) * QP + (32 * dt + 16 * s + 4 * hi) * 2;
          const u32x2 lo = *(const u32x2*)qp, hi8 = *(const u32x2*)(qp + 16); const u32x4 bw = {lo.x, lo.y, hi8.x, hi8.y};
          ot[nt] = __builtin_amdgcn_mfma_f32_32x32x16_bf16(af, *reinterpret_cast<const bf16x8*>(&bw), ot[nt], 0, 0, 0); } }
      __builtin_amdgcn_sched_barrier(0); }
#pragma unroll
    for (int nt = 0; nt < 2; ++nt)
#pragma unroll
      for (int r = 0; r < 16; ++r) ot[nt][r] *= gC;
    __builtin_amdgcn_sched_barrier(0);
    bf16x8 vfr[4];
    { s16x4 vlo[4], vhi[4];
      vlo[0] = trr<0 * 16 * VP>(vtb); vhi[0] = trr<0 * 16 * VP + 8 * VP>(vtb); vlo[1] = trr<1 * 16 * VP>(vtb); vhi[1] = trr<1 * 16 * VP + 8 * VP>(vtb);
      vlo[2] = trr<2 * 16 * VP>(vtb); vhi[2] = trr<2 * 16 * VP + 8 * VP>(vtb); vlo[3] = trr<3 * 16 * VP>(vtb); vhi[3] = trr<3 * 16 * VP + 8 * VP>(vtb);
      asm volatile("s_waitcnt lgkmcnt(0)" : "+v"(vlo[0]), "+v"(vlo[1]), "+v"(vlo[2]), "+v"(vlo[3]), "+v"(vhi[0]), "+v"(vhi[1]), "+v"(vhi[2]), "+v"(vhi[3]) :: "memory"); __builtin_amdgcn_sched_barrier(0);
#pragma unroll
      for (int ks = 0; ks < 4; ++ks) vfr[ks] = (bf16x8){vlo[ks][0], vlo[ks][1], vlo[ks][2], vlo[ks][3], vhi[ks][0], vhi[ks][1], vhi[ks][2], vhi[ks][3]}; }
#pragma unroll
    for (int nt = 0; nt < 2; ++nt)
#pragma unroll
      for (int jt = 0; jt <= nt; ++jt) { f32x16 pt = {};
#pragma unroll
        for (int kk = 0; kk < 8; ++kk) { const bf16x8 ka = *(const bf16x8*)(Ks + (32 * jt + r32) * KPI + (16 * kk + 8 * hi) * 2), qb = *(const bf16x8*)(Qs + (32 * nt + r32) * QP + (16 * kk + 8 * hi) * 2);
          pt = __builtin_amdgcn_mfma_f32_32x32x16_bf16(ka, qb, pt, 0, 0, 0); }
        if (jt == nt) {
#pragma unroll
          for (int r = 0; r < 16; ++r) if (crow(r, hi) > r32) pt[r] = 0.f; }
#pragma unroll
        for (int s = 0; s < 2; ++s) ot[nt] = __builtin_amdgcn_mfma_f32_32x32x16_bf16(vfr[2 * jt + s], pk8(pt, s), ot[nt], 0, 0, 0);
        __builtin_amdgcn_sched_barrier(0); }
#pragma unroll
    for (int dt = 0; dt < 4; ++dt) {
#pragma unroll
      for (int r = 0; r < 16; ++r) S[dt][r] *= gC;
      s16x4 kl[4], kh[4];
      kl[0] = trr<0 * 16 * KPI>(ktb + dt * 64); kh[0] = trr<0 * 16 * KPI + 8 * KPI>(ktb + dt * 64); kl[1] = trr<1 * 16 * KPI>(ktb + dt * 64); kh[1] = trr<1 * 16 * KPI + 8 * KPI>(ktb + dt * 64);
      kl[2] = trr<2 * 16 * KPI>(ktb + dt * 64); kh[2] = trr<2 * 16 * KPI + 8 * KPI>(ktb + dt * 64); kl[3] = trr<3 * 16 * KPI>(ktb + dt * 64); kh[3] = trr<3 * 16 * KPI + 8 * KPI>(ktb + dt * 64);
      asm volatile("s_waitcnt lgkmcnt(0)" : "+v"(kl[0]), "+v"(kl[1]), "+v"(kl[2]), "+v"(kl[3]), "+v"(kh[0]), "+v"(kh[1]), "+v"(kh[2]), "+v"(kh[3]) :: "memory"); __builtin_amdgcn_sched_barrier(0);
#pragma unroll
      for (int ks = 0; ks < 4; ++ks) S[dt] = __builtin_amdgcn_mfma_f32_32x32x16_bf16((bf16x8){kl[ks][0], kl[ks][1], kl[ks][2], kl[ks][3], kh[ks][0], kh[ks][1], kh[ks][2], kh[ks][3]}, vfr[ks], S[dt], 0, 0, 0);
      __builtin_amdgcn_sched_barrier(0); }
    u32x2 gt4[4];
    { const unsigned char* gb_ = RG + tok0 * 1024 + h * 256;
#pragma unroll
      for (int i = 0; i < 4; ++i) gt4[i] = *(const u32x2*)(gb_ + (voffV >> 1) + i * 16384); }
#pragma unroll
    for (int nt = 0; nt < 2; ++nt) { const float rs = exp2f(lg * (float)(32 * nt + r32 + 1 - C)); float s1 = 0.f, s2 = 0.f;
#pragma unroll
      for (int r = 0; r < 16; ++r) { ot[nt][r] *= rs; s1 += ot[nt][r]; s2 += ot[nt][r] * ot[nt][r]; }
      s1 = xhalf_sum(s1); s2 = xhalf_sum(s2);
      if (hi == 0) { st[(w * 64 + 32 * nt + r32) * 2] = s1; st[(w * 64 + 32 * nt + r32) * 2 + 1] = s2; } }
    __syncthreads();
    if (c + 1 < c1) { RET_STAGE(); if (c + 2 < c1) RET_LOAD(c + 2); }
#pragma unroll
    for (int nt = 0; nt < 2; ++nt) { float s1 = 0.f, s2 = 0.f;
#pragma unroll
      for (int ww = 0; ww < 8; ++ww) { s1 += st[(ww * 64 + 32 * nt + r32) * 2]; s2 += st[(ww * 64 + 32 * nt + r32) * 2 + 1]; }
      const float mu = s1 * (1.f / 256.f), var = fmaxf(s2 * (1.f / 256.f) - mu * mu, 0.f), rstd = rsqrtf(var + EPS);
#pragma unroll
      for (int g = 0; g < 4; ++g) { float y[4];
#pragma unroll
        for (int j = 0; j < 4; ++j) y[j] = (ot[nt][4 * g + j] - mu) * rstd * gnorm[h * 256 + 32 * w + 8 * g + 4 * hi + j];
        const u32x2 o2 = {cvtpk(y[0], y[1]), cvtpk(y[2], y[3])};
        *(u32x2*)(Ys + (32 * nt + r32) * VP + (32 * w + 8 * g + 4 * hi) * 2) = o2; } }
    __syncthreads();
    { unsigned char* ob_ = A2F8 + tok0 * 1024 + h * 256;
#pragma unroll
      for (int i = 0; i < 4; ++i) { const int row = (tid >> 5) + 16 * i, ch = tid & 31;
        const u32x4 yv = *(const u32x4*)(Ys + row * VP + ch * 16); const u32x2 gt = gt4[i];
        const auto g01 = __builtin_amdgcn_cvt_pk_f32_fp8((int)gt.x, false), g23 = __builtin_amdgcn_cvt_pk_f32_fp8((int)gt.x, true), g45 = __builtin_amdgcn_cvt_pk_f32_fp8((int)gt.y, false), g67 = __builtin_amdgcn_cvt_pk_f32_fp8((int)gt.y, true);
        int w0 = __builtin_amdgcn_cvt_pk_fp8_f32(pg8::bf_lo(yv.x) * silu_(g01[0]), pg8::bf_hi(yv.x) * silu_(g01[1]), 0, false); w0 = __builtin_amdgcn_cvt_pk_fp8_f32(pg8::bf_lo(yv.y) * silu_(g23[0]), pg8::bf_hi(yv.y) * silu_(g23[1]), w0, true);
        int w1 = __builtin_amdgcn_cvt_pk_fp8_f32(pg8::bf_lo(yv.z) * silu_(g45[0]), pg8::bf_hi(yv.z) * silu_(g45[1]), 0, false); w1 = __builtin_amdgcn_cvt_pk_fp8_f32(pg8::bf_lo(yv.w) * silu_(g67[0]), pg8::bf_hi(yv.w) * silu_(g67[1]), w1, true);
        *(unsigned long long*)(ob_ + (size_t)row * 1024 + ch * 8) = (unsigned long long)(unsigned)w0 | ((unsigned long long)(unsigned)w1 << 32); } }
  }
  if (c1 < SEQ / C) {
#pragma unroll
    for (int dt = 0; dt < 4; ++dt)
#pragma unroll
      for (int r = 0; r < 16; ++r) state[(dt * 16 + r) * 512 + tid] = S[dt][r]; }
  __syncthreads();
#undef RET_LOAD
#undef RET_STAGE
#undef RET_F8
}
}


constexpr int RET_SPLIT = 26;
__device__ __forceinline__ int ret_wg_index(const Frame& F) { const int bx = (int)blockIdx.x, j = bx >> 3; return (j & 3) == 0 ? ((j >> 2) * 8 + (bx & 7)) : -1; }
__device__ __forceinline__ void p4_attn(Frame& F, const Args& a, unsigned char* lds_generic) {
    const size_t nt_ = (size_t)F.ntok;
    const bf16* QA = (const bf16*)(F.act + nt_ * O_QA); bf16* ATT = (bf16*)(F.act + nt_ * O_QA);
    unsigned char* aux = a.xb + nt_ * 2048;
    const bf16* KP = (const bf16*)(aux + nt_ * AUX_KP); const bf16* VV = (const bf16*)(aux + nt_ * AUX_VV); const unsigned* MASK = (const unsigned*)(aux + nt_ * AUX_MASK);
    volatile LAS unsigned* MISC = (volatile LAS unsigned*)(F.lds + MISC_OFF);
    unsigned* qctr = (unsigned*)(F.ws + WS_CTL) + CW_Q4;
    const unsigned char* RQ = F.act + nt_ * O_RQ; const unsigned char* RK = F.act + nt_ * O_RK; const unsigned char* RV = F.act + nt_ * O_RV; const unsigned char* RG = F.act + nt_ * O_RG;
    const int nb = F.ntok / SEQ, nret = nb * 4, nitems = nb * 64;
    { const int ri = ret_wg_index(F); if (ri >= 0 && ri < nret && RET_SPLIT < SEQ / 64)
        ret::ret_item(ri >> 2, ri & 3, RQ, RK, RV, RG, A2F8_PTR, a.in[8], (char*)lds_generic, RET_SPLIT, SEQ / 64, RSTATE_PTR + (size_t)ri * 32768); }
    __syncthreads(); if (F.tid == 0) MISC[0] = atomicAdd(qctr, 1u); __syncthreads();
    int it = (int)MISC[0];
    while (it < nitems) {
        unsigned nxt_ = 0u; if (F.tid == 0) nxt_ = atomicAdd(qctr, 1u);
        const int qb = 63 - it / nb, b = it % nb, NT = (qb >> 1) + 1;
        const size_t row0 = (size_t)b * SEQ + qb * 32;
        att::attn_item((const bf16*)((const unsigned char*)QA + row0 * 1024), KP + (size_t)b * SEQ * 128, VV + (size_t)b * SEQ * 128, MASK + (size_t)b * 64 * 2048 + qb * 32, (bf16*)((unsigned char*)ATT + row0 * 1024), NT, (char*)lds_generic, F.lds);
        __syncthreads(); if (F.tid == 0) MISC[0] = nxt_; __syncthreads();
        it = (int)MISC[0];
    }
}


__device__ __forceinline__ void p7_router(Frame& F, const Args& a) {
    const int lane = F.lane, r32 = lane & 31, hi = lane >> 5, tid = F.tid;
    unsigned char* mo = F.act; unsigned char* N2 = mo + MO_N2; unsigned char* meta = mo + MO_META;
    (void)meta; int* LTOK = (int*)(mo + MO_LIST); float* LRS = (float*)(mo + MO_LIST) + 24 * LIST_CAP; float* LCL = LRS + 24 * LIST_CAP; float* LCH = LCL + 24 * LIST_CAP;
    const bf16* Wh = (const bf16*)(F.ws + WS_WR); const bf16* Wl = Wh + 32 * 1024;
    const float* g2 = a.in[12]; const float* b_gr = a.in[14]; const float* b_er = a.in[16];
    const bf16* hbase = (const bf16*)(F.act + MO_H16);
    unsigned* gcnt = (unsigned*)(F.ws + WS_CTL) + CW_MOE;
    LAS unsigned* lcnt = (LAS unsigned*)(F.lds + RING_OFF);
    if (tid < 64) lcnt[tid] = 0u;
    LAS unsigned char* Wlds = F.lds + 20480; LAS float* g2l = (LAS float*)(F.lds + 20480 + 98304);
    for (int i = tid; i < 2 * 24 * 128; i += NWAVES * 64) { const int c = i & 127, n = (i >> 7) % 24, hl = i / (24 * 128);
        *(LAS v4u*)(Wlds + (hl * 24 + n) * 2048 + ((c ^ (n & 15)) * 16)) = *(const v4u*)((hl ? Wl : Wh) + (size_t)n * 1024 + c * 8); }
    for (int i = tid; i < 256; i += NWAVES * 64) *(LAS f32x4*)(g2l + i * 4) = *(const f32x4*)(g2 + i * 4);
    __syncthreads();
    const int ntasks = F.ntok / 32, tpw = ntasks / F.G;
    const int tw = F.wave & 3, kh = F.wave >> 2;
    const bool have = tw < tpw; const int t = (F.vcu * tpw + tw) * 32 + r32;
    LAS float* xch = (LAS float*)(F.lds + RING_OFF + 1024);
    int bucket = 0, posl = 0; float clo = 0.f, chi = 0.f, rstd = 0.f;
    f32x16 acc = f32x16{}; float ss = 0.f;
    if (have) {
        const bf16* hrow = hbase + (size_t)t * D + hi * 8 + kh * 512; unsigned char* nrow = N2 + (size_t)t * D + hi * 8 + kh * 512;
        const LAS float* g2k = g2l + kh * 512 + hi * 8; const int rr = r32 < 24 ? r32 : r32 - 8;
        const LAS unsigned char* whk = Wlds + rr * 2048; const LAS unsigned char* wlk = Wlds + (24 + rr) * 2048; const int c0 = kh * 64 + hi, sw = rr & 15;
#pragma unroll 8
        for (int kk = 0; kk < 32; ++kk) {
            const v4u hv = *(const v4u*)(hrow + kk * 16); const f32x4 a0 = {pg8::bf_lo(hv.x), pg8::bf_hi(hv.x), pg8::bf_lo(hv.y), pg8::bf_hi(hv.y)}, a1 = {pg8::bf_lo(hv.z), pg8::bf_hi(hv.z), pg8::bf_lo(hv.w), pg8::bf_hi(hv.w)};
            const f32x4 q0 = *(const LAS f32x4*)(g2k + kk * 16), q1 = *(const LAS f32x4*)(g2k + kk * 16 + 4);
            ss += (a0.x * a0.x + a0.y * a0.y) + (a0.z * a0.z + a0.w * a0.w) + (a1.x * a1.x + a1.y * a1.y) + (a1.z * a1.z + a1.w * a1.w);
            const float x[8] = {a0.x * q0.x, a0.y * q0.y, a0.z * q0.z, a0.w * q0.w, a1.x * q1.x, a1.y * q1.y, a1.z * q1.z, a1.w * q1.w};
            unsigned hb[8]; float lo[8];
#pragma unroll
            for (int j = 0; j < 8; ++j) { hb[j] = f2bf(x[j]); lo[j] = x[j] - __uint_as_float(hb[j] << 16); }
            v4u xh; xh.x = hb[0] | (hb[1] << 16); xh.y = hb[2] | (hb[3] << 16); xh.z = hb[4] | (hb[5] << 16); xh.w = hb[6] | (hb[7] << 16);
            v4u xl; xl.x = pk2(lo[0], lo[1]); xl.y = pk2(lo[2], lo[3]); xl.z = pk2(lo[4], lo[5]); xl.w = pk2(lo[6], lo[7]);
            { int w0 = __builtin_amdgcn_cvt_pk_fp8_f32(x[0], x[1], 0, false); w0 = __builtin_amdgcn_cvt_pk_fp8_f32(x[2], x[3], w0, true); int w1 = __builtin_amdgcn_cvt_pk_fp8_f32(x[4], x[5], 0, false); w1 = __builtin_amdgcn_cvt_pk_fp8_f32(x[6], x[7], w1, true);
              *(unsigned long long*)(nrow + kk * 16) = (unsigned long long)(unsigned)w0 | ((unsigned long long)(unsigned)w1 << 32); }
            const int co = ((c0 + kk * 2) ^ sw) * 16; const bf16x8_t wh = *(const LAS bf16x8_t*)(whk + co), wl = *(const LAS bf16x8_t*)(wlk + co);
            const bf16x8_t bh = __builtin_bit_cast(bf16x8_t, xh), bl = __builtin_bit_cast(bf16x8_t, xl);
            acc = __builtin_amdgcn_mfma_f32_32x32x16_bf16(wh, bh, acc, 0, 0, 0);
            acc = __builtin_amdgcn_mfma_f32_32x32x16_bf16(wh, bl, acc, 0, 0, 0);
            acc = __builtin_amdgcn_mfma_f32_32x32x16_bf16(wl, bh, acc, 0, 0, 0);
        }
        if (kh == 1) {
#pragma unroll
            for (int r = 0; r < 16; ++r) xch[(tw * 17 + r) * 64 + lane] = acc[r];
            xch[(tw * 17 + 16) * 64 + lane] = ss; }
    }
    __syncthreads();
    if (have && kh == 0) {
#pragma unroll
        for (int r = 0; r < 16; ++r) acc[r] += xch[(tw * 17 + r) * 64 + lane];
        ss += xch[(tw * 17 + 16) * 64 + lane];
        ss = xhalf_sum(ss); rstd = rsqrtf(ss * (1.f / D) + EPS);
        float L[24];
#pragma unroll
        for (int r = 0; r < 12; ++r) { const float v = acc[r]; auto rr = __builtin_amdgcn_permlane32_swap(__float_as_uint(v), __float_as_uint(v), false, false);
            L[(r & 3) + 8 * (r >> 2)] = __uint_as_float(rr[0]); L[(r & 3) + 8 * (r >> 2) + 4] = __uint_as_float(rr[1]); }
        float gl[4];
#pragma unroll
        for (int i = 0; i < 4; ++i) gl[i] = L[i] * rstd + b_gr[i];
        int g = 0; float gm = gl[0];
#pragma unroll
        for (int i = 1; i < 4; ++i) if (gl[i] > gm) { gm = gl[i]; g = i; }
        float se = 0.f;
#pragma unroll
        for (int i = 0; i < 4; ++i) se += __expf(gl[i] - gm);
        const float gw = 1.f / se;
        float el[4];
#pragma unroll
        for (int i = 0; i < 4; ++i) { const float l0 = L[4 + i], l1 = L[8 + i], l2 = L[12 + i], l3 = L[16 + i]; const float lv = g == 0 ? l0 : (g == 1 ? l1 : (g == 2 ? l2 : l3));
            const float b0 = b_er[i], b1 = b_er[4 + i], b2 = b_er[8 + i], b3 = b_er[12 + i]; el[i] = lv * rstd + (g == 0 ? b0 : (g == 1 ? b1 : (g == 2 ? b2 : b3))); }
        int i1 = 0; float v1 = el[0];
#pragma unroll
        for (int i = 1; i < 4; ++i) if (el[i] > v1) { v1 = el[i]; i1 = i; }
        int i2 = -1; float v2 = 0.f;
#pragma unroll
        for (int i = 0; i < 4; ++i) if (i != i1 && (i2 < 0 || el[i] > v2)) { v2 = el[i]; i2 = i; }
        const float e2 = __expf(v2 - v1), p1 = gw / (1.f + e2), p2 = gw * e2 / (1.f + e2);
        const int lo_ = i1 < i2 ? i1 : i2, hi_ = i1 < i2 ? i2 : i1;
        const int pair = lo_ == 0 ? (hi_ - 1) : (lo_ == 1 ? (hi_ + 1) : 5);
        bucket = g * 6 + pair; clo = i1 < i2 ? p1 : p2; chi = i1 < i2 ? p2 : p1;
        if (hi == 0) posl = (int)__hip_atomic_fetch_add(&lcnt[bucket], 1u, __ATOMIC_RELAXED, __HIP_MEMORY_SCOPE_WORKGROUP);
    }
    __syncthreads();
    if (tid < 24) lcnt[32 + tid] = atomicAdd(gcnt + tid, lcnt[tid]);
    __syncthreads();
    if (have && kh == 0 && hi == 0) { const int li = bucket * LIST_CAP + (int)lcnt[32 + bucket] + posl; LTOK[li] = t; LRS[li] = rstd; LCL[li] = clo; LCH[li] = chi; }
}
__device__ __forceinline__ int moe_tiles(const unsigned* gcnt, int* rowstart  ) { int rs = 0;
    for (int b = 0; b < 24; ++b) { rowstart[b] = rs; rs += (int)((gcnt[b] + 255u) & ~255u); } rowstart[24] = rs; return rs >> 8; }
template <bool GATHER_> struct MoeOrder {
    static constexpr bool GATHER = GATHER_; const int* ptok;
    int ntile, G, c; const char* A; size_t tA; const char* W; int mode; const LAS unsigned char* tb; size_t rowB;
    __device__ bool next(int i, pg8::Unit& u) const {
        const long L = (long)i * G + c; if (L >= (long)ntile * 4) return false;
        u.pm = (int)(L >> 2); u.pn = (int)(L & 3); u.a = GATHER_ ? A : A + (size_t)u.pm * tA;
        const int bk = tb[u.pm], g = bk / 6, pr = bk % 6; { const LAS int* t24 = (const LAS int*)(tb + 512); const int rs_ = t24[bk], cn_ = t24[24 + bk], left = cn_ - (u.pm * 256 - rs_); u.aux = bk * LIST_CAP - rs_; u.nvalid = left < 0 ? 0 : (left > 256 ? 256 : left); } const int lo = pr < 3 ? 0 : (pr < 5 ? 1 : 2), hi = pr < 3 ? pr + 1 : (pr < 5 ? pr - 1 : 3);
        const int elo = g * 4 + lo, ehi = g * 4 + hi;
        if (mode == 1) { const int e = u.pn < 2 ? elo : ehi; u.b = W + ((size_t)e * 512 + (size_t)(u.pn & 1) * 256) * rowB; u.bjump = 0; }
        else { u.b = W + ((size_t)elo * 1024 + (size_t)u.pn * 256) * rowB; u.bjump = (long)(ehi - elo) * 1024 * (long)rowB - (long)rowB; }
        return true;
    }
    __device__ __forceinline__ void a_ready(const pg8::Unit&) const {}
    __device__ __forceinline__ void done(const pg8::Unit&) const {}
};
__device__ __forceinline__ float silu_f(float x) { return x * __builtin_amdgcn_rcpf(1.f + __builtin_amdgcn_exp2f(-1.4426950408889634f * x)); }
struct EpiMoe1 {
    static constexpr bool PERM = true, AFTER_DRAIN = false;
    unsigned char* ACT; const float* PRS; const float* PCL; const float* PCH;
    __device__ __forceinline__ void operator()(const pg8::f32x4 (&acc)[2][2][4][2], const pg8::Unit& u, int wr, int wc, int fr, int fq) const {
        const int row0 = u.pm * pg8::BM + wr * 64 + fr, slot = u.pn >> 1, fcol0 = slot * 256 + (u.pn & 1) * 128 + wc * 16 + 4 * fq; const float* PC = slot ? PCH : PCL;
#pragma unroll
        for (int ai = 0; ai < 2; ++ai)
#pragma unroll
            for (int m = 0; m < 4; ++m) { const int row = row0 + ai * pg8::HALF + m * 16; const bool ok = (wr * 64 + fr + ai * pg8::HALF + m * 16) < u.nvalid; const float rs = ok ? PRS[u.aux + row] : 0.f, cw = ok ? PC[u.aux + row] * 16.f : 0.f; unsigned char* rowp = ACT + (size_t)row * 512 + fcol0;
#pragma unroll
                for (int bj = 0; bj < 2; ++bj) { const pg8::f32x4 v0 = acc[ai][bj][m][0], v1 = acc[ai][bj][m][1];
                    const float a0 = silu_f(v0[0] * rs) * (v0[1] * rs) * cw, a1 = silu_f(v0[2] * rs) * (v0[3] * rs) * cw, a2 = silu_f(v1[0] * rs) * (v1[1] * rs) * cw, a3 = silu_f(v1[2] * rs) * (v1[3] * rs) * cw;
                    int w = __builtin_amdgcn_cvt_pk_fp8_f32(a0, a1, 0, false); w = __builtin_amdgcn_cvt_pk_fp8_f32(a2, a3, w, true); *(int*)(rowp + bj * 64) = w; } }
    }
};
struct EpiMoe2 {
    static constexpr bool PERM = true, AFTER_DRAIN = false;
    float* out; const pg8::bf16_t* h16; const int* PTOK;
    __device__ __forceinline__ void operator()(const pg8::f32x4 (&acc)[2][2][4][2], const pg8::Unit& u, int wr, int wc, int fr, int fq) const {
        const int row0 = u.pm * pg8::BM + wr * 64 + fr, col0 = u.pn * pg8::BM + wc * 32 + 8 * fq;
        int tk[2][4]; pg8::u32x4 hl[2][4][2];
#pragma unroll
        for (int ai = 0; ai < 2; ++ai)
#pragma unroll
            for (int m = 0; m < 4; ++m) { const int rr_ = wr * 64 + fr + ai * pg8::HALF + m * 16; tk[ai][m] = rr_ < u.nvalid ? PTOK[u.aux + row0 + ai * pg8::HALF + m * 16] : -1; }
#pragma unroll
        for (int ai = 0; ai < 2; ++ai)
#pragma unroll
            for (int m = 0; m < 4; ++m) { const pg8::bf16_t* hp = h16 + (size_t)(tk[ai][m] < 0 ? 0 : tk[ai][m]) * 1024 + col0;
#pragma unroll
                for (int bj = 0; bj < 2; ++bj) hl[ai][m][bj] = *(const pg8::u32x4*)(hp + bj * pg8::HALF); }
#pragma unroll
        for (int ai = 0; ai < 2; ++ai)
#pragma unroll
            for (int m = 0; m < 4; ++m) if (tk[ai][m] >= 0) { float* rowp = out + (size_t)tk[ai][m] * 1024 + col0;
#pragma unroll
                for (int bj = 0; bj < 2; ++bj) { const pg8::u32x4 hv = hl[ai][m][bj];
                    const pg8::f32x4 h0 = {pg8::bf_lo(hv.x), pg8::bf_hi(hv.x), pg8::bf_lo(hv.y), pg8::bf_hi(hv.y)}, h1 = {pg8::bf_lo(hv.z), pg8::bf_hi(hv.z), pg8::bf_lo(hv.w), pg8::bf_hi(hv.w)};
                    *(pg8::f32x4*)(rowp + bj * pg8::HALF) = h0 + acc[ai][bj][m][0]; *(pg8::f32x4*)(rowp + bj * pg8::HALF + 4) = h1 + acc[ai][bj][m][1]; } }
    }
};
__device__ __forceinline__ int moe_setup(Frame& F, LAS unsigned char* tb) {
    const unsigned* gcnt = (const unsigned*)(F.ws + WS_CTL) + CW_MOE;
    LAS int* nt_ = (LAS int*)(tb + 256);
    __syncthreads();
    if (F.tid == 0) { LAS int* t24 = (LAS int*)(tb + 512); int tl = 0; for (int b = 0; b < 24; ++b) { const int n = (int)((gcnt[b] + 255u) >> 8); t24[b] = tl * 256; t24[24 + b] = (int)gcnt[b]; for (int i = 0; i < n; ++i) tb[tl + i] = (unsigned char)b; tl += n; } nt_[0] = tl; }
    __syncthreads();
    return nt_[0];
}

__global__ void __launch_bounds__(NWAVES * 64, 2) mk_fwd(Args args) {
    extern __shared__ __attribute__((aligned(16))) unsigned char lds[];
    Frame F;
    F.lds = (LAS unsigned char*)lds;
    F.tid = threadIdx.x; F.lane = F.tid & 63; F.wave = __builtin_amdgcn_readfirstlane(F.tid >> 6);
    F.G = gridDim.x; { const int bx = blockIdx.x; F.vcu = (F.G % 8 == 0) ? (bx % 8) * (F.G / 8) + bx / 8 : bx; }
    F.ntok = args.ntok; F.ws = args.ws; F.act = args.ws + WS_ACT; F.xbp = args.xb;
    const int lo = args.ph_lo, hi = args.ph_hi;
    cooperative_groups::grid_group grid = cooperative_groups::this_grid();
    volatile LAS unsigned* MISCW = (volatile LAS unsigned*)(F.lds + MISC_OFF);
    for (int u = F.tid; u < (LDS_BYTES - LDSCTL_OFF) / 4; u += NWAVES * 64) ((LAS unsigned*)(F.lds + LDSCTL_OFF))[u] = 0u;
    __syncthreads();
    XcdBarrier bar = xcd_barrier_post((unsigned*)(F.ws + WS_CTL) + CW_BAR, MISCW + 8);
#define IN(k) (lo <= (k) && (k) < hi)
#define SEAM(k) do { if (IN(k) && IN((k) + 1)) { xcd_barrier(bar); } } while (0)
    if (IN(0)) { p0_prologue(F, args); }
    SEAM(0);
    if (IN(1)) {
        EpiProj E{F.act, (size_t)F.ntok, RSTD1_PTR};
        { pg8::Gemm g{512, 512, 512, 8};
          P1Order S; S.nM = F.ntok / 256; S.nN = 25; S.nwg = S.nM * 25; S.G = F.G; S.c = (int)blockIdx.x; S.mode = 0; S.A = (const char*)(args.xb + (size_t)F.ntok * AUX_XB8); S.Bt = (const char*)(F.ws + WS_WIN8); S.tA = (size_t)256 * 1024; S.tB = (size_t)256 * 1024;
          pg8::gemm_phase<EpiProj, P1Order, true, true, true>(F.lds + RING_OFF, g, S, E); }
        { pg8::Gemm g{1024, 1024, 1024, 16};
          P1Order S; S.nM = F.ntok / 256; S.nN = 3; S.nwg = S.nM * 3; S.G = F.G; S.c = ((int)blockIdx.x + F.G / 2) % F.G; S.mode = 1; S.A = (const char*)args.xb; S.Bt = (const char*)(F.ws + WS_WIN); S.tA = (size_t)256 * 2048; S.tB = (size_t)256 * 2048;
          pg8::gemm_phase<EpiProj, P1Order, true, true, false>(F.lds + RING_OFF, g, S, E); }
    }
    SEAM(1);
    if (IN(2)) { p2_post(F, args); }
    SEAM(2);
    if (IN(3)) {
        const int ri = ret_wg_index(F), nret = (F.ntok / SEQ) * 4;
        if (ri < 0) p3_index(F, args);
        else if (ri < nret) { const size_t nt_ = (size_t)F.ntok;
            ret::ret_item(ri >> 2, ri & 3, F.act + nt_ * O_RQ, F.act + nt_ * O_RK, F.act + nt_ * O_RV, F.act + nt_ * O_RG, A2F8_PTR, args.in[8], (char*)lds, 0, RET_SPLIT, RSTATE_PTR + (size_t)ri * 32768); }
    }
    SEAM(3);
    if (IN(4)) { p4_attn(F, args, lds); }
    SEAM(4);
    if (IN(5)) {
        const size_t nt_ = (size_t)F.ntok;
        const unsigned char* GA8 = F.act + nt_ * O_GA; const unsigned char* GR8 = F.act + nt_ * O_GR;
        pg8::Gemm g{512, 512, 512, 8, 122, 123};
        GateOrder S; S.S0.init(F.ntok, 1024, F.G, (int)blockIdx.x, F.act + nt_ * O_QA, 512, F.ws + WS_WATT8, 512); S.A1 = (const char*)A2F8_PTR; S.B1 = (const char*)(F.ws + WS_WRET8);
        EpiGateFused E{GA8, GR8, F.act + nt_ * O_MIX8};
        pg8::gemm_phase<EpiGateFused, GateOrder, true, true, true>(F.lds + RING_OFF, g, S, E);
    }
    SEAM(5);
    if (IN(6)) {
        pg8::Gemm g{512, 512, 512, 8, 122, 124}; const size_t nt_ = (size_t)F.ntok;
        pg8::StaticOrder S; S.init(F.ntok, 1024, F.G, (int)blockIdx.x, F.act + nt_ * O_MIX8, 512, F.ws + WS_WOUT8, 512);
        EpiResid E{(const pg8::bf16_t*)args.xb, (pg8::bf16_t*)(F.act + MO_H16)};
        pg8::gemm_phase<EpiResid, pg8::StaticOrder, true, true, true>(F.lds + RING_OFF, g, S, E);
    }
    SEAM(6);
    if (IN(7)) { p7_router(F, args); }
    SEAM(7);
    if (IN(9)) {
        LAS unsigned char* tb = F.lds + LDSCTL_OFF - 1024; const int ntile = moe_setup(F, tb);
        unsigned char* meta = F.act + MO_META;
        pg8::Gemm g{512, 512, 512, 8, 122, 127};
        MoeOrder<true> S{(const int*)(F.act + MO_LIST), ntile, F.G, (int)blockIdx.x, (const char*)(F.act + MO_N2), (size_t)0, (const char*)(F.ws + WS_W18), 1, tb, (size_t)1024};
        EpiMoe1 E{(unsigned char*)(F.act + MO_ACT), (const float*)(F.act + MO_LIST) + 24 * LIST_CAP, (const float*)(F.act + MO_LIST) + 48 * LIST_CAP, (const float*)(F.act + MO_LIST) + 72 * LIST_CAP};
        pg8::gemm_phase<EpiMoe1, MoeOrder<true>, true, true, true>(F.lds + RING_OFF, g, S, E);
    }
    SEAM(9);
    if (IN(10)) {
        LAS unsigned char* tb = F.lds + LDSCTL_OFF - 1024; const int ntile = moe_setup(F, tb);
        unsigned char* meta = F.act + MO_META;
        pg8::Gemm g{256, 256, 128, 2, 123, 123};
        MoeOrder<false> S{nullptr, ntile, F.G, (int)blockIdx.x, (const char*)(F.act + MO_ACT), (size_t)256 * 512, (const char*)(F.ws + WS_WD8), 2, tb, (size_t)256};
        EpiMoe2 E{args.out + (size_t)args.tok0 * D, (const pg8::bf16_t*)(F.act + MO_H16), (const int*)(F.act + MO_LIST)};
        pg8::gemm_phase<EpiMoe2, MoeOrder<false>, true, true, true>(F.lds + RING_OFF, g, S, E);
    }
    if (hi - lo > 1) grid.sync();
#undef IN
#undef SEAM
}

extern "C" void kernel_launch(void* const* d_in, const int* in_sizes, int n_in, void* d_out, int out_size, void* d_ws, size_t ws_size, hipStream_t stream) {
    static int grid = 0;
    if (grid == 0) {
        int dev = 0, cus = 0, per_cu = 0;
        (void)hipGetDevice(&dev); (void)hipDeviceGetAttribute(&cus, hipDeviceAttributeMultiprocessorCount, dev);
        if (hipFuncSetAttribute((const void*)mk_fwd, hipFuncAttributeMaxDynamicSharedMemorySize, LDS_BYTES) != hipSuccess) { fprintf(stderr, "kernel_launch: hipFuncSetAttribute failed\n"); grid = -1; return; }
        (void)hipOccupancyMaxActiveBlocksPerMultiprocessor(&per_cu, (const void*)mk_fwd, NWAVES * 64, LDS_BYTES);
        (void)hipGetLastError();
        if (per_cu < 1) { fprintf(stderr, "kernel_launch: occupancy query says %d blocks per CU\n", per_cu); per_cu = 1; }
        grid = cus * per_cu;
        if (n_in != 20 || ws_size < (size_t)512 * MiB) { fprintf(stderr, "kernel_launch: unexpected n_in %d / ws_size %zu\n", n_in, ws_size); grid = -1; return; }
        if (grid != 256) { fprintf(stderr, "kernel_launch: this kernel's phase schedules are written for a 256-workgroup grid (256 CUs x 1); the device reports %d x %d; nothing launched\n", cus, per_cu); grid = -1; return; }
    }
    if (grid < 0) return;
    float* out = (float*)d_out;
    unsigned char* ws = (unsigned char*)d_ws;
    (void)in_sizes; (void)out_size;
    (void)hipMemsetAsync(ws + WS_CTL, 0, CTL_ZERO_BYTES, stream);
    Args a{};
    for (int i = 0; i < 20; ++i) a.in[i] = (const float*)d_in[i];
    a.out = out; a.ws = ws; a.xb = (unsigned char*)d_out; a.ntok = T; a.tok0 = 0;
    void* kargs[] = {(void*)&a};
    if (PROBE_PH >= 0) { a.ph_lo = PROBE_PH; a.ph_hi = PROBE_PH + 1; a.mode = PROBE_MODE;
        (void)hipLaunchCooperativeKernel((const void*)mk_fwd, dim3(grid), dim3(NWAVES * 64), kargs, (unsigned)LDS_BYTES, stream);
        (void)hipMemsetAsync(ws + WS_CTL, 0, CTL_ZERO_BYTES, stream); }
    a.ph_lo = 0; a.ph_hi = 11; a.mode = 0;
    const hipError_t le = hipLaunchCooperativeKernel((const void*)mk_fwd, dim3(grid), dim3(NWAVES * 64), kargs, (unsigned)LDS_BYTES, stream);
    if (le != hipSuccess) fprintf(stderr, "kernel_launch: cooperative launch failed: %s (grid %d)\n", hipGetErrorString(le), grid);
}
```

```cpp
#include <hip/hip_runtime.h>
#include <hip/hip_cooperative_groups.h>
#include <cstdio>
#include <cstdint>

namespace pg8 {
#define PG8_LAS __attribute__((address_space(3)))
typedef unsigned short bf16_t;
typedef short bf16x8 __attribute__((ext_vector_type(8)));
typedef float f32x4 __attribute__((ext_vector_type(4)));
typedef unsigned u32x4 __attribute__((ext_vector_type(4)));
typedef unsigned u32x2 __attribute__((ext_vector_type(2)));
typedef int v4i_t __attribute__((ext_vector_type(4)));
typedef int v8i_t __attribute__((ext_vector_type(8)));
constexpr int BM = 256, BK = 64, HALF = 128, HTB = HALF * BK * 2  , STAGE_BYTES = 8 * HTB, NXCD = 8, WGM = 8;

__host__ __device__ __forceinline__ int lds_byte(int r, int c) { const int st = (r >> 4) * 2 + (c >> 5), rr = r & 15, cc = c & 31, ob = rr * 64 + cc * 2; return st * 1024 + (ob ^ (((ob >> 9) & 1) << 5)); }
__host__ __device__ __forceinline__ void stage_rc(int b, int& R, int& C) { const int st = b / 1024, sb = b % 1024, swz = sb ^ (((sb >> 9) & 1) << 5); R = (st >> 1) * 16 + swz / 64; C = (st & 1) * 32 + (swz % 64) / 2; }
__host__ __device__ __forceinline__ int perm32(int rho) { const int n = rho >> 4, i = rho & 15; return 8 * (i >> 2) + 4 * n + (i & 3); }

struct Unit { int pm, pn; const char* a; const char* b; long bjump; int aux; int nvalid; };
struct Gemm { int K, lda, ldb, ksplit; int sw = 122, sa = 127; };

struct StaticOrder {
    static constexpr bool GATHER = false; const int* ptok = nullptr;
    int nM, nN, nwg, G, c; const char* A; const char* Bt; size_t tA, tB;
    __device__ void init(int M, int N, int G_, int c_, const void* A_, int lda, const void* Bt_, int ldb) { nM = M / BM; nN = N / BM; nwg = nM * nN; G = G_; c = c_; A = (const char*)A_; Bt = (const char*)Bt_; tA = (size_t)BM * lda * 2; tB = (size_t)BM * ldb * 2; }
    __device__ bool next(int i, Unit& u) const {
        const long L = (long)i * G + c; if (L >= nwg) return false;
        int wgid = (int)L; { const int q = nwg / NXCD, r = nwg % NXCD, xcd = wgid % NXCD, off = wgid / NXCD; wgid = (xcd < r ? xcd * (q + 1) : r * (q + 1) + (xcd - r) * q) + off; }
        const int nig = WGM * nN, gid = wgid / nig, fm = gid * WGM, gsz = (nM - fm) < WGM ? (nM - fm) : WGM;
        u.pm = fm + ((wgid % nig) % gsz); u.pn = (wgid % nig) / gsz; u.a = A + (size_t)u.pm * tA; u.b = Bt + (size_t)u.pn * tB; u.bjump = 0; u.aux = 0; u.nvalid = 256; return true;
    }
    __device__ __forceinline__ void a_ready(const Unit&) const {}
    __device__ __forceinline__ void done(const Unit&) const {}
};

typedef float f32x2c __attribute__((ext_vector_type(2))); typedef __bf16 bf16x2c __attribute__((ext_vector_type(2)));
__device__ __forceinline__ unsigned cvt_pk_bf16(float lo, float hi) { const f32x2c v = {lo, hi}; const bf16x2c b = __builtin_convertvector(v, bf16x2c); return __builtin_bit_cast(unsigned, b); }
__device__ __forceinline__ float bf_lo(unsigned w) { return __uint_as_float(w << 16); }
__device__ __forceinline__ float bf_hi(unsigned w) { return __uint_as_float(w & 0xffff0000u); }


template <class E, class = void> struct epi_keeps { static constexpr bool v = false; };
template <class E> struct epi_keeps<E, decltype((void)E::KEEPS)> { static constexpr bool v = E::KEEPS; };
template <class Epi, class Sched, bool ALIGN_EPI = false, bool SP2 = false, bool FP8 = false>
__device__ __forceinline__ void gemm_phase(PG8_LAS unsigned char* lds, const Gemm g, const Sched& S, const Epi& E) {
    int tid = threadIdx.x; asm volatile("" : "+v"(tid));
    const int wid = __builtin_amdgcn_readfirstlane(tid >> 6), lane = tid & 63, wr = wid >> 2, wc = wid & 3, fr = lane & 15, fq = lane >> 4;
    const int K = g.K, nt = K / BK;
    unsigned voffA[2], voffB[2]; int gR[2]; unsigned gC[2];
#pragma unroll
    for (int i = 0; i < 2; ++i) { int R, C; stage_rc(tid * 16 + i * 8192, R, C); const int Rb = Epi::PERM ? ((R & ~31) + perm32(R & 31)) : R; gR[i] = R; gC[i] = (unsigned)C * 2u;
        voffA[i] = (unsigned)(R * g.lda + C) * 2u; voffB[i] = (unsigned)(Rb * g.ldb + C) * 2u; }
    unsigned gA0[2] = {0u, 0u}, gA1[2] = {0u, 0u}, gN0[2] = {0u, 0u}, gN1[2] = {0u, 0u};
#define PG8_GOFF(u_, o0, o1) do { _Pragma("unroll") for (int i_ = 0; i_ < 2; ++i_) { const int r0_ = gR[i_], r1_ = HALF + gR[i_]; const int l0_ = S.ptok[(u_).aux + (u_).pm * BM + (r0_ < (u_).nvalid ? r0_ : 0)], l1_ = S.ptok[(u_).aux + (u_).pm * BM + (r1_ < (u_).nvalid ? r1_ : 0)]; const int t0_ = r0_ < (u_).nvalid ? l0_ : 0, t1_ = r1_ < (u_).nvalid ? l1_ : 0; \
        o0[i_] = (unsigned)t0_ * (unsigned)(g.lda * 2) + gC[i_]; o1[i_] = (unsigned)t1_ * (unsigned)(g.lda * 2) + gC[i_]; } } while (0)
    const size_t kstep = (size_t)(BK * 2);
    const size_t hstepA = Sched::GATHER ? (size_t)0 : (size_t)HALF * g.lda * 2, hstepB = (size_t)HALF * g.ldb * 2;
    const unsigned ldsw = (unsigned)wid * 1024u;
    const int aoff = lds_byte(wr * 64 + fr, fq * 8), boff = lds_byte(wc * 32 + fr, fq * 8);
#define PG8_CAT(x0, x1) __builtin_shufflevector(__builtin_bit_cast(v4i_t, x0), __builtin_bit_cast(v4i_t, x1), 0, 1, 2, 3, 4, 5, 6, 7)
#define PG8_SA(b, h) (((b) * 2 + (h)) * HTB)
#define PG8_SB(b, h) ((4 + (b) * 2 + (h)) * HTB)
#define PG8_STAGE(bufoff, gbase, voff) do { _Pragma("unroll") for (int _i = 0; _i < 2; ++_i) \
        __builtin_amdgcn_global_load_lds((const unsigned*)((const char*)(gbase) + (voff)[_i]), (PG8_LAS unsigned*)(lds + (bufoff) + ldsw + _i * 8192), 16, 0, 0); } while (0)
#define PG8_LDA(dst, b, h) do { if constexpr (FP8) { _Pragma("unroll") for (int m = 0; m < 4; ++m) dst##8[m] = PG8_CAT(*(const PG8_LAS bf16x8*)(lds + PG8_SA(b, h) + aoff + m * 2048), *(const PG8_LAS bf16x8*)(lds + PG8_SA(b, h) + aoff + m * 2048 + 1024)); } \
      else { _Pragma("unroll") for (int m = 0; m < 4; ++m) _Pragma("unroll") for (int k = 0; k < 2; ++k) dst[m][k] = *(const PG8_LAS bf16x8*)(lds + PG8_SA(b, h) + aoff + m * 2048 + k * 1024); } } while (0)
#define PG8_LDB(dst, b, h) do { if constexpr (FP8) { _Pragma("unroll") for (int n = 0; n < 2; ++n) dst##8[n] = PG8_CAT(*(const PG8_LAS bf16x8*)(lds + PG8_SB(b, h) + boff + n * 2048), *(const PG8_LAS bf16x8*)(lds + PG8_SB(b, h) + boff + n * 2048 + 1024)); } \
      else { _Pragma("unroll") for (int n = 0; n < 2; ++n) _Pragma("unroll") for (int k = 0; k < 2; ++k) dst[n][k] = *(const PG8_LAS bf16x8*)(lds + PG8_SB(b, h) + boff + n * 2048 + k * 1024); } } while (0)
#define PG8_MMA(ai, bj, At, Bt) do { __builtin_amdgcn_s_setprio(1); if constexpr (FP8) { _Pragma("unroll") for (int m = 0; m < 4; ++m) _Pragma("unroll") for (int n = 0; n < 2; ++n) \
        asm volatile("v_mfma_scale_f32_16x16x128_f8f6f4 %0, %1, %2, %0, %3, %4 op_sel_hi:[0,0,0]" : "+v"(acc[ai][bj][m][n]) : "v"(Bt##8[n]), "v"(At##8[m]), "v"(scw8), "v"(sca8)); } \
      else { _Pragma("unroll") for (int m = 0; m < 4; ++m) _Pragma("unroll") for (int n = 0; n < 2; ++n) _Pragma("unroll") for (int k = 0; k < 2; ++k) \
        acc[ai][bj][m][n] = __builtin_amdgcn_mfma_f32_16x16x32_bf16(Bt[n][k], At[m][k], acc[ai][bj][m][n], 0, 0, 0); } __builtin_amdgcn_s_setprio(0); } while (0)
#define PG8_WAIT_V(n) asm volatile("s_waitcnt vmcnt(" #n ")" ::: "memory")
#define PG8_WAIT_L(n) asm volatile("s_waitcnt lgkmcnt(" #n ")" ::: "memory")
#define PG8_BAR __builtin_amdgcn_s_barrier()
#define PG8_SCHED __builtin_amdgcn_sched_barrier(0)
    Unit cur, nxt; int ui = 0;
    if (!S.next(0, cur)) return;
    f32x4 acc[2][2][4][2];
#pragma unroll
    for (int a = 0; a < 2; ++a)
#pragma unroll
        for (int b = 0; b < 2; ++b)
#pragma unroll
            for (int m = 0; m < 4; ++m)
#pragma unroll
                for (int n = 0; n < 2; ++n) acc[a][b][m][n] = (f32x4){0.f, 0.f, 0.f, 0.f};
    int scw8 = g.sw, sca8 = g.sa; asm volatile("" : "+v"(scw8), "+v"(sca8));
    bf16x8 At[4][2], B0[2][2], B1[2][2]; v8i_t At8[4], B08[2], B18[2];
    const char* cA = cur.a; const char* cB = cur.b; long cJ = cur.bjump;
    S.a_ready(cur);
    if constexpr (SP2) {
        if constexpr (Sched::GATHER) PG8_GOFF(cur, gA0, gA1);
        PG8_STAGE(PG8_SB(0, 0), cB, voffB); PG8_STAGE(PG8_SB(0, 1), cB + hstepB, voffB); do { if constexpr (Sched::GATHER) { PG8_STAGE(PG8_SA(0, 0), cA, gA0); } else { PG8_STAGE(PG8_SA(0, 0), cA, voffA); } } while (0); do { if constexpr (Sched::GATHER) { PG8_STAGE(PG8_SA(0, 1), cA, gA1); } else { PG8_STAGE(PG8_SA(0, 1), cA + hstepA, voffA); } } while (0);
        if (wr == 1) PG8_BAR;
        PG8_WAIT_V(2); PG8_BAR;
        PG8_STAGE(PG8_SB(1, 0), cB + kstep, voffB); do { if constexpr (Sched::GATHER) { PG8_STAGE(PG8_SA(1, 0), cA + kstep, gA0); } else { PG8_STAGE(PG8_SA(1, 0), cA + kstep, voffA); } } while (0); PG8_STAGE(PG8_SB(1, 1), cB + hstepB + kstep, voffB);
        PG8_WAIT_V(6); PG8_BAR;
    } else {
        PG8_STAGE(PG8_SB(0, 0), cB, voffB); PG8_STAGE(PG8_SA(0, 0), cA, voffA); PG8_STAGE(PG8_SB(0, 1), cB + hstepB, voffB); PG8_STAGE(PG8_SA(0, 1), cA + hstepA, voffA);
        if (wr == 1) PG8_BAR;
        PG8_WAIT_V(4); PG8_BAR;
        PG8_STAGE(PG8_SB(1, 0), cB + kstep, voffB); PG8_STAGE(PG8_SA(1, 0), cA + kstep, voffA); PG8_STAGE(PG8_SB(1, 1), cB + hstepB + kstep, voffB);
        PG8_WAIT_V(6); PG8_BAR;
    }
    for (;;) {
        const bool has_next = S.next(ui + 1, nxt);
        const char* nA = has_next ? nxt.a : cA; const char* nB = has_next ? nxt.b : cB;
        if constexpr (Sched::GATHER) {
            if (has_next) { _Pragma("unroll") for (int i_ = 0; i_ < 2; ++i_) { const int r0_ = gR[i_], r1_ = HALF + gR[i_];
                const unsigned a0_ = (unsigned)S.ptok[nxt.aux + nxt.pm * BM + (r0_ < nxt.nvalid ? r0_ : 0)], a1_ = (unsigned)S.ptok[nxt.aux + nxt.pm * BM + (r1_ < nxt.nvalid ? r1_ : 0)];
                gN0[i_] = r0_ < nxt.nvalid ? a0_ : 0u; gN1[i_] = r1_ < nxt.nvalid ? a1_ : 0u; } }
            else { gN0[0] = gA0[0]; gN0[1] = gA0[1]; gN1[0] = gA1[0]; gN1[1] = gA1[1]; } }
#pragma unroll 1
        for (int t = 0; t < nt; t += 2) {
            const bool last = (t == nt - 2);
            const char* a1 = cA + (size_t)(t + 1) * kstep;
            const char* a2 = last ? nA : cA + (size_t)(t + 2) * kstep; const char* b2 = last ? nB : cB + (size_t)(t + 2) * kstep + ((t + 2) >= g.ksplit ? cJ : 0L);
            const char* a3 = a2 + kstep; const char* b3 = b2 + kstep;
            if (last && has_next) S.a_ready(nxt);
            unsigned x0[2] = {0u, 0u}, x1[2] = {0u, 0u};
            if constexpr (Sched::GATHER) { if (last && has_next) { _Pragma("unroll") for (int i_ = 0; i_ < 2; ++i_) { gN0[i_] = gN0[i_] * (unsigned)(g.lda * 2) + gC[i_]; gN1[i_] = gN1[i_] * (unsigned)(g.lda * 2) + gC[i_]; } }
              x0[0] = last ? gN0[0] : gA0[0]; x0[1] = last ? gN0[1] : gA0[1]; x1[0] = last ? gN1[0] : gA1[0]; x1[1] = last ? gN1[1] : gA1[1]; }
            if constexpr (SP2) {
            PG8_LDB(B0, 0, 0); PG8_LDB(B1, 0, 1); PG8_SCHED; PG8_LDA(At, 0, 0); do { if constexpr (Sched::GATHER) { PG8_STAGE(PG8_SA(1, 1), a1, gA1); } else { PG8_STAGE(PG8_SA(1, 1), a1 + hstepA, voffA); } } while (0);
            PG8_WAIT_V(8); PG8_WAIT_L(0); PG8_BAR; PG8_MMA(0, 0, At, B0); PG8_MMA(0, 1, At, B1); PG8_BAR; PG8_SCHED;
            PG8_LDA(At, 0, 1); PG8_STAGE(PG8_SB(0, 0), b2, voffB); PG8_STAGE(PG8_SB(0, 1), b2 + hstepB, voffB); do { if constexpr (Sched::GATHER) { PG8_STAGE(PG8_SA(0, 0), a2, x0); } else { PG8_STAGE(PG8_SA(0, 0), a2, voffA); } } while (0);
            PG8_WAIT_V(8); PG8_WAIT_L(0); PG8_BAR; PG8_MMA(1, 0, At, B0); PG8_MMA(1, 1, At, B1); PG8_BAR; PG8_SCHED;
            PG8_LDB(B0, 1, 0); PG8_LDB(B1, 1, 1); PG8_SCHED; PG8_LDA(At, 1, 0); do { if constexpr (Sched::GATHER) { PG8_STAGE(PG8_SA(0, 1), a2, x1); } else { PG8_STAGE(PG8_SA(0, 1), a2 + hstepA, voffA); } } while (0);
            PG8_WAIT_V(8); PG8_WAIT_L(0); PG8_BAR; PG8_MMA(0, 0, At, B0); PG8_MMA(0, 1, At, B1); PG8_BAR; PG8_SCHED;
            PG8_LDA(At, 1, 1); PG8_STAGE(PG8_SB(1, 0), b3, voffB); PG8_STAGE(PG8_SB(1, 1), b3 + hstepB, voffB); do { if constexpr (Sched::GATHER) { PG8_STAGE(PG8_SA(1, 0), a3, x0); } else { PG8_STAGE(PG8_SA(1, 0), a3, voffA); } } while (0);
            PG8_WAIT_V(8); PG8_WAIT_L(0); PG8_BAR; PG8_MMA(1, 0, At, B0); PG8_MMA(1, 1, At, B1); PG8_BAR; PG8_SCHED;
            } else {
            PG8_LDB(B0, 0, 0); PG8_SCHED; PG8_LDA(At, 0, 0); PG8_STAGE(PG8_SA(1, 1), a1 + hstepA, voffA);
            PG8_WAIT_L(8); PG8_BAR; PG8_WAIT_L(0); PG8_MMA(0, 0, At, B0); PG8_BAR; PG8_SCHED;
            PG8_LDB(B1, 0, 1); PG8_STAGE(PG8_SB(0, 0), b2, voffB);
            PG8_BAR; PG8_WAIT_L(0); PG8_MMA(0, 1, At, B1); PG8_BAR;
            PG8_LDA(At, 0, 1); PG8_STAGE(PG8_SA(0, 0), a2, voffA);
            PG8_BAR; PG8_WAIT_L(0); PG8_MMA(1, 0, At, B0); PG8_BAR; PG8_SCHED;
            PG8_STAGE(PG8_SB(0, 1), b2 + hstepB, voffB);
            PG8_WAIT_V(6); PG8_BAR; PG8_MMA(1, 1, At, B1); PG8_BAR;
            PG8_LDB(B0, 1, 0); PG8_SCHED; PG8_LDA(At, 1, 0); PG8_STAGE(PG8_SA(0, 1), a2 + hstepA, voffA);
            PG8_WAIT_L(8); PG8_BAR; PG8_WAIT_L(0); PG8_MMA(0, 0, At, B0); PG8_BAR; PG8_SCHED;
            PG8_LDB(B1, 1, 1); PG8_STAGE(PG8_SB(1, 0), b3, voffB);
            PG8_BAR; PG8_WAIT_L(0); PG8_MMA(0, 1, At, B1); PG8_BAR;
            PG8_LDA(At, 1, 1); PG8_STAGE(PG8_SA(1, 0), a3, voffA);
            PG8_BAR; PG8_WAIT_L(0); PG8_MMA(1, 0, At, B0); PG8_BAR; PG8_SCHED;
            PG8_STAGE(PG8_SB(1, 1), b3 + hstepB, voffB);
            PG8_WAIT_V(6); PG8_BAR; PG8_MMA(1, 1, At, B1); PG8_BAR;
            }
        }
        if constexpr (ALIGN_EPI) { if (wr == 0) PG8_BAR; }
        bool keep_acc = false;
        if constexpr (epi_keeps<Epi>::v) { keep_acc = E.keep(cur); if (keep_acc) E.mid(acc, cur, wr, wc, fr, fq); else E(acc, cur, wr, wc, fr, fq); S.done(cur); } else
        if constexpr (!Epi::AFTER_DRAIN) { E(acc, cur, wr, wc, fr, fq); S.done(cur); }
        if (!has_next) break;
        if (!keep_acc) {
#pragma unroll
        for (int a = 0; a < 2; ++a)
#pragma unroll
            for (int b = 0; b < 2; ++b)
#pragma unroll
                for (int m = 0; m < 4; ++m)
#pragma unroll
                    for (int n = 0; n < 2; ++n) acc[a][b][m][n] = (f32x4){0.f, 0.f, 0.f, 0.f};
        }
        cur = nxt; cA = nA; cB = nB; cJ = cur.bjump; ++ui;
        if constexpr (Sched::GATHER) { gA0[0] = gN0[0]; gA0[1] = gN0[1]; gA1[0] = gN1[0]; gA1[1] = gN1[1]; }
        if constexpr (ALIGN_EPI) { if (wr == 1) PG8_BAR; }
    }
    PG8_WAIT_V(0);
    if constexpr (!ALIGN_EPI) { if (wr == 0) PG8_BAR; }
    PG8_BAR;
    if constexpr (Epi::AFTER_DRAIN) { E.fused(acc, cur, wr, wc, fr, fq, lds, wid, lane); S.done(cur); }
#undef PG8_GOFF
#undef PG8_SA
#undef PG8_SB
#undef PG8_STAGE
#undef PG8_LDA
#undef PG8_LDB
#undef PG8_MMA
#undef PG8_CAT
#undef PG8_WAIT_V
#undef PG8_WAIT_L
#undef PG8_BAR
#undef PG8_SCHED
}
}

#ifndef PROBE_PH
#define PROBE_PH (-1)
#endif
#ifndef PROBE_MODE
#define PROBE_MODE (0)
#endif
constexpr int D = 1024, BATCH = 16, SEQ = 2048, T = BATCH * SEQ;
constexpr int INW = 6984, INWP = 7168;
constexpr int C_QA = 0, C_CKV = 1024, C_QI = 1280, C_KI = 1792, C_WI = 1856, C_RQ = 1864, C_RK = 2376, C_RV = 2888, C_RG = 3912, C_GA = 4936, C_GR = 5960;
constexpr float EPS = 1e-6f;
constexpr int NWAVES = 8;

constexpr size_t MiB = 1u << 20;
constexpr size_t WS_CTL = 0, CTL_ZERO_BYTES = 1 * MiB; constexpr int CTL_USED_WORDS = 8192;
constexpr size_t WS_WIN = 1 * MiB, WS_WKV = 15 * MiB, WS_WATT = 16 * MiB, WS_WRET = 18 * MiB, WS_WOUT = 20 * MiB, WS_W1 = 22 * MiB, WS_WD = 38 * MiB, WS_ACT = 46 * MiB;
constexpr size_t O_QA = 0, O_CKV = 2048, O_QI = 2560, O_KW = 3584, O_RQ = 3840, O_RK = 4864, O_RV = 5888, O_RG = 7936, O_GA = 9984, O_GR = 12032, O_END = 14080;

constexpr int MP_ROWS = 38912;
constexpr size_t MO_APERM = 0, MO_ACT = 80 * MiB, MO_N2 = 120 * MiB, MO_META = 184 * MiB;
constexpr size_t MM_B = 0, MM_P = 131072, MM_CL = 262144, MM_CH = 393216, MM_RS = 524288, MM_PTOK = 655360, MM_PRS = 819200, MM_PCL = 983040, MM_PCH = 1146880, MM_END = 1310720;
constexpr size_t WS_WR = 15 * MiB + 512 * 1024;
constexpr size_t O_A2F8 = 1024;
constexpr size_t O_RSTATE = O_RQ + 512;
#define A2F8_PTR (F.act + (size_t)F.ntok * O_A2F8)
#define RSTATE_PTR ((float*)(F.act + (size_t)F.ntok * O_RSTATE))
#define RSTD1_PTR ((float*)(F.act + (size_t)F.ntok * O_RSTATE + 8 * MiB))
constexpr size_t MO_LIST = 152 * MiB; constexpr int LIST_CAP = 32768;
constexpr size_t MO_H16 = 192 * MiB;
constexpr size_t WS_WIN8 = 488 * MiB;
constexpr size_t WS_WATT8 = 495 * MiB, WS_WRET8 = 496 * MiB, WS_WOUT8 = 497 * MiB;
constexpr size_t O_MIX8 = 3840;
constexpr size_t WS_W18 = 498 * MiB, WS_WD8 = 506 * MiB;
constexpr size_t AUX_XB8 = 2048 + 896;
constexpr int F8_FIRST_TILE = 8;
constexpr int CW_MOE = 256;
constexpr int RING_OFF = 0, RING_BYTES = 131072, P3_HIST_OFF = 131072, P3_TOT_OFF = 147456, P3_T_OFF = 149504, LDSCTL_OFF = 151552, MISC_OFF = LDSCTL_OFF + 320, LDS_BYTES = 152576;
constexpr int CW_Q3 = 64, CW_Q4 = 128;

#define GAS __attribute__((address_space(1)))
#define LAS __attribute__((address_space(3)))
typedef unsigned short bf16;
typedef unsigned v4u __attribute__((ext_vector_type(4)));
typedef float f32x4 __attribute__((ext_vector_type(4)));
#define LDS_WAIT() asm volatile("s_waitcnt lgkmcnt(0)" ::: "memory")
#define VM_WAIT() asm volatile("s_waitcnt vmcnt(0)" ::: "memory")
__device__ __forceinline__ unsigned pk2(float lo, float hi) { return pg8::cvt_pk_bf16(lo, hi); }
__device__ __forceinline__ unsigned f2bf(float f) { return pg8::cvt_pk_bf16(f, 0.f) & 0xffffu; }
__device__ __forceinline__ float bf2f(bf16 b) { return __uint_as_float((unsigned)b << 16); }


typedef GAS unsigned gu32;
constexpr int CW_BAR = 4096;
#define XB_TMO      128
#define XB_XCNT(j)  (256  + 64 * (j))
#define XB_XSUB(j)  (1280 + 64 * (j))
#define XB_XGEN(j)  (2304 + 64 * (j))
#define XB_TOP      3328
#define XB_TOPGEN   3392
#define XCD_BAR_WORDS 3456
#define XB_SPIN_CAP (1u << 18)

__device__ __forceinline__ unsigned xb_ld(unsigned* p)              { return __hip_atomic_load(p, __ATOMIC_RELAXED, __HIP_MEMORY_SCOPE_AGENT); }
__device__ __forceinline__ unsigned xb_add(unsigned* p, unsigned v) { return __hip_atomic_fetch_add(p, v, __ATOMIC_RELAXED, __HIP_MEMORY_SCOPE_AGENT); }
__device__ __forceinline__ unsigned xb_xcc_id() { return (unsigned)__builtin_amdgcn_s_getreg((3 << 11) | 20) & 0xFu; }
#define XB_SPIN(cond, bar) do { unsigned _sp = 0; while (cond) { __builtin_amdgcn_s_sleep(1); \
    if ((++_sp & 255u) == 0u) { if (xb_ld(&(bar)[XB_TMO])) break; if (_sp > XB_SPIN_CAP) { atomicAdd(&(bar)[XB_TMO], 1u); break; } } } } while (0)

struct XcdBarrier {
    unsigned* bar; unsigned x;
    volatile LAS unsigned* st;
};

__device__ __forceinline__ XcdBarrier xcd_barrier_post(unsigned* bar, volatile LAS unsigned* st) {
    XcdBarrier b; b.bar = bar; b.x = xb_xcc_id(); b.st = st;
    if (threadIdx.x == 0) (void)xb_add(&bar[XB_XCNT(b.x)], 1u);
    return b;
}
__device__ __forceinline__ void xcd_barrier_complete(unsigned* bar, unsigned x, unsigned& nloc, unsigned& nx) {
    const unsigned G = gridDim.x * gridDim.y * gridDim.z;
    unsigned sum, cnt, mine, sp = 0u;
    for (;;) {
        sum = 0u; cnt = 0u; mine = 0u;
#pragma unroll
        for (unsigned j = 0; j < 16; ++j) { const unsigned c = xb_ld(&bar[XB_XCNT(j)]); sum += c; cnt += (c > 0u) ? 1u : 0u; mine = (j == x) ? c : mine; }
        if (sum == G) break;
        __builtin_amdgcn_s_sleep(1);
        if ((++sp & 255u) == 0u) { if (xb_ld(&bar[XB_TMO])) break; if (sp > XB_SPIN_CAP) { atomicAdd(&bar[XB_TMO], 1u); break; } }
    }
    nloc = mine > 0u ? mine : 1u; nx = cnt > 0u ? cnt : 1u;
}

__device__ __forceinline__ void xcd_barrier(const XcdBarrier& b) {
    asm volatile("s_waitcnt vmcnt(0)" ::: "memory");
    __syncthreads();
    if (threadIdx.x == 0) {
        unsigned* bar = b.bar;
        __builtin_amdgcn_s_waitcnt(0);
        unsigned nloc = b.st[0], nx = b.st[1];
        if (nloc == 0u) { xcd_barrier_complete(bar, b.x, nloc, nx); b.st[0] = nloc; b.st[1] = nx; }
        const unsigned old = xb_add(&bar[XB_XSUB(b.x)], 1u);
        const unsigned gen = old / nloc;
        if (old + 1u == (gen + 1u) * nloc) {
            __builtin_amdgcn_fence(__ATOMIC_RELEASE, "agent");
            asm volatile("s_waitcnt vmcnt(0)" ::: "memory");
            const unsigned og = xb_add(&bar[XB_TOP], 1u);
            const unsigned tg = og / nx;
            if (og + 1u == (tg + 1u) * nx) xb_add(&bar[XB_TOPGEN], 1u);
            else XB_SPIN(xb_ld(&bar[XB_TOPGEN]) == tg, bar);
            __builtin_amdgcn_fence(__ATOMIC_ACQUIRE, "agent");
            xb_add(&bar[XB_XGEN(b.x)], 1u);
            asm volatile("s_waitcnt vmcnt(0)" ::: "memory");
        } else {
            XB_SPIN(xb_ld(&bar[XB_XGEN(b.x)]) == gen, bar);
            __builtin_amdgcn_fence(__ATOMIC_ACQUIRE, "agent");
            asm volatile("s_waitcnt vmcnt(0)" ::: "memory");
        }
    }
    __syncthreads();
}

struct Args { const float* in[20]; float* out; unsigned char* ws; unsigned char* xb; int ph_lo, ph_hi, ntok, tok0, mode, pad; };

struct Frame {
    LAS unsigned char* lds;
    int tid, lane, wave, vcu, G;
    int ntok;
    unsigned char* ws; unsigned char* act; unsigned char* xbp;
};

struct EpiProj {
    static constexpr bool PERM = true, AFTER_DRAIN = false;
    unsigned char* act; size_t ntok; const float* rstd1;
    static __device__ __forceinline__ unsigned q4(const pg8::f32x4& v) { int w = __builtin_amdgcn_cvt_pk_fp8_f32(v[0], v[1], 0, false); return (unsigned)__builtin_amdgcn_cvt_pk_fp8_f32(v[2], v[3], w, true); }
    __device__ __forceinline__ void operator()(const pg8::f32x4 (&acc)[2][2][4][2], const pg8::Unit& u, int wr, int wc, int fr, int fq) const {
        const int pn = u.pn; size_t O; int ld, cb, nbj = 2; bool f8 = false;
        if (pn < 4) { O = O_QA; ld = 1024; cb = pn * 256; }
        else if (pn == 4) { O = O_CKV; ld = 256; cb = 0; }
        else if (pn < 7) { O = O_QI; ld = 512; cb = (pn - 5) * 256; }
        else if (pn == 7) { O = O_KW; ld = 128; cb = 0; nbj = 1; }
        else if (pn < 10) { O = O_RQ; ld = 512; cb = (pn - 8) * 256; }
        else if (pn < 12) { O = O_RK; ld = 512; cb = (pn - 10) * 256; }
        else { O = O_RV + (size_t)((pn - 12) >> 2) * 2048; ld = 1024; cb = ((pn - 12) & 3) * 256; }
        f8 = pn < 5 || pn >= F8_FIRST_TILE;
        const int row0 = u.pm * pg8::BM + wr * 64 + fr;
        if (f8) {
            unsigned char* base = act + ntok * O; const bool odd = fq & 1; const int colb = cb + wc * 32 + 8 * (fq & ~1);
#pragma unroll
            for (int ai = 0; ai < 2; ++ai)
#pragma unroll
                for (int bj = 0; bj < 2; ++bj)
#pragma unroll
                    for (int mp = 0; mp < 2; ++mp) { const unsigned x0 = q4(acc[ai][bj][2 * mp][0]), x1 = q4(acc[ai][bj][2 * mp][1]), y0 = q4(acc[ai][bj][2 * mp + 1][0]), y1 = q4(acc[ai][bj][2 * mp + 1][1]);
                        const unsigned r0 = (unsigned)__builtin_amdgcn_ds_swizzle((int)(odd ? x0 : y0), 0x401F), r1 = (unsigned)__builtin_amdgcn_ds_swizzle((int)(odd ? x1 : y1), 0x401F);
                        pg8::u32x4 w; if (odd) { w.x = r0; w.y = r1; w.z = y0; w.w = y1; } else { w.x = x0; w.y = x1; w.z = r0; w.w = r1; }
                        *(pg8::u32x4*)(base + (size_t)(row0 + ai * pg8::HALF + (2 * mp + (odd ? 1 : 0)) * 16) * ld + colb + bj * pg8::HALF) = w; }
            return;
        }
        pg8::bf16_t* base = (pg8::bf16_t*)(act + ntok * O);
        const int col0 = cb + wc * 32 + 8 * fq;
        float rs1[2][4];
#pragma unroll
        for (int ai = 0; ai < 2; ++ai)
#pragma unroll
            for (int m = 0; m < 4; ++m) rs1[ai][m] = rstd1[row0 + ai * pg8::HALF + m * 16];
#pragma unroll
        for (int ai = 0; ai < 2; ++ai)
#pragma unroll
            for (int m = 0; m < 4; ++m) { pg8::bf16_t* rowp = base + (size_t)(row0 + ai * pg8::HALF + m * 16) * ld + col0; const float rs = rs1[ai][m];
#pragma unroll
                for (int bj = 0; bj < 2; ++bj) if (bj < nbj) { const pg8::f32x4 v0 = acc[ai][bj][m][0] * rs, v1 = acc[ai][bj][m][1] * rs;
                    pg8::u32x4 w; w.x = pg8::cvt_pk_bf16(v0[0], v0[1]); w.y = pg8::cvt_pk_bf16(v0[2], v0[3]); w.z = pg8::cvt_pk_bf16(v1[0], v1[1]); w.w = pg8::cvt_pk_bf16(v1[2], v1[3]);
                    *(pg8::u32x4*)(rowp + bj * pg8::HALF) = w; } }
    }
};

__device__ __forceinline__ float sigm(float x) { return __builtin_amdgcn_rcpf(1.f + __builtin_amdgcn_exp2f(-1.4426950408889634f * x)); }
__device__ __forceinline__ void f8x8(const pg8::u32x2 g, float (&f)[8]) { const auto a = __builtin_amdgcn_cvt_pk_f32_fp8((int)g.x, false), b = __builtin_amdgcn_cvt_pk_f32_fp8((int)g.x, true), c = __builtin_amdgcn_cvt_pk_f32_fp8((int)g.y, false), d = __builtin_amdgcn_cvt_pk_f32_fp8((int)g.y, true);
    f[0] = a[0]; f[1] = a[1]; f[2] = b[0]; f[3] = b[1]; f[4] = c[0]; f[5] = c[1]; f[6] = d[0]; f[7] = d[1]; }
__device__ __forceinline__ void st_f8_pair(unsigned char* base, size_t ld, int row_m0, int colb, bool odd, unsigned x0, unsigned x1, unsigned y0, unsigned y1) {
    const unsigned r0 = (unsigned)__builtin_amdgcn_ds_swizzle((int)(odd ? x0 : y0), 0x401F), r1 = (unsigned)__builtin_amdgcn_ds_swizzle((int)(odd ? x1 : y1), 0x401F);
    pg8::u32x4 w; if (odd) { w.x = r0; w.y = r1; w.z = y0; w.w = y1; } else { w.x = x0; w.y = x1; w.z = r0; w.w = r1; }
    *(pg8::u32x4*)(base + (size_t)(row_m0 + (odd ? 16 : 0)) * ld + colb) = w;
}
__device__ __forceinline__ unsigned q4f(float a, float b, float c, float d) { int w = __builtin_amdgcn_cvt_pk_fp8_f32(a, b, 0, false); return (unsigned)__builtin_amdgcn_cvt_pk_fp8_f32(c, d, w, true); }
struct GateOrder {
    static constexpr bool GATHER = false; const int* ptok = nullptr;
    pg8::StaticOrder S0; const char* A1; const char* B1;
    __device__ bool next(int i, pg8::Unit& u) const { if (!S0.next(i >> 1, u)) return false; if (i & 1) { u.a = A1 + (size_t)u.pm * S0.tA; u.b = B1 + (size_t)u.pn * S0.tB; u.aux = 1; } return true; }
    __device__ __forceinline__ void a_ready(const pg8::Unit&) const {}
    __device__ __forceinline__ void done(const pg8::Unit&) const {}
};
__device__ __forceinline__ float sigm_c(float x) { return __builtin_amdgcn_rcpf(1.f + __builtin_amdgcn_exp2f(-1.4426950408889634f * fmaxf(x, -40.f))); }
struct EpiGateFused {
    static constexpr bool PERM = true, AFTER_DRAIN = false, KEEPS = true;
    const unsigned char* GA8; const unsigned char* GR8; unsigned char* MIX8;
    __device__ __forceinline__ bool keep(const pg8::Unit& u) const { return u.aux == 0; }
    __device__ __forceinline__ void mid(pg8::f32x4 (&acc)[2][2][4][2], const pg8::Unit& u, int wr, int wc, int fr, int fq) const {
        const int row0 = u.pm * pg8::BM + wr * 64 + fr, col0 = u.pn * pg8::BM + wc * 32 + 8 * fq;
#pragma unroll
        for (int ai = 0; ai < 2; ++ai) { pg8::u32x2 ga[2][4], gr[2][4];
#pragma unroll
            for (int bj = 0; bj < 2; ++bj)
#pragma unroll
                for (int m = 0; m < 4; ++m) { const size_t ro = (size_t)(row0 + ai * pg8::HALF + m * 16) * 1024 + col0 + bj * pg8::HALF; ga[bj][m] = *(const pg8::u32x2*)(GA8 + ro); gr[bj][m] = *(const pg8::u32x2*)(GR8 + ro); }
#pragma unroll
            for (int bj = 0; bj < 2; ++bj)
#pragma unroll
                for (int m = 0; m < 4; ++m) { float a[8], r[8]; f8x8(ga[bj][m], a); f8x8(gr[bj][m], r);
#pragma unroll
                    for (int j = 0; j < 4; ++j) { acc[ai][bj][m][0][j] *= sigm(a[j]) * (0.0625f * (1.f + __builtin_amdgcn_exp2f(-1.4426950408889634f * fmaxf(r[j], -40.f))));
                                                  acc[ai][bj][m][1][j] *= sigm(a[4 + j]) * (0.0625f * (1.f + __builtin_amdgcn_exp2f(-1.4426950408889634f * fmaxf(r[4 + j], -40.f)))); } } }
    }
    __device__ __forceinline__ void operator()(const pg8::f32x4 (&acc)[2][2][4][2], const pg8::Unit& u, int wr, int wc, int fr, int fq) const {
        const int row0 = u.pm * pg8::BM + wr * 64 + fr, col0 = u.pn * pg8::BM + wc * 32 + 8 * fq, colb = u.pn * pg8::BM + wc * 32 + 8 * (fq & ~1); const bool odd = fq & 1;
        pg8::u32x2 gl[2][2][4];
#pragma unroll
        for (int ai = 0; ai < 2; ++ai)
#pragma unroll
            for (int bj = 0; bj < 2; ++bj)
#pragma unroll
                for (int m = 0; m < 4; ++m) gl[ai][bj][m] = *(const pg8::u32x2*)(GR8 + (size_t)(row0 + ai * pg8::HALF + m * 16) * 1024 + col0 + bj * pg8::HALF);
#pragma unroll
        for (int ai = 0; ai < 2; ++ai)
#pragma unroll
            for (int bj = 0; bj < 2; ++bj)
#pragma unroll
                for (int mp = 0; mp < 2; ++mp) { unsigned q[2][2];
#pragma unroll
                    for (int e = 0; e < 2; ++e) { const int m = 2 * mp + e; float g[8]; f8x8(gl[ai][bj][m], g);
                        const pg8::f32x4 v0 = acc[ai][bj][m][0], v1 = acc[ai][bj][m][1];
                        q[e][0] = q4f(128.f * sigm_c(g[0]) * v0[0], 128.f * sigm_c(g[1]) * v0[1], 128.f * sigm_c(g[2]) * v0[2], 128.f * sigm_c(g[3]) * v0[3]);
                        q[e][1] = q4f(128.f * sigm_c(g[4]) * v1[0], 128.f * sigm_c(g[5]) * v1[1], 128.f * sigm_c(g[6]) * v1[2], 128.f * sigm_c(g[7]) * v1[3]); }
                    st_f8_pair(MIX8, 1024, row0 + ai * pg8::HALF + 2 * mp * 16, colb + bj * pg8::HALF, odd, q[0][0], q[0][1], q[1][0], q[1][1]); }
    }
};
struct EpiResid {
    static constexpr bool PERM = true, AFTER_DRAIN = false;
    const pg8::bf16_t* xb; pg8::bf16_t* h16;
    __device__ __forceinline__ void operator()(const pg8::f32x4 (&acc)[2][2][4][2], const pg8::Unit& u, int wr, int wc, int fr, int fq) const {
        const int row0 = u.pm * pg8::BM + wr * 64 + fr, col0 = u.pn * pg8::BM + wc * 32 + 8 * fq;
        pg8::u32x4 xl[2][4][2];
#pragma unroll
        for (int ai = 0; ai < 2; ++ai)
#pragma unroll
            for (int m = 0; m < 4; ++m)
#pragma unroll
                for (int bj = 0; bj < 2; ++bj) xl[ai][m][bj] = *(const pg8::u32x4*)(xb + (size_t)(row0 + ai * pg8::HALF + m * 16) * 1024 + col0 + bj * pg8::HALF);
#pragma unroll
        for (int ai = 0; ai < 2; ++ai)
#pragma unroll
            for (int m = 0; m < 4; ++m) { const size_t ro = (size_t)(row0 + ai * pg8::HALF + m * 16) * 1024 + col0;
#pragma unroll
                for (int bj = 0; bj < 2; ++bj) { const pg8::u32x4 xv = xl[ai][m][bj]; const pg8::f32x4 v0 = acc[ai][bj][m][0], v1 = acc[ai][bj][m][1];
                    pg8::u32x4 w; w.x = pg8::cvt_pk_bf16(v0[0] + pg8::bf_lo(xv.x), v0[1] + pg8::bf_hi(xv.x)); w.y = pg8::cvt_pk_bf16(v0[2] + pg8::bf_lo(xv.y), v0[3] + pg8::bf_hi(xv.y));
                    w.z = pg8::cvt_pk_bf16(v1[0] + pg8::bf_lo(xv.z), v1[1] + pg8::bf_hi(xv.z)); w.w = pg8::cvt_pk_bf16(v1[2] + pg8::bf_lo(xv.w), v1[3] + pg8::bf_hi(xv.w));
                    *(pg8::u32x4*)(h16 + ro + bj * pg8::HALF) = w; } }
    }
};


struct P1Order {
    static constexpr bool GATHER = false; const int* ptok = nullptr;
    int nM, nN, nwg, G, c, mode; const char* A; const char* Bt; size_t tA, tB;
    __device__ bool next(int i, pg8::Unit& u) const {
        const long L = (long)i * G + c; if (L >= nwg) return false;
        int wgid = (int)L; { const int q = nwg / pg8::NXCD, r = nwg % pg8::NXCD, xcd = wgid % pg8::NXCD, off = wgid / pg8::NXCD; wgid = (xcd < r ? xcd * (q + 1) : r * (q + 1) + (xcd - r) * q) + off; }
        const int nig = pg8::WGM * nN, gid = wgid / nig, fm = gid * pg8::WGM, gsz = (nM - fm) < pg8::WGM ? (nM - fm) : pg8::WGM;
        u.pm = fm + ((wgid % nig) % gsz); const int pc = (wgid % nig) / gsz; u.pn = mode ? 5 + pc : (pc < 5 ? pc : pc + 3);
        u.a = A + (size_t)u.pm * tA; u.b = Bt + (size_t)u.pn * tB; u.bjump = 0; u.aux = 0; u.nvalid = 256; return true;
    }
    __device__ __forceinline__ void a_ready(const pg8::Unit&) const {}
    __device__ __forceinline__ void done(const pg8::Unit&) const {}
};

__device__ __forceinline__ float wave_sum(float v) {
#pragma unroll
    for (int o = 1; o < 64; o <<= 1) v += __shfl_xor(v, o);
    return v;
}
__device__ __forceinline__ void p0_transpose_item(const float* W, int K, int N, bf16* WT, int map, int row_off, int par, const float* gk, LAS float* scr, int item, int lane, unsigned char* WT8 = nullptr, float s8 = 32.f) {
    const int nblk = (N + 31) / 32, kb = item / nblk, nb = item % nblk, k0 = 64 * kb, n0 = 32 * nb;
    const int c4 = lane & 7, rr = lane >> 3; const bool okc = (n0 + 4 * c4) < N;
    f32x4 v[8];
#pragma unroll
    for (int i = 0; i < 8; ++i) { const int kk = i * 8 + rr; v[i] = okc ? __builtin_nontemporal_load((const f32x4*)(W + (size_t)(k0 + kk) * N + n0 + 4 * c4)) : (f32x4){0.f, 0.f, 0.f, 0.f}; }
#pragma unroll
    for (int i = 0; i < 8; ++i) { const int kk = i * 8 + rr; f32x4 x = v[i]; if (gk) x = x * gk[k0 + kk]; *(LAS f32x4*)(scr + kk * 36 + 4 * c4) = x; }
    LDS_WAIT(); asm volatile("" ::: "memory");
    const int c = lane & 7;
#pragma unroll
    for (int j = 0; j < 4; ++j) { const int nl = (lane >> 3) + 8 * j, n = n0 + nl; const LAS float* s = scr + (8 * c) * 36 + nl;
        v4u o; o.x = pk2(s[0 * 36], s[1 * 36]); o.y = pk2(s[2 * 36], s[3 * 36]); o.z = pk2(s[4 * 36], s[5 * 36]); o.w = pk2(s[6 * 36], s[7 * 36]);
        if (n < N) { const int row = (map == 0) ? row_off + n : (map == 1) ? (n < 1864 ? n : n + 184) : row_off + 2 * n + par;
            const bool idx_rows = (map == 1) && row >= 1280 && row < 2048;
            if (WT && (map != 1 || idx_rows)) *(GAS v4u*)(WT + (size_t)row * K + k0 + 8 * c) = o;
            if (WT8 && !idx_rows) { int w0 = __builtin_amdgcn_cvt_pk_fp8_f32(s[0 * 36] * s8, s[1 * 36] * s8, 0, false); w0 = __builtin_amdgcn_cvt_pk_fp8_f32(s[2 * 36] * s8, s[3 * 36] * s8, w0, true);
                int w1 = __builtin_amdgcn_cvt_pk_fp8_f32(s[4 * 36] * s8, s[5 * 36] * s8, 0, false); w1 = __builtin_amdgcn_cvt_pk_fp8_f32(s[6 * 36] * s8, s[7 * 36] * s8, w1, true);
                *(GAS unsigned long long*)(WT8 + (size_t)row * K + k0 + 8 * c) = (unsigned long long)(unsigned)w0 | ((unsigned long long)(unsigned)w1 << 32); } } }
    LDS_WAIT(); asm volatile("" ::: "memory");
}
__device__ __forceinline__ void p0_prologue(Frame& F, const Args& a) {
    LAS float* scr = (LAS float*)(F.lds + RING_OFF + F.wave * 16384);
    const int gw = F.vcu * NWAVES + F.wave, NGW = F.G * NWAVES;
    bf16* Win_t = (bf16*)(F.ws + WS_WIN); bf16* Wkv_t = (bf16*)(F.ws + WS_WKV);
    constexpr int I_IN = 16 * 219, I_KV = 4 * 8, I_SQ = 16 * 32, I_GU = 16 * 8  , I_DN = 4 * 32  ;
    constexpr int NITEMS = I_IN + I_KV + 3 * I_SQ + 16 * (2 * I_GU + I_DN);
    for (int it = gw; it < NITEMS; it += NGW) {
        int r = it;
        if (r < I_IN) { p0_transpose_item(a.in[2], 1024, INW, Win_t, 1, 0, 0, a.in[1], scr, r, F.lane, F.ws + WS_WIN8); continue; } r -= I_IN;
        if (r < I_KV) { p0_transpose_item(a.in[4], 256, 256, Wkv_t, 0, 0, 0, a.in[3], scr, r, F.lane); continue; } r -= I_KV;
        if (r < I_SQ) { p0_transpose_item(a.in[9], 1024, 1024, nullptr, 0, 0, 0, nullptr, scr, r, F.lane, F.ws + WS_WATT8, 32.f); continue; } r -= I_SQ;
        if (r < I_SQ) { p0_transpose_item(a.in[10], 1024, 1024, nullptr, 0, 0, 0, nullptr, scr, r, F.lane, F.ws + WS_WRET8, 32.f); continue; } r -= I_SQ;
        if (r < I_SQ) { p0_transpose_item(a.in[11], 1024, 1024, nullptr, 0, 0, 0, nullptr, scr, r, F.lane, F.ws + WS_WOUT8, 32.f); continue; } r -= I_SQ;
        const int e = r / (2 * I_GU + I_DN), q = r % (2 * I_GU + I_DN);
        if (q < I_GU) p0_transpose_item(a.in[17] + (size_t)e * 1024 * 256, 1024, 256, nullptr, 2, e * 512, 0, nullptr, scr, q, F.lane, F.ws + WS_W18, 32.f);
        else if (q < 2 * I_GU) p0_transpose_item(a.in[18] + (size_t)e * 1024 * 256, 1024, 256, nullptr, 2, e * 512, 1, nullptr, scr, q - I_GU, F.lane, F.ws + WS_W18, 32.f);
        else p0_transpose_item(a.in[19] + (size_t)e * 256 * 1024, 256, 1024, nullptr, 0, 0, 0, nullptr, scr, q - 2 * I_GU, F.lane, F.ws + WS_WD8 + (size_t)e * 1024 * 256, 16.f);
    }
    { const int gt = (F.vcu * NWAVES + F.wave) * 64 + F.lane, NGT = F.G * NWAVES * 64; GAS v4u* z = (GAS v4u*)(Win_t + (size_t)1864 * 1024);
      for (int i = gt; i < 184 * 1024 * 2 / 16; i += NGT) z[i] = (v4u){0u, 0u, 0u, 0u}; }
    { const int gt = (F.vcu * NWAVES + F.wave) * 64 + F.lane, NGT = F.G * NWAVES * 64; bf16* Wh = (bf16*)(F.ws + WS_WR); bf16* Wl = Wh + 32 * 1024;
      for (int i = gt; i < 32 * 1024; i += NGT) { const int n = i >> 10, k = i & 1023; const float wv = n < 4 ? a.in[13][k * 4 + n] : (n < 20 ? a.in[15][k * 16 + (n - 4)] : 0.f);
        const unsigned hb = f2bf(wv); const float hf = __uint_as_float(hb << 16); Wh[i] = (bf16)hb; Wl[i] = (bf16)f2bf(wv - hf); } }
    const float* x = a.in[0] + (size_t)a.tok0 * D; unsigned char* xb8 = a.xb + (size_t)F.ntok * AUX_XB8;
    for (int m = gw; m < F.ntok; m += 2 * NGW) {
        const int m2 = m + NGW; const bool two = m2 < F.ntok;
        const GAS f32x4* xr = (const GAS f32x4*)(x + (size_t)m * D) + F.lane; const GAS f32x4* xr2 = (const GAS f32x4*)(x + (size_t)(two ? m2 : m) * D) + F.lane;
        f32x4 v[4], u[4]; float s = 0.f, s2 = 0.f;
#pragma unroll
        for (int j = 0; j < 4; ++j) { v[j] = __builtin_nontemporal_load(xr + 64 * j); u[j] = __builtin_nontemporal_load(xr2 + 64 * j); }
#pragma unroll
        for (int j = 0; j < 4; ++j) { s += (v[j].x * v[j].x + v[j].y * v[j].y) + (v[j].z * v[j].z + v[j].w * v[j].w); s2 += (u[j].x * u[j].x + u[j].y * u[j].y) + (u[j].z * u[j].z + u[j].w * u[j].w); }
        const float rstd = 1.f / sqrtf(wave_sum(s) * (1.f / D) + EPS), rstd2 = 1.f / sqrtf(wave_sum(s2) * (1.f / D) + EPS);
        if (F.lane == 0) { RSTD1_PTR[m] = rstd; if (two) RSTD1_PTR[m2] = rstd2; }
        GAS unsigned long long* o8 = (GAS unsigned long long*)(a.xb + (size_t)m * D * 2) + F.lane; GAS unsigned* q8 = (GAS unsigned*)(xb8 + (size_t)m * D) + F.lane;
#pragma unroll
        for (int j = 0; j < 4; ++j) { __builtin_nontemporal_store((unsigned long long)pk2(v[j].x, v[j].y) | ((unsigned long long)pk2(v[j].z, v[j].w) << 32), o8 + 64 * j);
            int w8 = __builtin_amdgcn_cvt_pk_fp8_f32(v[j].x * rstd, v[j].y * rstd, 0, false); w8 = __builtin_amdgcn_cvt_pk_fp8_f32(v[j].z * rstd, v[j].w * rstd, w8, true); q8[64 * j] = (unsigned)w8; }
        if (two) { GAS unsigned long long* p8 = (GAS unsigned long long*)(a.xb + (size_t)m2 * D * 2) + F.lane; GAS unsigned* r8 = (GAS unsigned*)(xb8 + (size_t)m2 * D) + F.lane;
#pragma unroll
            for (int j = 0; j < 4; ++j) { __builtin_nontemporal_store((unsigned long long)pk2(u[j].x, u[j].y) | ((unsigned long long)pk2(u[j].z, u[j].w) << 32), p8 + 64 * j);
                int w8 = __builtin_amdgcn_cvt_pk_fp8_f32(u[j].x * rstd2, u[j].y * rstd2, 0, false); w8 = __builtin_amdgcn_cvt_pk_fp8_f32(u[j].z * rstd2, u[j].w * rstd2, w8, true); r8[64 * j] = (unsigned)w8; } }
    }
}


constexpr size_t AUX_KP = 0, AUX_VV = 256, AUX_KIN = 512, AUX_MASK = 640, AUX_END = 896;
typedef short bf16x8_t __attribute__((ext_vector_type(8)));
typedef float f32x16 __attribute__((ext_vector_type(16)));
__device__ __forceinline__ int crow(int r, int hi) { return (r & 3) + 8 * (r >> 2) + 4 * hi; }
__device__ __forceinline__ float xhalf_sum(float v) { auto rr = __builtin_amdgcn_permlane32_swap(__float_as_uint(v), __float_as_uint(v), false, false); return __uint_as_float(rr[0]) + __uint_as_float(rr[1]); }
__device__ __forceinline__ float sumsq8(bf16x8_t v) { float s = 0.f;
#pragma unroll
    for (int j = 0; j < 8; ++j) { const float f = __uint_as_float((unsigned)(unsigned short)v[j] << 16); s += f * f; } return s; }
__device__ __forceinline__ void p2_post(Frame& F, const Args& a) {
    const int gw = F.vcu * NWAVES + F.wave, NGW = F.G * NWAVES, lane = F.lane, r32 = lane & 31, hi = lane >> 5;
    const size_t nt_ = (size_t)F.ntok;
    const bf16* CKV = (const bf16*)(F.act + nt_ * O_CKV); const bf16* KW = (const bf16*)(F.act + nt_ * O_KW);
    const bf16* Wkv_t = (const bf16*)(F.ws + WS_WKV);
    unsigned char* aux = a.xb + nt_ * 2048;
    bf16* KP = (bf16*)(aux + nt_ * AUX_KP); bf16* VV = (bf16*)(aux + nt_ * AUX_VV); bf16* KIN = (bf16*)(aux + nt_ * AUX_KIN);
    const float* g_q = a.in[5]; const float* g_k = a.in[6]; const float* g_ki = a.in[7];
    constexpr int WP = 528;
    LAS unsigned char* Wl = F.lds + RING_OFF; LAS float* gl = (LAS float*)(F.lds + RING_OFF + 256 * WP);
    for (int i = F.tid; i < 256 * 32; i += NWAVES * 64) { const int n = i >> 5, ch = i & 31; *(LAS v4u*)(Wl + n * WP + ch * 16) = *(const v4u*)(Wkv_t + (size_t)n * 256 + ch * 8); }
    if (F.tid < 128) gl[F.tid] = g_k[F.tid] * g_q[F.tid] * (0.08838834764831845f * 1.4426950408889634f);
    else if (F.tid < 192) gl[F.tid] = g_ki[F.tid - 128];
    __syncthreads();
    const int ntask = 2 * (F.ntok / 32);
    for (int task = gw; task < ntask; task += NGW) {
        const int kind = task & 1, t0 = (task >> 1) * 32;
        const unsigned char* crowp = (const unsigned char*)CKV + (size_t)(t0 + r32) * 256 + hi * 8;
        bf16x8_t bfr[16]; float ss = 0.f;
        bf16x8_t kv4[4] = {};
        if (kind == 0) { const bf16* kr = KW + (size_t)(t0 + r32) * 128 + hi * 32;
#pragma unroll
            for (int j = 0; j < 4; ++j) kv4[j] = *(const bf16x8_t*)(kr + 8 * j); }
#pragma unroll
        for (int kk = 0; kk < 16; ++kk) { const unsigned long long c8 = *(const unsigned long long*)(crowp + kk * 16); const int lo = (int)(unsigned)c8, hi32 = (int)(unsigned)(c8 >> 32);
            const auto a_ = __builtin_amdgcn_cvt_pk_f32_fp8(lo, false), b_ = __builtin_amdgcn_cvt_pk_f32_fp8(lo, true), c_ = __builtin_amdgcn_cvt_pk_f32_fp8(hi32, false), d_ = __builtin_amdgcn_cvt_pk_f32_fp8(hi32, true);
            ss += (a_[0] * a_[0] + a_[1] * a_[1]) + (b_[0] * b_[0] + b_[1] * b_[1]) + (c_[0] * c_[0] + c_[1] * c_[1]) + (d_[0] * d_[0] + d_[1] * d_[1]);
            v4u pk; pk.x = pk2(a_[0], a_[1]); pk.y = pk2(b_[0], b_[1]); pk.z = pk2(c_[0], c_[1]); pk.w = pk2(d_[0], d_[1]); bfr[kk] = __builtin_bit_cast(bf16x8_t, pk); }
        ss = xhalf_sum(ss);
        const float rstd = rsqrtf(ss * (1.f / 256.f) + EPS);
        f32x16 acc[4];
#pragma unroll
        for (int nt = 0; nt < 4; ++nt) { acc[nt] = f32x16{};
            const LAS unsigned char* wrow = Wl + (kind * 128 + nt * 32 + r32) * WP + hi * 16;
#pragma unroll
            for (int kk = 0; kk < 16; ++kk) { const bf16x8_t af = *(const LAS bf16x8_t*)(wrow + kk * 32); acc[nt] = __builtin_amdgcn_mfma_f32_32x32x16_bf16(af, bfr[kk], acc[nt], 0, 0, 0); if ((kk & 3) == 3) __builtin_amdgcn_sched_barrier(0); } }
        float sc = rstd;
        if (kind == 0) { float sk = 0.f;
#pragma unroll
            for (int nt = 0; nt < 4; ++nt)
#pragma unroll
                for (int r = 0; r < 16; ++r) { const float v = acc[nt][r] * rstd; sk += v * v; }
            sk = xhalf_sum(sk);
            sc = rstd * rsqrtf(sk * (1.f / 128.f) + EPS); }
        bf16* orow = (kind == 0 ? KP : VV) + (size_t)(t0 + r32) * 128;
#pragma unroll
        for (int nt = 0; nt < 4; ++nt)
#pragma unroll
            for (int g = 0; g < 4; ++g) { const int ch = nt * 32 + 8 * g + 4 * hi; float v[4];
#pragma unroll
                for (int j = 0; j < 4; ++j) { v[j] = acc[nt][4 * g + j] * sc; if (kind == 0) v[j] *= gl[ch + j]; }
                if (kind == 0) { int w8 = __builtin_amdgcn_cvt_pk_fp8_f32(v[0] * 32.f, v[1] * 32.f, 0, false); w8 = __builtin_amdgcn_cvt_pk_fp8_f32(v[2] * 32.f, v[3] * 32.f, w8, true);
                    *(unsigned*)((unsigned char*)KP + (size_t)(t0 + r32) * 128 + (g & 1) * 64 + (nt * 2 + (g >> 1)) * 8 + 4 * hi) = (unsigned)w8; }
                else { unsigned char* vt = (unsigned char*)VV + ((size_t)(t0 >> 6) * 128 + ch) * 64 + ((r32 >> 2) & 1) * 32 + ((t0 >> 5) & 1) * 16 + (r32 & 3) + 4 * (r32 >> 3);
#pragma unroll
                    for (int j = 0; j < 4; ++j) vt[j * 64] = (unsigned char)__builtin_amdgcn_cvt_pk_fp8_f32(v[j] * 8.f, 0.f, 0, false); } }
        if (kind == 0) {
            float s2 = 0.f;
#pragma unroll
            for (int j = 0; j < 4; ++j) s2 += sumsq8(kv4[j]);
            s2 = xhalf_sum(s2);
            const float rk = rsqrtf(s2 * (1.f / 64.f) + EPS);
            bf16* ko = KIN + (size_t)(t0 + r32) * 64 + hi * 32;
#pragma unroll
            for (int j = 0; j < 4; ++j) { float f[8];
#pragma unroll
                for (int e = 0; e < 8; ++e) f[e] = __uint_as_float((unsigned)(unsigned short)kv4[j][e] << 16) * rk * gl[128 + hi * 32 + 8 * j + e];
                v4u o; o.x = pk2(f[0], f[1]); o.y = pk2(f[2], f[3]); o.z = pk2(f[4], f[5]); o.w = pk2(f[6], f[7]);
                *(v4u*)(ko + 8 * j) = o; }
        }
    }
    __syncthreads();
}

typedef float f32x4_t __attribute__((ext_vector_type(4)));
__device__ __forceinline__ unsigned key15_of(float s) { const unsigned short hb = __builtin_bit_cast(unsigned short, (_Float16)s); const unsigned u = (hb & 0x8000u) ? (~(unsigned)hb & 0xffffu) : ((unsigned)hb | 0x8000u); return u >> 1; }
__device__ __forceinline__ unsigned sad4(unsigned x) { return __builtin_amdgcn_sad_u8(x, 0u, 0u); }
__device__ __forceinline__ void p3_merge(LAS unsigned* hist, LAS unsigned short* tot, int w, int g, int q, int& need, int& bsel) {
    __syncthreads();
    const int o = 4 * w + g; unsigned c = 0;
#pragma unroll
    for (int p = 0; p < 32; ++p) { const int tidp = (p >> 2) * 64 + (p & 3) * 16 + q; c += (hist[(o >> 2) * 512 + tidp] >> (8 * (o & 3))) & 0xffu; }
    tot[q * 32 + o] = (unsigned short)c;
    __syncthreads();
    v4u tv[4];
#pragma unroll
    for (int j = 0; j < 4; ++j) tv[j] = *(const LAS v4u*)((const LAS unsigned char*)tot + q * 64 + j * 16);
    int cum = 0, bs = 0, ab = 0; bool found = false;
#pragma unroll
    for (int bin = 31; bin >= 0; --bin) { const unsigned wd = tv[bin >> 3][(bin >> 1) & 3]; const int cc = (int)((bin & 1) ? (wd >> 16) : (wd & 0xffffu));
        if (!found && cum + cc >= need) { bs = bin; ab = cum; found = true; } cum += cc; }
    bsel = bs; need -= ab;
}
__device__ __forceinline__ void p3_index(Frame& F, const Args& a) {
    const int tid = F.tid, lane = F.lane, w = F.wave, q = lane & 15, g = lane >> 4;
    LAS unsigned* keys = (LAS unsigned*)(F.lds + RING_OFF);
    LAS unsigned char* qbuf = F.lds + 65536;
    LAS unsigned* hist = (LAS unsigned*)(F.lds + P3_HIST_OFF);
    LAS unsigned short* tot = (LAS unsigned short*)(F.lds + P3_TOT_OFF);
    LAS unsigned char* Tt = (LAS unsigned char*)(F.lds + P3_T_OFF);
    const size_t nt_ = (size_t)F.ntok;
    const bf16* QI = (const bf16*)(F.act + nt_ * O_QI); const bf16* KW = (const bf16*)(F.act + nt_ * O_KW);
    unsigned char* aux = a.xb + nt_ * 2048;
    const bf16* KIN = (const bf16*)(aux + nt_ * AUX_KIN); unsigned* MASK = (unsigned*)(aux + nt_ * AUX_MASK);
    const int nb = F.ntok / SEQ, nitems = nb * 128; const int bxj = (int)blockIdx.x >> 3;
    const int G = F.G - F.G / 4, c = (bxj - (bxj >> 2) - 1) * 8 + ((int)blockIdx.x & 7);
#define P3_ITEM(k) ((k) * G + (((k) & 1) ? (G - 1 - c) : c))
#define P3_QDMA(it_, buf_) do { const int qg_ = 127 - (it_) / nb, b_ = (it_) % nb; _Pragma("unroll") for (int i_ = 0; i_ < 2; ++i_) { const int row_ = w * 2 + i_; \
        const char* src_ = (const char*)(QI + ((size_t)b_ * SEQ + qg_ * 16 + row_) * 512) + ((lane ^ (row_ & 15)) * 16); \
        __builtin_amdgcn_global_load_lds((const unsigned*)src_, (LAS unsigned*)(qbuf + (buf_) * 16384 + row_ * 1024), 16, 0, 0); } } while (0)
    const int nround = (nitems + G - 1) / G;
    if (P3_ITEM(0) < nitems) P3_QDMA(P3_ITEM(0), 0);
    v4u wvn = (v4u){0u, 0u, 0u, 0u};
    if (P3_ITEM(0) < nitems) { const int it0 = P3_ITEM(0); wvn = *(const v4u*)(KW + ((size_t)(it0 % nb) * SEQ + (127 - it0 / nb) * 16 + q) * 128 + 64); }
    for (int k = 0; k < nround; ++k) {
        const int it = P3_ITEM(k); if (it >= nitems) break;
        const int qg = 127 - it / nb, b = it % nb, q0 = qg * 16, qme = q0 + q;
        unsigned* Mb = MASK + (size_t)b * 64 * 2048;
        const int kb_hi = ((qg >> 3) + 1) << 2, nkb = (qg >> 1) + 1;
        asm volatile("s_waitcnt vmcnt(0) lgkmcnt(0)\n\ts_barrier" ::: "memory");
        const v4u wv = wvn;
        { const int itn = P3_ITEM(k + 1); if (k + 1 < nround && itn < nitems) { P3_QDMA(itn, (k + 1) & 1); wvn = *(const v4u*)(KW + ((size_t)(itn % nb) * SEQ + (127 - itn / nb) * 16 + q) * 128 + 64); } }
        if (qg < 16) {
            if (tid < kb_hi * 16) { const int kb = tid >> 4, qq = q0 + (tid & 15), nbits = qq - kb * 32 + 1; Mb[kb * 2048 + qq] = nbits >= 32 ? 0xffffffffu : (nbits <= 0 ? 0u : ((1u << nbits) - 1u)); }
            continue;
        }
        float wq[8];
        { const float cc = 0.35355339059327373f * 0.125f;
          wq[0] = pg8::bf_lo(wv.x) * cc; wq[1] = pg8::bf_hi(wv.x) * cc; wq[2] = pg8::bf_lo(wv.y) * cc; wq[3] = pg8::bf_hi(wv.y) * cc; wq[4] = pg8::bf_lo(wv.z) * cc; wq[5] = pg8::bf_hi(wv.z) * cc; wq[6] = pg8::bf_lo(wv.w) * cc; wq[7] = pg8::bf_hi(wv.w) * cc; }
        bf16x8_t qfr[8][2], qlin[2];
        { const LAS unsigned char* qrow = qbuf + (k & 1) * 16384 + q * 1024;
#pragma unroll
          for (int h = 0; h < 8; ++h)
#pragma unroll
            for (int ks = 0; ks < 2; ++ks) qfr[h][ks] = *(const LAS bf16x8_t*)(qrow + (((h * 8 + ks * 4 + g) ^ q) * 16)); }
#pragma unroll
        for (int ks = 0; ks < 2; ++ks) { float f[8];
#pragma unroll
            for (int j = 0; j < 8; ++j) { float s = 0.f;
#pragma unroll
                for (int h = 0; h < 8; ++h) s += wq[h] * __uint_as_float((unsigned)(unsigned short)qfr[h][ks][j] << 16);
                f[j] = s; }
            v4u o; o.x = pk2(f[0], f[1]); o.y = pk2(f[2], f[3]); o.z = pk2(f[4], f[5]); o.w = pk2(f[6], f[7]); qlin[ks] = __builtin_bit_cast(bf16x8_t, o); }
#pragma unroll
        for (int i = 0; i < 8; ++i) hist[i * 512 + tid] = 0u;
        const bf16* kbase = KIN + ((size_t)b * SEQ + q) * 64 + g * 8;
        bf16x8_t afr[2][2], afn[2][2];
#pragma unroll
        for (int t = 0; t < 2; ++t)
#pragma unroll
            for (int ks = 0; ks < 2; ++ks) afn[t][ks] = *(const bf16x8_t*)(kbase + (size_t)(w * 32 + t * 16) * 64 + ks * 32);
        for (int s = 0, kb = w; kb < nkb; ++s, kb += 8) {
            const bool diag = (kb == nkb - 1);
#pragma unroll
            for (int t = 0; t < 2; ++t)
#pragma unroll
                for (int ks = 0; ks < 2; ++ks) afr[t][ks] = afn[t][ks];
            if (kb + 8 < nkb) {
#pragma unroll
                for (int t = 0; t < 2; ++t)
#pragma unroll
                    for (int ks = 0; ks < 2; ++ks) afn[t][ks] = *(const bf16x8_t*)(kbase + (size_t)((kb + 8) * 32 + t * 16) * 64 + ks * 32); }
#pragma unroll
            for (int t = 0; t < 2; ++t) {
                f32x4_t sacc = f32x4_t{};
#pragma unroll
                for (int ks = 0; ks < 2; ++ks) sacc = __builtin_amdgcn_mfma_f32_16x16x32_bf16(afr[t][ks], qlin[ks], sacc, 0, 0, 0);
#pragma unroll
                for (int h = 0; h < 8; ++h) { f32x4_t d = f32x4_t{};
#pragma unroll
                    for (int ks = 0; ks < 2; ++ks) d = __builtin_amdgcn_mfma_f32_16x16x32_bf16(afr[t][ks], qfr[h][ks], d, 0, 0, 0);
#pragma unroll
                    for (int r = 0; r < 4; ++r) { float s_ = fmaf(fabsf(d[r]), wq[h], sacc[r]); asm("" : "+v"(s_)); sacc[r] = s_; } }
#pragma unroll
                for (int i = 0; i < 2; ++i) { unsigned k2[2];
#pragma unroll
                    for (int e = 0; e < 2; ++e) { const int r = 2 * i + e; unsigned kk_ = key15_of(sacc[r]); if (diag && kb * 32 + t * 16 + 4 * g + r > qme) kk_ = 0u; k2[e] = kk_;
                        const unsigned dg = kk_ >> 10; (void)__hip_atomic_fetch_add((LAS unsigned*)&hist[(dg >> 2) * 512 + tid], 1u << ((dg & 3u) * 8u), __ATOMIC_RELAXED, __HIP_MEMORY_SCOPE_WORKGROUP); }
                    keys[(s * 4 + t * 2 + i) * 512 + tid] = k2[0] | (k2[1] << 16); }
            }
        }
        int need = 256, bsel;
        p3_merge(hist, tot, w, g, q, need, bsel);
        unsigned prefix = (unsigned)bsel;
#pragma unroll
        for (int pass = 0; pass < 2; ++pass) {
            const int sh_hi = pass == 0 ? 10 : 5, sh = pass == 0 ? 5 : 0;
#pragma unroll
            for (int i = 0; i < 8; ++i) hist[i * 512 + tid] = 0u;
#pragma unroll
            for (int s = 0; s < 8; ++s) if (w + 8 * s < nkb) {
#pragma unroll
                for (int i = 0; i < 4; ++i) { const unsigned d2 = keys[(s * 4 + i) * 512 + tid];
#pragma unroll
                    for (int e = 0; e < 2; ++e) { const unsigned kk_ = e ? (d2 >> 16) : (d2 & 0xffffu);
                        if ((kk_ >> sh_hi) == prefix) { const unsigned dg = (kk_ >> sh) & 31u; (void)__hip_atomic_fetch_add((LAS unsigned*)&hist[(dg >> 2) * 512 + tid], 1u << ((dg & 3u) * 8u), __ATOMIC_RELAXED, __HIP_MEMORY_SCOPE_WORKGROUP); } } } }
            p3_merge(hist, tot, w, g, q, need, bsel);
            prefix = (prefix << 5) | (unsigned)bsel;
        }
        const unsigned tau = prefix; const int need_eq = need;
        unsigned gtw[8], eqw[8];
#pragma unroll
        for (int s = 0; s < 8; ++s) { const int kb = w + 8 * s; gtw[s] = 0u; eqw[s] = 0u;
            if (kb < nkb) { unsigned gg = 0u, qq = 0u;
#pragma unroll
                for (int i = 0; i < 4; ++i) { const unsigned d2 = keys[(s * 4 + i) * 512 + tid];
#pragma unroll
                    for (int e = 0; e < 2; ++e) { const unsigned kk_ = e ? (d2 >> 16) : (d2 & 0xffffu); const int bit = (i >> 1) * 16 + 4 * g + (i & 1) * 2 + e;
                        gg |= (kk_ > tau ? 1u : 0u) << bit; qq |= (kk_ == tau ? 1u : 0u) << bit; } }
                gg |= (unsigned)__shfl_xor((int)gg, 16); gg |= (unsigned)__shfl_xor((int)gg, 32); qq |= (unsigned)__shfl_xor((int)qq, 16); qq |= (unsigned)__shfl_xor((int)qq, 32);
                gtw[s] = gg; eqw[s] = qq;
                if (g == 0) Tt[q * 64 + kb] = (unsigned char)__builtin_popcount(qq); } }
        __syncthreads();
        { unsigned run = 0u;
#pragma unroll
          for (int s = 0; s < 8; ++s) { const int kb = w + 8 * s;
            if (kb < nkb) { const unsigned g0 = *(const LAS unsigned*)(Tt + q * 64 + 8 * s), g1 = *(const LAS unsigned*)(Tt + q * 64 + 8 * s + 4);
                const unsigned m0 = w >= 4 ? g0 : (w == 0 ? 0u : (g0 & ((1u << (8 * w)) - 1u))), m1 = w > 4 ? (g1 & ((1u << (8 * (w - 4))) - 1u)) : 0u;
                const int pre = (int)(run + sad4(m0) + sad4(m1)), m = need_eq - pre, pc = __builtin_popcount(eqw[s]);
                unsigned se = eqw[s];
                if (m < pc) { se = 0u; unsigned x = eqw[s]; for (int i = 0; i < m; ++i) { const unsigned bb = x & (0u - x); se |= bb; x ^= bb; } }
                if (g == 0) Mb[kb * 2048 + qme] = gtw[s] | se;
                run += sad4(g0) + sad4(g1); } } }
        if (tid < (kb_hi - nkb) * 16) Mb[(nkb + (tid >> 4)) * 2048 + q0 + (tid & 15)] = 0u;
    }
    asm volatile("s_waitcnt vmcnt(0) lgkmcnt(0)" ::: "memory");
    __syncthreads();
#undef P3_ITEM
#undef P3_QDMA
}

namespace att {
using bf16x8 = __attribute__((ext_vector_type(8))) short;
using s16x4  = __attribute__((ext_vector_type(4))) short;
using u32x4  = __attribute__((ext_vector_type(4))) unsigned;
using v4i = __attribute__((ext_vector_type(4))) int; using v8i = __attribute__((ext_vector_type(8))) int;
constexpr int KVBLK = 64;
constexpr size_t SHM_V = KVBLK * 128 * 2, SHM_K = KVBLK * 128 * 2;
constexpr int OFF_WS = 65536, OFF_MK = 65536 + 2048, OFF_Q = 65536 + 2048 + 16384, QPITCH = 272;
constexpr float THR2 = 8.f;
#define KSWZ(row, colB) ((row) * 256 + ((colB) ^ (((row) & 7) << 4)))
#define SBAR() __builtin_amdgcn_sched_barrier(0)
__device__ __forceinline__ unsigned cvtpk(float lo, float hi) { unsigned r; asm volatile("v_cvt_pk_bf16_f32 %0, %1, %2" : "=v"(r) : "v"(lo), "v"(hi)); return r; }
__device__ __forceinline__ float msk(float p, unsigned w, int bit) { const int m = __builtin_amdgcn_sbfe((int)w, bit, 1); return __uint_as_float((__float_as_uint(p) & (unsigned)m) | (0xff800000u & ~(unsigned)m)); }
__device__ __forceinline__ void partialSM(f32x16& p0, f32x16& p1, unsigned w0, unsigned w1, float& m_reg, float& mn, float& alpha) {
#pragma unroll
  for (int r = 0; r < 16; ++r) { const int bit = (r & 3) + 8 * (r >> 2); p0[r] = msk(p0[r], w0, bit); p1[r] = msk(p1[r], w1, bit); }
  float pmax = p0[0];
#pragma unroll
  for (int r = 1; r < 16; ++r) pmax = fmaxf(pmax, p0[r]);
#pragma unroll
  for (int r = 0; r < 16; ++r) pmax = fmaxf(pmax, p1[r]);
  { auto rr = __builtin_amdgcn_permlane32_swap(__float_as_uint(pmax), __float_as_uint(pmax), false, false); pmax = fmaxf(__uint_as_float(rr[0]), __uint_as_float(rr[1])); }
  if (__builtin_expect(__all(pmax - m_reg <= THR2), 1)) { mn = m_reg; alpha = 1.f; }
  else { mn = fmaxf(m_reg, pmax); alpha = __builtin_amdgcn_exp2f(m_reg - mn); m_reg = mn; }
#pragma unroll
  for (int r = 0; r < 16; ++r) { p0[r] -= mn; p1[r] -= mn; }
#pragma unroll
  for (int r = 0; r < 16; ++r) p0[r] = __builtin_amdgcn_exp2f(p0[r]);
}
__device__ __forceinline__ void finishSM(f32x16& p0, f32x16& p1, float alpha, float& l_reg, bf16x8& pa0, bf16x8& pa1, bf16x8& pa2, bf16x8& pa3) {
#pragma unroll
  for (int r = 0; r < 16; ++r) p1[r] = __builtin_amdgcn_exp2f(p1[r]);
  float ps = 0;
#pragma unroll
  for (int r = 0; r < 16; ++r) ps += p0[r];
#pragma unroll
  for (int r = 0; r < 16; ++r) ps += p1[r];
  { auto rr = __builtin_amdgcn_permlane32_swap(__float_as_uint(ps), __float_as_uint(ps), false, false); ps = __uint_as_float(rr[0]) + __uint_as_float(rr[1]); }
  l_reg = l_reg * alpha + ps;
#define PK4(P, BASE, OUT) do { unsigned a0 = cvtpk(P[BASE + 0], P[BASE + 1]), a1 = cvtpk(P[BASE + 2], P[BASE + 3]);   \
    unsigned b0 = cvtpk(P[BASE + 4], P[BASE + 5]), b1 = cvtpk(P[BASE + 6], P[BASE + 7]);                              \
    auto r0 = __builtin_amdgcn_permlane32_swap(a0, b0, false, false); auto r1 = __builtin_amdgcn_permlane32_swap(a1, b1, false, false); \
    u32x4 w = {r0[0], r1[0], r0[1], r1[1]}; OUT = *reinterpret_cast<bf16x8*>(&w); } while (0)
  PK4(p0, 0, pa0); PK4(p0, 8, pa1); PK4(p1, 0, pa2); PK4(p1, 8, pa3);
#undef PK4
}
__device__ __forceinline__ void qkt(f32x16& p0, f32x16& p1, const char* Ks, const char* qrow, const float (&bo)[16], float kb0, float kb1, int r32, int hi) {
#pragma unroll
  for (int r = 0; r < 16; ++r) { p0[r] = bo[r] + kb0; p1[r] = bo[r] + kb1; }
#pragma unroll
  for (int d0 = 0; d0 < 8; ++d0) { const int cb = (d0 * 16 + hi * 8) * 2;
    const bf16x8 b0 = *reinterpret_cast<const bf16x8*>(Ks + KSWZ(r32, cb));
    const bf16x8 b1 = *reinterpret_cast<const bf16x8*>(Ks + KSWZ(32 + r32, cb));
    const bf16x8 qf = *reinterpret_cast<const bf16x8*>(qrow + d0 * 32);
    p0 = __builtin_amdgcn_mfma_f32_32x32x16_bf16(b0, qf, p0, 0, 0, 0);
    p1 = __builtin_amdgcn_mfma_f32_32x32x16_bf16(b1, qf, p1, 0, 0, 0); }
}
__device__ __forceinline__ int v_st(int k, int c) { const int kk = (k & ~0xC) | ((k & 4) << 1) | ((k & 8) >> 1); return ((kk >> 3) * 4 + (c >> 5)) * 512 + ((kk & 7) * 32 + (c & 31)) * 2; }
__device__ __forceinline__ int v_rd_base(int lane) { return ((lane & 3) << 3) | (((lane >> 2) & 3) << 6) | (((lane >> 4) & 1) << 5) | (((lane >> 5) & 1) << 8); }
constexpr int v_rd_off(int d0, int ks, int half) { return d0 * 512 + ks * 4096 + half * 2048; }
template <int OFF> __device__ __forceinline__ s16x4 tr_read(int vb) { s16x4 r; asm volatile("ds_read_b64_tr_b16 %0, %1 offset:%2" : "=&v"(r) : "v"(vb), "i"(OFF) : "memory"); return r; }
template <int D0> __device__ __forceinline__ void pv_one(f32x16& od, int vb, bf16x8 pa0, bf16x8 pa1, bf16x8 pa2, bf16x8 pa3) {
  const s16x4 l0 = tr_read<v_rd_off(D0, 0, 0)>(vb), h0 = tr_read<v_rd_off(D0, 0, 1)>(vb), l1 = tr_read<v_rd_off(D0, 1, 0)>(vb), h1 = tr_read<v_rd_off(D0, 1, 1)>(vb);
  const s16x4 l2 = tr_read<v_rd_off(D0, 2, 0)>(vb), h2 = tr_read<v_rd_off(D0, 2, 1)>(vb), l3 = tr_read<v_rd_off(D0, 3, 0)>(vb), h3 = tr_read<v_rd_off(D0, 3, 1)>(vb);
  asm volatile("s_waitcnt lgkmcnt(0)" ::: "memory"); SBAR();
#define PK(L, H) (bf16x8){L[0], L[1], L[2], L[3], H[0], H[1], H[2], H[3]}
  od = __builtin_amdgcn_mfma_f32_32x32x16_bf16(pa0, PK(l0, h0), od, 0, 0, 0);
  od = __builtin_amdgcn_mfma_f32_32x32x16_bf16(pa1, PK(l1, h1), od, 0, 0, 0);
  od = __builtin_amdgcn_mfma_f32_32x32x16_bf16(pa2, PK(l2, h2), od, 0, 0, 0);
  od = __builtin_amdgcn_mfma_f32_32x32x16_bf16(pa3, PK(l3, h3), od, 0, 0, 0);
#undef PK
}
__device__ __forceinline__ void pv_d0(f32x16* o, int vb, bf16x8 pa0, bf16x8 pa1, bf16x8 pa2, bf16x8 pa3) {
  pv_one<0>(o[0], vb, pa0, pa1, pa2, pa3); pv_one<1>(o[1], vb, pa0, pa1, pa2, pa3); pv_one<2>(o[2], vb, pa0, pa1, pa2, pa3); pv_one<3>(o[3], vb, pa0, pa1, pa2, pa3);
}
__device__ __forceinline__ void attn_item(const bf16* __restrict__ Qb, const bf16* __restrict__ Kh, const bf16* __restrict__ Vh, const unsigned* __restrict__ Mq, bf16* __restrict__ Ob, int NT, char* lds, LAS unsigned char* ldsL, float SM, int hbase) {
  const int tid = threadIdx.x, wid = __builtin_amdgcn_readfirstlane(tid >> 6), lane = tid & 63, r32 = lane & 31, hi = lane >> 5;
  const int head = hbase + (wid & 3), qh = wid >> 2;
  float* ws = (float*)(lds + OFF_WS) + wid * 64; float* li_l = ws; float* al_l = ws + 32;
  unsigned* mk = (unsigned*)(lds + OFF_MK);
  unsigned soff[4];
#pragma unroll
  for (int i = 0; i < 4; ++i) { const int pc = (wid & 3) * 4 + i;
    if (wid < 4) { const int pk_ = (wid & 3) * 2 + (i & 1), row = pk_ * 8 + (lane >> 3), ch = lane & 7; soff[i] = (unsigned)(row * 128 + ((ch ^ ((row >> 1) & 7)) << 4)); }
    else { const int pv_ = (wid & 3) * 2 + (i & 1), row = pv_ * 16 + (lane >> 2), ch = lane & 3; (void)pc; soff[i] = (unsigned)(row * 64 + ((ch ^ ((row >> 2) & 3)) << 4)); } }
  const char* gsrc = (const char*)(wid < 4 ? Kh : Vh);
  const unsigned ldst = (unsigned)((wid < 4 ? 0 : 8192) + (wid & 3) * 2048);
  constexpr int npc = 2; constexpr size_t tstride = 8192;
#define DMA_TILE(t, slot) do { _Pragma("unroll") for (int i_ = 0; i_ < 4; ++i_) if (i_ < npc) \
    __builtin_amdgcn_global_load_lds((const unsigned*)(gsrc + (size_t)(t) * tstride + soff[i_]), (LAS unsigned*)(ldsL + (slot) * 16384 + ldst + i_ * 1024), 16, 0, 0); } while (0)
  DMA_TILE(NT - 1, 0);
  float m_reg = 0.f, l_reg = 0; bool inited = false; f32x16 o[4] = {}; v8i qv[2];
  { const unsigned char* Qw = (const unsigned char*)Qb + (size_t)(qh * 32 + r32) * 1024 + head * 128 + hi * 8; float ss = 0.f; unsigned long long q8[8];
#pragma unroll
    for (int d0 = 0; d0 < 8; ++d0) q8[d0] = *reinterpret_cast<const unsigned long long*>(Qw + d0 * 16);
    unsigned mv[8];
#pragma unroll
    for (int i = 0; i < 8; ++i) { const int idx = tid + 512 * i; mv[i] = idx < NT * 128 ? Mq[(size_t)(idx >> 6) * 2048 + (idx & 63)] : 0u; }
#pragma unroll
    for (int i = 0; i < 8; ++i) { const int idx = tid + 512 * i; if (idx < NT * 128) mk[idx] = mv[i]; }
    float qf[8][8];
#pragma unroll
    for (int d0 = 0; d0 < 8; ++d0) { const int lo = (int)(unsigned)q8[d0], hi32 = (int)(unsigned)(q8[d0] >> 32);
      const auto a_ = __builtin_amdgcn_cvt_pk_f32_fp8(lo, false), b_ = __builtin_amdgcn_cvt_pk_f32_fp8(lo, true), c_ = __builtin_amdgcn_cvt_pk_f32_fp8(hi32, false), d_ = __builtin_amdgcn_cvt_pk_f32_fp8(hi32, true);
      qf[d0][0] = a_[0]; qf[d0][1] = a_[1]; qf[d0][2] = b_[0]; qf[d0][3] = b_[1]; qf[d0][4] = c_[0]; qf[d0][5] = c_[1]; qf[d0][6] = d_[0]; qf[d0][7] = d_[1];
#pragma unroll
      for (int j = 0; j < 8; ++j) ss += qf[d0][j] * qf[d0][j]; }
    ss = xhalf_sum(ss); const float rq = rsqrtf(ss * (1.f / 128.f) + EPS);
#pragma unroll
    for (int d0 = 0; d0 < 8; ++d0) { const float r16 = rq * 16.f;
      int w0 = __builtin_amdgcn_cvt_pk_fp8_f32(qf[d0][0] * r16, qf[d0][1] * r16, 0, false); w0 = __builtin_amdgcn_cvt_pk_fp8_f32(qf[d0][2] * r16, qf[d0][3] * r16, w0, true);
      int w1 = __builtin_amdgcn_cvt_pk_fp8_f32(qf[d0][4] * r16, qf[d0][5] * r16, 0, false); w1 = __builtin_amdgcn_cvt_pk_fp8_f32(qf[d0][6] * r16, qf[d0][7] * r16, w1, true);
      qv[d0 >> 2][(d0 & 3) * 2] = w0; qv[d0 >> 2][(d0 & 3) * 2 + 1] = w1; } }
  const float slope2 = __builtin_amdgcn_exp2f(-(float)(head + 1)) * 1.4426950408889634f;
  float bo[16];
#pragma unroll
  for (int r = 0; r < 16; ++r) bo[r] = __uint_as_float(__builtin_amdgcn_readfirstlane(__float_as_uint(slope2 * (float)((r & 3) + 8 * (r >> 2)))));
  const float hoff = slope2 * (float)(4 * hi);
  asm volatile("s_waitcnt vmcnt(0) lgkmcnt(0)\n\ts_barrier" ::: "memory");
  if (1 < NT) DMA_TILE(NT - 2, 1);
  if (2 < NT) DMA_TILE(NT - 3, 2);
  bool act = true;
  for (int i = 0; i < NT; ++i) {
    const int j = NT - 1 - i, sl = i & 3;
    if (i + 3 < NT) DMA_TILE(NT - 4 - i, (i + 3) & 3);
    if (act) {
    const char* Ks = lds + sl * 16384;
    const unsigned w0 = mk[(2 * j) * 64 + qh * 32 + r32] >> (4 * hi), w1 = mk[(2 * j + 1) * 64 + qh * 32 + r32] >> (4 * hi);
    f32x16 p0, p1;
    { const float kb0 = slope2 * (float)(j * 64) + hoff - m_reg, kb1 = kb0 + slope2 * 32.f;
#pragma unroll
      for (int r = 0; r < 16; ++r) { p0[r] = bo[r] + kb0; p1[r] = bo[r] + kb1; }
#define KFRAG(row_, j_) __builtin_shufflevector(*reinterpret_cast<const v4i*>(Ks + (row_) * 128 + (((hi * 4 + (j_) * 2) ^ (((row_) >> 1) & 7)) << 4)), *reinterpret_cast<const v4i*>(Ks + (row_) * 128 + (((hi * 4 + (j_) * 2 + 1) ^ (((row_) >> 1) & 7)) << 4)), 0, 1, 2, 3, 4, 5, 6, 7)
      const v8i ka0 = KFRAG(r32, 0), kb0_ = KFRAG(32 + r32, 0), ka1 = KFRAG(r32, 1), kb1_ = KFRAG(32 + r32, 1);
#undef KFRAG
      p0 = __builtin_amdgcn_mfma_scale_f32_32x32x64_f8f6f4(ka0, qv[0], p0, 0, 0, 0, 122, 0, 123);
      p1 = __builtin_amdgcn_mfma_scale_f32_32x32x64_f8f6f4(kb0_, qv[0], p1, 0, 0, 0, 122, 0, 123);
      p0 = __builtin_amdgcn_mfma_scale_f32_32x32x64_f8f6f4(ka1, qv[1], p0, 0, 0, 0, 122, 0, 123);
      p1 = __builtin_amdgcn_mfma_scale_f32_32x32x64_f8f6f4(kb1_, qv[1], p1, 0, 0, 0, 122, 0, 123); }
    float alpha; v8i pf; float pmax;
    {
#pragma unroll
      for (int r = 0; r < 16; ++r) { const int bit = (r & 3) + 8 * (r >> 2); p0[r] = msk(p0[r], w0, bit); p1[r] = msk(p1[r], w1, bit); }
      pmax = fmaxf(p0[0], p1[0]);
#pragma unroll
      for (int r = 1; r < 16; ++r) pmax = fmaxf(fmaxf(pmax, p0[r]), p1[r]);
      { auto rr = __builtin_amdgcn_permlane32_swap(__float_as_uint(pmax), __float_as_uint(pmax), false, false); pmax = fmaxf(__uint_as_float(rr[0]), __uint_as_float(rr[1])); }
    }
    if (!__all(inited ? pmax <= -12.f : !(pmax > -3.0e38f))) {
    {
      alpha = 1.f;
      const bool fin = pmax > -3.0e38f;
      if (__builtin_expect(!__all(pmax <= THR2 && (inited || !fin)), 0)) {
        const float dl = inited ? fmaxf(pmax, 0.f) : (fin ? pmax : 0.f);
        alpha = inited ? __builtin_amdgcn_exp2f(-dl) : 1.f; m_reg += dl; inited = inited || fin;
#pragma unroll
        for (int r = 0; r < 16; ++r) { p0[r] -= dl; p1[r] -= dl; } }
#pragma unroll
      for (int r = 0; r < 16; ++r) { p0[r] = __builtin_amdgcn_exp2f(p0[r]); p1[r] = __builtin_amdgcn_exp2f(p1[r]); }
      float ps = 0.f;
#pragma unroll
      for (int d = 0; d < 4; ++d) { int wa = __builtin_amdgcn_cvt_pk_fp8_f32(p0[4 * d], p0[4 * d + 1], 0, false); wa = __builtin_amdgcn_cvt_pk_fp8_f32(p0[4 * d + 2], p0[4 * d + 3], wa, true);
        int wb = __builtin_amdgcn_cvt_pk_fp8_f32(p1[4 * d], p1[4 * d + 1], 0, false); wb = __builtin_amdgcn_cvt_pk_fp8_f32(p1[4 * d + 2], p1[4 * d + 3], wb, true);
        pf[d] = wa; pf[4 + d] = wb;
        const auto a0 = __builtin_amdgcn_cvt_pk_f32_fp8(wa, false), a1 = __builtin_amdgcn_cvt_pk_f32_fp8(wa, true), b0 = __builtin_amdgcn_cvt_pk_f32_fp8(wb, false), b1 = __builtin_amdgcn_cvt_pk_f32_fp8(wb, true);
        ps += (a0[0] + a0[1]) + (a1[0] + a1[1]) + (b0[0] + b0[1]) + (b1[0] + b1[1]); }
      { auto rr = __builtin_amdgcn_permlane32_swap(__float_as_uint(ps), __float_as_uint(ps), false, false); ps = __uint_as_float(rr[0]) + __uint_as_float(rr[1]); }
      l_reg = l_reg * alpha + ps;
      if (__any(alpha < 1.f)) { if (hi == 0) al_l[r32] = alpha; asm volatile("s_waitcnt lgkmcnt(0)" ::: "memory");
#pragma unroll
        for (int d = 0; d < 4; ++d)
#pragma unroll
          for (int r = 0; r < 16; ++r) o[d][r] *= al_l[crow(r, hi)]; }
    }
    { const char* Vs = lds + sl * 16384 + 8192;
#define VFRAG(D_) __builtin_shufflevector(*reinterpret_cast<const v4i*>(Vs + ((D_) * 32 + r32) * 64 + (((hi * 2) ^ ((((D_) * 32 + r32) >> 2) & 3)) << 4)), *reinterpret_cast<const v4i*>(Vs + ((D_) * 32 + r32) * 64 + (((hi * 2 + 1) ^ ((((D_) * 32 + r32) >> 2) & 3)) << 4)), 0, 1, 2, 3, 4, 5, 6, 7)
      const v8i v0 = VFRAG(0), v1 = VFRAG(1), v2 = VFRAG(2), v3 = VFRAG(3);
#undef VFRAG
      o[0] = __builtin_amdgcn_mfma_scale_f32_32x32x64_f8f6f4(pf, v0, o[0], 0, 0, 0, 127, 0, 124);
      o[1] = __builtin_amdgcn_mfma_scale_f32_32x32x64_f8f6f4(pf, v1, o[1], 0, 0, 0, 127, 0, 124);
      o[2] = __builtin_amdgcn_mfma_scale_f32_32x32x64_f8f6f4(pf, v2, o[2], 0, 0, 0, 127, 0, 124);
      o[3] = __builtin_amdgcn_mfma_scale_f32_32x32x64_f8f6f4(pf, v3, o[3], 0, 0, 0, 127, 0, 124);
    }
    }
    if (j > 0 && __all(inited && slope2 * (float)(64 * j - 1) + SM - m_reg <= -12.f)) act = false;
    }
    if (i + 3 < NT) asm volatile("s_waitcnt vmcnt(4) lgkmcnt(0)\n\ts_barrier" ::: "memory");
    else if (i + 2 < NT) asm volatile("s_waitcnt vmcnt(2) lgkmcnt(0)\n\ts_barrier" ::: "memory");
    else asm volatile("s_waitcnt vmcnt(0) lgkmcnt(0)\n\ts_barrier" ::: "memory");
  }
  if (hi == 0) li_l[r32] = l_reg; asm volatile("s_waitcnt lgkmcnt(0)" ::: "memory");
  float rli[16];
#pragma unroll
  for (int r = 0; r < 16; ++r) rli[r] = __builtin_amdgcn_rcpf(li_l[crow(r, hi)]);
  unsigned char* stg = (unsigned char*)(lds + wid * 4096);
#pragma unroll
  for (int r = 0; r < 16; ++r) { const int orow = crow(r, hi); const float sc16 = rli[r] * 16.f;
#pragma unroll
    for (int d0 = 0; d0 < 4; ++d0) stg[orow * 128 + d0 * 32 + r32] = (unsigned char)__builtin_amdgcn_cvt_pk_fp8_f32(o[d0][r] * sc16, 0.f, 0, false); }
  asm volatile("s_waitcnt lgkmcnt(0)" ::: "memory");
#pragma unroll
  for (int i = 0; i < 4; ++i) { const int row = i * 8 + (lane >> 3), ch = lane & 7; const u32x4 v = *(const u32x4*)(stg + row * 128 + ch * 16);
    *(u32x4*)((unsigned char*)Ob + (size_t)(qh * 32 + row) * 1024 + head * 128 + ch * 16) = v; }
#undef DMA_TILE
}
#undef KSWZ
#undef SBAR
}


namespace ret {
using bf16x8 = __attribute__((ext_vector_type(8))) short;
using s16x4  = __attribute__((ext_vector_type(4))) short;
using u32x4  = __attribute__((ext_vector_type(4))) unsigned;
using u32x2  = __attribute__((ext_vector_type(2))) unsigned;
constexpr int C = 64, QP = 272, KPI = 272, VP = 576;
constexpr int OFF_Q = 0, OFF_K = 17408, OFF_V = 34816, OFF_ST = 71680, OFF_Y = 75776;
typedef float f32x2_t __attribute__((ext_vector_type(2))); typedef __bf16 bf16x2_t __attribute__((ext_vector_type(2)));
__device__ __forceinline__ unsigned cvtpk(float lo, float hi) { const f32x2_t v = {lo, hi}; const bf16x2_t b = __builtin_convertvector(v, bf16x2_t); return __builtin_bit_cast(unsigned, b); }
template <int OFF> __device__ __forceinline__ s16x4 trr(int base) { s16x4 r; asm volatile("ds_read_b64_tr_b16 %0, %1 offset:%2" : "=&v"(r) : "v"(base), "i"(OFF) : "memory"); return r; }
__device__ __forceinline__ bf16x8 pk8(const f32x16& x, int s) { u32x4 w = {cvtpk(x[8 * s + 0], x[8 * s + 1]), cvtpk(x[8 * s + 2], x[8 * s + 3]), cvtpk(x[8 * s + 4], x[8 * s + 5]), cvtpk(x[8 * s + 6], x[8 * s + 7])}; return *reinterpret_cast<bf16x8*>(&w); }
__device__ __forceinline__ float silu_(float x) { return x * __builtin_amdgcn_rcpf(1.f + __builtin_amdgcn_exp2f(-1.4426950408889634f * x)); }
__device__ __forceinline__ void ret_item(int b, int h, const unsigned char* __restrict__ RQ, const unsigned char* __restrict__ RK, const unsigned char* __restrict__ RV, const unsigned char* __restrict__ RG, unsigned char* A2F8, const float* __restrict__ gnorm, char* lds, int c0, int c1, float* state) {
  const int tid = threadIdx.x, w = __builtin_amdgcn_readfirstlane(tid >> 6), lane = tid & 63, r32 = lane & 31, hi = lane >> 5;
  const float lg = __log2f(1.f - exp2f(-5.f - (float)h)), gC = exp2f(64.f * lg);
  char* Qs = lds + OFF_Q; char* Ks = lds + OFF_K; char* Vs = lds + OFF_V; float* st = (float*)(lds + OFF_ST); char* Ys = lds + OFF_Y;
  f32x16 S[4] = {};
  if (c0 > 0) {
#pragma unroll
    for (int dt = 0; dt < 4; ++dt)
#pragma unroll
      for (int r = 0; r < 16; ++r) S[dt][r] = state[(dt * 16 + r) * 512 + tid]; }
  const unsigned voffQ = (unsigned)(((tid >> 4) * 512 + (tid & 15) * 8) * 2), voffV = (unsigned)(((tid >> 5) * 1024 + (tid & 31) * 8) * 2);
  const int trq = (lane & 15) >> 2, trp = lane & 3, trg = (lane >> 4) & 1;
  const int vtb = (int)(uintptr_t)(lds + OFF_V) + (4 * hi + trq) * VP + (32 * w + 16 * trg + 4 * trp) * 2, ktb = (int)(uintptr_t)(lds + OFF_K) + (4 * hi + trq) * KPI + (16 * trg + 4 * trp) * 2;
  u32x2 pq[2], pk[2], pv[4];
  const unsigned voffQ8 = (unsigned)((tid >> 4) * 512 + (tid & 15) * 8), voffV8 = voffV >> 1;
#define RET_LOAD(cc) do { const size_t t0_ = (size_t)b * SEQ + (size_t)(cc) * C; const unsigned char* qb_ = RQ + t0_ * 512 + h * 128; const unsigned char* kb_ = RK + t0_ * 512 + h * 128; const unsigned char* vb_ = RV + t0_ * 1024 + h * 256; \
    _Pragma("unroll") for (int i = 0; i < 2; ++i) { pq[i] = __builtin_nontemporal_load((const u32x2*)(qb_ + voffQ8 + i * 16384)); pk[i] = __builtin_nontemporal_load((const u32x2*)(kb_ + voffQ8 + i * 16384)); } \
    _Pragma("unroll") for (int i = 0; i < 4; ++i) pv[i] = __builtin_nontemporal_load((const u32x2*)(vb_ + voffV8 + i * 16384)); } while (0)
#define RET_F8(src_, f_, out_) do { const auto a_ = __builtin_amdgcn_cvt_pk_f32_fp8((int)(src_).x, false), b_ = __builtin_amdgcn_cvt_pk_f32_fp8((int)(src_).x, true), c_ = __builtin_amdgcn_cvt_pk_f32_fp8((int)(src_).y, false), d_ = __builtin_amdgcn_cvt_pk_f32_fp8((int)(src_).y, true); \
    out_.x = cvtpk(a_[0] * (f_), a_[1] * (f_)); out_.y = cvtpk(b_[0] * (f_), b_[1] * (f_)); out_.z = cvtpk(c_[0] * (f_), c_[1] * (f_)); out_.w = cvtpk(d_[0] * (f_), d_[1] * (f_)); } while (0)
#define RET_STAGE() do { \
    _Pragma("unroll") for (int i = 0; i < 2; ++i) { const int row = (tid >> 4) + 32 * i, ch = tid & 15; \
      u32x4 qo; RET_F8(pq[i], 1.f, qo); *(u32x4*)(Qs + row * QP + ch * 16) = qo; \
      const float f = exp2f(lg * (float)(C - 1 - row)) * 0.08838834764831845f; \
      u32x4 ko; RET_F8(pk[i], f, ko); *(u32x4*)(Ks + row * KPI + ch * 16) = ko; } \
    _Pragma("unroll") for (int i = 0; i < 4; ++i) { const int row = (tid >> 5) + 16 * i, ch = tid & 31; u32x4 vo; RET_F8(pv[i], 1.f, vo); *(u32x4*)(Vs + row * VP + ch * 16) = vo; } } while (0)
  RET_LOAD(c0);
  __syncthreads();
  RET_STAGE();
  if (c0 + 1 < c1) RET_LOAD(c0 + 1);
  __syncthreads();
  for (int c = c0; c < c1; ++c) {
    const size_t tok0 = (size_t)b * SEQ + (size_t)c * C;
    f32x16 ot[2] = {};
#pragma unroll
    for (int dt = 0; dt < 4; ++dt) {
#pragma unroll
      for (int s = 0; s < 2; ++s) { const bf16x8 af = pk8(S[dt], s);
#pragma unroll
        for (int nt = 0; nt < 2; ++nt) { const char* qp = Qs + (32 * nt + r32) * QP + (32 * dt + 16 * s + 4 * hi) * 2;
          const u32x2 lo = *(const u32x2*)qp, hi8 = *(const u32x2*)(qp + 16); const u32x4 bw = {lo.x, lo.y, hi8.x, hi8.y};
          ot[nt] = __builtin_amdgcn_mfma_f32_32x32x16_bf16(af, *reinterpret_cast<const bf16x8*>(&bw), ot[nt], 0, 0, 0); } }
      __builtin_amdgcn_sched_barrier(0); }
#pragma unroll
    for (int nt = 0; nt < 2; ++nt)
#pragma unroll
      for (int r = 0; r < 16; ++r) ot[nt][r] *= gC;
    __builtin_amdgcn_sched_barrier(0);
    bf16x8 vfr[4];
    { s16x4 vlo[4], vhi[4];
      vlo[0] = trr<0 * 16 * VP>(vtb); vhi[0] = trr<0 * 16 * VP + 8 * VP>(vtb); vlo[1] = trr<1 * 16 * VP>(vtb); vhi[1] = trr<1 * 16 * VP + 8 * VP>(vtb);
      vlo[2] = trr<2 * 16 * VP>(vtb); vhi[2] = trr<2 * 16 * VP + 8 * VP>(vtb); vlo[3] = trr<3 * 16 * VP>(vtb); vhi[3] = trr<3 * 16 * VP + 8 * VP>(vtb);
      asm volatile("s_waitcnt lgkmcnt(0)" : "+v"(vlo[0]), "+v"(vlo[1]), "+v"(vlo[2]), "+v"(vlo[3]), "+v"(vhi[0]), "+v"(vhi[1]), "+v"(vhi[2]), "+v"(vhi[3]) :: "memory"); __builtin_amdgcn_sched_barrier(0);
#pragma unroll
      for (int ks = 0; ks < 4; ++ks) vfr[ks] = (bf16x8){vlo[ks][0], vlo[ks][1], vlo[ks][2], vlo[ks][3], vhi[ks][0], vhi[ks][1], vhi[ks][2], vhi[ks][3]}; }
#pragma unroll
    for (int nt = 0; nt < 2; ++nt)
#pragma unroll
      for (int jt = 0; jt <= nt; ++jt) { f32x16 pt = {};
#pragma unroll
        for (int kk = 0; kk < 8; ++kk) { const bf16x8 ka = *(const bf16x8*)(Ks + (32 * jt + r32) * KPI + (16 * kk + 8 * hi) * 2), qb = *(const bf16x8*)(Qs + (32 * nt + r32) * QP + (16 * kk + 8 * hi) * 2);
          pt = __builtin_amdgcn_mfma_f32_32x32x16_bf16(ka, qb, pt, 0, 0, 0); }
        if (jt == nt) {
#pragma unroll
          for (int r = 0; r < 16; ++r) if (crow(r, hi) > r32) pt[r] = 0.f; }
#pragma unroll
        for (int s = 0; s < 2; ++s) ot[nt] = __builtin_amdgcn_mfma_f32_32x32x16_bf16(vfr[2 * jt + s], pk8(pt, s), ot[nt], 0, 0, 0);
        __builtin_amdgcn_sched_barrier(0); }
#pragma unroll
    for (int dt = 0; dt < 4; ++dt) {
#pragma unroll
      for (int r = 0; r < 16; ++r) S[dt][r] *= gC;
      s16x4 kl[4], kh[4];
      kl[0] = trr<0 * 16 * KPI>(ktb + dt * 64); kh[0] = trr<0 * 16 * KPI + 8 * KPI>(ktb + dt * 64); kl[1] = trr<1 * 16 * KPI>(ktb + dt * 64); kh[1] = trr<1 * 16 * KPI + 8 * KPI>(ktb + dt * 64);
      kl[2] = trr<2 * 16 * KPI>(ktb + dt * 64); kh[2] = trr<2 * 16 * KPI + 8 * KPI>(ktb + dt * 64); kl[3] = trr<3 * 16 * KPI>(ktb + dt * 64); kh[3] = trr<3 * 16 * KPI + 8 * KPI>(ktb + dt * 64);
      asm volatile("s_waitcnt lgkmcnt(0)" : "+v"(kl[0]), "+v"(kl[1]), "+v"(kl[2]), "+v"(kl[3]), "+v"(kh[0]), "+v"(kh[1]), "+v"(kh[2]), "+v"(kh[3]) :: "memory"); __builtin_amdgcn_sched_barrier(0);
#pragma unroll
      for (int ks = 0; ks < 4; ++ks) S[dt] = __builtin_amdgcn_mfma_f32_32x32x16_bf16((bf16x8){kl[ks][0], kl[ks][1], kl[ks][2], kl[ks][3], kh[ks][0], kh[ks][1], kh[ks][2], kh[ks][3]}, vfr[ks], S[dt], 0, 0, 0);
      __builtin_amdgcn_sched_barrier(0); }
    u32x2 gt4[4];
    { const unsigned char* gb_ = RG + tok0 * 1024 + h * 256;
#pragma unroll
      for (int i = 0; i < 4; ++i) gt4[i] = *(const u32x2*)(gb_ + (voffV >> 1) + i * 16384); }
#pragma unroll
    for (int nt = 0; nt < 2; ++nt) { const float rs = exp2f(lg * (float)(32 * nt + r32 + 1 - C)); float s1 = 0.f, s2 = 0.f;
#pragma unroll
      for (int r = 0; r < 16; ++r) { ot[nt][r] *= rs; s1 += ot[nt][r]; s2 += ot[nt][r] * ot[nt][r]; }
      s1 = xhalf_sum(s1); s2 = xhalf_sum(s2);
      if (hi == 0) { st[(w * 64 + 32 * nt + r32) * 2] = s1; st[(w * 64 + 32 * nt + r32) * 2 + 1] = s2; } }
    __syncthreads();
    if (c + 1 < c1) RET_STAGE();
    { const int cl_ = c + 2 < c1 ? c + 2 : c1 - 1; RET_LOAD(cl_); }
#pragma unroll
    for (int nt = 0; nt < 2; ++nt) { float s1 = 0.f, s2 = 0.f;
#pragma unroll
      for (int ww = 0; ww < 8; ++ww) { s1 += st[(ww * 64 + 32 * nt + r32) * 2]; s2 += st[(ww * 64 + 32 * nt + r32) * 2 + 1]; }
      const float mu = s1 * (1.f / 256.f), var = fmaxf(s2 * (1.f / 256.f) - mu * mu, 0.f), rstd = rsqrtf(var + EPS);
#pragma unroll
      for (int g = 0; g < 4; ++g) { float y[4];
#pragma unroll
        for (int j = 0; j < 4; ++j) y[j] = (ot[nt][4 * g + j] - mu) * rstd * gnorm[h * 256 + 32 * w + 8 * g + 4 * hi + j];
        const u32x2 o2 = {cvtpk(y[0], y[1]), cvtpk(y[2], y[3])};
        *(u32x2*)(Ys + (32 * nt + r32) * VP + (32 * w + 8 * g + 4 * hi) * 2) = o2; } }
    __syncthreads();
    { unsigned char* ob_ = A2F8 + tok0 * 1024 + h * 256;
#pragma unroll
      for (int i = 0; i < 4; ++i) { const int row = (tid >> 5) + 16 * i, ch = tid & 31;
        const u32x4 yv = *(const u32x4*)(Ys + row * VP + ch * 16); const u32x2 gt = gt4[i];
        const auto g01 = __builtin_amdgcn_cvt_pk_f32_fp8((int)gt.x, false), g23 = __builtin_amdgcn_cvt_pk_f32_fp8((int)gt.x, true), g45 = __builtin_amdgcn_cvt_pk_f32_fp8((int)gt.y, false), g67 = __builtin_amdgcn_cvt_pk_f32_fp8((int)gt.y, true);
        int w0 = __builtin_amdgcn_cvt_pk_fp8_f32(pg8::bf_lo(yv.x) * silu_(g01[0]), pg8::bf_hi(yv.x) * silu_(g01[1]), 0, false); w0 = __builtin_amdgcn_cvt_pk_fp8_f32(pg8::bf_lo(yv.y) * silu_(g23[0]), pg8::bf_hi(yv.y) * silu_(g23[1]), w0, true);
        int w1 = __builtin_amdgcn_cvt_pk_fp8_f32(pg8::bf_lo(yv.z) * silu_(g45[0]), pg8::bf_hi(yv.z) * silu_(g45[1]), 0, false); w1 = __builtin_amdgcn_cvt_pk_fp8_f32(pg8::bf_lo(yv.w) * silu_(g67[0]), pg8::bf_hi(yv.w) * silu_(g67[1]), w1, true);
        *(unsigned long long*)(ob_ + (size_t)row * 1024 + ch * 8) = (unsigned long long)(unsigned)w0 | ((unsigned long long)(unsigned)w1 << 32); } }
  }
  if (c1 < SEQ / C) {
#pragma unroll
    for (int dt = 0; dt < 4; ++dt)
#pragma unroll
      for (int r = 0; r < 16; ++r) state[(dt * 16 + r) * 512 + tid] = S[dt][r]; }
  __syncthreads();
#undef RET_LOAD
#undef RET_STAGE
#undef RET_F8
}
}


constexpr int RET_SPLIT = 26;
__device__ __forceinline__ int ret_wg_index(const Frame& F) { const int bx = (int)blockIdx.x, j = bx >> 3; return (j & 3) == 0 ? ((j >> 2) * 8 + (bx & 7)) : -1; }
__device__ __forceinline__ void p4_attn(Frame& F, const Args& a, unsigned char* lds_generic) {
    const size_t nt_ = (size_t)F.ntok;
    const bf16* QA = (const bf16*)(F.act + nt_ * O_QA); bf16* ATT = (bf16*)(F.act + nt_ * O_QA);
    unsigned char* aux = a.xb + nt_ * 2048;
    const bf16* KP = (const bf16*)(aux + nt_ * AUX_KP); const bf16* VV = (const bf16*)(aux + nt_ * AUX_VV); const unsigned* MASK = (const unsigned*)(aux + nt_ * AUX_MASK);
    volatile LAS unsigned* MISC = (volatile LAS unsigned*)(F.lds + MISC_OFF);
    unsigned* qctr = (unsigned*)(F.ws + WS_CTL) + CW_Q4;
    const unsigned char* RQ = F.act + nt_ * O_RQ; const unsigned char* RK = F.act + nt_ * O_RK; const unsigned char* RV = F.act + nt_ * O_RV; const unsigned char* RG = F.act + nt_ * O_RG;
    const int nb = F.ntok / SEQ, nret = nb * 4, nitems = nb * 64;
    { const int ri = ret_wg_index(F); if (ri >= 0 && ri < nret && RET_SPLIT < SEQ / 64)
        ret::ret_item(ri >> 2, ri & 3, RQ, RK, RV, RG, A2F8_PTR, a.in[8], (char*)lds_generic, RET_SPLIT, SEQ / 64, RSTATE_PTR + (size_t)ri * 32768); }
    float SM;
    { LAS float* red = (LAS float*)(F.lds + RING_OFF); const float* g_q = a.in[5]; const float* g_k = a.in[6];
      float gm = F.tid < 128 ? fabsf(g_k[F.tid] * g_q[F.tid]) : 0.f;
#pragma unroll
      for (int o = 32; o > 0; o >>= 1) gm = fmaxf(gm, __shfl_xor(gm, o));
      __syncthreads(); if (F.lane == 0) red[F.wave] = gm; __syncthreads();
      gm = fmaxf(red[0], red[1]); SM = 128.f * gm * (0.08838834764831845f * 1.4426950408889634f) * 1.13f * 1.02f; __syncthreads(); }
    __syncthreads(); if (F.tid == 0) MISC[0] = atomicAdd(qctr, 1u); __syncthreads();
    int it = (int)MISC[0];
    while (it < nitems) {
        const int half_ = nb * 32, hbase = it < half_ ? 4 : 0, iu = it < half_ ? it : it - half_; const int qb = 31 - iu / nb, b = iu % nb, NT = qb + 1;
        const size_t row0 = (size_t)b * SEQ + qb * 64;
        att::attn_item((const bf16*)((const unsigned char*)QA + row0 * 1024), (const bf16*)((const unsigned char*)KP + (size_t)b * SEQ * 128), (const bf16*)((const unsigned char*)VV + (size_t)b * SEQ * 128), MASK + (size_t)b * 64 * 2048 + qb * 64, (bf16*)((unsigned char*)ATT + row0 * 1024), NT, (char*)lds_generic, F.lds, SM, hbase);
        __syncthreads(); if (F.tid == 0) MISC[0] = atomicAdd(qctr, 1u); __syncthreads();
        it = (int)MISC[0];
    }
}


__device__ __forceinline__ void p7_router(Frame& F, const Args& a) {
    const int lane = F.lane, r32 = lane & 31, hi = lane >> 5, tid = F.tid;
    unsigned char* mo = F.act; unsigned char* N2 = mo + MO_N2; unsigned char* meta = mo + MO_META;
    (void)meta; int* LTOK = (int*)(mo + MO_LIST); float* LRS = (float*)(mo + MO_LIST) + 24 * LIST_CAP; float* LCL = LRS + 24 * LIST_CAP; float* LCH = LCL + 24 * LIST_CAP;
    const bf16* Wh = (const bf16*)(F.ws + WS_WR); const bf16* Wl = Wh + 32 * 1024;
    const float* g2 = a.in[12]; const float* b_gr = a.in[14]; const float* b_er = a.in[16];
    const bf16* hbase = (const bf16*)(F.act + MO_H16);
    unsigned* gcnt = (unsigned*)(F.ws + WS_CTL) + CW_MOE;
    LAS unsigned* lcnt = (LAS unsigned*)(F.lds + RING_OFF);
    if (tid < 64) lcnt[tid] = 0u;
    LAS unsigned char* Wlds = F.lds + 20480; LAS float* g2l = (LAS float*)(F.lds + 20480 + 98304);
    for (int i = tid; i < 2 * 24 * 128; i += NWAVES * 64) { const int c = i & 127, n = (i >> 7) % 24, hl = i / (24 * 128);
        *(LAS v4u*)(Wlds + (hl * 24 + n) * 2048 + ((c ^ (n & 15)) * 16)) = *(const v4u*)((hl ? Wl : Wh) + (size_t)n * 1024 + c * 8); }
    for (int i = tid; i < 256; i += NWAVES * 64) *(LAS f32x4*)(g2l + i * 4) = *(const f32x4*)(g2 + i * 4);
    __syncthreads();
    const int ntasks = F.ntok / 32, tpw = ntasks / F.G;
    const int tw = F.wave & 3, kh = F.wave >> 2;
    const bool have = tw < tpw; const int t = (F.vcu * tpw + tw) * 32 + r32;
    LAS float* xch = (LAS float*)(F.lds + RING_OFF + 1024);
    int bucket = 0, posl = 0; float clo = 0.f, chi = 0.f, rstd = 0.f;
    f32x16 acc = f32x16{}; float ss = 0.f;
    if (have) {
        const bf16* hrow = hbase + (size_t)t * D + hi * 8 + kh * 512; unsigned char* nrow = N2 + (size_t)t * D + hi * 8 + kh * 512;
        const LAS float* g2k = g2l + kh * 512 + hi * 8; const int rr = r32 < 24 ? r32 : r32 - 8;
        const LAS unsigned char* whk = Wlds + rr * 2048; const LAS unsigned char* wlk = Wlds + (24 + rr) * 2048; const int c0 = kh * 64 + hi, sw = rr & 15;
        v4u hvs[32];
#pragma unroll
        for (int kk = 0; kk < 32; ++kk) hvs[kk] = *(const v4u*)(hrow + kk * 16);
#pragma unroll
        for (int kk = 0; kk < 32; ++kk) {
            const v4u hv = hvs[kk]; const f32x4 a0 = {pg8::bf_lo(hv.x), pg8::bf_hi(hv.x), pg8::bf_lo(hv.y), pg8::bf_hi(hv.y)}, a1 = {pg8::bf_lo(hv.z), pg8::bf_hi(hv.z), pg8::bf_lo(hv.w), pg8::bf_hi(hv.w)};
            const f32x4 q0 = *(const LAS f32x4*)(g2k + kk * 16), q1 = *(const LAS f32x4*)(g2k + kk * 16 + 4);
            ss += (a0.x * a0.x + a0.y * a0.y) + (a0.z * a0.z + a0.w * a0.w) + (a1.x * a1.x + a1.y * a1.y) + (a1.z * a1.z + a1.w * a1.w);
            const float x[8] = {a0.x * q0.x, a0.y * q0.y, a0.z * q0.z, a0.w * q0.w, a1.x * q1.x, a1.y * q1.y, a1.z * q1.z, a1.w * q1.w};
            unsigned hb[8]; float lo[8];
#pragma unroll
            for (int j = 0; j < 8; ++j) { hb[j] = f2bf(x[j]); lo[j] = x[j] - __uint_as_float(hb[j] << 16); }
            v4u xh; xh.x = hb[0] | (hb[1] << 16); xh.y = hb[2] | (hb[3] << 16); xh.z = hb[4] | (hb[5] << 16); xh.w = hb[6] | (hb[7] << 16);
            v4u xl; xl.x = pk2(lo[0], lo[1]); xl.y = pk2(lo[2], lo[3]); xl.z = pk2(lo[4], lo[5]); xl.w = pk2(lo[6], lo[7]);
            { int w0 = __builtin_amdgcn_cvt_pk_fp8_f32(x[0], x[1], 0, false); w0 = __builtin_amdgcn_cvt_pk_fp8_f32(x[2], x[3], w0, true); int w1 = __builtin_amdgcn_cvt_pk_fp8_f32(x[4], x[5], 0, false); w1 = __builtin_amdgcn_cvt_pk_fp8_f32(x[6], x[7], w1, true);
              *(unsigned long long*)(nrow + kk * 16) = (unsigned long long)(unsigned)w0 | ((unsigned long long)(unsigned)w1 << 32); }
            const int co = ((c0 + kk * 2) ^ sw) * 16; const bf16x8_t wh = *(const LAS bf16x8_t*)(whk + co), wl = *(const LAS bf16x8_t*)(wlk + co);
            const bf16x8_t bh = __builtin_bit_cast(bf16x8_t, xh), bl = __builtin_bit_cast(bf16x8_t, xl);
            acc = __builtin_amdgcn_mfma_f32_32x32x16_bf16(wh, bh, acc, 0, 0, 0);
            acc = __builtin_amdgcn_mfma_f32_32x32x16_bf16(wh, bl, acc, 0, 0, 0);
            acc = __builtin_amdgcn_mfma_f32_32x32x16_bf16(wl, bh, acc, 0, 0, 0);
        }
        if (kh == 1) {
#pragma unroll
            for (int r = 0; r < 16; ++r) xch[(tw * 17 + r) * 64 + lane] = acc[r];
            xch[(tw * 17 + 16) * 64 + lane] = ss; }
    }
    __syncthreads();
    if (have && kh == 0) {
#pragma unroll
        for (int r = 0; r < 16; ++r) acc[r] += xch[(tw * 17 + r) * 64 + lane];
        ss += xch[(tw * 17 + 16) * 64 + lane];
        ss = xhalf_sum(ss); rstd = rsqrtf(ss * (1.f / D) + EPS);
        float L[24];
#pragma unroll
        for (int r = 0; r < 12; ++r) { const float v = acc[r]; auto rr = __builtin_amdgcn_permlane32_swap(__float_as_uint(v), __float_as_uint(v), false, false);
            L[(r & 3) + 8 * (r >> 2)] = __uint_as_float(rr[0]); L[(r & 3) + 8 * (r >> 2) + 4] = __uint_as_float(rr[1]); }
        float gl[4];
#pragma unroll
        for (int i = 0; i < 4; ++i) gl[i] = L[i] * rstd + b_gr[i];
        int g = 0; float gm = gl[0];
#pragma unroll
        for (int i = 1; i < 4; ++i) if (gl[i] > gm) { gm = gl[i]; g = i; }
        float se = 0.f;
#pragma unroll
        for (int i = 0; i < 4; ++i) se += __expf(gl[i] - gm);
        const float gw = 1.f / se;
        float el[4];
#pragma unroll
        for (int i = 0; i < 4; ++i) { const float l0 = L[4 + i], l1 = L[8 + i], l2 = L[12 + i], l3 = L[16 + i]; const float lv = g == 0 ? l0 : (g == 1 ? l1 : (g == 2 ? l2 : l3));
            const float b0 = b_er[i], b1 = b_er[4 + i], b2 = b_er[8 + i], b3 = b_er[12 + i]; el[i] = lv * rstd + (g == 0 ? b0 : (g == 1 ? b1 : (g == 2 ? b2 : b3))); }
        int i1 = 0; float v1 = el[0];
#pragma unroll
        for (int i = 1; i < 4; ++i) if (el[i] > v1) { v1 = el[i]; i1 = i; }
        int i2 = -1; float v2 = 0.f;
#pragma unroll
        for (int i = 0; i < 4; ++i) if (i != i1 && (i2 < 0 || el[i] > v2)) { v2 = el[i]; i2 = i; }
        const float e2 = __expf(v2 - v1), p1 = gw / (1.f + e2), p2 = gw * e2 / (1.f + e2);
        const int lo_ = i1 < i2 ? i1 : i2, hi_ = i1 < i2 ? i2 : i1;
        const int pair = lo_ == 0 ? (hi_ - 1) : (lo_ == 1 ? (hi_ + 1) : 5);
        bucket = g * 6 + pair; clo = i1 < i2 ? p1 : p2; chi = i1 < i2 ? p2 : p1;
        if (hi == 0) posl = (int)__hip_atomic_fetch_add(&lcnt[bucket], 1u, __ATOMIC_RELAXED, __HIP_MEMORY_SCOPE_WORKGROUP);
    }
    __syncthreads();
    if (tid < 24) lcnt[32 + tid] = atomicAdd(gcnt + tid, lcnt[tid]);
    __syncthreads();
    if (have && kh == 0 && hi == 0) { const int li = bucket * LIST_CAP + (int)lcnt[32 + bucket] + posl; LTOK[li] = t; LRS[li] = rstd; LCL[li] = clo; LCH[li] = chi; }
}
__device__ __forceinline__ int moe_tiles(const unsigned* gcnt, int* rowstart  ) { int rs = 0;
    for (int b = 0; b < 24; ++b) { rowstart[b] = rs; rs += (int)((gcnt[b] + 255u) & ~255u); } rowstart[24] = rs; return rs >> 8; }
template <bool GATHER_> struct MoeOrder {
    static constexpr bool GATHER = GATHER_; const int* ptok;
    int ntile, G, c; const char* A; size_t tA; const char* W; int mode; const LAS unsigned char* tb; size_t rowB;
    __device__ bool next(int i, pg8::Unit& u) const {
        const long L = (long)i * G + c; if (L >= (long)ntile * 4) return false;
        u.pm = (int)(L >> 2); u.pn = (int)(L & 3); u.a = GATHER_ ? A : A + (size_t)u.pm * tA;
        const int bk = tb[u.pm], g = bk / 6, pr = bk % 6; { const LAS int* t24 = (const LAS int*)(tb + 512); const int rs_ = t24[bk], cn_ = t24[24 + bk], left = cn_ - (u.pm * 256 - rs_); u.aux = bk * LIST_CAP - rs_; u.nvalid = left < 0 ? 0 : (left > 256 ? 256 : left); } const int lo = pr < 3 ? 0 : (pr < 5 ? 1 : 2), hi = pr < 3 ? pr + 1 : (pr < 5 ? pr - 1 : 3);
        const int elo = g * 4 + lo, ehi = g * 4 + hi;
        if (mode == 1) { const int e = u.pn < 2 ? elo : ehi; u.b = W + ((size_t)e * 512 + (size_t)(u.pn & 1) * 256) * rowB; u.bjump = 0; }
        else { u.b = W + ((size_t)elo * 1024 + (size_t)u.pn * 256) * rowB; u.bjump = (long)(ehi - elo) * 1024 * (long)rowB - (long)rowB; }
        return true;
    }
    __device__ __forceinline__ void a_ready(const pg8::Unit&) const {}
    __device__ __forceinline__ void done(const pg8::Unit&) const {}
};
__device__ __forceinline__ float silu_f(float x) { return x * __builtin_amdgcn_rcpf(1.f + __builtin_amdgcn_exp2f(-1.4426950408889634f * x)); }
struct EpiMoe1 {
    static constexpr bool PERM = true, AFTER_DRAIN = false;
    unsigned char* ACT; const float* PRS; const float* PCL; const float* PCH;
    __device__ __forceinline__ void operator()(const pg8::f32x4 (&acc)[2][2][4][2], const pg8::Unit& u, int wr, int wc, int fr, int fq) const {
        const int row0 = u.pm * pg8::BM + wr * 64 + fr, slot = u.pn >> 1, fcol0 = slot * 256 + (u.pn & 1) * 128 + wc * 16 + 4 * fq; const float* PC = slot ? PCH : PCL;
        float rsv[2][4], cwv[2][4];
#pragma unroll
        for (int ai = 0; ai < 2; ++ai)
#pragma unroll
            for (int m = 0; m < 4; ++m) { const int row = row0 + ai * pg8::HALF + m * 16; const bool ok = (wr * 64 + fr + ai * pg8::HALF + m * 16) < u.nvalid; const int li = u.aux + (ok ? row : u.pm * pg8::BM); const float r_ = PRS[li], c_ = PC[li];
                rsv[ai][m] = ok ? r_ : 0.f; cwv[ai][m] = ok ? c_ * 16.f : 0.f; }
#pragma unroll
        for (int ai = 0; ai < 2; ++ai)
#pragma unroll
            for (int m = 0; m < 4; ++m) { const int row = row0 + ai * pg8::HALF + m * 16; const float rs = rsv[ai][m], cw = cwv[ai][m]; unsigned char* rowp = ACT + (size_t)row * 512 + fcol0;
#pragma unroll
                for (int bj = 0; bj < 2; ++bj) { const pg8::f32x4 v0 = acc[ai][bj][m][0], v1 = acc[ai][bj][m][1];
                    const float a0 = silu_f(v0[0] * rs) * (v0[1] * rs) * cw, a1 = silu_f(v0[2] * rs) * (v0[3] * rs) * cw, a2 = silu_f(v1[0] * rs) * (v1[1] * rs) * cw, a3 = silu_f(v1[2] * rs) * (v1[3] * rs) * cw;
                    int w = __builtin_amdgcn_cvt_pk_fp8_f32(a0, a1, 0, false); w = __builtin_amdgcn_cvt_pk_fp8_f32(a2, a3, w, true); *(int*)(rowp + bj * 64) = w; } }
    }
};
struct EpiMoe2 {
    static constexpr bool PERM = true, AFTER_DRAIN = false;
    float* out; const pg8::bf16_t* h16; const int* PTOK;
    __device__ __forceinline__ void operator()(const pg8::f32x4 (&acc)[2][2][4][2], const pg8::Unit& u, int wr, int wc, int fr, int fq) const {
        const int row0 = u.pm * pg8::BM + wr * 64 + fr, col0 = u.pn * pg8::BM + wc * 32 + 8 * fq;
        int tk[2][4]; pg8::u32x4 hl[2][4][2];
#pragma unroll
        for (int ai = 0; ai < 2; ++ai)
#pragma unroll
            for (int m = 0; m < 4; ++m) { const int rr_ = wr * 64 + fr + ai * pg8::HALF + m * 16; const int l_ = PTOK[u.aux + (rr_ < u.nvalid ? row0 + ai * pg8::HALF + m * 16 : u.pm * pg8::BM)]; tk[ai][m] = rr_ < u.nvalid ? l_ : -1; }
#pragma unroll
        for (int ai = 0; ai < 2; ++ai)
#pragma unroll
            for (int m = 0; m < 4; ++m) { const pg8::bf16_t* hp = h16 + (size_t)(tk[ai][m] < 0 ? 0 : tk[ai][m]) * 1024 + col0;
#pragma unroll
                for (int bj = 0; bj < 2; ++bj) hl[ai][m][bj] = *(const pg8::u32x4*)(hp + bj * pg8::HALF); }
#pragma unroll
        for (int ai = 0; ai < 2; ++ai)
#pragma unroll
            for (int m = 0; m < 4; ++m) if (tk[ai][m] >= 0) { float* rowp = out + (size_t)tk[ai][m] * 1024 + col0;
#pragma unroll
                for (int bj = 0; bj < 2; ++bj) { const pg8::u32x4 hv = hl[ai][m][bj];
                    const pg8::f32x4 h0 = {pg8::bf_lo(hv.x), pg8::bf_hi(hv.x), pg8::bf_lo(hv.y), pg8::bf_hi(hv.y)}, h1 = {pg8::bf_lo(hv.z), pg8::bf_hi(hv.z), pg8::bf_lo(hv.w), pg8::bf_hi(hv.w)};
                    *(pg8::f32x4*)(rowp + bj * pg8::HALF) = h0 + acc[ai][bj][m][0]; *(pg8::f32x4*)(rowp + bj * pg8::HALF + 4) = h1 + acc[ai][bj][m][1]; } }
    }
};
__device__ __forceinline__ int moe_setup(Frame& F, LAS unsigned char* tb) {
    const unsigned* gcnt = (const unsigned*)(F.ws + WS_CTL) + CW_MOE;
    LAS int* nt_ = (LAS int*)(tb + 256); LAS int* t24 = (LAS int*)(tb + 512);
    __syncthreads();
    if (F.tid < 24) t24[24 + F.tid] = (int)gcnt[F.tid];
    __syncthreads();
    if (F.tid == 0) { int tl = 0; for (int b = 0; b < 24; ++b) { const int n = (t24[24 + b] + 255) >> 8; t24[b] = tl * 256; tl += n; } nt_[0] = tl; }
    __syncthreads();
    { const int ntile = nt_[0];
      if (F.tid < ntile) { const int r = F.tid * 256; int bb = 0;
#pragma unroll
        for (int b = 1; b < 24; ++b) bb = (t24[b] <= r && t24[24 + b] > 0) ? b : bb;
        tb[F.tid] = (unsigned char)bb; } }
    __syncthreads();
    return nt_[0];
}

__global__ void __launch_bounds__(NWAVES * 64, 2) mk_fwd(Args args) {
    extern __shared__ __attribute__((aligned(16))) unsigned char lds[];
    Frame F;
    F.lds = (LAS unsigned char*)lds;
    F.tid = threadIdx.x; F.lane = F.tid & 63; F.wave = __builtin_amdgcn_readfirstlane(F.tid >> 6);
    F.G = gridDim.x; { const int bx = blockIdx.x; F.vcu = (F.G % 8 == 0) ? (bx % 8) * (F.G / 8) + bx / 8 : bx; }
    F.ntok = args.ntok; F.ws = args.ws; F.act = args.ws + WS_ACT; F.xbp = args.xb;
    const int lo = args.ph_lo, hi = args.ph_hi;
    cooperative_groups::grid_group grid = cooperative_groups::this_grid();
    volatile LAS unsigned* MISCW = (volatile LAS unsigned*)(F.lds + MISC_OFF);
    for (int u = F.tid; u < (LDS_BYTES - LDSCTL_OFF) / 4; u += NWAVES * 64) ((LAS unsigned*)(F.lds + LDSCTL_OFF))[u] = 0u;
    __syncthreads();
#define IN(k) (lo <= (k) && (k) < hi)
#define SEAM(k) do { if (IN(k) && IN((k) + 1)) { xcd_barrier(bar); } } while (0)
    if (hi - lo > 1) {
        if (blockIdx.x == 0) { unsigned* cw = (unsigned*)(F.ws + WS_CTL);
            const int t = F.tid; int wi = -1;
            if (t < 16) wi = CW_BAR + XB_XCNT(t); else if (t < 32) wi = CW_BAR + XB_XSUB(t - 16); else if (t < 48) wi = CW_BAR + XB_XGEN(t - 32);
            else if (t == 48) wi = CW_BAR + XB_TMO; else if (t == 49) wi = CW_BAR + XB_TOP; else if (t == 50) wi = CW_BAR + XB_TOPGEN; else if (t == 51) wi = CW_Q3; else if (t == 52) wi = CW_Q4;
            else if (t >= 64 && t < 88) wi = CW_MOE + (t - 64);
            if (wi >= 0) __hip_atomic_store(cw + wi, 0u, __ATOMIC_RELAXED, __HIP_MEMORY_SCOPE_AGENT);
            __threadfence(); }
        grid.sync();
    }
    XcdBarrier bar = xcd_barrier_post((unsigned*)(F.ws + WS_CTL) + CW_BAR, MISCW + 8);
    if (IN(0)) { p0_prologue(F, args); }
    SEAM(0);
    if (IN(1)) {
        EpiProj E{F.act, (size_t)F.ntok, RSTD1_PTR};
        { pg8::Gemm g{512, 512, 512, 8};
          P1Order S; S.nM = F.ntok / 256; S.nN = 25; S.nwg = S.nM * 25; S.G = F.G; S.c = (int)blockIdx.x; S.mode = 0; S.A = (const char*)(args.xb + (size_t)F.ntok * AUX_XB8); S.Bt = (const char*)(F.ws + WS_WIN8); S.tA = (size_t)256 * 1024; S.tB = (size_t)256 * 1024;
          pg8::gemm_phase<EpiProj, P1Order, true, true, true>(F.lds + RING_OFF, g, S, E); }
        { pg8::Gemm g{1024, 1024, 1024, 16};
          P1Order S; S.nM = F.ntok / 256; S.nN = 3; S.nwg = S.nM * 3; S.G = F.G; S.c = ((int)blockIdx.x + F.G / 2) % F.G; S.mode = 1; S.A = (const char*)args.xb; S.Bt = (const char*)(F.ws + WS_WIN); S.tA = (size_t)256 * 2048; S.tB = (size_t)256 * 2048;
          pg8::gemm_phase<EpiProj, P1Order, true, true, false>(F.lds + RING_OFF, g, S, E); }
    }
    SEAM(1);
    if (IN(2)) { p2_post(F, args); }
    SEAM(2);
    if (IN(3)) {
        const int ri = ret_wg_index(F), nret = (F.ntok / SEQ) * 4;
        if (ri < 0) p3_index(F, args);
        else if (ri < nret) { const size_t nt_ = (size_t)F.ntok;
            ret::ret_item(ri >> 2, ri & 3, F.act + nt_ * O_RQ, F.act + nt_ * O_RK, F.act + nt_ * O_RV, F.act + nt_ * O_RG, A2F8_PTR, args.in[8], (char*)lds, 0, RET_SPLIT, RSTATE_PTR + (size_t)ri * 32768); }
    }
    SEAM(3);
    if (IN(4)) { p4_attn(F, args, lds); }
    SEAM(4);
    if (IN(5)) {
        const size_t nt_ = (size_t)F.ntok;
        const unsigned char* GA8 = F.act + nt_ * O_GA; const unsigned char* GR8 = F.act + nt_ * O_GR;
        pg8::Gemm g{512, 512, 512, 8, 122, 123};
        GateOrder S; S.S0.init(F.ntok, 1024, F.G, (int)blockIdx.x, F.act + nt_ * O_QA, 512, F.ws + WS_WATT8, 512); S.A1 = (const char*)A2F8_PTR; S.B1 = (const char*)(F.ws + WS_WRET8);
        EpiGateFused E{GA8, GR8, F.act + nt_ * O_MIX8};
        pg8::gemm_phase<EpiGateFused, GateOrder, true, true, true>(F.lds + RING_OFF, g, S, E);
    }
    SEAM(5);
    if (IN(6)) {
        pg8::Gemm g{512, 512, 512, 8, 122, 124}; const size_t nt_ = (size_t)F.ntok;
        pg8::StaticOrder S; S.init(F.ntok, 1024, F.G, (int)blockIdx.x, F.act + nt_ * O_MIX8, 512, F.ws + WS_WOUT8, 512);
        EpiResid E{(const pg8::bf16_t*)args.xb, (pg8::bf16_t*)(F.act + MO_H16)};
        pg8::gemm_phase<EpiResid, pg8::StaticOrder, true, true, true>(F.lds + RING_OFF, g, S, E);
    }
    SEAM(6);
    if (IN(7)) { p7_router(F, args); }
    SEAM(7);
    if (IN(9)) {
        LAS unsigned char* tb = F.lds + LDSCTL_OFF - 1024; const int ntile = moe_setup(F, tb);
        unsigned char* meta = F.act + MO_META;
        pg8::Gemm g{512, 512, 512, 8, 122, 127};
        MoeOrder<true> S{(const int*)(F.act + MO_LIST), ntile, F.G, F.vcu  , (const char*)(F.act + MO_N2), (size_t)0, (const char*)(F.ws + WS_W18), 1, tb, (size_t)1024};
        EpiMoe1 E{(unsigned char*)(F.act + MO_ACT), (const float*)(F.act + MO_LIST) + 24 * LIST_CAP, (const float*)(F.act + MO_LIST) + 48 * LIST_CAP, (const float*)(F.act + MO_LIST) + 72 * LIST_CAP};
        pg8::gemm_phase<EpiMoe1, MoeOrder<true>, true, true, true>(F.lds + RING_OFF, g, S, E);
    }
    SEAM(9);
    if (IN(10)) {
        LAS unsigned char* tb = F.lds + LDSCTL_OFF - 1024; const int ntile = moe_setup(F, tb);
        unsigned char* meta = F.act + MO_META;
        pg8::Gemm g{256, 256, 128, 2, 123, 123};
        MoeOrder<false> S{nullptr, ntile, F.G, F.vcu, (const char*)(F.act + MO_ACT), (size_t)256 * 512, (const char*)(F.ws + WS_WD8), 2, tb, (size_t)256};
        EpiMoe2 E{args.out + (size_t)args.tok0 * D, (const pg8::bf16_t*)(F.act + MO_H16), (const int*)(F.act + MO_LIST)};
        pg8::gemm_phase<EpiMoe2, MoeOrder<false>, true, true, true>(F.lds + RING_OFF, g, S, E);
    }

#undef IN
#undef SEAM
}

extern "C" void kernel_launch(void* const* d_in, const int* in_sizes, int n_in, void* d_out, int out_size, void* d_ws, size_t ws_size, hipStream_t stream) {
    static int grid = 0;
    if (grid == 0) {
        int dev = 0, cus = 0, per_cu = 0;
        (void)hipGetDevice(&dev); (void)hipDeviceGetAttribute(&cus, hipDeviceAttributeMultiprocessorCount, dev);
        if (hipFuncSetAttribute((const void*)mk_fwd, hipFuncAttributeMaxDynamicSharedMemorySize, LDS_BYTES) != hipSuccess) { fprintf(stderr, "kernel_launch: hipFuncSetAttribute failed\n"); grid = -1; return; }
        (void)hipOccupancyMaxActiveBlocksPerMultiprocessor(&per_cu, (const void*)mk_fwd, NWAVES * 64, LDS_BYTES);
        (void)hipGetLastError();
        if (per_cu < 1) { fprintf(stderr, "kernel_launch: occupancy query says %d blocks per CU\n", per_cu); per_cu = 1; }
        grid = cus * per_cu;
        if (n_in != 20 || ws_size < (size_t)512 * MiB) { fprintf(stderr, "kernel_launch: unexpected n_in %d / ws_size %zu\n", n_in, ws_size); grid = -1; return; }
        if (grid != 256) { fprintf(stderr, "kernel_launch: this kernel's phase schedules are written for a 256-workgroup grid (256 CUs x 1); the device reports %d x %d; nothing launched\n", cus, per_cu); grid = -1; return; }
    }
    if (grid < 0) return;
    float* out = (float*)d_out;
    unsigned char* ws = (unsigned char*)d_ws;
    (void)in_sizes; (void)out_size;
    if (PROBE_PH >= 0) (void)hipMemsetAsync(ws + WS_CTL, 0, CTL_ZERO_BYTES, stream);
    Args a{};
    for (int i = 0; i < 20; ++i) a.in[i] = (const float*)d_in[i];
    a.out = out; a.ws = ws; a.xb = (unsigned char*)d_out; a.ntok = T; a.tok0 = 0;
    void* kargs[] = {(void*)&a};
    if (PROBE_PH >= 0) { a.ph_lo = PROBE_PH; a.ph_hi = PROBE_PH + 1; a.mode = PROBE_MODE;
        (void)hipLaunchCooperativeKernel((const void*)mk_fwd, dim3(grid), dim3(NWAVES * 64), kargs, (unsigned)LDS_BYTES, stream);
        (void)hipMemsetAsync(ws + WS_CTL, 0, CTL_ZERO_BYTES, stream); }
    a.ph_lo = 0; a.ph_hi = 11; a.mode = 0;
    const hipError_t le = hipLaunchCooperativeKernel((const void*)mk_fwd, dim3(grid), dim3(NWAVES * 64), kargs, (unsigned)LDS_BYTES, stream);
    if (le != hipSuccess) fprintf(stderr, "kernel_launch: cooperative launch failed: %s (grid %d)\n", hipGetErrorString(le), grid);
}
```
